# Optimizing an MI355X kernel written in HIP

```python
import math
import jax, jax.numpy as jnp
from jax import lax
import numpy as np


D_MODEL = 1024
BATCH = 2
SEQ = 8192
DEPTH = 2

SSM_GROUP = 16
SSM_STATE = 64
SSM_WIDTH = D_MODEL // 2
SSM_GROUPS = SSM_WIDTH // SSM_GROUP
HEAD_DIM = 64
N_HEADS = D_MODEL // HEAD_DIM
N_KV = N_HEADS // 4
HPG = N_HEADS // N_KV
ATTN_WIDTH = N_HEADS * HEAD_DIM
KV_WIDTH = N_KV * HEAD_DIM
CMP_BLOCK = 32
CMP_STRIDE = 16
CMP_HIDDEN = 4 * HEAD_DIM
SLC_BLOCK = 64
SLC_TOPK = 16
WINDOW = 512
Q_CHUNK = 64
FORCED_SCORE = 1e4
IN_WIDTH = ATTN_WIDTH + 6 * KV_WIDTH + 3 * N_HEADS + SSM_WIDTH + 2 * D_MODEL
N_GROUPS = 4
EXP_PER_GROUP = 8
N_EXPERTS = N_GROUPS * EXP_PER_GROUP
TOPK_IN_GROUP = 2
D_EXPERT = D_MODEL // 4
MOE_BLOCK = 128
EPS = 1e-6
NEG = -1e30

kernel_name = "hybrid_s5_nsa_hmoe_adaln"


def rms_norm(x, g):
    xf = x.astype(jnp.float32)
    y = xf * lax.rsqrt(jnp.mean(xf * xf, axis=-1, keepdims=True) + EPS)
    return (y * g.astype(jnp.float32)).astype(x.dtype)


def masked_softmax(s, mask):
    p = jax.nn.softmax(jnp.where(mask, s.astype(jnp.float32), NEG), axis=-1)
    return p * mask


def s5_mixer(u, lam_re, lam_im, log_dt, b_re, b_im, c_re, c_im, d_skip, w_glu):
    f32 = jnp.float32
    Bsz, L, _ = u.shape
    ug = u.astype(f32).reshape(Bsz, L, SSM_GROUPS, SSM_GROUP)
    dt = jnp.exp(log_dt.astype(f32))[:, None]
    lr, li = lam_re.astype(f32), lam_im.astype(f32)
    mag = jnp.exp(lr * dt)
    ab_re, ab_im = mag * jnp.cos(li * dt), mag * jnp.sin(li * dt)
    den = lr * lr + li * li
    nr = ab_re - 1.0
    cr = (nr * lr + ab_im * li) / den
    cim = (ab_im * lr - nr * li) / den
    br, bim = b_re.astype(f32), b_im.astype(f32)
    bb_re = cr[..., None] * br - cim[..., None] * bim
    bb_im = cr[..., None] * bim + cim[..., None] * br
    bu_re = jnp.einsum('blgh,gph->blgp', ug, bb_re)
    bu_im = jnp.einsum('blgh,gph->blgp', ug, bb_im)
    a_re = jnp.broadcast_to(ab_re, bu_re.shape)
    a_im = jnp.broadcast_to(ab_im, bu_im.shape)

    def combine(e1, e2):
        a1r, a1i, b1r, b1i = e1
        a2r, a2i, b2r, b2i = e2
        return (a2r * a1r - a2i * a1i, a2r * a1i + a2i * a1r,
                a2r * b1r - a2i * b1i + b2r, a2r * b1i + a2i * b1r + b2i)

    _, _, s_re, s_im = lax.associative_scan(combine, (a_re, a_im, bu_re, bu_im), axis=1)
    y = (jnp.einsum('blgp,ghp->blgh', s_re, c_re.astype(f32))
         - jnp.einsum('blgp,ghp->blgh', s_im, c_im.astype(f32))
         + d_skip.astype(f32) * ug)
    y = jax.nn.gelu(y.reshape(Bsz, L, SSM_WIDTH))
    y = y * jax.nn.sigmoid(y @ w_glu.astype(f32))
    return y.astype(u.dtype)


def compress_kv(kv, pos, w1, w2):
    Bsz, L, G, hd = kv.shape
    n_cmp = (L - CMP_BLOCK) // CMP_STRIDE + 1
    idx = jnp.arange(n_cmp)[:, None] * CMP_STRIDE + jnp.arange(CMP_BLOCK)[None, :]
    blocks = kv[:, idx] + pos[:, None, :]
    blocks = jnp.swapaxes(blocks, 2, 3).reshape(Bsz, n_cmp, G, CMP_BLOCK * hd)
    return jax.nn.gelu(blocks @ w1) @ w2


def nsa_attention(q, k_cmp, v_cmp, k_slc, v_slc, k_win, v_win, gates, cmp_pos, cmp_w1, cmp_w2):
    Bsz, L = q.shape[:2]
    n_cmp = (L - CMP_BLOCK) // CMP_STRIDE + 1
    n_slc = L // SLC_BLOCK
    n_sel = min(SLC_TOPK, n_slc)
    n_chunks = L // Q_CHUNK
    scale = HEAD_DIM ** -0.5
    kc = compress_kv(k_cmp, cmp_pos[0], cmp_w1[0], cmp_w2[0])
    vc = compress_kv(v_cmp, cmp_pos[1], cmp_w1[1], cmp_w2[1])
    cmp_end = jnp.arange(n_cmp) * CMP_STRIDE + CMP_BLOCK - 1
    c_start = jnp.arange(n_cmp)[:, None] * CMP_STRIDE
    s_start = jnp.arange(n_slc)[None, :] * SLC_BLOCK
    overlap = ((c_start < s_start + SLC_BLOCK) & (c_start + CMP_BLOCK > s_start)).astype(jnp.float32)
    ks_blk = jnp.moveaxis(k_slc.reshape(Bsz, n_slc, SLC_BLOCK, N_KV, HEAD_DIM), 3, 1)
    vs_blk = jnp.moveaxis(v_slc.reshape(Bsz, n_slc, SLC_BLOCK, N_KV, HEAD_DIM), 3, 1)
    kw = jnp.pad(k_win, ((0, 0), (WINDOW, 0), (0, 0), (0, 0)))
    vw = jnp.pad(v_win, ((0, 0), (WINDOW, 0), (0, 0), (0, 0)))
    bi = jnp.arange(Bsz)[:, None, None, None]
    gi = jnp.arange(N_KV)[None, :, None, None]
    blk = jnp.arange(n_slc)

    def chunk(args):
        c_idx, qc, gc = args
        t = c_idx * Q_CHUNK + jnp.arange(Q_CHUNK)
        s = jnp.einsum('bqghd,bngd->bqghn', qc, kc) * scale
        m = cmp_end[None, :] <= t[:, None]
        p_cmp = masked_softmax(s, m[None, :, None, None, :])
        o_cmp = jnp.einsum('bqghn,bngd->bqghd', p_cmp.astype(vc.dtype), vc)
        imp = jnp.einsum('bqghn,ns->bqgs', p_cmp, overlap)
        cur = t[:, None] // SLC_BLOCK
        forced = (blk[None, :] == 0) | (blk[None, :] == cur) | (blk[None, :] == cur - 1)
        future = blk[None, :] * SLC_BLOCK > t[:, None]
        imp = jnp.where(forced[None, :, None, :], FORCED_SCORE, imp)
        imp = jnp.where(future[None, :, None, :], -1.0, imp)
        _, sel = lax.top_k(imp, n_sel)
        sel = jnp.transpose(sel, (0, 2, 1, 3))
        ks = ks_blk[bi, gi, sel].reshape(Bsz, N_KV, Q_CHUNK, n_sel * SLC_BLOCK, HEAD_DIM)
        vs = vs_blk[bi, gi, sel].reshape(Bsz, N_KV, Q_CHUNK, n_sel * SLC_BLOCK, HEAD_DIM)
        kpos = (sel[..., None] * SLC_BLOCK + jnp.arange(SLC_BLOCK)).reshape(Bsz, N_KV, Q_CHUNK, n_sel * SLC_BLOCK)
        m = jnp.transpose(kpos <= t[None, None, :, None], (0, 2, 1, 3))[:, :, :, None, :]
        s = jnp.einsum('bqghd,bgqkd->bqghk', qc, ks) * scale
        p = masked_softmax(s, m)
        o_slc = jnp.einsum('bqghk,bgqkd->bqghd', p.astype(vs.dtype), vs)
        start = c_idx * Q_CHUNK
        kwc = lax.dynamic_slice_in_dim(kw, start, WINDOW + Q_CHUNK, axis=1)
        vwc = lax.dynamic_slice_in_dim(vw, start, WINDOW + Q_CHUNK, axis=1)
        wpos = start - WINDOW + jnp.arange(WINDOW + Q_CHUNK)
        d = t[:, None] - wpos[None, :]
        m = (d >= 0) & (d < WINDOW) & (wpos[None, :] >= 0)
        s = jnp.einsum('bqghd,bkgd->bqghk', qc, kwc) * scale
        p = masked_softmax(s, m[None, :, None, None, :])
        o_win = jnp.einsum('bqghk,bkgd->bqghd', p.astype(vwc.dtype), vwc)
        return (gc[:, :, 0, :, :, None] * o_cmp + gc[:, :, 1, :, :, None] * o_slc
                + gc[:, :, 2, :, :, None] * o_win)

    q_ch = jnp.moveaxis(q.reshape(Bsz, n_chunks, Q_CHUNK, N_KV, HPG, HEAD_DIM), 1, 0)
    g_ch = jnp.moveaxis(gates.reshape(Bsz, n_chunks, Q_CHUNK, 3, N_KV, HPG), 1, 0)
    o = lax.map(chunk, (jnp.arange(n_chunks), q_ch, g_ch))
    return jnp.moveaxis(o, 0, 1).reshape(Bsz, L, ATTN_WIDTH)


def token_mixer(h, w_in, ssm_lam_re, ssm_lam_im, ssm_log_dt, ssm_b_re, ssm_b_im, ssm_c_re, ssm_c_im,
                ssm_d, ssm_w_glu, ssm_w_o, nsa_cmp_pos, nsa_cmp_w1, nsa_cmp_w2, nsa_w_o, w_out):
    Bsz, L, _ = h.shape
    proj = h @ w_in
    o1 = ATTN_WIDTH
    o2 = o1 + 6 * KV_WIDTH
    o3 = o2 + 3 * N_HEADS
    o4 = o3 + SSM_WIDTH
    q, kv, nsa_g, u, merge_g = jnp.split(proj, [o1, o2, o3, o4], axis=-1)
    k_cmp, v_cmp, k_slc, v_slc, k_win, v_win = [t.reshape(Bsz, L, N_KV, HEAD_DIM) for t in jnp.split(kv, 6, axis=-1)]
    attn = nsa_attention(q.reshape(Bsz, L, N_KV, HPG, HEAD_DIM), k_cmp, v_cmp, k_slc, v_slc, k_win, v_win,
                         jax.nn.sigmoid(nsa_g).reshape(Bsz, L, 3, N_KV, HPG), nsa_cmp_pos, nsa_cmp_w1, nsa_cmp_w2)
    ssm = s5_mixer(u, ssm_lam_re, ssm_lam_im, ssm_log_dt, ssm_b_re, ssm_b_im, ssm_c_re, ssm_c_im, ssm_d, ssm_w_glu)
    g_attn, g_ssm = jnp.split(jax.nn.sigmoid(merge_g), 2, axis=-1)
    merged = g_attn * (attn @ nsa_w_o) + g_ssm * (ssm @ ssm_w_o)
    return merged @ w_out


def hier_moe(h, w_group, b_group, w_expert, b_expert, w_gate, w_up, w_down):
    Bsz, L, D = h.shape
    xt = h.reshape(-1, D)
    N = xt.shape[0]
    g_prob = jax.nn.softmax((xt @ w_group + b_group).astype(jnp.float32), axis=-1)
    g_p, g_idx = lax.top_k(g_prob, 1)
    e_logits = (xt @ w_expert + b_expert).astype(jnp.float32).reshape(N, N_GROUPS, EXP_PER_GROUP)
    e_logits = jnp.take_along_axis(e_logits, jnp.broadcast_to(g_idx[:, :, None], (N, 1, EXP_PER_GROUP)), axis=1)[:, 0]
    e_p, e_idx = lax.top_k(jax.nn.softmax(e_logits, axis=-1), TOPK_IN_GROUP)
    w = g_p * e_p / jnp.sum(e_p, axis=-1, keepdims=True)
    eid = g_idx * EXP_PER_GROUP + e_idx
    A = N * TOPK_IN_GROUP
    flat_e = eid.reshape(-1)
    flat_t = jnp.repeat(jnp.arange(N, dtype=jnp.int32), TOPK_IN_GROUP)
    flat_w = w.reshape(-1)
    order = jnp.argsort(flat_e)
    se = flat_e[order]
    counts = jnp.zeros(N_EXPERTS, jnp.int32).at[flat_e].add(1)
    starts = jnp.cumsum(counts) - counts
    pcounts = (counts + MOE_BLOCK - 1) // MOE_BLOCK * MOE_BLOCK
    pends = jnp.cumsum(pcounts)
    pstarts = pends - pcounts
    dest = pstarts[se] + jnp.arange(A) - starts[se]
    P = A + N_EXPERTS * MOE_BLOCK
    n_blk = P // MOE_BLOCK
    buf_t = jnp.zeros(P, jnp.int32).at[dest].set(flat_t[order])
    buf_w = jnp.zeros(P, jnp.float32).at[dest].set(flat_w[order])
    blk_e = jnp.minimum(jnp.searchsorted(pends, jnp.arange(n_blk) * MOE_BLOCK, side='right'), N_EXPERTS - 1)
    xs = xt[buf_t].reshape(n_blk, MOE_BLOCK, D)

    def expert_block(args):
        xb, e = args
        return (jax.nn.silu(xb @ w_gate[e]) * (xb @ w_up[e])) @ w_down[e]

    ys = lax.map(expert_block, (xs, blk_e)).reshape(P, D)
    out = jnp.zeros((N, D), jnp.float32).at[buf_t].add(ys.astype(jnp.float32) * buf_w[:, None])
    return out.astype(h.dtype).reshape(Bsz, L, D)


def setup_inputs(seed: int = 0) -> dict:
    key = jax.random.key(seed)
    ks = jax.random.split(key, 32)
    f32 = jnp.float32

    def nrm(k, shape, s):
        return jax.random.normal(k, shape, f32) * s

    n_idx = jnp.arange(SSM_STATE, dtype=f32)
    return {
        'x': nrm(ks[0], (BATCH, SEQ, D_MODEL), 1.0),
        'c': nrm(ks[1], (BATCH, D_MODEL), 1.0),
        'ada_w': nrm(ks[2], (DEPTH, D_MODEL, 6 * D_MODEL), 0.5 * D_MODEL ** -0.5),
        'ada_b': nrm(ks[3], (DEPTH, 6 * D_MODEL), 0.01),
        'norm1_g': 1.0 + nrm(ks[4], (DEPTH, D_MODEL), 0.02),
        'w_in': nrm(ks[5], (DEPTH, D_MODEL, IN_WIDTH), D_MODEL ** -0.5),
        'ssm_lam_re': -0.5 + nrm(ks[6], (DEPTH, SSM_GROUPS, SSM_STATE), 0.01),
        'ssm_lam_im': math.pi * n_idx + nrm(ks[7], (DEPTH, SSM_GROUPS, SSM_STATE), 0.01),
        'ssm_log_dt': jax.random.uniform(ks[8], (DEPTH, SSM_GROUPS), f32, math.log(1e-3), math.log(1e-1)),
        'ssm_b_re': nrm(ks[9], (DEPTH, SSM_GROUPS, SSM_STATE, SSM_GROUP), (2 * SSM_GROUP) ** -0.5),
        'ssm_b_im': nrm(ks[10], (DEPTH, SSM_GROUPS, SSM_STATE, SSM_GROUP), (2 * SSM_GROUP) ** -0.5),
        'ssm_c_re': nrm(ks[11], (DEPTH, SSM_GROUPS, SSM_GROUP, SSM_STATE), SSM_STATE ** -0.5),
        'ssm_c_im': nrm(ks[12], (DEPTH, SSM_GROUPS, SSM_GROUP, SSM_STATE), SSM_STATE ** -0.5),
        'ssm_d': nrm(ks[13], (DEPTH, SSM_GROUPS, SSM_GROUP), 1.0),
        'ssm_w_glu': nrm(ks[14], (DEPTH, SSM_WIDTH, SSM_WIDTH), SSM_WIDTH ** -0.5),
        'ssm_w_o': nrm(ks[15], (DEPTH, SSM_WIDTH, D_MODEL), SSM_WIDTH ** -0.5),
        'nsa_cmp_pos': nrm(ks[16], (DEPTH, 2, CMP_BLOCK, HEAD_DIM), 0.02),
        'nsa_cmp_w1': nrm(ks[17], (DEPTH, 2, CMP_BLOCK * HEAD_DIM, CMP_HIDDEN), (CMP_BLOCK * HEAD_DIM) ** -0.5),
        'nsa_cmp_w2': nrm(ks[18], (DEPTH, 2, CMP_HIDDEN, HEAD_DIM), CMP_HIDDEN ** -0.5),
        'nsa_w_o': nrm(ks[19], (DEPTH, ATTN_WIDTH, D_MODEL), ATTN_WIDTH ** -0.5),
        'w_out': nrm(ks[20], (DEPTH, D_MODEL, D_MODEL), D_MODEL ** -0.5),
        'norm2_g': 1.0 + nrm(ks[21], (DEPTH, D_MODEL), 0.02),
        'moe_w_group': nrm(ks[22], (DEPTH, D_MODEL, N_GROUPS), D_MODEL ** -0.5),
        'moe_b_group': nrm(ks[23], (DEPTH, N_GROUPS), 0.01),
        'moe_w_expert': nrm(ks[24], (DEPTH, D_MODEL, N_EXPERTS), D_MODEL ** -0.5),
        'moe_b_expert': nrm(ks[25], (DEPTH, N_EXPERTS), 0.01),
        'moe_w_gate': nrm(ks[26], (DEPTH, N_EXPERTS, D_MODEL, D_EXPERT), D_MODEL ** -0.5),
        'moe_w_up': nrm(ks[27], (DEPTH, N_EXPERTS, D_MODEL, D_EXPERT), D_MODEL ** -0.5),
        'moe_w_down': nrm(ks[28], (DEPTH, N_EXPERTS, D_EXPERT, D_MODEL), D_EXPERT ** -0.5),
        'final_g': 1.0 + nrm(ks[29], (D_MODEL,), 0.02),
    }


def reference(x, c, ada_w, ada_b, norm1_g, w_in, ssm_lam_re, ssm_lam_im, ssm_log_dt, ssm_b_re, ssm_b_im,
              ssm_c_re, ssm_c_im, ssm_d, ssm_w_glu, ssm_w_o, nsa_cmp_pos, nsa_cmp_w1, nsa_cmp_w2, nsa_w_o,
              w_out, norm2_g, moe_w_group, moe_b_group, moe_w_expert, moe_b_expert, moe_w_gate, moe_w_up,
              moe_w_down, final_g):
    cs = jax.nn.silu(c)
    for l in range(DEPTH):
        mod = cs @ ada_w[l] + ada_b[l]
        sh1, sc1, g1, sh2, sc2, g2 = jnp.split(mod[:, None, :], 6, axis=-1)
        h = rms_norm(x, norm1_g[l]) * (1.0 + sc1) + sh1
        x = x + g1 * token_mixer(h, w_in[l], ssm_lam_re[l], ssm_lam_im[l], ssm_log_dt[l], ssm_b_re[l],
                                 ssm_b_im[l], ssm_c_re[l], ssm_c_im[l], ssm_d[l], ssm_w_glu[l], ssm_w_o[l],
                                 nsa_cmp_pos[l], nsa_cmp_w1[l], nsa_cmp_w2[l], nsa_w_o[l], w_out[l])
        h = rms_norm(x, norm2_g[l]) * (1.0 + sc2) + sh2
        x = x + g2 * hier_moe(h, moe_w_group[l], moe_b_group[l], moe_w_expert[l], moe_b_expert[l],
                              moe_w_gate[l], moe_w_up[l], moe_w_down[l])
    return rms_norm(x, final_g)
```

```cpp
#include <hip/hip_runtime.h>
#include <hip/hip_cooperative_groups.h>
#include <cstdio>
#include <cstdint>
namespace cg = cooperative_groups;

#ifndef EN_MIXER
#define EN_MIXER 1
#endif
#ifndef EN_ATTN
#define EN_ATTN 1
#endif
#ifndef EN_MOE
#define EN_MOE 1
#endif

#define DI __device__ __forceinline__
typedef unsigned short bf16_t;
typedef short bf16x8 __attribute__((ext_vector_type(8)));
typedef short s16x4 __attribute__((ext_vector_type(4)));
typedef float f32x4 __attribute__((ext_vector_type(4)));
typedef float f32x16 __attribute__((ext_vector_type(16)));
typedef unsigned u32x4 __attribute__((ext_vector_type(4)));
typedef unsigned u32x2 __attribute__((ext_vector_type(2)));

constexpr int DM = 1024, NB = 2, SEQ = 8192, NT = NB * SEQ, DEPTH = 2;
constexpr int INW = 5168, INWP = 5376;
constexpr int NTHR = 512, NWAVE = 8;
constexpr int NEXP = 32, LISTCAP = 16384;
constexpr float EPS = 1e-6f;
constexpr float QSCALE = 0.125f * 1.4426950408889634f;

constexpr size_t MiB = 1u << 20;
constexpr size_t WS_CNT = 0;
constexpr size_t WS_BAR = 1024;
constexpr size_t WS_ZERO_BYTES = 16384;
constexpr size_t WS_MOD = 16384;
constexpr size_t WS_CB = WS_MOD + 2 * 2 * 6144 * 4;
constexpr size_t WS_S5P = WS_CB + 2 * 2 * 256 * 4;
constexpr size_t WS_WT = WS_S5P + 2 * 32 * 64 * 36 * 4;
constexpr size_t WS_SMALL_END = WS_WT + (size_t)NT * 2 * 4;
static_assert(WS_SMALL_END <= 1 * MiB, "small region");
constexpr size_t WS_W = 1 * MiB;
constexpr size_t W_IN = 0;
constexpr size_t W_GLU = W_IN + (size_t)INWP * 1024 * 2;
constexpr size_t W_O = W_GLU + 512 * 512 * 2;
constexpr size_t W_SO = W_O + 1024 * 1024 * 2;
constexpr size_t W_OUT = W_SO + 1024 * 512 * 2;
constexpr size_t W_C1 = W_OUT + 1024 * 1024 * 2;
constexpr size_t W_C2 = W_C1 + 2 * 256 * 2048 * 2;
constexpr size_t W_GU = W_C2 + 2 * 128 * 256 * 2;
constexpr size_t W_D = W_GU + (size_t)32 * 512 * 1024 * 2;
constexpr size_t W_END = W_D + (size_t)32 * 1024 * 256 * 2;
static_assert(W_END <= 67 * MiB, "weights region");
constexpr size_t WS_A = 68 * MiB;
constexpr size_t WS_B = WS_A + 32 * MiB;
constexpr size_t WS_C = WS_B + 32 * MiB;
constexpr size_t WS_DV = WS_C + 32 * MiB;
constexpr size_t WS_E = WS_DV + 16 * MiB;
constexpr size_t WS_F = WS_E + 32 * MiB;
constexpr size_t WS_G = WS_F + 64 * MiB;
constexpr size_t WS_GATES = WS_G + 16 * MiB;
constexpr size_t WS_HID = WS_GATES + 3 * MiB;
constexpr size_t WS_KC = WS_HID + 4 * MiB;
constexpr size_t WS_VC = WS_KC + 512 * 1024;
constexpr size_t WS_L = WS_VC + 512 * 1024;
constexpr size_t WS_LIST = WS_L + 4 * MiB;
constexpr size_t WS_OT = WS_LIST + 2 * MiB;
constexpr size_t WS_TAB = WS_OT + 16 * MiB;
constexpr size_t TAB_KT = 0, TAB_M1 = 1 * MiB, TAB_M2 = 9 * MiB, TAB_LAYER = 17 * MiB;
constexpr size_t WS_END = WS_TAB + 2 * TAB_LAYER;
constexpr size_t WS_KSF = WS_END;
constexpr size_t WS_END2 = WS_KSF + 8 * MiB;
constexpr size_t WS_SIN = WS_E + 16 * MiB;
constexpr int LDS_BYTES = 151552;

struct Params { const float* in[30]; float* out; unsigned char* ws; };

DI int otid() { int t = threadIdx.x; asm volatile("" : "+v"(t)); return t; }
DI int obid() { int t = blockIdx.x; asm volatile("" : "+s"(t)); return t; }
DI unsigned f2bf(float f) { unsigned u = __float_as_uint(f); return (u + 0x7fffu + ((u >> 16) & 1u)) >> 16; }
typedef float f32x2_t __attribute__((ext_vector_type(2))); typedef __bf16 bf16x2_t __attribute__((ext_vector_type(2)));
DI unsigned pk2(float lo, float hi) { const f32x2_t v = {lo, hi}; const bf16x2_t b = __builtin_convertvector(v, bf16x2_t); return __builtin_bit_cast(unsigned, b); }
DI float bflo(unsigned w) { return __uint_as_float(w << 16); }
DI float bfhi(unsigned w) { return __uint_as_float(w & 0xffff0000u); }
DI int perm16(int x) { return (x & ~12) | ((x & 4) << 1) | ((x & 8) >> 1); }
DI float wave_sum(float v) {
#pragma unroll
  for (int o = 1; o < 64; o <<= 1) v += __shfl_xor(v, o);
  return v;
}
DI float sigmoidf_(float x) { return 1.f / (1.f + __expf(-x)); }
DI float gelu_tanh(float x) {
  const float z = 0.7978845608028654f * (x + 0.044715f * x * x * x);
  const float e = __expf(2.f * z);
  const float th = 1.f - 2.f / (e + 1.f);
  return 0.5f * x * (1.f + th);
}
DI void sincos_d(double x, double& s, double& c) {
  const double k = rint(x * 0.6366197723675814);
  double r = fma(-k, 1.5707963267948966, x);
  r = fma(-k, 6.123233995736766e-17, r);
  const int q = ((int)k) & 3;
  const double r2 = r * r;
  const double sp = r * (1.0 + r2 * (-1.0 / 6 + r2 * (1.0 / 120 + r2 * (-1.0 / 5040 + r2 * (1.0 / 362880 + r2 * (-1.0 / 39916800 + r2 * (1.0 / 6227020800.0)))))));
  const double cp = 1.0 + r2 * (-0.5 + r2 * (1.0 / 24 + r2 * (-1.0 / 720 + r2 * (1.0 / 40320 + r2 * (-1.0 / 3628800 + r2 * (1.0 / 479001600 + r2 * (-1.0 / 87178291200.0)))))));
  s = (q == 0) ? sp : (q == 1) ? cp : (q == 2) ? -sp : -cp;
  c = (q == 0) ? cp : (q == 1) ? -sp : (q == 2) ? -cp : sp;
}

DI void gemv_item(float* lds, const float* W, int K, int N, int j0, const float* v0, const float* v1, bool do_silu, const float* bias, float* o0, float* o1) {
  const int tid = otid();
  float* sv = lds; float* red = lds + 4096;
  for (int k = tid; k < K; k += NTHR) {
    float a = v0[k], b = v1 ? v1[k] : 0.f;
    if (do_silu) { a = a / (1.f + expf(-a)); b = b / (1.f + expf(-b)); }
    sv[k] = a; sv[2048 + k] = b;
  }
  __syncthreads();
  const int jl = tid & 63, ks = tid >> 6, kper = K >> 3;
  const float* wp = W + (size_t)(ks * kper) * N + j0 + jl;
  float a0 = 0.f, a1 = 0.f;
#pragma unroll 8
  for (int k = 0; k < kper; ++k) { const float w = wp[(size_t)k * N]; a0 += sv[ks * kper + k] * w; a1 += sv[2048 + ks * kper + k] * w; }
  red[(ks * 64 + jl) * 2] = a0; red[(ks * 64 + jl) * 2 + 1] = a1;
  __syncthreads();
  if (tid < 64) {
    float s0 = 0.f, s1 = 0.f;
    for (int i = 0; i < 8; ++i) { s0 += red[(i * 64 + tid) * 2]; s1 += red[(i * 64 + tid) * 2 + 1]; }
    const float bb = bias ? bias[j0 + tid] : 0.f;
    o0[j0 + tid] = s0 + bb; if (o1) o1[j0 + tid] = s1 + bb;
  }
  __syncthreads();
}

DI void s5_params(const Params& P, int gtid) {
  if (gtid >= DEPTH * 32 * 64) return;
  const int l = gtid / 2048, g = (gtid / 64) % 32, p = gtid % 64;
  const float dt = expf(P.in[8][l * 32 + g]);
  const float lr = P.in[6][(l * 32 + g) * 64 + p], li = P.in[7][(l * 32 + g) * 64 + p];
  const float mag = expf(lr * dt); const float ang = li * dt;
  double sd, cd; sincos_d((double)ang, sd, cd);
  const float ab_re = mag * (float)cd, ab_im = mag * (float)sd;
  const float den = lr * lr + li * li, nr = ab_re - 1.0f;
  const float cr = (nr * lr + ab_im * li) / den, ci = (ab_im * lr - nr * li) / den;
  float* o = (float*)(P.ws + WS_S5P) + (size_t)((l * 32 + g) * 64 + p) * 36;
  o[0] = ab_re; o[1] = ab_im;
  double pr = ab_re, pi = ab_im;
  for (int i = 0; i < 6; ++i) { const double nr2 = pr * pr - pi * pi, ni2 = 2.0 * pr * pi; pr = nr2; pi = ni2; }
  o[2] = (float)pr; o[3] = (float)pi;
  const float* br = P.in[9] + (size_t)((l * 32 + g) * 64 + p) * 16; const float* bi = P.in[10] + (size_t)((l * 32 + g) * 64 + p) * 16;
  for (int h = 0; h < 16; ++h) { o[4 + 2 * h] = cr * br[h] - ci * bi[h]; o[5 + 2 * h] = cr * bi[h] + ci * br[h]; }
}

DI void s5_tables(const Params& P, int l, int g, int part, unsigned char* lds) {
  const int tid = otid(), lane = tid & 63;
  float* BBr = (float*)lds; float* BBi = BBr + 1024; float* CR = BBi + 1024; float* CI = CR + 1024;
  float* APr = CI + 1024; float* APi = APr + 65 * 64;
  bf16_t* tab = (bf16_t*)(P.ws + WS_TAB + (size_t)l * TAB_LAYER);
  bf16_t* Kt = tab + TAB_KT / 2 + (size_t)g * 64 * 256; bf16_t* M1 = tab + TAB_M1 / 2 + (size_t)g * 128 * 1024; bf16_t* M2 = tab + TAB_M2 / 2 + (size_t)g * 1024 * 128;
  __syncthreads();
  if (tid < 64) {
    const int p = tid;
    const float dt = expf(P.in[8][l * 32 + g]);
    const float lr = P.in[6][(l * 32 + g) * 64 + p], li = P.in[7][(l * 32 + g) * 64 + p];
    const float mag = expf(lr * dt); const float ang = li * dt;
    double sd, cd; sincos_d((double)ang, sd, cd);
    const float ab_re = mag * (float)cd, ab_im = mag * (float)sd;
    const float den = lr * lr + li * li, nr = ab_re - 1.0f;
    const float cr = (nr * lr + ab_im * li) / den, ci = (ab_im * lr - nr * li) / den;
    const float* br = P.in[9] + (size_t)((l * 32 + g) * 64 + p) * 16; const float* bi = P.in[10] + (size_t)((l * 32 + g) * 64 + p) * 16;
    for (int h = 0; h < 16; ++h) { BBr[p * 16 + h] = cr * br[h] - ci * bi[h]; BBi[p * 16 + h] = cr * bi[h] + ci * br[h]; }
    double pr = 1.0, pi = 0.0;
    for (int tau = 0; tau <= 64; ++tau) { APr[tau * 64 + p] = (float)pr; APi[tau * 64 + p] = (float)pi; const double n1 = pr * ab_re - pi * ab_im, n2 = pr * ab_im + pi * ab_re; pr = n1; pi = n2; }
  }
  for (int i = tid; i < 1024; i += NTHR) { CR[i] = P.in[11][(size_t)(l * 32 + g) * 1024 + i]; CI[i] = P.in[12][(size_t)(l * 32 + g) * 1024 + i]; }
  __syncthreads();
  if (part < 4)
  for (int task = part * 256 + tid; task < part * 256 + 256; task += NTHR) {
    const int tau = task >> 4, h = task & 15;
    float a[16];
#pragma unroll
    for (int j = 0; j < 16; ++j) a[j] = 0.f;
    for (int p = 0; p < 64; ++p) {
      const float c_r = CR[h * 64 + p], c_i = CI[h * 64 + p], a_r = APr[tau * 64 + p], a_i = APi[tau * 64 + p];
      const float xr = c_r * a_r - c_i * a_i, xi = c_r * a_i + c_i * a_r;
#pragma unroll
      for (int j4 = 0; j4 < 4; ++j4) { const f32x4 b_r = *(const f32x4*)(BBr + p * 16 + 4 * j4), b_i = *(const f32x4*)(BBi + p * 16 + 4 * j4);
        a[4 * j4] += xr * b_r.x - xi * b_i.x; a[4 * j4 + 1] += xr * b_r.y - xi * b_i.y; a[4 * j4 + 2] += xr * b_r.z - xi * b_i.z; a[4 * j4 + 3] += xr * b_r.w - xi * b_i.w; }
    }
    u32x4 o0, o1; o0.x = pk2(a[0], a[1]); o0.y = pk2(a[2], a[3]); o0.z = pk2(a[4], a[5]); o0.w = pk2(a[6], a[7]); o1.x = pk2(a[8], a[9]); o1.y = pk2(a[10], a[11]); o1.z = pk2(a[12], a[13]); o1.w = pk2(a[14], a[15]);
    *(u32x4*)(Kt + (size_t)task * 16) = o0; *(u32x4*)(Kt + (size_t)task * 16 + 8) = o1;
  }
  if (part == 4)
  for (int task = tid; task < 4096; task += NTHR) {
    const int p = task >> 6, i = task & 63;
    const float a_r = APr[(63 - i) * 64 + p], a_i = APi[(63 - i) * 64 + p];
    float re[16], im[16];
#pragma unroll
    for (int j = 0; j < 16; ++j) { const float b_r = BBr[p * 16 + j], b_i = BBi[p * 16 + j]; re[j] = a_r * b_r - a_i * b_i; im[j] = a_r * b_i + a_i * b_r; }
    u32x4 o; bf16_t* d0 = M1 + (size_t)(2 * p) * 1024 + i * 16; bf16_t* d1 = d0 + 1024;
    o.x = pk2(re[0], re[1]); o.y = pk2(re[2], re[3]); o.z = pk2(re[4], re[5]); o.w = pk2(re[6], re[7]); *(u32x4*)d0 = o;
    o.x = pk2(re[8], re[9]); o.y = pk2(re[10], re[11]); o.z = pk2(re[12], re[13]); o.w = pk2(re[14], re[15]); *(u32x4*)(d0 + 8) = o;
    o.x = pk2(im[0], im[1]); o.y = pk2(im[2], im[3]); o.z = pk2(im[4], im[5]); o.w = pk2(im[6], im[7]); *(u32x4*)d1 = o;
    o.x = pk2(im[8], im[9]); o.y = pk2(im[10], im[11]); o.z = pk2(im[12], im[13]); o.w = pk2(im[14], im[15]); *(u32x4*)(d1 + 8) = o;
  }
  if (part == 5)
  for (int task = tid; task < 4096; task += NTHR) {
    const int th = task >> 2, pq = task & 3, t = th >> 4, h = th & 15;
    unsigned w[16];
#pragma unroll
    for (int j = 0; j < 16; ++j) { const int p = pq * 16 + j;
      const float c_r = CR[h * 64 + p], c_i = CI[h * 64 + p], a_r = APr[(t + 1) * 64 + p], a_i = APi[(t + 1) * 64 + p];
      w[j] = pk2(c_r * a_r - c_i * a_i, -(c_r * a_i + c_i * a_r)); }
    bf16_t* d = M2 + (size_t)th * 128 + pq * 32;
    *(u32x4*)d = (u32x4){w[0], w[1], w[2], w[3]}; *(u32x4*)(d + 8) = (u32x4){w[4], w[5], w[6], w[7]};
    *(u32x4*)(d + 16) = (u32x4){w[8], w[9], w[10], w[11]}; *(u32x4*)(d + 24) = (u32x4){w[12], w[13], w[14], w[15]};
  }
  __syncthreads();
}

struct ConvJob { const float* src; bf16_t* dst; int ldw, K, c0, ncols, nmat, ldd, drow0, mode; size_t sstride, dstride; };
DI int conv_nitems(const ConvJob& j) { return j.nmat * (j.K >> 6) * ((j.ncols + 31) >> 5); }
DI int conv_drow(int mode, int drow0, int n) { return mode == 0 ? drow0 + n : drow0 + ((n >> 6) * 128 + ((n >> 4) & 3) * 32 + (n & 15)); }
DI void conv_item(const ConvJob& jb, int item, float* scr, int lane) {
  const int nblk = (jb.ncols + 31) >> 5, per = (jb.K >> 6) * nblk;
  const int mat = item / per, r = item % per, kb = r / nblk, nb = r % nblk, k0 = 64 * kb, n0 = 32 * nb;
  const float* W = jb.src + (size_t)mat * jb.sstride; bf16_t* WT = jb.dst + (size_t)mat * jb.dstride;
  const int n4 = (lane & 7) * 4; const bool nok = (n0 + n4) < jb.ncols;
#pragma unroll
  for (int i = 0; i < 8; ++i) { const int kk = 8 * i + (lane >> 3);
    const f32x4 v = nok ? *(const f32x4*)(W + (size_t)(k0 + kk) * jb.ldw + jb.c0 + n0 + n4) : (f32x4){0.f, 0.f, 0.f, 0.f};
    *(f32x4*)(scr + kk * 36 + n4) = v; }
  asm volatile("s_waitcnt lgkmcnt(0)" ::: "memory");
  const int c = lane & 7;
#pragma unroll
  for (int j = 0; j < 4; ++j) {
    const int n = (lane >> 3) + 8 * j; const float* sp = scr + (8 * c) * 36 + n;
    u32x4 o; o.x = pk2(sp[0], sp[36]); o.y = pk2(sp[72], sp[108]); o.z = pk2(sp[144], sp[180]); o.w = pk2(sp[216], sp[252]);
    if (n0 + n < jb.ncols) *(u32x4*)(WT + (size_t)conv_drow(jb.mode, jb.drow0, n0 + n) * jb.ldd + k0 + 8 * c) = o;
  }
  asm volatile("s_waitcnt lgkmcnt(0)" ::: "memory");
}
DI ConvJob conv_job(const Params& P, int l, int j) {
  unsigned char* wb = P.ws + WS_W; ConvJob J; J.nmat = 1; J.mode = 0; J.sstride = 0; J.dstride = 0; J.drow0 = 0; J.c0 = 0;
  const float* win = P.in[5] + (size_t)l * 1024 * INW;
  if (j < 5) { J.src = win; J.ldw = INW; J.K = 1024; J.dst = (bf16_t*)(wb + W_IN); J.ldd = 1024;
    if (j == 0) { J.c0 = 0; J.ncols = 1024; J.drow0 = 0; }
    else if (j == 1) { J.c0 = 1024; J.ncols = 1536; J.drow0 = 1024; }
    else if (j == 2) { J.c0 = 3120; J.ncols = 2048; J.drow0 = 2560; }
    else if (j == 3) { J.c0 = 2608; J.ncols = 512; J.drow0 = 4608; }
    else { J.c0 = 2560; J.ncols = 48; J.drow0 = 5120; }
  } else if (j == 5) { J.src = P.in[14] + (size_t)l * 512 * 512; J.ldw = 512; J.K = 512; J.ncols = 512; J.dst = (bf16_t*)(wb + W_GLU); J.ldd = 512; }
  else if (j == 6) { J.src = P.in[19] + (size_t)l * 1024 * 1024; J.ldw = 1024; J.K = 1024; J.ncols = 1024; J.dst = (bf16_t*)(wb + W_O); J.ldd = 1024; }
  else if (j == 7) { J.src = P.in[15] + (size_t)l * 512 * 1024; J.ldw = 1024; J.K = 512; J.ncols = 1024; J.dst = (bf16_t*)(wb + W_SO); J.ldd = 512; }
  else if (j == 8) { J.src = P.in[20] + (size_t)l * 1024 * 1024; J.ldw = 1024; J.K = 1024; J.ncols = 1024; J.dst = (bf16_t*)(wb + W_OUT); J.ldd = 1024; }
  else if (j == 9) { J.src = P.in[17] + (size_t)l * 2 * 2048 * 256; J.ldw = 256; J.K = 2048; J.ncols = 256; J.nmat = 2; J.sstride = 2048 * 256; J.dstride = 256 * 2048; J.dst = (bf16_t*)(wb + W_C1); J.ldd = 2048; }
  else if (j == 10) { J.src = P.in[18] + (size_t)l * 2 * 256 * 64; J.ldw = 64; J.K = 256; J.ncols = 64; J.nmat = 2; J.sstride = 256 * 64; J.dstride = 128 * 256; J.dst = (bf16_t*)(wb + W_C2); J.ldd = 256; }
  else if (j == 11) { J.src = P.in[26] + (size_t)l * 32 * 1024 * 256; J.ldw = 256; J.K = 1024; J.ncols = 256; J.nmat = 32; J.sstride = 1024 * 256; J.dstride = 512 * 1024; J.dst = (bf16_t*)(wb + W_GU); J.ldd = 1024; J.mode = 1; J.drow0 = 0; }
  else if (j == 12) { J.src = P.in[27] + (size_t)l * 32 * 1024 * 256; J.ldw = 256; J.K = 1024; J.ncols = 256; J.nmat = 32; J.sstride = 1024 * 256; J.dstride = 512 * 1024; J.dst = (bf16_t*)(wb + W_GU); J.ldd = 1024; J.mode = 1; J.drow0 = 16; }
  else { J.src = P.in[28] + (size_t)l * 32 * 256 * 1024; J.ldw = 1024; J.K = 256; J.ncols = 1024; J.nmat = 32; J.sstride = 256 * 1024; J.dstride = 1024 * 256; J.dst = (bf16_t*)(wb + W_D); J.ldd = 256; }
  return J;
}
DI void convert_weights(const Params& P_, int l, unsigned char* lds) {
  Params P = P_; { size_t z_ = 0; asm volatile("" : "+s"(z_)); P.ws = P_.ws + z_; }
  const int tid_ = otid(), bid = obid(), wave = tid_ >> 6, lane = tid_ & 63; (void)bid;
  float* scr = (float*)lds + wave * (64 * 36);
  const int NGW = gridDim.x * NWAVE; int off = bid * NWAVE + wave;
  for (int j = 0; j < 14; ++j) {
    const ConvJob J = conv_job(P, l, j); const int n = conv_nitems(J);
    while (off < n) { conv_item(J, off, scr, lane); off += NGW; }
    off -= n;
  }
}

template <int MODE>
DI void norm_simple(const Params& P_, int l) {
  Params P = P_; { size_t z_ = 0; asm volatile("" : "+s"(z_)); P.ws = P_.ws + z_; }
  const int tid_ = otid(), bid = obid(), wave = tid_ >> 6, lane = tid_ & 63; (void)bid;
  const int NGW = gridDim.x * NWAVE;
  const float* mod = (const float*)(P.ws + WS_MOD);
  const bf16_t* ys = (const bf16_t*)(P.ws + WS_F);
  bf16_t* xn = (bf16_t*)(P.ws + WS_A);
  for (int row = bid * NWAVE + wave; row < NT; row += NGW) {
    const int b = row >> 13;
    const float* xr = (MODE == 0 ? P.in[0] : P.out) + (size_t)row * DM;
    f32x4 v[4];
#pragma unroll
    for (int j = 0; j < 4; ++j) v[j] = *(const f32x4*)(xr + 4 * lane + 256 * j);
    if (MODE != 0 && EN_MOE) {
      const float* g2 = mod + (size_t)(((MODE == 1 ? 0 : 1) * 2 + b) * 6144) + 5120;
#pragma unroll
      for (int j = 0; j < 4; ++j) {
        const int col = 4 * lane + 256 * j;
        const u32x2 y0 = *(const u32x2*)(ys + (size_t)(row * 2) * DM + col), y1 = *(const u32x2*)(ys + (size_t)(row * 2 + 1) * DM + col);
        const f32x4 gg = *(const f32x4*)(g2 + col);
        v[j].x += gg.x * (bflo(y0.x) + bflo(y1.x)); v[j].y += gg.y * (bfhi(y0.x) + bfhi(y1.x));
        v[j].z += gg.z * (bflo(y0.y) + bflo(y1.y)); v[j].w += gg.w * (bfhi(y0.y) + bfhi(y1.y));
      }
    }
    float ss = 0.f;
#pragma unroll
    for (int j = 0; j < 4; ++j) ss += v[j].x * v[j].x + v[j].y * v[j].y + v[j].z * v[j].z + v[j].w * v[j].w;
    ss = wave_sum(ss);
    const float inv = rsqrtf(ss * (1.f / DM) + EPS);
    if (MODE == 3) {
      const float* fg = P.in[29];
#pragma unroll
      for (int j = 0; j < 4; ++j) { const int col = 4 * lane + 256 * j; const f32x4 g = *(const f32x4*)(fg + col); *(f32x4*)(P.out + (size_t)row * DM + col) = v[j] * inv * g; }
    } else {
      if (MODE == 1) {
#pragma unroll
        for (int j = 0; j < 4; ++j) *(f32x4*)(P.out + (size_t)row * DM + 4 * lane + 256 * j) = v[j];
      }
      const float* ng = P.in[4] + (size_t)l * DM; const float* md = mod + (size_t)((l * 2 + b) * 6144);
#pragma unroll
      for (int j = 0; j < 4; ++j) {
        const int col = 4 * lane + 256 * j;
        const f32x4 g = *(const f32x4*)(ng + col), sh = *(const f32x4*)(md + col), sc = *(const f32x4*)(md + 1024 + col);
        const f32x4 h = v[j] * inv * g * (sc + 1.f) + sh;
        u32x2 o; o.x = pk2(h.x, h.y); o.y = pk2(h.z, h.w);
        *(u32x2*)(xn + (size_t)row * DM + col) = o;
      }
    }
  }
}

constexpr int RT_HS = 1028;
DI void norm_route(const Params& P_, int l, unsigned char* lds) {
  Params P = P_; { size_t z_ = 0; asm volatile("" : "+s"(z_)); P.ws = P_.ws + z_; }
  const int tid = otid(), bid = obid(), wave = tid >> 6, lane = tid & 63;
  const float* mod = (const float*)(P.ws + WS_MOD);
  bf16_t* h2 = (bf16_t*)(P.ws + WS_A);
  float* hs = (float*)lds;
  float* Wc = (float*)lds + 32 * RT_HS;
  const float* wg = P.in[22] + (size_t)l * DM * 4; const float* we = P.in[24] + (size_t)l * DM * 32;
  const float* bg = P.in[23] + l * 4; const float* be = P.in[25] + l * 32;
  int* cnt = (int*)(P.ws + WS_CNT) + l * 32; int* list = (int*)(P.ws + WS_LIST); float* wts = (float*)(P.ws + WS_WT);
  const int rg = wave >> 2, kq = wave & 3;
  for (int grp = bid; grp < NT / 32; grp += gridDim.x) {
    const int row0 = grp * 32 + wave * 4, b = row0 >> 13;
    const float* ng = P.in[21] + (size_t)l * DM; const float* md = mod + (size_t)((l * 2 + b) * 6144);
    {
      f32x4 v[4][4];
#pragma unroll
      for (int r = 0; r < 4; ++r)
#pragma unroll
        for (int j = 0; j < 4; ++j) v[r][j] = *(const f32x4*)(P.out + (size_t)(row0 + r) * DM + 4 * lane + 256 * j);
      float inv[4];
#pragma unroll
      for (int r = 0; r < 4; ++r) { float ss = 0.f;
#pragma unroll
        for (int j = 0; j < 4; ++j) ss += v[r][j].x * v[r][j].x + v[r][j].y * v[r][j].y + v[r][j].z * v[r][j].z + v[r][j].w * v[r][j].w;
        inv[r] = rsqrtf(wave_sum(ss) * (1.f / DM) + EPS); }
#pragma unroll
      for (int j = 0; j < 4; ++j) {
        const int col = 4 * lane + 256 * j;
        const f32x4 g = *(const f32x4*)(ng + col), sh = *(const f32x4*)(md + 3072 + col), sc = *(const f32x4*)(md + 4096 + col);
#pragma unroll
        for (int r = 0; r < 4; ++r) {
          const f32x4 hh = v[r][j] * inv[r] * g * (sc + 1.f) + sh;
          u32x2 o; o.x = pk2(hh.x, hh.y); o.y = pk2(hh.z, hh.w);
          *(u32x2*)(h2 + (size_t)(row0 + r) * DM + col) = o;
          *(f32x4*)(hs + (wave * 4 + r) * RT_HS + col) = hh;
        }
      }
    }
    f32x4 we0, we1, wg0 = {0.f, 0.f, 0.f, 0.f};
#define WLOAD(kc) do { we0 = *(const f32x4*)(we + (size_t)(kc) * 4096 + tid * 4); we1 = *(const f32x4*)(we + (size_t)(kc) * 4096 + 2048 + tid * 4); if (tid < 128) wg0 = *(const f32x4*)(wg + (size_t)(kc) * 512 + tid * 4); } while (0)
#define WSTORE() do { *(f32x4*)(Wc + (tid >> 3) * 36 + (tid & 7) * 4) = we0; *(f32x4*)(Wc + (64 + (tid >> 3)) * 36 + (tid & 7) * 4) = we1; if (tid < 128) *(f32x4*)(Wc + tid * 36 + 32) = wg0; } while (0)
    WLOAD(0);
    f32x4 acc0 = {0.f, 0.f, 0.f, 0.f}, acc1 = acc0, acc2 = acc0;
    for (int kc = 0; kc < 8; ++kc) {
      __syncthreads();
      WSTORE();
      if (kc + 1 < 8) WLOAD(kc + 1);
      __syncthreads();
      const float* ap = hs + (rg * 16 + (lane & 15)) * RT_HS + kc * 128 + kq * 32 + (lane >> 4);
      const float* bp = Wc + (kq * 32 + (lane >> 4)) * 36 + (lane & 15);
#pragma unroll
      for (int ks = 0; ks < 8; ++ks) {
        const float av = ap[4 * ks];
        const float b0 = bp[(4 * ks) * 36], b1 = bp[(4 * ks) * 36 + 16], b2 = (lane & 15) < 4 ? bp[(4 * ks) * 36 + 32] : 0.f;
        acc0 = __builtin_amdgcn_mfma_f32_16x16x4f32(av, b0, acc0, 0, 0, 0);
        acc1 = __builtin_amdgcn_mfma_f32_16x16x4f32(av, b1, acc1, 0, 0, 0);
        acc2 = __builtin_amdgcn_mfma_f32_16x16x4f32(av, b2, acc2, 0, 0, 0);
      }
    }
#undef WLOAD
#undef WSTORE
    __syncthreads();
    {
      float* part = hs + kq * (32 * 40);
#pragma unroll
      for (int i = 0; i < 4; ++i) { const int row = rg * 16 + 4 * (lane >> 4) + i, col = lane & 15;
        part[row * 40 + col] = acc0[i]; part[row * 40 + 16 + col] = acc1[i]; if (col < 4) part[row * 40 + 32 + col] = acc2[i]; }
    }
    __syncthreads();
    if (tid < 32) {
      const int row = grp * 32 + tid;
      float L[36];
#pragma unroll
      for (int o = 0; o < 36; ++o) L[o] = (hs[tid * 40 + o] + hs[1280 + tid * 40 + o]) + (hs[2560 + tid * 40 + o] + hs[3840 + tid * 40 + o]);
      float gm = -1e30f; int gi = 0;
#pragma unroll
      for (int i = 0; i < 4; ++i) { const float v = L[32 + i] + bg[i]; if (v > gm) { gm = v; gi = i; } }
      float gs = 0.f;
#pragma unroll
      for (int i = 0; i < 4; ++i) gs += expf(L[32 + i] + bg[i] - gm);
      const float gp = 1.f / gs;
      float el[8];
#pragma unroll
      for (int i = 0; i < 8; ++i) el[i] = (gi == 0 ? L[i] : gi == 1 ? L[8 + i] : gi == 2 ? L[16 + i] : L[24 + i]) + be[gi * 8 + i];
      float em = -1e30f;
#pragma unroll
      for (int i = 0; i < 8; ++i) em = fmaxf(em, el[i]);
      float p1 = -1.f, p2 = -1.f; int i1 = 0, i2 = 0;
#pragma unroll
      for (int i = 0; i < 8; ++i) {
        const float pe = expf(el[i] - em);
        if (pe > p1) { p2 = p1; i2 = i1; p1 = pe; i1 = i; } else if (pe > p2) { p2 = pe; i2 = i; }
      }
      const float w1 = gp * p1 / (p1 + p2), w2 = gp * p2 / (p1 + p2);
      const int e1 = gi * 8 + i1, e2 = gi * 8 + i2;
      const int pos1 = atomicAdd(&cnt[e1], 1); list[e1 * LISTCAP + pos1] = row * 2; wts[row * 2] = w1;
      const int pos2 = atomicAdd(&cnt[e2], 1); list[e2 * LISTCAP + pos2] = row * 2 + 1; wts[row * 2 + 1] = w2;
    }
    __syncthreads();
  }
}

namespace pg8 {
#define PG8_LAS __attribute__((address_space(3)))
typedef unsigned short bf16_t;
typedef short bf16x8 __attribute__((ext_vector_type(8)));
typedef float f32x4 __attribute__((ext_vector_type(4)));
typedef unsigned u32x4 __attribute__((ext_vector_type(4)));
constexpr int BM = 256, BK = 64, HALF = 128, HTB = HALF * BK * 2  , STAGE_BYTES = 8 * HTB, NXCD = 8, WGM = 8;

__host__ __device__ __forceinline__ int lds_byte(int r, int c) { const int st = (r >> 4) * 2 + (c >> 5), rr = r & 15, cc = c & 31, ob = rr * 64 + cc * 2; return st * 1024 + (ob ^ (((ob >> 9) & 1) << 5)); }
__host__ __device__ __forceinline__ void stage_rc(int b, int& R, int& C) { const int st = b / 1024, sb = b % 1024, swz = sb ^ (((sb >> 9) & 1) << 5); R = (st >> 1) * 16 + swz / 64; C = (st & 1) * 32 + (swz % 64) / 2; }
__host__ __device__ __forceinline__ int perm32(int rho) { const int n = rho >> 4, i = rho & 15; return 8 * (i >> 2) + 4 * n + (i & 3); }

struct Unit { int pm, pn; };
struct Gemm { const bf16_t* A; const bf16_t* Bt; int M, N, K; };

struct StaticOrder {
    int nM, nN, nwg, G, c;
    __host__ __device__ void init(int M, int N, int G_, int c_) { nM = M / BM; nN = N / BM; nwg = nM * nN; G = G_; c = c_; }
    __host__ __device__ bool next(int i, Unit& u) const {
        const long L = (long)i * G + c; if (L >= nwg) return false;
        int wgid = (int)L; { const int q = nwg / NXCD, r = nwg % NXCD, xcd = wgid % NXCD, off = wgid / NXCD; wgid = (xcd < r ? xcd * (q + 1) : r * (q + 1) + (xcd - r) * q) + off; }
        const int nig = WGM * nN, gid = wgid / nig, fm = gid * WGM, gsz = (nM - fm) < WGM ? (nM - fm) : WGM;
        u.pm = fm + ((wgid % nig) % gsz); u.pn = (wgid % nig) / gsz; return true;
    }
    __device__ __forceinline__ void a_ready(const Unit&) const {}
    __device__ __forceinline__ void done(const Unit&) const {}
};
template <class Epi, class Sched, bool ALIGN_EPI = false, bool SP2 = false>
__device__ __forceinline__ void gemm_phase(PG8_LAS unsigned char* lds, const Gemm g, const Sched& S, const Epi& E) {
    const int tid = otid(), wid = __builtin_amdgcn_readfirstlane(tid >> 6), lane = tid & 63, wr = wid >> 2, wc = wid & 3, fr = lane & 15, fq = lane >> 4;
    const int K = g.K, nt = K / BK;
    unsigned voffA[2], voffB[2];
#pragma unroll
    for (int i = 0; i < 2; ++i) { int R, C; stage_rc(tid * 16 + i * 8192, R, C); const int Rb = Epi::PERM ? ((R & ~31) + perm32(R & 31)) : R;
        voffA[i] = (unsigned)(R * K + C) * 2u; voffB[i] = (unsigned)(Rb * K + C) * 2u; }
    const size_t kstep = (size_t)(BK * 2);
    const size_t hstep = (size_t)HALF * K * 2;
    const size_t tstep = 2 * hstep;
    const unsigned ldsw = (unsigned)wid * 1024u;
    const int aoff = lds_byte(wr * 64 + fr, fq * 8), boff = lds_byte(wc * 32 + fr, fq * 8);
#define PG8_SA(b, h) (((b) * 2 + (h)) * HTB)
#define PG8_SB(b, h) ((4 + (b) * 2 + (h)) * HTB)
#define PG8_STAGE(bufoff, gbase, voff) do { _Pragma("unroll") for (int _i = 0; _i < 2; ++_i) \
        __builtin_amdgcn_global_load_lds((const unsigned*)((const char*)(gbase) + (voff)[_i]), (PG8_LAS unsigned*)(lds + (bufoff) + ldsw + _i * 8192), 16, 0, 0); } while (0)
#define PG8_LDA(dst, b, h) do { _Pragma("unroll") for (int m = 0; m < 4; ++m) _Pragma("unroll") for (int k = 0; k < 2; ++k) dst[m][k] = *(const PG8_LAS bf16x8*)(lds + PG8_SA(b, h) + aoff + m * 2048 + k * 1024); } while (0)
#define PG8_LDB(dst, b, h) do { _Pragma("unroll") for (int n = 0; n < 2; ++n) _Pragma("unroll") for (int k = 0; k < 2; ++k) dst[n][k] = *(const PG8_LAS bf16x8*)(lds + PG8_SB(b, h) + boff + n * 2048 + k * 1024); } while (0)
#define PG8_MMA(ai, bj, At, Bt) do { __builtin_amdgcn_s_setprio(1); _Pragma("unroll") for (int m = 0; m < 4; ++m) _Pragma("unroll") for (int n = 0; n < 2; ++n) _Pragma("unroll") for (int k = 0; k < 2; ++k) \
        acc[ai][bj][m][n] = __builtin_amdgcn_mfma_f32_16x16x32_bf16(Bt[n][k], At[m][k], acc[ai][bj][m][n], 0, 0, 0); __builtin_amdgcn_s_setprio(0); } while (0)
#define PG8_WAIT_V(n) asm volatile("s_waitcnt vmcnt(" #n ")" ::: "memory")
#define PG8_WAIT_L(n) asm volatile("s_waitcnt lgkmcnt(" #n ")" ::: "memory")
#define PG8_BAR __builtin_amdgcn_s_barrier()
#define PG8_SCHED __builtin_amdgcn_sched_barrier(0)
    Unit cur, nxt; int ui = 0;
    if (!S.next(0, cur)) return;
    f32x4 acc[2][2][4][2];
#pragma unroll
    for (int a = 0; a < 2; ++a)
#pragma unroll
        for (int b = 0; b < 2; ++b)
#pragma unroll
            for (int m = 0; m < 4; ++m)
#pragma unroll
                for (int n = 0; n < 2; ++n) acc[a][b][m][n] = (f32x4){0.f, 0.f, 0.f, 0.f};
    bf16x8 At[4][2], B0[2][2], B1[2][2];
    const char* cA = (const char*)g.A + (size_t)cur.pm * tstep; const char* cB = (const char*)g.Bt + (size_t)cur.pn * tstep;
    S.a_ready(cur);
    if constexpr (SP2) {
        PG8_STAGE(PG8_SB(0, 0), cB, voffB); PG8_STAGE(PG8_SB(0, 1), cB + hstep, voffB); PG8_STAGE(PG8_SA(0, 0), cA, voffA); PG8_STAGE(PG8_SA(0, 1), cA + hstep, voffA);
        if (wr == 1) PG8_BAR;
        PG8_WAIT_V(2); PG8_BAR;
        PG8_STAGE(PG8_SB(1, 0), cB + kstep, voffB); PG8_STAGE(PG8_SA(1, 0), cA + kstep, voffA); PG8_STAGE(PG8_SB(1, 1), cB + hstep + kstep, voffB);
        PG8_WAIT_V(6); PG8_BAR;
    } else {
        PG8_STAGE(PG8_SB(0, 0), cB, voffB); PG8_STAGE(PG8_SA(0, 0), cA, voffA); PG8_STAGE(PG8_SB(0, 1), cB + hstep, voffB); PG8_STAGE(PG8_SA(0, 1), cA + hstep, voffA);
        if (wr == 1) PG8_BAR;
        PG8_WAIT_V(4); PG8_BAR;
        PG8_STAGE(PG8_SB(1, 0), cB + kstep, voffB); PG8_STAGE(PG8_SA(1, 0), cA + kstep, voffA); PG8_STAGE(PG8_SB(1, 1), cB + hstep + kstep, voffB);
        PG8_WAIT_V(6); PG8_BAR;
    }
    for (;;) {
        const bool has_next = S.next(ui + 1, nxt);
        const char* nA = has_next ? (const char*)g.A + (size_t)nxt.pm * tstep : cA; const char* nB = has_next ? (const char*)g.Bt + (size_t)nxt.pn * tstep : cB;
        for (int t = 0; t < nt; t += 2) {
            const bool last = (t == nt - 2);
            const char* a1 = cA + (size_t)(t + 1) * kstep;
            const char* a2 = last ? nA : cA + (size_t)(t + 2) * kstep; const char* b2 = last ? nB : cB + (size_t)(t + 2) * kstep;
            const char* a3 = a2 + kstep; const char* b3 = b2 + kstep;
            if (last && has_next) S.a_ready(nxt);
            if constexpr (SP2) {
            PG8_LDB(B0, 0, 0); PG8_LDB(B1, 0, 1); PG8_SCHED; PG8_LDA(At, 0, 0); PG8_STAGE(PG8_SA(1, 1), a1 + hstep, voffA);
            PG8_WAIT_V(8); PG8_WAIT_L(0); PG8_BAR; PG8_MMA(0, 0, At, B0); PG8_MMA(0, 1, At, B1); PG8_BAR; PG8_SCHED;
            PG8_LDA(At, 0, 1); PG8_STAGE(PG8_SB(0, 0), b2, voffB); PG8_STAGE(PG8_SB(0, 1), b2 + hstep, voffB); PG8_STAGE(PG8_SA(0, 0), a2, voffA);
            PG8_WAIT_V(8); PG8_WAIT_L(0); PG8_BAR; PG8_MMA(1, 0, At, B0); PG8_MMA(1, 1, At, B1); PG8_BAR; PG8_SCHED;
            PG8_LDB(B0, 1, 0); PG8_LDB(B1, 1, 1); PG8_SCHED; PG8_LDA(At, 1, 0); PG8_STAGE(PG8_SA(0, 1), a2 + hstep, voffA);
            PG8_WAIT_V(8); PG8_WAIT_L(0); PG8_BAR; PG8_MMA(0, 0, At, B0); PG8_MMA(0, 1, At, B1); PG8_BAR; PG8_SCHED;
            PG8_LDA(At, 1, 1); PG8_STAGE(PG8_SB(1, 0), b3, voffB); PG8_STAGE(PG8_SB(1, 1), b3 + hstep, voffB); PG8_STAGE(PG8_SA(1, 0), a3, voffA);
            PG8_WAIT_V(8); PG8_WAIT_L(0); PG8_BAR; PG8_MMA(1, 0, At, B0); PG8_MMA(1, 1, At, B1); PG8_BAR; PG8_SCHED;
            } else {
            PG8_LDB(B0, 0, 0); PG8_SCHED; PG8_LDA(At, 0, 0); PG8_STAGE(PG8_SA(1, 1), a1 + hstep, voffA);
            PG8_WAIT_L(8); PG8_BAR; PG8_WAIT_L(0); PG8_MMA(0, 0, At, B0); PG8_BAR; PG8_SCHED;
            PG8_LDB(B1, 0, 1); PG8_STAGE(PG8_SB(0, 0), b2, voffB);
            PG8_BAR; PG8_WAIT_L(0); PG8_MMA(0, 1, At, B1); PG8_BAR;
            PG8_LDA(At, 0, 1); PG8_STAGE(PG8_SA(0, 0), a2, voffA);
            PG8_BAR; PG8_WAIT_L(0); PG8_MMA(1, 0, At, B0); PG8_BAR; PG8_SCHED;
            PG8_STAGE(PG8_SB(0, 1), b2 + hstep, voffB);
            PG8_WAIT_V(6); PG8_BAR; PG8_MMA(1, 1, At, B1); PG8_BAR;
            PG8_LDB(B0, 1, 0); PG8_SCHED; PG8_LDA(At, 1, 0); PG8_STAGE(PG8_SA(0, 1), a2 + hstep, voffA);
            PG8_WAIT_L(8); PG8_BAR; PG8_WAIT_L(0); PG8_MMA(0, 0, At, B0); PG8_BAR; PG8_SCHED;
            PG8_LDB(B1, 1, 1); PG8_STAGE(PG8_SB(1, 0), b3, voffB);
            PG8_BAR; PG8_WAIT_L(0); PG8_MMA(0, 1, At, B1); PG8_BAR;
            PG8_LDA(At, 1, 1); PG8_STAGE(PG8_SA(1, 0), a3, voffA);
            PG8_BAR; PG8_WAIT_L(0); PG8_MMA(1, 0, At, B0); PG8_BAR; PG8_SCHED;
            PG8_STAGE(PG8_SB(1, 1), b3 + hstep, voffB);
            PG8_WAIT_V(6); PG8_BAR; PG8_MMA(1, 1, At, B1); PG8_BAR;
            }
        }
        if constexpr (ALIGN_EPI) { if (wr == 0) PG8_BAR; }
        if constexpr (!Epi::AFTER_DRAIN) { E(acc, cur, wr, wc, fr, fq); S.done(cur); }
        if (!has_next) break;
#pragma unroll
        for (int a = 0; a < 2; ++a)
#pragma unroll
            for (int b = 0; b < 2; ++b)
#pragma unroll
                for (int m = 0; m < 4; ++m)
#pragma unroll
                    for (int n = 0; n < 2; ++n) acc[a][b][m][n] = (f32x4){0.f, 0.f, 0.f, 0.f};
        cur = nxt; cA = nA; cB = nB; ++ui;
        if constexpr (ALIGN_EPI) { if (wr == 1) PG8_BAR; }
    }
    PG8_WAIT_V(0);
    if constexpr (!ALIGN_EPI) { if (wr == 0) PG8_BAR; }
    PG8_BAR;
    if constexpr (Epi::AFTER_DRAIN) { E.fused(acc, cur, wr, wc, fr, fq, lds, wid, lane); S.done(cur); }
#undef PG8_SA
#undef PG8_SB
#undef PG8_STAGE
#undef PG8_LDA
#undef PG8_LDB
#undef PG8_MMA
#undef PG8_WAIT_V
#undef PG8_WAIT_L
#undef PG8_BAR
#undef PG8_SCHED
}
}

constexpr int GT_ROWB = 144, GT_A = 0, GT_B = 128 * GT_ROWB, GT_STAGE = 2 * 128 * GT_ROWB;
DI void gemm_kloop(unsigned char* lds, const bf16_t* a0, const bf16_t* a1, int a_kadv, const bf16_t* b0, const bf16_t* b1, int nk, f32x4 (&acc)[4][2]) {
  const int tid = otid(), lane = tid & 63, wid = tid >> 6, wr = wid >> 2, wc = wid & 3, fr = lane & 15, fq = lane >> 4;
  const int lr = tid >> 3, lkb = (tid & 7) * 16;
  u32x4 xa0, xa1, xb0, xb1, ya0, ya1, yb0, yb1;
#define GT_GLOAD(p0_, p1_, q0_, q1_, kt) do { p0_ = *(const u32x4*)(a0 + (size_t)(kt) * a_kadv); p1_ = *(const u32x4*)(a1 + (size_t)(kt) * a_kadv); q0_ = *(const u32x4*)(b0 + (kt) * 64); q1_ = *(const u32x4*)(b1 + (kt) * 64); } while (0)
#define GT_LSTORE(p0_, p1_, q0_, q1_, buf) do { unsigned char* s_ = lds + (buf) * GT_STAGE; \
    *(u32x4*)(s_ + GT_A + lr * GT_ROWB + lkb) = p0_; *(u32x4*)(s_ + GT_A + (lr + 64) * GT_ROWB + lkb) = p1_; \
    *(u32x4*)(s_ + GT_B + lr * GT_ROWB + lkb) = q0_; *(u32x4*)(s_ + GT_B + (lr + 64) * GT_ROWB + lkb) = q1_; } while (0)
#define GT_COMPUTE(buf) do { \
    const unsigned char* As = lds + (buf) * GT_STAGE + GT_A + (wr * 64 + fr) * GT_ROWB + fq * 16; \
    const unsigned char* Bs = lds + (buf) * GT_STAGE + GT_B + (wc * 32 + fr) * GT_ROWB + fq * 16; \
    _Pragma("unroll") for (int ks = 0; ks < 2; ++ks) { \
      bf16x8 af[4], bfr[2]; \
      _Pragma("unroll") for (int m = 0; m < 4; ++m) af[m] = *(const bf16x8*)(As + m * 16 * GT_ROWB + ks * 64); \
      _Pragma("unroll") for (int n = 0; n < 2; ++n) bfr[n] = *(const bf16x8*)(Bs + n * 16 * GT_ROWB + ks * 64); \
      _Pragma("unroll") for (int m = 0; m < 4; ++m) _Pragma("unroll") for (int n = 0; n < 2; ++n) acc[m][n] = __builtin_amdgcn_mfma_f32_16x16x32_bf16(bfr[n], af[m], acc[m][n], 0, 0, 0); } } while (0)
  GT_GLOAD(xa0, xa1, xb0, xb1, 0); GT_LSTORE(xa0, xa1, xb0, xb1, 0); if (nk > 1) GT_GLOAD(ya0, ya1, yb0, yb1, 1); __syncthreads();
  for (int kt = 0; kt < nk; kt += 2) {
    if (kt + 2 < nk) GT_GLOAD(xa0, xa1, xb0, xb1, kt + 2);
    GT_COMPUTE(0);
    if (kt + 1 < nk) GT_LSTORE(ya0, ya1, yb0, yb1, 1);
    __syncthreads();
    if (kt + 1 >= nk) break;
    if (kt + 3 < nk) GT_GLOAD(ya0, ya1, yb0, yb1, kt + 3);
    GT_COMPUTE(1);
    if (kt + 2 < nk) GT_LSTORE(xa0, xa1, xb0, xb1, 0);
    __syncthreads();
  }
#undef GT_GLOAD
#undef GT_LSTORE
#undef GT_COMPUTE
}
#define ACC_ZERO(acc) do { _Pragma("unroll") for (int m_ = 0; m_ < 4; ++m_) _Pragma("unroll") for (int n_ = 0; n_ < 2; ++n_) acc[m_][n_] = (f32x4){0.f, 0.f, 0.f, 0.f}; } while (0)
#define TILE_IDS const int tid = otid(), bid = obid(), lane = tid & 63, wid = tid >> 6, wr = wid >> 2, wc = wid & 3, fr = lane & 15, fq = lane >> 4, lr = tid >> 3, lk = (tid & 7) * 8; (void)bid; (void)lane; (void)wr; (void)wc; (void)fr; (void)fq; (void)lr; (void)lk

DI void phase_gates(const Params& P_, unsigned char* lds) {
  Params P = P_; { size_t z_ = 0; asm volatile("" : "+s"(z_)); P.ws = P_.ws + z_; }
  TILE_IDS;
  const bf16_t* xn = (const bf16_t*)(P.ws + WS_A); const bf16_t* wt = (const bf16_t*)(P.ws + WS_W + W_IN) + (size_t)5120 * DM; float* gates = (float*)(P.ws + WS_GATES);
  for (int tile = (int)gridDim.x - 1 - bid; tile < NT / 128; tile += gridDim.x) {
    const int row0 = tile * 128;
    f32x4 acc[4][2]; ACC_ZERO(acc);
    gemm_kloop(lds, xn + (size_t)(row0 + lr) * DM + lk, xn + (size_t)(row0 + lr + 64) * DM + lk, 64, wt + (size_t)lr * DM + lk, wt + (size_t)(lr + 64) * DM + lk, DM / 64, acc);
#pragma unroll
    for (int m = 0; m < 4; ++m)
#pragma unroll
      for (int n = 0; n < 2; ++n) {
        const int row = row0 + wr * 64 + m * 16 + fr, c2 = wc * 32 + n * 16 + 4 * fq; const f32x4 v = acc[m][n];
        if (c2 < 48) { f32x4 o = {sigmoidf_(v.x), sigmoidf_(v.y), sigmoidf_(v.z), sigmoidf_(v.w)}; *(f32x4*)(gates + (size_t)row * 48 + c2) = o; }
      }
  }
}
DI void phase_cmp1(const Params& P_, int l, unsigned char* lds) {
  Params P = P_; { size_t z_ = 0; asm volatile("" : "+s"(z_)); P.ws = P_.ws + z_; }
  TILE_IDS;
  const bf16_t* kvk = (const bf16_t*)(P.ws + WS_C); bf16_t* hid = (bf16_t*)(P.ws + WS_HID);
  const float* cb = (const float*)(P.ws + WS_CB) + l * 512;
  for (int tile = bid; tile < 128; tile += gridDim.x) {
    const int kv = tile >> 6, rt = (tile >> 1) & 31, ct = tile & 1, row0 = rt * 128, col0 = ct * 128;
    const bf16_t* wt = (const bf16_t*)(P.ws + WS_W + W_C1) + (size_t)kv * 256 * 2048;
    const bf16_t* ap[2];
#pragma unroll
    for (int i = 0; i < 2; ++i) { const int rr = row0 + lr + 64 * i, b = rr >> 11, n = (rr >> 2) & 511, g = rr & 3, nn = n > 510 ? 510 : n;
      ap[i] = kvk + (size_t)(b * SEQ + 16 * nn) * DM + kv * 256 + g * 64 + lk; }
    f32x4 acc[4][2]; ACC_ZERO(acc);
    gemm_kloop(lds, ap[0], ap[1], DM, wt + (size_t)(col0 + lr) * 2048 + lk, wt + (size_t)(col0 + lr + 64) * 2048 + lk, 32, acc);
#pragma unroll
    for (int m = 0; m < 4; ++m)
#pragma unroll
      for (int n = 0; n < 2; ++n) {
        const int row = row0 + wr * 64 + m * 16 + fr, col = col0 + wc * 32 + n * 16 + 4 * fq;
        const f32x4 bb = *(const f32x4*)(cb + kv * 256 + col); const f32x4 v = acc[m][n] + bb;
        u32x2 o; o.x = pk2(gelu_tanh(v.x), gelu_tanh(v.y)); o.y = pk2(gelu_tanh(v.z), gelu_tanh(v.w));
        *(u32x2*)(hid + ((size_t)kv * 4096 + row) * 256 + col) = o;
      }
  }
}
DI void phase_cmp2(const Params& P_, unsigned char* lds) {
  Params P = P_; { size_t z_ = 0; asm volatile("" : "+s"(z_)); P.ws = P_.ws + z_; }
  TILE_IDS;
  const bf16_t* hid = (const bf16_t*)(P.ws + WS_HID); bf16_t* kc = (bf16_t*)(P.ws + WS_KC); bf16_t* vc = (bf16_t*)(P.ws + WS_VC);
  for (int tile = bid; tile < 64; tile += gridDim.x) {
    const int kv = tile >> 5, rt = tile & 31, row0 = rt * 128;
    const bf16_t* wt = (const bf16_t*)(P.ws + WS_W + W_C2) + (size_t)kv * 128 * 256;
    const bf16_t* a = hid + ((size_t)kv * 4096 + row0) * 256;
    f32x4 acc[4][2]; ACC_ZERO(acc);
    gemm_kloop(lds, a + (size_t)lr * 256 + lk, a + (size_t)(lr + 64) * 256 + lk, 64, wt + (size_t)lr * 256 + lk, wt + (size_t)(lr + 64) * 256 + lk, 4, acc);
    if (wc < 2) {
#pragma unroll
      for (int m = 0; m < 4; ++m)
#pragma unroll
        for (int n = 0; n < 2; ++n) {
          const int rr = row0 + wr * 64 + m * 16 + fr, d = wc * 32 + n * 16 + 4 * fq;
          const int b = rr >> 11, nn = (rr >> 2) & 511, g = rr & 3; const f32x4 v = acc[m][n];
          if (kv == 0) { u32x2 o; o.x = pk2(v.x, v.y); o.y = pk2(v.z, v.w); *(u32x2*)(kc + ((size_t)((b * 4 + g) * 512 + nn)) * 64 + d) = o; }
          else { bf16_t* dst = vc + ((size_t)((b * 4 + g) * 64 + d)) * 512 + perm16(nn); dst[0] = (bf16_t)f2bf(v.x); dst[512] = (bf16_t)f2bf(v.y); dst[1024] = (bf16_t)f2bf(v.z); dst[1536] = (bf16_t)f2bf(v.w); }
        }
    }
  }
}
DI void phase_glu(const Params& P_, unsigned char* lds) {
  Params P = P_; { size_t z_ = 0; asm volatile("" : "+s"(z_)); P.ws = P_.ws + z_; }
  TILE_IDS;
  const bf16_t* y = (const bf16_t*)(P.ws + WS_G); const bf16_t* wt = (const bf16_t*)(P.ws + WS_W + W_GLU); bf16_t* ssm = (bf16_t*)(P.ws + WS_E);
  for (int tile = bid; tile < (NT / 128) * 4; tile += gridDim.x) {
    const int rt = tile >> 2, ct = tile & 3, row0 = rt * 128, col0 = ct * 128;
    f32x4 acc[4][2]; ACC_ZERO(acc);
    gemm_kloop(lds, y + (size_t)(row0 + lr) * 512 + lk, y + (size_t)(row0 + lr + 64) * 512 + lk, 64, wt + (size_t)(col0 + lr) * 512 + lk, wt + (size_t)(col0 + lr + 64) * 512 + lk, 8, acc);
#pragma unroll
    for (int m = 0; m < 4; ++m)
#pragma unroll
      for (int n = 0; n < 2; ++n) {
        const int row = row0 + wr * 64 + m * 16 + fr, col = col0 + wc * 32 + n * 16 + 4 * fq;
        const u32x2 yy = *(const u32x2*)(y + (size_t)row * 512 + col); const f32x4 v = acc[m][n];
        u32x2 o; o.x = pk2(bflo(yy.x) * sigmoidf_(v.x), bfhi(yy.x) * sigmoidf_(v.y)); o.y = pk2(bflo(yy.y) * sigmoidf_(v.z), bfhi(yy.y) * sigmoidf_(v.w));
        *(u32x2*)(ssm + (size_t)row * 512 + col) = o;
      }
  }
}
struct EpiInproj {
  static constexpr bool PERM = false, AFTER_DRAIN = false;
  bf16_t* qb; bf16_t* kvk; bf16_t* vT; bf16_t* mg; bf16_t* ub; float* gates;
  DI void operator()(const f32x4 (&acc)[2][2][4][2], const pg8::Unit& u, int wr, int wc, int fr_, int fq_) const {
    const int pn = u.pn; int fr = fr_, fq = fq_; asm volatile("" : "+v"(fr), "+v"(fq));
#pragma unroll
    for (int ai = 0; ai < 2; ++ai)
#pragma unroll
      for (int m = 0; m < 4; ++m) {
        const int row = u.pm * 256 + ai * 128 + wr * 64 + m * 16 + fr;
#pragma unroll
        for (int bj = 0; bj < 2; ++bj)
#pragma unroll
          for (int n = 0; n < 2; ++n) {
            const int cl = bj * 128 + wc * 32 + n * 16 + 4 * fq;
            const f32x4 v = acc[ai][bj][m][n];
            if (pn < 4) { u32x2 o; o.x = pk2(v.x * QSCALE, v.y * QSCALE); o.y = pk2(v.z * QSCALE, v.w * QSCALE); *(u32x2*)(qb + (size_t)row * DM + pn * 256 + cl) = o; }
            else if (pn < 10) {
              const int seg = pn - 4;
              if (seg == 5) {
                const int b = row >> 13, t = row & (SEQ - 1), g = cl >> 6, d = cl & 63;
                bf16_t* dst = vT + ((size_t)(((1 * NB + b) * 4 + g) * 64 + d)) * SEQ + perm16(t);
                dst[0] = (bf16_t)f2bf(v.x); dst[SEQ] = (bf16_t)f2bf(v.y); dst[2 * SEQ] = (bf16_t)f2bf(v.z); dst[3 * SEQ] = (bf16_t)f2bf(v.w);
              } else if (seg == 3) {
                const unsigned t = row & (SEQ - 1), pos = perm16(t) & 63;
                const unsigned ro = ((unsigned)(row >> 13) * 512u + (t >> 6)) * 4096u + (pos >> 3) * 256u + (pos & 7), co = (unsigned)(cl >> 6) * 524288u + (unsigned)((cl >> 5) & 1) * 2048u + (unsigned)(cl & 31) * 8u;
                bf16_t* dst = vT + (ro + co);
                dst[0] = (bf16_t)f2bf(v.x); dst[8] = (bf16_t)f2bf(v.y); dst[16] = (bf16_t)f2bf(v.z); dst[24] = (bf16_t)f2bf(v.w);
              } else if (seg == 2) {
                const unsigned t = row & (SEQ - 1);
                const unsigned ro = ((unsigned)(row >> 13) * 512u + (t >> 6)) * 4096u + ((t >> 5) & 1) * 2048u + (t & 31) * 8u, co = (unsigned)(cl >> 6) * 524288u + (unsigned)((cl >> 3) & 7) * 256u + (unsigned)(cl & 7);
                u32x2 o; o.x = pk2(v.x, v.y); o.y = pk2(v.z, v.w);
                *(u32x2*)(kvk + (WS_KSF - WS_C) / 2 + (ro + co)) = o;
              } else {
                const int slot = seg == 4 ? 3 : seg;
                u32x2 o; o.x = pk2(v.x, v.y); o.y = pk2(v.z, v.w); *(u32x2*)(kvk + (size_t)row * DM + slot * 256 + cl) = o;
              }
            } else if (pn < 18) {
              u32x2 o; o.x = pk2(sigmoidf_(v.x), sigmoidf_(v.y)); o.y = pk2(sigmoidf_(v.z), sigmoidf_(v.w)); *(u32x2*)(mg + (size_t)row * 2048 + (pn - 10) * 256 + cl) = o;
            } else if (pn < 20) { const int ch = (pn - 18) * 256 + cl; u32x2 o; o.x = pk2(v.x, v.y); o.y = pk2(v.z, v.w); *(u32x2*)(ub + ((size_t)(ch >> 4) * NT + row) * 16 + (ch & 15)) = o; }
            else { if (cl < 48) { f32x4 o = {sigmoidf_(v.x), sigmoidf_(v.y), sigmoidf_(v.z), sigmoidf_(v.w)}; *(f32x4*)(gates + (size_t)row * 48 + cl) = o; } }
          }
      }
  }
};
DI void phase_inproj8(const Params& P_, unsigned char* lds) {
  Params P = P_; { size_t z_ = 0; asm volatile("" : "+s"(z_)); P.ws = P_.ws + z_; }
  pg8::Gemm g{(const bf16_t*)(P.ws + WS_A), (const bf16_t*)(P.ws + WS_W + W_IN), NT, 5120, DM};
  pg8::StaticOrder S; S.init(NT, 5120, gridDim.x, obid());
  EpiInproj E{(bf16_t*)(P.ws + WS_B), (bf16_t*)(P.ws + WS_C), (bf16_t*)(P.ws + WS_DV), (bf16_t*)(P.ws + WS_F), (bf16_t*)(P.ws + WS_E), (float*)(P.ws + WS_GATES)};
  pg8::gemm_phase<EpiInproj, pg8::StaticOrder, true, true>((PG8_LAS unsigned char*)lds, g, S, E);
}
struct EpiMerge1 {
  static constexpr bool PERM = false, AFTER_DRAIN = false;
  const bf16_t* mg; bf16_t* tmp;
  DI void operator()(const f32x4 (&acc)[2][2][4][2], const pg8::Unit& u, int wr, int wc, int fr, int fq) const {
#pragma unroll
    for (int ai = 0; ai < 2; ++ai)
#pragma unroll
      for (int m = 0; m < 4; ++m) {
        const int row = u.pm * 256 + ai * 128 + wr * 64 + m * 16 + fr;
#pragma unroll
        for (int bj = 0; bj < 2; ++bj)
#pragma unroll
          for (int n = 0; n < 2; ++n) {
            const int col = u.pn * 256 + bj * 128 + wc * 32 + n * 16 + 4 * fq; const f32x4 v = acc[ai][bj][m][n];
            const u32x2 ga = *(const u32x2*)(mg + (size_t)row * 2048 + col);
            u32x2 o; o.x = pk2(v.x * bflo(ga.x), v.y * bfhi(ga.x)); o.y = pk2(v.z * bflo(ga.y), v.w * bfhi(ga.y));
            *(u32x2*)(tmp + (size_t)row * DM + col) = o;
          }
      }
  }
};
struct EpiMerge2 {
  static constexpr bool PERM = false, AFTER_DRAIN = false;
  const bf16_t* mg; const bf16_t* tmp; bf16_t* mer;
  DI void operator()(const f32x4 (&acc)[2][2][4][2], const pg8::Unit& u, int wr, int wc, int fr, int fq) const {
#pragma unroll
    for (int ai = 0; ai < 2; ++ai)
#pragma unroll
      for (int m = 0; m < 4; ++m) {
        const int row = u.pm * 256 + ai * 128 + wr * 64 + m * 16 + fr;
#pragma unroll
        for (int bj = 0; bj < 2; ++bj)
#pragma unroll
          for (int n = 0; n < 2; ++n) {
            const int col = u.pn * 256 + bj * 128 + wc * 32 + n * 16 + 4 * fq; const f32x4 v = acc[ai][bj][m][n];
            const u32x2 gs = *(const u32x2*)(mg + (size_t)row * 2048 + 1024 + col);
#if EN_ATTN
            const u32x2 tv = *(const u32x2*)(tmp + (size_t)row * DM + col);
            const float t0 = bflo(tv.x), t1 = bfhi(tv.x), t2 = bflo(tv.y), t3 = bfhi(tv.y);
#else
            const float t0 = 0.f, t1 = 0.f, t2 = 0.f, t3 = 0.f;
#endif
            u32x2 o; o.x = pk2(t0 + v.x * bflo(gs.x), t1 + v.y * bfhi(gs.x)); o.y = pk2(t2 + v.z * bflo(gs.y), t3 + v.w * bfhi(gs.y));
            *(u32x2*)(mer + (size_t)row * DM + col) = o;
          }
      }
  }
};
DI void phase_merge8(const Params& P_, unsigned char* lds) {
  Params P = P_; { size_t z_ = 0; asm volatile("" : "+s"(z_)); P.ws = P_.ws + z_; }
#if EN_ATTN
  { pg8::Gemm g{(const bf16_t*)(P.ws + WS_A), (const bf16_t*)(P.ws + WS_W + W_O), NT, DM, DM};
    pg8::StaticOrder S; S.init(NT, DM, gridDim.x, obid());
    EpiMerge1 E{(const bf16_t*)(P.ws + WS_F), (bf16_t*)(P.ws + WS_C)};
    pg8::gemm_phase<EpiMerge1, pg8::StaticOrder, true, true>((PG8_LAS unsigned char*)lds, g, S, E); }
#endif
  { pg8::Gemm g{(const bf16_t*)(P.ws + WS_E), (const bf16_t*)(P.ws + WS_W + W_SO), NT, DM, 512};
    pg8::StaticOrder S; S.init(NT, DM, gridDim.x, obid());
    EpiMerge2 E{(const bf16_t*)(P.ws + WS_F), (const bf16_t*)(P.ws + WS_C), (bf16_t*)(P.ws + WS_B)};
    pg8::gemm_phase<EpiMerge2, pg8::StaticOrder, true, true>((PG8_LAS unsigned char*)lds, g, S, E); }
}
struct EpiWout {
  static constexpr bool PERM = false, AFTER_DRAIN = false;
  const float* mod; const float* xin; float* out;
  DI void operator()(const f32x4 (&acc)[2][2][4][2], const pg8::Unit& u, int wr, int wc, int fr, int fq) const {
#pragma unroll
    for (int ai = 0; ai < 2; ++ai)
#pragma unroll
      for (int m = 0; m < 4; ++m) {
        const int row = u.pm * 256 + ai * 128 + wr * 64 + m * 16 + fr, b = row >> 13;
#pragma unroll
        for (int bj = 0; bj < 2; ++bj)
#pragma unroll
          for (int n = 0; n < 2; ++n) {
            const int col = u.pn * 256 + bj * 128 + wc * 32 + n * 16 + 4 * fq;
            const f32x4 g1 = *(const f32x4*)(mod + (size_t)b * 6144 + 2048 + col);
            const f32x4 xv = *(const f32x4*)(xin + (size_t)row * DM + col);
            *(f32x4*)(out + (size_t)row * DM + col) = xv + g1 * acc[ai][bj][m][n];
          }
      }
  }
};
DI void phase_wout8(const Params& P_, int l, unsigned char* lds) {
  Params P = P_; { size_t z_ = 0; asm volatile("" : "+s"(z_)); P.ws = P_.ws + z_; }
  pg8::Gemm g{(const bf16_t*)(P.ws + WS_B), (const bf16_t*)(P.ws + WS_W + W_OUT), NT, DM, DM};
  pg8::StaticOrder S; S.init(NT, DM, gridDim.x, obid());
  EpiWout E{(const float*)(P.ws + WS_MOD) + (size_t)(l * 2) * 6144, l == 0 ? P.in[0] : P.out, P.out};
  pg8::gemm_phase<EpiWout, pg8::StaticOrder, true, true>((PG8_LAS unsigned char*)lds, g, S, E);
}

DI bool moe_find(const int* cnt, int rb, int& e, int& rbl, int& ce) {
  int base = 0;
  for (int i = 0; i < NEXP; ++i) { const int c = cnt[i], nb = (c + 127) >> 7; if (rb < base + nb) { e = i; rbl = rb - base; ce = c; return true; } base += nb; }
  return false;
}
DI void phase_moe1(const Params& P_, int l, unsigned char* lds) {
  Params P = P_; { size_t z_ = 0; asm volatile("" : "+s"(z_)); P.ws = P_.ws + z_; }
  TILE_IDS;
  const int* cnt = (const int*)(P.ws + WS_CNT) + l * 32; const int* list = (const int*)(P.ws + WS_LIST);
  const bf16_t* h2 = (const bf16_t*)(P.ws + WS_A); bf16_t* act = (bf16_t*)(P.ws + WS_B);
  int total = 0; for (int i = 0; i < NEXP; ++i) total += (cnt[i] + 127) >> 7;
  for (int tile = bid; tile < total * 4; tile += gridDim.x) {
    const int rb = tile >> 2, ct = tile & 3; int e = 0, rbl = 0, ce = 1; moe_find(cnt, rb, e, rbl, ce);
    const bf16_t* wt = (const bf16_t*)(P.ws + WS_W + W_GU) + (size_t)e * 512 * 1024 + (size_t)(ct * 128) * 1024;
    const bf16_t* ap[2];
#pragma unroll
    for (int i = 0; i < 2; ++i) { int idx = rbl * 128 + lr + 64 * i; idx = idx < ce ? idx : ce - 1; const int tok = list[e * LISTCAP + idx] >> 1; ap[i] = h2 + (size_t)tok * DM + lk; }
    f32x4 acc[4][2]; ACC_ZERO(acc);
    gemm_kloop(lds, ap[0], ap[1], 64, wt + (size_t)lr * DM + lk, wt + (size_t)(lr + 64) * DM + lk, 16, acc);
#pragma unroll
    for (int m = 0; m < 4; ++m) {
      const int arow = rb * 128 + wr * 64 + m * 16 + fr, col = ct * 64 + wc * 16 + 4 * fq;
      const f32x4 g = acc[m][0], u = acc[m][1];
      u32x2 o; o.x = pk2(g.x * sigmoidf_(g.x) * u.x, g.y * sigmoidf_(g.y) * u.y); o.y = pk2(g.z * sigmoidf_(g.z) * u.z, g.w * sigmoidf_(g.w) * u.w);
      *(u32x2*)(act + (size_t)arow * 256 + col) = o;
    }
  }
}
DI void phase_moe2(const Params& P_, int l, unsigned char* lds) {
  Params P = P_; { size_t z_ = 0; asm volatile("" : "+s"(z_)); P.ws = P_.ws + z_; }
  TILE_IDS;
  const int* cnt = (const int*)(P.ws + WS_CNT) + l * 32; const int* list = (const int*)(P.ws + WS_LIST); const float* wts = (const float*)(P.ws + WS_WT);
  const bf16_t* act = (const bf16_t*)(P.ws + WS_B); bf16_t* ys = (bf16_t*)(P.ws + WS_F);
  constexpr int ASUB = 128 * GT_ROWB, BOFF = 4 * ASUB;
  int total = 0; for (int i = 0; i < NEXP; ++i) total += (cnt[i] + 127) >> 7;
  const int lkb = (tid & 7) * 16;
  for (int item = bid; item < total * 4; item += gridDim.x) {
    const int rb = item >> 2, ct0 = (item & 3) * 2; int e = 0, rbl = 0, ce = 1; moe_find(cnt, rb, e, rbl, ce);
    const bf16_t* wt = (const bf16_t*)(P.ws + WS_W + W_D) + (size_t)e * 1024 * 256;
    const bf16_t* a0 = act + (size_t)(rb * 128 + lr) * 256 + lk; const bf16_t* a1 = a0 + 64 * 256;
    u32x4 ra[8], xb0, xb1, yb0, yb1;
#pragma unroll
    for (int k = 0; k < 4; ++k) { ra[2 * k] = *(const u32x4*)(a0 + 64 * k); ra[2 * k + 1] = *(const u32x4*)(a1 + 64 * k); }
#define M2_BLOAD(q0_, q1_, s_) do { const bf16_t* bp_ = wt + (size_t)((ct0 + ((s_) >> 2)) * 128 + lr) * 256 + ((s_) & 3) * 64 + lk; q0_ = *(const u32x4*)bp_; q1_ = *(const u32x4*)(bp_ + 64 * 256); } while (0)
#define M2_BSTORE(q0_, q1_, buf_) do { unsigned char* s_ = lds + BOFF + (buf_) * ASUB; *(u32x4*)(s_ + lr * GT_ROWB + lkb) = q0_; *(u32x4*)(s_ + (lr + 64) * GT_ROWB + lkb) = q1_; } while (0)
#define M2_COMPUTE(s_, buf_) do { \
      const unsigned char* As = lds + ((s_) & 3) * ASUB + (wr * 64 + fr) * GT_ROWB + fq * 16; \
      const unsigned char* Bs = lds + BOFF + (buf_) * ASUB + (wc * 32 + fr) * GT_ROWB + fq * 16; \
      _Pragma("unroll") for (int ks = 0; ks < 2; ++ks) { \
        bf16x8 af[4], bfr[2]; \
        _Pragma("unroll") for (int m = 0; m < 4; ++m) af[m] = *(const bf16x8*)(As + m * 16 * GT_ROWB + ks * 64); \
        _Pragma("unroll") for (int n = 0; n < 2; ++n) bfr[n] = *(const bf16x8*)(Bs + n * 16 * GT_ROWB + ks * 64); \
        _Pragma("unroll") for (int m = 0; m < 4; ++m) _Pragma("unroll") for (int n = 0; n < 2; ++n) acc[m][n] = __builtin_amdgcn_mfma_f32_16x16x32_bf16(bfr[n], af[m], acc[m][n], 0, 0, 0); } } while (0)
#define M2_EPI(ct_) do { _Pragma("unroll") for (int m = 0; m < 4; ++m) { const int idx = rbl * 128 + wr * 64 + m * 16 + fr; \
      if (idx < ce) { const int slot = list[e * LISTCAP + idx]; const float w_ = wts[slot]; \
        _Pragma("unroll") for (int n = 0; n < 2; ++n) { const int col = (ct_) * 128 + wc * 32 + n * 16 + 4 * fq; const f32x4 v = acc[m][n] * w_; \
          u32x2 o; o.x = pk2(v.x, v.y); o.y = pk2(v.z, v.w); *(u32x2*)(ys + (size_t)slot * DM + col) = o; } } } ACC_ZERO(acc); } while (0)
    M2_BLOAD(xb0, xb1, 0);
#pragma unroll
    for (int k = 0; k < 4; ++k) { *(u32x4*)(lds + k * ASUB + lr * GT_ROWB + lkb) = ra[2 * k]; *(u32x4*)(lds + k * ASUB + (lr + 64) * GT_ROWB + lkb) = ra[2 * k + 1]; }
    M2_BSTORE(xb0, xb1, 0);
    M2_BLOAD(yb0, yb1, 1);
    __syncthreads();
    f32x4 acc[4][2]; ACC_ZERO(acc);
#pragma unroll 1
    for (int s2 = 0; s2 < 8; s2 += 2) {
      if (s2 + 2 < 8) M2_BLOAD(xb0, xb1, s2 + 2);
      M2_COMPUTE(s2, 0);
      M2_BSTORE(yb0, yb1, 1);
      __syncthreads();
      if (s2 + 3 < 8) M2_BLOAD(yb0, yb1, s2 + 3);
      M2_COMPUTE(s2 + 1, 1);
      if (s2 == 2) M2_EPI(ct0);
      if (s2 == 6) M2_EPI(ct0 + 1);
      if (s2 + 2 < 8) M2_BSTORE(xb0, xb1, 0);
      __syncthreads();
    }
#undef M2_BLOAD
#undef M2_BSTORE
#undef M2_COMPUTE
#undef M2_EPI
  }
}

typedef float f32x2v __attribute__((ext_vector_type(2)));
DI void phase_s5a(const Params& P_, int l, unsigned char* lds) {
  Params P = P_; { size_t z_ = 0; asm volatile("" : "+s"(z_)); P.ws = P_.ws + z_; }
  TILE_IDS;
  const bf16_t* ub = (const bf16_t*)(P.ws + WS_E); float* Lb = (float*)(P.ws + WS_L);
  const bf16_t* M1 = (const bf16_t*)(P.ws + WS_TAB + (size_t)l * TAB_LAYER + TAB_M1);
  const int first = (int)gridDim.x >= 192 ? 128 : 0;
  for (int tile = bid - first; tile >= 0 && tile < 64; tile += gridDim.x) {
    const int g = tile >> 1, rt = tile & 1;
    const bf16_t* a = ub + ((size_t)g * NT / 64 + rt * 128) * 1024;
    const bf16_t* wt = M1 + (size_t)g * 128 * 1024;
    f32x4 acc[4][2]; ACC_ZERO(acc);
    gemm_kloop(lds, a + (size_t)lr * 1024 + lk, a + (size_t)(lr + 64) * 1024 + lk, 64, wt + (size_t)lr * 1024 + lk, wt + (size_t)(lr + 64) * 1024 + lk, 16, acc);
#pragma unroll
    for (int m = 0; m < 4; ++m)
#pragma unroll
      for (int n = 0; n < 2; ++n) {
        const int R = rt * 128 + wr * 64 + m * 16 + fr, comp = wc * 32 + n * 16 + 4 * fq;
        *(f32x4*)(Lb + ((size_t)(R * 32 + g) * 64) * 2 + comp) = acc[m][n];
      }
  }
}
DI void s5_carry(const Params& P_, int l) {
  Params P = P_; { size_t z_ = 0; asm volatile("" : "+s"(z_)); P.ws = P_.ws + z_; }
  const int tid_ = otid(), bid = obid(), wave = tid_ >> 6, lane = tid_ & 63;
  const int item = (gridDim.x * NWAVE - 1) - (bid * NWAVE + wave);
  if (item >= NB * 32) return;
  const int b = item >> 5, g = item & 31;
  const float* pp = (const float*)(P.ws + WS_S5P) + (size_t)((l * 32 + g) * 64 + lane) * 36;
  const float aTr = pp[2], aTi = pp[3];
  float2* Lp = (float2*)(P.ws + WS_L) + ((size_t)(b * 128) * 32 + g) * 64 + lane;
  unsigned* Sp = (unsigned*)(P.ws + WS_SIN) + ((size_t)(g * 256 + b * 128)) * 64 + lane;
  float sr = 0.f, si = 0.f; asm volatile("" : "+v"(sr), "+v"(si));
  for (int c0 = 0; c0 < 128; c0 += 8) {
    float2 v[8];
#pragma unroll
    for (int k = 0; k < 8; ++k) v[k] = Lp[(size_t)(c0 + k) * 2048];
#pragma unroll
    for (int k = 0; k < 8; ++k) { Lp[(size_t)(c0 + k) * 2048] = make_float2(sr, si); Sp[(size_t)(c0 + k) * 64] = pk2(sr, si);
      const float nr = aTr * sr - aTi * si + v[k].x, ni = aTr * si + aTi * sr + v[k].y; sr = nr; si = ni; }
  }
}
DI void phase_s5c(const Params& P_, int l, unsigned char* lds) {
  Params P = P_; { size_t z_ = 0; asm volatile("" : "+s"(z_)); P.ws = P_.ws + z_; }
  TILE_IDS;
  const bf16_t* ub = (const bf16_t*)(P.ws + WS_E); const bf16_t* sinb = (const bf16_t*)(P.ws + WS_SIN); bf16_t* yb = (bf16_t*)(P.ws + WS_G);
  const bf16_t* tab = (const bf16_t*)(P.ws + WS_TAB + (size_t)l * TAB_LAYER);
  int* dctr = (int*)(P.ws + 640) + l; int* dslot = (int*)(lds + LDS_BYTES - 32);
  constexpr int ROWB = 144, SA = 0, SB = 128 * ROWB, STAGE = 2 * 128 * ROWB;
  const int lkb = (tid & 7) * 16, kch = tid & 7;
  for (;;) {
    if (threadIdx.x == 0) *dslot = atomicAdd(dctr, 1);
    __syncthreads();
    const int tile = *dslot;
    __syncthreads();
    if (tile >= 512) break;
    const int g = tile >> 4, rt = (tile >> 3) & 1, ct = tile & 7;
    const bf16_t* Kt = tab + TAB_KT / 2 + (size_t)g * 64 * 256; const bf16_t* M2 = tab + TAB_M2 / 2 + (size_t)g * 1024 * 128;
    const bf16_t* ua = ub + ((size_t)g * 256 + rt * 128) * 1024; const bf16_t* sa = sinb + ((size_t)g * 256 + rt * 128) * 128;
    const int nbt = 2 * ct + 2 < 16 ? 2 * ct + 2 : 16, ns = nbt + 2;
    u32x4 xa0, xa1, xb0, xb1, ya0, ya1, yb0, yb1;
#define S5_LOAD(p0_, p1_, q0_, q1_, s_) do { \
      if ((s_) < nbt) { p0_ = *(const u32x4*)(ua + (size_t)lr * 1024 + (s_) * 64 + lk); p1_ = *(const u32x4*)(ua + (size_t)(lr + 64) * 1024 + (s_) * 64 + lk); \
        const int i_ = 4 * (s_) + (kch >> 1), hq_ = (kch & 1) * 8; \
        { const int t_ = 8 * ct + (lr >> 4), h_ = lr & 15; q0_ = t_ >= i_ ? *(const u32x4*)(Kt + ((t_ - i_) * 16 + h_) * 16 + hq_) : (u32x4){0u, 0u, 0u, 0u}; } \
        { const int t_ = 8 * ct + 4 + (lr >> 4), h_ = lr & 15; q1_ = t_ >= i_ ? *(const u32x4*)(Kt + ((t_ - i_) * 16 + h_) * 16 + hq_) : (u32x4){0u, 0u, 0u, 0u}; } \
      } else { const int k0_ = ((s_) - nbt) * 64 + lk; \
        p0_ = *(const u32x4*)(sa + (size_t)lr * 128 + k0_); p1_ = *(const u32x4*)(sa + (size_t)(lr + 64) * 128 + k0_); \
        q0_ = *(const u32x4*)(M2 + (size_t)(ct * 128 + lr) * 128 + k0_); q1_ = *(const u32x4*)(M2 + (size_t)(ct * 128 + lr + 64) * 128 + k0_); } } while (0)
#define S5_STORE(p0_, p1_, q0_, q1_, buf) do { unsigned char* s_ = lds + (buf) * STAGE; \
      *(u32x4*)(s_ + SA + lr * ROWB + lkb) = p0_; *(u32x4*)(s_ + SA + (lr + 64) * ROWB + lkb) = p1_; \
      *(u32x4*)(s_ + SB + lr * ROWB + lkb) = q0_; *(u32x4*)(s_ + SB + (lr + 64) * ROWB + lkb) = q1_; } while (0)
#define S5_COMPUTE(buf) do { \
      const unsigned char* As = lds + (buf) * STAGE + SA + (wr * 64 + fr) * ROWB + fq * 16; \
      const unsigned char* Bs = lds + (buf) * STAGE + SB + (wc * 32 + fr) * ROWB + fq * 16; \
      _Pragma("unroll") for (int ks = 0; ks < 2; ++ks) { \
        bf16x8 af[4], bfr[2]; \
        _Pragma("unroll") for (int m = 0; m < 4; ++m) af[m] = *(const bf16x8*)(As + m * 16 * ROWB + ks * 64); \
        _Pragma("unroll") for (int n = 0; n < 2; ++n) bfr[n] = *(const bf16x8*)(Bs + n * 16 * ROWB + ks * 64); \
        _Pragma("unroll") for (int m = 0; m < 4; ++m) _Pragma("unroll") for (int n = 0; n < 2; ++n) acc[m][n] = __builtin_amdgcn_mfma_f32_16x16x32_bf16(bfr[n], af[m], acc[m][n], 0, 0, 0); } } while (0)
    f32x4 acc[4][2]; ACC_ZERO(acc);
    S5_LOAD(xa0, xa1, xb0, xb1, 0); S5_STORE(xa0, xa1, xb0, xb1, 0); S5_LOAD(ya0, ya1, yb0, yb1, 1); __syncthreads();
    for (int st = 0; st < ns; st += 2) {
      if (st + 2 < ns) S5_LOAD(xa0, xa1, xb0, xb1, st + 2);
      S5_COMPUTE(0);
      if (st + 1 < ns) S5_STORE(ya0, ya1, yb0, yb1, 1);
      __syncthreads();
      if (st + 1 >= ns) break;
      if (st + 3 < ns) S5_LOAD(ya0, ya1, yb0, yb1, st + 3);
      S5_COMPUTE(1);
      if (st + 2 < ns) S5_STORE(xa0, xa1, xb0, xb1, 0);
      __syncthreads();
    }
#undef S5_LOAD
#undef S5_STORE
#undef S5_COMPUTE
    const float* dsk = P.in[13] + (size_t)(l * 32 + g) * 16;
#pragma unroll
    for (int m = 0; m < 4; ++m)
#pragma unroll
      for (int n = 0; n < 2; ++n) {
        const int R = rt * 128 + wr * 64 + m * 16 + fr, col = ct * 128 + wc * 32 + n * 16 + 4 * fq, t = col >> 4, h = col & 15;
        const u32x2 uu = *(const u32x2*)(ub + ((size_t)g * 256 + R) * 1024 + col); const f32x4 dd = *(const f32x4*)(dsk + h); const f32x4 v = acc[m][n];
        const float y0 = gelu_tanh(v.x + dd.x * bflo(uu.x)), y1 = gelu_tanh(v.y + dd.y * bfhi(uu.x)), y2 = gelu_tanh(v.z + dd.z * bflo(uu.y)), y3 = gelu_tanh(v.w + dd.w * bfhi(uu.y));
        const size_t tokn = (size_t)(R >> 7) * SEQ + 64 * (R & 127) + t;
        u32x2 o; o.x = pk2(y0, y1); o.y = pk2(y2, y3); *(u32x2*)(yb + tokn * 512 + g * 16 + h) = o;
      }
  }
}

constexpr int AT_ROWB = 144, AT_KS = 0, AT_VS = 2 * 64 * AT_ROWB, AT_IMP = 4 * 64 * AT_ROWB, AT_OACC = AT_IMP, AT_IMPS = 129, AT_EE = AT_IMP + 64 * AT_IMPS * 4,
              AT_SEL = AT_IMP + 66048, AT_QS = AT_SEL + 1024, AT_QL = AT_QS + 32768, AT_NJ = AT_QL + 8192, AT_ITEMS = AT_NJ + 512, AT_MREF = AT_ITEMS + 512,
              AT_LACC = AT_MREF + 1024, AT_INVQ = AT_LACC + 1024, AT_MISC = AT_INVQ + 512, AT_LOWN = AT_MISC + 64, AT_END = AT_LOWN + 1024;
static_assert(AT_END <= LDS_BYTES - 16, "attention LDS");
#define MFMA32(a, b, c) __builtin_amdgcn_mfma_f32_32x32x16_bf16((a), (b), (c), 0, 0, 0)
DI int crow_of(int reg, int hh) { return (reg & 3) + 8 * (reg >> 2) + 4 * hh; }

struct AttnState { f32x16 o0, o1; float m, l; };
DI void st_init(AttnState& S) { S.m = -1e30f; S.l = 0.f;
#pragma unroll
  for (int i = 0; i < 16; ++i) { S.o0[i] = 0.f; S.o1[i] = 0.f; } }

DI void at_qk(const unsigned char* lds, int buf, int r, int hh, int qrow, f32x16& p0, f32x16& p1) {
  const unsigned char* kb = lds + AT_KS + buf * 64 * AT_ROWB + r * AT_ROWB + hh * 16;
  const unsigned char* qp = lds + AT_QS + qrow * 128;
  const f32x16 z = {0.f, 0.f, 0.f, 0.f, 0.f, 0.f, 0.f, 0.f, 0.f, 0.f, 0.f, 0.f, 0.f, 0.f, 0.f, 0.f};
#pragma unroll
  for (int ds = 0; ds < 4; ++ds) { const bf16x8 a0 = *(const bf16x8*)(kb + ds * 32), a1 = *(const bf16x8*)(kb + 32 * AT_ROWB + ds * 32);
    const bf16x8 q = *(const bf16x8*)(qp + (((ds * 2 + hh) ^ (qrow & 7)) * 16));
    if (ds == 0) { p0 = MFMA32(a0, q, z); p1 = MFMA32(a1, q, z); } else { p0 = MFMA32(a0, q, p0); p1 = MFMA32(a1, q, p1); }
    if (ds == 1) __builtin_amdgcn_sched_barrier(0); }
}
DI bf16x8 pack8(const f32x16& p, int s2) {
  u32x4 w; w.x = pk2(p[8 * s2], p[8 * s2 + 1]); w.y = pk2(p[8 * s2 + 2], p[8 * s2 + 3]); w.z = pk2(p[8 * s2 + 4], p[8 * s2 + 5]); w.w = pk2(p[8 * s2 + 6], p[8 * s2 + 7]);
  return __builtin_bit_cast(bf16x8, w);
}
DI void at_pv(const unsigned char* lds, int buf, int r, int hh, const f32x16& p0, const f32x16& p1, f32x16& oa, f32x16& ob) {
  const unsigned char* vb = lds + AT_VS + buf * 64 * AT_ROWB + r * AT_ROWB + hh * 16;
#pragma unroll
  for (int gk = 0; gk < 4; ++gk) {
    const bf16x8 pb = (gk < 2) ? pack8(p0, gk & 1) : pack8(p1, gk & 1);
    const bf16x8 va = *(const bf16x8*)(vb + gk * 32), vb2 = *(const bf16x8*)(vb + 32 * AT_ROWB + gk * 32);
    oa = MFMA32(va, pb, oa); ob = MFMA32(vb2, pb, ob);
    if (gk == 1) __builtin_amdgcn_sched_barrier(0);
  }
}
template <int MODE>
DI void at_online(AttnState& S, f32x16& p0, f32x16& p1, int key0, int lo, int hi, bool on, int hh) {
  float tm = -1e30f;
  if (MODE == 1) {
    int lor = lo - key0 - 4 * hh, hir = hi - key0 - 4 * hh;
    if (hir < lor) { lor = 4096; hir = 4096; }
    const unsigned span = (unsigned)(hir - lor);
#pragma unroll
    for (int i = 0; i < 16; ++i) { const int c0 = (i & 3) + 8 * (i >> 2);
      p0[i] = ((unsigned)(c0 - lor) <= span) ? p0[i] : -1e30f; p1[i] = ((unsigned)(c0 + 32 - lor) <= span) ? p1[i] : -1e30f; }
  }
  if (MODE != 1) asm volatile("s_nop 15\n\ts_nop 7" : "+v"(p0), "+v"(p1));
#pragma unroll
  for (int i = 0; i < 16; ++i) asm("v_max3_f32 %0, %0, %1, %2" : "+v"(tm) : "v"(p0[i]), "v"(p1[i]));
  tm = fmaxf(tm, __shfl_xor(tm, 32));
  if (MODE == 2) tm = on ? tm : -1e30f;
  if (__any(tm > S.m)) {
    const float mn = fmaxf(S.m, tm); const float al = __builtin_amdgcn_exp2f(S.m - mn); S.m = mn; S.l *= al;
#pragma unroll
    for (int i = 0; i < 16; ++i) { S.o0[i] *= al; S.o1[i] *= al; }
  }
  float mn = S.m;
  if (MODE == 2) mn = on ? mn : 1e30f;
  if (MODE == 1) mn = mn < -1e29f ? 1e30f : mn;
  float rs = 0.f;
#pragma unroll
  for (int i = 0; i < 16; ++i) {
    const float e0 = __builtin_amdgcn_exp2f(p0[i] - mn), e1 = __builtin_amdgcn_exp2f(p1[i] - mn);
    p0[i] = e0; p1[i] = e1; rs += e0 + e1;
  }
  S.l += rs;
}

DI void attn_tile(const Params& P_, unsigned char* lds, int b, int g, int c) {
  Params P = P_; { size_t z_ = 0; asm volatile("" : "+s"(z_)); P.ws = P_.ws + z_; }
#define AT_IDS const int tid = otid(), lane = tid & 63, w = tid >> 6, r = lane & 31, hh = lane >> 5, qi = 8 * w + (r >> 2), h = r & 3, t = 64 * c + qi, qrow = 32 * w + r, srow = tid >> 3, sch = (tid & 7) * 8, ahead = lane >> 4, ach = lane & 15; const unsigned tok = (unsigned)b * SEQ + t, goff = tok * 48 + g * 4 + h; (void)qi; (void)h; (void)t; (void)qrow; (void)srow; (void)sch; (void)ahead; (void)ach; (void)tok; (void)goff; (void)hh; (void)w; (void)r
  const bf16_t* qb = (const bf16_t*)(P.ws + WS_B); const bf16_t* kvk = (const bf16_t*)(P.ws + WS_C); const bf16_t* vT = (const bf16_t*)(P.ws + WS_DV);
  const bf16_t* kcb = (const bf16_t*)(P.ws + WS_KC); const bf16_t* vcb = (const bf16_t*)(P.ws + WS_VC);
  const float* gbase = (const float*)(P.ws + WS_GATES);
#define gates(i) gbase[goff + (i)]
  bf16_t* attn = (bf16_t*)(P.ws + WS_A);
  float* otb = (float*)(P.ws + WS_OT) + (size_t)obid() * 16384;
#define otg(i) otb[(unsigned)tid + (i) * 512u]
  float* IMP = (float*)(lds + AT_IMP); float* EE = (float*)(lds + AT_EE); unsigned* SEL = (unsigned*)(lds + AT_SEL);
  AttnState S; f32x16 p0, p1; u32x4 rkA, rvA;
  { AT_IDS;
  { const int row = tid >> 1, half = tid & 1, q_i = row >> 2, hd = row & 3;
    const unsigned so = ((unsigned)b * SEQ + 64 * c + q_i) * DM + (g * 4 + hd) * 64 + half * 32;
#pragma unroll
    for (int k = 0; k < 4; ++k) { const u32x4 v = *(const u32x4*)(qb + so + k * 8); *(u32x4*)(lds + AT_QS + row * 128 + (((half * 4 + k) ^ (row & 7)) * 16)) = v; } }
  __syncthreads();
#define ST_LOAD(rk, rv, kp, kstride, vp, vstride, kt) do { rk = *(const u32x4*)((kp) + (unsigned)(((kt) * 64 + srow) * (kstride) + sch)); rv = *(const u32x4*)((vp) + (unsigned)(srow * (vstride) + (kt) * 64 + sch)); } while (0)
#define ST_STORE(rk, rv, buf) do { *(u32x4*)(lds + AT_KS + (buf) * 64 * AT_ROWB + srow * AT_ROWB + sch * 2) = rk; *(u32x4*)(lds + AT_VS + (buf) * 64 * AT_ROWB + srow * AT_ROWB + sch * 2) = rv; } while (0)
#define SWEEP(kp, kstride, vp, vstride, kt0, n, ...) do { \
    ST_LOAD(rkA, rvA, kp, kstride, vp, vstride, (kt0)); ST_STORE(rkA, rvA, 0); __syncthreads(); \
    for (int i_ = 0; i_ < (n); ++i_) { \
      if (i_ + 1 < (n)) ST_LOAD(rkA, rvA, kp, kstride, vp, vstride, (kt0) + i_ + 1); \
      { const int step_ = i_; const int buf_ = i_ & 1; __VA_ARGS__ } \
      if (i_ + 1 < (n)) ST_STORE(rkA, rvA, (i_ + 1) & 1); \
      __syncthreads(); \
    } } while (0)
#define ST_LOADF(rk, rv, kt) do { rk = *(const u32x4*)(kps + (size_t)(kt) * 4096 + tid * 8); rv = *(const u32x4*)(vps + (size_t)(kt) * 4096 + tid * 8); } while (0)
#define ST_STOREF(rk, rv, buf) do { const int fo_ = ((tid >> 8) * 32 + (tid & 31)) * AT_ROWB + (((tid >> 6) & 3) * 2 + ((tid >> 5) & 1)) * 16; \
    *(u32x4*)(lds + AT_KS + (buf) * 64 * AT_ROWB + fo_) = rk; *(u32x4*)(lds + AT_VS + (buf) * 64 * AT_ROWB + fo_) = rv; } while (0)
#define SWEEPF(kt0, n, ...) do { \
    ST_LOADF(rkA, rvA, (kt0)); ST_STOREF(rkA, rvA, 0); __syncthreads(); \
    for (int i_ = 0; i_ < (n); ++i_) { \
      if (i_ + 1 < (n)) ST_LOADF(rkA, rvA, (kt0) + i_ + 1); \
      { const int step_ = i_; const int buf_ = i_ & 1; __VA_ARGS__ } \
      if (i_ + 1 < (n)) ST_STOREF(rkA, rvA, (i_ + 1) & 1); \
      __syncthreads(); \
    } } while (0)
  {
    const bf16_t* kp = kvk + (size_t)b * SEQ * DM + 3 * 256 + g * 64; const bf16_t* vp = vT + (size_t)(((1 * NB + b) * 4 + g) * 64) * SEQ;
    const int j0 = c >= 8 ? c - 8 : 0, nj = c - j0 + 1;
    st_init(S);
    SWEEP(kp, DM, vp, SEQ, j0, nj, {
      at_qk(lds, buf_, r, hh, qrow, p0, p1);
      at_online<1>(S, p0, p1, (j0 + step_) * 64, t - 511, t, true, hh);
      at_pv(lds, buf_, r, hh, p0, p1, S.o0, S.o1); });
    const float lt = S.l + __shfl_xor(S.l, 32); const float sc = lt > 0.f ? gates(32) / lt : 0.f;
#pragma unroll
    for (int i = 0; i < 16; ++i) { otg(i) = S.o0[i] * sc; otg(16 + i) = S.o1[i] * sc; }
  }
  {
    const bf16_t* kcp = kcb + (size_t)((b * 4 + g) * 512) * 64; const bf16_t* vcp = vcb + (size_t)((b * 4 + g) * 64) * 512;
    const int nmax = t >= 31 ? (t - 31) >> 4 : -1;
    const int nct = (4 * c + 2) / 64 + 1;
    st_init(S);
    SWEEP(kcp, 64, vcp, 512, 0, nct, {
      at_qk(lds, buf_, r, hh, qrow, p0, p1);
      at_online<1>(S, p0, p1, step_ * 64, 0, nmax, true, hh); });
    const float lt = S.l + __shfl_xor(S.l, 32);
    const float cinv = lt > 0.f ? 1.f / lt : 0.f; const float cm = S.m;
    st_init(S);
    SWEEP(kcp, 64, vcp, 512, 0, nct, {
      at_qk(lds, buf_, r, hh, qrow, p0, p1);
      const int nrel = nmax - step_ * 64 - 4 * hh;
      _Pragma("unroll") for (int k = 0; k < 16; ++k) { const int c0 = (k & 3) + 8 * (k >> 2), c1 = c0 + 32;
        p0[k] = c0 <= nrel ? __builtin_amdgcn_exp2f(p0[k] - cm) * cinv : 0.f; p1[k] = c1 <= nrel ? __builtin_amdgcn_exp2f(p1[k] - cm) * cinv : 0.f; }
      at_pv(lds, buf_, r, hh, p0, p1, S.o0, S.o1);
      _Pragma("unroll") for (int kh = 0; kh < 2; ++kh)
      _Pragma("unroll") for (int gi = 0; gi < 4; ++gi) {
          float g4 = kh == 0 ? (p0[4 * gi] + p0[4 * gi + 1]) + (p0[4 * gi + 2] + p0[4 * gi + 3]) : (p1[4 * gi] + p1[4 * gi + 1]) + (p1[4 * gi + 2] + p1[4 * gi + 3]);
          float e3 = kh == 0 ? p0[4 * gi + 3] : p1[4 * gi + 3];
          g4 += __shfl_xor(g4, 1); g4 += __shfl_xor(g4, 2); e3 += __shfl_xor(e3, 1); e3 += __shfl_xor(e3, 2);
          if (h == 0) { const int s = (step_ * 64 + kh * 32 + 8 * gi + 4 * hh) >> 2; IMP[qi * AT_IMPS + s] = g4; EE[qi * AT_IMPS + s] = e3; }
      } });
    const float gc = gates(0);
#pragma unroll
    for (int i = 0; i < 16; ++i) { otg(i) += S.o0[i] * gc; otg(16 + i) += S.o1[i] * gc; }
  }
  }
  const bf16_t* kps = (const bf16_t*)(P.ws + WS_KSF) + (size_t)((b * 4 + g) * 128) * 4096; const bf16_t* vps = vT + (size_t)((b * 4 + g) * 128) * 4096;
  if (c <= 15) { AT_IDS;
    st_init(S);
    if (c > 0) {
      SWEEPF(0, c, {
        at_qk(lds, buf_, r, hh, qrow, p0, p1);
        at_online<0>(S, p0, p1, 0, 0, 0, true, hh);
        at_pv(lds, buf_, r, hh, p0, p1, S.o0, S.o1); });
    }
    SWEEPF(c, 1, {
      at_qk(lds, buf_, r, hh, qrow, p0, p1);
      at_online<1>(S, p0, p1, (c + step_) * 64, 0, t, true, hh);
      at_pv(lds, buf_, r, hh, p0, p1, S.o0, S.o1); });
    const float lt = S.l + __shfl_xor(S.l, 32); const float slc_sc = lt > 0.f ? gates(16) / lt : 0.f;
    bf16_t* op = attn + (tok * DM + (g * 4 + h) * 64);
#pragma unroll
    for (int i = 0; i < 16; ++i) { S.o0[i] = S.o0[i] * slc_sc + otg(i); S.o1[i] = S.o1[i] * slc_sc + otg(16 + i); }
#pragma unroll
    for (int gi = 0; gi < 4; ++gi) {
      u32x2 a; a.x = pk2(S.o0[4 * gi], S.o0[4 * gi + 1]); a.y = pk2(S.o0[4 * gi + 2], S.o0[4 * gi + 3]);
      u32x2 bq; bq.x = pk2(S.o1[4 * gi], S.o1[4 * gi + 1]); bq.y = pk2(S.o1[4 * gi + 2], S.o1[4 * gi + 3]);
      *(u32x2*)(op + 8 * gi + 4 * hh) = a; *(u32x2*)(op + 32 + 8 * gi + 4 * hh) = bq;
    }
  } else {
    const int nc = c - 2;
    unsigned char* QL = lds + AT_QL; int* NJ = (int*)(lds + AT_NJ); unsigned short* ITEMS = (unsigned short*)(lds + AT_ITEMS); int* MISC = (int*)(lds + AT_MISC);
    float* MREF = (float*)(lds + AT_MREF); float* LS = (float*)(lds + AT_LACC); unsigned char* INVQ = lds + AT_INVQ; unsigned char* SLOT = lds + AT_IMP;
    float* const LOWN = (float*)(lds + AT_LOWN); const float k64 = 5.421010862427522e-20f;
    { AT_IDS;
    for (int idx = tid; idx < 64 * nc; idx += NTHR) { const int q = idx / nc, s = 1 + idx % nc; IMP[q * AT_IMPS + s] += EE[q * AT_IMPS + s - 1]; }
    if (tid < 256) SEL[tid] = 0u;
    if (tid < 128) ((unsigned*)INVQ)[tid] = 0u;
    __syncthreads();
    {
      const int q = tid >> 3, sub = tid & 7; const float* ip = IMP + q * AT_IMPS;
      unsigned key[16];
#pragma unroll
      for (int k = 0; k < 16; ++k) { const int s = 1 + sub + 8 * k; key[k] = s <= nc ? __float_as_uint(ip[s]) + 1u : 0u; }
      unsigned T = 0u;
      for (int bit = 30; bit >= 0; --bit) {
        const unsigned cand = T | (1u << bit); int cn = 0;
#pragma unroll
        for (int k = 0; k < 16; ++k) cn += key[k] >= cand ? 1 : 0;
        cn += __shfl_xor(cn, 1); cn += __shfl_xor(cn, 2); cn += __shfl_xor(cn, 4);
        if (cn >= 13) T = cand;
      }
      int ngt = 0, neq = 0;
#pragma unroll
      for (int k = 0; k < 16; ++k) { ngt += key[k] > T ? 1 : 0; neq += key[k] == T ? 1 : 0; }
      ngt += __shfl_xor(ngt, 1); ngt += __shfl_xor(ngt, 2); ngt += __shfl_xor(ngt, 4);
      neq += __shfl_xor(neq, 1); neq += __shfl_xor(neq, 2); neq += __shfl_xor(neq, 4);
      const int need = 13 - ngt;
      unsigned w0 = 0u, w1 = 0u, w2 = 0u, w3 = 0u;
      if (!__any(neq > need)) {
#pragma unroll
        for (int k = 0; k < 16; ++k) if (key[k] >= T && key[k] != 0u) { const int s = 1 + sub + 8 * k; const unsigned bt = 1u << (s & 31); if (s < 32) w0 |= bt; else if (s < 64) w1 |= bt; else if (s < 96) w2 |= bt; else w3 |= bt; }
      } else {
        int taken = 0; const int gsh = lane & ~7;
#pragma unroll
        for (int k = 0; k < 16; ++k) {
          const bool eq = key[k] == T && key[k] != 0u; const unsigned long long mk = __ballot(eq);
          const unsigned grp = (unsigned)(mk >> gsh) & 0xffu; const int before = __popc(grp & ((1u << sub) - 1u));
          const bool pick = key[k] > T || (eq && taken + before < need);
          taken += __popc(grp);
          if (pick) { const int s = 1 + sub + 8 * k; const unsigned bt = 1u << (s & 31); if (s < 32) w0 |= bt; else if (s < 64) w1 |= bt; else if (s < 96) w2 |= bt; else w3 |= bt; }
        }
      }
      if (w0) atomicOr(&SEL[q * 4], w0); if (w1) atomicOr(&SEL[q * 4 + 1], w1); if (w2) atomicOr(&SEL[q * 4 + 2], w2); if (w3) atomicOr(&SEL[q * 4 + 3], w3);
    }
    __syncthreads();
    for (int j = 1 + w; j <= nc; j += NWAVE) {
      const bool bit = (SEL[lane * 4 + (j >> 5)] >> (j & 31)) & 1u;
      const unsigned long long mk = __ballot(bit);
      const int rank = __builtin_amdgcn_mbcnt_hi((unsigned)(mk >> 32), __builtin_amdgcn_mbcnt_lo((unsigned)mk, 0u));
      if (bit) QL[j * 64 + rank] = (unsigned char)lane;
      if (lane == 0) NJ[j] = __popcll(mk);
    }
    __syncthreads();
    if (w == 0) {
      const int ja = 1 + lane, jb = 65 + lane;
      const int ca = ja <= nc ? (NJ[ja] + 7) >> 3 : 0, cb = jb <= nc ? (NJ[jb] + 7) >> 3 : 0;
      int sa = ca, sb = cb;
#pragma unroll
      for (int o = 1; o < 64; o <<= 1) { const int ta = __shfl_up(sa, o), tb = __shfl_up(sb, o); if (lane >= o) { sa += ta; sb += tb; } }
      const int tota = __shfl(sa, 63);
      for (int k = 0; k < ca; ++k) ITEMS[sa - ca + k] = (unsigned short)(ja * 8 + k);
      for (int k = 0; k < cb; ++k) ITEMS[tota + sb - cb + k] = (unsigned short)(jb * 8 + k);
      if (lane == 63) MISC[0] = tota + sb;
    }
    }
    { AT_IDS;
    st_init(S);
    SWEEPF(0, 1, {
      at_qk(lds, buf_, r, hh, qrow, p0, p1);
      at_online<0>(S, p0, p1, 0, 0, 0, true, hh);
      at_pv(lds, buf_, r, hh, p0, p1, S.o0, S.o1); });
    SWEEPF(c - 1, 2, {
      at_qk(lds, buf_, r, hh, qrow, p0, p1);
      if (step_ == 1) at_online<1>(S, p0, p1, c * 64, 0, t, true, hh); else at_online<0>(S, p0, p1, 0, 0, 0, true, hh);
      at_pv(lds, buf_, r, hh, p0, p1, S.o0, S.o1); });
    { const float lt = S.l + __shfl_xor(S.l, 32);
      if (hh == 0) { MREF[qrow] = S.m + 64.f; LS[w * 32 + r] = lt * k64; } }
#define SLOT_WRITE(x, o0_, o1_, scale_) do { unsigned char* sp_ = SLOT + (x) * 8192 + r * 256; \
      _Pragma("unroll") for (int gi_ = 0; gi_ < 4; ++gi_) { \
        const f32x4 va_ = {o0_[4 * gi_] * (scale_), o0_[4 * gi_ + 1] * (scale_), o0_[4 * gi_ + 2] * (scale_), o0_[4 * gi_ + 3] * (scale_)}; \
        const f32x4 vb_ = {o1_[4 * gi_] * (scale_), o1_[4 * gi_ + 1] * (scale_), o1_[4 * gi_ + 2] * (scale_), o1_[4 * gi_ + 3] * (scale_)}; \
        *(f32x4*)(sp_ + (((2 * gi_ + hh) ^ (r & 15)) * 16)) = va_; *(f32x4*)(sp_ + (((8 + 2 * gi_ + hh) ^ (r & 15)) * 16)) = vb_; } } while (0)
#define SLOT_READ(x, col_) (*(const f32x4*)(SLOT + (x) * 8192 + (col_) * 256 + ((ach ^ ((col_) & 15)) * 16)))
    SLOT_WRITE(w, S.o0, S.o1, k64);
    __syncthreads();
    }
    {
      AT_IDS; const int wu = __builtin_amdgcn_readfirstlane(w);
      const int nitems = MISC[0], nrounds = (nitems + 3) >> 2;
      if (wu >= 4) {
        const int ow = wu - 4, oq = lane >> 2, oh = lane & 3, srcslot = 2 * ow + (lane >> 5), scol = lane & 31;
        f32x4 acc[16]; float accl;
        { const unsigned char* rp = SLOT + srcslot * 8192 + scol * 256;
#pragma unroll
          for (int k = 0; k < 16; ++k) acc[k] = *(const f32x4*)(rp + ((k ^ (scol & 15)) * 16));
          accl = LS[srcslot * 32 + scol]; }
        __syncthreads();
        for (int rd = 0; rd <= nrounds; ++rd) {
          if (rd > 0) {
            const int set = (rd - 1) & 1;
            unsigned* ivp = (unsigned*)(INVQ + set * 256) + 16 * ow + oq;
            unsigned iv = *ivp;
            if (__any(iv != 0u)) {
              if (iv != 0u && oh == 0) *ivp = 0u;
              do {
                const int x = (iv & 0xffu) ? 0 : (iv & 0xff00u) ? 1 : (iv & 0xff0000u) ? 2 : 3;
                const unsigned byte = (iv >> (8 * x)) & 0xffu;
                iv &= ~(0xffu << (8 * x));
                if (byte) {
                  const int col = (int)(byte - 1) * 4 + oh;
                  const unsigned char* rp = SLOT + (set * 4 + x) * 8192 + col * 256;
#pragma unroll
                  for (int k = 0; k < 16; ++k) acc[k] += *(const f32x4*)(rp + ((k ^ (col & 15)) * 16));
                  accl += LS[(set * 4 + x) * 32 + col];
                }
              } while (__any(iv != 0u));
            }
          }
          __syncthreads();
        }
#pragma unroll
        for (int i = 0; i < 16; ++i) { S.o0[i] = otg(i); S.o1[i] = otg(16 + i); }
        SLOT_WRITE(w, S.o0, S.o1, 1.0f);
        __syncthreads();
        {
          const unsigned tq = (unsigned)b * SEQ + 64 * c + 16 * ow + oq;
          const float gs = gbase[tq * 48 + 16 + g * 4 + oh]; const float sc = accl > 0.f ? gs / accl : 0.f;
          const unsigned char* rp = SLOT + srcslot * 8192 + scol * 256;
          bf16_t* op = attn + (tq * DM + (g * 4 + oh) * 64);
#pragma unroll
          for (int k2 = 0; k2 < 8; ++k2) {
            const f32x4 v0 = acc[2 * k2] * sc + *(const f32x4*)(rp + (((2 * k2) ^ (scol & 15)) * 16)), v1 = acc[2 * k2 + 1] * sc + *(const f32x4*)(rp + (((2 * k2 + 1) ^ (scol & 15)) * 16));
            u32x4 o; o.x = pk2(v0.x, v0.y); o.y = pk2(v0.z, v0.w); o.z = pk2(v1.x, v1.y); o.w = pk2(v1.z, v1.w);
            *(u32x4*)(op + 8 * k2) = o;
          }
        }
      } else {
        __syncthreads();
        const bf16_t* kgl = kps + lane * 8; const bf16_t* vgl = vps + lane * 8;
        bf16x8 kf[8], vf[8];
#define KLOAD(jj) do { _Pragma("unroll") for (int f_ = 0; f_ < 8; ++f_) kf[f_] = *(const bf16x8*)(kgl + (size_t)(jj) * 4096 + f_ * 512); } while (0)
#define VLOAD(jj) do { _Pragma("unroll") for (int f_ = 0; f_ < 8; ++f_) vf[f_] = *(const bf16x8*)(vgl + (size_t)(jj) * 4096 + f_ * 512); } while (0)
        int jc = 0, rowc = 0, qqc = 0; bool validc = false; float mrc = 1e30f;
#define ITEM_META(e_, j_, valid_, qq_, row_, mr_) do { j_ = (e_) >> 3; const int k_ = (e_) & 7; const int qs_ = 8 * k_ + (r >> 2); valid_ = qs_ < NJ[j_]; \
          qq_ = QL[j_ * 64 + (valid_ ? qs_ : 8 * k_)]; row_ = qq_ * 4 + h; mr_ = valid_ ? MREF[row_] : 1e30f; } while (0)
        if (wu < nitems) { const int e0 = ITEMS[wu]; ITEM_META(e0, jc, validc, qqc, rowc, mrc); KLOAD(jc); VLOAD(jc); }
        for (int rd = 0; rd < nrounds; ++rd) {
          const int it = rd * 4 + wu, set = rd & 1;
          if (it < nitems) {
            const bool hasn = it + 4 < nitems;
            const int en = hasn ? ITEMS[it + 4] : 0;
            const f32x16 z = {0.f, 0.f, 0.f, 0.f, 0.f, 0.f, 0.f, 0.f, 0.f, 0.f, 0.f, 0.f, 0.f, 0.f, 0.f, 0.f};
#pragma unroll
            for (int ds = 0; ds < 4; ++ds) {
              const bf16x8 qv = *(const bf16x8*)(lds + AT_QS + rowc * 128 + (((ds * 2 + hh) ^ (rowc & 7)) * 16));
              if (ds == 0) { p0 = MFMA32(kf[0], qv, z); p1 = MFMA32(kf[4], qv, z); } else { p0 = MFMA32(kf[ds], qv, p0); p1 = MFMA32(kf[4 + ds], qv, p1); }
            }
            int jn = 0, rown = 0, qqn = 0; bool validn = false; float mrn = 1e30f;
            if (hasn) { ITEM_META(en, jn, validn, qqn, rown, mrn); KLOAD(jn); }
            float rs = 0.f;
#pragma unroll
            for (int i = 0; i < 16; ++i) {
              p0[i] = __builtin_amdgcn_exp2f(fminf(p0[i] - mrc, 120.f)); p1[i] = __builtin_amdgcn_exp2f(fminf(p1[i] - mrc, 120.f)); rs += p0[i] + p1[i];
            }
            rs += __shfl_xor(rs, 32);
            f32x16 o0 = z, o1 = z;
#pragma unroll
            for (int gk = 0; gk < 4; ++gk) { const bf16x8 pb = (gk < 2) ? pack8(p0, gk & 1) : pack8(p1, gk & 1); o0 = MFMA32(vf[gk], pb, o0); o1 = MFMA32(vf[4 + gk], pb, o1); }
            if (hasn) VLOAD(jn);
            SLOT_WRITE(set * 4 + wu, o0, o1, 1.0f);
            if (hh == 0) LS[(set * 4 + wu) * 32 + r] = rs;
            if (validc && h == 0 && hh == 0) INVQ[set * 256 + qqc * 4 + wu] = (unsigned char)((r >> 2) + 1);
            jc = jn; rowc = rown; qqc = qqn; validc = validn; mrc = mrn;
          }
          __syncthreads();
        }
#undef ITEM_META
#undef KLOAD
#undef VLOAD
        __syncthreads();
#pragma unroll
        for (int i = 0; i < 16; ++i) { S.o0[i] = otg(i); S.o1[i] = otg(16 + i); }
        SLOT_WRITE(w, S.o0, S.o1, 1.0f);
        __syncthreads();
      }
    }
#undef SLOT_WRITE
#undef SLOT_READ
  }
  __syncthreads();
#undef ST_LOAD
#undef ST_STORE
#undef SWEEP
#undef ST_LOADF
#undef ST_STOREF
#undef SWEEPF
#undef gates
#undef otg
#undef AT_IDS
}
DI void phase_attn(const Params& P_, unsigned char* lds) {
  Params P = P_; { size_t z_ = 0; asm volatile("" : "+s"(z_)); P.ws = P_.ws + z_; }
  const int G = gridDim.x, bx = obid();
  const int vcu = (G % 8 == 0) ? (bx % 8) * (G / 8) + bx / 8 : bx;
  for (int idx = vcu; idx < 1024; idx += G) {
    const int i = idx >> 8, v = idx & 255, bg = v >> 5, s = v & 31;
    const int c = i == 0 ? s : i == 1 ? 63 - s : i == 2 ? 64 + s : 127 - s;
    attn_tile(P, lds, bg >> 2, bg & 3, c);
  }
}


#define LAS __attribute__((address_space(3)))
#define XB_TMO      128
#define XB_XCNT(j)  (256  + 64 * (j))
#define XB_XSUB(j)  (1280 + 64 * (j))
#define XB_XGEN(j)  (2304 + 64 * (j))
#define XB_TOP      3328
#define XB_TOPGEN   3392
#define XCD_BAR_WORDS 3456
#define XB_SPIN_CAP (1u << 18)
__device__ __forceinline__ unsigned xb_ld(unsigned* p)              { return __hip_atomic_load(p, __ATOMIC_RELAXED, __HIP_MEMORY_SCOPE_AGENT); }
__device__ __forceinline__ unsigned xb_add(unsigned* p, unsigned v) { return __hip_atomic_fetch_add(p, v, __ATOMIC_RELAXED, __HIP_MEMORY_SCOPE_AGENT); }
__device__ __forceinline__ unsigned xb_xcc_id() { return (unsigned)__builtin_amdgcn_s_getreg((3 << 11) | 20) & 0xFu; }
#define XB_SPIN(cond, bar) do { unsigned _sp = 0; while (cond) { __builtin_amdgcn_s_sleep(1); \
    if ((++_sp & 255u) == 0u) { if (xb_ld(&(bar)[XB_TMO])) break; if (_sp > XB_SPIN_CAP) { atomicAdd(&(bar)[XB_TMO], 1u); break; } } } } while (0)
struct XcdBarrier { unsigned* bar; unsigned x; volatile LAS unsigned* st; };
__device__ __forceinline__ XcdBarrier xcd_barrier_post(unsigned* bar, volatile LAS unsigned* st) {
    XcdBarrier b; b.bar = bar; b.x = xb_xcc_id(); b.st = st;
    if (threadIdx.x == 0) (void)xb_add(&bar[XB_XCNT(b.x)], 1u);
    return b;
}
__device__ __forceinline__ void xcd_barrier_complete(unsigned* bar, unsigned x, unsigned& nloc, unsigned& nx) {
    const unsigned G = gridDim.x * gridDim.y * gridDim.z;
    unsigned sum, cnt, mine, sp = 0u;
    for (;;) {
        sum = 0u; cnt = 0u; mine = 0u;
#pragma unroll
        for (unsigned j = 0; j < 16; ++j) { const unsigned c = xb_ld(&bar[XB_XCNT(j)]); sum += c; cnt += (c > 0u) ? 1u : 0u; mine = (j == x) ? c : mine; }
        if (sum == G) break;
        __builtin_amdgcn_s_sleep(1);
        if ((++sp & 255u) == 0u) { if (xb_ld(&bar[XB_TMO])) break; if (sp > XB_SPIN_CAP) { atomicAdd(&bar[XB_TMO], 1u); break; } }
    }
    nloc = mine > 0u ? mine : 1u; nx = cnt > 0u ? cnt : 1u;
}
__device__ __forceinline__ void xcd_barrier(const XcdBarrier& b) {
    asm volatile("s_waitcnt vmcnt(0)" ::: "memory");
    __syncthreads();
    if (threadIdx.x == 0) {
        unsigned* bar = b.bar; { size_t z_ = 0; asm volatile("" : "+s"(z_)); bar += z_; }
        __builtin_amdgcn_s_waitcnt(0);
        unsigned nloc = b.st[0], nx = b.st[1];
        if (nloc == 0u) { xcd_barrier_complete(bar, b.x, nloc, nx); b.st[0] = nloc; b.st[1] = nx; }
        const unsigned old = xb_add(&bar[XB_XSUB(b.x)], 1u);
        const unsigned gen = old / nloc;
        if (old + 1u == (gen + 1u) * nloc) {
            __builtin_amdgcn_fence(__ATOMIC_RELEASE, "agent");
            asm volatile("s_waitcnt vmcnt(0)" ::: "memory");
            const unsigned og = xb_add(&bar[XB_TOP], 1u);
            const unsigned tg = og / nx;
            if (og + 1u == (tg + 1u) * nx) xb_add(&bar[XB_TOPGEN], 1u);
            else XB_SPIN(xb_ld(&bar[XB_TOPGEN]) == tg, bar);
            __builtin_amdgcn_fence(__ATOMIC_ACQUIRE, "agent");
            xb_add(&bar[XB_XGEN(b.x)], 1u);
            asm volatile("s_waitcnt vmcnt(0)" ::: "memory");
        } else {
            XB_SPIN(xb_ld(&bar[XB_XGEN(b.x)]) == gen, bar);
            __builtin_amdgcn_fence(__ATOMIC_ACQUIRE, "agent");
            asm volatile("s_waitcnt vmcnt(0)" ::: "memory");
        }
    }
    __syncthreads();
}

__global__ void __launch_bounds__(NTHR) fwd_kernel(Params P) {
  extern __shared__ __attribute__((aligned(16))) unsigned char lds[];
  cg::grid_group grid = cg::this_grid();
  const int gtid = blockIdx.x * NTHR + threadIdx.x;
  if (threadIdx.x < 4) ((unsigned*)(lds + LDS_BYTES - 16))[threadIdx.x] = 0u;
  __syncthreads();
  const XcdBarrier xbar = xcd_barrier_post((unsigned*)(P.ws + WS_BAR), (volatile LAS unsigned*)(lds + LDS_BYTES - 16));
#define GSYNC() xcd_barrier(xbar)
  s5_params(P, gtid);
  {
    float* modb = (float*)(P.ws + WS_MOD); float* cbb = (float*)(P.ws + WS_CB);
    for (int it = blockIdx.x; it < 192 + 16; it += gridDim.x) {
      if (it < 192) { const int l = it / 96, j0 = (it % 96) * 64;
        gemv_item((float*)lds, P.in[2] + (size_t)l * DM * 6144, DM, 6144, j0, P.in[1], P.in[1] + DM, true, P.in[3] + l * 6144, modb + (size_t)(l * 2) * 6144, modb + (size_t)(l * 2 + 1) * 6144);
      } else { const int r = it - 192, l = r >> 3, kv = (r >> 2) & 1, j0 = (r & 3) * 64;
        gemv_item((float*)lds, P.in[17] + (size_t)(l * 2 + kv) * 2048 * 256, 2048, 256, j0, P.in[16] + (size_t)(l * 2 + kv) * 2048, nullptr, false, nullptr, cbb + (l * 2 + kv) * 256, nullptr);
      }
    }
  }
  for (int it = blockIdx.x; it < DEPTH * 32 * 6; it += gridDim.x) s5_tables(P, it / 192, (it % 192) / 6, it % 6, lds);
  convert_weights(P, 0, lds);
  grid.sync();
  for (int l = 0; l < DEPTH; ++l) {
    if (l == 0) norm_simple<0>(P, l); else { norm_simple<1>(P, l); convert_weights(P, 1, lds); }
    GSYNC();
#if EN_MIXER
    phase_inproj8(P, lds);
    GSYNC();
    phase_s5a(P, l, lds);
    __syncthreads();
#if EN_ATTN
    phase_gates(P, lds);
    __syncthreads();
    phase_cmp1(P, l, lds);
#endif
    GSYNC();
    s5_carry(P, l);
#if EN_ATTN
    phase_cmp2(P, lds);
#endif
    GSYNC();
#if EN_ATTN
    phase_attn(P, lds);
    __syncthreads();
#endif
    phase_s5c(P, l, lds);
    GSYNC();
    phase_glu(P, lds);
    GSYNC();
    phase_merge8(P, lds);
    GSYNC();
    phase_wout8(P, l, lds);
    GSYNC();
#else
    if (l == 0) { for (size_t i = (size_t)gtid * 4; i < (size_t)NT * DM; i += (size_t)gridDim.x * NTHR * 4) *(f32x4*)(P.out + i) = *(const f32x4*)(P.in[0] + i); GSYNC(); }
#endif
#if EN_MOE
    norm_route(P, l, lds);
    GSYNC();
    phase_moe1(P, l, lds);
    GSYNC();
    phase_moe2(P, l, lds);
    GSYNC();
#endif
  }
  norm_simple<3>(P, 0);
}

extern "C" void kernel_launch(void* const* d_in, const int* in_sizes, int n_in, void* d_out, int out_size, void* d_ws, size_t ws_size, hipStream_t stream) {
  static int grid = 0;
  if (grid == 0) {
    if (n_in != 30 || out_size != NT * DM || ws_size < WS_END2) { fprintf(stderr, "kernel_launch: unexpected shapes (n_in %d out %d ws %zu need %zu)\n", n_in, out_size, ws_size, (size_t)WS_END2); grid = -1; return; }
    int dev = 0, cus = 0, per_cu = 0;
    hipGetDevice(&dev);
    hipDeviceGetAttribute(&cus, hipDeviceAttributeMultiprocessorCount, dev);
    hipFuncSetAttribute((const void*)fwd_kernel, hipFuncAttributeMaxDynamicSharedMemorySize, LDS_BYTES);
    hipOccupancyMaxActiveBlocksPerMultiprocessor(&per_cu, (const void*)fwd_kernel, NTHR, LDS_BYTES);
    if (per_cu < 1) { fprintf(stderr, "kernel_launch: occupancy query says %d blocks/CU\n", per_cu); per_cu = 1; }
    grid = cus;
    (void)hipGetLastError();
  }
  if (grid < 0) return;
  Params p{};
  for (int i = 0; i < 30; ++i) p.in[i] = (const float*)d_in[i];
  p.out = (float*)d_out; p.ws = (unsigned char*)d_ws;
  if (hipMemsetAsync(p.ws, 0, WS_ZERO_BYTES, stream) != hipSuccess) { fprintf(stderr, "kernel_launch: memset failed\n"); return; }
  void* args[] = {&p};
  hipError_t e = hipLaunchCooperativeKernel((const void*)fwd_kernel, dim3(grid), dim3(NTHR), args, LDS_BYTES, stream);
  if (e != hipSuccess) fprintf(stderr, "cooperative launch failed: %s (grid %d)\n", hipGetErrorString(e), grid);
}
```

```cpp
#include <hip/hip_runtime.h>
#include <hip/hip_cooperative_groups.h>
#include <cstdio>
#include <cstdint>
namespace cg = cooperative_groups;

#ifndef EN_MIXER
#define EN_MIXER 1
#endif
#ifndef EN_ATTN
#define EN_ATTN 1
#endif
#ifndef EN_MOE
#define EN_MOE 1
#endif

#define DI __device__ __forceinline__
typedef unsigned short bf16_t;
typedef short bf16x8 __attribute__((ext_vector_type(8)));
typedef short s16x4 __attribute__((ext_vector_type(4)));
typedef float f32x4 __attribute__((ext_vector_type(4)));
typedef float f32x16 __attribute__((ext_vector_type(16)));
typedef unsigned u32x4 __attribute__((ext_vector_type(4)));
typedef unsigned u32x2 __attribute__((ext_vector_type(2)));

constexpr int DM = 1024, NB = 2, SEQ = 8192, NT = NB * SEQ, DEPTH = 2;
constexpr int INW = 5168, INWP = 5376;
constexpr int NTHR = 512, NWAVE = 8;
constexpr int NEXP = 32, LISTCAP = 16384;
constexpr float EPS = 1e-6f;
constexpr float QSCALE = 0.125f * 1.4426950408889634f;

constexpr size_t MiB = 1u << 20;
constexpr size_t WS_CNT = 0;
constexpr size_t WS_BAR = 1024;
constexpr size_t WS_ZERO_BYTES = 16384;
constexpr size_t WS_MOD = 16384;
constexpr size_t WS_CB = WS_MOD + 2 * 2 * 6144 * 4;
constexpr size_t WS_S5P = WS_CB + 2 * 2 * 256 * 4;
constexpr size_t WS_WT = WS_S5P + 2 * 32 * 64 * 36 * 4;
constexpr size_t WS_SMALL_END = WS_WT + (size_t)NT * 2 * 4;
static_assert(WS_SMALL_END <= 1 * MiB, "small region");
constexpr size_t WS_W = 1 * MiB;
constexpr size_t W_IN = 0;
constexpr size_t W_GLU = W_IN + (size_t)INWP * 1024 * 2;
constexpr size_t W_O = W_GLU + 512 * 512 * 2;
constexpr size_t W_SO = W_O + 1024 * 1024 * 2;
constexpr size_t W_OUT = W_SO + 1024 * 512 * 2;
constexpr size_t W_C1 = W_OUT + 1024 * 1024 * 2;
constexpr size_t W_C2 = W_C1 + 2 * 256 * 2048 * 2;
constexpr size_t W_GU = W_C2 + 2 * 128 * 256 * 2;
constexpr size_t W_D = W_GU + (size_t)32 * 512 * 1024 * 2;
constexpr size_t W_END = W_D + (size_t)32 * 1024 * 256 * 2;
static_assert(W_END <= 67 * MiB, "weights region");
constexpr size_t WS_A = 68 * MiB;
constexpr size_t WS_B = WS_A + 32 * MiB;
constexpr size_t WS_C = WS_B + 32 * MiB;
constexpr size_t WS_DV = WS_C + 32 * MiB;
constexpr size_t WS_E = WS_DV + 16 * MiB;
constexpr size_t WS_F = WS_E + 32 * MiB;
constexpr size_t WS_G = WS_F + 64 * MiB;
constexpr size_t WS_GATES = WS_G + 16 * MiB;
constexpr size_t WS_HID = WS_GATES + 3 * MiB;
constexpr size_t WS_KC = WS_HID + 4 * MiB;
constexpr size_t WS_VC = WS_KC + 512 * 1024;
constexpr size_t WS_L = WS_VC + 512 * 1024;
constexpr size_t WS_LIST = WS_L + 4 * MiB;
constexpr size_t WS_OT = WS_LIST + 2 * MiB;
constexpr size_t WS_TAB = WS_OT + 16 * MiB;
constexpr size_t TAB_KT = 0, TAB_M1 = 1 * MiB, TAB_M2 = 9 * MiB, TAB_LAYER = 17 * MiB;
constexpr size_t WS_END = WS_TAB + 2 * TAB_LAYER;
constexpr size_t WS_KSF = WS_END;
constexpr size_t WS_END2 = WS_KSF + 8 * MiB;
constexpr size_t WS_SIN = WS_E + 16 * MiB;
constexpr int LDS_BYTES = 151552;

struct Params { const float* in[30]; float* out; unsigned char* ws; };

DI int otid() { int t = threadIdx.x; asm volatile("" : "+v"(t)); return t; }
DI int obid() { int t = blockIdx.x; asm volatile("" : "+s"(t)); return t; }
DI unsigned f2bf(float f) { unsigned u = __float_as_uint(f); return (u + 0x7fffu + ((u >> 16) & 1u)) >> 16; }
typedef float f32x2_t __attribute__((ext_vector_type(2))); typedef __bf16 bf16x2_t __attribute__((ext_vector_type(2)));
DI unsigned pk2(float lo, float hi) { const f32x2_t v = {lo, hi}; const bf16x2_t b = __builtin_convertvector(v, bf16x2_t); return __builtin_bit_cast(unsigned, b); }
DI float bflo(unsigned w) { return __uint_as_float(w << 16); }
DI float bfhi(unsigned w) { return __uint_as_float(w & 0xffff0000u); }
DI int perm16(int x) { return (x & ~12) | ((x & 4) << 1) | ((x & 8) >> 1); }
DI float wave_sum(float v) {
#pragma unroll
  for (int o = 1; o < 64; o <<= 1) v += __shfl_xor(v, o);
  return v;
}
DI float sigmoidf_(float x) { return 1.f / (1.f + __expf(-x)); }
DI float gelu_tanh(float x) {
  const float z = 0.7978845608028654f * (x + 0.044715f * x * x * x);
  const float e = __expf(2.f * z);
  const float th = 1.f - 2.f / (e + 1.f);
  return 0.5f * x * (1.f + th);
}
DI void sincos_d(double x, double& s, double& c) {
  const double k = rint(x * 0.6366197723675814);
  double r = fma(-k, 1.5707963267948966, x);
  r = fma(-k, 6.123233995736766e-17, r);
  const int q = ((int)k) & 3;
  const double r2 = r * r;
  const double sp = r * (1.0 + r2 * (-1.0 / 6 + r2 * (1.0 / 120 + r2 * (-1.0 / 5040 + r2 * (1.0 / 362880 + r2 * (-1.0 / 39916800 + r2 * (1.0 / 6227020800.0)))))));
  const double cp = 1.0 + r2 * (-0.5 + r2 * (1.0 / 24 + r2 * (-1.0 / 720 + r2 * (1.0 / 40320 + r2 * (-1.0 / 3628800 + r2 * (1.0 / 479001600 + r2 * (-1.0 / 87178291200.0)))))));
  s = (q == 0) ? sp : (q == 1) ? cp : (q == 2) ? -sp : -cp;
  c = (q == 0) ? cp : (q == 1) ? -sp : (q == 2) ? -cp : sp;
}

DI void gemv_item(float* lds, const float* W, int K, int N, int j0, const float* v0, const float* v1, bool do_silu, const float* bias, float* o0, float* o1) {
  const int tid = otid();
  float* sv = lds; float* red = lds + 4096;
  for (int k = tid; k < K; k += NTHR) {
    float a = v0[k], b = v1 ? v1[k] : 0.f;
    if (do_silu) { a = a / (1.f + expf(-a)); b = b / (1.f + expf(-b)); }
    sv[k] = a; sv[2048 + k] = b;
  }
  __syncthreads();
  const int jl = tid & 63, ks = tid >> 6, kper = K >> 3;
  const float* wp = W + (size_t)(ks * kper) * N + j0 + jl;
  float a0 = 0.f, a1 = 0.f;
#pragma unroll 8
  for (int k = 0; k < kper; ++k) { const float w = wp[(size_t)k * N]; a0 += sv[ks * kper + k] * w; a1 += sv[2048 + ks * kper + k] * w; }
  red[(ks * 64 + jl) * 2] = a0; red[(ks * 64 + jl) * 2 + 1] = a1;
  __syncthreads();
  if (tid < 64) {
    float s0 = 0.f, s1 = 0.f;
    for (int i = 0; i < 8; ++i) { s0 += red[(i * 64 + tid) * 2]; s1 += red[(i * 64 + tid) * 2 + 1]; }
    const float bb = bias ? bias[j0 + tid] : 0.f;
    o0[j0 + tid] = s0 + bb; if (o1) o1[j0 + tid] = s1 + bb;
  }
  __syncthreads();
}

DI void s5_params(const Params& P, int gtid) {
  if (gtid >= DEPTH * 32 * 64) return;
  const int l = gtid / 2048, g = (gtid / 64) % 32, p = gtid % 64;
  const float dt = expf(P.in[8][l * 32 + g]);
  const float lr = P.in[6][(l * 32 + g) * 64 + p], li = P.in[7][(l * 32 + g) * 64 + p];
  const float mag = expf(lr * dt); const float ang = li * dt;
  double sd, cd; sincos_d((double)ang, sd, cd);
  const float ab_re = mag * (float)cd, ab_im = mag * (float)sd;
  const float den = lr * lr + li * li, nr = ab_re - 1.0f;
  const float cr = (nr * lr + ab_im * li) / den, ci = (ab_im * lr - nr * li) / den;
  float* o = (float*)(P.ws + WS_S5P) + (size_t)((l * 32 + g) * 64 + p) * 36;
  o[0] = ab_re; o[1] = ab_im;
  double pr = ab_re, pi = ab_im;
  for (int i = 0; i < 6; ++i) { const double nr2 = pr * pr - pi * pi, ni2 = 2.0 * pr * pi; pr = nr2; pi = ni2; }
  o[2] = (float)pr; o[3] = (float)pi;
  const float* br = P.in[9] + (size_t)((l * 32 + g) * 64 + p) * 16; const float* bi = P.in[10] + (size_t)((l * 32 + g) * 64 + p) * 16;
  for (int h = 0; h < 16; ++h) { o[4 + 2 * h] = cr * br[h] - ci * bi[h]; o[5 + 2 * h] = cr * bi[h] + ci * br[h]; }
}

DI void s5_tables(const Params& P, int l, int g, int part, unsigned char* lds) {
  const int tid = otid(), lane = tid & 63;
  float* BBr = (float*)lds; float* BBi = BBr + 1024; float* CR = BBi + 1024; float* CI = CR + 1024;
  float* APr = CI + 1024; float* APi = APr + 65 * 64;
  bf16_t* tab = (bf16_t*)(P.ws + WS_TAB + (size_t)l * TAB_LAYER);
  bf16_t* Kt = tab + TAB_KT / 2 + (size_t)g * 64 * 256; bf16_t* M1 = tab + TAB_M1 / 2 + (size_t)g * 128 * 1024; bf16_t* M2 = tab + TAB_M2 / 2 + (size_t)g * 1024 * 128;
  __syncthreads();
  if (tid < 64) {
    const int p = tid;
    const float dt = expf(P.in[8][l * 32 + g]);
    const float lr = P.in[6][(l * 32 + g) * 64 + p], li = P.in[7][(l * 32 + g) * 64 + p];
    const float mag = expf(lr * dt); const float ang = li * dt;
    double sd, cd; sincos_d((double)ang, sd, cd);
    const float ab_re = mag * (float)cd, ab_im = mag * (float)sd;
    const float den = lr * lr + li * li, nr = ab_re - 1.0f;
    const float cr = (nr * lr + ab_im * li) / den, ci = (ab_im * lr - nr * li) / den;
    const float* br = P.in[9] + (size_t)((l * 32 + g) * 64 + p) * 16; const float* bi = P.in[10] + (size_t)((l * 32 + g) * 64 + p) * 16;
    for (int h = 0; h < 16; ++h) { BBr[p * 16 + h] = cr * br[h] - ci * bi[h]; BBi[p * 16 + h] = cr * bi[h] + ci * br[h]; }
    double pr = 1.0, pi = 0.0;
    for (int tau = 0; tau <= 64; ++tau) { APr[tau * 64 + p] = (float)pr; APi[tau * 64 + p] = (float)pi; const double n1 = pr * ab_re - pi * ab_im, n2 = pr * ab_im + pi * ab_re; pr = n1; pi = n2; }
  }
  for (int i = tid; i < 1024; i += NTHR) { CR[i] = P.in[11][(size_t)(l * 32 + g) * 1024 + i]; CI[i] = P.in[12][(size_t)(l * 32 + g) * 1024 + i]; }
  __syncthreads();
  if (part < 4)
  for (int task = part * 256 + tid; task < part * 256 + 256; task += NTHR) {
    const int tau = task >> 4, h = task & 15;
    float a[16];
#pragma unroll
    for (int j = 0; j < 16; ++j) a[j] = 0.f;
    for (int p = 0; p < 64; ++p) {
      const float c_r = CR[h * 64 + p], c_i = CI[h * 64 + p], a_r = APr[tau * 64 + p], a_i = APi[tau * 64 + p];
      const float xr = c_r * a_r - c_i * a_i, xi = c_r * a_i + c_i * a_r;
#pragma unroll
      for (int j4 = 0; j4 < 4; ++j4) { const f32x4 b_r = *(const f32x4*)(BBr + p * 16 + 4 * j4), b_i = *(const f32x4*)(BBi + p * 16 + 4 * j4);
        a[4 * j4] += xr * b_r.x - xi * b_i.x; a[4 * j4 + 1] += xr * b_r.y - xi * b_i.y; a[4 * j4 + 2] += xr * b_r.z - xi * b_i.z; a[4 * j4 + 3] += xr * b_r.w - xi * b_i.w; }
    }
    u32x4 o0, o1; o0.x = pk2(a[0], a[1]); o0.y = pk2(a[2], a[3]); o0.z = pk2(a[4], a[5]); o0.w = pk2(a[6], a[7]); o1.x = pk2(a[8], a[9]); o1.y = pk2(a[10], a[11]); o1.z = pk2(a[12], a[13]); o1.w = pk2(a[14], a[15]);
    *(u32x4*)(Kt + (size_t)task * 16) = o0; *(u32x4*)(Kt + (size_t)task * 16 + 8) = o1;
  }
  if (part == 4)
  for (int task = tid; task < 4096; task += NTHR) {
    const int p = task >> 6, i = task & 63;
    const float a_r = APr[(63 - i) * 64 + p], a_i = APi[(63 - i) * 64 + p];
    float re[16], im[16];
#pragma unroll
    for (int j = 0; j < 16; ++j) { const float b_r = BBr[p * 16 + j], b_i = BBi[p * 16 + j]; re[j] = a_r * b_r - a_i * b_i; im[j] = a_r * b_i + a_i * b_r; }
    u32x4 o; bf16_t* d0 = M1 + (size_t)(2 * p) * 1024 + i * 16; bf16_t* d1 = d0 + 1024;
    o.x = pk2(re[0], re[1]); o.y = pk2(re[2], re[3]); o.z = pk2(re[4], re[5]); o.w = pk2(re[6], re[7]); *(u32x4*)d0 = o;
    o.x = pk2(re[8], re[9]); o.y = pk2(re[10], re[11]); o.z = pk2(re[12], re[13]); o.w = pk2(re[14], re[15]); *(u32x4*)(d0 + 8) = o;
    o.x = pk2(im[0], im[1]); o.y = pk2(im[2], im[3]); o.z = pk2(im[4], im[5]); o.w = pk2(im[6], im[7]); *(u32x4*)d1 = o;
    o.x = pk2(im[8], im[9]); o.y = pk2(im[10], im[11]); o.z = pk2(im[12], im[13]); o.w = pk2(im[14], im[15]); *(u32x4*)(d1 + 8) = o;
  }
  if (part == 5)
  for (int task = tid; task < 4096; task += NTHR) {
    const int th = task >> 2, pq = task & 3, t = th >> 4, h = th & 15;
    unsigned w[16];
#pragma unroll
    for (int j = 0; j < 16; ++j) { const int p = pq * 16 + j;
      const float c_r = CR[h * 64 + p], c_i = CI[h * 64 + p], a_r = APr[(t + 1) * 64 + p], a_i = APi[(t + 1) * 64 + p];
      w[j] = pk2(c_r * a_r - c_i * a_i, -(c_r * a_i + c_i * a_r)); }
    bf16_t* d = M2 + (size_t)th * 128 + pq * 32;
    *(u32x4*)d = (u32x4){w[0], w[1], w[2], w[3]}; *(u32x4*)(d + 8) = (u32x4){w[4], w[5], w[6], w[7]};
    *(u32x4*)(d + 16) = (u32x4){w[8], w[9], w[10], w[11]}; *(u32x4*)(d + 24) = (u32x4){w[12], w[13], w[14], w[15]};
  }
  __syncthreads();
}

struct ConvJob { const float* src; bf16_t* dst; int ldw, K, c0, ncols, nmat, ldd, drow0, mode; size_t sstride, dstride; };
DI int conv_nitems(const ConvJob& j) { return j.nmat * (j.K >> 6) * ((j.ncols + 31) >> 5); }
DI int conv_drow(int mode, int drow0, int n) { return mode == 0 ? drow0 + n : drow0 + ((n >> 6) * 128 + ((n >> 4) & 3) * 32 + (n & 15)); }
DI void conv_item(const ConvJob& jb, int item, float* scr, int lane) {
  const int nblk = (jb.ncols + 31) >> 5, per = (jb.K >> 6) * nblk;
  const int mat = item / per, r = item % per, kb = r / nblk, nb = r % nblk, k0 = 64 * kb, n0 = 32 * nb;
  const float* W = jb.src + (size_t)mat * jb.sstride; bf16_t* WT = jb.dst + (size_t)mat * jb.dstride;
  const int n4 = (lane & 7) * 4; const bool nok = (n0 + n4) < jb.ncols;
#pragma unroll
  for (int i = 0; i < 8; ++i) { const int kk = 8 * i + (lane >> 3);
    const f32x4 v = nok ? *(const f32x4*)(W + (size_t)(k0 + kk) * jb.ldw + jb.c0 + n0 + n4) : (f32x4){0.f, 0.f, 0.f, 0.f};
    *(f32x4*)(scr + kk * 36 + n4) = v; }
  asm volatile("s_waitcnt lgkmcnt(0)" ::: "memory");
  const int c = lane & 7;
#pragma unroll
  for (int j = 0; j < 4; ++j) {
    const int n = (lane >> 3) + 8 * j; const float* sp = scr + (8 * c) * 36 + n;
    u32x4 o; o.x = pk2(sp[0], sp[36]); o.y = pk2(sp[72], sp[108]); o.z = pk2(sp[144], sp[180]); o.w = pk2(sp[216], sp[252]);
    if (n0 + n < jb.ncols) *(u32x4*)(WT + (size_t)conv_drow(jb.mode, jb.drow0, n0 + n) * jb.ldd + k0 + 8 * c) = o;
  }
  asm volatile("s_waitcnt lgkmcnt(0)" ::: "memory");
}
DI ConvJob conv_job(const Params& P, int l, int j) {
  unsigned char* wb = P.ws + WS_W; ConvJob J; J.nmat = 1; J.mode = 0; J.sstride = 0; J.dstride = 0; J.drow0 = 0; J.c0 = 0;
  const float* win = P.in[5] + (size_t)l * 1024 * INW;
  if (j < 5) { J.src = win; J.ldw = INW; J.K = 1024; J.dst = (bf16_t*)(wb + W_IN); J.ldd = 1024;
    if (j == 0) { J.c0 = 0; J.ncols = 1024; J.drow0 = 0; }
    else if (j == 1) { J.c0 = 1024; J.ncols = 1536; J.drow0 = 1024; }
    else if (j == 2) { J.c0 = 3120; J.ncols = 2048; J.drow0 = 2560; }
    else if (j == 3) { J.c0 = 2608; J.ncols = 512; J.drow0 = 4608; }
    else { J.c0 = 2560; J.ncols = 48; J.drow0 = 5120; }
  } else if (j == 5) { J.src = P.in[14] + (size_t)l * 512 * 512; J.ldw = 512; J.K = 512; J.ncols = 512; J.dst = (bf16_t*)(wb + W_GLU); J.ldd = 512; }
  else if (j == 6) { J.src = P.in[19] + (size_t)l * 1024 * 1024; J.ldw = 1024; J.K = 1024; J.ncols = 1024; J.dst = (bf16_t*)(wb + W_O); J.ldd = 1024; }
  else if (j == 7) { J.src = P.in[15] + (size_t)l * 512 * 1024; J.ldw = 1024; J.K = 512; J.ncols = 1024; J.dst = (bf16_t*)(wb + W_SO); J.ldd = 512; }
  else if (j == 8) { J.src = P.in[20] + (size_t)l * 1024 * 1024; J.ldw = 1024; J.K = 1024; J.ncols = 1024; J.dst = (bf16_t*)(wb + W_OUT); J.ldd = 1024; }
  else if (j == 9) { J.src = P.in[17] + (size_t)l * 2 * 2048 * 256; J.ldw = 256; J.K = 2048; J.ncols = 256; J.nmat = 2; J.sstride = 2048 * 256; J.dstride = 256 * 2048; J.dst = (bf16_t*)(wb + W_C1); J.ldd = 2048; }
  else if (j == 10) { J.src = P.in[18] + (size_t)l * 2 * 256 * 64; J.ldw = 64; J.K = 256; J.ncols = 64; J.nmat = 2; J.sstride = 256 * 64; J.dstride = 128 * 256; J.dst = (bf16_t*)(wb + W_C2); J.ldd = 256; }
  else if (j == 11) { J.src = P.in[26] + (size_t)l * 32 * 1024 * 256; J.ldw = 256; J.K = 1024; J.ncols = 256; J.nmat = 32; J.sstride = 1024 * 256; J.dstride = 512 * 1024; J.dst = (bf16_t*)(wb + W_GU); J.ldd = 1024; J.mode = 1; J.drow0 = 0; }
  else if (j == 12) { J.src = P.in[27] + (size_t)l * 32 * 1024 * 256; J.ldw = 256; J.K = 1024; J.ncols = 256; J.nmat = 32; J.sstride = 1024 * 256; J.dstride = 512 * 1024; J.dst = (bf16_t*)(wb + W_GU); J.ldd = 1024; J.mode = 1; J.drow0 = 16; }
  else { J.src = P.in[28] + (size_t)l * 32 * 256 * 1024; J.ldw = 1024; J.K = 256; J.ncols = 1024; J.nmat = 32; J.sstride = 256 * 1024; J.dstride = 1024 * 256; J.dst = (bf16_t*)(wb + W_D); J.ldd = 256; }
  return J;
}
DI void convert_weights(const Params& P_, int l, unsigned char* lds) {
  Params P = P_; { size_t z_ = 0; asm volatile("" : "+s"(z_)); P.ws = P_.ws + z_; }
  const int tid_ = otid(), bid = obid(), wave = tid_ >> 6, lane = tid_ & 63; (void)bid;
  float* scr = (float*)lds + wave * (64 * 36);
  const int NGW = gridDim.x * NWAVE; int off = bid * NWAVE + wave;
  for (int j = 0; j < 14; ++j) {
    const ConvJob J = conv_job(P, l, j); const int n = conv_nitems(J);
    while (off < n) { conv_item(J, off, scr, lane); off += NGW; }
    off -= n;
  }
}

template <int MODE>
DI void norm_simple(const Params& P_, int l) {
  Params P = P_; { size_t z_ = 0; asm volatile("" : "+s"(z_)); P.ws = P_.ws + z_; }
  const int tid_ = otid(), bid = obid(), wave = tid_ >> 6, lane = tid_ & 63; (void)bid;
  const int NGW = gridDim.x * NWAVE;
  const float* mod = (const float*)(P.ws + WS_MOD);
  const bf16_t* ys = (const bf16_t*)(P.ws + WS_F);
  bf16_t* xn = (bf16_t*)(P.ws + WS_A);
  for (int row = bid * NWAVE + wave; row < NT; row += NGW) {
    const int b = row >> 13;
    const float* xr = (MODE == 0 ? P.in[0] : P.out) + (size_t)row * DM;
    f32x4 v[4];
#pragma unroll
    for (int j = 0; j < 4; ++j) v[j] = *(const f32x4*)(xr + 4 * lane + 256 * j);
    if (MODE != 0 && EN_MOE) {
      const float* g2 = mod + (size_t)(((MODE == 1 ? 0 : 1) * 2 + b) * 6144) + 5120;
#pragma unroll
      for (int j = 0; j < 4; ++j) {
        const int col = 4 * lane + 256 * j;
        const u32x2 y0 = *(const u32x2*)(ys + (size_t)(row * 2) * DM + col), y1 = *(const u32x2*)(ys + (size_t)(row * 2 + 1) * DM + col);
        const f32x4 gg = *(const f32x4*)(g2 + col);
        v[j].x += gg.x * (bflo(y0.x) + bflo(y1.x)); v[j].y += gg.y * (bfhi(y0.x) + bfhi(y1.x));
        v[j].z += gg.z * (bflo(y0.y) + bflo(y1.y)); v[j].w += gg.w * (bfhi(y0.y) + bfhi(y1.y));
      }
    }
    float ss = 0.f;
#pragma unroll
    for (int j = 0; j < 4; ++j) ss += v[j].x * v[j].x + v[j].y * v[j].y + v[j].z * v[j].z + v[j].w * v[j].w;
    ss = wave_sum(ss);
    const float inv = rsqrtf(ss * (1.f / DM) + EPS);
    if (MODE == 3) {
      const float* fg = P.in[29];
#pragma unroll
      for (int j = 0; j < 4; ++j) { const int col = 4 * lane + 256 * j; const f32x4 g = *(const f32x4*)(fg + col); *(f32x4*)(P.out + (size_t)row * DM + col) = v[j] * inv * g; }
    } else {
      if (MODE == 1) {
#pragma unroll
        for (int j = 0; j < 4; ++j) *(f32x4*)(P.out + (size_t)row * DM + 4 * lane + 256 * j) = v[j];
      }
      const float* ng = P.in[4] + (size_t)l * DM; const float* md = mod + (size_t)((l * 2 + b) * 6144);
#pragma unroll
      for (int j = 0; j < 4; ++j) {
        const int col = 4 * lane + 256 * j;
        const f32x4 g = *(const f32x4*)(ng + col), sh = *(const f32x4*)(md + col), sc = *(const f32x4*)(md + 1024 + col);
        const f32x4 h = v[j] * inv * g * (sc + 1.f) + sh;
        u32x2 o; o.x = pk2(h.x, h.y); o.y = pk2(h.z, h.w);
        *(u32x2*)(xn + (size_t)row * DM + col) = o;
      }
    }
  }
}

constexpr int RT_HS = 1028;
DI void norm_route(const Params& P_, int l, unsigned char* lds) {
  Params P = P_; { size_t z_ = 0; asm volatile("" : "+s"(z_)); P.ws = P_.ws + z_; }
  const int tid = otid(), bid = obid(), wave = tid >> 6, lane = tid & 63;
  const float* mod = (const float*)(P.ws + WS_MOD);
  bf16_t* h2 = (bf16_t*)(P.ws + WS_A);
  float* hs = (float*)lds;
  float* Wc = (float*)lds + 32 * RT_HS;
  const float* wg = P.in[22] + (size_t)l * DM * 4; const float* we = P.in[24] + (size_t)l * DM * 32;
  const float* bg = P.in[23] + l * 4; const float* be = P.in[25] + l * 32;
  int* cnt = (int*)(P.ws + WS_CNT) + l * 32; int* list = (int*)(P.ws + WS_LIST); float* wts = (float*)(P.ws + WS_WT);
  const int rg = wave >> 2, kq = wave & 3;
  for (int grp = bid; grp < NT / 32; grp += gridDim.x) {
    const int row0 = grp * 32 + wave * 4, b = row0 >> 13;
    const float* ng = P.in[21] + (size_t)l * DM; const float* md = mod + (size_t)((l * 2 + b) * 6144);
    {
      f32x4 v[4][4];
#pragma unroll
      for (int r = 0; r < 4; ++r)
#pragma unroll
        for (int j = 0; j < 4; ++j) v[r][j] = *(const f32x4*)(P.out + (size_t)(row0 + r) * DM + 4 * lane + 256 * j);
      float inv[4];
#pragma unroll
      for (int r = 0; r < 4; ++r) { float ss = 0.f;
#pragma unroll
        for (int j = 0; j < 4; ++j) ss += v[r][j].x * v[r][j].x + v[r][j].y * v[r][j].y + v[r][j].z * v[r][j].z + v[r][j].w * v[r][j].w;
        inv[r] = rsqrtf(wave_sum(ss) * (1.f / DM) + EPS); }
#pragma unroll
      for (int j = 0; j < 4; ++j) {
        const int col = 4 * lane + 256 * j;
        const f32x4 g = *(const f32x4*)(ng + col), sh = *(const f32x4*)(md + 3072 + col), sc = *(const f32x4*)(md + 4096 + col);
#pragma unroll
        for (int r = 0; r < 4; ++r) {
          const f32x4 hh = v[r][j] * inv[r] * g * (sc + 1.f) + sh;
          u32x2 o; o.x = pk2(hh.x, hh.y); o.y = pk2(hh.z, hh.w);
          *(u32x2*)(h2 + (size_t)(row0 + r) * DM + col) = o;
          *(f32x4*)(hs + (wave * 4 + r) * RT_HS + col) = hh;
        }
      }
    }
    f32x4 we0, we1, wg0 = {0.f, 0.f, 0.f, 0.f};
#define WLOAD(kc) do { we0 = *(const f32x4*)(we + (size_t)(kc) * 4096 + tid * 4); we1 = *(const f32x4*)(we + (size_t)(kc) * 4096 + 2048 + tid * 4); if (tid < 128) wg0 = *(const f32x4*)(wg + (size_t)(kc) * 512 + tid * 4); } while (0)
#define WSTORE() do { *(f32x4*)(Wc + (tid >> 3) * 36 + (tid & 7) * 4) = we0; *(f32x4*)(Wc + (64 + (tid >> 3)) * 36 + (tid & 7) * 4) = we1; if (tid < 128) *(f32x4*)(Wc + tid * 36 + 32) = wg0; } while (0)
    WLOAD(0);
    f32x4 acc0 = {0.f, 0.f, 0.f, 0.f}, acc1 = acc0, acc2 = acc0;
    for (int kc = 0; kc < 8; ++kc) {
      __syncthreads();
      WSTORE();
      if (kc + 1 < 8) WLOAD(kc + 1);
      __syncthreads();
      const float* ap = hs + (rg * 16 + (lane & 15)) * RT_HS + kc * 128 + kq * 32 + (lane >> 4);
      const float* bp = Wc + (kq * 32 + (lane >> 4)) * 36 + (lane & 15);
#pragma unroll
      for (int ks = 0; ks < 8; ++ks) {
        const float av = ap[4 * ks];
        const float b0 = bp[(4 * ks) * 36], b1 = bp[(4 * ks) * 36 + 16], b2 = (lane & 15) < 4 ? bp[(4 * ks) * 36 + 32] : 0.f;
        acc0 = __builtin_amdgcn_mfma_f32_16x16x4f32(av, b0, acc0, 0, 0, 0);
        acc1 = __builtin_amdgcn_mfma_f32_16x16x4f32(av, b1, acc1, 0, 0, 0);
        acc2 = __builtin_amdgcn_mfma_f32_16x16x4f32(av, b2, acc2, 0, 0, 0);
      }
    }
#undef WLOAD
#undef WSTORE
    __syncthreads();
    {
      float* part = hs + kq * (32 * 40);
#pragma unroll
      for (int i = 0; i < 4; ++i) { const int row = rg * 16 + 4 * (lane >> 4) + i, col = lane & 15;
        part[row * 40 + col] = acc0[i]; part[row * 40 + 16 + col] = acc1[i]; if (col < 4) part[row * 40 + 32 + col] = acc2[i]; }
    }
    __syncthreads();
    if (tid < 32) {
      const int row = grp * 32 + tid;
      float L[36];
#pragma unroll
      for (int o = 0; o < 36; ++o) L[o] = (hs[tid * 40 + o] + hs[1280 + tid * 40 + o]) + (hs[2560 + tid * 40 + o] + hs[3840 + tid * 40 + o]);
      float gm = -1e30f; int gi = 0;
#pragma unroll
      for (int i = 0; i < 4; ++i) { const float v = L[32 + i] + bg[i]; if (v > gm) { gm = v; gi = i; } }
      float gs = 0.f;
#pragma unroll
      for (int i = 0; i < 4; ++i) gs += expf(L[32 + i] + bg[i] - gm);
      const float gp = 1.f / gs;
      float el[8];
#pragma unroll
      for (int i = 0; i < 8; ++i) el[i] = (gi == 0 ? L[i] : gi == 1 ? L[8 + i] : gi == 2 ? L[16 + i] : L[24 + i]) + be[gi * 8 + i];
      float em = -1e30f;
#pragma unroll
      for (int i = 0; i < 8; ++i) em = fmaxf(em, el[i]);
      float p1 = -1.f, p2 = -1.f; int i1 = 0, i2 = 0;
#pragma unroll
      for (int i = 0; i < 8; ++i) {
        const float pe = expf(el[i] - em);
        if (pe > p1) { p2 = p1; i2 = i1; p1 = pe; i1 = i; } else if (pe > p2) { p2 = pe; i2 = i; }
      }
      const float w1 = gp * p1 / (p1 + p2), w2 = gp * p2 / (p1 + p2);
      const int e1 = gi * 8 + i1, e2 = gi * 8 + i2;
      const int pos1 = atomicAdd(&cnt[e1], 1); list[e1 * LISTCAP + pos1] = row * 2; wts[row * 2] = w1;
      const int pos2 = atomicAdd(&cnt[e2], 1); list[e2 * LISTCAP + pos2] = row * 2 + 1; wts[row * 2 + 1] = w2;
    }
    __syncthreads();
  }
}

namespace pg8 {
#define PG8_LAS __attribute__((address_space(3)))
typedef unsigned short bf16_t;
typedef short bf16x8 __attribute__((ext_vector_type(8)));
typedef float f32x4 __attribute__((ext_vector_type(4)));
typedef unsigned u32x4 __attribute__((ext_vector_type(4)));
constexpr int BM = 256, BK = 64, HALF = 128, HTB = HALF * BK * 2  , STAGE_BYTES = 8 * HTB, NXCD = 8, WGM = 8;

__host__ __device__ __forceinline__ int lds_byte(int r, int c) { const int st = (r >> 4) * 2 + (c >> 5), rr = r & 15, cc = c & 31, ob = rr * 64 + cc * 2; return st * 1024 + (ob ^ (((ob >> 9) & 1) << 5)); }
__host__ __device__ __forceinline__ void stage_rc(int b, int& R, int& C) { const int st = b / 1024, sb = b % 1024, swz = sb ^ (((sb >> 9) & 1) << 5); R = (st >> 1) * 16 + swz / 64; C = (st & 1) * 32 + (swz % 64) / 2; }
__host__ __device__ __forceinline__ int perm32(int rho) { const int n = rho >> 4, i = rho & 15; return 8 * (i >> 2) + 4 * n + (i & 3); }

struct Unit { int pm, pn; };
struct Gemm { const bf16_t* A; const bf16_t* Bt; int M, N, K; };

struct StaticOrder {
    int nM, nN, nwg, G, c;
    __host__ __device__ void init(int M, int N, int G_, int c_) { nM = M / BM; nN = N / BM; nwg = nM * nN; G = G_; c = c_; }
    __host__ __device__ bool next(int i, Unit& u) const {
        const long L = (long)i * G + c; if (L >= nwg) return false;
        int wgid = (int)L; { const int q = nwg / NXCD, r = nwg % NXCD, xcd = wgid % NXCD, off = wgid / NXCD; wgid = (xcd < r ? xcd * (q + 1) : r * (q + 1) + (xcd - r) * q) + off; }
        const int nig = WGM * nN, gid = wgid / nig, fm = gid * WGM, gsz = (nM - fm) < WGM ? (nM - fm) : WGM;
        u.pm = fm + ((wgid % nig) % gsz); u.pn = (wgid % nig) / gsz; return true;
    }
    __device__ __forceinline__ void a_ready(const Unit&) const {}
    __device__ __forceinline__ void done(const Unit&) const {}
};
template <class Epi, class Sched, bool ALIGN_EPI = false, bool SP2 = false>
__device__ __forceinline__ void gemm_phase(PG8_LAS unsigned char* lds, const Gemm g, const Sched& S, const Epi& E) {
    const int tid = otid(), wid = __builtin_amdgcn_readfirstlane(tid >> 6), lane = tid & 63, wr = wid >> 2, wc = wid & 3, fr = lane & 15, fq = lane >> 4;
    const int K = g.K, nt = K / BK;
    unsigned voffA[2], voffB[2];
#pragma unroll
    for (int i = 0; i < 2; ++i) { int R, C; stage_rc(tid * 16 + i * 8192, R, C); const int Rb = Epi::PERM ? ((R & ~31) + perm32(R & 31)) : R;
        voffA[i] = (unsigned)(R * K + C) * 2u; voffB[i] = (unsigned)(Rb * K + C) * 2u; }
    const size_t kstep = (size_t)(BK * 2);
    const size_t hstep = (size_t)HALF * K * 2;
    const size_t tstep = 2 * hstep;
    const unsigned ldsw = (unsigned)wid * 1024u;
    const int aoff = lds_byte(wr * 64 + fr, fq * 8), boff = lds_byte(wc * 32 + fr, fq * 8);
#define PG8_SA(b, h) (((b) * 2 + (h)) * HTB)
#define PG8_SB(b, h) ((4 + (b) * 2 + (h)) * HTB)
#define PG8_STAGE(bufoff, gbase, voff) do { _Pragma("unroll") for (int _i = 0; _i < 2; ++_i) \
        __builtin_amdgcn_global_load_lds((const unsigned*)((const char*)(gbase) + (voff)[_i]), (PG8_LAS unsigned*)(lds + (bufoff) + ldsw + _i * 8192), 16, 0, 0); } while (0)
#define PG8_LDA(dst, b, h) do { _Pragma("unroll") for (int m = 0; m < 4; ++m) _Pragma("unroll") for (int k = 0; k < 2; ++k) dst[m][k] = *(const PG8_LAS bf16x8*)(lds + PG8_SA(b, h) + aoff + m * 2048 + k * 1024); } while (0)
#define PG8_LDB(dst, b, h) do { _Pragma("unroll") for (int n = 0; n < 2; ++n) _Pragma("unroll") for (int k = 0; k < 2; ++k) dst[n][k] = *(const PG8_LAS bf16x8*)(lds + PG8_SB(b, h) + boff + n * 2048 + k * 1024); } while (0)
#define PG8_MMA(ai, bj, At, Bt) do { __builtin_amdgcn_s_setprio(1); _Pragma("unroll") for (int m = 0; m < 4; ++m) _Pragma("unroll") for (int n = 0; n < 2; ++n) _Pragma("unroll") for (int k = 0; k < 2; ++k) \
        acc[ai][bj][m][n] = __builtin_amdgcn_mfma_f32_16x16x32_bf16(Bt[n][k], At[m][k], acc[ai][bj][m][n], 0, 0, 0); __builtin_amdgcn_s_setprio(0); } while (0)
#define PG8_WAIT_V(n) asm volatile("s_waitcnt vmcnt(" #n ")" ::: "memory")
#define PG8_WAIT_L(n) asm volatile("s_waitcnt lgkmcnt(" #n ")" ::: "memory")
#define PG8_BAR __builtin_amdgcn_s_barrier()
#define PG8_SCHED __builtin_amdgcn_sched_barrier(0)
    Unit cur, nxt; int ui = 0;
    if (!S.next(0, cur)) return;
    f32x4 acc[2][2][4][2];
#pragma unroll
    for (int a = 0; a < 2; ++a)
#pragma unroll
        for (int b = 0; b < 2; ++b)
#pragma unroll
            for (int m = 0; m < 4; ++m)
#pragma unroll
                for (int n = 0; n < 2; ++n) acc[a][b][m][n] = (f32x4){0.f, 0.f, 0.f, 0.f};
    bf16x8 At[4][2], B0[2][2], B1[2][2];
    const char* cA = (const char*)g.A + (size_t)cur.pm * tstep; const char* cB = (const char*)g.Bt + (size_t)cur.pn * tstep;
    S.a_ready(cur);
    if constexpr (SP2) {
        PG8_STAGE(PG8_SB(0, 0), cB, voffB); PG8_STAGE(PG8_SB(0, 1), cB + hstep, voffB); PG8_STAGE(PG8_SA(0, 0), cA, voffA); PG8_STAGE(PG8_SA(0, 1), cA + hstep, voffA);
        if (wr == 1) PG8_BAR;
        PG8_WAIT_V(2); PG8_BAR;
        PG8_STAGE(PG8_SB(1, 0), cB + kstep, voffB); PG8_STAGE(PG8_SA(1, 0), cA + kstep, voffA); PG8_STAGE(PG8_SB(1, 1), cB + hstep + kstep, voffB);
        PG8_WAIT_V(6); PG8_BAR;
    } else {
        PG8_STAGE(PG8_SB(0, 0), cB, voffB); PG8_STAGE(PG8_SA(0, 0), cA, voffA); PG8_STAGE(PG8_SB(0, 1), cB + hstep, voffB); PG8_STAGE(PG8_SA(0, 1), cA + hstep, voffA);
        if (wr == 1) PG8_BAR;
        PG8_WAIT_V(4); PG8_BAR;
        PG8_STAGE(PG8_SB(1, 0), cB + kstep, voffB); PG8_STAGE(PG8_SA(1, 0), cA + kstep, voffA); PG8_STAGE(PG8_SB(1, 1), cB + hstep + kstep, voffB);
        PG8_WAIT_V(6); PG8_BAR;
    }
    for (;;) {
        const bool has_next = S.next(ui + 1, nxt);
        const char* nA = has_next ? (const char*)g.A + (size_t)nxt.pm * tstep : cA; const char* nB = has_next ? (const char*)g.Bt + (size_t)nxt.pn * tstep : cB;
        for (int t = 0; t < nt; t += 2) {
            const bool last = (t == nt - 2);
            const char* a1 = cA + (size_t)(t + 1) * kstep;
            const char* a2 = last ? nA : cA + (size_t)(t + 2) * kstep; const char* b2 = last ? nB : cB + (size_t)(t + 2) * kstep;
            const char* a3 = a2 + kstep; const char* b3 = b2 + kstep;
            if (last && has_next) S.a_ready(nxt);
            if constexpr (SP2) {
            PG8_LDB(B0, 0, 0); PG8_LDB(B1, 0, 1); PG8_SCHED; PG8_LDA(At, 0, 0); PG8_STAGE(PG8_SA(1, 1), a1 + hstep, voffA);
            PG8_WAIT_V(8); PG8_WAIT_L(0); PG8_BAR; PG8_MMA(0, 0, At, B0); PG8_MMA(0, 1, At, B1); PG8_BAR; PG8_SCHED;
            PG8_LDA(At, 0, 1); PG8_STAGE(PG8_SB(0, 0), b2, voffB); PG8_STAGE(PG8_SB(0, 1), b2 + hstep, voffB); PG8_STAGE(PG8_SA(0, 0), a2, voffA);
            PG8_WAIT_V(8); PG8_WAIT_L(0); PG8_BAR; PG8_MMA(1, 0, At, B0); PG8_MMA(1, 1, At, B1); PG8_BAR; PG8_SCHED;
            PG8_LDB(B0, 1, 0); PG8_LDB(B1, 1, 1); PG8_SCHED; PG8_LDA(At, 1, 0); PG8_STAGE(PG8_SA(0, 1), a2 + hstep, voffA);
            PG8_WAIT_V(8); PG8_WAIT_L(0); PG8_BAR; PG8_MMA(0, 0, At, B0); PG8_MMA(0, 1, At, B1); PG8_BAR; PG8_SCHED;
            PG8_LDA(At, 1, 1); PG8_STAGE(PG8_SB(1, 0), b3, voffB); PG8_STAGE(PG8_SB(1, 1), b3 + hstep, voffB); PG8_STAGE(PG8_SA(1, 0), a3, voffA);
            PG8_WAIT_V(8); PG8_WAIT_L(0); PG8_BAR; PG8_MMA(1, 0, At, B0); PG8_MMA(1, 1, At, B1); PG8_BAR; PG8_SCHED;
            } else {
            PG8_LDB(B0, 0, 0); PG8_SCHED; PG8_LDA(At, 0, 0); PG8_STAGE(PG8_SA(1, 1), a1 + hstep, voffA);
            PG8_WAIT_L(8); PG8_BAR; PG8_WAIT_L(0); PG8_MMA(0, 0, At, B0); PG8_BAR; PG8_SCHED;
            PG8_LDB(B1, 0, 1); PG8_STAGE(PG8_SB(0, 0), b2, voffB);
            PG8_BAR; PG8_WAIT_L(0); PG8_MMA(0, 1, At, B1); PG8_BAR;
            PG8_LDA(At, 0, 1); PG8_STAGE(PG8_SA(0, 0), a2, voffA);
            PG8_BAR; PG8_WAIT_L(0); PG8_MMA(1, 0, At, B0); PG8_BAR; PG8_SCHED;
            PG8_STAGE(PG8_SB(0, 1), b2 + hstep, voffB);
            PG8_WAIT_V(6); PG8_BAR; PG8_MMA(1, 1, At, B1); PG8_BAR;
            PG8_LDB(B0, 1, 0); PG8_SCHED; PG8_LDA(At, 1, 0); PG8_STAGE(PG8_SA(0, 1), a2 + hstep, voffA);
            PG8_WAIT_L(8); PG8_BAR; PG8_WAIT_L(0); PG8_MMA(0, 0, At, B0); PG8_BAR; PG8_SCHED;
            PG8_LDB(B1, 1, 1); PG8_STAGE(PG8_SB(1, 0), b3, voffB);
            PG8_BAR; PG8_WAIT_L(0); PG8_MMA(0, 1, At, B1); PG8_BAR;
            PG8_LDA(At, 1, 1); PG8_STAGE(PG8_SA(1, 0), a3, voffA);
            PG8_BAR; PG8_WAIT_L(0); PG8_MMA(1, 0, At, B0); PG8_BAR; PG8_SCHED;
            PG8_STAGE(PG8_SB(1, 1), b3 + hstep, voffB);
            PG8_WAIT_V(6); PG8_BAR; PG8_MMA(1, 1, At, B1); PG8_BAR;
            }
        }
        if constexpr (ALIGN_EPI) { if (wr == 0) PG8_BAR; }
        if constexpr (!Epi::AFTER_DRAIN) { E(acc, cur, wr, wc, fr, fq); S.done(cur); }
        if (!has_next) break;
#pragma unroll
        for (int a = 0; a < 2; ++a)
#pragma unroll
            for (int b = 0; b < 2; ++b)
#pragma unroll
                for (int m = 0; m < 4; ++m)
#pragma unroll
                    for (int n = 0; n < 2; ++n) acc[a][b][m][n] = (f32x4){0.f, 0.f, 0.f, 0.f};
        cur = nxt; cA = nA; cB = nB; ++ui;
        if constexpr (ALIGN_EPI) { if (wr == 1) PG8_BAR; }
    }
    PG8_WAIT_V(0);
    if constexpr (!ALIGN_EPI) { if (wr == 0) PG8_BAR; }
    PG8_BAR;
    if constexpr (Epi::AFTER_DRAIN) { E.fused(acc, cur, wr, wc, fr, fq, lds, wid, lane); S.done(cur); }
#undef PG8_SA
#undef PG8_SB
#undef PG8_STAGE
#undef PG8_LDA
#undef PG8_LDB
#undef PG8_MMA
#undef PG8_WAIT_V
#undef PG8_WAIT_L
#undef PG8_BAR
#undef PG8_SCHED
}
}

constexpr int GT_ROWB = 144, GT_A = 0, GT_B = 128 * GT_ROWB, GT_STAGE = 2 * 128 * GT_ROWB;
DI void gemm_kloop(unsigned char* lds, const bf16_t* a0, const bf16_t* a1, int a_kadv, const bf16_t* b0, const bf16_t* b1, int nk, f32x4 (&acc)[4][2]) {
  const int tid = otid(), lane = tid & 63, wid = tid >> 6, wr = wid >> 2, wc = wid & 3, fr = lane & 15, fq = lane >> 4;
  const int lr = tid >> 3, lkb = (tid & 7) * 16;
  u32x4 xa0, xa1, xb0, xb1, ya0, ya1, yb0, yb1;
#define GT_GLOAD(p0_, p1_, q0_, q1_, kt) do { p0_ = *(const u32x4*)(a0 + (size_t)(kt) * a_kadv); p1_ = *(const u32x4*)(a1 + (size_t)(kt) * a_kadv); q0_ = *(const u32x4*)(b0 + (kt) * 64); q1_ = *(const u32x4*)(b1 + (kt) * 64); } while (0)
#define GT_LSTORE(p0_, p1_, q0_, q1_, buf) do { unsigned char* s_ = lds + (buf) * GT_STAGE; \
    *(u32x4*)(s_ + GT_A + lr * GT_ROWB + lkb) = p0_; *(u32x4*)(s_ + GT_A + (lr + 64) * GT_ROWB + lkb) = p1_; \
    *(u32x4*)(s_ + GT_B + lr * GT_ROWB + lkb) = q0_; *(u32x4*)(s_ + GT_B + (lr + 64) * GT_ROWB + lkb) = q1_; } while (0)
#define GT_COMPUTE(buf) do { \
    const unsigned char* As = lds + (buf) * GT_STAGE + GT_A + (wr * 64 + fr) * GT_ROWB + fq * 16; \
    const unsigned char* Bs = lds + (buf) * GT_STAGE + GT_B + (wc * 32 + fr) * GT_ROWB + fq * 16; \
    _Pragma("unroll") for (int ks = 0; ks < 2; ++ks) { \
      bf16x8 af[4], bfr[2]; \
      _Pragma("unroll") for (int m = 0; m < 4; ++m) af[m] = *(const bf16x8*)(As + m * 16 * GT_ROWB + ks * 64); \
      _Pragma("unroll") for (int n = 0; n < 2; ++n) bfr[n] = *(const bf16x8*)(Bs + n * 16 * GT_ROWB + ks * 64); \
      _Pragma("unroll") for (int m = 0; m < 4; ++m) _Pragma("unroll") for (int n = 0; n < 2; ++n) acc[m][n] = __builtin_amdgcn_mfma_f32_16x16x32_bf16(bfr[n], af[m], acc[m][n], 0, 0, 0); } } while (0)
  GT_GLOAD(xa0, xa1, xb0, xb1, 0); GT_LSTORE(xa0, xa1, xb0, xb1, 0); if (nk > 1) GT_GLOAD(ya0, ya1, yb0, yb1, 1); __syncthreads();
  for (int kt = 0; kt < nk; kt += 2) {
    if (kt + 2 < nk) GT_GLOAD(xa0, xa1, xb0, xb1, kt + 2);
    GT_COMPUTE(0);
    if (kt + 1 < nk) GT_LSTORE(ya0, ya1, yb0, yb1, 1);
    __syncthreads();
    if (kt + 1 >= nk) break;
    if (kt + 3 < nk) GT_GLOAD(ya0, ya1, yb0, yb1, kt + 3);
    GT_COMPUTE(1);
    if (kt + 2 < nk) GT_LSTORE(xa0, xa1, xb0, xb1, 0);
    __syncthreads();
  }
#undef GT_GLOAD
#undef GT_LSTORE
#undef GT_COMPUTE
}
#define ACC_ZERO(acc) do { _Pragma("unroll") for (int m_ = 0; m_ < 4; ++m_) _Pragma("unroll") for (int n_ = 0; n_ < 2; ++n_) acc[m_][n_] = (f32x4){0.f, 0.f, 0.f, 0.f}; } while (0)
#define TILE_IDS const int tid = otid(), bid = obid(), lane = tid & 63, wid = tid >> 6, wr = wid >> 2, wc = wid & 3, fr = lane & 15, fq = lane >> 4, lr = tid >> 3, lk = (tid & 7) * 8; (void)bid; (void)lane; (void)wr; (void)wc; (void)fr; (void)fq; (void)lr; (void)lk

DI void phase_gates(const Params& P_, unsigned char* lds) {
  Params P = P_; { size_t z_ = 0; asm volatile("" : "+s"(z_)); P.ws = P_.ws + z_; }
  TILE_IDS;
  const bf16_t* xn = (const bf16_t*)(P.ws + WS_A); const bf16_t* wt = (const bf16_t*)(P.ws + WS_W + W_IN) + (size_t)5120 * DM; float* gates = (float*)(P.ws + WS_GATES);
  for (int tile = (int)gridDim.x - 1 - bid; tile < NT / 128; tile += gridDim.x) {
    const int row0 = tile * 128;
    f32x4 acc[4][2]; ACC_ZERO(acc);
    gemm_kloop(lds, xn + (size_t)(row0 + lr) * DM + lk, xn + (size_t)(row0 + lr + 64) * DM + lk, 64, wt + (size_t)lr * DM + lk, wt + (size_t)(lr + 64) * DM + lk, DM / 64, acc);
#pragma unroll
    for (int m = 0; m < 4; ++m)
#pragma unroll
      for (int n = 0; n < 2; ++n) {
        const int row = row0 + wr * 64 + m * 16 + fr, c2 = wc * 32 + n * 16 + 4 * fq; const f32x4 v = acc[m][n];
        if (c2 < 48) { f32x4 o = {sigmoidf_(v.x), sigmoidf_(v.y), sigmoidf_(v.z), sigmoidf_(v.w)}; *(f32x4*)(gates + (size_t)row * 48 + c2) = o; }
      }
  }
}
DI void phase_cmp1(const Params& P_, int l, unsigned char* lds) {
  Params P = P_; { size_t z_ = 0; asm volatile("" : "+s"(z_)); P.ws = P_.ws + z_; }
  TILE_IDS;
  const bf16_t* kvk = (const bf16_t*)(P.ws + WS_C); bf16_t* hid = (bf16_t*)(P.ws + WS_HID);
  const float* cb = (const float*)(P.ws + WS_CB) + l * 512;
  for (int tile = bid; tile < 128; tile += gridDim.x) {
    const int kv = tile >> 6, rt = (tile >> 1) & 31, ct = tile & 1, row0 = rt * 128, col0 = ct * 128;
    const bf16_t* wt = (const bf16_t*)(P.ws + WS_W + W_C1) + (size_t)kv * 256 * 2048;
    const bf16_t* ap[2];
#pragma unroll
    for (int i = 0; i < 2; ++i) { const int rr = row0 + lr + 64 * i, b = rr >> 11, n = (rr >> 2) & 511, g = rr & 3, nn = n > 510 ? 510 : n;
      ap[i] = kvk + (size_t)(b * SEQ + 16 * nn) * DM + kv * 256 + g * 64 + lk; }
    f32x4 acc[4][2]; ACC_ZERO(acc);
    gemm_kloop(lds, ap[0], ap[1], DM, wt + (size_t)(col0 + lr) * 2048 + lk, wt + (size_t)(col0 + lr + 64) * 2048 + lk, 32, acc);
#pragma unroll
    for (int m = 0; m < 4; ++m)
#pragma unroll
      for (int n = 0; n < 2; ++n) {
        const int row = row0 + wr * 64 + m * 16 + fr, col = col0 + wc * 32 + n * 16 + 4 * fq;
        const f32x4 bb = *(const f32x4*)(cb + kv * 256 + col); const f32x4 v = acc[m][n] + bb;
        u32x2 o; o.x = pk2(gelu_tanh(v.x), gelu_tanh(v.y)); o.y = pk2(gelu_tanh(v.z), gelu_tanh(v.w));
        *(u32x2*)(hid + ((size_t)kv * 4096 + row) * 256 + col) = o;
      }
  }
}
DI void phase_cmp2(const Params& P_, unsigned char* lds) {
  Params P = P_; { size_t z_ = 0; asm volatile("" : "+s"(z_)); P.ws = P_.ws + z_; }
  TILE_IDS;
  const bf16_t* hid = (const bf16_t*)(P.ws + WS_HID); bf16_t* kc = (bf16_t*)(P.ws + WS_KC); bf16_t* vc = (bf16_t*)(P.ws + WS_VC);
  for (int tile = bid; tile < 64; tile += gridDim.x) {
    const int kv = tile >> 5, rt = tile & 31, row0 = rt * 128;
    const bf16_t* wt = (const bf16_t*)(P.ws + WS_W + W_C2) + (size_t)kv * 128 * 256;
    const bf16_t* a = hid + ((size_t)kv * 4096 + row0) * 256;
    f32x4 acc[4][2]; ACC_ZERO(acc);
    gemm_kloop(lds, a + (size_t)lr * 256 + lk, a + (size_t)(lr + 64) * 256 + lk, 64, wt + (size_t)lr * 256 + lk, wt + (size_t)(lr + 64) * 256 + lk, 4, acc);
    if (wc < 2) {
#pragma unroll
      for (int m = 0; m < 4; ++m)
#pragma unroll
        for (int n = 0; n < 2; ++n) {
          const int rr = row0 + wr * 64 + m * 16 + fr, d = wc * 32 + n * 16 + 4 * fq;
          const int b = rr >> 11, nn = (rr >> 2) & 511, g = rr & 3; const f32x4 v = acc[m][n];
          if (kv == 0) { u32x2 o; o.x = pk2(v.x, v.y); o.y = pk2(v.z, v.w); *(u32x2*)(kc + ((size_t)((b * 4 + g) * 512 + nn)) * 64 + d) = o; }
          else { bf16_t* dst = vc + ((size_t)((b * 4 + g) * 64 + d)) * 512 + perm16(nn); dst[0] = (bf16_t)f2bf(v.x); dst[512] = (bf16_t)f2bf(v.y); dst[1024] = (bf16_t)f2bf(v.z); dst[1536] = (bf16_t)f2bf(v.w); }
        }
    }
  }
}
DI void phase_glu(const Params& P_, unsigned char* lds) {
  Params P = P_; { size_t z_ = 0; asm volatile("" : "+s"(z_)); P.ws = P_.ws + z_; }
  TILE_IDS;
  const bf16_t* y = (const bf16_t*)(P.ws + WS_G); const bf16_t* wt = (const bf16_t*)(P.ws + WS_W + W_GLU); bf16_t* ssm = (bf16_t*)(P.ws + WS_E);
  for (int tile = bid; tile < (NT / 128) * 4; tile += gridDim.x) {
    const int rt = tile >> 2, ct = tile & 3, row0 = rt * 128, col0 = ct * 128;
    f32x4 acc[4][2]; ACC_ZERO(acc);
    gemm_kloop(lds, y + (size_t)(row0 + lr) * 512 + lk, y + (size_t)(row0 + lr + 64) * 512 + lk, 64, wt + (size_t)(col0 + lr) * 512 + lk, wt + (size_t)(col0 + lr + 64) * 512 + lk, 8, acc);
#pragma unroll
    for (int m = 0; m < 4; ++m)
#pragma unroll
      for (int n = 0; n < 2; ++n) {
        const int row = row0 + wr * 64 + m * 16 + fr, col = col0 + wc * 32 + n * 16 + 4 * fq;
        const u32x2 yy = *(const u32x2*)(y + (size_t)row * 512 + col); const f32x4 v = acc[m][n];
        u32x2 o; o.x = pk2(bflo(yy.x) * sigmoidf_(v.x), bfhi(yy.x) * sigmoidf_(v.y)); o.y = pk2(bflo(yy.y) * sigmoidf_(v.z), bfhi(yy.y) * sigmoidf_(v.w));
        *(u32x2*)(ssm + (size_t)row * 512 + col) = o;
      }
  }
}
struct EpiInproj {
  static constexpr bool PERM = false, AFTER_DRAIN = false;
  bf16_t* qb; bf16_t* kvk; bf16_t* vT; bf16_t* mg; bf16_t* ub; float* gates;
  DI void operator()(const f32x4 (&acc)[2][2][4][2], const pg8::Unit& u, int wr, int wc, int fr_, int fq_) const {
    const int pn = u.pn; int fr = fr_, fq = fq_; asm volatile("" : "+v"(fr), "+v"(fq));
#pragma unroll
    for (int ai = 0; ai < 2; ++ai)
#pragma unroll
      for (int m = 0; m < 4; ++m) {
        const int row = u.pm * 256 + ai * 128 + wr * 64 + m * 16 + fr;
#pragma unroll
        for (int bj = 0; bj < 2; ++bj)
#pragma unroll
          for (int n = 0; n < 2; ++n) {
            const int cl = bj * 128 + wc * 32 + n * 16 + 4 * fq;
            const f32x4 v = acc[ai][bj][m][n];
            if (pn < 4) { u32x2 o; o.x = pk2(v.x * QSCALE, v.y * QSCALE); o.y = pk2(v.z * QSCALE, v.w * QSCALE); *(u32x2*)(qb + (size_t)row * DM + pn * 256 + cl) = o; }
            else if (pn < 10) {
              const int seg = pn - 4;
              if (seg == 5) {
                const int b = row >> 13, t = row & (SEQ - 1), g = cl >> 6, d = cl & 63;
                bf16_t* dst = vT + ((size_t)(((1 * NB + b) * 4 + g) * 64 + d)) * SEQ + perm16(t);
                dst[0] = (bf16_t)f2bf(v.x); dst[SEQ] = (bf16_t)f2bf(v.y); dst[2 * SEQ] = (bf16_t)f2bf(v.z); dst[3 * SEQ] = (bf16_t)f2bf(v.w);
              } else if (seg == 3) {
                const unsigned t = row & (SEQ - 1), pos = perm16(t) & 63;
                const unsigned ro = ((unsigned)(row >> 13) * 512u + (t >> 6)) * 4096u + (pos >> 3) * 256u + (pos & 7), co = (unsigned)(cl >> 6) * 524288u + (unsigned)((cl >> 5) & 1) * 2048u + (unsigned)(cl & 31) * 8u;
                bf16_t* dst = vT + (ro + co);
                dst[0] = (bf16_t)f2bf(v.x); dst[8] = (bf16_t)f2bf(v.y); dst[16] = (bf16_t)f2bf(v.z); dst[24] = (bf16_t)f2bf(v.w);
              } else if (seg == 2) {
                const unsigned t = row & (SEQ - 1);
                const unsigned ro = ((unsigned)(row >> 13) * 512u + (t >> 6)) * 4096u + ((t >> 5) & 1) * 2048u + (t & 31) * 8u, co = (unsigned)(cl >> 6) * 524288u + (unsigned)((cl >> 3) & 7) * 256u + (unsigned)(cl & 7);
                u32x2 o; o.x = pk2(v.x, v.y); o.y = pk2(v.z, v.w);
                *(u32x2*)(kvk + (WS_KSF - WS_C) / 2 + (ro + co)) = o;
              } else {
                const int slot = seg == 4 ? 3 : seg;
                u32x2 o; o.x = pk2(v.x, v.y); o.y = pk2(v.z, v.w); *(u32x2*)(kvk + (size_t)row * DM + slot * 256 + cl) = o;
              }
            } else if (pn < 18) {
              u32x2 o; o.x = pk2(sigmoidf_(v.x), sigmoidf_(v.y)); o.y = pk2(sigmoidf_(v.z), sigmoidf_(v.w)); *(u32x2*)(mg + (size_t)row * 2048 + (pn - 10) * 256 + cl) = o;
            } else if (pn < 20) { const int ch = (pn - 18) * 256 + cl; u32x2 o; o.x = pk2(v.x, v.y); o.y = pk2(v.z, v.w); *(u32x2*)(ub + ((size_t)(ch >> 4) * NT + row) * 16 + (ch & 15)) = o; }
            else { if (cl < 48) { f32x4 o = {sigmoidf_(v.x), sigmoidf_(v.y), sigmoidf_(v.z), sigmoidf_(v.w)}; *(f32x4*)(gates + (size_t)row * 48 + cl) = o; } }
          }
      }
  }
};
DI void phase_inproj8(const Params& P_, unsigned char* lds) {
  Params P = P_; { size_t z_ = 0; asm volatile("" : "+s"(z_)); P.ws = P_.ws + z_; }
  pg8::Gemm g{(const bf16_t*)(P.ws + WS_A), (const bf16_t*)(P.ws + WS_W + W_IN), NT, 5120, DM};
  pg8::StaticOrder S; S.init(NT, 5120, gridDim.x, obid());
  EpiInproj E{(bf16_t*)(P.ws + WS_B), (bf16_t*)(P.ws + WS_C), (bf16_t*)(P.ws + WS_DV), (bf16_t*)(P.ws + WS_F), (bf16_t*)(P.ws + WS_E), (float*)(P.ws + WS_GATES)};
  pg8::gemm_phase<EpiInproj, pg8::StaticOrder, true, true>((PG8_LAS unsigned char*)lds, g, S, E);
}
struct EpiMerge1 {
  static constexpr bool PERM = false, AFTER_DRAIN = false;
  const bf16_t* mg; bf16_t* tmp;
  DI void operator()(const f32x4 (&acc)[2][2][4][2], const pg8::Unit& u, int wr, int wc, int fr, int fq) const {
#pragma unroll
    for (int ai = 0; ai < 2; ++ai)
#pragma unroll
      for (int m = 0; m < 4; ++m) {
        const int row = u.pm * 256 + ai * 128 + wr * 64 + m * 16 + fr;
#pragma unroll
        for (int bj = 0; bj < 2; ++bj)
#pragma unroll
          for (int n = 0; n < 2; ++n) {
            const int col = u.pn * 256 + bj * 128 + wc * 32 + n * 16 + 4 * fq; const f32x4 v = acc[ai][bj][m][n];
            const u32x2 ga = *(const u32x2*)(mg + (size_t)row * 2048 + col);
            u32x2 o; o.x = pk2(v.x * bflo(ga.x), v.y * bfhi(ga.x)); o.y = pk2(v.z * bflo(ga.y), v.w * bfhi(ga.y));
            *(u32x2*)(tmp + (size_t)row * DM + col) = o;
          }
      }
  }
};
struct EpiMerge2 {
  static constexpr bool PERM = false, AFTER_DRAIN = false;
  const bf16_t* mg; const bf16_t* tmp; bf16_t* mer;
  DI void operator()(const f32x4 (&acc)[2][2][4][2], const pg8::Unit& u, int wr, int wc, int fr, int fq) const {
#pragma unroll
    for (int ai = 0; ai < 2; ++ai)
#pragma unroll
      for (int m = 0; m < 4; ++m) {
        const int row = u.pm * 256 + ai * 128 + wr * 64 + m * 16 + fr;
#pragma unroll
        for (int bj = 0; bj < 2; ++bj)
#pragma unroll
          for (int n = 0; n < 2; ++n) {
            const int col = u.pn * 256 + bj * 128 + wc * 32 + n * 16 + 4 * fq; const f32x4 v = acc[ai][bj][m][n];
            const u32x2 gs = *(const u32x2*)(mg + (size_t)row * 2048 + 1024 + col);
#if EN_ATTN
            const u32x2 tv = *(const u32x2*)(tmp + (size_t)row * DM + col);
            const float t0 = bflo(tv.x), t1 = bfhi(tv.x), t2 = bflo(tv.y), t3 = bfhi(tv.y);
#else
            const float t0 = 0.f, t1 = 0.f, t2 = 0.f, t3 = 0.f;
#endif
            u32x2 o; o.x = pk2(t0 + v.x * bflo(gs.x), t1 + v.y * bfhi(gs.x)); o.y = pk2(t2 + v.z * bflo(gs.y), t3 + v.w * bfhi(gs.y));
            *(u32x2*)(mer + (size_t)row * DM + col) = o;
          }
      }
  }
};
DI void phase_merge8(const Params& P_, unsigned char* lds) {
  Params P = P_; { size_t z_ = 0; asm volatile("" : "+s"(z_)); P.ws = P_.ws + z_; }
#if EN_ATTN
  { pg8::Gemm g{(const bf16_t*)(P.ws + WS_A), (const bf16_t*)(P.ws + WS_W + W_O), NT, DM, DM};
    pg8::StaticOrder S; S.init(NT, DM, gridDim.x, obid());
    EpiMerge1 E{(const bf16_t*)(P.ws + WS_F), (bf16_t*)(P.ws + WS_C)};
    pg8::gemm_phase<EpiMerge1, pg8::StaticOrder, true, true>((PG8_LAS unsigned char*)lds, g, S, E); }
#endif
  { pg8::Gemm g{(const bf16_t*)(P.ws + WS_E), (const bf16_t*)(P.ws + WS_W + W_SO), NT, DM, 512};
    pg8::StaticOrder S; S.init(NT, DM, gridDim.x, obid());
    EpiMerge2 E{(const bf16_t*)(P.ws + WS_F), (const bf16_t*)(P.ws + WS_C), (bf16_t*)(P.ws + WS_B)};
    pg8::gemm_phase<EpiMerge2, pg8::StaticOrder, true, true>((PG8_LAS unsigned char*)lds, g, S, E); }
}
struct EpiWout {
  static constexpr bool PERM = false, AFTER_DRAIN = false;
  const float* mod; const float* xin; float* out;
  DI void operator()(const f32x4 (&acc)[2][2][4][2], const pg8::Unit& u, int wr, int wc, int fr, int fq) const {
#pragma unroll
    for (int ai = 0; ai < 2; ++ai)
#pragma unroll
      for (int m = 0; m < 4; ++m) {
        const int row = u.pm * 256 + ai * 128 + wr * 64 + m * 16 + fr, b = row >> 13;
#pragma unroll
        for (int bj = 0; bj < 2; ++bj)
#pragma unroll
          for (int n = 0; n < 2; ++n) {
            const int col = u.pn * 256 + bj * 128 + wc * 32 + n * 16 + 4 * fq;
            const f32x4 g1 = *(const f32x4*)(mod + (size_t)b * 6144 + 2048 + col);
            const f32x4 xv = *(const f32x4*)(xin + (size_t)row * DM + col);
            *(f32x4*)(out + (size_t)row * DM + col) = xv + g1 * acc[ai][bj][m][n];
          }
      }
  }
};
DI void phase_wout8(const Params& P_, int l, unsigned char* lds) {
  Params P = P_; { size_t z_ = 0; asm volatile("" : "+s"(z_)); P.ws = P_.ws + z_; }
  pg8::Gemm g{(const bf16_t*)(P.ws + WS_B), (const bf16_t*)(P.ws + WS_W + W_OUT), NT, DM, DM};
  pg8::StaticOrder S; S.init(NT, DM, gridDim.x, obid());
  EpiWout E{(const float*)(P.ws + WS_MOD) + (size_t)(l * 2) * 6144, l == 0 ? P.in[0] : P.out, P.out};
  pg8::gemm_phase<EpiWout, pg8::StaticOrder, true, true>((PG8_LAS unsigned char*)lds, g, S, E);
}

DI bool moe_find(const int* cnt, int rb, int& e, int& rbl, int& ce) {
  int base = 0;
  for (int i = 0; i < NEXP; ++i) { const int c = cnt[i], nb = (c + 127) >> 7; if (rb < base + nb) { e = i; rbl = rb - base; ce = c; return true; } base += nb; }
  return false;
}
DI void phase_moe1(const Params& P_, int l, unsigned char* lds) {
  Params P = P_; { size_t z_ = 0; asm volatile("" : "+s"(z_)); P.ws = P_.ws + z_; }
  TILE_IDS;
  const int* cnt = (const int*)(P.ws + WS_CNT) + l * 32; const int* list = (const int*)(P.ws + WS_LIST);
  const bf16_t* h2 = (const bf16_t*)(P.ws + WS_A); bf16_t* act = (bf16_t*)(P.ws + WS_B);
  int total = 0; for (int i = 0; i < NEXP; ++i) total += (cnt[i] + 127) >> 7;
  for (int tile = bid; tile < total * 4; tile += gridDim.x) {
    const int rb = tile >> 2, ct = tile & 3; int e = 0, rbl = 0, ce = 1; moe_find(cnt, rb, e, rbl, ce);
    const bf16_t* wt = (const bf16_t*)(P.ws + WS_W + W_GU) + (size_t)e * 512 * 1024 + (size_t)(ct * 128) * 1024;
    const bf16_t* ap[2];
#pragma unroll
    for (int i = 0; i < 2; ++i) { int idx = rbl * 128 + lr + 64 * i; idx = idx < ce ? idx : ce - 1; const int tok = list[e * LISTCAP + idx] >> 1; ap[i] = h2 + (size_t)tok * DM + lk; }
    f32x4 acc[4][2]; ACC_ZERO(acc);
    gemm_kloop(lds, ap[0], ap[1], 64, wt + (size_t)lr * DM + lk, wt + (size_t)(lr + 64) * DM + lk, 16, acc);
#pragma unroll
    for (int m = 0; m < 4; ++m) {
      const int arow = rb * 128 + wr * 64 + m * 16 + fr, col = ct * 64 + wc * 16 + 4 * fq;
      const f32x4 g = acc[m][0], u = acc[m][1];
      u32x2 o; o.x = pk2(g.x * sigmoidf_(g.x) * u.x, g.y * sigmoidf_(g.y) * u.y); o.y = pk2(g.z * sigmoidf_(g.z) * u.z, g.w * sigmoidf_(g.w) * u.w);
      *(u32x2*)(act + (size_t)arow * 256 + col) = o;
    }
  }
}
DI void phase_moe2(const Params& P_, int l, unsigned char* lds) {
  Params P = P_; { size_t z_ = 0; asm volatile("" : "+s"(z_)); P.ws = P_.ws + z_; }
  TILE_IDS;
  const int* cnt = (const int*)(P.ws + WS_CNT) + l * 32; const int* list = (const int*)(P.ws + WS_LIST); const float* wts = (const float*)(P.ws + WS_WT);
  const bf16_t* act = (const bf16_t*)(P.ws + WS_B); bf16_t* ys = (bf16_t*)(P.ws + WS_F);
  constexpr int ASUB = 128 * GT_ROWB, BOFF = 4 * ASUB;
  int total = 0; for (int i = 0; i < NEXP; ++i) total += (cnt[i] + 127) >> 7;
  const int lkb = (tid & 7) * 16;
  for (int item = bid; item < total * 4; item += gridDim.x) {
    const int rb = item >> 2, ct0 = (item & 3) * 2; int e = 0, rbl = 0, ce = 1; moe_find(cnt, rb, e, rbl, ce);
    const bf16_t* wt = (const bf16_t*)(P.ws + WS_W + W_D) + (size_t)e * 1024 * 256;
    const bf16_t* a0 = act + (size_t)(rb * 128 + lr) * 256 + lk; const bf16_t* a1 = a0 + 64 * 256;
    u32x4 ra[8], xb0, xb1, yb0, yb1;
#pragma unroll
    for (int k = 0; k < 4; ++k) { ra[2 * k] = *(const u32x4*)(a0 + 64 * k); ra[2 * k + 1] = *(const u32x4*)(a1 + 64 * k); }
#define M2_BLOAD(q0_, q1_, s_) do { const bf16_t* bp_ = wt + (size_t)((ct0 + ((s_) >> 2)) * 128 + lr) * 256 + ((s_) & 3) * 64 + lk; q0_ = *(const u32x4*)bp_; q1_ = *(const u32x4*)(bp_ + 64 * 256); } while (0)
#define M2_BSTORE(q0_, q1_, buf_) do { unsigned char* s_ = lds + BOFF + (buf_) * ASUB; *(u32x4*)(s_ + lr * GT_ROWB + lkb) = q0_; *(u32x4*)(s_ + (lr + 64) * GT_ROWB + lkb) = q1_; } while (0)
#define M2_COMPUTE(s_, buf_) do { \
      const unsigned char* As = lds + ((s_) & 3) * ASUB + (wr * 64 + fr) * GT_ROWB + fq * 16; \
      const unsigned char* Bs = lds + BOFF + (buf_) * ASUB + (wc * 32 + fr) * GT_ROWB + fq * 16; \
      _Pragma("unroll") for (int ks = 0; ks < 2; ++ks) { \
        bf16x8 af[4], bfr[2]; \
        _Pragma("unroll") for (int m = 0; m < 4; ++m) af[m] = *(const bf16x8*)(As + m * 16 * GT_ROWB + ks * 64); \
        _Pragma("unroll") for (int n = 0; n < 2; ++n) bfr[n] = *(const bf16x8*)(Bs + n * 16 * GT_ROWB + ks * 64); \
        _Pragma("unroll") for (int m = 0; m < 4; ++m) _Pragma("unroll") for (int n = 0; n < 2; ++n) acc[m][n] = __builtin_amdgcn_mfma_f32_16x16x32_bf16(bfr[n], af[m], acc[m][n], 0, 0, 0); } } while (0)
#define M2_EPI(ct_) do { _Pragma("unroll") for (int m = 0; m < 4; ++m) { const int idx = rbl * 128 + wr * 64 + m * 16 + fr; \
      if (idx < ce) { const int slot = list[e * LISTCAP + idx]; const float w_ = wts[slot]; \
        _Pragma("unroll") for (int n = 0; n < 2; ++n) { const int col = (ct_) * 128 + wc * 32 + n * 16 + 4 * fq; const f32x4 v = acc[m][n] * w_; \
          u32x2 o; o.x = pk2(v.x, v.y); o.y = pk2(v.z, v.w); *(u32x2*)(ys + (size_t)slot * DM + col) = o; } } } ACC_ZERO(acc); } while (0)
    M2_BLOAD(xb0, xb1, 0);
#pragma unroll
    for (int k = 0; k < 4; ++k) { *(u32x4*)(lds + k * ASUB + lr * GT_ROWB + lkb) = ra[2 * k]; *(u32x4*)(lds + k * ASUB + (lr + 64) * GT_ROWB + lkb) = ra[2 * k + 1]; }
    M2_BSTORE(xb0, xb1, 0);
    M2_BLOAD(yb0, yb1, 1);
    __syncthreads();
    f32x4 acc[4][2]; ACC_ZERO(acc);
#pragma unroll 1
    for (int s2 = 0; s2 < 8; s2 += 2) {
      if (s2 + 2 < 8) M2_BLOAD(xb0, xb1, s2 + 2);
      M2_COMPUTE(s2, 0);
      M2_BSTORE(yb0, yb1, 1);
      __syncthreads();
      if (s2 + 3 < 8) M2_BLOAD(yb0, yb1, s2 + 3);
      M2_COMPUTE(s2 + 1, 1);
      if (s2 == 2) M2_EPI(ct0);
      if (s2 == 6) M2_EPI(ct0 + 1);
      if (s2 + 2 < 8) M2_BSTORE(xb0, xb1, 0);
      __syncthreads();
    }
#undef M2_BLOAD
#undef M2_BSTORE
#undef M2_COMPUTE
#undef M2_EPI
  }
}

typedef float f32x2v __attribute__((ext_vector_type(2)));
DI void phase_s5a(const Params& P_, int l, unsigned char* lds) {
  Params P = P_; { size_t z_ = 0; asm volatile("" : "+s"(z_)); P.ws = P_.ws + z_; }
  TILE_IDS;
  const bf16_t* ub = (const bf16_t*)(P.ws + WS_E); float* Lb = (float*)(P.ws + WS_L);
  const bf16_t* M1 = (const bf16_t*)(P.ws + WS_TAB + (size_t)l * TAB_LAYER + TAB_M1);
  const int first = (int)gridDim.x >= 192 ? 128 : 0;
  for (int tile = bid - first; tile >= 0 && tile < 64; tile += gridDim.x) {
    const int g = tile >> 1, rt = tile & 1;
    const bf16_t* a = ub + ((size_t)g * NT / 64 + rt * 128) * 1024;
    const bf16_t* wt = M1 + (size_t)g * 128 * 1024;
    f32x4 acc[4][2]; ACC_ZERO(acc);
    gemm_kloop(lds, a + (size_t)lr * 1024 + lk, a + (size_t)(lr + 64) * 1024 + lk, 64, wt + (size_t)lr * 1024 + lk, wt + (size_t)(lr + 64) * 1024 + lk, 16, acc);
#pragma unroll
    for (int m = 0; m < 4; ++m)
#pragma unroll
      for (int n = 0; n < 2; ++n) {
        const int R = rt * 128 + wr * 64 + m * 16 + fr, comp = wc * 32 + n * 16 + 4 * fq;
        *(f32x4*)(Lb + ((size_t)(R * 32 + g) * 64) * 2 + comp) = acc[m][n];
      }
  }
}
DI void s5_carry(const Params& P_, int l) {
  Params P = P_; { size_t z_ = 0; asm volatile("" : "+s"(z_)); P.ws = P_.ws + z_; }
  const int tid_ = otid(), bid = obid(), wave = tid_ >> 6, lane = tid_ & 63;
  const int item = (gridDim.x * NWAVE - 1) - (bid * NWAVE + wave);
  if (item >= NB * 32) return;
  const int b = item >> 5, g = item & 31;
  const float* pp = (const float*)(P.ws + WS_S5P) + (size_t)((l * 32 + g) * 64 + lane) * 36;
  const float aTr = pp[2], aTi = pp[3];
  float2* Lp = (float2*)(P.ws + WS_L) + ((size_t)(b * 128) * 32 + g) * 64 + lane;
  unsigned* Sp = (unsigned*)(P.ws + WS_SIN) + ((size_t)(g * 256 + b * 128)) * 64 + lane;
  float sr = 0.f, si = 0.f; asm volatile("" : "+v"(sr), "+v"(si));
  for (int c0 = 0; c0 < 128; c0 += 8) {
    float2 v[8];
#pragma unroll
    for (int k = 0; k < 8; ++k) v[k] = Lp[(size_t)(c0 + k) * 2048];
#pragma unroll
    for (int k = 0; k < 8; ++k) { Lp[(size_t)(c0 + k) * 2048] = make_float2(sr, si); Sp[(size_t)(c0 + k) * 64] = pk2(sr, si);
      const float nr = aTr * sr - aTi * si + v[k].x, ni = aTr * si + aTi * sr + v[k].y; sr = nr; si = ni; }
  }
}
DI void phase_s5c(const Params& P_, int l, unsigned char* lds) {
  Params P = P_; { size_t z_ = 0; asm volatile("" : "+s"(z_)); P.ws = P_.ws + z_; }
  TILE_IDS;
  const bf16_t* ub = (const bf16_t*)(P.ws + WS_E); const bf16_t* sinb = (const bf16_t*)(P.ws + WS_SIN); bf16_t* yb = (bf16_t*)(P.ws + WS_G);
  const bf16_t* tab = (const bf16_t*)(P.ws + WS_TAB + (size_t)l * TAB_LAYER);
  int* dctr = (int*)(P.ws + 640) + l; int* dslot = (int*)(lds + LDS_BYTES - 32);
  constexpr int ROWB = 144, SA = 0, SB = 128 * ROWB, STAGE = 2 * 128 * ROWB;
  const int lkb = (tid & 7) * 16, kch = tid & 7;
  for (;;) {
    if (threadIdx.x == 0) *dslot = atomicAdd(dctr, 1);
    __syncthreads();
    const int tile = *dslot;
    __syncthreads();
    if (tile >= 512) break;
    const int g = tile >> 4, rt = (tile >> 3) & 1, ct = tile & 7;
    const bf16_t* Kt = tab + TAB_KT / 2 + (size_t)g * 64 * 256; const bf16_t* M2 = tab + TAB_M2 / 2 + (size_t)g * 1024 * 128;
    const bf16_t* ua = ub + ((size_t)g * 256 + rt * 128) * 1024; const bf16_t* sa = sinb + ((size_t)g * 256 + rt * 128) * 128;
    const int nbt = 2 * ct + 2 < 16 ? 2 * ct + 2 : 16, ns = nbt + 2;
    u32x4 xa0, xa1, xb0, xb1, ya0, ya1, yb0, yb1;
#define S5_LOAD(p0_, p1_, q0_, q1_, s_) do { \
      if ((s_) < nbt) { p0_ = *(const u32x4*)(ua + (size_t)lr * 1024 + (s_) * 64 + lk); p1_ = *(const u32x4*)(ua + (size_t)(lr + 64) * 1024 + (s_) * 64 + lk); \
        const int i_ = 4 * (s_) + (kch >> 1), hq_ = (kch & 1) * 8; \
        { const int t_ = 8 * ct + (lr >> 4), h_ = lr & 15; q0_ = t_ >= i_ ? *(const u32x4*)(Kt + ((t_ - i_) * 16 + h_) * 16 + hq_) : (u32x4){0u, 0u, 0u, 0u}; } \
        { const int t_ = 8 * ct + 4 + (lr >> 4), h_ = lr & 15; q1_ = t_ >= i_ ? *(const u32x4*)(Kt + ((t_ - i_) * 16 + h_) * 16 + hq_) : (u32x4){0u, 0u, 0u, 0u}; } \
      } else { const int k0_ = ((s_) - nbt) * 64 + lk; \
        p0_ = *(const u32x4*)(sa + (size_t)lr * 128 + k0_); p1_ = *(const u32x4*)(sa + (size_t)(lr + 64) * 128 + k0_); \
        q0_ = *(const u32x4*)(M2 + (size_t)(ct * 128 + lr) * 128 + k0_); q1_ = *(const u32x4*)(M2 + (size_t)(ct * 128 + lr + 64) * 128 + k0_); } } while (0)
#define S5_STORE(p0_, p1_, q0_, q1_, buf) do { unsigned char* s_ = lds + (buf) * STAGE; \
      *(u32x4*)(s_ + SA + lr * ROWB + lkb) = p0_; *(u32x4*)(s_ + SA + (lr + 64) * ROWB + lkb) = p1_; \
      *(u32x4*)(s_ + SB + lr * ROWB + lkb) = q0_; *(u32x4*)(s_ + SB + (lr + 64) * ROWB + lkb) = q1_; } while (0)
#define S5_COMPUTE(buf) do { \
      const unsigned char* As = lds + (buf) * STAGE + SA + (wr * 64 + fr) * ROWB + fq * 16; \
      const unsigned char* Bs = lds + (buf) * STAGE + SB + (wc * 32 + fr) * ROWB + fq * 16; \
      _Pragma("unroll") for (int ks = 0; ks < 2; ++ks) { \
        bf16x8 af[4], bfr[2]; \
        _Pragma("unroll") for (int m = 0; m < 4; ++m) af[m] = *(const bf16x8*)(As + m * 16 * ROWB + ks * 64); \
        _Pragma("unroll") for (int n = 0; n < 2; ++n) bfr[n] = *(const bf16x8*)(Bs + n * 16 * ROWB + ks * 64); \
        _Pragma("unroll") for (int m = 0; m < 4; ++m) _Pragma("unroll") for (int n = 0; n < 2; ++n) acc[m][n] = __builtin_amdgcn_mfma_f32_16x16x32_bf16(bfr[n], af[m], acc[m][n], 0, 0, 0); } } while (0)
    f32x4 acc[4][2]; ACC_ZERO(acc);
    S5_LOAD(xa0, xa1, xb0, xb1, 0); S5_STORE(xa0, xa1, xb0, xb1, 0); S5_LOAD(ya0, ya1, yb0, yb1, 1); __syncthreads();
    for (int st = 0; st < ns; st += 2) {
      if (st + 2 < ns) S5_LOAD(xa0, xa1, xb0, xb1, st + 2);
      S5_COMPUTE(0);
      if (st + 1 < ns) S5_STORE(ya0, ya1, yb0, yb1, 1);
      __syncthreads();
      if (st + 1 >= ns) break;
      if (st + 3 < ns) S5_LOAD(ya0, ya1, yb0, yb1, st + 3);
      S5_COMPUTE(1);
      if (st + 2 < ns) S5_STORE(xa0, xa1, xb0, xb1, 0);
      __syncthreads();
    }
#undef S5_LOAD
#undef S5_STORE
#undef S5_COMPUTE
    const float* dsk = P.in[13] + (size_t)(l * 32 + g) * 16;
#pragma unroll
    for (int m = 0; m < 4; ++m)
#pragma unroll
      for (int n = 0; n < 2; ++n) {
        const int R = rt * 128 + wr * 64 + m * 16 + fr, col = ct * 128 + wc * 32 + n * 16 + 4 * fq, t = col >> 4, h = col & 15;
        const u32x2 uu = *(const u32x2*)(ub + ((size_t)g * 256 + R) * 1024 + col); const f32x4 dd = *(const f32x4*)(dsk + h); const f32x4 v = acc[m][n];
        const float y0 = gelu_tanh(v.x + dd.x * bflo(uu.x)), y1 = gelu_tanh(v.y + dd.y * bfhi(uu.x)), y2 = gelu_tanh(v.z + dd.z * bflo(uu.y)), y3 = gelu_tanh(v.w + dd.w * bfhi(uu.y));
        const size_t tokn = (size_t)(R >> 7) * SEQ + 64 * (R & 127) + t;
        u32x2 o; o.x = pk2(y0, y1); o.y = pk2(y2, y3); *(u32x2*)(yb + tokn * 512 + g * 16 + h) = o;
      }
  }
}

constexpr int AT_ROWB = 144, AT_KS = 0, AT_VS = 2 * 64 * AT_ROWB, AT_IMP = 4 * 64 * AT_ROWB, AT_OACC = AT_IMP, AT_IMPS = 129, AT_EE = AT_IMP + 64 * AT_IMPS * 4,
              AT_SEL = AT_IMP + 66048, AT_QS = AT_SEL + 1024, AT_QL = AT_QS + 32768, AT_NJ = AT_QL + 8192, AT_ITEMS = AT_NJ + 512, AT_MREF = AT_ITEMS + 512,
              AT_LACC = AT_MREF + 1024, AT_INVQ = AT_LACC + 1024, AT_MISC = AT_INVQ + 512, AT_LOWN = AT_MISC + 64, AT_END = AT_LOWN + 1024;
static_assert(AT_END <= LDS_BYTES - 16, "attention LDS");
#define MFMA32(a, b, c) __builtin_amdgcn_mfma_f32_32x32x16_bf16((a), (b), (c), 0, 0, 0)
DI int crow_of(int reg, int hh) { return (reg & 3) + 8 * (reg >> 2) + 4 * hh; }

struct AttnState { f32x16 o0, o1; float m, l; };
DI void st_init(AttnState& S) { S.m = -1e30f; S.l = 0.f;
#pragma unroll
  for (int i = 0; i < 16; ++i) { S.o0[i] = 0.f; S.o1[i] = 0.f; } }

DI void at_qk(const unsigned char* lds, int buf, int r, int hh, int qrow, f32x16& p0, f32x16& p1) {
  const unsigned char* kb = lds + AT_KS + buf * 64 * AT_ROWB + r * AT_ROWB + hh * 16;
  const unsigned char* qp = lds + AT_QS + qrow * 128;
  const f32x16 z = {0.f, 0.f, 0.f, 0.f, 0.f, 0.f, 0.f, 0.f, 0.f, 0.f, 0.f, 0.f, 0.f, 0.f, 0.f, 0.f};
#pragma unroll
  for (int ds = 0; ds < 4; ++ds) { const bf16x8 a0 = *(const bf16x8*)(kb + ds * 32), a1 = *(const bf16x8*)(kb + 32 * AT_ROWB + ds * 32);
    const bf16x8 q = *(const bf16x8*)(qp + (((ds * 2 + hh) ^ (qrow & 7)) * 16));
    if (ds == 0) { p0 = MFMA32(a0, q, z); p1 = MFMA32(a1, q, z); } else { p0 = MFMA32(a0, q, p0); p1 = MFMA32(a1, q, p1); }
    if (ds == 1) __builtin_amdgcn_sched_barrier(0); }
}
DI bf16x8 pack8(const f32x16& p, int s2) {
  u32x4 w; w.x = pk2(p[8 * s2], p[8 * s2 + 1]); w.y = pk2(p[8 * s2 + 2], p[8 * s2 + 3]); w.z = pk2(p[8 * s2 + 4], p[8 * s2 + 5]); w.w = pk2(p[8 * s2 + 6], p[8 * s2 + 7]);
  return __builtin_bit_cast(bf16x8, w);
}
DI void at_pv(const unsigned char* lds, int buf, int r, int hh, const f32x16& p0, const f32x16& p1, f32x16& oa, f32x16& ob) {
  const unsigned char* vb = lds + AT_VS + buf * 64 * AT_ROWB + r * AT_ROWB + hh * 16;
#pragma unroll
  for (int gk = 0; gk < 4; ++gk) {
    const bf16x8 pb = (gk < 2) ? pack8(p0, gk & 1) : pack8(p1, gk & 1);
    const bf16x8 va = *(const bf16x8*)(vb + gk * 32), vb2 = *(const bf16x8*)(vb + 32 * AT_ROWB + gk * 32);
    oa = MFMA32(va, pb, oa); ob = MFMA32(vb2, pb, ob);
    if (gk == 1) __builtin_amdgcn_sched_barrier(0);
  }
}
template <int MODE>
DI void at_online(AttnState& S, f32x16& p0, f32x16& p1, int key0, int lo, int hi, bool on, int hh) {
  float tm = -1e30f;
  if (MODE == 1) {
    int lor = lo - key0 - 4 * hh, hir = hi - key0 - 4 * hh;
    if (hir < lor) { lor = 4096; hir = 4096; }
    const unsigned span = (unsigned)(hir - lor);
#pragma unroll
    for (int i = 0; i < 16; ++i) { const int c0 = (i & 3) + 8 * (i >> 2);
      p0[i] = ((unsigned)(c0 - lor) <= span) ? p0[i] : -1e30f; p1[i] = ((unsigned)(c0 + 32 - lor) <= span) ? p1[i] : -1e30f; }
  }
  if (MODE != 1) asm volatile("s_nop 15\n\ts_nop 7" : "+v"(p0), "+v"(p1));
#pragma unroll
  for (int i = 0; i < 16; ++i) asm("v_max3_f32 %0, %0, %1, %2" : "+v"(tm) : "v"(p0[i]), "v"(p1[i]));
  tm = fmaxf(tm, __shfl_xor(tm, 32));
  if (MODE == 2) tm = on ? tm : -1e30f;
  if (__any(tm > S.m)) {
    const float mn = fmaxf(S.m, tm); const float al = __builtin_amdgcn_exp2f(S.m - mn); S.m = mn; S.l *= al;
#pragma unroll
    for (int i = 0; i < 16; ++i) { S.o0[i] *= al; S.o1[i] *= al; }
  }
  float mn = S.m;
  if (MODE == 2) mn = on ? mn : 1e30f;
  if (MODE == 1) mn = mn < -1e29f ? 1e30f : mn;
  float rs = 0.f;
#pragma unroll
  for (int i = 0; i < 16; ++i) {
    const float e0 = __builtin_amdgcn_exp2f(p0[i] - mn), e1 = __builtin_amdgcn_exp2f(p1[i] - mn);
    p0[i] = e0; p1[i] = e1; rs += e0 + e1;
  }
  S.l += rs;
}

DI void attn_tile(const Params& P_, unsigned char* lds, int b, int g, int c) {
  Params P = P_; { size_t z_ = 0; asm volatile("" : "+s"(z_)); P.ws = P_.ws + z_; }
#define AT_IDS const int tid = otid(), lane = tid & 63, w = tid >> 6, r = lane & 31, hh = lane >> 5, qi = 8 * w + (r >> 2), h = r & 3, t = 64 * c + qi, qrow = 32 * w + r, srow = tid >> 3, sch = (tid & 7) * 8, ahead = lane >> 4, ach = lane & 15; const unsigned tok = (unsigned)b * SEQ + t, goff = tok * 48 + g * 4 + h; (void)qi; (void)h; (void)t; (void)qrow; (void)srow; (void)sch; (void)ahead; (void)ach; (void)tok; (void)goff; (void)hh; (void)w; (void)r
  const bf16_t* qb = (const bf16_t*)(P.ws + WS_B); const bf16_t* kvk = (const bf16_t*)(P.ws + WS_C); const bf16_t* vT = (const bf16_t*)(P.ws + WS_DV);
  const bf16_t* kcb = (const bf16_t*)(P.ws + WS_KC); const bf16_t* vcb = (const bf16_t*)(P.ws + WS_VC);
  const float* gbase = (const float*)(P.ws + WS_GATES);
#define gates(i) gbase[goff + (i)]
  bf16_t* attn = (bf16_t*)(P.ws + WS_A);
  float* otb = (float*)(P.ws + WS_OT) + (size_t)obid() * 16384;
#define otg(i) otb[(unsigned)tid + (i) * 512u]
  float* IMP = (float*)(lds + AT_IMP); float* EE = (float*)(lds + AT_EE); unsigned* SEL = (unsigned*)(lds + AT_SEL);
  AttnState S; f32x16 p0, p1; u32x4 rkA, rvA;
  { AT_IDS;
  { const int row = tid >> 1, half = tid & 1, q_i = row >> 2, hd = row & 3;
    const unsigned so = ((unsigned)b * SEQ + 64 * c + q_i) * DM + (g * 4 + hd) * 64 + half * 32;
#pragma unroll
    for (int k = 0; k < 4; ++k) { const u32x4 v = *(const u32x4*)(qb + so + k * 8); *(u32x4*)(lds + AT_QS + row * 128 + (((half * 4 + k) ^ (row & 7)) * 16)) = v; } }
  __syncthreads();
#define ST_LOAD(rk, rv, kp, kstride, vp, vstride, kt) do { rk = *(const u32x4*)((kp) + (unsigned)(((kt) * 64 + srow) * (kstride) + sch)); rv = *(const u32x4*)((vp) + (unsigned)(srow * (vstride) + (kt) * 64 + sch)); } while (0)
#define ST_STORE(rk, rv, buf) do { *(u32x4*)(lds + AT_KS + (buf) * 64 * AT_ROWB + srow * AT_ROWB + sch * 2) = rk; *(u32x4*)(lds + AT_VS + (buf) * 64 * AT_ROWB + srow * AT_ROWB + sch * 2) = rv; } while (0)
#define SWEEP(kp, kstride, vp, vstride, kt0, n, ...) do { \
    ST_LOAD(rkA, rvA, kp, kstride, vp, vstride, (kt0)); ST_STORE(rkA, rvA, 0); __syncthreads(); \
    for (int i_ = 0; i_ < (n); ++i_) { \
      if (i_ + 1 < (n)) ST_LOAD(rkA, rvA, kp, kstride, vp, vstride, (kt0) + i_ + 1); \
      { const int step_ = i_; const int buf_ = i_ & 1; __VA_ARGS__ } \
      if (i_ + 1 < (n)) ST_STORE(rkA, rvA, (i_ + 1) & 1); \
      __syncthreads(); \
    } } while (0)
#define ST_LOADF(rk, rv, kt) do { rk = *(const u32x4*)(kps + (size_t)(kt) * 4096 + tid * 8); rv = *(const u32x4*)(vps + (size_t)(kt) * 4096 + tid * 8); } while (0)
#define ST_STOREF(rk, rv, buf) do { const int fo_ = ((tid >> 8) * 32 + (tid & 31)) * AT_ROWB + (((tid >> 6) & 3) * 2 + ((tid >> 5) & 1)) * 16; \
    *(u32x4*)(lds + AT_KS + (buf) * 64 * AT_ROWB + fo_) = rk; *(u32x4*)(lds + AT_VS + (buf) * 64 * AT_ROWB + fo_) = rv; } while (0)
#define SWEEPF(kt0, n, ...) do { \
    ST_LOADF(rkA, rvA, (kt0)); ST_STOREF(rkA, rvA, 0); __syncthreads(); \
    for (int i_ = 0; i_ < (n); ++i_) { \
      if (i_ + 1 < (n)) ST_LOADF(rkA, rvA, (kt0) + i_ + 1); \
      { const int step_ = i_; const int buf_ = i_ & 1; __VA_ARGS__ } \
      if (i_ + 1 < (n)) ST_STOREF(rkA, rvA, (i_ + 1) & 1); \
      __syncthreads(); \
    } } while (0)
  {
    const bf16_t* kp = kvk + (size_t)b * SEQ * DM + 3 * 256 + g * 64; const bf16_t* vp = vT + (size_t)(((1 * NB + b) * 4 + g) * 64) * SEQ;
    const int j0 = c >= 8 ? c - 8 : 0, nj = c - j0 + 1;
    st_init(S);
    SWEEP(kp, DM, vp, SEQ, j0, nj, {
      at_qk(lds, buf_, r, hh, qrow, p0, p1);
      at_online<1>(S, p0, p1, (j0 + step_) * 64, t - 511, t, true, hh);
      at_pv(lds, buf_, r, hh, p0, p1, S.o0, S.o1); });
    const float lt = S.l + __shfl_xor(S.l, 32); const float sc = lt > 0.f ? gates(32) / lt : 0.f;
#pragma unroll
    for (int i = 0; i < 16; ++i) { otg(i) = S.o0[i] * sc; otg(16 + i) = S.o1[i] * sc; }
  }
  {
    const bf16_t* kcp = kcb + (size_t)((b * 4 + g) * 512) * 64; const bf16_t* vcp = vcb + (size_t)((b * 4 + g) * 64) * 512;
    const int nmax = t >= 31 ? (t - 31) >> 4 : -1;
    const int nct = (4 * c + 2) / 64 + 1;
    st_init(S);
    SWEEP(kcp, 64, vcp, 512, 0, nct, {
      at_qk(lds, buf_, r, hh, qrow, p0, p1);
      at_online<1>(S, p0, p1, step_ * 64, 0, nmax, true, hh); });
    const float lt = S.l + __shfl_xor(S.l, 32);
    const float cinv = lt > 0.f ? 1.f / lt : 0.f; const float cm = S.m;
    st_init(S);
    SWEEP(kcp, 64, vcp, 512, 0, nct, {
      at_qk(lds, buf_, r, hh, qrow, p0, p1);
      const int nrel = nmax - step_ * 64 - 4 * hh;
      _Pragma("unroll") for (int k = 0; k < 16; ++k) { const int c0 = (k & 3) + 8 * (k >> 2), c1 = c0 + 32;
        p0[k] = c0 <= nrel ? __builtin_amdgcn_exp2f(p0[k] - cm) * cinv : 0.f; p1[k] = c1 <= nrel ? __builtin_amdgcn_exp2f(p1[k] - cm) * cinv : 0.f; }
      at_pv(lds, buf_, r, hh, p0, p1, S.o0, S.o1);
      _Pragma("unroll") for (int kh = 0; kh < 2; ++kh)
      _Pragma("unroll") for (int gi = 0; gi < 4; ++gi) {
          float g4 = kh == 0 ? (p0[4 * gi] + p0[4 * gi + 1]) + (p0[4 * gi + 2] + p0[4 * gi + 3]) : (p1[4 * gi] + p1[4 * gi + 1]) + (p1[4 * gi + 2] + p1[4 * gi + 3]);
          float e3 = kh == 0 ? p0[4 * gi + 3] : p1[4 * gi + 3];
          g4 += __shfl_xor(g4, 1); g4 += __shfl_xor(g4, 2); e3 += __shfl_xor(e3, 1); e3 += __shfl_xor(e3, 2);
          if (h == 0) { const int s = (step_ * 64 + kh * 32 + 8 * gi + 4 * hh) >> 2; IMP[qi * AT_IMPS + s] = g4; EE[qi * AT_IMPS + s] = e3; }
      } });
    const float gc = gates(0);
#pragma unroll
    for (int i = 0; i < 16; ++i) { otg(i) += S.o0[i] * gc; otg(16 + i) += S.o1[i] * gc; }
  }
  }
  const bf16_t* kps = (const bf16_t*)(P.ws + WS_KSF) + (size_t)((b * 4 + g) * 128) * 4096; const bf16_t* vps = vT + (size_t)((b * 4 + g) * 128) * 4096;
  if (c <= 15) { AT_IDS;
    st_init(S);
    if (c > 0) {
      SWEEPF(0, c, {
        at_qk(lds, buf_, r, hh, qrow, p0, p1);
        at_online<0>(S, p0, p1, 0, 0, 0, true, hh);
        at_pv(lds, buf_, r, hh, p0, p1, S.o0, S.o1); });
    }
    SWEEPF(c, 1, {
      at_qk(lds, buf_, r, hh, qrow, p0, p1);
      at_online<1>(S, p0, p1, (c + step_) * 64, 0, t, true, hh);
      at_pv(lds, buf_, r, hh, p0, p1, S.o0, S.o1); });
    const float lt = S.l + __shfl_xor(S.l, 32); const float slc_sc = lt > 0.f ? gates(16) / lt : 0.f;
    bf16_t* op = attn + (tok * DM + (g * 4 + h) * 64);
#pragma unroll
    for (int i = 0; i < 16; ++i) { S.o0[i] = S.o0[i] * slc_sc + otg(i); S.o1[i] = S.o1[i] * slc_sc + otg(16 + i); }
#pragma unroll
    for (int gi = 0; gi < 4; ++gi) {
      u32x2 a; a.x = pk2(S.o0[4 * gi], S.o0[4 * gi + 1]); a.y = pk2(S.o0[4 * gi + 2], S.o0[4 * gi + 3]);
      u32x2 bq; bq.x = pk2(S.o1[4 * gi], S.o1[4 * gi + 1]); bq.y = pk2(S.o1[4 * gi + 2], S.o1[4 * gi + 3]);
      *(u32x2*)(op + 8 * gi + 4 * hh) = a; *(u32x2*)(op + 32 + 8 * gi + 4 * hh) = bq;
    }
  } else {
    const int nc = c - 2;
    unsigned char* QL = lds + AT_QL; int* NJ = (int*)(lds + AT_NJ); unsigned short* ITEMS = (unsigned short*)(lds + AT_ITEMS); int* MISC = (int*)(lds + AT_MISC);
    float* MREF = (float*)(lds + AT_MREF); float* LS = (float*)(lds + AT_LACC); unsigned char* INVQ = lds + AT_INVQ; unsigned char* SLOT = lds + AT_IMP;
    float* const LOWN = (float*)(lds + AT_LOWN); const float k64 = 5.421010862427522e-20f;
    { AT_IDS;
    for (int idx = tid; idx < 64 * nc; idx += NTHR) { const int q = idx / nc, s = 1 + idx % nc; IMP[q * AT_IMPS + s] += EE[q * AT_IMPS + s - 1]; }
    if (tid < 256) SEL[tid] = 0u;
    if (tid < 128) ((unsigned*)INVQ)[tid] = 0u;
    __syncthreads();
    {
      const int q = tid >> 3, sub = tid & 7; const float* ip = IMP + q * AT_IMPS;
      unsigned key[16];
#pragma unroll
      for (int k = 0; k < 16; ++k) { const int s = 1 + sub + 8 * k; key[k] = s <= nc ? __float_as_uint(ip[s]) + 1u : 0u; }
      unsigned T = 0u;
      for (int bit = 30; bit >= 0; --bit) {
        const unsigned cand = T | (1u << bit); int cn = 0;
#pragma unroll
        for (int k = 0; k < 16; ++k) cn += key[k] >= cand ? 1 : 0;
        cn += __shfl_xor(cn, 1); cn += __shfl_xor(cn, 2); cn += __shfl_xor(cn, 4);
        if (cn >= 13) T = cand;
      }
      int ngt = 0, neq = 0;
#pragma unroll
      for (int k = 0; k < 16; ++k) { ngt += key[k] > T ? 1 : 0; neq += key[k] == T ? 1 : 0; }
      ngt += __shfl_xor(ngt, 1); ngt += __shfl_xor(ngt, 2); ngt += __shfl_xor(ngt, 4);
      neq += __shfl_xor(neq, 1); neq += __shfl_xor(neq, 2); neq += __shfl_xor(neq, 4);
      const int need = 13 - ngt;
      unsigned w0 = 0u, w1 = 0u, w2 = 0u, w3 = 0u;
      if (!__any(neq > need)) {
#pragma unroll
        for (int k = 0; k < 16; ++k) if (key[k] >= T && key[k] != 0u) { const int s = 1 + sub + 8 * k; const unsigned bt = 1u << (s & 31); if (s < 32) w0 |= bt; else if (s < 64) w1 |= bt; else if (s < 96) w2 |= bt; else w3 |= bt; }
      } else {
        int taken = 0; const int gsh = lane & ~7;
#pragma unroll
        for (int k = 0; k < 16; ++k) {
          const bool eq = key[k] == T && key[k] != 0u; const unsigned long long mk = __ballot(eq);
          const unsigned grp = (unsigned)(mk >> gsh) & 0xffu; const int before = __popc(grp & ((1u << sub) - 1u));
          const bool pick = key[k] > T || (eq && taken + before < need);
          taken += __popc(grp);
          if (pick) { const int s = 1 + sub + 8 * k; const unsigned bt = 1u << (s & 31); if (s < 32) w0 |= bt; else if (s < 64) w1 |= bt; else if (s < 96) w2 |= bt; else w3 |= bt; }
        }
      }
      if (w0) atomicOr(&SEL[q * 4], w0); if (w1) atomicOr(&SEL[q * 4 + 1], w1); if (w2) atomicOr(&SEL[q * 4 + 2], w2); if (w3) atomicOr(&SEL[q * 4 + 3], w3);
    }
    __syncthreads();
    for (int j = 1 + w; j <= nc; j += NWAVE) {
      const bool bit = (SEL[lane * 4 + (j >> 5)] >> (j & 31)) & 1u;
      const unsigned long long mk = __ballot(bit);
      const int rank = __builtin_amdgcn_mbcnt_hi((unsigned)(mk >> 32), __builtin_amdgcn_mbcnt_lo((unsigned)mk, 0u));
      if (bit) QL[j * 64 + rank] = (unsigned char)lane;
      const int cnt = __popcll(mk);
      if (lane < ((8 - (cnt & 7)) & 7)) QL[j * 64 + cnt + lane] = 0;
      if (lane == 0) NJ[j] = cnt;
    }
    __syncthreads();
    if (w == 0) {
      const int ja = 1 + lane, jb = 65 + lane;
      const int ca = ja <= nc ? (NJ[ja] + 7) >> 3 : 0, cb = jb <= nc ? (NJ[jb] + 7) >> 3 : 0;
      int sa = ca, sb = cb;
#pragma unroll
      for (int o = 1; o < 64; o <<= 1) { const int ta = __shfl_up(sa, o), tb = __shfl_up(sb, o); if (lane >= o) { sa += ta; sb += tb; } }
      const int tota = __shfl(sa, 63);
      for (int k = 0; k < ca; ++k) ITEMS[sa - ca + k] = (unsigned short)(ja * 8 + k);
      for (int k = 0; k < cb; ++k) ITEMS[tota + sb - cb + k] = (unsigned short)(jb * 8 + k);
      if (lane == 63) MISC[0] = tota + sb;
    }
    }
    { AT_IDS;
    st_init(S);
    SWEEPF(0, 1, {
      at_qk(lds, buf_, r, hh, qrow, p0, p1);
      at_online<0>(S, p0, p1, 0, 0, 0, true, hh);
      at_pv(lds, buf_, r, hh, p0, p1, S.o0, S.o1); });
    SWEEPF(c - 1, 2, {
      at_qk(lds, buf_, r, hh, qrow, p0, p1);
      if (step_ == 1) at_online<1>(S, p0, p1, c * 64, 0, t, true, hh); else at_online<0>(S, p0, p1, 0, 0, 0, true, hh);
      at_pv(lds, buf_, r, hh, p0, p1, S.o0, S.o1); });
    { const float lt = S.l + __shfl_xor(S.l, 32);
      if (hh == 0) { MREF[qrow] = S.m + 64.f; LS[w * 32 + r] = lt * k64; } }
#define SLOT_WRITE(x, o0_, o1_, scale_) do { unsigned char* sp_ = SLOT + (x) * 8192 + r * 256; \
      _Pragma("unroll") for (int gi_ = 0; gi_ < 4; ++gi_) { \
        const f32x4 va_ = {o0_[4 * gi_] * (scale_), o0_[4 * gi_ + 1] * (scale_), o0_[4 * gi_ + 2] * (scale_), o0_[4 * gi_ + 3] * (scale_)}; \
        const f32x4 vb_ = {o1_[4 * gi_] * (scale_), o1_[4 * gi_ + 1] * (scale_), o1_[4 * gi_ + 2] * (scale_), o1_[4 * gi_ + 3] * (scale_)}; \
        *(f32x4*)(sp_ + (((2 * gi_ + hh) ^ (r & 15)) * 16)) = va_; *(f32x4*)(sp_ + (((8 + 2 * gi_ + hh) ^ (r & 15)) * 16)) = vb_; } } while (0)
#define SLOT_READ(x, col_) (*(const f32x4*)(SLOT + (x) * 8192 + (col_) * 256 + ((ach ^ ((col_) & 15)) * 16)))
    SLOT_WRITE(w, S.o0, S.o1, k64);
    __syncthreads();
    }
    {
      AT_IDS; const int wu = __builtin_amdgcn_readfirstlane(w);
      const int nitems = MISC[0], nrounds = (nitems + 3) >> 2;
      if (wu >= 4) {
        const int ow = wu - 4, oq = lane >> 2, oh = lane & 3, srcslot = 2 * ow + (lane >> 5), scol = lane & 31;
        f32x4 acc[16]; float accl;
        { const unsigned char* rp = SLOT + srcslot * 8192 + scol * 256;
#pragma unroll
          for (int k = 0; k < 16; ++k) acc[k] = *(const f32x4*)(rp + ((k ^ (scol & 15)) * 16));
          accl = LS[srcslot * 32 + scol]; }
        __syncthreads();
        for (int rd = 0; rd <= nrounds; ++rd) {
          if (rd > 0) {
            const int set = (rd - 1) & 1;
            unsigned* ivp = (unsigned*)(INVQ + set * 256) + 16 * ow + oq;
            unsigned iv = *ivp;
            if (__any(iv != 0u)) {
              if (iv != 0u && oh == 0) *ivp = 0u;
              do {
                const int x = (iv & 0xffu) ? 0 : (iv & 0xff00u) ? 1 : (iv & 0xff0000u) ? 2 : 3;
                const unsigned byte = (iv >> (8 * x)) & 0xffu;
                iv &= ~(0xffu << (8 * x));
                if (byte) {
                  const int col = (int)(byte - 1) * 4 + oh;
                  const unsigned char* rp = SLOT + (set * 4 + x) * 8192 + col * 256;
#pragma unroll
                  for (int k = 0; k < 16; ++k) acc[k] += *(const f32x4*)(rp + ((k ^ (col & 15)) * 16));
                  accl += LS[(set * 4 + x) * 32 + col];
                }
              } while (__any(iv != 0u));
            }
          }
          __syncthreads();
        }
#pragma unroll
        for (int i = 0; i < 16; ++i) { S.o0[i] = otg(i); S.o1[i] = otg(16 + i); }
        SLOT_WRITE(w, S.o0, S.o1, 1.0f);
        __syncthreads();
        {
          const unsigned tq = (unsigned)b * SEQ + 64 * c + 16 * ow + oq;
          const float gs = gbase[tq * 48 + 16 + g * 4 + oh]; const float sc = accl > 0.f ? gs / accl : 0.f;
          const unsigned char* rp = SLOT + srcslot * 8192 + scol * 256;
          bf16_t* op = attn + (tq * DM + (g * 4 + oh) * 64);
#pragma unroll
          for (int k2 = 0; k2 < 8; ++k2) {
            const f32x4 v0 = acc[2 * k2] * sc + *(const f32x4*)(rp + (((2 * k2) ^ (scol & 15)) * 16)), v1 = acc[2 * k2 + 1] * sc + *(const f32x4*)(rp + (((2 * k2 + 1) ^ (scol & 15)) * 16));
            u32x4 o; o.x = pk2(v0.x, v0.y); o.y = pk2(v0.z, v0.w); o.z = pk2(v1.x, v1.y); o.w = pk2(v1.z, v1.w);
            *(u32x4*)(op + 8 * k2) = o;
          }
        }
      } else {
        __syncthreads();
        const bf16_t* kgl = kps + lane * 8; const bf16_t* vgl = vps + lane * 8;
        bf16x8 kfA[8], vfA[8], kfB[8], vfB[8];
#define FLOAD(KF, VF, jj) do { _Pragma("unroll") for (int f_ = 0; f_ < 8; ++f_) { KF[f_] = *(const bf16x8*)(kgl + (size_t)(jj) * 4096 + f_ * 512); VF[f_] = *(const bf16x8*)(vgl + (size_t)(jj) * 4096 + f_ * 512); } } while (0)
        int rowc = 0, qqc = 0; bool validc = false; float mrc = 1e30f; int en = 0;
        if (wu < nitems) { const int e0 = ITEMS[wu]; const int j0_ = e0 >> 3; const int qs_ = 8 * (e0 & 7) + (r >> 2); validc = qs_ < NJ[j0_]; qqc = QL[j0_ * 64 + qs_]; rowc = qqc * 4 + h; mrc = validc ? MREF[rowc] : 1e30f; FLOAD(kfA, vfA, j0_); }
        if (wu + 4 < nitems) en = __builtin_amdgcn_readfirstlane(ITEMS[wu + 4]);
        FLOAD(kfB, vfB, en >> 3);
#define ITEM_ROUND(KF, VF, rd_) do { \
          const int it = (rd_) * 4 + wu, set = (rd_) & 1; \
          if (it < nitems) { \
            const bool hasn = it + 4 < nitems; \
            const int jn = en >> 3, qsn = 8 * (en & 7) + (r >> 2);        \
            const int njn = NJ[jn]; const int qqn = QL[jn * 64 + qsn]; \
            const int en2 = it + 8 < nitems ? __builtin_amdgcn_readfirstlane(ITEMS[it + 8]) : 0; const int j2 = en2 >> 3; \
            const f32x16 z = {0.f, 0.f, 0.f, 0.f, 0.f, 0.f, 0.f, 0.f, 0.f, 0.f, 0.f, 0.f, 0.f, 0.f, 0.f, 0.f}; \
            _Pragma("unroll") for (int ds = 0; ds < 4; ++ds) { \
              const bf16x8 qv = *(const bf16x8*)(lds + AT_QS + rowc * 128 + (((ds * 2 + hh) ^ (rowc & 7)) * 16)); \
              if (ds == 0) { p0 = MFMA32(KF[0], qv, z); p1 = MFMA32(KF[4], qv, z); } else { p0 = MFMA32(KF[ds], qv, p0); p1 = MFMA32(KF[4 + ds], qv, p1); } \
            } \
            const bool validn = hasn && qsn < njn; const int rown = qqn * 4 + h; \
            const float mrn = validn ? MREF[rown] : 1e30f; \
            float rs = 0.f; \
            _Pragma("unroll") for (int i = 0; i < 16; ++i) { \
              p0[i] = __builtin_amdgcn_exp2f(fminf(p0[i] - mrc, 120.f)); p1[i] = __builtin_amdgcn_exp2f(fminf(p1[i] - mrc, 120.f)); rs += p0[i] + p1[i]; \
              if (i & 1) { KF[i >> 1] = *(const bf16x8*)(kgl + (size_t)j2 * 4096 + (i >> 1) * 512); __builtin_amdgcn_sched_barrier(0); } \
            } \
            rs += __shfl_xor(rs, 32); \
            f32x16 o0 = z, o1 = z; \
            _Pragma("unroll") for (int gk = 0; gk < 4; ++gk) { const bf16x8 pb = (gk < 2) ? pack8(p0, gk & 1) : pack8(p1, gk & 1); o0 = MFMA32(VF[gk], pb, o0); o1 = MFMA32(VF[4 + gk], pb, o1); } \
            { unsigned char* sp_ = SLOT + (set * 4 + wu) * 8192 + r * 256; \
              _Pragma("unroll") for (int gi = 0; gi < 4; ++gi) { \
                const f32x4 va_ = {o0[4 * gi], o0[4 * gi + 1], o0[4 * gi + 2], o0[4 * gi + 3]}; const f32x4 vb_ = {o1[4 * gi], o1[4 * gi + 1], o1[4 * gi + 2], o1[4 * gi + 3]}; \
                *(f32x4*)(sp_ + (((2 * gi + hh) ^ (r & 15)) * 16)) = va_; *(f32x4*)(sp_ + (((8 + 2 * gi + hh) ^ (r & 15)) * 16)) = vb_; \
                VF[2 * gi] = *(const bf16x8*)(vgl + (size_t)j2 * 4096 + (2 * gi) * 512); VF[2 * gi + 1] = *(const bf16x8*)(vgl + (size_t)j2 * 4096 + (2 * gi + 1) * 512); \
                __builtin_amdgcn_sched_barrier(0); \
              } } \
            if (hh == 0) LS[(set * 4 + wu) * 32 + r] = rs; \
            if (validc && h == 0 && hh == 0) INVQ[set * 256 + qqc * 4 + wu] = (unsigned char)((r >> 2) + 1); \
            rowc = rown; qqc = qqn; validc = validn; mrc = mrn; en = en2; \
          } } while (0)
        for (int rd = 0; rd < nrounds; rd += 2) {
          ITEM_ROUND(kfA, vfA, rd);
          __syncthreads();
          if (rd + 1 < nrounds) {
            ITEM_ROUND(kfB, vfB, rd + 1);
            __syncthreads();
          }
        }
#undef ITEM_ROUND
#undef FLOAD
#undef ITEM_META
#undef KLOAD
#undef VLOAD
        __syncthreads();
#pragma unroll
        for (int i = 0; i < 16; ++i) { S.o0[i] = otg(i); S.o1[i] = otg(16 + i); }
        SLOT_WRITE(w, S.o0, S.o1, 1.0f);
        __syncthreads();
      }
    }
#undef SLOT_WRITE
#undef SLOT_READ
  }
  __syncthreads();
#undef ST_LOAD
#undef ST_STORE
#undef SWEEP
#undef ST_LOADF
#undef ST_STOREF
#undef SWEEPF
#undef gates
#undef otg
#undef AT_IDS
}
DI void phase_attn(const Params& P_, unsigned char* lds) {
  Params P = P_; { size_t z_ = 0; asm volatile("" : "+s"(z_)); P.ws = P_.ws + z_; }
  const int G = gridDim.x, bx = obid();
  const int vcu = (G % 8 == 0) ? (bx % 8) * (G / 8) + bx / 8 : bx;
  for (int idx = vcu; idx < 1024; idx += G) {
    const int i = idx >> 8, v = idx & 255, bg = v >> 5, s = v & 31;
    const int c = i == 0 ? s : i == 1 ? 63 - s : i == 2 ? 64 + s : 127 - s;
    attn_tile(P, lds, bg >> 2, bg & 3, c);
  }
}


#define LAS __attribute__((address_space(3)))
#define XB_TMO      128
#define XB_XCNT(j)  (256  + 64 * (j))
#define XB_XSUB(j)  (1280 + 64 * (j))
#define XB_XGEN(j)  (2304 + 64 * (j))
#define XB_TOP      3328
#define XB_TOPGEN   3392
#define XCD_BAR_WORDS 3456
#define XB_SPIN_CAP (1u << 18)
__device__ __forceinline__ unsigned xb_ld(unsigned* p)              { return __hip_atomic_load(p, __ATOMIC_RELAXED, __HIP_MEMORY_SCOPE_AGENT); }
__device__ __forceinline__ unsigned xb_add(unsigned* p, unsigned v) { return __hip_atomic_fetch_add(p, v, __ATOMIC_RELAXED, __HIP_MEMORY_SCOPE_AGENT); }
__device__ __forceinline__ unsigned xb_xcc_id() { return (unsigned)__builtin_amdgcn_s_getreg((3 << 11) | 20) & 0xFu; }
#define XB_SPIN(cond, bar) do { unsigned _sp = 0; while (cond) { __builtin_amdgcn_s_sleep(1); \
    if ((++_sp & 255u) == 0u) { if (xb_ld(&(bar)[XB_TMO])) break; if (_sp > XB_SPIN_CAP) { atomicAdd(&(bar)[XB_TMO], 1u); break; } } } } while (0)
struct XcdBarrier { unsigned* bar; unsigned x; volatile LAS unsigned* st; };
__device__ __forceinline__ XcdBarrier xcd_barrier_post(unsigned* bar, volatile LAS unsigned* st) {
    XcdBarrier b; b.bar = bar; b.x = xb_xcc_id(); b.st = st;
    if (threadIdx.x == 0) (void)xb_add(&bar[XB_XCNT(b.x)], 1u);
    return b;
}
__device__ __forceinline__ void xcd_barrier_complete(unsigned* bar, unsigned x, unsigned& nloc, unsigned& nx) {
    const unsigned G = gridDim.x * gridDim.y * gridDim.z;
    unsigned sum, cnt, mine, sp = 0u;
    for (;;) {
        sum = 0u; cnt = 0u; mine = 0u;
#pragma unroll
        for (unsigned j = 0; j < 16; ++j) { const unsigned c = xb_ld(&bar[XB_XCNT(j)]); sum += c; cnt += (c > 0u) ? 1u : 0u; mine = (j == x) ? c : mine; }
        if (sum == G) break;
        __builtin_amdgcn_s_sleep(1);
        if ((++sp & 255u) == 0u) { if (xb_ld(&bar[XB_TMO])) break; if (sp > XB_SPIN_CAP) { atomicAdd(&bar[XB_TMO], 1u); break; } }
    }
    nloc = mine > 0u ? mine : 1u; nx = cnt > 0u ? cnt : 1u;
}
__device__ __forceinline__ void xcd_barrier(const XcdBarrier& b) {
    asm volatile("s_waitcnt vmcnt(0)" ::: "memory");
    __syncthreads();
    if (threadIdx.x == 0) {
        unsigned* bar = b.bar; { size_t z_ = 0; asm volatile("" : "+s"(z_)); bar += z_; }
        __builtin_amdgcn_s_waitcnt(0);
        unsigned nloc = b.st[0], nx = b.st[1];
        if (nloc == 0u) { xcd_barrier_complete(bar, b.x, nloc, nx); b.st[0] = nloc; b.st[1] = nx; }
        const unsigned old = xb_add(&bar[XB_XSUB(b.x)], 1u);
        const unsigned gen = old / nloc;
        if (old + 1u == (gen + 1u) * nloc) {
            __builtin_amdgcn_fence(__ATOMIC_RELEASE, "agent");
            asm volatile("s_waitcnt vmcnt(0)" ::: "memory");
            const unsigned og = xb_add(&bar[XB_TOP], 1u);
            const unsigned tg = og / nx;
            if (og + 1u == (tg + 1u) * nx) xb_add(&bar[XB_TOPGEN], 1u);
            else XB_SPIN(xb_ld(&bar[XB_TOPGEN]) == tg, bar);
            __builtin_amdgcn_fence(__ATOMIC_ACQUIRE, "agent");
            xb_add(&bar[XB_XGEN(b.x)], 1u);
            asm volatile("s_waitcnt vmcnt(0)" ::: "memory");
        } else {
            XB_SPIN(xb_ld(&bar[XB_XGEN(b.x)]) == gen, bar);
            __builtin_amdgcn_fence(__ATOMIC_ACQUIRE, "agent");
            asm volatile("s_waitcnt vmcnt(0)" ::: "memory");
        }
    }
    __syncthreads();
}

__global__ void __launch_bounds__(NTHR) fwd_kernel(Params P) {
  extern __shared__ __attribute__((aligned(16))) unsigned char lds[];
  cg::grid_group grid = cg::this_grid();
  const int gtid = blockIdx.x * NTHR + threadIdx.x;
  if (threadIdx.x < 4) ((unsigned*)(lds + LDS_BYTES - 16))[threadIdx.x] = 0u;
  __syncthreads();
  const XcdBarrier xbar = xcd_barrier_post((unsigned*)(P.ws + WS_BAR), (volatile LAS unsigned*)(lds + LDS_BYTES - 16));
#define GSYNC() xcd_barrier(xbar)
  s5_params(P, gtid);
  {
    float* modb = (float*)(P.ws + WS_MOD); float* cbb = (float*)(P.ws + WS_CB);
    for (int it = blockIdx.x; it < 192 + 16; it += gridDim.x) {
      if (it < 192) { const int l = it / 96, j0 = (it % 96) * 64;
        gemv_item((float*)lds, P.in[2] + (size_t)l * DM * 6144, DM, 6144, j0, P.in[1], P.in[1] + DM, true, P.in[3] + l * 6144, modb + (size_t)(l * 2) * 6144, modb + (size_t)(l * 2 + 1) * 6144);
      } else { const int r = it - 192, l = r >> 3, kv = (r >> 2) & 1, j0 = (r & 3) * 64;
        gemv_item((float*)lds, P.in[17] + (size_t)(l * 2 + kv) * 2048 * 256, 2048, 256, j0, P.in[16] + (size_t)(l * 2 + kv) * 2048, nullptr, false, nullptr, cbb + (l * 2 + kv) * 256, nullptr);
      }
    }
  }
  for (int it = blockIdx.x; it < DEPTH * 32 * 6; it += gridDim.x) s5_tables(P, it / 192, (it % 192) / 6, it % 6, lds);
  convert_weights(P, 0, lds);
  grid.sync();
  for (int l = 0; l < DEPTH; ++l) {
    if (l == 0) norm_simple<0>(P, l); else { norm_simple<1>(P, l); convert_weights(P, 1, lds); }
    GSYNC();
#if EN_MIXER
    phase_inproj8(P, lds);
    GSYNC();
    phase_s5a(P, l, lds);
    __syncthreads();
#if EN_ATTN
    phase_gates(P, lds);
    __syncthreads();
    phase_cmp1(P, l, lds);
#endif
    GSYNC();
    s5_carry(P, l);
#if EN_ATTN
    phase_cmp2(P, lds);
#endif
    GSYNC();
#if EN_ATTN
    phase_attn(P, lds);
    __syncthreads();
#endif
    phase_s5c(P, l, lds);
    GSYNC();
    phase_glu(P, lds);
    GSYNC();
    phase_merge8(P, lds);
    GSYNC();
    phase_wout8(P, l, lds);
    GSYNC();
#else
    if (l == 0) { for (size_t i = (size_t)gtid * 4; i < (size_t)NT * DM; i += (size_t)gridDim.x * NTHR * 4) *(f32x4*)(P.out + i) = *(const f32x4*)(P.in[0] + i); GSYNC(); }
#endif
#if EN_MOE
    norm_route(P, l, lds);
    GSYNC();
    phase_moe1(P, l, lds);
    GSYNC();
    phase_moe2(P, l, lds);
    GSYNC();
#endif
  }
  norm_simple<3>(P, 0);
}

extern "C" void kernel_launch(void* const* d_in, const int* in_sizes, int n_in, void* d_out, int out_size, void* d_ws, size_t ws_size, hipStream_t stream) {
  static int grid = 0;
  if (grid == 0) {
    if (n_in != 30 || out_size != NT * DM || ws_size < WS_END2) { fprintf(stderr, "kernel_launch: unexpected shapes (n_in %d out %d ws %zu need %zu)\n", n_in, out_size, ws_size, (size_t)WS_END2); grid = -1; return; }
    int dev = 0, cus = 0, per_cu = 0;
    hipGetDevice(&dev);
    hipDeviceGetAttribute(&cus, hipDeviceAttributeMultiprocessorCount, dev);
    hipFuncSetAttribute((const void*)fwd_kernel, hipFuncAttributeMaxDynamicSharedMemorySize, LDS_BYTES);
    hipOccupancyMaxActiveBlocksPerMultiprocessor(&per_cu, (const void*)fwd_kernel, NTHR, LDS_BYTES);
    if (per_cu < 1) { fprintf(stderr, "kernel_launch: occupancy query says %d blocks/CU\n", per_cu); per_cu = 1; }
    grid = cus;
    (void)hipGetLastError();
  }
  if (grid < 0) return;
  Params p{};
  for (int i = 0; i < 30; ++i) p.in[i] = (const float*)d_in[i];
  p.out = (float*)d_out; p.ws = (unsigned char*)d_ws;
  if (hipMemsetAsync(p.ws, 0, WS_ZERO_BYTES, stream) != hipSuccess) { fprintf(stderr, "kernel_launch: memset failed\n"); return; }
  void* args[] = {&p};
  hipError_t e = hipLaunchCooperativeKernel((const void*)fwd_kernel, dim3(grid), dim3(NTHR), args, LDS_BYTES, stream);
  if (e != hipSuccess) fprintf(stderr, "cooperative launch failed: %s (grid %d)\n", hipGetErrorString(e), grid);
}
```

```cpp
#include <hip/hip_runtime.h>
#include <hip/hip_cooperative_groups.h>
#include <cstdio>
#include <cstdint>
namespace cg = cooperative_groups;

#ifndef EN_MIXER
#define EN_MIXER 1
#endif
#ifndef EN_ATTN
#define EN_ATTN 1
#endif
#ifndef EN_MOE
#define EN_MOE 1
#endif

#define DI __device__ __forceinline__
typedef unsigned short bf16_t;
typedef short bf16x8 __attribute__((ext_vector_type(8)));
typedef short s16x4 __attribute__((ext_vector_type(4)));
typedef float f32x4 __attribute__((ext_vector_type(4)));
typedef float f32x16 __attribute__((ext_vector_type(16)));
typedef unsigned u32x4 __attribute__((ext_vector_type(4)));
typedef unsigned u32x2 __attribute__((ext_vector_type(2)));

constexpr int DM = 1024, NB = 2, SEQ = 8192, NT = NB * SEQ, DEPTH = 2;
constexpr int INW = 5168, INWP = 5376;
constexpr int NTHR = 512, NWAVE = 8;
constexpr int NEXP = 32, LISTCAP = 16384;
constexpr float EPS = 1e-6f;
constexpr float QSCALE = 0.125f * 1.4426950408889634f;

constexpr size_t MiB = 1u << 20;
constexpr size_t WS_CNT = 0;
constexpr size_t WS_BAR = 1024;
constexpr size_t WS_ZERO_BYTES = 16384;
constexpr size_t WS_MOD = 16384;
constexpr size_t WS_CB = WS_MOD + 2 * 2 * 6144 * 4;
constexpr size_t WS_S5P = WS_CB + 2 * 2 * 256 * 4;
constexpr size_t WS_WT = WS_S5P + 2 * 32 * 64 * 36 * 4;
constexpr size_t WS_SMALL_END = WS_WT + (size_t)NT * 2 * 4;
static_assert(WS_SMALL_END <= 1 * MiB, "small region");
constexpr size_t WS_W = 1 * MiB;
constexpr size_t W_IN = 0;
constexpr size_t W_GLU = W_IN + (size_t)INWP * 1024 * 2;
constexpr size_t W_O = W_GLU + 512 * 512 * 2;
constexpr size_t W_SO = W_O + 1024 * 1024 * 2;
constexpr size_t W_OUT = W_SO + 1024 * 512 * 2;
constexpr size_t W_C1 = W_OUT + 1024 * 1024 * 2;
constexpr size_t W_C2 = W_C1 + 2 * 256 * 2048 * 2;
constexpr size_t W_GU = W_C2 + 2 * 128 * 256 * 2;
constexpr size_t W_D = W_GU + (size_t)32 * 512 * 1024 * 2;
constexpr size_t W_END = W_D + (size_t)32 * 1024 * 256 * 2;
static_assert(W_END <= 67 * MiB, "weights region");
constexpr size_t WS_A = 68 * MiB;
constexpr size_t WS_B = WS_A + 32 * MiB;
constexpr size_t WS_C = WS_B + 32 * MiB;
constexpr size_t WS_DV = WS_C + 32 * MiB;
constexpr size_t WS_E = WS_DV + 16 * MiB;
constexpr size_t WS_F = WS_E + 32 * MiB;
constexpr size_t WS_G = WS_F + 64 * MiB;
constexpr size_t WS_GATES = WS_G + 16 * MiB;
constexpr size_t WS_HID = WS_GATES + 3 * MiB;
constexpr size_t WS_KC = WS_HID + 4 * MiB;
constexpr size_t WS_VC = WS_KC + 512 * 1024;
constexpr size_t WS_L = WS_VC + 512 * 1024;
constexpr size_t WS_LIST = WS_L + 4 * MiB;
constexpr size_t WS_OT = WS_LIST + 2 * MiB;
constexpr size_t WS_TAB = WS_OT + 16 * MiB;
constexpr size_t TAB_KT = 0, TAB_M1 = 1 * MiB, TAB_M2 = 9 * MiB, TAB_LAYER = 17 * MiB;
constexpr size_t WS_END = WS_TAB + 2 * TAB_LAYER;
constexpr size_t WS_KSF = WS_END;
constexpr size_t WS_END2 = WS_KSF + 8 * MiB;
constexpr size_t WS_SIN = WS_E + 16 * MiB;
constexpr int LDS_BYTES = 151552;

struct Params { const float* in[30]; float* out; unsigned char* ws; };

DI int otid() { int t = threadIdx.x; asm volatile("" : "+v"(t)); return t; }
DI int obid() { int t = blockIdx.x; asm volatile("" : "+s"(t)); return t; }
DI unsigned f2bf(float f) { unsigned u = __float_as_uint(f); return (u + 0x7fffu + ((u >> 16) & 1u)) >> 16; }
typedef float f32x2_t __attribute__((ext_vector_type(2))); typedef __bf16 bf16x2_t __attribute__((ext_vector_type(2)));
DI unsigned pk2(float lo, float hi) { const f32x2_t v = {lo, hi}; const bf16x2_t b = __builtin_convertvector(v, bf16x2_t); return __builtin_bit_cast(unsigned, b); }
DI float bflo(unsigned w) { return __uint_as_float(w << 16); }
DI float bfhi(unsigned w) { return __uint_as_float(w & 0xffff0000u); }
DI int perm16(int x) { return (x & ~12) | ((x & 4) << 1) | ((x & 8) >> 1); }
DI float wave_sum(float v) {
#pragma unroll
  for (int o = 1; o < 64; o <<= 1) v += __shfl_xor(v, o);
  return v;
}
DI float sigmoidf_(float x) { return 1.f / (1.f + __expf(-x)); }
DI float gelu_tanh(float x) {
  const float z = 0.7978845608028654f * (x + 0.044715f * x * x * x);
  const float e = __expf(2.f * z);
  const float th = 1.f - 2.f / (e + 1.f);
  return 0.5f * x * (1.f + th);
}
DI void sincos_d(double x, double& s, double& c) {
  const double k = rint(x * 0.6366197723675814);
  double r = fma(-k, 1.5707963267948966, x);
  r = fma(-k, 6.123233995736766e-17, r);
  const int q = ((int)k) & 3;
  const double r2 = r * r;
  const double sp = r * (1.0 + r2 * (-1.0 / 6 + r2 * (1.0 / 120 + r2 * (-1.0 / 5040 + r2 * (1.0 / 362880 + r2 * (-1.0 / 39916800 + r2 * (1.0 / 6227020800.0)))))));
  const double cp = 1.0 + r2 * (-0.5 + r2 * (1.0 / 24 + r2 * (-1.0 / 720 + r2 * (1.0 / 40320 + r2 * (-1.0 / 3628800 + r2 * (1.0 / 479001600 + r2 * (-1.0 / 87178291200.0)))))));
  s = (q == 0) ? sp : (q == 1) ? cp : (q == 2) ? -sp : -cp;
  c = (q == 0) ? cp : (q == 1) ? -sp : (q == 2) ? -cp : sp;
}

DI void gemv_item(float* lds, const float* W, int K, int N, int j0, const float* v0, const float* v1, bool do_silu, const float* bias, float* o0, float* o1) {
  const int tid = otid();
  float* sv = lds; float* red = lds + 4096;
  for (int k = tid; k < K; k += NTHR) {
    float a = v0[k], b = v1 ? v1[k] : 0.f;
    if (do_silu) { a = a / (1.f + expf(-a)); b = b / (1.f + expf(-b)); }
    sv[k] = a; sv[2048 + k] = b;
  }
  __syncthreads();
  const int jl = tid & 63, ks = tid >> 6, kper = K >> 3;
  const float* wp = W + (size_t)(ks * kper) * N + j0 + jl;
  float a0 = 0.f, a1 = 0.f;
#pragma unroll 8
  for (int k = 0; k < kper; ++k) { const float w = wp[(size_t)k * N]; a0 += sv[ks * kper + k] * w; a1 += sv[2048 + ks * kper + k] * w; }
  red[(ks * 64 + jl) * 2] = a0; red[(ks * 64 + jl) * 2 + 1] = a1;
  __syncthreads();
  if (tid < 64) {
    float s0 = 0.f, s1 = 0.f;
    for (int i = 0; i < 8; ++i) { s0 += red[(i * 64 + tid) * 2]; s1 += red[(i * 64 + tid) * 2 + 1]; }
    const float bb = bias ? bias[j0 + tid] : 0.f;
    o0[j0 + tid] = s0 + bb; if (o1) o1[j0 + tid] = s1 + bb;
  }
  __syncthreads();
}

DI void s5_params(const Params& P, int gtid) {
  if (gtid >= DEPTH * 32 * 64) return;
  const int l = gtid / 2048, g = (gtid / 64) % 32, p = gtid % 64;
  const float dt = expf(P.in[8][l * 32 + g]);
  const float lr = P.in[6][(l * 32 + g) * 64 + p], li = P.in[7][(l * 32 + g) * 64 + p];
  const float mag = expf(lr * dt); const float ang = li * dt;
  double sd, cd; sincos_d((double)ang, sd, cd);
  const float ab_re = mag * (float)cd, ab_im = mag * (float)sd;
  const float den = lr * lr + li * li, nr = ab_re - 1.0f;
  const float cr = (nr * lr + ab_im * li) / den, ci = (ab_im * lr - nr * li) / den;
  float* o = (float*)(P.ws + WS_S5P) + (size_t)((l * 32 + g) * 64 + p) * 36;
  o[0] = ab_re; o[1] = ab_im;
  double pr = ab_re, pi = ab_im;
  for (int i = 0; i < 6; ++i) { const double nr2 = pr * pr - pi * pi, ni2 = 2.0 * pr * pi; pr = nr2; pi = ni2; }
  o[2] = (float)pr; o[3] = (float)pi;
  const float* br = P.in[9] + (size_t)((l * 32 + g) * 64 + p) * 16; const float* bi = P.in[10] + (size_t)((l * 32 + g) * 64 + p) * 16;
  for (int h = 0; h < 16; ++h) { o[4 + 2 * h] = cr * br[h] - ci * bi[h]; o[5 + 2 * h] = cr * bi[h] + ci * br[h]; }
}

DI void s5_tables(const Params& P, int l, int g, int part, unsigned char* lds) {
  const int tid = otid(), lane = tid & 63;
  float* BBr = (float*)lds; float* BBi = BBr + 1024; float* CR = BBi + 1024; float* CI = CR + 1024;
  float* APr = CI + 1024; float* APi = APr + 65 * 64;
  bf16_t* tab = (bf16_t*)(P.ws + WS_TAB + (size_t)l * TAB_LAYER);
  bf16_t* Kt = tab + TAB_KT / 2 + (size_t)g * 64 * 256; bf16_t* M1 = tab + TAB_M1 / 2 + (size_t)g * 128 * 1024; bf16_t* M2 = tab + TAB_M2 / 2 + (size_t)g * 1024 * 128;
  __syncthreads();
  if (tid < 64) {
    const int p = tid;
    const float dt = expf(P.in[8][l * 32 + g]);
    const float lr = P.in[6][(l * 32 + g) * 64 + p], li = P.in[7][(l * 32 + g) * 64 + p];
    const float mag = expf(lr * dt); const float ang = li * dt;
    double sd, cd; sincos_d((double)ang, sd, cd);
    const float ab_re = mag * (float)cd, ab_im = mag * (float)sd;
    const float den = lr * lr + li * li, nr = ab_re - 1.0f;
    const float cr = (nr * lr + ab_im * li) / den, ci = (ab_im * lr - nr * li) / den;
    const float* br = P.in[9] + (size_t)((l * 32 + g) * 64 + p) * 16; const float* bi = P.in[10] + (size_t)((l * 32 + g) * 64 + p) * 16;
    for (int h = 0; h < 16; ++h) { BBr[p * 16 + h] = cr * br[h] - ci * bi[h]; BBi[p * 16 + h] = cr * bi[h] + ci * br[h]; }
    double pr = 1.0, pi = 0.0;
    for (int tau = 0; tau <= 64; ++tau) { APr[tau * 64 + p] = (float)pr; APi[tau * 64 + p] = (float)pi; const double n1 = pr * ab_re - pi * ab_im, n2 = pr * ab_im + pi * ab_re; pr = n1; pi = n2; }
  }
  for (int i = tid; i < 1024; i += NTHR) { CR[i] = P.in[11][(size_t)(l * 32 + g) * 1024 + i]; CI[i] = P.in[12][(size_t)(l * 32 + g) * 1024 + i]; }
  __syncthreads();
  if (part < 4)
  for (int task = part * 256 + tid; task < part * 256 + 256; task += NTHR) {
    const int tau = task >> 4, h = task & 15;
    float a[16];
#pragma unroll
    for (int j = 0; j < 16; ++j) a[j] = 0.f;
    for (int p = 0; p < 64; ++p) {
      const float c_r = CR[h * 64 + p], c_i = CI[h * 64 + p], a_r = APr[tau * 64 + p], a_i = APi[tau * 64 + p];
      const float xr = c_r * a_r - c_i * a_i, xi = c_r * a_i + c_i * a_r;
#pragma unroll
      for (int j4 = 0; j4 < 4; ++j4) { const f32x4 b_r = *(const f32x4*)(BBr + p * 16 + 4 * j4), b_i = *(const f32x4*)(BBi + p * 16 + 4 * j4);
        a[4 * j4] += xr * b_r.x - xi * b_i.x; a[4 * j4 + 1] += xr * b_r.y - xi * b_i.y; a[4 * j4 + 2] += xr * b_r.z - xi * b_i.z; a[4 * j4 + 3] += xr * b_r.w - xi * b_i.w; }
    }
    u32x4 o0, o1; o0.x = pk2(a[0], a[1]); o0.y = pk2(a[2], a[3]); o0.z = pk2(a[4], a[5]); o0.w = pk2(a[6], a[7]); o1.x = pk2(a[8], a[9]); o1.y = pk2(a[10], a[11]); o1.z = pk2(a[12], a[13]); o1.w = pk2(a[14], a[15]);
    *(u32x4*)(Kt + (size_t)task * 16) = o0; *(u32x4*)(Kt + (size_t)task * 16 + 8) = o1;
  }
  if (part == 4)
  for (int task = tid; task < 4096; task += NTHR) {
    const int p = task >> 6, i = task & 63;
    const float a_r = APr[(63 - i) * 64 + p], a_i = APi[(63 - i) * 64 + p];
    float re[16], im[16];
#pragma unroll
    for (int j = 0; j < 16; ++j) { const float b_r = BBr[p * 16 + j], b_i = BBi[p * 16 + j]; re[j] = a_r * b_r - a_i * b_i; im[j] = a_r * b_i + a_i * b_r; }
    u32x4 o; bf16_t* d0 = M1 + (size_t)(2 * p) * 1024 + i * 16; bf16_t* d1 = d0 + 1024;
    o.x = pk2(re[0], re[1]); o.y = pk2(re[2], re[3]); o.z = pk2(re[4], re[5]); o.w = pk2(re[6], re[7]); *(u32x4*)d0 = o;
    o.x = pk2(re[8], re[9]); o.y = pk2(re[10], re[11]); o.z = pk2(re[12], re[13]); o.w = pk2(re[14], re[15]); *(u32x4*)(d0 + 8) = o;
    o.x = pk2(im[0], im[1]); o.y = pk2(im[2], im[3]); o.z = pk2(im[4], im[5]); o.w = pk2(im[6], im[7]); *(u32x4*)d1 = o;
    o.x = pk2(im[8], im[9]); o.y = pk2(im[10], im[11]); o.z = pk2(im[12], im[13]); o.w = pk2(im[14], im[15]); *(u32x4*)(d1 + 8) = o;
  }
  if (part == 5)
  for (int task = tid; task < 4096; task += NTHR) {
    const int th = task >> 2, pq = task & 3, t = th >> 4, h = th & 15;
    unsigned w[16];
#pragma unroll
    for (int j = 0; j < 16; ++j) { const int p = pq * 16 + j;
      const float c_r = CR[h * 64 + p], c_i = CI[h * 64 + p], a_r = APr[(t + 1) * 64 + p], a_i = APi[(t + 1) * 64 + p];
      w[j] = pk2(c_r * a_r - c_i * a_i, -(c_r * a_i + c_i * a_r)); }
    bf16_t* d = M2 + (size_t)th * 128 + pq * 32;
    *(u32x4*)d = (u32x4){w[0], w[1], w[2], w[3]}; *(u32x4*)(d + 8) = (u32x4){w[4], w[5], w[6], w[7]};
    *(u32x4*)(d + 16) = (u32x4){w[8], w[9], w[10], w[11]}; *(u32x4*)(d + 24) = (u32x4){w[12], w[13], w[14], w[15]};
  }
  __syncthreads();
}

struct ConvJob { const float* src; bf16_t* dst; int ldw, K, c0, ncols, nmat, ldd, drow0, mode; size_t sstride, dstride; };
DI int conv_nitems(const ConvJob& j) { return j.nmat * (j.K >> 6) * ((j.ncols + 31) >> 5); }
DI int conv_drow(int mode, int drow0, int n) { return mode == 0 ? drow0 + n : drow0 + ((n >> 6) * 128 + ((n >> 4) & 3) * 32 + (n & 15)); }
DI void conv_item(const ConvJob& jb, int item, float* scr, int lane) {
  const int nblk = (jb.ncols + 31) >> 5, per = (jb.K >> 6) * nblk;
  const int mat = item / per, r = item % per, kb = r / nblk, nb = r % nblk, k0 = 64 * kb, n0 = 32 * nb;
  const float* W = jb.src + (size_t)mat * jb.sstride; bf16_t* WT = jb.dst + (size_t)mat * jb.dstride;
  const int n4 = (lane & 7) * 4; const bool nok = (n0 + n4) < jb.ncols;
#pragma unroll
  for (int i = 0; i < 8; ++i) { const int kk = 8 * i + (lane >> 3);
    const f32x4 v = nok ? *(const f32x4*)(W + (size_t)(k0 + kk) * jb.ldw + jb.c0 + n0 + n4) : (f32x4){0.f, 0.f, 0.f, 0.f};
    *(f32x4*)(scr + kk * 36 + n4) = v; }
  asm volatile("s_waitcnt lgkmcnt(0)" ::: "memory");
  const int c = lane & 7;
#pragma unroll
  for (int j = 0; j < 4; ++j) {
    const int n = (lane >> 3) + 8 * j; const float* sp = scr + (8 * c) * 36 + n;
    u32x4 o; o.x = pk2(sp[0], sp[36]); o.y = pk2(sp[72], sp[108]); o.z = pk2(sp[144], sp[180]); o.w = pk2(sp[216], sp[252]);
    if (n0 + n < jb.ncols) *(u32x4*)(WT + (size_t)conv_drow(jb.mode, jb.drow0, n0 + n) * jb.ldd + k0 + 8 * c) = o;
  }
  asm volatile("s_waitcnt lgkmcnt(0)" ::: "memory");
}
DI ConvJob conv_job(const Params& P, int l, int j) {
  unsigned char* wb = P.ws + WS_W; ConvJob J; J.nmat = 1; J.mode = 0; J.sstride = 0; J.dstride = 0; J.drow0 = 0; J.c0 = 0;
  const float* win = P.in[5] + (size_t)l * 1024 * INW;
  if (j < 5) { J.src = win; J.ldw = INW; J.K = 1024; J.dst = (bf16_t*)(wb + W_IN); J.ldd = 1024;
    if (j == 0) { J.c0 = 0; J.ncols = 1024; J.drow0 = 0; }
    else if (j == 1) { J.c0 = 1024; J.ncols = 1536; J.drow0 = 1024; }
    else if (j == 2) { J.c0 = 3120; J.ncols = 2048; J.drow0 = 2560; }
    else if (j == 3) { J.c0 = 2608; J.ncols = 512; J.drow0 = 4608; }
    else { J.c0 = 2560; J.ncols = 48; J.drow0 = 5120; }
  } else if (j == 5) { J.src = P.in[14] + (size_t)l * 512 * 512; J.ldw = 512; J.K = 512; J.ncols = 512; J.dst = (bf16_t*)(wb + W_GLU); J.ldd = 512; }
  else if (j == 6) { J.src = P.in[19] + (size_t)l * 1024 * 1024; J.ldw = 1024; J.K = 1024; J.ncols = 1024; J.dst = (bf16_t*)(wb + W_O); J.ldd = 1024; }
  else if (j == 7) { J.src = P.in[15] + (size_t)l * 512 * 1024; J.ldw = 1024; J.K = 512; J.ncols = 1024; J.dst = (bf16_t*)(wb + W_SO); J.ldd = 512; }
  else if (j == 8) { J.src = P.in[20] + (size_t)l * 1024 * 1024; J.ldw = 1024; J.K = 1024; J.ncols = 1024; J.dst = (bf16_t*)(wb + W_OUT); J.ldd = 1024; }
  else if (j == 9) { J.src = P.in[17] + (size_t)l * 2 * 2048 * 256; J.ldw = 256; J.K = 2048; J.ncols = 256; J.nmat = 2; J.sstride = 2048 * 256; J.dstride = 256 * 2048; J.dst = (bf16_t*)(wb + W_C1); J.ldd = 2048; }
  else if (j == 10) { J.src = P.in[18] + (size_t)l * 2 * 256 * 64; J.ldw = 64; J.K = 256; J.ncols = 64; J.nmat = 2; J.sstride = 256 * 64; J.dstride = 128 * 256; J.dst = (bf16_t*)(wb + W_C2); J.ldd = 256; }
  else if (j == 11) { J.src = P.in[26] + (size_t)l * 32 * 1024 * 256; J.ldw = 256; J.K = 1024; J.ncols = 256; J.nmat = 32; J.sstride = 1024 * 256; J.dstride = 512 * 1024; J.dst = (bf16_t*)(wb + W_GU); J.ldd = 1024; J.mode = 1; J.drow0 = 0; }
  else if (j == 12) { J.src = P.in[27] + (size_t)l * 32 * 1024 * 256; J.ldw = 256; J.K = 1024; J.ncols = 256; J.nmat = 32; J.sstride = 1024 * 256; J.dstride = 512 * 1024; J.dst = (bf16_t*)(wb + W_GU); J.ldd = 1024; J.mode = 1; J.drow0 = 16; }
  else { J.src = P.in[28] + (size_t)l * 32 * 256 * 1024; J.ldw = 1024; J.K = 256; J.ncols = 1024; J.nmat = 32; J.sstride = 256 * 1024; J.dstride = 1024 * 256; J.dst = (bf16_t*)(wb + W_D); J.ldd = 256; }
  return J;
}
DI void convert_weights(const Params& P_, int l, unsigned char* lds) {
  Params P = P_; { size_t z_ = 0; asm volatile("" : "+s"(z_)); P.ws = P_.ws + z_; }
  const int tid_ = otid(), bid = obid(), wave = tid_ >> 6, lane = tid_ & 63; (void)bid;
  float* scr = (float*)lds + wave * (64 * 36);
  const int NGW = gridDim.x * NWAVE; int off = bid * NWAVE + wave;
  for (int j = 0; j < 14; ++j) {
    const ConvJob J = conv_job(P, l, j); const int n = conv_nitems(J);
    while (off < n) { conv_item(J, off, scr, lane); off += NGW; }
    off -= n;
  }
}

template <int MODE>
DI void norm_simple(const Params& P_, int l) {
  Params P = P_; { size_t z_ = 0; asm volatile("" : "+s"(z_)); P.ws = P_.ws + z_; }
  const int tid_ = otid(), bid = obid(), wave = tid_ >> 6, lane = tid_ & 63; (void)bid;
  const int NGW = gridDim.x * NWAVE;
  const float* mod = (const float*)(P.ws + WS_MOD);
  const bf16_t* ys = (const bf16_t*)(P.ws + WS_F);
  bf16_t* xn = (bf16_t*)(P.ws + WS_A);
  for (int row = bid * NWAVE + wave; row < NT; row += NGW) {
    const int b = row >> 13;
    const float* xr = (MODE == 0 ? P.in[0] : P.out) + (size_t)row * DM;
    f32x4 v[4];
#pragma unroll
    for (int j = 0; j < 4; ++j) v[j] = *(const f32x4*)(xr + 4 * lane + 256 * j);
    if (MODE != 0 && EN_MOE) {
      const float* g2 = mod + (size_t)(((MODE == 1 ? 0 : 1) * 2 + b) * 6144) + 5120;
#pragma unroll
      for (int j = 0; j < 4; ++j) {
        const int col = 4 * lane + 256 * j;
        const u32x2 y0 = *(const u32x2*)(ys + (size_t)(row * 2) * DM + col), y1 = *(const u32x2*)(ys + (size_t)(row * 2 + 1) * DM + col);
        const f32x4 gg = *(const f32x4*)(g2 + col);
        v[j].x += gg.x * (bflo(y0.x) + bflo(y1.x)); v[j].y += gg.y * (bfhi(y0.x) + bfhi(y1.x));
        v[j].z += gg.z * (bflo(y0.y) + bflo(y1.y)); v[j].w += gg.w * (bfhi(y0.y) + bfhi(y1.y));
      }
    }
    float ss = 0.f;
#pragma unroll
    for (int j = 0; j < 4; ++j) ss += v[j].x * v[j].x + v[j].y * v[j].y + v[j].z * v[j].z + v[j].w * v[j].w;
    ss = wave_sum(ss);
    const float inv = rsqrtf(ss * (1.f / DM) + EPS);
    if (MODE == 3) {
      const float* fg = P.in[29];
#pragma unroll
      for (int j = 0; j < 4; ++j) { const int col = 4 * lane + 256 * j; const f32x4 g = *(const f32x4*)(fg + col); *(f32x4*)(P.out + (size_t)row * DM + col) = v[j] * inv * g; }
    } else {
      if (MODE == 1) {
#pragma unroll
        for (int j = 0; j < 4; ++j) *(f32x4*)(P.out + (size_t)row * DM + 4 * lane + 256 * j) = v[j];
      }
      const float* ng = P.in[4] + (size_t)l * DM; const float* md = mod + (size_t)((l * 2 + b) * 6144);
#pragma unroll
      for (int j = 0; j < 4; ++j) {
        const int col = 4 * lane + 256 * j;
        const f32x4 g = *(const f32x4*)(ng + col), sh = *(const f32x4*)(md + col), sc = *(const f32x4*)(md + 1024 + col);
        const f32x4 h = v[j] * inv * g * (sc + 1.f) + sh;
        u32x2 o; o.x = pk2(h.x, h.y); o.y = pk2(h.z, h.w);
        *(u32x2*)(xn + (size_t)row * DM + col) = o;
      }
    }
  }
}

constexpr int RT_HS = 1028;
DI void norm_route(const Params& P_, int l, unsigned char* lds) {
  Params P = P_; { size_t z_ = 0; asm volatile("" : "+s"(z_)); P.ws = P_.ws + z_; }
  const int tid = otid(), bid = obid(), wave = tid >> 6, lane = tid & 63;
  const float* mod = (const float*)(P.ws + WS_MOD);
  bf16_t* h2 = (bf16_t*)(P.ws + WS_A);
  float* hs = (float*)lds;
  float* Wc = (float*)lds + 32 * RT_HS;
  const float* wg = P.in[22] + (size_t)l * DM * 4; const float* we = P.in[24] + (size_t)l * DM * 32;
  const float* bg = P.in[23] + l * 4; const float* be = P.in[25] + l * 32;
  int* cnt = (int*)(P.ws + WS_CNT) + l * 32; int* list = (int*)(P.ws + WS_LIST); float* wts = (float*)(P.ws + WS_WT);
  const int rg = wave >> 2, kq = wave & 3;
  for (int grp = bid; grp < NT / 32; grp += gridDim.x) {
    const int row0 = grp * 32 + wave * 4, b = row0 >> 13;
    const float* ng = P.in[21] + (size_t)l * DM; const float* md = mod + (size_t)((l * 2 + b) * 6144);
    {
      f32x4 v[4][4];
#pragma unroll
      for (int r = 0; r < 4; ++r)
#pragma unroll
        for (int j = 0; j < 4; ++j) v[r][j] = *(const f32x4*)(P.out + (size_t)(row0 + r) * DM + 4 * lane + 256 * j);
      float inv[4];
#pragma unroll
      for (int r = 0; r < 4; ++r) { float ss = 0.f;
#pragma unroll
        for (int j = 0; j < 4; ++j) ss += v[r][j].x * v[r][j].x + v[r][j].y * v[r][j].y + v[r][j].z * v[r][j].z + v[r][j].w * v[r][j].w;
        inv[r] = rsqrtf(wave_sum(ss) * (1.f / DM) + EPS); }
#pragma unroll
      for (int j = 0; j < 4; ++j) {
        const int col = 4 * lane + 256 * j;
        const f32x4 g = *(const f32x4*)(ng + col), sh = *(const f32x4*)(md + 3072 + col), sc = *(const f32x4*)(md + 4096 + col);
#pragma unroll
        for (int r = 0; r < 4; ++r) {
          const f32x4 hh = v[r][j] * inv[r] * g * (sc + 1.f) + sh;
          u32x2 o; o.x = pk2(hh.x, hh.y); o.y = pk2(hh.z, hh.w);
          *(u32x2*)(h2 + (size_t)(row0 + r) * DM + col) = o;
          *(f32x4*)(hs + (wave * 4 + r) * RT_HS + col) = hh;
        }
      }
    }
    f32x4 we0, we1, wg0 = {0.f, 0.f, 0.f, 0.f};
#define WLOAD(kc) do { we0 = *(const f32x4*)(we + (size_t)(kc) * 4096 + tid * 4); we1 = *(const f32x4*)(we + (size_t)(kc) * 4096 + 2048 + tid * 4); if (tid < 128) wg0 = *(const f32x4*)(wg + (size_t)(kc) * 512 + tid * 4); } while (0)
#define WSTORE() do { *(f32x4*)(Wc + (tid >> 3) * 36 + (tid & 7) * 4) = we0; *(f32x4*)(Wc + (64 + (tid >> 3)) * 36 + (tid & 7) * 4) = we1; if (tid < 128) *(f32x4*)(Wc + tid * 36 + 32) = wg0; } while (0)
    WLOAD(0);
    f32x4 acc0 = {0.f, 0.f, 0.f, 0.f}, acc1 = acc0, acc2 = acc0;
    for (int kc = 0; kc < 8; ++kc) {
      __syncthreads();
      WSTORE();
      if (kc + 1 < 8) WLOAD(kc + 1);
      __syncthreads();
      const float* ap = hs + (rg * 16 + (lane & 15)) * RT_HS + kc * 128 + kq * 32 + (lane >> 4);
      const float* bp = Wc + (kq * 32 + (lane >> 4)) * 36 + (lane & 15);
#pragma unroll
      for (int ks = 0; ks < 8; ++ks) {
        const float av = ap[4 * ks];
        const float b0 = bp[(4 * ks) * 36], b1 = bp[(4 * ks) * 36 + 16], b2 = (lane & 15) < 4 ? bp[(4 * ks) * 36 + 32] : 0.f;
        acc0 = __builtin_amdgcn_mfma_f32_16x16x4f32(av, b0, acc0, 0, 0, 0);
        acc1 = __builtin_amdgcn_mfma_f32_16x16x4f32(av, b1, acc1, 0, 0, 0);
        acc2 = __builtin_amdgcn_mfma_f32_16x16x4f32(av, b2, acc2, 0, 0, 0);
      }
    }
#undef WLOAD
#undef WSTORE
    __syncthreads();
    {
      float* part = hs + kq * (32 * 40);
#pragma unroll
      for (int i = 0; i < 4; ++i) { const int row = rg * 16 + 4 * (lane >> 4) + i, col = lane & 15;
        part[row * 40 + col] = acc0[i]; part[row * 40 + 16 + col] = acc1[i]; if (col < 4) part[row * 40 + 32 + col] = acc2[i]; }
    }
    __syncthreads();
    if (tid < 32) {
      const int row = grp * 32 + tid;
      float L[36];
#pragma unroll
      for (int o = 0; o < 36; ++o) L[o] = (hs[tid * 40 + o] + hs[1280 + tid * 40 + o]) + (hs[2560 + tid * 40 + o] + hs[3840 + tid * 40 + o]);
      float gm = -1e30f; int gi = 0;
#pragma unroll
      for (int i = 0; i < 4; ++i) { const float v = L[32 + i] + bg[i]; if (v > gm) { gm = v; gi = i; } }
      float gs = 0.f;
#pragma unroll
      for (int i = 0; i < 4; ++i) gs += expf(L[32 + i] + bg[i] - gm);
      const float gp = 1.f / gs;
      float el[8];
#pragma unroll
      for (int i = 0; i < 8; ++i) el[i] = (gi == 0 ? L[i] : gi == 1 ? L[8 + i] : gi == 2 ? L[16 + i] : L[24 + i]) + be[gi * 8 + i];
      float em = -1e30f;
#pragma unroll
      for (int i = 0; i < 8; ++i) em = fmaxf(em, el[i]);
      float p1 = -1.f, p2 = -1.f; int i1 = 0, i2 = 0;
#pragma unroll
      for (int i = 0; i < 8; ++i) {
        const float pe = expf(el[i] - em);
        if (pe > p1) { p2 = p1; i2 = i1; p1 = pe; i1 = i; } else if (pe > p2) { p2 = pe; i2 = i; }
      }
      const float w1 = gp * p1 / (p1 + p2), w2 = gp * p2 / (p1 + p2);
      const int e1 = gi * 8 + i1, e2 = gi * 8 + i2;
      const int pos1 = atomicAdd(&cnt[e1], 1); list[e1 * LISTCAP + pos1] = row * 2; wts[row * 2] = w1;
      const int pos2 = atomicAdd(&cnt[e2], 1); list[e2 * LISTCAP + pos2] = row * 2 + 1; wts[row * 2 + 1] = w2;
    }
    __syncthreads();
  }
}

namespace pg8 {
#define PG8_LAS __attribute__((address_space(3)))
typedef unsigned short bf16_t;
typedef short bf16x8 __attribute__((ext_vector_type(8)));
typedef float f32x4 __attribute__((ext_vector_type(4)));
typedef unsigned u32x4 __attribute__((ext_vector_type(4)));
constexpr int BM = 256, BK = 64, HALF = 128, HTB = HALF * BK * 2  , STAGE_BYTES = 8 * HTB, NXCD = 8, WGM = 8;

__host__ __device__ __forceinline__ int lds_byte(int r, int c) { const int st = (r >> 4) * 2 + (c >> 5), rr = r & 15, cc = c & 31, ob = rr * 64 + cc * 2; return st * 1024 + (ob ^ (((ob >> 9) & 1) << 5)); }
__host__ __device__ __forceinline__ void stage_rc(int b, int& R, int& C) { const int st = b / 1024, sb = b % 1024, swz = sb ^ (((sb >> 9) & 1) << 5); R = (st >> 1) * 16 + swz / 64; C = (st & 1) * 32 + (swz % 64) / 2; }
__host__ __device__ __forceinline__ int perm32(int rho) { const int n = rho >> 4, i = rho & 15; return 8 * (i >> 2) + 4 * n + (i & 3); }

struct Unit { int pm, pn; };
struct Gemm { const bf16_t* A; const bf16_t* Bt; int M, N, K; };

struct StaticOrder {
    int nM, nN, nwg, G, c;
    __host__ __device__ void init(int M, int N, int G_, int c_) { nM = M / BM; nN = N / BM; nwg = nM * nN; G = G_; c = c_; }
    __host__ __device__ bool next(int i, Unit& u) const {
        const long L = (long)i * G + c; if (L >= nwg) return false;
        int wgid = (int)L; { const int q = nwg / NXCD, r = nwg % NXCD, xcd = wgid % NXCD, off = wgid / NXCD; wgid = (xcd < r ? xcd * (q + 1) : r * (q + 1) + (xcd - r) * q) + off; }
        const int nig = WGM * nN, gid = wgid / nig, fm = gid * WGM, gsz = (nM - fm) < WGM ? (nM - fm) : WGM;
        u.pm = fm + ((wgid % nig) % gsz); u.pn = (wgid % nig) / gsz; return true;
    }
    __device__ __forceinline__ void a_ready(const Unit&) const {}
    __device__ __forceinline__ void done(const Unit&) const {}
};
template <class Epi, class Sched, bool ALIGN_EPI = false, bool SP2 = false>
__device__ __forceinline__ void gemm_phase(PG8_LAS unsigned char* lds, const Gemm g, const Sched& S, const Epi& E) {
    const int tid = otid(), wid = __builtin_amdgcn_readfirstlane(tid >> 6), lane = tid & 63, wr = wid >> 2, wc = wid & 3, fr = lane & 15, fq = lane >> 4;
    const int K = g.K, nt = K / BK;
    unsigned voffA[2], voffB[2];
#pragma unroll
    for (int i = 0; i < 2; ++i) { int R, C; stage_rc(tid * 16 + i * 8192, R, C); const int Rb = Epi::PERM ? ((R & ~31) + perm32(R & 31)) : R;
        voffA[i] = (unsigned)(R * K + C) * 2u; voffB[i] = (unsigned)(Rb * K + C) * 2u; }
    const size_t kstep = (size_t)(BK * 2);
    const size_t hstep = (size_t)HALF * K * 2;
    const size_t tstep = 2 * hstep;
    const unsigned ldsw = (unsigned)wid * 1024u;
    const int aoff = lds_byte(wr * 64 + fr, fq * 8), boff = lds_byte(wc * 32 + fr, fq * 8);
#define PG8_SA(b, h) (((b) * 2 + (h)) * HTB)
#define PG8_SB(b, h) ((4 + (b) * 2 + (h)) * HTB)
#define PG8_STAGE(bufoff, gbase, voff) do { _Pragma("unroll") for (int _i = 0; _i < 2; ++_i) \
        __builtin_amdgcn_global_load_lds((const unsigned*)((const char*)(gbase) + (voff)[_i]), (PG8_LAS unsigned*)(lds + (bufoff) + ldsw + _i * 8192), 16, 0, 0); } while (0)
#define PG8_LDA(dst, b, h) do { _Pragma("unroll") for (int m = 0; m < 4; ++m) _Pragma("unroll") for (int k = 0; k < 2; ++k) dst[m][k] = *(const PG8_LAS bf16x8*)(lds + PG8_SA(b, h) + aoff + m * 2048 + k * 1024); } while (0)
#define PG8_LDB(dst, b, h) do { _Pragma("unroll") for (int n = 0; n < 2; ++n) _Pragma("unroll") for (int k = 0; k < 2; ++k) dst[n][k] = *(const PG8_LAS bf16x8*)(lds + PG8_SB(b, h) + boff + n * 2048 + k * 1024); } while (0)
#define PG8_MMA(ai, bj, At, Bt) do { __builtin_amdgcn_s_setprio(1); _Pragma("unroll") for (int m = 0; m < 4; ++m) _Pragma("unroll") for (int n = 0; n < 2; ++n) _Pragma("unroll") for (int k = 0; k < 2; ++k) \
        acc[ai][bj][m][n] = __builtin_amdgcn_mfma_f32_16x16x32_bf16(Bt[n][k], At[m][k], acc[ai][bj][m][n], 0, 0, 0); __builtin_amdgcn_s_setprio(0); } while (0)
#define PG8_WAIT_V(n) asm volatile("s_waitcnt vmcnt(" #n ")" ::: "memory")
#define PG8_WAIT_L(n) asm volatile("s_waitcnt lgkmcnt(" #n ")" ::: "memory")
#define PG8_BAR __builtin_amdgcn_s_barrier()
#define PG8_SCHED __builtin_amdgcn_sched_barrier(0)
    Unit cur, nxt; int ui = 0;
    if (!S.next(0, cur)) return;
    f32x4 acc[2][2][4][2];
#pragma unroll
    for (int a = 0; a < 2; ++a)
#pragma unroll
        for (int b = 0; b < 2; ++b)
#pragma unroll
            for (int m = 0; m < 4; ++m)
#pragma unroll
                for (int n = 0; n < 2; ++n) acc[a][b][m][n] = (f32x4){0.f, 0.f, 0.f, 0.f};
    bf16x8 At[4][2], B0[2][2], B1[2][2];
    const char* cA = (const char*)g.A + (size_t)cur.pm * tstep; const char* cB = (const char*)g.Bt + (size_t)cur.pn * tstep;
    S.a_ready(cur);
    if constexpr (SP2) {
        PG8_STAGE(PG8_SB(0, 0), cB, voffB); PG8_STAGE(PG8_SB(0, 1), cB + hstep, voffB); PG8_STAGE(PG8_SA(0, 0), cA, voffA); PG8_STAGE(PG8_SA(0, 1), cA + hstep, voffA);
        if (wr == 1) PG8_BAR;
        PG8_WAIT_V(2); PG8_BAR;
        PG8_STAGE(PG8_SB(1, 0), cB + kstep, voffB); PG8_STAGE(PG8_SA(1, 0), cA + kstep, voffA); PG8_STAGE(PG8_SB(1, 1), cB + hstep + kstep, voffB);
        PG8_WAIT_V(6); PG8_BAR;
    } else {
        PG8_STAGE(PG8_SB(0, 0), cB, voffB); PG8_STAGE(PG8_SA(0, 0), cA, voffA); PG8_STAGE(PG8_SB(0, 1), cB + hstep, voffB); PG8_STAGE(PG8_SA(0, 1), cA + hstep, voffA);
        if (wr == 1) PG8_BAR;
        PG8_WAIT_V(4); PG8_BAR;
        PG8_STAGE(PG8_SB(1, 0), cB + kstep, voffB); PG8_STAGE(PG8_SA(1, 0), cA + kstep, voffA); PG8_STAGE(PG8_SB(1, 1), cB + hstep + kstep, voffB);
        PG8_WAIT_V(6); PG8_BAR;
    }
    for (;;) {
        const bool has_next = S.next(ui + 1, nxt);
        const char* nA = has_next ? (const char*)g.A + (size_t)nxt.pm * tstep : cA; const char* nB = has_next ? (const char*)g.Bt + (size_t)nxt.pn * tstep : cB;
        for (int t = 0; t < nt; t += 2) {
            const bool last = (t == nt - 2);
            const char* a1 = cA + (size_t)(t + 1) * kstep;
            const char* a2 = last ? nA : cA + (size_t)(t + 2) * kstep; const char* b2 = last ? nB : cB + (size_t)(t + 2) * kstep;
            const char* a3 = a2 + kstep; const char* b3 = b2 + kstep;
            if (last && has_next) S.a_ready(nxt);
            if constexpr (SP2) {
            PG8_LDB(B0, 0, 0); PG8_LDB(B1, 0, 1); PG8_SCHED; PG8_LDA(At, 0, 0); PG8_STAGE(PG8_SA(1, 1), a1 + hstep, voffA);
            PG8_WAIT_V(8); PG8_WAIT_L(0); PG8_BAR; PG8_MMA(0, 0, At, B0); PG8_MMA(0, 1, At, B1); PG8_BAR; PG8_SCHED;
            PG8_LDA(At, 0, 1); PG8_STAGE(PG8_SB(0, 0), b2, voffB); PG8_STAGE(PG8_SB(0, 1), b2 + hstep, voffB); PG8_STAGE(PG8_SA(0, 0), a2, voffA);
            PG8_WAIT_V(8); PG8_WAIT_L(0); PG8_BAR; PG8_MMA(1, 0, At, B0); PG8_MMA(1, 1, At, B1); PG8_BAR; PG8_SCHED;
            PG8_LDB(B0, 1, 0); PG8_LDB(B1, 1, 1); PG8_SCHED; PG8_LDA(At, 1, 0); PG8_STAGE(PG8_SA(0, 1), a2 + hstep, voffA);
            PG8_WAIT_V(8); PG8_WAIT_L(0); PG8_BAR; PG8_MMA(0, 0, At, B0); PG8_MMA(0, 1, At, B1); PG8_BAR; PG8_SCHED;
            PG8_LDA(At, 1, 1); PG8_STAGE(PG8_SB(1, 0), b3, voffB); PG8_STAGE(PG8_SB(1, 1), b3 + hstep, voffB); PG8_STAGE(PG8_SA(1, 0), a3, voffA);
            PG8_WAIT_V(8); PG8_WAIT_L(0); PG8_BAR; PG8_MMA(1, 0, At, B0); PG8_MMA(1, 1, At, B1); PG8_BAR; PG8_SCHED;
            } else {
            PG8_LDB(B0, 0, 0); PG8_SCHED; PG8_LDA(At, 0, 0); PG8_STAGE(PG8_SA(1, 1), a1 + hstep, voffA);
            PG8_WAIT_L(8); PG8_BAR; PG8_WAIT_L(0); PG8_MMA(0, 0, At, B0); PG8_BAR; PG8_SCHED;
            PG8_LDB(B1, 0, 1); PG8_STAGE(PG8_SB(0, 0), b2, voffB);
            PG8_BAR; PG8_WAIT_L(0); PG8_MMA(0, 1, At, B1); PG8_BAR;
            PG8_LDA(At, 0, 1); PG8_STAGE(PG8_SA(0, 0), a2, voffA);
            PG8_BAR; PG8_WAIT_L(0); PG8_MMA(1, 0, At, B0); PG8_BAR; PG8_SCHED;
            PG8_STAGE(PG8_SB(0, 1), b2 + hstep, voffB);
            PG8_WAIT_V(6); PG8_BAR; PG8_MMA(1, 1, At, B1); PG8_BAR;
            PG8_LDB(B0, 1, 0); PG8_SCHED; PG8_LDA(At, 1, 0); PG8_STAGE(PG8_SA(0, 1), a2 + hstep, voffA);
            PG8_WAIT_L(8); PG8_BAR; PG8_WAIT_L(0); PG8_MMA(0, 0, At, B0); PG8_BAR; PG8_SCHED;
            PG8_LDB(B1, 1, 1); PG8_STAGE(PG8_SB(1, 0), b3, voffB);
            PG8_BAR; PG8_WAIT_L(0); PG8_MMA(0, 1, At, B1); PG8_BAR;
            PG8_LDA(At, 1, 1); PG8_STAGE(PG8_SA(1, 0), a3, voffA);
            PG8_BAR; PG8_WAIT_L(0); PG8_MMA(1, 0, At, B0); PG8_BAR; PG8_SCHED;
            PG8_STAGE(PG8_SB(1, 1), b3 + hstep, voffB);
            PG8_WAIT_V(6); PG8_BAR; PG8_MMA(1, 1, At, B1); PG8_BAR;
            }
        }
        if constexpr (ALIGN_EPI) { if (wr == 0) PG8_BAR; }
        if constexpr (!Epi::AFTER_DRAIN) { E(acc, cur, wr, wc, fr, fq); S.done(cur); }
        if (!has_next) break;
#pragma unroll
        for (int a = 0; a < 2; ++a)
#pragma unroll
            for (int b = 0; b < 2; ++b)
#pragma unroll
                for (int m = 0; m < 4; ++m)
#pragma unroll
                    for (int n = 0; n < 2; ++n) acc[a][b][m][n] = (f32x4){0.f, 0.f, 0.f, 0.f};
        cur = nxt; cA = nA; cB = nB; ++ui;
        if constexpr (ALIGN_EPI) { if (wr == 1) PG8_BAR; }
    }
    PG8_WAIT_V(0);
    if constexpr (!ALIGN_EPI) { if (wr == 0) PG8_BAR; }
    PG8_BAR;
    if constexpr (Epi::AFTER_DRAIN) { E.fused(acc, cur, wr, wc, fr, fq, lds, wid, lane); S.done(cur); }
#undef PG8_SA
#undef PG8_SB
#undef PG8_STAGE
#undef PG8_LDA
#undef PG8_LDB
#undef PG8_MMA
#undef PG8_WAIT_V
#undef PG8_WAIT_L
#undef PG8_BAR
#undef PG8_SCHED
}
}

constexpr int GT_ROWB = 144, GT_A = 0, GT_B = 128 * GT_ROWB, GT_STAGE = 2 * 128 * GT_ROWB;
DI void gemm_kloop(unsigned char* lds, const bf16_t* a0, const bf16_t* a1, int a_kadv, const bf16_t* b0, const bf16_t* b1, int nk, f32x4 (&acc)[4][2]) {
  const int tid = otid(), lane = tid & 63, wid = tid >> 6, wr = wid >> 2, wc = wid & 3, fr = lane & 15, fq = lane >> 4;
  const int lr = tid >> 3, lkb = (tid & 7) * 16;
  u32x4 xa0, xa1, xb0, xb1, ya0, ya1, yb0, yb1;
#define GT_GLOAD(p0_, p1_, q0_, q1_, kt) do { p0_ = *(const u32x4*)(a0 + (size_t)(kt) * a_kadv); p1_ = *(const u32x4*)(a1 + (size_t)(kt) * a_kadv); q0_ = *(const u32x4*)(b0 + (kt) * 64); q1_ = *(const u32x4*)(b1 + (kt) * 64); } while (0)
#define GT_LSTORE(p0_, p1_, q0_, q1_, buf) do { unsigned char* s_ = lds + (buf) * GT_STAGE; \
    *(u32x4*)(s_ + GT_A + lr * GT_ROWB + lkb) = p0_; *(u32x4*)(s_ + GT_A + (lr + 64) * GT_ROWB + lkb) = p1_; \
    *(u32x4*)(s_ + GT_B + lr * GT_ROWB + lkb) = q0_; *(u32x4*)(s_ + GT_B + (lr + 64) * GT_ROWB + lkb) = q1_; } while (0)
#define GT_COMPUTE(buf) do { \
    const unsigned char* As = lds + (buf) * GT_STAGE + GT_A + (wr * 64 + fr) * GT_ROWB + fq * 16; \
    const unsigned char* Bs = lds + (buf) * GT_STAGE + GT_B + (wc * 32 + fr) * GT_ROWB + fq * 16; \
    _Pragma("unroll") for (int ks = 0; ks < 2; ++ks) { \
      bf16x8 af[4], bfr[2]; \
      _Pragma("unroll") for (int m = 0; m < 4; ++m) af[m] = *(const bf16x8*)(As + m * 16 * GT_ROWB + ks * 64); \
      _Pragma("unroll") for (int n = 0; n < 2; ++n) bfr[n] = *(const bf16x8*)(Bs + n * 16 * GT_ROWB + ks * 64); \
      _Pragma("unroll") for (int m = 0; m < 4; ++m) _Pragma("unroll") for (int n = 0; n < 2; ++n) acc[m][n] = __builtin_amdgcn_mfma_f32_16x16x32_bf16(bfr[n], af[m], acc[m][n], 0, 0, 0); } } while (0)
  GT_GLOAD(xa0, xa1, xb0, xb1, 0); GT_LSTORE(xa0, xa1, xb0, xb1, 0); if (nk > 1) GT_GLOAD(ya0, ya1, yb0, yb1, 1); __syncthreads();
  for (int kt = 0; kt < nk; kt += 2) {
    if (kt + 2 < nk) GT_GLOAD(xa0, xa1, xb0, xb1, kt + 2);
    GT_COMPUTE(0);
    if (kt + 1 < nk) GT_LSTORE(ya0, ya1, yb0, yb1, 1);
    __syncthreads();
    if (kt + 1 >= nk) break;
    if (kt + 3 < nk) GT_GLOAD(ya0, ya1, yb0, yb1, kt + 3);
    GT_COMPUTE(1);
    if (kt + 2 < nk) GT_LSTORE(xa0, xa1, xb0, xb1, 0);
    __syncthreads();
  }
#undef GT_GLOAD
#undef GT_LSTORE
#undef GT_COMPUTE
}
#define ACC_ZERO(acc) do { _Pragma("unroll") for (int m_ = 0; m_ < 4; ++m_) _Pragma("unroll") for (int n_ = 0; n_ < 2; ++n_) acc[m_][n_] = (f32x4){0.f, 0.f, 0.f, 0.f}; } while (0)
#define TILE_IDS const int tid = otid(), bid = obid(), lane = tid & 63, wid = tid >> 6, wr = wid >> 2, wc = wid & 3, fr = lane & 15, fq = lane >> 4, lr = tid >> 3, lk = (tid & 7) * 8; (void)bid; (void)lane; (void)wr; (void)wc; (void)fr; (void)fq; (void)lr; (void)lk

DI void phase_gates(const Params& P_, unsigned char* lds) {
  Params P = P_; { size_t z_ = 0; asm volatile("" : "+s"(z_)); P.ws = P_.ws + z_; }
  TILE_IDS;
  const bf16_t* xn = (const bf16_t*)(P.ws + WS_A); const bf16_t* wt = (const bf16_t*)(P.ws + WS_W + W_IN) + (size_t)5120 * DM; float* gates = (float*)(P.ws + WS_GATES);
  for (int tile = (int)gridDim.x - 1 - bid; tile < NT / 128; tile += gridDim.x) {
    const int row0 = tile * 128;
    f32x4 acc[4][2]; ACC_ZERO(acc);
    gemm_kloop(lds, xn + (size_t)(row0 + lr) * DM + lk, xn + (size_t)(row0 + lr + 64) * DM + lk, 64, wt + (size_t)lr * DM + lk, wt + (size_t)(lr + 64) * DM + lk, DM / 64, acc);
#pragma unroll
    for (int m = 0; m < 4; ++m)
#pragma unroll
      for (int n = 0; n < 2; ++n) {
        const int row = row0 + wr * 64 + m * 16 + fr, c2 = wc * 32 + n * 16 + 4 * fq; const f32x4 v = acc[m][n];
        if (c2 < 48) { f32x4 o = {sigmoidf_(v.x), sigmoidf_(v.y), sigmoidf_(v.z), sigmoidf_(v.w)}; *(f32x4*)(gates + (size_t)row * 48 + c2) = o; }
      }
  }
}
DI void phase_cmp1(const Params& P_, int l, unsigned char* lds) {
  Params P = P_; { size_t z_ = 0; asm volatile("" : "+s"(z_)); P.ws = P_.ws + z_; }
  TILE_IDS;
  const bf16_t* kvk = (const bf16_t*)(P.ws + WS_C); bf16_t* hid = (bf16_t*)(P.ws + WS_HID);
  const float* cb = (const float*)(P.ws + WS_CB) + l * 512;
  for (int tile = bid; tile < 128; tile += gridDim.x) {
    const int kv = tile >> 6, rt = (tile >> 1) & 31, ct = tile & 1, row0 = rt * 128, col0 = ct * 128;
    const bf16_t* wt = (const bf16_t*)(P.ws + WS_W + W_C1) + (size_t)kv * 256 * 2048;
    const bf16_t* ap[2];
#pragma unroll
    for (int i = 0; i < 2; ++i) { const int rr = row0 + lr + 64 * i, b = rr >> 11, n = (rr >> 2) & 511, g = rr & 3, nn = n > 510 ? 510 : n;
      ap[i] = kvk + (size_t)(b * SEQ + 16 * nn) * DM + kv * 256 + g * 64 + lk; }
    f32x4 acc[4][2]; ACC_ZERO(acc);
    gemm_kloop(lds, ap[0], ap[1], DM, wt + (size_t)(col0 + lr) * 2048 + lk, wt + (size_t)(col0 + lr + 64) * 2048 + lk, 32, acc);
#pragma unroll
    for (int m = 0; m < 4; ++m)
#pragma unroll
      for (int n = 0; n < 2; ++n) {
        const int row = row0 + wr * 64 + m * 16 + fr, col = col0 + wc * 32 + n * 16 + 4 * fq;
        const f32x4 bb = *(const f32x4*)(cb + kv * 256 + col); const f32x4 v = acc[m][n] + bb;
        u32x2 o; o.x = pk2(gelu_tanh(v.x), gelu_tanh(v.y)); o.y = pk2(gelu_tanh(v.z), gelu_tanh(v.w));
        *(u32x2*)(hid + ((size_t)kv * 4096 + row) * 256 + col) = o;
      }
  }
}
DI void phase_cmp2(const Params& P_, unsigned char* lds) {
  Params P = P_; { size_t z_ = 0; asm volatile("" : "+s"(z_)); P.ws = P_.ws + z_; }
  TILE_IDS;
  const bf16_t* hid = (const bf16_t*)(P.ws + WS_HID); bf16_t* kc = (bf16_t*)(P.ws + WS_KC); bf16_t* vc = (bf16_t*)(P.ws + WS_VC);
  for (int tile = bid; tile < 64; tile += gridDim.x) {
    const int kv = tile >> 5, rt = tile & 31, row0 = rt * 128;
    const bf16_t* wt = (const bf16_t*)(P.ws + WS_W + W_C2) + (size_t)kv * 128 * 256;
    const bf16_t* a = hid + ((size_t)kv * 4096 + row0) * 256;
    f32x4 acc[4][2]; ACC_ZERO(acc);
    gemm_kloop(lds, a + (size_t)lr * 256 + lk, a + (size_t)(lr + 64) * 256 + lk, 64, wt + (size_t)lr * 256 + lk, wt + (size_t)(lr + 64) * 256 + lk, 4, acc);
    if (wc < 2) {
#pragma unroll
      for (int m = 0; m < 4; ++m)
#pragma unroll
        for (int n = 0; n < 2; ++n) {
          const int rr = row0 + wr * 64 + m * 16 + fr, d = wc * 32 + n * 16 + 4 * fq;
          const int b = rr >> 11, nn = (rr >> 2) & 511, g = rr & 3; const f32x4 v = acc[m][n];
          if (kv == 0) { u32x2 o; o.x = pk2(v.x, v.y); o.y = pk2(v.z, v.w); *(u32x2*)(kc + ((size_t)((b * 4 + g) * 512 + nn)) * 64 + d) = o; }
          else { bf16_t* dst = vc + ((size_t)((b * 4 + g) * 64 + d)) * 512 + perm16(nn); dst[0] = (bf16_t)f2bf(v.x); dst[512] = (bf16_t)f2bf(v.y); dst[1024] = (bf16_t)f2bf(v.z); dst[1536] = (bf16_t)f2bf(v.w); }
        }
    }
  }
}
DI void phase_glu(const Params& P_, unsigned char* lds) {
  Params P = P_; { size_t z_ = 0; asm volatile("" : "+s"(z_)); P.ws = P_.ws + z_; }
  TILE_IDS;
  const bf16_t* y = (const bf16_t*)(P.ws + WS_G); const bf16_t* wt = (const bf16_t*)(P.ws + WS_W + W_GLU); bf16_t* ssm = (bf16_t*)(P.ws + WS_E);
  for (int tile = bid; tile < (NT / 128) * 4; tile += gridDim.x) {
    const int rt = tile >> 2, ct = tile & 3, row0 = rt * 128, col0 = ct * 128;
    f32x4 acc[4][2]; ACC_ZERO(acc);
    gemm_kloop(lds, y + (size_t)(row0 + lr) * 512 + lk, y + (size_t)(row0 + lr + 64) * 512 + lk, 64, wt + (size_t)(col0 + lr) * 512 + lk, wt + (size_t)(col0 + lr + 64) * 512 + lk, 8, acc);
#pragma unroll
    for (int m = 0; m < 4; ++m)
#pragma unroll
      for (int n = 0; n < 2; ++n) {
        const int row = row0 + wr * 64 + m * 16 + fr, col = col0 + wc * 32 + n * 16 + 4 * fq;
        const u32x2 yy = *(const u32x2*)(y + (size_t)row * 512 + col); const f32x4 v = acc[m][n];
        u32x2 o; o.x = pk2(bflo(yy.x) * sigmoidf_(v.x), bfhi(yy.x) * sigmoidf_(v.y)); o.y = pk2(bflo(yy.y) * sigmoidf_(v.z), bfhi(yy.y) * sigmoidf_(v.w));
        *(u32x2*)(ssm + (size_t)row * 512 + col) = o;
      }
  }
}
struct EpiInproj {
  static constexpr bool PERM = false, AFTER_DRAIN = false;
  bf16_t* qb; bf16_t* kvk; bf16_t* vT; bf16_t* mg; bf16_t* ub; float* gates;
  DI void operator()(const f32x4 (&acc)[2][2][4][2], const pg8::Unit& u, int wr, int wc, int fr_, int fq_) const {
    const int pn = u.pn; int fr = fr_, fq = fq_; asm volatile("" : "+v"(fr), "+v"(fq));
#pragma unroll
    for (int ai = 0; ai < 2; ++ai)
#pragma unroll
      for (int m = 0; m < 4; ++m) {
        const int row = u.pm * 256 + ai * 128 + wr * 64 + m * 16 + fr;
#pragma unroll
        for (int bj = 0; bj < 2; ++bj)
#pragma unroll
          for (int n = 0; n < 2; ++n) {
            const int cl = bj * 128 + wc * 32 + n * 16 + 4 * fq;
            const f32x4 v = acc[ai][bj][m][n];
            if (pn < 4) { u32x2 o; o.x = pk2(v.x * QSCALE, v.y * QSCALE); o.y = pk2(v.z * QSCALE, v.w * QSCALE); *(u32x2*)(qb + (size_t)row * DM + pn * 256 + cl) = o; }
            else if (pn < 10) {
              const int seg = pn - 4;
              if (seg == 5) {
                const int b = row >> 13, t = row & (SEQ - 1), g = cl >> 6, d = cl & 63;
                bf16_t* dst = vT + ((size_t)(((1 * NB + b) * 4 + g) * 64 + d)) * SEQ + perm16(t);
                dst[0] = (bf16_t)f2bf(v.x); dst[SEQ] = (bf16_t)f2bf(v.y); dst[2 * SEQ] = (bf16_t)f2bf(v.z); dst[3 * SEQ] = (bf16_t)f2bf(v.w);
              } else if (seg == 3) {
                const unsigned t = row & (SEQ - 1), pos = perm16(t) & 63;
                const unsigned ro = ((unsigned)(row >> 13) * 512u + (t >> 6)) * 4096u + (pos >> 3) * 256u + (pos & 7), co = (unsigned)(cl >> 6) * 524288u + (unsigned)((cl >> 5) & 1) * 2048u + (unsigned)(cl & 31) * 8u;
                bf16_t* dst = vT + (ro + co);
                dst[0] = (bf16_t)f2bf(v.x); dst[8] = (bf16_t)f2bf(v.y); dst[16] = (bf16_t)f2bf(v.z); dst[24] = (bf16_t)f2bf(v.w);
              } else if (seg == 2) {
                const unsigned t = row & (SEQ - 1);
                const unsigned ro = ((unsigned)(row >> 13) * 512u + (t >> 6)) * 4096u + ((t >> 5) & 1) * 2048u + (t & 31) * 8u, co = (unsigned)(cl >> 6) * 524288u + (unsigned)((cl >> 3) & 7) * 256u + (unsigned)(cl & 7);
                u32x2 o; o.x = pk2(v.x, v.y); o.y = pk2(v.z, v.w);
                *(u32x2*)(kvk + (WS_KSF - WS_C) / 2 + (ro + co)) = o;
              } else {
                const int slot = seg == 4 ? 3 : seg;
                u32x2 o; o.x = pk2(v.x, v.y); o.y = pk2(v.z, v.w); *(u32x2*)(kvk + (size_t)row * DM + slot * 256 + cl) = o;
              }
            } else if (pn < 18) {
              u32x2 o; o.x = pk2(sigmoidf_(v.x), sigmoidf_(v.y)); o.y = pk2(sigmoidf_(v.z), sigmoidf_(v.w)); *(u32x2*)(mg + (size_t)row * 2048 + (pn - 10) * 256 + cl) = o;
            } else if (pn < 20) { const int ch = (pn - 18) * 256 + cl; u32x2 o; o.x = pk2(v.x, v.y); o.y = pk2(v.z, v.w); *(u32x2*)(ub + ((size_t)(ch >> 4) * NT + row) * 16 + (ch & 15)) = o; }
            else { if (cl < 48) { f32x4 o = {sigmoidf_(v.x), sigmoidf_(v.y), sigmoidf_(v.z), sigmoidf_(v.w)}; *(f32x4*)(gates + (size_t)row * 48 + cl) = o; } }
          }
      }
  }
};
DI void phase_inproj8(const Params& P_, unsigned char* lds) {
  Params P = P_; { size_t z_ = 0; asm volatile("" : "+s"(z_)); P.ws = P_.ws + z_; }
  pg8::Gemm g{(const bf16_t*)(P.ws + WS_A), (const bf16_t*)(P.ws + WS_W + W_IN), NT, 5120, DM};
  pg8::StaticOrder S; S.init(NT, 5120, gridDim.x, obid());
  EpiInproj E{(bf16_t*)(P.ws + WS_B), (bf16_t*)(P.ws + WS_C), (bf16_t*)(P.ws + WS_DV), (bf16_t*)(P.ws + WS_F), (bf16_t*)(P.ws + WS_E), (float*)(P.ws + WS_GATES)};
  pg8::gemm_phase<EpiInproj, pg8::StaticOrder, true, true>((PG8_LAS unsigned char*)lds, g, S, E);
}
struct EpiMerge1 {
  static constexpr bool PERM = false, AFTER_DRAIN = false;
  const bf16_t* mg; bf16_t* tmp;
  DI void operator()(const f32x4 (&acc)[2][2][4][2], const pg8::Unit& u, int wr, int wc, int fr, int fq) const {
#pragma unroll
    for (int ai = 0; ai < 2; ++ai)
#pragma unroll
      for (int m = 0; m < 4; ++m) {
        const int row = u.pm * 256 + ai * 128 + wr * 64 + m * 16 + fr;
#pragma unroll
        for (int bj = 0; bj < 2; ++bj)
#pragma unroll
          for (int n = 0; n < 2; ++n) {
            const int col = u.pn * 256 + bj * 128 + wc * 32 + n * 16 + 4 * fq; const f32x4 v = acc[ai][bj][m][n];
            const u32x2 ga = *(const u32x2*)(mg + (size_t)row * 2048 + col);
            u32x2 o; o.x = pk2(v.x * bflo(ga.x), v.y * bfhi(ga.x)); o.y = pk2(v.z * bflo(ga.y), v.w * bfhi(ga.y));
            *(u32x2*)(tmp + (size_t)row * DM + col) = o;
          }
      }
  }
};
struct EpiMerge2 {
  static constexpr bool PERM = false, AFTER_DRAIN = false;
  const bf16_t* mg; const bf16_t* tmp; bf16_t* mer;
  DI void operator()(const f32x4 (&acc)[2][2][4][2], const pg8::Unit& u, int wr, int wc, int fr, int fq) const {
#pragma unroll
    for (int ai = 0; ai < 2; ++ai)
#pragma unroll
      for (int m = 0; m < 4; ++m) {
        const int row = u.pm * 256 + ai * 128 + wr * 64 + m * 16 + fr;
#pragma unroll
        for (int bj = 0; bj < 2; ++bj)
#pragma unroll
          for (int n = 0; n < 2; ++n) {
            const int col = u.pn * 256 + bj * 128 + wc * 32 + n * 16 + 4 * fq; const f32x4 v = acc[ai][bj][m][n];
            const u32x2 gs = *(const u32x2*)(mg + (size_t)row * 2048 + 1024 + col);
#if EN_ATTN
            const u32x2 tv = *(const u32x2*)(tmp + (size_t)row * DM + col);
            const float t0 = bflo(tv.x), t1 = bfhi(tv.x), t2 = bflo(tv.y), t3 = bfhi(tv.y);
#else
            const float t0 = 0.f, t1 = 0.f, t2 = 0.f, t3 = 0.f;
#endif
            u32x2 o; o.x = pk2(t0 + v.x * bflo(gs.x), t1 + v.y * bfhi(gs.x)); o.y = pk2(t2 + v.z * bflo(gs.y), t3 + v.w * bfhi(gs.y));
            *(u32x2*)(mer + (size_t)row * DM + col) = o;
          }
      }
  }
};
DI void phase_merge8(const Params& P_, unsigned char* lds) {
  Params P = P_; { size_t z_ = 0; asm volatile("" : "+s"(z_)); P.ws = P_.ws + z_; }
#if EN_ATTN
  { pg8::Gemm g{(const bf16_t*)(P.ws + WS_A), (const bf16_t*)(P.ws + WS_W + W_O), NT, DM, DM};
    pg8::StaticOrder S; S.init(NT, DM, gridDim.x, obid());
    EpiMerge1 E{(const bf16_t*)(P.ws + WS_F), (bf16_t*)(P.ws + WS_C)};
    pg8::gemm_phase<EpiMerge1, pg8::StaticOrder, true, true>((PG8_LAS unsigned char*)lds, g, S, E); }
#endif
  { pg8::Gemm g{(const bf16_t*)(P.ws + WS_E), (const bf16_t*)(P.ws + WS_W + W_SO), NT, DM, 512};
    pg8::StaticOrder S; S.init(NT, DM, gridDim.x, obid());
    EpiMerge2 E{(const bf16_t*)(P.ws + WS_F), (const bf16_t*)(P.ws + WS_C), (bf16_t*)(P.ws + WS_B)};
    pg8::gemm_phase<EpiMerge2, pg8::StaticOrder, true, true>((PG8_LAS unsigned char*)lds, g, S, E); }
}
struct EpiWout {
  static constexpr bool PERM = false, AFTER_DRAIN = false;
  const float* mod; const float* xin; float* out;
  DI void operator()(const f32x4 (&acc)[2][2][4][2], const pg8::Unit& u, int wr, int wc, int fr, int fq) const {
#pragma unroll
    for (int ai = 0; ai < 2; ++ai)
#pragma unroll
      for (int m = 0; m < 4; ++m) {
        const int row = u.pm * 256 + ai * 128 + wr * 64 + m * 16 + fr, b = row >> 13;
#pragma unroll
        for (int bj = 0; bj < 2; ++bj)
#pragma unroll
          for (int n = 0; n < 2; ++n) {
            const int col = u.pn * 256 + bj * 128 + wc * 32 + n * 16 + 4 * fq;
            const f32x4 g1 = *(const f32x4*)(mod + (size_t)b * 6144 + 2048 + col);
            const f32x4 xv = *(const f32x4*)(xin + (size_t)row * DM + col);
            *(f32x4*)(out + (size_t)row * DM + col) = xv + g1 * acc[ai][bj][m][n];
          }
      }
  }
};
DI void phase_wout8(const Params& P_, int l, unsigned char* lds) {
  Params P = P_; { size_t z_ = 0; asm volatile("" : "+s"(z_)); P.ws = P_.ws + z_; }
  pg8::Gemm g{(const bf16_t*)(P.ws + WS_B), (const bf16_t*)(P.ws + WS_W + W_OUT), NT, DM, DM};
  pg8::StaticOrder S; S.init(NT, DM, gridDim.x, obid());
  EpiWout E{(const float*)(P.ws + WS_MOD) + (size_t)(l * 2) * 6144, l == 0 ? P.in[0] : P.out, P.out};
  pg8::gemm_phase<EpiWout, pg8::StaticOrder, true, true>((PG8_LAS unsigned char*)lds, g, S, E);
}

DI bool moe_find(const int* cnt, int rb, int& e, int& rbl, int& ce) {
  int base = 0;
  for (int i = 0; i < NEXP; ++i) { const int c = cnt[i], nb = (c + 127) >> 7; if (rb < base + nb) { e = i; rbl = rb - base; ce = c; return true; } base += nb; }
  return false;
}
DI void phase_moe1(const Params& P_, int l, unsigned char* lds) {
  Params P = P_; { size_t z_ = 0; asm volatile("" : "+s"(z_)); P.ws = P_.ws + z_; }
  TILE_IDS;
  const int* cnt = (const int*)(P.ws + WS_CNT) + l * 32; const int* list = (const int*)(P.ws + WS_LIST);
  const bf16_t* h2 = (const bf16_t*)(P.ws + WS_A); bf16_t* act = (bf16_t*)(P.ws + WS_B);
  int total = 0; for (int i = 0; i < NEXP; ++i) total += (cnt[i] + 127) >> 7;
  for (int tile = bid; tile < total * 4; tile += gridDim.x) {
    const int rb = tile >> 2, ct = tile & 3; int e = 0, rbl = 0, ce = 1; moe_find(cnt, rb, e, rbl, ce);
    const bf16_t* wt = (const bf16_t*)(P.ws + WS_W + W_GU) + (size_t)e * 512 * 1024 + (size_t)(ct * 128) * 1024;
    const bf16_t* ap[2];
#pragma unroll
    for (int i = 0; i < 2; ++i) { int idx = rbl * 128 + lr + 64 * i; idx = idx < ce ? idx : ce - 1; const int tok = list[e * LISTCAP + idx] >> 1; ap[i] = h2 + (size_t)tok * DM + lk; }
    f32x4 acc[4][2]; ACC_ZERO(acc);
    gemm_kloop(lds, ap[0], ap[1], 64, wt + (size_t)lr * DM + lk, wt + (size_t)(lr + 64) * DM + lk, 16, acc);
#pragma unroll
    for (int m = 0; m < 4; ++m) {
      const int arow = rb * 128 + wr * 64 + m * 16 + fr, col = ct * 64 + wc * 16 + 4 * fq;
      const f32x4 g = acc[m][0], u = acc[m][1];
      u32x2 o; o.x = pk2(g.x * sigmoidf_(g.x) * u.x, g.y * sigmoidf_(g.y) * u.y); o.y = pk2(g.z * sigmoidf_(g.z) * u.z, g.w * sigmoidf_(g.w) * u.w);
      *(u32x2*)(act + (size_t)arow * 256 + col) = o;
    }
  }
}
DI void phase_moe2(const Params& P_, int l, unsigned char* lds) {
  Params P = P_; { size_t z_ = 0; asm volatile("" : "+s"(z_)); P.ws = P_.ws + z_; }
  TILE_IDS;
  const int* cnt = (const int*)(P.ws + WS_CNT) + l * 32; const int* list = (const int*)(P.ws + WS_LIST); const float* wts = (const float*)(P.ws + WS_WT);
  const bf16_t* act = (const bf16_t*)(P.ws + WS_B); bf16_t* ys = (bf16_t*)(P.ws + WS_F);
  constexpr int ASUB = 128 * GT_ROWB, BOFF = 4 * ASUB;
  int total = 0; for (int i = 0; i < NEXP; ++i) total += (cnt[i] + 127) >> 7;
  const int lkb = (tid & 7) * 16;
  for (int item = bid; item < total * 4; item += gridDim.x) {
    const int rb = item >> 2, ct0 = (item & 3) * 2; int e = 0, rbl = 0, ce = 1; moe_find(cnt, rb, e, rbl, ce);
    const bf16_t* wt = (const bf16_t*)(P.ws + WS_W + W_D) + (size_t)e * 1024 * 256;
    const bf16_t* a0 = act + (size_t)(rb * 128 + lr) * 256 + lk; const bf16_t* a1 = a0 + 64 * 256;
    u32x4 ra[8], xb0, xb1, yb0, yb1;
#pragma unroll
    for (int k = 0; k < 4; ++k) { ra[2 * k] = *(const u32x4*)(a0 + 64 * k); ra[2 * k + 1] = *(const u32x4*)(a1 + 64 * k); }
#define M2_BLOAD(q0_, q1_, s_) do { const bf16_t* bp_ = wt + (size_t)((ct0 + ((s_) >> 2)) * 128 + lr) * 256 + ((s_) & 3) * 64 + lk; q0_ = *(const u32x4*)bp_; q1_ = *(const u32x4*)(bp_ + 64 * 256); } while (0)
#define M2_BSTORE(q0_, q1_, buf_) do { unsigned char* s_ = lds + BOFF + (buf_) * ASUB; *(u32x4*)(s_ + lr * GT_ROWB + lkb) = q0_; *(u32x4*)(s_ + (lr + 64) * GT_ROWB + lkb) = q1_; } while (0)
#define M2_COMPUTE(s_, buf_) do { \
      const unsigned char* As = lds + ((s_) & 3) * ASUB + (wr * 64 + fr) * GT_ROWB + fq * 16; \
      const unsigned char* Bs = lds + BOFF + (buf_) * ASUB + (wc * 32 + fr) * GT_ROWB + fq * 16; \
      _Pragma("unroll") for (int ks = 0; ks < 2; ++ks) { \
        bf16x8 af[4], bfr[2]; \
        _Pragma("unroll") for (int m = 0; m < 4; ++m) af[m] = *(const bf16x8*)(As + m * 16 * GT_ROWB + ks * 64); \
        _Pragma("unroll") for (int n = 0; n < 2; ++n) bfr[n] = *(const bf16x8*)(Bs + n * 16 * GT_ROWB + ks * 64); \
        _Pragma("unroll") for (int m = 0; m < 4; ++m) _Pragma("unroll") for (int n = 0; n < 2; ++n) acc[m][n] = __builtin_amdgcn_mfma_f32_16x16x32_bf16(bfr[n], af[m], acc[m][n], 0, 0, 0); } } while (0)
#define M2_EPI(ct_) do { _Pragma("unroll") for (int m = 0; m < 4; ++m) { const int idx = rbl * 128 + wr * 64 + m * 16 + fr; \
      if (idx < ce) { const int slot = list[e * LISTCAP + idx]; const float w_ = wts[slot]; \
        _Pragma("unroll") for (int n = 0; n < 2; ++n) { const int col = (ct_) * 128 + wc * 32 + n * 16 + 4 * fq; const f32x4 v = acc[m][n] * w_; \
          u32x2 o; o.x = pk2(v.x, v.y); o.y = pk2(v.z, v.w); *(u32x2*)(ys + (size_t)slot * DM + col) = o; } } } ACC_ZERO(acc); } while (0)
    M2_BLOAD(xb0, xb1, 0);
#pragma unroll
    for (int k = 0; k < 4; ++k) { *(u32x4*)(lds + k * ASUB + lr * GT_ROWB + lkb) = ra[2 * k]; *(u32x4*)(lds + k * ASUB + (lr + 64) * GT_ROWB + lkb) = ra[2 * k + 1]; }
    M2_BSTORE(xb0, xb1, 0);
    M2_BLOAD(yb0, yb1, 1);
    __syncthreads();
    f32x4 acc[4][2]; ACC_ZERO(acc);
#pragma unroll 1
    for (int s2 = 0; s2 < 8; s2 += 2) {
      if (s2 + 2 < 8) M2_BLOAD(xb0, xb1, s2 + 2);
      M2_COMPUTE(s2, 0);
      M2_BSTORE(yb0, yb1, 1);
      __syncthreads();
      if (s2 + 3 < 8) M2_BLOAD(yb0, yb1, s2 + 3);
      M2_COMPUTE(s2 + 1, 1);
      if (s2 == 2) M2_EPI(ct0);
      if (s2 == 6) M2_EPI(ct0 + 1);
      if (s2 + 2 < 8) M2_BSTORE(xb0, xb1, 0);
      __syncthreads();
    }
#undef M2_BLOAD
#undef M2_BSTORE
#undef M2_COMPUTE
#undef M2_EPI
  }
}

typedef float f32x2v __attribute__((ext_vector_type(2)));
DI void phase_s5a(const Params& P_, int l, unsigned char* lds) {
  Params P = P_; { size_t z_ = 0; asm volatile("" : "+s"(z_)); P.ws = P_.ws + z_; }
  TILE_IDS;
  const bf16_t* ub = (const bf16_t*)(P.ws + WS_E); float* Lb = (float*)(P.ws + WS_L);
  const bf16_t* M1 = (const bf16_t*)(P.ws + WS_TAB + (size_t)l * TAB_LAYER + TAB_M1);
  const int first = (int)gridDim.x >= 192 ? 128 : 0;
  for (int tile = bid - first; tile >= 0 && tile < 64; tile += gridDim.x) {
    const int g = tile >> 1, rt = tile & 1;
    const bf16_t* a = ub + ((size_t)g * NT / 64 + rt * 128) * 1024;
    const bf16_t* wt = M1 + (size_t)g * 128 * 1024;
    f32x4 acc[4][2]; ACC_ZERO(acc);
    gemm_kloop(lds, a + (size_t)lr * 1024 + lk, a + (size_t)(lr + 64) * 1024 + lk, 64, wt + (size_t)lr * 1024 + lk, wt + (size_t)(lr + 64) * 1024 + lk, 16, acc);
#pragma unroll
    for (int m = 0; m < 4; ++m)
#pragma unroll
      for (int n = 0; n < 2; ++n) {
        const int R = rt * 128 + wr * 64 + m * 16 + fr, comp = wc * 32 + n * 16 + 4 * fq;
        *(f32x4*)(Lb + ((size_t)(R * 32 + g) * 64) * 2 + comp) = acc[m][n];
      }
  }
}
DI void s5_carry(const Params& P_, int l) {
  Params P = P_; { size_t z_ = 0; asm volatile("" : "+s"(z_)); P.ws = P_.ws + z_; }
  const int tid_ = otid(), bid = obid(), wave = tid_ >> 6, lane = tid_ & 63;
  const int item = (gridDim.x * NWAVE - 1) - (bid * NWAVE + wave);
  if (item >= NB * 32) return;
  const int b = item >> 5, g = item & 31;
  const float* pp = (const float*)(P.ws + WS_S5P) + (size_t)((l * 32 + g) * 64 + lane) * 36;
  const float aTr = pp[2], aTi = pp[3];
  float2* Lp = (float2*)(P.ws + WS_L) + ((size_t)(b * 128) * 32 + g) * 64 + lane;
  unsigned* Sp = (unsigned*)(P.ws + WS_SIN) + ((size_t)(g * 256 + b * 128)) * 64 + lane;
  float sr = 0.f, si = 0.f; asm volatile("" : "+v"(sr), "+v"(si));
  for (int c0 = 0; c0 < 128; c0 += 8) {
    float2 v[8];
#pragma unroll
    for (int k = 0; k < 8; ++k) v[k] = Lp[(size_t)(c0 + k) * 2048];
#pragma unroll
    for (int k = 0; k < 8; ++k) { Lp[(size_t)(c0 + k) * 2048] = make_float2(sr, si); Sp[(size_t)(c0 + k) * 64] = pk2(sr, si);
      const float nr = aTr * sr - aTi * si + v[k].x, ni = aTr * si + aTi * sr + v[k].y; sr = nr; si = ni; }
  }
}
DI void phase_s5c(const Params& P_, int l, unsigned char* lds) {
  Params P = P_; { size_t z_ = 0; asm volatile("" : "+s"(z_)); P.ws = P_.ws + z_; }
  TILE_IDS;
  const bf16_t* ub = (const bf16_t*)(P.ws + WS_E); const bf16_t* sinb = (const bf16_t*)(P.ws + WS_SIN); bf16_t* yb = (bf16_t*)(P.ws + WS_G);
  const bf16_t* tab = (const bf16_t*)(P.ws + WS_TAB + (size_t)l * TAB_LAYER);
  int* dctr = (int*)(P.ws + 640) + l; int* dslot = (int*)(lds + LDS_BYTES - 32);
  constexpr int ROWB = 144, SA = 0, SB = 128 * ROWB, STAGE = 2 * 128 * ROWB;
  const int lkb = (tid & 7) * 16, kch = tid & 7;
  for (;;) {
    if (threadIdx.x == 0) *dslot = atomicAdd(dctr, 1);
    __syncthreads();
    const int tile = *dslot;
    __syncthreads();
    if (tile >= 512) break;
    const int g = tile >> 4, rt = (tile >> 3) & 1, ct = tile & 7;
    const bf16_t* Kt = tab + TAB_KT / 2 + (size_t)g * 64 * 256; const bf16_t* M2 = tab + TAB_M2 / 2 + (size_t)g * 1024 * 128;
    const bf16_t* ua = ub + ((size_t)g * 256 + rt * 128) * 1024; const bf16_t* sa = sinb + ((size_t)g * 256 + rt * 128) * 128;
    const int nbt = 2 * ct + 2 < 16 ? 2 * ct + 2 : 16, ns = nbt + 2;
    u32x4 xa0, xa1, xb0, xb1, ya0, ya1, yb0, yb1;
#define S5_LOAD(p0_, p1_, q0_, q1_, s_) do { \
      if ((s_) < nbt) { p0_ = *(const u32x4*)(ua + (size_t)lr * 1024 + (s_) * 64 + lk); p1_ = *(const u32x4*)(ua + (size_t)(lr + 64) * 1024 + (s_) * 64 + lk); \
        const int i_ = 4 * (s_) + (kch >> 1), hq_ = (kch & 1) * 8; \
        { const int t_ = 8 * ct + (lr >> 4), h_ = lr & 15; q0_ = t_ >= i_ ? *(const u32x4*)(Kt + ((t_ - i_) * 16 + h_) * 16 + hq_) : (u32x4){0u, 0u, 0u, 0u}; } \
        { const int t_ = 8 * ct + 4 + (lr >> 4), h_ = lr & 15; q1_ = t_ >= i_ ? *(const u32x4*)(Kt + ((t_ - i_) * 16 + h_) * 16 + hq_) : (u32x4){0u, 0u, 0u, 0u}; } \
      } else { const int k0_ = ((s_) - nbt) * 64 + lk; \
        p0_ = *(const u32x4*)(sa + (size_t)lr * 128 + k0_); p1_ = *(const u32x4*)(sa + (size_t)(lr + 64) * 128 + k0_); \
        q0_ = *(const u32x4*)(M2 + (size_t)(ct * 128 + lr) * 128 + k0_); q1_ = *(const u32x4*)(M2 + (size_t)(ct * 128 + lr + 64) * 128 + k0_); } } while (0)
#define S5_STORE(p0_, p1_, q0_, q1_, buf) do { unsigned char* s_ = lds + (buf) * STAGE; \
      *(u32x4*)(s_ + SA + lr * ROWB + lkb) = p0_; *(u32x4*)(s_ + SA + (lr + 64) * ROWB + lkb) = p1_; \
      *(u32x4*)(s_ + SB + lr * ROWB + lkb) = q0_; *(u32x4*)(s_ + SB + (lr + 64) * ROWB + lkb) = q1_; } while (0)
#define S5_COMPUTE(buf) do { \
      const unsigned char* As = lds + (buf) * STAGE + SA + (wr * 64 + fr) * ROWB + fq * 16; \
      const unsigned char* Bs = lds + (buf) * STAGE + SB + (wc * 32 + fr) * ROWB + fq * 16; \
      _Pragma("unroll") for (int ks = 0; ks < 2; ++ks) { \
        bf16x8 af[4], bfr[2]; \
        _Pragma("unroll") for (int m = 0; m < 4; ++m) af[m] = *(const bf16x8*)(As + m * 16 * ROWB + ks * 64); \
        _Pragma("unroll") for (int n = 0; n < 2; ++n) bfr[n] = *(const bf16x8*)(Bs + n * 16 * ROWB + ks * 64); \
        _Pragma("unroll") for (int m = 0; m < 4; ++m) _Pragma("unroll") for (int n = 0; n < 2; ++n) acc[m][n] = __builtin_amdgcn_mfma_f32_16x16x32_bf16(bfr[n], af[m], acc[m][n], 0, 0, 0); } } while (0)
    f32x4 acc[4][2]; ACC_ZERO(acc);
    S5_LOAD(xa0, xa1, xb0, xb1, 0); S5_STORE(xa0, xa1, xb0, xb1, 0); S5_LOAD(ya0, ya1, yb0, yb1, 1); __syncthreads();
    for (int st = 0; st < ns; st += 2) {
      if (st + 2 < ns) S5_LOAD(xa0, xa1, xb0, xb1, st + 2);
      S5_COMPUTE(0);
      if (st + 1 < ns) S5_STORE(ya0, ya1, yb0, yb1, 1);
      __syncthreads();
      if (st + 1 >= ns) break;
      if (st + 3 < ns) S5_LOAD(ya0, ya1, yb0, yb1, st + 3);
      S5_COMPUTE(1);
      if (st + 2 < ns) S5_STORE(xa0, xa1, xb0, xb1, 0);
      __syncthreads();
    }
#undef S5_LOAD
#undef S5_STORE
#undef S5_COMPUTE
    const float* dsk = P.in[13] + (size_t)(l * 32 + g) * 16;
#pragma unroll
    for (int m = 0; m < 4; ++m)
#pragma unroll
      for (int n = 0; n < 2; ++n) {
        const int R = rt * 128 + wr * 64 + m * 16 + fr, col = ct * 128 + wc * 32 + n * 16 + 4 * fq, t = col >> 4, h = col & 15;
        const u32x2 uu = *(const u32x2*)(ub + ((size_t)g * 256 + R) * 1024 + col); const f32x4 dd = *(const f32x4*)(dsk + h); const f32x4 v = acc[m][n];
        const float y0 = gelu_tanh(v.x + dd.x * bflo(uu.x)), y1 = gelu_tanh(v.y + dd.y * bfhi(uu.x)), y2 = gelu_tanh(v.z + dd.z * bflo(uu.y)), y3 = gelu_tanh(v.w + dd.w * bfhi(uu.y));
        const size_t tokn = (size_t)(R >> 7) * SEQ + 64 * (R & 127) + t;
        u32x2 o; o.x = pk2(y0, y1); o.y = pk2(y2, y3); *(u32x2*)(yb + tokn * 512 + g * 16 + h) = o;
      }
  }
}

constexpr int AT_ROWB = 144, AT_KS = 0, AT_VS = 2 * 64 * AT_ROWB, AT_IMP = 4 * 64 * AT_ROWB, AT_OACC = AT_IMP, AT_IMPS = 129, AT_EE = AT_IMP + 64 * AT_IMPS * 4,
              AT_SEL = AT_IMP + 66048, AT_QS = AT_SEL + 1024, AT_QL = AT_QS + 32768, AT_NJ = AT_QL + 8192, AT_ITEMS = AT_NJ + 512, AT_MREF = AT_ITEMS + 512,
              AT_LACC = AT_MREF + 1024, AT_INVQ = AT_LACC + 1024, AT_MISC = AT_INVQ + 512, AT_LOWN = AT_MISC + 64, AT_END = AT_LOWN + 1024;
static_assert(AT_END <= LDS_BYTES - 16, "attention LDS");
#define MFMA32(a, b, c) __builtin_amdgcn_mfma_f32_32x32x16_bf16((a), (b), (c), 0, 0, 0)
DI int crow_of(int reg, int hh) { return (reg & 3) + 8 * (reg >> 2) + 4 * hh; }

struct AttnState { f32x16 o0, o1; float m, l; };
DI void st_init(AttnState& S) { S.m = -1e30f; S.l = 0.f;
#pragma unroll
  for (int i = 0; i < 16; ++i) { S.o0[i] = 0.f; S.o1[i] = 0.f; } }

DI void at_qk(const unsigned char* lds, int buf, int r, int hh, int qrow, f32x16& p0, f32x16& p1) {
  const unsigned char* kb = lds + AT_KS + buf * 64 * AT_ROWB + r * AT_ROWB + hh * 16;
  const unsigned char* qp = lds + AT_QS + qrow * 128;
  const f32x16 z = {0.f, 0.f, 0.f, 0.f, 0.f, 0.f, 0.f, 0.f, 0.f, 0.f, 0.f, 0.f, 0.f, 0.f, 0.f, 0.f};
#pragma unroll
  for (int ds = 0; ds < 4; ++ds) { const bf16x8 a0 = *(const bf16x8*)(kb + ds * 32), a1 = *(const bf16x8*)(kb + 32 * AT_ROWB + ds * 32);
    const bf16x8 q = *(const bf16x8*)(qp + (((ds * 2 + hh) ^ (qrow & 7)) * 16));
    if (ds == 0) { p0 = MFMA32(a0, q, z); p1 = MFMA32(a1, q, z); } else { p0 = MFMA32(a0, q, p0); p1 = MFMA32(a1, q, p1); }
    if (ds == 1) __builtin_amdgcn_sched_barrier(0); }
}
DI bf16x8 pack8(const f32x16& p, int s2) {
  u32x4 w; w.x = pk2(p[8 * s2], p[8 * s2 + 1]); w.y = pk2(p[8 * s2 + 2], p[8 * s2 + 3]); w.z = pk2(p[8 * s2 + 4], p[8 * s2 + 5]); w.w = pk2(p[8 * s2 + 6], p[8 * s2 + 7]);
  return __builtin_bit_cast(bf16x8, w);
}
DI void at_pv(const unsigned char* lds, int buf, int r, int hh, const f32x16& p0, const f32x16& p1, f32x16& oa, f32x16& ob) {
  const unsigned char* vb = lds + AT_VS + buf * 64 * AT_ROWB + r * AT_ROWB + hh * 16;
#pragma unroll
  for (int gk = 0; gk < 4; ++gk) {
    const bf16x8 pb = (gk < 2) ? pack8(p0, gk & 1) : pack8(p1, gk & 1);
    const bf16x8 va = *(const bf16x8*)(vb + gk * 32), vb2 = *(const bf16x8*)(vb + 32 * AT_ROWB + gk * 32);
    oa = MFMA32(va, pb, oa); ob = MFMA32(vb2, pb, ob);
    if (gk == 1) __builtin_amdgcn_sched_barrier(0);
  }
}
template <int MODE>
DI void at_online(AttnState& S, f32x16& p0, f32x16& p1, int key0, int lo, int hi, bool on, int hh) {
  float tm = -1e30f;
  if (MODE == 1) {
    int lor = lo - key0 - 4 * hh, hir = hi - key0 - 4 * hh;
    if (hir < lor) { lor = 4096; hir = 4096; }
    const unsigned span = (unsigned)(hir - lor);
#pragma unroll
    for (int i = 0; i < 16; ++i) { const int c0 = (i & 3) + 8 * (i >> 2);
      p0[i] = ((unsigned)(c0 - lor) <= span) ? p0[i] : -1e30f; p1[i] = ((unsigned)(c0 + 32 - lor) <= span) ? p1[i] : -1e30f; }
  }
  if (MODE != 1) asm volatile("s_nop 15\n\ts_nop 7" : "+v"(p0), "+v"(p1));
#pragma unroll
  for (int i = 0; i < 16; ++i) asm("v_max3_f32 %0, %0, %1, %2" : "+v"(tm) : "v"(p0[i]), "v"(p1[i]));
  tm = fmaxf(tm, __shfl_xor(tm, 32));
  if (MODE == 2) tm = on ? tm : -1e30f;
  if (__any(tm > S.m)) {
    const float mn = fmaxf(S.m, tm); const float al = __builtin_amdgcn_exp2f(S.m - mn); S.m = mn; S.l *= al;
#pragma unroll
    for (int i = 0; i < 16; ++i) { S.o0[i] *= al; S.o1[i] *= al; }
  }
  float mn = S.m;
  if (MODE == 2) mn = on ? mn : 1e30f;
  if (MODE == 1) mn = mn < -1e29f ? 1e30f : mn;
  float rs = 0.f;
#pragma unroll
  for (int i = 0; i < 16; ++i) {
    const float e0 = __builtin_amdgcn_exp2f(p0[i] - mn), e1 = __builtin_amdgcn_exp2f(p1[i] - mn);
    p0[i] = e0; p1[i] = e1; rs += e0 + e1;
  }
  S.l += rs;
}

DI void attn_tile(const Params& P_, unsigned char* lds, int b, int g, int c) {
  Params P = P_; { size_t z_ = 0; asm volatile("" : "+s"(z_)); P.ws = P_.ws + z_; }
#define AT_IDS const int tid = otid(), lane = tid & 63, w = tid >> 6, r = lane & 31, hh = lane >> 5, qi = 8 * w + (r >> 2), h = r & 3, t = 64 * c + qi, qrow = 32 * w + r, srow = tid >> 3, sch = (tid & 7) * 8, ahead = lane >> 4, ach = lane & 15; const unsigned tok = (unsigned)b * SEQ + t, goff = tok * 48 + g * 4 + h; (void)qi; (void)h; (void)t; (void)qrow; (void)srow; (void)sch; (void)ahead; (void)ach; (void)tok; (void)goff; (void)hh; (void)w; (void)r
  const bf16_t* qb = (const bf16_t*)(P.ws + WS_B); const bf16_t* kvk = (const bf16_t*)(P.ws + WS_C); const bf16_t* vT = (const bf16_t*)(P.ws + WS_DV);
  const bf16_t* kcb = (const bf16_t*)(P.ws + WS_KC); const bf16_t* vcb = (const bf16_t*)(P.ws + WS_VC);
  const float* gbase = (const float*)(P.ws + WS_GATES);
#define gates(i) gbase[goff + (i)]
  bf16_t* attn = (bf16_t*)(P.ws + WS_A);
  float* otb = (float*)(P.ws + WS_OT) + (size_t)obid() * 16384;
#define otg(i) otb[(unsigned)tid + (i) * 512u]
  float* IMP = (float*)(lds + AT_IMP); float* EE = (float*)(lds + AT_EE); unsigned* SEL = (unsigned*)(lds + AT_SEL);
  AttnState S; f32x16 p0, p1; u32x4 rkA, rvA;
  { AT_IDS;
  { const int row = tid >> 1, half = tid & 1, q_i = row >> 2, hd = row & 3;
    const unsigned so = ((unsigned)b * SEQ + 64 * c + q_i) * DM + (g * 4 + hd) * 64 + half * 32;
#pragma unroll
    for (int k = 0; k < 4; ++k) { const u32x4 v = *(const u32x4*)(qb + so + k * 8); *(u32x4*)(lds + AT_QS + row * 128 + (((half * 4 + k) ^ (row & 7)) * 16)) = v; } }
  __syncthreads();
#define ST_LOAD(rk, rv, kp, kstride, vp, vstride, kt) do { rk = *(const u32x4*)((kp) + (unsigned)(((kt) * 64 + srow) * (kstride) + sch)); rv = *(const u32x4*)((vp) + (unsigned)(srow * (vstride) + (kt) * 64 + sch)); } while (0)
#define ST_STORE(rk, rv, buf) do { *(u32x4*)(lds + AT_KS + (buf) * 64 * AT_ROWB + srow * AT_ROWB + sch * 2) = rk; *(u32x4*)(lds + AT_VS + (buf) * 64 * AT_ROWB + srow * AT_ROWB + sch * 2) = rv; } while (0)
#define SWEEP(kp, kstride, vp, vstride, kt0, n, ...) do { \
    ST_LOAD(rkA, rvA, kp, kstride, vp, vstride, (kt0)); ST_STORE(rkA, rvA, 0); __syncthreads(); \
    for (int i_ = 0; i_ < (n); ++i_) { \
      if (i_ + 1 < (n)) ST_LOAD(rkA, rvA, kp, kstride, vp, vstride, (kt0) + i_ + 1); \
      { const int step_ = i_; const int buf_ = i_ & 1; __VA_ARGS__ } \
      if (i_ + 1 < (n)) ST_STORE(rkA, rvA, (i_ + 1) & 1); \
      __syncthreads(); \
    } } while (0)
#define ST_LOADF(rk, rv, kt) do { rk = *(const u32x4*)(kps + (size_t)(kt) * 4096 + tid * 8); rv = *(const u32x4*)(vps + (size_t)(kt) * 4096 + tid * 8); } while (0)
#define ST_STOREF(rk, rv, buf) do { const int fo_ = ((tid >> 8) * 32 + (tid & 31)) * AT_ROWB + (((tid >> 6) & 3) * 2 + ((tid >> 5) & 1)) * 16; \
    *(u32x4*)(lds + AT_KS + (buf) * 64 * AT_ROWB + fo_) = rk; *(u32x4*)(lds + AT_VS + (buf) * 64 * AT_ROWB + fo_) = rv; } while (0)
#define SWEEPF(kt0, n, ...) do { \
    ST_LOADF(rkA, rvA, (kt0)); ST_STOREF(rkA, rvA, 0); __syncthreads(); \
    for (int i_ = 0; i_ < (n); ++i_) { \
      if (i_ + 1 < (n)) ST_LOADF(rkA, rvA, (kt0) + i_ + 1); \
      { const int step_ = i_; const int buf_ = i_ & 1; __VA_ARGS__ } \
      if (i_ + 1 < (n)) ST_STOREF(rkA, rvA, (i_ + 1) & 1); \
      __syncthreads(); \
    } } while (0)
  {
    const bf16_t* kp = kvk + (size_t)b * SEQ * DM + 3 * 256 + g * 64; const bf16_t* vp = vT + (size_t)(((1 * NB + b) * 4 + g) * 64) * SEQ;
    const int j0 = c >= 8 ? c - 8 : 0, nj = c - j0 + 1;
    st_init(S);
    SWEEP(kp, DM, vp, SEQ, j0, nj, {
      at_qk(lds, buf_, r, hh, qrow, p0, p1);
      at_online<1>(S, p0, p1, (j0 + step_) * 64, t - 511, t, true, hh);
      at_pv(lds, buf_, r, hh, p0, p1, S.o0, S.o1); });
    const float lt = S.l + __shfl_xor(S.l, 32); const float sc = lt > 0.f ? gates(32) / lt : 0.f;
#pragma unroll
    for (int i = 0; i < 16; ++i) { otg(i) = S.o0[i] * sc; otg(16 + i) = S.o1[i] * sc; }
  }
  {
    const bf16_t* kcp = kcb + (size_t)((b * 4 + g) * 512) * 64; const bf16_t* vcp = vcb + (size_t)((b * 4 + g) * 64) * 512;
    const int nmax = t >= 31 ? (t - 31) >> 4 : -1;
    const int nct = (4 * c + 2) / 64 + 1;
    st_init(S);
    SWEEP(kcp, 64, vcp, 512, 0, nct, {
      at_qk(lds, buf_, r, hh, qrow, p0, p1);
      at_online<1>(S, p0, p1, step_ * 64, 0, nmax, true, hh); });
    const float lt = S.l + __shfl_xor(S.l, 32);
    const float cinv = lt > 0.f ? 1.f / lt : 0.f; const float cm = S.m;
    st_init(S);
    SWEEP(kcp, 64, vcp, 512, 0, nct, {
      at_qk(lds, buf_, r, hh, qrow, p0, p1);
      const int nrel = nmax - step_ * 64 - 4 * hh;
      _Pragma("unroll") for (int k = 0; k < 16; ++k) { const int c0 = (k & 3) + 8 * (k >> 2), c1 = c0 + 32;
        p0[k] = c0 <= nrel ? __builtin_amdgcn_exp2f(p0[k] - cm) * cinv : 0.f; p1[k] = c1 <= nrel ? __builtin_amdgcn_exp2f(p1[k] - cm) * cinv : 0.f; }
      at_pv(lds, buf_, r, hh, p0, p1, S.o0, S.o1);
      _Pragma("unroll") for (int kh = 0; kh < 2; ++kh)
      _Pragma("unroll") for (int gi = 0; gi < 4; ++gi) {
          float g4 = kh == 0 ? (p0[4 * gi] + p0[4 * gi + 1]) + (p0[4 * gi + 2] + p0[4 * gi + 3]) : (p1[4 * gi] + p1[4 * gi + 1]) + (p1[4 * gi + 2] + p1[4 * gi + 3]);
          float e3 = kh == 0 ? p0[4 * gi + 3] : p1[4 * gi + 3];
          g4 += __shfl_xor(g4, 1); g4 += __shfl_xor(g4, 2); e3 += __shfl_xor(e3, 1); e3 += __shfl_xor(e3, 2);
          if (h == 0) { const int s = (step_ * 64 + kh * 32 + 8 * gi + 4 * hh) >> 2; IMP[qi * AT_IMPS + s] = g4; EE[qi * AT_IMPS + s] = e3; }
      } });
    const float gc = gates(0);
#pragma unroll
    for (int i = 0; i < 16; ++i) { otg(i) += S.o0[i] * gc; otg(16 + i) += S.o1[i] * gc; }
  }
  }
  const bf16_t* kps = (const bf16_t*)(P.ws + WS_KSF) + (size_t)((b * 4 + g) * 128) * 4096; const bf16_t* vps = vT + (size_t)((b * 4 + g) * 128) * 4096;
  if (c <= 15) { AT_IDS;
    st_init(S);
    if (c > 0) {
      SWEEPF(0, c, {
        at_qk(lds, buf_, r, hh, qrow, p0, p1);
        at_online<0>(S, p0, p1, 0, 0, 0, true, hh);
        at_pv(lds, buf_, r, hh, p0, p1, S.o0, S.o1); });
    }
    SWEEPF(c, 1, {
      at_qk(lds, buf_, r, hh, qrow, p0, p1);
      at_online<1>(S, p0, p1, (c + step_) * 64, 0, t, true, hh);
      at_pv(lds, buf_, r, hh, p0, p1, S.o0, S.o1); });
    const float lt = S.l + __shfl_xor(S.l, 32); const float slc_sc = lt > 0.f ? gates(16) / lt : 0.f;
    bf16_t* op = attn + (tok * DM + (g * 4 + h) * 64);
#pragma unroll
    for (int i = 0; i < 16; ++i) { S.o0[i] = S.o0[i] * slc_sc + otg(i); S.o1[i] = S.o1[i] * slc_sc + otg(16 + i); }
#pragma unroll
    for (int gi = 0; gi < 4; ++gi) {
      u32x2 a; a.x = pk2(S.o0[4 * gi], S.o0[4 * gi + 1]); a.y = pk2(S.o0[4 * gi + 2], S.o0[4 * gi + 3]);
      u32x2 bq; bq.x = pk2(S.o1[4 * gi], S.o1[4 * gi + 1]); bq.y = pk2(S.o1[4 * gi + 2], S.o1[4 * gi + 3]);
      *(u32x2*)(op + 8 * gi + 4 * hh) = a; *(u32x2*)(op + 32 + 8 * gi + 4 * hh) = bq;
    }
  } else {
    const int nc = c - 2;
    unsigned char* QL = lds + AT_QL; int* NJ = (int*)(lds + AT_NJ); unsigned short* ITEMS = (unsigned short*)(lds + AT_ITEMS); int* MISC = (int*)(lds + AT_MISC);
    float* MREF = (float*)(lds + AT_MREF); float* LS = (float*)(lds + AT_LACC); unsigned char* INVQ = lds + AT_INVQ; unsigned char* SLOT = lds + AT_IMP;
    float* const LOWN = (float*)(lds + AT_LOWN); const float k64 = 5.421010862427522e-20f;
    { AT_IDS;
    for (int idx = tid; idx < 64 * nc; idx += NTHR) { const int q = idx / nc, s = 1 + idx % nc; IMP[q * AT_IMPS + s] += EE[q * AT_IMPS + s - 1]; }
    if (tid < 256) SEL[tid] = 0u;
    if (tid < 128) ((unsigned*)INVQ)[tid] = 0u;
    __syncthreads();
    {
      const int q = tid >> 3, sub = tid & 7; const float* ip = IMP + q * AT_IMPS;
      unsigned key[16];
#pragma unroll
      for (int k = 0; k < 16; ++k) { const int s = 1 + sub + 8 * k; key[k] = s <= nc ? __float_as_uint(ip[s]) + 1u : 0u; }
      unsigned T = 0u;
      for (int bit = 30; bit >= 0; --bit) {
        const unsigned cand = T | (1u << bit); int cn = 0;
#pragma unroll
        for (int k = 0; k < 16; ++k) cn += key[k] >= cand ? 1 : 0;
        cn += __shfl_xor(cn, 1); cn += __shfl_xor(cn, 2); cn += __shfl_xor(cn, 4);
        if (cn >= 13) T = cand;
      }
      int ngt = 0, neq = 0;
#pragma unroll
      for (int k = 0; k < 16; ++k) { ngt += key[k] > T ? 1 : 0; neq += key[k] == T ? 1 : 0; }
      ngt += __shfl_xor(ngt, 1); ngt += __shfl_xor(ngt, 2); ngt += __shfl_xor(ngt, 4);
      neq += __shfl_xor(neq, 1); neq += __shfl_xor(neq, 2); neq += __shfl_xor(neq, 4);
      const int need = 13 - ngt;
      unsigned w0 = 0u, w1 = 0u, w2 = 0u, w3 = 0u;
      if (!__any(neq > need)) {
#pragma unroll
        for (int k = 0; k < 16; ++k) if (key[k] >= T && key[k] != 0u) { const int s = 1 + sub + 8 * k; const unsigned bt = 1u << (s & 31); if (s < 32) w0 |= bt; else if (s < 64) w1 |= bt; else if (s < 96) w2 |= bt; else w3 |= bt; }
      } else {
        int taken = 0; const int gsh = lane & ~7;
#pragma unroll
        for (int k = 0; k < 16; ++k) {
          const bool eq = key[k] == T && key[k] != 0u; const unsigned long long mk = __ballot(eq);
          const unsigned grp = (unsigned)(mk >> gsh) & 0xffu; const int before = __popc(grp & ((1u << sub) - 1u));
          const bool pick = key[k] > T || (eq && taken + before < need);
          taken += __popc(grp);
          if (pick) { const int s = 1 + sub + 8 * k; const unsigned bt = 1u << (s & 31); if (s < 32) w0 |= bt; else if (s < 64) w1 |= bt; else if (s < 96) w2 |= bt; else w3 |= bt; }
        }
      }
      if (w0) atomicOr(&SEL[q * 4], w0); if (w1) atomicOr(&SEL[q * 4 + 1], w1); if (w2) atomicOr(&SEL[q * 4 + 2], w2); if (w3) atomicOr(&SEL[q * 4 + 3], w3);
    }
    __syncthreads();
    for (int j = 1 + w; j <= nc; j += NWAVE) {
      const bool bit = (SEL[lane * 4 + (j >> 5)] >> (j & 31)) & 1u;
      const unsigned long long mk = __ballot(bit);
      const int rank = __builtin_amdgcn_mbcnt_hi((unsigned)(mk >> 32), __builtin_amdgcn_mbcnt_lo((unsigned)mk, 0u));
      if (bit) QL[j * 64 + rank] = (unsigned char)lane;
      const int cnt = __popcll(mk);
      if (lane < ((8 - (cnt & 7)) & 7)) QL[j * 64 + cnt + lane] = 0;
      if (lane == 0) NJ[j] = cnt;
    }
    __syncthreads();
    if (w == 0) {
      const int ja = 1 + lane, jb = 65 + lane;
      const int ca = ja <= nc ? (NJ[ja] + 7) >> 3 : 0, cb = jb <= nc ? (NJ[jb] + 7) >> 3 : 0;
      int sa = ca, sb = cb;
#pragma unroll
      for (int o = 1; o < 64; o <<= 1) { const int ta = __shfl_up(sa, o), tb = __shfl_up(sb, o); if (lane >= o) { sa += ta; sb += tb; } }
      const int tota = __shfl(sa, 63);
      for (int k = 0; k < ca; ++k) ITEMS[sa - ca + k] = (unsigned short)(ja * 8 + k);
      for (int k = 0; k < cb; ++k) ITEMS[tota + sb - cb + k] = (unsigned short)(jb * 8 + k);
      if (lane == 63) MISC[0] = tota + sb;
    }
    }
    { AT_IDS;
    st_init(S);
    SWEEPF(0, 1, {
      at_qk(lds, buf_, r, hh, qrow, p0, p1);
      at_online<0>(S, p0, p1, 0, 0, 0, true, hh);
      at_pv(lds, buf_, r, hh, p0, p1, S.o0, S.o1); });
    SWEEPF(c - 1, 2, {
      at_qk(lds, buf_, r, hh, qrow, p0, p1);
      if (step_ == 1) at_online<1>(S, p0, p1, c * 64, 0, t, true, hh); else at_online<0>(S, p0, p1, 0, 0, 0, true, hh);
      at_pv(lds, buf_, r, hh, p0, p1, S.o0, S.o1); });
    { const float lt = S.l + __shfl_xor(S.l, 32);
      if (hh == 0) { MREF[qrow] = S.m + 64.f; LS[w * 32 + r] = lt * k64; } }
#define SLOT_WRITE(x, o0_, o1_, scale_) do { unsigned char* sp_ = SLOT + (x) * 8192 + r * 256; \
      _Pragma("unroll") for (int gi_ = 0; gi_ < 4; ++gi_) { \
        const f32x4 va_ = {o0_[4 * gi_] * (scale_), o0_[4 * gi_ + 1] * (scale_), o0_[4 * gi_ + 2] * (scale_), o0_[4 * gi_ + 3] * (scale_)}; \
        const f32x4 vb_ = {o1_[4 * gi_] * (scale_), o1_[4 * gi_ + 1] * (scale_), o1_[4 * gi_ + 2] * (scale_), o1_[4 * gi_ + 3] * (scale_)}; \
        *(f32x4*)(sp_ + (((2 * gi_ + hh) ^ (r & 15)) * 16)) = va_; *(f32x4*)(sp_ + (((8 + 2 * gi_ + hh) ^ (r & 15)) * 16)) = vb_; } } while (0)
#define SLOT_READ(x, col_) (*(const f32x4*)(SLOT + (x) * 8192 + (col_) * 256 + ((ach ^ ((col_) & 15)) * 16)))
    SLOT_WRITE(w, S.o0, S.o1, k64);
    __syncthreads();
    }
    {
      AT_IDS; const int wu = __builtin_amdgcn_readfirstlane(w);
      const int nitems = MISC[0], nrounds = (nitems + 3) >> 2;
      if (wu >= 4) {
        const int ow = wu - 4, oq = lane >> 2, oh = lane & 3, srcslot = 2 * ow + (lane >> 5), scol = lane & 31;
        f32x4 acc[16]; float accl;
        { const unsigned char* rp = SLOT + srcslot * 8192 + scol * 256;
#pragma unroll
          for (int k = 0; k < 16; ++k) acc[k] = *(const f32x4*)(rp + ((k ^ (scol & 15)) * 16));
          accl = LS[srcslot * 32 + scol]; }
        __syncthreads();
        for (int rd = 0; rd <= nrounds; ++rd) {
          if (rd > 0) {
            const int set = (rd - 1) & 1;
            unsigned* ivp = (unsigned*)(INVQ + set * 256) + 16 * ow + oq;
            unsigned iv = *ivp;
            if (__any(iv != 0u)) {
              if (iv != 0u && oh == 0) *ivp = 0u;
              do {
                const int x = (iv & 0xffu) ? 0 : (iv & 0xff00u) ? 1 : (iv & 0xff0000u) ? 2 : 3;
                const unsigned byte = (iv >> (8 * x)) & 0xffu;
                iv &= ~(0xffu << (8 * x));
                if (byte) {
                  const int col = (int)(byte - 1) * 4 + oh;
                  const unsigned char* rp = SLOT + (set * 4 + x) * 8192 + col * 256;
                  f32x4 tq[16];
#pragma unroll
                  for (int k = 0; k < 16; ++k) tq[k] = *(const f32x4*)(rp + ((k ^ (col & 15)) * 16));
                  const float tl = LS[(set * 4 + x) * 32 + col];
                  __builtin_amdgcn_sched_barrier(0);
#pragma unroll
                  for (int k = 0; k < 16; ++k) acc[k] += tq[k];
                  accl += tl;
                }
              } while (__any(iv != 0u));
            }
          }
          __syncthreads();
        }
#pragma unroll
        for (int i = 0; i < 16; ++i) { S.o0[i] = otg(i); S.o1[i] = otg(16 + i); }
        SLOT_WRITE(w, S.o0, S.o1, 1.0f);
        __syncthreads();
        {
          const unsigned tq = (unsigned)b * SEQ + 64 * c + 16 * ow + oq;
          const float gs = gbase[tq * 48 + 16 + g * 4 + oh]; const float sc = accl > 0.f ? gs / accl : 0.f;
          const unsigned char* rp = SLOT + srcslot * 8192 + scol * 256;
          bf16_t* op = attn + (tq * DM + (g * 4 + oh) * 64);
#pragma unroll
          for (int k2 = 0; k2 < 8; ++k2) {
            const f32x4 v0 = acc[2 * k2] * sc + *(const f32x4*)(rp + (((2 * k2) ^ (scol & 15)) * 16)), v1 = acc[2 * k2 + 1] * sc + *(const f32x4*)(rp + (((2 * k2 + 1) ^ (scol & 15)) * 16));
            u32x4 o; o.x = pk2(v0.x, v0.y); o.y = pk2(v0.z, v0.w); o.z = pk2(v1.x, v1.y); o.w = pk2(v1.z, v1.w);
            *(u32x4*)(op + 8 * k2) = o;
          }
        }
      } else {
        __syncthreads();
        const bf16_t* kgl = kps + lane * 8; const bf16_t* vgl = vps + lane * 8;
        bf16x8 kfA[8], vfA[8], kfB[8], vfB[8];
#define FLOAD(KF, VF, jj) do { _Pragma("unroll") for (int f_ = 0; f_ < 8; ++f_) { KF[f_] = *(const bf16x8*)(kgl + (size_t)(jj) * 4096 + f_ * 512); VF[f_] = *(const bf16x8*)(vgl + (size_t)(jj) * 4096 + f_ * 512); } } while (0)
        int rowc = 0, qqc = 0; bool validc = false; float mrc = 1e30f; int en = 0;
        if (wu < nitems) { const int e0 = ITEMS[wu]; const int j0_ = e0 >> 3; const int qs_ = 8 * (e0 & 7) + (r >> 2); validc = qs_ < NJ[j0_]; qqc = QL[j0_ * 64 + qs_]; rowc = qqc * 4 + h; mrc = validc ? MREF[rowc] : 1e30f; FLOAD(kfA, vfA, j0_); }
        if (wu + 4 < nitems) en = __builtin_amdgcn_readfirstlane(ITEMS[wu + 4]);
        FLOAD(kfB, vfB, en >> 3);
#define ITEM_ROUND(KF, VF, rd_) do { \
          const int it = (rd_) * 4 + wu, set = (rd_) & 1; \
          if (it < nitems) { \
            const bool hasn = it + 4 < nitems; \
            const int jn = en >> 3, qsn = 8 * (en & 7) + (r >> 2);        \
            const int njn = NJ[jn]; const int qqn = QL[jn * 64 + qsn]; \
            const int en2 = it + 8 < nitems ? __builtin_amdgcn_readfirstlane(ITEMS[it + 8]) : 0; const int j2 = en2 >> 3; \
            const f32x16 z = {0.f, 0.f, 0.f, 0.f, 0.f, 0.f, 0.f, 0.f, 0.f, 0.f, 0.f, 0.f, 0.f, 0.f, 0.f, 0.f}; \
            _Pragma("unroll") for (int ds = 0; ds < 4; ++ds) { \
              const bf16x8 qv = *(const bf16x8*)(lds + AT_QS + rowc * 128 + (((ds * 2 + hh) ^ (rowc & 7)) * 16)); \
              if (ds == 0) { p0 = MFMA32(KF[0], qv, z); p1 = MFMA32(KF[4], qv, z); } else { p0 = MFMA32(KF[ds], qv, p0); p1 = MFMA32(KF[4 + ds], qv, p1); } \
            } \
            const bool validn = hasn && qsn < njn; const int rown = qqn * 4 + h; \
            const float mrn = validn ? MREF[rown] : 1e30f; \
            float rs = 0.f; \
            _Pragma("unroll") for (int i = 0; i < 16; ++i) { \
              p0[i] = __builtin_amdgcn_exp2f(fminf(p0[i] - mrc, 120.f)); p1[i] = __builtin_amdgcn_exp2f(fminf(p1[i] - mrc, 120.f)); rs += p0[i] + p1[i]; \
              if (i & 1) { KF[i >> 1] = *(const bf16x8*)(kgl + (size_t)j2 * 4096 + (i >> 1) * 512); __builtin_amdgcn_sched_barrier(0); } \
            } \
            rs += __shfl_xor(rs, 32); \
            f32x16 o0 = z, o1 = z; \
            _Pragma("unroll") for (int gk = 0; gk < 4; ++gk) { const bf16x8 pb = (gk < 2) ? pack8(p0, gk & 1) : pack8(p1, gk & 1); o0 = MFMA32(VF[gk], pb, o0); o1 = MFMA32(VF[4 + gk], pb, o1); } \
            { unsigned char* sp_ = SLOT + (set * 4 + wu) * 8192 + r * 256; \
              _Pragma("unroll") for (int gi = 0; gi < 4; ++gi) { \
                const f32x4 va_ = {o0[4 * gi], o0[4 * gi + 1], o0[4 * gi + 2], o0[4 * gi + 3]}; const f32x4 vb_ = {o1[4 * gi], o1[4 * gi + 1], o1[4 * gi + 2], o1[4 * gi + 3]}; \
                *(f32x4*)(sp_ + (((2 * gi + hh) ^ (r & 15)) * 16)) = va_; *(f32x4*)(sp_ + (((8 + 2 * gi + hh) ^ (r & 15)) * 16)) = vb_; \
                VF[2 * gi] = *(const bf16x8*)(vgl + (size_t)j2 * 4096 + (2 * gi) * 512); VF[2 * gi + 1] = *(const bf16x8*)(vgl + (size_t)j2 * 4096 + (2 * gi + 1) * 512); \
                __builtin_amdgcn_sched_barrier(0); \
              } } \
            if (hh == 0) LS[(set * 4 + wu) * 32 + r] = rs; \
            if (validc && h == 0 && hh == 0) INVQ[set * 256 + qqc * 4 + wu] = (unsigned char)((r >> 2) + 1); \
            rowc = rown; qqc = qqn; validc = validn; mrc = mrn; en = en2; \
          } } while (0)
        for (int rd = 0; rd < nrounds; rd += 2) {
          ITEM_ROUND(kfA, vfA, rd);
          __syncthreads();
          if (rd + 1 < nrounds) {
            ITEM_ROUND(kfB, vfB, rd + 1);
            __syncthreads();
          }
        }
#undef ITEM_ROUND
#undef FLOAD
#undef ITEM_META
#undef KLOAD
#undef VLOAD
        __syncthreads();
#pragma unroll
        for (int i = 0; i < 16; ++i) { S.o0[i] = otg(i); S.o1[i] = otg(16 + i); }
        SLOT_WRITE(w, S.o0, S.o1, 1.0f);
        __syncthreads();
      }
    }
#undef SLOT_WRITE
#undef SLOT_READ
  }
  __syncthreads();
#undef ST_LOAD
#undef ST_STORE
#undef SWEEP
#undef ST_LOADF
#undef ST_STOREF
#undef SWEEPF
#undef gates
#undef otg
#undef AT_IDS
}
DI void phase_attn(const Params& P_, unsigned char* lds) {
  Params P = P_; { size_t z_ = 0; asm volatile("" : "+s"(z_)); P.ws = P_.ws + z_; }
  const int G = gridDim.x, bx = obid();
  const int vcu = (G % 8 == 0) ? (bx % 8) * (G / 8) + bx / 8 : bx;
  for (int idx = vcu; idx < 1024; idx += G) {
    const int i = idx >> 8, v = idx & 255, bg = v >> 5, s = v & 31;
    const int c = i == 0 ? s : i == 1 ? 63 - s : i == 2 ? 64 + s : 127 - s;
    attn_tile(P, lds, bg >> 2, bg & 3, c);
  }
}


#define LAS __attribute__((address_space(3)))
#define XB_TMO      128
#define XB_XCNT(j)  (256  + 64 * (j))
#define XB_XSUB(j)  (1280 + 64 * (j))
#define XB_XGEN(j)  (2304 + 64 * (j))
#define XB_TOP      3328
#define XB_TOPGEN   3392
#define XCD_BAR_WORDS 3456
#define XB_SPIN_CAP (1u << 18)
__device__ __forceinline__ unsigned xb_ld(unsigned* p)              { return __hip_atomic_load(p, __ATOMIC_RELAXED, __HIP_MEMORY_SCOPE_AGENT); }
__device__ __forceinline__ unsigned xb_add(unsigned* p, unsigned v) { return __hip_atomic_fetch_add(p, v, __ATOMIC_RELAXED, __HIP_MEMORY_SCOPE_AGENT); }
__device__ __forceinline__ unsigned xb_xcc_id() { return (unsigned)__builtin_amdgcn_s_getreg((3 << 11) | 20) & 0xFu; }
#define XB_SPIN(cond, bar) do { unsigned _sp = 0; while (cond) { __builtin_amdgcn_s_sleep(1); \
    if ((++_sp & 255u) == 0u) { if (xb_ld(&(bar)[XB_TMO])) break; if (_sp > XB_SPIN_CAP) { atomicAdd(&(bar)[XB_TMO], 1u); break; } } } } while (0)
struct XcdBarrier { unsigned* bar; unsigned x; volatile LAS unsigned* st; };
__device__ __forceinline__ XcdBarrier xcd_barrier_post(unsigned* bar, volatile LAS unsigned* st) {
    XcdBarrier b; b.bar = bar; b.x = xb_xcc_id(); b.st = st;
    if (threadIdx.x == 0) (void)xb_add(&bar[XB_XCNT(b.x)], 1u);
    return b;
}
__device__ __forceinline__ void xcd_barrier_complete(unsigned* bar, unsigned x, unsigned& nloc, unsigned& nx) {
    const unsigned G = gridDim.x * gridDim.y * gridDim.z;
    unsigned sum, cnt, mine, sp = 0u;
    for (;;) {
        sum = 0u; cnt = 0u; mine = 0u;
#pragma unroll
        for (unsigned j = 0; j < 16; ++j) { const unsigned c = xb_ld(&bar[XB_XCNT(j)]); sum += c; cnt += (c > 0u) ? 1u : 0u; mine = (j == x) ? c : mine; }
        if (sum == G) break;
        __builtin_amdgcn_s_sleep(1);
        if ((++sp & 255u) == 0u) { if (xb_ld(&bar[XB_TMO])) break; if (sp > XB_SPIN_CAP) { atomicAdd(&bar[XB_TMO], 1u); break; } }
    }
    nloc = mine > 0u ? mine : 1u; nx = cnt > 0u ? cnt : 1u;
}
__device__ __forceinline__ void xcd_barrier(const XcdBarrier& b) {
    asm volatile("s_waitcnt vmcnt(0)" ::: "memory");
    __syncthreads();
    if (threadIdx.x == 0) {
        unsigned* bar = b.bar; { size_t z_ = 0; asm volatile("" : "+s"(z_)); bar += z_; }
        __builtin_amdgcn_s_waitcnt(0);
        unsigned nloc = b.st[0], nx = b.st[1];
        if (nloc == 0u) { xcd_barrier_complete(bar, b.x, nloc, nx); b.st[0] = nloc; b.st[1] = nx; }
        const unsigned old = xb_add(&bar[XB_XSUB(b.x)], 1u);
        const unsigned gen = old / nloc;
        if (old + 1u == (gen + 1u) * nloc) {
            __builtin_amdgcn_fence(__ATOMIC_RELEASE, "agent");
            asm volatile("s_waitcnt vmcnt(0)" ::: "memory");
            const unsigned og = xb_add(&bar[XB_TOP], 1u);
            const unsigned tg = og / nx;
            if (og + 1u == (tg + 1u) * nx) xb_add(&bar[XB_TOPGEN], 1u);
            else XB_SPIN(xb_ld(&bar[XB_TOPGEN]) == tg, bar);
            __builtin_amdgcn_fence(__ATOMIC_ACQUIRE, "agent");
            xb_add(&bar[XB_XGEN(b.x)], 1u);
            asm volatile("s_waitcnt vmcnt(0)" ::: "memory");
        } else {
            XB_SPIN(xb_ld(&bar[XB_XGEN(b.x)]) == gen, bar);
            __builtin_amdgcn_fence(__ATOMIC_ACQUIRE, "agent");
            asm volatile("s_waitcnt vmcnt(0)" ::: "memory");
        }
    }
    __syncthreads();
}

__global__ void __launch_bounds__(NTHR) fwd_kernel(Params P) {
  extern __shared__ __attribute__((aligned(16))) unsigned char lds[];
  cg::grid_group grid = cg::this_grid();
  const int gtid = blockIdx.x * NTHR + threadIdx.x;
  if (threadIdx.x < 4) ((unsigned*)(lds + LDS_BYTES - 16))[threadIdx.x] = 0u;
  __syncthreads();
  const XcdBarrier xbar = xcd_barrier_post((unsigned*)(P.ws + WS_BAR), (volatile LAS unsigned*)(lds + LDS_BYTES - 16));
#define GSYNC() xcd_barrier(xbar)
  s5_params(P, gtid);
  {
    float* modb = (float*)(P.ws + WS_MOD); float* cbb = (float*)(P.ws + WS_CB);
    for (int it = blockIdx.x; it < 192 + 16; it += gridDim.x) {
      if (it < 192) { const int l = it / 96, j0 = (it % 96) * 64;
        gemv_item((float*)lds, P.in[2] + (size_t)l * DM * 6144, DM, 6144, j0, P.in[1], P.in[1] + DM, true, P.in[3] + l * 6144, modb + (size_t)(l * 2) * 6144, modb + (size_t)(l * 2 + 1) * 6144);
      } else { const int r = it - 192, l = r >> 3, kv = (r >> 2) & 1, j0 = (r & 3) * 64;
        gemv_item((float*)lds, P.in[17] + (size_t)(l * 2 + kv) * 2048 * 256, 2048, 256, j0, P.in[16] + (size_t)(l * 2 + kv) * 2048, nullptr, false, nullptr, cbb + (l * 2 + kv) * 256, nullptr);
      }
    }
  }
  for (int it = blockIdx.x; it < DEPTH * 32 * 6; it += gridDim.x) s5_tables(P, it / 192, (it % 192) / 6, it % 6, lds);
  convert_weights(P, 0, lds);
  grid.sync();
  for (int l = 0; l < DEPTH; ++l) {
    if (l == 0) norm_simple<0>(P, l); else { norm_simple<1>(P, l); convert_weights(P, 1, lds); }
    GSYNC();
#if EN_MIXER
    phase_inproj8(P, lds);
    GSYNC();
    phase_s5a(P, l, lds);
    __syncthreads();
#if EN_ATTN
    phase_gates(P, lds);
    __syncthreads();
    phase_cmp1(P, l, lds);
#endif
    GSYNC();
    s5_carry(P, l);
#if EN_ATTN
    phase_cmp2(P, lds);
#endif
    GSYNC();
#if EN_ATTN
    phase_attn(P, lds);
    __syncthreads();
#endif
    phase_s5c(P, l, lds);
    GSYNC();
    phase_glu(P, lds);
    GSYNC();
    phase_merge8(P, lds);
    GSYNC();
    phase_wout8(P, l, lds);
    GSYNC();
#else
    if (l == 0) { for (size_t i = (size_t)gtid * 4; i < (size_t)NT * DM; i += (size_t)gridDim.x * NTHR * 4) *(f32x4*)(P.out + i) = *(const f32x4*)(P.in[0] + i); GSYNC(); }
#endif
#if EN_MOE
    norm_route(P, l, lds);
    GSYNC();
    phase_moe1(P, l, lds);
    GSYNC();
    phase_moe2(P, l, lds);
    GSYNC();
#endif
  }
  norm_simple<3>(P, 0);
}

extern "C" void kernel_launch(void* const* d_in, const int* in_sizes, int n_in, void* d_out, int out_size, void* d_ws, size_t ws_size, hipStream_t stream) {
  static int grid = 0;
  if (grid == 0) {
    if (n_in != 30 || out_size != NT * DM || ws_size < WS_END2) { fprintf(stderr, "kernel_launch: unexpected shapes (n_in %d out %d ws %zu need %zu)\n", n_in, out_size, ws_size, (size_t)WS_END2); grid = -1; return; }
    int dev = 0, cus = 0, per_cu = 0;
    hipGetDevice(&dev);
    hipDeviceGetAttribute(&cus, hipDeviceAttributeMultiprocessorCount, dev);
    hipFuncSetAttribute((const void*)fwd_kernel, hipFuncAttributeMaxDynamicSharedMemorySize, LDS_BYTES);
    hipOccupancyMaxActiveBlocksPerMultiprocessor(&per_cu, (const void*)fwd_kernel, NTHR, LDS_BYTES);
    if (per_cu < 1) { fprintf(stderr, "kernel_launch: occupancy query says %d blocks/CU\n", per_cu); per_cu = 1; }
    grid = cus;
    (void)hipGetLastError();
  }
  if (grid < 0) return;
  Params p{};
  for (int i = 0; i < 30; ++i) p.in[i] = (const float*)d_in[i];
  p.out = (float*)d_out; p.ws = (unsigned char*)d_ws;
  if (hipMemsetAsync(p.ws, 0, WS_ZERO_BYTES, stream) != hipSuccess) { fprintf(stderr, "kernel_launch: memset failed\n"); return; }
  void* args[] = {&p};
  hipError_t e = hipLaunchCooperativeKernel((const void*)fwd_kernel, dim3(grid), dim3(NTHR), args, LDS_BYTES, stream);
  if (e != hipSuccess) fprintf(stderr, "cooperative launch failed: %s (grid %d)\n", hipGetErrorString(e), grid);
}
```

```cpp
#include <hip/hip_runtime.h>
#include <hip/hip_cooperative_groups.h>
#include <cstdio>
#include <cstdint>
namespace cg = cooperative_groups;

#ifndef EN_MIXER
#define EN_MIXER 1
#endif
#ifndef EN_ATTN
#define EN_ATTN 1
#endif
#ifndef EN_MOE
#define EN_MOE 1
#endif

#define DI __device__ __forceinline__
typedef unsigned short bf16_t;
typedef short bf16x8 __attribute__((ext_vector_type(8)));
typedef short s16x4 __attribute__((ext_vector_type(4)));
typedef float f32x4 __attribute__((ext_vector_type(4)));
typedef float f32x16 __attribute__((ext_vector_type(16)));
typedef unsigned u32x4 __attribute__((ext_vector_type(4)));
typedef unsigned u32x2 __attribute__((ext_vector_type(2)));

constexpr int DM = 1024, NB = 2, SEQ = 8192, NT = NB * SEQ, DEPTH = 2;
constexpr int INW = 5168, INWP = 5376;
constexpr int NTHR = 512, NWAVE = 8;
constexpr int NEXP = 32, LISTCAP = 16384;
constexpr float EPS = 1e-6f;
constexpr float QSCALE = 0.125f * 1.4426950408889634f;

constexpr size_t MiB = 1u << 20;
constexpr size_t WS_CNT = 0;
constexpr size_t WS_BAR = 1024;
constexpr size_t WS_ZERO_BYTES = 16384;
constexpr size_t WS_MOD = 16384;
constexpr size_t WS_CB = WS_MOD + 2 * 2 * 6144 * 4;
constexpr size_t WS_S5P = WS_CB + 2 * 2 * 256 * 4;
constexpr size_t WS_WT = WS_S5P + 2 * 32 * 64 * 36 * 4;
constexpr size_t WS_SMALL_END = WS_WT + (size_t)NT * 2 * 4;
static_assert(WS_SMALL_END <= 1 * MiB, "small region");
constexpr size_t WS_W = 1 * MiB;
constexpr size_t W_IN = 0;
constexpr size_t W_GLU = W_IN + (size_t)INWP * 1024 * 2;
constexpr size_t W_O = W_GLU + 512 * 512 * 2;
constexpr size_t W_SO = W_O + 1024 * 1024 * 2;
constexpr size_t W_OUT = W_SO + 1024 * 512 * 2;
constexpr size_t W_C1 = W_OUT + 1024 * 1024 * 2;
constexpr size_t W_C2 = W_C1 + 2 * 256 * 2048 * 2;
constexpr size_t W_GU = W_C2 + 2 * 128 * 256 * 2;
constexpr size_t W_D = W_GU + (size_t)32 * 512 * 1024 * 2;
constexpr size_t W_END = W_D + (size_t)32 * 1024 * 256 * 2;
static_assert(W_END <= 67 * MiB, "weights region");
constexpr size_t WS_A = 68 * MiB;
constexpr size_t WS_B = WS_A + 32 * MiB;
constexpr size_t WS_C = WS_B + 32 * MiB;
constexpr size_t WS_DV = WS_C + 32 * MiB;
constexpr size_t WS_E = WS_DV + 16 * MiB;
constexpr size_t WS_F = WS_E + 32 * MiB;
constexpr size_t WS_G = WS_F + 64 * MiB;
constexpr size_t WS_GATES = WS_G + 16 * MiB;
constexpr size_t WS_HID = WS_GATES + 3 * MiB;
constexpr size_t WS_KC = WS_HID + 4 * MiB;
constexpr size_t WS_VC = WS_KC + 512 * 1024;
constexpr size_t WS_L = WS_VC + 512 * 1024;
constexpr size_t WS_LIST = WS_L + 4 * MiB;
constexpr size_t WS_OT = WS_LIST + 2 * MiB;
constexpr size_t WS_TAB = WS_OT + 16 * MiB;
constexpr size_t TAB_KT = 0, TAB_M1 = 1 * MiB, TAB_M2 = 9 * MiB, TAB_LAYER = 17 * MiB;
constexpr size_t WS_END = WS_TAB + 2 * TAB_LAYER;
constexpr size_t WS_KSF = WS_END;
constexpr size_t WS_END2 = WS_KSF + 8 * MiB;
constexpr size_t WS_SIN = WS_E + 16 * MiB;
constexpr int LDS_BYTES = 151552;

struct Params { const float* in[30]; float* out; unsigned char* ws; };

DI int otid() { int t = threadIdx.x; asm volatile("" : "+v"(t)); return t; }
DI int obid() { int t = blockIdx.x; asm volatile("" : "+s"(t)); return t; }
DI unsigned f2bf(float f) { unsigned u = __float_as_uint(f); return (u + 0x7fffu + ((u >> 16) & 1u)) >> 16; }
typedef float f32x2_t __attribute__((ext_vector_type(2))); typedef __bf16 bf16x2_t __attribute__((ext_vector_type(2)));
DI unsigned pk2(float lo, float hi) { const f32x2_t v = {lo, hi}; const bf16x2_t b = __builtin_convertvector(v, bf16x2_t); return __builtin_bit_cast(unsigned, b); }
DI float bflo(unsigned w) { return __uint_as_float(w << 16); }
DI float bfhi(unsigned w) { return __uint_as_float(w & 0xffff0000u); }
DI int perm16(int x) { return (x & ~12) | ((x & 4) << 1) | ((x & 8) >> 1); }
DI float wave_sum(float v) {
#pragma unroll
  for (int o = 1; o < 64; o <<= 1) v += __shfl_xor(v, o);
  return v;
}
DI float sigmoidf_(float x) { return 1.f / (1.f + __expf(-x)); }
DI float gelu_tanh(float x) {
  const float z = 0.7978845608028654f * (x + 0.044715f * x * x * x);
  const float e = __expf(2.f * z);
  const float th = 1.f - 2.f / (e + 1.f);
  return 0.5f * x * (1.f + th);
}
DI void sincos_d(double x, double& s, double& c) {
  const double k = rint(x * 0.6366197723675814);
  double r = fma(-k, 1.5707963267948966, x);
  r = fma(-k, 6.123233995736766e-17, r);
  const int q = ((int)k) & 3;
  const double r2 = r * r;
  const double sp = r * (1.0 + r2 * (-1.0 / 6 + r2 * (1.0 / 120 + r2 * (-1.0 / 5040 + r2 * (1.0 / 362880 + r2 * (-1.0 / 39916800 + r2 * (1.0 / 6227020800.0)))))));
  const double cp = 1.0 + r2 * (-0.5 + r2 * (1.0 / 24 + r2 * (-1.0 / 720 + r2 * (1.0 / 40320 + r2 * (-1.0 / 3628800 + r2 * (1.0 / 479001600 + r2 * (-1.0 / 87178291200.0)))))));
  s = (q == 0) ? sp : (q == 1) ? cp : (q == 2) ? -sp : -cp;
  c = (q == 0) ? cp : (q == 1) ? -sp : (q == 2) ? -cp : sp;
}

DI void gemv_item(float* lds, const float* W, int K, int N, int j0, const float* v0, const float* v1, bool do_silu, const float* bias, float* o0, float* o1) {
  const int tid = otid();
  float* sv = lds; float* red = lds + 4096;
  for (int k = tid; k < K; k += NTHR) {
    float a = v0[k], b = v1 ? v1[k] : 0.f;
    if (do_silu) { a = a / (1.f + expf(-a)); b = b / (1.f + expf(-b)); }
    sv[k] = a; sv[2048 + k] = b;
  }
  __syncthreads();
  const int jl = tid & 63, ks = tid >> 6, kper = K >> 3;
  const float* wp = W + (size_t)(ks * kper) * N + j0 + jl;
  float a0 = 0.f, a1 = 0.f;
#pragma unroll 8
  for (int k = 0; k < kper; ++k) { const float w = wp[(size_t)k * N]; a0 += sv[ks * kper + k] * w; a1 += sv[2048 + ks * kper + k] * w; }
  red[(ks * 64 + jl) * 2] = a0; red[(ks * 64 + jl) * 2 + 1] = a1;
  __syncthreads();
  if (tid < 64) {
    float s0 = 0.f, s1 = 0.f;
    for (int i = 0; i < 8; ++i) { s0 += red[(i * 64 + tid) * 2]; s1 += red[(i * 64 + tid) * 2 + 1]; }
    const float bb = bias ? bias[j0 + tid] : 0.f;
    o0[j0 + tid] = s0 + bb; if (o1) o1[j0 + tid] = s1 + bb;
  }
  __syncthreads();
}

DI void s5_params(const Params& P, int gtid) {
  if (gtid >= DEPTH * 32 * 64) return;
  const int l = gtid / 2048, g = (gtid / 64) % 32, p = gtid % 64;
  const float dt = expf(P.in[8][l * 32 + g]);
  const float lr = P.in[6][(l * 32 + g) * 64 + p], li = P.in[7][(l * 32 + g) * 64 + p];
  const float mag = expf(lr * dt); const float ang = li * dt;
  double sd, cd; sincos_d((double)ang, sd, cd);
  const float ab_re = mag * (float)cd, ab_im = mag * (float)sd;
  const float den = lr * lr + li * li, nr = ab_re - 1.0f;
  const float cr = (nr * lr + ab_im * li) / den, ci = (ab_im * lr - nr * li) / den;
  float* o = (float*)(P.ws + WS_S5P) + (size_t)((l * 32 + g) * 64 + p) * 36;
  o[0] = ab_re; o[1] = ab_im;
  double pr = ab_re, pi = ab_im;
  for (int i = 0; i < 6; ++i) { const double nr2 = pr * pr - pi * pi, ni2 = 2.0 * pr * pi; pr = nr2; pi = ni2; }
  o[2] = (float)pr; o[3] = (float)pi;
  const float* br = P.in[9] + (size_t)((l * 32 + g) * 64 + p) * 16; const float* bi = P.in[10] + (size_t)((l * 32 + g) * 64 + p) * 16;
  for (int h = 0; h < 16; ++h) { o[4 + 2 * h] = cr * br[h] - ci * bi[h]; o[5 + 2 * h] = cr * bi[h] + ci * br[h]; }
}

DI void s5_tables(const Params& P, int l, int g, int part, unsigned char* lds) {
  const int tid = otid(), lane = tid & 63;
  float* BBr = (float*)lds; float* BBi = BBr + 1024; float* CR = BBi + 1024; float* CI = CR + 1024;
  float* APr = CI + 1024; float* APi = APr + 65 * 64;
  bf16_t* tab = (bf16_t*)(P.ws + WS_TAB + (size_t)l * TAB_LAYER);
  bf16_t* Kt = tab + TAB_KT / 2 + (size_t)g * 64 * 256; bf16_t* M1 = tab + TAB_M1 / 2 + (size_t)g * 128 * 1024; bf16_t* M2 = tab + TAB_M2 / 2 + (size_t)g * 1024 * 128;
  __syncthreads();
  if (tid < 64) {
    const int p = tid;
    const float dt = expf(P.in[8][l * 32 + g]);
    const float lr = P.in[6][(l * 32 + g) * 64 + p], li = P.in[7][(l * 32 + g) * 64 + p];
    const float mag = expf(lr * dt); const float ang = li * dt;
    double sd, cd; sincos_d((double)ang, sd, cd);
    const float ab_re = mag * (float)cd, ab_im = mag * (float)sd;
    const float den = lr * lr + li * li, nr = ab_re - 1.0f;
    const float cr = (nr * lr + ab_im * li) / den, ci = (ab_im * lr - nr * li) / den;
    const float* br = P.in[9] + (size_t)((l * 32 + g) * 64 + p) * 16; const float* bi = P.in[10] + (size_t)((l * 32 + g) * 64 + p) * 16;
    for (int h = 0; h < 16; ++h) { BBr[p * 16 + h] = cr * br[h] - ci * bi[h]; BBi[p * 16 + h] = cr * bi[h] + ci * br[h]; }
    double pr = 1.0, pi = 0.0;
    for (int tau = 0; tau <= 64; ++tau) { APr[tau * 64 + p] = (float)pr; APi[tau * 64 + p] = (float)pi; const double n1 = pr * ab_re - pi * ab_im, n2 = pr * ab_im + pi * ab_re; pr = n1; pi = n2; }
  }
  for (int i = tid; i < 1024; i += NTHR) { CR[i] = P.in[11][(size_t)(l * 32 + g) * 1024 + i]; CI[i] = P.in[12][(size_t)(l * 32 + g) * 1024 + i]; }
  __syncthreads();
  if (part < 4)
  for (int task = part * 256 + tid; task < part * 256 + 256; task += NTHR) {
    const int tau = task >> 4, h = task & 15;
    float a[16];
#pragma unroll
    for (int j = 0; j < 16; ++j) a[j] = 0.f;
    for (int p = 0; p < 64; ++p) {
      const float c_r = CR[h * 64 + p], c_i = CI[h * 64 + p], a_r = APr[tau * 64 + p], a_i = APi[tau * 64 + p];
      const float xr = c_r * a_r - c_i * a_i, xi = c_r * a_i + c_i * a_r;
#pragma unroll
      for (int j4 = 0; j4 < 4; ++j4) { const f32x4 b_r = *(const f32x4*)(BBr + p * 16 + 4 * j4), b_i = *(const f32x4*)(BBi + p * 16 + 4 * j4);
        a[4 * j4] += xr * b_r.x - xi * b_i.x; a[4 * j4 + 1] += xr * b_r.y - xi * b_i.y; a[4 * j4 + 2] += xr * b_r.z - xi * b_i.z; a[4 * j4 + 3] += xr * b_r.w - xi * b_i.w; }
    }
    u32x4 o0, o1; o0.x = pk2(a[0], a[1]); o0.y = pk2(a[2], a[3]); o0.z = pk2(a[4], a[5]); o0.w = pk2(a[6], a[7]); o1.x = pk2(a[8], a[9]); o1.y = pk2(a[10], a[11]); o1.z = pk2(a[12], a[13]); o1.w = pk2(a[14], a[15]);
    *(u32x4*)(Kt + (size_t)task * 16) = o0; *(u32x4*)(Kt + (size_t)task * 16 + 8) = o1;
  }
  if (part == 4)
  for (int task = tid; task < 4096; task += NTHR) {
    const int p = task >> 6, i = task & 63;
    const float a_r = APr[(63 - i) * 64 + p], a_i = APi[(63 - i) * 64 + p];
    float re[16], im[16];
#pragma unroll
    for (int j = 0; j < 16; ++j) { const float b_r = BBr[p * 16 + j], b_i = BBi[p * 16 + j]; re[j] = a_r * b_r - a_i * b_i; im[j] = a_r * b_i + a_i * b_r; }
    u32x4 o; bf16_t* d0 = M1 + (size_t)(2 * p) * 1024 + i * 16; bf16_t* d1 = d0 + 1024;
    o.x = pk2(re[0], re[1]); o.y = pk2(re[2], re[3]); o.z = pk2(re[4], re[5]); o.w = pk2(re[6], re[7]); *(u32x4*)d0 = o;
    o.x = pk2(re[8], re[9]); o.y = pk2(re[10], re[11]); o.z = pk2(re[12], re[13]); o.w = pk2(re[14], re[15]); *(u32x4*)(d0 + 8) = o;
    o.x = pk2(im[0], im[1]); o.y = pk2(im[2], im[3]); o.z = pk2(im[4], im[5]); o.w = pk2(im[6], im[7]); *(u32x4*)d1 = o;
    o.x = pk2(im[8], im[9]); o.y = pk2(im[10], im[11]); o.z = pk2(im[12], im[13]); o.w = pk2(im[14], im[15]); *(u32x4*)(d1 + 8) = o;
  }
  if (part == 5)
  for (int task = tid; task < 4096; task += NTHR) {
    const int th = task >> 2, pq = task & 3, t = th >> 4, h = th & 15;
    unsigned w[16];
#pragma unroll
    for (int j = 0; j < 16; ++j) { const int p = pq * 16 + j;
      const float c_r = CR[h * 64 + p], c_i = CI[h * 64 + p], a_r = APr[(t + 1) * 64 + p], a_i = APi[(t + 1) * 64 + p];
      w[j] = pk2(c_r * a_r - c_i * a_i, -(c_r * a_i + c_i * a_r)); }
    bf16_t* d = M2 + (size_t)th * 128 + pq * 32;
    *(u32x4*)d = (u32x4){w[0], w[1], w[2], w[3]}; *(u32x4*)(d + 8) = (u32x4){w[4], w[5], w[6], w[7]};
    *(u32x4*)(d + 16) = (u32x4){w[8], w[9], w[10], w[11]}; *(u32x4*)(d + 24) = (u32x4){w[12], w[13], w[14], w[15]};
  }
  __syncthreads();
}

struct ConvJob { const float* src; bf16_t* dst; int ldw, K, c0, ncols, nmat, ldd, drow0, mode; size_t sstride, dstride; };
DI int conv_nitems(const ConvJob& j) { return j.nmat * (j.K >> 6) * ((j.ncols + 31) >> 5); }
DI int conv_drow(int mode, int drow0, int n) { return mode == 0 ? drow0 + n : drow0 + ((n >> 6) * 128 + ((n >> 4) & 3) * 32 + (n & 15)); }
DI void conv_item(const ConvJob& jb, int item, float* scr, int lane) {
  const int nblk = (jb.ncols + 31) >> 5, per = (jb.K >> 6) * nblk;
  const int mat = item / per, r = item % per, kb = r / nblk, nb = r % nblk, k0 = 64 * kb, n0 = 32 * nb;
  const float* W = jb.src + (size_t)mat * jb.sstride; bf16_t* WT = jb.dst + (size_t)mat * jb.dstride;
  const int n4 = (lane & 7) * 4; const bool nok = (n0 + n4) < jb.ncols;
#pragma unroll
  for (int i = 0; i < 8; ++i) { const int kk = 8 * i + (lane >> 3);
    const f32x4 v = nok ? *(const f32x4*)(W + (size_t)(k0 + kk) * jb.ldw + jb.c0 + n0 + n4) : (f32x4){0.f, 0.f, 0.f, 0.f};
    *(f32x4*)(scr + kk * 36 + n4) = v; }
  asm volatile("s_waitcnt lgkmcnt(0)" ::: "memory");
  const int c = lane & 7;
#pragma unroll
  for (int j = 0; j < 4; ++j) {
    const int n = (lane >> 3) + 8 * j; const float* sp = scr + (8 * c) * 36 + n;
    u32x4 o; o.x = pk2(sp[0], sp[36]); o.y = pk2(sp[72], sp[108]); o.z = pk2(sp[144], sp[180]); o.w = pk2(sp[216], sp[252]);
    if (n0 + n < jb.ncols) *(u32x4*)(WT + (size_t)conv_drow(jb.mode, jb.drow0, n0 + n) * jb.ldd + k0 + 8 * c) = o;
  }
  asm volatile("s_waitcnt lgkmcnt(0)" ::: "memory");
}
DI ConvJob conv_job(const Params& P, int l, int j) {
  unsigned char* wb = P.ws + WS_W; ConvJob J; J.nmat = 1; J.mode = 0; J.sstride = 0; J.dstride = 0; J.drow0 = 0; J.c0 = 0;
  const float* win = P.in[5] + (size_t)l * 1024 * INW;
  if (j < 5) { J.src = win; J.ldw = INW; J.K = 1024; J.dst = (bf16_t*)(wb + W_IN); J.ldd = 1024;
    if (j == 0) { J.c0 = 0; J.ncols = 1024; J.drow0 = 0; }
    else if (j == 1) { J.c0 = 1024; J.ncols = 1536; J.drow0 = 1024; }
    else if (j == 2) { J.c0 = 3120; J.ncols = 2048; J.drow0 = 2560; }
    else if (j == 3) { J.c0 = 2608; J.ncols = 512; J.drow0 = 4608; }
    else { J.c0 = 2560; J.ncols = 48; J.drow0 = 5120; }
  } else if (j == 5) { J.src = P.in[14] + (size_t)l * 512 * 512; J.ldw = 512; J.K = 512; J.ncols = 512; J.dst = (bf16_t*)(wb + W_GLU); J.ldd = 512; }
  else if (j == 6) { J.src = P.in[19] + (size_t)l * 1024 * 1024; J.ldw = 1024; J.K = 1024; J.ncols = 1024; J.dst = (bf16_t*)(wb + W_O); J.ldd = 1024; }
  else if (j == 7) { J.src = P.in[15] + (size_t)l * 512 * 1024; J.ldw = 1024; J.K = 512; J.ncols = 1024; J.dst = (bf16_t*)(wb + W_SO); J.ldd = 512; }
  else if (j == 8) { J.src = P.in[20] + (size_t)l * 1024 * 1024; J.ldw = 1024; J.K = 1024; J.ncols = 1024; J.dst = (bf16_t*)(wb + W_OUT); J.ldd = 1024; }
  else if (j == 9) { J.src = P.in[17] + (size_t)l * 2 * 2048 * 256; J.ldw = 256; J.K = 2048; J.ncols = 256; J.nmat = 2; J.sstride = 2048 * 256; J.dstride = 256 * 2048; J.dst = (bf16_t*)(wb + W_C1); J.ldd = 2048; }
  else if (j == 10) { J.src = P.in[18] + (size_t)l * 2 * 256 * 64; J.ldw = 64; J.K = 256; J.ncols = 64; J.nmat = 2; J.sstride = 256 * 64; J.dstride = 128 * 256; J.dst = (bf16_t*)(wb + W_C2); J.ldd = 256; }
  else if (j == 11) { J.src = P.in[26] + (size_t)l * 32 * 1024 * 256; J.ldw = 256; J.K = 1024; J.ncols = 256; J.nmat = 32; J.sstride = 1024 * 256; J.dstride = 512 * 1024; J.dst = (bf16_t*)(wb + W_GU); J.ldd = 1024; J.mode = 1; J.drow0 = 0; }
  else if (j == 12) { J.src = P.in[27] + (size_t)l * 32 * 1024 * 256; J.ldw = 256; J.K = 1024; J.ncols = 256; J.nmat = 32; J.sstride = 1024 * 256; J.dstride = 512 * 1024; J.dst = (bf16_t*)(wb + W_GU); J.ldd = 1024; J.mode = 1; J.drow0 = 16; }
  else { J.src = P.in[28] + (size_t)l * 32 * 256 * 1024; J.ldw = 1024; J.K = 256; J.ncols = 1024; J.nmat = 32; J.sstride = 256 * 1024; J.dstride = 1024 * 256; J.dst = (bf16_t*)(wb + W_D); J.ldd = 256; }
  return J;
}
DI void convert_weights(const Params& P_, int l, unsigned char* lds) {
  Params P = P_; { size_t z_ = 0; asm volatile("" : "+s"(z_)); P.ws = P_.ws + z_; }
  const int tid_ = otid(), bid = obid(), wave = tid_ >> 6, lane = tid_ & 63; (void)bid;
  float* scr = (float*)lds + wave * (64 * 36);
  const int NGW = gridDim.x * NWAVE; int off = bid * NWAVE + wave;
  for (int j = 0; j < 14; ++j) {
    const ConvJob J = conv_job(P, l, j); const int n = conv_nitems(J);
    while (off < n) { conv_item(J, off, scr, lane); off += NGW; }
    off -= n;
  }
}

template <int MODE>
DI void norm_simple(const Params& P_, int l) {
  Params P = P_; { size_t z_ = 0; asm volatile("" : "+s"(z_)); P.ws = P_.ws + z_; }
  const int tid_ = otid(), bid = obid(), wave = tid_ >> 6, lane = tid_ & 63; (void)bid;
  const int NGW = gridDim.x * NWAVE;
  const float* mod = (const float*)(P.ws + WS_MOD);
  const bf16_t* ys = (const bf16_t*)(P.ws + WS_F);
  bf16_t* xn = (bf16_t*)(P.ws + WS_A);
  for (int row = bid * NWAVE + wave; row < NT; row += NGW) {
    const int b = row >> 13;
    const float* xr = (MODE == 0 ? P.in[0] : P.out) + (size_t)row * DM;
    f32x4 v[4];
#pragma unroll
    for (int j = 0; j < 4; ++j) v[j] = *(const f32x4*)(xr + 4 * lane + 256 * j);
    if (MODE != 0 && EN_MOE) {
      const float* g2 = mod + (size_t)(((MODE == 1 ? 0 : 1) * 2 + b) * 6144) + 5120;
#pragma unroll
      for (int j = 0; j < 4; ++j) {
        const int col = 4 * lane + 256 * j;
        const u32x2 y0 = *(const u32x2*)(ys + (size_t)(row * 2) * DM + col), y1 = *(const u32x2*)(ys + (size_t)(row * 2 + 1) * DM + col);
        const f32x4 gg = *(const f32x4*)(g2 + col);
        v[j].x += gg.x * (bflo(y0.x) + bflo(y1.x)); v[j].y += gg.y * (bfhi(y0.x) + bfhi(y1.x));
        v[j].z += gg.z * (bflo(y0.y) + bflo(y1.y)); v[j].w += gg.w * (bfhi(y0.y) + bfhi(y1.y));
      }
    }
    float ss = 0.f;
#pragma unroll
    for (int j = 0; j < 4; ++j) ss += v[j].x * v[j].x + v[j].y * v[j].y + v[j].z * v[j].z + v[j].w * v[j].w;
    ss = wave_sum(ss);
    const float inv = rsqrtf(ss * (1.f / DM) + EPS);
    if (MODE == 3) {
      const float* fg = P.in[29];
#pragma unroll
      for (int j = 0; j < 4; ++j) { const int col = 4 * lane + 256 * j; const f32x4 g = *(const f32x4*)(fg + col); *(f32x4*)(P.out + (size_t)row * DM + col) = v[j] * inv * g; }
    } else {
      if (MODE == 1) {
#pragma unroll
        for (int j = 0; j < 4; ++j) *(f32x4*)(P.out + (size_t)row * DM + 4 * lane + 256 * j) = v[j];
      }
      const float* ng = P.in[4] + (size_t)l * DM; const float* md = mod + (size_t)((l * 2 + b) * 6144);
#pragma unroll
      for (int j = 0; j < 4; ++j) {
        const int col = 4 * lane + 256 * j;
        const f32x4 g = *(const f32x4*)(ng + col), sh = *(const f32x4*)(md + col), sc = *(const f32x4*)(md + 1024 + col);
        const f32x4 h = v[j] * inv * g * (sc + 1.f) + sh;
        u32x2 o; o.x = pk2(h.x, h.y); o.y = pk2(h.z, h.w);
        *(u32x2*)(xn + (size_t)row * DM + col) = o;
      }
    }
  }
}

constexpr int RT_HS = 1028;
DI void norm_route(const Params& P_, int l, unsigned char* lds) {
  Params P = P_; { size_t z_ = 0; asm volatile("" : "+s"(z_)); P.ws = P_.ws + z_; }
  const int tid = otid(), bid = obid(), wave = tid >> 6, lane = tid & 63;
  const float* mod = (const float*)(P.ws + WS_MOD);
  bf16_t* h2 = (bf16_t*)(P.ws + WS_A);
  float* hs = (float*)lds;
  float* Wc = (float*)lds + 32 * RT_HS;
  const float* wg = P.in[22] + (size_t)l * DM * 4; const float* we = P.in[24] + (size_t)l * DM * 32;
  const float* bg = P.in[23] + l * 4; const float* be = P.in[25] + l * 32;
  int* cnt = (int*)(P.ws + WS_CNT) + l * 32; int* list = (int*)(P.ws + WS_LIST); float* wts = (float*)(P.ws + WS_WT);
  const int rg = wave >> 2, kq = wave & 3;
  for (int grp = bid; grp < NT / 32; grp += gridDim.x) {
    const int row0 = grp * 32 + wave * 4, b = row0 >> 13;
    const float* ng = P.in[21] + (size_t)l * DM; const float* md = mod + (size_t)((l * 2 + b) * 6144);
    {
      f32x4 v[4][4];
#pragma unroll
      for (int r = 0; r < 4; ++r)
#pragma unroll
        for (int j = 0; j < 4; ++j) v[r][j] = *(const f32x4*)(P.out + (size_t)(row0 + r) * DM + 4 * lane + 256 * j);
      float inv[4];
#pragma unroll
      for (int r = 0; r < 4; ++r) { float ss = 0.f;
#pragma unroll
        for (int j = 0; j < 4; ++j) ss += v[r][j].x * v[r][j].x + v[r][j].y * v[r][j].y + v[r][j].z * v[r][j].z + v[r][j].w * v[r][j].w;
        inv[r] = rsqrtf(wave_sum(ss) * (1.f / DM) + EPS); }
#pragma unroll
      for (int j = 0; j < 4; ++j) {
        const int col = 4 * lane + 256 * j;
        const f32x4 g = *(const f32x4*)(ng + col), sh = *(const f32x4*)(md + 3072 + col), sc = *(const f32x4*)(md + 4096 + col);
#pragma unroll
        for (int r = 0; r < 4; ++r) {
          const f32x4 hh = v[r][j] * inv[r] * g * (sc + 1.f) + sh;
          u32x2 o; o.x = pk2(hh.x, hh.y); o.y = pk2(hh.z, hh.w);
          *(u32x2*)(h2 + (size_t)(row0 + r) * DM + col) = o;
          *(f32x4*)(hs + (wave * 4 + r) * RT_HS + col) = hh;
        }
      }
    }
    f32x4 we0, we1, wg0 = {0.f, 0.f, 0.f, 0.f};
#define WLOAD(kc) do { we0 = *(const f32x4*)(we + (size_t)(kc) * 4096 + tid * 4); we1 = *(const f32x4*)(we + (size_t)(kc) * 4096 + 2048 + tid * 4); if (tid < 128) wg0 = *(const f32x4*)(wg + (size_t)(kc) * 512 + tid * 4); } while (0)
#define WSTORE() do { *(f32x4*)(Wc + (tid >> 3) * 36 + (tid & 7) * 4) = we0; *(f32x4*)(Wc + (64 + (tid >> 3)) * 36 + (tid & 7) * 4) = we1; if (tid < 128) *(f32x4*)(Wc + tid * 36 + 32) = wg0; } while (0)
    WLOAD(0);
    f32x4 acc0 = {0.f, 0.f, 0.f, 0.f}, acc1 = acc0, acc2 = acc0;
    for (int kc = 0; kc < 8; ++kc) {
      __syncthreads();
      WSTORE();
      if (kc + 1 < 8) WLOAD(kc + 1);
      __syncthreads();
      const float* ap = hs + (rg * 16 + (lane & 15)) * RT_HS + kc * 128 + kq * 32 + (lane >> 4);
      const float* bp = Wc + (kq * 32 + (lane >> 4)) * 36 + (lane & 15);
#pragma unroll
      for (int ks = 0; ks < 8; ++ks) {
        const float av = ap[4 * ks];
        const float b0 = bp[(4 * ks) * 36], b1 = bp[(4 * ks) * 36 + 16], b2 = (lane & 15) < 4 ? bp[(4 * ks) * 36 + 32] : 0.f;
        acc0 = __builtin_amdgcn_mfma_f32_16x16x4f32(av, b0, acc0, 0, 0, 0);
        acc1 = __builtin_amdgcn_mfma_f32_16x16x4f32(av, b1, acc1, 0, 0, 0);
        acc2 = __builtin_amdgcn_mfma_f32_16x16x4f32(av, b2, acc2, 0, 0, 0);
      }
    }
#undef WLOAD
#undef WSTORE
    __syncthreads();
    {
      float* part = hs + kq * (32 * 40);
#pragma unroll
      for (int i = 0; i < 4; ++i) { const int row = rg * 16 + 4 * (lane >> 4) + i, col = lane & 15;
        part[row * 40 + col] = acc0[i]; part[row * 40 + 16 + col] = acc1[i]; if (col < 4) part[row * 40 + 32 + col] = acc2[i]; }
    }
    __syncthreads();
    if (tid < 32) {
      const int row = grp * 32 + tid;
      float L[36];
#pragma unroll
      for (int o = 0; o < 36; ++o) L[o] = (hs[tid * 40 + o] + hs[1280 + tid * 40 + o]) + (hs[2560 + tid * 40 + o] + hs[3840 + tid * 40 + o]);
      float gm = -1e30f; int gi = 0;
#pragma unroll
      for (int i = 0; i < 4; ++i) { const float v = L[32 + i] + bg[i]; if (v > gm) { gm = v; gi = i; } }
      float gs = 0.f;
#pragma unroll
      for (int i = 0; i < 4; ++i) gs += expf(L[32 + i] + bg[i] - gm);
      const float gp = 1.f / gs;
      float el[8];
#pragma unroll
      for (int i = 0; i < 8; ++i) el[i] = (gi == 0 ? L[i] : gi == 1 ? L[8 + i] : gi == 2 ? L[16 + i] : L[24 + i]) + be[gi * 8 + i];
      float em = -1e30f;
#pragma unroll
      for (int i = 0; i < 8; ++i) em = fmaxf(em, el[i]);
      float p1 = -1.f, p2 = -1.f; int i1 = 0, i2 = 0;
#pragma unroll
      for (int i = 0; i < 8; ++i) {
        const float pe = expf(el[i] - em);
        if (pe > p1) { p2 = p1; i2 = i1; p1 = pe; i1 = i; } else if (pe > p2) { p2 = pe; i2 = i; }
      }
      const float w1 = gp * p1 / (p1 + p2), w2 = gp * p2 / (p1 + p2);
      const int e1 = gi * 8 + i1, e2 = gi * 8 + i2;
      const int pos1 = atomicAdd(&cnt[e1], 1); list[e1 * LISTCAP + pos1] = row * 2; wts[row * 2] = w1;
      const int pos2 = atomicAdd(&cnt[e2], 1); list[e2 * LISTCAP + pos2] = row * 2 + 1; wts[row * 2 + 1] = w2;
    }
    __syncthreads();
  }
}

namespace pg8 {
#define PG8_LAS __attribute__((address_space(3)))
typedef unsigned short bf16_t;
typedef short bf16x8 __attribute__((ext_vector_type(8)));
typedef float f32x4 __attribute__((ext_vector_type(4)));
typedef unsigned u32x4 __attribute__((ext_vector_type(4)));
constexpr int BM = 256, BK = 64, HALF = 128, HTB = HALF * BK * 2  , STAGE_BYTES = 8 * HTB, NXCD = 8, WGM = 8;

__host__ __device__ __forceinline__ int lds_byte(int r, int c) { const int st = (r >> 4) * 2 + (c >> 5), rr = r & 15, cc = c & 31, ob = rr * 64 + cc * 2; return st * 1024 + (ob ^ (((ob >> 9) & 1) << 5)); }
__host__ __device__ __forceinline__ void stage_rc(int b, int& R, int& C) { const int st = b / 1024, sb = b % 1024, swz = sb ^ (((sb >> 9) & 1) << 5); R = (st >> 1) * 16 + swz / 64; C = (st & 1) * 32 + (swz % 64) / 2; }
__host__ __device__ __forceinline__ int perm32(int rho) { const int n = rho >> 4, i = rho & 15; return 8 * (i >> 2) + 4 * n + (i & 3); }

struct Unit { int pm, pn; };
struct Gemm { const bf16_t* A; const bf16_t* Bt; int M, N, K; };

struct StaticOrder {
    int nM, nN, nwg, G, c;
    __host__ __device__ void init(int M, int N, int G_, int c_) { nM = M / BM; nN = N / BM; nwg = nM * nN; G = G_; c = c_; }
    __host__ __device__ bool next(int i, Unit& u) const {
        const long L = (long)i * G + c; if (L >= nwg) return false;
        int wgid = (int)L; { const int q = nwg / NXCD, r = nwg % NXCD, xcd = wgid % NXCD, off = wgid / NXCD; wgid = (xcd < r ? xcd * (q + 1) : r * (q + 1) + (xcd - r) * q) + off; }
        const int nig = WGM * nN, gid = wgid / nig, fm = gid * WGM, gsz = (nM - fm) < WGM ? (nM - fm) : WGM;
        u.pm = fm + ((wgid % nig) % gsz); u.pn = (wgid % nig) / gsz; return true;
    }
    __device__ __forceinline__ void a_ready(const Unit&) const {}
    __device__ __forceinline__ void done(const Unit&) const {}
};
template <class Epi, class Sched, bool ALIGN_EPI = false, bool SP2 = false>
__device__ __forceinline__ void gemm_phase(PG8_LAS unsigned char* lds, const Gemm g, const Sched& S, const Epi& E) {
    const int tid = otid(), wid = __builtin_amdgcn_readfirstlane(tid >> 6), lane = tid & 63, wr = wid >> 2, wc = wid & 3, fr = lane & 15, fq = lane >> 4;
    const int K = g.K, nt = K / BK;
    unsigned voffA[2], voffB[2];
#pragma unroll
    for (int i = 0; i < 2; ++i) { int R, C; stage_rc(tid * 16 + i * 8192, R, C); const int Rb = Epi::PERM ? ((R & ~31) + perm32(R & 31)) : R;
        voffA[i] = (unsigned)(R * K + C) * 2u; voffB[i] = (unsigned)(Rb * K + C) * 2u; }
    const size_t kstep = (size_t)(BK * 2);
    const size_t hstep = (size_t)HALF * K * 2;
    const size_t tstep = 2 * hstep;
    const unsigned ldsw = (unsigned)wid * 1024u;
    const int aoff = lds_byte(wr * 64 + fr, fq * 8), boff = lds_byte(wc * 32 + fr, fq * 8);
#define PG8_SA(b, h) (((b) * 2 + (h)) * HTB)
#define PG8_SB(b, h) ((4 + (b) * 2 + (h)) * HTB)
#define PG8_STAGE(bufoff, gbase, voff) do { _Pragma("unroll") for (int _i = 0; _i < 2; ++_i) \
        __builtin_amdgcn_global_load_lds((const unsigned*)((const char*)(gbase) + (voff)[_i]), (PG8_LAS unsigned*)(lds + (bufoff) + ldsw + _i * 8192), 16, 0, 0); } while (0)
#define PG8_LDA(dst, b, h) do { _Pragma("unroll") for (int m = 0; m < 4; ++m) _Pragma("unroll") for (int k = 0; k < 2; ++k) dst[m][k] = *(const PG8_LAS bf16x8*)(lds + PG8_SA(b, h) + aoff + m * 2048 + k * 1024); } while (0)
#define PG8_LDB(dst, b, h) do { _Pragma("unroll") for (int n = 0; n < 2; ++n) _Pragma("unroll") for (int k = 0; k < 2; ++k) dst[n][k] = *(const PG8_LAS bf16x8*)(lds + PG8_SB(b, h) + boff + n * 2048 + k * 1024); } while (0)
#define PG8_MMA(ai, bj, At, Bt) do { __builtin_amdgcn_s_setprio(1); _Pragma("unroll") for (int m = 0; m < 4; ++m) _Pragma("unroll") for (int n = 0; n < 2; ++n) _Pragma("unroll") for (int k = 0; k < 2; ++k) \
        acc[ai][bj][m][n] = __builtin_amdgcn_mfma_f32_16x16x32_bf16(Bt[n][k], At[m][k], acc[ai][bj][m][n], 0, 0, 0); __builtin_amdgcn_s_setprio(0); } while (0)
#define PG8_WAIT_V(n) asm volatile("s_waitcnt vmcnt(" #n ")" ::: "memory")
#define PG8_WAIT_L(n) asm volatile("s_waitcnt lgkmcnt(" #n ")" ::: "memory")
#define PG8_BAR __builtin_amdgcn_s_barrier()
#define PG8_SCHED __builtin_amdgcn_sched_barrier(0)
    Unit cur, nxt; int ui = 0;
    if (!S.next(0, cur)) return;
    f32x4 acc[2][2][4][2];
#pragma unroll
    for (int a = 0; a < 2; ++a)
#pragma unroll
        for (int b = 0; b < 2; ++b)
#pragma unroll
            for (int m = 0; m < 4; ++m)
#pragma unroll
                for (int n = 0; n < 2; ++n) acc[a][b][m][n] = (f32x4){0.f, 0.f, 0.f, 0.f};
    bf16x8 At[4][2], B0[2][2], B1[2][2];
    const char* cA = (const char*)g.A + (size_t)cur.pm * tstep; const char* cB = (const char*)g.Bt + (size_t)cur.pn * tstep;
    S.a_ready(cur);
    if constexpr (SP2) {
        PG8_STAGE(PG8_SB(0, 0), cB, voffB); PG8_STAGE(PG8_SB(0, 1), cB + hstep, voffB); PG8_STAGE(PG8_SA(0, 0), cA, voffA); PG8_STAGE(PG8_SA(0, 1), cA + hstep, voffA);
        if (wr == 1) PG8_BAR;
        PG8_WAIT_V(2); PG8_BAR;
        PG8_STAGE(PG8_SB(1, 0), cB + kstep, voffB); PG8_STAGE(PG8_SA(1, 0), cA + kstep, voffA); PG8_STAGE(PG8_SB(1, 1), cB + hstep + kstep, voffB);
        PG8_WAIT_V(6); PG8_BAR;
    } else {
        PG8_STAGE(PG8_SB(0, 0), cB, voffB); PG8_STAGE(PG8_SA(0, 0), cA, voffA); PG8_STAGE(PG8_SB(0, 1), cB + hstep, voffB); PG8_STAGE(PG8_SA(0, 1), cA + hstep, voffA);
        if (wr == 1) PG8_BAR;
        PG8_WAIT_V(4); PG8_BAR;
        PG8_STAGE(PG8_SB(1, 0), cB + kstep, voffB); PG8_STAGE(PG8_SA(1, 0), cA + kstep, voffA); PG8_STAGE(PG8_SB(1, 1), cB + hstep + kstep, voffB);
        PG8_WAIT_V(6); PG8_BAR;
    }
    for (;;) {
        const bool has_next = S.next(ui + 1, nxt);
        const char* nA = has_next ? (const char*)g.A + (size_t)nxt.pm * tstep : cA; const char* nB = has_next ? (const char*)g.Bt + (size_t)nxt.pn * tstep : cB;
        for (int t = 0; t < nt; t += 2) {
            const bool last = (t == nt - 2);
            const char* a1 = cA + (size_t)(t + 1) * kstep;
            const char* a2 = last ? nA : cA + (size_t)(t + 2) * kstep; const char* b2 = last ? nB : cB + (size_t)(t + 2) * kstep;
            const char* a3 = a2 + kstep; const char* b3 = b2 + kstep;
            if (last && has_next) S.a_ready(nxt);
            if constexpr (SP2) {
            PG8_LDB(B0, 0, 0); PG8_LDB(B1, 0, 1); PG8_SCHED; PG8_LDA(At, 0, 0); PG8_STAGE(PG8_SA(1, 1), a1 + hstep, voffA);
            PG8_WAIT_V(8); PG8_WAIT_L(0); PG8_BAR; PG8_MMA(0, 0, At, B0); PG8_MMA(0, 1, At, B1); PG8_BAR; PG8_SCHED;
            PG8_LDA(At, 0, 1); PG8_STAGE(PG8_SB(0, 0), b2, voffB); PG8_STAGE(PG8_SB(0, 1), b2 + hstep, voffB); PG8_STAGE(PG8_SA(0, 0), a2, voffA);
            PG8_WAIT_V(8); PG8_WAIT_L(0); PG8_BAR; PG8_MMA(1, 0, At, B0); PG8_MMA(1, 1, At, B1); PG8_BAR; PG8_SCHED;
            PG8_LDB(B0, 1, 0); PG8_LDB(B1, 1, 1); PG8_SCHED; PG8_LDA(At, 1, 0); PG8_STAGE(PG8_SA(0, 1), a2 + hstep, voffA);
            PG8_WAIT_V(8); PG8_WAIT_L(0); PG8_BAR; PG8_MMA(0, 0, At, B0); PG8_MMA(0, 1, At, B1); PG8_BAR; PG8_SCHED;
            PG8_LDA(At, 1, 1); PG8_STAGE(PG8_SB(1, 0), b3, voffB); PG8_STAGE(PG8_SB(1, 1), b3 + hstep, voffB); PG8_STAGE(PG8_SA(1, 0), a3, voffA);
            PG8_WAIT_V(8); PG8_WAIT_L(0); PG8_BAR; PG8_MMA(1, 0, At, B0); PG8_MMA(1, 1, At, B1); PG8_BAR; PG8_SCHED;
            } else {
            PG8_LDB(B0, 0, 0); PG8_SCHED; PG8_LDA(At, 0, 0); PG8_STAGE(PG8_SA(1, 1), a1 + hstep, voffA);
            PG8_WAIT_L(8); PG8_BAR; PG8_WAIT_L(0); PG8_MMA(0, 0, At, B0); PG8_BAR; PG8_SCHED;
            PG8_LDB(B1, 0, 1); PG8_STAGE(PG8_SB(0, 0), b2, voffB);
            PG8_BAR; PG8_WAIT_L(0); PG8_MMA(0, 1, At, B1); PG8_BAR;
            PG8_LDA(At, 0, 1); PG8_STAGE(PG8_SA(0, 0), a2, voffA);
            PG8_BAR; PG8_WAIT_L(0); PG8_MMA(1, 0, At, B0); PG8_BAR; PG8_SCHED;
            PG8_STAGE(PG8_SB(0, 1), b2 + hstep, voffB);
            PG8_WAIT_V(6); PG8_BAR; PG8_MMA(1, 1, At, B1); PG8_BAR;
            PG8_LDB(B0, 1, 0); PG8_SCHED; PG8_LDA(At, 1, 0); PG8_STAGE(PG8_SA(0, 1), a2 + hstep, voffA);
            PG8_WAIT_L(8); PG8_BAR; PG8_WAIT_L(0); PG8_MMA(0, 0, At, B0); PG8_BAR; PG8_SCHED;
            PG8_LDB(B1, 1, 1); PG8_STAGE(PG8_SB(1, 0), b3, voffB);
            PG8_BAR; PG8_WAIT_L(0); PG8_MMA(0, 1, At, B1); PG8_BAR;
            PG8_LDA(At, 1, 1); PG8_STAGE(PG8_SA(1, 0), a3, voffA);
            PG8_BAR; PG8_WAIT_L(0); PG8_MMA(1, 0, At, B0); PG8_BAR; PG8_SCHED;
            PG8_STAGE(PG8_SB(1, 1), b3 + hstep, voffB);
            PG8_WAIT_V(6); PG8_BAR; PG8_MMA(1, 1, At, B1); PG8_BAR;
            }
        }
        if constexpr (ALIGN_EPI) { if (wr == 0) PG8_BAR; }
        if constexpr (!Epi::AFTER_DRAIN) { E(acc, cur, wr, wc, fr, fq); S.done(cur); }
        if (!has_next) break;
#pragma unroll
        for (int a = 0; a < 2; ++a)
#pragma unroll
            for (int b = 0; b < 2; ++b)
#pragma unroll
                for (int m = 0; m < 4; ++m)
#pragma unroll
                    for (int n = 0; n < 2; ++n) acc[a][b][m][n] = (f32x4){0.f, 0.f, 0.f, 0.f};
        cur = nxt; cA = nA; cB = nB; ++ui;
        if constexpr (ALIGN_EPI) { if (wr == 1) PG8_BAR; }
    }
    PG8_WAIT_V(0);
    if constexpr (!ALIGN_EPI) { if (wr == 0) PG8_BAR; }
    PG8_BAR;
    if constexpr (Epi::AFTER_DRAIN) { E.fused(acc, cur, wr, wc, fr, fq, lds, wid, lane); S.done(cur); }
#undef PG8_SA
#undef PG8_SB
#undef PG8_STAGE
#undef PG8_LDA
#undef PG8_LDB
#undef PG8_MMA
#undef PG8_WAIT_V
#undef PG8_WAIT_L
#undef PG8_BAR
#undef PG8_SCHED
}
}

constexpr int GT_ROWB = 144, GT_A = 0, GT_B = 128 * GT_ROWB, GT_STAGE = 2 * 128 * GT_ROWB;
DI void gemm_kloop(unsigned char* lds, const bf16_t* a0, const bf16_t* a1, int a_kadv, const bf16_t* b0, const bf16_t* b1, int nk, f32x4 (&acc)[4][2]) {
  const int tid = otid(), lane = tid & 63, wid = tid >> 6, wr = wid >> 2, wc = wid & 3, fr = lane & 15, fq = lane >> 4;
  const int lr = tid >> 3, lkb = (tid & 7) * 16;
  u32x4 xa0, xa1, xb0, xb1, ya0, ya1, yb0, yb1;
#define GT_GLOAD(p0_, p1_, q0_, q1_, kt) do { p0_ = *(const u32x4*)(a0 + (size_t)(kt) * a_kadv); p1_ = *(const u32x4*)(a1 + (size_t)(kt) * a_kadv); q0_ = *(const u32x4*)(b0 + (kt) * 64); q1_ = *(const u32x4*)(b1 + (kt) * 64); } while (0)
#define GT_LSTORE(p0_, p1_, q0_, q1_, buf) do { unsigned char* s_ = lds + (buf) * GT_STAGE; \
    *(u32x4*)(s_ + GT_A + lr * GT_ROWB + lkb) = p0_; *(u32x4*)(s_ + GT_A + (lr + 64) * GT_ROWB + lkb) = p1_; \
    *(u32x4*)(s_ + GT_B + lr * GT_ROWB + lkb) = q0_; *(u32x4*)(s_ + GT_B + (lr + 64) * GT_ROWB + lkb) = q1_; } while (0)
#define GT_COMPUTE(buf) do { \
    const unsigned char* As = lds + (buf) * GT_STAGE + GT_A + (wr * 64 + fr) * GT_ROWB + fq * 16; \
    const unsigned char* Bs = lds + (buf) * GT_STAGE + GT_B + (wc * 32 + fr) * GT_ROWB + fq * 16; \
    _Pragma("unroll") for (int ks = 0; ks < 2; ++ks) { \
      bf16x8 af[4], bfr[2]; \
      _Pragma("unroll") for (int m = 0; m < 4; ++m) af[m] = *(const bf16x8*)(As + m * 16 * GT_ROWB + ks * 64); \
      _Pragma("unroll") for (int n = 0; n < 2; ++n) bfr[n] = *(const bf16x8*)(Bs + n * 16 * GT_ROWB + ks * 64); \
      _Pragma("unroll") for (int m = 0; m < 4; ++m) _Pragma("unroll") for (int n = 0; n < 2; ++n) acc[m][n] = __builtin_amdgcn_mfma_f32_16x16x32_bf16(bfr[n], af[m], acc[m][n], 0, 0, 0); } } while (0)
  GT_GLOAD(xa0, xa1, xb0, xb1, 0); GT_LSTORE(xa0, xa1, xb0, xb1, 0); if (nk > 1) GT_GLOAD(ya0, ya1, yb0, yb1, 1); __syncthreads();
  for (int kt = 0; kt < nk; kt += 2) {
    if (kt + 2 < nk) GT_GLOAD(xa0, xa1, xb0, xb1, kt + 2);
    GT_COMPUTE(0);
    if (kt + 1 < nk) GT_LSTORE(ya0, ya1, yb0, yb1, 1);
    __syncthreads();
    if (kt + 1 >= nk) break;
    if (kt + 3 < nk) GT_GLOAD(ya0, ya1, yb0, yb1, kt + 3);
    GT_COMPUTE(1);
    if (kt + 2 < nk) GT_LSTORE(xa0, xa1, xb0, xb1, 0);
    __syncthreads();
  }
#undef GT_GLOAD
#undef GT_LSTORE
#undef GT_COMPUTE
}
#define ACC_ZERO(acc) do { _Pragma("unroll") for (int m_ = 0; m_ < 4; ++m_) _Pragma("unroll") for (int n_ = 0; n_ < 2; ++n_) acc[m_][n_] = (f32x4){0.f, 0.f, 0.f, 0.f}; } while (0)
#define TILE_IDS const int tid = otid(), bid = obid(), lane = tid & 63, wid = tid >> 6, wr = wid >> 2, wc = wid & 3, fr = lane & 15, fq = lane >> 4, lr = tid >> 3, lk = (tid & 7) * 8; (void)bid; (void)lane; (void)wr; (void)wc; (void)fr; (void)fq; (void)lr; (void)lk

DI void phase_gates(const Params& P_, unsigned char* lds) {
  Params P = P_; { size_t z_ = 0; asm volatile("" : "+s"(z_)); P.ws = P_.ws + z_; }
  TILE_IDS;
  const bf16_t* xn = (const bf16_t*)(P.ws + WS_A); const bf16_t* wt = (const bf16_t*)(P.ws + WS_W + W_IN) + (size_t)5120 * DM; float* gates = (float*)(P.ws + WS_GATES);
  for (int tile = (int)gridDim.x - 1 - bid; tile < NT / 128; tile += gridDim.x) {
    const int row0 = tile * 128;
    f32x4 acc[4][2]; ACC_ZERO(acc);
    gemm_kloop(lds, xn + (size_t)(row0 + lr) * DM + lk, xn + (size_t)(row0 + lr + 64) * DM + lk, 64, wt + (size_t)lr * DM + lk, wt + (size_t)(lr + 64) * DM + lk, DM / 64, acc);
#pragma unroll
    for (int m = 0; m < 4; ++m)
#pragma unroll
      for (int n = 0; n < 2; ++n) {
        const int row = row0 + wr * 64 + m * 16 + fr, c2 = wc * 32 + n * 16 + 4 * fq; const f32x4 v = acc[m][n];
        if (c2 < 48) { f32x4 o = {sigmoidf_(v.x), sigmoidf_(v.y), sigmoidf_(v.z), sigmoidf_(v.w)}; *(f32x4*)(gates + (size_t)row * 48 + c2) = o; }
      }
  }
}
DI void phase_cmp1(const Params& P_, int l, unsigned char* lds) {
  Params P = P_; { size_t z_ = 0; asm volatile("" : "+s"(z_)); P.ws = P_.ws + z_; }
  TILE_IDS;
  const bf16_t* kvk = (const bf16_t*)(P.ws + WS_C); bf16_t* hid = (bf16_t*)(P.ws + WS_HID);
  const float* cb = (const float*)(P.ws + WS_CB) + l * 512;
  for (int tile = bid; tile < 128; tile += gridDim.x) {
    const int kv = tile >> 6, rt = (tile >> 1) & 31, ct = tile & 1, row0 = rt * 128, col0 = ct * 128;
    const bf16_t* wt = (const bf16_t*)(P.ws + WS_W + W_C1) + (size_t)kv * 256 * 2048;
    const bf16_t* ap[2];
#pragma unroll
    for (int i = 0; i < 2; ++i) { const int rr = row0 + lr + 64 * i, b = rr >> 11, n = (rr >> 2) & 511, g = rr & 3, nn = n > 510 ? 510 : n;
      ap[i] = kvk + (size_t)(b * SEQ + 16 * nn) * DM + kv * 256 + g * 64 + lk; }
    f32x4 acc[4][2]; ACC_ZERO(acc);
    gemm_kloop(lds, ap[0], ap[1], DM, wt + (size_t)(col0 + lr) * 2048 + lk, wt + (size_t)(col0 + lr + 64) * 2048 + lk, 32, acc);
#pragma unroll
    for (int m = 0; m < 4; ++m)
#pragma unroll
      for (int n = 0; n < 2; ++n) {
        const int row = row0 + wr * 64 + m * 16 + fr, col = col0 + wc * 32 + n * 16 + 4 * fq;
        const f32x4 bb = *(const f32x4*)(cb + kv * 256 + col); const f32x4 v = acc[m][n] + bb;
        u32x2 o; o.x = pk2(gelu_tanh(v.x), gelu_tanh(v.y)); o.y = pk2(gelu_tanh(v.z), gelu_tanh(v.w));
        *(u32x2*)(hid + ((size_t)kv * 4096 + row) * 256 + col) = o;
      }
  }
}
DI void phase_cmp2(const Params& P_, unsigned char* lds) {
  Params P = P_; { size_t z_ = 0; asm volatile("" : "+s"(z_)); P.ws = P_.ws + z_; }
  TILE_IDS;
  const bf16_t* hid = (const bf16_t*)(P.ws + WS_HID); bf16_t* kc = (bf16_t*)(P.ws + WS_KC); bf16_t* vc = (bf16_t*)(P.ws + WS_VC);
  for (int tile = bid; tile < 64; tile += gridDim.x) {
    const int kv = tile >> 5, rt = tile & 31, row0 = rt * 128;
    const bf16_t* wt = (const bf16_t*)(P.ws + WS_W + W_C2) + (size_t)kv * 128 * 256;
    const bf16_t* a = hid + ((size_t)kv * 4096 + row0) * 256;
    f32x4 acc[4][2]; ACC_ZERO(acc);
    gemm_kloop(lds, a + (size_t)lr * 256 + lk, a + (size_t)(lr + 64) * 256 + lk, 64, wt + (size_t)lr * 256 + lk, wt + (size_t)(lr + 64) * 256 + lk, 4, acc);
    if (wc < 2) {
#pragma unroll
      for (int m = 0; m < 4; ++m)
#pragma unroll
        for (int n = 0; n < 2; ++n) {
          const int rr = row0 + wr * 64 + m * 16 + fr, d = wc * 32 + n * 16 + 4 * fq;
          const int b = rr >> 11, nn = (rr >> 2) & 511, g = rr & 3; const f32x4 v = acc[m][n];
          if (kv == 0) { u32x2 o; o.x = pk2(v.x, v.y); o.y = pk2(v.z, v.w); *(u32x2*)(kc + ((size_t)((b * 4 + g) * 512 + nn)) * 64 + d) = o; }
          else { bf16_t* dst = vc + ((size_t)((b * 4 + g) * 64 + d)) * 512 + perm16(nn); dst[0] = (bf16_t)f2bf(v.x); dst[512] = (bf16_t)f2bf(v.y); dst[1024] = (bf16_t)f2bf(v.z); dst[1536] = (bf16_t)f2bf(v.w); }
        }
    }
  }
}
DI void phase_glu(const Params& P_, unsigned char* lds) {
  Params P = P_; { size_t z_ = 0; asm volatile("" : "+s"(z_)); P.ws = P_.ws + z_; }
  TILE_IDS;
  const bf16_t* y = (const bf16_t*)(P.ws + WS_G); const bf16_t* wt = (const bf16_t*)(P.ws + WS_W + W_GLU); bf16_t* ssm = (bf16_t*)(P.ws + WS_E);
  for (int tile = bid; tile < (NT / 128) * 4; tile += gridDim.x) {
    const int rt = tile >> 2, ct = tile & 3, row0 = rt * 128, col0 = ct * 128;
    f32x4 acc[4][2]; ACC_ZERO(acc);
    gemm_kloop(lds, y + (size_t)(row0 + lr) * 512 + lk, y + (size_t)(row0 + lr + 64) * 512 + lk, 64, wt + (size_t)(col0 + lr) * 512 + lk, wt + (size_t)(col0 + lr + 64) * 512 + lk, 8, acc);
#pragma unroll
    for (int m = 0; m < 4; ++m)
#pragma unroll
      for (int n = 0; n < 2; ++n) {
        const int row = row0 + wr * 64 + m * 16 + fr, col = col0 + wc * 32 + n * 16 + 4 * fq;
        const u32x2 yy = *(const u32x2*)(y + (size_t)row * 512 + col); const f32x4 v = acc[m][n];
        u32x2 o; o.x = pk2(bflo(yy.x) * sigmoidf_(v.x), bfhi(yy.x) * sigmoidf_(v.y)); o.y = pk2(bflo(yy.y) * sigmoidf_(v.z), bfhi(yy.y) * sigmoidf_(v.w));
        *(u32x2*)(ssm + (size_t)row * 512 + col) = o;
      }
  }
}
struct EpiInproj {
  static constexpr bool PERM = false, AFTER_DRAIN = false;
  bf16_t* qb; bf16_t* kvk; bf16_t* vT; bf16_t* mg; bf16_t* ub; float* gates;
  DI void operator()(const f32x4 (&acc)[2][2][4][2], const pg8::Unit& u, int wr, int wc, int fr_, int fq_) const {
    const int pn = u.pn; int fr = fr_, fq = fq_; asm volatile("" : "+v"(fr), "+v"(fq));
#pragma unroll
    for (int ai = 0; ai < 2; ++ai)
#pragma unroll
      for (int m = 0; m < 4; ++m) {
        const int row = u.pm * 256 + ai * 128 + wr * 64 + m * 16 + fr;
#pragma unroll
        for (int bj = 0; bj < 2; ++bj)
#pragma unroll
          for (int n = 0; n < 2; ++n) {
            const int cl = bj * 128 + wc * 32 + n * 16 + 4 * fq;
            const f32x4 v = acc[ai][bj][m][n];
            if (pn < 4) { u32x2 o; o.x = pk2(v.x * QSCALE, v.y * QSCALE); o.y = pk2(v.z * QSCALE, v.w * QSCALE); *(u32x2*)(qb + (size_t)row * DM + pn * 256 + cl) = o; }
            else if (pn < 10) {
              const int seg = pn - 4;
              if (seg == 5) {
                const int b = row >> 13, t = row & (SEQ - 1), g = cl >> 6, d = cl & 63;
                bf16_t* dst = vT + ((size_t)(((1 * NB + b) * 4 + g) * 64 + d)) * SEQ + perm16(t);
                dst[0] = (bf16_t)f2bf(v.x); dst[SEQ] = (bf16_t)f2bf(v.y); dst[2 * SEQ] = (bf16_t)f2bf(v.z); dst[3 * SEQ] = (bf16_t)f2bf(v.w);
              } else if (seg == 3) {
                const unsigned t = row & (SEQ - 1), pos = perm16(t) & 63;
                const unsigned ro = ((unsigned)(row >> 13) * 512u + (t >> 6)) * 4096u + (pos >> 3) * 256u + (pos & 7), co = (unsigned)(cl >> 6) * 524288u + (unsigned)((cl >> 5) & 1) * 2048u + (unsigned)(cl & 31) * 8u;
                bf16_t* dst = vT + (ro + co);
                dst[0] = (bf16_t)f2bf(v.x); dst[8] = (bf16_t)f2bf(v.y); dst[16] = (bf16_t)f2bf(v.z); dst[24] = (bf16_t)f2bf(v.w);
              } else if (seg == 2) {
                const unsigned t = row & (SEQ - 1);
                const unsigned ro = ((unsigned)(row >> 13) * 512u + (t >> 6)) * 4096u + ((t >> 5) & 1) * 2048u + (t & 31) * 8u, co = (unsigned)(cl >> 6) * 524288u + (unsigned)((cl >> 3) & 7) * 256u + (unsigned)(cl & 7);
                u32x2 o; o.x = pk2(v.x, v.y); o.y = pk2(v.z, v.w);
                *(u32x2*)(kvk + (WS_KSF - WS_C) / 2 + (ro + co)) = o;
              } else {
                const int slot = seg == 4 ? 3 : seg;
                u32x2 o; o.x = pk2(v.x, v.y); o.y = pk2(v.z, v.w); *(u32x2*)(kvk + (size_t)row * DM + slot * 256 + cl) = o;
              }
            } else if (pn < 18) {
              u32x2 o; o.x = pk2(sigmoidf_(v.x), sigmoidf_(v.y)); o.y = pk2(sigmoidf_(v.z), sigmoidf_(v.w)); *(u32x2*)(mg + (size_t)row * 2048 + (pn - 10) * 256 + cl) = o;
            } else if (pn < 20) { const int ch = (pn - 18) * 256 + cl; u32x2 o; o.x = pk2(v.x, v.y); o.y = pk2(v.z, v.w); *(u32x2*)(ub + ((size_t)(ch >> 4) * NT + row) * 16 + (ch & 15)) = o; }
            else { if (cl < 48) { f32x4 o = {sigmoidf_(v.x), sigmoidf_(v.y), sigmoidf_(v.z), sigmoidf_(v.w)}; *(f32x4*)(gates + (size_t)row * 48 + cl) = o; } }
          }
      }
  }
};
DI void phase_inproj8(const Params& P_, unsigned char* lds) {
  Params P = P_; { size_t z_ = 0; asm volatile("" : "+s"(z_)); P.ws = P_.ws + z_; }
  pg8::Gemm g{(const bf16_t*)(P.ws + WS_A), (const bf16_t*)(P.ws + WS_W + W_IN), NT, 5120, DM};
  pg8::StaticOrder S; S.init(NT, 5120, gridDim.x, obid());
  EpiInproj E{(bf16_t*)(P.ws + WS_B), (bf16_t*)(P.ws + WS_C), (bf16_t*)(P.ws + WS_DV), (bf16_t*)(P.ws + WS_F), (bf16_t*)(P.ws + WS_E), (float*)(P.ws + WS_GATES)};
  pg8::gemm_phase<EpiInproj, pg8::StaticOrder, true, true>((PG8_LAS unsigned char*)lds, g, S, E);
}
struct EpiMerge1 {
  static constexpr bool PERM = false, AFTER_DRAIN = false;
  const bf16_t* mg; bf16_t* tmp;
  DI void operator()(const f32x4 (&acc)[2][2][4][2], const pg8::Unit& u, int wr, int wc, int fr, int fq) const {
#pragma unroll
    for (int ai = 0; ai < 2; ++ai)
#pragma unroll
      for (int m = 0; m < 4; ++m) {
        const int row = u.pm * 256 + ai * 128 + wr * 64 + m * 16 + fr;
#pragma unroll
        for (int bj = 0; bj < 2; ++bj)
#pragma unroll
          for (int n = 0; n < 2; ++n) {
            const int col = u.pn * 256 + bj * 128 + wc * 32 + n * 16 + 4 * fq; const f32x4 v = acc[ai][bj][m][n];
            const u32x2 ga = *(const u32x2*)(mg + (size_t)row * 2048 + col);
            u32x2 o; o.x = pk2(v.x * bflo(ga.x), v.y * bfhi(ga.x)); o.y = pk2(v.z * bflo(ga.y), v.w * bfhi(ga.y));
            *(u32x2*)(tmp + (size_t)row * DM + col) = o;
          }
      }
  }
};
struct EpiMerge2 {
  static constexpr bool PERM = false, AFTER_DRAIN = false;
  const bf16_t* mg; const bf16_t* tmp; bf16_t* mer;
  DI void operator()(const f32x4 (&acc)[2][2][4][2], const pg8::Unit& u, int wr, int wc, int fr, int fq) const {
#pragma unroll
    for (int ai = 0; ai < 2; ++ai)
#pragma unroll
      for (int m = 0; m < 4; ++m) {
        const int row = u.pm * 256 + ai * 128 + wr * 64 + m * 16 + fr;
#pragma unroll
        for (int bj = 0; bj < 2; ++bj)
#pragma unroll
          for (int n = 0; n < 2; ++n) {
            const int col = u.pn * 256 + bj * 128 + wc * 32 + n * 16 + 4 * fq; const f32x4 v = acc[ai][bj][m][n];
            const u32x2 gs = *(const u32x2*)(mg + (size_t)row * 2048 + 1024 + col);
#if EN_ATTN
            const u32x2 tv = *(const u32x2*)(tmp + (size_t)row * DM + col);
            const float t0 = bflo(tv.x), t1 = bfhi(tv.x), t2 = bflo(tv.y), t3 = bfhi(tv.y);
#else
            const float t0 = 0.f, t1 = 0.f, t2 = 0.f, t3 = 0.f;
#endif
            u32x2 o; o.x = pk2(t0 + v.x * bflo(gs.x), t1 + v.y * bfhi(gs.x)); o.y = pk2(t2 + v.z * bflo(gs.y), t3 + v.w * bfhi(gs.y));
            *(u32x2*)(mer + (size_t)row * DM + col) = o;
          }
      }
  }
};
DI void phase_merge8(const Params& P_, unsigned char* lds) {
  Params P = P_; { size_t z_ = 0; asm volatile("" : "+s"(z_)); P.ws = P_.ws + z_; }
#if EN_ATTN
  { pg8::Gemm g{(const bf16_t*)(P.ws + WS_A), (const bf16_t*)(P.ws + WS_W + W_O), NT, DM, DM};
    pg8::StaticOrder S; S.init(NT, DM, gridDim.x, obid());
    EpiMerge1 E{(const bf16_t*)(P.ws + WS_F), (bf16_t*)(P.ws + WS_C)};
    pg8::gemm_phase<EpiMerge1, pg8::StaticOrder, true, true>((PG8_LAS unsigned char*)lds, g, S, E); }
#endif
  { pg8::Gemm g{(const bf16_t*)(P.ws + WS_E), (const bf16_t*)(P.ws + WS_W + W_SO), NT, DM, 512};
    pg8::StaticOrder S; S.init(NT, DM, gridDim.x, obid());
    EpiMerge2 E{(const bf16_t*)(P.ws + WS_F), (const bf16_t*)(P.ws + WS_C), (bf16_t*)(P.ws + WS_B)};
    pg8::gemm_phase<EpiMerge2, pg8::StaticOrder, true, true>((PG8_LAS unsigned char*)lds, g, S, E); }
}
struct EpiWout {
  static constexpr bool PERM = false, AFTER_DRAIN = false;
  const float* mod; const float* xin; float* out;
  DI void operator()(const f32x4 (&acc)[2][2][4][2], const pg8::Unit& u, int wr, int wc, int fr, int fq) const {
#pragma unroll
    for (int ai = 0; ai < 2; ++ai)
#pragma unroll
      for (int m = 0; m < 4; ++m) {
        const int row = u.pm * 256 + ai * 128 + wr * 64 + m * 16 + fr, b = row >> 13;
#pragma unroll
        for (int bj = 0; bj < 2; ++bj)
#pragma unroll
          for (int n = 0; n < 2; ++n) {
            const int col = u.pn * 256 + bj * 128 + wc * 32 + n * 16 + 4 * fq;
            const f32x4 g1 = *(const f32x4*)(mod + (size_t)b * 6144 + 2048 + col);
            const f32x4 xv = *(const f32x4*)(xin + (size_t)row * DM + col);
            *(f32x4*)(out + (size_t)row * DM + col) = xv + g1 * acc[ai][bj][m][n];
          }
      }
  }
};
DI void phase_wout8(const Params& P_, int l, unsigned char* lds) {
  Params P = P_; { size_t z_ = 0; asm volatile("" : "+s"(z_)); P.ws = P_.ws + z_; }
  pg8::Gemm g{(const bf16_t*)(P.ws + WS_B), (const bf16_t*)(P.ws + WS_W + W_OUT), NT, DM, DM};
  pg8::StaticOrder S; S.init(NT, DM, gridDim.x, obid());
  EpiWout E{(const float*)(P.ws + WS_MOD) + (size_t)(l * 2) * 6144, l == 0 ? P.in[0] : P.out, P.out};
  pg8::gemm_phase<EpiWout, pg8::StaticOrder, true, true>((PG8_LAS unsigned char*)lds, g, S, E);
}

DI bool moe_find(const int* cnt, int rb, int& e, int& rbl, int& ce) {
  int base = 0;
  for (int i = 0; i < NEXP; ++i) { const int c = cnt[i], nb = (c + 127) >> 7; if (rb < base + nb) { e = i; rbl = rb - base; ce = c; return true; } base += nb; }
  return false;
}
DI void phase_moe1(const Params& P_, int l, unsigned char* lds) {
  Params P = P_; { size_t z_ = 0; asm volatile("" : "+s"(z_)); P.ws = P_.ws + z_; }
  TILE_IDS;
  const int* cnt = (const int*)(P.ws + WS_CNT) + l * 32; const int* list = (const int*)(P.ws + WS_LIST);
  const bf16_t* h2 = (const bf16_t*)(P.ws + WS_A); bf16_t* act = (bf16_t*)(P.ws + WS_B);
  int total = 0; for (int i = 0; i < NEXP; ++i) total += (cnt[i] + 127) >> 7;
  for (int tile = bid; tile < total * 4; tile += gridDim.x) {
    const int rb = tile >> 2, ct = tile & 3; int e = 0, rbl = 0, ce = 1; moe_find(cnt, rb, e, rbl, ce);
    const bf16_t* wt = (const bf16_t*)(P.ws + WS_W + W_GU) + (size_t)e * 512 * 1024 + (size_t)(ct * 128) * 1024;
    const bf16_t* ap[2];
#pragma unroll
    for (int i = 0; i < 2; ++i) { int idx = rbl * 128 + lr + 64 * i; idx = idx < ce ? idx : ce - 1; const int tok = list[e * LISTCAP + idx] >> 1; ap[i] = h2 + (size_t)tok * DM + lk; }
    f32x4 acc[4][2]; ACC_ZERO(acc);
    gemm_kloop(lds, ap[0], ap[1], 64, wt + (size_t)lr * DM + lk, wt + (size_t)(lr + 64) * DM + lk, 16, acc);
#pragma unroll
    for (int m = 0; m < 4; ++m) {
      const int arow = rb * 128 + wr * 64 + m * 16 + fr, col = ct * 64 + wc * 16 + 4 * fq;
      const f32x4 g = acc[m][0], u = acc[m][1];
      u32x2 o; o.x = pk2(g.x * sigmoidf_(g.x) * u.x, g.y * sigmoidf_(g.y) * u.y); o.y = pk2(g.z * sigmoidf_(g.z) * u.z, g.w * sigmoidf_(g.w) * u.w);
      *(u32x2*)(act + (size_t)arow * 256 + col) = o;
    }
  }
}
DI void phase_moe2(const Params& P_, int l, unsigned char* lds) {
  Params P = P_; { size_t z_ = 0; asm volatile("" : "+s"(z_)); P.ws = P_.ws + z_; }
  TILE_IDS;
  const int* cnt = (const int*)(P.ws + WS_CNT) + l * 32; const int* list = (const int*)(P.ws + WS_LIST); const float* wts = (const float*)(P.ws + WS_WT);
  const bf16_t* act = (const bf16_t*)(P.ws + WS_B); bf16_t* ys = (bf16_t*)(P.ws + WS_F);
  constexpr int ASUB = 128 * GT_ROWB, BOFF = 4 * ASUB;
  int total = 0; for (int i = 0; i < NEXP; ++i) total += (cnt[i] + 127) >> 7;
  const int lkb = (tid & 7) * 16;
  for (int item = bid; item < total * 4; item += gridDim.x) {
    const int rb = item >> 2, ct0 = (item & 3) * 2; int e = 0, rbl = 0, ce = 1; moe_find(cnt, rb, e, rbl, ce);
    const bf16_t* wt = (const bf16_t*)(P.ws + WS_W + W_D) + (size_t)e * 1024 * 256;
    const bf16_t* a0 = act + (size_t)(rb * 128 + lr) * 256 + lk; const bf16_t* a1 = a0 + 64 * 256;
    u32x4 ra[8], xb0, xb1, yb0, yb1;
#pragma unroll
    for (int k = 0; k < 4; ++k) { ra[2 * k] = *(const u32x4*)(a0 + 64 * k); ra[2 * k + 1] = *(const u32x4*)(a1 + 64 * k); }
#define M2_BLOAD(q0_, q1_, s_) do { const bf16_t* bp_ = wt + (size_t)((ct0 + ((s_) >> 2)) * 128 + lr) * 256 + ((s_) & 3) * 64 + lk; q0_ = *(const u32x4*)bp_; q1_ = *(const u32x4*)(bp_ + 64 * 256); } while (0)
#define M2_BSTORE(q0_, q1_, buf_) do { unsigned char* s_ = lds + BOFF + (buf_) * ASUB; *(u32x4*)(s_ + lr * GT_ROWB + lkb) = q0_; *(u32x4*)(s_ + (lr + 64) * GT_ROWB + lkb) = q1_; } while (0)
#define M2_COMPUTE(s_, buf_) do { \
      const unsigned char* As = lds + ((s_) & 3) * ASUB + (wr * 64 + fr) * GT_ROWB + fq * 16; \
      const unsigned char* Bs = lds + BOFF + (buf_) * ASUB + (wc * 32 + fr) * GT_ROWB + fq * 16; \
      _Pragma("unroll") for (int ks = 0; ks < 2; ++ks) { \
        bf16x8 af[4], bfr[2]; \
        _Pragma("unroll") for (int m = 0; m < 4; ++m) af[m] = *(const bf16x8*)(As + m * 16 * GT_ROWB + ks * 64); \
        _Pragma("unroll") for (int n = 0; n < 2; ++n) bfr[n] = *(const bf16x8*)(Bs + n * 16 * GT_ROWB + ks * 64); \
        _Pragma("unroll") for (int m = 0; m < 4; ++m) _Pragma("unroll") for (int n = 0; n < 2; ++n) acc[m][n] = __builtin_amdgcn_mfma_f32_16x16x32_bf16(bfr[n], af[m], acc[m][n], 0, 0, 0); } } while (0)
#define M2_EPI(ct_) do { _Pragma("unroll") for (int m = 0; m < 4; ++m) { const int idx = rbl * 128 + wr * 64 + m * 16 + fr; \
      if (idx < ce) { const int slot = list[e * LISTCAP + idx]; const float w_ = wts[slot]; \
        _Pragma("unroll") for (int n = 0; n < 2; ++n) { const int col = (ct_) * 128 + wc * 32 + n * 16 + 4 * fq; const f32x4 v = acc[m][n] * w_; \
          u32x2 o; o.x = pk2(v.x, v.y); o.y = pk2(v.z, v.w); *(u32x2*)(ys + (size_t)slot * DM + col) = o; } } } ACC_ZERO(acc); } while (0)
    M2_BLOAD(xb0, xb1, 0);
#pragma unroll
    for (int k = 0; k < 4; ++k) { *(u32x4*)(lds + k * ASUB + lr * GT_ROWB + lkb) = ra[2 * k]; *(u32x4*)(lds + k * ASUB + (lr + 64) * GT_ROWB + lkb) = ra[2 * k + 1]; }
    M2_BSTORE(xb0, xb1, 0);
    M2_BLOAD(yb0, yb1, 1);
    __syncthreads();
    f32x4 acc[4][2]; ACC_ZERO(acc);
#pragma unroll 1
    for (int s2 = 0; s2 < 8; s2 += 2) {
      if (s2 + 2 < 8) M2_BLOAD(xb0, xb1, s2 + 2);
      M2_COMPUTE(s2, 0);
      M2_BSTORE(yb0, yb1, 1);
      __syncthreads();
      if (s2 + 3 < 8) M2_BLOAD(yb0, yb1, s2 + 3);
      M2_COMPUTE(s2 + 1, 1);
      if (s2 == 2) M2_EPI(ct0);
      if (s2 == 6) M2_EPI(ct0 + 1);
      if (s2 + 2 < 8) M2_BSTORE(xb0, xb1, 0);
      __syncthreads();
    }
#undef M2_BLOAD
#undef M2_BSTORE
#undef M2_COMPUTE
#undef M2_EPI
  }
}

typedef float f32x2v __attribute__((ext_vector_type(2)));
DI void phase_s5a(const Params& P_, int l, unsigned char* lds) {
  Params P = P_; { size_t z_ = 0; asm volatile("" : "+s"(z_)); P.ws = P_.ws + z_; }
  TILE_IDS;
  const bf16_t* ub = (const bf16_t*)(P.ws + WS_E); float* Lb = (float*)(P.ws + WS_L);
  const bf16_t* M1 = (const bf16_t*)(P.ws + WS_TAB + (size_t)l * TAB_LAYER + TAB_M1);
  const int first = (int)gridDim.x >= 192 ? 128 : 0;
  for (int tile = bid - first; tile >= 0 && tile < 64; tile += gridDim.x) {
    const int g = tile >> 1, rt = tile & 1;
    const bf16_t* a = ub + ((size_t)g * NT / 64 + rt * 128) * 1024;
    const bf16_t* wt = M1 + (size_t)g * 128 * 1024;
    f32x4 acc[4][2]; ACC_ZERO(acc);
    gemm_kloop(lds, a + (size_t)lr * 1024 + lk, a + (size_t)(lr + 64) * 1024 + lk, 64, wt + (size_t)lr * 1024 + lk, wt + (size_t)(lr + 64) * 1024 + lk, 16, acc);
#pragma unroll
    for (int m = 0; m < 4; ++m)
#pragma unroll
      for (int n = 0; n < 2; ++n) {
        const int R = rt * 128 + wr * 64 + m * 16 + fr, comp = wc * 32 + n * 16 + 4 * fq;
        *(f32x4*)(Lb + ((size_t)(R * 32 + g) * 64) * 2 + comp) = acc[m][n];
      }
  }
}
DI void s5_carry(const Params& P_, int l) {
  Params P = P_; { size_t z_ = 0; asm volatile("" : "+s"(z_)); P.ws = P_.ws + z_; }
  const int tid_ = otid(), bid = obid(), wave = tid_ >> 6, lane = tid_ & 63;
  const int item = (gridDim.x * NWAVE - 1) - (bid * NWAVE + wave);
  if (item >= NB * 32) return;
  const int b = item >> 5, g = item & 31;
  const float* pp = (const float*)(P.ws + WS_S5P) + (size_t)((l * 32 + g) * 64 + lane) * 36;
  const float aTr = pp[2], aTi = pp[3];
  float2* Lp = (float2*)(P.ws + WS_L) + ((size_t)(b * 128) * 32 + g) * 64 + lane;
  unsigned* Sp = (unsigned*)(P.ws + WS_SIN) + ((size_t)(g * 256 + b * 128)) * 64 + lane;
  float sr = 0.f, si = 0.f; asm volatile("" : "+v"(sr), "+v"(si));
  for (int c0 = 0; c0 < 128; c0 += 8) {
    float2 v[8];
#pragma unroll
    for (int k = 0; k < 8; ++k) v[k] = Lp[(size_t)(c0 + k) * 2048];
#pragma unroll
    for (int k = 0; k < 8; ++k) { Lp[(size_t)(c0 + k) * 2048] = make_float2(sr, si); Sp[(size_t)(c0 + k) * 64] = pk2(sr, si);
      const float nr = aTr * sr - aTi * si + v[k].x, ni = aTr * si + aTi * sr + v[k].y; sr = nr; si = ni; }
  }
}
DI void phase_s5c(const Params& P_, int l, unsigned char* lds) {
  Params P = P_; { size_t z_ = 0; asm volatile("" : "+s"(z_)); P.ws = P_.ws + z_; }
  TILE_IDS;
  const bf16_t* ub = (const bf16_t*)(P.ws + WS_E); const bf16_t* sinb = (const bf16_t*)(P.ws + WS_SIN); bf16_t* yb = (bf16_t*)(P.ws + WS_G);
  const bf16_t* tab = (const bf16_t*)(P.ws + WS_TAB + (size_t)l * TAB_LAYER);
  int* dctr = (int*)(P.ws + 640) + l; int* dslot = (int*)(lds + LDS_BYTES - 32);
  constexpr int ROWB = 144, SA = 0, SB = 128 * ROWB, STAGE = 2 * 128 * ROWB;
  const int lkb = (tid & 7) * 16, kch = tid & 7;
  for (;;) {
    if (threadIdx.x == 0) *dslot = atomicAdd(dctr, 1);
    __syncthreads();
    const int tile = *dslot;
    __syncthreads();
    if (tile >= 512) break;
    const int g = tile >> 4, rt = (tile >> 3) & 1, ct = tile & 7;
    const bf16_t* Kt = tab + TAB_KT / 2 + (size_t)g * 64 * 256; const bf16_t* M2 = tab + TAB_M2 / 2 + (size_t)g * 1024 * 128;
    const bf16_t* ua = ub + ((size_t)g * 256 + rt * 128) * 1024; const bf16_t* sa = sinb + ((size_t)g * 256 + rt * 128) * 128;
    const int nbt = 2 * ct + 2 < 16 ? 2 * ct + 2 : 16, ns = nbt + 2;
    u32x4 xa0, xa1, xb0, xb1, ya0, ya1, yb0, yb1;
#define S5_LOAD(p0_, p1_, q0_, q1_, s_) do { \
      if ((s_) < nbt) { p0_ = *(const u32x4*)(ua + (size_t)lr * 1024 + (s_) * 64 + lk); p1_ = *(const u32x4*)(ua + (size_t)(lr + 64) * 1024 + (s_) * 64 + lk); \
        const int i_ = 4 * (s_) + (kch >> 1), hq_ = (kch & 1) * 8; \
        { const int t_ = 8 * ct + (lr >> 4), h_ = lr & 15; q0_ = t_ >= i_ ? *(const u32x4*)(Kt + ((t_ - i_) * 16 + h_) * 16 + hq_) : (u32x4){0u, 0u, 0u, 0u}; } \
        { const int t_ = 8 * ct + 4 + (lr >> 4), h_ = lr & 15; q1_ = t_ >= i_ ? *(const u32x4*)(Kt + ((t_ - i_) * 16 + h_) * 16 + hq_) : (u32x4){0u, 0u, 0u, 0u}; } \
      } else { const int k0_ = ((s_) - nbt) * 64 + lk; \
        p0_ = *(const u32x4*)(sa + (size_t)lr * 128 + k0_); p1_ = *(const u32x4*)(sa + (size_t)(lr + 64) * 128 + k0_); \
        q0_ = *(const u32x4*)(M2 + (size_t)(ct * 128 + lr) * 128 + k0_); q1_ = *(const u32x4*)(M2 + (size_t)(ct * 128 + lr + 64) * 128 + k0_); } } while (0)
#define S5_STORE(p0_, p1_, q0_, q1_, buf) do { unsigned char* s_ = lds + (buf) * STAGE; \
      *(u32x4*)(s_ + SA + lr * ROWB + lkb) = p0_; *(u32x4*)(s_ + SA + (lr + 64) * ROWB + lkb) = p1_; \
      *(u32x4*)(s_ + SB + lr * ROWB + lkb) = q0_; *(u32x4*)(s_ + SB + (lr + 64) * ROWB + lkb) = q1_; } while (0)
#define S5_COMPUTE(buf) do { \
      const unsigned char* As = lds + (buf) * STAGE + SA + (wr * 64 + fr) * ROWB + fq * 16; \
      const unsigned char* Bs = lds + (buf) * STAGE + SB + (wc * 32 + fr) * ROWB + fq * 16; \
      _Pragma("unroll") for (int ks = 0; ks < 2; ++ks) { \
        bf16x8 af[4], bfr[2]; \
        _Pragma("unroll") for (int m = 0; m < 4; ++m) af[m] = *(const bf16x8*)(As + m * 16 * ROWB + ks * 64); \
        _Pragma("unroll") for (int n = 0; n < 2; ++n) bfr[n] = *(const bf16x8*)(Bs + n * 16 * ROWB + ks * 64); \
        _Pragma("unroll") for (int m = 0; m < 4; ++m) _Pragma("unroll") for (int n = 0; n < 2; ++n) acc[m][n] = __builtin_amdgcn_mfma_f32_16x16x32_bf16(bfr[n], af[m], acc[m][n], 0, 0, 0); } } while (0)
    f32x4 acc[4][2]; ACC_ZERO(acc);
    S5_LOAD(xa0, xa1, xb0, xb1, 0); S5_STORE(xa0, xa1, xb0, xb1, 0); S5_LOAD(ya0, ya1, yb0, yb1, 1); __syncthreads();
    for (int st = 0; st < ns; st += 2) {
      if (st + 2 < ns) S5_LOAD(xa0, xa1, xb0, xb1, st + 2);
      S5_COMPUTE(0);
      if (st + 1 < ns) S5_STORE(ya0, ya1, yb0, yb1, 1);
      __syncthreads();
      if (st + 1 >= ns) break;
      if (st + 3 < ns) S5_LOAD(ya0, ya1, yb0, yb1, st + 3);
      S5_COMPUTE(1);
      if (st + 2 < ns) S5_STORE(xa0, xa1, xb0, xb1, 0);
      __syncthreads();
    }
#undef S5_LOAD
#undef S5_STORE
#undef S5_COMPUTE
    const float* dsk = P.in[13] + (size_t)(l * 32 + g) * 16;
#pragma unroll
    for (int m = 0; m < 4; ++m)
#pragma unroll
      for (int n = 0; n < 2; ++n) {
        const int R = rt * 128 + wr * 64 + m * 16 + fr, col = ct * 128 + wc * 32 + n * 16 + 4 * fq, t = col >> 4, h = col & 15;
        const u32x2 uu = *(const u32x2*)(ub + ((size_t)g * 256 + R) * 1024 + col); const f32x4 dd = *(const f32x4*)(dsk + h); const f32x4 v = acc[m][n];
        const float y0 = gelu_tanh(v.x + dd.x * bflo(uu.x)), y1 = gelu_tanh(v.y + dd.y * bfhi(uu.x)), y2 = gelu_tanh(v.z + dd.z * bflo(uu.y)), y3 = gelu_tanh(v.w + dd.w * bfhi(uu.y));
        const size_t tokn = (size_t)(R >> 7) * SEQ + 64 * (R & 127) + t;
        u32x2 o; o.x = pk2(y0, y1); o.y = pk2(y2, y3); *(u32x2*)(yb + tokn * 512 + g * 16 + h) = o;
      }
  }
}

constexpr int AT_ROWB = 144, AT_KS = 0, AT_VS = 2 * 64 * AT_ROWB, AT_IMP = 4 * 64 * AT_ROWB, AT_OACC = AT_IMP, AT_IMPS = 129, AT_EE = AT_IMP + 64 * AT_IMPS * 4,
              AT_SEL = AT_IMP + 66048, AT_QS = AT_SEL + 1024, AT_QL = AT_QS + 32768, AT_NJ = AT_QL + 8192, AT_ITEMS = AT_NJ + 512, AT_MREF = AT_ITEMS + 512,
              AT_LACC = AT_MREF + 1024, AT_INVQ = AT_LACC + 1024, AT_MISC = AT_INVQ + 512, AT_LOWN = AT_MISC + 64, AT_END = AT_LOWN + 1024;
static_assert(AT_END <= LDS_BYTES - 16, "attention LDS");
#define MFMA32(a, b, c) __builtin_amdgcn_mfma_f32_32x32x16_bf16((a), (b), (c), 0, 0, 0)
DI int crow_of(int reg, int hh) { return (reg & 3) + 8 * (reg >> 2) + 4 * hh; }

struct AttnState { f32x16 o0, o1; float m, l; };
DI void st_init(AttnState& S) { S.m = -1e30f; S.l = 0.f;
#pragma unroll
  for (int i = 0; i < 16; ++i) { S.o0[i] = 0.f; S.o1[i] = 0.f; } }

DI void at_ldk(const unsigned char* lds, int buf, int r, int hh, bf16x8 (&kf)[8]) {
  const unsigned char* kb = lds + AT_KS + buf * 64 * AT_ROWB + r * AT_ROWB + hh * 16;
#pragma unroll
  for (int ds = 0; ds < 4; ++ds) { kf[ds] = *(const bf16x8*)(kb + ds * 32); kf[4 + ds] = *(const bf16x8*)(kb + 32 * AT_ROWB + ds * 32); }
}
DI void at_ldv(const unsigned char* lds, int buf, int r, int hh, bf16x8 (&vf)[8]) {
  const unsigned char* vb = lds + AT_VS + buf * 64 * AT_ROWB + r * AT_ROWB + hh * 16;
#pragma unroll
  for (int gk = 0; gk < 4; ++gk) { vf[gk] = *(const bf16x8*)(vb + gk * 32); vf[4 + gk] = *(const bf16x8*)(vb + 32 * AT_ROWB + gk * 32); }
}
DI void at_qk(const bf16x8 (&kf)[8], const bf16x8 (&qf)[4], f32x16& p0, f32x16& p1) {
  const f32x16 z = {0.f, 0.f, 0.f, 0.f, 0.f, 0.f, 0.f, 0.f, 0.f, 0.f, 0.f, 0.f, 0.f, 0.f, 0.f, 0.f};
#pragma unroll
  for (int ds = 0; ds < 4; ++ds) { if (ds == 0) { p0 = MFMA32(kf[0], qf[0], z); p1 = MFMA32(kf[4], qf[0], z); } else { p0 = MFMA32(kf[ds], qf[ds], p0); p1 = MFMA32(kf[4 + ds], qf[ds], p1); } }
}
DI bf16x8 pack8(const f32x16& p, int s2) {
  u32x4 w; w.x = pk2(p[8 * s2], p[8 * s2 + 1]); w.y = pk2(p[8 * s2 + 2], p[8 * s2 + 3]); w.z = pk2(p[8 * s2 + 4], p[8 * s2 + 5]); w.w = pk2(p[8 * s2 + 6], p[8 * s2 + 7]);
  return __builtin_bit_cast(bf16x8, w);
}
DI void at_pv(const bf16x8 (&vf)[8], const f32x16& p0, const f32x16& p1, f32x16& oa, f32x16& ob) {
#pragma unroll
  for (int gk = 0; gk < 4; ++gk) {
    const bf16x8 pb = (gk < 2) ? pack8(p0, gk & 1) : pack8(p1, gk & 1);
    oa = MFMA32(vf[gk], pb, oa); ob = MFMA32(vf[4 + gk], pb, ob);
  }
}
template <int MODE>
DI void at_online(AttnState& S, f32x16& p0, f32x16& p1, int key0, int lo, int hi, bool on, int hh) {
  float tm = -1e30f;
  if (MODE == 1) {
    int lor = lo - key0 - 4 * hh, hir = hi - key0 - 4 * hh;
    if (hir < lor) { lor = 4096; hir = 4096; }
    const unsigned span = (unsigned)(hir - lor);
#pragma unroll
    for (int i = 0; i < 16; ++i) { const int c0 = (i & 3) + 8 * (i >> 2);
      p0[i] = ((unsigned)(c0 - lor) <= span) ? p0[i] : -1e30f; p1[i] = ((unsigned)(c0 + 32 - lor) <= span) ? p1[i] : -1e30f; }
  }
  if (MODE != 1) asm volatile("s_nop 15\n\ts_nop 7" : "+v"(p0), "+v"(p1));
#define MX3_8(o_) asm("v_max3_f32 %0, %0, %1, %2\n\tv_max3_f32 %0, %0, %3, %4\n\tv_max3_f32 %0, %0, %5, %6\n\tv_max3_f32 %0, %0, %7, %8\n\tv_max3_f32 %0, %0, %9, %10\n\tv_max3_f32 %0, %0, %11, %12\n\tv_max3_f32 %0, %0, %13, %14\n\tv_max3_f32 %0, %0, %15, %16" \
      : "+v"(tm) : "v"(p0[o_]), "v"(p1[o_]), "v"(p0[o_ + 1]), "v"(p1[o_ + 1]), "v"(p0[o_ + 2]), "v"(p1[o_ + 2]), "v"(p0[o_ + 3]), "v"(p1[o_ + 3]), "v"(p0[o_ + 4]), "v"(p1[o_ + 4]), "v"(p0[o_ + 5]), "v"(p1[o_ + 5]), "v"(p0[o_ + 6]), "v"(p1[o_ + 6]), "v"(p0[o_ + 7]), "v"(p1[o_ + 7]))
  MX3_8(0); MX3_8(8);
#undef MX3_8
  tm = fmaxf(tm, __shfl_xor(tm, 32));
  if (MODE == 2) tm = on ? tm : -1e30f;
  if (__any(tm > S.m)) {
    const float mn = fmaxf(S.m, tm); const float al = __builtin_amdgcn_exp2f(S.m - mn); S.m = mn; S.l *= al;
#pragma unroll
    for (int i = 0; i < 16; ++i) { S.o0[i] *= al; S.o1[i] *= al; }
  }
  float mn = S.m;
  if (MODE == 2) mn = on ? mn : 1e30f;
  if (MODE == 1) mn = mn < -1e29f ? 1e30f : mn;
  float rs = 0.f;
#pragma unroll
  for (int i = 0; i < 16; ++i) {
    const float e0 = __builtin_amdgcn_exp2f(p0[i] - mn), e1 = __builtin_amdgcn_exp2f(p1[i] - mn);
    p0[i] = e0; p1[i] = e1; rs += e0 + e1;
  }
  S.l += rs;
}

DI void attn_tile(const Params& P_, unsigned char* lds, int b, int g, int c) {
  Params P = P_; { size_t z_ = 0; asm volatile("" : "+s"(z_)); P.ws = P_.ws + z_; }
#define AT_IDS const int tid = otid(), lane = tid & 63, w = tid >> 6, r = lane & 31, hh = lane >> 5, qi = 8 * w + (r >> 2), h = r & 3, t = 64 * c + qi, qrow = 32 * w + r, srow = tid >> 3, sch = (tid & 7) * 8, ahead = lane >> 4, ach = lane & 15; const unsigned tok = (unsigned)b * SEQ + t, goff = tok * 48 + g * 4 + h; (void)qi; (void)h; (void)t; (void)qrow; (void)srow; (void)sch; (void)ahead; (void)ach; (void)tok; (void)goff; (void)hh; (void)w; (void)r
  const bf16_t* qb = (const bf16_t*)(P.ws + WS_B); const bf16_t* kvk = (const bf16_t*)(P.ws + WS_C); const bf16_t* vT = (const bf16_t*)(P.ws + WS_DV);
  const bf16_t* kcb = (const bf16_t*)(P.ws + WS_KC); const bf16_t* vcb = (const bf16_t*)(P.ws + WS_VC);
  const float* gbase = (const float*)(P.ws + WS_GATES);
#define gates(i) gbase[goff + (i)]
  bf16_t* attn = (bf16_t*)(P.ws + WS_A);
  float* otb = (float*)(P.ws + WS_OT) + (size_t)obid() * 16384;
#define otg(i) otb[(unsigned)tid + (i) * 512u]
  float* IMP = (float*)(lds + AT_IMP); float* EE = (float*)(lds + AT_EE); unsigned* SEL = (unsigned*)(lds + AT_SEL);
  AttnState S; f32x16 p0, p1; u32x4 rkA, rvA; bf16x8 qf[4], kfr[8], vfr[8];
#define QF_LOAD() do { _Pragma("unroll") for (int ds_ = 0; ds_ < 4; ++ds_) qf[ds_] = *(const bf16x8*)(lds + AT_QS + qrow * 128 + (((ds_ * 2 + hh) ^ (qrow & 7)) * 16)); } while (0)
#define AT_QKV() do { at_ldk(lds, buf_, r, hh, kfr); __builtin_amdgcn_sched_barrier(0); at_qk(kfr, qf, p0, p1); at_ldv(lds, buf_, r, hh, vfr); __builtin_amdgcn_sched_barrier(0); } while (0)
  { AT_IDS;
  { const int row = tid >> 1, half = tid & 1, q_i = row >> 2, hd = row & 3;
    const unsigned so = ((unsigned)b * SEQ + 64 * c + q_i) * DM + (g * 4 + hd) * 64 + half * 32;
#pragma unroll
    for (int k = 0; k < 4; ++k) { const u32x4 v = *(const u32x4*)(qb + so + k * 8); *(u32x4*)(lds + AT_QS + row * 128 + (((half * 4 + k) ^ (row & 7)) * 16)) = v; } }
  __syncthreads();
  QF_LOAD();
#define ST_LOAD(rk, rv, kp, kstride, vp, vstride, kt) do { rk = *(const u32x4*)((kp) + (unsigned)(((kt) * 64 + srow) * (kstride) + sch)); rv = *(const u32x4*)((vp) + (unsigned)(srow * (vstride) + (kt) * 64 + sch)); } while (0)
#define ST_STORE(rk, rv, buf) do { *(u32x4*)(lds + AT_KS + (buf) * 64 * AT_ROWB + srow * AT_ROWB + sch * 2) = rk; *(u32x4*)(lds + AT_VS + (buf) * 64 * AT_ROWB + srow * AT_ROWB + sch * 2) = rv; } while (0)
#define SWEEP(kp, kstride, vp, vstride, kt0, n, ...) do { \
    ST_LOAD(rkA, rvA, kp, kstride, vp, vstride, (kt0)); ST_STORE(rkA, rvA, 0); __syncthreads(); \
    for (int i_ = 0; i_ < (n); ++i_) { \
      if (i_ + 1 < (n)) ST_LOAD(rkA, rvA, kp, kstride, vp, vstride, (kt0) + i_ + 1); \
      { const int step_ = i_; const int buf_ = i_ & 1; __VA_ARGS__ } \
      if (i_ + 1 < (n)) ST_STORE(rkA, rvA, (i_ + 1) & 1); \
      __syncthreads(); \
    } } while (0)
#define ST_LOADF(rk, rv, kt) do { rk = *(const u32x4*)(kps + (size_t)(kt) * 4096 + tid * 8); rv = *(const u32x4*)(vps + (size_t)(kt) * 4096 + tid * 8); } while (0)
#define ST_STOREF(rk, rv, buf) do { const int fo_ = ((tid >> 8) * 32 + (tid & 31)) * AT_ROWB + (((tid >> 6) & 3) * 2 + ((tid >> 5) & 1)) * 16; \
    *(u32x4*)(lds + AT_KS + (buf) * 64 * AT_ROWB + fo_) = rk; *(u32x4*)(lds + AT_VS + (buf) * 64 * AT_ROWB + fo_) = rv; } while (0)
#define SWEEPF(kt0, n, ...) do { \
    ST_LOADF(rkA, rvA, (kt0)); ST_STOREF(rkA, rvA, 0); __syncthreads(); \
    for (int i_ = 0; i_ < (n); ++i_) { \
      if (i_ + 1 < (n)) ST_LOADF(rkA, rvA, (kt0) + i_ + 1); \
      { const int step_ = i_; const int buf_ = i_ & 1; __VA_ARGS__ } \
      if (i_ + 1 < (n)) ST_STOREF(rkA, rvA, (i_ + 1) & 1); \
      __syncthreads(); \
    } } while (0)
  {
    const bf16_t* kp = kvk + (size_t)b * SEQ * DM + 3 * 256 + g * 64; const bf16_t* vp = vT + (size_t)(((1 * NB + b) * 4 + g) * 64) * SEQ;
    const int j0 = c >= 8 ? c - 8 : 0, nj = c - j0 + 1;
    st_init(S);
    SWEEP(kp, DM, vp, SEQ, j0, nj, {
      AT_QKV();
      if ((step_ == 0 && c >= 8) || step_ == nj - 1) at_online<1>(S, p0, p1, (j0 + step_) * 64, t - 511, t, true, hh);
      else at_online<0>(S, p0, p1, 0, 0, 0, true, hh);
      at_pv(vfr, p0, p1, S.o0, S.o1); });
    const float lt = S.l + __shfl_xor(S.l, 32); const float sc = lt > 0.f ? gates(32) / lt : 0.f;
#pragma unroll
    for (int i = 0; i < 16; ++i) { otg(i) = S.o0[i] * sc; otg(16 + i) = S.o1[i] * sc; }
  }
  {
    const bf16_t* kcp = kcb + (size_t)((b * 4 + g) * 512) * 64; const bf16_t* vcp = vcb + (size_t)((b * 4 + g) * 64) * 512;
    const int nmax = t >= 31 ? (t - 31) >> 4 : -1;
    const int nct = (4 * c + 2) / 64 + 1;
    st_init(S);
    SWEEP(kcp, 64, vcp, 512, 0, nct, {
      at_ldk(lds, buf_, r, hh, kfr); __builtin_amdgcn_sched_barrier(0); at_qk(kfr, qf, p0, p1);
      if (64 * step_ + 63 <= 4 * c - 2) at_online<0>(S, p0, p1, 0, 0, 0, true, hh);
      else at_online<1>(S, p0, p1, step_ * 64, 0, nmax, true, hh); });
    const float lt = S.l + __shfl_xor(S.l, 32);
    const float cinv = lt > 0.f ? 1.f / lt : 0.f; const float cm = S.m;
    st_init(S);
    SWEEP(kcp, 64, vcp, 512, 0, nct, {
      AT_QKV();
      if (64 * step_ + 63 <= 4 * c - 2) {
        _Pragma("unroll") for (int k = 0; k < 16; ++k) { p0[k] = __builtin_amdgcn_exp2f(p0[k] - cm) * cinv; p1[k] = __builtin_amdgcn_exp2f(p1[k] - cm) * cinv; }
      } else {
        const int nrel = nmax - step_ * 64 - 4 * hh;
        _Pragma("unroll") for (int k = 0; k < 16; ++k) { const int c0 = (k & 3) + 8 * (k >> 2), c1 = c0 + 32;
          p0[k] = c0 <= nrel ? __builtin_amdgcn_exp2f(p0[k] - cm) * cinv : 0.f; p1[k] = c1 <= nrel ? __builtin_amdgcn_exp2f(p1[k] - cm) * cinv : 0.f; }
      }
      at_pv(vfr, p0, p1, S.o0, S.o1);
      _Pragma("unroll") for (int kh = 0; kh < 2; ++kh)
      _Pragma("unroll") for (int gi = 0; gi < 4; ++gi) {
          float g4 = kh == 0 ? (p0[4 * gi] + p0[4 * gi + 1]) + (p0[4 * gi + 2] + p0[4 * gi + 3]) : (p1[4 * gi] + p1[4 * gi + 1]) + (p1[4 * gi + 2] + p1[4 * gi + 3]);
          float e3 = kh == 0 ? p0[4 * gi + 3] : p1[4 * gi + 3];
          g4 += __shfl_xor(g4, 1); g4 += __shfl_xor(g4, 2); e3 += __shfl_xor(e3, 1); e3 += __shfl_xor(e3, 2);
          if (h == 0) { const int s = (step_ * 64 + kh * 32 + 8 * gi + 4 * hh) >> 2; IMP[qi * AT_IMPS + s] = g4; EE[qi * AT_IMPS + s] = e3; }
      } });
    const float gc = gates(0);
#pragma unroll
    for (int i = 0; i < 16; ++i) { otg(i) += S.o0[i] * gc; otg(16 + i) += S.o1[i] * gc; }
  }
  }
  const bf16_t* kps = (const bf16_t*)(P.ws + WS_KSF) + (size_t)((b * 4 + g) * 128) * 4096; const bf16_t* vps = vT + (size_t)((b * 4 + g) * 128) * 4096;
  if (c <= 15) { AT_IDS; QF_LOAD();
    st_init(S);
    if (c > 0) {
      SWEEPF(0, c, {
        AT_QKV();
        at_online<0>(S, p0, p1, 0, 0, 0, true, hh);
        at_pv(vfr, p0, p1, S.o0, S.o1); });
    }
    SWEEPF(c, 1, {
      AT_QKV();
      at_online<1>(S, p0, p1, (c + step_) * 64, 0, t, true, hh);
      at_pv(vfr, p0, p1, S.o0, S.o1); });
    const float lt = S.l + __shfl_xor(S.l, 32); const float slc_sc = lt > 0.f ? gates(16) / lt : 0.f;
    bf16_t* op = attn + (tok * DM + (g * 4 + h) * 64);
#pragma unroll
    for (int i = 0; i < 16; ++i) { S.o0[i] = S.o0[i] * slc_sc + otg(i); S.o1[i] = S.o1[i] * slc_sc + otg(16 + i); }
#pragma unroll
    for (int gi = 0; gi < 4; ++gi) {
      u32x2 a; a.x = pk2(S.o0[4 * gi], S.o0[4 * gi + 1]); a.y = pk2(S.o0[4 * gi + 2], S.o0[4 * gi + 3]);
      u32x2 bq; bq.x = pk2(S.o1[4 * gi], S.o1[4 * gi + 1]); bq.y = pk2(S.o1[4 * gi + 2], S.o1[4 * gi + 3]);
      *(u32x2*)(op + 8 * gi + 4 * hh) = a; *(u32x2*)(op + 32 + 8 * gi + 4 * hh) = bq;
    }
  } else {
    const int nc = c - 2;
    unsigned char* QL = lds + AT_QL; int* NJ = (int*)(lds + AT_NJ); unsigned short* ITEMS = (unsigned short*)(lds + AT_ITEMS); int* MISC = (int*)(lds + AT_MISC);
    float* MREF = (float*)(lds + AT_MREF); float* LS = (float*)(lds + AT_LACC); unsigned char* INVQ = lds + AT_INVQ; unsigned char* SLOT = lds + AT_IMP;
    float* const LOWN = (float*)(lds + AT_LOWN); const float k64 = 5.421010862427522e-20f;
    { AT_IDS;
    for (int idx = tid; idx < 64 * nc; idx += NTHR) { const int q = idx / nc, s = 1 + idx % nc; IMP[q * AT_IMPS + s] += EE[q * AT_IMPS + s - 1]; }
    if (tid < 256) SEL[tid] = 0u;
    if (tid < 128) ((unsigned*)INVQ)[tid] = 0u;
    __syncthreads();
    {
      const int q = tid >> 3, sub = tid & 7; const float* ip = IMP + q * AT_IMPS;
      unsigned key[16];
#pragma unroll
      for (int k = 0; k < 16; ++k) { const int s = 1 + sub + 8 * k; key[k] = s <= nc ? __float_as_uint(ip[s]) + 1u : 0u; }
      unsigned T = 0u;
      for (int bit = 30; bit >= 0; --bit) {
        const unsigned cand = T | (1u << bit); int cn = 0;
#pragma unroll
        for (int k = 0; k < 16; ++k) cn += key[k] >= cand ? 1 : 0;
        cn += __shfl_xor(cn, 1); cn += __shfl_xor(cn, 2); cn += __shfl_xor(cn, 4);
        if (cn >= 13) T = cand;
      }
      int ngt = 0, neq = 0;
#pragma unroll
      for (int k = 0; k < 16; ++k) { ngt += key[k] > T ? 1 : 0; neq += key[k] == T ? 1 : 0; }
      ngt += __shfl_xor(ngt, 1); ngt += __shfl_xor(ngt, 2); ngt += __shfl_xor(ngt, 4);
      neq += __shfl_xor(neq, 1); neq += __shfl_xor(neq, 2); neq += __shfl_xor(neq, 4);
      const int need = 13 - ngt;
      unsigned w0 = 0u, w1 = 0u, w2 = 0u, w3 = 0u;
      if (!__any(neq > need)) {
#pragma unroll
        for (int k = 0; k < 16; ++k) if (key[k] >= T && key[k] != 0u) { const int s = 1 + sub + 8 * k; const unsigned bt = 1u << (s & 31); if (s < 32) w0 |= bt; else if (s < 64) w1 |= bt; else if (s < 96) w2 |= bt; else w3 |= bt; }
      } else {
        int taken = 0; const int gsh = lane & ~7;
#pragma unroll
        for (int k = 0; k < 16; ++k) {
          const bool eq = key[k] == T && key[k] != 0u; const unsigned long long mk = __ballot(eq);
          const unsigned grp = (unsigned)(mk >> gsh) & 0xffu; const int before = __popc(grp & ((1u << sub) - 1u));
          const bool pick = key[k] > T || (eq && taken + before < need);
          taken += __popc(grp);
          if (pick) { const int s = 1 + sub + 8 * k; const unsigned bt = 1u << (s & 31); if (s < 32) w0 |= bt; else if (s < 64) w1 |= bt; else if (s < 96) w2 |= bt; else w3 |= bt; }
        }
      }
      if (w0) atomicOr(&SEL[q * 4], w0); if (w1) atomicOr(&SEL[q * 4 + 1], w1); if (w2) atomicOr(&SEL[q * 4 + 2], w2); if (w3) atomicOr(&SEL[q * 4 + 3], w3);
    }
    __syncthreads();
    for (int j = 1 + w; j <= nc; j += NWAVE) {
      const bool bit = (SEL[lane * 4 + (j >> 5)] >> (j & 31)) & 1u;
      const unsigned long long mk = __ballot(bit);
      const int rank = __builtin_amdgcn_mbcnt_hi((unsigned)(mk >> 32), __builtin_amdgcn_mbcnt_lo((unsigned)mk, 0u));
      if (bit) QL[j * 64 + rank] = (unsigned char)lane;
      const int cnt = __popcll(mk);
      if (lane < ((8 - (cnt & 7)) & 7)) QL[j * 64 + cnt + lane] = 0;
      if (lane == 0) NJ[j] = cnt;
    }
    __syncthreads();
    if (w == 0) {
      const int ja = 1 + lane, jb = 65 + lane;
      const int ca = ja <= nc ? (NJ[ja] + 7) >> 3 : 0, cb = jb <= nc ? (NJ[jb] + 7) >> 3 : 0;
      int sa = ca, sb = cb;
#pragma unroll
      for (int o = 1; o < 64; o <<= 1) { const int ta = __shfl_up(sa, o), tb = __shfl_up(sb, o); if (lane >= o) { sa += ta; sb += tb; } }
      const int tota = __shfl(sa, 63);
      for (int k = 0; k < ca; ++k) ITEMS[sa - ca + k] = (unsigned short)(ja * 8 + k);
      for (int k = 0; k < cb; ++k) ITEMS[tota + sb - cb + k] = (unsigned short)(jb * 8 + k);
      if (lane == 63) MISC[0] = tota + sb;
    }
    }
    { AT_IDS; QF_LOAD();
    st_init(S);
    SWEEPF(0, 1, {
      AT_QKV();
      at_online<0>(S, p0, p1, 0, 0, 0, true, hh);
      at_pv(vfr, p0, p1, S.o0, S.o1); });
    SWEEPF(c - 1, 2, {
      AT_QKV();
      if (step_ == 1) at_online<1>(S, p0, p1, c * 64, 0, t, true, hh); else at_online<0>(S, p0, p1, 0, 0, 0, true, hh);
      at_pv(vfr, p0, p1, S.o0, S.o1); });
    { const float lt = S.l + __shfl_xor(S.l, 32);
      if (hh == 0) { MREF[qrow] = S.m + 64.f; LS[w * 32 + r] = lt * k64; } }
#define SLOT_WRITE(x, o0_, o1_, scale_) do { unsigned char* sp_ = SLOT + (x) * 8192 + r * 256; \
      _Pragma("unroll") for (int gi_ = 0; gi_ < 4; ++gi_) { \
        const f32x4 va_ = {o0_[4 * gi_] * (scale_), o0_[4 * gi_ + 1] * (scale_), o0_[4 * gi_ + 2] * (scale_), o0_[4 * gi_ + 3] * (scale_)}; \
        const f32x4 vb_ = {o1_[4 * gi_] * (scale_), o1_[4 * gi_ + 1] * (scale_), o1_[4 * gi_ + 2] * (scale_), o1_[4 * gi_ + 3] * (scale_)}; \
        *(f32x4*)(sp_ + (((2 * gi_ + hh) ^ (r & 15)) * 16)) = va_; *(f32x4*)(sp_ + (((8 + 2 * gi_ + hh) ^ (r & 15)) * 16)) = vb_; } } while (0)
#define SLOT_READ(x, col_) (*(const f32x4*)(SLOT + (x) * 8192 + (col_) * 256 + ((ach ^ ((col_) & 15)) * 16)))
    SLOT_WRITE(w, S.o0, S.o1, k64);
    __syncthreads();
    }
    {
      AT_IDS; const int wu = __builtin_amdgcn_readfirstlane(w);
      const int nitems = MISC[0], nrounds = (nitems + 3) >> 2;
      if (wu >= 4) {
        const int ow = wu - 4, oq = lane >> 2, oh = lane & 3, srcslot = 2 * ow + (lane >> 5), scol = lane & 31;
        f32x4 acc[16]; float accl;
        { const unsigned char* rp = SLOT + srcslot * 8192 + scol * 256;
#pragma unroll
          for (int k = 0; k < 16; ++k) acc[k] = *(const f32x4*)(rp + ((k ^ (scol & 15)) * 16));
          accl = LS[srcslot * 32 + scol]; }
        __syncthreads();
        for (int rd = 0; rd <= nrounds; ++rd) {
          if (rd > 0) {
            const int set = (rd - 1) & 1;
            unsigned* ivp = (unsigned*)(INVQ + set * 256) + 16 * ow + oq;
            unsigned iv = *ivp;
            if (__any(iv != 0u)) {
              if (iv != 0u && oh == 0) *ivp = 0u;
              do {
                const int x = (iv & 0xffu) ? 0 : (iv & 0xff00u) ? 1 : (iv & 0xff0000u) ? 2 : 3;
                const unsigned byte = (iv >> (8 * x)) & 0xffu;
                iv &= ~(0xffu << (8 * x));
                if (byte) {
                  const int col = (int)(byte - 1) * 4 + oh;
                  const unsigned char* rp = SLOT + (set * 4 + x) * 8192 + col * 256;
                  f32x4 tq[16];
#pragma unroll
                  for (int k = 0; k < 16; ++k) tq[k] = *(const f32x4*)(rp + ((k ^ (col & 15)) * 16));
                  const float tl = LS[(set * 4 + x) * 32 + col];
                  __builtin_amdgcn_sched_barrier(0);
#pragma unroll
                  for (int k = 0; k < 16; ++k) acc[k] += tq[k];
                  accl += tl;
                }
              } while (__any(iv != 0u));
            }
          }
          __syncthreads();
        }
#pragma unroll
        for (int i = 0; i < 16; ++i) { S.o0[i] = otg(i); S.o1[i] = otg(16 + i); }
        SLOT_WRITE(w, S.o0, S.o1, 1.0f);
        __syncthreads();
        {
          const unsigned tq = (unsigned)b * SEQ + 64 * c + 16 * ow + oq;
          const float gs = gbase[tq * 48 + 16 + g * 4 + oh]; const float sc = accl > 0.f ? gs / accl : 0.f;
          const unsigned char* rp = SLOT + srcslot * 8192 + scol * 256;
          bf16_t* op = attn + (tq * DM + (g * 4 + oh) * 64);
#pragma unroll
          for (int k2 = 0; k2 < 8; ++k2) {
            const f32x4 v0 = acc[2 * k2] * sc + *(const f32x4*)(rp + (((2 * k2) ^ (scol & 15)) * 16)), v1 = acc[2 * k2 + 1] * sc + *(const f32x4*)(rp + (((2 * k2 + 1) ^ (scol & 15)) * 16));
            u32x4 o; o.x = pk2(v0.x, v0.y); o.y = pk2(v0.z, v0.w); o.z = pk2(v1.x, v1.y); o.w = pk2(v1.z, v1.w);
            *(u32x4*)(op + 8 * k2) = o;
          }
        }
      } else {
        __syncthreads();
        const bf16_t* kgl = kps + lane * 8; const bf16_t* vgl = vps + lane * 8;
        bf16x8 kfA[8], vfA[8], kfB[8], vfB[8];
#define FLOAD(KF, VF, jj) do { _Pragma("unroll") for (int f_ = 0; f_ < 8; ++f_) { KF[f_] = *(const bf16x8*)(kgl + (size_t)(jj) * 4096 + f_ * 512); VF[f_] = *(const bf16x8*)(vgl + (size_t)(jj) * 4096 + f_ * 512); } } while (0)
        int rowc = 0, qqc = 0; bool validc = false; float mrc = 1e30f; int en = 0;
        if (wu < nitems) { const int e0 = ITEMS[wu]; const int j0_ = e0 >> 3; const int qs_ = 8 * (e0 & 7) + (r >> 2); validc = qs_ < NJ[j0_]; qqc = QL[j0_ * 64 + qs_]; rowc = qqc * 4 + h; mrc = validc ? MREF[rowc] : 1e30f; FLOAD(kfA, vfA, j0_); }
        if (wu + 4 < nitems) en = __builtin_amdgcn_readfirstlane(ITEMS[wu + 4]);
        FLOAD(kfB, vfB, en >> 3);
#define ITEM_ROUND(KF, VF, rd_) do { \
          const int it = (rd_) * 4 + wu, set = (rd_) & 1; \
          if (it < nitems) { \
            const bool hasn = it + 4 < nitems; \
            const int jn = en >> 3, qsn = 8 * (en & 7) + (r >> 2);        \
            bf16x8 qv[4];                                               \
            _Pragma("unroll") for (int ds = 0; ds < 4; ++ds) qv[ds] = *(const bf16x8*)(lds + AT_QS + rowc * 128 + (((ds * 2 + hh) ^ (rowc & 7)) * 16)); \
            const int njn = NJ[jn]; const int qqn = QL[jn * 64 + qsn]; \
            const int en2 = it + 8 < nitems ? __builtin_amdgcn_readfirstlane(ITEMS[it + 8]) : 0; const int j2 = en2 >> 3; \
            __builtin_amdgcn_sched_barrier(0); \
            const f32x16 z = {0.f, 0.f, 0.f, 0.f, 0.f, 0.f, 0.f, 0.f, 0.f, 0.f, 0.f, 0.f, 0.f, 0.f, 0.f, 0.f}; \
            _Pragma("unroll") for (int ds = 0; ds < 4; ++ds) { \
              if (ds == 0) { p0 = MFMA32(KF[0], qv[0], z); p1 = MFMA32(KF[4], qv[0], z); } else { p0 = MFMA32(KF[ds], qv[ds], p0); p1 = MFMA32(KF[4 + ds], qv[ds], p1); } \
            } \
            const bool validn = hasn && qsn < njn; const int rown = qqn * 4 + h; \
            const float mrn = validn ? MREF[rown] : 1e30f; \
            float rs = 0.f; \
            _Pragma("unroll") for (int i = 0; i < 16; ++i) { \
              p0[i] = __builtin_amdgcn_exp2f(fminf(p0[i] - mrc, 120.f)); p1[i] = __builtin_amdgcn_exp2f(fminf(p1[i] - mrc, 120.f)); rs += p0[i] + p1[i]; \
              if (i & 1) { KF[i >> 1] = *(const bf16x8*)(kgl + (size_t)j2 * 4096 + (i >> 1) * 512); __builtin_amdgcn_sched_barrier(0); } \
            } \
            rs += __shfl_xor(rs, 32); \
            f32x16 o0 = z, o1 = z; \
            _Pragma("unroll") for (int gk = 0; gk < 4; ++gk) { const bf16x8 pb = (gk < 2) ? pack8(p0, gk & 1) : pack8(p1, gk & 1); o0 = MFMA32(VF[gk], pb, o0); o1 = MFMA32(VF[4 + gk], pb, o1); } \
            { unsigned char* sp_ = SLOT + (set * 4 + wu) * 8192 + r * 256; \
              _Pragma("unroll") for (int gi = 0; gi < 4; ++gi) { \
                const f32x4 va_ = {o0[4 * gi], o0[4 * gi + 1], o0[4 * gi + 2], o0[4 * gi + 3]}; const f32x4 vb_ = {o1[4 * gi], o1[4 * gi + 1], o1[4 * gi + 2], o1[4 * gi + 3]}; \
                *(f32x4*)(sp_ + (((2 * gi + hh) ^ (r & 15)) * 16)) = va_; *(f32x4*)(sp_ + (((8 + 2 * gi + hh) ^ (r & 15)) * 16)) = vb_; \
                VF[2 * gi] = *(const bf16x8*)(vgl + (size_t)j2 * 4096 + (2 * gi) * 512); VF[2 * gi + 1] = *(const bf16x8*)(vgl + (size_t)j2 * 4096 + (2 * gi + 1) * 512); \
                __builtin_amdgcn_sched_barrier(0); \
              } } \
            if (hh == 0) LS[(set * 4 + wu) * 32 + r] = rs; \
            if (validc && h == 0 && hh == 0) INVQ[set * 256 + qqc * 4 + wu] = (unsigned char)((r >> 2) + 1); \
            rowc = rown; qqc = qqn; validc = validn; mrc = mrn; en = en2; \
          } } while (0)
        for (int rd = 0; rd < nrounds; rd += 2) {
          ITEM_ROUND(kfA, vfA, rd);
          __syncthreads();
          if (rd + 1 < nrounds) {
            ITEM_ROUND(kfB, vfB, rd + 1);
            __syncthreads();
          }
        }
#undef ITEM_ROUND
#undef FLOAD
#undef ITEM_META
#undef KLOAD
#undef VLOAD
        __syncthreads();
#pragma unroll
        for (int i = 0; i < 16; ++i) { S.o0[i] = otg(i); S.o1[i] = otg(16 + i); }
        SLOT_WRITE(w, S.o0, S.o1, 1.0f);
        __syncthreads();
      }
    }
#undef SLOT_WRITE
#undef SLOT_READ
  }
  __syncthreads();
#undef ST_LOAD
#undef ST_STORE
#undef SWEEP
#undef ST_LOADF
#undef ST_STOREF
#undef SWEEPF
#undef gates
#undef otg
#undef QF_LOAD
#undef AT_QKV
#undef AT_IDS
}
DI void phase_attn(const Params& P_, unsigned char* lds) {
  Params P = P_; { size_t z_ = 0; asm volatile("" : "+s"(z_)); P.ws = P_.ws + z_; }
  const int G = gridDim.x, bx = obid();
  const int vcu = (G % 8 == 0) ? (bx % 8) * (G / 8) + bx / 8 : bx;
  for (int idx = vcu; idx < 1024; idx += G) {
    const int i = idx >> 8, v = idx & 255, bg = v >> 5, s = v & 31;
    const int c = i == 0 ? s : i == 1 ? 63 - s : i == 2 ? 64 + s : 127 - s;
    attn_tile(P, lds, bg >> 2, bg & 3, c);
  }
}


#define LAS __attribute__((address_space(3)))
#define XB_TMO      128
#define XB_XCNT(j)  (256  + 64 * (j))
#define XB_XSUB(j)  (1280 + 64 * (j))
#define XB_XGEN(j)  (2304 + 64 * (j))
#define XB_TOP      3328
#define XB_TOPGEN   3392
#define XCD_BAR_WORDS 3456
#define XB_SPIN_CAP (1u << 18)
__device__ __forceinline__ unsigned xb_ld(unsigned* p)              { return __hip_atomic_load(p, __ATOMIC_RELAXED, __HIP_MEMORY_SCOPE_AGENT); }
__device__ __forceinline__ unsigned xb_add(unsigned* p, unsigned v) { return __hip_atomic_fetch_add(p, v, __ATOMIC_RELAXED, __HIP_MEMORY_SCOPE_AGENT); }
__device__ __forceinline__ unsigned xb_xcc_id() { return (unsigned)__builtin_amdgcn_s_getreg((3 << 11) | 20) & 0xFu; }
#define XB_SPIN(cond, bar) do { unsigned _sp = 0; while (cond) { __builtin_amdgcn_s_sleep(1); \
    if ((++_sp & 255u) == 0u) { if (xb_ld(&(bar)[XB_TMO])) break; if (_sp > XB_SPIN_CAP) { atomicAdd(&(bar)[XB_TMO], 1u); break; } } } } while (0)
struct XcdBarrier { unsigned* bar; unsigned x; volatile LAS unsigned* st; };
__device__ __forceinline__ XcdBarrier xcd_barrier_post(unsigned* bar, volatile LAS unsigned* st) {
    XcdBarrier b; b.bar = bar; b.x = xb_xcc_id(); b.st = st;
    if (threadIdx.x == 0) (void)xb_add(&bar[XB_XCNT(b.x)], 1u);
    return b;
}
__device__ __forceinline__ void xcd_barrier_complete(unsigned* bar, unsigned x, unsigned& nloc, unsigned& nx) {
    const unsigned G = gridDim.x * gridDim.y * gridDim.z;
    unsigned sum, cnt, mine, sp = 0u;
    for (;;) {
        sum = 0u; cnt = 0u; mine = 0u;
#pragma unroll
        for (unsigned j = 0; j < 16; ++j) { const unsigned c = xb_ld(&bar[XB_XCNT(j)]); sum += c; cnt += (c > 0u) ? 1u : 0u; mine = (j == x) ? c : mine; }
        if (sum == G) break;
        __builtin_amdgcn_s_sleep(1);
        if ((++sp & 255u) == 0u) { if (xb_ld(&bar[XB_TMO])) break; if (sp > XB_SPIN_CAP) { atomicAdd(&bar[XB_TMO], 1u); break; } }
    }
    nloc = mine > 0u ? mine : 1u; nx = cnt > 0u ? cnt : 1u;
}
__device__ __forceinline__ void xcd_barrier(const XcdBarrier& b) {
    asm volatile("s_waitcnt vmcnt(0)" ::: "memory");
    __syncthreads();
    if (threadIdx.x == 0) {
        unsigned* bar = b.bar; { size_t z_ = 0; asm volatile("" : "+s"(z_)); bar += z_; }
        __builtin_amdgcn_s_waitcnt(0);
        unsigned nloc = b.st[0], nx = b.st[1];
        if (nloc == 0u) { xcd_barrier_complete(bar, b.x, nloc, nx); b.st[0] = nloc; b.st[1] = nx; }
        const unsigned old = xb_add(&bar[XB_XSUB(b.x)], 1u);
        const unsigned gen = old / nloc;
        if (old + 1u == (gen + 1u) * nloc) {
            __builtin_amdgcn_fence(__ATOMIC_RELEASE, "agent");
            asm volatile("s_waitcnt vmcnt(0)" ::: "memory");
            const unsigned og = xb_add(&bar[XB_TOP], 1u);
            const unsigned tg = og / nx;
            if (og + 1u == (tg + 1u) * nx) xb_add(&bar[XB_TOPGEN], 1u);
            else XB_SPIN(xb_ld(&bar[XB_TOPGEN]) == tg, bar);
            __builtin_amdgcn_fence(__ATOMIC_ACQUIRE, "agent");
            xb_add(&bar[XB_XGEN(b.x)], 1u);
            asm volatile("s_waitcnt vmcnt(0)" ::: "memory");
        } else {
            XB_SPIN(xb_ld(&bar[XB_XGEN(b.x)]) == gen, bar);
            __builtin_amdgcn_fence(__ATOMIC_ACQUIRE, "agent");
            asm volatile("s_waitcnt vmcnt(0)" ::: "memory");
        }
    }
    __syncthreads();
}

__global__ void __launch_bounds__(NTHR) fwd_kernel(Params P) {
  extern __shared__ __attribute__((aligned(16))) unsigned char lds[];
  cg::grid_group grid = cg::this_grid();
  const int gtid = blockIdx.x * NTHR + threadIdx.x;
  if (threadIdx.x < 4) ((unsigned*)(lds + LDS_BYTES - 16))[threadIdx.x] = 0u;
  __syncthreads();
  const XcdBarrier xbar = xcd_barrier_post((unsigned*)(P.ws + WS_BAR), (volatile LAS unsigned*)(lds + LDS_BYTES - 16));
#define GSYNC() xcd_barrier(xbar)
  s5_params(P, gtid);
  {
    float* modb = (float*)(P.ws + WS_MOD); float* cbb = (float*)(P.ws + WS_CB);
    for (int it = blockIdx.x; it < 192 + 16; it += gridDim.x) {
      if (it < 192) { const int l = it / 96, j0 = (it % 96) * 64;
        gemv_item((float*)lds, P.in[2] + (size_t)l * DM * 6144, DM, 6144, j0, P.in[1], P.in[1] + DM, true, P.in[3] + l * 6144, modb + (size_t)(l * 2) * 6144, modb + (size_t)(l * 2 + 1) * 6144);
      } else { const int r = it - 192, l = r >> 3, kv = (r >> 2) & 1, j0 = (r & 3) * 64;
        gemv_item((float*)lds, P.in[17] + (size_t)(l * 2 + kv) * 2048 * 256, 2048, 256, j0, P.in[16] + (size_t)(l * 2 + kv) * 2048, nullptr, false, nullptr, cbb + (l * 2 + kv) * 256, nullptr);
      }
    }
  }
  for (int it = blockIdx.x; it < DEPTH * 32 * 6; it += gridDim.x) s5_tables(P, it / 192, (it % 192) / 6, it % 6, lds);
  convert_weights(P, 0, lds);
  grid.sync();
  for (int l = 0; l < DEPTH; ++l) {
    if (l == 0) norm_simple<0>(P, l); else { norm_simple<1>(P, l); convert_weights(P, 1, lds); }
    GSYNC();
#if EN_MIXER
    phase_inproj8(P, lds);
    GSYNC();
    phase_s5a(P, l, lds);
    __syncthreads();
#if EN_ATTN
    phase_gates(P, lds);
    __syncthreads();
    phase_cmp1(P, l, lds);
#endif
    GSYNC();
    s5_carry(P, l);
#if EN_ATTN
    phase_cmp2(P, lds);
#endif
    GSYNC();
#if EN_ATTN
    phase_attn(P, lds);
    __syncthreads();
#endif
    phase_s5c(P, l, lds);
    GSYNC();
    phase_glu(P, lds);
    GSYNC();
    phase_merge8(P, lds);
    GSYNC();
    phase_wout8(P, l, lds);
    GSYNC();
#else
    if (l == 0) { for (size_t i = (size_t)gtid * 4; i < (size_t)NT * DM; i += (size_t)gridDim.x * NTHR * 4) *(f32x4*)(P.out + i) = *(const f32x4*)(P.in[0] + i); GSYNC(); }
#endif
#if EN_MOE
    norm_route(P, l, lds);
    GSYNC();
    phase_moe1(P, l, lds);
    GSYNC();
    phase_moe2(P, l, lds);
    GSYNC();
#endif
  }
  norm_simple<3>(P, 0);
}

extern "C" void kernel_launch(void* const* d_in, const int* in_sizes, int n_in, void* d_out, int out_size, void* d_ws, size_t ws_size, hipStream_t stream) {
  static int grid = 0;
  if (grid == 0) {
    if (n_in != 30 || out_size != NT * DM || ws_size < WS_END2) { fprintf(stderr, "kernel_launch: unexpected shapes (n_in %d out %d ws %zu need %zu)\n", n_in, out_size, ws_size, (size_t)WS_END2); grid = -1; return; }
    int dev = 0, cus = 0, per_cu = 0;
    hipGetDevice(&dev);
    hipDeviceGetAttribute(&cus, hipDeviceAttributeMultiprocessorCount, dev);
    hipFuncSetAttribute((const void*)fwd_kernel, hipFuncAttributeMaxDynamicSharedMemorySize, LDS_BYTES);
    hipOccupancyMaxActiveBlocksPerMultiprocessor(&per_cu, (const void*)fwd_kernel, NTHR, LDS_BYTES);
    if (per_cu < 1) { fprintf(stderr, "kernel_launch: occupancy query says %d blocks/CU\n", per_cu); per_cu = 1; }
    grid = cus;
    (void)hipGetLastError();
  }
  if (grid < 0) return;
  Params p{};
  for (int i = 0; i < 30; ++i) p.in[i] = (const float*)d_in[i];
  p.out = (float*)d_out; p.ws = (unsigned char*)d_ws;
  if (hipMemsetAsync(p.ws, 0, WS_ZERO_BYTES, stream) != hipSuccess) { fprintf(stderr, "kernel_launch: memset failed\n"); return; }
  void* args[] = {&p};
  hipError_t e = hipLaunchCooperativeKernel((const void*)fwd_kernel, dim3(grid), dim3(NTHR), args, LDS_BYTES, stream);
  if (e != hipSuccess) fprintf(stderr, "cooperative launch failed: %s (grid %d)\n", hipGetErrorString(e), grid);
}
```

```cpp
#include <hip/hip_runtime.h>
#include <hip/hip_cooperative_groups.h>
#include <cstdio>
#include <cstdint>
namespace cg = cooperative_groups;

#ifndef EN_MIXER
#define EN_MIXER 1
#endif
#ifndef EN_ATTN
#define EN_ATTN 1
#endif
#ifndef EN_MOE
#define EN_MOE 1
#endif

#define DI __device__ __forceinline__
typedef unsigned short bf16_t;
typedef short bf16x8 __attribute__((ext_vector_type(8)));
typedef short s16x4 __attribute__((ext_vector_type(4)));
typedef float f32x4 __attribute__((ext_vector_type(4)));
typedef float f32x16 __attribute__((ext_vector_type(16)));
typedef unsigned u32x4 __attribute__((ext_vector_type(4)));
typedef unsigned u32x2 __attribute__((ext_vector_type(2)));

constexpr int DM = 1024, NB = 2, SEQ = 8192, NT = NB * SEQ, DEPTH = 2;
constexpr int INW = 5168, INWP = 5376;
constexpr int NTHR = 512, NWAVE = 8;
constexpr int NEXP = 32, LISTCAP = 16384;
constexpr float EPS = 1e-6f;
constexpr float QSCALE = 0.125f * 1.4426950408889634f;

constexpr size_t MiB = 1u << 20;
constexpr size_t WS_CNT = 0;
constexpr size_t WS_BAR = 1024;
constexpr size_t WS_ZERO_BYTES = 16384;
constexpr size_t WS_MOD = 16384;
constexpr size_t WS_CB = WS_MOD + 2 * 2 * 6144 * 4;
constexpr size_t WS_S5P = WS_CB + 2 * 2 * 256 * 4;
constexpr size_t WS_WT = WS_S5P + 2 * 32 * 64 * 36 * 4;
constexpr size_t WS_SMALL_END = WS_WT + (size_t)NT * 2 * 4;
static_assert(WS_SMALL_END <= 1 * MiB, "small region");
constexpr size_t WS_W = 1 * MiB;
constexpr size_t W_IN = 0;
constexpr size_t W_GLU = W_IN + (size_t)INWP * 1024 * 2;
constexpr size_t W_O = W_GLU + 512 * 512 * 2;
constexpr size_t W_SO = W_O + 1024 * 1024 * 2;
constexpr size_t W_OUT = W_SO + 1024 * 512 * 2;
constexpr size_t W_C1 = W_OUT + 1024 * 1024 * 2;
constexpr size_t W_C2 = W_C1 + 2 * 256 * 2048 * 2;
constexpr size_t W_GU = W_C2 + 2 * 128 * 256 * 2;
constexpr size_t W_D = W_GU + (size_t)32 * 512 * 1024 * 2;
constexpr size_t W_END = W_D + (size_t)32 * 1024 * 256 * 2;
static_assert(W_END <= 67 * MiB, "weights region");
constexpr size_t WS_A = 68 * MiB;
constexpr size_t WS_B = WS_A + 32 * MiB;
constexpr size_t WS_C = WS_B + 32 * MiB;
constexpr size_t WS_DV = WS_C + 32 * MiB;
constexpr size_t WS_E = WS_DV + 16 * MiB;
constexpr size_t WS_F = WS_E + 32 * MiB;
constexpr size_t WS_G = WS_F + 64 * MiB;
constexpr size_t WS_GATES = WS_G + 16 * MiB;
constexpr size_t WS_HID = WS_GATES + 3 * MiB;
constexpr size_t WS_KC = WS_HID + 4 * MiB;
constexpr size_t WS_VC = WS_KC + 512 * 1024;
constexpr size_t WS_L = WS_VC + 512 * 1024;
constexpr size_t WS_LIST = WS_L + 4 * MiB;
constexpr size_t WS_OT = WS_LIST + 2 * MiB;
constexpr size_t WS_TAB = WS_OT + 16 * MiB;
constexpr size_t TAB_KT = 0, TAB_M1 = 1 * MiB, TAB_M2 = 9 * MiB, TAB_LAYER = 17 * MiB;
constexpr size_t WS_END = WS_TAB + 2 * TAB_LAYER;
constexpr size_t WS_KSF = WS_END;
constexpr size_t WS_END2 = WS_KSF + 8 * MiB;
constexpr size_t WS_SIN = WS_E + 16 * MiB;
constexpr int LDS_BYTES = 151552;

struct Params { const float* in[30]; float* out; unsigned char* ws; };

DI int otid() { int t = threadIdx.x; asm volatile("" : "+v"(t)); return t; }
DI int obid() { int t = blockIdx.x; asm volatile("" : "+s"(t)); return t; }
DI unsigned f2bf(float f) { unsigned u = __float_as_uint(f); return (u + 0x7fffu + ((u >> 16) & 1u)) >> 16; }
typedef float f32x2_t __attribute__((ext_vector_type(2))); typedef __bf16 bf16x2_t __attribute__((ext_vector_type(2)));
DI unsigned pk2(float lo, float hi) { const f32x2_t v = {lo, hi}; const bf16x2_t b = __builtin_convertvector(v, bf16x2_t); return __builtin_bit_cast(unsigned, b); }
DI float bflo(unsigned w) { return __uint_as_float(w << 16); }
DI float bfhi(unsigned w) { return __uint_as_float(w & 0xffff0000u); }
DI int perm16(int x) { return (x & ~12) | ((x & 4) << 1) | ((x & 8) >> 1); }
DI float wave_sum(float v) {
#pragma unroll
  for (int o = 1; o < 64; o <<= 1) v += __shfl_xor(v, o);
  return v;
}
DI float sigmoidf_(float x) { return 1.f / (1.f + __expf(-x)); }
DI float gelu_tanh(float x) {
  const float z = 0.7978845608028654f * (x + 0.044715f * x * x * x);
  const float e = __expf(2.f * z);
  const float th = 1.f - 2.f / (e + 1.f);
  return 0.5f * x * (1.f + th);
}
DI void sincos_d(double x, double& s, double& c) {
  const double k = rint(x * 0.6366197723675814);
  double r = fma(-k, 1.5707963267948966, x);
  r = fma(-k, 6.123233995736766e-17, r);
  const int q = ((int)k) & 3;
  const double r2 = r * r;
  const double sp = r * (1.0 + r2 * (-1.0 / 6 + r2 * (1.0 / 120 + r2 * (-1.0 / 5040 + r2 * (1.0 / 362880 + r2 * (-1.0 / 39916800 + r2 * (1.0 / 6227020800.0)))))));
  const double cp = 1.0 + r2 * (-0.5 + r2 * (1.0 / 24 + r2 * (-1.0 / 720 + r2 * (1.0 / 40320 + r2 * (-1.0 / 3628800 + r2 * (1.0 / 479001600 + r2 * (-1.0 / 87178291200.0)))))));
  s = (q == 0) ? sp : (q == 1) ? cp : (q == 2) ? -sp : -cp;
  c = (q == 0) ? cp : (q == 1) ? -sp : (q == 2) ? -cp : sp;
}

DI void gemv_item(float* lds, const float* W, int K, int N, int j0, const float* v0, const float* v1, bool do_silu, const float* bias, float* o0, float* o1) {
  const int tid = otid();
  float* sv = lds; float* red = lds + 4096;
  for (int k = tid; k < K; k += NTHR) {
    float a = v0[k], b = v1 ? v1[k] : 0.f;
    if (do_silu) { a = a / (1.f + expf(-a)); b = b / (1.f + expf(-b)); }
    sv[k] = a; sv[2048 + k] = b;
  }
  __syncthreads();
  const int jl = tid & 63, ks = tid >> 6, kper = K >> 3;
  const float* wp = W + (size_t)(ks * kper) * N + j0 + jl;
  float a0 = 0.f, a1 = 0.f;
#pragma unroll 8
  for (int k = 0; k < kper; ++k) { const float w = wp[(size_t)k * N]; a0 += sv[ks * kper + k] * w; a1 += sv[2048 + ks * kper + k] * w; }
  red[(ks * 64 + jl) * 2] = a0; red[(ks * 64 + jl) * 2 + 1] = a1;
  __syncthreads();
  if (tid < 64) {
    float s0 = 0.f, s1 = 0.f;
    for (int i = 0; i < 8; ++i) { s0 += red[(i * 64 + tid) * 2]; s1 += red[(i * 64 + tid) * 2 + 1]; }
    const float bb = bias ? bias[j0 + tid] : 0.f;
    o0[j0 + tid] = s0 + bb; if (o1) o1[j0 + tid] = s1 + bb;
  }
  __syncthreads();
}

DI void s5_params(const Params& P, int gtid) {
  if (gtid >= DEPTH * 32 * 64) return;
  const int l = gtid / 2048, g = (gtid / 64) % 32, p = gtid % 64;
  const float dt = expf(P.in[8][l * 32 + g]);
  const float lr = P.in[6][(l * 32 + g) * 64 + p], li = P.in[7][(l * 32 + g) * 64 + p];
  const float mag = expf(lr * dt); const float ang = li * dt;
  double sd, cd; sincos_d((double)ang, sd, cd);
  const float ab_re = mag * (float)cd, ab_im = mag * (float)sd;
  const float den = lr * lr + li * li, nr = ab_re - 1.0f;
  const float cr = (nr * lr + ab_im * li) / den, ci = (ab_im * lr - nr * li) / den;
  float* o = (float*)(P.ws + WS_S5P) + (size_t)((l * 32 + g) * 64 + p) * 36;
  o[0] = ab_re; o[1] = ab_im;
  double pr = ab_re, pi = ab_im;
  for (int i = 0; i < 6; ++i) { const double nr2 = pr * pr - pi * pi, ni2 = 2.0 * pr * pi; pr = nr2; pi = ni2; }
  o[2] = (float)pr; o[3] = (float)pi;
  const float* br = P.in[9] + (size_t)((l * 32 + g) * 64 + p) * 16; const float* bi = P.in[10] + (size_t)((l * 32 + g) * 64 + p) * 16;
  for (int h = 0; h < 16; ++h) { o[4 + 2 * h] = cr * br[h] - ci * bi[h]; o[5 + 2 * h] = cr * bi[h] + ci * br[h]; }
}

DI void s5_tables(const Params& P, int l, int g, int part, unsigned char* lds) {
  const int tid = otid(), lane = tid & 63;
  float* BBr = (float*)lds; float* BBi = BBr + 1024; float* CR = BBi + 1024; float* CI = CR + 1024;
  float* APr = CI + 1024; float* APi = APr + 65 * 64;
  bf16_t* tab = (bf16_t*)(P.ws + WS_TAB + (size_t)l * TAB_LAYER);
  bf16_t* Kt = tab + TAB_KT / 2 + (size_t)g * 64 * 256; bf16_t* M1 = tab + TAB_M1 / 2 + (size_t)g * 128 * 1024; bf16_t* M2 = tab + TAB_M2 / 2 + (size_t)g * 1024 * 128;
  __syncthreads();
  if (tid < 64) {
    const int p = tid;
    const float dt = expf(P.in[8][l * 32 + g]);
    const float lr = P.in[6][(l * 32 + g) * 64 + p], li = P.in[7][(l * 32 + g) * 64 + p];
    const float mag = expf(lr * dt); const float ang = li * dt;
    double sd, cd; sincos_d((double)ang, sd, cd);
    const float ab_re = mag * (float)cd, ab_im = mag * (float)sd;
    const float den = lr * lr + li * li, nr = ab_re - 1.0f;
    const float cr = (nr * lr + ab_im * li) / den, ci = (ab_im * lr - nr * li) / den;
    const float* br = P.in[9] + (size_t)((l * 32 + g) * 64 + p) * 16; const float* bi = P.in[10] + (size_t)((l * 32 + g) * 64 + p) * 16;
    for (int h = 0; h < 16; ++h) { BBr[p * 16 + h] = cr * br[h] - ci * bi[h]; BBi[p * 16 + h] = cr * bi[h] + ci * br[h]; }
    double pr = 1.0, pi = 0.0;
    for (int tau = 0; tau <= 64; ++tau) { APr[tau * 64 + p] = (float)pr; APi[tau * 64 + p] = (float)pi; const double n1 = pr * ab_re - pi * ab_im, n2 = pr * ab_im + pi * ab_re; pr = n1; pi = n2; }
  }
  for (int i = tid; i < 1024; i += NTHR) { CR[i] = P.in[11][(size_t)(l * 32 + g) * 1024 + i]; CI[i] = P.in[12][(size_t)(l * 32 + g) * 1024 + i]; }
  __syncthreads();
  if (part < 4)
  for (int task = part * 256 + tid; task < part * 256 + 256; task += NTHR) {
    const int tau = task >> 4, h = task & 15;
    float a[16];
#pragma unroll
    for (int j = 0; j < 16; ++j) a[j] = 0.f;
    for (int p = 0; p < 64; ++p) {
      const float c_r = CR[h * 64 + p], c_i = CI[h * 64 + p], a_r = APr[tau * 64 + p], a_i = APi[tau * 64 + p];
      const float xr = c_r * a_r - c_i * a_i, xi = c_r * a_i + c_i * a_r;
#pragma unroll
      for (int j4 = 0; j4 < 4; ++j4) { const f32x4 b_r = *(const f32x4*)(BBr + p * 16 + 4 * j4), b_i = *(const f32x4*)(BBi + p * 16 + 4 * j4);
        a[4 * j4] += xr * b_r.x - xi * b_i.x; a[4 * j4 + 1] += xr * b_r.y - xi * b_i.y; a[4 * j4 + 2] += xr * b_r.z - xi * b_i.z; a[4 * j4 + 3] += xr * b_r.w - xi * b_i.w; }
    }
    u32x4 o0, o1; o0.x = pk2(a[0], a[1]); o0.y = pk2(a[2], a[3]); o0.z = pk2(a[4], a[5]); o0.w = pk2(a[6], a[7]); o1.x = pk2(a[8], a[9]); o1.y = pk2(a[10], a[11]); o1.z = pk2(a[12], a[13]); o1.w = pk2(a[14], a[15]);
    *(u32x4*)(Kt + (size_t)task * 16) = o0; *(u32x4*)(Kt + (size_t)task * 16 + 8) = o1;
  }
  if (part == 4)
  for (int task = tid; task < 4096; task += NTHR) {
    const int p = task >> 6, i = task & 63;
    const float a_r = APr[(63 - i) * 64 + p], a_i = APi[(63 - i) * 64 + p];
    float re[16], im[16];
#pragma unroll
    for (int j = 0; j < 16; ++j) { const float b_r = BBr[p * 16 + j], b_i = BBi[p * 16 + j]; re[j] = a_r * b_r - a_i * b_i; im[j] = a_r * b_i + a_i * b_r; }
    u32x4 o; bf16_t* d0 = M1 + (size_t)(2 * p) * 1024 + i * 16; bf16_t* d1 = d0 + 1024;
    o.x = pk2(re[0], re[1]); o.y = pk2(re[2], re[3]); o.z = pk2(re[4], re[5]); o.w = pk2(re[6], re[7]); *(u32x4*)d0 = o;
    o.x = pk2(re[8], re[9]); o.y = pk2(re[10], re[11]); o.z = pk2(re[12], re[13]); o.w = pk2(re[14], re[15]); *(u32x4*)(d0 + 8) = o;
    o.x = pk2(im[0], im[1]); o.y = pk2(im[2], im[3]); o.z = pk2(im[4], im[5]); o.w = pk2(im[6], im[7]); *(u32x4*)d1 = o;
    o.x = pk2(im[8], im[9]); o.y = pk2(im[10], im[11]); o.z = pk2(im[12], im[13]); o.w = pk2(im[14], im[15]); *(u32x4*)(d1 + 8) = o;
  }
  if (part == 5)
  for (int task = tid; task < 4096; task += NTHR) {
    const int th = task >> 2, pq = task & 3, t = th >> 4, h = th & 15;
    unsigned w[16];
#pragma unroll
    for (int j = 0; j < 16; ++j) { const int p = pq * 16 + j;
      const float c_r = CR[h * 64 + p], c_i = CI[h * 64 + p], a_r = APr[(t + 1) * 64 + p], a_i = APi[(t + 1) * 64 + p];
      w[j] = pk2(c_r * a_r - c_i * a_i, -(c_r * a_i + c_i * a_r)); }
    bf16_t* d = M2 + (size_t)th * 128 + pq * 32;
    *(u32x4*)d = (u32x4){w[0], w[1], w[2], w[3]}; *(u32x4*)(d + 8) = (u32x4){w[4], w[5], w[6], w[7]};
    *(u32x4*)(d + 16) = (u32x4){w[8], w[9], w[10], w[11]}; *(u32x4*)(d + 24) = (u32x4){w[12], w[13], w[14], w[15]};
  }
  __syncthreads();
}

struct ConvJob { const float* src; bf16_t* dst; int ldw, K, c0, ncols, nmat, ldd, drow0, mode; size_t sstride, dstride; };
DI int conv_nitems(const ConvJob& j) { return j.nmat * (j.K >> 6) * ((j.ncols + 31) >> 5); }
DI int conv_drow(int mode, int drow0, int n) { return mode == 0 ? drow0 + n : drow0 + ((n >> 6) * 128 + ((n >> 4) & 3) * 32 + (n & 15)); }
DI void conv_item(const ConvJob& jb, int item, float* scr, int lane) {
  const int nblk = (jb.ncols + 31) >> 5, per = (jb.K >> 6) * nblk;
  const int mat = item / per, r = item % per, kb = r / nblk, nb = r % nblk, k0 = 64 * kb, n0 = 32 * nb;
  const float* W = jb.src + (size_t)mat * jb.sstride; bf16_t* WT = jb.dst + (size_t)mat * jb.dstride;
  const int n4 = (lane & 7) * 4; const bool nok = (n0 + n4) < jb.ncols;
#pragma unroll
  for (int i = 0; i < 8; ++i) { const int kk = 8 * i + (lane >> 3);
    const f32x4 v = nok ? *(const f32x4*)(W + (size_t)(k0 + kk) * jb.ldw + jb.c0 + n0 + n4) : (f32x4){0.f, 0.f, 0.f, 0.f};
    *(f32x4*)(scr + kk * 36 + n4) = v; }
  asm volatile("s_waitcnt lgkmcnt(0)" ::: "memory");
  const int c = lane & 7;
#pragma unroll
  for (int j = 0; j < 4; ++j) {
    const int n = (lane >> 3) + 8 * j; const float* sp = scr + (8 * c) * 36 + n;
    u32x4 o; o.x = pk2(sp[0], sp[36]); o.y = pk2(sp[72], sp[108]); o.z = pk2(sp[144], sp[180]); o.w = pk2(sp[216], sp[252]);
    if (n0 + n < jb.ncols) *(u32x4*)(WT + (size_t)conv_drow(jb.mode, jb.drow0, n0 + n) * jb.ldd + k0 + 8 * c) = o;
  }
  asm volatile("s_waitcnt lgkmcnt(0)" ::: "memory");
}
DI ConvJob conv_job(const Params& P, int l, int j) {
  unsigned char* wb = P.ws + WS_W; ConvJob J; J.nmat = 1; J.mode = 0; J.sstride = 0; J.dstride = 0; J.drow0 = 0; J.c0 = 0;
  const float* win = P.in[5] + (size_t)l * 1024 * INW;
  if (j < 5) { J.src = win; J.ldw = INW; J.K = 1024; J.dst = (bf16_t*)(wb + W_IN); J.ldd = 1024;
    if (j == 0) { J.c0 = 0; J.ncols = 1024; J.drow0 = 0; }
    else if (j == 1) { J.c0 = 1024; J.ncols = 1536; J.drow0 = 1024; }
    else if (j == 2) { J.c0 = 3120; J.ncols = 2048; J.drow0 = 2560; }
    else if (j == 3) { J.c0 = 2608; J.ncols = 512; J.drow0 = 4608; }
    else { J.c0 = 2560; J.ncols = 48; J.drow0 = 5120; }
  } else if (j == 5) { J.src = P.in[14] + (size_t)l * 512 * 512; J.ldw = 512; J.K = 512; J.ncols = 512; J.dst = (bf16_t*)(wb + W_GLU); J.ldd = 512; }
  else if (j == 6) { J.src = P.in[19] + (size_t)l * 1024 * 1024; J.ldw = 1024; J.K = 1024; J.ncols = 1024; J.dst = (bf16_t*)(wb + W_O); J.ldd = 1024; }
  else if (j == 7) { J.src = P.in[15] + (size_t)l * 512 * 1024; J.ldw = 1024; J.K = 512; J.ncols = 1024; J.dst = (bf16_t*)(wb + W_SO); J.ldd = 512; }
  else if (j == 8) { J.src = P.in[20] + (size_t)l * 1024 * 1024; J.ldw = 1024; J.K = 1024; J.ncols = 1024; J.dst = (bf16_t*)(wb + W_OUT); J.ldd = 1024; }
  else if (j == 9) { J.src = P.in[17] + (size_t)l * 2 * 2048 * 256; J.ldw = 256; J.K = 2048; J.ncols = 256; J.nmat = 2; J.sstride = 2048 * 256; J.dstride = 256 * 2048; J.dst = (bf16_t*)(wb + W_C1); J.ldd = 2048; }
  else if (j == 10) { J.src = P.in[18] + (size_t)l * 2 * 256 * 64; J.ldw = 64; J.K = 256; J.ncols = 64; J.nmat = 2; J.sstride = 256 * 64; J.dstride = 128 * 256; J.dst = (bf16_t*)(wb + W_C2); J.ldd = 256; }
  else if (j == 11) { J.src = P.in[26] + (size_t)l * 32 * 1024 * 256; J.ldw = 256; J.K = 1024; J.ncols = 256; J.nmat = 32; J.sstride = 1024 * 256; J.dstride = 512 * 1024; J.dst = (bf16_t*)(wb + W_GU); J.ldd = 1024; J.mode = 1; J.drow0 = 0; }
  else if (j == 12) { J.src = P.in[27] + (size_t)l * 32 * 1024 * 256; J.ldw = 256; J.K = 1024; J.ncols = 256; J.nmat = 32; J.sstride = 1024 * 256; J.dstride = 512 * 1024; J.dst = (bf16_t*)(wb + W_GU); J.ldd = 1024; J.mode = 1; J.drow0 = 16; }
  else { J.src = P.in[28] + (size_t)l * 32 * 256 * 1024; J.ldw = 1024; J.K = 256; J.ncols = 1024; J.nmat = 32; J.sstride = 256 * 1024; J.dstride = 1024 * 256; J.dst = (bf16_t*)(wb + W_D); J.ldd = 256; }
  return J;
}
DI void convert_weights(const Params& P_, int l, unsigned char* lds) {
  Params P = P_; { size_t z_ = 0; asm volatile("" : "+s"(z_)); P.ws = P_.ws + z_; }
  const int tid_ = otid(), bid = obid(), wave = tid_ >> 6, lane = tid_ & 63; (void)bid;
  float* scr = (float*)lds + wave * (64 * 36);
  const int NGW = gridDim.x * NWAVE; int off = bid * NWAVE + wave;
  for (int j = 0; j < 14; ++j) {
    const ConvJob J = conv_job(P, l, j); const int n = conv_nitems(J);
    while (off < n) { conv_item(J, off, scr, lane); off += NGW; }
    off -= n;
  }
}

template <int MODE>
DI void norm_simple(const Params& P_, int l) {
  Params P = P_; { size_t z_ = 0; asm volatile("" : "+s"(z_)); P.ws = P_.ws + z_; }
  const int tid_ = otid(), bid = obid(), wave = tid_ >> 6, lane = tid_ & 63; (void)bid;
  const int NGW = gridDim.x * NWAVE;
  const float* mod = (const float*)(P.ws + WS_MOD);
  const bf16_t* ys = (const bf16_t*)(P.ws + WS_F);
  bf16_t* xn = (bf16_t*)(P.ws + WS_A);
  for (int row = bid * NWAVE + wave; row < NT; row += NGW) {
    const int b = row >> 13;
    const float* xr = (MODE == 0 ? P.in[0] : P.out) + (size_t)row * DM;
    f32x4 v[4];
#pragma unroll
    for (int j = 0; j < 4; ++j) v[j] = *(const f32x4*)(xr + 4 * lane + 256 * j);
    if (MODE != 0 && EN_MOE) {
      const float* g2 = mod + (size_t)(((MODE == 1 ? 0 : 1) * 2 + b) * 6144) + 5120;
#pragma unroll
      for (int j = 0; j < 4; ++j) {
        const int col = 4 * lane + 256 * j;
        const u32x2 y0 = *(const u32x2*)(ys + (size_t)(row * 2) * DM + col), y1 = *(const u32x2*)(ys + (size_t)(row * 2 + 1) * DM + col);
        const f32x4 gg = *(const f32x4*)(g2 + col);
        v[j].x += gg.x * (bflo(y0.x) + bflo(y1.x)); v[j].y += gg.y * (bfhi(y0.x) + bfhi(y1.x));
        v[j].z += gg.z * (bflo(y0.y) + bflo(y1.y)); v[j].w += gg.w * (bfhi(y0.y) + bfhi(y1.y));
      }
    }
    float ss = 0.f;
#pragma unroll
    for (int j = 0; j < 4; ++j) ss += v[j].x * v[j].x + v[j].y * v[j].y + v[j].z * v[j].z + v[j].w * v[j].w;
    ss = wave_sum(ss);
    const float inv = rsqrtf(ss * (1.f / DM) + EPS);
    if (MODE == 3) {
      const float* fg = P.in[29];
#pragma unroll
      for (int j = 0; j < 4; ++j) { const int col = 4 * lane + 256 * j; const f32x4 g = *(const f32x4*)(fg + col); *(f32x4*)(P.out + (size_t)row * DM + col) = v[j] * inv * g; }
    } else {
      if (MODE == 1) {
#pragma unroll
        for (int j = 0; j < 4; ++j) *(f32x4*)(P.out + (size_t)row * DM + 4 * lane + 256 * j) = v[j];
      }
      const float* ng = P.in[4] + (size_t)l * DM; const float* md = mod + (size_t)((l * 2 + b) * 6144);
#pragma unroll
      for (int j = 0; j < 4; ++j) {
        const int col = 4 * lane + 256 * j;
        const f32x4 g = *(const f32x4*)(ng + col), sh = *(const f32x4*)(md + col), sc = *(const f32x4*)(md + 1024 + col);
        const f32x4 h = v[j] * inv * g * (sc + 1.f) + sh;
        u32x2 o; o.x = pk2(h.x, h.y); o.y = pk2(h.z, h.w);
        *(u32x2*)(xn + (size_t)row * DM + col) = o;
      }
    }
  }
}

constexpr int RT_HS = 1028;
DI void norm_route(const Params& P_, int l, unsigned char* lds) {
  Params P = P_; { size_t z_ = 0; asm volatile("" : "+s"(z_)); P.ws = P_.ws + z_; }
  const int tid = otid(), bid = obid(), wave = tid >> 6, lane = tid & 63;
  const float* mod = (const float*)(P.ws + WS_MOD);
  bf16_t* h2 = (bf16_t*)(P.ws + WS_A);
  float* hs = (float*)lds;
  float* Wc = (float*)lds + 32 * RT_HS;
  const float* wg = P.in[22] + (size_t)l * DM * 4; const float* we = P.in[24] + (size_t)l * DM * 32;
  const float* bg = P.in[23] + l * 4; const float* be = P.in[25] + l * 32;
  int* cnt = (int*)(P.ws + WS_CNT) + l * 32; int* list = (int*)(P.ws + WS_LIST); float* wts = (float*)(P.ws + WS_WT);
  const int rg = wave >> 2, kq = wave & 3;
  for (int grp = bid; grp < NT / 32; grp += gridDim.x) {
    const int row0 = grp * 32 + wave * 4, b = row0 >> 13;
    const float* ng = P.in[21] + (size_t)l * DM; const float* md = mod + (size_t)((l * 2 + b) * 6144);
    {
      f32x4 v[4][4];
#pragma unroll
      for (int r = 0; r < 4; ++r)
#pragma unroll
        for (int j = 0; j < 4; ++j) v[r][j] = *(const f32x4*)(P.out + (size_t)(row0 + r) * DM + 4 * lane + 256 * j);
      float inv[4];
#pragma unroll
      for (int r = 0; r < 4; ++r) { float ss = 0.f;
#pragma unroll
        for (int j = 0; j < 4; ++j) ss += v[r][j].x * v[r][j].x + v[r][j].y * v[r][j].y + v[r][j].z * v[r][j].z + v[r][j].w * v[r][j].w;
        inv[r] = rsqrtf(wave_sum(ss) * (1.f / DM) + EPS); }
#pragma unroll
      for (int j = 0; j < 4; ++j) {
        const int col = 4 * lane + 256 * j;
        const f32x4 g = *(const f32x4*)(ng + col), sh = *(const f32x4*)(md + 3072 + col), sc = *(const f32x4*)(md + 4096 + col);
#pragma unroll
        for (int r = 0; r < 4; ++r) {
          const f32x4 hh = v[r][j] * inv[r] * g * (sc + 1.f) + sh;
          u32x2 o; o.x = pk2(hh.x, hh.y); o.y = pk2(hh.z, hh.w);
          *(u32x2*)(h2 + (size_t)(row0 + r) * DM + col) = o;
          *(f32x4*)(hs + (wave * 4 + r) * RT_HS + col) = hh;
        }
      }
    }
    f32x4 we0, we1, wg0 = {0.f, 0.f, 0.f, 0.f};
#define WLOAD(kc) do { we0 = *(const f32x4*)(we + (size_t)(kc) * 4096 + tid * 4); we1 = *(const f32x4*)(we + (size_t)(kc) * 4096 + 2048 + tid * 4); if (tid < 128) wg0 = *(const f32x4*)(wg + (size_t)(kc) * 512 + tid * 4); } while (0)
#define WSTORE() do { *(f32x4*)(Wc + (tid >> 3) * 36 + (tid & 7) * 4) = we0; *(f32x4*)(Wc + (64 + (tid >> 3)) * 36 + (tid & 7) * 4) = we1; if (tid < 128) *(f32x4*)(Wc + tid * 36 + 32) = wg0; } while (0)
    WLOAD(0);
    f32x4 acc0 = {0.f, 0.f, 0.f, 0.f}, acc1 = acc0, acc2 = acc0;
    for (int kc = 0; kc < 8; ++kc) {
      __syncthreads();
      WSTORE();
      if (kc + 1 < 8) WLOAD(kc + 1);
      __syncthreads();
      const float* ap = hs + (rg * 16 + (lane & 15)) * RT_HS + kc * 128 + kq * 32 + (lane >> 4);
      const float* bp = Wc + (kq * 32 + (lane >> 4)) * 36 + (lane & 15);
#pragma unroll
      for (int ks = 0; ks < 8; ++ks) {
        const float av = ap[4 * ks];
        const float b0 = bp[(4 * ks) * 36], b1 = bp[(4 * ks) * 36 + 16], b2 = (lane & 15) < 4 ? bp[(4 * ks) * 36 + 32] : 0.f;
        acc0 = __builtin_amdgcn_mfma_f32_16x16x4f32(av, b0, acc0, 0, 0, 0);
        acc1 = __builtin_amdgcn_mfma_f32_16x16x4f32(av, b1, acc1, 0, 0, 0);
        acc2 = __builtin_amdgcn_mfma_f32_16x16x4f32(av, b2, acc2, 0, 0, 0);
      }
    }
#undef WLOAD
#undef WSTORE
    __syncthreads();
    {
      float* part = hs + kq * (32 * 40);
#pragma unroll
      for (int i = 0; i < 4; ++i) { const int row = rg * 16 + 4 * (lane >> 4) + i, col = lane & 15;
        part[row * 40 + col] = acc0[i]; part[row * 40 + 16 + col] = acc1[i]; if (col < 4) part[row * 40 + 32 + col] = acc2[i]; }
    }
    __syncthreads();
    if (tid < 32) {
      const int row = grp * 32 + tid;
      float L[36];
#pragma unroll
      for (int o = 0; o < 36; ++o) L[o] = (hs[tid * 40 + o] + hs[1280 + tid * 40 + o]) + (hs[2560 + tid * 40 + o] + hs[3840 + tid * 40 + o]);
      float gm = -1e30f; int gi = 0;
#pragma unroll
      for (int i = 0; i < 4; ++i) { const float v = L[32 + i] + bg[i]; if (v > gm) { gm = v; gi = i; } }
      float gs = 0.f;
#pragma unroll
      for (int i = 0; i < 4; ++i) gs += expf(L[32 + i] + bg[i] - gm);
      const float gp = 1.f / gs;
      float el[8];
#pragma unroll
      for (int i = 0; i < 8; ++i) el[i] = (gi == 0 ? L[i] : gi == 1 ? L[8 + i] : gi == 2 ? L[16 + i] : L[24 + i]) + be[gi * 8 + i];
      float em = -1e30f;
#pragma unroll
      for (int i = 0; i < 8; ++i) em = fmaxf(em, el[i]);
      float p1 = -1.f, p2 = -1.f; int i1 = 0, i2 = 0;
#pragma unroll
      for (int i = 0; i < 8; ++i) {
        const float pe = expf(el[i] - em);
        if (pe > p1) { p2 = p1; i2 = i1; p1 = pe; i1 = i; } else if (pe > p2) { p2 = pe; i2 = i; }
      }
      const float w1 = gp * p1 / (p1 + p2), w2 = gp * p2 / (p1 + p2);
      const int e1 = gi * 8 + i1, e2 = gi * 8 + i2;
      const int pos1 = atomicAdd(&cnt[e1], 1); list[e1 * LISTCAP + pos1] = row * 2; wts[row * 2] = w1;
      const int pos2 = atomicAdd(&cnt[e2], 1); list[e2 * LISTCAP + pos2] = row * 2 + 1; wts[row * 2 + 1] = w2;
    }
    __syncthreads();
  }
}

namespace pg8 {
#define PG8_LAS __attribute__((address_space(3)))
typedef unsigned short bf16_t;
typedef short bf16x8 __attribute__((ext_vector_type(8)));
typedef float f32x4 __attribute__((ext_vector_type(4)));
typedef unsigned u32x4 __attribute__((ext_vector_type(4)));
constexpr int BM = 256, BK = 64, HALF = 128, HTB = HALF * BK * 2  , STAGE_BYTES = 8 * HTB, NXCD = 8, WGM = 8;

__host__ __device__ __forceinline__ int lds_byte(int r, int c) { const int st = (r >> 4) * 2 + (c >> 5), rr = r & 15, cc = c & 31, ob = rr * 64 + cc * 2; return st * 1024 + (ob ^ (((ob >> 9) & 1) << 5)); }
__host__ __device__ __forceinline__ void stage_rc(int b, int& R, int& C) { const int st = b / 1024, sb = b % 1024, swz = sb ^ (((sb >> 9) & 1) << 5); R = (st >> 1) * 16 + swz / 64; C = (st & 1) * 32 + (swz % 64) / 2; }
__host__ __device__ __forceinline__ int perm32(int rho) { const int n = rho >> 4, i = rho & 15; return 8 * (i >> 2) + 4 * n + (i & 3); }

struct Unit { int pm, pn; };
struct Gemm { const bf16_t* A; const bf16_t* Bt; int M, N, K; };

struct StaticOrder {
    int nM, nN, nwg, G, c;
    __host__ __device__ void init(int M, int N, int G_, int c_) { nM = M / BM; nN = N / BM; nwg = nM * nN; G = G_; c = c_; }
    __host__ __device__ bool next(int i, Unit& u) const {
        const long L = (long)i * G + c; if (L >= nwg) return false;
        int wgid = (int)L; { const int q = nwg / NXCD, r = nwg % NXCD, xcd = wgid % NXCD, off = wgid / NXCD; wgid = (xcd < r ? xcd * (q + 1) : r * (q + 1) + (xcd - r) * q) + off; }
        const int nig = WGM * nN, gid = wgid / nig, fm = gid * WGM, gsz = (nM - fm) < WGM ? (nM - fm) : WGM;
        u.pm = fm + ((wgid % nig) % gsz); u.pn = (wgid % nig) / gsz; return true;
    }
    __device__ __forceinline__ void a_ready(const Unit&) const {}
    __device__ __forceinline__ void done(const Unit&) const {}
};
template <class Epi, class Sched, bool ALIGN_EPI = false, bool SP2 = false>
__device__ __forceinline__ void gemm_phase(PG8_LAS unsigned char* lds, const Gemm g, const Sched& S, const Epi& E) {
    const int tid = otid(), wid = __builtin_amdgcn_readfirstlane(tid >> 6), lane = tid & 63, wr = wid >> 2, wc = wid & 3, fr = lane & 15, fq = lane >> 4;
    const int K = g.K, nt = K / BK;
    unsigned voffA[2], voffB[2];
#pragma unroll
    for (int i = 0; i < 2; ++i) { int R, C; stage_rc(tid * 16 + i * 8192, R, C); const int Rb = Epi::PERM ? ((R & ~31) + perm32(R & 31)) : R;
        voffA[i] = (unsigned)(R * K + C) * 2u; voffB[i] = (unsigned)(Rb * K + C) * 2u; }
    const size_t kstep = (size_t)(BK * 2);
    const size_t hstep = (size_t)HALF * K * 2;
    const size_t tstep = 2 * hstep;
    const unsigned ldsw = (unsigned)wid * 1024u;
    const int aoff = lds_byte(wr * 64 + fr, fq * 8), boff = lds_byte(wc * 32 + fr, fq * 8);
#define PG8_SA(b, h) (((b) * 2 + (h)) * HTB)
#define PG8_SB(b, h) ((4 + (b) * 2 + (h)) * HTB)
#define PG8_STAGE(bufoff, gbase, voff) do { _Pragma("unroll") for (int _i = 0; _i < 2; ++_i) \
        __builtin_amdgcn_global_load_lds((const unsigned*)((const char*)(gbase) + (voff)[_i]), (PG8_LAS unsigned*)(lds + (bufoff) + ldsw + _i * 8192), 16, 0, 0); } while (0)
#define PG8_LDA(dst, b, h) do { _Pragma("unroll") for (int m = 0; m < 4; ++m) _Pragma("unroll") for (int k = 0; k < 2; ++k) dst[m][k] = *(const PG8_LAS bf16x8*)(lds + PG8_SA(b, h) + aoff + m * 2048 + k * 1024); } while (0)
#define PG8_LDB(dst, b, h) do { _Pragma("unroll") for (int n = 0; n < 2; ++n) _Pragma("unroll") for (int k = 0; k < 2; ++k) dst[n][k] = *(const PG8_LAS bf16x8*)(lds + PG8_SB(b, h) + boff + n * 2048 + k * 1024); } while (0)
#define PG8_MMA(ai, bj, At, Bt) do { __builtin_amdgcn_s_setprio(1); _Pragma("unroll") for (int m = 0; m < 4; ++m) _Pragma("unroll") for (int n = 0; n < 2; ++n) _Pragma("unroll") for (int k = 0; k < 2; ++k) \
        acc[ai][bj][m][n] = __builtin_amdgcn_mfma_f32_16x16x32_bf16(Bt[n][k], At[m][k], acc[ai][bj][m][n], 0, 0, 0); __builtin_amdgcn_s_setprio(0); } while (0)
#define PG8_WAIT_V(n) asm volatile("s_waitcnt vmcnt(" #n ")" ::: "memory")
#define PG8_WAIT_L(n) asm volatile("s_waitcnt lgkmcnt(" #n ")" ::: "memory")
#define PG8_BAR __builtin_amdgcn_s_barrier()
#define PG8_SCHED __builtin_amdgcn_sched_barrier(0)
    Unit cur, nxt; int ui = 0;
    if (!S.next(0, cur)) return;
    f32x4 acc[2][2][4][2];
#pragma unroll
    for (int a = 0; a < 2; ++a)
#pragma unroll
        for (int b = 0; b < 2; ++b)
#pragma unroll
            for (int m = 0; m < 4; ++m)
#pragma unroll
                for (int n = 0; n < 2; ++n) acc[a][b][m][n] = (f32x4){0.f, 0.f, 0.f, 0.f};
    bf16x8 At[4][2], B0[2][2], B1[2][2];
    const char* cA = (const char*)g.A + (size_t)cur.pm * tstep; const char* cB = (const char*)g.Bt + (size_t)cur.pn * tstep;
    S.a_ready(cur);
    if constexpr (SP2) {
        PG8_STAGE(PG8_SB(0, 0), cB, voffB); PG8_STAGE(PG8_SB(0, 1), cB + hstep, voffB); PG8_STAGE(PG8_SA(0, 0), cA, voffA); PG8_STAGE(PG8_SA(0, 1), cA + hstep, voffA);
        if (wr == 1) PG8_BAR;
        PG8_WAIT_V(2); PG8_BAR;
        PG8_STAGE(PG8_SB(1, 0), cB + kstep, voffB); PG8_STAGE(PG8_SA(1, 0), cA + kstep, voffA); PG8_STAGE(PG8_SB(1, 1), cB + hstep + kstep, voffB);
        PG8_WAIT_V(6); PG8_BAR;
    } else {
        PG8_STAGE(PG8_SB(0, 0), cB, voffB); PG8_STAGE(PG8_SA(0, 0), cA, voffA); PG8_STAGE(PG8_SB(0, 1), cB + hstep, voffB); PG8_STAGE(PG8_SA(0, 1), cA + hstep, voffA);
        if (wr == 1) PG8_BAR;
        PG8_WAIT_V(4); PG8_BAR;
        PG8_STAGE(PG8_SB(1, 0), cB + kstep, voffB); PG8_STAGE(PG8_SA(1, 0), cA + kstep, voffA); PG8_STAGE(PG8_SB(1, 1), cB + hstep + kstep, voffB);
        PG8_WAIT_V(6); PG8_BAR;
    }
    for (;;) {
        const bool has_next = S.next(ui + 1, nxt);
        const char* nA = has_next ? (const char*)g.A + (size_t)nxt.pm * tstep : cA; const char* nB = has_next ? (const char*)g.Bt + (size_t)nxt.pn * tstep : cB;
        for (int t = 0; t < nt; t += 2) {
            const bool last = (t == nt - 2);
            const char* a1 = cA + (size_t)(t + 1) * kstep;
            const char* a2 = last ? nA : cA + (size_t)(t + 2) * kstep; const char* b2 = last ? nB : cB + (size_t)(t + 2) * kstep;
            const char* a3 = a2 + kstep; const char* b3 = b2 + kstep;
            if (last && has_next) S.a_ready(nxt);
            if constexpr (SP2) {
            PG8_LDB(B0, 0, 0); PG8_LDB(B1, 0, 1); PG8_SCHED; PG8_LDA(At, 0, 0); PG8_STAGE(PG8_SA(1, 1), a1 + hstep, voffA);
            PG8_WAIT_V(8); PG8_WAIT_L(0); PG8_BAR; PG8_MMA(0, 0, At, B0); PG8_MMA(0, 1, At, B1); PG8_BAR; PG8_SCHED;
            PG8_LDA(At, 0, 1); PG8_STAGE(PG8_SB(0, 0), b2, voffB); PG8_STAGE(PG8_SB(0, 1), b2 + hstep, voffB); PG8_STAGE(PG8_SA(0, 0), a2, voffA);
            PG8_WAIT_V(8); PG8_WAIT_L(0); PG8_BAR; PG8_MMA(1, 0, At, B0); PG8_MMA(1, 1, At, B1); PG8_BAR; PG8_SCHED;
            PG8_LDB(B0, 1, 0); PG8_LDB(B1, 1, 1); PG8_SCHED; PG8_LDA(At, 1, 0); PG8_STAGE(PG8_SA(0, 1), a2 + hstep, voffA);
            PG8_WAIT_V(8); PG8_WAIT_L(0); PG8_BAR; PG8_MMA(0, 0, At, B0); PG8_MMA(0, 1, At, B1); PG8_BAR; PG8_SCHED;
            PG8_LDA(At, 1, 1); PG8_STAGE(PG8_SB(1, 0), b3, voffB); PG8_STAGE(PG8_SB(1, 1), b3 + hstep, voffB); PG8_STAGE(PG8_SA(1, 0), a3, voffA);
            PG8_WAIT_V(8); PG8_WAIT_L(0); PG8_BAR; PG8_MMA(1, 0, At, B0); PG8_MMA(1, 1, At, B1); PG8_BAR; PG8_SCHED;
            } else {
            PG8_LDB(B0, 0, 0); PG8_SCHED; PG8_LDA(At, 0, 0); PG8_STAGE(PG8_SA(1, 1), a1 + hstep, voffA);
            PG8_WAIT_L(8); PG8_BAR; PG8_WAIT_L(0); PG8_MMA(0, 0, At, B0); PG8_BAR; PG8_SCHED;
            PG8_LDB(B1, 0, 1); PG8_STAGE(PG8_SB(0, 0), b2, voffB);
            PG8_BAR; PG8_WAIT_L(0); PG8_MMA(0, 1, At, B1); PG8_BAR;
            PG8_LDA(At, 0, 1); PG8_STAGE(PG8_SA(0, 0), a2, voffA);
            PG8_BAR; PG8_WAIT_L(0); PG8_MMA(1, 0, At, B0); PG8_BAR; PG8_SCHED;
            PG8_STAGE(PG8_SB(0, 1), b2 + hstep, voffB);
            PG8_WAIT_V(6); PG8_BAR; PG8_MMA(1, 1, At, B1); PG8_BAR;
            PG8_LDB(B0, 1, 0); PG8_SCHED; PG8_LDA(At, 1, 0); PG8_STAGE(PG8_SA(0, 1), a2 + hstep, voffA);
            PG8_WAIT_L(8); PG8_BAR; PG8_WAIT_L(0); PG8_MMA(0, 0, At, B0); PG8_BAR; PG8_SCHED;
            PG8_LDB(B1, 1, 1); PG8_STAGE(PG8_SB(1, 0), b3, voffB);
            PG8_BAR; PG8_WAIT_L(0); PG8_MMA(0, 1, At, B1); PG8_BAR;
            PG8_LDA(At, 1, 1); PG8_STAGE(PG8_SA(1, 0), a3, voffA);
            PG8_BAR; PG8_WAIT_L(0); PG8_MMA(1, 0, At, B0); PG8_BAR; PG8_SCHED;
            PG8_STAGE(PG8_SB(1, 1), b3 + hstep, voffB);
            PG8_WAIT_V(6); PG8_BAR; PG8_MMA(1, 1, At, B1); PG8_BAR;
            }
        }
        if constexpr (ALIGN_EPI) { if (wr == 0) PG8_BAR; }
        if constexpr (!Epi::AFTER_DRAIN) { E(acc, cur, wr, wc, fr, fq); S.done(cur); }
        if (!has_next) break;
#pragma unroll
        for (int a = 0; a < 2; ++a)
#pragma unroll
            for (int b = 0; b < 2; ++b)
#pragma unroll
                for (int m = 0; m < 4; ++m)
#pragma unroll
                    for (int n = 0; n < 2; ++n) acc[a][b][m][n] = (f32x4){0.f, 0.f, 0.f, 0.f};
        cur = nxt; cA = nA; cB = nB; ++ui;
        if constexpr (ALIGN_EPI) { if (wr == 1) PG8_BAR; }
    }
    PG8_WAIT_V(0);
    if constexpr (!ALIGN_EPI) { if (wr == 0) PG8_BAR; }
    PG8_BAR;
    if constexpr (Epi::AFTER_DRAIN) { E.fused(acc, cur, wr, wc, fr, fq, lds, wid, lane); S.done(cur); }
#undef PG8_SA
#undef PG8_SB
#undef PG8_STAGE
#undef PG8_LDA
#undef PG8_LDB
#undef PG8_MMA
#undef PG8_WAIT_V
#undef PG8_WAIT_L
#undef PG8_BAR
#undef PG8_SCHED
}
}

constexpr int GT_ROWB = 144, GT_A = 0, GT_B = 128 * GT_ROWB, GT_STAGE = 2 * 128 * GT_ROWB;
DI void gemm_kloop(unsigned char* lds, const bf16_t* a0, const bf16_t* a1, int a_kadv, const bf16_t* b0, const bf16_t* b1, int nk, f32x4 (&acc)[4][2]) {
  const int tid = otid(), lane = tid & 63, wid = tid >> 6, wr = wid >> 2, wc = wid & 3, fr = lane & 15, fq = lane >> 4;
  const int lr = tid >> 3, lkb = (tid & 7) * 16;
  u32x4 xa0, xa1, xb0, xb1, ya0, ya1, yb0, yb1;
#define GT_GLOAD(p0_, p1_, q0_, q1_, kt) do { p0_ = *(const u32x4*)(a0 + (size_t)(kt) * a_kadv); p1_ = *(const u32x4*)(a1 + (size_t)(kt) * a_kadv); q0_ = *(const u32x4*)(b0 + (kt) * 64); q1_ = *(const u32x4*)(b1 + (kt) * 64); } while (0)
#define GT_LSTORE(p0_, p1_, q0_, q1_, buf) do { unsigned char* s_ = lds + (buf) * GT_STAGE; \
    *(u32x4*)(s_ + GT_A + lr * GT_ROWB + lkb) = p0_; *(u32x4*)(s_ + GT_A + (lr + 64) * GT_ROWB + lkb) = p1_; \
    *(u32x4*)(s_ + GT_B + lr * GT_ROWB + lkb) = q0_; *(u32x4*)(s_ + GT_B + (lr + 64) * GT_ROWB + lkb) = q1_; } while (0)
#define GT_COMPUTE(buf) do { \
    const unsigned char* As = lds + (buf) * GT_STAGE + GT_A + (wr * 64 + fr) * GT_ROWB + fq * 16; \
    const unsigned char* Bs = lds + (buf) * GT_STAGE + GT_B + (wc * 32 + fr) * GT_ROWB + fq * 16; \
    _Pragma("unroll") for (int ks = 0; ks < 2; ++ks) { \
      bf16x8 af[4], bfr[2]; \
      _Pragma("unroll") for (int m = 0; m < 4; ++m) af[m] = *(const bf16x8*)(As + m * 16 * GT_ROWB + ks * 64); \
      _Pragma("unroll") for (int n = 0; n < 2; ++n) bfr[n] = *(const bf16x8*)(Bs + n * 16 * GT_ROWB + ks * 64); \
      _Pragma("unroll") for (int m = 0; m < 4; ++m) _Pragma("unroll") for (int n = 0; n < 2; ++n) acc[m][n] = __builtin_amdgcn_mfma_f32_16x16x32_bf16(bfr[n], af[m], acc[m][n], 0, 0, 0); } } while (0)
  GT_GLOAD(xa0, xa1, xb0, xb1, 0); GT_LSTORE(xa0, xa1, xb0, xb1, 0); if (nk > 1) GT_GLOAD(ya0, ya1, yb0, yb1, 1); __syncthreads();
  for (int kt = 0; kt < nk; kt += 2) {
    if (kt + 2 < nk) GT_GLOAD(xa0, xa1, xb0, xb1, kt + 2);
    GT_COMPUTE(0);
    if (kt + 1 < nk) GT_LSTORE(ya0, ya1, yb0, yb1, 1);
    __syncthreads();
    if (kt + 1 >= nk) break;
    if (kt + 3 < nk) GT_GLOAD(ya0, ya1, yb0, yb1, kt + 3);
    GT_COMPUTE(1);
    if (kt + 2 < nk) GT_LSTORE(xa0, xa1, xb0, xb1, 0);
    __syncthreads();
  }
#undef GT_GLOAD
#undef GT_LSTORE
#undef GT_COMPUTE
}
#define ACC_ZERO(acc) do { _Pragma("unroll") for (int m_ = 0; m_ < 4; ++m_) _Pragma("unroll") for (int n_ = 0; n_ < 2; ++n_) acc[m_][n_] = (f32x4){0.f, 0.f, 0.f, 0.f}; } while (0)
#define TILE_IDS const int tid = otid(), bid = obid(), lane = tid & 63, wid = tid >> 6, wr = wid >> 2, wc = wid & 3, fr = lane & 15, fq = lane >> 4, lr = tid >> 3, lk = (tid & 7) * 8; (void)bid; (void)lane; (void)wr; (void)wc; (void)fr; (void)fq; (void)lr; (void)lk

DI void phase_gates(const Params& P_, unsigned char* lds) {
  Params P = P_; { size_t z_ = 0; asm volatile("" : "+s"(z_)); P.ws = P_.ws + z_; }
  TILE_IDS;
  const bf16_t* xn = (const bf16_t*)(P.ws + WS_A); const bf16_t* wt = (const bf16_t*)(P.ws + WS_W + W_IN) + (size_t)5120 * DM; float* gates = (float*)(P.ws + WS_GATES);
  for (int tile = (int)gridDim.x - 1 - bid; tile < NT / 128; tile += gridDim.x) {
    const int row0 = tile * 128;
    f32x4 acc[4][2]; ACC_ZERO(acc);
    gemm_kloop(lds, xn + (size_t)(row0 + lr) * DM + lk, xn + (size_t)(row0 + lr + 64) * DM + lk, 64, wt + (size_t)lr * DM + lk, wt + (size_t)(lr + 64) * DM + lk, DM / 64, acc);
#pragma unroll
    for (int m = 0; m < 4; ++m)
#pragma unroll
      for (int n = 0; n < 2; ++n) {
        const int row = row0 + wr * 64 + m * 16 + fr, c2 = wc * 32 + n * 16 + 4 * fq; const f32x4 v = acc[m][n];
        if (c2 < 48) { f32x4 o = {sigmoidf_(v.x), sigmoidf_(v.y), sigmoidf_(v.z), sigmoidf_(v.w)}; *(f32x4*)(gates + (size_t)row * 48 + c2) = o; }
      }
  }
}
DI void phase_cmp1(const Params& P_, int l, unsigned char* lds) {
  Params P = P_; { size_t z_ = 0; asm volatile("" : "+s"(z_)); P.ws = P_.ws + z_; }
  TILE_IDS;
  const bf16_t* kvk = (const bf16_t*)(P.ws + WS_C); bf16_t* hid = (bf16_t*)(P.ws + WS_HID);
  const float* cb = (const float*)(P.ws + WS_CB) + l * 512;
  for (int tile = bid; tile < 128; tile += gridDim.x) {
    const int kv = tile >> 6, rt = (tile >> 1) & 31, ct = tile & 1, row0 = rt * 128, col0 = ct * 128;
    const bf16_t* wt = (const bf16_t*)(P.ws + WS_W + W_C1) + (size_t)kv * 256 * 2048;
    const bf16_t* ap[2];
#pragma unroll
    for (int i = 0; i < 2; ++i) { const int rr = row0 + lr + 64 * i, b = rr >> 11, n = (rr >> 2) & 511, g = rr & 3, nn = n > 510 ? 510 : n;
      ap[i] = kvk + (size_t)(b * SEQ + 16 * nn) * DM + kv * 256 + g * 64 + lk; }
    f32x4 acc[4][2]; ACC_ZERO(acc);
    gemm_kloop(lds, ap[0], ap[1], DM, wt + (size_t)(col0 + lr) * 2048 + lk, wt + (size_t)(col0 + lr + 64) * 2048 + lk, 32, acc);
#pragma unroll
    for (int m = 0; m < 4; ++m)
#pragma unroll
      for (int n = 0; n < 2; ++n) {
        const int row = row0 + wr * 64 + m * 16 + fr, col = col0 + wc * 32 + n * 16 + 4 * fq;
        const f32x4 bb = *(const f32x4*)(cb + kv * 256 + col); const f32x4 v = acc[m][n] + bb;
        u32x2 o; o.x = pk2(gelu_tanh(v.x), gelu_tanh(v.y)); o.y = pk2(gelu_tanh(v.z), gelu_tanh(v.w));
        *(u32x2*)(hid + ((size_t)kv * 4096 + row) * 256 + col) = o;
      }
  }
}
DI void phase_cmp2(const Params& P_, unsigned char* lds) {
  Params P = P_; { size_t z_ = 0; asm volatile("" : "+s"(z_)); P.ws = P_.ws + z_; }
  TILE_IDS;
  const bf16_t* hid = (const bf16_t*)(P.ws + WS_HID); bf16_t* kc = (bf16_t*)(P.ws + WS_KC); bf16_t* vc = (bf16_t*)(P.ws + WS_VC);
  for (int tile = bid; tile < 64; tile += gridDim.x) {
    const int kv = tile >> 5, rt = tile & 31, row0 = rt * 128;
    const bf16_t* wt = (const bf16_t*)(P.ws + WS_W + W_C2) + (size_t)kv * 128 * 256;
    const bf16_t* a = hid + ((size_t)kv * 4096 + row0) * 256;
    f32x4 acc[4][2]; ACC_ZERO(acc);
    gemm_kloop(lds, a + (size_t)lr * 256 + lk, a + (size_t)(lr + 64) * 256 + lk, 64, wt + (size_t)lr * 256 + lk, wt + (size_t)(lr + 64) * 256 + lk, 4, acc);
    if (wc < 2) {
#pragma unroll
      for (int m = 0; m < 4; ++m)
#pragma unroll
        for (int n = 0; n < 2; ++n) {
          const int rr = row0 + wr * 64 + m * 16 + fr, d = wc * 32 + n * 16 + 4 * fq;
          const int b = rr >> 11, nn = (rr >> 2) & 511, g = rr & 3; const f32x4 v = acc[m][n];
          if (kv == 0) { u32x2 o; o.x = pk2(v.x, v.y); o.y = pk2(v.z, v.w); *(u32x2*)(kc + ((size_t)((b * 4 + g) * 512 + nn)) * 64 + d) = o; }
          else { bf16_t* dst = vc + ((size_t)((b * 4 + g) * 64 + d)) * 512 + perm16(nn); dst[0] = (bf16_t)f2bf(v.x); dst[512] = (bf16_t)f2bf(v.y); dst[1024] = (bf16_t)f2bf(v.z); dst[1536] = (bf16_t)f2bf(v.w); }
        }
    }
  }
}
DI void phase_glu(const Params& P_, unsigned char* lds) {
  Params P = P_; { size_t z_ = 0; asm volatile("" : "+s"(z_)); P.ws = P_.ws + z_; }
  TILE_IDS;
  const bf16_t* y = (const bf16_t*)(P.ws + WS_G); const bf16_t* wt = (const bf16_t*)(P.ws + WS_W + W_GLU); bf16_t* ssm = (bf16_t*)(P.ws + WS_E);
  for (int tile = bid; tile < (NT / 128) * 4; tile += gridDim.x) {
    const int rt = tile >> 2, ct = tile & 3, row0 = rt * 128, col0 = ct * 128;
    f32x4 acc[4][2]; ACC_ZERO(acc);
    gemm_kloop(lds, y + (size_t)(row0 + lr) * 512 + lk, y + (size_t)(row0 + lr + 64) * 512 + lk, 64, wt + (size_t)(col0 + lr) * 512 + lk, wt + (size_t)(col0 + lr + 64) * 512 + lk, 8, acc);
#pragma unroll
    for (int m = 0; m < 4; ++m)
#pragma unroll
      for (int n = 0; n < 2; ++n) {
        const int row = row0 + wr * 64 + m * 16 + fr, col = col0 + wc * 32 + n * 16 + 4 * fq;
        const u32x2 yy = *(const u32x2*)(y + (size_t)row * 512 + col); const f32x4 v = acc[m][n];
        u32x2 o; o.x = pk2(bflo(yy.x) * sigmoidf_(v.x), bfhi(yy.x) * sigmoidf_(v.y)); o.y = pk2(bflo(yy.y) * sigmoidf_(v.z), bfhi(yy.y) * sigmoidf_(v.w));
        *(u32x2*)(ssm + (size_t)row * 512 + col) = o;
      }
  }
}
struct EpiInproj {
  static constexpr bool PERM = false, AFTER_DRAIN = false;
  bf16_t* qb; bf16_t* kvk; bf16_t* vT; bf16_t* mg; bf16_t* ub; float* gates;
  DI void operator()(const f32x4 (&acc)[2][2][4][2], const pg8::Unit& u, int wr, int wc, int fr_, int fq_) const {
    const int pn = u.pn; int fr = fr_, fq = fq_; asm volatile("" : "+v"(fr), "+v"(fq));
#pragma unroll
    for (int ai = 0; ai < 2; ++ai)
#pragma unroll
      for (int m = 0; m < 4; ++m) {
        const int row = u.pm * 256 + ai * 128 + wr * 64 + m * 16 + fr;
#pragma unroll
        for (int bj = 0; bj < 2; ++bj)
#pragma unroll
          for (int n = 0; n < 2; ++n) {
            const int cl = bj * 128 + wc * 32 + n * 16 + 4 * fq;
            const f32x4 v = acc[ai][bj][m][n];
            if (pn < 4) { u32x2 o; o.x = pk2(v.x * QSCALE, v.y * QSCALE); o.y = pk2(v.z * QSCALE, v.w * QSCALE); *(u32x2*)(qb + (size_t)row * DM + pn * 256 + cl) = o; }
            else if (pn < 10) {
              const int seg = pn - 4;
              if (seg == 5) {
                const int b = row >> 13, t = row & (SEQ - 1), g = cl >> 6, d = cl & 63;
                bf16_t* dst = vT + ((size_t)(((1 * NB + b) * 4 + g) * 64 + d)) * SEQ + perm16(t);
                dst[0] = (bf16_t)f2bf(v.x); dst[SEQ] = (bf16_t)f2bf(v.y); dst[2 * SEQ] = (bf16_t)f2bf(v.z); dst[3 * SEQ] = (bf16_t)f2bf(v.w);
              } else if (seg == 3) {
                const unsigned t = row & (SEQ - 1), pos = perm16(t) & 63;
                const unsigned ro = ((unsigned)(row >> 13) * 512u + (t >> 6)) * 4096u + (pos >> 3) * 256u + (pos & 7), co = (unsigned)(cl >> 6) * 524288u + (unsigned)((cl >> 5) & 1) * 2048u + (unsigned)(cl & 31) * 8u;
                bf16_t* dst = vT + (ro + co);
                dst[0] = (bf16_t)f2bf(v.x); dst[8] = (bf16_t)f2bf(v.y); dst[16] = (bf16_t)f2bf(v.z); dst[24] = (bf16_t)f2bf(v.w);
              } else if (seg == 2) {
                const unsigned t = row & (SEQ - 1);
                const unsigned ro = ((unsigned)(row >> 13) * 512u + (t >> 6)) * 4096u + ((t >> 5) & 1) * 2048u + (t & 31) * 8u, co = (unsigned)(cl >> 6) * 524288u + (unsigned)((cl >> 3) & 7) * 256u + (unsigned)(cl & 7);
                u32x2 o; o.x = pk2(v.x, v.y); o.y = pk2(v.z, v.w);
                *(u32x2*)(kvk + (WS_KSF - WS_C) / 2 + (ro + co)) = o;
              } else {
                const int slot = seg == 4 ? 3 : seg;
                u32x2 o; o.x = pk2(v.x, v.y); o.y = pk2(v.z, v.w); *(u32x2*)(kvk + (size_t)row * DM + slot * 256 + cl) = o;
              }
            } else if (pn < 18) {
              u32x2 o; o.x = pk2(sigmoidf_(v.x), sigmoidf_(v.y)); o.y = pk2(sigmoidf_(v.z), sigmoidf_(v.w)); *(u32x2*)(mg + (size_t)row * 2048 + (pn - 10) * 256 + cl) = o;
            } else if (pn < 20) { const int ch = (pn - 18) * 256 + cl; u32x2 o; o.x = pk2(v.x, v.y); o.y = pk2(v.z, v.w); *(u32x2*)(ub + ((size_t)(ch >> 4) * NT + row) * 16 + (ch & 15)) = o; }
            else { if (cl < 48) { f32x4 o = {sigmoidf_(v.x), sigmoidf_(v.y), sigmoidf_(v.z), sigmoidf_(v.w)}; *(f32x4*)(gates + (size_t)row * 48 + cl) = o; } }
          }
      }
  }
};
DI void phase_inproj8(const Params& P_, unsigned char* lds) {
  Params P = P_; { size_t z_ = 0; asm volatile("" : "+s"(z_)); P.ws = P_.ws + z_; }
  pg8::Gemm g{(const bf16_t*)(P.ws + WS_A), (const bf16_t*)(P.ws + WS_W + W_IN), NT, 5120, DM};
  pg8::StaticOrder S; S.init(NT, 5120, gridDim.x, obid());
  EpiInproj E{(bf16_t*)(P.ws + WS_B), (bf16_t*)(P.ws + WS_C), (bf16_t*)(P.ws + WS_DV), (bf16_t*)(P.ws + WS_F), (bf16_t*)(P.ws + WS_E), (float*)(P.ws + WS_GATES)};
  pg8::gemm_phase<EpiInproj, pg8::StaticOrder, true, true>((PG8_LAS unsigned char*)lds, g, S, E);
}
struct EpiMerge1 {
  static constexpr bool PERM = false, AFTER_DRAIN = false;
  const bf16_t* mg; bf16_t* tmp;
  DI void operator()(const f32x4 (&acc)[2][2][4][2], const pg8::Unit& u, int wr, int wc, int fr, int fq) const {
#pragma unroll
    for (int ai = 0; ai < 2; ++ai) {
      u32x2 ga[4][2][2];
#pragma unroll
      for (int m = 0; m < 4; ++m)
#pragma unroll
        for (int bj = 0; bj < 2; ++bj)
#pragma unroll
          for (int n = 0; n < 2; ++n) {
            const int row = u.pm * 256 + ai * 128 + wr * 64 + m * 16 + fr, col = u.pn * 256 + bj * 128 + wc * 32 + n * 16 + 4 * fq;
            ga[m][bj][n] = *(const u32x2*)(mg + (size_t)row * 2048 + col);
          }
      __builtin_amdgcn_sched_barrier(0);
#pragma unroll
      for (int m = 0; m < 4; ++m)
#pragma unroll
        for (int bj = 0; bj < 2; ++bj)
#pragma unroll
          for (int n = 0; n < 2; ++n) {
            const int row = u.pm * 256 + ai * 128 + wr * 64 + m * 16 + fr, col = u.pn * 256 + bj * 128 + wc * 32 + n * 16 + 4 * fq;
            const f32x4 v = acc[ai][bj][m][n]; const u32x2 g = ga[m][bj][n];
            u32x2 o; o.x = pk2(v.x * bflo(g.x), v.y * bfhi(g.x)); o.y = pk2(v.z * bflo(g.y), v.w * bfhi(g.y));
            *(u32x2*)(tmp + (size_t)row * DM + col) = o;
          }
      __builtin_amdgcn_sched_barrier(0);
    }
  }
};
struct EpiMerge2 {
  static constexpr bool PERM = false, AFTER_DRAIN = false;
  const bf16_t* mg; const bf16_t* tmp; bf16_t* mer;
  DI void operator()(const f32x4 (&acc)[2][2][4][2], const pg8::Unit& u, int wr, int wc, int fr, int fq) const {
#pragma unroll
    for (int ai = 0; ai < 2; ++ai)
#pragma unroll
      for (int mh = 0; mh < 2; ++mh) {
        u32x2 gs[2][2][2], tv[2][2][2];
#pragma unroll
        for (int mm = 0; mm < 2; ++mm)
#pragma unroll
          for (int bj = 0; bj < 2; ++bj)
#pragma unroll
            for (int n = 0; n < 2; ++n) {
              const int row = u.pm * 256 + ai * 128 + wr * 64 + (mh * 2 + mm) * 16 + fr, col = u.pn * 256 + bj * 128 + wc * 32 + n * 16 + 4 * fq;
              gs[mm][bj][n] = *(const u32x2*)(mg + (size_t)row * 2048 + 1024 + col);
#if EN_ATTN
              tv[mm][bj][n] = *(const u32x2*)(tmp + (size_t)row * DM + col);
#else
              tv[mm][bj][n] = (u32x2){0u, 0u};
#endif
            }
        __builtin_amdgcn_sched_barrier(0);
#pragma unroll
        for (int mm = 0; mm < 2; ++mm)
#pragma unroll
          for (int bj = 0; bj < 2; ++bj)
#pragma unroll
            for (int n = 0; n < 2; ++n) {
              const int row = u.pm * 256 + ai * 128 + wr * 64 + (mh * 2 + mm) * 16 + fr, col = u.pn * 256 + bj * 128 + wc * 32 + n * 16 + 4 * fq;
              const f32x4 v = acc[ai][bj][mh * 2 + mm][n]; const u32x2 g = gs[mm][bj][n], t = tv[mm][bj][n];
              u32x2 o; o.x = pk2(bflo(t.x) + v.x * bflo(g.x), bfhi(t.x) + v.y * bfhi(g.x)); o.y = pk2(bflo(t.y) + v.z * bflo(g.y), bfhi(t.y) + v.w * bfhi(g.y));
              *(u32x2*)(mer + (size_t)row * DM + col) = o;
            }
        __builtin_amdgcn_sched_barrier(0);
      }
  }
};
DI void phase_merge8(const Params& P_, unsigned char* lds) {
  Params P = P_; { size_t z_ = 0; asm volatile("" : "+s"(z_)); P.ws = P_.ws + z_; }
#if EN_ATTN
  { pg8::Gemm g{(const bf16_t*)(P.ws + WS_A), (const bf16_t*)(P.ws + WS_W + W_O), NT, DM, DM};
    pg8::StaticOrder S; S.init(NT, DM, gridDim.x, obid());
    EpiMerge1 E{(const bf16_t*)(P.ws + WS_F), (bf16_t*)(P.ws + WS_C)};
    pg8::gemm_phase<EpiMerge1, pg8::StaticOrder, true, true>((PG8_LAS unsigned char*)lds, g, S, E); }
#endif
  { pg8::Gemm g{(const bf16_t*)(P.ws + WS_E), (const bf16_t*)(P.ws + WS_W + W_SO), NT, DM, 512};
    pg8::StaticOrder S; S.init(NT, DM, gridDim.x, obid());
    EpiMerge2 E{(const bf16_t*)(P.ws + WS_F), (const bf16_t*)(P.ws + WS_C), (bf16_t*)(P.ws + WS_B)};
    pg8::gemm_phase<EpiMerge2, pg8::StaticOrder, true, true>((PG8_LAS unsigned char*)lds, g, S, E); }
}
struct EpiWout {
  static constexpr bool PERM = false, AFTER_DRAIN = false;
  const float* mod; const float* xin; float* out;
  DI void operator()(const f32x4 (&acc)[2][2][4][2], const pg8::Unit& u, int wr, int wc, int fr, int fq) const {
    const int b = (u.pm * 256) >> 13;
    f32x4 g1[2][2];
#pragma unroll
    for (int bj = 0; bj < 2; ++bj)
#pragma unroll
      for (int n = 0; n < 2; ++n) g1[bj][n] = *(const f32x4*)(mod + (size_t)b * 6144 + 2048 + u.pn * 256 + bj * 128 + wc * 32 + n * 16 + 4 * fq);
#pragma unroll
    for (int ai = 0; ai < 2; ++ai)
#pragma unroll
      for (int mh = 0; mh < 2; ++mh) {
        f32x4 xv[2][2][2];
#pragma unroll
        for (int mm = 0; mm < 2; ++mm)
#pragma unroll
          for (int bj = 0; bj < 2; ++bj)
#pragma unroll
            for (int n = 0; n < 2; ++n) {
              const int row = u.pm * 256 + ai * 128 + wr * 64 + (mh * 2 + mm) * 16 + fr, col = u.pn * 256 + bj * 128 + wc * 32 + n * 16 + 4 * fq;
              xv[mm][bj][n] = *(const f32x4*)(xin + (size_t)row * DM + col);
            }
        __builtin_amdgcn_sched_barrier(0);
#pragma unroll
        for (int mm = 0; mm < 2; ++mm)
#pragma unroll
          for (int bj = 0; bj < 2; ++bj)
#pragma unroll
            for (int n = 0; n < 2; ++n) {
              const int row = u.pm * 256 + ai * 128 + wr * 64 + (mh * 2 + mm) * 16 + fr, col = u.pn * 256 + bj * 128 + wc * 32 + n * 16 + 4 * fq;
              *(f32x4*)(out + (size_t)row * DM + col) = xv[mm][bj][n] + g1[bj][n] * acc[ai][bj][mh * 2 + mm][n];
            }
        __builtin_amdgcn_sched_barrier(0);
      }
  }
};
DI void phase_wout8(const Params& P_, int l, unsigned char* lds) {
  Params P = P_; { size_t z_ = 0; asm volatile("" : "+s"(z_)); P.ws = P_.ws + z_; }
  pg8::Gemm g{(const bf16_t*)(P.ws + WS_B), (const bf16_t*)(P.ws + WS_W + W_OUT), NT, DM, DM};
  pg8::StaticOrder S; S.init(NT, DM, gridDim.x, obid());
  EpiWout E{(const float*)(P.ws + WS_MOD) + (size_t)(l * 2) * 6144, l == 0 ? P.in[0] : P.out, P.out};
  pg8::gemm_phase<EpiWout, pg8::StaticOrder, true, true>((PG8_LAS unsigned char*)lds, g, S, E);
}

struct MoeTab { int cv, pin; };
DI MoeTab moe_tab(const int* cnt) {
  const int lane = otid() & 63; MoeTab T; T.cv = cnt[lane & 31]; int p = (T.cv + 127) >> 7;
#pragma unroll
  for (int o = 1; o < 32; o <<= 1) { const int t = __shfl_up(p, o); if ((lane & 31) >= o) p += t; }
  T.pin = p; return T;
}
DI int moe_total(const MoeTab& T) { return __builtin_amdgcn_readlane(T.pin, 31); }
DI void moe_find(const MoeTab& T, int rb, int& e, int& rbl, int& ce) {
  const unsigned m = (unsigned)__ballot(T.pin <= rb);
  e = __popc(m); e = e < NEXP ? e : NEXP - 1;
  const int nb = (__shfl(T.cv, e) + 127) >> 7;
  ce = __shfl(T.cv, e); rbl = rb - (__shfl(T.pin, e) - nb);
  e = __builtin_amdgcn_readfirstlane(e); rbl = __builtin_amdgcn_readfirstlane(rbl); ce = __builtin_amdgcn_readfirstlane(ce);
}
DI void phase_moe1(const Params& P_, int l, unsigned char* lds) {
  Params P = P_; { size_t z_ = 0; asm volatile("" : "+s"(z_)); P.ws = P_.ws + z_; }
  TILE_IDS;
  const int* cnt = (const int*)(P.ws + WS_CNT) + l * 32; const int* list = (const int*)(P.ws + WS_LIST);
  const bf16_t* h2 = (const bf16_t*)(P.ws + WS_A); bf16_t* act = (bf16_t*)(P.ws + WS_B);
  const MoeTab MT = moe_tab(cnt); const int total = moe_total(MT);
  for (int tile = bid; tile < total * 4; tile += gridDim.x) {
    const int rb = tile >> 2, ct = tile & 3; int e = 0, rbl = 0, ce = 1; moe_find(MT, rb, e, rbl, ce);
    const bf16_t* wt = (const bf16_t*)(P.ws + WS_W + W_GU) + (size_t)e * 512 * 1024 + (size_t)(ct * 128) * 1024;
    const bf16_t* ap[2];
#pragma unroll
    for (int i = 0; i < 2; ++i) { int idx = rbl * 128 + lr + 64 * i; idx = idx < ce ? idx : ce - 1; const int tok = list[e * LISTCAP + idx] >> 1; ap[i] = h2 + (size_t)tok * DM + lk; }
    f32x4 acc[4][2]; ACC_ZERO(acc);
    gemm_kloop(lds, ap[0], ap[1], 64, wt + (size_t)lr * DM + lk, wt + (size_t)(lr + 64) * DM + lk, 16, acc);
#pragma unroll
    for (int m = 0; m < 4; ++m) {
      const int arow = rb * 128 + wr * 64 + m * 16 + fr, col = ct * 64 + wc * 16 + 4 * fq;
      const f32x4 g = acc[m][0], u = acc[m][1];
      u32x2 o; o.x = pk2(g.x * sigmoidf_(g.x) * u.x, g.y * sigmoidf_(g.y) * u.y); o.y = pk2(g.z * sigmoidf_(g.z) * u.z, g.w * sigmoidf_(g.w) * u.w);
      *(u32x2*)(act + (size_t)arow * 256 + col) = o;
    }
  }
}
DI void phase_moe2(const Params& P_, int l, unsigned char* lds) {
  Params P = P_; { size_t z_ = 0; asm volatile("" : "+s"(z_)); P.ws = P_.ws + z_; }
  TILE_IDS;
  const int* cnt = (const int*)(P.ws + WS_CNT) + l * 32; const int* list = (const int*)(P.ws + WS_LIST); const float* wts = (const float*)(P.ws + WS_WT);
  const bf16_t* act = (const bf16_t*)(P.ws + WS_B); bf16_t* ys = (bf16_t*)(P.ws + WS_F);
  constexpr int ASUB = 128 * GT_ROWB, BOFF = 4 * ASUB;
  const MoeTab MT = moe_tab(cnt); const int total = moe_total(MT);
  const int lkb = (tid & 7) * 16;
  for (int item = bid; item < total * 4; item += gridDim.x) {
    const int rb = item >> 2, ct0 = (item & 3) * 2; int e = 0, rbl = 0, ce = 1; moe_find(MT, rb, e, rbl, ce);
    const bf16_t* wt = (const bf16_t*)(P.ws + WS_W + W_D) + (size_t)e * 1024 * 256;
    const bf16_t* a0 = act + (size_t)(rb * 128 + lr) * 256 + lk; const bf16_t* a1 = a0 + 64 * 256;
    u32x4 ra[8], xb0, xb1, yb0, yb1;
#pragma unroll
    for (int k = 0; k < 4; ++k) { ra[2 * k] = *(const u32x4*)(a0 + 64 * k); ra[2 * k + 1] = *(const u32x4*)(a1 + 64 * k); }
#define M2_BLOAD(q0_, q1_, s_) do { const bf16_t* bp_ = wt + (size_t)((ct0 + ((s_) >> 2)) * 128 + lr) * 256 + ((s_) & 3) * 64 + lk; q0_ = *(const u32x4*)bp_; q1_ = *(const u32x4*)(bp_ + 64 * 256); } while (0)
#define M2_BSTORE(q0_, q1_, buf_) do { unsigned char* s_ = lds + BOFF + (buf_) * ASUB; *(u32x4*)(s_ + lr * GT_ROWB + lkb) = q0_; *(u32x4*)(s_ + (lr + 64) * GT_ROWB + lkb) = q1_; } while (0)
#define M2_COMPUTE(s_, buf_) do { \
      const unsigned char* As = lds + ((s_) & 3) * ASUB + (wr * 64 + fr) * GT_ROWB + fq * 16; \
      const unsigned char* Bs = lds + BOFF + (buf_) * ASUB + (wc * 32 + fr) * GT_ROWB + fq * 16; \
      _Pragma("unroll") for (int ks = 0; ks < 2; ++ks) { \
        bf16x8 af[4], bfr[2]; \
        _Pragma("unroll") for (int m = 0; m < 4; ++m) af[m] = *(const bf16x8*)(As + m * 16 * GT_ROWB + ks * 64); \
        _Pragma("unroll") for (int n = 0; n < 2; ++n) bfr[n] = *(const bf16x8*)(Bs + n * 16 * GT_ROWB + ks * 64); \
        _Pragma("unroll") for (int m = 0; m < 4; ++m) _Pragma("unroll") for (int n = 0; n < 2; ++n) acc[m][n] = __builtin_amdgcn_mfma_f32_16x16x32_bf16(bfr[n], af[m], acc[m][n], 0, 0, 0); } } while (0)
#define M2_EPI(ct_) do { _Pragma("unroll") for (int m = 0; m < 4; ++m) { const int idx = rbl * 128 + wr * 64 + m * 16 + fr; \
      if (idx < ce) { const int slot = list[e * LISTCAP + idx]; const float w_ = wts[slot]; \
        _Pragma("unroll") for (int n = 0; n < 2; ++n) { const int col = (ct_) * 128 + wc * 32 + n * 16 + 4 * fq; const f32x4 v = acc[m][n] * w_; \
          u32x2 o; o.x = pk2(v.x, v.y); o.y = pk2(v.z, v.w); *(u32x2*)(ys + (size_t)slot * DM + col) = o; } } } ACC_ZERO(acc); } while (0)
    M2_BLOAD(xb0, xb1, 0);
#pragma unroll
    for (int k = 0; k < 4; ++k) { *(u32x4*)(lds + k * ASUB + lr * GT_ROWB + lkb) = ra[2 * k]; *(u32x4*)(lds + k * ASUB + (lr + 64) * GT_ROWB + lkb) = ra[2 * k + 1]; }
    M2_BSTORE(xb0, xb1, 0);
    M2_BLOAD(yb0, yb1, 1);
    __syncthreads();
    f32x4 acc[4][2]; ACC_ZERO(acc);
#pragma unroll 1
    for (int s2 = 0; s2 < 8; s2 += 2) {
      if (s2 + 2 < 8) M2_BLOAD(xb0, xb1, s2 + 2);
      M2_COMPUTE(s2, 0);
      M2_BSTORE(yb0, yb1, 1);
      __syncthreads();
      if (s2 + 3 < 8) M2_BLOAD(yb0, yb1, s2 + 3);
      M2_COMPUTE(s2 + 1, 1);
      if (s2 == 2) M2_EPI(ct0);
      if (s2 == 6) M2_EPI(ct0 + 1);
      if (s2 + 2 < 8) M2_BSTORE(xb0, xb1, 0);
      __syncthreads();
    }
#undef M2_BLOAD
#undef M2_BSTORE
#undef M2_COMPUTE
#undef M2_EPI
  }
}

typedef float f32x2v __attribute__((ext_vector_type(2)));
DI void phase_s5a(const Params& P_, int l, unsigned char* lds) {
  Params P = P_; { size_t z_ = 0; asm volatile("" : "+s"(z_)); P.ws = P_.ws + z_; }
  TILE_IDS;
  const bf16_t* ub = (const bf16_t*)(P.ws + WS_E); float* Lb = (float*)(P.ws + WS_L);
  const bf16_t* M1 = (const bf16_t*)(P.ws + WS_TAB + (size_t)l * TAB_LAYER + TAB_M1);
  const int first = (int)gridDim.x >= 192 ? 128 : 0;
  for (int tile = bid - first; tile >= 0 && tile < 64; tile += gridDim.x) {
    const int g = tile >> 1, rt = tile & 1;
    const bf16_t* a = ub + ((size_t)g * NT / 64 + rt * 128) * 1024;
    const bf16_t* wt = M1 + (size_t)g * 128 * 1024;
    f32x4 acc[4][2]; ACC_ZERO(acc);
    gemm_kloop(lds, a + (size_t)lr * 1024 + lk, a + (size_t)(lr + 64) * 1024 + lk, 64, wt + (size_t)lr * 1024 + lk, wt + (size_t)(lr + 64) * 1024 + lk, 16, acc);
#pragma unroll
    for (int m = 0; m < 4; ++m)
#pragma unroll
      for (int n = 0; n < 2; ++n) {
        const int R = rt * 128 + wr * 64 + m * 16 + fr, comp = wc * 32 + n * 16 + 4 * fq;
        *(f32x4*)(Lb + ((size_t)(R * 32 + g) * 64) * 2 + comp) = acc[m][n];
      }
  }
}
DI void s5_carry(const Params& P_, int l) {
  Params P = P_; { size_t z_ = 0; asm volatile("" : "+s"(z_)); P.ws = P_.ws + z_; }
  const int tid_ = otid(), bid = obid(), wave = tid_ >> 6, lane = tid_ & 63;
  const int item = (gridDim.x * NWAVE - 1) - (bid * NWAVE + wave);
  if (item >= NB * 32) return;
  const int b = item >> 5, g = item & 31;
  const float* pp = (const float*)(P.ws + WS_S5P) + (size_t)((l * 32 + g) * 64 + lane) * 36;
  const float aTr = pp[2], aTi = pp[3];
  float2* Lp = (float2*)(P.ws + WS_L) + ((size_t)(b * 128) * 32 + g) * 64 + lane;
  unsigned* Sp = (unsigned*)(P.ws + WS_SIN) + ((size_t)(g * 256 + b * 128)) * 64 + lane;
  float sr = 0.f, si = 0.f; asm volatile("" : "+v"(sr), "+v"(si));
  for (int c0 = 0; c0 < 128; c0 += 8) {
    float2 v[8];
#pragma unroll
    for (int k = 0; k < 8; ++k) v[k] = Lp[(size_t)(c0 + k) * 2048];
#pragma unroll
    for (int k = 0; k < 8; ++k) { Lp[(size_t)(c0 + k) * 2048] = make_float2(sr, si); Sp[(size_t)(c0 + k) * 64] = pk2(sr, si);
      const float nr = aTr * sr - aTi * si + v[k].x, ni = aTr * si + aTi * sr + v[k].y; sr = nr; si = ni; }
  }
}
DI void phase_s5c(const Params& P_, int l, unsigned char* lds) {
  Params P = P_; { size_t z_ = 0; asm volatile("" : "+s"(z_)); P.ws = P_.ws + z_; }
  TILE_IDS;
  const bf16_t* ub = (const bf16_t*)(P.ws + WS_E); const bf16_t* sinb = (const bf16_t*)(P.ws + WS_SIN); bf16_t* yb = (bf16_t*)(P.ws + WS_G);
  const bf16_t* tab = (const bf16_t*)(P.ws + WS_TAB + (size_t)l * TAB_LAYER);
  int* dctr = (int*)(P.ws + 640) + l; int* dslot = (int*)(lds + LDS_BYTES - 32);
  constexpr int ROWB = 144, SA = 0, SB = 128 * ROWB, STAGE = 2 * 128 * ROWB;
  const int lkb = (tid & 7) * 16, kch = tid & 7;
  for (;;) {
    if (threadIdx.x == 0) *dslot = atomicAdd(dctr, 1);
    __syncthreads();
    const int tile = *dslot;
    __syncthreads();
    if (tile >= 512) break;
    const int g = tile >> 4, rt = (tile >> 3) & 1, ct = tile & 7;
    const bf16_t* Kt = tab + TAB_KT / 2 + (size_t)g * 64 * 256; const bf16_t* M2 = tab + TAB_M2 / 2 + (size_t)g * 1024 * 128;
    const bf16_t* ua = ub + ((size_t)g * 256 + rt * 128) * 1024; const bf16_t* sa = sinb + ((size_t)g * 256 + rt * 128) * 128;
    const int nbt = 2 * ct + 2 < 16 ? 2 * ct + 2 : 16, ns = nbt + 2;
    u32x4 xa0, xa1, xb0, xb1, ya0, ya1, yb0, yb1;
#define S5_LOAD(p0_, p1_, q0_, q1_, s_) do { \
      if ((s_) < nbt) { p0_ = *(const u32x4*)(ua + (size_t)lr * 1024 + (s_) * 64 + lk); p1_ = *(const u32x4*)(ua + (size_t)(lr + 64) * 1024 + (s_) * 64 + lk); \
        const int i_ = 4 * (s_) + (kch >> 1), hq_ = (kch & 1) * 8; \
        { const int t_ = 8 * ct + (lr >> 4), h_ = lr & 15; q0_ = t_ >= i_ ? *(const u32x4*)(Kt + ((t_ - i_) * 16 + h_) * 16 + hq_) : (u32x4){0u, 0u, 0u, 0u}; } \
        { const int t_ = 8 * ct + 4 + (lr >> 4), h_ = lr & 15; q1_ = t_ >= i_ ? *(const u32x4*)(Kt + ((t_ - i_) * 16 + h_) * 16 + hq_) : (u32x4){0u, 0u, 0u, 0u}; } \
      } else { const int k0_ = ((s_) - nbt) * 64 + lk; \
        p0_ = *(const u32x4*)(sa + (size_t)lr * 128 + k0_); p1_ = *(const u32x4*)(sa + (size_t)(lr + 64) * 128 + k0_); \
        q0_ = *(const u32x4*)(M2 + (size_t)(ct * 128 + lr) * 128 + k0_); q1_ = *(const u32x4*)(M2 + (size_t)(ct * 128 + lr + 64) * 128 + k0_); } } while (0)
#define S5_STORE(p0_, p1_, q0_, q1_, buf) do { unsigned char* s_ = lds + (buf) * STAGE; \
      *(u32x4*)(s_ + SA + lr * ROWB + lkb) = p0_; *(u32x4*)(s_ + SA + (lr + 64) * ROWB + lkb) = p1_; \
      *(u32x4*)(s_ + SB + lr * ROWB + lkb) = q0_; *(u32x4*)(s_ + SB + (lr + 64) * ROWB + lkb) = q1_; } while (0)
#define S5_COMPUTE(buf) do { \
      const unsigned char* As = lds + (buf) * STAGE + SA + (wr * 64 + fr) * ROWB + fq * 16; \
      const unsigned char* Bs = lds + (buf) * STAGE + SB + (wc * 32 + fr) * ROWB + fq * 16; \
      _Pragma("unroll") for (int ks = 0; ks < 2; ++ks) { \
        bf16x8 af[4], bfr[2]; \
        _Pragma("unroll") for (int m = 0; m < 4; ++m) af[m] = *(const bf16x8*)(As + m * 16 * ROWB + ks * 64); \
        _Pragma("unroll") for (int n = 0; n < 2; ++n) bfr[n] = *(const bf16x8*)(Bs + n * 16 * ROWB + ks * 64); \
        _Pragma("unroll") for (int m = 0; m < 4; ++m) _Pragma("unroll") for (int n = 0; n < 2; ++n) acc[m][n] = __builtin_amdgcn_mfma_f32_16x16x32_bf16(bfr[n], af[m], acc[m][n], 0, 0, 0); } } while (0)
    f32x4 acc[4][2]; ACC_ZERO(acc);
    S5_LOAD(xa0, xa1, xb0, xb1, 0); S5_STORE(xa0, xa1, xb0, xb1, 0); S5_LOAD(ya0, ya1, yb0, yb1, 1); __syncthreads();
    for (int st = 0; st < ns; st += 2) {
      if (st + 2 < ns) S5_LOAD(xa0, xa1, xb0, xb1, st + 2);
      S5_COMPUTE(0);
      if (st + 1 < ns) S5_STORE(ya0, ya1, yb0, yb1, 1);
      __syncthreads();
      if (st + 1 >= ns) break;
      if (st + 3 < ns) S5_LOAD(ya0, ya1, yb0, yb1, st + 3);
      S5_COMPUTE(1);
      if (st + 2 < ns) S5_STORE(xa0, xa1, xb0, xb1, 0);
      __syncthreads();
    }
#undef S5_LOAD
#undef S5_STORE
#undef S5_COMPUTE
    const float* dsk = P.in[13] + (size_t)(l * 32 + g) * 16;
#pragma unroll
    for (int m = 0; m < 4; ++m)
#pragma unroll
      for (int n = 0; n < 2; ++n) {
        const int R = rt * 128 + wr * 64 + m * 16 + fr, col = ct * 128 + wc * 32 + n * 16 + 4 * fq, t = col >> 4, h = col & 15;
        const u32x2 uu = *(const u32x2*)(ub + ((size_t)g * 256 + R) * 1024 + col); const f32x4 dd = *(const f32x4*)(dsk + h); const f32x4 v = acc[m][n];
        const float y0 = gelu_tanh(v.x + dd.x * bflo(uu.x)), y1 = gelu_tanh(v.y + dd.y * bfhi(uu.x)), y2 = gelu_tanh(v.z + dd.z * bflo(uu.y)), y3 = gelu_tanh(v.w + dd.w * bfhi(uu.y));
        const size_t tokn = (size_t)(R >> 7) * SEQ + 64 * (R & 127) + t;
        u32x2 o; o.x = pk2(y0, y1); o.y = pk2(y2, y3); *(u32x2*)(yb + tokn * 512 + g * 16 + h) = o;
      }
  }
}

constexpr int AT_ROWB = 144, AT_KS = 0, AT_VS = 2 * 64 * AT_ROWB, AT_IMP = 4 * 64 * AT_ROWB, AT_OACC = AT_IMP, AT_IMPS = 129, AT_EE = AT_IMP + 64 * AT_IMPS * 4,
              AT_SEL = AT_IMP + 66048, AT_QS = AT_SEL + 1024, AT_QL = AT_QS + 32768, AT_NJ = AT_QL + 8192, AT_ITEMS = AT_NJ + 512, AT_MREF = AT_ITEMS + 512,
              AT_LACC = AT_MREF + 1024, AT_INVQ = AT_LACC + 1024, AT_MISC = AT_INVQ + 512, AT_LOWN = AT_MISC + 64, AT_END = AT_LOWN + 1024;
static_assert(AT_END <= LDS_BYTES - 16, "attention LDS");
#define MFMA32(a, b, c) __builtin_amdgcn_mfma_f32_32x32x16_bf16((a), (b), (c), 0, 0, 0)
DI int crow_of(int reg, int hh) { return (reg & 3) + 8 * (reg >> 2) + 4 * hh; }

struct AttnState { f32x16 o0, o1; float m, l; };
DI void st_init(AttnState& S) { S.m = -1e30f; S.l = 0.f;
#pragma unroll
  for (int i = 0; i < 16; ++i) { S.o0[i] = 0.f; S.o1[i] = 0.f; } }

DI void at_ldk(const unsigned char* lds, int buf, int r, int hh, bf16x8 (&kf)[8]) {
  const unsigned char* kb = lds + AT_KS + buf * 64 * AT_ROWB + r * AT_ROWB + hh * 16;
#pragma unroll
  for (int ds = 0; ds < 4; ++ds) { kf[ds] = *(const bf16x8*)(kb + ds * 32); kf[4 + ds] = *(const bf16x8*)(kb + 32 * AT_ROWB + ds * 32); }
}
DI void at_ldv(const unsigned char* lds, int buf, int r, int hh, bf16x8 (&vf)[8]) {
  const unsigned char* vb = lds + AT_VS + buf * 64 * AT_ROWB + r * AT_ROWB + hh * 16;
#pragma unroll
  for (int gk = 0; gk < 4; ++gk) { vf[gk] = *(const bf16x8*)(vb + gk * 32); vf[4 + gk] = *(const bf16x8*)(vb + 32 * AT_ROWB + gk * 32); }
}
DI void at_qk(const bf16x8 (&kf)[8], const bf16x8 (&qf)[4], f32x16& p0, f32x16& p1) {
  const f32x16 z = {0.f, 0.f, 0.f, 0.f, 0.f, 0.f, 0.f, 0.f, 0.f, 0.f, 0.f, 0.f, 0.f, 0.f, 0.f, 0.f};
#pragma unroll
  for (int ds = 0; ds < 4; ++ds) { if (ds == 0) { p0 = MFMA32(kf[0], qf[0], z); p1 = MFMA32(kf[4], qf[0], z); } else { p0 = MFMA32(kf[ds], qf[ds], p0); p1 = MFMA32(kf[4 + ds], qf[ds], p1); } }
}
DI bf16x8 pack8(const f32x16& p, int s2) {
  u32x4 w; w.x = pk2(p[8 * s2], p[8 * s2 + 1]); w.y = pk2(p[8 * s2 + 2], p[8 * s2 + 3]); w.z = pk2(p[8 * s2 + 4], p[8 * s2 + 5]); w.w = pk2(p[8 * s2 + 6], p[8 * s2 + 7]);
  return __builtin_bit_cast(bf16x8, w);
}
DI void at_pv(const bf16x8 (&vf)[8], const f32x16& p0, const f32x16& p1, f32x16& oa, f32x16& ob) {
#pragma unroll
  for (int gk = 0; gk < 4; ++gk) {
    const bf16x8 pb = (gk < 2) ? pack8(p0, gk & 1) : pack8(p1, gk & 1);
    oa = MFMA32(vf[gk], pb, oa); ob = MFMA32(vf[4 + gk], pb, ob);
  }
}
template <int MODE>
DI void at_online(AttnState& S, f32x16& p0, f32x16& p1, int key0, int lo, int hi, bool on, int hh) {
  float tm = -1e30f;
  if (MODE == 1) {
    int lor = lo - key0 - 4 * hh, hir = hi - key0 - 4 * hh;
    if (hir < lor) { lor = 4096; hir = 4096; }
    const unsigned span = (unsigned)(hir - lor);
#pragma unroll
    for (int i = 0; i < 16; ++i) { const int c0 = (i & 3) + 8 * (i >> 2);
      p0[i] = ((unsigned)(c0 - lor) <= span) ? p0[i] : -1e30f; p1[i] = ((unsigned)(c0 + 32 - lor) <= span) ? p1[i] : -1e30f; }
  }
  if (MODE != 1) asm volatile("s_nop 15\n\ts_nop 7" : "+v"(p0), "+v"(p1));
#define MX3_8(o_) asm("v_max3_f32 %0, %0, %1, %2\n\tv_max3_f32 %0, %0, %3, %4\n\tv_max3_f32 %0, %0, %5, %6\n\tv_max3_f32 %0, %0, %7, %8\n\tv_max3_f32 %0, %0, %9, %10\n\tv_max3_f32 %0, %0, %11, %12\n\tv_max3_f32 %0, %0, %13, %14\n\tv_max3_f32 %0, %0, %15, %16" \
      : "+v"(tm) : "v"(p0[o_]), "v"(p1[o_]), "v"(p0[o_ + 1]), "v"(p1[o_ + 1]), "v"(p0[o_ + 2]), "v"(p1[o_ + 2]), "v"(p0[o_ + 3]), "v"(p1[o_ + 3]), "v"(p0[o_ + 4]), "v"(p1[o_ + 4]), "v"(p0[o_ + 5]), "v"(p1[o_ + 5]), "v"(p0[o_ + 6]), "v"(p1[o_ + 6]), "v"(p0[o_ + 7]), "v"(p1[o_ + 7]))
  MX3_8(0); MX3_8(8);
#undef MX3_8
  tm = fmaxf(tm, __shfl_xor(tm, 32));
  if (MODE == 2) tm = on ? tm : -1e30f;
  if (__any(tm > S.m)) {
    const float mn = fmaxf(S.m, tm); const float al = __builtin_amdgcn_exp2f(S.m - mn); S.m = mn; S.l *= al;
#pragma unroll
    for (int i = 0; i < 16; ++i) { S.o0[i] *= al; S.o1[i] *= al; }
  }
  float mn = S.m;
  if (MODE == 2) mn = on ? mn : 1e30f;
  if (MODE == 1) mn = mn < -1e29f ? 1e30f : mn;
  float rs = 0.f;
#pragma unroll
  for (int i = 0; i < 16; ++i) {
    const float e0 = __builtin_amdgcn_exp2f(p0[i] - mn), e1 = __builtin_amdgcn_exp2f(p1[i] - mn);
    p0[i] = e0; p1[i] = e1; rs += e0 + e1;
  }
  S.l += rs;
}

DI void attn_tile(const Params& P_, unsigned char* lds, int b, int g, int c) {
  Params P = P_; { size_t z_ = 0; asm volatile("" : "+s"(z_)); P.ws = P_.ws + z_; }
#define AT_IDS const int tid = otid(), lane = tid & 63, w = tid >> 6, r = lane & 31, hh = lane >> 5, qi = 8 * w + (r >> 2), h = r & 3, t = 64 * c + qi, qrow = 32 * w + r, srow = tid >> 3, sch = (tid & 7) * 8, ahead = lane >> 4, ach = lane & 15; const unsigned tok = (unsigned)b * SEQ + t, goff = tok * 48 + g * 4 + h; (void)qi; (void)h; (void)t; (void)qrow; (void)srow; (void)sch; (void)ahead; (void)ach; (void)tok; (void)goff; (void)hh; (void)w; (void)r
  const bf16_t* qb = (const bf16_t*)(P.ws + WS_B); const bf16_t* kvk = (const bf16_t*)(P.ws + WS_C); const bf16_t* vT = (const bf16_t*)(P.ws + WS_DV);
  const bf16_t* kcb = (const bf16_t*)(P.ws + WS_KC); const bf16_t* vcb = (const bf16_t*)(P.ws + WS_VC);
  const float* gbase = (const float*)(P.ws + WS_GATES);
#define gates(i) gbase[goff + (i)]
  bf16_t* attn = (bf16_t*)(P.ws + WS_A);
  float* otb = (float*)(P.ws + WS_OT) + (size_t)obid() * 16384;
#define otg(i) otb[(unsigned)tid + (i) * 512u]
  float* IMP = (float*)(lds + AT_IMP); float* EE = (float*)(lds + AT_EE); unsigned* SEL = (unsigned*)(lds + AT_SEL);
  AttnState S; f32x16 p0, p1; u32x4 rkA, rvA; bf16x8 qf[4], kfr[8], vfr[8];
#define QF_LOAD() do { _Pragma("unroll") for (int ds_ = 0; ds_ < 4; ++ds_) qf[ds_] = *(const bf16x8*)(lds + AT_QS + qrow * 128 + (((ds_ * 2 + hh) ^ (qrow & 7)) * 16)); } while (0)
#define AT_QKV() do { at_ldk(lds, buf_, r, hh, kfr); __builtin_amdgcn_sched_barrier(0); at_qk(kfr, qf, p0, p1); at_ldv(lds, buf_, r, hh, vfr); __builtin_amdgcn_sched_barrier(0); } while (0)
  { AT_IDS;
  { const int row = tid >> 1, half = tid & 1, q_i = row >> 2, hd = row & 3;
    const unsigned so = ((unsigned)b * SEQ + 64 * c + q_i) * DM + (g * 4 + hd) * 64 + half * 32;
#pragma unroll
    for (int k = 0; k < 4; ++k) { const u32x4 v = *(const u32x4*)(qb + so + k * 8); *(u32x4*)(lds + AT_QS + row * 128 + (((half * 4 + k) ^ (row & 7)) * 16)) = v; } }
  __syncthreads();
  QF_LOAD();
#define ST_LOAD(rk, rv, kp, kstride, vp, vstride, kt) do { rk = *(const u32x4*)((kp) + (unsigned)(((kt) * 64 + srow) * (kstride) + sch)); rv = *(const u32x4*)((vp) + (unsigned)(srow * (vstride) + (kt) * 64 + sch)); } while (0)
#define ST_STORE(rk, rv, buf) do { *(u32x4*)(lds + AT_KS + (buf) * 64 * AT_ROWB + srow * AT_ROWB + sch * 2) = rk; *(u32x4*)(lds + AT_VS + (buf) * 64 * AT_ROWB + srow * AT_ROWB + sch * 2) = rv; } while (0)
#define SWEEP(kp, kstride, vp, vstride, kt0, n, ...) do { \
    ST_LOAD(rkA, rvA, kp, kstride, vp, vstride, (kt0)); ST_STORE(rkA, rvA, 0); __syncthreads(); \
    for (int i_ = 0; i_ < (n); ++i_) { \
      if (i_ + 1 < (n)) ST_LOAD(rkA, rvA, kp, kstride, vp, vstride, (kt0) + i_ + 1); \
      { const int step_ = i_; const int buf_ = i_ & 1; __VA_ARGS__ } \
      if (i_ + 1 < (n)) ST_STORE(rkA, rvA, (i_ + 1) & 1); \
      __syncthreads(); \
    } } while (0)
#define ST_LOADF(rk, rv, kt) do { rk = *(const u32x4*)(kps + (size_t)(kt) * 4096 + tid * 8); rv = *(const u32x4*)(vps + (size_t)(kt) * 4096 + tid * 8); } while (0)
#define ST_STOREF(rk, rv, buf) do { const int fo_ = ((tid >> 8) * 32 + (tid & 31)) * AT_ROWB + (((tid >> 6) & 3) * 2 + ((tid >> 5) & 1)) * 16; \
    *(u32x4*)(lds + AT_KS + (buf) * 64 * AT_ROWB + fo_) = rk; *(u32x4*)(lds + AT_VS + (buf) * 64 * AT_ROWB + fo_) = rv; } while (0)
#define SWEEPF(kt0, n, ...) do { \
    ST_LOADF(rkA, rvA, (kt0)); ST_STOREF(rkA, rvA, 0); __syncthreads(); \
    for (int i_ = 0; i_ < (n); ++i_) { \
      if (i_ + 1 < (n)) ST_LOADF(rkA, rvA, (kt0) + i_ + 1); \
      { const int step_ = i_; const int buf_ = i_ & 1; __VA_ARGS__ } \
      if (i_ + 1 < (n)) ST_STOREF(rkA, rvA, (i_ + 1) & 1); \
      __syncthreads(); \
    } } while (0)
  {
    const bf16_t* kp = kvk + (size_t)b * SEQ * DM + 3 * 256 + g * 64; const bf16_t* vp = vT + (size_t)(((1 * NB + b) * 4 + g) * 64) * SEQ;
    const int j0 = c >= 8 ? c - 8 : 0, nj = c - j0 + 1;
    st_init(S);
    SWEEP(kp, DM, vp, SEQ, j0, nj, {
      AT_QKV();
      if ((step_ == 0 && c >= 8) || step_ == nj - 1) at_online<1>(S, p0, p1, (j0 + step_) * 64, t - 511, t, true, hh);
      else at_online<0>(S, p0, p1, 0, 0, 0, true, hh);
      at_pv(vfr, p0, p1, S.o0, S.o1); });
    const float lt = S.l + __shfl_xor(S.l, 32); const float sc = lt > 0.f ? gates(32) / lt : 0.f;
#pragma unroll
    for (int i = 0; i < 16; ++i) { otg(i) = S.o0[i] * sc; otg(16 + i) = S.o1[i] * sc; }
  }
  {
    const bf16_t* kcp = kcb + (size_t)((b * 4 + g) * 512) * 64; const bf16_t* vcp = vcb + (size_t)((b * 4 + g) * 64) * 512;
    const int nmax = t >= 31 ? (t - 31) >> 4 : -1;
    const int nct = (4 * c + 2) / 64 + 1;
    st_init(S);
    SWEEP(kcp, 64, vcp, 512, 0, nct, {
      at_ldk(lds, buf_, r, hh, kfr); __builtin_amdgcn_sched_barrier(0); at_qk(kfr, qf, p0, p1);
      if (64 * step_ + 63 <= 4 * c - 2) at_online<0>(S, p0, p1, 0, 0, 0, true, hh);
      else at_online<1>(S, p0, p1, step_ * 64, 0, nmax, true, hh); });
    const float lt = S.l + __shfl_xor(S.l, 32);
    const float cinv = lt > 0.f ? 1.f / lt : 0.f; const float cm = S.m;
    st_init(S);
    SWEEP(kcp, 64, vcp, 512, 0, nct, {
      AT_QKV();
      if (64 * step_ + 63 <= 4 * c - 2) {
        _Pragma("unroll") for (int k = 0; k < 16; ++k) { p0[k] = __builtin_amdgcn_exp2f(p0[k] - cm) * cinv; p1[k] = __builtin_amdgcn_exp2f(p1[k] - cm) * cinv; }
      } else {
        const int nrel = nmax - step_ * 64 - 4 * hh;
        _Pragma("unroll") for (int k = 0; k < 16; ++k) { const int c0 = (k & 3) + 8 * (k >> 2), c1 = c0 + 32;
          p0[k] = c0 <= nrel ? __builtin_amdgcn_exp2f(p0[k] - cm) * cinv : 0.f; p1[k] = c1 <= nrel ? __builtin_amdgcn_exp2f(p1[k] - cm) * cinv : 0.f; }
      }
      at_pv(vfr, p0, p1, S.o0, S.o1);
      _Pragma("unroll") for (int kh = 0; kh < 2; ++kh)
      _Pragma("unroll") for (int gi = 0; gi < 4; ++gi) {
          float g4 = kh == 0 ? (p0[4 * gi] + p0[4 * gi + 1]) + (p0[4 * gi + 2] + p0[4 * gi + 3]) : (p1[4 * gi] + p1[4 * gi + 1]) + (p1[4 * gi + 2] + p1[4 * gi + 3]);
          float e3 = kh == 0 ? p0[4 * gi + 3] : p1[4 * gi + 3];
          g4 += __shfl_xor(g4, 1); g4 += __shfl_xor(g4, 2); e3 += __shfl_xor(e3, 1); e3 += __shfl_xor(e3, 2);
          if (h == 0) { const int s = (step_ * 64 + kh * 32 + 8 * gi + 4 * hh) >> 2; IMP[qi * AT_IMPS + s] = g4; EE[qi * AT_IMPS + s] = e3; }
      } });
    const float gc = gates(0);
#pragma unroll
    for (int i = 0; i < 16; ++i) { p0[i] = otg(i); p1[i] = otg(16 + i); }
    __builtin_amdgcn_sched_barrier(0);
#pragma unroll
    for (int i = 0; i < 16; ++i) { otg(i) = p0[i] + S.o0[i] * gc; otg(16 + i) = p1[i] + S.o1[i] * gc; }
  }
  }
  const bf16_t* kps = (const bf16_t*)(P.ws + WS_KSF) + (size_t)((b * 4 + g) * 128) * 4096; const bf16_t* vps = vT + (size_t)((b * 4 + g) * 128) * 4096;
  if (c <= 15) { AT_IDS; QF_LOAD();
    st_init(S);
    if (c > 0) {
      SWEEPF(0, c, {
        AT_QKV();
        at_online<0>(S, p0, p1, 0, 0, 0, true, hh);
        at_pv(vfr, p0, p1, S.o0, S.o1); });
    }
    SWEEPF(c, 1, {
      AT_QKV();
      at_online<1>(S, p0, p1, (c + step_) * 64, 0, t, true, hh);
      at_pv(vfr, p0, p1, S.o0, S.o1); });
    const float lt = S.l + __shfl_xor(S.l, 32); const float slc_sc = lt > 0.f ? gates(16) / lt : 0.f;
    bf16_t* op = attn + (tok * DM + (g * 4 + h) * 64);
#pragma unroll
    for (int i = 0; i < 16; ++i) { S.o0[i] = S.o0[i] * slc_sc + otg(i); S.o1[i] = S.o1[i] * slc_sc + otg(16 + i); }
#pragma unroll
    for (int gi = 0; gi < 4; ++gi) {
      u32x2 a; a.x = pk2(S.o0[4 * gi], S.o0[4 * gi + 1]); a.y = pk2(S.o0[4 * gi + 2], S.o0[4 * gi + 3]);
      u32x2 bq; bq.x = pk2(S.o1[4 * gi], S.o1[4 * gi + 1]); bq.y = pk2(S.o1[4 * gi + 2], S.o1[4 * gi + 3]);
      *(u32x2*)(op + 8 * gi + 4 * hh) = a; *(u32x2*)(op + 32 + 8 * gi + 4 * hh) = bq;
    }
  } else {
    const int nc = c - 2;
    unsigned char* QL = lds + AT_QL; int* NJ = (int*)(lds + AT_NJ); unsigned short* ITEMS = (unsigned short*)(lds + AT_ITEMS); int* MISC = (int*)(lds + AT_MISC);
    float* MREF = (float*)(lds + AT_MREF); float* LS = (float*)(lds + AT_LACC); unsigned char* INVQ = lds + AT_INVQ; unsigned char* SLOT = lds + AT_IMP;
    float* const LOWN = (float*)(lds + AT_LOWN); const float k64 = 5.421010862427522e-20f;
    { AT_IDS;
    for (int idx = tid; idx < 64 * nc; idx += NTHR) { const int q = idx / nc, s = 1 + idx % nc; IMP[q * AT_IMPS + s] += EE[q * AT_IMPS + s - 1]; }
    if (tid < 256) SEL[tid] = 0u;
    if (tid < 128) ((unsigned*)INVQ)[tid] = 0u;
    __syncthreads();
    {
      const int q = tid >> 3, sub = tid & 7; const float* ip = IMP + q * AT_IMPS;
      unsigned key[16];
#pragma unroll
      for (int k = 0; k < 16; ++k) { const int s = 1 + sub + 8 * k; key[k] = s <= nc ? __float_as_uint(ip[s]) + 1u : 0u; }
      unsigned T = 0u;
      for (int bit = 30; bit >= 0; --bit) {
        const unsigned cand = T | (1u << bit); int cn = 0;
#pragma unroll
        for (int k = 0; k < 16; ++k) cn += key[k] >= cand ? 1 : 0;
        cn += __shfl_xor(cn, 1); cn += __shfl_xor(cn, 2); cn += __shfl_xor(cn, 4);
        if (cn >= 13) T = cand;
      }
      int ngt = 0, neq = 0;
#pragma unroll
      for (int k = 0; k < 16; ++k) { ngt += key[k] > T ? 1 : 0; neq += key[k] == T ? 1 : 0; }
      ngt += __shfl_xor(ngt, 1); ngt += __shfl_xor(ngt, 2); ngt += __shfl_xor(ngt, 4);
      neq += __shfl_xor(neq, 1); neq += __shfl_xor(neq, 2); neq += __shfl_xor(neq, 4);
      const int need = 13 - ngt;
      unsigned w0 = 0u, w1 = 0u, w2 = 0u, w3 = 0u;
      if (!__any(neq > need)) {
#pragma unroll
        for (int k = 0; k < 16; ++k) if (key[k] >= T && key[k] != 0u) { const int s = 1 + sub + 8 * k; const unsigned bt = 1u << (s & 31); if (s < 32) w0 |= bt; else if (s < 64) w1 |= bt; else if (s < 96) w2 |= bt; else w3 |= bt; }
      } else {
        int taken = 0; const int gsh = lane & ~7;
#pragma unroll
        for (int k = 0; k < 16; ++k) {
          const bool eq = key[k] == T && key[k] != 0u; const unsigned long long mk = __ballot(eq);
          const unsigned grp = (unsigned)(mk >> gsh) & 0xffu; const int before = __popc(grp & ((1u << sub) - 1u));
          const bool pick = key[k] > T || (eq && taken + before < need);
          taken += __popc(grp);
          if (pick) { const int s = 1 + sub + 8 * k; const unsigned bt = 1u << (s & 31); if (s < 32) w0 |= bt; else if (s < 64) w1 |= bt; else if (s < 96) w2 |= bt; else w3 |= bt; }
        }
      }
      if (w0) atomicOr(&SEL[q * 4], w0); if (w1) atomicOr(&SEL[q * 4 + 1], w1); if (w2) atomicOr(&SEL[q * 4 + 2], w2); if (w3) atomicOr(&SEL[q * 4 + 3], w3);
    }
    __syncthreads();
    for (int j = 1 + w; j <= nc; j += NWAVE) {
      const bool bit = (SEL[lane * 4 + (j >> 5)] >> (j & 31)) & 1u;
      const unsigned long long mk = __ballot(bit);
      const int rank = __builtin_amdgcn_mbcnt_hi((unsigned)(mk >> 32), __builtin_amdgcn_mbcnt_lo((unsigned)mk, 0u));
      if (bit) QL[j * 64 + rank] = (unsigned char)lane;
      const int cnt = __popcll(mk);
      if (lane < ((8 - (cnt & 7)) & 7)) QL[j * 64 + cnt + lane] = 0;
      if (lane == 0) NJ[j] = cnt;
    }
    __syncthreads();
    if (w == 0) {
      const int ja = 1 + lane, jb = 65 + lane;
      const int ca = ja <= nc ? (NJ[ja] + 7) >> 3 : 0, cb = jb <= nc ? (NJ[jb] + 7) >> 3 : 0;
      int sa = ca, sb = cb;
#pragma unroll
      for (int o = 1; o < 64; o <<= 1) { const int ta = __shfl_up(sa, o), tb = __shfl_up(sb, o); if (lane >= o) { sa += ta; sb += tb; } }
      const int tota = __shfl(sa, 63);
      for (int k = 0; k < ca; ++k) ITEMS[sa - ca + k] = (unsigned short)(ja * 8 + k);
      for (int k = 0; k < cb; ++k) ITEMS[tota + sb - cb + k] = (unsigned short)(jb * 8 + k);
      if (lane == 63) MISC[0] = tota + sb;
    }
    }
    { AT_IDS; QF_LOAD();
    st_init(S);
    SWEEPF(0, 1, {
      AT_QKV();
      at_online<0>(S, p0, p1, 0, 0, 0, true, hh);
      at_pv(vfr, p0, p1, S.o0, S.o1); });
    SWEEPF(c - 1, 2, {
      AT_QKV();
      if (step_ == 1) at_online<1>(S, p0, p1, c * 64, 0, t, true, hh); else at_online<0>(S, p0, p1, 0, 0, 0, true, hh);
      at_pv(vfr, p0, p1, S.o0, S.o1); });
    { const float lt = S.l + __shfl_xor(S.l, 32);
      if (hh == 0) { MREF[qrow] = S.m + 64.f; LS[w * 32 + r] = lt * k64; } }
#define SLOT_WRITE(x, o0_, o1_, scale_) do { unsigned char* sp_ = SLOT + (x) * 8192 + r * 256; \
      _Pragma("unroll") for (int gi_ = 0; gi_ < 4; ++gi_) { \
        const f32x4 va_ = {o0_[4 * gi_] * (scale_), o0_[4 * gi_ + 1] * (scale_), o0_[4 * gi_ + 2] * (scale_), o0_[4 * gi_ + 3] * (scale_)}; \
        const f32x4 vb_ = {o1_[4 * gi_] * (scale_), o1_[4 * gi_ + 1] * (scale_), o1_[4 * gi_ + 2] * (scale_), o1_[4 * gi_ + 3] * (scale_)}; \
        *(f32x4*)(sp_ + (((2 * gi_ + hh) ^ (r & 15)) * 16)) = va_; *(f32x4*)(sp_ + (((8 + 2 * gi_ + hh) ^ (r & 15)) * 16)) = vb_; } } while (0)
#define SLOT_READ(x, col_) (*(const f32x4*)(SLOT + (x) * 8192 + (col_) * 256 + ((ach ^ ((col_) & 15)) * 16)))
    SLOT_WRITE(w, S.o0, S.o1, k64);
    __syncthreads();
    }
    {
      AT_IDS; const int wu = __builtin_amdgcn_readfirstlane(w);
      const int nitems = MISC[0], nrounds = (nitems + 3) >> 2;
      if (wu >= 4) {
        const int ow = wu - 4, oq = lane >> 2, oh = lane & 3, srcslot = 2 * ow + (lane >> 5), scol = lane & 31;
        f32x4 acc[16]; float accl;
        { const unsigned char* rp = SLOT + srcslot * 8192 + scol * 256;
#pragma unroll
          for (int k = 0; k < 16; ++k) acc[k] = *(const f32x4*)(rp + ((k ^ (scol & 15)) * 16));
          accl = LS[srcslot * 32 + scol]; }
        __syncthreads();
        for (int rd = 0; rd <= nrounds; ++rd) {
          if (rd > 0) {
            const int set = (rd - 1) & 1;
            unsigned* ivp = (unsigned*)(INVQ + set * 256) + 16 * ow + oq;
            unsigned iv = *ivp;
            if (__any(iv != 0u)) {
              if (iv != 0u && oh == 0) *ivp = 0u;
              do {
                const int x = (iv & 0xffu) ? 0 : (iv & 0xff00u) ? 1 : (iv & 0xff0000u) ? 2 : 3;
                const unsigned byte = (iv >> (8 * x)) & 0xffu;
                iv &= ~(0xffu << (8 * x));
                if (byte) {
                  const int col = (int)(byte - 1) * 4 + oh;
                  const unsigned char* rp = SLOT + (set * 4 + x) * 8192 + col * 256;
                  f32x4 tq[16];
#pragma unroll
                  for (int k = 0; k < 16; ++k) tq[k] = *(const f32x4*)(rp + ((k ^ (col & 15)) * 16));
                  const float tl = LS[(set * 4 + x) * 32 + col];
                  __builtin_amdgcn_sched_barrier(0);
#pragma unroll
                  for (int k = 0; k < 16; ++k) acc[k] += tq[k];
                  accl += tl;
                }
              } while (__any(iv != 0u));
            }
          }
          __syncthreads();
        }
#pragma unroll
        for (int i = 0; i < 16; ++i) { S.o0[i] = otg(i); S.o1[i] = otg(16 + i); }
        SLOT_WRITE(w, S.o0, S.o1, 1.0f);
        __syncthreads();
        {
          const unsigned tq = (unsigned)b * SEQ + 64 * c + 16 * ow + oq;
          const float gs = gbase[tq * 48 + 16 + g * 4 + oh]; const float sc = accl > 0.f ? gs / accl : 0.f;
          const unsigned char* rp = SLOT + srcslot * 8192 + scol * 256;
          bf16_t* op = attn + (tq * DM + (g * 4 + oh) * 64);
#pragma unroll
          for (int k2 = 0; k2 < 8; ++k2) {
            const f32x4 v0 = acc[2 * k2] * sc + *(const f32x4*)(rp + (((2 * k2) ^ (scol & 15)) * 16)), v1 = acc[2 * k2 + 1] * sc + *(const f32x4*)(rp + (((2 * k2 + 1) ^ (scol & 15)) * 16));
            u32x4 o; o.x = pk2(v0.x, v0.y); o.y = pk2(v0.z, v0.w); o.z = pk2(v1.x, v1.y); o.w = pk2(v1.z, v1.w);
            *(u32x4*)(op + 8 * k2) = o;
          }
        }
      } else {
        __syncthreads();
        const bf16_t* kgl = kps + lane * 8; const bf16_t* vgl = vps + lane * 8;
        bf16x8 kfA[8], vfA[8], kfB[8], vfB[8];
#define FLOAD(KF, VF, jj) do { _Pragma("unroll") for (int f_ = 0; f_ < 8; ++f_) { KF[f_] = *(const bf16x8*)(kgl + (size_t)(jj) * 4096 + f_ * 512); VF[f_] = *(const bf16x8*)(vgl + (size_t)(jj) * 4096 + f_ * 512); } } while (0)
        int rowc = 0, qqc = 0; bool validc = false; float mrc = 1e30f; int en = 0;
        if (wu < nitems) { const int e0 = ITEMS[wu]; const int j0_ = e0 >> 3; const int qs_ = 8 * (e0 & 7) + (r >> 2); validc = qs_ < NJ[j0_]; qqc = QL[j0_ * 64 + qs_]; rowc = qqc * 4 + h; mrc = validc ? MREF[rowc] : 1e30f; FLOAD(kfA, vfA, j0_); }
        if (wu + 4 < nitems) en = __builtin_amdgcn_readfirstlane(ITEMS[wu + 4]);
        FLOAD(kfB, vfB, en >> 3);
#define ITEM_ROUND(KF, VF, rd_) do { \
          const int it = (rd_) * 4 + wu, set = (rd_) & 1; \
          if (it < nitems) { \
            const bool hasn = it + 4 < nitems; \
            const int jn = en >> 3, qsn = 8 * (en & 7) + (r >> 2);        \
            bf16x8 qv[4];                                               \
            _Pragma("unroll") for (int ds = 0; ds < 4; ++ds) qv[ds] = *(const bf16x8*)(lds + AT_QS + rowc * 128 + (((ds * 2 + hh) ^ (rowc & 7)) * 16)); \
            const int njn = NJ[jn]; const int qqn = QL[jn * 64 + qsn]; \
            const int en2 = it + 8 < nitems ? __builtin_amdgcn_readfirstlane(ITEMS[it + 8]) : 0; const int j2 = en2 >> 3; \
            __builtin_amdgcn_sched_barrier(0); \
            const f32x16 z = {0.f, 0.f, 0.f, 0.f, 0.f, 0.f, 0.f, 0.f, 0.f, 0.f, 0.f, 0.f, 0.f, 0.f, 0.f, 0.f}; \
            _Pragma("unroll") for (int ds = 0; ds < 4; ++ds) { \
              if (ds == 0) { p0 = MFMA32(KF[0], qv[0], z); p1 = MFMA32(KF[4], qv[0], z); } else { p0 = MFMA32(KF[ds], qv[ds], p0); p1 = MFMA32(KF[4 + ds], qv[ds], p1); } \
            } \
            const bool validn = hasn && qsn < njn; const int rown = qqn * 4 + h; \
            const float mrn = validn ? MREF[rown] : 1e30f; \
            float rs = 0.f; \
            _Pragma("unroll") for (int i = 0; i < 16; ++i) { \
              p0[i] = __builtin_amdgcn_exp2f(fminf(p0[i] - mrc, 120.f)); p1[i] = __builtin_amdgcn_exp2f(fminf(p1[i] - mrc, 120.f)); rs += p0[i] + p1[i]; \
              if (i & 1) { KF[i >> 1] = *(const bf16x8*)(kgl + (size_t)j2 * 4096 + (i >> 1) * 512); __builtin_amdgcn_sched_barrier(0); } \
            } \
            rs += __shfl_xor(rs, 32); \
            f32x16 o0 = z, o1 = z; \
            _Pragma("unroll") for (int gk = 0; gk < 4; ++gk) { const bf16x8 pb = (gk < 2) ? pack8(p0, gk & 1) : pack8(p1, gk & 1); o0 = MFMA32(VF[gk], pb, o0); o1 = MFMA32(VF[4 + gk], pb, o1); } \
            { unsigned char* sp_ = SLOT + (set * 4 + wu) * 8192 + r * 256; \
              _Pragma("unroll") for (int gi = 0; gi < 4; ++gi) { \
                const f32x4 va_ = {o0[4 * gi], o0[4 * gi + 1], o0[4 * gi + 2], o0[4 * gi + 3]}; const f32x4 vb_ = {o1[4 * gi], o1[4 * gi + 1], o1[4 * gi + 2], o1[4 * gi + 3]}; \
                *(f32x4*)(sp_ + (((2 * gi + hh) ^ (r & 15)) * 16)) = va_; *(f32x4*)(sp_ + (((8 + 2 * gi + hh) ^ (r & 15)) * 16)) = vb_; \
                VF[2 * gi] = *(const bf16x8*)(vgl + (size_t)j2 * 4096 + (2 * gi) * 512); VF[2 * gi + 1] = *(const bf16x8*)(vgl + (size_t)j2 * 4096 + (2 * gi + 1) * 512); \
                __builtin_amdgcn_sched_barrier(0); \
              } } \
            if (hh == 0) LS[(set * 4 + wu) * 32 + r] = rs; \
            if (validc && h == 0 && hh == 0) INVQ[set * 256 + qqc * 4 + wu] = (unsigned char)((r >> 2) + 1); \
            rowc = rown; qqc = qqn; validc = validn; mrc = mrn; en = en2; \
          } } while (0)
        for (int rd = 0; rd < nrounds; rd += 2) {
          ITEM_ROUND(kfA, vfA, rd);
          __syncthreads();
          if (rd + 1 < nrounds) {
            ITEM_ROUND(kfB, vfB, rd + 1);
            __syncthreads();
          }
        }
#undef ITEM_ROUND
#undef FLOAD
#undef ITEM_META
#undef KLOAD
#undef VLOAD
        __syncthreads();
#pragma unroll
        for (int i = 0; i < 16; ++i) { S.o0[i] = otg(i); S.o1[i] = otg(16 + i); }
        SLOT_WRITE(w, S.o0, S.o1, 1.0f);
        __syncthreads();
      }
    }
#undef SLOT_WRITE
#undef SLOT_READ
  }
  __syncthreads();
#undef ST_LOAD
#undef ST_STORE
#undef SWEEP
#undef ST_LOADF
#undef ST_STOREF
#undef SWEEPF
#undef gates
#undef otg
#undef QF_LOAD
#undef AT_QKV
#undef AT_IDS
}
DI void phase_attn(const Params& P_, unsigned char* lds) {
  Params P = P_; { size_t z_ = 0; asm volatile("" : "+s"(z_)); P.ws = P_.ws + z_; }
  const int G = gridDim.x, bx = obid();
  const int vcu = (G % 8 == 0) ? (bx % 8) * (G / 8) + bx / 8 : bx;
  for (int idx = vcu; idx < 1024; idx += G) {
    const int i = idx >> 8, v = idx & 255, bg = v >> 5, s = v & 31;
    const int c = i == 0 ? s : i == 1 ? 63 - s : i == 2 ? 64 + s : 127 - s;
    attn_tile(P, lds, bg >> 2, bg & 3, c);
  }
}


#define LAS __attribute__((address_space(3)))
#define XB_TMO      128
#define XB_XCNT(j)  (256  + 64 * (j))
#define XB_XSUB(j)  (1280 + 64 * (j))
#define XB_XGEN(j)  (2304 + 64 * (j))
#define XB_TOP      3328
#define XB_TOPGEN   3392
#define XCD_BAR_WORDS 3456
#define XB_SPIN_CAP (1u << 18)
__device__ __forceinline__ unsigned xb_ld(unsigned* p)              { return __hip_atomic_load(p, __ATOMIC_RELAXED, __HIP_MEMORY_SCOPE_AGENT); }
__device__ __forceinline__ unsigned xb_add(unsigned* p, unsigned v) { return __hip_atomic_fetch_add(p, v, __ATOMIC_RELAXED, __HIP_MEMORY_SCOPE_AGENT); }
__device__ __forceinline__ unsigned xb_xcc_id() { return (unsigned)__builtin_amdgcn_s_getreg((3 << 11) | 20) & 0xFu; }
#define XB_SPIN(cond, bar) do { unsigned _sp = 0; while (cond) { __builtin_amdgcn_s_sleep(1); \
    if ((++_sp & 255u) == 0u) { if (xb_ld(&(bar)[XB_TMO])) break; if (_sp > XB_SPIN_CAP) { atomicAdd(&(bar)[XB_TMO], 1u); break; } } } } while (0)
struct XcdBarrier { unsigned* bar; unsigned x; volatile LAS unsigned* st; };
__device__ __forceinline__ XcdBarrier xcd_barrier_post(unsigned* bar, volatile LAS unsigned* st) {
    XcdBarrier b; b.bar = bar; b.x = xb_xcc_id(); b.st = st;
    if (threadIdx.x == 0) (void)xb_add(&bar[XB_XCNT(b.x)], 1u);
    return b;
}
__device__ __forceinline__ void xcd_barrier_complete(unsigned* bar, unsigned x, unsigned& nloc, unsigned& nx) {
    const unsigned G = gridDim.x * gridDim.y * gridDim.z;
    unsigned sum, cnt, mine, sp = 0u;
    for (;;) {
        sum = 0u; cnt = 0u; mine = 0u;
#pragma unroll
        for (unsigned j = 0; j < 16; ++j) { const unsigned c = xb_ld(&bar[XB_XCNT(j)]); sum += c; cnt += (c > 0u) ? 1u : 0u; mine = (j == x) ? c : mine; }
        if (sum == G) break;
        __builtin_amdgcn_s_sleep(1);
        if ((++sp & 255u) == 0u) { if (xb_ld(&bar[XB_TMO])) break; if (sp > XB_SPIN_CAP) { atomicAdd(&bar[XB_TMO], 1u); break; } }
    }
    nloc = mine > 0u ? mine : 1u; nx = cnt > 0u ? cnt : 1u;
}
__device__ __forceinline__ void xcd_barrier(const XcdBarrier& b) {
    asm volatile("s_waitcnt vmcnt(0)" ::: "memory");
    __syncthreads();
    if (threadIdx.x == 0) {
        unsigned* bar = b.bar; { size_t z_ = 0; asm volatile("" : "+s"(z_)); bar += z_; }
        __builtin_amdgcn_s_waitcnt(0);
        unsigned nloc = b.st[0], nx = b.st[1];
        if (nloc == 0u) { xcd_barrier_complete(bar, b.x, nloc, nx); b.st[0] = nloc; b.st[1] = nx; }
        const unsigned old = xb_add(&bar[XB_XSUB(b.x)], 1u);
        const unsigned gen = old / nloc;
        if (old + 1u == (gen + 1u) * nloc) {
            __builtin_amdgcn_fence(__ATOMIC_RELEASE, "agent");
            asm volatile("s_waitcnt vmcnt(0)" ::: "memory");
            const unsigned og = xb_add(&bar[XB_TOP], 1u);
            const unsigned tg = og / nx;
            if (og + 1u == (tg + 1u) * nx) xb_add(&bar[XB_TOPGEN], 1u);
            else XB_SPIN(xb_ld(&bar[XB_TOPGEN]) == tg, bar);
            __builtin_amdgcn_fence(__ATOMIC_ACQUIRE, "agent");
            xb_add(&bar[XB_XGEN(b.x)], 1u);
            asm volatile("s_waitcnt vmcnt(0)" ::: "memory");
        } else {
            XB_SPIN(xb_ld(&bar[XB_XGEN(b.x)]) == gen, bar);
            __builtin_amdgcn_fence(__ATOMIC_ACQUIRE, "agent");
            asm volatile("s_waitcnt vmcnt(0)" ::: "memory");
        }
    }
    __syncthreads();
}

__global__ void __launch_bounds__(NTHR) fwd_kernel(Params P) {
  extern __shared__ __attribute__((aligned(16))) unsigned char lds[];
  cg::grid_group grid = cg::this_grid();
  const int gtid = blockIdx.x * NTHR + threadIdx.x;
  if (threadIdx.x < 4) ((unsigned*)(lds + LDS_BYTES - 16))[threadIdx.x] = 0u;
  __syncthreads();
  const XcdBarrier xbar = xcd_barrier_post((unsigned*)(P.ws + WS_BAR), (volatile LAS unsigned*)(lds + LDS_BYTES - 16));
#define GSYNC() xcd_barrier(xbar)
  s5_params(P, gtid);
  {
    float* modb = (float*)(P.ws + WS_MOD); float* cbb = (float*)(P.ws + WS_CB);
    for (int it = blockIdx.x; it < 192 + 16; it += gridDim.x) {
      if (it < 192) { const int l = it / 96, j0 = (it % 96) * 64;
        gemv_item((float*)lds, P.in[2] + (size_t)l * DM * 6144, DM, 6144, j0, P.in[1], P.in[1] + DM, true, P.in[3] + l * 6144, modb + (size_t)(l * 2) * 6144, modb + (size_t)(l * 2 + 1) * 6144);
      } else { const int r = it - 192, l = r >> 3, kv = (r >> 2) & 1, j0 = (r & 3) * 64;
        gemv_item((float*)lds, P.in[17] + (size_t)(l * 2 + kv) * 2048 * 256, 2048, 256, j0, P.in[16] + (size_t)(l * 2 + kv) * 2048, nullptr, false, nullptr, cbb + (l * 2 + kv) * 256, nullptr);
      }
    }
  }
  for (int it = blockIdx.x; it < DEPTH * 32 * 6; it += gridDim.x) s5_tables(P, it / 192, (it % 192) / 6, it % 6, lds);
  convert_weights(P, 0, lds);
  grid.sync();
  for (int l = 0; l < DEPTH; ++l) {
    if (l == 0) norm_simple<0>(P, l); else { norm_simple<1>(P, l); convert_weights(P, 1, lds); }
    GSYNC();
#if EN_MIXER
    phase_inproj8(P, lds);
    GSYNC();
    phase_s5a(P, l, lds);
    __syncthreads();
#if EN_ATTN
    phase_gates(P, lds);
    __syncthreads();
    phase_cmp1(P, l, lds);
#endif
    GSYNC();
    s5_carry(P, l);
#if EN_ATTN
    phase_cmp2(P, lds);
#endif
    GSYNC();
#if EN_ATTN
    phase_attn(P, lds);
    __syncthreads();
#endif
    phase_s5c(P, l, lds);
    GSYNC();
    phase_glu(P, lds);
    GSYNC();
    phase_merge8(P, lds);
    GSYNC();
    phase_wout8(P, l, lds);
    GSYNC();
#else
    if (l == 0) { for (size_t i = (size_t)gtid * 4; i < (size_t)NT * DM; i += (size_t)gridDim.x * NTHR * 4) *(f32x4*)(P.out + i) = *(const f32x4*)(P.in[0] + i); GSYNC(); }
#endif
#if EN_MOE
    norm_route(P, l, lds);
    GSYNC();
    phase_moe1(P, l, lds);
    GSYNC();
    phase_moe2(P, l, lds);
    GSYNC();
#endif
  }
  norm_simple<3>(P, 0);
}

extern "C" void kernel_launch(void* const* d_in, const int* in_sizes, int n_in, void* d_out, int out_size, void* d_ws, size_t ws_size, hipStream_t stream) {
  static int grid = 0;
  if (grid == 0) {
    if (n_in != 30 || out_size != NT * DM || ws_size < WS_END2) { fprintf(stderr, "kernel_launch: unexpected shapes (n_in %d out %d ws %zu need %zu)\n", n_in, out_size, ws_size, (size_t)WS_END2); grid = -1; return; }
    int dev = 0, cus = 0, per_cu = 0;
    hipGetDevice(&dev);
    hipDeviceGetAttribute(&cus, hipDeviceAttributeMultiprocessorCount, dev);
    hipFuncSetAttribute((const void*)fwd_kernel, hipFuncAttributeMaxDynamicSharedMemorySize, LDS_BYTES);
    hipOccupancyMaxActiveBlocksPerMultiprocessor(&per_cu, (const void*)fwd_kernel, NTHR, LDS_BYTES);
    if (per_cu < 1) { fprintf(stderr, "kernel_launch: occupancy query says %d blocks/CU\n", per_cu); per_cu = 1; }
    grid = cus;
    (void)hipGetLastError();
  }
  if (grid < 0) return;
  Params p{};
  for (int i = 0; i < 30; ++i) p.in[i] = (const float*)d_in[i];
  p.out = (float*)d_out; p.ws = (unsigned char*)d_ws;
  if (hipMemsetAsync(p.ws, 0, WS_ZERO_BYTES, stream) != hipSuccess) { fprintf(stderr, "kernel_launch: memset failed\n"); return; }
  void* args[] = {&p};
  hipError_t e = hipLaunchCooperativeKernel((const void*)fwd_kernel, dim3(grid), dim3(NTHR), args, LDS_BYTES, stream);
  if (e != hipSuccess) fprintf(stderr, "cooperative launch failed: %s (grid %d)\n", hipGetErrorString(e), grid);
}
```

```cpp
#include <hip/hip_runtime.h>
#include <hip/hip_cooperative_groups.h>
#include <cstdio>
#include <cstdint>
namespace cg = cooperative_groups;

#ifndef EN_MIXER
#define EN_MIXER 1
#endif
#ifndef EN_ATTN
#define EN_ATTN 1
#endif
#ifndef EN_MOE
#define EN_MOE 1
#endif

#define DI __device__ __forceinline__
typedef unsigned short bf16_t;
typedef short bf16x8 __attribute__((ext_vector_type(8)));
typedef short s16x4 __attribute__((ext_vector_type(4)));
typedef float f32x4 __attribute__((ext_vector_type(4)));
typedef float f32x16 __attribute__((ext_vector_type(16)));
typedef unsigned u32x4 __attribute__((ext_vector_type(4)));
typedef unsigned u32x2 __attribute__((ext_vector_type(2)));

constexpr int DM = 1024, NB = 2, SEQ = 8192, NT = NB * SEQ, DEPTH = 2;
constexpr int INW = 5168, INWP = 5376;
constexpr int NTHR = 512, NWAVE = 8;
constexpr int NEXP = 32, LISTCAP = 16384;
constexpr float EPS = 1e-6f;
constexpr float QSCALE = 0.125f * 1.4426950408889634f;

constexpr size_t MiB = 1u << 20;
constexpr size_t WS_CNT = 0;
constexpr size_t WS_BAR = 1024;
constexpr size_t WS_ZERO_BYTES = 16384;
constexpr size_t WS_MOD = 16384;
constexpr size_t WS_CB = WS_MOD + 2 * 2 * 6144 * 4;
constexpr size_t WS_S5P = WS_CB + 2 * 2 * 256 * 4;
constexpr size_t WS_WT = WS_S5P + 2 * 32 * 64 * 36 * 4;
constexpr size_t WS_SMALL_END = WS_WT + (size_t)NT * 2 * 4;
static_assert(WS_SMALL_END <= 1 * MiB, "small region");
constexpr size_t WS_W = 1 * MiB;
constexpr size_t W_IN = 0;
constexpr size_t W_GLU = W_IN + (size_t)INWP * 1024 * 2;
constexpr size_t W_O = W_GLU + 512 * 512 * 2;
constexpr size_t W_SO = W_O + 1024 * 1024 * 2;
constexpr size_t W_OUT = W_SO + 1024 * 512 * 2;
constexpr size_t W_C1 = W_OUT + 1024 * 1024 * 2;
constexpr size_t W_C2 = W_C1 + 2 * 256 * 2048 * 2;
constexpr size_t W_GU = W_C2 + 2 * 128 * 256 * 2;
constexpr size_t W_D = W_GU + (size_t)32 * 512 * 1024 * 2;
constexpr size_t W_END = W_D + (size_t)32 * 1024 * 256 * 2;
static_assert(W_END <= 67 * MiB, "weights region");
constexpr size_t WS_A = 68 * MiB;
constexpr size_t WS_B = WS_A + 32 * MiB;
constexpr size_t WS_C = WS_B + 32 * MiB;
constexpr size_t WS_DV = WS_C + 32 * MiB;
constexpr size_t WS_E = WS_DV + 16 * MiB;
constexpr size_t WS_F = WS_E + 32 * MiB;
constexpr size_t WS_G = WS_F + 64 * MiB;
constexpr size_t WS_GATES = WS_G + 16 * MiB;
constexpr size_t WS_HID = WS_GATES + 3 * MiB;
constexpr size_t WS_KC = WS_HID + 4 * MiB;
constexpr size_t WS_VC = WS_KC + 512 * 1024;
constexpr size_t WS_L = WS_VC + 512 * 1024;
constexpr size_t WS_LIST = WS_L + 4 * MiB;
constexpr size_t WS_OT = WS_LIST + 2 * MiB;
constexpr size_t WS_TAB = WS_OT + 16 * MiB;
constexpr size_t TAB_KT = 0, TAB_M1 = 1 * MiB, TAB_M2 = 9 * MiB, TAB_LAYER = 17 * MiB;
constexpr size_t WS_END = WS_TAB + 2 * TAB_LAYER;
constexpr size_t WS_KSF = WS_END;
constexpr size_t WS_END2 = WS_KSF + 8 * MiB;
constexpr size_t WS_SIN = WS_E + 16 * MiB;
constexpr int LDS_BYTES = 151552;

struct Params { const float* in[30]; float* out; unsigned char* ws; };

DI int otid() { int t = threadIdx.x; asm volatile("" : "+v"(t)); return t; }
DI int obid() { int t = blockIdx.x; asm volatile("" : "+s"(t)); return t; }
DI unsigned f2bf(float f) { unsigned u = __float_as_uint(f); return (u + 0x7fffu + ((u >> 16) & 1u)) >> 16; }
typedef float f32x2_t __attribute__((ext_vector_type(2))); typedef __bf16 bf16x2_t __attribute__((ext_vector_type(2)));
DI unsigned pk2(float lo, float hi) { const f32x2_t v = {lo, hi}; const bf16x2_t b = __builtin_convertvector(v, bf16x2_t); return __builtin_bit_cast(unsigned, b); }
DI float bflo(unsigned w) { return __uint_as_float(w << 16); }
DI float bfhi(unsigned w) { return __uint_as_float(w & 0xffff0000u); }
DI int perm16(int x) { return (x & ~12) | ((x & 4) << 1) | ((x & 8) >> 1); }
DI float wave_sum(float v) {
#pragma unroll
  for (int o = 1; o < 64; o <<= 1) v += __shfl_xor(v, o);
  return v;
}
DI float sigmoidf_(float x) { return 1.f / (1.f + __expf(-x)); }
DI float gelu_tanh(float x) {
  const float z = 0.7978845608028654f * (x + 0.044715f * x * x * x);
  const float e = __expf(2.f * z);
  const float th = 1.f - 2.f / (e + 1.f);
  return 0.5f * x * (1.f + th);
}
DI void sincos_d(double x, double& s, double& c) {
  const double k = rint(x * 0.6366197723675814);
  double r = fma(-k, 1.5707963267948966, x);
  r = fma(-k, 6.123233995736766e-17, r);
  const int q = ((int)k) & 3;
  const double r2 = r * r;
  const double sp = r * (1.0 + r2 * (-1.0 / 6 + r2 * (1.0 / 120 + r2 * (-1.0 / 5040 + r2 * (1.0 / 362880 + r2 * (-1.0 / 39916800 + r2 * (1.0 / 6227020800.0)))))));
  const double cp = 1.0 + r2 * (-0.5 + r2 * (1.0 / 24 + r2 * (-1.0 / 720 + r2 * (1.0 / 40320 + r2 * (-1.0 / 3628800 + r2 * (1.0 / 479001600 + r2 * (-1.0 / 87178291200.0)))))));
  s = (q == 0) ? sp : (q == 1) ? cp : (q == 2) ? -sp : -cp;
  c = (q == 0) ? cp : (q == 1) ? -sp : (q == 2) ? -cp : sp;
}

DI void gemv_item(float* lds, const float* W, int K, int N, int j0, const float* v0, const float* v1, bool do_silu, const float* bias, float* o0, float* o1) {
  const int tid = otid();
  float* sv = lds; float* red = lds + 4096;
  for (int k = tid; k < K; k += NTHR) {
    float a = v0[k], b = v1 ? v1[k] : 0.f;
    if (do_silu) { a = a / (1.f + expf(-a)); b = b / (1.f + expf(-b)); }
    sv[k] = a; sv[2048 + k] = b;
  }
  __syncthreads();
  const int jl = tid & 63, ks = tid >> 6, kper = K >> 3;
  const float* wp = W + (size_t)(ks * kper) * N + j0 + jl;
  float a0 = 0.f, a1 = 0.f;
#pragma unroll 8
  for (int k = 0; k < kper; ++k) { const float w = wp[(size_t)k * N]; a0 += sv[ks * kper + k] * w; a1 += sv[2048 + ks * kper + k] * w; }
  red[(ks * 64 + jl) * 2] = a0; red[(ks * 64 + jl) * 2 + 1] = a1;
  __syncthreads();
  if (tid < 64) {
    float s0 = 0.f, s1 = 0.f;
    for (int i = 0; i < 8; ++i) { s0 += red[(i * 64 + tid) * 2]; s1 += red[(i * 64 + tid) * 2 + 1]; }
    const float bb = bias ? bias[j0 + tid] : 0.f;
    o0[j0 + tid] = s0 + bb; if (o1) o1[j0 + tid] = s1 + bb;
  }
  __syncthreads();
}

DI void s5_params(const Params& P, int gtid) {
  if (gtid >= DEPTH * 32 * 64) return;
  const int l = gtid / 2048, g = (gtid / 64) % 32, p = gtid % 64;
  const float dt = expf(P.in[8][l * 32 + g]);
  const float lr = P.in[6][(l * 32 + g) * 64 + p], li = P.in[7][(l * 32 + g) * 64 + p];
  const float mag = expf(lr * dt); const float ang = li * dt;
  double sd, cd; sincos_d((double)ang, sd, cd);
  const float ab_re = mag * (float)cd, ab_im = mag * (float)sd;
  float* o = (float*)(P.ws + WS_S5P) + (size_t)((l * 32 + g) * 64 + p) * 36;
  o[0] = ab_re; o[1] = ab_im;
  double pr = ab_re, pi = ab_im;
  for (int i = 0; i < 6; ++i) { const double nr2 = pr * pr - pi * pi, ni2 = 2.0 * pr * pi; pr = nr2; pi = ni2; }
  o[2] = (float)pr; o[3] = (float)pi;
}

DI void s5_tables(const Params& P, int l, int g, int part, unsigned char* lds) {
  const int tid = otid(), lane = tid & 63;
  float* BBr = (float*)lds; float* BBi = BBr + 1024; float* CR = BBi + 1024; float* CI = CR + 1024;
  float* APr = CI + 1024; float* APi = APr + 65 * 64;
  bf16_t* tab = (bf16_t*)(P.ws + WS_TAB + (size_t)l * TAB_LAYER);
  bf16_t* Kt = tab + TAB_KT / 2 + (size_t)g * 64 * 256; bf16_t* M1 = tab + TAB_M1 / 2 + (size_t)g * 128 * 1024; bf16_t* M2 = tab + TAB_M2 / 2 + (size_t)g * 1024 * 128;
  __syncthreads();
  if (tid < 64) {
    const int p = tid;
    const float dt = expf(P.in[8][l * 32 + g]);
    const float lr = P.in[6][(l * 32 + g) * 64 + p], li = P.in[7][(l * 32 + g) * 64 + p];
    const float mag = expf(lr * dt); const float ang = li * dt;
    double sd, cd; sincos_d((double)ang, sd, cd);
    const float ab_re = mag * (float)cd, ab_im = mag * (float)sd;
    const float den = lr * lr + li * li, nr = ab_re - 1.0f;
    const float cr = (nr * lr + ab_im * li) / den, ci = (ab_im * lr - nr * li) / den;
    const float* br = P.in[9] + (size_t)((l * 32 + g) * 64 + p) * 16; const float* bi = P.in[10] + (size_t)((l * 32 + g) * 64 + p) * 16;
    for (int h = 0; h < 16; ++h) { BBr[p * 16 + h] = cr * br[h] - ci * bi[h]; BBi[p * 16 + h] = cr * bi[h] + ci * br[h]; }
    double pr = 1.0, pi = 0.0;
    for (int tau = 0; tau <= 64; ++tau) { APr[tau * 64 + p] = (float)pr; APi[tau * 64 + p] = (float)pi; const double n1 = pr * ab_re - pi * ab_im, n2 = pr * ab_im + pi * ab_re; pr = n1; pi = n2; }
  }
  for (int i = tid; i < 1024; i += NTHR) { CR[i] = P.in[11][(size_t)(l * 32 + g) * 1024 + i]; CI[i] = P.in[12][(size_t)(l * 32 + g) * 1024 + i]; }
  __syncthreads();
  if (part < 4)
  for (int task = part * 256 + tid; task < part * 256 + 256; task += NTHR) {
    const int tau = task >> 4, h = task & 15;
    float a[16];
#pragma unroll
    for (int j = 0; j < 16; ++j) a[j] = 0.f;
    for (int p = 0; p < 64; ++p) {
      const float c_r = CR[h * 64 + p], c_i = CI[h * 64 + p], a_r = APr[tau * 64 + p], a_i = APi[tau * 64 + p];
      const float xr = c_r * a_r - c_i * a_i, xi = c_r * a_i + c_i * a_r;
#pragma unroll
      for (int j4 = 0; j4 < 4; ++j4) { const f32x4 b_r = *(const f32x4*)(BBr + p * 16 + 4 * j4), b_i = *(const f32x4*)(BBi + p * 16 + 4 * j4);
        a[4 * j4] += xr * b_r.x - xi * b_i.x; a[4 * j4 + 1] += xr * b_r.y - xi * b_i.y; a[4 * j4 + 2] += xr * b_r.z - xi * b_i.z; a[4 * j4 + 3] += xr * b_r.w - xi * b_i.w; }
    }
    u32x4 o0, o1; o0.x = pk2(a[0], a[1]); o0.y = pk2(a[2], a[3]); o0.z = pk2(a[4], a[5]); o0.w = pk2(a[6], a[7]); o1.x = pk2(a[8], a[9]); o1.y = pk2(a[10], a[11]); o1.z = pk2(a[12], a[13]); o1.w = pk2(a[14], a[15]);
    *(u32x4*)(Kt + (size_t)task * 16) = o0; *(u32x4*)(Kt + (size_t)task * 16 + 8) = o1;
  }
  if (part == 4)
  for (int task = tid; task < 4096; task += NTHR) {
    const int p = task >> 6, i = task & 63;
    const float a_r = APr[(63 - i) * 64 + p], a_i = APi[(63 - i) * 64 + p];
    float re[16], im[16];
#pragma unroll
    for (int j = 0; j < 16; ++j) { const float b_r = BBr[p * 16 + j], b_i = BBi[p * 16 + j]; re[j] = a_r * b_r - a_i * b_i; im[j] = a_r * b_i + a_i * b_r; }
    u32x4 o; bf16_t* d0 = M1 + (size_t)(2 * p) * 1024 + i * 16; bf16_t* d1 = d0 + 1024;
    o.x = pk2(re[0], re[1]); o.y = pk2(re[2], re[3]); o.z = pk2(re[4], re[5]); o.w = pk2(re[6], re[7]); *(u32x4*)d0 = o;
    o.x = pk2(re[8], re[9]); o.y = pk2(re[10], re[11]); o.z = pk2(re[12], re[13]); o.w = pk2(re[14], re[15]); *(u32x4*)(d0 + 8) = o;
    o.x = pk2(im[0], im[1]); o.y = pk2(im[2], im[3]); o.z = pk2(im[4], im[5]); o.w = pk2(im[6], im[7]); *(u32x4*)d1 = o;
    o.x = pk2(im[8], im[9]); o.y = pk2(im[10], im[11]); o.z = pk2(im[12], im[13]); o.w = pk2(im[14], im[15]); *(u32x4*)(d1 + 8) = o;
  }
  if (part == 5)
  for (int task = tid; task < 4096; task += NTHR) {
    const int th = task >> 2, pq = task & 3, t = th >> 4, h = th & 15;
    unsigned w[16];
#pragma unroll
    for (int j = 0; j < 16; ++j) { const int p = pq * 16 + j;
      const float c_r = CR[h * 64 + p], c_i = CI[h * 64 + p], a_r = APr[(t + 1) * 64 + p], a_i = APi[(t + 1) * 64 + p];
      w[j] = pk2(c_r * a_r - c_i * a_i, -(c_r * a_i + c_i * a_r)); }
    bf16_t* d = M2 + (size_t)th * 128 + pq * 32;
    *(u32x4*)d = (u32x4){w[0], w[1], w[2], w[3]}; *(u32x4*)(d + 8) = (u32x4){w[4], w[5], w[6], w[7]};
    *(u32x4*)(d + 16) = (u32x4){w[8], w[9], w[10], w[11]}; *(u32x4*)(d + 24) = (u32x4){w[12], w[13], w[14], w[15]};
  }
  __syncthreads();
}

struct ConvJob { const float* src; bf16_t* dst; int ldw, K, c0, ncols, nmat, ldd, drow0, mode; size_t sstride, dstride; };
DI int conv_nitems(const ConvJob& j) { return j.nmat * (j.K >> 6) * ((j.ncols + 31) >> 5); }
DI int conv_drow(int mode, int drow0, int n) { return mode == 0 ? drow0 + n : drow0 + ((n >> 6) * 128 + ((n >> 4) & 3) * 32 + (n & 15)); }
DI void conv_item(const ConvJob& jb, int item, float* scr, int lane) {
  const int nblk = (jb.ncols + 31) >> 5, per = (jb.K >> 6) * nblk;
  const int mat = item / per, r = item % per, kb = r / nblk, nb = r % nblk, k0 = 64 * kb, n0 = 32 * nb;
  const float* W = jb.src + (size_t)mat * jb.sstride; bf16_t* WT = jb.dst + (size_t)mat * jb.dstride;
  const int n4 = (lane & 7) * 4; const bool nok = (n0 + n4) < jb.ncols;
#pragma unroll
  for (int i = 0; i < 8; ++i) { const int kk = 8 * i + (lane >> 3);
    const f32x4 v = nok ? *(const f32x4*)(W + (size_t)(k0 + kk) * jb.ldw + jb.c0 + n0 + n4) : (f32x4){0.f, 0.f, 0.f, 0.f};
    *(f32x4*)(scr + kk * 36 + n4) = v; }
  asm volatile("s_waitcnt lgkmcnt(0)" ::: "memory");
  const int c = lane & 7;
#pragma unroll
  for (int j = 0; j < 4; ++j) {
    const int n = (lane >> 3) + 8 * j; const float* sp = scr + (8 * c) * 36 + n;
    u32x4 o; o.x = pk2(sp[0], sp[36]); o.y = pk2(sp[72], sp[108]); o.z = pk2(sp[144], sp[180]); o.w = pk2(sp[216], sp[252]);
    if (n0 + n < jb.ncols) *(u32x4*)(WT + (size_t)conv_drow(jb.mode, jb.drow0, n0 + n) * jb.ldd + k0 + 8 * c) = o;
  }
  asm volatile("s_waitcnt lgkmcnt(0)" ::: "memory");
}
DI ConvJob conv_job(const Params& P, int l, int j) {
  unsigned char* wb = P.ws + WS_W; ConvJob J; J.nmat = 1; J.mode = 0; J.sstride = 0; J.dstride = 0; J.drow0 = 0; J.c0 = 0;
  const float* win = P.in[5] + (size_t)l * 1024 * INW;
  if (j < 5) { J.src = win; J.ldw = INW; J.K = 1024; J.dst = (bf16_t*)(wb + W_IN); J.ldd = 1024;
    if (j == 0) { J.c0 = 0; J.ncols = 1024; J.drow0 = 0; }
    else if (j == 1) { J.c0 = 1024; J.ncols = 1536; J.drow0 = 1024; }
    else if (j == 2) { J.c0 = 3120; J.ncols = 2048; J.drow0 = 2560; }
    else if (j == 3) { J.c0 = 2608; J.ncols = 512; J.drow0 = 4608; }
    else { J.c0 = 2560; J.ncols = 48; J.drow0 = 5120; }
  } else if (j == 5) { J.src = P.in[14] + (size_t)l * 512 * 512; J.ldw = 512; J.K = 512; J.ncols = 512; J.dst = (bf16_t*)(wb + W_GLU); J.ldd = 512; }
  else if (j == 6) { J.src = P.in[19] + (size_t)l * 1024 * 1024; J.ldw = 1024; J.K = 1024; J.ncols = 1024; J.dst = (bf16_t*)(wb + W_O); J.ldd = 1024; }
  else if (j == 7) { J.src = P.in[15] + (size_t)l * 512 * 1024; J.ldw = 1024; J.K = 512; J.ncols = 1024; J.dst = (bf16_t*)(wb + W_SO); J.ldd = 512; }
  else if (j == 8) { J.src = P.in[20] + (size_t)l * 1024 * 1024; J.ldw = 1024; J.K = 1024; J.ncols = 1024; J.dst = (bf16_t*)(wb + W_OUT); J.ldd = 1024; }
  else if (j == 9) { J.src = P.in[17] + (size_t)l * 2 * 2048 * 256; J.ldw = 256; J.K = 2048; J.ncols = 256; J.nmat = 2; J.sstride = 2048 * 256; J.dstride = 256 * 2048; J.dst = (bf16_t*)(wb + W_C1); J.ldd = 2048; }
  else if (j == 10) { J.src = P.in[18] + (size_t)l * 2 * 256 * 64; J.ldw = 64; J.K = 256; J.ncols = 64; J.nmat = 2; J.sstride = 256 * 64; J.dstride = 128 * 256; J.dst = (bf16_t*)(wb + W_C2); J.ldd = 256; }
  else if (j == 11) { J.src = P.in[26] + (size_t)l * 32 * 1024 * 256; J.ldw = 256; J.K = 1024; J.ncols = 256; J.nmat = 32; J.sstride = 1024 * 256; J.dstride = 512 * 1024; J.dst = (bf16_t*)(wb + W_GU); J.ldd = 1024; J.mode = 1; J.drow0 = 0; }
  else if (j == 12) { J.src = P.in[27] + (size_t)l * 32 * 1024 * 256; J.ldw = 256; J.K = 1024; J.ncols = 256; J.nmat = 32; J.sstride = 1024 * 256; J.dstride = 512 * 1024; J.dst = (bf16_t*)(wb + W_GU); J.ldd = 1024; J.mode = 1; J.drow0 = 16; }
  else { J.src = P.in[28] + (size_t)l * 32 * 256 * 1024; J.ldw = 1024; J.K = 256; J.ncols = 1024; J.nmat = 32; J.sstride = 256 * 1024; J.dstride = 1024 * 256; J.dst = (bf16_t*)(wb + W_D); J.ldd = 256; }
  return J;
}
DI void convert_weights(const Params& P_, int l, unsigned char* lds) {
  Params P = P_; { size_t z_ = 0; asm volatile("" : "+s"(z_)); P.ws = P_.ws + z_; }
  const int tid_ = otid(), bid = obid(), wave = tid_ >> 6, lane = tid_ & 63; (void)bid;
  float* scr = (float*)lds + wave * (64 * 36);
  const int NGW = gridDim.x * NWAVE; int off = bid * NWAVE + wave;
  for (int j = 0; j < 14; ++j) {
    const ConvJob J = conv_job(P, l, j); const int n = conv_nitems(J);
    while (off < n) { conv_item(J, off, scr, lane); off += NGW; }
    off -= n;
  }
}

template <int MODE>
DI void norm_simple(const Params& P_, int l) {
  Params P = P_; { size_t z_ = 0; asm volatile("" : "+s"(z_)); P.ws = P_.ws + z_; }
  const int tid_ = otid(), bid = obid(), wave = tid_ >> 6, lane = tid_ & 63; (void)bid;
  const int NGW = gridDim.x * NWAVE;
  const float* mod = (const float*)(P.ws + WS_MOD);
  const bf16_t* ys = (const bf16_t*)(P.ws + WS_F);
  bf16_t* xn = (bf16_t*)(P.ws + WS_A);
  const float* xbase = MODE == 0 ? P.in[0] : P.out;
  constexpr bool ADDY = (MODE != 0) && EN_MOE;
  f32x4 g[4], sh[4], sc[4], gg[4]; int pb = -1;
  { const float* gp = MODE == 3 ? P.in[29] : P.in[4] + (size_t)l * DM;
#pragma unroll
    for (int j = 0; j < 4; ++j) g[j] = *(const f32x4*)(gp + 4 * lane + 256 * j); }
  f32x4 v[4]; u32x2 y0[4], y1[4];
#define NS_LOAD(vv, a0, a1, rr) do { const float* xr_ = xbase + (size_t)(rr) * DM; \
    _Pragma("unroll") for (int j = 0; j < 4; ++j) vv[j] = *(const f32x4*)(xr_ + 4 * lane + 256 * j); \
    if (ADDY) { _Pragma("unroll") for (int j = 0; j < 4; ++j) { a0[j] = *(const u32x2*)(ys + (size_t)((rr) * 2) * DM + 4 * lane + 256 * j); a1[j] = *(const u32x2*)(ys + (size_t)((rr) * 2 + 1) * DM + 4 * lane + 256 * j); } } } while (0)
  const int row0 = bid * NWAVE + wave;
  if (row0 < NT) NS_LOAD(v, y0, y1, row0);
  for (int row = row0; row < NT; row += NGW) {
    const int b = row >> 13;
    if (b != pb) { pb = b;
      if (ADDY) { const float* g2 = mod + (size_t)(((MODE == 1 ? 0 : 1) * 2 + b) * 6144) + 5120;
#pragma unroll
        for (int j = 0; j < 4; ++j) gg[j] = *(const f32x4*)(g2 + 4 * lane + 256 * j); }
      if (MODE != 3) { const float* md = mod + (size_t)((l * 2 + b) * 6144);
#pragma unroll
        for (int j = 0; j < 4; ++j) { sh[j] = *(const f32x4*)(md + 4 * lane + 256 * j); sc[j] = *(const f32x4*)(md + 1024 + 4 * lane + 256 * j); } }
    }
    f32x4 vn[4]; u32x2 y0n[4], y1n[4];
    if (row + NGW < NT) NS_LOAD(vn, y0n, y1n, row + NGW);
    __builtin_amdgcn_sched_barrier(0);
    if (ADDY) {
#pragma unroll
      for (int j = 0; j < 4; ++j) {
        v[j].x += gg[j].x * (bflo(y0[j].x) + bflo(y1[j].x)); v[j].y += gg[j].y * (bfhi(y0[j].x) + bfhi(y1[j].x));
        v[j].z += gg[j].z * (bflo(y0[j].y) + bflo(y1[j].y)); v[j].w += gg[j].w * (bfhi(y0[j].y) + bfhi(y1[j].y));
      }
    }
    float ss = 0.f;
#pragma unroll
    for (int j = 0; j < 4; ++j) ss += v[j].x * v[j].x + v[j].y * v[j].y + v[j].z * v[j].z + v[j].w * v[j].w;
    ss = wave_sum(ss);
    const float inv = rsqrtf(ss * (1.f / DM) + EPS);
    if (MODE == 3) {
#pragma unroll
      for (int j = 0; j < 4; ++j) { const int col = 4 * lane + 256 * j; *(f32x4*)(P.out + (size_t)row * DM + col) = v[j] * inv * g[j]; }
    } else {
      if (MODE == 1) {
#pragma unroll
        for (int j = 0; j < 4; ++j) *(f32x4*)(P.out + (size_t)row * DM + 4 * lane + 256 * j) = v[j];
      }
#pragma unroll
      for (int j = 0; j < 4; ++j) {
        const int col = 4 * lane + 256 * j;
        const f32x4 h = v[j] * inv * g[j] * (sc[j] + 1.f) + sh[j];
        u32x2 o; o.x = pk2(h.x, h.y); o.y = pk2(h.z, h.w);
        *(u32x2*)(xn + (size_t)row * DM + col) = o;
      }
    }
#pragma unroll
    for (int j = 0; j < 4; ++j) { v[j] = vn[j]; y0[j] = y0n[j]; y1[j] = y1n[j]; }
  }
#undef NS_LOAD
}

constexpr int RT_HS = 1028;
DI void norm_route(const Params& P_, int l, unsigned char* lds) {
  Params P = P_; { size_t z_ = 0; asm volatile("" : "+s"(z_)); P.ws = P_.ws + z_; }
  const int tid = otid(), bid = obid(), wave = tid >> 6, lane = tid & 63;
  const float* mod = (const float*)(P.ws + WS_MOD);
  bf16_t* h2 = (bf16_t*)(P.ws + WS_A);
  float* hs = (float*)lds;
  float* Wc = (float*)lds + 32 * RT_HS;
  const float* wg = P.in[22] + (size_t)l * DM * 4; const float* we = P.in[24] + (size_t)l * DM * 32;
  const float* bg = P.in[23] + l * 4; const float* be = P.in[25] + l * 32;
  int* cnt = (int*)(P.ws + WS_CNT) + l * 32; int* list = (int*)(P.ws + WS_LIST); float* wts = (float*)(P.ws + WS_WT);
  const int rg = wave >> 2, kq = wave & 3;
  for (int grp = bid; grp < NT / 32; grp += gridDim.x) {
    const int row0 = grp * 32 + wave * 4, b = row0 >> 13;
    const float* ng = P.in[21] + (size_t)l * DM; const float* md = mod + (size_t)((l * 2 + b) * 6144);
    {
      f32x4 v[4][4];
#pragma unroll
      for (int r = 0; r < 4; ++r)
#pragma unroll
        for (int j = 0; j < 4; ++j) v[r][j] = *(const f32x4*)(P.out + (size_t)(row0 + r) * DM + 4 * lane + 256 * j);
      float inv[4];
#pragma unroll
      for (int r = 0; r < 4; ++r) { float ss = 0.f;
#pragma unroll
        for (int j = 0; j < 4; ++j) ss += v[r][j].x * v[r][j].x + v[r][j].y * v[r][j].y + v[r][j].z * v[r][j].z + v[r][j].w * v[r][j].w;
        inv[r] = rsqrtf(wave_sum(ss) * (1.f / DM) + EPS); }
#pragma unroll
      for (int j = 0; j < 4; ++j) {
        const int col = 4 * lane + 256 * j;
        const f32x4 g = *(const f32x4*)(ng + col), sh = *(const f32x4*)(md + 3072 + col), sc = *(const f32x4*)(md + 4096 + col);
#pragma unroll
        for (int r = 0; r < 4; ++r) {
          const f32x4 hh = v[r][j] * inv[r] * g * (sc + 1.f) + sh;
          u32x2 o; o.x = pk2(hh.x, hh.y); o.y = pk2(hh.z, hh.w);
          *(u32x2*)(h2 + (size_t)(row0 + r) * DM + col) = o;
          *(f32x4*)(hs + (wave * 4 + r) * RT_HS + col) = hh;
        }
      }
    }
    f32x4 we0, we1, wg0 = {0.f, 0.f, 0.f, 0.f};
#define WLOAD(kc) do { we0 = *(const f32x4*)(we + (size_t)(kc) * 4096 + tid * 4); we1 = *(const f32x4*)(we + (size_t)(kc) * 4096 + 2048 + tid * 4); if (tid < 128) wg0 = *(const f32x4*)(wg + (size_t)(kc) * 512 + tid * 4); } while (0)
#define WSTORE() do { *(f32x4*)(Wc + (tid >> 3) * 36 + (tid & 7) * 4) = we0; *(f32x4*)(Wc + (64 + (tid >> 3)) * 36 + (tid & 7) * 4) = we1; if (tid < 128) *(f32x4*)(Wc + tid * 36 + 32) = wg0; } while (0)
    WLOAD(0);
    f32x4 acc0 = {0.f, 0.f, 0.f, 0.f}, acc1 = acc0, acc2 = acc0;
    for (int kc = 0; kc < 8; ++kc) {
      __syncthreads();
      WSTORE();
      if (kc + 1 < 8) WLOAD(kc + 1);
      __syncthreads();
      const float* ap = hs + (rg * 16 + (lane & 15)) * RT_HS + kc * 128 + kq * 32 + (lane >> 4);
      const float* bp = Wc + (kq * 32 + (lane >> 4)) * 36 + (lane & 15);
#pragma unroll
      for (int ks = 0; ks < 8; ++ks) {
        const float av = ap[4 * ks];
        const float b0 = bp[(4 * ks) * 36], b1 = bp[(4 * ks) * 36 + 16], b2 = (lane & 15) < 4 ? bp[(4 * ks) * 36 + 32] : 0.f;
        acc0 = __builtin_amdgcn_mfma_f32_16x16x4f32(av, b0, acc0, 0, 0, 0);
        acc1 = __builtin_amdgcn_mfma_f32_16x16x4f32(av, b1, acc1, 0, 0, 0);
        acc2 = __builtin_amdgcn_mfma_f32_16x16x4f32(av, b2, acc2, 0, 0, 0);
      }
    }
#undef WLOAD
#undef WSTORE
    __syncthreads();
    {
      float* part = hs + kq * (32 * 40);
#pragma unroll
      for (int i = 0; i < 4; ++i) { const int row = rg * 16 + 4 * (lane >> 4) + i, col = lane & 15;
        part[row * 40 + col] = acc0[i]; part[row * 40 + 16 + col] = acc1[i]; if (col < 4) part[row * 40 + 32 + col] = acc2[i]; }
    }
    __syncthreads();
    if (tid < 32) {
      const int row = grp * 32 + tid;
      float L[36];
#pragma unroll
      for (int o = 0; o < 36; ++o) L[o] = (hs[tid * 40 + o] + hs[1280 + tid * 40 + o]) + (hs[2560 + tid * 40 + o] + hs[3840 + tid * 40 + o]);
      float gm = -1e30f; int gi = 0;
#pragma unroll
      for (int i = 0; i < 4; ++i) { const float v = L[32 + i] + bg[i]; if (v > gm) { gm = v; gi = i; } }
      float gs = 0.f;
#pragma unroll
      for (int i = 0; i < 4; ++i) gs += expf(L[32 + i] + bg[i] - gm);
      const float gp = 1.f / gs;
      float el[8];
#pragma unroll
      for (int i = 0; i < 8; ++i) el[i] = (gi == 0 ? L[i] : gi == 1 ? L[8 + i] : gi == 2 ? L[16 + i] : L[24 + i]) + be[gi * 8 + i];
      float em = -1e30f;
#pragma unroll
      for (int i = 0; i < 8; ++i) em = fmaxf(em, el[i]);
      float p1 = -1.f, p2 = -1.f; int i1 = 0, i2 = 0;
#pragma unroll
      for (int i = 0; i < 8; ++i) {
        const float pe = expf(el[i] - em);
        if (pe > p1) { p2 = p1; i2 = i1; p1 = pe; i1 = i; } else if (pe > p2) { p2 = pe; i2 = i; }
      }
      const float w1 = gp * p1 / (p1 + p2), w2 = gp * p2 / (p1 + p2);
      const int e1 = gi * 8 + i1, e2 = gi * 8 + i2;
      const int pos1 = atomicAdd(&cnt[e1], 1); list[e1 * LISTCAP + pos1] = row * 2; wts[row * 2] = w1;
      const int pos2 = atomicAdd(&cnt[e2], 1); list[e2 * LISTCAP + pos2] = row * 2 + 1; wts[row * 2 + 1] = w2;
    }
    __syncthreads();
  }
}

namespace pg8 {
#define PG8_LAS __attribute__((address_space(3)))
typedef unsigned short bf16_t;
typedef short bf16x8 __attribute__((ext_vector_type(8)));
typedef float f32x4 __attribute__((ext_vector_type(4)));
typedef unsigned u32x4 __attribute__((ext_vector_type(4)));
constexpr int BM = 256, BK = 64, HALF = 128, HTB = HALF * BK * 2  , STAGE_BYTES = 8 * HTB, NXCD = 8, WGM = 8;

__host__ __device__ __forceinline__ int lds_byte(int r, int c) { const int st = (r >> 4) * 2 + (c >> 5), rr = r & 15, cc = c & 31, ob = rr * 64 + cc * 2; return st * 1024 + (ob ^ (((ob >> 9) & 1) << 5)); }
__host__ __device__ __forceinline__ void stage_rc(int b, int& R, int& C) { const int st = b / 1024, sb = b % 1024, swz = sb ^ (((sb >> 9) & 1) << 5); R = (st >> 1) * 16 + swz / 64; C = (st & 1) * 32 + (swz % 64) / 2; }
__host__ __device__ __forceinline__ int perm32(int rho) { const int n = rho >> 4, i = rho & 15; return 8 * (i >> 2) + 4 * n + (i & 3); }

struct Unit { int pm, pn; };
struct Gemm { const bf16_t* A; const bf16_t* Bt; int M, N, K; };

struct StaticOrder {
    int nM, nN, nwg, G, c;
    __host__ __device__ void init(int M, int N, int G_, int c_) { nM = M / BM; nN = N / BM; nwg = nM * nN; G = G_; c = c_; }
    __host__ __device__ bool next(int i, Unit& u) const {
        const long L = (long)i * G + c; if (L >= nwg) return false;
        int wgid = (int)L; { const int q = nwg / NXCD, r = nwg % NXCD, xcd = wgid % NXCD, off = wgid / NXCD; wgid = (xcd < r ? xcd * (q + 1) : r * (q + 1) + (xcd - r) * q) + off; }
        const int nig = WGM * nN, gid = wgid / nig, fm = gid * WGM, gsz = (nM - fm) < WGM ? (nM - fm) : WGM;
        u.pm = fm + ((wgid % nig) % gsz); u.pn = (wgid % nig) / gsz; return true;
    }
    __device__ __forceinline__ void a_ready(const Unit&) const {}
    __device__ __forceinline__ void done(const Unit&) const {}
};
template <class Epi, class Sched, bool ALIGN_EPI = false, bool SP2 = false>
__device__ __forceinline__ void gemm_phase(PG8_LAS unsigned char* lds, const Gemm g, const Sched& S, const Epi& E) {
    const int tid = otid(), wid = __builtin_amdgcn_readfirstlane(tid >> 6), lane = tid & 63, wr = wid >> 2, wc = wid & 3, fr = lane & 15, fq = lane >> 4;
    const int K = g.K, nt = K / BK;
    unsigned voffA[2], voffB[2];
#pragma unroll
    for (int i = 0; i < 2; ++i) { int R, C; stage_rc(tid * 16 + i * 8192, R, C); const int Rb = Epi::PERM ? ((R & ~31) + perm32(R & 31)) : R;
        voffA[i] = (unsigned)(R * K + C) * 2u; voffB[i] = (unsigned)(Rb * K + C) * 2u; }
    const size_t kstep = (size_t)(BK * 2);
    const size_t hstep = (size_t)HALF * K * 2;
    const size_t tstep = 2 * hstep;
    const unsigned ldsw = (unsigned)wid * 1024u;
    const int aoff = lds_byte(wr * 64 + fr, fq * 8), boff = lds_byte(wc * 32 + fr, fq * 8);
#define PG8_SA(b, h) (((b) * 2 + (h)) * HTB)
#define PG8_SB(b, h) ((4 + (b) * 2 + (h)) * HTB)
#define PG8_STAGE(bufoff, gbase, voff) do { _Pragma("unroll") for (int _i = 0; _i < 2; ++_i) \
        __builtin_amdgcn_global_load_lds((const unsigned*)((const char*)(gbase) + (voff)[_i]), (PG8_LAS unsigned*)(lds + (bufoff) + ldsw + _i * 8192), 16, 0, 0); } while (0)
#define PG8_LDA(dst, b, h) do { _Pragma("unroll") for (int m = 0; m < 4; ++m) _Pragma("unroll") for (int k = 0; k < 2; ++k) dst[m][k] = *(const PG8_LAS bf16x8*)(lds + PG8_SA(b, h) + aoff + m * 2048 + k * 1024); } while (0)
#define PG8_LDB(dst, b, h) do { _Pragma("unroll") for (int n = 0; n < 2; ++n) _Pragma("unroll") for (int k = 0; k < 2; ++k) dst[n][k] = *(const PG8_LAS bf16x8*)(lds + PG8_SB(b, h) + boff + n * 2048 + k * 1024); } while (0)
#define PG8_MMA(ai, bj, At, Bt) do { __builtin_amdgcn_s_setprio(1); _Pragma("unroll") for (int m = 0; m < 4; ++m) _Pragma("unroll") for (int n = 0; n < 2; ++n) _Pragma("unroll") for (int k = 0; k < 2; ++k) \
        acc[ai][bj][m][n] = __builtin_amdgcn_mfma_f32_16x16x32_bf16(Bt[n][k], At[m][k], acc[ai][bj][m][n], 0, 0, 0); __builtin_amdgcn_s_setprio(0); } while (0)
#define PG8_WAIT_V(n) asm volatile("s_waitcnt vmcnt(" #n ")" ::: "memory")
#define PG8_WAIT_L(n) asm volatile("s_waitcnt lgkmcnt(" #n ")" ::: "memory")
#define PG8_BAR __builtin_amdgcn_s_barrier()
#define PG8_SCHED __builtin_amdgcn_sched_barrier(0)
    Unit cur, nxt; int ui = 0;
    if (!S.next(0, cur)) return;
    f32x4 acc[2][2][4][2];
#pragma unroll
    for (int a = 0; a < 2; ++a)
#pragma unroll
        for (int b = 0; b < 2; ++b)
#pragma unroll
            for (int m = 0; m < 4; ++m)
#pragma unroll
                for (int n = 0; n < 2; ++n) acc[a][b][m][n] = (f32x4){0.f, 0.f, 0.f, 0.f};
    bf16x8 At[4][2], B0[2][2], B1[2][2];
    const char* cA = (const char*)g.A + (size_t)cur.pm * tstep; const char* cB = (const char*)g.Bt + (size_t)cur.pn * tstep;
    S.a_ready(cur);
    if constexpr (SP2) {
        PG8_STAGE(PG8_SB(0, 0), cB, voffB); PG8_STAGE(PG8_SB(0, 1), cB + hstep, voffB); PG8_STAGE(PG8_SA(0, 0), cA, voffA); PG8_STAGE(PG8_SA(0, 1), cA + hstep, voffA);
        if (wr == 1) PG8_BAR;
        PG8_WAIT_V(2); PG8_BAR;
        PG8_STAGE(PG8_SB(1, 0), cB + kstep, voffB); PG8_STAGE(PG8_SA(1, 0), cA + kstep, voffA); PG8_STAGE(PG8_SB(1, 1), cB + hstep + kstep, voffB);
        PG8_WAIT_V(6); PG8_BAR;
    } else {
        PG8_STAGE(PG8_SB(0, 0), cB, voffB); PG8_STAGE(PG8_SA(0, 0), cA, voffA); PG8_STAGE(PG8_SB(0, 1), cB + hstep, voffB); PG8_STAGE(PG8_SA(0, 1), cA + hstep, voffA);
        if (wr == 1) PG8_BAR;
        PG8_WAIT_V(4); PG8_BAR;
        PG8_STAGE(PG8_SB(1, 0), cB + kstep, voffB); PG8_STAGE(PG8_SA(1, 0), cA + kstep, voffA); PG8_STAGE(PG8_SB(1, 1), cB + hstep + kstep, voffB);
        PG8_WAIT_V(6); PG8_BAR;
    }
    for (;;) {
        const bool has_next = S.next(ui + 1, nxt);
        const char* nA = has_next ? (const char*)g.A + (size_t)nxt.pm * tstep : cA; const char* nB = has_next ? (const char*)g.Bt + (size_t)nxt.pn * tstep : cB;
        for (int t = 0; t < nt; t += 2) {
            const bool last = (t == nt - 2);
            const char* a1 = cA + (size_t)(t + 1) * kstep;
            const char* a2 = last ? nA : cA + (size_t)(t + 2) * kstep; const char* b2 = last ? nB : cB + (size_t)(t + 2) * kstep;
            const char* a3 = a2 + kstep; const char* b3 = b2 + kstep;
            if (last && has_next) S.a_ready(nxt);
            if constexpr (SP2) {
            PG8_LDB(B0, 0, 0); PG8_LDB(B1, 0, 1); PG8_SCHED; PG8_LDA(At, 0, 0); PG8_STAGE(PG8_SA(1, 1), a1 + hstep, voffA);
            PG8_WAIT_V(8); PG8_WAIT_L(0); PG8_BAR; PG8_MMA(0, 0, At, B0); PG8_MMA(0, 1, At, B1); PG8_BAR; PG8_SCHED;
            PG8_LDA(At, 0, 1); PG8_STAGE(PG8_SB(0, 0), b2, voffB); PG8_STAGE(PG8_SB(0, 1), b2 + hstep, voffB); PG8_STAGE(PG8_SA(0, 0), a2, voffA);
            PG8_WAIT_V(8); PG8_WAIT_L(0); PG8_BAR; PG8_MMA(1, 0, At, B0); PG8_MMA(1, 1, At, B1); PG8_BAR; PG8_SCHED;
            PG8_LDB(B0, 1, 0); PG8_LDB(B1, 1, 1); PG8_SCHED; PG8_LDA(At, 1, 0); PG8_STAGE(PG8_SA(0, 1), a2 + hstep, voffA);
            PG8_WAIT_V(8); PG8_WAIT_L(0); PG8_BAR; PG8_MMA(0, 0, At, B0); PG8_MMA(0, 1, At, B1); PG8_BAR; PG8_SCHED;
            PG8_LDA(At, 1, 1); PG8_STAGE(PG8_SB(1, 0), b3, voffB); PG8_STAGE(PG8_SB(1, 1), b3 + hstep, voffB); PG8_STAGE(PG8_SA(1, 0), a3, voffA);
            PG8_WAIT_V(8); PG8_WAIT_L(0); PG8_BAR; PG8_MMA(1, 0, At, B0); PG8_MMA(1, 1, At, B1); PG8_BAR; PG8_SCHED;
            } else {
            PG8_LDB(B0, 0, 0); PG8_SCHED; PG8_LDA(At, 0, 0); PG8_STAGE(PG8_SA(1, 1), a1 + hstep, voffA);
            PG8_WAIT_L(8); PG8_BAR; PG8_WAIT_L(0); PG8_MMA(0, 0, At, B0); PG8_BAR; PG8_SCHED;
            PG8_LDB(B1, 0, 1); PG8_STAGE(PG8_SB(0, 0), b2, voffB);
            PG8_BAR; PG8_WAIT_L(0); PG8_MMA(0, 1, At, B1); PG8_BAR;
            PG8_LDA(At, 0, 1); PG8_STAGE(PG8_SA(0, 0), a2, voffA);
            PG8_BAR; PG8_WAIT_L(0); PG8_MMA(1, 0, At, B0); PG8_BAR; PG8_SCHED;
            PG8_STAGE(PG8_SB(0, 1), b2 + hstep, voffB);
            PG8_WAIT_V(6); PG8_BAR; PG8_MMA(1, 1, At, B1); PG8_BAR;
            PG8_LDB(B0, 1, 0); PG8_SCHED; PG8_LDA(At, 1, 0); PG8_STAGE(PG8_SA(0, 1), a2 + hstep, voffA);
            PG8_WAIT_L(8); PG8_BAR; PG8_WAIT_L(0); PG8_MMA(0, 0, At, B0); PG8_BAR; PG8_SCHED;
            PG8_LDB(B1, 1, 1); PG8_STAGE(PG8_SB(1, 0), b3, voffB);
            PG8_BAR; PG8_WAIT_L(0); PG8_MMA(0, 1, At, B1); PG8_BAR;
            PG8_LDA(At, 1, 1); PG8_STAGE(PG8_SA(1, 0), a3, voffA);
            PG8_BAR; PG8_WAIT_L(0); PG8_MMA(1, 0, At, B0); PG8_BAR; PG8_SCHED;
            PG8_STAGE(PG8_SB(1, 1), b3 + hstep, voffB);
            PG8_WAIT_V(6); PG8_BAR; PG8_MMA(1, 1, At, B1); PG8_BAR;
            }
        }
        if constexpr (ALIGN_EPI) { if (wr == 0) PG8_BAR; }
        if constexpr (!Epi::AFTER_DRAIN) { E(acc, cur, wr, wc, fr, fq); S.done(cur); }
        if (!has_next) break;
#pragma unroll
        for (int a = 0; a < 2; ++a)
#pragma unroll
            for (int b = 0; b < 2; ++b)
#pragma unroll
                for (int m = 0; m < 4; ++m)
#pragma unroll
                    for (int n = 0; n < 2; ++n) acc[a][b][m][n] = (f32x4){0.f, 0.f, 0.f, 0.f};
        cur = nxt; cA = nA; cB = nB; ++ui;
        if constexpr (ALIGN_EPI) { if (wr == 1) PG8_BAR; }
    }
    PG8_WAIT_V(0);
    if constexpr (!ALIGN_EPI) { if (wr == 0) PG8_BAR; }
    PG8_BAR;
    if constexpr (Epi::AFTER_DRAIN) { E.fused(acc, cur, wr, wc, fr, fq, lds, wid, lane); S.done(cur); }
#undef PG8_SA
#undef PG8_SB
#undef PG8_STAGE
#undef PG8_LDA
#undef PG8_LDB
#undef PG8_MMA
#undef PG8_WAIT_V
#undef PG8_WAIT_L
#undef PG8_BAR
#undef PG8_SCHED
}
}

constexpr int GT_ROWB = 144, GT_A = 0, GT_B = 128 * GT_ROWB, GT_STAGE = 2 * 128 * GT_ROWB;
DI void gemm_kloop(unsigned char* lds, const bf16_t* a0, const bf16_t* a1, int a_kadv, const bf16_t* b0, const bf16_t* b1, int nk, f32x4 (&acc)[4][2]) {
  const int tid = otid(), lane = tid & 63, wid = tid >> 6, wr = wid >> 2, wc = wid & 3, fr = lane & 15, fq = lane >> 4;
  const int lr = tid >> 3, lkb = (tid & 7) * 16;
  u32x4 xa0, xa1, xb0, xb1, ya0, ya1, yb0, yb1;
#define GT_GLOAD(p0_, p1_, q0_, q1_, kt) do { p0_ = *(const u32x4*)(a0 + (size_t)(kt) * a_kadv); p1_ = *(const u32x4*)(a1 + (size_t)(kt) * a_kadv); q0_ = *(const u32x4*)(b0 + (kt) * 64); q1_ = *(const u32x4*)(b1 + (kt) * 64); } while (0)
#define GT_LSTORE(p0_, p1_, q0_, q1_, buf) do { unsigned char* s_ = lds + (buf) * GT_STAGE; \
    *(u32x4*)(s_ + GT_A + lr * GT_ROWB + lkb) = p0_; *(u32x4*)(s_ + GT_A + (lr + 64) * GT_ROWB + lkb) = p1_; \
    *(u32x4*)(s_ + GT_B + lr * GT_ROWB + lkb) = q0_; *(u32x4*)(s_ + GT_B + (lr + 64) * GT_ROWB + lkb) = q1_; } while (0)
#define GT_COMPUTE(buf) do { \
    const unsigned char* As = lds + (buf) * GT_STAGE + GT_A + (wr * 64 + fr) * GT_ROWB + fq * 16; \
    const unsigned char* Bs = lds + (buf) * GT_STAGE + GT_B + (wc * 32 + fr) * GT_ROWB + fq * 16; \
    _Pragma("unroll") for (int ks = 0; ks < 2; ++ks) { \
      bf16x8 af[4], bfr[2]; \
      _Pragma("unroll") for (int m = 0; m < 4; ++m) af[m] = *(const bf16x8*)(As + m * 16 * GT_ROWB + ks * 64); \
      _Pragma("unroll") for (int n = 0; n < 2; ++n) bfr[n] = *(const bf16x8*)(Bs + n * 16 * GT_ROWB + ks * 64); \
      _Pragma("unroll") for (int m = 0; m < 4; ++m) _Pragma("unroll") for (int n = 0; n < 2; ++n) acc[m][n] = __builtin_amdgcn_mfma_f32_16x16x32_bf16(bfr[n], af[m], acc[m][n], 0, 0, 0); } } while (0)
  GT_GLOAD(xa0, xa1, xb0, xb1, 0); GT_LSTORE(xa0, xa1, xb0, xb1, 0); if (nk > 1) GT_GLOAD(ya0, ya1, yb0, yb1, 1); __syncthreads();
  for (int kt = 0; kt < nk; kt += 2) {
    if (kt + 2 < nk) GT_GLOAD(xa0, xa1, xb0, xb1, kt + 2);
    GT_COMPUTE(0);
    if (kt + 1 < nk) GT_LSTORE(ya0, ya1, yb0, yb1, 1);
    __syncthreads();
    if (kt + 1 >= nk) break;
    if (kt + 3 < nk) GT_GLOAD(ya0, ya1, yb0, yb1, kt + 3);
    GT_COMPUTE(1);
    if (kt + 2 < nk) GT_LSTORE(xa0, xa1, xb0, xb1, 0);
    __syncthreads();
  }
#undef GT_GLOAD
#undef GT_LSTORE
#undef GT_COMPUTE
}
#define ACC_ZERO(acc) do { _Pragma("unroll") for (int m_ = 0; m_ < 4; ++m_) _Pragma("unroll") for (int n_ = 0; n_ < 2; ++n_) acc[m_][n_] = (f32x4){0.f, 0.f, 0.f, 0.f}; } while (0)
#define TILE_IDS const int tid = otid(), bid = obid(), lane = tid & 63, wid = tid >> 6, wr = wid >> 2, wc = wid & 3, fr = lane & 15, fq = lane >> 4, lr = tid >> 3, lk = (tid & 7) * 8; (void)bid; (void)lane; (void)wr; (void)wc; (void)fr; (void)fq; (void)lr; (void)lk

DI void phase_gates(const Params& P_, unsigned char* lds) {
  Params P = P_; { size_t z_ = 0; asm volatile("" : "+s"(z_)); P.ws = P_.ws + z_; }
  TILE_IDS;
  const bf16_t* xn = (const bf16_t*)(P.ws + WS_A); const bf16_t* wt = (const bf16_t*)(P.ws + WS_W + W_IN) + (size_t)5120 * DM; float* gates = (float*)(P.ws + WS_GATES);
  for (int tile = (int)gridDim.x - 1 - bid; tile < NT / 128; tile += gridDim.x) {
    const int row0 = tile * 128;
    f32x4 acc[4][2]; ACC_ZERO(acc);
    gemm_kloop(lds, xn + (size_t)(row0 + lr) * DM + lk, xn + (size_t)(row0 + lr + 64) * DM + lk, 64, wt + (size_t)lr * DM + lk, wt + (size_t)(lr + 64) * DM + lk, DM / 64, acc);
#pragma unroll
    for (int m = 0; m < 4; ++m)
#pragma unroll
      for (int n = 0; n < 2; ++n) {
        const int row = row0 + wr * 64 + m * 16 + fr, c2 = wc * 32 + n * 16 + 4 * fq; const f32x4 v = acc[m][n];
        if (c2 < 48) { f32x4 o = {sigmoidf_(v.x), sigmoidf_(v.y), sigmoidf_(v.z), sigmoidf_(v.w)}; *(f32x4*)(gates + (size_t)row * 48 + c2) = o; }
      }
  }
}
DI void phase_cmp1(const Params& P_, int l, unsigned char* lds) {
  Params P = P_; { size_t z_ = 0; asm volatile("" : "+s"(z_)); P.ws = P_.ws + z_; }
  TILE_IDS;
  const bf16_t* kvk = (const bf16_t*)(P.ws + WS_C); bf16_t* hid = (bf16_t*)(P.ws + WS_HID);
  const float* cb = (const float*)(P.ws + WS_CB) + l * 512;
  for (int tile = bid; tile < 128; tile += gridDim.x) {
    const int kv = tile >> 6, rt = (tile >> 1) & 31, ct = tile & 1, row0 = rt * 128, col0 = ct * 128;
    const bf16_t* wt = (const bf16_t*)(P.ws + WS_W + W_C1) + (size_t)kv * 256 * 2048;
    const bf16_t* ap[2];
#pragma unroll
    for (int i = 0; i < 2; ++i) { const int rr = row0 + lr + 64 * i, b = rr >> 11, n = (rr >> 2) & 511, g = rr & 3, nn = n > 510 ? 510 : n;
      ap[i] = kvk + (size_t)(b * SEQ + 16 * nn) * DM + kv * 256 + g * 64 + lk; }
    f32x4 acc[4][2]; ACC_ZERO(acc);
    gemm_kloop(lds, ap[0], ap[1], DM, wt + (size_t)(col0 + lr) * 2048 + lk, wt + (size_t)(col0 + lr + 64) * 2048 + lk, 32, acc);
#pragma unroll
    for (int m = 0; m < 4; ++m)
#pragma unroll
      for (int n = 0; n < 2; ++n) {
        const int row = row0 + wr * 64 + m * 16 + fr, col = col0 + wc * 32 + n * 16 + 4 * fq;
        const f32x4 bb = *(const f32x4*)(cb + kv * 256 + col); const f32x4 v = acc[m][n] + bb;
        u32x2 o; o.x = pk2(gelu_tanh(v.x), gelu_tanh(v.y)); o.y = pk2(gelu_tanh(v.z), gelu_tanh(v.w));
        *(u32x2*)(hid + ((size_t)kv * 4096 + row) * 256 + col) = o;
      }
  }
}
DI void phase_cmp2(const Params& P_, unsigned char* lds) {
  Params P = P_; { size_t z_ = 0; asm volatile("" : "+s"(z_)); P.ws = P_.ws + z_; }
  TILE_IDS;
  const bf16_t* hid = (const bf16_t*)(P.ws + WS_HID); bf16_t* kc = (bf16_t*)(P.ws + WS_KC); bf16_t* vc = (bf16_t*)(P.ws + WS_VC);
  for (int tile = bid; tile < 64; tile += gridDim.x) {
    const int kv = tile >> 5, rt = tile & 31, row0 = rt * 128;
    const bf16_t* wt = (const bf16_t*)(P.ws + WS_W + W_C2) + (size_t)kv * 128 * 256;
    const bf16_t* a = hid + ((size_t)kv * 4096 + row0) * 256;
    f32x4 acc[4][2]; ACC_ZERO(acc);
    gemm_kloop(lds, a + (size_t)lr * 256 + lk, a + (size_t)(lr + 64) * 256 + lk, 64, wt + (size_t)lr * 256 + lk, wt + (size_t)(lr + 64) * 256 + lk, 4, acc);
    if (wc < 2) {
#pragma unroll
      for (int m = 0; m < 4; ++m)
#pragma unroll
        for (int n = 0; n < 2; ++n) {
          const int rr = row0 + wr * 64 + m * 16 + fr, d = wc * 32 + n * 16 + 4 * fq;
          const int b = rr >> 11, nn = (rr >> 2) & 511, g = rr & 3; const f32x4 v = acc[m][n];
          if (kv == 0) { u32x2 o; o.x = pk2(v.x, v.y); o.y = pk2(v.z, v.w); *(u32x2*)(kc + ((size_t)((b * 4 + g) * 512 + nn)) * 64 + d) = o; }
          else { bf16_t* dst = vc + ((size_t)((b * 4 + g) * 64 + d)) * 512 + perm16(nn); dst[0] = (bf16_t)f2bf(v.x); dst[512] = (bf16_t)f2bf(v.y); dst[1024] = (bf16_t)f2bf(v.z); dst[1536] = (bf16_t)f2bf(v.w); }
        }
    }
  }
}
DI void phase_glu(const Params& P_, unsigned char* lds) {
  Params P = P_; { size_t z_ = 0; asm volatile("" : "+s"(z_)); P.ws = P_.ws + z_; }
  TILE_IDS;
  const bf16_t* y = (const bf16_t*)(P.ws + WS_G); const bf16_t* wt = (const bf16_t*)(P.ws + WS_W + W_GLU); bf16_t* ssm = (bf16_t*)(P.ws + WS_E);
  for (int tile = bid; tile < (NT / 128) * 4; tile += gridDim.x) {
    const int rt = tile >> 2, ct = tile & 3, row0 = rt * 128, col0 = ct * 128;
    f32x4 acc[4][2]; ACC_ZERO(acc);
    gemm_kloop(lds, y + (size_t)(row0 + lr) * 512 + lk, y + (size_t)(row0 + lr + 64) * 512 + lk, 64, wt + (size_t)(col0 + lr) * 512 + lk, wt + (size_t)(col0 + lr + 64) * 512 + lk, 8, acc);
#pragma unroll
    for (int m = 0; m < 4; ++m)
#pragma unroll
      for (int n = 0; n < 2; ++n) {
        const int row = row0 + wr * 64 + m * 16 + fr, col = col0 + wc * 32 + n * 16 + 4 * fq;
        const u32x2 yy = *(const u32x2*)(y + (size_t)row * 512 + col); const f32x4 v = acc[m][n];
        u32x2 o; o.x = pk2(bflo(yy.x) * sigmoidf_(v.x), bfhi(yy.x) * sigmoidf_(v.y)); o.y = pk2(bflo(yy.y) * sigmoidf_(v.z), bfhi(yy.y) * sigmoidf_(v.w));
        *(u32x2*)(ssm + (size_t)row * 512 + col) = o;
      }
  }
}
struct EpiInproj {
  static constexpr bool PERM = false, AFTER_DRAIN = false;
  bf16_t* qb; bf16_t* kvk; bf16_t* vT; bf16_t* mg; bf16_t* ub; float* gates;
  DI void operator()(const f32x4 (&acc)[2][2][4][2], const pg8::Unit& u, int wr, int wc, int fr_, int fq_) const {
    const int pn = u.pn; int fr = fr_, fq = fq_; asm volatile("" : "+v"(fr), "+v"(fq));
#pragma unroll
    for (int ai = 0; ai < 2; ++ai)
#pragma unroll
      for (int m = 0; m < 4; ++m) {
        const int row = u.pm * 256 + ai * 128 + wr * 64 + m * 16 + fr;
#pragma unroll
        for (int bj = 0; bj < 2; ++bj)
#pragma unroll
          for (int n = 0; n < 2; ++n) {
            const int cl = bj * 128 + wc * 32 + n * 16 + 4 * fq;
            const f32x4 v = acc[ai][bj][m][n];
            if (pn < 4) { u32x2 o; o.x = pk2(v.x * QSCALE, v.y * QSCALE); o.y = pk2(v.z * QSCALE, v.w * QSCALE); *(u32x2*)(qb + (size_t)row * DM + pn * 256 + cl) = o; }
            else if (pn < 10) {
              const int seg = pn - 4;
              if (seg == 5) {
                const int b = row >> 13, t = row & (SEQ - 1), g = cl >> 6, d = cl & 63;
                bf16_t* dst = vT + ((size_t)(((1 * NB + b) * 4 + g) * 64 + d)) * SEQ + perm16(t);
                dst[0] = (bf16_t)f2bf(v.x); dst[SEQ] = (bf16_t)f2bf(v.y); dst[2 * SEQ] = (bf16_t)f2bf(v.z); dst[3 * SEQ] = (bf16_t)f2bf(v.w);
              } else if (seg == 3) {
                const unsigned t = row & (SEQ - 1), pos = perm16(t) & 63;
                const unsigned ro = ((unsigned)(row >> 13) * 512u + (t >> 6)) * 4096u + (pos >> 3) * 256u + (pos & 7), co = (unsigned)(cl >> 6) * 524288u + (unsigned)((cl >> 5) & 1) * 2048u + (unsigned)(cl & 31) * 8u;
                bf16_t* dst = vT + (ro + co);
                dst[0] = (bf16_t)f2bf(v.x); dst[8] = (bf16_t)f2bf(v.y); dst[16] = (bf16_t)f2bf(v.z); dst[24] = (bf16_t)f2bf(v.w);
              } else if (seg == 2) {
                const unsigned t = row & (SEQ - 1);
                const unsigned ro = ((unsigned)(row >> 13) * 512u + (t >> 6)) * 4096u + ((t >> 5) & 1) * 2048u + (t & 31) * 8u, co = (unsigned)(cl >> 6) * 524288u + (unsigned)((cl >> 3) & 7) * 256u + (unsigned)(cl & 7);
                u32x2 o; o.x = pk2(v.x, v.y); o.y = pk2(v.z, v.w);
                *(u32x2*)(kvk + (WS_KSF - WS_C) / 2 + (ro + co)) = o;
              } else {
                const int slot = seg == 4 ? 3 : seg;
                u32x2 o; o.x = pk2(v.x, v.y); o.y = pk2(v.z, v.w); *(u32x2*)(kvk + (size_t)row * DM + slot * 256 + cl) = o;
              }
            } else if (pn < 18) {
              u32x2 o; o.x = pk2(sigmoidf_(v.x), sigmoidf_(v.y)); o.y = pk2(sigmoidf_(v.z), sigmoidf_(v.w)); *(u32x2*)(mg + (size_t)row * 2048 + (pn - 10) * 256 + cl) = o;
            } else if (pn < 20) { const int ch = (pn - 18) * 256 + cl; u32x2 o; o.x = pk2(v.x, v.y); o.y = pk2(v.z, v.w); *(u32x2*)(ub + ((size_t)(ch >> 4) * NT + row) * 16 + (ch & 15)) = o; }
            else { if (cl < 48) { f32x4 o = {sigmoidf_(v.x), sigmoidf_(v.y), sigmoidf_(v.z), sigmoidf_(v.w)}; *(f32x4*)(gates + (size_t)row * 48 + cl) = o; } }
          }
      }
  }
};
DI void phase_inproj8(const Params& P_, unsigned char* lds) {
  Params P = P_; { size_t z_ = 0; asm volatile("" : "+s"(z_)); P.ws = P_.ws + z_; }
  pg8::Gemm g{(const bf16_t*)(P.ws + WS_A), (const bf16_t*)(P.ws + WS_W + W_IN), NT, 5120, DM};
  pg8::StaticOrder S; S.init(NT, 5120, gridDim.x, obid());
  EpiInproj E{(bf16_t*)(P.ws + WS_B), (bf16_t*)(P.ws + WS_C), (bf16_t*)(P.ws + WS_DV), (bf16_t*)(P.ws + WS_F), (bf16_t*)(P.ws + WS_E), (float*)(P.ws + WS_GATES)};
  pg8::gemm_phase<EpiInproj, pg8::StaticOrder, true, true>((PG8_LAS unsigned char*)lds, g, S, E);
}
struct EpiMerge1 {
  static constexpr bool PERM = false, AFTER_DRAIN = false;
  const bf16_t* mg; bf16_t* tmp;
  DI void operator()(const f32x4 (&acc)[2][2][4][2], const pg8::Unit& u, int wr, int wc, int fr, int fq) const {
#pragma unroll
    for (int ai = 0; ai < 2; ++ai) {
      u32x2 ga[4][2][2];
#pragma unroll
      for (int m = 0; m < 4; ++m)
#pragma unroll
        for (int bj = 0; bj < 2; ++bj)
#pragma unroll
          for (int n = 0; n < 2; ++n) {
            const int row = u.pm * 256 + ai * 128 + wr * 64 + m * 16 + fr, col = u.pn * 256 + bj * 128 + wc * 32 + n * 16 + 4 * fq;
            ga[m][bj][n] = *(const u32x2*)(mg + (size_t)row * 2048 + col);
          }
      __builtin_amdgcn_sched_barrier(0);
#pragma unroll
      for (int m = 0; m < 4; ++m)
#pragma unroll
        for (int bj = 0; bj < 2; ++bj)
#pragma unroll
          for (int n = 0; n < 2; ++n) {
            const int row = u.pm * 256 + ai * 128 + wr * 64 + m * 16 + fr, col = u.pn * 256 + bj * 128 + wc * 32 + n * 16 + 4 * fq;
            const f32x4 v = acc[ai][bj][m][n]; const u32x2 g = ga[m][bj][n];
            u32x2 o; o.x = pk2(v.x * bflo(g.x), v.y * bfhi(g.x)); o.y = pk2(v.z * bflo(g.y), v.w * bfhi(g.y));
            *(u32x2*)(tmp + (size_t)row * DM + col) = o;
          }
      __builtin_amdgcn_sched_barrier(0);
    }
  }
};
struct EpiMerge2 {
  static constexpr bool PERM = false, AFTER_DRAIN = false;
  const bf16_t* mg; const bf16_t* tmp; bf16_t* mer;
  DI void operator()(const f32x4 (&acc)[2][2][4][2], const pg8::Unit& u, int wr, int wc, int fr, int fq) const {
#pragma unroll
    for (int ai = 0; ai < 2; ++ai)
#pragma unroll
      for (int mh = 0; mh < 2; ++mh) {
        u32x2 gs[2][2][2], tv[2][2][2];
#pragma unroll
        for (int mm = 0; mm < 2; ++mm)
#pragma unroll
          for (int bj = 0; bj < 2; ++bj)
#pragma unroll
            for (int n = 0; n < 2; ++n) {
              const int row = u.pm * 256 + ai * 128 + wr * 64 + (mh * 2 + mm) * 16 + fr, col = u.pn * 256 + bj * 128 + wc * 32 + n * 16 + 4 * fq;
              gs[mm][bj][n] = *(const u32x2*)(mg + (size_t)row * 2048 + 1024 + col);
#if EN_ATTN
              tv[mm][bj][n] = *(const u32x2*)(tmp + (size_t)row * DM + col);
#else
              tv[mm][bj][n] = (u32x2){0u, 0u};
#endif
            }
        __builtin_amdgcn_sched_barrier(0);
#pragma unroll
        for (int mm = 0; mm < 2; ++mm)
#pragma unroll
          for (int bj = 0; bj < 2; ++bj)
#pragma unroll
            for (int n = 0; n < 2; ++n) {
              const int row = u.pm * 256 + ai * 128 + wr * 64 + (mh * 2 + mm) * 16 + fr, col = u.pn * 256 + bj * 128 + wc * 32 + n * 16 + 4 * fq;
              const f32x4 v = acc[ai][bj][mh * 2 + mm][n]; const u32x2 g = gs[mm][bj][n], t = tv[mm][bj][n];
              u32x2 o; o.x = pk2(bflo(t.x) + v.x * bflo(g.x), bfhi(t.x) + v.y * bfhi(g.x)); o.y = pk2(bflo(t.y) + v.z * bflo(g.y), bfhi(t.y) + v.w * bfhi(g.y));
              *(u32x2*)(mer + (size_t)row * DM + col) = o;
            }
        __builtin_amdgcn_sched_barrier(0);
      }
  }
};
DI void phase_merge8(const Params& P_, unsigned char* lds) {
  Params P = P_; { size_t z_ = 0; asm volatile("" : "+s"(z_)); P.ws = P_.ws + z_; }
#if EN_ATTN
  { pg8::Gemm g{(const bf16_t*)(P.ws + WS_A), (const bf16_t*)(P.ws + WS_W + W_O), NT, DM, DM};
    pg8::StaticOrder S; S.init(NT, DM, gridDim.x, obid());
    EpiMerge1 E{(const bf16_t*)(P.ws + WS_F), (bf16_t*)(P.ws + WS_C)};
    pg8::gemm_phase<EpiMerge1, pg8::StaticOrder, true, true>((PG8_LAS unsigned char*)lds, g, S, E); }
#endif
  { pg8::Gemm g{(const bf16_t*)(P.ws + WS_E), (const bf16_t*)(P.ws + WS_W + W_SO), NT, DM, 512};
    pg8::StaticOrder S; S.init(NT, DM, gridDim.x, obid());
    EpiMerge2 E{(const bf16_t*)(P.ws + WS_F), (const bf16_t*)(P.ws + WS_C), (bf16_t*)(P.ws + WS_B)};
    pg8::gemm_phase<EpiMerge2, pg8::StaticOrder, true, true>((PG8_LAS unsigned char*)lds, g, S, E); }
}
struct EpiWout {
  static constexpr bool PERM = false, AFTER_DRAIN = false;
  const float* mod; const float* xin; float* out;
  DI void operator()(const f32x4 (&acc)[2][2][4][2], const pg8::Unit& u, int wr, int wc, int fr, int fq) const {
    const int b = (u.pm * 256) >> 13;
    f32x4 g1[2][2];
#pragma unroll
    for (int bj = 0; bj < 2; ++bj)
#pragma unroll
      for (int n = 0; n < 2; ++n) g1[bj][n] = *(const f32x4*)(mod + (size_t)b * 6144 + 2048 + u.pn * 256 + bj * 128 + wc * 32 + n * 16 + 4 * fq);
#pragma unroll
    for (int ai = 0; ai < 2; ++ai)
#pragma unroll
      for (int mh = 0; mh < 2; ++mh) {
        f32x4 xv[2][2][2];
#pragma unroll
        for (int mm = 0; mm < 2; ++mm)
#pragma unroll
          for (int bj = 0; bj < 2; ++bj)
#pragma unroll
            for (int n = 0; n < 2; ++n) {
              const int row = u.pm * 256 + ai * 128 + wr * 64 + (mh * 2 + mm) * 16 + fr, col = u.pn * 256 + bj * 128 + wc * 32 + n * 16 + 4 * fq;
              xv[mm][bj][n] = *(const f32x4*)(xin + (size_t)row * DM + col);
            }
        __builtin_amdgcn_sched_barrier(0);
#pragma unroll
        for (int mm = 0; mm < 2; ++mm)
#pragma unroll
          for (int bj = 0; bj < 2; ++bj)
#pragma unroll
            for (int n = 0; n < 2; ++n) {
              const int row = u.pm * 256 + ai * 128 + wr * 64 + (mh * 2 + mm) * 16 + fr, col = u.pn * 256 + bj * 128 + wc * 32 + n * 16 + 4 * fq;
              *(f32x4*)(out + (size_t)row * DM + col) = xv[mm][bj][n] + g1[bj][n] * acc[ai][bj][mh * 2 + mm][n];
            }
        __builtin_amdgcn_sched_barrier(0);
      }
  }
};
DI void phase_wout8(const Params& P_, int l, unsigned char* lds) {
  Params P = P_; { size_t z_ = 0; asm volatile("" : "+s"(z_)); P.ws = P_.ws + z_; }
  pg8::Gemm g{(const bf16_t*)(P.ws + WS_B), (const bf16_t*)(P.ws + WS_W + W_OUT), NT, DM, DM};
  pg8::StaticOrder S; S.init(NT, DM, gridDim.x, obid());
  EpiWout E{(const float*)(P.ws + WS_MOD) + (size_t)(l * 2) * 6144, l == 0 ? P.in[0] : P.out, P.out};
  pg8::gemm_phase<EpiWout, pg8::StaticOrder, true, true>((PG8_LAS unsigned char*)lds, g, S, E);
}

struct MoeTab { int cv, pin; };
DI MoeTab moe_tab(const int* cnt) {
  const int lane = otid() & 63; MoeTab T; T.cv = cnt[lane & 31]; int p = (T.cv + 127) >> 7;
#pragma unroll
  for (int o = 1; o < 32; o <<= 1) { const int t = __shfl_up(p, o); if ((lane & 31) >= o) p += t; }
  T.pin = p; return T;
}
DI int moe_total(const MoeTab& T) { return __builtin_amdgcn_readlane(T.pin, 31); }
DI void moe_find(const MoeTab& T, int rb, int& e, int& rbl, int& ce) {
  const unsigned m = (unsigned)__ballot(T.pin <= rb);
  e = __popc(m); e = e < NEXP ? e : NEXP - 1;
  const int nb = (__shfl(T.cv, e) + 127) >> 7;
  ce = __shfl(T.cv, e); rbl = rb - (__shfl(T.pin, e) - nb);
  e = __builtin_amdgcn_readfirstlane(e); rbl = __builtin_amdgcn_readfirstlane(rbl); ce = __builtin_amdgcn_readfirstlane(ce);
}
DI void phase_moe1(const Params& P_, int l, unsigned char* lds) {
  Params P = P_; { size_t z_ = 0; asm volatile("" : "+s"(z_)); P.ws = P_.ws + z_; }
  TILE_IDS;
  const int* cnt = (const int*)(P.ws + WS_CNT) + l * 32; const int* list = (const int*)(P.ws + WS_LIST);
  const bf16_t* h2 = (const bf16_t*)(P.ws + WS_A); bf16_t* act = (bf16_t*)(P.ws + WS_B);
  const MoeTab MT = moe_tab(cnt); const int total = moe_total(MT);
  for (int tile = bid; tile < total * 4; tile += gridDim.x) {
    const int rb = tile >> 2, ct = tile & 3; int e = 0, rbl = 0, ce = 1; moe_find(MT, rb, e, rbl, ce);
    const bf16_t* wt = (const bf16_t*)(P.ws + WS_W + W_GU) + (size_t)e * 512 * 1024 + (size_t)(ct * 128) * 1024;
    const bf16_t* ap[2];
#pragma unroll
    for (int i = 0; i < 2; ++i) { int idx = rbl * 128 + lr + 64 * i; idx = idx < ce ? idx : ce - 1; const int tok = list[e * LISTCAP + idx] >> 1; ap[i] = h2 + (size_t)tok * DM + lk; }
    f32x4 acc[4][2]; ACC_ZERO(acc);
    gemm_kloop(lds, ap[0], ap[1], 64, wt + (size_t)lr * DM + lk, wt + (size_t)(lr + 64) * DM + lk, 16, acc);
#pragma unroll
    for (int m = 0; m < 4; ++m) {
      const int arow = rb * 128 + wr * 64 + m * 16 + fr, col = ct * 64 + wc * 16 + 4 * fq;
      const f32x4 g = acc[m][0], u = acc[m][1];
      u32x2 o; o.x = pk2(g.x * sigmoidf_(g.x) * u.x, g.y * sigmoidf_(g.y) * u.y); o.y = pk2(g.z * sigmoidf_(g.z) * u.z, g.w * sigmoidf_(g.w) * u.w);
      *(u32x2*)(act + (size_t)arow * 256 + col) = o;
    }
  }
}
DI void phase_moe2(const Params& P_, int l, unsigned char* lds) {
  Params P = P_; { size_t z_ = 0; asm volatile("" : "+s"(z_)); P.ws = P_.ws + z_; }
  TILE_IDS;
  const int* cnt = (const int*)(P.ws + WS_CNT) + l * 32; const int* list = (const int*)(P.ws + WS_LIST); const float* wts = (const float*)(P.ws + WS_WT);
  const bf16_t* act = (const bf16_t*)(P.ws + WS_B); bf16_t* ys = (bf16_t*)(P.ws + WS_F);
  constexpr int ASUB = 128 * GT_ROWB, BOFF = 4 * ASUB;
  const MoeTab MT = moe_tab(cnt); const int total = moe_total(MT);
  const int lkb = (tid & 7) * 16;
  for (int item = bid; item < total * 4; item += gridDim.x) {
    const int rb = item >> 2, ct0 = (item & 3) * 2; int e = 0, rbl = 0, ce = 1; moe_find(MT, rb, e, rbl, ce);
    const bf16_t* wt = (const bf16_t*)(P.ws + WS_W + W_D) + (size_t)e * 1024 * 256;
    const bf16_t* a0 = act + (size_t)(rb * 128 + lr) * 256 + lk; const bf16_t* a1 = a0 + 64 * 256;
    u32x4 ra[8], xb0, xb1, yb0, yb1;
#pragma unroll
    for (int k = 0; k < 4; ++k) { ra[2 * k] = *(const u32x4*)(a0 + 64 * k); ra[2 * k + 1] = *(const u32x4*)(a1 + 64 * k); }
#define M2_BLOAD(q0_, q1_, s_) do { const bf16_t* bp_ = wt + (size_t)((ct0 + ((s_) >> 2)) * 128 + lr) * 256 + ((s_) & 3) * 64 + lk; q0_ = *(const u32x4*)bp_; q1_ = *(const u32x4*)(bp_ + 64 * 256); } while (0)
#define M2_BSTORE(q0_, q1_, buf_) do { unsigned char* s_ = lds + BOFF + (buf_) * ASUB; *(u32x4*)(s_ + lr * GT_ROWB + lkb) = q0_; *(u32x4*)(s_ + (lr + 64) * GT_ROWB + lkb) = q1_; } while (0)
#define M2_COMPUTE(s_, buf_) do { \
      const unsigned char* As = lds + ((s_) & 3) * ASUB + (wr * 64 + fr) * GT_ROWB + fq * 16; \
      const unsigned char* Bs = lds + BOFF + (buf_) * ASUB + (wc * 32 + fr) * GT_ROWB + fq * 16; \
      _Pragma("unroll") for (int ks = 0; ks < 2; ++ks) { \
        bf16x8 af[4], bfr[2]; \
        _Pragma("unroll") for (int m = 0; m < 4; ++m) af[m] = *(const bf16x8*)(As + m * 16 * GT_ROWB + ks * 64); \
        _Pragma("unroll") for (int n = 0; n < 2; ++n) bfr[n] = *(const bf16x8*)(Bs + n * 16 * GT_ROWB + ks * 64); \
        _Pragma("unroll") for (int m = 0; m < 4; ++m) _Pragma("unroll") for (int n = 0; n < 2; ++n) acc[m][n] = __builtin_amdgcn_mfma_f32_16x16x32_bf16(bfr[n], af[m], acc[m][n], 0, 0, 0); } } while (0)
#define M2_EPI(ct_) do { _Pragma("unroll") for (int m = 0; m < 4; ++m) { const int idx = rbl * 128 + wr * 64 + m * 16 + fr; \
      if (idx < ce) { const int slot = eslot[m]; const float w_ = ewt[m]; \
        _Pragma("unroll") for (int n = 0; n < 2; ++n) { const int col = (ct_) * 128 + wc * 32 + n * 16 + 4 * fq; const f32x4 v = acc[m][n] * w_; \
          u32x2 o; o.x = pk2(v.x, v.y); o.y = pk2(v.z, v.w); *(u32x2*)(ys + (size_t)slot * DM + col) = o; } } } ACC_ZERO(acc); } while (0)
    int eslot[4]; float ewt[4];
#pragma unroll
    for (int m = 0; m < 4; ++m) { int idx = rbl * 128 + wr * 64 + m * 16 + fr; idx = idx < ce ? idx : ce - 1; eslot[m] = list[e * LISTCAP + idx]; }
#pragma unroll
    for (int m = 0; m < 4; ++m) ewt[m] = wts[eslot[m]];
    M2_BLOAD(xb0, xb1, 0);
#pragma unroll
    for (int k = 0; k < 4; ++k) { *(u32x4*)(lds + k * ASUB + lr * GT_ROWB + lkb) = ra[2 * k]; *(u32x4*)(lds + k * ASUB + (lr + 64) * GT_ROWB + lkb) = ra[2 * k + 1]; }
    M2_BSTORE(xb0, xb1, 0);
    M2_BLOAD(yb0, yb1, 1);
    __syncthreads();
    f32x4 acc[4][2]; ACC_ZERO(acc);
#pragma unroll 1
    for (int s2 = 0; s2 < 8; s2 += 2) {
      if (s2 + 2 < 8) M2_BLOAD(xb0, xb1, s2 + 2);
      M2_COMPUTE(s2, 0);
      M2_BSTORE(yb0, yb1, 1);
      __syncthreads();
      if (s2 + 3 < 8) M2_BLOAD(yb0, yb1, s2 + 3);
      M2_COMPUTE(s2 + 1, 1);
      if (s2 == 2) M2_EPI(ct0);
      if (s2 == 6) M2_EPI(ct0 + 1);
      if (s2 + 2 < 8) M2_BSTORE(xb0, xb1, 0);
      __syncthreads();
    }
#undef M2_BLOAD
#undef M2_BSTORE
#undef M2_COMPUTE
#undef M2_EPI
  }
}

typedef float f32x2v __attribute__((ext_vector_type(2)));
DI void phase_s5a(const Params& P_, int l, unsigned char* lds) {
  Params P = P_; { size_t z_ = 0; asm volatile("" : "+s"(z_)); P.ws = P_.ws + z_; }
  TILE_IDS;
  const bf16_t* ub = (const bf16_t*)(P.ws + WS_E); float* Lb = (float*)(P.ws + WS_L);
  const bf16_t* M1 = (const bf16_t*)(P.ws + WS_TAB + (size_t)l * TAB_LAYER + TAB_M1);
  const int first = (int)gridDim.x >= 192 ? 128 : 0;
  for (int tile = bid - first; tile >= 0 && tile < 64; tile += gridDim.x) {
    const int g = tile >> 1, rt = tile & 1;
    const bf16_t* a = ub + ((size_t)g * NT / 64 + rt * 128) * 1024;
    const bf16_t* wt = M1 + (size_t)g * 128 * 1024;
    f32x4 acc[4][2]; ACC_ZERO(acc);
    gemm_kloop(lds, a + (size_t)lr * 1024 + lk, a + (size_t)(lr + 64) * 1024 + lk, 64, wt + (size_t)lr * 1024 + lk, wt + (size_t)(lr + 64) * 1024 + lk, 16, acc);
#pragma unroll
    for (int m = 0; m < 4; ++m)
#pragma unroll
      for (int n = 0; n < 2; ++n) {
        const int R = rt * 128 + wr * 64 + m * 16 + fr, comp = wc * 32 + n * 16 + 4 * fq;
        *(f32x4*)(Lb + ((size_t)(R * 32 + g) * 64) * 2 + comp) = acc[m][n];
      }
  }
}
DI void s5_carry(const Params& P_, int l) {
  Params P = P_; { size_t z_ = 0; asm volatile("" : "+s"(z_)); P.ws = P_.ws + z_; }
  const int tid_ = otid(), bid = obid(), wave = tid_ >> 6, lane = tid_ & 63;
  const int item = (gridDim.x * NWAVE - 1) - (bid * NWAVE + wave);
  if (item >= NB * 32) return;
  const int b = item >> 5, g = item & 31;
  const float* pp = (const float*)(P.ws + WS_S5P) + (size_t)((l * 32 + g) * 64 + lane) * 36;
  const float aTr = pp[2], aTi = pp[3];
  float2* Lp = (float2*)(P.ws + WS_L) + ((size_t)(b * 128) * 32 + g) * 64 + lane;
  unsigned* Sp = (unsigned*)(P.ws + WS_SIN) + ((size_t)(g * 256 + b * 128)) * 64 + lane;
  float sr = 0.f, si = 0.f; asm volatile("" : "+v"(sr), "+v"(si));
  float2 va[8], vb[8];
#define CY_LOAD(vv, c0_) do { _Pragma("unroll") for (int k = 0; k < 8; ++k) vv[k] = Lp[(size_t)((c0_) + k) * 2048]; } while (0)
#define CY_STEP(vv, c0_) do { _Pragma("unroll") for (int k = 0; k < 8; ++k) { Lp[(size_t)((c0_) + k) * 2048] = make_float2(sr, si); Sp[(size_t)((c0_) + k) * 64] = pk2(sr, si); \
      const float nr = aTr * sr - aTi * si + vv[k].x, ni = aTr * si + aTi * sr + vv[k].y; sr = nr; si = ni; } } while (0)
#define CY_PIN(vv) do { _Pragma("unroll") for (int k = 0; k < 8; ++k) asm volatile("" : "+v"(vv[k].x), "+v"(vv[k].y)); } while (0)
  CY_LOAD(va, 0);
#pragma unroll
  for (int c0 = 0; c0 < 128; c0 += 16) {
    CY_LOAD(vb, c0 + 8);
    CY_PIN(va);
    CY_STEP(va, c0);
    if (c0 + 16 < 128) CY_LOAD(va, c0 + 16);
    CY_PIN(vb);
    CY_STEP(vb, c0 + 8);
  }
#undef CY_PIN
#undef CY_LOAD
#undef CY_STEP
}
DI void phase_s5c(const Params& P_, int l, unsigned char* lds) {
  Params P = P_; { size_t z_ = 0; asm volatile("" : "+s"(z_)); P.ws = P_.ws + z_; }
  TILE_IDS;
  const bf16_t* ub = (const bf16_t*)(P.ws + WS_E); const bf16_t* sinb = (const bf16_t*)(P.ws + WS_SIN); bf16_t* yb = (bf16_t*)(P.ws + WS_G);
  const bf16_t* tab = (const bf16_t*)(P.ws + WS_TAB + (size_t)l * TAB_LAYER);
  int* dctr = (int*)(P.ws + 640) + l; int* dslot = (int*)(lds + LDS_BYTES - 32);
  constexpr int ROWB = 144, SA = 0, SB = 128 * ROWB, STAGE = 2 * 128 * ROWB;
  const int lkb = (tid & 7) * 16, kch = tid & 7;
  for (;;) {
    if (threadIdx.x == 0) *dslot = atomicAdd(dctr, 1);
    __syncthreads();
    const int tile = *dslot;
    __syncthreads();
    if (tile >= 512) break;
    const int g = tile >> 4, rt = (tile >> 3) & 1, ct = tile & 7;
    const bf16_t* Kt = tab + TAB_KT / 2 + (size_t)g * 64 * 256; const bf16_t* M2 = tab + TAB_M2 / 2 + (size_t)g * 1024 * 128;
    const bf16_t* ua = ub + ((size_t)g * 256 + rt * 128) * 1024; const bf16_t* sa = sinb + ((size_t)g * 256 + rt * 128) * 128;
    const int nbt = 2 * ct + 2 < 16 ? 2 * ct + 2 : 16, ns = nbt + 2;
    u32x4 xa0, xa1, xb0, xb1, ya0, ya1, yb0, yb1;
#define S5_LOAD(p0_, p1_, q0_, q1_, s_) do { \
      if ((s_) < nbt) { p0_ = *(const u32x4*)(ua + (size_t)lr * 1024 + (s_) * 64 + lk); p1_ = *(const u32x4*)(ua + (size_t)(lr + 64) * 1024 + (s_) * 64 + lk); \
        const int i_ = 4 * (s_) + (kch >> 1), hq_ = (kch & 1) * 8; \
        { const int t_ = 8 * ct + (lr >> 4), h_ = lr & 15; q0_ = t_ >= i_ ? *(const u32x4*)(Kt + ((t_ - i_) * 16 + h_) * 16 + hq_) : (u32x4){0u, 0u, 0u, 0u}; } \
        { const int t_ = 8 * ct + 4 + (lr >> 4), h_ = lr & 15; q1_ = t_ >= i_ ? *(const u32x4*)(Kt + ((t_ - i_) * 16 + h_) * 16 + hq_) : (u32x4){0u, 0u, 0u, 0u}; } \
      } else { const int k0_ = ((s_) - nbt) * 64 + lk; \
        p0_ = *(const u32x4*)(sa + (size_t)lr * 128 + k0_); p1_ = *(const u32x4*)(sa + (size_t)(lr + 64) * 128 + k0_); \
        q0_ = *(const u32x4*)(M2 + (size_t)(ct * 128 + lr) * 128 + k0_); q1_ = *(const u32x4*)(M2 + (size_t)(ct * 128 + lr + 64) * 128 + k0_); } } while (0)
#define S5_STORE(p0_, p1_, q0_, q1_, buf) do { unsigned char* s_ = lds + (buf) * STAGE; \
      *(u32x4*)(s_ + SA + lr * ROWB + lkb) = p0_; *(u32x4*)(s_ + SA + (lr + 64) * ROWB + lkb) = p1_; \
      *(u32x4*)(s_ + SB + lr * ROWB + lkb) = q0_; *(u32x4*)(s_ + SB + (lr + 64) * ROWB + lkb) = q1_; } while (0)
#define S5_COMPUTE(buf) do { \
      const unsigned char* As = lds + (buf) * STAGE + SA + (wr * 64 + fr) * ROWB + fq * 16; \
      const unsigned char* Bs = lds + (buf) * STAGE + SB + (wc * 32 + fr) * ROWB + fq * 16; \
      _Pragma("unroll") for (int ks = 0; ks < 2; ++ks) { \
        bf16x8 af[4], bfr[2]; \
        _Pragma("unroll") for (int m = 0; m < 4; ++m) af[m] = *(const bf16x8*)(As + m * 16 * ROWB + ks * 64); \
        _Pragma("unroll") for (int n = 0; n < 2; ++n) bfr[n] = *(const bf16x8*)(Bs + n * 16 * ROWB + ks * 64); \
        _Pragma("unroll") for (int m = 0; m < 4; ++m) _Pragma("unroll") for (int n = 0; n < 2; ++n) acc[m][n] = __builtin_amdgcn_mfma_f32_16x16x32_bf16(bfr[n], af[m], acc[m][n], 0, 0, 0); } } while (0)
    f32x4 acc[4][2]; ACC_ZERO(acc);
    S5_LOAD(xa0, xa1, xb0, xb1, 0); S5_STORE(xa0, xa1, xb0, xb1, 0); S5_LOAD(ya0, ya1, yb0, yb1, 1); __syncthreads();
    for (int st = 0; st < ns; st += 2) {
      if (st + 2 < ns) S5_LOAD(xa0, xa1, xb0, xb1, st + 2);
      S5_COMPUTE(0);
      if (st + 1 < ns) S5_STORE(ya0, ya1, yb0, yb1, 1);
      __syncthreads();
      if (st + 1 >= ns) break;
      if (st + 3 < ns) S5_LOAD(ya0, ya1, yb0, yb1, st + 3);
      S5_COMPUTE(1);
      if (st + 2 < ns) S5_STORE(xa0, xa1, xb0, xb1, 0);
      __syncthreads();
    }
#undef S5_LOAD
#undef S5_STORE
#undef S5_COMPUTE
    const float* dsk = P.in[13] + (size_t)(l * 32 + g) * 16;
#pragma unroll
    for (int m = 0; m < 4; ++m)
#pragma unroll
      for (int n = 0; n < 2; ++n) {
        const int R = rt * 128 + wr * 64 + m * 16 + fr, col = ct * 128 + wc * 32 + n * 16 + 4 * fq, t = col >> 4, h = col & 15;
        const u32x2 uu = *(const u32x2*)(ub + ((size_t)g * 256 + R) * 1024 + col); const f32x4 dd = *(const f32x4*)(dsk + h); const f32x4 v = acc[m][n];
        const float y0 = gelu_tanh(v.x + dd.x * bflo(uu.x)), y1 = gelu_tanh(v.y + dd.y * bfhi(uu.x)), y2 = gelu_tanh(v.z + dd.z * bflo(uu.y)), y3 = gelu_tanh(v.w + dd.w * bfhi(uu.y));
        const size_t tokn = (size_t)(R >> 7) * SEQ + 64 * (R & 127) + t;
        u32x2 o; o.x = pk2(y0, y1); o.y = pk2(y2, y3); *(u32x2*)(yb + tokn * 512 + g * 16 + h) = o;
      }
  }
}

constexpr int AT_ROWB = 144, AT_KS = 0, AT_VS = 2 * 64 * AT_ROWB, AT_IMP = 4 * 64 * AT_ROWB, AT_OACC = AT_IMP, AT_IMPS = 129, AT_EE = AT_IMP + 64 * AT_IMPS * 4,
              AT_SEL = AT_IMP + 66048, AT_QS = AT_SEL + 1024, AT_QL = AT_QS + 32768, AT_NJ = AT_QL + 8192, AT_ITEMS = AT_NJ + 512, AT_MREF = AT_ITEMS + 512,
              AT_LACC = AT_MREF + 1024, AT_INVQ = AT_LACC + 1024, AT_MISC = AT_INVQ + 512, AT_LOWN = AT_MISC + 64, AT_END = AT_LOWN + 1024;
static_assert(AT_END <= LDS_BYTES - 16, "attention LDS");
#define MFMA32(a, b, c) __builtin_amdgcn_mfma_f32_32x32x16_bf16((a), (b), (c), 0, 0, 0)
DI int crow_of(int reg, int hh) { return (reg & 3) + 8 * (reg >> 2) + 4 * hh; }

struct AttnState { f32x16 o0, o1; float m, l; };
DI void st_init(AttnState& S) { S.m = -1e30f; S.l = 0.f;
#pragma unroll
  for (int i = 0; i < 16; ++i) { S.o0[i] = 0.f; S.o1[i] = 0.f; } }

DI void at_ldk(const unsigned char* lds, int buf, int r, int hh, bf16x8 (&kf)[8]) {
  const unsigned char* kb = lds + AT_KS + buf * 64 * AT_ROWB + r * AT_ROWB + hh * 16;
#pragma unroll
  for (int ds = 0; ds < 4; ++ds) { kf[ds] = *(const bf16x8*)(kb + ds * 32); kf[4 + ds] = *(const bf16x8*)(kb + 32 * AT_ROWB + ds * 32); }
}
DI void at_ldv(const unsigned char* lds, int buf, int r, int hh, bf16x8 (&vf)[8]) {
  const unsigned char* vb = lds + AT_VS + buf * 64 * AT_ROWB + r * AT_ROWB + hh * 16;
#pragma unroll
  for (int gk = 0; gk < 4; ++gk) { vf[gk] = *(const bf16x8*)(vb + gk * 32); vf[4 + gk] = *(const bf16x8*)(vb + 32 * AT_ROWB + gk * 32); }
}
DI void at_qk(const bf16x8 (&kf)[8], const bf16x8 (&qf)[4], f32x16& p0, f32x16& p1) {
  const f32x16 z = {0.f, 0.f, 0.f, 0.f, 0.f, 0.f, 0.f, 0.f, 0.f, 0.f, 0.f, 0.f, 0.f, 0.f, 0.f, 0.f};
#pragma unroll
  for (int ds = 0; ds < 4; ++ds) { if (ds == 0) { p0 = MFMA32(kf[0], qf[0], z); p1 = MFMA32(kf[4], qf[0], z); } else { p0 = MFMA32(kf[ds], qf[ds], p0); p1 = MFMA32(kf[4 + ds], qf[ds], p1); } }
}
DI bf16x8 pack8(const f32x16& p, int s2) {
  u32x4 w; w.x = pk2(p[8 * s2], p[8 * s2 + 1]); w.y = pk2(p[8 * s2 + 2], p[8 * s2 + 3]); w.z = pk2(p[8 * s2 + 4], p[8 * s2 + 5]); w.w = pk2(p[8 * s2 + 6], p[8 * s2 + 7]);
  return __builtin_bit_cast(bf16x8, w);
}
DI void at_pv(const bf16x8 (&vf)[8], const f32x16& p0, const f32x16& p1, f32x16& oa, f32x16& ob) {
#pragma unroll
  for (int gk = 0; gk < 4; ++gk) {
    const bf16x8 pb = (gk < 2) ? pack8(p0, gk & 1) : pack8(p1, gk & 1);
    oa = MFMA32(vf[gk], pb, oa); ob = MFMA32(vf[4 + gk], pb, ob);
  }
}
template <int MODE>
DI void at_online(AttnState& S, f32x16& p0, f32x16& p1, int key0, int lo, int hi, bool on, int hh) {
  float tm = -1e30f;
  if (MODE == 1) {
    int lor = lo - key0 - 4 * hh, hir = hi - key0 - 4 * hh;
    if (hir < lor) { lor = 4096; hir = 4096; }
    const unsigned span = (unsigned)(hir - lor);
#pragma unroll
    for (int i = 0; i < 16; ++i) { const int c0 = (i & 3) + 8 * (i >> 2);
      p0[i] = ((unsigned)(c0 - lor) <= span) ? p0[i] : -1e30f; p1[i] = ((unsigned)(c0 + 32 - lor) <= span) ? p1[i] : -1e30f; }
  }
  if (MODE != 1) asm volatile("s_nop 15\n\ts_nop 7" : "+v"(p0), "+v"(p1));
#define MX3_8(o_) asm("v_max3_f32 %0, %0, %1, %2\n\tv_max3_f32 %0, %0, %3, %4\n\tv_max3_f32 %0, %0, %5, %6\n\tv_max3_f32 %0, %0, %7, %8\n\tv_max3_f32 %0, %0, %9, %10\n\tv_max3_f32 %0, %0, %11, %12\n\tv_max3_f32 %0, %0, %13, %14\n\tv_max3_f32 %0, %0, %15, %16" \
      : "+v"(tm) : "v"(p0[o_]), "v"(p1[o_]), "v"(p0[o_ + 1]), "v"(p1[o_ + 1]), "v"(p0[o_ + 2]), "v"(p1[o_ + 2]), "v"(p0[o_ + 3]), "v"(p1[o_ + 3]), "v"(p0[o_ + 4]), "v"(p1[o_ + 4]), "v"(p0[o_ + 5]), "v"(p1[o_ + 5]), "v"(p0[o_ + 6]), "v"(p1[o_ + 6]), "v"(p0[o_ + 7]), "v"(p1[o_ + 7]))
  MX3_8(0); MX3_8(8);
#undef MX3_8
  tm = fmaxf(tm, __shfl_xor(tm, 32));
  if (MODE == 2) tm = on ? tm : -1e30f;
  if (__any(tm > S.m)) {
    const float mn = fmaxf(S.m, tm); const float al = __builtin_amdgcn_exp2f(S.m - mn); S.m = mn; S.l *= al;
#pragma unroll
    for (int i = 0; i < 16; ++i) { S.o0[i] *= al; S.o1[i] *= al; }
  }
  float mn = S.m;
  if (MODE == 2) mn = on ? mn : 1e30f;
  if (MODE == 1) mn = mn < -1e29f ? 1e30f : mn;
  float rs = 0.f;
#pragma unroll
  for (int i = 0; i < 16; ++i) {
    const float e0 = __builtin_amdgcn_exp2f(p0[i] - mn), e1 = __builtin_amdgcn_exp2f(p1[i] - mn);
    p0[i] = e0; p1[i] = e1; rs += e0 + e1;
  }
  S.l += rs;
}

DI void attn_tile(const Params& P_, unsigned char* lds, int b, int g, int c) {
  Params P = P_; { size_t z_ = 0; asm volatile("" : "+s"(z_)); P.ws = P_.ws + z_; }
#define AT_IDS const int tid = otid(), lane = tid & 63, w = tid >> 6, r = lane & 31, hh = lane >> 5, qi = 8 * w + (r >> 2), h = r & 3, t = 64 * c + qi, qrow = 32 * w + r, srow = tid >> 3, sch = (tid & 7) * 8, ahead = lane >> 4, ach = lane & 15; const unsigned tok = (unsigned)b * SEQ + t, goff = tok * 48 + g * 4 + h; (void)qi; (void)h; (void)t; (void)qrow; (void)srow; (void)sch; (void)ahead; (void)ach; (void)tok; (void)goff; (void)hh; (void)w; (void)r
  const bf16_t* qb = (const bf16_t*)(P.ws + WS_B); const bf16_t* kvk = (const bf16_t*)(P.ws + WS_C); const bf16_t* vT = (const bf16_t*)(P.ws + WS_DV);
  const bf16_t* kcb = (const bf16_t*)(P.ws + WS_KC); const bf16_t* vcb = (const bf16_t*)(P.ws + WS_VC);
  const float* gbase = (const float*)(P.ws + WS_GATES);
#define gates(i) gbase[goff + (i)]
  bf16_t* attn = (bf16_t*)(P.ws + WS_A);
  float* otb = (float*)(P.ws + WS_OT) + (size_t)obid() * 16384;
#define otg(i) otb[(unsigned)tid + (i) * 512u]
  float* IMP = (float*)(lds + AT_IMP); float* EE = (float*)(lds + AT_EE); unsigned* SEL = (unsigned*)(lds + AT_SEL);
  AttnState S; f32x16 p0, p1; u32x4 rkA, rvA; bf16x8 qf[4], kfr[8], vfr[8];
#define QF_LOAD() do { _Pragma("unroll") for (int ds_ = 0; ds_ < 4; ++ds_) qf[ds_] = *(const bf16x8*)(lds + AT_QS + qrow * 128 + (((ds_ * 2 + hh) ^ (qrow & 7)) * 16)); } while (0)
#define AT_QKV() do { at_ldk(lds, buf_, r, hh, kfr); __builtin_amdgcn_sched_barrier(0); at_qk(kfr, qf, p0, p1); at_ldv(lds, buf_, r, hh, vfr); __builtin_amdgcn_sched_barrier(0); } while (0)
  { AT_IDS;
  { const int row = tid >> 1, half = tid & 1, q_i = row >> 2, hd = row & 3;
    const unsigned so = ((unsigned)b * SEQ + 64 * c + q_i) * DM + (g * 4 + hd) * 64 + half * 32;
#pragma unroll
    for (int k = 0; k < 4; ++k) { const u32x4 v = *(const u32x4*)(qb + so + k * 8); *(u32x4*)(lds + AT_QS + row * 128 + (((half * 4 + k) ^ (row & 7)) * 16)) = v; } }
  __syncthreads();
  QF_LOAD();
#define ST_LOAD(rk, rv, kp, kstride, vp, vstride, kt) do { rk = *(const u32x4*)((kp) + (unsigned)(((kt) * 64 + srow) * (kstride) + sch)); rv = *(const u32x4*)((vp) + (unsigned)(srow * (vstride) + (kt) * 64 + sch)); } while (0)
#define ST_STORE(rk, rv, buf) do { *(u32x4*)(lds + AT_KS + (buf) * 64 * AT_ROWB + srow * AT_ROWB + sch * 2) = rk; *(u32x4*)(lds + AT_VS + (buf) * 64 * AT_ROWB + srow * AT_ROWB + sch * 2) = rv; } while (0)
#define SWEEP(kp, kstride, vp, vstride, kt0, n, ...) do { \
    ST_LOAD(rkA, rvA, kp, kstride, vp, vstride, (kt0)); ST_STORE(rkA, rvA, 0); __syncthreads(); \
    for (int i_ = 0; i_ < (n); ++i_) { \
      if (i_ + 1 < (n)) ST_LOAD(rkA, rvA, kp, kstride, vp, vstride, (kt0) + i_ + 1); \
      { const int step_ = i_; const int buf_ = i_ & 1; __VA_ARGS__ } \
      if (i_ + 1 < (n)) ST_STORE(rkA, rvA, (i_ + 1) & 1); \
      __syncthreads(); \
    } } while (0)
#define ST_LOADF(rk, rv, kt) do { rk = *(const u32x4*)(kps + (size_t)(kt) * 4096 + tid * 8); rv = *(const u32x4*)(vps + (size_t)(kt) * 4096 + tid * 8); } while (0)
#define ST_STOREF(rk, rv, buf) do { const int fo_ = ((tid >> 8) * 32 + (tid & 31)) * AT_ROWB + (((tid >> 6) & 3) * 2 + ((tid >> 5) & 1)) * 16; \
    *(u32x4*)(lds + AT_KS + (buf) * 64 * AT_ROWB + fo_) = rk; *(u32x4*)(lds + AT_VS + (buf) * 64 * AT_ROWB + fo_) = rv; } while (0)
#define SWEEPF(kt0, n, ...) do { \
    ST_LOADF(rkA, rvA, (kt0)); ST_STOREF(rkA, rvA, 0); __syncthreads(); \
    for (int i_ = 0; i_ < (n); ++i_) { \
      if (i_ + 1 < (n)) ST_LOADF(rkA, rvA, (kt0) + i_ + 1); \
      { const int step_ = i_; const int buf_ = i_ & 1; __VA_ARGS__ } \
      if (i_ + 1 < (n)) ST_STOREF(rkA, rvA, (i_ + 1) & 1); \
      __syncthreads(); \
    } } while (0)
  {
    const bf16_t* kp = kvk + (size_t)b * SEQ * DM + 3 * 256 + g * 64; const bf16_t* vp = vT + (size_t)(((1 * NB + b) * 4 + g) * 64) * SEQ;
    const int j0 = c >= 8 ? c - 8 : 0, nj = c - j0 + 1;
    st_init(S);
    SWEEP(kp, DM, vp, SEQ, j0, nj, {
      AT_QKV();
      if ((step_ == 0 && c >= 8) || step_ == nj - 1) at_online<1>(S, p0, p1, (j0 + step_) * 64, t - 511, t, true, hh);
      else at_online<0>(S, p0, p1, 0, 0, 0, true, hh);
      at_pv(vfr, p0, p1, S.o0, S.o1); });
    const float lt = S.l + __shfl_xor(S.l, 32); const float sc = lt > 0.f ? gates(32) / lt : 0.f;
#pragma unroll
    for (int i = 0; i < 16; ++i) { otg(i) = S.o0[i] * sc; otg(16 + i) = S.o1[i] * sc; }
  }
  {
    const bf16_t* kcp = kcb + (size_t)((b * 4 + g) * 512) * 64; const bf16_t* vcp = vcb + (size_t)((b * 4 + g) * 64) * 512;
    const int nmax = t >= 31 ? (t - 31) >> 4 : -1;
    const int nct = (4 * c + 2) / 64 + 1;
    st_init(S);
    SWEEP(kcp, 64, vcp, 512, 0, nct, {
      at_ldk(lds, buf_, r, hh, kfr); __builtin_amdgcn_sched_barrier(0); at_qk(kfr, qf, p0, p1);
      if (64 * step_ + 63 <= 4 * c - 2) at_online<0>(S, p0, p1, 0, 0, 0, true, hh);
      else at_online<1>(S, p0, p1, step_ * 64, 0, nmax, true, hh); });
    const float lt = S.l + __shfl_xor(S.l, 32);
    const float cinv = lt > 0.f ? 1.f / lt : 0.f; const float cm = S.m;
    st_init(S);
    SWEEP(kcp, 64, vcp, 512, 0, nct, {
      AT_QKV();
      if (64 * step_ + 63 <= 4 * c - 2) {
        _Pragma("unroll") for (int k = 0; k < 16; ++k) { p0[k] = __builtin_amdgcn_exp2f(p0[k] - cm) * cinv; p1[k] = __builtin_amdgcn_exp2f(p1[k] - cm) * cinv; }
      } else {
        const int nrel = nmax - step_ * 64 - 4 * hh;
        _Pragma("unroll") for (int k = 0; k < 16; ++k) { const int c0 = (k & 3) + 8 * (k >> 2), c1 = c0 + 32;
          p0[k] = c0 <= nrel ? __builtin_amdgcn_exp2f(p0[k] - cm) * cinv : 0.f; p1[k] = c1 <= nrel ? __builtin_amdgcn_exp2f(p1[k] - cm) * cinv : 0.f; }
      }
      at_pv(vfr, p0, p1, S.o0, S.o1);
      _Pragma("unroll") for (int kh = 0; kh < 2; ++kh)
      _Pragma("unroll") for (int gi = 0; gi < 4; ++gi) {
          float g4 = kh == 0 ? (p0[4 * gi] + p0[4 * gi + 1]) + (p0[4 * gi + 2] + p0[4 * gi + 3]) : (p1[4 * gi] + p1[4 * gi + 1]) + (p1[4 * gi + 2] + p1[4 * gi + 3]);
          float e3 = kh == 0 ? p0[4 * gi + 3] : p1[4 * gi + 3];
          g4 += __shfl_xor(g4, 1); g4 += __shfl_xor(g4, 2); e3 += __shfl_xor(e3, 1); e3 += __shfl_xor(e3, 2);
          if (h == 0) { const int s = (step_ * 64 + kh * 32 + 8 * gi + 4 * hh) >> 2; IMP[qi * AT_IMPS + s] = g4; EE[qi * AT_IMPS + s] = e3; }
      } });
    const float gc = gates(0);
#pragma unroll
    for (int i = 0; i < 16; ++i) { p0[i] = otg(i); p1[i] = otg(16 + i); }
    __builtin_amdgcn_sched_barrier(0);
#pragma unroll
    for (int i = 0; i < 16; ++i) { otg(i) = p0[i] + S.o0[i] * gc; otg(16 + i) = p1[i] + S.o1[i] * gc; }
  }
  }
  const bf16_t* kps = (const bf16_t*)(P.ws + WS_KSF) + (size_t)((b * 4 + g) * 128) * 4096; const bf16_t* vps = vT + (size_t)((b * 4 + g) * 128) * 4096;
  if (c <= 15) { AT_IDS; QF_LOAD();
    st_init(S);
    if (c > 0) {
      SWEEPF(0, c, {
        AT_QKV();
        at_online<0>(S, p0, p1, 0, 0, 0, true, hh);
        at_pv(vfr, p0, p1, S.o0, S.o1); });
    }
    SWEEPF(c, 1, {
      AT_QKV();
      at_online<1>(S, p0, p1, (c + step_) * 64, 0, t, true, hh);
      at_pv(vfr, p0, p1, S.o0, S.o1); });
    const float lt = S.l + __shfl_xor(S.l, 32); const float slc_sc = lt > 0.f ? gates(16) / lt : 0.f;
    bf16_t* op = attn + (tok * DM + (g * 4 + h) * 64);
#pragma unroll
    for (int i = 0; i < 16; ++i) { S.o0[i] = S.o0[i] * slc_sc + otg(i); S.o1[i] = S.o1[i] * slc_sc + otg(16 + i); }
#pragma unroll
    for (int gi = 0; gi < 4; ++gi) {
      u32x2 a; a.x = pk2(S.o0[4 * gi], S.o0[4 * gi + 1]); a.y = pk2(S.o0[4 * gi + 2], S.o0[4 * gi + 3]);
      u32x2 bq; bq.x = pk2(S.o1[4 * gi], S.o1[4 * gi + 1]); bq.y = pk2(S.o1[4 * gi + 2], S.o1[4 * gi + 3]);
      *(u32x2*)(op + 8 * gi + 4 * hh) = a; *(u32x2*)(op + 32 + 8 * gi + 4 * hh) = bq;
    }
  } else {
    const int nc = c - 2;
    unsigned char* QL = lds + AT_QL; int* NJ = (int*)(lds + AT_NJ); unsigned short* ITEMS = (unsigned short*)(lds + AT_ITEMS); int* MISC = (int*)(lds + AT_MISC);
    float* MREF = (float*)(lds + AT_MREF); float* LS = (float*)(lds + AT_LACC); unsigned char* INVQ = lds + AT_INVQ; unsigned char* SLOT = lds + AT_IMP;
    float* const LOWN = (float*)(lds + AT_LOWN); const float k64 = 5.421010862427522e-20f;
    { AT_IDS;
    for (int idx = tid; idx < 64 * nc; idx += NTHR) { const int q = idx / nc, s = 1 + idx % nc; IMP[q * AT_IMPS + s] += EE[q * AT_IMPS + s - 1]; }
    if (tid < 256) SEL[tid] = 0u;
    if (tid < 128) ((unsigned*)INVQ)[tid] = 0u;
    __syncthreads();
    {
      const int q = tid >> 3, sub = tid & 7; const float* ip = IMP + q * AT_IMPS;
      unsigned key[16];
#pragma unroll
      for (int k = 0; k < 16; ++k) { const int s = 1 + sub + 8 * k; key[k] = s <= nc ? __float_as_uint(ip[s]) + 1u : 0u; }
      unsigned T = 0u;
      for (int bit = 30; bit >= 0; --bit) {
        const unsigned cand = T | (1u << bit); int cn = 0;
#pragma unroll
        for (int k = 0; k < 16; ++k) cn += key[k] >= cand ? 1 : 0;
        cn += __shfl_xor(cn, 1); cn += __shfl_xor(cn, 2); cn += __shfl_xor(cn, 4);
        if (cn >= 13) T = cand;
      }
      int ngt = 0, neq = 0;
#pragma unroll
      for (int k = 0; k < 16; ++k) { ngt += key[k] > T ? 1 : 0; neq += key[k] == T ? 1 : 0; }
      ngt += __shfl_xor(ngt, 1); ngt += __shfl_xor(ngt, 2); ngt += __shfl_xor(ngt, 4);
      neq += __shfl_xor(neq, 1); neq += __shfl_xor(neq, 2); neq += __shfl_xor(neq, 4);
      const int need = 13 - ngt;
      unsigned w0 = 0u, w1 = 0u, w2 = 0u, w3 = 0u;
      if (!__any(neq > need)) {
#pragma unroll
        for (int k = 0; k < 16; ++k) if (key[k] >= T && key[k] != 0u) { const int s = 1 + sub + 8 * k; const unsigned bt = 1u << (s & 31); if (s < 32) w0 |= bt; else if (s < 64) w1 |= bt; else if (s < 96) w2 |= bt; else w3 |= bt; }
      } else {
        int taken = 0; const int gsh = lane & ~7;
#pragma unroll
        for (int k = 0; k < 16; ++k) {
          const bool eq = key[k] == T && key[k] != 0u; const unsigned long long mk = __ballot(eq);
          const unsigned grp = (unsigned)(mk >> gsh) & 0xffu; const int before = __popc(grp & ((1u << sub) - 1u));
          const bool pick = key[k] > T || (eq && taken + before < need);
          taken += __popc(grp);
          if (pick) { const int s = 1 + sub + 8 * k; const unsigned bt = 1u << (s & 31); if (s < 32) w0 |= bt; else if (s < 64) w1 |= bt; else if (s < 96) w2 |= bt; else w3 |= bt; }
        }
      }
      if (w0) atomicOr(&SEL[q * 4], w0); if (w1) atomicOr(&SEL[q * 4 + 1], w1); if (w2) atomicOr(&SEL[q * 4 + 2], w2); if (w3) atomicOr(&SEL[q * 4 + 3], w3);
    }
    __syncthreads();
    for (int j = 1 + w; j <= nc; j += NWAVE) {
      const bool bit = (SEL[lane * 4 + (j >> 5)] >> (j & 31)) & 1u;
      const unsigned long long mk = __ballot(bit);
      const int rank = __builtin_amdgcn_mbcnt_hi((unsigned)(mk >> 32), __builtin_amdgcn_mbcnt_lo((unsigned)mk, 0u));
      if (bit) QL[j * 64 + rank] = (unsigned char)lane;
      const int cnt = __popcll(mk);
      if (lane < ((8 - (cnt & 7)) & 7)) QL[j * 64 + cnt + lane] = 0;
      if (lane == 0) NJ[j] = cnt;
    }
    __syncthreads();
    if (w == 0) {
      const int ja = 1 + lane, jb = 65 + lane;
      const int ca = ja <= nc ? (NJ[ja] + 7) >> 3 : 0, cb = jb <= nc ? (NJ[jb] + 7) >> 3 : 0;
      int sa = ca, sb = cb;
#pragma unroll
      for (int o = 1; o < 64; o <<= 1) { const int ta = __shfl_up(sa, o), tb = __shfl_up(sb, o); if (lane >= o) { sa += ta; sb += tb; } }
      const int tota = __shfl(sa, 63);
      for (int k = 0; k < ca; ++k) ITEMS[sa - ca + k] = (unsigned short)(ja * 8 + k);
      for (int k = 0; k < cb; ++k) ITEMS[tota + sb - cb + k] = (unsigned short)(jb * 8 + k);
      if (lane == 63) MISC[0] = tota + sb;
    }
    }
    { AT_IDS; QF_LOAD();
    st_init(S);
    SWEEPF(0, 1, {
      AT_QKV();
      at_online<0>(S, p0, p1, 0, 0, 0, true, hh);
      at_pv(vfr, p0, p1, S.o0, S.o1); });
    SWEEPF(c - 1, 2, {
      AT_QKV();
      if (step_ == 1) at_online<1>(S, p0, p1, c * 64, 0, t, true, hh); else at_online<0>(S, p0, p1, 0, 0, 0, true, hh);
      at_pv(vfr, p0, p1, S.o0, S.o1); });
    { const float lt = S.l + __shfl_xor(S.l, 32);
      if (hh == 0) { MREF[qrow] = S.m + 64.f; LS[w * 32 + r] = lt * k64; } }
#define SLOT_WRITE(x, o0_, o1_, scale_) do { unsigned char* sp_ = SLOT + (x) * 8192 + r * 256; \
      _Pragma("unroll") for (int gi_ = 0; gi_ < 4; ++gi_) { \
        const f32x4 va_ = {o0_[4 * gi_] * (scale_), o0_[4 * gi_ + 1] * (scale_), o0_[4 * gi_ + 2] * (scale_), o0_[4 * gi_ + 3] * (scale_)}; \
        const f32x4 vb_ = {o1_[4 * gi_] * (scale_), o1_[4 * gi_ + 1] * (scale_), o1_[4 * gi_ + 2] * (scale_), o1_[4 * gi_ + 3] * (scale_)}; \
        *(f32x4*)(sp_ + (((2 * gi_ + hh) ^ (r & 15)) * 16)) = va_; *(f32x4*)(sp_ + (((8 + 2 * gi_ + hh) ^ (r & 15)) * 16)) = vb_; } } while (0)
#define SLOT_READ(x, col_) (*(const f32x4*)(SLOT + (x) * 8192 + (col_) * 256 + ((ach ^ ((col_) & 15)) * 16)))
    SLOT_WRITE(w, S.o0, S.o1, k64);
    __syncthreads();
    }
    {
      AT_IDS; const int wu = __builtin_amdgcn_readfirstlane(w);
      const int nitems = MISC[0], nrounds = (nitems + 3) >> 2;
      if (wu >= 4) {
        const int ow = wu - 4, oq = lane >> 2, oh = lane & 3, srcslot = 2 * ow + (lane >> 5), scol = lane & 31;
        f32x4 acc[16]; float accl;
        { const unsigned char* rp = SLOT + srcslot * 8192 + scol * 256;
#pragma unroll
          for (int k = 0; k < 16; ++k) acc[k] = *(const f32x4*)(rp + ((k ^ (scol & 15)) * 16));
          accl = LS[srcslot * 32 + scol]; }
        __syncthreads();
        for (int rd = 0; rd <= nrounds; ++rd) {
          if (rd > 0) {
            const int set = (rd - 1) & 1;
            unsigned* ivp = (unsigned*)(INVQ + set * 256) + 16 * ow + oq;
            unsigned iv = *ivp;
            if (__any(iv != 0u)) {
              if (iv != 0u && oh == 0) *ivp = 0u;
              do {
                const int x = (iv & 0xffu) ? 0 : (iv & 0xff00u) ? 1 : (iv & 0xff0000u) ? 2 : 3;
                const unsigned byte = (iv >> (8 * x)) & 0xffu;
                iv &= ~(0xffu << (8 * x));
                if (byte) {
                  const int col = (int)(byte - 1) * 4 + oh;
                  const unsigned char* rp = SLOT + (set * 4 + x) * 8192 + col * 256;
                  f32x4 tq[16];
#pragma unroll
                  for (int k = 0; k < 16; ++k) tq[k] = *(const f32x4*)(rp + ((k ^ (col & 15)) * 16));
                  const float tl = LS[(set * 4 + x) * 32 + col];
                  __builtin_amdgcn_sched_barrier(0);
#pragma unroll
                  for (int k = 0; k < 16; ++k) acc[k] += tq[k];
                  accl += tl;
                }
              } while (__any(iv != 0u));
            }
          }
          __syncthreads();
        }
#pragma unroll
        for (int i = 0; i < 16; ++i) { S.o0[i] = otg(i); S.o1[i] = otg(16 + i); }
        SLOT_WRITE(w, S.o0, S.o1, 1.0f);
        __syncthreads();
        {
          const unsigned tq = (unsigned)b * SEQ + 64 * c + 16 * ow + oq;
          const float gs = gbase[tq * 48 + 16 + g * 4 + oh]; const float sc = accl > 0.f ? gs / accl : 0.f;
          const unsigned char* rp = SLOT + srcslot * 8192 + scol * 256;
          bf16_t* op = attn + (tq * DM + (g * 4 + oh) * 64);
#pragma unroll
          for (int k2 = 0; k2 < 8; ++k2) {
            const f32x4 v0 = acc[2 * k2] * sc + *(const f32x4*)(rp + (((2 * k2) ^ (scol & 15)) * 16)), v1 = acc[2 * k2 + 1] * sc + *(const f32x4*)(rp + (((2 * k2 + 1) ^ (scol & 15)) * 16));
            u32x4 o; o.x = pk2(v0.x, v0.y); o.y = pk2(v0.z, v0.w); o.z = pk2(v1.x, v1.y); o.w = pk2(v1.z, v1.w);
            *(u32x4*)(op + 8 * k2) = o;
          }
        }
      } else {
        __syncthreads();
        const bf16_t* kgl = kps + lane * 8; const bf16_t* vgl = vps + lane * 8;
        bf16x8 kfA[8], vfA[8], kfB[8], vfB[8];
#define FLOAD(KF, VF, jj) do { _Pragma("unroll") for (int f_ = 0; f_ < 8; ++f_) { KF[f_] = *(const bf16x8*)(kgl + (size_t)(jj) * 4096 + f_ * 512); VF[f_] = *(const bf16x8*)(vgl + (size_t)(jj) * 4096 + f_ * 512); } } while (0)
        int rowc = 0, qqc = 0; bool validc = false; float mrc = 1e30f; int en = 0;
        if (wu < nitems) { const int e0 = ITEMS[wu]; const int j0_ = e0 >> 3; const int qs_ = 8 * (e0 & 7) + (r >> 2); validc = qs_ < NJ[j0_]; qqc = QL[j0_ * 64 + qs_]; rowc = qqc * 4 + h; mrc = validc ? MREF[rowc] : 1e30f; FLOAD(kfA, vfA, j0_); }
        if (wu + 4 < nitems) en = __builtin_amdgcn_readfirstlane(ITEMS[wu + 4]);
        FLOAD(kfB, vfB, en >> 3);
#define ITEM_ROUND(KF, VF, rd_) do { \
          const int it = (rd_) * 4 + wu, set = (rd_) & 1; \
          if (it < nitems) { \
            const bool hasn = it + 4 < nitems; \
            const int jn = en >> 3, qsn = 8 * (en & 7) + (r >> 2);        \
            bf16x8 qv[4];                                               \
            _Pragma("unroll") for (int ds = 0; ds < 4; ++ds) qv[ds] = *(const bf16x8*)(lds + AT_QS + rowc * 128 + (((ds * 2 + hh) ^ (rowc & 7)) * 16)); \
            const int njn = NJ[jn]; const int qqn = QL[jn * 64 + qsn]; \
            const int en2 = it + 8 < nitems ? __builtin_amdgcn_readfirstlane(ITEMS[it + 8]) : 0; const int j2 = en2 >> 3; \
            __builtin_amdgcn_sched_barrier(0); \
            const f32x16 z = {0.f, 0.f, 0.f, 0.f, 0.f, 0.f, 0.f, 0.f, 0.f, 0.f, 0.f, 0.f, 0.f, 0.f, 0.f, 0.f}; \
            _Pragma("unroll") for (int ds = 0; ds < 4; ++ds) { \
              if (ds == 0) { p0 = MFMA32(KF[0], qv[0], z); p1 = MFMA32(KF[4], qv[0], z); } else { p0 = MFMA32(KF[ds], qv[ds], p0); p1 = MFMA32(KF[4 + ds], qv[ds], p1); } \
            } \
            const bool validn = hasn && qsn < njn; const int rown = qqn * 4 + h; \
            const float mrn = validn ? MREF[rown] : 1e30f; \
            float rs = 0.f; \
            _Pragma("unroll") for (int i = 0; i < 16; ++i) { \
              p0[i] = __builtin_amdgcn_exp2f(fminf(p0[i] - mrc, 120.f)); p1[i] = __builtin_amdgcn_exp2f(fminf(p1[i] - mrc, 120.f)); rs += p0[i] + p1[i]; \
              if (i & 1) { KF[i >> 1] = *(const bf16x8*)(kgl + (size_t)j2 * 4096 + (i >> 1) * 512); __builtin_amdgcn_sched_barrier(0); } \
            } \
            rs += __shfl_xor(rs, 32); \
            f32x16 o0 = z, o1 = z; \
            _Pragma("unroll") for (int gk = 0; gk < 4; ++gk) { const bf16x8 pb = (gk < 2) ? pack8(p0, gk & 1) : pack8(p1, gk & 1); o0 = MFMA32(VF[gk], pb, o0); o1 = MFMA32(VF[4 + gk], pb, o1); } \
            { unsigned char* sp_ = SLOT + (set * 4 + wu) * 8192 + r * 256; \
              _Pragma("unroll") for (int gi = 0; gi < 4; ++gi) { \
                const f32x4 va_ = {o0[4 * gi], o0[4 * gi + 1], o0[4 * gi + 2], o0[4 * gi + 3]}; const f32x4 vb_ = {o1[4 * gi], o1[4 * gi + 1], o1[4 * gi + 2], o1[4 * gi + 3]}; \
                *(f32x4*)(sp_ + (((2 * gi + hh) ^ (r & 15)) * 16)) = va_; *(f32x4*)(sp_ + (((8 + 2 * gi + hh) ^ (r & 15)) * 16)) = vb_; \
                VF[2 * gi] = *(const bf16x8*)(vgl + (size_t)j2 * 4096 + (2 * gi) * 512); VF[2 * gi + 1] = *(const bf16x8*)(vgl + (size_t)j2 * 4096 + (2 * gi + 1) * 512); \
                __builtin_amdgcn_sched_barrier(0); \
              } } \
            if (hh == 0) LS[(set * 4 + wu) * 32 + r] = rs; \
            if (validc && h == 0 && hh == 0) INVQ[set * 256 + qqc * 4 + wu] = (unsigned char)((r >> 2) + 1); \
            rowc = rown; qqc = qqn; validc = validn; mrc = mrn; en = en2; \
          } } while (0)
        for (int rd = 0; rd < nrounds; rd += 2) {
          ITEM_ROUND(kfA, vfA, rd);
          __syncthreads();
          if (rd + 1 < nrounds) {
            ITEM_ROUND(kfB, vfB, rd + 1);
            __syncthreads();
          }
        }
#undef ITEM_ROUND
#undef FLOAD
#undef ITEM_META
#undef KLOAD
#undef VLOAD
        __syncthreads();
#pragma unroll
        for (int i = 0; i < 16; ++i) { S.o0[i] = otg(i); S.o1[i] = otg(16 + i); }
        SLOT_WRITE(w, S.o0, S.o1, 1.0f);
        __syncthreads();
      }
    }
#undef SLOT_WRITE
#undef SLOT_READ
  }
  __syncthreads();
#undef ST_LOAD
#undef ST_STORE
#undef SWEEP
#undef ST_LOADF
#undef ST_STOREF
#undef SWEEPF
#undef gates
#undef otg
#undef QF_LOAD
#undef AT_QKV
#undef AT_IDS
}
DI void phase_attn(const Params& P_, unsigned char* lds) {
  Params P = P_; { size_t z_ = 0; asm volatile("" : "+s"(z_)); P.ws = P_.ws + z_; }
  const int G = gridDim.x, bx = obid();
  const int vcu = (G % 8 == 0) ? (bx % 8) * (G / 8) + bx / 8 : bx;
  for (int idx = vcu; idx < 1024; idx += G) {
    const int i = idx >> 8, v = idx & 255, bg = v >> 5, s = v & 31;
    const int c = i == 0 ? s : i == 1 ? 63 - s : i == 2 ? 64 + s : 127 - s;
    attn_tile(P, lds, bg >> 2, bg & 3, c);
  }
}


#define LAS __attribute__((address_space(3)))
#define XB_TMO      128
#define XB_XCNT(j)  (256  + 64 * (j))
#define XB_XSUB(j)  (1280 + 64 * (j))
#define XB_XGEN(j)  (2304 + 64 * (j))
#define XB_TOP      3328
#define XB_TOPGEN   3392
#define XCD_BAR_WORDS 3456
#define XB_SPIN_CAP (1u << 18)
__device__ __forceinline__ unsigned xb_ld(unsigned* p)              { return __hip_atomic_load(p, __ATOMIC_RELAXED, __HIP_MEMORY_SCOPE_AGENT); }
__device__ __forceinline__ unsigned xb_add(unsigned* p, unsigned v) { return __hip_atomic_fetch_add(p, v, __ATOMIC_RELAXED, __HIP_MEMORY_SCOPE_AGENT); }
__device__ __forceinline__ unsigned xb_xcc_id() { return (unsigned)__builtin_amdgcn_s_getreg((3 << 11) | 20) & 0xFu; }
#define XB_SPIN(cond, bar) do { unsigned _sp = 0; while (cond) { __builtin_amdgcn_s_sleep(1); \
    if ((++_sp & 255u) == 0u) { if (xb_ld(&(bar)[XB_TMO])) break; if (_sp > XB_SPIN_CAP) { atomicAdd(&(bar)[XB_TMO], 1u); break; } } } } while (0)
struct XcdBarrier { unsigned* bar; unsigned x; volatile LAS unsigned* st; };
__device__ __forceinline__ XcdBarrier xcd_barrier_post(unsigned* bar, volatile LAS unsigned* st) {
    XcdBarrier b; b.bar = bar; b.x = xb_xcc_id(); b.st = st;
    if (threadIdx.x == 0) (void)xb_add(&bar[XB_XCNT(b.x)], 1u);
    return b;
}
__device__ __forceinline__ void xcd_barrier_complete(unsigned* bar, unsigned x, unsigned& nloc, unsigned& nx) {
    const unsigned G = gridDim.x * gridDim.y * gridDim.z;
    unsigned sum, cnt, mine, sp = 0u;
    for (;;) {
        sum = 0u; cnt = 0u; mine = 0u;
#pragma unroll
        for (unsigned j = 0; j < 16; ++j) { const unsigned c = xb_ld(&bar[XB_XCNT(j)]); sum += c; cnt += (c > 0u) ? 1u : 0u; mine = (j == x) ? c : mine; }
        if (sum == G) break;
        __builtin_amdgcn_s_sleep(1);
        if ((++sp & 255u) == 0u) { if (xb_ld(&bar[XB_TMO])) break; if (sp > XB_SPIN_CAP) { atomicAdd(&bar[XB_TMO], 1u); break; } }
    }
    nloc = mine > 0u ? mine : 1u; nx = cnt > 0u ? cnt : 1u;
}
__device__ __forceinline__ void xcd_barrier(const XcdBarrier& b) {
    asm volatile("s_waitcnt vmcnt(0)" ::: "memory");
    __syncthreads();
    if (threadIdx.x == 0) {
        unsigned* bar = b.bar; { size_t z_ = 0; asm volatile("" : "+s"(z_)); bar += z_; }
        __builtin_amdgcn_s_waitcnt(0);
        unsigned nloc = b.st[0], nx = b.st[1];
        if (nloc == 0u) { xcd_barrier_complete(bar, b.x, nloc, nx); b.st[0] = nloc; b.st[1] = nx; }
        const unsigned old = xb_add(&bar[XB_XSUB(b.x)], 1u);
        const unsigned gen = old / nloc;
        if (old + 1u == (gen + 1u) * nloc) {
            __builtin_amdgcn_fence(__ATOMIC_RELEASE, "agent");
            asm volatile("s_waitcnt vmcnt(0)" ::: "memory");
            const unsigned og = xb_add(&bar[XB_TOP], 1u);
            const unsigned tg = og / nx;
            if (og + 1u == (tg + 1u) * nx) xb_add(&bar[XB_TOPGEN], 1u);
            else XB_SPIN(xb_ld(&bar[XB_TOPGEN]) == tg, bar);
            __builtin_amdgcn_fence(__ATOMIC_ACQUIRE, "agent");
            xb_add(&bar[XB_XGEN(b.x)], 1u);
            asm volatile("s_waitcnt vmcnt(0)" ::: "memory");
        } else {
            XB_SPIN(xb_ld(&bar[XB_XGEN(b.x)]) == gen, bar);
            __builtin_amdgcn_fence(__ATOMIC_ACQUIRE, "agent");
            asm volatile("s_waitcnt vmcnt(0)" ::: "memory");
        }
    }
    __syncthreads();
}

__global__ void __launch_bounds__(NTHR) fwd_kernel(Params P) {
  extern __shared__ __attribute__((aligned(16))) unsigned char lds[];
  cg::grid_group grid = cg::this_grid();
  const int gtid = blockIdx.x * NTHR + threadIdx.x;
  if (threadIdx.x < 4) ((unsigned*)(lds + LDS_BYTES - 16))[threadIdx.x] = 0u;
  __syncthreads();
  const XcdBarrier xbar = xcd_barrier_post((unsigned*)(P.ws + WS_BAR), (volatile LAS unsigned*)(lds + LDS_BYTES - 16));
#define GSYNC() xcd_barrier(xbar)
  s5_params(P, gtid);
  {
    float* modb = (float*)(P.ws + WS_MOD); float* cbb = (float*)(P.ws + WS_CB);
    for (int it = blockIdx.x; it < 192 + 16; it += gridDim.x) {
      if (it < 192) { const int l = it / 96, j0 = (it % 96) * 64;
        gemv_item((float*)lds, P.in[2] + (size_t)l * DM * 6144, DM, 6144, j0, P.in[1], P.in[1] + DM, true, P.in[3] + l * 6144, modb + (size_t)(l * 2) * 6144, modb + (size_t)(l * 2 + 1) * 6144);
      } else { const int r = it - 192, l = r >> 3, kv = (r >> 2) & 1, j0 = (r & 3) * 64;
        gemv_item((float*)lds, P.in[17] + (size_t)(l * 2 + kv) * 2048 * 256, 2048, 256, j0, P.in[16] + (size_t)(l * 2 + kv) * 2048, nullptr, false, nullptr, cbb + (l * 2 + kv) * 256, nullptr);
      }
    }
  }
  for (int it = blockIdx.x; it < DEPTH * 32 * 6; it += gridDim.x) s5_tables(P, it / 192, (it % 192) / 6, it % 6, lds);
  convert_weights(P, 0, lds);
  grid.sync();
  for (int l = 0; l < DEPTH; ++l) {
    if (l == 0) norm_simple<0>(P, l); else { norm_simple<1>(P, l); convert_weights(P, 1, lds); }
    GSYNC();
#if EN_MIXER
    phase_inproj8(P, lds);
    GSYNC();
    phase_s5a(P, l, lds);
    __syncthreads();
#if EN_ATTN
    phase_gates(P, lds);
    __syncthreads();
    phase_cmp1(P, l, lds);
#endif
    GSYNC();
    s5_carry(P, l);
#if EN_ATTN
    phase_cmp2(P, lds);
#endif
    GSYNC();
#if EN_ATTN
    phase_attn(P, lds);
    __syncthreads();
#endif
    phase_s5c(P, l, lds);
    GSYNC();
    phase_glu(P, lds);
    GSYNC();
    phase_merge8(P, lds);
    GSYNC();
    phase_wout8(P, l, lds);
    GSYNC();
#else
    if (l == 0) { for (size_t i = (size_t)gtid * 4; i < (size_t)NT * DM; i += (size_t)gridDim.x * NTHR * 4) *(f32x4*)(P.out + i) = *(const f32x4*)(P.in[0] + i); GSYNC(); }
#endif
#if EN_MOE
    norm_route(P, l, lds);
    GSYNC();
    phase_moe1(P, l, lds);
    GSYNC();
    phase_moe2(P, l, lds);
    GSYNC();
#endif
  }
  norm_simple<3>(P, 0);
}

extern "C" void kernel_launch(void* const* d_in, const int* in_sizes, int n_in, void* d_out, int out_size, void* d_ws, size_t ws_size, hipStream_t stream) {
  static int grid = 0;
  if (grid == 0) {
    if (n_in != 30 || out_size != NT * DM || ws_size < WS_END2) { fprintf(stderr, "kernel_launch: unexpected shapes (n_in %d out %d ws %zu need %zu)\n", n_in, out_size, ws_size, (size_t)WS_END2); grid = -1; return; }
    int dev = 0, cus = 0, per_cu = 0;
    hipGetDevice(&dev);
    hipDeviceGetAttribute(&cus, hipDeviceAttributeMultiprocessorCount, dev);
    hipFuncSetAttribute((const void*)fwd_kernel, hipFuncAttributeMaxDynamicSharedMemorySize, LDS_BYTES);
    hipOccupancyMaxActiveBlocksPerMultiprocessor(&per_cu, (const void*)fwd_kernel, NTHR, LDS_BYTES);
    if (per_cu < 1) { fprintf(stderr, "kernel_launch: occupancy query says %d blocks/CU\n", per_cu); per_cu = 1; }
    grid = cus;
    (void)hipGetLastError();
  }
  if (grid < 0) return;
  Params p{};
  for (int i = 0; i < 30; ++i) p.in[i] = (const float*)d_in[i];
  p.out = (float*)d_out; p.ws = (unsigned char*)d_ws;
  if (hipMemsetAsync(p.ws, 0, WS_ZERO_BYTES, stream) != hipSuccess) { fprintf(stderr, "kernel_launch: memset failed\n"); return; }
  void* args[] = {&p};
  hipError_t e = hipLaunchCooperativeKernel((const void*)fwd_kernel, dim3(grid), dim3(NTHR), args, LDS_BYTES, stream);
  if (e != hipSuccess) fprintf(stderr, "cooperative launch failed: %s (grid %d)\n", hipGetErrorString(e), grid);
}
```

```cpp
#include <hip/hip_runtime.h>
#include <hip/hip_cooperative_groups.h>
#include <cstdio>
#include <cstdint>
namespace cg = cooperative_groups;

#ifndef EN_MIXER
#define EN_MIXER 1
#endif
#ifndef EN_ATTN
#define EN_ATTN 1
#endif
#ifndef EN_MOE
#define EN_MOE 1
#endif

#define DI __device__ __forceinline__
typedef unsigned short bf16_t;
typedef short bf16x8 __attribute__((ext_vector_type(8)));
typedef short s16x4 __attribute__((ext_vector_type(4)));
typedef float f32x4 __attribute__((ext_vector_type(4)));
typedef float f32x16 __attribute__((ext_vector_type(16)));
typedef unsigned u32x4 __attribute__((ext_vector_type(4)));
typedef unsigned u32x2 __attribute__((ext_vector_type(2)));

constexpr int DM = 1024, NB = 2, SEQ = 8192, NT = NB * SEQ, DEPTH = 2;
constexpr int INW = 5168, INWP = 5376;
constexpr int NTHR = 512, NWAVE = 8;
constexpr int NEXP = 32, LISTCAP = 16384;
constexpr float EPS = 1e-6f;
constexpr float QSCALE = 0.125f * 1.4426950408889634f;

constexpr size_t MiB = 1u << 20;
constexpr size_t WS_CNT = 0;
constexpr size_t WS_BAR = 1024;
constexpr size_t WS_ZERO_BYTES = 16384;
constexpr size_t WS_MOD = 16384;
constexpr size_t WS_CB = WS_MOD + 2 * 2 * 6144 * 4;
constexpr size_t WS_S5P = WS_CB + 2 * 2 * 256 * 4;
constexpr size_t WS_WT = WS_S5P + 2 * 32 * 64 * 36 * 4;
constexpr size_t WS_SMALL_END = WS_WT + (size_t)NT * 2 * 4;
static_assert(WS_SMALL_END <= 1 * MiB, "small region");
constexpr size_t WS_W = 1 * MiB;
constexpr size_t W_IN = 0;
constexpr size_t W_GLU = W_IN + (size_t)INWP * 1024 * 2;
constexpr size_t W_O = W_GLU + 512 * 512 * 2;
constexpr size_t W_SO = W_O + 1024 * 1024 * 2;
constexpr size_t W_OUT = W_SO + 1024 * 512 * 2;
constexpr size_t W_C1 = W_OUT + 1024 * 1024 * 2;
constexpr size_t W_C2 = W_C1 + 2 * 256 * 2048 * 2;
constexpr size_t W_GU = W_C2 + 2 * 128 * 256 * 2;
constexpr size_t W_D = W_GU + (size_t)32 * 512 * 1024 * 2;
constexpr size_t W_END = W_D + (size_t)32 * 1024 * 256 * 2;
static_assert(W_END <= 67 * MiB, "weights region");
constexpr size_t WS_A = 68 * MiB;
constexpr size_t WS_B = WS_A + 32 * MiB;
constexpr size_t WS_C = WS_B + 32 * MiB;
constexpr size_t WS_DV = WS_C + 32 * MiB;
constexpr size_t WS_E = WS_DV + 16 * MiB;
constexpr size_t WS_F = WS_E + 32 * MiB;
constexpr size_t WS_G = WS_F + 64 * MiB;
constexpr size_t WS_GATES = WS_G + 16 * MiB;
constexpr size_t WS_HID = WS_GATES + 3 * MiB;
constexpr size_t WS_KC = WS_HID + 4 * MiB;
constexpr size_t WS_VC = WS_KC + 512 * 1024;
constexpr size_t WS_L = WS_VC + 512 * 1024;
constexpr size_t WS_LIST = WS_L + 4 * MiB;
constexpr size_t WS_OT = WS_LIST + 2 * MiB;
constexpr size_t WS_TAB = WS_OT + 16 * MiB;
constexpr size_t TAB_KT = 0, TAB_M1 = 1 * MiB, TAB_M2 = 9 * MiB, TAB_LAYER = 17 * MiB;
constexpr size_t WS_END = WS_TAB + 2 * TAB_LAYER;
constexpr size_t WS_KSF = WS_END;
constexpr size_t WS_END2 = WS_KSF + 8 * MiB;
constexpr size_t WS_SIN = WS_E + 16 * MiB;
constexpr int LDS_BYTES = 151552;

struct Params { const float* in[30]; float* out; unsigned char* ws; };

DI int otid() { int t = threadIdx.x; asm volatile("" : "+v"(t)); return t; }
DI int obid() { int t = blockIdx.x; asm volatile("" : "+s"(t)); return t; }
DI unsigned f2bf(float f) { unsigned u = __float_as_uint(f); return (u + 0x7fffu + ((u >> 16) & 1u)) >> 16; }
typedef float f32x2_t __attribute__((ext_vector_type(2))); typedef __bf16 bf16x2_t __attribute__((ext_vector_type(2)));
DI unsigned pk2(float lo, float hi) { const f32x2_t v = {lo, hi}; const bf16x2_t b = __builtin_convertvector(v, bf16x2_t); return __builtin_bit_cast(unsigned, b); }
DI float bflo(unsigned w) { return __uint_as_float(w << 16); }
DI float bfhi(unsigned w) { return __uint_as_float(w & 0xffff0000u); }
DI int perm16(int x) { return (x & ~12) | ((x & 4) << 1) | ((x & 8) >> 1); }
DI float wave_sum(float v) {
#pragma unroll
  for (int o = 1; o < 64; o <<= 1) v += __shfl_xor(v, o);
  return v;
}
DI float sigmoidf_(float x) { return __builtin_amdgcn_rcpf(1.f + __expf(-x)); }
DI float gelu_tanh(float x) {
  const float z = 0.7978845608028654f * (x + 0.044715f * x * x * x);
  const float e = __expf(2.f * z);
  const float th = 1.f - 2.f * __builtin_amdgcn_rcpf(e + 1.f);
  return 0.5f * x * (1.f + th);
}
DI void sincos_d(double x, double& s, double& c) {
  const double k = rint(x * 0.6366197723675814);
  double r = fma(-k, 1.5707963267948966, x);
  r = fma(-k, 6.123233995736766e-17, r);
  const int q = ((int)k) & 3;
  const double r2 = r * r;
  const double sp = r * (1.0 + r2 * (-1.0 / 6 + r2 * (1.0 / 120 + r2 * (-1.0 / 5040 + r2 * (1.0 / 362880 + r2 * (-1.0 / 39916800 + r2 * (1.0 / 6227020800.0)))))));
  const double cp = 1.0 + r2 * (-0.5 + r2 * (1.0 / 24 + r2 * (-1.0 / 720 + r2 * (1.0 / 40320 + r2 * (-1.0 / 3628800 + r2 * (1.0 / 479001600 + r2 * (-1.0 / 87178291200.0)))))));
  s = (q == 0) ? sp : (q == 1) ? cp : (q == 2) ? -sp : -cp;
  c = (q == 0) ? cp : (q == 1) ? -sp : (q == 2) ? -cp : sp;
}

DI void gemv_item(float* lds, const float* W, int K, int N, int j0, const float* v0, const float* v1, bool do_silu, const float* bias, float* o0, float* o1) {
  const int tid = otid();
  float* sv = lds; float* red = lds + 4096;
  for (int k = tid; k < K; k += NTHR) {
    float a = v0[k], b = v1 ? v1[k] : 0.f;
    if (do_silu) { a = a / (1.f + expf(-a)); b = b / (1.f + expf(-b)); }
    sv[k] = a; sv[2048 + k] = b;
  }
  __syncthreads();
  const int jl = tid & 63, ks = tid >> 6, kper = K >> 3;
  const float* wp = W + (size_t)(ks * kper) * N + j0 + jl;
  float a0 = 0.f, a1 = 0.f;
#pragma unroll 8
  for (int k = 0; k < kper; ++k) { const float w = wp[(size_t)k * N]; a0 += sv[ks * kper + k] * w; a1 += sv[2048 + ks * kper + k] * w; }
  red[(ks * 64 + jl) * 2] = a0; red[(ks * 64 + jl) * 2 + 1] = a1;
  __syncthreads();
  if (tid < 64) {
    float s0 = 0.f, s1 = 0.f;
    for (int i = 0; i < 8; ++i) { s0 += red[(i * 64 + tid) * 2]; s1 += red[(i * 64 + tid) * 2 + 1]; }
    const float bb = bias ? bias[j0 + tid] : 0.f;
    o0[j0 + tid] = s0 + bb; if (o1) o1[j0 + tid] = s1 + bb;
  }
  __syncthreads();
}

DI void s5_params(const Params& P, int gtid) {
  if (gtid >= DEPTH * 32 * 64) return;
  const int l = gtid / 2048, g = (gtid / 64) % 32, p = gtid % 64;
  const float dt = expf(P.in[8][l * 32 + g]);
  const float lr = P.in[6][(l * 32 + g) * 64 + p], li = P.in[7][(l * 32 + g) * 64 + p];
  const float mag = expf(lr * dt); const float ang = li * dt;
  double sd, cd; sincos_d((double)ang, sd, cd);
  const float ab_re = mag * (float)cd, ab_im = mag * (float)sd;
  float* o = (float*)(P.ws + WS_S5P) + (size_t)((l * 32 + g) * 64 + p) * 36;
  o[0] = ab_re; o[1] = ab_im;
  double pr = ab_re, pi = ab_im;
  for (int i = 0; i < 6; ++i) { const double nr2 = pr * pr - pi * pi, ni2 = 2.0 * pr * pi; pr = nr2; pi = ni2; }
  o[2] = (float)pr; o[3] = (float)pi;
}

DI void s5_tables(const Params& P, int l, int g, int part, unsigned char* lds) {
  const int tid = otid(), lane = tid & 63;
  float* BBr = (float*)lds; float* BBi = BBr + 1024; float* CR = BBi + 1024; float* CI = CR + 1024;
  float* APr = CI + 1024; float* APi = APr + 65 * 64;
  bf16_t* tab = (bf16_t*)(P.ws + WS_TAB + (size_t)l * TAB_LAYER);
  bf16_t* Kt = tab + TAB_KT / 2 + (size_t)g * 64 * 256; bf16_t* M1 = tab + TAB_M1 / 2 + (size_t)g * 128 * 1024; bf16_t* M2 = tab + TAB_M2 / 2 + (size_t)g * 1024 * 128;
  __syncthreads();
  if (tid < 64) {
    const int p = tid;
    const float dt = expf(P.in[8][l * 32 + g]);
    const float lr = P.in[6][(l * 32 + g) * 64 + p], li = P.in[7][(l * 32 + g) * 64 + p];
    const float mag = expf(lr * dt); const float ang = li * dt;
    double sd, cd; sincos_d((double)ang, sd, cd);
    const float ab_re = mag * (float)cd, ab_im = mag * (float)sd;
    const float den = lr * lr + li * li, nr = ab_re - 1.0f;
    const float cr = (nr * lr + ab_im * li) / den, ci = (ab_im * lr - nr * li) / den;
    const float* br = P.in[9] + (size_t)((l * 32 + g) * 64 + p) * 16; const float* bi = P.in[10] + (size_t)((l * 32 + g) * 64 + p) * 16;
    for (int h = 0; h < 16; ++h) { BBr[p * 16 + h] = cr * br[h] - ci * bi[h]; BBi[p * 16 + h] = cr * bi[h] + ci * br[h]; }
    double pr = 1.0, pi = 0.0;
    for (int tau = 0; tau <= 64; ++tau) { APr[tau * 64 + p] = (float)pr; APi[tau * 64 + p] = (float)pi; const double n1 = pr * ab_re - pi * ab_im, n2 = pr * ab_im + pi * ab_re; pr = n1; pi = n2; }
  }
  for (int i = tid; i < 1024; i += NTHR) { CR[i] = P.in[11][(size_t)(l * 32 + g) * 1024 + i]; CI[i] = P.in[12][(size_t)(l * 32 + g) * 1024 + i]; }
  __syncthreads();
  if (part < 4)
  for (int task = part * 256 + tid; task < part * 256 + 256; task += NTHR) {
    const int tau = task >> 4, h = task & 15;
    float a[16];
#pragma unroll
    for (int j = 0; j < 16; ++j) a[j] = 0.f;
    for (int p = 0; p < 64; ++p) {
      const float c_r = CR[h * 64 + p], c_i = CI[h * 64 + p], a_r = APr[tau * 64 + p], a_i = APi[tau * 64 + p];
      const float xr = c_r * a_r - c_i * a_i, xi = c_r * a_i + c_i * a_r;
#pragma unroll
      for (int j4 = 0; j4 < 4; ++j4) { const f32x4 b_r = *(const f32x4*)(BBr + p * 16 + 4 * j4), b_i = *(const f32x4*)(BBi + p * 16 + 4 * j4);
        a[4 * j4] += xr * b_r.x - xi * b_i.x; a[4 * j4 + 1] += xr * b_r.y - xi * b_i.y; a[4 * j4 + 2] += xr * b_r.z - xi * b_i.z; a[4 * j4 + 3] += xr * b_r.w - xi * b_i.w; }
    }
    u32x4 o0, o1; o0.x = pk2(a[0], a[1]); o0.y = pk2(a[2], a[3]); o0.z = pk2(a[4], a[5]); o0.w = pk2(a[6], a[7]); o1.x = pk2(a[8], a[9]); o1.y = pk2(a[10], a[11]); o1.z = pk2(a[12], a[13]); o1.w = pk2(a[14], a[15]);
    *(u32x4*)(Kt + (size_t)task * 16) = o0; *(u32x4*)(Kt + (size_t)task * 16 + 8) = o1;
  }
  if (part == 4)
  for (int task = tid; task < 4096; task += NTHR) {
    const int p = task >> 6, i = task & 63;
    const float a_r = APr[(63 - i) * 64 + p], a_i = APi[(63 - i) * 64 + p];
    float re[16], im[16];
#pragma unroll
    for (int j = 0; j < 16; ++j) { const float b_r = BBr[p * 16 + j], b_i = BBi[p * 16 + j]; re[j] = a_r * b_r - a_i * b_i; im[j] = a_r * b_i + a_i * b_r; }
    u32x4 o; bf16_t* d0 = M1 + (size_t)(2 * p) * 1024 + i * 16; bf16_t* d1 = d0 + 1024;
    o.x = pk2(re[0], re[1]); o.y = pk2(re[2], re[3]); o.z = pk2(re[4], re[5]); o.w = pk2(re[6], re[7]); *(u32x4*)d0 = o;
    o.x = pk2(re[8], re[9]); o.y = pk2(re[10], re[11]); o.z = pk2(re[12], re[13]); o.w = pk2(re[14], re[15]); *(u32x4*)(d0 + 8) = o;
    o.x = pk2(im[0], im[1]); o.y = pk2(im[2], im[3]); o.z = pk2(im[4], im[5]); o.w = pk2(im[6], im[7]); *(u32x4*)d1 = o;
    o.x = pk2(im[8], im[9]); o.y = pk2(im[10], im[11]); o.z = pk2(im[12], im[13]); o.w = pk2(im[14], im[15]); *(u32x4*)(d1 + 8) = o;
  }
  if (part == 5)
  for (int task = tid; task < 4096; task += NTHR) {
    const int th = task >> 2, pq = task & 3, t = th >> 4, h = th & 15;
    unsigned w[16];
#pragma unroll
    for (int j = 0; j < 16; ++j) { const int p = pq * 16 + j;
      const float c_r = CR[h * 64 + p], c_i = CI[h * 64 + p], a_r = APr[(t + 1) * 64 + p], a_i = APi[(t + 1) * 64 + p];
      w[j] = pk2(c_r * a_r - c_i * a_i, -(c_r * a_i + c_i * a_r)); }
    bf16_t* d = M2 + (size_t)th * 128 + pq * 32;
    *(u32x4*)d = (u32x4){w[0], w[1], w[2], w[3]}; *(u32x4*)(d + 8) = (u32x4){w[4], w[5], w[6], w[7]};
    *(u32x4*)(d + 16) = (u32x4){w[8], w[9], w[10], w[11]}; *(u32x4*)(d + 24) = (u32x4){w[12], w[13], w[14], w[15]};
  }
  __syncthreads();
}

struct ConvJob { const float* src; bf16_t* dst; int ldw, K, c0, ncols, nmat, ldd, drow0, mode; size_t sstride, dstride; };
DI int conv_nitems(const ConvJob& j) { return j.nmat * (j.K >> 6) * ((j.ncols + 31) >> 5); }
DI int conv_drow(int mode, int drow0, int n) { return mode == 0 ? drow0 + n : drow0 + ((n >> 6) * 128 + ((n >> 4) & 3) * 32 + (n & 15)); }
DI void conv_item(const ConvJob& jb, int item, float* scr, int lane) {
  const int nblk = (jb.ncols + 31) >> 5, per = (jb.K >> 6) * nblk;
  const int mat = item / per, r = item % per, kb = r / nblk, nb = r % nblk, k0 = 64 * kb, n0 = 32 * nb;
  const float* W = jb.src + (size_t)mat * jb.sstride; bf16_t* WT = jb.dst + (size_t)mat * jb.dstride;
  const int n4 = (lane & 7) * 4; const bool nok = (n0 + n4) < jb.ncols;
#pragma unroll
  for (int i = 0; i < 8; ++i) { const int kk = 8 * i + (lane >> 3);
    const f32x4 v = nok ? *(const f32x4*)(W + (size_t)(k0 + kk) * jb.ldw + jb.c0 + n0 + n4) : (f32x4){0.f, 0.f, 0.f, 0.f};
    *(f32x4*)(scr + kk * 36 + n4) = v; }
  asm volatile("s_waitcnt lgkmcnt(0)" ::: "memory");
  const int c = lane & 7;
#pragma unroll
  for (int j = 0; j < 4; ++j) {
    const int n = (lane >> 3) + 8 * j; const float* sp = scr + (8 * c) * 36 + n;
    u32x4 o; o.x = pk2(sp[0], sp[36]); o.y = pk2(sp[72], sp[108]); o.z = pk2(sp[144], sp[180]); o.w = pk2(sp[216], sp[252]);
    if (n0 + n < jb.ncols) *(u32x4*)(WT + (size_t)conv_drow(jb.mode, jb.drow0, n0 + n) * jb.ldd + k0 + 8 * c) = o;
  }
  asm volatile("s_waitcnt lgkmcnt(0)" ::: "memory");
}
DI ConvJob conv_job(const Params& P, int l, int j) {
  unsigned char* wb = P.ws + WS_W; ConvJob J; J.nmat = 1; J.mode = 0; J.sstride = 0; J.dstride = 0; J.drow0 = 0; J.c0 = 0;
  const float* win = P.in[5] + (size_t)l * 1024 * INW;
  if (j < 5) { J.src = win; J.ldw = INW; J.K = 1024; J.dst = (bf16_t*)(wb + W_IN); J.ldd = 1024;
    if (j == 0) { J.c0 = 0; J.ncols = 1024; J.drow0 = 0; }
    else if (j == 1) { J.c0 = 1024; J.ncols = 1536; J.drow0 = 1024; }
    else if (j == 2) { J.c0 = 3120; J.ncols = 2048; J.drow0 = 2560; }
    else if (j == 3) { J.c0 = 2608; J.ncols = 512; J.drow0 = 4608; }
    else { J.c0 = 2560; J.ncols = 48; J.drow0 = 5120; }
  } else if (j == 5) { J.src = P.in[14] + (size_t)l * 512 * 512; J.ldw = 512; J.K = 512; J.ncols = 512; J.dst = (bf16_t*)(wb + W_GLU); J.ldd = 512; }
  else if (j == 6) { J.src = P.in[19] + (size_t)l * 1024 * 1024; J.ldw = 1024; J.K = 1024; J.ncols = 1024; J.dst = (bf16_t*)(wb + W_O); J.ldd = 1024; }
  else if (j == 7) { J.src = P.in[15] + (size_t)l * 512 * 1024; J.ldw = 1024; J.K = 512; J.ncols = 1024; J.dst = (bf16_t*)(wb + W_SO); J.ldd = 512; }
  else if (j == 8) { J.src = P.in[20] + (size_t)l * 1024 * 1024; J.ldw = 1024; J.K = 1024; J.ncols = 1024; J.dst = (bf16_t*)(wb + W_OUT); J.ldd = 1024; }
  else if (j == 9) { J.src = P.in[17] + (size_t)l * 2 * 2048 * 256; J.ldw = 256; J.K = 2048; J.ncols = 256; J.nmat = 2; J.sstride = 2048 * 256; J.dstride = 256 * 2048; J.dst = (bf16_t*)(wb + W_C1); J.ldd = 2048; }
  else if (j == 10) { J.src = P.in[18] + (size_t)l * 2 * 256 * 64; J.ldw = 64; J.K = 256; J.ncols = 64; J.nmat = 2; J.sstride = 256 * 64; J.dstride = 128 * 256; J.dst = (bf16_t*)(wb + W_C2); J.ldd = 256; }
  else if (j == 11) { J.src = P.in[26] + (size_t)l * 32 * 1024 * 256; J.ldw = 256; J.K = 1024; J.ncols = 256; J.nmat = 32; J.sstride = 1024 * 256; J.dstride = 512 * 1024; J.dst = (bf16_t*)(wb + W_GU); J.ldd = 1024; J.mode = 1; J.drow0 = 0; }
  else if (j == 12) { J.src = P.in[27] + (size_t)l * 32 * 1024 * 256; J.ldw = 256; J.K = 1024; J.ncols = 256; J.nmat = 32; J.sstride = 1024 * 256; J.dstride = 512 * 1024; J.dst = (bf16_t*)(wb + W_GU); J.ldd = 1024; J.mode = 1; J.drow0 = 16; }
  else { J.src = P.in[28] + (size_t)l * 32 * 256 * 1024; J.ldw = 1024; J.K = 256; J.ncols = 1024; J.nmat = 32; J.sstride = 256 * 1024; J.dstride = 1024 * 256; J.dst = (bf16_t*)(wb + W_D); J.ldd = 256; }
  return J;
}
DI void convert_weights(const Params& P_, int l, unsigned char* lds) {
  Params P = P_; { size_t z_ = 0; asm volatile("" : "+s"(z_)); P.ws = P_.ws + z_; }
  const int tid_ = otid(), bid = obid(), wave = tid_ >> 6, lane = tid_ & 63; (void)bid;
  float* scr = (float*)lds + wave * (64 * 36);
  const int NGW = gridDim.x * NWAVE; int off = bid * NWAVE + wave;
  for (int j = 0; j < 14; ++j) {
    const ConvJob J = conv_job(P, l, j); const int n = conv_nitems(J);
    while (off < n) { conv_item(J, off, scr, lane); off += NGW; }
    off -= n;
  }
}

template <int MODE>
DI void norm_simple(const Params& P_, int l) {
  Params P = P_; { size_t z_ = 0; asm volatile("" : "+s"(z_)); P.ws = P_.ws + z_; }
  const int tid_ = otid(), bid = obid(), wave = tid_ >> 6, lane = tid_ & 63; (void)bid;
  const int NGW = gridDim.x * NWAVE;
  const float* mod = (const float*)(P.ws + WS_MOD);
  const bf16_t* ys = (const bf16_t*)(P.ws + WS_F);
  bf16_t* xn = (bf16_t*)(P.ws + WS_A);
  const float* xbase = MODE == 0 ? P.in[0] : P.out;
  constexpr bool ADDY = (MODE != 0) && EN_MOE;
  f32x4 g[4], sh[4], sc[4], gg[4]; int pb = -1;
  { const float* gp = MODE == 3 ? P.in[29] : P.in[4] + (size_t)l * DM;
#pragma unroll
    for (int j = 0; j < 4; ++j) g[j] = *(const f32x4*)(gp + 4 * lane + 256 * j); }
  f32x4 v[4]; u32x2 y0[4], y1[4];
#define NS_LOAD(vv, a0, a1, rr) do { const float* xr_ = xbase + (size_t)(rr) * DM; \
    _Pragma("unroll") for (int j = 0; j < 4; ++j) vv[j] = *(const f32x4*)(xr_ + 4 * lane + 256 * j); \
    if (ADDY) { _Pragma("unroll") for (int j = 0; j < 4; ++j) { a0[j] = *(const u32x2*)(ys + (size_t)((rr) * 2) * DM + 4 * lane + 256 * j); a1[j] = *(const u32x2*)(ys + (size_t)((rr) * 2 + 1) * DM + 4 * lane + 256 * j); } } } while (0)
  const int row0 = bid * NWAVE + wave;
  if (row0 < NT) NS_LOAD(v, y0, y1, row0);
  for (int row = row0; row < NT; row += NGW) {
    const int b = row >> 13;
    if (b != pb) { pb = b;
      if (ADDY) { const float* g2 = mod + (size_t)(((MODE == 1 ? 0 : 1) * 2 + b) * 6144) + 5120;
#pragma unroll
        for (int j = 0; j < 4; ++j) gg[j] = *(const f32x4*)(g2 + 4 * lane + 256 * j); }
      if (MODE != 3) { const float* md = mod + (size_t)((l * 2 + b) * 6144);
#pragma unroll
        for (int j = 0; j < 4; ++j) { sh[j] = *(const f32x4*)(md + 4 * lane + 256 * j); sc[j] = *(const f32x4*)(md + 1024 + 4 * lane + 256 * j); } }
    }
    f32x4 vn[4]; u32x2 y0n[4], y1n[4];
    if (row + NGW < NT) NS_LOAD(vn, y0n, y1n, row + NGW);
    __builtin_amdgcn_sched_barrier(0);
    if (ADDY) {
#pragma unroll
      for (int j = 0; j < 4; ++j) {
        v[j].x += gg[j].x * (bflo(y0[j].x) + bflo(y1[j].x)); v[j].y += gg[j].y * (bfhi(y0[j].x) + bfhi(y1[j].x));
        v[j].z += gg[j].z * (bflo(y0[j].y) + bflo(y1[j].y)); v[j].w += gg[j].w * (bfhi(y0[j].y) + bfhi(y1[j].y));
      }
    }
    float ss = 0.f;
#pragma unroll
    for (int j = 0; j < 4; ++j) ss += v[j].x * v[j].x + v[j].y * v[j].y + v[j].z * v[j].z + v[j].w * v[j].w;
    ss = wave_sum(ss);
    const float inv = rsqrtf(ss * (1.f / DM) + EPS);
    if (MODE == 3) {
#pragma unroll
      for (int j = 0; j < 4; ++j) { const int col = 4 * lane + 256 * j; *(f32x4*)(P.out + (size_t)row * DM + col) = v[j] * inv * g[j]; }
    } else {
      if (MODE == 1) {
#pragma unroll
        for (int j = 0; j < 4; ++j) *(f32x4*)(P.out + (size_t)row * DM + 4 * lane + 256 * j) = v[j];
      }
#pragma unroll
      for (int j = 0; j < 4; ++j) {
        const int col = 4 * lane + 256 * j;
        const f32x4 h = v[j] * inv * g[j] * (sc[j] + 1.f) + sh[j];
        u32x2 o; o.x = pk2(h.x, h.y); o.y = pk2(h.z, h.w);
        *(u32x2*)(xn + (size_t)row * DM + col) = o;
      }
    }
#pragma unroll
    for (int j = 0; j < 4; ++j) { v[j] = vn[j]; y0[j] = y0n[j]; y1[j] = y1n[j]; }
  }
#undef NS_LOAD
}

constexpr int RT_HS = 1028;
DI void norm_route(const Params& P_, int l, unsigned char* lds) {
  Params P = P_; { size_t z_ = 0; asm volatile("" : "+s"(z_)); P.ws = P_.ws + z_; }
  const int tid = otid(), bid = obid(), wave = tid >> 6, lane = tid & 63;
  const float* mod = (const float*)(P.ws + WS_MOD);
  bf16_t* h2 = (bf16_t*)(P.ws + WS_A);
  float* hs = (float*)lds;
  float* Wc = (float*)lds + 32 * RT_HS;
  const float* wg = P.in[22] + (size_t)l * DM * 4; const float* we = P.in[24] + (size_t)l * DM * 32;
  const float* bg = P.in[23] + l * 4; const float* be = P.in[25] + l * 32;
  int* cnt = (int*)(P.ws + WS_CNT) + l * 32; int* list = (int*)(P.ws + WS_LIST); float* wts = (float*)(P.ws + WS_WT);
  const int rg = wave >> 2, kq = wave & 3;
  for (int grp = bid; grp < NT / 32; grp += gridDim.x) {
    const int row0 = grp * 32 + wave * 4, b = row0 >> 13;
    const float* ng = P.in[21] + (size_t)l * DM; const float* md = mod + (size_t)((l * 2 + b) * 6144);
    {
      f32x4 v[4][4];
#pragma unroll
      for (int r = 0; r < 4; ++r)
#pragma unroll
        for (int j = 0; j < 4; ++j) v[r][j] = *(const f32x4*)(P.out + (size_t)(row0 + r) * DM + 4 * lane + 256 * j);
      float inv[4];
#pragma unroll
      for (int r = 0; r < 4; ++r) { float ss = 0.f;
#pragma unroll
        for (int j = 0; j < 4; ++j) ss += v[r][j].x * v[r][j].x + v[r][j].y * v[r][j].y + v[r][j].z * v[r][j].z + v[r][j].w * v[r][j].w;
        inv[r] = rsqrtf(wave_sum(ss) * (1.f / DM) + EPS); }
#pragma unroll
      for (int j = 0; j < 4; ++j) {
        const int col = 4 * lane + 256 * j;
        const f32x4 g = *(const f32x4*)(ng + col), sh = *(const f32x4*)(md + 3072 + col), sc = *(const f32x4*)(md + 4096 + col);
#pragma unroll
        for (int r = 0; r < 4; ++r) {
          const f32x4 hh = v[r][j] * inv[r] * g * (sc + 1.f) + sh;
          u32x2 o; o.x = pk2(hh.x, hh.y); o.y = pk2(hh.z, hh.w);
          *(u32x2*)(h2 + (size_t)(row0 + r) * DM + col) = o;
          *(f32x4*)(hs + (wave * 4 + r) * RT_HS + col) = hh;
        }
      }
    }
    f32x4 we0, we1, wg0 = {0.f, 0.f, 0.f, 0.f};
#define WLOAD(kc) do { we0 = *(const f32x4*)(we + (size_t)(kc) * 4096 + tid * 4); we1 = *(const f32x4*)(we + (size_t)(kc) * 4096 + 2048 + tid * 4); if (tid < 128) wg0 = *(const f32x4*)(wg + (size_t)(kc) * 512 + tid * 4); } while (0)
#define WSTORE() do { *(f32x4*)(Wc + (tid >> 3) * 36 + (tid & 7) * 4) = we0; *(f32x4*)(Wc + (64 + (tid >> 3)) * 36 + (tid & 7) * 4) = we1; if (tid < 128) *(f32x4*)(Wc + tid * 36 + 32) = wg0; } while (0)
    WLOAD(0);
    f32x4 acc0 = {0.f, 0.f, 0.f, 0.f}, acc1 = acc0, acc2 = acc0;
    for (int kc = 0; kc < 8; ++kc) {
      __syncthreads();
      WSTORE();
      if (kc + 1 < 8) WLOAD(kc + 1);
      __syncthreads();
      const float* ap = hs + (rg * 16 + (lane & 15)) * RT_HS + kc * 128 + kq * 32 + (lane >> 4);
      const float* bp = Wc + (kq * 32 + (lane >> 4)) * 36 + (lane & 15);
#pragma unroll
      for (int ks = 0; ks < 8; ++ks) {
        const float av = ap[4 * ks];
        const float b0 = bp[(4 * ks) * 36], b1 = bp[(4 * ks) * 36 + 16], b2 = (lane & 15) < 4 ? bp[(4 * ks) * 36 + 32] : 0.f;
        acc0 = __builtin_amdgcn_mfma_f32_16x16x4f32(av, b0, acc0, 0, 0, 0);
        acc1 = __builtin_amdgcn_mfma_f32_16x16x4f32(av, b1, acc1, 0, 0, 0);
        acc2 = __builtin_amdgcn_mfma_f32_16x16x4f32(av, b2, acc2, 0, 0, 0);
      }
    }
#undef WLOAD
#undef WSTORE
    __syncthreads();
    {
      float* part = hs + kq * (32 * 40);
#pragma unroll
      for (int i = 0; i < 4; ++i) { const int row = rg * 16 + 4 * (lane >> 4) + i, col = lane & 15;
        part[row * 40 + col] = acc0[i]; part[row * 40 + 16 + col] = acc1[i]; if (col < 4) part[row * 40 + 32 + col] = acc2[i]; }
    }
    __syncthreads();
    if (tid < 32) {
      const int row = grp * 32 + tid;
      float L[36];
#pragma unroll
      for (int o = 0; o < 36; ++o) L[o] = (hs[tid * 40 + o] + hs[1280 + tid * 40 + o]) + (hs[2560 + tid * 40 + o] + hs[3840 + tid * 40 + o]);
      float gm = -1e30f; int gi = 0;
#pragma unroll
      for (int i = 0; i < 4; ++i) { const float v = L[32 + i] + bg[i]; if (v > gm) { gm = v; gi = i; } }
      float gs = 0.f;
#pragma unroll
      for (int i = 0; i < 4; ++i) gs += expf(L[32 + i] + bg[i] - gm);
      const float gp = 1.f / gs;
      float el[8];
#pragma unroll
      for (int i = 0; i < 8; ++i) el[i] = (gi == 0 ? L[i] : gi == 1 ? L[8 + i] : gi == 2 ? L[16 + i] : L[24 + i]) + be[gi * 8 + i];
      float em = -1e30f;
#pragma unroll
      for (int i = 0; i < 8; ++i) em = fmaxf(em, el[i]);
      float p1 = -1.f, p2 = -1.f; int i1 = 0, i2 = 0;
#pragma unroll
      for (int i = 0; i < 8; ++i) {
        const float pe = expf(el[i] - em);
        if (pe > p1) { p2 = p1; i2 = i1; p1 = pe; i1 = i; } else if (pe > p2) { p2 = pe; i2 = i; }
      }
      const float w1 = gp * p1 / (p1 + p2), w2 = gp * p2 / (p1 + p2);
      const int e1 = gi * 8 + i1, e2 = gi * 8 + i2;
      const int pos1 = atomicAdd(&cnt[e1], 1); list[e1 * LISTCAP + pos1] = row * 2; wts[row * 2] = w1;
      const int pos2 = atomicAdd(&cnt[e2], 1); list[e2 * LISTCAP + pos2] = row * 2 + 1; wts[row * 2 + 1] = w2;
    }
    __syncthreads();
  }
}

namespace pg8 {
#define PG8_LAS __attribute__((address_space(3)))
typedef unsigned short bf16_t;
typedef short bf16x8 __attribute__((ext_vector_type(8)));
typedef float f32x4 __attribute__((ext_vector_type(4)));
typedef unsigned u32x4 __attribute__((ext_vector_type(4)));
constexpr int BM = 256, BK = 64, HALF = 128, HTB = HALF * BK * 2  , STAGE_BYTES = 8 * HTB, NXCD = 8, WGM = 8;

__host__ __device__ __forceinline__ int lds_byte(int r, int c) { const int st = (r >> 4) * 2 + (c >> 5), rr = r & 15, cc = c & 31, ob = rr * 64 + cc * 2; return st * 1024 + (ob ^ (((ob >> 9) & 1) << 5)); }
__host__ __device__ __forceinline__ void stage_rc(int b, int& R, int& C) { const int st = b / 1024, sb = b % 1024, swz = sb ^ (((sb >> 9) & 1) << 5); R = (st >> 1) * 16 + swz / 64; C = (st & 1) * 32 + (swz % 64) / 2; }
__host__ __device__ __forceinline__ int perm32(int rho) { const int n = rho >> 4, i = rho & 15; return 8 * (i >> 2) + 4 * n + (i & 3); }

struct Unit { int pm, pn; };
struct Gemm { const bf16_t* A; const bf16_t* Bt; int M, N, K; };

struct StaticOrder {
    int nM, nN, nwg, G, c;
    __host__ __device__ void init(int M, int N, int G_, int c_) { nM = M / BM; nN = N / BM; nwg = nM * nN; G = G_; c = c_; }
    __host__ __device__ bool next(int i, Unit& u) const {
        const long L = (long)i * G + c; if (L >= nwg) return false;
        int wgid = (int)L; { const int q = nwg / NXCD, r = nwg % NXCD, xcd = wgid % NXCD, off = wgid / NXCD; wgid = (xcd < r ? xcd * (q + 1) : r * (q + 1) + (xcd - r) * q) + off; }
        const int nig = WGM * nN, gid = wgid / nig, fm = gid * WGM, gsz = (nM - fm) < WGM ? (nM - fm) : WGM;
        u.pm = fm + ((wgid % nig) % gsz); u.pn = (wgid % nig) / gsz; return true;
    }
    __device__ __forceinline__ void a_ready(const Unit&) const {}
    __device__ __forceinline__ void done(const Unit&) const {}
};
template <class Epi, class Sched, bool ALIGN_EPI = false, bool SP2 = false>
__device__ __forceinline__ void gemm_phase(PG8_LAS unsigned char* lds, const Gemm g, const Sched& S, const Epi& E) {
    const int tid = otid(), wid = __builtin_amdgcn_readfirstlane(tid >> 6), lane = tid & 63, wr = wid >> 2, wc = wid & 3, fr = lane & 15, fq = lane >> 4;
    const int K = g.K, nt = K / BK;
    unsigned voffA[2], voffB[2];
#pragma unroll
    for (int i = 0; i < 2; ++i) { int R, C; stage_rc(tid * 16 + i * 8192, R, C); const int Rb = Epi::PERM ? ((R & ~31) + perm32(R & 31)) : R;
        voffA[i] = (unsigned)(R * K + C) * 2u; voffB[i] = (unsigned)(Rb * K + C) * 2u; }
    const size_t kstep = (size_t)(BK * 2);
    const size_t hstep = (size_t)HALF * K * 2;
    const size_t tstep = 2 * hstep;
    const unsigned ldsw = (unsigned)wid * 1024u;
    const int aoff = lds_byte(wr * 64 + fr, fq * 8), boff = lds_byte(wc * 32 + fr, fq * 8);
#define PG8_SA(b, h) (((b) * 2 + (h)) * HTB)
#define PG8_SB(b, h) ((4 + (b) * 2 + (h)) * HTB)
#define PG8_STAGE(bufoff, gbase, voff) do { _Pragma("unroll") for (int _i = 0; _i < 2; ++_i) \
        __builtin_amdgcn_global_load_lds((const unsigned*)((const char*)(gbase) + (voff)[_i]), (PG8_LAS unsigned*)(lds + (bufoff) + ldsw + _i * 8192), 16, 0, 0); } while (0)
#define PG8_LDA(dst, b, h) do { _Pragma("unroll") for (int m = 0; m < 4; ++m) _Pragma("unroll") for (int k = 0; k < 2; ++k) dst[m][k] = *(const PG8_LAS bf16x8*)(lds + PG8_SA(b, h) + aoff + m * 2048 + k * 1024); } while (0)
#define PG8_LDB(dst, b, h) do { _Pragma("unroll") for (int n = 0; n < 2; ++n) _Pragma("unroll") for (int k = 0; k < 2; ++k) dst[n][k] = *(const PG8_LAS bf16x8*)(lds + PG8_SB(b, h) + boff + n * 2048 + k * 1024); } while (0)
#define PG8_MMA(ai, bj, At, Bt) do { __builtin_amdgcn_s_setprio(1); _Pragma("unroll") for (int m = 0; m < 4; ++m) _Pragma("unroll") for (int n = 0; n < 2; ++n) _Pragma("unroll") for (int k = 0; k < 2; ++k) \
        acc[ai][bj][m][n] = __builtin_amdgcn_mfma_f32_16x16x32_bf16(Bt[n][k], At[m][k], acc[ai][bj][m][n], 0, 0, 0); __builtin_amdgcn_s_setprio(0); } while (0)
#define PG8_WAIT_V(n) asm volatile("s_waitcnt vmcnt(" #n ")" ::: "memory")
#define PG8_WAIT_L(n) asm volatile("s_waitcnt lgkmcnt(" #n ")" ::: "memory")
#define PG8_BAR __builtin_amdgcn_s_barrier()
#define PG8_SCHED __builtin_amdgcn_sched_barrier(0)
    Unit cur, nxt; int ui = 0;
    if (!S.next(0, cur)) return;
    f32x4 acc[2][2][4][2];
#pragma unroll
    for (int a = 0; a < 2; ++a)
#pragma unroll
        for (int b = 0; b < 2; ++b)
#pragma unroll
            for (int m = 0; m < 4; ++m)
#pragma unroll
                for (int n = 0; n < 2; ++n) acc[a][b][m][n] = (f32x4){0.f, 0.f, 0.f, 0.f};
    bf16x8 At[4][2], B0[2][2], B1[2][2];
    const char* cA = (const char*)g.A + (size_t)cur.pm * tstep; const char* cB = (const char*)g.Bt + (size_t)cur.pn * tstep;
    S.a_ready(cur);
    if constexpr (SP2) {
        PG8_STAGE(PG8_SB(0, 0), cB, voffB); PG8_STAGE(PG8_SB(0, 1), cB + hstep, voffB); PG8_STAGE(PG8_SA(0, 0), cA, voffA); PG8_STAGE(PG8_SA(0, 1), cA + hstep, voffA);
        if (wr == 1) PG8_BAR;
        PG8_WAIT_V(2); PG8_BAR;
        PG8_STAGE(PG8_SB(1, 0), cB + kstep, voffB); PG8_STAGE(PG8_SA(1, 0), cA + kstep, voffA); PG8_STAGE(PG8_SB(1, 1), cB + hstep + kstep, voffB);
        PG8_WAIT_V(6); PG8_BAR;
    } else {
        PG8_STAGE(PG8_SB(0, 0), cB, voffB); PG8_STAGE(PG8_SA(0, 0), cA, voffA); PG8_STAGE(PG8_SB(0, 1), cB + hstep, voffB); PG8_STAGE(PG8_SA(0, 1), cA + hstep, voffA);
        if (wr == 1) PG8_BAR;
        PG8_WAIT_V(4); PG8_BAR;
        PG8_STAGE(PG8_SB(1, 0), cB + kstep, voffB); PG8_STAGE(PG8_SA(1, 0), cA + kstep, voffA); PG8_STAGE(PG8_SB(1, 1), cB + hstep + kstep, voffB);
        PG8_WAIT_V(6); PG8_BAR;
    }
    for (;;) {
        const bool has_next = S.next(ui + 1, nxt);
        const char* nA = has_next ? (const char*)g.A + (size_t)nxt.pm * tstep : cA; const char* nB = has_next ? (const char*)g.Bt + (size_t)nxt.pn * tstep : cB;
        for (int t = 0; t < nt; t += 2) {
            const bool last = (t == nt - 2);
            const char* a1 = cA + (size_t)(t + 1) * kstep;
            const char* a2 = last ? nA : cA + (size_t)(t + 2) * kstep; const char* b2 = last ? nB : cB + (size_t)(t + 2) * kstep;
            const char* a3 = a2 + kstep; const char* b3 = b2 + kstep;
            if (last && has_next) S.a_ready(nxt);
            if constexpr (SP2) {
            PG8_LDB(B0, 0, 0); PG8_LDB(B1, 0, 1); PG8_SCHED; PG8_LDA(At, 0, 0); PG8_STAGE(PG8_SA(1, 1), a1 + hstep, voffA);
            PG8_WAIT_V(8); PG8_WAIT_L(0); PG8_BAR; PG8_MMA(0, 0, At, B0); PG8_MMA(0, 1, At, B1); PG8_BAR; PG8_SCHED;
            PG8_LDA(At, 0, 1); PG8_STAGE(PG8_SB(0, 0), b2, voffB); PG8_STAGE(PG8_SB(0, 1), b2 + hstep, voffB); PG8_STAGE(PG8_SA(0, 0), a2, voffA);
            PG8_WAIT_V(8); PG8_WAIT_L(0); PG8_BAR; PG8_MMA(1, 0, At, B0); PG8_MMA(1, 1, At, B1); PG8_BAR; PG8_SCHED;
            PG8_LDB(B0, 1, 0); PG8_LDB(B1, 1, 1); PG8_SCHED; PG8_LDA(At, 1, 0); PG8_STAGE(PG8_SA(0, 1), a2 + hstep, voffA);
            PG8_WAIT_V(8); PG8_WAIT_L(0); PG8_BAR; PG8_MMA(0, 0, At, B0); PG8_MMA(0, 1, At, B1); PG8_BAR; PG8_SCHED;
            PG8_LDA(At, 1, 1); PG8_STAGE(PG8_SB(1, 0), b3, voffB); PG8_STAGE(PG8_SB(1, 1), b3 + hstep, voffB); PG8_STAGE(PG8_SA(1, 0), a3, voffA);
            PG8_WAIT_V(8); PG8_WAIT_L(0); PG8_BAR; PG8_MMA(1, 0, At, B0); PG8_MMA(1, 1, At, B1); PG8_BAR; PG8_SCHED;
            } else {
            PG8_LDB(B0, 0, 0); PG8_SCHED; PG8_LDA(At, 0, 0); PG8_STAGE(PG8_SA(1, 1), a1 + hstep, voffA);
            PG8_WAIT_L(8); PG8_BAR; PG8_WAIT_L(0); PG8_MMA(0, 0, At, B0); PG8_BAR; PG8_SCHED;
            PG8_LDB(B1, 0, 1); PG8_STAGE(PG8_SB(0, 0), b2, voffB);
            PG8_BAR; PG8_WAIT_L(0); PG8_MMA(0, 1, At, B1); PG8_BAR;
            PG8_LDA(At, 0, 1); PG8_STAGE(PG8_SA(0, 0), a2, voffA);
            PG8_BAR; PG8_WAIT_L(0); PG8_MMA(1, 0, At, B0); PG8_BAR; PG8_SCHED;
            PG8_STAGE(PG8_SB(0, 1), b2 + hstep, voffB);
            PG8_WAIT_V(6); PG8_BAR; PG8_MMA(1, 1, At, B1); PG8_BAR;
            PG8_LDB(B0, 1, 0); PG8_SCHED; PG8_LDA(At, 1, 0); PG8_STAGE(PG8_SA(0, 1), a2 + hstep, voffA);
            PG8_WAIT_L(8); PG8_BAR; PG8_WAIT_L(0); PG8_MMA(0, 0, At, B0); PG8_BAR; PG8_SCHED;
            PG8_LDB(B1, 1, 1); PG8_STAGE(PG8_SB(1, 0), b3, voffB);
            PG8_BAR; PG8_WAIT_L(0); PG8_MMA(0, 1, At, B1); PG8_BAR;
            PG8_LDA(At, 1, 1); PG8_STAGE(PG8_SA(1, 0), a3, voffA);
            PG8_BAR; PG8_WAIT_L(0); PG8_MMA(1, 0, At, B0); PG8_BAR; PG8_SCHED;
            PG8_STAGE(PG8_SB(1, 1), b3 + hstep, voffB);
            PG8_WAIT_V(6); PG8_BAR; PG8_MMA(1, 1, At, B1); PG8_BAR;
            }
        }
        if constexpr (ALIGN_EPI) { if (wr == 0) PG8_BAR; }
        if constexpr (!Epi::AFTER_DRAIN) { E(acc, cur, wr, wc, fr, fq); S.done(cur); }
        if (!has_next) break;
#pragma unroll
        for (int a = 0; a < 2; ++a)
#pragma unroll
            for (int b = 0; b < 2; ++b)
#pragma unroll
                for (int m = 0; m < 4; ++m)
#pragma unroll
                    for (int n = 0; n < 2; ++n) acc[a][b][m][n] = (f32x4){0.f, 0.f, 0.f, 0.f};
        cur = nxt; cA = nA; cB = nB; ++ui;
        if constexpr (ALIGN_EPI) { if (wr == 1) PG8_BAR; }
    }
    PG8_WAIT_V(0);
    if constexpr (!ALIGN_EPI) { if (wr == 0) PG8_BAR; }
    PG8_BAR;
    if constexpr (Epi::AFTER_DRAIN) { E.fused(acc, cur, wr, wc, fr, fq, lds, wid, lane); S.done(cur); }
#undef PG8_SA
#undef PG8_SB
#undef PG8_STAGE
#undef PG8_LDA
#undef PG8_LDB
#undef PG8_MMA
#undef PG8_WAIT_V
#undef PG8_WAIT_L
#undef PG8_BAR
#undef PG8_SCHED
}
}

constexpr int GT_ROWB = 144, GT_A = 0, GT_B = 128 * GT_ROWB, GT_STAGE = 2 * 128 * GT_ROWB;
DI void gemm_kloop(unsigned char* lds, const bf16_t* a0, const bf16_t* a1, int a_kadv, const bf16_t* b0, const bf16_t* b1, int nk, f32x4 (&acc)[4][2]) {
  const int tid = otid(), lane = tid & 63, wid = tid >> 6, wr = wid >> 2, wc = wid & 3, fr = lane & 15, fq = lane >> 4;
  const int lr = tid >> 3, lkb = (tid & 7) * 16;
  u32x4 xa0, xa1, xb0, xb1, ya0, ya1, yb0, yb1;
#define GT_GLOAD(p0_, p1_, q0_, q1_, kt) do { p0_ = *(const u32x4*)(a0 + (size_t)(kt) * a_kadv); p1_ = *(const u32x4*)(a1 + (size_t)(kt) * a_kadv); q0_ = *(const u32x4*)(b0 + (kt) * 64); q1_ = *(const u32x4*)(b1 + (kt) * 64); } while (0)
#define GT_LSTORE(p0_, p1_, q0_, q1_, buf) do { unsigned char* s_ = lds + (buf) * GT_STAGE; \
    *(u32x4*)(s_ + GT_A + lr * GT_ROWB + lkb) = p0_; *(u32x4*)(s_ + GT_A + (lr + 64) * GT_ROWB + lkb) = p1_; \
    *(u32x4*)(s_ + GT_B + lr * GT_ROWB + lkb) = q0_; *(u32x4*)(s_ + GT_B + (lr + 64) * GT_ROWB + lkb) = q1_; } while (0)
#define GT_COMPUTE(buf) do { \
    const unsigned char* As = lds + (buf) * GT_STAGE + GT_A + (wr * 64 + fr) * GT_ROWB + fq * 16; \
    const unsigned char* Bs = lds + (buf) * GT_STAGE + GT_B + (wc * 32 + fr) * GT_ROWB + fq * 16; \
    _Pragma("unroll") for (int ks = 0; ks < 2; ++ks) { \
      bf16x8 af[4], bfr[2]; \
      _Pragma("unroll") for (int m = 0; m < 4; ++m) af[m] = *(const bf16x8*)(As + m * 16 * GT_ROWB + ks * 64); \
      _Pragma("unroll") for (int n = 0; n < 2; ++n) bfr[n] = *(const bf16x8*)(Bs + n * 16 * GT_ROWB + ks * 64); \
      _Pragma("unroll") for (int m = 0; m < 4; ++m) _Pragma("unroll") for (int n = 0; n < 2; ++n) acc[m][n] = __builtin_amdgcn_mfma_f32_16x16x32_bf16(bfr[n], af[m], acc[m][n], 0, 0, 0); } } while (0)
  GT_GLOAD(xa0, xa1, xb0, xb1, 0); GT_LSTORE(xa0, xa1, xb0, xb1, 0); if (nk > 1) GT_GLOAD(ya0, ya1, yb0, yb1, 1); __syncthreads();
  for (int kt = 0; kt < nk; kt += 2) {
    if (kt + 2 < nk) GT_GLOAD(xa0, xa1, xb0, xb1, kt + 2);
    GT_COMPUTE(0);
    if (kt + 1 < nk) GT_LSTORE(ya0, ya1, yb0, yb1, 1);
    __syncthreads();
    if (kt + 1 >= nk) break;
    if (kt + 3 < nk) GT_GLOAD(ya0, ya1, yb0, yb1, kt + 3);
    GT_COMPUTE(1);
    if (kt + 2 < nk) GT_LSTORE(xa0, xa1, xb0, xb1, 0);
    __syncthreads();
  }
#undef GT_GLOAD
#undef GT_LSTORE
#undef GT_COMPUTE
}
#define ACC_ZERO(acc) do { _Pragma("unroll") for (int m_ = 0; m_ < 4; ++m_) _Pragma("unroll") for (int n_ = 0; n_ < 2; ++n_) acc[m_][n_] = (f32x4){0.f, 0.f, 0.f, 0.f}; } while (0)
#define TILE_IDS const int tid = otid(), bid = obid(), lane = tid & 63, wid = tid >> 6, wr = wid >> 2, wc = wid & 3, fr = lane & 15, fq = lane >> 4, lr = tid >> 3, lk = (tid & 7) * 8; (void)bid; (void)lane; (void)wr; (void)wc; (void)fr; (void)fq; (void)lr; (void)lk

DI void phase_gates(const Params& P_, unsigned char* lds) {
  Params P = P_; { size_t z_ = 0; asm volatile("" : "+s"(z_)); P.ws = P_.ws + z_; }
  TILE_IDS;
  const bf16_t* xn = (const bf16_t*)(P.ws + WS_A); const bf16_t* wt = (const bf16_t*)(P.ws + WS_W + W_IN) + (size_t)5120 * DM; float* gates = (float*)(P.ws + WS_GATES);
  for (int tile = (int)gridDim.x - 1 - bid; tile < NT / 128; tile += gridDim.x) {
    const int row0 = tile * 128;
    f32x4 acc[4][2]; ACC_ZERO(acc);
    gemm_kloop(lds, xn + (size_t)(row0 + lr) * DM + lk, xn + (size_t)(row0 + lr + 64) * DM + lk, 64, wt + (size_t)lr * DM + lk, wt + (size_t)(lr + 64) * DM + lk, DM / 64, acc);
#pragma unroll
    for (int m = 0; m < 4; ++m)
#pragma unroll
      for (int n = 0; n < 2; ++n) {
        const int row = row0 + wr * 64 + m * 16 + fr, c2 = wc * 32 + n * 16 + 4 * fq; const f32x4 v = acc[m][n];
        if (c2 < 48) { f32x4 o = {sigmoidf_(v.x), sigmoidf_(v.y), sigmoidf_(v.z), sigmoidf_(v.w)}; *(f32x4*)(gates + (size_t)row * 48 + c2) = o; }
      }
  }
}
DI void phase_cmp1(const Params& P_, int l, unsigned char* lds) {
  Params P = P_; { size_t z_ = 0; asm volatile("" : "+s"(z_)); P.ws = P_.ws + z_; }
  TILE_IDS;
  const bf16_t* kvk = (const bf16_t*)(P.ws + WS_C); bf16_t* hid = (bf16_t*)(P.ws + WS_HID);
  const float* cb = (const float*)(P.ws + WS_CB) + l * 512;
  for (int tile = bid; tile < 128; tile += gridDim.x) {
    const int kv = tile >> 6, rt = (tile >> 1) & 31, ct = tile & 1, row0 = rt * 128, col0 = ct * 128;
    const bf16_t* wt = (const bf16_t*)(P.ws + WS_W + W_C1) + (size_t)kv * 256 * 2048;
    const bf16_t* ap[2];
#pragma unroll
    for (int i = 0; i < 2; ++i) { const int rr = row0 + lr + 64 * i, b = rr >> 11, n = (rr >> 2) & 511, g = rr & 3, nn = n > 510 ? 510 : n;
      ap[i] = kvk + (size_t)(b * SEQ + 16 * nn) * DM + kv * 256 + g * 64 + lk; }
    f32x4 acc[4][2]; ACC_ZERO(acc);
    gemm_kloop(lds, ap[0], ap[1], DM, wt + (size_t)(col0 + lr) * 2048 + lk, wt + (size_t)(col0 + lr + 64) * 2048 + lk, 32, acc);
#pragma unroll
    for (int m = 0; m < 4; ++m)
#pragma unroll
      for (int n = 0; n < 2; ++n) {
        const int row = row0 + wr * 64 + m * 16 + fr, col = col0 + wc * 32 + n * 16 + 4 * fq;
        const f32x4 bb = *(const f32x4*)(cb + kv * 256 + col); const f32x4 v = acc[m][n] + bb;
        u32x2 o; o.x = pk2(gelu_tanh(v.x), gelu_tanh(v.y)); o.y = pk2(gelu_tanh(v.z), gelu_tanh(v.w));
        *(u32x2*)(hid + ((size_t)kv * 4096 + row) * 256 + col) = o;
      }
  }
}
DI void phase_cmp2(const Params& P_, unsigned char* lds) {
  Params P = P_; { size_t z_ = 0; asm volatile("" : "+s"(z_)); P.ws = P_.ws + z_; }
  TILE_IDS;
  const bf16_t* hid = (const bf16_t*)(P.ws + WS_HID); bf16_t* kc = (bf16_t*)(P.ws + WS_KC); bf16_t* vc = (bf16_t*)(P.ws + WS_VC);
  for (int tile = bid; tile < 64; tile += gridDim.x) {
    const int kv = tile >> 5, rt = tile & 31, row0 = rt * 128;
    const bf16_t* wt = (const bf16_t*)(P.ws + WS_W + W_C2) + (size_t)kv * 128 * 256;
    const bf16_t* a = hid + ((size_t)kv * 4096 + row0) * 256;
    f32x4 acc[4][2]; ACC_ZERO(acc);
    gemm_kloop(lds, a + (size_t)lr * 256 + lk, a + (size_t)(lr + 64) * 256 + lk, 64, wt + (size_t)lr * 256 + lk, wt + (size_t)(lr + 64) * 256 + lk, 4, acc);
    if (wc < 2) {
#pragma unroll
      for (int m = 0; m < 4; ++m)
#pragma unroll
        for (int n = 0; n < 2; ++n) {
          const int rr = row0 + wr * 64 + m * 16 + fr, d = wc * 32 + n * 16 + 4 * fq;
          const int b = rr >> 11, nn = (rr >> 2) & 511, g = rr & 3; const f32x4 v = acc[m][n];
          if (kv == 0) { u32x2 o; o.x = pk2(v.x, v.y); o.y = pk2(v.z, v.w); *(u32x2*)(kc + ((size_t)((b * 4 + g) * 512 + nn)) * 64 + d) = o; }
          else { bf16_t* dst = vc + ((size_t)((b * 4 + g) * 64 + d)) * 512 + perm16(nn); dst[0] = (bf16_t)f2bf(v.x); dst[512] = (bf16_t)f2bf(v.y); dst[1024] = (bf16_t)f2bf(v.z); dst[1536] = (bf16_t)f2bf(v.w); }
        }
    }
  }
}
DI void phase_glu(const Params& P_, unsigned char* lds) {
  Params P = P_; { size_t z_ = 0; asm volatile("" : "+s"(z_)); P.ws = P_.ws + z_; }
  TILE_IDS;
  const bf16_t* y = (const bf16_t*)(P.ws + WS_G); const bf16_t* wt = (const bf16_t*)(P.ws + WS_W + W_GLU); bf16_t* ssm = (bf16_t*)(P.ws + WS_E);
  for (int tile = bid; tile < (NT / 128) * 4; tile += gridDim.x) {
    const int rt = tile >> 2, ct = tile & 3, row0 = rt * 128, col0 = ct * 128;
    f32x4 acc[4][2]; ACC_ZERO(acc);
    gemm_kloop(lds, y + (size_t)(row0 + lr) * 512 + lk, y + (size_t)(row0 + lr + 64) * 512 + lk, 64, wt + (size_t)(col0 + lr) * 512 + lk, wt + (size_t)(col0 + lr + 64) * 512 + lk, 8, acc);
#pragma unroll
    for (int m = 0; m < 4; ++m)
#pragma unroll
      for (int n = 0; n < 2; ++n) {
        const int row = row0 + wr * 64 + m * 16 + fr, col = col0 + wc * 32 + n * 16 + 4 * fq;
        const u32x2 yy = *(const u32x2*)(y + (size_t)row * 512 + col); const f32x4 v = acc[m][n];
        u32x2 o; o.x = pk2(bflo(yy.x) * sigmoidf_(v.x), bfhi(yy.x) * sigmoidf_(v.y)); o.y = pk2(bflo(yy.y) * sigmoidf_(v.z), bfhi(yy.y) * sigmoidf_(v.w));
        *(u32x2*)(ssm + (size_t)row * 512 + col) = o;
      }
  }
}
struct EpiInproj {
  static constexpr bool PERM = false, AFTER_DRAIN = false;
  bf16_t* qb; bf16_t* kvk; bf16_t* vT; bf16_t* mg; bf16_t* ub; float* gates;
  DI void operator()(const f32x4 (&acc)[2][2][4][2], const pg8::Unit& u, int wr, int wc, int fr_, int fq_) const {
    const int pn = u.pn; int fr = fr_, fq = fq_; asm volatile("" : "+v"(fr), "+v"(fq));
#pragma unroll
    for (int ai = 0; ai < 2; ++ai)
#pragma unroll
      for (int m = 0; m < 4; ++m) {
        const int row = u.pm * 256 + ai * 128 + wr * 64 + m * 16 + fr;
#pragma unroll
        for (int bj = 0; bj < 2; ++bj)
#pragma unroll
          for (int n = 0; n < 2; ++n) {
            const int cl = bj * 128 + wc * 32 + n * 16 + 4 * fq;
            const f32x4 v = acc[ai][bj][m][n];
            if (pn < 4) { u32x2 o; o.x = pk2(v.x * QSCALE, v.y * QSCALE); o.y = pk2(v.z * QSCALE, v.w * QSCALE); *(u32x2*)(qb + (size_t)row * DM + pn * 256 + cl) = o; }
            else if (pn < 10) {
              const int seg = pn - 4;
              if (seg == 5) {
                const int b = row >> 13, t = row & (SEQ - 1), g = cl >> 6, d = cl & 63;
                bf16_t* dst = vT + ((size_t)(((1 * NB + b) * 4 + g) * 64 + d)) * SEQ + perm16(t);
                dst[0] = (bf16_t)f2bf(v.x); dst[SEQ] = (bf16_t)f2bf(v.y); dst[2 * SEQ] = (bf16_t)f2bf(v.z); dst[3 * SEQ] = (bf16_t)f2bf(v.w);
              } else if (seg == 3) {
                const unsigned t = row & (SEQ - 1), pos = perm16(t) & 63;
                const unsigned ro = ((unsigned)(row >> 13) * 512u + (t >> 6)) * 4096u + (pos >> 3) * 256u + (pos & 7), co = (unsigned)(cl >> 6) * 524288u + (unsigned)((cl >> 5) & 1) * 2048u + (unsigned)(cl & 31) * 8u;
                bf16_t* dst = vT + (ro + co);
                dst[0] = (bf16_t)f2bf(v.x); dst[8] = (bf16_t)f2bf(v.y); dst[16] = (bf16_t)f2bf(v.z); dst[24] = (bf16_t)f2bf(v.w);
              } else if (seg == 2) {
                const unsigned t = row & (SEQ - 1);
                const unsigned ro = ((unsigned)(row >> 13) * 512u + (t >> 6)) * 4096u + ((t >> 5) & 1) * 2048u + (t & 31) * 8u, co = (unsigned)(cl >> 6) * 524288u + (unsigned)((cl >> 3) & 7) * 256u + (unsigned)(cl & 7);
                u32x2 o; o.x = pk2(v.x, v.y); o.y = pk2(v.z, v.w);
                *(u32x2*)(kvk + (WS_KSF - WS_C) / 2 + (ro + co)) = o;
              } else {
                const int slot = seg == 4 ? 3 : seg;
                u32x2 o; o.x = pk2(v.x, v.y); o.y = pk2(v.z, v.w); *(u32x2*)(kvk + (size_t)row * DM + slot * 256 + cl) = o;
              }
            } else if (pn < 18) {
              u32x2 o; o.x = pk2(sigmoidf_(v.x), sigmoidf_(v.y)); o.y = pk2(sigmoidf_(v.z), sigmoidf_(v.w)); *(u32x2*)(mg + (size_t)row * 2048 + (pn - 10) * 256 + cl) = o;
            } else if (pn < 20) { const int ch = (pn - 18) * 256 + cl; u32x2 o; o.x = pk2(v.x, v.y); o.y = pk2(v.z, v.w); *(u32x2*)(ub + ((size_t)(ch >> 4) * NT + row) * 16 + (ch & 15)) = o; }
            else { if (cl < 48) { f32x4 o = {sigmoidf_(v.x), sigmoidf_(v.y), sigmoidf_(v.z), sigmoidf_(v.w)}; *(f32x4*)(gates + (size_t)row * 48 + cl) = o; } }
          }
      }
  }
};
DI void phase_inproj8(const Params& P_, unsigned char* lds) {
  Params P = P_; { size_t z_ = 0; asm volatile("" : "+s"(z_)); P.ws = P_.ws + z_; }
  pg8::Gemm g{(const bf16_t*)(P.ws + WS_A), (const bf16_t*)(P.ws + WS_W + W_IN), NT, 5120, DM};
  pg8::StaticOrder S; S.init(NT, 5120, gridDim.x, obid());
  EpiInproj E{(bf16_t*)(P.ws + WS_B), (bf16_t*)(P.ws + WS_C), (bf16_t*)(P.ws + WS_DV), (bf16_t*)(P.ws + WS_F), (bf16_t*)(P.ws + WS_E), (float*)(P.ws + WS_GATES)};
  pg8::gemm_phase<EpiInproj, pg8::StaticOrder, true, true>((PG8_LAS unsigned char*)lds, g, S, E);
}
struct EpiMerge1 {
  static constexpr bool PERM = false, AFTER_DRAIN = false;
  const bf16_t* mg; bf16_t* tmp;
  DI void operator()(const f32x4 (&acc)[2][2][4][2], const pg8::Unit& u, int wr, int wc, int fr, int fq) const {
#pragma unroll
    for (int ai = 0; ai < 2; ++ai) {
      u32x2 ga[4][2][2];
#pragma unroll
      for (int m = 0; m < 4; ++m)
#pragma unroll
        for (int bj = 0; bj < 2; ++bj)
#pragma unroll
          for (int n = 0; n < 2; ++n) {
            const int row = u.pm * 256 + ai * 128 + wr * 64 + m * 16 + fr, col = u.pn * 256 + bj * 128 + wc * 32 + n * 16 + 4 * fq;
            ga[m][bj][n] = *(const u32x2*)(mg + (size_t)row * 2048 + col);
          }
      __builtin_amdgcn_sched_barrier(0);
#pragma unroll
      for (int m = 0; m < 4; ++m)
#pragma unroll
        for (int bj = 0; bj < 2; ++bj)
#pragma unroll
          for (int n = 0; n < 2; ++n) {
            const int row = u.pm * 256 + ai * 128 + wr * 64 + m * 16 + fr, col = u.pn * 256 + bj * 128 + wc * 32 + n * 16 + 4 * fq;
            const f32x4 v = acc[ai][bj][m][n]; const u32x2 g = ga[m][bj][n];
            u32x2 o; o.x = pk2(v.x * bflo(g.x), v.y * bfhi(g.x)); o.y = pk2(v.z * bflo(g.y), v.w * bfhi(g.y));
            *(u32x2*)(tmp + (size_t)row * DM + col) = o;
          }
      __builtin_amdgcn_sched_barrier(0);
    }
  }
};
struct EpiMerge2 {
  static constexpr bool PERM = false, AFTER_DRAIN = false;
  const bf16_t* mg; const bf16_t* tmp; bf16_t* mer;
  DI void operator()(const f32x4 (&acc)[2][2][4][2], const pg8::Unit& u, int wr, int wc, int fr, int fq) const {
#pragma unroll
    for (int ai = 0; ai < 2; ++ai)
#pragma unroll
      for (int mh = 0; mh < 2; ++mh) {
        u32x2 gs[2][2][2], tv[2][2][2];
#pragma unroll
        for (int mm = 0; mm < 2; ++mm)
#pragma unroll
          for (int bj = 0; bj < 2; ++bj)
#pragma unroll
            for (int n = 0; n < 2; ++n) {
              const int row = u.pm * 256 + ai * 128 + wr * 64 + (mh * 2 + mm) * 16 + fr, col = u.pn * 256 + bj * 128 + wc * 32 + n * 16 + 4 * fq;
              gs[mm][bj][n] = *(const u32x2*)(mg + (size_t)row * 2048 + 1024 + col);
#if EN_ATTN
              tv[mm][bj][n] = *(const u32x2*)(tmp + (size_t)row * DM + col);
#else
              tv[mm][bj][n] = (u32x2){0u, 0u};
#endif
            }
        __builtin_amdgcn_sched_barrier(0);
#pragma unroll
        for (int mm = 0; mm < 2; ++mm)
#pragma unroll
          for (int bj = 0; bj < 2; ++bj)
#pragma unroll
            for (int n = 0; n < 2; ++n) {
              const int row = u.pm * 256 + ai * 128 + wr * 64 + (mh * 2 + mm) * 16 + fr, col = u.pn * 256 + bj * 128 + wc * 32 + n * 16 + 4 * fq;
              const f32x4 v = acc[ai][bj][mh * 2 + mm][n]; const u32x2 g = gs[mm][bj][n], t = tv[mm][bj][n];
              u32x2 o; o.x = pk2(bflo(t.x) + v.x * bflo(g.x), bfhi(t.x) + v.y * bfhi(g.x)); o.y = pk2(bflo(t.y) + v.z * bflo(g.y), bfhi(t.y) + v.w * bfhi(g.y));
              *(u32x2*)(mer + (size_t)row * DM + col) = o;
            }
        __builtin_amdgcn_sched_barrier(0);
      }
  }
};
DI void phase_merge8(const Params& P_, unsigned char* lds) {
  Params P = P_; { size_t z_ = 0; asm volatile("" : "+s"(z_)); P.ws = P_.ws + z_; }
#if EN_ATTN
  { pg8::Gemm g{(const bf16_t*)(P.ws + WS_A), (const bf16_t*)(P.ws + WS_W + W_O), NT, DM, DM};
    pg8::StaticOrder S; S.init(NT, DM, gridDim.x, obid());
    EpiMerge1 E{(const bf16_t*)(P.ws + WS_F), (bf16_t*)(P.ws + WS_C)};
    pg8::gemm_phase<EpiMerge1, pg8::StaticOrder, true, true>((PG8_LAS unsigned char*)lds, g, S, E); }
#endif
  { pg8::Gemm g{(const bf16_t*)(P.ws + WS_E), (const bf16_t*)(P.ws + WS_W + W_SO), NT, DM, 512};
    pg8::StaticOrder S; S.init(NT, DM, gridDim.x, obid());
    EpiMerge2 E{(const bf16_t*)(P.ws + WS_F), (const bf16_t*)(P.ws + WS_C), (bf16_t*)(P.ws + WS_B)};
    pg8::gemm_phase<EpiMerge2, pg8::StaticOrder, true, true>((PG8_LAS unsigned char*)lds, g, S, E); }
}
struct EpiWout {
  static constexpr bool PERM = false, AFTER_DRAIN = false;
  const float* mod; const float* xin; float* out;
  DI void operator()(const f32x4 (&acc)[2][2][4][2], const pg8::Unit& u, int wr, int wc, int fr, int fq) const {
    const int b = (u.pm * 256) >> 13;
    f32x4 g1[2][2];
#pragma unroll
    for (int bj = 0; bj < 2; ++bj)
#pragma unroll
      for (int n = 0; n < 2; ++n) g1[bj][n] = *(const f32x4*)(mod + (size_t)b * 6144 + 2048 + u.pn * 256 + bj * 128 + wc * 32 + n * 16 + 4 * fq);
#pragma unroll
    for (int ai = 0; ai < 2; ++ai)
#pragma unroll
      for (int mh = 0; mh < 2; ++mh) {
        f32x4 xv[2][2][2];
#pragma unroll
        for (int mm = 0; mm < 2; ++mm)
#pragma unroll
          for (int bj = 0; bj < 2; ++bj)
#pragma unroll
            for (int n = 0; n < 2; ++n) {
              const int row = u.pm * 256 + ai * 128 + wr * 64 + (mh * 2 + mm) * 16 + fr, col = u.pn * 256 + bj * 128 + wc * 32 + n * 16 + 4 * fq;
              xv[mm][bj][n] = *(const f32x4*)(xin + (size_t)row * DM + col);
            }
        __builtin_amdgcn_sched_barrier(0);
#pragma unroll
        for (int mm = 0; mm < 2; ++mm)
#pragma unroll
          for (int bj = 0; bj < 2; ++bj)
#pragma unroll
            for (int n = 0; n < 2; ++n) {
              const int row = u.pm * 256 + ai * 128 + wr * 64 + (mh * 2 + mm) * 16 + fr, col = u.pn * 256 + bj * 128 + wc * 32 + n * 16 + 4 * fq;
              *(f32x4*)(out + (size_t)row * DM + col) = xv[mm][bj][n] + g1[bj][n] * acc[ai][bj][mh * 2 + mm][n];
            }
        __builtin_amdgcn_sched_barrier(0);
      }
  }
};
DI void phase_wout8(const Params& P_, int l, unsigned char* lds) {
  Params P = P_; { size_t z_ = 0; asm volatile("" : "+s"(z_)); P.ws = P_.ws + z_; }
  pg8::Gemm g{(const bf16_t*)(P.ws + WS_B), (const bf16_t*)(P.ws + WS_W + W_OUT), NT, DM, DM};
  pg8::StaticOrder S; S.init(NT, DM, gridDim.x, obid());
  EpiWout E{(const float*)(P.ws + WS_MOD) + (size_t)(l * 2) * 6144, l == 0 ? P.in[0] : P.out, P.out};
  pg8::gemm_phase<EpiWout, pg8::StaticOrder, true, true>((PG8_LAS unsigned char*)lds, g, S, E);
}

struct MoeTab { int cv, pin; };
DI MoeTab moe_tab(const int* cnt) {
  const int lane = otid() & 63; MoeTab T; T.cv = cnt[lane & 31]; int p = (T.cv + 127) >> 7;
#pragma unroll
  for (int o = 1; o < 32; o <<= 1) { const int t = __shfl_up(p, o); if ((lane & 31) >= o) p += t; }
  T.pin = p; return T;
}
DI int moe_total(const MoeTab& T) { return __builtin_amdgcn_readlane(T.pin, 31); }
DI void moe_find(const MoeTab& T, int rb, int& e, int& rbl, int& ce) {
  const unsigned m = (unsigned)__ballot(T.pin <= rb);
  e = __popc(m); e = e < NEXP ? e : NEXP - 1;
  const int nb = (__shfl(T.cv, e) + 127) >> 7;
  ce = __shfl(T.cv, e); rbl = rb - (__shfl(T.pin, e) - nb);
  e = __builtin_amdgcn_readfirstlane(e); rbl = __builtin_amdgcn_readfirstlane(rbl); ce = __builtin_amdgcn_readfirstlane(ce);
}
DI void phase_moe1(const Params& P_, int l, unsigned char* lds) {
  Params P = P_; { size_t z_ = 0; asm volatile("" : "+s"(z_)); P.ws = P_.ws + z_; }
  TILE_IDS;
  const int* cnt = (const int*)(P.ws + WS_CNT) + l * 32; const int* list = (const int*)(P.ws + WS_LIST);
  const bf16_t* h2 = (const bf16_t*)(P.ws + WS_A); bf16_t* act = (bf16_t*)(P.ws + WS_B);
  const MoeTab MT = moe_tab(cnt); const int total = moe_total(MT);
  for (int tile = bid; tile < total * 4; tile += gridDim.x) {
    const int rb = tile >> 2, ct = tile & 3; int e = 0, rbl = 0, ce = 1; moe_find(MT, rb, e, rbl, ce);
    const bf16_t* wt = (const bf16_t*)(P.ws + WS_W + W_GU) + (size_t)e * 512 * 1024 + (size_t)(ct * 128) * 1024;
    const bf16_t* ap[2];
#pragma unroll
    for (int i = 0; i < 2; ++i) { int idx = rbl * 128 + lr + 64 * i; idx = idx < ce ? idx : ce - 1; const int tok = list[e * LISTCAP + idx] >> 1; ap[i] = h2 + (size_t)tok * DM + lk; }
    f32x4 acc[4][2]; ACC_ZERO(acc);
    gemm_kloop(lds, ap[0], ap[1], 64, wt + (size_t)lr * DM + lk, wt + (size_t)(lr + 64) * DM + lk, 16, acc);
#pragma unroll
    for (int m = 0; m < 4; ++m) {
      const int arow = rb * 128 + wr * 64 + m * 16 + fr, col = ct * 64 + wc * 16 + 4 * fq;
      const f32x4 g = acc[m][0], u = acc[m][1];
      u32x2 o; o.x = pk2(g.x * sigmoidf_(g.x) * u.x, g.y * sigmoidf_(g.y) * u.y); o.y = pk2(g.z * sigmoidf_(g.z) * u.z, g.w * sigmoidf_(g.w) * u.w);
      *(u32x2*)(act + (size_t)arow * 256 + col) = o;
    }
  }
}
DI void phase_moe2(const Params& P_, int l, unsigned char* lds) {
  Params P = P_; { size_t z_ = 0; asm volatile("" : "+s"(z_)); P.ws = P_.ws + z_; }
  TILE_IDS;
  const int* cnt = (const int*)(P.ws + WS_CNT) + l * 32; const int* list = (const int*)(P.ws + WS_LIST); const float* wts = (const float*)(P.ws + WS_WT);
  const bf16_t* act = (const bf16_t*)(P.ws + WS_B); bf16_t* ys = (bf16_t*)(P.ws + WS_F);
  constexpr int ASUB = 128 * GT_ROWB, BOFF = 4 * ASUB;
  const MoeTab MT = moe_tab(cnt); const int total = moe_total(MT);
  const int lkb = (tid & 7) * 16;
  for (int item = bid; item < total * 4; item += gridDim.x) {
    const int rb = item >> 2, ct0 = (item & 3) * 2; int e = 0, rbl = 0, ce = 1; moe_find(MT, rb, e, rbl, ce);
    const bf16_t* wt = (const bf16_t*)(P.ws + WS_W + W_D) + (size_t)e * 1024 * 256;
    const bf16_t* a0 = act + (size_t)(rb * 128 + lr) * 256 + lk; const bf16_t* a1 = a0 + 64 * 256;
    u32x4 ra[8], xb0, xb1, yb0, yb1;
#pragma unroll
    for (int k = 0; k < 4; ++k) { ra[2 * k] = *(const u32x4*)(a0 + 64 * k); ra[2 * k + 1] = *(const u32x4*)(a1 + 64 * k); }
#define M2_BLOAD(q0_, q1_, s_) do { const bf16_t* bp_ = wt + (size_t)((ct0 + ((s_) >> 2)) * 128 + lr) * 256 + ((s_) & 3) * 64 + lk; q0_ = *(const u32x4*)bp_; q1_ = *(const u32x4*)(bp_ + 64 * 256); } while (0)
#define M2_BSTORE(q0_, q1_, buf_) do { unsigned char* s_ = lds + BOFF + (buf_) * ASUB; *(u32x4*)(s_ + lr * GT_ROWB + lkb) = q0_; *(u32x4*)(s_ + (lr + 64) * GT_ROWB + lkb) = q1_; } while (0)
#define M2_COMPUTE(s_, buf_) do { \
      const unsigned char* As = lds + ((s_) & 3) * ASUB + (wr * 64 + fr) * GT_ROWB + fq * 16; \
      const unsigned char* Bs = lds + BOFF + (buf_) * ASUB + (wc * 32 + fr) * GT_ROWB + fq * 16; \
      _Pragma("unroll") for (int ks = 0; ks < 2; ++ks) { \
        bf16x8 af[4], bfr[2]; \
        _Pragma("unroll") for (int m = 0; m < 4; ++m) af[m] = *(const bf16x8*)(As + m * 16 * GT_ROWB + ks * 64); \
        _Pragma("unroll") for (int n = 0; n < 2; ++n) bfr[n] = *(const bf16x8*)(Bs + n * 16 * GT_ROWB + ks * 64); \
        _Pragma("unroll") for (int m = 0; m < 4; ++m) _Pragma("unroll") for (int n = 0; n < 2; ++n) acc[m][n] = __builtin_amdgcn_mfma_f32_16x16x32_bf16(bfr[n], af[m], acc[m][n], 0, 0, 0); } } while (0)
#define M2_EPI(ct_) do { _Pragma("unroll") for (int m = 0; m < 4; ++m) { const int idx = rbl * 128 + wr * 64 + m * 16 + fr; \
      if (idx < ce) { const int slot = eslot[m]; const float w_ = ewt[m]; \
        _Pragma("unroll") for (int n = 0; n < 2; ++n) { const int col = (ct_) * 128 + wc * 32 + n * 16 + 4 * fq; const f32x4 v = acc[m][n] * w_; \
          u32x2 o; o.x = pk2(v.x, v.y); o.y = pk2(v.z, v.w); *(u32x2*)(ys + (size_t)slot * DM + col) = o; } } } ACC_ZERO(acc); } while (0)
    int eslot[4]; float ewt[4];
#pragma unroll
    for (int m = 0; m < 4; ++m) { int idx = rbl * 128 + wr * 64 + m * 16 + fr; idx = idx < ce ? idx : ce - 1; eslot[m] = list[e * LISTCAP + idx]; }
#pragma unroll
    for (int m = 0; m < 4; ++m) ewt[m] = wts[eslot[m]];
    M2_BLOAD(xb0, xb1, 0);
#pragma unroll
    for (int k = 0; k < 4; ++k) { *(u32x4*)(lds + k * ASUB + lr * GT_ROWB + lkb) = ra[2 * k]; *(u32x4*)(lds + k * ASUB + (lr + 64) * GT_ROWB + lkb) = ra[2 * k + 1]; }
    M2_BSTORE(xb0, xb1, 0);
    M2_BLOAD(yb0, yb1, 1);
    __syncthreads();
    f32x4 acc[4][2]; ACC_ZERO(acc);
#pragma unroll 1
    for (int s2 = 0; s2 < 8; s2 += 2) {
      if (s2 + 2 < 8) M2_BLOAD(xb0, xb1, s2 + 2);
      M2_COMPUTE(s2, 0);
      M2_BSTORE(yb0, yb1, 1);
      __syncthreads();
      if (s2 + 3 < 8) M2_BLOAD(yb0, yb1, s2 + 3);
      M2_COMPUTE(s2 + 1, 1);
      if (s2 == 2) M2_EPI(ct0);
      if (s2 == 6) M2_EPI(ct0 + 1);
      if (s2 + 2 < 8) M2_BSTORE(xb0, xb1, 0);
      __syncthreads();
    }
#undef M2_BLOAD
#undef M2_BSTORE
#undef M2_COMPUTE
#undef M2_EPI
  }
}

typedef float f32x2v __attribute__((ext_vector_type(2)));
DI void phase_s5a(const Params& P_, int l, unsigned char* lds) {
  Params P = P_; { size_t z_ = 0; asm volatile("" : "+s"(z_)); P.ws = P_.ws + z_; }
  TILE_IDS;
  const bf16_t* ub = (const bf16_t*)(P.ws + WS_E); float* Lb = (float*)(P.ws + WS_L);
  const bf16_t* M1 = (const bf16_t*)(P.ws + WS_TAB + (size_t)l * TAB_LAYER + TAB_M1);
  const int first = (int)gridDim.x >= 192 ? 128 : 0;
  for (int tile = bid - first; tile >= 0 && tile < 64; tile += gridDim.x) {
    const int g = tile >> 1, rt = tile & 1;
    const bf16_t* a = ub + ((size_t)g * NT / 64 + rt * 128) * 1024;
    const bf16_t* wt = M1 + (size_t)g * 128 * 1024;
    f32x4 acc[4][2]; ACC_ZERO(acc);
    gemm_kloop(lds, a + (size_t)lr * 1024 + lk, a + (size_t)(lr + 64) * 1024 + lk, 64, wt + (size_t)lr * 1024 + lk, wt + (size_t)(lr + 64) * 1024 + lk, 16, acc);
#pragma unroll
    for (int m = 0; m < 4; ++m)
#pragma unroll
      for (int n = 0; n < 2; ++n) {
        const int R = rt * 128 + wr * 64 + m * 16 + fr, comp = wc * 32 + n * 16 + 4 * fq;
        *(f32x4*)(Lb + ((size_t)(R * 32 + g) * 64) * 2 + comp) = acc[m][n];
      }
  }
}
DI void s5_carry(const Params& P_, int l) {
  Params P = P_; { size_t z_ = 0; asm volatile("" : "+s"(z_)); P.ws = P_.ws + z_; }
  const int tid_ = otid(), bid = obid(), wave = tid_ >> 6, lane = tid_ & 63;
  const int item = (gridDim.x * NWAVE - 1) - (bid * NWAVE + wave);
  if (item >= NB * 32) return;
  const int b = item >> 5, g = item & 31;
  const float* pp = (const float*)(P.ws + WS_S5P) + (size_t)((l * 32 + g) * 64 + lane) * 36;
  const float aTr = pp[2], aTi = pp[3];
  float2* Lp = (float2*)(P.ws + WS_L) + ((size_t)(b * 128) * 32 + g) * 64 + lane;
  unsigned* Sp = (unsigned*)(P.ws + WS_SIN) + ((size_t)(g * 256 + b * 128)) * 64 + lane;
  float sr = 0.f, si = 0.f; asm volatile("" : "+v"(sr), "+v"(si));
  float2 va[8], vb[8];
#define CY_LOAD(vv, c0_) do { _Pragma("unroll") for (int k = 0; k < 8; ++k) vv[k] = Lp[(size_t)((c0_) + k) * 2048]; } while (0)
#define CY_STEP(vv, c0_) do { _Pragma("unroll") for (int k = 0; k < 8; ++k) { Lp[(size_t)((c0_) + k) * 2048] = make_float2(sr, si); Sp[(size_t)((c0_) + k) * 64] = pk2(sr, si); \
      const float nr = aTr * sr - aTi * si + vv[k].x, ni = aTr * si + aTi * sr + vv[k].y; sr = nr; si = ni; } } while (0)
#define CY_PIN(vv) do { _Pragma("unroll") for (int k = 0; k < 8; ++k) asm volatile("" : "+v"(vv[k].x), "+v"(vv[k].y)); } while (0)
  CY_LOAD(va, 0);
#pragma unroll
  for (int c0 = 0; c0 < 128; c0 += 16) {
    CY_LOAD(vb, c0 + 8);
    CY_PIN(va);
    CY_STEP(va, c0);
    if (c0 + 16 < 128) CY_LOAD(va, c0 + 16);
    CY_PIN(vb);
    CY_STEP(vb, c0 + 8);
  }
#undef CY_PIN
#undef CY_LOAD
#undef CY_STEP
}
DI void phase_s5c(const Params& P_, int l, unsigned char* lds) {
  Params P = P_; { size_t z_ = 0; asm volatile("" : "+s"(z_)); P.ws = P_.ws + z_; }
  TILE_IDS;
  const bf16_t* ub = (const bf16_t*)(P.ws + WS_E); const bf16_t* sinb = (const bf16_t*)(P.ws + WS_SIN); bf16_t* yb = (bf16_t*)(P.ws + WS_G);
  const bf16_t* tab = (const bf16_t*)(P.ws + WS_TAB + (size_t)l * TAB_LAYER);
  int* dctr = (int*)(P.ws + 640) + l; int* dslot = (int*)(lds + LDS_BYTES - 32);
  constexpr int ROWB = 144, SA = 0, SB = 128 * ROWB, STAGE = 2 * 128 * ROWB;
  const int lkb = (tid & 7) * 16, kch = tid & 7;
  for (;;) {
    if (threadIdx.x == 0) *dslot = atomicAdd(dctr, 1);
    __syncthreads();
    const int tile = *dslot;
    __syncthreads();
    if (tile >= 512) break;
    const int g = tile >> 4, rt = (tile >> 3) & 1, ct = tile & 7;
    const bf16_t* Kt = tab + TAB_KT / 2 + (size_t)g * 64 * 256; const bf16_t* M2 = tab + TAB_M2 / 2 + (size_t)g * 1024 * 128;
    const bf16_t* ua = ub + ((size_t)g * 256 + rt * 128) * 1024; const bf16_t* sa = sinb + ((size_t)g * 256 + rt * 128) * 128;
    const int nbt = 2 * ct + 2 < 16 ? 2 * ct + 2 : 16, ns = nbt + 2;
    u32x4 xa0, xa1, xb0, xb1, ya0, ya1, yb0, yb1;
#define S5_LOAD(p0_, p1_, q0_, q1_, s_) do { \
      if ((s_) < nbt) { p0_ = *(const u32x4*)(ua + (size_t)lr * 1024 + (s_) * 64 + lk); p1_ = *(const u32x4*)(ua + (size_t)(lr + 64) * 1024 + (s_) * 64 + lk); \
        const int i_ = 4 * (s_) + (kch >> 1), hq_ = (kch & 1) * 8; \
        { const int t_ = 8 * ct + (lr >> 4), h_ = lr & 15; q0_ = t_ >= i_ ? *(const u32x4*)(Kt + ((t_ - i_) * 16 + h_) * 16 + hq_) : (u32x4){0u, 0u, 0u, 0u}; } \
        { const int t_ = 8 * ct + 4 + (lr >> 4), h_ = lr & 15; q1_ = t_ >= i_ ? *(const u32x4*)(Kt + ((t_ - i_) * 16 + h_) * 16 + hq_) : (u32x4){0u, 0u, 0u, 0u}; } \
      } else { const int k0_ = ((s_) - nbt) * 64 + lk; \
        p0_ = *(const u32x4*)(sa + (size_t)lr * 128 + k0_); p1_ = *(const u32x4*)(sa + (size_t)(lr + 64) * 128 + k0_); \
        q0_ = *(const u32x4*)(M2 + (size_t)(ct * 128 + lr) * 128 + k0_); q1_ = *(const u32x4*)(M2 + (size_t)(ct * 128 + lr + 64) * 128 + k0_); } } while (0)
#define S5_STORE(p0_, p1_, q0_, q1_, buf) do { unsigned char* s_ = lds + (buf) * STAGE; \
      *(u32x4*)(s_ + SA + lr * ROWB + lkb) = p0_; *(u32x4*)(s_ + SA + (lr + 64) * ROWB + lkb) = p1_; \
      *(u32x4*)(s_ + SB + lr * ROWB + lkb) = q0_; *(u32x4*)(s_ + SB + (lr + 64) * ROWB + lkb) = q1_; } while (0)
#define S5_COMPUTE(buf) do { \
      const unsigned char* As = lds + (buf) * STAGE + SA + (wr * 64 + fr) * ROWB + fq * 16; \
      const unsigned char* Bs = lds + (buf) * STAGE + SB + (wc * 32 + fr) * ROWB + fq * 16; \
      _Pragma("unroll") for (int ks = 0; ks < 2; ++ks) { \
        bf16x8 af[4], bfr[2]; \
        _Pragma("unroll") for (int m = 0; m < 4; ++m) af[m] = *(const bf16x8*)(As + m * 16 * ROWB + ks * 64); \
        _Pragma("unroll") for (int n = 0; n < 2; ++n) bfr[n] = *(const bf16x8*)(Bs + n * 16 * ROWB + ks * 64); \
        _Pragma("unroll") for (int m = 0; m < 4; ++m) _Pragma("unroll") for (int n = 0; n < 2; ++n) acc[m][n] = __builtin_amdgcn_mfma_f32_16x16x32_bf16(bfr[n], af[m], acc[m][n], 0, 0, 0); } } while (0)
    f32x4 acc[4][2]; ACC_ZERO(acc);
    S5_LOAD(xa0, xa1, xb0, xb1, 0); S5_STORE(xa0, xa1, xb0, xb1, 0); S5_LOAD(ya0, ya1, yb0, yb1, 1); __syncthreads();
    for (int st = 0; st < ns; st += 2) {
      if (st + 2 < ns) S5_LOAD(xa0, xa1, xb0, xb1, st + 2);
      S5_COMPUTE(0);
      if (st + 1 < ns) S5_STORE(ya0, ya1, yb0, yb1, 1);
      __syncthreads();
      if (st + 1 >= ns) break;
      if (st + 3 < ns) S5_LOAD(ya0, ya1, yb0, yb1, st + 3);
      S5_COMPUTE(1);
      if (st + 2 < ns) S5_STORE(xa0, xa1, xb0, xb1, 0);
      __syncthreads();
    }
#undef S5_LOAD
#undef S5_STORE
#undef S5_COMPUTE
    const float* dsk = P.in[13] + (size_t)(l * 32 + g) * 16;
#pragma unroll
    for (int m = 0; m < 4; ++m)
#pragma unroll
      for (int n = 0; n < 2; ++n) {
        const int R = rt * 128 + wr * 64 + m * 16 + fr, col = ct * 128 + wc * 32 + n * 16 + 4 * fq, t = col >> 4, h = col & 15;
        const u32x2 uu = *(const u32x2*)(ub + ((size_t)g * 256 + R) * 1024 + col); const f32x4 dd = *(const f32x4*)(dsk + h); const f32x4 v = acc[m][n];
        const float y0 = gelu_tanh(v.x + dd.x * bflo(uu.x)), y1 = gelu_tanh(v.y + dd.y * bfhi(uu.x)), y2 = gelu_tanh(v.z + dd.z * bflo(uu.y)), y3 = gelu_tanh(v.w + dd.w * bfhi(uu.y));
        const size_t tokn = (size_t)(R >> 7) * SEQ + 64 * (R & 127) + t;
        u32x2 o; o.x = pk2(y0, y1); o.y = pk2(y2, y3); *(u32x2*)(yb + tokn * 512 + g * 16 + h) = o;
      }
  }
}

constexpr int AT_ROWB = 144, AT_KS = 0, AT_VS = 2 * 64 * AT_ROWB, AT_IMP = 4 * 64 * AT_ROWB, AT_OACC = AT_IMP, AT_IMPS = 129, AT_EE = AT_IMP + 64 * AT_IMPS * 4,
              AT_SEL = AT_IMP + 66048, AT_QS = AT_SEL + 1024, AT_QL = AT_QS + 32768, AT_NJ = AT_QL + 8192, AT_ITEMS = AT_NJ + 512, AT_MREF = AT_ITEMS + 512,
              AT_LACC = AT_MREF + 1024, AT_INVQ = AT_LACC + 1024, AT_MISC = AT_INVQ + 512, AT_LOWN = AT_MISC + 64, AT_END = AT_LOWN + 1024;
static_assert(AT_END <= LDS_BYTES - 16, "attention LDS");
#define MFMA32(a, b, c) __builtin_amdgcn_mfma_f32_32x32x16_bf16((a), (b), (c), 0, 0, 0)
DI int crow_of(int reg, int hh) { return (reg & 3) + 8 * (reg >> 2) + 4 * hh; }

struct AttnState { f32x16 o0, o1; float m, l; };
DI void st_init(AttnState& S) { S.m = -1e30f; S.l = 0.f;
#pragma unroll
  for (int i = 0; i < 16; ++i) { S.o0[i] = 0.f; S.o1[i] = 0.f; } }

DI void at_ldk(const unsigned char* lds, int buf, int r, int hh, bf16x8 (&kf)[8]) {
  const unsigned char* kb = lds + AT_KS + buf * 64 * AT_ROWB + r * AT_ROWB + hh * 16;
#pragma unroll
  for (int ds = 0; ds < 4; ++ds) { kf[ds] = *(const bf16x8*)(kb + ds * 32); kf[4 + ds] = *(const bf16x8*)(kb + 32 * AT_ROWB + ds * 32); }
}
DI void at_ldv(const unsigned char* lds, int buf, int r, int hh, bf16x8 (&vf)[8]) {
  const unsigned char* vb = lds + AT_VS + buf * 64 * AT_ROWB + r * AT_ROWB + hh * 16;
#pragma unroll
  for (int gk = 0; gk < 4; ++gk) { vf[gk] = *(const bf16x8*)(vb + gk * 32); vf[4 + gk] = *(const bf16x8*)(vb + 32 * AT_ROWB + gk * 32); }
}
DI void at_qk(const bf16x8 (&kf)[8], const bf16x8 (&qf)[4], f32x16& p0, f32x16& p1) {
  const f32x16 z = {0.f, 0.f, 0.f, 0.f, 0.f, 0.f, 0.f, 0.f, 0.f, 0.f, 0.f, 0.f, 0.f, 0.f, 0.f, 0.f};
#pragma unroll
  for (int ds = 0; ds < 4; ++ds) { if (ds == 0) { p0 = MFMA32(kf[0], qf[0], z); p1 = MFMA32(kf[4], qf[0], z); } else { p0 = MFMA32(kf[ds], qf[ds], p0); p1 = MFMA32(kf[4 + ds], qf[ds], p1); } }
}
DI bf16x8 pack8(const f32x16& p, int s2) {
  u32x4 w; w.x = pk2(p[8 * s2], p[8 * s2 + 1]); w.y = pk2(p[8 * s2 + 2], p[8 * s2 + 3]); w.z = pk2(p[8 * s2 + 4], p[8 * s2 + 5]); w.w = pk2(p[8 * s2 + 6], p[8 * s2 + 7]);
  return __builtin_bit_cast(bf16x8, w);
}
DI void at_pv(const bf16x8 (&vf)[8], const f32x16& p0, const f32x16& p1, f32x16& oa, f32x16& ob) {
#pragma unroll
  for (int gk = 0; gk < 4; ++gk) {
    const bf16x8 pb = (gk < 2) ? pack8(p0, gk & 1) : pack8(p1, gk & 1);
    oa = MFMA32(vf[gk], pb, oa); ob = MFMA32(vf[4 + gk], pb, ob);
  }
}
template <int MODE>
DI void at_online(AttnState& S, f32x16& p0, f32x16& p1, int key0, int lo, int hi, bool on, int hh) {
  float tm = -1e30f;
  if (MODE == 1) {
    int lor = lo - key0 - 4 * hh, hir = hi - key0 - 4 * hh;
    if (hir < lor) { lor = 4096; hir = 4096; }
    const unsigned span = (unsigned)(hir - lor);
#pragma unroll
    for (int i = 0; i < 16; ++i) { const int c0 = (i & 3) + 8 * (i >> 2);
      p0[i] = ((unsigned)(c0 - lor) <= span) ? p0[i] : -1e30f; p1[i] = ((unsigned)(c0 + 32 - lor) <= span) ? p1[i] : -1e30f; }
  }
  if (MODE != 1) asm volatile("s_nop 15\n\ts_nop 7" : "+v"(p0), "+v"(p1));
#define MX3_8(o_) asm("v_max3_f32 %0, %0, %1, %2\n\tv_max3_f32 %0, %0, %3, %4\n\tv_max3_f32 %0, %0, %5, %6\n\tv_max3_f32 %0, %0, %7, %8\n\tv_max3_f32 %0, %0, %9, %10\n\tv_max3_f32 %0, %0, %11, %12\n\tv_max3_f32 %0, %0, %13, %14\n\tv_max3_f32 %0, %0, %15, %16" \
      : "+v"(tm) : "v"(p0[o_]), "v"(p1[o_]), "v"(p0[o_ + 1]), "v"(p1[o_ + 1]), "v"(p0[o_ + 2]), "v"(p1[o_ + 2]), "v"(p0[o_ + 3]), "v"(p1[o_ + 3]), "v"(p0[o_ + 4]), "v"(p1[o_ + 4]), "v"(p0[o_ + 5]), "v"(p1[o_ + 5]), "v"(p0[o_ + 6]), "v"(p1[o_ + 6]), "v"(p0[o_ + 7]), "v"(p1[o_ + 7]))
  MX3_8(0); MX3_8(8);
#undef MX3_8
  tm = fmaxf(tm, __shfl_xor(tm, 32));
  if (MODE == 2) tm = on ? tm : -1e30f;
  if (__any(tm > S.m)) {
    const float mn = fmaxf(S.m, tm); const float al = __builtin_amdgcn_exp2f(S.m - mn); S.m = mn; S.l *= al;
#pragma unroll
    for (int i = 0; i < 16; ++i) { S.o0[i] *= al; S.o1[i] *= al; }
  }
  float mn = S.m;
  if (MODE == 2) mn = on ? mn : 1e30f;
  if (MODE == 1) mn = mn < -1e29f ? 1e30f : mn;
  float rs = 0.f;
#pragma unroll
  for (int i = 0; i < 16; ++i) {
    const float e0 = __builtin_amdgcn_exp2f(p0[i] - mn), e1 = __builtin_amdgcn_exp2f(p1[i] - mn);
    p0[i] = e0; p1[i] = e1; rs += e0 + e1;
  }
  S.l += rs;
}

DI void attn_tile(const Params& P_, unsigned char* lds, int b, int g, int c) {
  Params P = P_; { size_t z_ = 0; asm volatile("" : "+s"(z_)); P.ws = P_.ws + z_; }
#define AT_IDS const int tid = otid(), lane = tid & 63, w = tid >> 6, r = lane & 31, hh = lane >> 5, qi = 8 * w + (r >> 2), h = r & 3, t = 64 * c + qi, qrow = 32 * w + r, srow = tid >> 3, sch = (tid & 7) * 8, ahead = lane >> 4, ach = lane & 15; const unsigned tok = (unsigned)b * SEQ + t, goff = tok * 48 + g * 4 + h; (void)qi; (void)h; (void)t; (void)qrow; (void)srow; (void)sch; (void)ahead; (void)ach; (void)tok; (void)goff; (void)hh; (void)w; (void)r
  const bf16_t* qb = (const bf16_t*)(P.ws + WS_B); const bf16_t* kvk = (const bf16_t*)(P.ws + WS_C); const bf16_t* vT = (const bf16_t*)(P.ws + WS_DV);
  const bf16_t* kcb = (const bf16_t*)(P.ws + WS_KC); const bf16_t* vcb = (const bf16_t*)(P.ws + WS_VC);
  const float* gbase = (const float*)(P.ws + WS_GATES);
#define gates(i) gbase[goff + (i)]
  bf16_t* attn = (bf16_t*)(P.ws + WS_A);
  float* otb = (float*)(P.ws + WS_OT) + (size_t)obid() * 16384;
#define otg(i) otb[(unsigned)tid + (i) * 512u]
  float* IMP = (float*)(lds + AT_IMP); float* EE = (float*)(lds + AT_EE); unsigned* SEL = (unsigned*)(lds + AT_SEL);
  AttnState S; f32x16 p0, p1; u32x4 rkA, rvA; bf16x8 qf[4], kfr[8], vfr[8];
#define QF_LOAD() do { _Pragma("unroll") for (int ds_ = 0; ds_ < 4; ++ds_) qf[ds_] = *(const bf16x8*)(lds + AT_QS + qrow * 128 + (((ds_ * 2 + hh) ^ (qrow & 7)) * 16)); } while (0)
#define AT_QKV() do { at_ldk(lds, buf_, r, hh, kfr); __builtin_amdgcn_sched_barrier(0); at_qk(kfr, qf, p0, p1); at_ldv(lds, buf_, r, hh, vfr); __builtin_amdgcn_sched_barrier(0); } while (0)
  { AT_IDS;
  { const int row = tid >> 1, half = tid & 1, q_i = row >> 2, hd = row & 3;
    const unsigned so = ((unsigned)b * SEQ + 64 * c + q_i) * DM + (g * 4 + hd) * 64 + half * 32;
#pragma unroll
    for (int k = 0; k < 4; ++k) { const u32x4 v = *(const u32x4*)(qb + so + k * 8); *(u32x4*)(lds + AT_QS + row * 128 + (((half * 4 + k) ^ (row & 7)) * 16)) = v; } }
  __syncthreads();
  QF_LOAD();
#define ST_LOAD(rk, rv, kp, kstride, vp, vstride, kt) do { rk = *(const u32x4*)((kp) + (unsigned)(((kt) * 64 + srow) * (kstride) + sch)); rv = *(const u32x4*)((vp) + (unsigned)(srow * (vstride) + (kt) * 64 + sch)); } while (0)
#define ST_STORE(rk, rv, buf) do { *(u32x4*)(lds + AT_KS + (buf) * 64 * AT_ROWB + srow * AT_ROWB + sch * 2) = rk; *(u32x4*)(lds + AT_VS + (buf) * 64 * AT_ROWB + srow * AT_ROWB + sch * 2) = rv; } while (0)
#define SWEEP(kp, kstride, vp, vstride, kt0, n, ...) do { \
    ST_LOAD(rkA, rvA, kp, kstride, vp, vstride, (kt0)); ST_STORE(rkA, rvA, 0); __syncthreads(); \
    for (int i_ = 0; i_ < (n); ++i_) { \
      if (i_ + 1 < (n)) ST_LOAD(rkA, rvA, kp, kstride, vp, vstride, (kt0) + i_ + 1); \
      { const int step_ = i_; const int buf_ = i_ & 1; __VA_ARGS__ } \
      if (i_ + 1 < (n)) ST_STORE(rkA, rvA, (i_ + 1) & 1); \
      __syncthreads(); \
    } } while (0)
#define ST_LOADF(rk, rv, kt) do { rk = *(const u32x4*)(kps + (size_t)(kt) * 4096 + tid * 8); rv = *(const u32x4*)(vps + (size_t)(kt) * 4096 + tid * 8); } while (0)
#define ST_STOREF(rk, rv, buf) do { const int fo_ = ((tid >> 8) * 32 + (tid & 31)) * AT_ROWB + (((tid >> 6) & 3) * 2 + ((tid >> 5) & 1)) * 16; \
    *(u32x4*)(lds + AT_KS + (buf) * 64 * AT_ROWB + fo_) = rk; *(u32x4*)(lds + AT_VS + (buf) * 64 * AT_ROWB + fo_) = rv; } while (0)
#define SWEEPF(kt0, n, ...) do { \
    ST_LOADF(rkA, rvA, (kt0)); ST_STOREF(rkA, rvA, 0); __syncthreads(); \
    for (int i_ = 0; i_ < (n); ++i_) { \
      if (i_ + 1 < (n)) ST_LOADF(rkA, rvA, (kt0) + i_ + 1); \
      { const int step_ = i_; const int buf_ = i_ & 1; __VA_ARGS__ } \
      if (i_ + 1 < (n)) ST_STOREF(rkA, rvA, (i_ + 1) & 1); \
      __syncthreads(); \
    } } while (0)
  {
    const bf16_t* kp = kvk + (size_t)b * SEQ * DM + 3 * 256 + g * 64; const bf16_t* vp = vT + (size_t)(((1 * NB + b) * 4 + g) * 64) * SEQ;
    const int j0 = c >= 8 ? c - 8 : 0, nj = c - j0 + 1;
    st_init(S);
    SWEEP(kp, DM, vp, SEQ, j0, nj, {
      AT_QKV();
      if ((step_ == 0 && c >= 8) || step_ == nj - 1) at_online<1>(S, p0, p1, (j0 + step_) * 64, t - 511, t, true, hh);
      else at_online<0>(S, p0, p1, 0, 0, 0, true, hh);
      at_pv(vfr, p0, p1, S.o0, S.o1); });
    const float lt = S.l + __shfl_xor(S.l, 32); const float sc = lt > 0.f ? gates(32) / lt : 0.f;
#pragma unroll
    for (int i = 0; i < 16; ++i) { otg(i) = S.o0[i] * sc; otg(16 + i) = S.o1[i] * sc; }
  }
  {
    const bf16_t* kcp = kcb + (size_t)((b * 4 + g) * 512) * 64; const bf16_t* vcp = vcb + (size_t)((b * 4 + g) * 64) * 512;
    const int nmax = t >= 31 ? (t - 31) >> 4 : -1;
    const int nct = (4 * c + 2) / 64 + 1;
    st_init(S);
    SWEEP(kcp, 64, vcp, 512, 0, nct, {
      at_ldk(lds, buf_, r, hh, kfr); __builtin_amdgcn_sched_barrier(0); at_qk(kfr, qf, p0, p1);
      if (64 * step_ + 63 <= 4 * c - 2) at_online<0>(S, p0, p1, 0, 0, 0, true, hh);
      else at_online<1>(S, p0, p1, step_ * 64, 0, nmax, true, hh); });
    const float lt = S.l + __shfl_xor(S.l, 32);
    const float cinv = lt > 0.f ? 1.f / lt : 0.f; const float cm = S.m;
    st_init(S);
    SWEEP(kcp, 64, vcp, 512, 0, nct, {
      AT_QKV();
      if (64 * step_ + 63 <= 4 * c - 2) {
        _Pragma("unroll") for (int k = 0; k < 16; ++k) { p0[k] = __builtin_amdgcn_exp2f(p0[k] - cm) * cinv; p1[k] = __builtin_amdgcn_exp2f(p1[k] - cm) * cinv; }
      } else {
        const int nrel = nmax - step_ * 64 - 4 * hh;
        _Pragma("unroll") for (int k = 0; k < 16; ++k) { const int c0 = (k & 3) + 8 * (k >> 2), c1 = c0 + 32;
          p0[k] = c0 <= nrel ? __builtin_amdgcn_exp2f(p0[k] - cm) * cinv : 0.f; p1[k] = c1 <= nrel ? __builtin_amdgcn_exp2f(p1[k] - cm) * cinv : 0.f; }
      }
      at_pv(vfr, p0, p1, S.o0, S.o1);
      _Pragma("unroll") for (int kh = 0; kh < 2; ++kh)
      _Pragma("unroll") for (int gi = 0; gi < 4; ++gi) {
          float g4 = kh == 0 ? (p0[4 * gi] + p0[4 * gi + 1]) + (p0[4 * gi + 2] + p0[4 * gi + 3]) : (p1[4 * gi] + p1[4 * gi + 1]) + (p1[4 * gi + 2] + p1[4 * gi + 3]);
          float e3 = kh == 0 ? p0[4 * gi + 3] : p1[4 * gi + 3];
          g4 += __shfl_xor(g4, 1); g4 += __shfl_xor(g4, 2); e3 += __shfl_xor(e3, 1); e3 += __shfl_xor(e3, 2);
          if (h == 0) { const int s = (step_ * 64 + kh * 32 + 8 * gi + 4 * hh) >> 2; IMP[qi * AT_IMPS + s] = g4; EE[qi * AT_IMPS + s] = e3; }
      } });
    const float gc = gates(0);
#pragma unroll
    for (int i = 0; i < 16; ++i) { p0[i] = otg(i); p1[i] = otg(16 + i); }
    __builtin_amdgcn_sched_barrier(0);
#pragma unroll
    for (int i = 0; i < 16; ++i) { otg(i) = p0[i] + S.o0[i] * gc; otg(16 + i) = p1[i] + S.o1[i] * gc; }
  }
  }
  const bf16_t* kps = (const bf16_t*)(P.ws + WS_KSF) + (size_t)((b * 4 + g) * 128) * 4096; const bf16_t* vps = vT + (size_t)((b * 4 + g) * 128) * 4096;
  if (c <= 15) { AT_IDS; QF_LOAD();
    st_init(S);
    if (c > 0) {
      SWEEPF(0, c, {
        AT_QKV();
        at_online<0>(S, p0, p1, 0, 0, 0, true, hh);
        at_pv(vfr, p0, p1, S.o0, S.o1); });
    }
    SWEEPF(c, 1, {
      AT_QKV();
      at_online<1>(S, p0, p1, (c + step_) * 64, 0, t, true, hh);
      at_pv(vfr, p0, p1, S.o0, S.o1); });
    const float lt = S.l + __shfl_xor(S.l, 32); const float slc_sc = lt > 0.f ? gates(16) / lt : 0.f;
    bf16_t* op = attn + (tok * DM + (g * 4 + h) * 64);
#pragma unroll
    for (int i = 0; i < 16; ++i) { S.o0[i] = S.o0[i] * slc_sc + otg(i); S.o1[i] = S.o1[i] * slc_sc + otg(16 + i); }
#pragma unroll
    for (int gi = 0; gi < 4; ++gi) {
      u32x2 a; a.x = pk2(S.o0[4 * gi], S.o0[4 * gi + 1]); a.y = pk2(S.o0[4 * gi + 2], S.o0[4 * gi + 3]);
      u32x2 bq; bq.x = pk2(S.o1[4 * gi], S.o1[4 * gi + 1]); bq.y = pk2(S.o1[4 * gi + 2], S.o1[4 * gi + 3]);
      *(u32x2*)(op + 8 * gi + 4 * hh) = a; *(u32x2*)(op + 32 + 8 * gi + 4 * hh) = bq;
    }
  } else {
    const int nc = c - 2;
    unsigned char* QL = lds + AT_QL; int* NJ = (int*)(lds + AT_NJ); unsigned short* ITEMS = (unsigned short*)(lds + AT_ITEMS); int* MISC = (int*)(lds + AT_MISC);
    float* MREF = (float*)(lds + AT_MREF); float* LS = (float*)(lds + AT_LACC); unsigned char* INVQ = lds + AT_INVQ; unsigned char* SLOT = lds + AT_IMP;
    float* const LOWN = (float*)(lds + AT_LOWN); const float k64 = 5.421010862427522e-20f;
    { AT_IDS;
    { const int q = tid >> 3; for (int s = 1 + (tid & 7); s <= nc; s += 8) IMP[q * AT_IMPS + s] += EE[q * AT_IMPS + s - 1]; }
    if (tid < 256) SEL[tid] = 0u;
    if (tid < 128) ((unsigned*)INVQ)[tid] = 0u;
    __syncthreads();
    {
      const int q = tid >> 3, sub = tid & 7; const float* ip = IMP + q * AT_IMPS;
      unsigned key[16];
#pragma unroll
      for (int k = 0; k < 16; ++k) { const int s = 1 + sub + 8 * k; key[k] = s <= nc ? __float_as_uint(ip[s]) + 1u : 0u; }
      unsigned T = 0u;
      for (int bit = 30; bit >= 0; --bit) {
        const unsigned cand = T | (1u << bit); int cn = 0;
#pragma unroll
        for (int k = 0; k < 16; ++k) cn += key[k] >= cand ? 1 : 0;
        cn += __shfl_xor(cn, 1); cn += __shfl_xor(cn, 2); cn += __shfl_xor(cn, 4);
        if (cn >= 13) T = cand;
      }
      int ngt = 0, neq = 0;
#pragma unroll
      for (int k = 0; k < 16; ++k) { ngt += key[k] > T ? 1 : 0; neq += key[k] == T ? 1 : 0; }
      ngt += __shfl_xor(ngt, 1); ngt += __shfl_xor(ngt, 2); ngt += __shfl_xor(ngt, 4);
      neq += __shfl_xor(neq, 1); neq += __shfl_xor(neq, 2); neq += __shfl_xor(neq, 4);
      const int need = 13 - ngt;
      unsigned w0 = 0u, w1 = 0u, w2 = 0u, w3 = 0u;
      if (!__any(neq > need)) {
#pragma unroll
        for (int k = 0; k < 16; ++k) if (key[k] >= T && key[k] != 0u) { const int s = 1 + sub + 8 * k; const unsigned bt = 1u << (s & 31); if (s < 32) w0 |= bt; else if (s < 64) w1 |= bt; else if (s < 96) w2 |= bt; else w3 |= bt; }
      } else {
        int taken = 0; const int gsh = lane & ~7;
#pragma unroll
        for (int k = 0; k < 16; ++k) {
          const bool eq = key[k] == T && key[k] != 0u; const unsigned long long mk = __ballot(eq);
          const unsigned grp = (unsigned)(mk >> gsh) & 0xffu; const int before = __popc(grp & ((1u << sub) - 1u));
          const bool pick = key[k] > T || (eq && taken + before < need);
          taken += __popc(grp);
          if (pick) { const int s = 1 + sub + 8 * k; const unsigned bt = 1u << (s & 31); if (s < 32) w0 |= bt; else if (s < 64) w1 |= bt; else if (s < 96) w2 |= bt; else w3 |= bt; }
        }
      }
      if (w0) atomicOr(&SEL[q * 4], w0); if (w1) atomicOr(&SEL[q * 4 + 1], w1); if (w2) atomicOr(&SEL[q * 4 + 2], w2); if (w3) atomicOr(&SEL[q * 4 + 3], w3);
    }
    __syncthreads();
    for (int j = 1 + w; j <= nc; j += NWAVE) {
      const bool bit = (SEL[lane * 4 + (j >> 5)] >> (j & 31)) & 1u;
      const unsigned long long mk = __ballot(bit);
      const int rank = __builtin_amdgcn_mbcnt_hi((unsigned)(mk >> 32), __builtin_amdgcn_mbcnt_lo((unsigned)mk, 0u));
      if (bit) QL[j * 64 + rank] = (unsigned char)lane;
      const int cnt = __popcll(mk);
      if (lane < ((8 - (cnt & 7)) & 7)) QL[j * 64 + cnt + lane] = 0;
      if (lane == 0) NJ[j] = cnt;
    }
    __syncthreads();
    if (w == 0) {
      const int ja = 1 + lane, jb = 65 + lane;
      const int ca = ja <= nc ? (NJ[ja] + 7) >> 3 : 0, cb = jb <= nc ? (NJ[jb] + 7) >> 3 : 0;
      int sa = ca, sb = cb;
#pragma unroll
      for (int o = 1; o < 64; o <<= 1) { const int ta = __shfl_up(sa, o), tb = __shfl_up(sb, o); if (lane >= o) { sa += ta; sb += tb; } }
      const int tota = __shfl(sa, 63);
      for (int k = 0; k < ca; ++k) ITEMS[sa - ca + k] = (unsigned short)(ja * 8 + k);
      for (int k = 0; k < cb; ++k) ITEMS[tota + sb - cb + k] = (unsigned short)(jb * 8 + k);
      if (lane == 63) MISC[0] = tota + sb;
    }
    }
    { AT_IDS; QF_LOAD();
    st_init(S);
    SWEEPF(0, 1, {
      AT_QKV();
      at_online<0>(S, p0, p1, 0, 0, 0, true, hh);
      at_pv(vfr, p0, p1, S.o0, S.o1); });
    SWEEPF(c - 1, 2, {
      AT_QKV();
      if (step_ == 1) at_online<1>(S, p0, p1, c * 64, 0, t, true, hh); else at_online<0>(S, p0, p1, 0, 0, 0, true, hh);
      at_pv(vfr, p0, p1, S.o0, S.o1); });
    { const float lt = S.l + __shfl_xor(S.l, 32);
      if (hh == 0) { MREF[qrow] = S.m + 64.f; LS[w * 32 + r] = lt * k64; } }
#define SLOT_WRITE(x, o0_, o1_, scale_) do { unsigned char* sp_ = SLOT + (x) * 8192 + r * 256; \
      _Pragma("unroll") for (int gi_ = 0; gi_ < 4; ++gi_) { \
        const f32x4 va_ = {o0_[4 * gi_] * (scale_), o0_[4 * gi_ + 1] * (scale_), o0_[4 * gi_ + 2] * (scale_), o0_[4 * gi_ + 3] * (scale_)}; \
        const f32x4 vb_ = {o1_[4 * gi_] * (scale_), o1_[4 * gi_ + 1] * (scale_), o1_[4 * gi_ + 2] * (scale_), o1_[4 * gi_ + 3] * (scale_)}; \
        *(f32x4*)(sp_ + (((2 * gi_ + hh) ^ (r & 15)) * 16)) = va_; *(f32x4*)(sp_ + (((8 + 2 * gi_ + hh) ^ (r & 15)) * 16)) = vb_; } } while (0)
#define SLOT_READ(x, col_) (*(const f32x4*)(SLOT + (x) * 8192 + (col_) * 256 + ((ach ^ ((col_) & 15)) * 16)))
    SLOT_WRITE(w, S.o0, S.o1, k64);
    __syncthreads();
    }
    {
      AT_IDS; const int wu = __builtin_amdgcn_readfirstlane(w);
      const int nitems = MISC[0], nrounds = (nitems + 3) >> 2;
      if (wu >= 4) {
        const int ow = wu - 4, oq = lane >> 2, oh = lane & 3, srcslot = 2 * ow + (lane >> 5), scol = lane & 31;
        f32x4 acc[16]; float accl;
        { const unsigned char* rp = SLOT + srcslot * 8192 + scol * 256;
#pragma unroll
          for (int k = 0; k < 16; ++k) acc[k] = *(const f32x4*)(rp + ((k ^ (scol & 15)) * 16));
          accl = LS[srcslot * 32 + scol]; }
        __syncthreads();
        for (int rd = 0; rd <= nrounds; ++rd) {
          if (rd > 0) {
            const int set = (rd - 1) & 1;
            unsigned* ivp = (unsigned*)(INVQ + set * 256) + 16 * ow + oq;
            unsigned iv = *ivp;
            if (__any(iv != 0u)) {
              if (iv != 0u && oh == 0) *ivp = 0u;
              do {
                const int x = (iv & 0xffu) ? 0 : (iv & 0xff00u) ? 1 : (iv & 0xff0000u) ? 2 : 3;
                const unsigned byte = (iv >> (8 * x)) & 0xffu;
                iv &= ~(0xffu << (8 * x));
                if (byte) {
                  const int col = (int)(byte - 1) * 4 + oh;
                  const unsigned char* rp = SLOT + (set * 4 + x) * 8192 + col * 256;
                  f32x4 tq[16];
#pragma unroll
                  for (int k = 0; k < 16; ++k) tq[k] = *(const f32x4*)(rp + ((k ^ (col & 15)) * 16));
                  const float tl = LS[(set * 4 + x) * 32 + col];
                  __builtin_amdgcn_sched_barrier(0);
#pragma unroll
                  for (int k = 0; k < 16; ++k) acc[k] += tq[k];
                  accl += tl;
                }
              } while (__any(iv != 0u));
            }
          }
          __syncthreads();
        }
#pragma unroll
        for (int i = 0; i < 16; ++i) { S.o0[i] = otg(i); S.o1[i] = otg(16 + i); }
        SLOT_WRITE(w, S.o0, S.o1, 1.0f);
        __syncthreads();
        {
          const unsigned tq = (unsigned)b * SEQ + 64 * c + 16 * ow + oq;
          const float gs = gbase[tq * 48 + 16 + g * 4 + oh]; const float sc = accl > 0.f ? gs / accl : 0.f;
          const unsigned char* rp = SLOT + srcslot * 8192 + scol * 256;
          bf16_t* op = attn + (tq * DM + (g * 4 + oh) * 64);
#pragma unroll
          for (int k2 = 0; k2 < 8; ++k2) {
            const f32x4 v0 = acc[2 * k2] * sc + *(const f32x4*)(rp + (((2 * k2) ^ (scol & 15)) * 16)), v1 = acc[2 * k2 + 1] * sc + *(const f32x4*)(rp + (((2 * k2 + 1) ^ (scol & 15)) * 16));
            u32x4 o; o.x = pk2(v0.x, v0.y); o.y = pk2(v0.z, v0.w); o.z = pk2(v1.x, v1.y); o.w = pk2(v1.z, v1.w);
            *(u32x4*)(op + 8 * k2) = o;
          }
        }
      } else {
        __syncthreads();
        const bf16_t* kgl = kps + lane * 8; const bf16_t* vgl = vps + lane * 8;
        bf16x8 kfA[8], vfA[8], kfB[8], vfB[8];
#define FLOAD(KF, VF, jj) do { _Pragma("unroll") for (int f_ = 0; f_ < 8; ++f_) { KF[f_] = *(const bf16x8*)(kgl + (size_t)(jj) * 4096 + f_ * 512); VF[f_] = *(const bf16x8*)(vgl + (size_t)(jj) * 4096 + f_ * 512); } } while (0)
        int rowc = 0, qqc = 0; bool validc = false; float mrc = 1e30f; int en = 0;
        if (wu < nitems) { const int e0 = ITEMS[wu]; const int j0_ = e0 >> 3; const int qs_ = 8 * (e0 & 7) + (r >> 2); validc = qs_ < NJ[j0_]; qqc = QL[j0_ * 64 + qs_]; rowc = qqc * 4 + h; mrc = validc ? MREF[rowc] : 1e30f; FLOAD(kfA, vfA, j0_); }
        if (wu + 4 < nitems) en = __builtin_amdgcn_readfirstlane(ITEMS[wu + 4]);
        FLOAD(kfB, vfB, en >> 3);
#define ITEM_ROUND(KF, VF, rd_) do { \
          const int it = (rd_) * 4 + wu, set = (rd_) & 1; \
          if (it < nitems) { \
            const bool hasn = it + 4 < nitems; \
            const int jn = en >> 3, qsn = 8 * (en & 7) + (r >> 2);        \
            bf16x8 qv[4];                                               \
            _Pragma("unroll") for (int ds = 0; ds < 4; ++ds) qv[ds] = *(const bf16x8*)(lds + AT_QS + rowc * 128 + (((ds * 2 + hh) ^ (rowc & 7)) * 16)); \
            const int njn = NJ[jn]; const int qqn = QL[jn * 64 + qsn]; \
            const int en2 = it + 8 < nitems ? __builtin_amdgcn_readfirstlane(ITEMS[it + 8]) : 0; const int j2 = en2 >> 3; \
            __builtin_amdgcn_sched_barrier(0); \
            const f32x16 z = {0.f, 0.f, 0.f, 0.f, 0.f, 0.f, 0.f, 0.f, 0.f, 0.f, 0.f, 0.f, 0.f, 0.f, 0.f, 0.f}; \
            _Pragma("unroll") for (int ds = 0; ds < 4; ++ds) { \
              if (ds == 0) { p0 = MFMA32(KF[0], qv[0], z); p1 = MFMA32(KF[4], qv[0], z); } else { p0 = MFMA32(KF[ds], qv[ds], p0); p1 = MFMA32(KF[4 + ds], qv[ds], p1); } \
            } \
            const bool validn = hasn && qsn < njn; const int rown = qqn * 4 + h; \
            const float mrn = validn ? MREF[rown] : 1e30f; \
            float rs = 0.f; \
            _Pragma("unroll") for (int i = 0; i < 16; ++i) { \
              p0[i] = __builtin_amdgcn_exp2f(fminf(p0[i] - mrc, 120.f)); p1[i] = __builtin_amdgcn_exp2f(fminf(p1[i] - mrc, 120.f)); rs += p0[i] + p1[i]; \
              if (i & 1) { KF[i >> 1] = *(const bf16x8*)(kgl + (size_t)j2 * 4096 + (i >> 1) * 512); __builtin_amdgcn_sched_barrier(0); } \
            } \
            rs += __shfl_xor(rs, 32); \
            f32x16 o0 = z, o1 = z; \
            _Pragma("unroll") for (int gk = 0; gk < 4; ++gk) { const bf16x8 pb = (gk < 2) ? pack8(p0, gk & 1) : pack8(p1, gk & 1); o0 = MFMA32(VF[gk], pb, o0); o1 = MFMA32(VF[4 + gk], pb, o1); } \
            { unsigned char* sp_ = SLOT + (set * 4 + wu) * 8192 + r * 256; \
              _Pragma("unroll") for (int gi = 0; gi < 4; ++gi) { \
                const f32x4 va_ = {o0[4 * gi], o0[4 * gi + 1], o0[4 * gi + 2], o0[4 * gi + 3]}; const f32x4 vb_ = {o1[4 * gi], o1[4 * gi + 1], o1[4 * gi + 2], o1[4 * gi + 3]}; \
                *(f32x4*)(sp_ + (((2 * gi + hh) ^ (r & 15)) * 16)) = va_; *(f32x4*)(sp_ + (((8 + 2 * gi + hh) ^ (r & 15)) * 16)) = vb_; \
                VF[2 * gi] = *(const bf16x8*)(vgl + (size_t)j2 * 4096 + (2 * gi) * 512); VF[2 * gi + 1] = *(const bf16x8*)(vgl + (size_t)j2 * 4096 + (2 * gi + 1) * 512); \
                __builtin_amdgcn_sched_barrier(0); \
              } } \
            if (hh == 0) LS[(set * 4 + wu) * 32 + r] = rs; \
            if (validc && h == 0 && hh == 0) INVQ[set * 256 + qqc * 4 + wu] = (unsigned char)((r >> 2) + 1); \
            rowc = rown; qqc = qqn; validc = validn; mrc = mrn; en = en2; \
          } } while (0)
        for (int rd = 0; rd < nrounds; rd += 2) {
          ITEM_ROUND(kfA, vfA, rd);
          __syncthreads();
          if (rd + 1 < nrounds) {
            ITEM_ROUND(kfB, vfB, rd + 1);
            __syncthreads();
          }
        }
#undef ITEM_ROUND
#undef FLOAD
#undef ITEM_META
#undef KLOAD
#undef VLOAD
        __syncthreads();
#pragma unroll
        for (int i = 0; i < 16; ++i) { S.o0[i] = otg(i); S.o1[i] = otg(16 + i); }
        SLOT_WRITE(w, S.o0, S.o1, 1.0f);
        __syncthreads();
      }
    }
#undef SLOT_WRITE
#undef SLOT_READ
  }
  __syncthreads();
#undef ST_LOAD
#undef ST_STORE
#undef SWEEP
#undef ST_LOADF
#undef ST_STOREF
#undef SWEEPF
#undef gates
#undef otg
#undef QF_LOAD
#undef AT_QKV
#undef AT_IDS
}
DI void phase_attn(const Params& P_, unsigned char* lds) {
  Params P = P_; { size_t z_ = 0; asm volatile("" : "+s"(z_)); P.ws = P_.ws + z_; }
  const int G = gridDim.x, bx = obid();
  const int vcu = (G % 8 == 0) ? (bx % 8) * (G / 8) + bx / 8 : bx;
  for (int idx = vcu; idx < 1024; idx += G) {
    const int i = idx >> 8, v = idx & 255, bg = v >> 5, s = v & 31;
    const int c = i == 0 ? s : i == 1 ? 63 - s : i == 2 ? 64 + s : 127 - s;
    attn_tile(P, lds, bg >> 2, bg & 3, c);
  }
}


#define LAS __attribute__((address_space(3)))
#define XB_TMO      128
#define XB_XCNT(j)  (256  + 64 * (j))
#define XB_XSUB(j)  (1280 + 64 * (j))
#define XB_XGEN(j)  (2304 + 64 * (j))
#define XB_TOP      3328
#define XB_TOPGEN   3392
#define XCD_BAR_WORDS 3456
#define XB_SPIN_CAP (1u << 18)
__device__ __forceinline__ unsigned xb_ld(unsigned* p)              { return __hip_atomic_load(p, __ATOMIC_RELAXED, __HIP_MEMORY_SCOPE_AGENT); }
__device__ __forceinline__ unsigned xb_add(unsigned* p, unsigned v) { return __hip_atomic_fetch_add(p, v, __ATOMIC_RELAXED, __HIP_MEMORY_SCOPE_AGENT); }
__device__ __forceinline__ unsigned xb_xcc_id() { return (unsigned)__builtin_amdgcn_s_getreg((3 << 11) | 20) & 0xFu; }
#define XB_SPIN(cond, bar) do { unsigned _sp = 0; while (cond) { __builtin_amdgcn_s_sleep(1); \
    if ((++_sp & 255u) == 0u) { if (xb_ld(&(bar)[XB_TMO])) break; if (_sp > XB_SPIN_CAP) { atomicAdd(&(bar)[XB_TMO], 1u); break; } } } } while (0)
struct XcdBarrier { unsigned* bar; unsigned x; volatile LAS unsigned* st; };
__device__ __forceinline__ XcdBarrier xcd_barrier_post(unsigned* bar, volatile LAS unsigned* st) {
    XcdBarrier b; b.bar = bar; b.x = xb_xcc_id(); b.st = st;
    if (threadIdx.x == 0) (void)xb_add(&bar[XB_XCNT(b.x)], 1u);
    return b;
}
__device__ __forceinline__ void xcd_barrier_complete(unsigned* bar, unsigned x, unsigned& nloc, unsigned& nx) {
    const unsigned G = gridDim.x * gridDim.y * gridDim.z;
    unsigned sum, cnt, mine, sp = 0u;
    for (;;) {
        sum = 0u; cnt = 0u; mine = 0u;
#pragma unroll
        for (unsigned j = 0; j < 16; ++j) { const unsigned c = xb_ld(&bar[XB_XCNT(j)]); sum += c; cnt += (c > 0u) ? 1u : 0u; mine = (j == x) ? c : mine; }
        if (sum == G) break;
        __builtin_amdgcn_s_sleep(1);
        if ((++sp & 255u) == 0u) { if (xb_ld(&bar[XB_TMO])) break; if (sp > XB_SPIN_CAP) { atomicAdd(&bar[XB_TMO], 1u); break; } }
    }
    nloc = mine > 0u ? mine : 1u; nx = cnt > 0u ? cnt : 1u;
}
__device__ __forceinline__ void xcd_barrier(const XcdBarrier& b) {
    asm volatile("s_waitcnt vmcnt(0)" ::: "memory");
    __syncthreads();
    if (threadIdx.x == 0) {
        unsigned* bar = b.bar; { size_t z_ = 0; asm volatile("" : "+s"(z_)); bar += z_; }
        __builtin_amdgcn_s_waitcnt(0);
        unsigned nloc = b.st[0], nx = b.st[1];
        if (nloc == 0u) { xcd_barrier_complete(bar, b.x, nloc, nx); b.st[0] = nloc; b.st[1] = nx; }
        const unsigned old = xb_add(&bar[XB_XSUB(b.x)], 1u);
        const unsigned gen = old / nloc;
        if (old + 1u == (gen + 1u) * nloc) {
            __builtin_amdgcn_fence(__ATOMIC_RELEASE, "agent");
            asm volatile("s_waitcnt vmcnt(0)" ::: "memory");
            const unsigned og = xb_add(&bar[XB_TOP], 1u);
            const unsigned tg = og / nx;
            if (og + 1u == (tg + 1u) * nx) xb_add(&bar[XB_TOPGEN], 1u);
            else XB_SPIN(xb_ld(&bar[XB_TOPGEN]) == tg, bar);
            __builtin_amdgcn_fence(__ATOMIC_ACQUIRE, "agent");
            xb_add(&bar[XB_XGEN(b.x)], 1u);
            asm volatile("s_waitcnt vmcnt(0)" ::: "memory");
        } else {
            XB_SPIN(xb_ld(&bar[XB_XGEN(b.x)]) == gen, bar);
            __builtin_amdgcn_fence(__ATOMIC_ACQUIRE, "agent");
            asm volatile("s_waitcnt vmcnt(0)" ::: "memory");
        }
    }
    __syncthreads();
}

__global__ void __launch_bounds__(NTHR) fwd_kernel(Params P) {
  extern __shared__ __attribute__((aligned(16))) unsigned char lds[];
  cg::grid_group grid = cg::this_grid();
  const int gtid = blockIdx.x * NTHR + threadIdx.x;
  if (threadIdx.x < 4) ((unsigned*)(lds + LDS_BYTES - 16))[threadIdx.x] = 0u;
  __syncthreads();
  const XcdBarrier xbar = xcd_barrier_post((unsigned*)(P.ws + WS_BAR), (volatile LAS unsigned*)(lds + LDS_BYTES - 16));
#define GSYNC() xcd_barrier(xbar)
  s5_params(P, gtid);
  {
    float* modb = (float*)(P.ws + WS_MOD); float* cbb = (float*)(P.ws + WS_CB);
    for (int it = blockIdx.x; it < 192 + 16; it += gridDim.x) {
      if (it < 192) { const int l = it / 96, j0 = (it % 96) * 64;
        gemv_item((float*)lds, P.in[2] + (size_t)l * DM * 6144, DM, 6144, j0, P.in[1], P.in[1] + DM, true, P.in[3] + l * 6144, modb + (size_t)(l * 2) * 6144, modb + (size_t)(l * 2 + 1) * 6144);
      } else { const int r = it - 192, l = r >> 3, kv = (r >> 2) & 1, j0 = (r & 3) * 64;
        gemv_item((float*)lds, P.in[17] + (size_t)(l * 2 + kv) * 2048 * 256, 2048, 256, j0, P.in[16] + (size_t)(l * 2 + kv) * 2048, nullptr, false, nullptr, cbb + (l * 2 + kv) * 256, nullptr);
      }
    }
  }
  for (int it = blockIdx.x; it < DEPTH * 32 * 6; it += gridDim.x) s5_tables(P, it / 192, (it % 192) / 6, it % 6, lds);
  convert_weights(P, 0, lds);
  grid.sync();
  for (int l = 0; l < DEPTH; ++l) {
    if (l == 0) norm_simple<0>(P, l); else { norm_simple<1>(P, l); convert_weights(P, 1, lds); }
    GSYNC();
#if EN_MIXER
    phase_inproj8(P, lds);
    GSYNC();
    phase_s5a(P, l, lds);
    __syncthreads();
#if EN_ATTN
    phase_gates(P, lds);
    __syncthreads();
    phase_cmp1(P, l, lds);
#endif
    GSYNC();
    s5_carry(P, l);
#if EN_ATTN
    phase_cmp2(P, lds);
#endif
    GSYNC();
#if EN_ATTN
    phase_attn(P, lds);
    __syncthreads();
#endif
    phase_s5c(P, l, lds);
    GSYNC();
    phase_glu(P, lds);
    GSYNC();
    phase_merge8(P, lds);
    GSYNC();
    phase_wout8(P, l, lds);
    GSYNC();
#else
    if (l == 0) { for (size_t i = (size_t)gtid * 4; i < (size_t)NT * DM; i += (size_t)gridDim.x * NTHR * 4) *(f32x4*)(P.out + i) = *(const f32x4*)(P.in[0] + i); GSYNC(); }
#endif
#if EN_MOE
    norm_route(P, l, lds);
    GSYNC();
    phase_moe1(P, l, lds);
    GSYNC();
    phase_moe2(P, l, lds);
    GSYNC();
#endif
  }
  norm_simple<3>(P, 0);
}

extern "C" void kernel_launch(void* const* d_in, const int* in_sizes, int n_in, void* d_out, int out_size, void* d_ws, size_t ws_size, hipStream_t stream) {
  static int grid = 0;
  if (grid == 0) {
    if (n_in != 30 || out_size != NT * DM || ws_size < WS_END2) { fprintf(stderr, "kernel_launch: unexpected shapes (n_in %d out %d ws %zu need %zu)\n", n_in, out_size, ws_size, (size_t)WS_END2); grid = -1; return; }
    int dev = 0, cus = 0, per_cu = 0;
    hipGetDevice(&dev);
    hipDeviceGetAttribute(&cus, hipDeviceAttributeMultiprocessorCount, dev);
    hipFuncSetAttribute((const void*)fwd_kernel, hipFuncAttributeMaxDynamicSharedMemorySize, LDS_BYTES);
    hipOccupancyMaxActiveBlocksPerMultiprocessor(&per_cu, (const void*)fwd_kernel, NTHR, LDS_BYTES);
    if (per_cu < 1) { fprintf(stderr, "kernel_launch: occupancy query says %d blocks/CU\n", per_cu); per_cu = 1; }
    grid = cus;
    (void)hipGetLastError();
  }
  if (grid < 0) return;
  Params p{};
  for (int i = 0; i < 30; ++i) p.in[i] = (const float*)d_in[i];
  p.out = (float*)d_out; p.ws = (unsigned char*)d_ws;
  if (hipMemsetAsync(p.ws, 0, WS_ZERO_BYTES, stream) != hipSuccess) { fprintf(stderr, "kernel_launch: memset failed\n"); return; }
  void* args[] = {&p};
  hipError_t e = hipLaunchCooperativeKernel((const void*)fwd_kernel, dim3(grid), dim3(NTHR), args, LDS_BYTES, stream);
  if (e != hipSuccess) fprintf(stderr, "cooperative launch failed: %s (grid %d)\n", hipGetErrorString(e), grid);
}
```

```cpp
#include <hip/hip_runtime.h>
#include <hip/hip_cooperative_groups.h>
#include <cstdio>
#include <cstdint>
namespace cg = cooperative_groups;

#ifndef EN_MIXER
#define EN_MIXER 1
#endif
#ifndef EN_ATTN
#define EN_ATTN 1
#endif
#ifndef EN_MOE
#define EN_MOE 1
#endif

#define DI __device__ __forceinline__
typedef unsigned short bf16_t;
typedef short bf16x8 __attribute__((ext_vector_type(8)));
typedef short s16x4 __attribute__((ext_vector_type(4)));
typedef float f32x4 __attribute__((ext_vector_type(4)));
typedef float f32x16 __attribute__((ext_vector_type(16)));
typedef unsigned u32x4 __attribute__((ext_vector_type(4)));
typedef unsigned u32x2 __attribute__((ext_vector_type(2)));

constexpr int DM = 1024, NB = 2, SEQ = 8192, NT = NB * SEQ, DEPTH = 2;
constexpr int INW = 5168, INWP = 5376;
constexpr int NTHR = 512, NWAVE = 8;
constexpr int NEXP = 32, LISTCAP = 16384;
constexpr float EPS = 1e-6f;
constexpr float QSCALE = 0.125f * 1.4426950408889634f;

constexpr size_t MiB = 1u << 20;
constexpr size_t WS_CNT = 0;
constexpr size_t WS_BAR = 1024;
constexpr size_t WS_ZERO_BYTES = 16384;
constexpr size_t WS_MOD = 16384;
constexpr size_t WS_CB = WS_MOD + 2 * 2 * 6144 * 4;
constexpr size_t WS_S5P = WS_CB + 2 * 2 * 256 * 4;
constexpr size_t WS_WT = WS_S5P + 2 * 32 * 64 * 36 * 4;
constexpr size_t WS_SMALL_END = WS_WT + (size_t)NT * 2 * 4;
static_assert(WS_SMALL_END <= 1 * MiB, "small region");
constexpr size_t WS_W = 1 * MiB;
constexpr size_t W_IN = 0;
constexpr size_t W_GLU = W_IN + (size_t)INWP * 1024 * 2;
constexpr size_t W_O = W_GLU + 512 * 512 * 2;
constexpr size_t W_SO = W_O + 1024 * 1024 * 2;
constexpr size_t W_OUT = W_SO + 1024 * 512 * 2;
constexpr size_t W_C1 = W_OUT + 1024 * 1024 * 2;
constexpr size_t W_C2 = W_C1 + 2 * 256 * 2048 * 2;
constexpr size_t W_GU = W_C2 + 2 * 128 * 256 * 2;
constexpr size_t W_D = W_GU + (size_t)32 * 512 * 1024 * 2;
constexpr size_t W_END = W_D + (size_t)32 * 1024 * 256 * 2;
static_assert(W_END <= 67 * MiB, "weights region");
constexpr size_t WS_A = 68 * MiB;
constexpr size_t WS_B = WS_A + 32 * MiB;
constexpr size_t WS_C = WS_B + 32 * MiB;
constexpr size_t WS_DV = WS_C + 32 * MiB;
constexpr size_t WS_E = WS_DV + 16 * MiB;
constexpr size_t WS_F = WS_E + 32 * MiB;
constexpr size_t WS_G = WS_F + 64 * MiB;
constexpr size_t WS_GATES = WS_G + 16 * MiB;
constexpr size_t WS_HID = WS_GATES + 3 * MiB;
constexpr size_t WS_KC = WS_HID + 4 * MiB;
constexpr size_t WS_VC = WS_KC + 512 * 1024;
constexpr size_t WS_L = WS_VC + 512 * 1024;
constexpr size_t WS_LIST = WS_L + 4 * MiB;
constexpr size_t WS_OT = WS_LIST + 2 * MiB;
constexpr size_t WS_TAB = WS_OT + 16 * MiB;
constexpr size_t TAB_KT = 0, TAB_M1 = 1 * MiB, TAB_M2 = 9 * MiB, TAB_LAYER = 17 * MiB;
constexpr size_t WS_END = WS_TAB + 2 * TAB_LAYER;
constexpr size_t WS_KSF = WS_END;
constexpr size_t WS_END2 = WS_KSF + 8 * MiB;
constexpr size_t WS_SIN = WS_E + 16 * MiB;
constexpr int LDS_BYTES = 151552;

struct Params { const float* in[30]; float* out; unsigned char* ws; };

DI int otid() { int t = threadIdx.x; asm volatile("" : "+v"(t)); return t; }
DI int obid() { int t = blockIdx.x; asm volatile("" : "+s"(t)); return t; }
DI unsigned f2bf(float f) { unsigned u = __float_as_uint(f); return (u + 0x7fffu + ((u >> 16) & 1u)) >> 16; }
typedef float f32x2_t __attribute__((ext_vector_type(2))); typedef __bf16 bf16x2_t __attribute__((ext_vector_type(2)));
DI unsigned pk2(float lo, float hi) { const f32x2_t v = {lo, hi}; const bf16x2_t b = __builtin_convertvector(v, bf16x2_t); return __builtin_bit_cast(unsigned, b); }
DI float bflo(unsigned w) { return __uint_as_float(w << 16); }
DI float bfhi(unsigned w) { return __uint_as_float(w & 0xffff0000u); }
DI int perm16(int x) { return (x & ~12) | ((x & 4) << 1) | ((x & 8) >> 1); }
DI float wave_sum(float v) {
#pragma unroll
  for (int o = 1; o < 64; o <<= 1) v += __shfl_xor(v, o);
  return v;
}
DI float sigmoidf_(float x) { return __builtin_amdgcn_rcpf(1.f + __expf(-x)); }
DI float gelu_tanh(float x) {
  const float z = 0.7978845608028654f * (x + 0.044715f * x * x * x);
  const float e = __expf(2.f * z);
  const float th = 1.f - 2.f * __builtin_amdgcn_rcpf(e + 1.f);
  return 0.5f * x * (1.f + th);
}
DI void sincos_d(double x, double& s, double& c) {
  const double k = rint(x * 0.6366197723675814);
  double r = fma(-k, 1.5707963267948966, x);
  r = fma(-k, 6.123233995736766e-17, r);
  const int q = ((int)k) & 3;
  const double r2 = r * r;
  const double sp = r * (1.0 + r2 * (-1.0 / 6 + r2 * (1.0 / 120 + r2 * (-1.0 / 5040 + r2 * (1.0 / 362880 + r2 * (-1.0 / 39916800 + r2 * (1.0 / 6227020800.0)))))));
  const double cp = 1.0 + r2 * (-0.5 + r2 * (1.0 / 24 + r2 * (-1.0 / 720 + r2 * (1.0 / 40320 + r2 * (-1.0 / 3628800 + r2 * (1.0 / 479001600 + r2 * (-1.0 / 87178291200.0)))))));
  s = (q == 0) ? sp : (q == 1) ? cp : (q == 2) ? -sp : -cp;
  c = (q == 0) ? cp : (q == 1) ? -sp : (q == 2) ? -cp : sp;
}

DI void gemv_item(float* lds, const float* W, int K, int N, int j0, const float* v0, const float* v1, bool do_silu, const float* bias, float* o0, float* o1) {
  const int tid = otid();
  float* sv = lds; float* red = lds + 4096;
  for (int k = tid; k < K; k += NTHR) {
    float a = v0[k], b = v1 ? v1[k] : 0.f;
    if (do_silu) { a = a / (1.f + expf(-a)); b = b / (1.f + expf(-b)); }
    sv[k] = a; sv[2048 + k] = b;
  }
  __syncthreads();
  const int jl = tid & 63, ks = tid >> 6, kper = K >> 3;
  const float* wp = W + (size_t)(ks * kper) * N + j0 + jl;
  float a0 = 0.f, a1 = 0.f;
#pragma unroll 8
  for (int k = 0; k < kper; ++k) { const float w = wp[(size_t)k * N]; a0 += sv[ks * kper + k] * w; a1 += sv[2048 + ks * kper + k] * w; }
  red[(ks * 64 + jl) * 2] = a0; red[(ks * 64 + jl) * 2 + 1] = a1;
  __syncthreads();
  if (tid < 64) {
    float s0 = 0.f, s1 = 0.f;
    for (int i = 0; i < 8; ++i) { s0 += red[(i * 64 + tid) * 2]; s1 += red[(i * 64 + tid) * 2 + 1]; }
    const float bb = bias ? bias[j0 + tid] : 0.f;
    o0[j0 + tid] = s0 + bb; if (o1) o1[j0 + tid] = s1 + bb;
  }
  __syncthreads();
}

DI void s5_params(const Params& P, int gtid) {
  if (gtid >= DEPTH * 32 * 64) return;
  const int l = gtid / 2048, g = (gtid / 64) % 32, p = gtid % 64;
  const float dt = expf(P.in[8][l * 32 + g]);
  const float lr = P.in[6][(l * 32 + g) * 64 + p], li = P.in[7][(l * 32 + g) * 64 + p];
  const float mag = expf(lr * dt); const float ang = li * dt;
  double sd, cd; sincos_d((double)ang, sd, cd);
  const float ab_re = mag * (float)cd, ab_im = mag * (float)sd;
  float* o = (float*)(P.ws + WS_S5P) + (size_t)((l * 32 + g) * 64 + p) * 36;
  o[0] = ab_re; o[1] = ab_im;
  double pr = ab_re, pi = ab_im;
  for (int i = 0; i < 6; ++i) { const double nr2 = pr * pr - pi * pi, ni2 = 2.0 * pr * pi; pr = nr2; pi = ni2; }
  o[2] = (float)pr; o[3] = (float)pi;
}

DI void s5_tables(const Params& P, int l, int g, int part, unsigned char* lds) {
  const int tid = otid(), lane = tid & 63;
  float* BBr = (float*)lds; float* BBi = BBr + 1024; float* CR = BBi + 1024; float* CI = CR + 1024;
  float* APr = CI + 1024; float* APi = APr + 65 * 64;
  bf16_t* tab = (bf16_t*)(P.ws + WS_TAB + (size_t)l * TAB_LAYER);
  bf16_t* Kt = tab + TAB_KT / 2 + (size_t)g * 64 * 256; bf16_t* M1 = tab + TAB_M1 / 2 + (size_t)g * 128 * 1024; bf16_t* M2 = tab + TAB_M2 / 2 + (size_t)g * 1024 * 128;
  __syncthreads();
  if (tid < 64) {
    const int p = tid;
    const float dt = expf(P.in[8][l * 32 + g]);
    const float lr = P.in[6][(l * 32 + g) * 64 + p], li = P.in[7][(l * 32 + g) * 64 + p];
    const float mag = expf(lr * dt); const float ang = li * dt;
    double sd, cd; sincos_d((double)ang, sd, cd);
    const float ab_re = mag * (float)cd, ab_im = mag * (float)sd;
    const float den = lr * lr + li * li, nr = ab_re - 1.0f;
    const float cr = (nr * lr + ab_im * li) / den, ci = (ab_im * lr - nr * li) / den;
    const float* br = P.in[9] + (size_t)((l * 32 + g) * 64 + p) * 16; const float* bi = P.in[10] + (size_t)((l * 32 + g) * 64 + p) * 16;
    for (int h = 0; h < 16; ++h) { BBr[p * 16 + h] = cr * br[h] - ci * bi[h]; BBi[p * 16 + h] = cr * bi[h] + ci * br[h]; }
    double pr = 1.0, pi = 0.0;
    for (int tau = 0; tau <= 64; ++tau) { APr[tau * 64 + p] = (float)pr; APi[tau * 64 + p] = (float)pi; const double n1 = pr * ab_re - pi * ab_im, n2 = pr * ab_im + pi * ab_re; pr = n1; pi = n2; }
  }
  for (int i = tid; i < 1024; i += NTHR) { CR[i] = P.in[11][(size_t)(l * 32 + g) * 1024 + i]; CI[i] = P.in[12][(size_t)(l * 32 + g) * 1024 + i]; }
  __syncthreads();
  if (part < 4)
  for (int task = part * 256 + tid; task < part * 256 + 256; task += NTHR) {
    const int tau = task >> 4, h = task & 15;
    float a[16];
#pragma unroll
    for (int j = 0; j < 16; ++j) a[j] = 0.f;
    for (int p = 0; p < 64; ++p) {
      const float c_r = CR[h * 64 + p], c_i = CI[h * 64 + p], a_r = APr[tau * 64 + p], a_i = APi[tau * 64 + p];
      const float xr = c_r * a_r - c_i * a_i, xi = c_r * a_i + c_i * a_r;
#pragma unroll
      for (int j4 = 0; j4 < 4; ++j4) { const f32x4 b_r = *(const f32x4*)(BBr + p * 16 + 4 * j4), b_i = *(const f32x4*)(BBi + p * 16 + 4 * j4);
        a[4 * j4] += xr * b_r.x - xi * b_i.x; a[4 * j4 + 1] += xr * b_r.y - xi * b_i.y; a[4 * j4 + 2] += xr * b_r.z - xi * b_i.z; a[4 * j4 + 3] += xr * b_r.w - xi * b_i.w; }
    }
    u32x4 o0, o1; o0.x = pk2(a[0], a[1]); o0.y = pk2(a[2], a[3]); o0.z = pk2(a[4], a[5]); o0.w = pk2(a[6], a[7]); o1.x = pk2(a[8], a[9]); o1.y = pk2(a[10], a[11]); o1.z = pk2(a[12], a[13]); o1.w = pk2(a[14], a[15]);
    *(u32x4*)(Kt + (size_t)task * 16) = o0; *(u32x4*)(Kt + (size_t)task * 16 + 8) = o1;
  }
  if (part == 4)
  for (int task = tid; task < 4096; task += NTHR) {
    const int p = task >> 6, i = task & 63;
    const float a_r = APr[(63 - i) * 64 + p], a_i = APi[(63 - i) * 64 + p];
    float re[16], im[16];
#pragma unroll
    for (int j = 0; j < 16; ++j) { const float b_r = BBr[p * 16 + j], b_i = BBi[p * 16 + j]; re[j] = a_r * b_r - a_i * b_i; im[j] = a_r * b_i + a_i * b_r; }
    u32x4 o; bf16_t* d0 = M1 + (size_t)(2 * p) * 1024 + i * 16; bf16_t* d1 = d0 + 1024;
    o.x = pk2(re[0], re[1]); o.y = pk2(re[2], re[3]); o.z = pk2(re[4], re[5]); o.w = pk2(re[6], re[7]); *(u32x4*)d0 = o;
    o.x = pk2(re[8], re[9]); o.y = pk2(re[10], re[11]); o.z = pk2(re[12], re[13]); o.w = pk2(re[14], re[15]); *(u32x4*)(d0 + 8) = o;
    o.x = pk2(im[0], im[1]); o.y = pk2(im[2], im[3]); o.z = pk2(im[4], im[5]); o.w = pk2(im[6], im[7]); *(u32x4*)d1 = o;
    o.x = pk2(im[8], im[9]); o.y = pk2(im[10], im[11]); o.z = pk2(im[12], im[13]); o.w = pk2(im[14], im[15]); *(u32x4*)(d1 + 8) = o;
  }
  if (part == 5)
  for (int task = tid; task < 4096; task += NTHR) {
    const int th = task >> 2, pq = task & 3, t = th >> 4, h = th & 15;
    unsigned w[16];
#pragma unroll
    for (int j = 0; j < 16; ++j) { const int p = pq * 16 + j;
      const float c_r = CR[h * 64 + p], c_i = CI[h * 64 + p], a_r = APr[(t + 1) * 64 + p], a_i = APi[(t + 1) * 64 + p];
      w[j] = pk2(c_r * a_r - c_i * a_i, -(c_r * a_i + c_i * a_r)); }
    bf16_t* d = M2 + (size_t)th * 128 + pq * 32;
    *(u32x4*)d = (u32x4){w[0], w[1], w[2], w[3]}; *(u32x4*)(d + 8) = (u32x4){w[4], w[5], w[6], w[7]};
    *(u32x4*)(d + 16) = (u32x4){w[8], w[9], w[10], w[11]}; *(u32x4*)(d + 24) = (u32x4){w[12], w[13], w[14], w[15]};
  }
  __syncthreads();
}

struct ConvJob { const float* src; bf16_t* dst; int ldw, K, c0, ncols, nmat, ldd, drow0, mode; size_t sstride, dstride; };
DI int conv_nitems(const ConvJob& j) { return j.nmat * (j.K >> 6) * ((j.ncols + 31) >> 5); }
DI int conv_drow(int mode, int drow0, int n) { return mode == 0 ? drow0 + n : drow0 + ((n >> 6) * 128 + ((n >> 4) & 3) * 32 + (n & 15)); }
DI void conv_item(const ConvJob& jb, int item, float* scr, int lane) {
  const int nblk = (jb.ncols + 31) >> 5, per = (jb.K >> 6) * nblk;
  const int mat = item / per, r = item % per, kb = r / nblk, nb = r % nblk, k0 = 64 * kb, n0 = 32 * nb;
  const float* W = jb.src + (size_t)mat * jb.sstride; bf16_t* WT = jb.dst + (size_t)mat * jb.dstride;
  const int n4 = (lane & 7) * 4; const bool nok = (n0 + n4) < jb.ncols;
#pragma unroll
  for (int i = 0; i < 8; ++i) { const int kk = 8 * i + (lane >> 3);
    const f32x4 v = nok ? *(const f32x4*)(W + (size_t)(k0 + kk) * jb.ldw + jb.c0 + n0 + n4) : (f32x4){0.f, 0.f, 0.f, 0.f};
    *(f32x4*)(scr + kk * 36 + n4) = v; }
  asm volatile("s_waitcnt lgkmcnt(0)" ::: "memory");
  const int c = lane & 7;
#pragma unroll
  for (int j = 0; j < 4; ++j) {
    const int n = (lane >> 3) + 8 * j; const float* sp = scr + (8 * c) * 36 + n;
    u32x4 o; o.x = pk2(sp[0], sp[36]); o.y = pk2(sp[72], sp[108]); o.z = pk2(sp[144], sp[180]); o.w = pk2(sp[216], sp[252]);
    if (n0 + n < jb.ncols) *(u32x4*)(WT + (size_t)conv_drow(jb.mode, jb.drow0, n0 + n) * jb.ldd + k0 + 8 * c) = o;
  }
  asm volatile("s_waitcnt lgkmcnt(0)" ::: "memory");
}
DI ConvJob conv_job(const Params& P, int l, int j) {
  unsigned char* wb = P.ws + WS_W; ConvJob J; J.nmat = 1; J.mode = 0; J.sstride = 0; J.dstride = 0; J.drow0 = 0; J.c0 = 0;
  const float* win = P.in[5] + (size_t)l * 1024 * INW;
  if (j < 5) { J.src = win; J.ldw = INW; J.K = 1024; J.dst = (bf16_t*)(wb + W_IN); J.ldd = 1024;
    if (j == 0) { J.c0 = 0; J.ncols = 1024; J.drow0 = 0; }
    else if (j == 1) { J.c0 = 1024; J.ncols = 1536; J.drow0 = 1024; }
    else if (j == 2) { J.c0 = 3120; J.ncols = 2048; J.drow0 = 2560; }
    else if (j == 3) { J.c0 = 2608; J.ncols = 512; J.drow0 = 4608; }
    else { J.c0 = 2560; J.ncols = 48; J.drow0 = 5120; }
  } else if (j == 5) { J.src = P.in[14] + (size_t)l * 512 * 512; J.ldw = 512; J.K = 512; J.ncols = 512; J.dst = (bf16_t*)(wb + W_GLU); J.ldd = 512; }
  else if (j == 6) { J.src = P.in[19] + (size_t)l * 1024 * 1024; J.ldw = 1024; J.K = 1024; J.ncols = 1024; J.dst = (bf16_t*)(wb + W_O); J.ldd = 1024; }
  else if (j == 7) { J.src = P.in[15] + (size_t)l * 512 * 1024; J.ldw = 1024; J.K = 512; J.ncols = 1024; J.dst = (bf16_t*)(wb + W_SO); J.ldd = 512; }
  else if (j == 8) { J.src = P.in[20] + (size_t)l * 1024 * 1024; J.ldw = 1024; J.K = 1024; J.ncols = 1024; J.dst = (bf16_t*)(wb + W_OUT); J.ldd = 1024; }
  else if (j == 9) { J.src = P.in[17] + (size_t)l * 2 * 2048 * 256; J.ldw = 256; J.K = 2048; J.ncols = 256; J.nmat = 2; J.sstride = 2048 * 256; J.dstride = 256 * 2048; J.dst = (bf16_t*)(wb + W_C1); J.ldd = 2048; }
  else if (j == 10) { J.src = P.in[18] + (size_t)l * 2 * 256 * 64; J.ldw = 64; J.K = 256; J.ncols = 64; J.nmat = 2; J.sstride = 256 * 64; J.dstride = 128 * 256; J.dst = (bf16_t*)(wb + W_C2); J.ldd = 256; }
  else if (j == 11) { J.src = P.in[26] + (size_t)l * 32 * 1024 * 256; J.ldw = 256; J.K = 1024; J.ncols = 256; J.nmat = 32; J.sstride = 1024 * 256; J.dstride = 512 * 1024; J.dst = (bf16_t*)(wb + W_GU); J.ldd = 1024; J.mode = 1; J.drow0 = 0; }
  else if (j == 12) { J.src = P.in[27] + (size_t)l * 32 * 1024 * 256; J.ldw = 256; J.K = 1024; J.ncols = 256; J.nmat = 32; J.sstride = 1024 * 256; J.dstride = 512 * 1024; J.dst = (bf16_t*)(wb + W_GU); J.ldd = 1024; J.mode = 1; J.drow0 = 16; }
  else { J.src = P.in[28] + (size_t)l * 32 * 256 * 1024; J.ldw = 1024; J.K = 256; J.ncols = 1024; J.nmat = 32; J.sstride = 256 * 1024; J.dstride = 1024 * 256; J.dst = (bf16_t*)(wb + W_D); J.ldd = 256; }
  return J;
}
DI void convert_weights(const Params& P_, int l, unsigned char* lds) {
  Params P = P_; { size_t z_ = 0; asm volatile("" : "+s"(z_)); P.ws = P_.ws + z_; }
  const int tid_ = otid(), bid = obid(), wave = tid_ >> 6, lane = tid_ & 63; (void)bid;
  float* scr = (float*)lds + wave * (64 * 36);
  const int NGW = gridDim.x * NWAVE; int off = bid * NWAVE + wave;
  for (int j = 0; j < 14; ++j) {
    const ConvJob J = conv_job(P, l, j); const int n = conv_nitems(J);
    while (off < n) { conv_item(J, off, scr, lane); off += NGW; }
    off -= n;
  }
}

template <int MODE>
DI void norm_simple(const Params& P_, int l) {
  Params P = P_; { size_t z_ = 0; asm volatile("" : "+s"(z_)); P.ws = P_.ws + z_; }
  const int tid_ = otid(), bid = obid(), wave = tid_ >> 6, lane = tid_ & 63; (void)bid;
  const int NGW = gridDim.x * NWAVE;
  const float* mod = (const float*)(P.ws + WS_MOD);
  const bf16_t* ys = (const bf16_t*)(P.ws + WS_F);
  bf16_t* xn = (bf16_t*)(P.ws + WS_A);
  const float* xbase = MODE == 0 ? P.in[0] : P.out;
  constexpr bool ADDY = (MODE != 0) && EN_MOE;
  f32x4 g[4], sh[4], sc[4], gg[4]; int pb = -1;
  { const float* gp = MODE == 3 ? P.in[29] : P.in[4] + (size_t)l * DM;
#pragma unroll
    for (int j = 0; j < 4; ++j) g[j] = *(const f32x4*)(gp + 4 * lane + 256 * j); }
  f32x4 v[4]; u32x2 y0[4], y1[4];
#define NS_LOAD(vv, a0, a1, rr) do { const float* xr_ = xbase + (size_t)(rr) * DM; \
    _Pragma("unroll") for (int j = 0; j < 4; ++j) vv[j] = *(const f32x4*)(xr_ + 4 * lane + 256 * j); \
    if (ADDY) { _Pragma("unroll") for (int j = 0; j < 4; ++j) { a0[j] = *(const u32x2*)(ys + (size_t)((rr) * 2) * DM + 4 * lane + 256 * j); a1[j] = *(const u32x2*)(ys + (size_t)((rr) * 2 + 1) * DM + 4 * lane + 256 * j); } } } while (0)
  const int row0 = bid * NWAVE + wave;
  if (row0 < NT) NS_LOAD(v, y0, y1, row0);
  for (int row = row0; row < NT; row += NGW) {
    const int b = row >> 13;
    if (b != pb) { pb = b;
      if (ADDY) { const float* g2 = mod + (size_t)(((MODE == 1 ? 0 : 1) * 2 + b) * 6144) + 5120;
#pragma unroll
        for (int j = 0; j < 4; ++j) gg[j] = *(const f32x4*)(g2 + 4 * lane + 256 * j); }
      if (MODE != 3) { const float* md = mod + (size_t)((l * 2 + b) * 6144);
#pragma unroll
        for (int j = 0; j < 4; ++j) { sh[j] = *(const f32x4*)(md + 4 * lane + 256 * j); sc[j] = *(const f32x4*)(md + 1024 + 4 * lane + 256 * j); } }
    }
    f32x4 vn[4]; u32x2 y0n[4], y1n[4];
    if (row + NGW < NT) NS_LOAD(vn, y0n, y1n, row + NGW);
    __builtin_amdgcn_sched_barrier(0);
    if (ADDY) {
#pragma unroll
      for (int j = 0; j < 4; ++j) {
        v[j].x += gg[j].x * (bflo(y0[j].x) + bflo(y1[j].x)); v[j].y += gg[j].y * (bfhi(y0[j].x) + bfhi(y1[j].x));
        v[j].z += gg[j].z * (bflo(y0[j].y) + bflo(y1[j].y)); v[j].w += gg[j].w * (bfhi(y0[j].y) + bfhi(y1[j].y));
      }
    }
    float ss = 0.f;
#pragma unroll
    for (int j = 0; j < 4; ++j) ss += v[j].x * v[j].x + v[j].y * v[j].y + v[j].z * v[j].z + v[j].w * v[j].w;
    ss = wave_sum(ss);
    const float inv = rsqrtf(ss * (1.f / DM) + EPS);
    if (MODE == 3) {
#pragma unroll
      for (int j = 0; j < 4; ++j) { const int col = 4 * lane + 256 * j; *(f32x4*)(P.out + (size_t)row * DM + col) = v[j] * inv * g[j]; }
    } else {
      if (MODE == 1) {
#pragma unroll
        for (int j = 0; j < 4; ++j) *(f32x4*)(P.out + (size_t)row * DM + 4 * lane + 256 * j) = v[j];
      }
#pragma unroll
      for (int j = 0; j < 4; ++j) {
        const int col = 4 * lane + 256 * j;
        const f32x4 h = v[j] * inv * g[j] * (sc[j] + 1.f) + sh[j];
        u32x2 o; o.x = pk2(h.x, h.y); o.y = pk2(h.z, h.w);
        *(u32x2*)(xn + (size_t)row * DM + col) = o;
      }
    }
#pragma unroll
    for (int j = 0; j < 4; ++j) { v[j] = vn[j]; y0[j] = y0n[j]; y1[j] = y1n[j]; }
  }
#undef NS_LOAD
}

constexpr int RT_HS = 1028;
DI void norm_route(const Params& P_, int l, unsigned char* lds) {
  Params P = P_; { size_t z_ = 0; asm volatile("" : "+s"(z_)); P.ws = P_.ws + z_; }
  const int tid = otid(), bid = obid(), wave = tid >> 6, lane = tid & 63;
  const float* mod = (const float*)(P.ws + WS_MOD);
  bf16_t* h2 = (bf16_t*)(P.ws + WS_A);
  float* hs = (float*)lds;
  float* Wc = (float*)lds + 32 * RT_HS;
  const float* wg = P.in[22] + (size_t)l * DM * 4; const float* we = P.in[24] + (size_t)l * DM * 32;
  const float* bg = P.in[23] + l * 4; const float* be = P.in[25] + l * 32;
  int* cnt = (int*)(P.ws + WS_CNT) + l * 32; int* list = (int*)(P.ws + WS_LIST); float* wts = (float*)(P.ws + WS_WT);
  const int rg = wave >> 2, kq = wave & 3;
  for (int grp = bid; grp < NT / 32; grp += gridDim.x) {
    const int row0 = grp * 32 + wave * 4, b = row0 >> 13;
    const float* ng = P.in[21] + (size_t)l * DM; const float* md = mod + (size_t)((l * 2 + b) * 6144);
    {
      f32x4 v[4][4];
#pragma unroll
      for (int r = 0; r < 4; ++r)
#pragma unroll
        for (int j = 0; j < 4; ++j) v[r][j] = *(const f32x4*)(P.out + (size_t)(row0 + r) * DM + 4 * lane + 256 * j);
      float inv[4];
#pragma unroll
      for (int r = 0; r < 4; ++r) { float ss = 0.f;
#pragma unroll
        for (int j = 0; j < 4; ++j) ss += v[r][j].x * v[r][j].x + v[r][j].y * v[r][j].y + v[r][j].z * v[r][j].z + v[r][j].w * v[r][j].w;
        inv[r] = rsqrtf(wave_sum(ss) * (1.f / DM) + EPS); }
#pragma unroll
      for (int j = 0; j < 4; ++j) {
        const int col = 4 * lane + 256 * j;
        const f32x4 g = *(const f32x4*)(ng + col), sh = *(const f32x4*)(md + 3072 + col), sc = *(const f32x4*)(md + 4096 + col);
#pragma unroll
        for (int r = 0; r < 4; ++r) {
          const f32x4 hh = v[r][j] * inv[r] * g * (sc + 1.f) + sh;
          u32x2 o; o.x = pk2(hh.x, hh.y); o.y = pk2(hh.z, hh.w);
          *(u32x2*)(h2 + (size_t)(row0 + r) * DM + col) = o;
          *(f32x4*)(hs + (wave * 4 + r) * RT_HS + col) = hh;
        }
      }
    }
    f32x4 we0, we1, wg0 = {0.f, 0.f, 0.f, 0.f};
#define WLOAD(kc) do { we0 = *(const f32x4*)(we + (size_t)(kc) * 4096 + tid * 4); we1 = *(const f32x4*)(we + (size_t)(kc) * 4096 + 2048 + tid * 4); if (tid < 128) wg0 = *(const f32x4*)(wg + (size_t)(kc) * 512 + tid * 4); } while (0)
#define WSTORE() do { *(f32x4*)(Wc + (tid >> 3) * 36 + (tid & 7) * 4) = we0; *(f32x4*)(Wc + (64 + (tid >> 3)) * 36 + (tid & 7) * 4) = we1; if (tid < 128) *(f32x4*)(Wc + tid * 36 + 32) = wg0; } while (0)
    WLOAD(0);
    f32x4 acc0 = {0.f, 0.f, 0.f, 0.f}, acc1 = acc0, acc2 = acc0;
    for (int kc = 0; kc < 8; ++kc) {
      __syncthreads();
      WSTORE();
      if (kc + 1 < 8) WLOAD(kc + 1);
      __syncthreads();
      const float* ap = hs + (rg * 16 + (lane & 15)) * RT_HS + kc * 128 + kq * 32 + (lane >> 4);
      const float* bp = Wc + (kq * 32 + (lane >> 4)) * 36 + (lane & 15);
#pragma unroll
      for (int ks = 0; ks < 8; ++ks) {
        const float av = ap[4 * ks];
        const float b0 = bp[(4 * ks) * 36], b1 = bp[(4 * ks) * 36 + 16], b2 = (lane & 15) < 4 ? bp[(4 * ks) * 36 + 32] : 0.f;
        acc0 = __builtin_amdgcn_mfma_f32_16x16x4f32(av, b0, acc0, 0, 0, 0);
        acc1 = __builtin_amdgcn_mfma_f32_16x16x4f32(av, b1, acc1, 0, 0, 0);
        acc2 = __builtin_amdgcn_mfma_f32_16x16x4f32(av, b2, acc2, 0, 0, 0);
      }
    }
#undef WLOAD
#undef WSTORE
    __syncthreads();
    {
      float* part = hs + kq * (32 * 40);
#pragma unroll
      for (int i = 0; i < 4; ++i) { const int row = rg * 16 + 4 * (lane >> 4) + i, col = lane & 15;
        part[row * 40 + col] = acc0[i]; part[row * 40 + 16 + col] = acc1[i]; if (col < 4) part[row * 40 + 32 + col] = acc2[i]; }
    }
    __syncthreads();
    if (tid < 32) {
      const int row = grp * 32 + tid;
      float L[36];
#pragma unroll
      for (int o = 0; o < 36; ++o) L[o] = (hs[tid * 40 + o] + hs[1280 + tid * 40 + o]) + (hs[2560 + tid * 40 + o] + hs[3840 + tid * 40 + o]);
      float gm = -1e30f; int gi = 0;
#pragma unroll
      for (int i = 0; i < 4; ++i) { const float v = L[32 + i] + bg[i]; if (v > gm) { gm = v; gi = i; } }
      float gs = 0.f;
#pragma unroll
      for (int i = 0; i < 4; ++i) gs += expf(L[32 + i] + bg[i] - gm);
      const float gp = 1.f / gs;
      float el[8];
#pragma unroll
      for (int i = 0; i < 8; ++i) el[i] = (gi == 0 ? L[i] : gi == 1 ? L[8 + i] : gi == 2 ? L[16 + i] : L[24 + i]) + be[gi * 8 + i];
      float em = -1e30f;
#pragma unroll
      for (int i = 0; i < 8; ++i) em = fmaxf(em, el[i]);
      float p1 = -1.f, p2 = -1.f; int i1 = 0, i2 = 0;
#pragma unroll
      for (int i = 0; i < 8; ++i) {
        const float pe = expf(el[i] - em);
        if (pe > p1) { p2 = p1; i2 = i1; p1 = pe; i1 = i; } else if (pe > p2) { p2 = pe; i2 = i; }
      }
      const float w1 = gp * p1 / (p1 + p2), w2 = gp * p2 / (p1 + p2);
      const int e1 = gi * 8 + i1, e2 = gi * 8 + i2;
      const int pos1 = atomicAdd(&cnt[e1], 1); list[e1 * LISTCAP + pos1] = row * 2; wts[row * 2] = w1;
      const int pos2 = atomicAdd(&cnt[e2], 1); list[e2 * LISTCAP + pos2] = row * 2 + 1; wts[row * 2 + 1] = w2;
    }
    __syncthreads();
  }
}

namespace pg8 {
#define PG8_LAS __attribute__((address_space(3)))
typedef unsigned short bf16_t;
typedef short bf16x8 __attribute__((ext_vector_type(8)));
typedef float f32x4 __attribute__((ext_vector_type(4)));
typedef unsigned u32x4 __attribute__((ext_vector_type(4)));
constexpr int BM = 256, BK = 64, HALF = 128, HTB = HALF * BK * 2  , STAGE_BYTES = 8 * HTB, NXCD = 8, WGM = 8;

__host__ __device__ __forceinline__ int lds_byte(int r, int c) { const int st = (r >> 4) * 2 + (c >> 5), rr = r & 15, cc = c & 31, ob = rr * 64 + cc * 2; return st * 1024 + (ob ^ (((ob >> 9) & 1) << 5)); }
__host__ __device__ __forceinline__ void stage_rc(int b, int& R, int& C) { const int st = b / 1024, sb = b % 1024, swz = sb ^ (((sb >> 9) & 1) << 5); R = (st >> 1) * 16 + swz / 64; C = (st & 1) * 32 + (swz % 64) / 2; }
__host__ __device__ __forceinline__ int perm32(int rho) { const int n = rho >> 4, i = rho & 15; return 8 * (i >> 2) + 4 * n + (i & 3); }

struct Unit { int pm, pn; };
struct Gemm { const bf16_t* A; const bf16_t* Bt; int M, N, K; };

struct StaticOrder {
    int nM, nN, nwg, G, c;
    __host__ __device__ void init(int M, int N, int G_, int c_) { nM = M / BM; nN = N / BM; nwg = nM * nN; G = G_; c = c_; }
    __host__ __device__ bool next(int i, Unit& u) const {
        const long L = (long)i * G + c; if (L >= nwg) return false;
        int wgid = (int)L; { const int q = nwg / NXCD, r = nwg % NXCD, xcd = wgid % NXCD, off = wgid / NXCD; wgid = (xcd < r ? xcd * (q + 1) : r * (q + 1) + (xcd - r) * q) + off; }
        const int nig = WGM * nN, gid = wgid / nig, fm = gid * WGM, gsz = (nM - fm) < WGM ? (nM - fm) : WGM;
        u.pm = fm + ((wgid % nig) % gsz); u.pn = (wgid % nig) / gsz; return true;
    }
    __device__ __forceinline__ void a_ready(const Unit&) const {}
    __device__ __forceinline__ void done(const Unit&) const {}
};
template <class Epi, class Sched, bool ALIGN_EPI = false, bool SP2 = false>
__device__ __forceinline__ void gemm_phase(PG8_LAS unsigned char* lds, const Gemm g, const Sched& S, const Epi& E) {
    const int tid = otid(), wid = __builtin_amdgcn_readfirstlane(tid >> 6), lane = tid & 63, wr = wid >> 2, wc = wid & 3, fr = lane & 15, fq = lane >> 4;
    const int K = g.K, nt = K / BK;
    unsigned voffA[2], voffB[2];
#pragma unroll
    for (int i = 0; i < 2; ++i) { int R, C; stage_rc(tid * 16 + i * 8192, R, C); const int Rb = Epi::PERM ? ((R & ~31) + perm32(R & 31)) : R;
        voffA[i] = (unsigned)(R * K + C) * 2u; voffB[i] = (unsigned)(Rb * K + C) * 2u; }
    const size_t kstep = (size_t)(BK * 2);
    const size_t hstep = (size_t)HALF * K * 2;
    const size_t tstep = 2 * hstep;
    const unsigned ldsw = (unsigned)wid * 1024u;
    const int aoff = lds_byte(wr * 64 + fr, fq * 8), boff = lds_byte(wc * 32 + fr, fq * 8);
#define PG8_SA(b, h) (((b) * 2 + (h)) * HTB)
#define PG8_SB(b, h) ((4 + (b) * 2 + (h)) * HTB)
#define PG8_STAGE(bufoff, gbase, voff) do { _Pragma("unroll") for (int _i = 0; _i < 2; ++_i) \
        __builtin_amdgcn_global_load_lds((const unsigned*)((const char*)(gbase) + (voff)[_i]), (PG8_LAS unsigned*)(lds + (bufoff) + ldsw + _i * 8192), 16, 0, 0); } while (0)
#define PG8_LDA(dst, b, h) do { _Pragma("unroll") for (int m = 0; m < 4; ++m) _Pragma("unroll") for (int k = 0; k < 2; ++k) dst[m][k] = *(const PG8_LAS bf16x8*)(lds + PG8_SA(b, h) + aoff + m * 2048 + k * 1024); } while (0)
#define PG8_LDB(dst, b, h) do { _Pragma("unroll") for (int n = 0; n < 2; ++n) _Pragma("unroll") for (int k = 0; k < 2; ++k) dst[n][k] = *(const PG8_LAS bf16x8*)(lds + PG8_SB(b, h) + boff + n * 2048 + k * 1024); } while (0)
#define PG8_MMA(ai, bj, At, Bt) do { __builtin_amdgcn_s_setprio(1); _Pragma("unroll") for (int m = 0; m < 4; ++m) _Pragma("unroll") for (int n = 0; n < 2; ++n) _Pragma("unroll") for (int k = 0; k < 2; ++k) \
        acc[ai][bj][m][n] = __builtin_amdgcn_mfma_f32_16x16x32_bf16(Bt[n][k], At[m][k], acc[ai][bj][m][n], 0, 0, 0); __builtin_amdgcn_s_setprio(0); } while (0)
#define PG8_WAIT_V(n) asm volatile("s_waitcnt vmcnt(" #n ")" ::: "memory")
#define PG8_WAIT_L(n) asm volatile("s_waitcnt lgkmcnt(" #n ")" ::: "memory")
#define PG8_BAR __builtin_amdgcn_s_barrier()
#define PG8_SCHED __builtin_amdgcn_sched_barrier(0)
    Unit cur, nxt; int ui = 0;
    if (!S.next(0, cur)) return;
    f32x4 acc[2][2][4][2];
#pragma unroll
    for (int a = 0; a < 2; ++a)
#pragma unroll
        for (int b = 0; b < 2; ++b)
#pragma unroll
            for (int m = 0; m < 4; ++m)
#pragma unroll
                for (int n = 0; n < 2; ++n) acc[a][b][m][n] = (f32x4){0.f, 0.f, 0.f, 0.f};
    bf16x8 At[4][2], B0[2][2], B1[2][2];
    const char* cA = (const char*)g.A + (size_t)cur.pm * tstep; const char* cB = (const char*)g.Bt + (size_t)cur.pn * tstep;
    S.a_ready(cur);
    if constexpr (SP2) {
        PG8_STAGE(PG8_SB(0, 0), cB, voffB); PG8_STAGE(PG8_SB(0, 1), cB + hstep, voffB); PG8_STAGE(PG8_SA(0, 0), cA, voffA); PG8_STAGE(PG8_SA(0, 1), cA + hstep, voffA);
        if (wr == 1) PG8_BAR;
        PG8_WAIT_V(2); PG8_BAR;
        PG8_STAGE(PG8_SB(1, 0), cB + kstep, voffB); PG8_STAGE(PG8_SA(1, 0), cA + kstep, voffA); PG8_STAGE(PG8_SB(1, 1), cB + hstep + kstep, voffB);
        PG8_WAIT_V(6); PG8_BAR;
    } else {
        PG8_STAGE(PG8_SB(0, 0), cB, voffB); PG8_STAGE(PG8_SA(0, 0), cA, voffA); PG8_STAGE(PG8_SB(0, 1), cB + hstep, voffB); PG8_STAGE(PG8_SA(0, 1), cA + hstep, voffA);
        if (wr == 1) PG8_BAR;
        PG8_WAIT_V(4); PG8_BAR;
        PG8_STAGE(PG8_SB(1, 0), cB + kstep, voffB); PG8_STAGE(PG8_SA(1, 0), cA + kstep, voffA); PG8_STAGE(PG8_SB(1, 1), cB + hstep + kstep, voffB);
        PG8_WAIT_V(6); PG8_BAR;
    }
    for (;;) {
        const bool has_next = S.next(ui + 1, nxt);
        const char* nA = has_next ? (const char*)g.A + (size_t)nxt.pm * tstep : cA; const char* nB = has_next ? (const char*)g.Bt + (size_t)nxt.pn * tstep : cB;
        for (int t = 0; t < nt; t += 2) {
            const bool last = (t == nt - 2);
            const char* a1 = cA + (size_t)(t + 1) * kstep;
            const char* a2 = last ? nA : cA + (size_t)(t + 2) * kstep; const char* b2 = last ? nB : cB + (size_t)(t + 2) * kstep;
            const char* a3 = a2 + kstep; const char* b3 = b2 + kstep;
            if (last && has_next) S.a_ready(nxt);
            if constexpr (SP2) {
            PG8_LDB(B0, 0, 0); PG8_LDB(B1, 0, 1); PG8_SCHED; PG8_LDA(At, 0, 0); PG8_STAGE(PG8_SA(1, 1), a1 + hstep, voffA);
            PG8_WAIT_V(8); PG8_WAIT_L(0); PG8_BAR; PG8_MMA(0, 0, At, B0); PG8_MMA(0, 1, At, B1); PG8_BAR; PG8_SCHED;
            PG8_LDA(At, 0, 1); PG8_STAGE(PG8_SB(0, 0), b2, voffB); PG8_STAGE(PG8_SB(0, 1), b2 + hstep, voffB); PG8_STAGE(PG8_SA(0, 0), a2, voffA);
            PG8_WAIT_V(8); PG8_WAIT_L(0); PG8_BAR; PG8_MMA(1, 0, At, B0); PG8_MMA(1, 1, At, B1); PG8_BAR; PG8_SCHED;
            PG8_LDB(B0, 1, 0); PG8_LDB(B1, 1, 1); PG8_SCHED; PG8_LDA(At, 1, 0); PG8_STAGE(PG8_SA(0, 1), a2 + hstep, voffA);
            PG8_WAIT_V(8); PG8_WAIT_L(0); PG8_BAR; PG8_MMA(0, 0, At, B0); PG8_MMA(0, 1, At, B1); PG8_BAR; PG8_SCHED;
            PG8_LDA(At, 1, 1); PG8_STAGE(PG8_SB(1, 0), b3, voffB); PG8_STAGE(PG8_SB(1, 1), b3 + hstep, voffB); PG8_STAGE(PG8_SA(1, 0), a3, voffA);
            PG8_WAIT_V(8); PG8_WAIT_L(0); PG8_BAR; PG8_MMA(1, 0, At, B0); PG8_MMA(1, 1, At, B1); PG8_BAR; PG8_SCHED;
            } else {
            PG8_LDB(B0, 0, 0); PG8_SCHED; PG8_LDA(At, 0, 0); PG8_STAGE(PG8_SA(1, 1), a1 + hstep, voffA);
            PG8_WAIT_L(8); PG8_BAR; PG8_WAIT_L(0); PG8_MMA(0, 0, At, B0); PG8_BAR; PG8_SCHED;
            PG8_LDB(B1, 0, 1); PG8_STAGE(PG8_SB(0, 0), b2, voffB);
            PG8_BAR; PG8_WAIT_L(0); PG8_MMA(0, 1, At, B1); PG8_BAR;
            PG8_LDA(At, 0, 1); PG8_STAGE(PG8_SA(0, 0), a2, voffA);
            PG8_BAR; PG8_WAIT_L(0); PG8_MMA(1, 0, At, B0); PG8_BAR; PG8_SCHED;
            PG8_STAGE(PG8_SB(0, 1), b2 + hstep, voffB);
            PG8_WAIT_V(6); PG8_BAR; PG8_MMA(1, 1, At, B1); PG8_BAR;
            PG8_LDB(B0, 1, 0); PG8_SCHED; PG8_LDA(At, 1, 0); PG8_STAGE(PG8_SA(0, 1), a2 + hstep, voffA);
            PG8_WAIT_L(8); PG8_BAR; PG8_WAIT_L(0); PG8_MMA(0, 0, At, B0); PG8_BAR; PG8_SCHED;
            PG8_LDB(B1, 1, 1); PG8_STAGE(PG8_SB(1, 0), b3, voffB);
            PG8_BAR; PG8_WAIT_L(0); PG8_MMA(0, 1, At, B1); PG8_BAR;
            PG8_LDA(At, 1, 1); PG8_STAGE(PG8_SA(1, 0), a3, voffA);
            PG8_BAR; PG8_WAIT_L(0); PG8_MMA(1, 0, At, B0); PG8_BAR; PG8_SCHED;
            PG8_STAGE(PG8_SB(1, 1), b3 + hstep, voffB);
            PG8_WAIT_V(6); PG8_BAR; PG8_MMA(1, 1, At, B1); PG8_BAR;
            }
        }
        if constexpr (ALIGN_EPI) { if (wr == 0) PG8_BAR; }
        if constexpr (!Epi::AFTER_DRAIN) { E(acc, cur, wr, wc, fr, fq); S.done(cur); }
        if (!has_next) break;
#pragma unroll
        for (int a = 0; a < 2; ++a)
#pragma unroll
            for (int b = 0; b < 2; ++b)
#pragma unroll
                for (int m = 0; m < 4; ++m)
#pragma unroll
                    for (int n = 0; n < 2; ++n) acc[a][b][m][n] = (f32x4){0.f, 0.f, 0.f, 0.f};
        cur = nxt; cA = nA; cB = nB; ++ui;
        if constexpr (ALIGN_EPI) { if (wr == 1) PG8_BAR; }
    }
    PG8_WAIT_V(0);
    if constexpr (!ALIGN_EPI) { if (wr == 0) PG8_BAR; }
    PG8_BAR;
    if constexpr (Epi::AFTER_DRAIN) { E.fused(acc, cur, wr, wc, fr, fq, lds, wid, lane); S.done(cur); }
#undef PG8_SA
#undef PG8_SB
#undef PG8_STAGE
#undef PG8_LDA
#undef PG8_LDB
#undef PG8_MMA
#undef PG8_WAIT_V
#undef PG8_WAIT_L
#undef PG8_BAR
#undef PG8_SCHED
}
}

constexpr int GT_ROWB = 128, GT_A = 0, GT_B = 128 * GT_ROWB, GT_STAGE = 2 * 128 * GT_ROWB;
#define GT_WOFF(lr_, tid_) ((lr_) * GT_ROWB + ((((tid_) & 7) ^ ((lr_) & 7)) * 16))
#define GT_RSW(ks_, fq_, fr_) ((((ks_) * 4 + (fq_)) ^ ((fr_) & 7)) * 16)
DI void gemm_kloop(unsigned char* lds, const bf16_t* a0, const bf16_t* a1, int a_kadv, const bf16_t* b0, const bf16_t* b1, int nk, f32x4 (&acc)[4][2]) {
  const int tid = otid(), lane = tid & 63, wid = tid >> 6, wr = wid >> 2, wc = wid & 3, fr = lane & 15, fq = lane >> 4;
  const int lr = tid >> 3, lkb = (tid & 7) * 16;
  u32x4 xa0, xa1, xb0, xb1, ya0, ya1, yb0, yb1;
#define GT_GLOAD(p0_, p1_, q0_, q1_, kt) do { p0_ = *(const u32x4*)(a0 + (size_t)(kt) * a_kadv); p1_ = *(const u32x4*)(a1 + (size_t)(kt) * a_kadv); q0_ = *(const u32x4*)(b0 + (kt) * 64); q1_ = *(const u32x4*)(b1 + (kt) * 64); } while (0)
#define GT_LSTORE(p0_, p1_, q0_, q1_, buf) do { unsigned char* s_ = lds + (buf) * GT_STAGE; \
    *(u32x4*)(s_ + GT_A + GT_WOFF(lr, tid)) = p0_; *(u32x4*)(s_ + GT_A + 64 * GT_ROWB + GT_WOFF(lr, tid)) = p1_; \
    *(u32x4*)(s_ + GT_B + GT_WOFF(lr, tid)) = q0_; *(u32x4*)(s_ + GT_B + 64 * GT_ROWB + GT_WOFF(lr, tid)) = q1_; } while (0)
#define GT_COMPUTE(buf) do { \
    const unsigned char* As = lds + (buf) * GT_STAGE + GT_A + (wr * 64 + fr) * GT_ROWB; \
    const unsigned char* Bs = lds + (buf) * GT_STAGE + GT_B + (wc * 32 + fr) * GT_ROWB; \
    _Pragma("unroll") for (int ks = 0; ks < 2; ++ks) { \
      bf16x8 af[4], bfr[2]; \
      _Pragma("unroll") for (int m = 0; m < 4; ++m) af[m] = *(const bf16x8*)(As + m * 16 * GT_ROWB + GT_RSW(ks, fq, fr)); \
      _Pragma("unroll") for (int n = 0; n < 2; ++n) bfr[n] = *(const bf16x8*)(Bs + n * 16 * GT_ROWB + GT_RSW(ks, fq, fr)); \
      _Pragma("unroll") for (int m = 0; m < 4; ++m) _Pragma("unroll") for (int n = 0; n < 2; ++n) acc[m][n] = __builtin_amdgcn_mfma_f32_16x16x32_bf16(bfr[n], af[m], acc[m][n], 0, 0, 0); } } while (0)
  GT_GLOAD(xa0, xa1, xb0, xb1, 0); GT_LSTORE(xa0, xa1, xb0, xb1, 0); if (nk > 1) GT_GLOAD(ya0, ya1, yb0, yb1, 1); __syncthreads();
  for (int kt = 0; kt < nk; kt += 2) {
    if (kt + 2 < nk) GT_GLOAD(xa0, xa1, xb0, xb1, kt + 2);
    GT_COMPUTE(0);
    if (kt + 1 < nk) GT_LSTORE(ya0, ya1, yb0, yb1, 1);
    __syncthreads();
    if (kt + 1 >= nk) break;
    if (kt + 3 < nk) GT_GLOAD(ya0, ya1, yb0, yb1, kt + 3);
    GT_COMPUTE(1);
    if (kt + 2 < nk) GT_LSTORE(xa0, xa1, xb0, xb1, 0);
    __syncthreads();
  }
#undef GT_GLOAD
#undef GT_LSTORE
#undef GT_COMPUTE
}
#define ACC_ZERO(acc) do { _Pragma("unroll") for (int m_ = 0; m_ < 4; ++m_) _Pragma("unroll") for (int n_ = 0; n_ < 2; ++n_) acc[m_][n_] = (f32x4){0.f, 0.f, 0.f, 0.f}; } while (0)
#define TILE_IDS const int tid = otid(), bid = obid(), lane = tid & 63, wid = tid >> 6, wr = wid >> 2, wc = wid & 3, fr = lane & 15, fq = lane >> 4, lr = tid >> 3, lk = (tid & 7) * 8; (void)bid; (void)lane; (void)wr; (void)wc; (void)fr; (void)fq; (void)lr; (void)lk

DI void phase_gates(const Params& P_, unsigned char* lds) {
  Params P = P_; { size_t z_ = 0; asm volatile("" : "+s"(z_)); P.ws = P_.ws + z_; }
  TILE_IDS;
  const bf16_t* xn = (const bf16_t*)(P.ws + WS_A); const bf16_t* wt = (const bf16_t*)(P.ws + WS_W + W_IN) + (size_t)5120 * DM; float* gates = (float*)(P.ws + WS_GATES);
  for (int tile = (int)gridDim.x - 1 - bid; tile < NT / 128; tile += gridDim.x) {
    const int row0 = tile * 128;
    f32x4 acc[4][2]; ACC_ZERO(acc);
    gemm_kloop(lds, xn + (size_t)(row0 + lr) * DM + lk, xn + (size_t)(row0 + lr + 64) * DM + lk, 64, wt + (size_t)lr * DM + lk, wt + (size_t)(lr + 64) * DM + lk, DM / 64, acc);
#pragma unroll
    for (int m = 0; m < 4; ++m)
#pragma unroll
      for (int n = 0; n < 2; ++n) {
        const int row = row0 + wr * 64 + m * 16 + fr, c2 = wc * 32 + n * 16 + 4 * fq; const f32x4 v = acc[m][n];
        if (c2 < 48) { f32x4 o = {sigmoidf_(v.x), sigmoidf_(v.y), sigmoidf_(v.z), sigmoidf_(v.w)}; *(f32x4*)(gates + (size_t)row * 48 + c2) = o; }
      }
  }
}
DI void phase_cmp1(const Params& P_, int l, unsigned char* lds) {
  Params P = P_; { size_t z_ = 0; asm volatile("" : "+s"(z_)); P.ws = P_.ws + z_; }
  TILE_IDS;
  const bf16_t* kvk = (const bf16_t*)(P.ws + WS_C); bf16_t* hid = (bf16_t*)(P.ws + WS_HID);
  const float* cb = (const float*)(P.ws + WS_CB) + l * 512;
  for (int tile = bid; tile < 128; tile += gridDim.x) {
    const int kv = tile >> 6, rt = (tile >> 1) & 31, ct = tile & 1, row0 = rt * 128, col0 = ct * 128;
    const bf16_t* wt = (const bf16_t*)(P.ws + WS_W + W_C1) + (size_t)kv * 256 * 2048;
    const bf16_t* ap[2];
#pragma unroll
    for (int i = 0; i < 2; ++i) { const int rr = row0 + lr + 64 * i, b = rr >> 11, n = (rr >> 2) & 511, g = rr & 3, nn = n > 510 ? 510 : n;
      ap[i] = kvk + (size_t)(b * SEQ + 16 * nn) * DM + kv * 256 + g * 64 + lk; }
    f32x4 acc[4][2]; ACC_ZERO(acc);
    gemm_kloop(lds, ap[0], ap[1], DM, wt + (size_t)(col0 + lr) * 2048 + lk, wt + (size_t)(col0 + lr + 64) * 2048 + lk, 32, acc);
#pragma unroll
    for (int m = 0; m < 4; ++m)
#pragma unroll
      for (int n = 0; n < 2; ++n) {
        const int row = row0 + wr * 64 + m * 16 + fr, col = col0 + wc * 32 + n * 16 + 4 * fq;
        const f32x4 bb = *(const f32x4*)(cb + kv * 256 + col); const f32x4 v = acc[m][n] + bb;
        u32x2 o; o.x = pk2(gelu_tanh(v.x), gelu_tanh(v.y)); o.y = pk2(gelu_tanh(v.z), gelu_tanh(v.w));
        *(u32x2*)(hid + ((size_t)kv * 4096 + row) * 256 + col) = o;
      }
  }
}
DI void phase_cmp2(const Params& P_, unsigned char* lds) {
  Params P = P_; { size_t z_ = 0; asm volatile("" : "+s"(z_)); P.ws = P_.ws + z_; }
  TILE_IDS;
  const bf16_t* hid = (const bf16_t*)(P.ws + WS_HID); bf16_t* kc = (bf16_t*)(P.ws + WS_KC); bf16_t* vc = (bf16_t*)(P.ws + WS_VC);
  for (int tile = bid; tile < 64; tile += gridDim.x) {
    const int kv = tile >> 5, rt = tile & 31, row0 = rt * 128;
    const bf16_t* wt = (const bf16_t*)(P.ws + WS_W + W_C2) + (size_t)kv * 128 * 256;
    const bf16_t* a = hid + ((size_t)kv * 4096 + row0) * 256;
    f32x4 acc[4][2]; ACC_ZERO(acc);
    gemm_kloop(lds, a + (size_t)lr * 256 + lk, a + (size_t)(lr + 64) * 256 + lk, 64, wt + (size_t)lr * 256 + lk, wt + (size_t)(lr + 64) * 256 + lk, 4, acc);
    if (wc < 2) {
#pragma unroll
      for (int m = 0; m < 4; ++m)
#pragma unroll
        for (int n = 0; n < 2; ++n) {
          const int rr = row0 + wr * 64 + m * 16 + fr, d = wc * 32 + n * 16 + 4 * fq;
          const int b = rr >> 11, nn = (rr >> 2) & 511, g = rr & 3; const f32x4 v = acc[m][n];
          if (kv == 0) { u32x2 o; o.x = pk2(v.x, v.y); o.y = pk2(v.z, v.w); *(u32x2*)(kc + ((size_t)((b * 4 + g) * 512 + nn)) * 64 + d) = o; }
          else { bf16_t* dst = vc + ((size_t)((b * 4 + g) * 64 + d)) * 512 + perm16(nn); dst[0] = (bf16_t)f2bf(v.x); dst[512] = (bf16_t)f2bf(v.y); dst[1024] = (bf16_t)f2bf(v.z); dst[1536] = (bf16_t)f2bf(v.w); }
        }
    }
  }
}
DI void phase_glu(const Params& P_, unsigned char* lds) {
  Params P = P_; { size_t z_ = 0; asm volatile("" : "+s"(z_)); P.ws = P_.ws + z_; }
  TILE_IDS;
  const bf16_t* y = (const bf16_t*)(P.ws + WS_G); const bf16_t* wt = (const bf16_t*)(P.ws + WS_W + W_GLU); bf16_t* ssm = (bf16_t*)(P.ws + WS_E);
  for (int tile = bid; tile < (NT / 128) * 4; tile += gridDim.x) {
    const int rt = tile >> 2, ct = tile & 3, row0 = rt * 128, col0 = ct * 128;
    f32x4 acc[4][2]; ACC_ZERO(acc);
    gemm_kloop(lds, y + (size_t)(row0 + lr) * 512 + lk, y + (size_t)(row0 + lr + 64) * 512 + lk, 64, wt + (size_t)(col0 + lr) * 512 + lk, wt + (size_t)(col0 + lr + 64) * 512 + lk, 8, acc);
#pragma unroll
    for (int m = 0; m < 4; ++m)
#pragma unroll
      for (int n = 0; n < 2; ++n) {
        const int row = row0 + wr * 64 + m * 16 + fr, col = col0 + wc * 32 + n * 16 + 4 * fq;
        const u32x2 yy = *(const u32x2*)(y + (size_t)row * 512 + col); const f32x4 v = acc[m][n];
        u32x2 o; o.x = pk2(bflo(yy.x) * sigmoidf_(v.x), bfhi(yy.x) * sigmoidf_(v.y)); o.y = pk2(bflo(yy.y) * sigmoidf_(v.z), bfhi(yy.y) * sigmoidf_(v.w));
        *(u32x2*)(ssm + (size_t)row * 512 + col) = o;
      }
  }
}
struct EpiInproj {
  static constexpr bool PERM = false, AFTER_DRAIN = false;
  bf16_t* qb; bf16_t* kvk; bf16_t* vT; bf16_t* mg; bf16_t* ub; float* gates;
  DI void operator()(const f32x4 (&acc)[2][2][4][2], const pg8::Unit& u, int wr, int wc, int fr_, int fq_) const {
    const int pn = u.pn; int fr = fr_, fq = fq_; asm volatile("" : "+v"(fr), "+v"(fq));
#pragma unroll
    for (int ai = 0; ai < 2; ++ai)
#pragma unroll
      for (int m = 0; m < 4; ++m) {
        const int row = u.pm * 256 + ai * 128 + wr * 64 + m * 16 + fr;
#pragma unroll
        for (int bj = 0; bj < 2; ++bj)
#pragma unroll
          for (int n = 0; n < 2; ++n) {
            const int cl = bj * 128 + wc * 32 + n * 16 + 4 * fq;
            const f32x4 v = acc[ai][bj][m][n];
            if (pn < 4) { u32x2 o; o.x = pk2(v.x * QSCALE, v.y * QSCALE); o.y = pk2(v.z * QSCALE, v.w * QSCALE); *(u32x2*)(qb + (size_t)row * DM + pn * 256 + cl) = o; }
            else if (pn < 10) {
              const int seg = pn - 4;
              if (seg == 5) {
                const int b = row >> 13, t = row & (SEQ - 1), g = cl >> 6, d = cl & 63;
                bf16_t* dst = vT + ((size_t)(((1 * NB + b) * 4 + g) * 64 + d)) * SEQ + perm16(t);
                dst[0] = (bf16_t)f2bf(v.x); dst[SEQ] = (bf16_t)f2bf(v.y); dst[2 * SEQ] = (bf16_t)f2bf(v.z); dst[3 * SEQ] = (bf16_t)f2bf(v.w);
              } else if (seg == 3) {
                const unsigned t = row & (SEQ - 1), pos = perm16(t) & 63;
                const unsigned ro = ((unsigned)(row >> 13) * 512u + (t >> 6)) * 4096u + (pos >> 3) * 256u + (pos & 7), co = (unsigned)(cl >> 6) * 524288u + (unsigned)((cl >> 5) & 1) * 2048u + (unsigned)(cl & 31) * 8u;
                bf16_t* dst = vT + (ro + co);
                dst[0] = (bf16_t)f2bf(v.x); dst[8] = (bf16_t)f2bf(v.y); dst[16] = (bf16_t)f2bf(v.z); dst[24] = (bf16_t)f2bf(v.w);
              } else if (seg == 2) {
                const unsigned t = row & (SEQ - 1);
                const unsigned ro = ((unsigned)(row >> 13) * 512u + (t >> 6)) * 4096u + ((t >> 5) & 1) * 2048u + (t & 31) * 8u, co = (unsigned)(cl >> 6) * 524288u + (unsigned)((cl >> 3) & 7) * 256u + (unsigned)(cl & 7);
                u32x2 o; o.x = pk2(v.x, v.y); o.y = pk2(v.z, v.w);
                *(u32x2*)(kvk + (WS_KSF - WS_C) / 2 + (ro + co)) = o;
              } else {
                const int slot = seg == 4 ? 3 : seg;
                u32x2 o; o.x = pk2(v.x, v.y); o.y = pk2(v.z, v.w); *(u32x2*)(kvk + (size_t)row * DM + slot * 256 + cl) = o;
              }
            } else if (pn < 18) {
              u32x2 o; o.x = pk2(sigmoidf_(v.x), sigmoidf_(v.y)); o.y = pk2(sigmoidf_(v.z), sigmoidf_(v.w)); *(u32x2*)(mg + (size_t)row * 2048 + (pn - 10) * 256 + cl) = o;
            } else if (pn < 20) { const int ch = (pn - 18) * 256 + cl; u32x2 o; o.x = pk2(v.x, v.y); o.y = pk2(v.z, v.w); *(u32x2*)(ub + ((size_t)(ch >> 4) * NT + row) * 16 + (ch & 15)) = o; }
            else { if (cl < 48) { f32x4 o = {sigmoidf_(v.x), sigmoidf_(v.y), sigmoidf_(v.z), sigmoidf_(v.w)}; *(f32x4*)(gates + (size_t)row * 48 + cl) = o; } }
          }
      }
  }
};
DI void phase_inproj8(const Params& P_, unsigned char* lds) {
  Params P = P_; { size_t z_ = 0; asm volatile("" : "+s"(z_)); P.ws = P_.ws + z_; }
  pg8::Gemm g{(const bf16_t*)(P.ws + WS_A), (const bf16_t*)(P.ws + WS_W + W_IN), NT, 5120, DM};
  pg8::StaticOrder S; S.init(NT, 5120, gridDim.x, obid());
  EpiInproj E{(bf16_t*)(P.ws + WS_B), (bf16_t*)(P.ws + WS_C), (bf16_t*)(P.ws + WS_DV), (bf16_t*)(P.ws + WS_F), (bf16_t*)(P.ws + WS_E), (float*)(P.ws + WS_GATES)};
  pg8::gemm_phase<EpiInproj, pg8::StaticOrder, true, true>((PG8_LAS unsigned char*)lds, g, S, E);
}
struct EpiMerge1 {
  static constexpr bool PERM = false, AFTER_DRAIN = false;
  const bf16_t* mg; bf16_t* tmp;
  DI void operator()(const f32x4 (&acc)[2][2][4][2], const pg8::Unit& u, int wr, int wc, int fr, int fq) const {
#pragma unroll
    for (int ai = 0; ai < 2; ++ai) {
      u32x2 ga[4][2][2];
#pragma unroll
      for (int m = 0; m < 4; ++m)
#pragma unroll
        for (int bj = 0; bj < 2; ++bj)
#pragma unroll
          for (int n = 0; n < 2; ++n) {
            const int row = u.pm * 256 + ai * 128 + wr * 64 + m * 16 + fr, col = u.pn * 256 + bj * 128 + wc * 32 + n * 16 + 4 * fq;
            ga[m][bj][n] = *(const u32x2*)(mg + (size_t)row * 2048 + col);
          }
      __builtin_amdgcn_sched_barrier(0);
#pragma unroll
      for (int m = 0; m < 4; ++m)
#pragma unroll
        for (int bj = 0; bj < 2; ++bj)
#pragma unroll
          for (int n = 0; n < 2; ++n) {
            const int row = u.pm * 256 + ai * 128 + wr * 64 + m * 16 + fr, col = u.pn * 256 + bj * 128 + wc * 32 + n * 16 + 4 * fq;
            const f32x4 v = acc[ai][bj][m][n]; const u32x2 g = ga[m][bj][n];
            u32x2 o; o.x = pk2(v.x * bflo(g.x), v.y * bfhi(g.x)); o.y = pk2(v.z * bflo(g.y), v.w * bfhi(g.y));
            *(u32x2*)(tmp + (size_t)row * DM + col) = o;
          }
      __builtin_amdgcn_sched_barrier(0);
    }
  }
};
struct EpiMerge2 {
  static constexpr bool PERM = false, AFTER_DRAIN = false;
  const bf16_t* mg; const bf16_t* tmp; bf16_t* mer;
  DI void operator()(const f32x4 (&acc)[2][2][4][2], const pg8::Unit& u, int wr, int wc, int fr, int fq) const {
#pragma unroll
    for (int ai = 0; ai < 2; ++ai)
#pragma unroll
      for (int mh = 0; mh < 2; ++mh) {
        u32x2 gs[2][2][2], tv[2][2][2];
#pragma unroll
        for (int mm = 0; mm < 2; ++mm)
#pragma unroll
          for (int bj = 0; bj < 2; ++bj)
#pragma unroll
            for (int n = 0; n < 2; ++n) {
              const int row = u.pm * 256 + ai * 128 + wr * 64 + (mh * 2 + mm) * 16 + fr, col = u.pn * 256 + bj * 128 + wc * 32 + n * 16 + 4 * fq;
              gs[mm][bj][n] = *(const u32x2*)(mg + (size_t)row * 2048 + 1024 + col);
#if EN_ATTN
              tv[mm][bj][n] = *(const u32x2*)(tmp + (size_t)row * DM + col);
#else
              tv[mm][bj][n] = (u32x2){0u, 0u};
#endif
            }
        __builtin_amdgcn_sched_barrier(0);
#pragma unroll
        for (int mm = 0; mm < 2; ++mm)
#pragma unroll
          for (int bj = 0; bj < 2; ++bj)
#pragma unroll
            for (int n = 0; n < 2; ++n) {
              const int row = u.pm * 256 + ai * 128 + wr * 64 + (mh * 2 + mm) * 16 + fr, col = u.pn * 256 + bj * 128 + wc * 32 + n * 16 + 4 * fq;
              const f32x4 v = acc[ai][bj][mh * 2 + mm][n]; const u32x2 g = gs[mm][bj][n], t = tv[mm][bj][n];
              u32x2 o; o.x = pk2(bflo(t.x) + v.x * bflo(g.x), bfhi(t.x) + v.y * bfhi(g.x)); o.y = pk2(bflo(t.y) + v.z * bflo(g.y), bfhi(t.y) + v.w * bfhi(g.y));
              *(u32x2*)(mer + (size_t)row * DM + col) = o;
            }
        __builtin_amdgcn_sched_barrier(0);
      }
  }
};
DI void phase_merge8(const Params& P_, unsigned char* lds) {
  Params P = P_; { size_t z_ = 0; asm volatile("" : "+s"(z_)); P.ws = P_.ws + z_; }
#if EN_ATTN
  { pg8::Gemm g{(const bf16_t*)(P.ws + WS_A), (const bf16_t*)(P.ws + WS_W + W_O), NT, DM, DM};
    pg8::StaticOrder S; S.init(NT, DM, gridDim.x, obid());
    EpiMerge1 E{(const bf16_t*)(P.ws + WS_F), (bf16_t*)(P.ws + WS_C)};
    pg8::gemm_phase<EpiMerge1, pg8::StaticOrder, true, true>((PG8_LAS unsigned char*)lds, g, S, E); }
#endif
  { pg8::Gemm g{(const bf16_t*)(P.ws + WS_E), (const bf16_t*)(P.ws + WS_W + W_SO), NT, DM, 512};
    pg8::StaticOrder S; S.init(NT, DM, gridDim.x, obid());
    EpiMerge2 E{(const bf16_t*)(P.ws + WS_F), (const bf16_t*)(P.ws + WS_C), (bf16_t*)(P.ws + WS_B)};
    pg8::gemm_phase<EpiMerge2, pg8::StaticOrder, true, true>((PG8_LAS unsigned char*)lds, g, S, E); }
}
struct EpiWout {
  static constexpr bool PERM = false, AFTER_DRAIN = false;
  const float* mod; const float* xin; float* out;
  DI void operator()(const f32x4 (&acc)[2][2][4][2], const pg8::Unit& u, int wr, int wc, int fr, int fq) const {
    const int b = (u.pm * 256) >> 13;
    f32x4 g1[2][2];
#pragma unroll
    for (int bj = 0; bj < 2; ++bj)
#pragma unroll
      for (int n = 0; n < 2; ++n) g1[bj][n] = *(const f32x4*)(mod + (size_t)b * 6144 + 2048 + u.pn * 256 + bj * 128 + wc * 32 + n * 16 + 4 * fq);
#pragma unroll
    for (int ai = 0; ai < 2; ++ai)
#pragma unroll
      for (int mh = 0; mh < 2; ++mh) {
        f32x4 xv[2][2][2];
#pragma unroll
        for (int mm = 0; mm < 2; ++mm)
#pragma unroll
          for (int bj = 0; bj < 2; ++bj)
#pragma unroll
            for (int n = 0; n < 2; ++n) {
              const int row = u.pm * 256 + ai * 128 + wr * 64 + (mh * 2 + mm) * 16 + fr, col = u.pn * 256 + bj * 128 + wc * 32 + n * 16 + 4 * fq;
              xv[mm][bj][n] = *(const f32x4*)(xin + (size_t)row * DM + col);
            }
        __builtin_amdgcn_sched_barrier(0);
#pragma unroll
        for (int mm = 0; mm < 2; ++mm)
#pragma unroll
          for (int bj = 0; bj < 2; ++bj)
#pragma unroll
            for (int n = 0; n < 2; ++n) {
              const int row = u.pm * 256 + ai * 128 + wr * 64 + (mh * 2 + mm) * 16 + fr, col = u.pn * 256 + bj * 128 + wc * 32 + n * 16 + 4 * fq;
              *(f32x4*)(out + (size_t)row * DM + col) = xv[mm][bj][n] + g1[bj][n] * acc[ai][bj][mh * 2 + mm][n];
            }
        __builtin_amdgcn_sched_barrier(0);
      }
  }
};
DI void phase_wout8(const Params& P_, int l, unsigned char* lds) {
  Params P = P_; { size_t z_ = 0; asm volatile("" : "+s"(z_)); P.ws = P_.ws + z_; }
  pg8::Gemm g{(const bf16_t*)(P.ws + WS_B), (const bf16_t*)(P.ws + WS_W + W_OUT), NT, DM, DM};
  pg8::StaticOrder S; S.init(NT, DM, gridDim.x, obid());
  EpiWout E{(const float*)(P.ws + WS_MOD) + (size_t)(l * 2) * 6144, l == 0 ? P.in[0] : P.out, P.out};
  pg8::gemm_phase<EpiWout, pg8::StaticOrder, true, true>((PG8_LAS unsigned char*)lds, g, S, E);
}

struct MoeTab { int cv, pin; };
DI MoeTab moe_tab(const int* cnt) {
  const int lane = otid() & 63; MoeTab T; T.cv = cnt[lane & 31]; int p = (T.cv + 127) >> 7;
#pragma unroll
  for (int o = 1; o < 32; o <<= 1) { const int t = __shfl_up(p, o); if ((lane & 31) >= o) p += t; }
  T.pin = p; return T;
}
DI int moe_total(const MoeTab& T) { return __builtin_amdgcn_readlane(T.pin, 31); }
DI void moe_find(const MoeTab& T, int rb, int& e, int& rbl, int& ce) {
  const unsigned m = (unsigned)__ballot(T.pin <= rb);
  e = __popc(m); e = e < NEXP ? e : NEXP - 1;
  const int nb = (__shfl(T.cv, e) + 127) >> 7;
  ce = __shfl(T.cv, e); rbl = rb - (__shfl(T.pin, e) - nb);
  e = __builtin_amdgcn_readfirstlane(e); rbl = __builtin_amdgcn_readfirstlane(rbl); ce = __builtin_amdgcn_readfirstlane(ce);
}
DI void phase_moe1(const Params& P_, int l, unsigned char* lds) {
  Params P = P_; { size_t z_ = 0; asm volatile("" : "+s"(z_)); P.ws = P_.ws + z_; }
  TILE_IDS;
  const int* cnt = (const int*)(P.ws + WS_CNT) + l * 32; const int* list = (const int*)(P.ws + WS_LIST);
  const bf16_t* h2 = (const bf16_t*)(P.ws + WS_A); bf16_t* act = (bf16_t*)(P.ws + WS_B);
  const MoeTab MT = moe_tab(cnt); const int total = moe_total(MT);
  for (int tile = bid; tile < total * 4; tile += gridDim.x) {
    const int rb = tile >> 2, ct = tile & 3; int e = 0, rbl = 0, ce = 1; moe_find(MT, rb, e, rbl, ce);
    const bf16_t* wt = (const bf16_t*)(P.ws + WS_W + W_GU) + (size_t)e * 512 * 1024 + (size_t)(ct * 128) * 1024;
    const bf16_t* ap[2];
#pragma unroll
    for (int i = 0; i < 2; ++i) { int idx = rbl * 128 + lr + 64 * i; idx = idx < ce ? idx : ce - 1; const int tok = list[e * LISTCAP + idx] >> 1; ap[i] = h2 + (size_t)tok * DM + lk; }
    f32x4 acc[4][2]; ACC_ZERO(acc);
    gemm_kloop(lds, ap[0], ap[1], 64, wt + (size_t)lr * DM + lk, wt + (size_t)(lr + 64) * DM + lk, 16, acc);
#pragma unroll
    for (int m = 0; m < 4; ++m) {
      const int arow = rb * 128 + wr * 64 + m * 16 + fr, col = ct * 64 + wc * 16 + 4 * fq;
      const f32x4 g = acc[m][0], u = acc[m][1];
      u32x2 o; o.x = pk2(g.x * sigmoidf_(g.x) * u.x, g.y * sigmoidf_(g.y) * u.y); o.y = pk2(g.z * sigmoidf_(g.z) * u.z, g.w * sigmoidf_(g.w) * u.w);
      *(u32x2*)(act + (size_t)arow * 256 + col) = o;
    }
  }
}
DI void phase_moe2(const Params& P_, int l, unsigned char* lds) {
  Params P = P_; { size_t z_ = 0; asm volatile("" : "+s"(z_)); P.ws = P_.ws + z_; }
  TILE_IDS;
  const int* cnt = (const int*)(P.ws + WS_CNT) + l * 32; const int* list = (const int*)(P.ws + WS_LIST); const float* wts = (const float*)(P.ws + WS_WT);
  const bf16_t* act = (const bf16_t*)(P.ws + WS_B); bf16_t* ys = (bf16_t*)(P.ws + WS_F);
  constexpr int ASUB = 128 * GT_ROWB, BOFF = 4 * ASUB;
  const MoeTab MT = moe_tab(cnt); const int total = moe_total(MT);
  const int lkb = (tid & 7) * 16;
  for (int item = bid; item < total * 4; item += gridDim.x) {
    const int rb = item >> 2, ct0 = (item & 3) * 2; int e = 0, rbl = 0, ce = 1; moe_find(MT, rb, e, rbl, ce);
    const bf16_t* wt = (const bf16_t*)(P.ws + WS_W + W_D) + (size_t)e * 1024 * 256;
    const bf16_t* a0 = act + (size_t)(rb * 128 + lr) * 256 + lk; const bf16_t* a1 = a0 + 64 * 256;
    u32x4 ra[8], xb0, xb1, yb0, yb1;
#pragma unroll
    for (int k = 0; k < 4; ++k) { ra[2 * k] = *(const u32x4*)(a0 + 64 * k); ra[2 * k + 1] = *(const u32x4*)(a1 + 64 * k); }
#define M2_BLOAD(q0_, q1_, s_) do { const bf16_t* bp_ = wt + (size_t)((ct0 + ((s_) >> 2)) * 128 + lr) * 256 + ((s_) & 3) * 64 + lk; q0_ = *(const u32x4*)bp_; q1_ = *(const u32x4*)(bp_ + 64 * 256); } while (0)
#define M2_BSTORE(q0_, q1_, buf_) do { unsigned char* s_ = lds + BOFF + (buf_) * ASUB; *(u32x4*)(s_ + GT_WOFF(lr, tid)) = q0_; *(u32x4*)(s_ + 64 * GT_ROWB + GT_WOFF(lr, tid)) = q1_; } while (0)
#define M2_COMPUTE(s_, buf_) do { \
      const unsigned char* As = lds + ((s_) & 3) * ASUB + (wr * 64 + fr) * GT_ROWB; \
      const unsigned char* Bs = lds + BOFF + (buf_) * ASUB + (wc * 32 + fr) * GT_ROWB; \
      _Pragma("unroll") for (int ks = 0; ks < 2; ++ks) { \
        bf16x8 af[4], bfr[2]; \
        _Pragma("unroll") for (int m = 0; m < 4; ++m) af[m] = *(const bf16x8*)(As + m * 16 * GT_ROWB + GT_RSW(ks, fq, fr)); \
        _Pragma("unroll") for (int n = 0; n < 2; ++n) bfr[n] = *(const bf16x8*)(Bs + n * 16 * GT_ROWB + GT_RSW(ks, fq, fr)); \
        _Pragma("unroll") for (int m = 0; m < 4; ++m) _Pragma("unroll") for (int n = 0; n < 2; ++n) acc[m][n] = __builtin_amdgcn_mfma_f32_16x16x32_bf16(bfr[n], af[m], acc[m][n], 0, 0, 0); } } while (0)
#define M2_EPI(ct_) do { _Pragma("unroll") for (int m = 0; m < 4; ++m) { const int idx = rbl * 128 + wr * 64 + m * 16 + fr; \
      if (idx < ce) { const int slot = eslot[m]; const float w_ = ewt[m]; \
        _Pragma("unroll") for (int n = 0; n < 2; ++n) { const int col = (ct_) * 128 + wc * 32 + n * 16 + 4 * fq; const f32x4 v = acc[m][n] * w_; \
          u32x2 o; o.x = pk2(v.x, v.y); o.y = pk2(v.z, v.w); *(u32x2*)(ys + (size_t)slot * DM + col) = o; } } } ACC_ZERO(acc); } while (0)
    int eslot[4]; float ewt[4];
#pragma unroll
    for (int m = 0; m < 4; ++m) { int idx = rbl * 128 + wr * 64 + m * 16 + fr; idx = idx < ce ? idx : ce - 1; eslot[m] = list[e * LISTCAP + idx]; }
#pragma unroll
    for (int m = 0; m < 4; ++m) ewt[m] = wts[eslot[m]];
    M2_BLOAD(xb0, xb1, 0);
#pragma unroll
    for (int k = 0; k < 4; ++k) { *(u32x4*)(lds + k * ASUB + GT_WOFF(lr, tid)) = ra[2 * k]; *(u32x4*)(lds + k * ASUB + 64 * GT_ROWB + GT_WOFF(lr, tid)) = ra[2 * k + 1]; }
    M2_BSTORE(xb0, xb1, 0);
    M2_BLOAD(yb0, yb1, 1);
    __syncthreads();
    f32x4 acc[4][2]; ACC_ZERO(acc);
#pragma unroll 1
    for (int s2 = 0; s2 < 8; s2 += 2) {
      if (s2 + 2 < 8) M2_BLOAD(xb0, xb1, s2 + 2);
      M2_COMPUTE(s2, 0);
      M2_BSTORE(yb0, yb1, 1);
      __syncthreads();
      if (s2 + 3 < 8) M2_BLOAD(yb0, yb1, s2 + 3);
      M2_COMPUTE(s2 + 1, 1);
      if (s2 == 2) M2_EPI(ct0);
      if (s2 == 6) M2_EPI(ct0 + 1);
      if (s2 + 2 < 8) M2_BSTORE(xb0, xb1, 0);
      __syncthreads();
    }
#undef M2_BLOAD
#undef M2_BSTORE
#undef M2_COMPUTE
#undef M2_EPI
  }
}

typedef float f32x2v __attribute__((ext_vector_type(2)));
DI void phase_s5a(const Params& P_, int l, unsigned char* lds) {
  Params P = P_; { size_t z_ = 0; asm volatile("" : "+s"(z_)); P.ws = P_.ws + z_; }
  TILE_IDS;
  const bf16_t* ub = (const bf16_t*)(P.ws + WS_E); float* Lb = (float*)(P.ws + WS_L);
  const bf16_t* M1 = (const bf16_t*)(P.ws + WS_TAB + (size_t)l * TAB_LAYER + TAB_M1);
  const int first = (int)gridDim.x >= 192 ? 128 : 0;
  for (int tile = bid - first; tile >= 0 && tile < 64; tile += gridDim.x) {
    const int g = tile >> 1, rt = tile & 1;
    const bf16_t* a = ub + ((size_t)g * NT / 64 + rt * 128) * 1024;
    const bf16_t* wt = M1 + (size_t)g * 128 * 1024;
    f32x4 acc[4][2]; ACC_ZERO(acc);
    gemm_kloop(lds, a + (size_t)lr * 1024 + lk, a + (size_t)(lr + 64) * 1024 + lk, 64, wt + (size_t)lr * 1024 + lk, wt + (size_t)(lr + 64) * 1024 + lk, 16, acc);
#pragma unroll
    for (int m = 0; m < 4; ++m)
#pragma unroll
      for (int n = 0; n < 2; ++n) {
        const int R = rt * 128 + wr * 64 + m * 16 + fr, comp = wc * 32 + n * 16 + 4 * fq;
        *(f32x4*)(Lb + ((size_t)(R * 32 + g) * 64) * 2 + comp) = acc[m][n];
      }
  }
}
DI void s5_carry(const Params& P_, int l) {
  Params P = P_; { size_t z_ = 0; asm volatile("" : "+s"(z_)); P.ws = P_.ws + z_; }
  const int tid_ = otid(), bid = obid(), wave = tid_ >> 6, lane = tid_ & 63;
  const int item = (gridDim.x * NWAVE - 1) - (bid * NWAVE + wave);
  if (item >= NB * 32) return;
  const int b = item >> 5, g = item & 31;
  const float* pp = (const float*)(P.ws + WS_S5P) + (size_t)((l * 32 + g) * 64 + lane) * 36;
  const float aTr = pp[2], aTi = pp[3];
  float2* Lp = (float2*)(P.ws + WS_L) + ((size_t)(b * 128) * 32 + g) * 64 + lane;
  unsigned* Sp = (unsigned*)(P.ws + WS_SIN) + ((size_t)(g * 256 + b * 128)) * 64 + lane;
  float sr = 0.f, si = 0.f; asm volatile("" : "+v"(sr), "+v"(si));
  float2 va[8], vb[8];
#define CY_LOAD(vv, c0_) do { _Pragma("unroll") for (int k = 0; k < 8; ++k) vv[k] = Lp[(size_t)((c0_) + k) * 2048]; } while (0)
#define CY_STEP(vv, c0_) do { _Pragma("unroll") for (int k = 0; k < 8; ++k) { Lp[(size_t)((c0_) + k) * 2048] = make_float2(sr, si); Sp[(size_t)((c0_) + k) * 64] = pk2(sr, si); \
      const float nr = aTr * sr - aTi * si + vv[k].x, ni = aTr * si + aTi * sr + vv[k].y; sr = nr; si = ni; } } while (0)
#define CY_PIN(vv) do { _Pragma("unroll") for (int k = 0; k < 8; ++k) asm volatile("" : "+v"(vv[k].x), "+v"(vv[k].y)); } while (0)
  CY_LOAD(va, 0);
#pragma unroll
  for (int c0 = 0; c0 < 128; c0 += 16) {
    CY_LOAD(vb, c0 + 8);
    CY_PIN(va);
    CY_STEP(va, c0);
    if (c0 + 16 < 128) CY_LOAD(va, c0 + 16);
    CY_PIN(vb);
    CY_STEP(vb, c0 + 8);
  }
#undef CY_PIN
#undef CY_LOAD
#undef CY_STEP
}
DI void phase_s5c(const Params& P_, int l, unsigned char* lds) {
  Params P = P_; { size_t z_ = 0; asm volatile("" : "+s"(z_)); P.ws = P_.ws + z_; }
  TILE_IDS;
  const bf16_t* ub = (const bf16_t*)(P.ws + WS_E); const bf16_t* sinb = (const bf16_t*)(P.ws + WS_SIN); bf16_t* yb = (bf16_t*)(P.ws + WS_G);
  const bf16_t* tab = (const bf16_t*)(P.ws + WS_TAB + (size_t)l * TAB_LAYER);
  int* dctr = (int*)(P.ws + 640) + l; int* dslot = (int*)(lds + LDS_BYTES - 32);
  constexpr int ROWB = GT_ROWB, SA = 0, SB = 128 * ROWB, STAGE = 2 * 128 * ROWB;
  const int lkb = (tid & 7) * 16, kch = tid & 7;
  for (;;) {
    if (threadIdx.x == 0) *dslot = atomicAdd(dctr, 1);
    __syncthreads();
    const int tile = *dslot;
    __syncthreads();
    if (tile >= 512) break;
    const int g = tile >> 4, rt = (tile >> 3) & 1, ct = tile & 7;
    const bf16_t* Kt = tab + TAB_KT / 2 + (size_t)g * 64 * 256; const bf16_t* M2 = tab + TAB_M2 / 2 + (size_t)g * 1024 * 128;
    const bf16_t* ua = ub + ((size_t)g * 256 + rt * 128) * 1024; const bf16_t* sa = sinb + ((size_t)g * 256 + rt * 128) * 128;
    const int nbt = 2 * ct + 2 < 16 ? 2 * ct + 2 : 16, ns = nbt + 2;
    u32x4 xa0, xa1, xb0, xb1, ya0, ya1, yb0, yb1;
#define S5_LOAD(p0_, p1_, q0_, q1_, s_) do { \
      if ((s_) < nbt) { p0_ = *(const u32x4*)(ua + (size_t)lr * 1024 + (s_) * 64 + lk); p1_ = *(const u32x4*)(ua + (size_t)(lr + 64) * 1024 + (s_) * 64 + lk); \
        const int i_ = 4 * (s_) + (kch >> 1), hq_ = (kch & 1) * 8; \
        { const int t_ = 8 * ct + (lr >> 4), h_ = lr & 15; q0_ = t_ >= i_ ? *(const u32x4*)(Kt + ((t_ - i_) * 16 + h_) * 16 + hq_) : (u32x4){0u, 0u, 0u, 0u}; } \
        { const int t_ = 8 * ct + 4 + (lr >> 4), h_ = lr & 15; q1_ = t_ >= i_ ? *(const u32x4*)(Kt + ((t_ - i_) * 16 + h_) * 16 + hq_) : (u32x4){0u, 0u, 0u, 0u}; } \
      } else { const int k0_ = ((s_) - nbt) * 64 + lk; \
        p0_ = *(const u32x4*)(sa + (size_t)lr * 128 + k0_); p1_ = *(const u32x4*)(sa + (size_t)(lr + 64) * 128 + k0_); \
        q0_ = *(const u32x4*)(M2 + (size_t)(ct * 128 + lr) * 128 + k0_); q1_ = *(const u32x4*)(M2 + (size_t)(ct * 128 + lr + 64) * 128 + k0_); } } while (0)
#define S5_STORE(p0_, p1_, q0_, q1_, buf) do { unsigned char* s_ = lds + (buf) * STAGE; \
      *(u32x4*)(s_ + SA + GT_WOFF(lr, tid)) = p0_; *(u32x4*)(s_ + SA + 64 * ROWB + GT_WOFF(lr, tid)) = p1_; \
      *(u32x4*)(s_ + SB + GT_WOFF(lr, tid)) = q0_; *(u32x4*)(s_ + SB + 64 * ROWB + GT_WOFF(lr, tid)) = q1_; } while (0)
#define S5_COMPUTE(buf) do { \
      const unsigned char* As = lds + (buf) * STAGE + SA + (wr * 64 + fr) * ROWB; \
      const unsigned char* Bs = lds + (buf) * STAGE + SB + (wc * 32 + fr) * ROWB; \
      _Pragma("unroll") for (int ks = 0; ks < 2; ++ks) { \
        bf16x8 af[4], bfr[2]; \
        _Pragma("unroll") for (int m = 0; m < 4; ++m) af[m] = *(const bf16x8*)(As + m * 16 * ROWB + GT_RSW(ks, fq, fr)); \
        _Pragma("unroll") for (int n = 0; n < 2; ++n) bfr[n] = *(const bf16x8*)(Bs + n * 16 * ROWB + GT_RSW(ks, fq, fr)); \
        _Pragma("unroll") for (int m = 0; m < 4; ++m) _Pragma("unroll") for (int n = 0; n < 2; ++n) acc[m][n] = __builtin_amdgcn_mfma_f32_16x16x32_bf16(bfr[n], af[m], acc[m][n], 0, 0, 0); } } while (0)
    f32x4 acc[4][2]; ACC_ZERO(acc);
    S5_LOAD(xa0, xa1, xb0, xb1, 0); S5_STORE(xa0, xa1, xb0, xb1, 0); S5_LOAD(ya0, ya1, yb0, yb1, 1); __syncthreads();
    for (int st = 0; st < ns; st += 2) {
      if (st + 2 < ns) S5_LOAD(xa0, xa1, xb0, xb1, st + 2);
      S5_COMPUTE(0);
      if (st + 1 < ns) S5_STORE(ya0, ya1, yb0, yb1, 1);
      __syncthreads();
      if (st + 1 >= ns) break;
      if (st + 3 < ns) S5_LOAD(ya0, ya1, yb0, yb1, st + 3);
      S5_COMPUTE(1);
      if (st + 2 < ns) S5_STORE(xa0, xa1, xb0, xb1, 0);
      __syncthreads();
    }
#undef S5_LOAD
#undef S5_STORE
#undef S5_COMPUTE
    const float* dsk = P.in[13] + (size_t)(l * 32 + g) * 16;
#pragma unroll
    for (int m = 0; m < 4; ++m)
#pragma unroll
      for (int n = 0; n < 2; ++n) {
        const int R = rt * 128 + wr * 64 + m * 16 + fr, col = ct * 128 + wc * 32 + n * 16 + 4 * fq, t = col >> 4, h = col & 15;
        const u32x2 uu = *(const u32x2*)(ub + ((size_t)g * 256 + R) * 1024 + col); const f32x4 dd = *(const f32x4*)(dsk + h); const f32x4 v = acc[m][n];
        const float y0 = gelu_tanh(v.x + dd.x * bflo(uu.x)), y1 = gelu_tanh(v.y + dd.y * bfhi(uu.x)), y2 = gelu_tanh(v.z + dd.z * bflo(uu.y)), y3 = gelu_tanh(v.w + dd.w * bfhi(uu.y));
        const size_t tokn = (size_t)(R >> 7) * SEQ + 64 * (R & 127) + t;
        u32x2 o; o.x = pk2(y0, y1); o.y = pk2(y2, y3); *(u32x2*)(yb + tokn * 512 + g * 16 + h) = o;
      }
  }
}

constexpr int AT_ROWB = 144, AT_KS = 0, AT_VS = 2 * 64 * AT_ROWB, AT_IMP = 4 * 64 * AT_ROWB, AT_OACC = AT_IMP, AT_IMPS = 129, AT_EE = AT_IMP + 64 * AT_IMPS * 4,
              AT_SEL = AT_IMP + 66048, AT_QS = AT_SEL + 1024, AT_QL = AT_QS + 32768, AT_NJ = AT_QL + 8192, AT_ITEMS = AT_NJ + 512, AT_MREF = AT_ITEMS + 512,
              AT_LACC = AT_MREF + 1024, AT_INVQ = AT_LACC + 1024, AT_MISC = AT_INVQ + 512, AT_LOWN = AT_MISC + 64, AT_END = AT_LOWN + 1024;
static_assert(AT_END <= LDS_BYTES - 16, "attention LDS");
#define MFMA32(a, b, c) __builtin_amdgcn_mfma_f32_32x32x16_bf16((a), (b), (c), 0, 0, 0)
DI int crow_of(int reg, int hh) { return (reg & 3) + 8 * (reg >> 2) + 4 * hh; }

struct AttnState { f32x16 o0, o1; float m, l; };
DI void st_init(AttnState& S) { S.m = -1e30f; S.l = 0.f;
#pragma unroll
  for (int i = 0; i < 16; ++i) { S.o0[i] = 0.f; S.o1[i] = 0.f; } }

DI void at_ldk(const unsigned char* lds, int buf, int r, int hh, bf16x8 (&kf)[8]) {
  const unsigned char* kb = lds + AT_KS + buf * 64 * AT_ROWB + r * AT_ROWB + hh * 16;
#pragma unroll
  for (int ds = 0; ds < 4; ++ds) { kf[ds] = *(const bf16x8*)(kb + ds * 32); kf[4 + ds] = *(const bf16x8*)(kb + 32 * AT_ROWB + ds * 32); }
}
DI void at_ldv(const unsigned char* lds, int buf, int r, int hh, bf16x8 (&vf)[8]) {
  const unsigned char* vb = lds + AT_VS + buf * 64 * AT_ROWB + r * AT_ROWB + hh * 16;
#pragma unroll
  for (int gk = 0; gk < 4; ++gk) { vf[gk] = *(const bf16x8*)(vb + gk * 32); vf[4 + gk] = *(const bf16x8*)(vb + 32 * AT_ROWB + gk * 32); }
}
DI void at_qk(const bf16x8 (&kf)[8], const bf16x8 (&qf)[4], f32x16& p0, f32x16& p1) {
  const f32x16 z = {0.f, 0.f, 0.f, 0.f, 0.f, 0.f, 0.f, 0.f, 0.f, 0.f, 0.f, 0.f, 0.f, 0.f, 0.f, 0.f};
#pragma unroll
  for (int ds = 0; ds < 4; ++ds) { if (ds == 0) { p0 = MFMA32(kf[0], qf[0], z); p1 = MFMA32(kf[4], qf[0], z); } else { p0 = MFMA32(kf[ds], qf[ds], p0); p1 = MFMA32(kf[4 + ds], qf[ds], p1); } }
}
DI bf16x8 pack8(const f32x16& p, int s2) {
  u32x4 w; w.x = pk2(p[8 * s2], p[8 * s2 + 1]); w.y = pk2(p[8 * s2 + 2], p[8 * s2 + 3]); w.z = pk2(p[8 * s2 + 4], p[8 * s2 + 5]); w.w = pk2(p[8 * s2 + 6], p[8 * s2 + 7]);
  return __builtin_bit_cast(bf16x8, w);
}
DI void at_pv(const bf16x8 (&vf)[8], const f32x16& p0, const f32x16& p1, f32x16& oa, f32x16& ob) {
#pragma unroll
  for (int gk = 0; gk < 4; ++gk) {
    const bf16x8 pb = (gk < 2) ? pack8(p0, gk & 1) : pack8(p1, gk & 1);
    oa = MFMA32(vf[gk], pb, oa); ob = MFMA32(vf[4 + gk], pb, ob);
  }
}
template <int MODE>
DI void at_online(AttnState& S, f32x16& p0, f32x16& p1, int key0, int lo, int hi, bool on, int hh) {
  float tm = -1e30f;
  if (MODE == 1) {
    int lor = lo - key0 - 4 * hh, hir = hi - key0 - 4 * hh;
    if (hir < lor) { lor = 4096; hir = 4096; }
    const unsigned span = (unsigned)(hir - lor);
#pragma unroll
    for (int i = 0; i < 16; ++i) { const int c0 = (i & 3) + 8 * (i >> 2);
      p0[i] = ((unsigned)(c0 - lor) <= span) ? p0[i] : -1e30f; p1[i] = ((unsigned)(c0 + 32 - lor) <= span) ? p1[i] : -1e30f; }
  }
  if (MODE != 1) asm volatile("s_nop 15\n\ts_nop 7" : "+v"(tm) : "v"(p0[15]), "v"(p1[15]));
#define MX3_8(o_) asm("v_max3_f32 %0, %0, %1, %2\n\tv_max3_f32 %0, %0, %3, %4\n\tv_max3_f32 %0, %0, %5, %6\n\tv_max3_f32 %0, %0, %7, %8\n\tv_max3_f32 %0, %0, %9, %10\n\tv_max3_f32 %0, %0, %11, %12\n\tv_max3_f32 %0, %0, %13, %14\n\tv_max3_f32 %0, %0, %15, %16" \
      : "+v"(tm) : "v"(p0[o_]), "v"(p1[o_]), "v"(p0[o_ + 1]), "v"(p1[o_ + 1]), "v"(p0[o_ + 2]), "v"(p1[o_ + 2]), "v"(p0[o_ + 3]), "v"(p1[o_ + 3]), "v"(p0[o_ + 4]), "v"(p1[o_ + 4]), "v"(p0[o_ + 5]), "v"(p1[o_ + 5]), "v"(p0[o_ + 6]), "v"(p1[o_ + 6]), "v"(p0[o_ + 7]), "v"(p1[o_ + 7]))
  MX3_8(0); MX3_8(8);
#undef MX3_8
  tm = fmaxf(tm, __shfl_xor(tm, 32));
  if (MODE == 2) tm = on ? tm : -1e30f;
  if (__any(tm > S.m)) {
    const float mn = fmaxf(S.m, tm); const float al = __builtin_amdgcn_exp2f(S.m - mn); S.m = mn; S.l *= al;
#pragma unroll
    for (int i = 0; i < 16; ++i) { S.o0[i] *= al; S.o1[i] *= al; }
  }
  float mn = S.m;
  if (MODE == 2) mn = on ? mn : 1e30f;
  if (MODE == 1) mn = mn < -1e29f ? 1e30f : mn;
  float rs = 0.f;
#pragma unroll
  for (int i = 0; i < 16; ++i) {
    const float e0 = __builtin_amdgcn_exp2f(p0[i] - mn), e1 = __builtin_amdgcn_exp2f(p1[i] - mn);
    p0[i] = e0; p1[i] = e1; rs += e0 + e1;
  }
  S.l += rs;
}

DI void attn_tile(const Params& P_, unsigned char* lds, int b, int g, int c) {
  Params P = P_; { size_t z_ = 0; asm volatile("" : "+s"(z_)); P.ws = P_.ws + z_; }
#define AT_IDS const int tid = otid(), lane = tid & 63, w = tid >> 6, r = lane & 31, hh = lane >> 5, qi = 8 * w + (r >> 2), h = r & 3, t = 64 * c + qi, qrow = 32 * w + r, srow = tid >> 3, sch = (tid & 7) * 8, ahead = lane >> 4, ach = lane & 15; const unsigned tok = (unsigned)b * SEQ + t, goff = tok * 48 + g * 4 + h; (void)qi; (void)h; (void)t; (void)qrow; (void)srow; (void)sch; (void)ahead; (void)ach; (void)tok; (void)goff; (void)hh; (void)w; (void)r
  const bf16_t* qb = (const bf16_t*)(P.ws + WS_B); const bf16_t* kvk = (const bf16_t*)(P.ws + WS_C); const bf16_t* vT = (const bf16_t*)(P.ws + WS_DV);
  const bf16_t* kcb = (const bf16_t*)(P.ws + WS_KC); const bf16_t* vcb = (const bf16_t*)(P.ws + WS_VC);
  const float* gbase = (const float*)(P.ws + WS_GATES);
#define gates(i) gbase[goff + (i)]
  bf16_t* attn = (bf16_t*)(P.ws + WS_A);
  float* otb = (float*)(P.ws + WS_OT) + (size_t)obid() * 16384;
#define otg(i) otb[(unsigned)tid + (i) * 512u]
  float* IMP = (float*)(lds + AT_IMP); float* EE = (float*)(lds + AT_EE); unsigned* SEL = (unsigned*)(lds + AT_SEL);
  AttnState S; f32x16 p0, p1; u32x4 rkA, rvA; bf16x8 qf[4], kfr[8], vfr[8];
#define QF_LOAD() do { _Pragma("unroll") for (int ds_ = 0; ds_ < 4; ++ds_) qf[ds_] = *(const bf16x8*)(lds + AT_QS + qrow * 128 + (((ds_ * 2 + hh) ^ (qrow & 7)) * 16)); } while (0)
#define AT_QKV() do { at_ldk(lds, buf_, r, hh, kfr); __builtin_amdgcn_sched_barrier(0); at_qk(kfr, qf, p0, p1); at_ldv(lds, buf_, r, hh, vfr); __builtin_amdgcn_sched_barrier(0); } while (0)
  { AT_IDS;
  { const int row = tid >> 1, half = tid & 1, q_i = row >> 2, hd = row & 3;
    const unsigned so = ((unsigned)b * SEQ + 64 * c + q_i) * DM + (g * 4 + hd) * 64 + half * 32;
#pragma unroll
    for (int k = 0; k < 4; ++k) { const u32x4 v = *(const u32x4*)(qb + so + k * 8); *(u32x4*)(lds + AT_QS + row * 128 + (((half * 4 + k) ^ (row & 7)) * 16)) = v; } }
  __syncthreads();
  QF_LOAD();
#define ST_LOAD(rk, rv, kp, kstride, vp, vstride, kt) do { rk = *(const u32x4*)((kp) + (unsigned)(((kt) * 64 + srow) * (kstride) + sch)); rv = *(const u32x4*)((vp) + (unsigned)(srow * (vstride) + (kt) * 64 + sch)); } while (0)
#define ST_STORE(rk, rv, buf) do { *(u32x4*)(lds + AT_KS + (buf) * 64 * AT_ROWB + srow * AT_ROWB + sch * 2) = rk; *(u32x4*)(lds + AT_VS + (buf) * 64 * AT_ROWB + srow * AT_ROWB + sch * 2) = rv; } while (0)
#define SWEEP(kp, kstride, vp, vstride, kt0, n, ...) do { \
    ST_LOAD(rkA, rvA, kp, kstride, vp, vstride, (kt0)); ST_STORE(rkA, rvA, 0); __syncthreads(); \
    for (int i_ = 0; i_ < (n); ++i_) { \
      if (i_ + 1 < (n)) ST_LOAD(rkA, rvA, kp, kstride, vp, vstride, (kt0) + i_ + 1); \
      { const int step_ = i_; const int buf_ = i_ & 1; __VA_ARGS__ } \
      if (i_ + 1 < (n)) ST_STORE(rkA, rvA, (i_ + 1) & 1); \
      __syncthreads(); \
    } } while (0)
#define ST_LOADF(rk, rv, kt) do { rk = *(const u32x4*)(kps + (size_t)(kt) * 4096 + tid * 8); rv = *(const u32x4*)(vps + (size_t)(kt) * 4096 + tid * 8); } while (0)
#define ST_STOREF(rk, rv, buf) do { const int fo_ = ((tid >> 8) * 32 + (tid & 31)) * AT_ROWB + (((tid >> 6) & 3) * 2 + ((tid >> 5) & 1)) * 16; \
    *(u32x4*)(lds + AT_KS + (buf) * 64 * AT_ROWB + fo_) = rk; *(u32x4*)(lds + AT_VS + (buf) * 64 * AT_ROWB + fo_) = rv; } while (0)
#define SWEEPF(kt0, n, ...) do { \
    ST_LOADF(rkA, rvA, (kt0)); ST_STOREF(rkA, rvA, 0); __syncthreads(); \
    for (int i_ = 0; i_ < (n); ++i_) { \
      if (i_ + 1 < (n)) ST_LOADF(rkA, rvA, (kt0) + i_ + 1); \
      { const int step_ = i_; const int buf_ = i_ & 1; __VA_ARGS__ } \
      if (i_ + 1 < (n)) ST_STOREF(rkA, rvA, (i_ + 1) & 1); \
      __syncthreads(); \
    } } while (0)
  {
    const bf16_t* kp = kvk + (size_t)b * SEQ * DM + 3 * 256 + g * 64; const bf16_t* vp = vT + (size_t)(((1 * NB + b) * 4 + g) * 64) * SEQ;
    const int j0 = c >= 8 ? c - 8 : 0, nj = c - j0 + 1;
    st_init(S);
    SWEEP(kp, DM, vp, SEQ, j0, nj, {
      AT_QKV();
      if ((step_ == 0 && c >= 8) || step_ == nj - 1) at_online<1>(S, p0, p1, (j0 + step_) * 64, t - 511, t, true, hh);
      else at_online<0>(S, p0, p1, 0, 0, 0, true, hh);
      at_pv(vfr, p0, p1, S.o0, S.o1); });
    const float lt = S.l + __shfl_xor(S.l, 32); const float sc = lt > 0.f ? gates(32) / lt : 0.f;
#pragma unroll
    for (int i = 0; i < 16; ++i) { otg(i) = S.o0[i] * sc; otg(16 + i) = S.o1[i] * sc; }
  }
  {
    const bf16_t* kcp = kcb + (size_t)((b * 4 + g) * 512) * 64; const bf16_t* vcp = vcb + (size_t)((b * 4 + g) * 64) * 512;
    const int nmax = t >= 31 ? (t - 31) >> 4 : -1;
    const int nct = (4 * c + 2) / 64 + 1;
    st_init(S);
    SWEEP(kcp, 64, vcp, 512, 0, nct, {
      at_ldk(lds, buf_, r, hh, kfr); __builtin_amdgcn_sched_barrier(0); at_qk(kfr, qf, p0, p1);
      if (64 * step_ + 63 <= 4 * c - 2) at_online<0>(S, p0, p1, 0, 0, 0, true, hh);
      else at_online<1>(S, p0, p1, step_ * 64, 0, nmax, true, hh); });
    const float lt = S.l + __shfl_xor(S.l, 32);
    const float cinv = lt > 0.f ? 1.f / lt : 0.f; const float cm = S.m;
    st_init(S);
    SWEEP(kcp, 64, vcp, 512, 0, nct, {
      AT_QKV();
      if (64 * step_ + 63 <= 4 * c - 2) {
        _Pragma("unroll") for (int k = 0; k < 16; ++k) { p0[k] = __builtin_amdgcn_exp2f(p0[k] - cm) * cinv; p1[k] = __builtin_amdgcn_exp2f(p1[k] - cm) * cinv; }
      } else {
        const int nrel = nmax - step_ * 64 - 4 * hh;
        _Pragma("unroll") for (int k = 0; k < 16; ++k) { const int c0 = (k & 3) + 8 * (k >> 2), c1 = c0 + 32;
          p0[k] = c0 <= nrel ? __builtin_amdgcn_exp2f(p0[k] - cm) * cinv : 0.f; p1[k] = c1 <= nrel ? __builtin_amdgcn_exp2f(p1[k] - cm) * cinv : 0.f; }
      }
      at_pv(vfr, p0, p1, S.o0, S.o1);
      _Pragma("unroll") for (int kh = 0; kh < 2; ++kh)
      _Pragma("unroll") for (int gi = 0; gi < 4; ++gi) {
          float g4 = kh == 0 ? (p0[4 * gi] + p0[4 * gi + 1]) + (p0[4 * gi + 2] + p0[4 * gi + 3]) : (p1[4 * gi] + p1[4 * gi + 1]) + (p1[4 * gi + 2] + p1[4 * gi + 3]);
          float e3 = kh == 0 ? p0[4 * gi + 3] : p1[4 * gi + 3];
          g4 += __shfl_xor(g4, 1); g4 += __shfl_xor(g4, 2); e3 += __shfl_xor(e3, 1); e3 += __shfl_xor(e3, 2);
          if (h == 0) { const int s = (step_ * 64 + kh * 32 + 8 * gi + 4 * hh) >> 2; IMP[qi * AT_IMPS + s] = g4; EE[qi * AT_IMPS + s] = e3; }
      } });
    const float gc = gates(0);
#pragma unroll
    for (int i = 0; i < 16; ++i) { p0[i] = otg(i); p1[i] = otg(16 + i); }
    __builtin_amdgcn_sched_barrier(0);
#pragma unroll
    for (int i = 0; i < 16; ++i) { otg(i) = p0[i] + S.o0[i] * gc; otg(16 + i) = p1[i] + S.o1[i] * gc; }
  }
  }
  const bf16_t* kps = (const bf16_t*)(P.ws + WS_KSF) + (size_t)((b * 4 + g) * 128) * 4096; const bf16_t* vps = vT + (size_t)((b * 4 + g) * 128) * 4096;
  if (c <= 15) { AT_IDS; QF_LOAD();
    st_init(S);
    if (c > 0) {
      SWEEPF(0, c, {
        AT_QKV();
        at_online<0>(S, p0, p1, 0, 0, 0, true, hh);
        at_pv(vfr, p0, p1, S.o0, S.o1); });
    }
    SWEEPF(c, 1, {
      AT_QKV();
      at_online<1>(S, p0, p1, (c + step_) * 64, 0, t, true, hh);
      at_pv(vfr, p0, p1, S.o0, S.o1); });
    const float lt = S.l + __shfl_xor(S.l, 32); const float slc_sc = lt > 0.f ? gates(16) / lt : 0.f;
    bf16_t* op = attn + (tok * DM + (g * 4 + h) * 64);
#pragma unroll
    for (int i = 0; i < 16; ++i) { S.o0[i] = S.o0[i] * slc_sc + otg(i); S.o1[i] = S.o1[i] * slc_sc + otg(16 + i); }
#pragma unroll
    for (int gi = 0; gi < 4; ++gi) {
      u32x2 a; a.x = pk2(S.o0[4 * gi], S.o0[4 * gi + 1]); a.y = pk2(S.o0[4 * gi + 2], S.o0[4 * gi + 3]);
      u32x2 bq; bq.x = pk2(S.o1[4 * gi], S.o1[4 * gi + 1]); bq.y = pk2(S.o1[4 * gi + 2], S.o1[4 * gi + 3]);
      *(u32x2*)(op + 8 * gi + 4 * hh) = a; *(u32x2*)(op + 32 + 8 * gi + 4 * hh) = bq;
    }
  } else {
    const int nc = c - 2;
    unsigned char* QL = lds + AT_QL; int* NJ = (int*)(lds + AT_NJ); unsigned short* ITEMS = (unsigned short*)(lds + AT_ITEMS); int* MISC = (int*)(lds + AT_MISC);
    float* MREF = (float*)(lds + AT_MREF); float* LS = (float*)(lds + AT_LACC); unsigned char* INVQ = lds + AT_INVQ; unsigned char* SLOT = lds + AT_IMP;
    float* const LOWN = (float*)(lds + AT_LOWN); const float k64 = 5.421010862427522e-20f;
    { AT_IDS;
    { const int q = tid >> 3; for (int s = 1 + (tid & 7); s <= nc; s += 8) IMP[q * AT_IMPS + s] += EE[q * AT_IMPS + s - 1]; }
    if (tid < 256) SEL[tid] = 0u;
    if (tid < 128) ((unsigned*)INVQ)[tid] = 0u;
    __syncthreads();
    {
      const int q = tid >> 3, sub = tid & 7; const float* ip = IMP + q * AT_IMPS;
      unsigned key[16];
#pragma unroll
      for (int k = 0; k < 16; ++k) { const int s = 1 + sub + 8 * k; key[k] = s <= nc ? __float_as_uint(ip[s]) + 1u : 0u; }
      unsigned T = 0u;
      for (int bit = 30; bit >= 0; --bit) {
        const unsigned cand = T | (1u << bit); int cn = 0;
#pragma unroll
        for (int k = 0; k < 16; ++k) cn += key[k] >= cand ? 1 : 0;
        cn += __shfl_xor(cn, 1); cn += __shfl_xor(cn, 2); cn += __shfl_xor(cn, 4);
        if (cn >= 13) T = cand;
      }
      int ngt = 0, neq = 0;
#pragma unroll
      for (int k = 0; k < 16; ++k) { ngt += key[k] > T ? 1 : 0; neq += key[k] == T ? 1 : 0; }
      ngt += __shfl_xor(ngt, 1); ngt += __shfl_xor(ngt, 2); ngt += __shfl_xor(ngt, 4);
      neq += __shfl_xor(neq, 1); neq += __shfl_xor(neq, 2); neq += __shfl_xor(neq, 4);
      const int need = 13 - ngt;
      unsigned w0 = 0u, w1 = 0u, w2 = 0u, w3 = 0u;
      if (!__any(neq > need)) {
#pragma unroll
        for (int k = 0; k < 16; ++k) if (key[k] >= T && key[k] != 0u) { const int s = 1 + sub + 8 * k; const unsigned bt = 1u << (s & 31); if (s < 32) w0 |= bt; else if (s < 64) w1 |= bt; else if (s < 96) w2 |= bt; else w3 |= bt; }
      } else {
        int taken = 0; const int gsh = lane & ~7;
#pragma unroll
        for (int k = 0; k < 16; ++k) {
          const bool eq = key[k] == T && key[k] != 0u; const unsigned long long mk = __ballot(eq);
          const unsigned grp = (unsigned)(mk >> gsh) & 0xffu; const int before = __popc(grp & ((1u << sub) - 1u));
          const bool pick = key[k] > T || (eq && taken + before < need);
          taken += __popc(grp);
          if (pick) { const int s = 1 + sub + 8 * k; const unsigned bt = 1u << (s & 31); if (s < 32) w0 |= bt; else if (s < 64) w1 |= bt; else if (s < 96) w2 |= bt; else w3 |= bt; }
        }
      }
      if (w0) atomicOr(&SEL[q * 4], w0); if (w1) atomicOr(&SEL[q * 4 + 1], w1); if (w2) atomicOr(&SEL[q * 4 + 2], w2); if (w3) atomicOr(&SEL[q * 4 + 3], w3);
    }
    __syncthreads();
    for (int j = 1 + w; j <= nc; j += NWAVE) {
      const bool bit = (SEL[lane * 4 + (j >> 5)] >> (j & 31)) & 1u;
      const unsigned long long mk = __ballot(bit);
      const int rank = __builtin_amdgcn_mbcnt_hi((unsigned)(mk >> 32), __builtin_amdgcn_mbcnt_lo((unsigned)mk, 0u));
      if (bit) QL[j * 64 + rank] = (unsigned char)lane;
      const int cnt = __popcll(mk);
      if (lane < ((8 - (cnt & 7)) & 7)) QL[j * 64 + cnt + lane] = 0;
      if (lane == 0) NJ[j] = cnt;
    }
    __syncthreads();
    if (w == 0) {
      const int ja = 1 + lane, jb = 65 + lane;
      const int ca = ja <= nc ? (NJ[ja] + 7) >> 3 : 0, cb = jb <= nc ? (NJ[jb] + 7) >> 3 : 0;
      int sa = ca, sb = cb;
#pragma unroll
      for (int o = 1; o < 64; o <<= 1) { const int ta = __shfl_up(sa, o), tb = __shfl_up(sb, o); if (lane >= o) { sa += ta; sb += tb; } }
      const int tota = __shfl(sa, 63);
      for (int k = 0; k < ca; ++k) ITEMS[sa - ca + k] = (unsigned short)(ja * 8 + k);
      for (int k = 0; k < cb; ++k) ITEMS[tota + sb - cb + k] = (unsigned short)(jb * 8 + k);
      if (lane == 63) MISC[0] = tota + sb;
    }
    }
    { AT_IDS; QF_LOAD();
    st_init(S);
    SWEEPF(0, 1, {
      AT_QKV();
      at_online<0>(S, p0, p1, 0, 0, 0, true, hh);
      at_pv(vfr, p0, p1, S.o0, S.o1); });
    SWEEPF(c - 1, 2, {
      AT_QKV();
      if (step_ == 1) at_online<1>(S, p0, p1, c * 64, 0, t, true, hh); else at_online<0>(S, p0, p1, 0, 0, 0, true, hh);
      at_pv(vfr, p0, p1, S.o0, S.o1); });
    { const float lt = S.l + __shfl_xor(S.l, 32);
      if (hh == 0) { MREF[qrow] = S.m + 64.f; LS[w * 32 + r] = lt * k64; } }
#define SLOT_WRITE(x, o0_, o1_, scale_) do { unsigned char* sp_ = SLOT + (x) * 8192 + r * 256; \
      _Pragma("unroll") for (int gi_ = 0; gi_ < 4; ++gi_) { \
        const f32x4 va_ = {o0_[4 * gi_] * (scale_), o0_[4 * gi_ + 1] * (scale_), o0_[4 * gi_ + 2] * (scale_), o0_[4 * gi_ + 3] * (scale_)}; \
        const f32x4 vb_ = {o1_[4 * gi_] * (scale_), o1_[4 * gi_ + 1] * (scale_), o1_[4 * gi_ + 2] * (scale_), o1_[4 * gi_ + 3] * (scale_)}; \
        *(f32x4*)(sp_ + (((2 * gi_ + hh) ^ (r & 15)) * 16)) = va_; *(f32x4*)(sp_ + (((8 + 2 * gi_ + hh) ^ (r & 15)) * 16)) = vb_; } } while (0)
#define SLOT_READ(x, col_) (*(const f32x4*)(SLOT + (x) * 8192 + (col_) * 256 + ((ach ^ ((col_) & 15)) * 16)))
    SLOT_WRITE(w, S.o0, S.o1, k64);
    __syncthreads();
    }
    {
      AT_IDS; const int wu = __builtin_amdgcn_readfirstlane(w);
      const int nitems = MISC[0], nrounds = (nitems + 3) >> 2;
      if (wu >= 4) {
        const int ow = wu - 4, oq = lane >> 2, oh = lane & 3, srcslot = 2 * ow + (lane >> 5), scol = lane & 31;
        f32x4 acc[16]; float accl;
        { const unsigned char* rp = SLOT + srcslot * 8192 + scol * 256;
#pragma unroll
          for (int k = 0; k < 16; ++k) acc[k] = *(const f32x4*)(rp + ((k ^ (scol & 15)) * 16));
          accl = LS[srcslot * 32 + scol]; }
        __syncthreads();
        for (int rd = 0; rd <= nrounds; ++rd) {
          if (rd > 0) {
            const int set = (rd - 1) & 1;
            unsigned* ivp = (unsigned*)(INVQ + set * 256) + 16 * ow + oq;
            unsigned iv = *ivp;
            if (__any(iv != 0u)) {
              if (iv != 0u && oh == 0) *ivp = 0u;
              do {
                const int x = (iv & 0xffu) ? 0 : (iv & 0xff00u) ? 1 : (iv & 0xff0000u) ? 2 : 3;
                const unsigned byte = (iv >> (8 * x)) & 0xffu;
                iv &= ~(0xffu << (8 * x));
                if (byte) {
                  const int col = (int)(byte - 1) * 4 + oh;
                  const unsigned char* rp = SLOT + (set * 4 + x) * 8192 + col * 256;
                  f32x4 tq[16];
#pragma unroll
                  for (int k = 0; k < 16; ++k) tq[k] = *(const f32x4*)(rp + ((k ^ (col & 15)) * 16));
                  const float tl = LS[(set * 4 + x) * 32 + col];
                  __builtin_amdgcn_sched_barrier(0);
#pragma unroll
                  for (int k = 0; k < 16; ++k) acc[k] += tq[k];
                  accl += tl;
                }
              } while (__any(iv != 0u));
            }
          }
          __syncthreads();
        }
#pragma unroll
        for (int i = 0; i < 16; ++i) { S.o0[i] = otg(i); S.o1[i] = otg(16 + i); }
        SLOT_WRITE(w, S.o0, S.o1, 1.0f);
        __syncthreads();
        {
          const unsigned tq = (unsigned)b * SEQ + 64 * c + 16 * ow + oq;
          const float gs = gbase[tq * 48 + 16 + g * 4 + oh]; const float sc = accl > 0.f ? gs / accl : 0.f;
          const unsigned char* rp = SLOT + srcslot * 8192 + scol * 256;
          bf16_t* op = attn + (tq * DM + (g * 4 + oh) * 64);
#pragma unroll
          for (int k2 = 0; k2 < 8; ++k2) {
            const f32x4 v0 = acc[2 * k2] * sc + *(const f32x4*)(rp + (((2 * k2) ^ (scol & 15)) * 16)), v1 = acc[2 * k2 + 1] * sc + *(const f32x4*)(rp + (((2 * k2 + 1) ^ (scol & 15)) * 16));
            u32x4 o; o.x = pk2(v0.x, v0.y); o.y = pk2(v0.z, v0.w); o.z = pk2(v1.x, v1.y); o.w = pk2(v1.z, v1.w);
            *(u32x4*)(op + 8 * k2) = o;
          }
        }
      } else {
        __syncthreads();
        const bf16_t* kgl = kps + lane * 8; const bf16_t* vgl = vps + lane * 8;
        bf16x8 kfA[8], vfA[8], kfB[8], vfB[8];
#define FLOAD(KF, VF, jj) do { _Pragma("unroll") for (int f_ = 0; f_ < 8; ++f_) { KF[f_] = *(const bf16x8*)(kgl + (size_t)(jj) * 4096 + f_ * 512); VF[f_] = *(const bf16x8*)(vgl + (size_t)(jj) * 4096 + f_ * 512); } } while (0)
        int rowc = 0, qqc = 0; bool validc = false; float mrc = 1e30f; int en = 0;
        if (wu < nitems) { const int e0 = ITEMS[wu]; const int j0_ = e0 >> 3; const int qs_ = 8 * (e0 & 7) + (r >> 2); validc = qs_ < NJ[j0_]; qqc = QL[j0_ * 64 + qs_]; rowc = qqc * 4 + h; mrc = validc ? MREF[rowc] : 1e30f; FLOAD(kfA, vfA, j0_); }
        if (wu + 4 < nitems) en = __builtin_amdgcn_readfirstlane(ITEMS[wu + 4]);
        FLOAD(kfB, vfB, en >> 3);
#define ITEM_ROUND(KF, VF, rd_) do { \
          const int it = (rd_) * 4 + wu, set = (rd_) & 1; \
          if (it < nitems) { \
            const bool hasn = it + 4 < nitems; \
            const int jn = en >> 3, qsn = 8 * (en & 7) + (r >> 2);        \
            bf16x8 qv[4];                                               \
            _Pragma("unroll") for (int ds = 0; ds < 4; ++ds) qv[ds] = *(const bf16x8*)(lds + AT_QS + rowc * 128 + (((ds * 2 + hh) ^ (rowc & 7)) * 16)); \
            const int njn = NJ[jn]; const int qqn = QL[jn * 64 + qsn]; \
            const int en2 = it + 8 < nitems ? __builtin_amdgcn_readfirstlane(ITEMS[it + 8]) : 0; const int j2 = en2 >> 3; \
            __builtin_amdgcn_sched_barrier(0); \
            const f32x16 z = {0.f, 0.f, 0.f, 0.f, 0.f, 0.f, 0.f, 0.f, 0.f, 0.f, 0.f, 0.f, 0.f, 0.f, 0.f, 0.f}; \
            _Pragma("unroll") for (int ds = 0; ds < 4; ++ds) { \
              if (ds == 0) { p0 = MFMA32(KF[0], qv[0], z); p1 = MFMA32(KF[4], qv[0], z); } else { p0 = MFMA32(KF[ds], qv[ds], p0); p1 = MFMA32(KF[4 + ds], qv[ds], p1); } \
            } \
            const bool validn = hasn && qsn < njn; const int rown = qqn * 4 + h; \
            const float mrn = validn ? MREF[rown] : 1e30f; \
            float rs = 0.f; \
            _Pragma("unroll") for (int i = 0; i < 16; ++i) { \
              p0[i] = __builtin_amdgcn_exp2f(fminf(p0[i] - mrc, 120.f)); p1[i] = __builtin_amdgcn_exp2f(fminf(p1[i] - mrc, 120.f)); rs += p0[i] + p1[i]; \
              if (i & 1) { KF[i >> 1] = *(const bf16x8*)(kgl + (size_t)j2 * 4096 + (i >> 1) * 512); __builtin_amdgcn_sched_barrier(0); } \
            } \
            rs += __shfl_xor(rs, 32); \
            f32x16 o0 = z, o1 = z; \
            _Pragma("unroll") for (int gk = 0; gk < 4; ++gk) { const bf16x8 pb = (gk < 2) ? pack8(p0, gk & 1) : pack8(p1, gk & 1); o0 = MFMA32(VF[gk], pb, o0); o1 = MFMA32(VF[4 + gk], pb, o1); } \
            { unsigned char* sp_ = SLOT + (set * 4 + wu) * 8192 + r * 256; \
              _Pragma("unroll") for (int gi = 0; gi < 4; ++gi) { \
                const f32x4 va_ = {o0[4 * gi], o0[4 * gi + 1], o0[4 * gi + 2], o0[4 * gi + 3]}; const f32x4 vb_ = {o1[4 * gi], o1[4 * gi + 1], o1[4 * gi + 2], o1[4 * gi + 3]}; \
                *(f32x4*)(sp_ + (((2 * gi + hh) ^ (r & 15)) * 16)) = va_; *(f32x4*)(sp_ + (((8 + 2 * gi + hh) ^ (r & 15)) * 16)) = vb_; \
                VF[2 * gi] = *(const bf16x8*)(vgl + (size_t)j2 * 4096 + (2 * gi) * 512); VF[2 * gi + 1] = *(const bf16x8*)(vgl + (size_t)j2 * 4096 + (2 * gi + 1) * 512); \
                __builtin_amdgcn_sched_barrier(0); \
              } } \
            if (hh == 0) LS[(set * 4 + wu) * 32 + r] = rs; \
            if (validc && h == 0 && hh == 0) INVQ[set * 256 + qqc * 4 + wu] = (unsigned char)((r >> 2) + 1); \
            rowc = rown; qqc = qqn; validc = validn; mrc = mrn; en = en2; \
          } } while (0)
        for (int rd = 0; rd < nrounds; rd += 2) {
          ITEM_ROUND(kfA, vfA, rd);
          __syncthreads();
          if (rd + 1 < nrounds) {
            ITEM_ROUND(kfB, vfB, rd + 1);
            __syncthreads();
          }
        }
#undef ITEM_ROUND
#undef FLOAD
#undef ITEM_META
#undef KLOAD
#undef VLOAD
        __syncthreads();
#pragma unroll
        for (int i = 0; i < 16; ++i) { S.o0[i] = otg(i); S.o1[i] = otg(16 + i); }
        SLOT_WRITE(w, S.o0, S.o1, 1.0f);
        __syncthreads();
      }
    }
#undef SLOT_WRITE
#undef SLOT_READ
  }
  __syncthreads();
#undef ST_LOAD
#undef ST_STORE
#undef SWEEP
#undef ST_LOADF
#undef ST_STOREF
#undef SWEEPF
#undef gates
#undef otg
#undef QF_LOAD
#undef AT_QKV
#undef AT_IDS
}
DI void phase_attn(const Params& P_, unsigned char* lds) {
  Params P = P_; { size_t z_ = 0; asm volatile("" : "+s"(z_)); P.ws = P_.ws + z_; }
  const int G = gridDim.x, bx = obid();
  const int vcu = (G % 8 == 0) ? (bx % 8) * (G / 8) + bx / 8 : bx;
  for (int idx = vcu; idx < 1024; idx += G) {
    const int i = idx >> 8, v = idx & 255, bg = v >> 5, s = v & 31;
    const int c = i == 0 ? s : i == 1 ? 63 - s : i == 2 ? 64 + s : 127 - s;
    attn_tile(P, lds, bg >> 2, bg & 3, c);
  }
}


#define LAS __attribute__((address_space(3)))
#define XB_TMO      128
#define XB_XCNT(j)  (256  + 64 * (j))
#define XB_XSUB(j)  (1280 + 64 * (j))
#define XB_XGEN(j)  (2304 + 64 * (j))
#define XB_TOP      3328
#define XB_TOPGEN   3392
#define XCD_BAR_WORDS 3456
#define XB_SPIN_CAP (1u << 18)
__device__ __forceinline__ unsigned xb_ld(unsigned* p)              { return __hip_atomic_load(p, __ATOMIC_RELAXED, __HIP_MEMORY_SCOPE_AGENT); }
__device__ __forceinline__ unsigned xb_add(unsigned* p, unsigned v) { return __hip_atomic_fetch_add(p, v, __ATOMIC_RELAXED, __HIP_MEMORY_SCOPE_AGENT); }
__device__ __forceinline__ unsigned xb_xcc_id() { return (unsigned)__builtin_amdgcn_s_getreg((3 << 11) | 20) & 0xFu; }
#define XB_SPIN(cond, bar) do { unsigned _sp = 0; while (cond) { __builtin_amdgcn_s_sleep(1); \
    if ((++_sp & 255u) == 0u) { if (xb_ld(&(bar)[XB_TMO])) break; if (_sp > XB_SPIN_CAP) { atomicAdd(&(bar)[XB_TMO], 1u); break; } } } } while (0)
struct XcdBarrier { unsigned* bar; unsigned x; volatile LAS unsigned* st; };
__device__ __forceinline__ XcdBarrier xcd_barrier_post(unsigned* bar, volatile LAS unsigned* st) {
    XcdBarrier b; b.bar = bar; b.x = xb_xcc_id(); b.st = st;
    if (threadIdx.x == 0) (void)xb_add(&bar[XB_XCNT(b.x)], 1u);
    return b;
}
__device__ __forceinline__ void xcd_barrier_complete(unsigned* bar, unsigned x, unsigned& nloc, unsigned& nx) {
    const unsigned G = gridDim.x * gridDim.y * gridDim.z;
    unsigned sum, cnt, mine, sp = 0u;
    for (;;) {
        sum = 0u; cnt = 0u; mine = 0u;
#pragma unroll
        for (unsigned j = 0; j < 16; ++j) { const unsigned c = xb_ld(&bar[XB_XCNT(j)]); sum += c; cnt += (c > 0u) ? 1u : 0u; mine = (j == x) ? c : mine; }
        if (sum == G) break;
        __builtin_amdgcn_s_sleep(1);
        if ((++sp & 255u) == 0u) { if (xb_ld(&bar[XB_TMO])) break; if (sp > XB_SPIN_CAP) { atomicAdd(&bar[XB_TMO], 1u); break; } }
    }
    nloc = mine > 0u ? mine : 1u; nx = cnt > 0u ? cnt : 1u;
}
__device__ __forceinline__ void xcd_barrier(const XcdBarrier& b) {
    asm volatile("s_waitcnt vmcnt(0)" ::: "memory");
    __syncthreads();
    if (threadIdx.x == 0) {
        unsigned* bar = b.bar; { size_t z_ = 0; asm volatile("" : "+s"(z_)); bar += z_; }
        __builtin_amdgcn_s_waitcnt(0);
        unsigned nloc = b.st[0], nx = b.st[1];
        if (nloc == 0u) { xcd_barrier_complete(bar, b.x, nloc, nx); b.st[0] = nloc; b.st[1] = nx; }
        const unsigned old = xb_add(&bar[XB_XSUB(b.x)], 1u);
        const unsigned gen = old / nloc;
        if (old + 1u == (gen + 1u) * nloc) {
            __builtin_amdgcn_fence(__ATOMIC_RELEASE, "agent");
            asm volatile("s_waitcnt vmcnt(0)" ::: "memory");
            const unsigned og = xb_add(&bar[XB_TOP], 1u);
            const unsigned tg = og / nx;
            if (og + 1u == (tg + 1u) * nx) xb_add(&bar[XB_TOPGEN], 1u);
            else XB_SPIN(xb_ld(&bar[XB_TOPGEN]) == tg, bar);
            __builtin_amdgcn_fence(__ATOMIC_ACQUIRE, "agent");
            xb_add(&bar[XB_XGEN(b.x)], 1u);
            asm volatile("s_waitcnt vmcnt(0)" ::: "memory");
        } else {
            XB_SPIN(xb_ld(&bar[XB_XGEN(b.x)]) == gen, bar);
            __builtin_amdgcn_fence(__ATOMIC_ACQUIRE, "agent");
            asm volatile("s_waitcnt vmcnt(0)" ::: "memory");
        }
    }
    __syncthreads();
}

__global__ void __launch_bounds__(NTHR) fwd_kernel(Params P) {
  extern __shared__ __attribute__((aligned(16))) unsigned char lds[];
  cg::grid_group grid = cg::this_grid();
  const int gtid = blockIdx.x * NTHR + threadIdx.x;
  if (threadIdx.x < 4) ((unsigned*)(lds + LDS_BYTES - 16))[threadIdx.x] = 0u;
  __syncthreads();
  const XcdBarrier xbar = xcd_barrier_post((unsigned*)(P.ws + WS_BAR), (volatile LAS unsigned*)(lds + LDS_BYTES - 16));
#define GSYNC() xcd_barrier(xbar)
  s5_params(P, gtid);
  {
    float* modb = (float*)(P.ws + WS_MOD); float* cbb = (float*)(P.ws + WS_CB);
    for (int it = blockIdx.x; it < 192 + 16; it += gridDim.x) {
      if (it < 192) { const int l = it / 96, j0 = (it % 96) * 64;
        gemv_item((float*)lds, P.in[2] + (size_t)l * DM * 6144, DM, 6144, j0, P.in[1], P.in[1] + DM, true, P.in[3] + l * 6144, modb + (size_t)(l * 2) * 6144, modb + (size_t)(l * 2 + 1) * 6144);
      } else { const int r = it - 192, l = r >> 3, kv = (r >> 2) & 1, j0 = (r & 3) * 64;
        gemv_item((float*)lds, P.in[17] + (size_t)(l * 2 + kv) * 2048 * 256, 2048, 256, j0, P.in[16] + (size_t)(l * 2 + kv) * 2048, nullptr, false, nullptr, cbb + (l * 2 + kv) * 256, nullptr);
      }
    }
  }
  for (int it = blockIdx.x; it < DEPTH * 32 * 6; it += gridDim.x) s5_tables(P, it / 192, (it % 192) / 6, it % 6, lds);
  convert_weights(P, 0, lds);
  grid.sync();
  for (int l = 0; l < DEPTH; ++l) {
    if (l == 0) norm_simple<0>(P, l); else { norm_simple<1>(P, l); convert_weights(P, 1, lds); }
    GSYNC();
#if EN_MIXER
    phase_inproj8(P, lds);
    GSYNC();
    phase_s5a(P, l, lds);
    __syncthreads();
#if EN_ATTN
    phase_gates(P, lds);
    __syncthreads();
    phase_cmp1(P, l, lds);
#endif
    GSYNC();
    s5_carry(P, l);
#if EN_ATTN
    phase_cmp2(P, lds);
#endif
    GSYNC();
#if EN_ATTN
    phase_attn(P, lds);
    __syncthreads();
#endif
    phase_s5c(P, l, lds);
    GSYNC();
    phase_glu(P, lds);
    GSYNC();
    phase_merge8(P, lds);
    GSYNC();
    phase_wout8(P, l, lds);
    GSYNC();
#else
    if (l == 0) { for (size_t i = (size_t)gtid * 4; i < (size_t)NT * DM; i += (size_t)gridDim.x * NTHR * 4) *(f32x4*)(P.out + i) = *(const f32x4*)(P.in[0] + i); GSYNC(); }
#endif
#if EN_MOE
    norm_route(P, l, lds);
    GSYNC();
    phase_moe1(P, l, lds);
    GSYNC();
    phase_moe2(P, l, lds);
    GSYNC();
#endif
  }
  norm_simple<3>(P, 0);
}

extern "C" void kernel_launch(void* const* d_in, const int* in_sizes, int n_in, void* d_out, int out_size, void* d_ws, size_t ws_size, hipStream_t stream) {
  static int grid = 0;
  if (grid == 0) {
    if (n_in != 30 || out_size != NT * DM || ws_size < WS_END2) { fprintf(stderr, "kernel_launch: unexpected shapes (n_in %d out %d ws %zu need %zu)\n", n_in, out_size, ws_size, (size_t)WS_END2); grid = -1; return; }
    int dev = 0, cus = 0, per_cu = 0;
    hipGetDevice(&dev);
    hipDeviceGetAttribute(&cus, hipDeviceAttributeMultiprocessorCount, dev);
    hipFuncSetAttribute((const void*)fwd_kernel, hipFuncAttributeMaxDynamicSharedMemorySize, LDS_BYTES);
    hipOccupancyMaxActiveBlocksPerMultiprocessor(&per_cu, (const void*)fwd_kernel, NTHR, LDS_BYTES);
    if (per_cu < 1) { fprintf(stderr, "kernel_launch: occupancy query says %d blocks/CU\n", per_cu); per_cu = 1; }
    grid = cus;
    (void)hipGetLastError();
  }
  if (grid < 0) return;
  Params p{};
  for (int i = 0; i < 30; ++i) p.in[i] = (const float*)d_in[i];
  p.out = (float*)d_out; p.ws = (unsigned char*)d_ws;
  if (hipMemsetAsync(p.ws, 0, WS_ZERO_BYTES, stream) != hipSuccess) { fprintf(stderr, "kernel_launch: memset failed\n"); return; }
  void* args[] = {&p};
  hipError_t e = hipLaunchCooperativeKernel((const void*)fwd_kernel, dim3(grid), dim3(NTHR), args, LDS_BYTES, stream);
  if (e != hipSuccess) fprintf(stderr, "cooperative launch failed: %s (grid %d)\n", hipGetErrorString(e), grid);
}
```

```cpp
#include <hip/hip_runtime.h>
#include <hip/hip_cooperative_groups.h>
#include <cstdio>
#include <cstdint>
namespace cg = cooperative_groups;

#ifndef EN_MIXER
#define EN_MIXER 1
#endif
#ifndef EN_ATTN
#define EN_ATTN 1
#endif
#ifndef EN_MOE
#define EN_MOE 1
#endif

#define DI __device__ __forceinline__
typedef unsigned short bf16_t;
typedef short bf16x8 __attribute__((ext_vector_type(8)));
typedef short s16x4 __attribute__((ext_vector_type(4)));
typedef float f32x4 __attribute__((ext_vector_type(4)));
typedef float f32x16 __attribute__((ext_vector_type(16)));
typedef unsigned u32x4 __attribute__((ext_vector_type(4)));
typedef unsigned u32x2 __attribute__((ext_vector_type(2)));

constexpr int DM = 1024, NB = 2, SEQ = 8192, NT = NB * SEQ, DEPTH = 2;
constexpr int INW = 5168, INWP = 5376;
constexpr int NTHR = 512, NWAVE = 8;
constexpr int NEXP = 32, LISTCAP = 16384;
constexpr float EPS = 1e-6f;
constexpr float QSCALE = 0.125f * 1.4426950408889634f;

constexpr size_t MiB = 1u << 20;
constexpr size_t WS_CNT = 0;
constexpr size_t WS_BAR = 1024;
constexpr size_t WS_ZERO_BYTES = 16384;
constexpr size_t WS_MOD = 16384;
constexpr size_t WS_CB = WS_MOD + 2 * 2 * 6144 * 4;
constexpr size_t WS_S5P = WS_CB + 2 * 2 * 256 * 4;
constexpr size_t WS_WT = WS_S5P + 2 * 32 * 64 * 36 * 4;
constexpr size_t WS_SMALL_END = WS_WT + (size_t)NT * 2 * 4;
static_assert(WS_SMALL_END <= 1 * MiB, "small region");
constexpr size_t WS_W = 1 * MiB;
constexpr size_t W_IN = 0;
constexpr size_t W_GLU = W_IN + (size_t)INWP * 1024 * 2;
constexpr size_t W_O = W_GLU + 512 * 512 * 2;
constexpr size_t W_SO = W_O + 1024 * 1024 * 2;
constexpr size_t W_OUT = W_SO + 1024 * 512 * 2;
constexpr size_t W_C1 = W_OUT + 1024 * 1024 * 2;
constexpr size_t W_C2 = W_C1 + 2 * 256 * 2048 * 2;
constexpr size_t W_GU = W_C2 + 2 * 128 * 256 * 2;
constexpr size_t W_D = W_GU + (size_t)32 * 512 * 1024 * 2;
constexpr size_t W_END = W_D + (size_t)32 * 1024 * 256 * 2;
static_assert(W_END <= 67 * MiB, "weights region");
constexpr size_t WS_A = 68 * MiB;
constexpr size_t WS_B = WS_A + 32 * MiB;
constexpr size_t WS_C = WS_B + 32 * MiB;
constexpr size_t WS_DV = WS_C + 32 * MiB;
constexpr size_t WS_E = WS_DV + 16 * MiB;
constexpr size_t WS_F = WS_E + 32 * MiB;
constexpr size_t WS_G = WS_F + 64 * MiB;
constexpr size_t WS_GATES = WS_G + 16 * MiB;
constexpr size_t WS_HID = WS_GATES + 3 * MiB;
constexpr size_t WS_KC = WS_HID + 4 * MiB;
constexpr size_t WS_VC = WS_KC + 512 * 1024;
constexpr size_t WS_L = WS_VC + 512 * 1024;
constexpr size_t WS_LIST = WS_L + 4 * MiB;
constexpr size_t WS_OT = WS_LIST + 2 * MiB;
constexpr size_t WS_TAB = WS_OT + 16 * MiB;
constexpr size_t TAB_KT = 0, TAB_M1 = 1 * MiB, TAB_M2 = 9 * MiB, TAB_LAYER = 17 * MiB;
constexpr size_t WS_END = WS_TAB + 2 * TAB_LAYER;
constexpr size_t WS_KSF = WS_END;
constexpr size_t WS_END2 = WS_KSF + 8 * MiB;
constexpr size_t WS_SIN = WS_E + 16 * MiB;
constexpr int LDS_BYTES = 151552;

struct Params { const float* in[30]; float* out; unsigned char* ws; };

DI int otid() { int t = threadIdx.x; asm volatile("" : "+v"(t)); return t; }
DI int obid() { int t = blockIdx.x; asm volatile("" : "+s"(t)); return t; }
DI unsigned f2bf(float f) { unsigned u = __float_as_uint(f); return (u + 0x7fffu + ((u >> 16) & 1u)) >> 16; }
typedef float f32x2_t __attribute__((ext_vector_type(2))); typedef __bf16 bf16x2_t __attribute__((ext_vector_type(2)));
DI unsigned pk2(float lo, float hi) { const f32x2_t v = {lo, hi}; const bf16x2_t b = __builtin_convertvector(v, bf16x2_t); return __builtin_bit_cast(unsigned, b); }
DI float bflo(unsigned w) { return __uint_as_float(w << 16); }
DI float bfhi(unsigned w) { return __uint_as_float(w & 0xffff0000u); }
DI int perm16(int x) { return (x & ~12) | ((x & 4) << 1) | ((x & 8) >> 1); }
template <int CTRL> DI float dppf(float x) { return __builtin_bit_cast(float, __builtin_amdgcn_mov_dpp(__builtin_bit_cast(int, x), CTRL, 0xf, 0xf, true)); }
template <int CTRL> DI int dppi(int x) { return __builtin_amdgcn_mov_dpp(x, CTRL, 0xf, 0xf, true); }
constexpr int DPP_X1 = 0xB1, DPP_X2 = 0x4E, DPP_HM = 0x141, DPP_X8 = 0x128;
DI float x32_sum(float x) { auto t = __builtin_amdgcn_permlane32_swap(__float_as_uint(x), __float_as_uint(x), false, false); return __uint_as_float(t[0]) + __uint_as_float(t[1]); }
DI float x32_max(float x) { auto t = __builtin_amdgcn_permlane32_swap(__float_as_uint(x), __float_as_uint(x), false, false); return fmaxf(__uint_as_float(t[0]), __uint_as_float(t[1])); }
DI float x16_sum(float x) { auto t = __builtin_amdgcn_permlane16_swap(__float_as_uint(x), __float_as_uint(x), false, false); return __uint_as_float(t[0]) + __uint_as_float(t[1]); }
DI int sum8i(int v) { v += dppi<DPP_X1>(v); v += dppi<DPP_X2>(v); v += dppi<DPP_HM>(v); return v; }
DI float wave_sum(float v) {
  v += dppf<DPP_X1>(v); v += dppf<DPP_X2>(v); v += dppf<DPP_HM>(v); v += dppf<DPP_X8>(v);
  return x32_sum(x16_sum(v));
}
DI float sigmoidf_(float x) { return __builtin_amdgcn_rcpf(1.f + __expf(-x)); }
DI float gelu_tanh(float x) {
  const float z = 0.7978845608028654f * (x + 0.044715f * x * x * x);
  const float e = __expf(2.f * z);
  const float th = 1.f - 2.f * __builtin_amdgcn_rcpf(e + 1.f);
  return 0.5f * x * (1.f + th);
}
DI void sincos_d(double x, double& s, double& c) {
  const double k = rint(x * 0.6366197723675814);
  double r = fma(-k, 1.5707963267948966, x);
  r = fma(-k, 6.123233995736766e-17, r);
  const int q = ((int)k) & 3;
  const double r2 = r * r;
  const double sp = r * (1.0 + r2 * (-1.0 / 6 + r2 * (1.0 / 120 + r2 * (-1.0 / 5040 + r2 * (1.0 / 362880 + r2 * (-1.0 / 39916800 + r2 * (1.0 / 6227020800.0)))))));
  const double cp = 1.0 + r2 * (-0.5 + r2 * (1.0 / 24 + r2 * (-1.0 / 720 + r2 * (1.0 / 40320 + r2 * (-1.0 / 3628800 + r2 * (1.0 / 479001600 + r2 * (-1.0 / 87178291200.0)))))));
  s = (q == 0) ? sp : (q == 1) ? cp : (q == 2) ? -sp : -cp;
  c = (q == 0) ? cp : (q == 1) ? -sp : (q == 2) ? -cp : sp;
}

DI void gemv_item(float* lds, const float* W, int K, int N, int j0, const float* v0, const float* v1, bool do_silu, const float* bias, float* o0, float* o1) {
  const int tid = otid();
  float* sv = lds; float* red = lds + 4096;
  for (int k = tid; k < K; k += NTHR) {
    float a = v0[k], b = v1 ? v1[k] : 0.f;
    if (do_silu) { a = a / (1.f + expf(-a)); b = b / (1.f + expf(-b)); }
    sv[k] = a; sv[2048 + k] = b;
  }
  __syncthreads();
  const int jl = tid & 63, ks = tid >> 6, kper = K >> 3;
  const float* wp = W + (size_t)(ks * kper) * N + j0 + jl;
  float a0 = 0.f, a1 = 0.f;
#pragma unroll 8
  for (int k = 0; k < kper; ++k) { const float w = wp[(size_t)k * N]; a0 += sv[ks * kper + k] * w; a1 += sv[2048 + ks * kper + k] * w; }
  red[(ks * 64 + jl) * 2] = a0; red[(ks * 64 + jl) * 2 + 1] = a1;
  __syncthreads();
  if (tid < 64) {
    float s0 = 0.f, s1 = 0.f;
    for (int i = 0; i < 8; ++i) { s0 += red[(i * 64 + tid) * 2]; s1 += red[(i * 64 + tid) * 2 + 1]; }
    const float bb = bias ? bias[j0 + tid] : 0.f;
    o0[j0 + tid] = s0 + bb; if (o1) o1[j0 + tid] = s1 + bb;
  }
  __syncthreads();
}

DI void s5_params(const Params& P, int gtid) {
  if (gtid >= DEPTH * 32 * 64) return;
  const int l = gtid / 2048, g = (gtid / 64) % 32, p = gtid % 64;
  const float dt = expf(P.in[8][l * 32 + g]);
  const float lr = P.in[6][(l * 32 + g) * 64 + p], li = P.in[7][(l * 32 + g) * 64 + p];
  const float mag = expf(lr * dt); const float ang = li * dt;
  double sd, cd; sincos_d((double)ang, sd, cd);
  const float ab_re = mag * (float)cd, ab_im = mag * (float)sd;
  float* o = (float*)(P.ws + WS_S5P) + (size_t)((l * 32 + g) * 64 + p) * 36;
  o[0] = ab_re; o[1] = ab_im;
  double pr = ab_re, pi = ab_im;
  for (int i = 0; i < 6; ++i) { const double nr2 = pr * pr - pi * pi, ni2 = 2.0 * pr * pi; pr = nr2; pi = ni2; }
  o[2] = (float)pr; o[3] = (float)pi;
}

DI void s5_tables(const Params& P, int l, int g, int part, unsigned char* lds) {
  const int tid = otid(), lane = tid & 63;
  float* BBr = (float*)lds; float* BBi = BBr + 1024; float* CR = BBi + 1024; float* CI = CR + 1024;
  float* APr = CI + 1024; float* APi = APr + 65 * 64;
  bf16_t* tab = (bf16_t*)(P.ws + WS_TAB + (size_t)l * TAB_LAYER);
  bf16_t* Kt = tab + TAB_KT / 2 + (size_t)g * 64 * 256; bf16_t* M1 = tab + TAB_M1 / 2 + (size_t)g * 128 * 1024; bf16_t* M2 = tab + TAB_M2 / 2 + (size_t)g * 1024 * 128;
  __syncthreads();
  if (tid < 64) {
    const int p = tid;
    const float dt = expf(P.in[8][l * 32 + g]);
    const float lr = P.in[6][(l * 32 + g) * 64 + p], li = P.in[7][(l * 32 + g) * 64 + p];
    const float mag = expf(lr * dt); const float ang = li * dt;
    double sd, cd; sincos_d((double)ang, sd, cd);
    const float ab_re = mag * (float)cd, ab_im = mag * (float)sd;
    const float den = lr * lr + li * li, nr = ab_re - 1.0f;
    const float cr = (nr * lr + ab_im * li) / den, ci = (ab_im * lr - nr * li) / den;
    const float* br = P.in[9] + (size_t)((l * 32 + g) * 64 + p) * 16; const float* bi = P.in[10] + (size_t)((l * 32 + g) * 64 + p) * 16;
    for (int h = 0; h < 16; ++h) { BBr[p * 16 + h] = cr * br[h] - ci * bi[h]; BBi[p * 16 + h] = cr * bi[h] + ci * br[h]; }
    double pr = 1.0, pi = 0.0;
    for (int tau = 0; tau <= 64; ++tau) { APr[tau * 64 + p] = (float)pr; APi[tau * 64 + p] = (float)pi; const double n1 = pr * ab_re - pi * ab_im, n2 = pr * ab_im + pi * ab_re; pr = n1; pi = n2; }
  }
  for (int i = tid; i < 1024; i += NTHR) { CR[i] = P.in[11][(size_t)(l * 32 + g) * 1024 + i]; CI[i] = P.in[12][(size_t)(l * 32 + g) * 1024 + i]; }
  __syncthreads();
  if (part < 4)
  for (int task = part * 256 + tid; task < part * 256 + 256; task += NTHR) {
    const int tau = task >> 4, h = task & 15;
    float a[16];
#pragma unroll
    for (int j = 0; j < 16; ++j) a[j] = 0.f;
    for (int p = 0; p < 64; ++p) {
      const float c_r = CR[h * 64 + p], c_i = CI[h * 64 + p], a_r = APr[tau * 64 + p], a_i = APi[tau * 64 + p];
      const float xr = c_r * a_r - c_i * a_i, xi = c_r * a_i + c_i * a_r;
#pragma unroll
      for (int j4 = 0; j4 < 4; ++j4) { const f32x4 b_r = *(const f32x4*)(BBr + p * 16 + 4 * j4), b_i = *(const f32x4*)(BBi + p * 16 + 4 * j4);
        a[4 * j4] += xr * b_r.x - xi * b_i.x; a[4 * j4 + 1] += xr * b_r.y - xi * b_i.y; a[4 * j4 + 2] += xr * b_r.z - xi * b_i.z; a[4 * j4 + 3] += xr * b_r.w - xi * b_i.w; }
    }
    u32x4 o0, o1; o0.x = pk2(a[0], a[1]); o0.y = pk2(a[2], a[3]); o0.z = pk2(a[4], a[5]); o0.w = pk2(a[6], a[7]); o1.x = pk2(a[8], a[9]); o1.y = pk2(a[10], a[11]); o1.z = pk2(a[12], a[13]); o1.w = pk2(a[14], a[15]);
    *(u32x4*)(Kt + (size_t)task * 16) = o0; *(u32x4*)(Kt + (size_t)task * 16 + 8) = o1;
  }
  if (part == 4)
  for (int task = tid; task < 4096; task += NTHR) {
    const int p = task >> 6, i = task & 63;
    const float a_r = APr[(63 - i) * 64 + p], a_i = APi[(63 - i) * 64 + p];
    float re[16], im[16];
#pragma unroll
    for (int j = 0; j < 16; ++j) { const float b_r = BBr[p * 16 + j], b_i = BBi[p * 16 + j]; re[j] = a_r * b_r - a_i * b_i; im[j] = a_r * b_i + a_i * b_r; }
    u32x4 o; bf16_t* d0 = M1 + (size_t)(2 * p) * 1024 + i * 16; bf16_t* d1 = d0 + 1024;
    o.x = pk2(re[0], re[1]); o.y = pk2(re[2], re[3]); o.z = pk2(re[4], re[5]); o.w = pk2(re[6], re[7]); *(u32x4*)d0 = o;
    o.x = pk2(re[8], re[9]); o.y = pk2(re[10], re[11]); o.z = pk2(re[12], re[13]); o.w = pk2(re[14], re[15]); *(u32x4*)(d0 + 8) = o;
    o.x = pk2(im[0], im[1]); o.y = pk2(im[2], im[3]); o.z = pk2(im[4], im[5]); o.w = pk2(im[6], im[7]); *(u32x4*)d1 = o;
    o.x = pk2(im[8], im[9]); o.y = pk2(im[10], im[11]); o.z = pk2(im[12], im[13]); o.w = pk2(im[14], im[15]); *(u32x4*)(d1 + 8) = o;
  }
  if (part == 5)
  for (int task = tid; task < 4096; task += NTHR) {
    const int th = task >> 2, pq = task & 3, t = th >> 4, h = th & 15;
    unsigned w[16];
#pragma unroll
    for (int j = 0; j < 16; ++j) { const int p = pq * 16 + j;
      const float c_r = CR[h * 64 + p], c_i = CI[h * 64 + p], a_r = APr[(t + 1) * 64 + p], a_i = APi[(t + 1) * 64 + p];
      w[j] = pk2(c_r * a_r - c_i * a_i, -(c_r * a_i + c_i * a_r)); }
    bf16_t* d = M2 + (size_t)th * 128 + pq * 32;
    *(u32x4*)d = (u32x4){w[0], w[1], w[2], w[3]}; *(u32x4*)(d + 8) = (u32x4){w[4], w[5], w[6], w[7]};
    *(u32x4*)(d + 16) = (u32x4){w[8], w[9], w[10], w[11]}; *(u32x4*)(d + 24) = (u32x4){w[12], w[13], w[14], w[15]};
  }
  __syncthreads();
}

struct ConvJob { const float* src; bf16_t* dst; int ldw, K, c0, ncols, nmat, ldd, drow0, mode; size_t sstride, dstride; };
DI int conv_nitems(const ConvJob& j) { return j.nmat * (j.K >> 6) * ((j.ncols + 31) >> 5); }
DI int conv_drow(int mode, int drow0, int n) { return mode == 0 ? drow0 + n : drow0 + ((n >> 6) * 128 + ((n >> 4) & 3) * 32 + (n & 15)); }
DI void conv_item(const ConvJob& jb, int item, float* scr, int lane) {
  const int nblk = (jb.ncols + 31) >> 5, per = (jb.K >> 6) * nblk;
  const int mat = item / per, r = item % per, kb = r / nblk, nb = r % nblk, k0 = 64 * kb, n0 = 32 * nb;
  const float* W = jb.src + (size_t)mat * jb.sstride; bf16_t* WT = jb.dst + (size_t)mat * jb.dstride;
  const int n4 = (lane & 7) * 4; const bool nok = (n0 + n4) < jb.ncols;
#pragma unroll
  for (int i = 0; i < 8; ++i) { const int kk = 8 * i + (lane >> 3);
    const f32x4 v = nok ? *(const f32x4*)(W + (size_t)(k0 + kk) * jb.ldw + jb.c0 + n0 + n4) : (f32x4){0.f, 0.f, 0.f, 0.f};
    *(f32x4*)(scr + kk * 36 + n4) = v; }
  asm volatile("s_waitcnt lgkmcnt(0)" ::: "memory");
  const int c = lane & 7;
#pragma unroll
  for (int j = 0; j < 4; ++j) {
    const int n = (lane >> 3) + 8 * j; const float* sp = scr + (8 * c) * 36 + n;
    u32x4 o; o.x = pk2(sp[0], sp[36]); o.y = pk2(sp[72], sp[108]); o.z = pk2(sp[144], sp[180]); o.w = pk2(sp[216], sp[252]);
    if (n0 + n < jb.ncols) *(u32x4*)(WT + (size_t)conv_drow(jb.mode, jb.drow0, n0 + n) * jb.ldd + k0 + 8 * c) = o;
  }
  asm volatile("s_waitcnt lgkmcnt(0)" ::: "memory");
}
DI ConvJob conv_job(const Params& P, int l, int j) {
  unsigned char* wb = P.ws + WS_W; ConvJob J; J.nmat = 1; J.mode = 0; J.sstride = 0; J.dstride = 0; J.drow0 = 0; J.c0 = 0;
  const float* win = P.in[5] + (size_t)l * 1024 * INW;
  if (j < 5) { J.src = win; J.ldw = INW; J.K = 1024; J.dst = (bf16_t*)(wb + W_IN); J.ldd = 1024;
    if (j == 0) { J.c0 = 0; J.ncols = 1024; J.drow0 = 0; }
    else if (j == 1) { J.c0 = 1024; J.ncols = 1536; J.drow0 = 1024; }
    else if (j == 2) { J.c0 = 3120; J.ncols = 2048; J.drow0 = 2560; }
    else if (j == 3) { J.c0 = 2608; J.ncols = 512; J.drow0 = 4608; }
    else { J.c0 = 2560; J.ncols = 48; J.drow0 = 5120; }
  } else if (j == 5) { J.src = P.in[14] + (size_t)l * 512 * 512; J.ldw = 512; J.K = 512; J.ncols = 512; J.dst = (bf16_t*)(wb + W_GLU); J.ldd = 512; }
  else if (j == 6) { J.src = P.in[19] + (size_t)l * 1024 * 1024; J.ldw = 1024; J.K = 1024; J.ncols = 1024; J.dst = (bf16_t*)(wb + W_O); J.ldd = 1024; }
  else if (j == 7) { J.src = P.in[15] + (size_t)l * 512 * 1024; J.ldw = 1024; J.K = 512; J.ncols = 1024; J.dst = (bf16_t*)(wb + W_SO); J.ldd = 512; }
  else if (j == 8) { J.src = P.in[20] + (size_t)l * 1024 * 1024; J.ldw = 1024; J.K = 1024; J.ncols = 1024; J.dst = (bf16_t*)(wb + W_OUT); J.ldd = 1024; }
  else if (j == 9) { J.src = P.in[17] + (size_t)l * 2 * 2048 * 256; J.ldw = 256; J.K = 2048; J.ncols = 256; J.nmat = 2; J.sstride = 2048 * 256; J.dstride = 256 * 2048; J.dst = (bf16_t*)(wb + W_C1); J.ldd = 2048; }
  else if (j == 10) { J.src = P.in[18] + (size_t)l * 2 * 256 * 64; J.ldw = 64; J.K = 256; J.ncols = 64; J.nmat = 2; J.sstride = 256 * 64; J.dstride = 128 * 256; J.dst = (bf16_t*)(wb + W_C2); J.ldd = 256; }
  else if (j == 11) { J.src = P.in[26] + (size_t)l * 32 * 1024 * 256; J.ldw = 256; J.K = 1024; J.ncols = 256; J.nmat = 32; J.sstride = 1024 * 256; J.dstride = 512 * 1024; J.dst = (bf16_t*)(wb + W_GU); J.ldd = 1024; J.mode = 1; J.drow0 = 0; }
  else if (j == 12) { J.src = P.in[27] + (size_t)l * 32 * 1024 * 256; J.ldw = 256; J.K = 1024; J.ncols = 256; J.nmat = 32; J.sstride = 1024 * 256; J.dstride = 512 * 1024; J.dst = (bf16_t*)(wb + W_GU); J.ldd = 1024; J.mode = 1; J.drow0 = 16; }
  else { J.src = P.in[28] + (size_t)l * 32 * 256 * 1024; J.ldw = 1024; J.K = 256; J.ncols = 1024; J.nmat = 32; J.sstride = 256 * 1024; J.dstride = 1024 * 256; J.dst = (bf16_t*)(wb + W_D); J.ldd = 256; }
  return J;
}
DI void convert_weights(const Params& P_, int l, unsigned char* lds) {
  Params P = P_; { size_t z_ = 0; asm volatile("" : "+s"(z_)); P.ws = P_.ws + z_; }
  const int tid_ = otid(), bid = obid(), wave = tid_ >> 6, lane = tid_ & 63; (void)bid;
  float* scr = (float*)lds + wave * (64 * 36);
  const int NGW = gridDim.x * NWAVE; int off = bid * NWAVE + wave;
  for (int j = 0; j < 14; ++j) {
    const ConvJob J = conv_job(P, l, j); const int n = conv_nitems(J);
    while (off < n) { conv_item(J, off, scr, lane); off += NGW; }
    off -= n;
  }
}

template <int MODE>
DI void norm_simple(const Params& P_, int l) {
  Params P = P_; { size_t z_ = 0; asm volatile("" : "+s"(z_)); P.ws = P_.ws + z_; }
  const int tid_ = otid(), bid = obid(), wave = tid_ >> 6, lane = tid_ & 63; (void)bid;
  const int NGW = gridDim.x * NWAVE;
  const float* mod = (const float*)(P.ws + WS_MOD);
  const bf16_t* ys = (const bf16_t*)(P.ws + WS_F);
  bf16_t* xn = (bf16_t*)(P.ws + WS_A);
  const float* xbase = MODE == 0 ? P.in[0] : P.out;
  constexpr bool ADDY = (MODE != 0) && EN_MOE;
  f32x4 g[4], sh[4], sc[4], gg[4]; int pb = -1;
  { const float* gp = MODE == 3 ? P.in[29] : P.in[4] + (size_t)l * DM;
#pragma unroll
    for (int j = 0; j < 4; ++j) g[j] = *(const f32x4*)(gp + 4 * lane + 256 * j); }
  f32x4 v[4]; u32x2 y0[4], y1[4];
#define NS_LOAD(vv, a0, a1, rr) do { const float* xr_ = xbase + (size_t)(rr) * DM; \
    _Pragma("unroll") for (int j = 0; j < 4; ++j) vv[j] = *(const f32x4*)(xr_ + 4 * lane + 256 * j); \
    if (ADDY) { _Pragma("unroll") for (int j = 0; j < 4; ++j) { a0[j] = *(const u32x2*)(ys + (size_t)((rr) * 2) * DM + 4 * lane + 256 * j); a1[j] = *(const u32x2*)(ys + (size_t)((rr) * 2 + 1) * DM + 4 * lane + 256 * j); } } } while (0)
  const int row0 = bid * NWAVE + wave;
  if (row0 < NT) NS_LOAD(v, y0, y1, row0);
  for (int row = row0; row < NT; row += NGW) {
    const int b = row >> 13;
    if (b != pb) { pb = b;
      if (ADDY) { const float* g2 = mod + (size_t)(((MODE == 1 ? 0 : 1) * 2 + b) * 6144) + 5120;
#pragma unroll
        for (int j = 0; j < 4; ++j) gg[j] = *(const f32x4*)(g2 + 4 * lane + 256 * j); }
      if (MODE != 3) { const float* md = mod + (size_t)((l * 2 + b) * 6144);
#pragma unroll
        for (int j = 0; j < 4; ++j) { sh[j] = *(const f32x4*)(md + 4 * lane + 256 * j); sc[j] = *(const f32x4*)(md + 1024 + 4 * lane + 256 * j); } }
    }
    f32x4 vn[4]; u32x2 y0n[4], y1n[4];
    if (row + NGW < NT) NS_LOAD(vn, y0n, y1n, row + NGW);
    __builtin_amdgcn_sched_barrier(0);
    if (ADDY) {
#pragma unroll
      for (int j = 0; j < 4; ++j) {
        v[j].x += gg[j].x * (bflo(y0[j].x) + bflo(y1[j].x)); v[j].y += gg[j].y * (bfhi(y0[j].x) + bfhi(y1[j].x));
        v[j].z += gg[j].z * (bflo(y0[j].y) + bflo(y1[j].y)); v[j].w += gg[j].w * (bfhi(y0[j].y) + bfhi(y1[j].y));
      }
    }
    float ss = 0.f;
#pragma unroll
    for (int j = 0; j < 4; ++j) ss += v[j].x * v[j].x + v[j].y * v[j].y + v[j].z * v[j].z + v[j].w * v[j].w;
    ss = wave_sum(ss);
    const float inv = rsqrtf(ss * (1.f / DM) + EPS);
    if (MODE == 3) {
#pragma unroll
      for (int j = 0; j < 4; ++j) { const int col = 4 * lane + 256 * j; *(f32x4*)(P.out + (size_t)row * DM + col) = v[j] * inv * g[j]; }
    } else {
      if (MODE == 1) {
#pragma unroll
        for (int j = 0; j < 4; ++j) *(f32x4*)(P.out + (size_t)row * DM + 4 * lane + 256 * j) = v[j];
      }
#pragma unroll
      for (int j = 0; j < 4; ++j) {
        const int col = 4 * lane + 256 * j;
        const f32x4 h = v[j] * inv * g[j] * (sc[j] + 1.f) + sh[j];
        u32x2 o; o.x = pk2(h.x, h.y); o.y = pk2(h.z, h.w);
        *(u32x2*)(xn + (size_t)row * DM + col) = o;
      }
    }
#pragma unroll
    for (int j = 0; j < 4; ++j) { v[j] = vn[j]; y0[j] = y0n[j]; y1[j] = y1n[j]; }
  }
#undef NS_LOAD
}

constexpr int RT_HS = 1028;
DI void norm_route(const Params& P_, int l, unsigned char* lds) {
  Params P = P_; { size_t z_ = 0; asm volatile("" : "+s"(z_)); P.ws = P_.ws + z_; }
  const int tid = otid(), bid = obid(), wave = tid >> 6, lane = tid & 63;
  const float* mod = (const float*)(P.ws + WS_MOD);
  bf16_t* h2 = (bf16_t*)(P.ws + WS_A);
  float* hs = (float*)lds;
  float* Wc = (float*)lds + 32 * RT_HS;
  const float* wg = P.in[22] + (size_t)l * DM * 4; const float* we = P.in[24] + (size_t)l * DM * 32;
  const float* bg = P.in[23] + l * 4; const float* be = P.in[25] + l * 32;
  int* cnt = (int*)(P.ws + WS_CNT) + l * 32; int* list = (int*)(P.ws + WS_LIST); float* wts = (float*)(P.ws + WS_WT);
  const int rg = wave >> 2, kq = wave & 3;
  for (int grp = bid; grp < NT / 32; grp += gridDim.x) {
    const int row0 = grp * 32 + wave * 4, b = row0 >> 13;
    const float* ng = P.in[21] + (size_t)l * DM; const float* md = mod + (size_t)((l * 2 + b) * 6144);
    {
      f32x4 v[4][4];
#pragma unroll
      for (int r = 0; r < 4; ++r)
#pragma unroll
        for (int j = 0; j < 4; ++j) v[r][j] = *(const f32x4*)(P.out + (size_t)(row0 + r) * DM + 4 * lane + 256 * j);
      float inv[4];
#pragma unroll
      for (int r = 0; r < 4; ++r) { float ss = 0.f;
#pragma unroll
        for (int j = 0; j < 4; ++j) ss += v[r][j].x * v[r][j].x + v[r][j].y * v[r][j].y + v[r][j].z * v[r][j].z + v[r][j].w * v[r][j].w;
        inv[r] = rsqrtf(wave_sum(ss) * (1.f / DM) + EPS); }
#pragma unroll
      for (int j = 0; j < 4; ++j) {
        const int col = 4 * lane + 256 * j;
        const f32x4 g = *(const f32x4*)(ng + col), sh = *(const f32x4*)(md + 3072 + col), sc = *(const f32x4*)(md + 4096 + col);
#pragma unroll
        for (int r = 0; r < 4; ++r) {
          const f32x4 hh = v[r][j] * inv[r] * g * (sc + 1.f) + sh;
          u32x2 o; o.x = pk2(hh.x, hh.y); o.y = pk2(hh.z, hh.w);
          *(u32x2*)(h2 + (size_t)(row0 + r) * DM + col) = o;
          *(f32x4*)(hs + (wave * 4 + r) * RT_HS + col) = hh;
        }
      }
    }
    f32x4 we0, we1, wg0 = {0.f, 0.f, 0.f, 0.f};
#define WLOAD(kc) do { we0 = *(const f32x4*)(we + (size_t)(kc) * 4096 + tid * 4); we1 = *(const f32x4*)(we + (size_t)(kc) * 4096 + 2048 + tid * 4); if (tid < 128) wg0 = *(const f32x4*)(wg + (size_t)(kc) * 512 + tid * 4); } while (0)
#define WSTORE() do { *(f32x4*)(Wc + (tid >> 3) * 36 + (tid & 7) * 4) = we0; *(f32x4*)(Wc + (64 + (tid >> 3)) * 36 + (tid & 7) * 4) = we1; if (tid < 128) *(f32x4*)(Wc + tid * 36 + 32) = wg0; } while (0)
    WLOAD(0);
    f32x4 acc0 = {0.f, 0.f, 0.f, 0.f}, acc1 = acc0, acc2 = acc0;
    for (int kc = 0; kc < 8; ++kc) {
      __syncthreads();
      WSTORE();
      if (kc + 1 < 8) WLOAD(kc + 1);
      __syncthreads();
      const float* ap = hs + (rg * 16 + (lane & 15)) * RT_HS + kc * 128 + kq * 32 + (lane >> 4);
      const float* bp = Wc + (kq * 32 + (lane >> 4)) * 36 + (lane & 15);
#pragma unroll
      for (int ks = 0; ks < 8; ++ks) {
        const float av = ap[4 * ks];
        const float b0 = bp[(4 * ks) * 36], b1 = bp[(4 * ks) * 36 + 16], b2 = (lane & 15) < 4 ? bp[(4 * ks) * 36 + 32] : 0.f;
        acc0 = __builtin_amdgcn_mfma_f32_16x16x4f32(av, b0, acc0, 0, 0, 0);
        acc1 = __builtin_amdgcn_mfma_f32_16x16x4f32(av, b1, acc1, 0, 0, 0);
        acc2 = __builtin_amdgcn_mfma_f32_16x16x4f32(av, b2, acc2, 0, 0, 0);
      }
    }
#undef WLOAD
#undef WSTORE
    __syncthreads();
    {
      float* part = hs + kq * (32 * 40);
#pragma unroll
      for (int i = 0; i < 4; ++i) { const int row = rg * 16 + 4 * (lane >> 4) + i, col = lane & 15;
        part[row * 40 + col] = acc0[i]; part[row * 40 + 16 + col] = acc1[i]; if (col < 4) part[row * 40 + 32 + col] = acc2[i]; }
    }
    __syncthreads();
    if (tid < 32) {
      const int row = grp * 32 + tid;
      float L[36];
#pragma unroll
      for (int o = 0; o < 36; ++o) L[o] = (hs[tid * 40 + o] + hs[1280 + tid * 40 + o]) + (hs[2560 + tid * 40 + o] + hs[3840 + tid * 40 + o]);
      float gm = -1e30f; int gi = 0;
#pragma unroll
      for (int i = 0; i < 4; ++i) { const float v = L[32 + i] + bg[i]; if (v > gm) { gm = v; gi = i; } }
      float gs = 0.f;
#pragma unroll
      for (int i = 0; i < 4; ++i) gs += expf(L[32 + i] + bg[i] - gm);
      const float gp = 1.f / gs;
      float el[8];
#pragma unroll
      for (int i = 0; i < 8; ++i) el[i] = (gi == 0 ? L[i] : gi == 1 ? L[8 + i] : gi == 2 ? L[16 + i] : L[24 + i]) + be[gi * 8 + i];
      float em = -1e30f;
#pragma unroll
      for (int i = 0; i < 8; ++i) em = fmaxf(em, el[i]);
      float p1 = -1.f, p2 = -1.f; int i1 = 0, i2 = 0;
#pragma unroll
      for (int i = 0; i < 8; ++i) {
        const float pe = expf(el[i] - em);
        if (pe > p1) { p2 = p1; i2 = i1; p1 = pe; i1 = i; } else if (pe > p2) { p2 = pe; i2 = i; }
      }
      const float w1 = gp * p1 / (p1 + p2), w2 = gp * p2 / (p1 + p2);
      const int e1 = gi * 8 + i1, e2 = gi * 8 + i2;
      const int pos1 = atomicAdd(&cnt[e1], 1); list[e1 * LISTCAP + pos1] = row * 2; wts[row * 2] = w1;
      const int pos2 = atomicAdd(&cnt[e2], 1); list[e2 * LISTCAP + pos2] = row * 2 + 1; wts[row * 2 + 1] = w2;
    }
    __syncthreads();
  }
}

namespace pg8 {
#define PG8_LAS __attribute__((address_space(3)))
typedef unsigned short bf16_t;
typedef short bf16x8 __attribute__((ext_vector_type(8)));
typedef float f32x4 __attribute__((ext_vector_type(4)));
typedef unsigned u32x4 __attribute__((ext_vector_type(4)));
constexpr int BM = 256, BK = 64, HALF = 128, HTB = HALF * BK * 2  , STAGE_BYTES = 8 * HTB, NXCD = 8, WGM = 8;

__host__ __device__ __forceinline__ int lds_byte(int r, int c) { const int st = (r >> 4) * 2 + (c >> 5), rr = r & 15, cc = c & 31, ob = rr * 64 + cc * 2; return st * 1024 + (ob ^ (((ob >> 9) & 1) << 5)); }
__host__ __device__ __forceinline__ void stage_rc(int b, int& R, int& C) { const int st = b / 1024, sb = b % 1024, swz = sb ^ (((sb >> 9) & 1) << 5); R = (st >> 1) * 16 + swz / 64; C = (st & 1) * 32 + (swz % 64) / 2; }
__host__ __device__ __forceinline__ int perm32(int rho) { const int n = rho >> 4, i = rho & 15; return 8 * (i >> 2) + 4 * n + (i & 3); }

struct Unit { int pm, pn; };
struct Gemm { const bf16_t* A; const bf16_t* Bt; int M, N, K; };

struct StaticOrder {
    int nM, nN, nwg, G, c;
    __host__ __device__ void init(int M, int N, int G_, int c_) { nM = M / BM; nN = N / BM; nwg = nM * nN; G = G_; c = c_; }
    __host__ __device__ bool next(int i, Unit& u) const {
        const long L = (long)i * G + c; if (L >= nwg) return false;
        int wgid = (int)L; { const int q = nwg / NXCD, r = nwg % NXCD, xcd = wgid % NXCD, off = wgid / NXCD; wgid = (xcd < r ? xcd * (q + 1) : r * (q + 1) + (xcd - r) * q) + off; }
        const int nig = WGM * nN, gid = wgid / nig, fm = gid * WGM, gsz = (nM - fm) < WGM ? (nM - fm) : WGM;
        u.pm = fm + ((wgid % nig) % gsz); u.pn = (wgid % nig) / gsz; return true;
    }
    __device__ __forceinline__ void a_ready(const Unit&) const {}
    __device__ __forceinline__ void done(const Unit&) const {}
};
template <class Epi, class Sched, bool ALIGN_EPI = false, bool SP2 = false>
__device__ __forceinline__ void gemm_phase(PG8_LAS unsigned char* lds, const Gemm g, const Sched& S, const Epi& E) {
    const int tid = otid(), wid = __builtin_amdgcn_readfirstlane(tid >> 6), lane = tid & 63, wr = wid >> 2, wc = wid & 3, fr = lane & 15, fq = lane >> 4;
    const int K = g.K, nt = K / BK;
    unsigned voffA[2], voffB[2];
#pragma unroll
    for (int i = 0; i < 2; ++i) { int R, C; stage_rc(tid * 16 + i * 8192, R, C); const int Rb = Epi::PERM ? ((R & ~31) + perm32(R & 31)) : R;
        voffA[i] = (unsigned)(R * K + C) * 2u; voffB[i] = (unsigned)(Rb * K + C) * 2u; }
    const size_t kstep = (size_t)(BK * 2);
    const size_t hstep = (size_t)HALF * K * 2;
    const size_t tstep = 2 * hstep;
    const unsigned ldsw = (unsigned)wid * 1024u;
    const int aoff = lds_byte(wr * 64 + fr, fq * 8), boff = lds_byte(wc * 32 + fr, fq * 8);
#define PG8_SA(b, h) (((b) * 2 + (h)) * HTB)
#define PG8_SB(b, h) ((4 + (b) * 2 + (h)) * HTB)
#define PG8_STAGE(bufoff, gbase, voff) do { _Pragma("unroll") for (int _i = 0; _i < 2; ++_i) \
        __builtin_amdgcn_global_load_lds((const unsigned*)((const char*)(gbase) + (voff)[_i]), (PG8_LAS unsigned*)(lds + (bufoff) + ldsw + _i * 8192), 16, 0, 0); } while (0)
#define PG8_LDA(dst, b, h) do { _Pragma("unroll") for (int m = 0; m < 4; ++m) _Pragma("unroll") for (int k = 0; k < 2; ++k) dst[m][k] = *(const PG8_LAS bf16x8*)(lds + PG8_SA(b, h) + aoff + m * 2048 + k * 1024); } while (0)
#define PG8_LDB(dst, b, h) do { _Pragma("unroll") for (int n = 0; n < 2; ++n) _Pragma("unroll") for (int k = 0; k < 2; ++k) dst[n][k] = *(const PG8_LAS bf16x8*)(lds + PG8_SB(b, h) + boff + n * 2048 + k * 1024); } while (0)
#define PG8_MMA(ai, bj, At, Bt) do { __builtin_amdgcn_s_setprio(1); _Pragma("unroll") for (int m = 0; m < 4; ++m) _Pragma("unroll") for (int n = 0; n < 2; ++n) _Pragma("unroll") for (int k = 0; k < 2; ++k) \
        acc[ai][bj][m][n] = __builtin_amdgcn_mfma_f32_16x16x32_bf16(Bt[n][k], At[m][k], acc[ai][bj][m][n], 0, 0, 0); __builtin_amdgcn_s_setprio(0); } while (0)
#define PG8_WAIT_V(n) asm volatile("s_waitcnt vmcnt(" #n ")" ::: "memory")
#define PG8_WAIT_L(n) asm volatile("s_waitcnt lgkmcnt(" #n ")" ::: "memory")
#define PG8_BAR __builtin_amdgcn_s_barrier()
#define PG8_SCHED __builtin_amdgcn_sched_barrier(0)
    Unit cur, nxt; int ui = 0;
    if (!S.next(0, cur)) return;
    f32x4 acc[2][2][4][2];
#pragma unroll
    for (int a = 0; a < 2; ++a)
#pragma unroll
        for (int b = 0; b < 2; ++b)
#pragma unroll
            for (int m = 0; m < 4; ++m)
#pragma unroll
                for (int n = 0; n < 2; ++n) acc[a][b][m][n] = (f32x4){0.f, 0.f, 0.f, 0.f};
    bf16x8 At[4][2], B0[2][2], B1[2][2];
    const char* cA = (const char*)g.A + (size_t)cur.pm * tstep; const char* cB = (const char*)g.Bt + (size_t)cur.pn * tstep;
    S.a_ready(cur);
    if constexpr (SP2) {
        PG8_STAGE(PG8_SB(0, 0), cB, voffB); PG8_STAGE(PG8_SB(0, 1), cB + hstep, voffB); PG8_STAGE(PG8_SA(0, 0), cA, voffA); PG8_STAGE(PG8_SA(0, 1), cA + hstep, voffA);
        if (wr == 1) PG8_BAR;
        PG8_WAIT_V(2); PG8_BAR;
        PG8_STAGE(PG8_SB(1, 0), cB + kstep, voffB); PG8_STAGE(PG8_SA(1, 0), cA + kstep, voffA); PG8_STAGE(PG8_SB(1, 1), cB + hstep + kstep, voffB);
        PG8_WAIT_V(6); PG8_BAR;
    } else {
        PG8_STAGE(PG8_SB(0, 0), cB, voffB); PG8_STAGE(PG8_SA(0, 0), cA, voffA); PG8_STAGE(PG8_SB(0, 1), cB + hstep, voffB); PG8_STAGE(PG8_SA(0, 1), cA + hstep, voffA);
        if (wr == 1) PG8_BAR;
        PG8_WAIT_V(4); PG8_BAR;
        PG8_STAGE(PG8_SB(1, 0), cB + kstep, voffB); PG8_STAGE(PG8_SA(1, 0), cA + kstep, voffA); PG8_STAGE(PG8_SB(1, 1), cB + hstep + kstep, voffB);
        PG8_WAIT_V(6); PG8_BAR;
    }
    for (;;) {
        const bool has_next = S.next(ui + 1, nxt);
        const char* nA = has_next ? (const char*)g.A + (size_t)nxt.pm * tstep : cA; const char* nB = has_next ? (const char*)g.Bt + (size_t)nxt.pn * tstep : cB;
        for (int t = 0; t < nt; t += 2) {
            const bool last = (t == nt - 2);
            const char* a1 = cA + (size_t)(t + 1) * kstep;
            const char* a2 = last ? nA : cA + (size_t)(t + 2) * kstep; const char* b2 = last ? nB : cB + (size_t)(t + 2) * kstep;
            const char* a3 = a2 + kstep; const char* b3 = b2 + kstep;
            if (last && has_next) S.a_ready(nxt);
            if constexpr (SP2) {
            PG8_LDB(B0, 0, 0); PG8_LDB(B1, 0, 1); PG8_SCHED; PG8_LDA(At, 0, 0); PG8_STAGE(PG8_SA(1, 1), a1 + hstep, voffA);
            PG8_WAIT_V(8); PG8_WAIT_L(0); PG8_BAR; PG8_MMA(0, 0, At, B0); PG8_MMA(0, 1, At, B1); PG8_BAR; PG8_SCHED;
            PG8_LDA(At, 0, 1); PG8_STAGE(PG8_SB(0, 0), b2, voffB); PG8_STAGE(PG8_SB(0, 1), b2 + hstep, voffB); PG8_STAGE(PG8_SA(0, 0), a2, voffA);
            PG8_WAIT_V(8); PG8_WAIT_L(0); PG8_BAR; PG8_MMA(1, 0, At, B0); PG8_MMA(1, 1, At, B1); PG8_BAR; PG8_SCHED;
            PG8_LDB(B0, 1, 0); PG8_LDB(B1, 1, 1); PG8_SCHED; PG8_LDA(At, 1, 0); PG8_STAGE(PG8_SA(0, 1), a2 + hstep, voffA);
            PG8_WAIT_V(8); PG8_WAIT_L(0); PG8_BAR; PG8_MMA(0, 0, At, B0); PG8_MMA(0, 1, At, B1); PG8_BAR; PG8_SCHED;
            PG8_LDA(At, 1, 1); PG8_STAGE(PG8_SB(1, 0), b3, voffB); PG8_STAGE(PG8_SB(1, 1), b3 + hstep, voffB); PG8_STAGE(PG8_SA(1, 0), a3, voffA);
            PG8_WAIT_V(8); PG8_WAIT_L(0); PG8_BAR; PG8_MMA(1, 0, At, B0); PG8_MMA(1, 1, At, B1); PG8_BAR; PG8_SCHED;
            } else {
            PG8_LDB(B0, 0, 0); PG8_SCHED; PG8_LDA(At, 0, 0); PG8_STAGE(PG8_SA(1, 1), a1 + hstep, voffA);
            PG8_WAIT_L(8); PG8_BAR; PG8_WAIT_L(0); PG8_MMA(0, 0, At, B0); PG8_BAR; PG8_SCHED;
            PG8_LDB(B1, 0, 1); PG8_STAGE(PG8_SB(0, 0), b2, voffB);
            PG8_BAR; PG8_WAIT_L(0); PG8_MMA(0, 1, At, B1); PG8_BAR;
            PG8_LDA(At, 0, 1); PG8_STAGE(PG8_SA(0, 0), a2, voffA);
            PG8_BAR; PG8_WAIT_L(0); PG8_MMA(1, 0, At, B0); PG8_BAR; PG8_SCHED;
            PG8_STAGE(PG8_SB(0, 1), b2 + hstep, voffB);
            PG8_WAIT_V(6); PG8_BAR; PG8_MMA(1, 1, At, B1); PG8_BAR;
            PG8_LDB(B0, 1, 0); PG8_SCHED; PG8_LDA(At, 1, 0); PG8_STAGE(PG8_SA(0, 1), a2 + hstep, voffA);
            PG8_WAIT_L(8); PG8_BAR; PG8_WAIT_L(0); PG8_MMA(0, 0, At, B0); PG8_BAR; PG8_SCHED;
            PG8_LDB(B1, 1, 1); PG8_STAGE(PG8_SB(1, 0), b3, voffB);
            PG8_BAR; PG8_WAIT_L(0); PG8_MMA(0, 1, At, B1); PG8_BAR;
            PG8_LDA(At, 1, 1); PG8_STAGE(PG8_SA(1, 0), a3, voffA);
            PG8_BAR; PG8_WAIT_L(0); PG8_MMA(1, 0, At, B0); PG8_BAR; PG8_SCHED;
            PG8_STAGE(PG8_SB(1, 1), b3 + hstep, voffB);
            PG8_WAIT_V(6); PG8_BAR; PG8_MMA(1, 1, At, B1); PG8_BAR;
            }
        }
        if constexpr (ALIGN_EPI) { if (wr == 0) PG8_BAR; }
        if constexpr (!Epi::AFTER_DRAIN) { E(acc, cur, wr, wc, fr, fq); S.done(cur); }
        if (!has_next) break;
#pragma unroll
        for (int a = 0; a < 2; ++a)
#pragma unroll
            for (int b = 0; b < 2; ++b)
#pragma unroll
                for (int m = 0; m < 4; ++m)
#pragma unroll
                    for (int n = 0; n < 2; ++n) acc[a][b][m][n] = (f32x4){0.f, 0.f, 0.f, 0.f};
        cur = nxt; cA = nA; cB = nB; ++ui;
        if constexpr (ALIGN_EPI) { if (wr == 1) PG8_BAR; }
    }
    PG8_WAIT_V(0);
    if constexpr (!ALIGN_EPI) { if (wr == 0) PG8_BAR; }
    PG8_BAR;
    if constexpr (Epi::AFTER_DRAIN) { E.fused(acc, cur, wr, wc, fr, fq, lds, wid, lane); S.done(cur); }
#undef PG8_SA
#undef PG8_SB
#undef PG8_STAGE
#undef PG8_LDA
#undef PG8_LDB
#undef PG8_MMA
#undef PG8_WAIT_V
#undef PG8_WAIT_L
#undef PG8_BAR
#undef PG8_SCHED
}
}

constexpr int GT_ROWB = 128, GT_A = 0, GT_B = 128 * GT_ROWB, GT_STAGE = 2 * 128 * GT_ROWB;
#define GT_WOFF(lr_, tid_) ((lr_) * GT_ROWB + ((((tid_) & 7) ^ ((lr_) & 7)) * 16))
#define GT_RSW(ks_, fq_, fr_) ((((ks_) * 4 + (fq_)) ^ ((fr_) & 7)) * 16)
DI void gemm_kloop(unsigned char* lds, const bf16_t* a0, const bf16_t* a1, int a_kadv, const bf16_t* b0, const bf16_t* b1, int nk, f32x4 (&acc)[4][2]) {
  const int tid = otid(), lane = tid & 63, wid = tid >> 6, wr = wid >> 2, wc = wid & 3, fr = lane & 15, fq = lane >> 4;
  const int lr = tid >> 3, lkb = (tid & 7) * 16;
  u32x4 xa0, xa1, xb0, xb1, ya0, ya1, yb0, yb1;
#define GT_GLOAD(p0_, p1_, q0_, q1_, kt) do { p0_ = *(const u32x4*)(a0 + (size_t)(kt) * a_kadv); p1_ = *(const u32x4*)(a1 + (size_t)(kt) * a_kadv); q0_ = *(const u32x4*)(b0 + (kt) * 64); q1_ = *(const u32x4*)(b1 + (kt) * 64); } while (0)
#define GT_LSTORE(p0_, p1_, q0_, q1_, buf) do { unsigned char* s_ = lds + (buf) * GT_STAGE; \
    *(u32x4*)(s_ + GT_A + GT_WOFF(lr, tid)) = p0_; *(u32x4*)(s_ + GT_A + 64 * GT_ROWB + GT_WOFF(lr, tid)) = p1_; \
    *(u32x4*)(s_ + GT_B + GT_WOFF(lr, tid)) = q0_; *(u32x4*)(s_ + GT_B + 64 * GT_ROWB + GT_WOFF(lr, tid)) = q1_; } while (0)
#define GT_COMPUTE(buf) do { \
    const unsigned char* As = lds + (buf) * GT_STAGE + GT_A + (wr * 64 + fr) * GT_ROWB; \
    const unsigned char* Bs = lds + (buf) * GT_STAGE + GT_B + (wc * 32 + fr) * GT_ROWB; \
    _Pragma("unroll") for (int ks = 0; ks < 2; ++ks) { \
      bf16x8 af[4], bfr[2]; \
      _Pragma("unroll") for (int m = 0; m < 4; ++m) af[m] = *(const bf16x8*)(As + m * 16 * GT_ROWB + GT_RSW(ks, fq, fr)); \
      _Pragma("unroll") for (int n = 0; n < 2; ++n) bfr[n] = *(const bf16x8*)(Bs + n * 16 * GT_ROWB + GT_RSW(ks, fq, fr)); \
      _Pragma("unroll") for (int m = 0; m < 4; ++m) _Pragma("unroll") for (int n = 0; n < 2; ++n) acc[m][n] = __builtin_amdgcn_mfma_f32_16x16x32_bf16(bfr[n], af[m], acc[m][n], 0, 0, 0); } } while (0)
  GT_GLOAD(xa0, xa1, xb0, xb1, 0); GT_LSTORE(xa0, xa1, xb0, xb1, 0); if (nk > 1) GT_GLOAD(ya0, ya1, yb0, yb1, 1); __syncthreads();
  for (int kt = 0; kt < nk; kt += 2) {
    if (kt + 2 < nk) GT_GLOAD(xa0, xa1, xb0, xb1, kt + 2);
    GT_COMPUTE(0);
    if (kt + 1 < nk) GT_LSTORE(ya0, ya1, yb0, yb1, 1);
    __syncthreads();
    if (kt + 1 >= nk) break;
    if (kt + 3 < nk) GT_GLOAD(ya0, ya1, yb0, yb1, kt + 3);
    GT_COMPUTE(1);
    if (kt + 2 < nk) GT_LSTORE(xa0, xa1, xb0, xb1, 0);
    __syncthreads();
  }
#undef GT_GLOAD
#undef GT_LSTORE
#undef GT_COMPUTE
}
#define ACC_ZERO(acc) do { _Pragma("unroll") for (int m_ = 0; m_ < 4; ++m_) _Pragma("unroll") for (int n_ = 0; n_ < 2; ++n_) acc[m_][n_] = (f32x4){0.f, 0.f, 0.f, 0.f}; } while (0)
#define TILE_IDS const int tid = otid(), bid = obid(), lane = tid & 63, wid = tid >> 6, wr = wid >> 2, wc = wid & 3, fr = lane & 15, fq = lane >> 4, lr = tid >> 3, lk = (tid & 7) * 8; (void)bid; (void)lane; (void)wr; (void)wc; (void)fr; (void)fq; (void)lr; (void)lk

DI void phase_gates(const Params& P_, unsigned char* lds) {
  Params P = P_; { size_t z_ = 0; asm volatile("" : "+s"(z_)); P.ws = P_.ws + z_; }
  TILE_IDS;
  const bf16_t* xn = (const bf16_t*)(P.ws + WS_A); const bf16_t* wt = (const bf16_t*)(P.ws + WS_W + W_IN) + (size_t)5120 * DM; float* gates = (float*)(P.ws + WS_GATES);
  for (int tile = (int)gridDim.x - 1 - bid; tile < NT / 128; tile += gridDim.x) {
    const int row0 = tile * 128;
    f32x4 acc[4][2]; ACC_ZERO(acc);
    gemm_kloop(lds, xn + (size_t)(row0 + lr) * DM + lk, xn + (size_t)(row0 + lr + 64) * DM + lk, 64, wt + (size_t)lr * DM + lk, wt + (size_t)(lr + 64) * DM + lk, DM / 64, acc);
#pragma unroll
    for (int m = 0; m < 4; ++m)
#pragma unroll
      for (int n = 0; n < 2; ++n) {
        const int row = row0 + wr * 64 + m * 16 + fr, c2 = wc * 32 + n * 16 + 4 * fq; const f32x4 v = acc[m][n];
        if (c2 < 48) { f32x4 o = {sigmoidf_(v.x), sigmoidf_(v.y), sigmoidf_(v.z), sigmoidf_(v.w)}; *(f32x4*)(gates + (size_t)row * 48 + c2) = o; }
      }
  }
}
DI void phase_cmp1(const Params& P_, int l, unsigned char* lds) {
  Params P = P_; { size_t z_ = 0; asm volatile("" : "+s"(z_)); P.ws = P_.ws + z_; }
  TILE_IDS;
  const bf16_t* kvk = (const bf16_t*)(P.ws + WS_C); bf16_t* hid = (bf16_t*)(P.ws + WS_HID);
  const float* cb = (const float*)(P.ws + WS_CB) + l * 512;
  for (int tile = bid; tile < 128; tile += gridDim.x) {
    const int kv = tile >> 6, rt = (tile >> 1) & 31, ct = tile & 1, row0 = rt * 128, col0 = ct * 128;
    const bf16_t* wt = (const bf16_t*)(P.ws + WS_W + W_C1) + (size_t)kv * 256 * 2048;
    const bf16_t* ap[2];
#pragma unroll
    for (int i = 0; i < 2; ++i) { const int rr = row0 + lr + 64 * i, b = rr >> 11, n = (rr >> 2) & 511, g = rr & 3, nn = n > 510 ? 510 : n;
      ap[i] = kvk + (size_t)(b * SEQ + 16 * nn) * DM + kv * 256 + g * 64 + lk; }
    f32x4 acc[4][2]; ACC_ZERO(acc);
    gemm_kloop(lds, ap[0], ap[1], DM, wt + (size_t)(col0 + lr) * 2048 + lk, wt + (size_t)(col0 + lr + 64) * 2048 + lk, 32, acc);
#pragma unroll
    for (int m = 0; m < 4; ++m)
#pragma unroll
      for (int n = 0; n < 2; ++n) {
        const int row = row0 + wr * 64 + m * 16 + fr, col = col0 + wc * 32 + n * 16 + 4 * fq;
        const f32x4 bb = *(const f32x4*)(cb + kv * 256 + col); const f32x4 v = acc[m][n] + bb;
        u32x2 o; o.x = pk2(gelu_tanh(v.x), gelu_tanh(v.y)); o.y = pk2(gelu_tanh(v.z), gelu_tanh(v.w));
        *(u32x2*)(hid + ((size_t)kv * 4096 + row) * 256 + col) = o;
      }
  }
}
DI void phase_cmp2(const Params& P_, unsigned char* lds) {
  Params P = P_; { size_t z_ = 0; asm volatile("" : "+s"(z_)); P.ws = P_.ws + z_; }
  TILE_IDS;
  const bf16_t* hid = (const bf16_t*)(P.ws + WS_HID); bf16_t* kc = (bf16_t*)(P.ws + WS_KC); bf16_t* vc = (bf16_t*)(P.ws + WS_VC);
  for (int tile = bid; tile < 64; tile += gridDim.x) {
    const int kv = tile >> 5, rt = tile & 31, row0 = rt * 128;
    const bf16_t* wt = (const bf16_t*)(P.ws + WS_W + W_C2) + (size_t)kv * 128 * 256;
    const bf16_t* a = hid + ((size_t)kv * 4096 + row0) * 256;
    f32x4 acc[4][2]; ACC_ZERO(acc);
    gemm_kloop(lds, a + (size_t)lr * 256 + lk, a + (size_t)(lr + 64) * 256 + lk, 64, wt + (size_t)lr * 256 + lk, wt + (size_t)(lr + 64) * 256 + lk, 4, acc);
    if (wc < 2) {
#pragma unroll
      for (int m = 0; m < 4; ++m)
#pragma unroll
        for (int n = 0; n < 2; ++n) {
          const int rr = row0 + wr * 64 + m * 16 + fr, d = wc * 32 + n * 16 + 4 * fq;
          const int b = rr >> 11, nn = (rr >> 2) & 511, g = rr & 3; const f32x4 v = acc[m][n];
          if (kv == 0) { u32x2 o; o.x = pk2(v.x, v.y); o.y = pk2(v.z, v.w); *(u32x2*)(kc + ((size_t)((b * 4 + g) * 512 + nn)) * 64 + d) = o; }
          else { bf16_t* dst = vc + ((size_t)((b * 4 + g) * 64 + d)) * 512 + perm16(nn); dst[0] = (bf16_t)f2bf(v.x); dst[512] = (bf16_t)f2bf(v.y); dst[1024] = (bf16_t)f2bf(v.z); dst[1536] = (bf16_t)f2bf(v.w); }
        }
    }
  }
}
DI void phase_glu(const Params& P_, unsigned char* lds) {
  Params P = P_; { size_t z_ = 0; asm volatile("" : "+s"(z_)); P.ws = P_.ws + z_; }
  TILE_IDS;
  const bf16_t* y = (const bf16_t*)(P.ws + WS_G); const bf16_t* wt = (const bf16_t*)(P.ws + WS_W + W_GLU); bf16_t* ssm = (bf16_t*)(P.ws + WS_E);
  for (int tile = bid; tile < (NT / 128) * 4; tile += gridDim.x) {
    const int rt = tile >> 2, ct = tile & 3, row0 = rt * 128, col0 = ct * 128;
    f32x4 acc[4][2]; ACC_ZERO(acc);
    gemm_kloop(lds, y + (size_t)(row0 + lr) * 512 + lk, y + (size_t)(row0 + lr + 64) * 512 + lk, 64, wt + (size_t)(col0 + lr) * 512 + lk, wt + (size_t)(col0 + lr + 64) * 512 + lk, 8, acc);
#pragma unroll
    for (int m = 0; m < 4; ++m)
#pragma unroll
      for (int n = 0; n < 2; ++n) {
        const int row = row0 + wr * 64 + m * 16 + fr, col = col0 + wc * 32 + n * 16 + 4 * fq;
        const u32x2 yy = *(const u32x2*)(y + (size_t)row * 512 + col); const f32x4 v = acc[m][n];
        u32x2 o; o.x = pk2(bflo(yy.x) * sigmoidf_(v.x), bfhi(yy.x) * sigmoidf_(v.y)); o.y = pk2(bflo(yy.y) * sigmoidf_(v.z), bfhi(yy.y) * sigmoidf_(v.w));
        *(u32x2*)(ssm + (size_t)row * 512 + col) = o;
      }
  }
}
struct EpiInproj {
  static constexpr bool PERM = false, AFTER_DRAIN = false;
  bf16_t* qb; bf16_t* kvk; bf16_t* vT; bf16_t* mg; bf16_t* ub; float* gates;
  DI void operator()(const f32x4 (&acc)[2][2][4][2], const pg8::Unit& u, int wr, int wc, int fr_, int fq_) const {
    const int pn = u.pn; int fr = fr_, fq = fq_; asm volatile("" : "+v"(fr), "+v"(fq));
#pragma unroll
    for (int ai = 0; ai < 2; ++ai)
#pragma unroll
      for (int m = 0; m < 4; ++m) {
        const int row = u.pm * 256 + ai * 128 + wr * 64 + m * 16 + fr;
#pragma unroll
        for (int bj = 0; bj < 2; ++bj)
#pragma unroll
          for (int n = 0; n < 2; ++n) {
            const int cl = bj * 128 + wc * 32 + n * 16 + 4 * fq;
            const f32x4 v = acc[ai][bj][m][n];
            if (pn < 4) { u32x2 o; o.x = pk2(v.x * QSCALE, v.y * QSCALE); o.y = pk2(v.z * QSCALE, v.w * QSCALE); *(u32x2*)(qb + (size_t)row * DM + pn * 256 + cl) = o; }
            else if (pn < 10) {
              const int seg = pn - 4;
              if (seg == 5) {
                const int b = row >> 13, t = row & (SEQ - 1), g = cl >> 6, d = cl & 63;
                bf16_t* dst = vT + ((size_t)(((1 * NB + b) * 4 + g) * 64 + d)) * SEQ + perm16(t);
                dst[0] = (bf16_t)f2bf(v.x); dst[SEQ] = (bf16_t)f2bf(v.y); dst[2 * SEQ] = (bf16_t)f2bf(v.z); dst[3 * SEQ] = (bf16_t)f2bf(v.w);
              } else if (seg == 3) {
                const unsigned t = row & (SEQ - 1), pos = perm16(t) & 63;
                const unsigned ro = ((unsigned)(row >> 13) * 512u + (t >> 6)) * 4096u + (pos >> 3) * 256u + (pos & 7), co = (unsigned)(cl >> 6) * 524288u + (unsigned)((cl >> 5) & 1) * 2048u + (unsigned)(cl & 31) * 8u;
                bf16_t* dst = vT + (ro + co);
                dst[0] = (bf16_t)f2bf(v.x); dst[8] = (bf16_t)f2bf(v.y); dst[16] = (bf16_t)f2bf(v.z); dst[24] = (bf16_t)f2bf(v.w);
              } else if (seg == 2) {
                const unsigned t = row & (SEQ - 1);
                const unsigned ro = ((unsigned)(row >> 13) * 512u + (t >> 6)) * 4096u + ((t >> 5) & 1) * 2048u + (t & 31) * 8u, co = (unsigned)(cl >> 6) * 524288u + (unsigned)((cl >> 3) & 7) * 256u + (unsigned)(cl & 7);
                u32x2 o; o.x = pk2(v.x, v.y); o.y = pk2(v.z, v.w);
                *(u32x2*)(kvk + (WS_KSF - WS_C) / 2 + (ro + co)) = o;
              } else {
                const int slot = seg == 4 ? 3 : seg;
                u32x2 o; o.x = pk2(v.x, v.y); o.y = pk2(v.z, v.w); *(u32x2*)(kvk + (size_t)row * DM + slot * 256 + cl) = o;
              }
            } else if (pn < 18) {
              u32x2 o; o.x = pk2(sigmoidf_(v.x), sigmoidf_(v.y)); o.y = pk2(sigmoidf_(v.z), sigmoidf_(v.w)); *(u32x2*)(mg + (size_t)row * 2048 + (pn - 10) * 256 + cl) = o;
            } else if (pn < 20) { const int ch = (pn - 18) * 256 + cl; u32x2 o; o.x = pk2(v.x, v.y); o.y = pk2(v.z, v.w); *(u32x2*)(ub + ((size_t)(ch >> 4) * NT + row) * 16 + (ch & 15)) = o; }
            else { if (cl < 48) { f32x4 o = {sigmoidf_(v.x), sigmoidf_(v.y), sigmoidf_(v.z), sigmoidf_(v.w)}; *(f32x4*)(gates + (size_t)row * 48 + cl) = o; } }
          }
      }
  }
};
DI void phase_inproj8(const Params& P_, unsigned char* lds) {
  Params P = P_; { size_t z_ = 0; asm volatile("" : "+s"(z_)); P.ws = P_.ws + z_; }
  pg8::Gemm g{(const bf16_t*)(P.ws + WS_A), (const bf16_t*)(P.ws + WS_W + W_IN), NT, 5120, DM};
  pg8::StaticOrder S; S.init(NT, 5120, gridDim.x, obid());
  EpiInproj E{(bf16_t*)(P.ws + WS_B), (bf16_t*)(P.ws + WS_C), (bf16_t*)(P.ws + WS_DV), (bf16_t*)(P.ws + WS_F), (bf16_t*)(P.ws + WS_E), (float*)(P.ws + WS_GATES)};
  pg8::gemm_phase<EpiInproj, pg8::StaticOrder, true, true>((PG8_LAS unsigned char*)lds, g, S, E);
}
struct EpiMerge1 {
  static constexpr bool PERM = false, AFTER_DRAIN = false;
  const bf16_t* mg; bf16_t* tmp;
  DI void operator()(const f32x4 (&acc)[2][2][4][2], const pg8::Unit& u, int wr, int wc, int fr, int fq) const {
#pragma unroll
    for (int ai = 0; ai < 2; ++ai) {
      u32x2 ga[4][2][2];
#pragma unroll
      for (int m = 0; m < 4; ++m)
#pragma unroll
        for (int bj = 0; bj < 2; ++bj)
#pragma unroll
          for (int n = 0; n < 2; ++n) {
            const int row = u.pm * 256 + ai * 128 + wr * 64 + m * 16 + fr, col = u.pn * 256 + bj * 128 + wc * 32 + n * 16 + 4 * fq;
            ga[m][bj][n] = *(const u32x2*)(mg + (size_t)row * 2048 + col);
          }
      __builtin_amdgcn_sched_barrier(0);
#pragma unroll
      for (int m = 0; m < 4; ++m)
#pragma unroll
        for (int bj = 0; bj < 2; ++bj)
#pragma unroll
          for (int n = 0; n < 2; ++n) {
            const int row = u.pm * 256 + ai * 128 + wr * 64 + m * 16 + fr, col = u.pn * 256 + bj * 128 + wc * 32 + n * 16 + 4 * fq;
            const f32x4 v = acc[ai][bj][m][n]; const u32x2 g = ga[m][bj][n];
            u32x2 o; o.x = pk2(v.x * bflo(g.x), v.y * bfhi(g.x)); o.y = pk2(v.z * bflo(g.y), v.w * bfhi(g.y));
            *(u32x2*)(tmp + (size_t)row * DM + col) = o;
          }
      __builtin_amdgcn_sched_barrier(0);
    }
  }
};
struct EpiMerge2 {
  static constexpr bool PERM = false, AFTER_DRAIN = false;
  const bf16_t* mg; const bf16_t* tmp; bf16_t* mer;
  DI void operator()(const f32x4 (&acc)[2][2][4][2], const pg8::Unit& u, int wr, int wc, int fr, int fq) const {
#pragma unroll
    for (int ai = 0; ai < 2; ++ai)
#pragma unroll
      for (int mh = 0; mh < 2; ++mh) {
        u32x2 gs[2][2][2], tv[2][2][2];
#pragma unroll
        for (int mm = 0; mm < 2; ++mm)
#pragma unroll
          for (int bj = 0; bj < 2; ++bj)
#pragma unroll
            for (int n = 0; n < 2; ++n) {
              const int row = u.pm * 256 + ai * 128 + wr * 64 + (mh * 2 + mm) * 16 + fr, col = u.pn * 256 + bj * 128 + wc * 32 + n * 16 + 4 * fq;
              gs[mm][bj][n] = *(const u32x2*)(mg + (size_t)row * 2048 + 1024 + col);
#if EN_ATTN
              tv[mm][bj][n] = *(const u32x2*)(tmp + (size_t)row * DM + col);
#else
              tv[mm][bj][n] = (u32x2){0u, 0u};
#endif
            }
        __builtin_amdgcn_sched_barrier(0);
#pragma unroll
        for (int mm = 0; mm < 2; ++mm)
#pragma unroll
          for (int bj = 0; bj < 2; ++bj)
#pragma unroll
            for (int n = 0; n < 2; ++n) {
              const int row = u.pm * 256 + ai * 128 + wr * 64 + (mh * 2 + mm) * 16 + fr, col = u.pn * 256 + bj * 128 + wc * 32 + n * 16 + 4 * fq;
              const f32x4 v = acc[ai][bj][mh * 2 + mm][n]; const u32x2 g = gs[mm][bj][n], t = tv[mm][bj][n];
              u32x2 o; o.x = pk2(bflo(t.x) + v.x * bflo(g.x), bfhi(t.x) + v.y * bfhi(g.x)); o.y = pk2(bflo(t.y) + v.z * bflo(g.y), bfhi(t.y) + v.w * bfhi(g.y));
              *(u32x2*)(mer + (size_t)row * DM + col) = o;
            }
        __builtin_amdgcn_sched_barrier(0);
      }
  }
};
DI void phase_merge8(const Params& P_, unsigned char* lds) {
  Params P = P_; { size_t z_ = 0; asm volatile("" : "+s"(z_)); P.ws = P_.ws + z_; }
#if EN_ATTN
  { pg8::Gemm g{(const bf16_t*)(P.ws + WS_A), (const bf16_t*)(P.ws + WS_W + W_O), NT, DM, DM};
    pg8::StaticOrder S; S.init(NT, DM, gridDim.x, obid());
    EpiMerge1 E{(const bf16_t*)(P.ws + WS_F), (bf16_t*)(P.ws + WS_C)};
    pg8::gemm_phase<EpiMerge1, pg8::StaticOrder, true, true>((PG8_LAS unsigned char*)lds, g, S, E); }
#endif
  { pg8::Gemm g{(const bf16_t*)(P.ws + WS_E), (const bf16_t*)(P.ws + WS_W + W_SO), NT, DM, 512};
    pg8::StaticOrder S; S.init(NT, DM, gridDim.x, obid());
    EpiMerge2 E{(const bf16_t*)(P.ws + WS_F), (const bf16_t*)(P.ws + WS_C), (bf16_t*)(P.ws + WS_B)};
    pg8::gemm_phase<EpiMerge2, pg8::StaticOrder, true, true>((PG8_LAS unsigned char*)lds, g, S, E); }
}
struct EpiWout {
  static constexpr bool PERM = false, AFTER_DRAIN = false;
  const float* mod; const float* xin; float* out;
  DI void operator()(const f32x4 (&acc)[2][2][4][2], const pg8::Unit& u, int wr, int wc, int fr, int fq) const {
    const int b = (u.pm * 256) >> 13;
    f32x4 g1[2][2];
#pragma unroll
    for (int bj = 0; bj < 2; ++bj)
#pragma unroll
      for (int n = 0; n < 2; ++n) g1[bj][n] = *(const f32x4*)(mod + (size_t)b * 6144 + 2048 + u.pn * 256 + bj * 128 + wc * 32 + n * 16 + 4 * fq);
#pragma unroll
    for (int ai = 0; ai < 2; ++ai)
#pragma unroll
      for (int mh = 0; mh < 2; ++mh) {
        f32x4 xv[2][2][2];
#pragma unroll
        for (int mm = 0; mm < 2; ++mm)
#pragma unroll
          for (int bj = 0; bj < 2; ++bj)
#pragma unroll
            for (int n = 0; n < 2; ++n) {
              const int row = u.pm * 256 + ai * 128 + wr * 64 + (mh * 2 + mm) * 16 + fr, col = u.pn * 256 + bj * 128 + wc * 32 + n * 16 + 4 * fq;
              xv[mm][bj][n] = *(const f32x4*)(xin + (size_t)row * DM + col);
            }
        __builtin_amdgcn_sched_barrier(0);
#pragma unroll
        for (int mm = 0; mm < 2; ++mm)
#pragma unroll
          for (int bj = 0; bj < 2; ++bj)
#pragma unroll
            for (int n = 0; n < 2; ++n) {
              const int row = u.pm * 256 + ai * 128 + wr * 64 + (mh * 2 + mm) * 16 + fr, col = u.pn * 256 + bj * 128 + wc * 32 + n * 16 + 4 * fq;
              *(f32x4*)(out + (size_t)row * DM + col) = xv[mm][bj][n] + g1[bj][n] * acc[ai][bj][mh * 2 + mm][n];
            }
        __builtin_amdgcn_sched_barrier(0);
      }
  }
};
DI void phase_wout8(const Params& P_, int l, unsigned char* lds) {
  Params P = P_; { size_t z_ = 0; asm volatile("" : "+s"(z_)); P.ws = P_.ws + z_; }
  pg8::Gemm g{(const bf16_t*)(P.ws + WS_B), (const bf16_t*)(P.ws + WS_W + W_OUT), NT, DM, DM};
  pg8::StaticOrder S; S.init(NT, DM, gridDim.x, obid());
  EpiWout E{(const float*)(P.ws + WS_MOD) + (size_t)(l * 2) * 6144, l == 0 ? P.in[0] : P.out, P.out};
  pg8::gemm_phase<EpiWout, pg8::StaticOrder, true, true>((PG8_LAS unsigned char*)lds, g, S, E);
}

struct MoeTab { int cv, pin; };
DI MoeTab moe_tab(const int* cnt) {
  const int lane = otid() & 63; MoeTab T; T.cv = cnt[lane & 31]; int p = (T.cv + 127) >> 7;
#pragma unroll
  for (int o = 1; o < 32; o <<= 1) { const int t = __shfl_up(p, o); if ((lane & 31) >= o) p += t; }
  T.pin = p; return T;
}
DI int moe_total(const MoeTab& T) { return __builtin_amdgcn_readlane(T.pin, 31); }
DI void moe_find(const MoeTab& T, int rb, int& e, int& rbl, int& ce) {
  const unsigned m = (unsigned)__ballot(T.pin <= rb);
  e = __popc(m); e = e < NEXP ? e : NEXP - 1;
  const int nb = (__shfl(T.cv, e) + 127) >> 7;
  ce = __shfl(T.cv, e); rbl = rb - (__shfl(T.pin, e) - nb);
  e = __builtin_amdgcn_readfirstlane(e); rbl = __builtin_amdgcn_readfirstlane(rbl); ce = __builtin_amdgcn_readfirstlane(ce);
}
DI void phase_moe1(const Params& P_, int l, unsigned char* lds) {
  Params P = P_; { size_t z_ = 0; asm volatile("" : "+s"(z_)); P.ws = P_.ws + z_; }
  TILE_IDS;
  const int* cnt = (const int*)(P.ws + WS_CNT) + l * 32; const int* list = (const int*)(P.ws + WS_LIST);
  const bf16_t* h2 = (const bf16_t*)(P.ws + WS_A); bf16_t* act = (bf16_t*)(P.ws + WS_B);
  const MoeTab MT = moe_tab(cnt); const int total = moe_total(MT);
  const int G_ = gridDim.x, nx_ = (G_ % 8 == 0) ? 8 : 1, xg_ = bid % nx_, xs_ = bid / nx_, xb0_ = (int)((long)total * xg_ / nx_), xb1_ = (int)((long)total * (xg_ + 1) / nx_);
  for (int tl = xs_; tl < (xb1_ - xb0_) * 4; tl += G_ / nx_) {
    const int rb = xb0_ + (tl >> 2), ct = tl & 3; int e = 0, rbl = 0, ce = 1; moe_find(MT, rb, e, rbl, ce);
    const bf16_t* wt = (const bf16_t*)(P.ws + WS_W + W_GU) + (size_t)e * 512 * 1024 + (size_t)(ct * 128) * 1024;
    const bf16_t* ap[2];
#pragma unroll
    for (int i = 0; i < 2; ++i) { int idx = rbl * 128 + lr + 64 * i; idx = idx < ce ? idx : ce - 1; const int tok = list[e * LISTCAP + idx] >> 1; ap[i] = h2 + (size_t)tok * DM + lk; }
    f32x4 acc[4][2]; ACC_ZERO(acc);
    gemm_kloop(lds, ap[0], ap[1], 64, wt + (size_t)lr * DM + lk, wt + (size_t)(lr + 64) * DM + lk, 16, acc);
#pragma unroll
    for (int m = 0; m < 4; ++m) {
      const int arow = rb * 128 + wr * 64 + m * 16 + fr, col = ct * 64 + wc * 16 + 4 * fq;
      const f32x4 g = acc[m][0], u = acc[m][1];
      u32x2 o; o.x = pk2(g.x * sigmoidf_(g.x) * u.x, g.y * sigmoidf_(g.y) * u.y); o.y = pk2(g.z * sigmoidf_(g.z) * u.z, g.w * sigmoidf_(g.w) * u.w);
      *(u32x2*)(act + (size_t)arow * 256 + col) = o;
    }
  }
}
DI void phase_moe2(const Params& P_, int l, unsigned char* lds) {
  Params P = P_; { size_t z_ = 0; asm volatile("" : "+s"(z_)); P.ws = P_.ws + z_; }
  TILE_IDS;
  const int* cnt = (const int*)(P.ws + WS_CNT) + l * 32; const int* list = (const int*)(P.ws + WS_LIST); const float* wts = (const float*)(P.ws + WS_WT);
  const bf16_t* act = (const bf16_t*)(P.ws + WS_B); bf16_t* ys = (bf16_t*)(P.ws + WS_F);
  constexpr int ASUB = 128 * GT_ROWB, BOFF = 4 * ASUB;
  const MoeTab MT = moe_tab(cnt); const int total = moe_total(MT);
  const int lkb = (tid & 7) * 16;
  const int G_ = gridDim.x, nx_ = (G_ % 8 == 0) ? 8 : 1, xg_ = bid % nx_, xs_ = bid / nx_, xb0_ = (int)((long)total * xg_ / nx_), xb1_ = (int)((long)total * (xg_ + 1) / nx_);
  for (int tl = xs_; tl < (xb1_ - xb0_) * 4; tl += G_ / nx_) {
    const int rb = xb0_ + (tl >> 2), ct0 = (tl & 3) * 2; int e = 0, rbl = 0, ce = 1; moe_find(MT, rb, e, rbl, ce);
    const bf16_t* wt = (const bf16_t*)(P.ws + WS_W + W_D) + (size_t)e * 1024 * 256;
    const bf16_t* a0 = act + (size_t)(rb * 128 + lr) * 256 + lk; const bf16_t* a1 = a0 + 64 * 256;
    u32x4 ra[8], bq[8][2];
#pragma unroll
    for (int k = 0; k < 4; ++k) { ra[2 * k] = *(const u32x4*)(a0 + 64 * k); ra[2 * k + 1] = *(const u32x4*)(a1 + 64 * k); }
#define M2_BLOAD(q0_, q1_, s_) do { const bf16_t* bp_ = wt + (size_t)((ct0 + ((s_) >> 2)) * 128 + lr) * 256 + ((s_) & 3) * 64 + lk; q0_ = *(const u32x4*)bp_; q1_ = *(const u32x4*)(bp_ + 64 * 256); } while (0)
#define M2_BSTORE(q0_, q1_, buf_) do { unsigned char* s_ = lds + BOFF + (buf_) * ASUB; *(u32x4*)(s_ + GT_WOFF(lr, tid)) = q0_; *(u32x4*)(s_ + 64 * GT_ROWB + GT_WOFF(lr, tid)) = q1_; } while (0)
#define M2_COMPUTE(s_, buf_) do { \
      const unsigned char* As = lds + ((s_) & 3) * ASUB + (wr * 64 + fr) * GT_ROWB; \
      const unsigned char* Bs = lds + BOFF + (buf_) * ASUB + (wc * 32 + fr) * GT_ROWB; \
      _Pragma("unroll") for (int ks = 0; ks < 2; ++ks) { \
        bf16x8 af[4], bfr[2]; \
        _Pragma("unroll") for (int m = 0; m < 4; ++m) af[m] = *(const bf16x8*)(As + m * 16 * GT_ROWB + GT_RSW(ks, fq, fr)); \
        _Pragma("unroll") for (int n = 0; n < 2; ++n) bfr[n] = *(const bf16x8*)(Bs + n * 16 * GT_ROWB + GT_RSW(ks, fq, fr)); \
        _Pragma("unroll") for (int m = 0; m < 4; ++m) _Pragma("unroll") for (int n = 0; n < 2; ++n) acc[m][n] = __builtin_amdgcn_mfma_f32_16x16x32_bf16(bfr[n], af[m], acc[m][n], 0, 0, 0); } } while (0)
#define M2_EPI(ct_) do { _Pragma("unroll") for (int m = 0; m < 4; ++m) { const int idx = rbl * 128 + wr * 64 + m * 16 + fr; \
      if (idx < ce) { const int slot = eslot[m]; const float w_ = ewt[m]; \
        _Pragma("unroll") for (int n = 0; n < 2; ++n) { const int col = (ct_) * 128 + wc * 32 + n * 16 + 4 * fq; const f32x4 v = acc[m][n] * w_; \
          u32x2 o; o.x = pk2(v.x, v.y); o.y = pk2(v.z, v.w); *(u32x2*)(ys + (size_t)slot * DM + col) = o; } } } ACC_ZERO(acc); } while (0)
    int eslot[4]; float ewt[4];
#pragma unroll
    for (int m = 0; m < 4; ++m) { int idx = rbl * 128 + wr * 64 + m * 16 + fr; idx = idx < ce ? idx : ce - 1; eslot[m] = list[e * LISTCAP + idx]; }
#pragma unroll
    for (int s2 = 0; s2 < 8; ++s2) M2_BLOAD(bq[s2][0], bq[s2][1], s2);
#pragma unroll
    for (int m = 0; m < 4; ++m) ewt[m] = wts[eslot[m]];
#pragma unroll
    for (int k = 0; k < 4; ++k) { *(u32x4*)(lds + k * ASUB + GT_WOFF(lr, tid)) = ra[2 * k]; *(u32x4*)(lds + k * ASUB + 64 * GT_ROWB + GT_WOFF(lr, tid)) = ra[2 * k + 1]; }
    M2_BSTORE(bq[0][0], bq[0][1], 0);
    __syncthreads();
    f32x4 acc[4][2]; ACC_ZERO(acc);
#pragma unroll
    for (int s2 = 0; s2 < 8; ++s2) {
      M2_COMPUTE(s2, s2 & 1);
      if (s2 + 1 < 8) M2_BSTORE(bq[s2 + 1][0], bq[s2 + 1][1], (s2 + 1) & 1);
      if (s2 == 3) M2_EPI(ct0);
      if (s2 == 7) M2_EPI(ct0 + 1);
      __syncthreads();
    }
#undef M2_BLOAD
#undef M2_BSTORE
#undef M2_COMPUTE
#undef M2_EPI
  }
}

typedef float f32x2v __attribute__((ext_vector_type(2)));
DI void phase_s5a(const Params& P_, int l, unsigned char* lds) {
  Params P = P_; { size_t z_ = 0; asm volatile("" : "+s"(z_)); P.ws = P_.ws + z_; }
  TILE_IDS;
  const bf16_t* ub = (const bf16_t*)(P.ws + WS_E); float* Lb = (float*)(P.ws + WS_L);
  const bf16_t* M1 = (const bf16_t*)(P.ws + WS_TAB + (size_t)l * TAB_LAYER + TAB_M1);
  const int first = (int)gridDim.x >= 192 ? 128 : 0;
  for (int tile = bid - first; tile >= 0 && tile < 64; tile += gridDim.x) {
    const int g = tile >> 1, rt = tile & 1;
    const bf16_t* a = ub + ((size_t)g * NT / 64 + rt * 128) * 1024;
    const bf16_t* wt = M1 + (size_t)g * 128 * 1024;
    f32x4 acc[4][2]; ACC_ZERO(acc);
    gemm_kloop(lds, a + (size_t)lr * 1024 + lk, a + (size_t)(lr + 64) * 1024 + lk, 64, wt + (size_t)lr * 1024 + lk, wt + (size_t)(lr + 64) * 1024 + lk, 16, acc);
#pragma unroll
    for (int m = 0; m < 4; ++m)
#pragma unroll
      for (int n = 0; n < 2; ++n) {
        const int R = rt * 128 + wr * 64 + m * 16 + fr, comp = wc * 32 + n * 16 + 4 * fq;
        *(f32x4*)(Lb + ((size_t)(R * 32 + g) * 64) * 2 + comp) = acc[m][n];
      }
  }
}
DI void s5_carry(const Params& P_, int l) {
  Params P = P_; { size_t z_ = 0; asm volatile("" : "+s"(z_)); P.ws = P_.ws + z_; }
  const int tid_ = otid(), bid = obid(), wave = tid_ >> 6, lane = tid_ & 63;
  const int item = (gridDim.x * NWAVE - 1) - (bid * NWAVE + wave);
  if (item >= NB * 32) return;
  const int b = item >> 5, g = item & 31;
  const float* pp = (const float*)(P.ws + WS_S5P) + (size_t)((l * 32 + g) * 64 + lane) * 36;
  const float aTr = pp[2], aTi = pp[3];
  float2* Lp = (float2*)(P.ws + WS_L) + ((size_t)(b * 128) * 32 + g) * 64 + lane;
  unsigned* Sp = (unsigned*)(P.ws + WS_SIN) + ((size_t)(g * 256 + b * 128)) * 64 + lane;
  float sr = 0.f, si = 0.f; asm volatile("" : "+v"(sr), "+v"(si));
  float2 va[8], vb[8];
#define CY_LOAD(vv, c0_) do { _Pragma("unroll") for (int k = 0; k < 8; ++k) vv[k] = Lp[(size_t)((c0_) + k) * 2048]; } while (0)
#define CY_STEP(vv, c0_) do { _Pragma("unroll") for (int k = 0; k < 8; ++k) { Lp[(size_t)((c0_) + k) * 2048] = make_float2(sr, si); Sp[(size_t)((c0_) + k) * 64] = pk2(sr, si); \
      const float nr = aTr * sr - aTi * si + vv[k].x, ni = aTr * si + aTi * sr + vv[k].y; sr = nr; si = ni; } } while (0)
#define CY_PIN(vv) do { _Pragma("unroll") for (int k = 0; k < 8; ++k) asm volatile("" : "+v"(vv[k].x), "+v"(vv[k].y)); } while (0)
  CY_LOAD(va, 0);
#pragma unroll
  for (int c0 = 0; c0 < 128; c0 += 16) {
    CY_LOAD(vb, c0 + 8);
    CY_PIN(va);
    CY_STEP(va, c0);
    if (c0 + 16 < 128) CY_LOAD(va, c0 + 16);
    CY_PIN(vb);
    CY_STEP(vb, c0 + 8);
  }
#undef CY_PIN
#undef CY_LOAD
#undef CY_STEP
}
DI void phase_s5c(const Params& P_, int l, unsigned char* lds) {
  Params P = P_; { size_t z_ = 0; asm volatile("" : "+s"(z_)); P.ws = P_.ws + z_; }
  TILE_IDS;
  const bf16_t* ub = (const bf16_t*)(P.ws + WS_E); const bf16_t* sinb = (const bf16_t*)(P.ws + WS_SIN); bf16_t* yb = (bf16_t*)(P.ws + WS_G);
  const bf16_t* tab = (const bf16_t*)(P.ws + WS_TAB + (size_t)l * TAB_LAYER);
  int* dctr = (int*)(P.ws + 640) + l; int* dslot = (int*)(lds + LDS_BYTES - 32);
  constexpr int ROWB = GT_ROWB, SA = 0, SB = 128 * ROWB, STAGE = 2 * 128 * ROWB;
  const int lkb = (tid & 7) * 16, kch = tid & 7;
  for (;;) {
    if (threadIdx.x == 0) *dslot = atomicAdd(dctr, 1);
    __syncthreads();
    const int tile = *dslot;
    __syncthreads();
    if (tile >= 512) break;
    const int g = tile >> 4, rt = (tile >> 3) & 1, ct = tile & 7;
    const bf16_t* Kt = tab + TAB_KT / 2 + (size_t)g * 64 * 256; const bf16_t* M2 = tab + TAB_M2 / 2 + (size_t)g * 1024 * 128;
    const bf16_t* ua = ub + ((size_t)g * 256 + rt * 128) * 1024; const bf16_t* sa = sinb + ((size_t)g * 256 + rt * 128) * 128;
    const int nbt = 2 * ct + 2 < 16 ? 2 * ct + 2 : 16, ns = nbt + 2;
    u32x4 xa0, xa1, xb0, xb1, ya0, ya1, yb0, yb1;
#define S5_LOAD(p0_, p1_, q0_, q1_, s_) do { \
      if ((s_) < nbt) { p0_ = *(const u32x4*)(ua + (size_t)lr * 1024 + (s_) * 64 + lk); p1_ = *(const u32x4*)(ua + (size_t)(lr + 64) * 1024 + (s_) * 64 + lk); \
        const int i_ = 4 * (s_) + (kch >> 1), hq_ = (kch & 1) * 8; \
        { const int t_ = 8 * ct + (lr >> 4), h_ = lr & 15; q0_ = t_ >= i_ ? *(const u32x4*)(Kt + ((t_ - i_) * 16 + h_) * 16 + hq_) : (u32x4){0u, 0u, 0u, 0u}; } \
        { const int t_ = 8 * ct + 4 + (lr >> 4), h_ = lr & 15; q1_ = t_ >= i_ ? *(const u32x4*)(Kt + ((t_ - i_) * 16 + h_) * 16 + hq_) : (u32x4){0u, 0u, 0u, 0u}; } \
      } else { const int k0_ = ((s_) - nbt) * 64 + lk; \
        p0_ = *(const u32x4*)(sa + (size_t)lr * 128 + k0_); p1_ = *(const u32x4*)(sa + (size_t)(lr + 64) * 128 + k0_); \
        q0_ = *(const u32x4*)(M2 + (size_t)(ct * 128 + lr) * 128 + k0_); q1_ = *(const u32x4*)(M2 + (size_t)(ct * 128 + lr + 64) * 128 + k0_); } } while (0)
#define S5_STORE(p0_, p1_, q0_, q1_, buf) do { unsigned char* s_ = lds + (buf) * STAGE; \
      *(u32x4*)(s_ + SA + GT_WOFF(lr, tid)) = p0_; *(u32x4*)(s_ + SA + 64 * ROWB + GT_WOFF(lr, tid)) = p1_; \
      *(u32x4*)(s_ + SB + GT_WOFF(lr, tid)) = q0_; *(u32x4*)(s_ + SB + 64 * ROWB + GT_WOFF(lr, tid)) = q1_; } while (0)
#define S5_COMPUTE(buf) do { \
      const unsigned char* As = lds + (buf) * STAGE + SA + (wr * 64 + fr) * ROWB; \
      const unsigned char* Bs = lds + (buf) * STAGE + SB + (wc * 32 + fr) * ROWB; \
      _Pragma("unroll") for (int ks = 0; ks < 2; ++ks) { \
        bf16x8 af[4], bfr[2]; \
        _Pragma("unroll") for (int m = 0; m < 4; ++m) af[m] = *(const bf16x8*)(As + m * 16 * ROWB + GT_RSW(ks, fq, fr)); \
        _Pragma("unroll") for (int n = 0; n < 2; ++n) bfr[n] = *(const bf16x8*)(Bs + n * 16 * ROWB + GT_RSW(ks, fq, fr)); \
        _Pragma("unroll") for (int m = 0; m < 4; ++m) _Pragma("unroll") for (int n = 0; n < 2; ++n) acc[m][n] = __builtin_amdgcn_mfma_f32_16x16x32_bf16(bfr[n], af[m], acc[m][n], 0, 0, 0); } } while (0)
    f32x4 acc[4][2]; ACC_ZERO(acc);
    S5_LOAD(xa0, xa1, xb0, xb1, 0); S5_STORE(xa0, xa1, xb0, xb1, 0); S5_LOAD(ya0, ya1, yb0, yb1, 1); __syncthreads();
    for (int st = 0; st < ns; st += 2) {
      if (st + 2 < ns) S5_LOAD(xa0, xa1, xb0, xb1, st + 2);
      S5_COMPUTE(0);
      if (st + 1 < ns) S5_STORE(ya0, ya1, yb0, yb1, 1);
      __syncthreads();
      if (st + 1 >= ns) break;
      if (st + 3 < ns) S5_LOAD(ya0, ya1, yb0, yb1, st + 3);
      S5_COMPUTE(1);
      if (st + 2 < ns) S5_STORE(xa0, xa1, xb0, xb1, 0);
      __syncthreads();
    }
#undef S5_LOAD
#undef S5_STORE
#undef S5_COMPUTE
    const float* dsk = P.in[13] + (size_t)(l * 32 + g) * 16;
#pragma unroll
    for (int m = 0; m < 4; ++m)
#pragma unroll
      for (int n = 0; n < 2; ++n) {
        const int R = rt * 128 + wr * 64 + m * 16 + fr, col = ct * 128 + wc * 32 + n * 16 + 4 * fq, t = col >> 4, h = col & 15;
        const u32x2 uu = *(const u32x2*)(ub + ((size_t)g * 256 + R) * 1024 + col); const f32x4 dd = *(const f32x4*)(dsk + h); const f32x4 v = acc[m][n];
        const float y0 = gelu_tanh(v.x + dd.x * bflo(uu.x)), y1 = gelu_tanh(v.y + dd.y * bfhi(uu.x)), y2 = gelu_tanh(v.z + dd.z * bflo(uu.y)), y3 = gelu_tanh(v.w + dd.w * bfhi(uu.y));
        const size_t tokn = (size_t)(R >> 7) * SEQ + 64 * (R & 127) + t;
        u32x2 o; o.x = pk2(y0, y1); o.y = pk2(y2, y3); *(u32x2*)(yb + tokn * 512 + g * 16 + h) = o;
      }
  }
}

constexpr int AT_ROWB = 144, AT_KS = 0, AT_VS = 2 * 64 * AT_ROWB, AT_IMP = 4 * 64 * AT_ROWB, AT_OACC = AT_IMP, AT_IMPS = 129, AT_EE = AT_IMP + 64 * AT_IMPS * 4,
              AT_SEL = AT_IMP + 66048, AT_QS = AT_SEL + 1024, AT_QL = AT_QS + 32768, AT_NJ = AT_QL + 8192, AT_ITEMS = AT_NJ + 512, AT_MREF = AT_ITEMS + 512,
              AT_LACC = AT_MREF + 1024, AT_INVQ = AT_LACC + 1024, AT_MISC = AT_INVQ + 512, AT_LOWN = AT_MISC + 64, AT_END = AT_LOWN + 1024;
static_assert(AT_END <= LDS_BYTES - 16, "attention LDS");
#define MFMA32(a, b, c) __builtin_amdgcn_mfma_f32_32x32x16_bf16((a), (b), (c), 0, 0, 0)
DI int crow_of(int reg, int hh) { return (reg & 3) + 8 * (reg >> 2) + 4 * hh; }

struct AttnState { f32x16 o0, o1; float m, l; };
DI void st_init(AttnState& S) { S.m = -1e30f; S.l = 0.f;
#pragma unroll
  for (int i = 0; i < 16; ++i) { S.o0[i] = 0.f; S.o1[i] = 0.f; } }

DI void at_ldk(const unsigned char* lds, int buf, int r, int hh, bf16x8 (&kf)[8]) {
  const unsigned char* kb = lds + AT_KS + buf * 64 * AT_ROWB + r * AT_ROWB + hh * 16;
#pragma unroll
  for (int ds = 0; ds < 4; ++ds) { kf[ds] = *(const bf16x8*)(kb + ds * 32); kf[4 + ds] = *(const bf16x8*)(kb + 32 * AT_ROWB + ds * 32); }
}
DI void at_ldv(const unsigned char* lds, int buf, int r, int hh, bf16x8 (&vf)[8]) {
  const unsigned char* vb = lds + AT_VS + buf * 64 * AT_ROWB + r * AT_ROWB + hh * 16;
#pragma unroll
  for (int gk = 0; gk < 4; ++gk) { vf[gk] = *(const bf16x8*)(vb + gk * 32); vf[4 + gk] = *(const bf16x8*)(vb + 32 * AT_ROWB + gk * 32); }
}
DI void at_qk(const bf16x8 (&kf)[8], const bf16x8 (&qf)[4], f32x16& p0, f32x16& p1) {
  const f32x16 z = {0.f, 0.f, 0.f, 0.f, 0.f, 0.f, 0.f, 0.f, 0.f, 0.f, 0.f, 0.f, 0.f, 0.f, 0.f, 0.f};
#pragma unroll
  for (int ds = 0; ds < 4; ++ds) { if (ds == 0) { p0 = MFMA32(kf[0], qf[0], z); p1 = MFMA32(kf[4], qf[0], z); } else { p0 = MFMA32(kf[ds], qf[ds], p0); p1 = MFMA32(kf[4 + ds], qf[ds], p1); } }
}
DI bf16x8 pack8(const f32x16& p, int s2) {
  u32x4 w; w.x = pk2(p[8 * s2], p[8 * s2 + 1]); w.y = pk2(p[8 * s2 + 2], p[8 * s2 + 3]); w.z = pk2(p[8 * s2 + 4], p[8 * s2 + 5]); w.w = pk2(p[8 * s2 + 6], p[8 * s2 + 7]);
  return __builtin_bit_cast(bf16x8, w);
}
DI void at_pv(const bf16x8 (&vf)[8], const f32x16& p0, const f32x16& p1, f32x16& oa, f32x16& ob) {
#pragma unroll
  for (int gk = 0; gk < 4; ++gk) {
    const bf16x8 pb = (gk < 2) ? pack8(p0, gk & 1) : pack8(p1, gk & 1);
    oa = MFMA32(vf[gk], pb, oa); ob = MFMA32(vf[4 + gk], pb, ob);
  }
}
template <int MODE>
DI void at_online(AttnState& S, f32x16& p0, f32x16& p1, int key0, int lo, int hi, bool on, int hh) {
  float tm = -1e30f;
  if (MODE == 1) {
    int lor = lo - key0 - 4 * hh, hir = hi - key0 - 4 * hh;
    if (hir < lor) { lor = 4096; hir = 4096; }
    const unsigned span = (unsigned)(hir - lor);
#pragma unroll
    for (int i = 0; i < 16; ++i) { const int c0 = (i & 3) + 8 * (i >> 2);
      p0[i] = ((unsigned)(c0 - lor) <= span) ? p0[i] : -1e30f; p1[i] = ((unsigned)(c0 + 32 - lor) <= span) ? p1[i] : -1e30f; }
  }
  if (MODE != 1) asm volatile("s_nop 15\n\ts_nop 7" : "+v"(tm) : "v"(p0[15]), "v"(p1[15]));
#define MX3_8(o_) asm("v_max3_f32 %0, %0, %1, %2\n\tv_max3_f32 %0, %0, %3, %4\n\tv_max3_f32 %0, %0, %5, %6\n\tv_max3_f32 %0, %0, %7, %8\n\tv_max3_f32 %0, %0, %9, %10\n\tv_max3_f32 %0, %0, %11, %12\n\tv_max3_f32 %0, %0, %13, %14\n\tv_max3_f32 %0, %0, %15, %16" \
      : "+v"(tm) : "v"(p0[o_]), "v"(p1[o_]), "v"(p0[o_ + 1]), "v"(p1[o_ + 1]), "v"(p0[o_ + 2]), "v"(p1[o_ + 2]), "v"(p0[o_ + 3]), "v"(p1[o_ + 3]), "v"(p0[o_ + 4]), "v"(p1[o_ + 4]), "v"(p0[o_ + 5]), "v"(p1[o_ + 5]), "v"(p0[o_ + 6]), "v"(p1[o_ + 6]), "v"(p0[o_ + 7]), "v"(p1[o_ + 7]))
  MX3_8(0); MX3_8(8);
#undef MX3_8
  tm = x32_max(tm);
  if (MODE == 2) tm = on ? tm : -1e30f;
  if (__any(tm > S.m)) {
    const float mn = fmaxf(S.m, tm); const float al = __builtin_amdgcn_exp2f(S.m - mn); S.m = mn; S.l *= al;
#pragma unroll
    for (int i = 0; i < 16; ++i) { S.o0[i] *= al; S.o1[i] *= al; }
  }
  float mn = S.m;
  if (MODE == 2) mn = on ? mn : 1e30f;
  if (MODE == 1) mn = mn < -1e29f ? 1e30f : mn;
  float rs = 0.f;
#pragma unroll
  for (int i = 0; i < 16; ++i) {
    const float e0 = __builtin_amdgcn_exp2f(p0[i] - mn), e1 = __builtin_amdgcn_exp2f(p1[i] - mn);
    p0[i] = e0; p1[i] = e1; rs += e0 + e1;
  }
  S.l += rs;
}

DI void attn_tile(const Params& P_, unsigned char* lds, int b, int g, int c) {
  Params P = P_; { size_t z_ = 0; asm volatile("" : "+s"(z_)); P.ws = P_.ws + z_; }
#define AT_IDS const int tid = otid(), lane = tid & 63, w = tid >> 6, r = lane & 31, hh = lane >> 5, qi = 8 * w + (r >> 2), h = r & 3, t = 64 * c + qi, qrow = 32 * w + r, srow = tid >> 3, sch = (tid & 7) * 8, ahead = lane >> 4, ach = lane & 15; const unsigned tok = (unsigned)b * SEQ + t, goff = tok * 48 + g * 4 + h; (void)qi; (void)h; (void)t; (void)qrow; (void)srow; (void)sch; (void)ahead; (void)ach; (void)tok; (void)goff; (void)hh; (void)w; (void)r
  const bf16_t* qb = (const bf16_t*)(P.ws + WS_B); const bf16_t* kvk = (const bf16_t*)(P.ws + WS_C); const bf16_t* vT = (const bf16_t*)(P.ws + WS_DV);
  const bf16_t* kcb = (const bf16_t*)(P.ws + WS_KC); const bf16_t* vcb = (const bf16_t*)(P.ws + WS_VC);
  const float* gbase = (const float*)(P.ws + WS_GATES);
#define gates(i) gbase[goff + (i)]
  bf16_t* attn = (bf16_t*)(P.ws + WS_A);
  float* otb = (float*)(P.ws + WS_OT) + (size_t)obid() * 16384;
#define otg(i) otb[(unsigned)tid + (i) * 512u]
  float* IMP = (float*)(lds + AT_IMP); float* EE = (float*)(lds + AT_EE); unsigned* SEL = (unsigned*)(lds + AT_SEL);
  AttnState S; f32x16 p0, p1; u32x4 rkA, rvA; bf16x8 qf[4], kfr[8], vfr[8];
#define QF_LOAD() do { _Pragma("unroll") for (int ds_ = 0; ds_ < 4; ++ds_) qf[ds_] = *(const bf16x8*)(lds + AT_QS + qrow * 128 + (((ds_ * 2 + hh) ^ (qrow & 7)) * 16)); } while (0)
#define AT_QKV() do { at_ldk(lds, buf_, r, hh, kfr); __builtin_amdgcn_sched_barrier(0); at_qk(kfr, qf, p0, p1); at_ldv(lds, buf_, r, hh, vfr); __builtin_amdgcn_sched_barrier(0); } while (0)
  { AT_IDS;
  { const int row = tid >> 1, half = tid & 1, q_i = row >> 2, hd = row & 3;
    const unsigned so = ((unsigned)b * SEQ + 64 * c + q_i) * DM + (g * 4 + hd) * 64 + half * 32;
#pragma unroll
    for (int k = 0; k < 4; ++k) { const u32x4 v = *(const u32x4*)(qb + so + k * 8); *(u32x4*)(lds + AT_QS + row * 128 + (((half * 4 + k) ^ (row & 7)) * 16)) = v; } }
  __syncthreads();
  QF_LOAD();
#define ST_LOAD(rk, rv, kp, kstride, vp, vstride, kt) do { rk = *(const u32x4*)((kp) + (unsigned)(((kt) * 64 + srow) * (kstride) + sch)); rv = *(const u32x4*)((vp) + (unsigned)(srow * (vstride) + (kt) * 64 + sch)); } while (0)
#define ST_STORE(rk, rv, buf) do { *(u32x4*)(lds + AT_KS + (buf) * 64 * AT_ROWB + srow * AT_ROWB + sch * 2) = rk; *(u32x4*)(lds + AT_VS + (buf) * 64 * AT_ROWB + srow * AT_ROWB + sch * 2) = rv; } while (0)
#define SWEEP(kp, kstride, vp, vstride, kt0, n, ...) do { \
    ST_LOAD(rkA, rvA, kp, kstride, vp, vstride, (kt0)); ST_STORE(rkA, rvA, 0); __syncthreads(); \
    for (int i_ = 0; i_ < (n); ++i_) { \
      if (i_ + 1 < (n)) ST_LOAD(rkA, rvA, kp, kstride, vp, vstride, (kt0) + i_ + 1); \
      { const int step_ = i_; const int buf_ = i_ & 1; __VA_ARGS__ } \
      if (i_ + 1 < (n)) ST_STORE(rkA, rvA, (i_ + 1) & 1); \
      __syncthreads(); \
    } } while (0)
#define ST_LOADF(rk, rv, kt) do { rk = *(const u32x4*)(kps + (size_t)(kt) * 4096 + tid * 8); rv = *(const u32x4*)(vps + (size_t)(kt) * 4096 + tid * 8); } while (0)
#define ST_STOREF(rk, rv, buf) do { const int fo_ = ((tid >> 8) * 32 + (tid & 31)) * AT_ROWB + (((tid >> 6) & 3) * 2 + ((tid >> 5) & 1)) * 16; \
    *(u32x4*)(lds + AT_KS + (buf) * 64 * AT_ROWB + fo_) = rk; *(u32x4*)(lds + AT_VS + (buf) * 64 * AT_ROWB + fo_) = rv; } while (0)
#define SWEEPF(kt0, n, ...) do { \
    ST_LOADF(rkA, rvA, (kt0)); ST_STOREF(rkA, rvA, 0); __syncthreads(); \
    for (int i_ = 0; i_ < (n); ++i_) { \
      if (i_ + 1 < (n)) ST_LOADF(rkA, rvA, (kt0) + i_ + 1); \
      { const int step_ = i_; const int buf_ = i_ & 1; __VA_ARGS__ } \
      if (i_ + 1 < (n)) ST_STOREF(rkA, rvA, (i_ + 1) & 1); \
      __syncthreads(); \
    } } while (0)
  {
    const bf16_t* kp = kvk + (size_t)b * SEQ * DM + 3 * 256 + g * 64; const bf16_t* vp = vT + (size_t)(((1 * NB + b) * 4 + g) * 64) * SEQ;
    const int j0 = c >= 8 ? c - 8 : 0, nj = c - j0 + 1;
    st_init(S);
    SWEEP(kp, DM, vp, SEQ, j0, nj, {
      AT_QKV();
      if ((step_ == 0 && c >= 8) || step_ == nj - 1) at_online<1>(S, p0, p1, (j0 + step_) * 64, t - 511, t, true, hh);
      else at_online<0>(S, p0, p1, 0, 0, 0, true, hh);
      at_pv(vfr, p0, p1, S.o0, S.o1); });
    const float lt = x32_sum(S.l); const float sc = lt > 0.f ? gates(32) / lt : 0.f;
#pragma unroll
    for (int i = 0; i < 16; ++i) { otg(i) = S.o0[i] * sc; otg(16 + i) = S.o1[i] * sc; }
  }
  {
    const bf16_t* kcp = kcb + (size_t)((b * 4 + g) * 512) * 64; const bf16_t* vcp = vcb + (size_t)((b * 4 + g) * 64) * 512;
    const int nmax = t >= 31 ? (t - 31) >> 4 : -1;
    const int nct = (4 * c + 2) / 64 + 1;
    st_init(S);
    SWEEP(kcp, 64, vcp, 512, 0, nct, {
      at_ldk(lds, buf_, r, hh, kfr); __builtin_amdgcn_sched_barrier(0); at_qk(kfr, qf, p0, p1);
      if (64 * step_ + 63 <= 4 * c - 2) at_online<0>(S, p0, p1, 0, 0, 0, true, hh);
      else at_online<1>(S, p0, p1, step_ * 64, 0, nmax, true, hh); });
    const float lt = x32_sum(S.l);
    const float cinv = lt > 0.f ? 1.f / lt : 0.f; const float cm = S.m;
    st_init(S);
    SWEEP(kcp, 64, vcp, 512, 0, nct, {
      AT_QKV();
      if (64 * step_ + 63 <= 4 * c - 2) {
        _Pragma("unroll") for (int k = 0; k < 16; ++k) { p0[k] = __builtin_amdgcn_exp2f(p0[k] - cm) * cinv; p1[k] = __builtin_amdgcn_exp2f(p1[k] - cm) * cinv; }
      } else {
        const int nrel = nmax - step_ * 64 - 4 * hh;
        _Pragma("unroll") for (int k = 0; k < 16; ++k) { const int c0 = (k & 3) + 8 * (k >> 2), c1 = c0 + 32;
          p0[k] = c0 <= nrel ? __builtin_amdgcn_exp2f(p0[k] - cm) * cinv : 0.f; p1[k] = c1 <= nrel ? __builtin_amdgcn_exp2f(p1[k] - cm) * cinv : 0.f; }
      }
      at_pv(vfr, p0, p1, S.o0, S.o1);
      _Pragma("unroll") for (int kh = 0; kh < 2; ++kh)
      _Pragma("unroll") for (int gi = 0; gi < 4; ++gi) {
          float g4 = kh == 0 ? (p0[4 * gi] + p0[4 * gi + 1]) + (p0[4 * gi + 2] + p0[4 * gi + 3]) : (p1[4 * gi] + p1[4 * gi + 1]) + (p1[4 * gi + 2] + p1[4 * gi + 3]);
          float e3 = kh == 0 ? p0[4 * gi + 3] : p1[4 * gi + 3];
          g4 += dppf<DPP_X1>(g4); g4 += dppf<DPP_X2>(g4); e3 += dppf<DPP_X1>(e3); e3 += dppf<DPP_X2>(e3);
          if (h == 0) { const int s = (step_ * 64 + kh * 32 + 8 * gi + 4 * hh) >> 2; IMP[qi * AT_IMPS + s] = g4; EE[qi * AT_IMPS + s] = e3; }
      } });
    const float gc = gates(0);
#pragma unroll
    for (int i = 0; i < 16; ++i) { p0[i] = otg(i); p1[i] = otg(16 + i); }
    __builtin_amdgcn_sched_barrier(0);
#pragma unroll
    for (int i = 0; i < 16; ++i) { otg(i) = p0[i] + S.o0[i] * gc; otg(16 + i) = p1[i] + S.o1[i] * gc; }
  }
  }
  const bf16_t* kps = (const bf16_t*)(P.ws + WS_KSF) + (size_t)((b * 4 + g) * 128) * 4096; const bf16_t* vps = vT + (size_t)((b * 4 + g) * 128) * 4096;
  if (c <= 15) { AT_IDS; QF_LOAD();
    st_init(S);
    if (c > 0) {
      SWEEPF(0, c, {
        AT_QKV();
        at_online<0>(S, p0, p1, 0, 0, 0, true, hh);
        at_pv(vfr, p0, p1, S.o0, S.o1); });
    }
    SWEEPF(c, 1, {
      AT_QKV();
      at_online<1>(S, p0, p1, (c + step_) * 64, 0, t, true, hh);
      at_pv(vfr, p0, p1, S.o0, S.o1); });
    const float lt = x32_sum(S.l); const float slc_sc = lt > 0.f ? gates(16) / lt : 0.f;
    bf16_t* op = attn + (tok * DM + (g * 4 + h) * 64);
#pragma unroll
    for (int i = 0; i < 16; ++i) { S.o0[i] = S.o0[i] * slc_sc + otg(i); S.o1[i] = S.o1[i] * slc_sc + otg(16 + i); }
#pragma unroll
    for (int gi = 0; gi < 4; ++gi) {
      u32x2 a; a.x = pk2(S.o0[4 * gi], S.o0[4 * gi + 1]); a.y = pk2(S.o0[4 * gi + 2], S.o0[4 * gi + 3]);
      u32x2 bq; bq.x = pk2(S.o1[4 * gi], S.o1[4 * gi + 1]); bq.y = pk2(S.o1[4 * gi + 2], S.o1[4 * gi + 3]);
      *(u32x2*)(op + 8 * gi + 4 * hh) = a; *(u32x2*)(op + 32 + 8 * gi + 4 * hh) = bq;
    }
  } else {
    const int nc = c - 2;
    unsigned char* QL = lds + AT_QL; int* NJ = (int*)(lds + AT_NJ); unsigned short* ITEMS = (unsigned short*)(lds + AT_ITEMS); int* MISC = (int*)(lds + AT_MISC);
    float* MREF = (float*)(lds + AT_MREF); float* LS = (float*)(lds + AT_LACC); unsigned char* INVQ = lds + AT_INVQ; unsigned char* SLOT = lds + AT_IMP;
    float* const LOWN = (float*)(lds + AT_LOWN); const float k64 = 5.421010862427522e-20f;
    { AT_IDS;
    { const int q = tid >> 3; for (int s = 1 + (tid & 7); s <= nc; s += 8) IMP[q * AT_IMPS + s] += EE[q * AT_IMPS + s - 1]; }
    if (tid < 256) SEL[tid] = 0u;
    if (tid < 128) ((unsigned*)INVQ)[tid] = 0u;
    __syncthreads();
    {
      const int q = tid >> 3, sub = tid & 7; const float* ip = IMP + q * AT_IMPS;
      unsigned key[16];
#pragma unroll
      for (int k = 0; k < 16; ++k) { const int s = 1 + sub + 8 * k; key[k] = s <= nc ? __float_as_uint(ip[s]) + 1u : 0u; }
      unsigned T = 0u;
      for (int bit = 30; bit >= 0; --bit) {
        const unsigned cand = T | (1u << bit); int cn = 0;
#pragma unroll
        for (int k = 0; k < 16; ++k) cn += key[k] >= cand ? 1 : 0;
        cn = sum8i(cn);
        if (cn >= 13) T = cand;
      }
      int ngt = 0, neq = 0;
#pragma unroll
      for (int k = 0; k < 16; ++k) { ngt += key[k] > T ? 1 : 0; neq += key[k] == T ? 1 : 0; }
      ngt = sum8i(ngt); neq = sum8i(neq);
      const int need = 13 - ngt;
      unsigned w0 = 0u, w1 = 0u, w2 = 0u, w3 = 0u;
      if (!__any(neq > need)) {
#pragma unroll
        for (int k = 0; k < 16; ++k) if (key[k] >= T && key[k] != 0u) { const int s = 1 + sub + 8 * k; const unsigned bt = 1u << (s & 31); if (s < 32) w0 |= bt; else if (s < 64) w1 |= bt; else if (s < 96) w2 |= bt; else w3 |= bt; }
      } else {
        int taken = 0; const int gsh = lane & ~7;
#pragma unroll
        for (int k = 0; k < 16; ++k) {
          const bool eq = key[k] == T && key[k] != 0u; const unsigned long long mk = __ballot(eq);
          const unsigned grp = (unsigned)(mk >> gsh) & 0xffu; const int before = __popc(grp & ((1u << sub) - 1u));
          const bool pick = key[k] > T || (eq && taken + before < need);
          taken += __popc(grp);
          if (pick) { const int s = 1 + sub + 8 * k; const unsigned bt = 1u << (s & 31); if (s < 32) w0 |= bt; else if (s < 64) w1 |= bt; else if (s < 96) w2 |= bt; else w3 |= bt; }
        }
      }
      if (w0) atomicOr(&SEL[q * 4], w0); if (w1) atomicOr(&SEL[q * 4 + 1], w1); if (w2) atomicOr(&SEL[q * 4 + 2], w2); if (w3) atomicOr(&SEL[q * 4 + 3], w3);
    }
    __syncthreads();
    for (int j = 1 + w; j <= nc; j += NWAVE) {
      const bool bit = (SEL[lane * 4 + (j >> 5)] >> (j & 31)) & 1u;
      const unsigned long long mk = __ballot(bit);
      const int rank = __builtin_amdgcn_mbcnt_hi((unsigned)(mk >> 32), __builtin_amdgcn_mbcnt_lo((unsigned)mk, 0u));
      if (bit) QL[j * 64 + rank] = (unsigned char)lane;
      const int cnt = __popcll(mk);
      if (lane < ((8 - (cnt & 7)) & 7)) QL[j * 64 + cnt + lane] = 0;
      if (lane == 0) NJ[j] = cnt;
    }
    __syncthreads();
    if (w == 0) {
      const int ja = 1 + lane, jb = 65 + lane;
      const int ca = ja <= nc ? (NJ[ja] + 7) >> 3 : 0, cb = jb <= nc ? (NJ[jb] + 7) >> 3 : 0;
      int sa = ca, sb = cb;
#pragma unroll
      for (int o = 1; o < 64; o <<= 1) { const int ta = __shfl_up(sa, o), tb = __shfl_up(sb, o); if (lane >= o) { sa += ta; sb += tb; } }
      const int tota = __shfl(sa, 63);
      for (int k = 0; k < ca; ++k) ITEMS[sa - ca + k] = (unsigned short)(ja * 8 + k);
      for (int k = 0; k < cb; ++k) ITEMS[tota + sb - cb + k] = (unsigned short)(jb * 8 + k);
      if (lane == 63) MISC[0] = tota + sb;
    }
    }
    { AT_IDS; QF_LOAD();
    st_init(S);
    SWEEPF(0, 1, {
      AT_QKV();
      at_online<0>(S, p0, p1, 0, 0, 0, true, hh);
      at_pv(vfr, p0, p1, S.o0, S.o1); });
    SWEEPF(c - 1, 2, {
      AT_QKV();
      if (step_ == 1) at_online<1>(S, p0, p1, c * 64, 0, t, true, hh); else at_online<0>(S, p0, p1, 0, 0, 0, true, hh);
      at_pv(vfr, p0, p1, S.o0, S.o1); });
    { const float lt = x32_sum(S.l);
      if (hh == 0) { MREF[qrow] = S.m + 64.f; LS[w * 32 + r] = lt * k64; } }
#define SLOT_WRITE(x, o0_, o1_, scale_) do { unsigned char* sp_ = SLOT + (x) * 8192 + r * 256; \
      _Pragma("unroll") for (int gi_ = 0; gi_ < 4; ++gi_) { \
        const f32x4 va_ = {o0_[4 * gi_] * (scale_), o0_[4 * gi_ + 1] * (scale_), o0_[4 * gi_ + 2] * (scale_), o0_[4 * gi_ + 3] * (scale_)}; \
        const f32x4 vb_ = {o1_[4 * gi_] * (scale_), o1_[4 * gi_ + 1] * (scale_), o1_[4 * gi_ + 2] * (scale_), o1_[4 * gi_ + 3] * (scale_)}; \
        *(f32x4*)(sp_ + (((2 * gi_ + hh) ^ (r & 15)) * 16)) = va_; *(f32x4*)(sp_ + (((8 + 2 * gi_ + hh) ^ (r & 15)) * 16)) = vb_; } } while (0)
#define SLOT_READ(x, col_) (*(const f32x4*)(SLOT + (x) * 8192 + (col_) * 256 + ((ach ^ ((col_) & 15)) * 16)))
    SLOT_WRITE(w, S.o0, S.o1, k64);
    __syncthreads();
    }
    {
      AT_IDS; const int wu = __builtin_amdgcn_readfirstlane(w);
      const int nitems = MISC[0], nrounds = (nitems + 3) >> 2;
      if (wu >= 4) {
        const int ow = wu - 4, oq = lane >> 2, oh = lane & 3, srcslot = 2 * ow + (lane >> 5), scol = lane & 31;
        f32x4 acc[16]; float accl;
        { const unsigned char* rp = SLOT + srcslot * 8192 + scol * 256;
#pragma unroll
          for (int k = 0; k < 16; ++k) acc[k] = *(const f32x4*)(rp + ((k ^ (scol & 15)) * 16));
          accl = LS[srcslot * 32 + scol]; }
        __syncthreads();
        for (int rd = 0; rd <= nrounds; ++rd) {
          if (rd > 0) {
            const int set = (rd - 1) & 1;
            unsigned* ivp = (unsigned*)(INVQ + set * 256) + 16 * ow + oq;
            unsigned iv = *ivp;
            if (__any(iv != 0u)) {
              if (iv != 0u && oh == 0) *ivp = 0u;
              do {
                const int x = (iv & 0xffu) ? 0 : (iv & 0xff00u) ? 1 : (iv & 0xff0000u) ? 2 : 3;
                const unsigned byte = (iv >> (8 * x)) & 0xffu;
                iv &= ~(0xffu << (8 * x));
                if (byte) {
                  const int col = (int)(byte - 1) * 4 + oh;
                  const unsigned char* rp = SLOT + (set * 4 + x) * 8192 + col * 256;
                  f32x4 tq[16];
#pragma unroll
                  for (int k = 0; k < 16; ++k) tq[k] = *(const f32x4*)(rp + ((k ^ (col & 15)) * 16));
                  const float tl = LS[(set * 4 + x) * 32 + col];
                  __builtin_amdgcn_sched_barrier(0);
#pragma unroll
                  for (int k = 0; k < 16; ++k) acc[k] += tq[k];
                  accl += tl;
                }
              } while (__any(iv != 0u));
            }
          }
          __syncthreads();
        }
#pragma unroll
        for (int i = 0; i < 16; ++i) { S.o0[i] = otg(i); S.o1[i] = otg(16 + i); }
        SLOT_WRITE(w, S.o0, S.o1, 1.0f);
        __syncthreads();
        {
          const unsigned tq = (unsigned)b * SEQ + 64 * c + 16 * ow + oq;
          const float gs = gbase[tq * 48 + 16 + g * 4 + oh]; const float sc = accl > 0.f ? gs / accl : 0.f;
          const unsigned char* rp = SLOT + srcslot * 8192 + scol * 256;
          bf16_t* op = attn + (tq * DM + (g * 4 + oh) * 64);
#pragma unroll
          for (int k2 = 0; k2 < 8; ++k2) {
            const f32x4 v0 = acc[2 * k2] * sc + *(const f32x4*)(rp + (((2 * k2) ^ (scol & 15)) * 16)), v1 = acc[2 * k2 + 1] * sc + *(const f32x4*)(rp + (((2 * k2 + 1) ^ (scol & 15)) * 16));
            u32x4 o; o.x = pk2(v0.x, v0.y); o.y = pk2(v0.z, v0.w); o.z = pk2(v1.x, v1.y); o.w = pk2(v1.z, v1.w);
            *(u32x4*)(op + 8 * k2) = o;
          }
        }
      } else {
        __syncthreads();
        const bf16_t* kgl = kps + lane * 8; const bf16_t* vgl = vps + lane * 8;
        bf16x8 kfA[8], vfA[8], kfB[8], vfB[8];
#define FLOAD(KF, VF, jj) do { _Pragma("unroll") for (int f_ = 0; f_ < 8; ++f_) { KF[f_] = *(const bf16x8*)(kgl + (size_t)(jj) * 4096 + f_ * 512); VF[f_] = *(const bf16x8*)(vgl + (size_t)(jj) * 4096 + f_ * 512); } } while (0)
        int rowc = 0, qqc = 0; bool validc = false; float mrc = 1e30f; int en = 0;
        if (wu < nitems) { const int e0 = ITEMS[wu]; const int j0_ = e0 >> 3; const int qs_ = 8 * (e0 & 7) + (r >> 2); validc = qs_ < NJ[j0_]; qqc = QL[j0_ * 64 + qs_]; rowc = qqc * 4 + h; mrc = validc ? MREF[rowc] : 1e30f; FLOAD(kfA, vfA, j0_); }
        if (wu + 4 < nitems) en = __builtin_amdgcn_readfirstlane(ITEMS[wu + 4]);
        FLOAD(kfB, vfB, en >> 3);
#define ITEM_ROUND(KF, VF, rd_) do { \
          const int it = (rd_) * 4 + wu, set = (rd_) & 1; \
          if (it < nitems) { \
            const bool hasn = it + 4 < nitems; \
            const int jn = en >> 3, qsn = 8 * (en & 7) + (r >> 2);        \
            bf16x8 qv[4];                                               \
            _Pragma("unroll") for (int ds = 0; ds < 4; ++ds) qv[ds] = *(const bf16x8*)(lds + AT_QS + rowc * 128 + (((ds * 2 + hh) ^ (rowc & 7)) * 16)); \
            const int njn = NJ[jn]; const int qqn = QL[jn * 64 + qsn]; \
            const int en2 = it + 8 < nitems ? __builtin_amdgcn_readfirstlane(ITEMS[it + 8]) : 0; const int j2 = en2 >> 3; \
            __builtin_amdgcn_sched_barrier(0); \
            const f32x16 z = {0.f, 0.f, 0.f, 0.f, 0.f, 0.f, 0.f, 0.f, 0.f, 0.f, 0.f, 0.f, 0.f, 0.f, 0.f, 0.f}; \
            _Pragma("unroll") for (int ds = 0; ds < 4; ++ds) { \
              if (ds == 0) { p0 = MFMA32(KF[0], qv[0], z); p1 = MFMA32(KF[4], qv[0], z); } else { p0 = MFMA32(KF[ds], qv[ds], p0); p1 = MFMA32(KF[4 + ds], qv[ds], p1); } \
            } \
            const bool validn = hasn && qsn < njn; const int rown = qqn * 4 + h; \
            const float mrn = validn ? MREF[rown] : 1e30f; \
            float rs = 0.f; \
            _Pragma("unroll") for (int i = 0; i < 16; ++i) { \
              p0[i] = __builtin_amdgcn_exp2f(fminf(p0[i] - mrc, 120.f)); p1[i] = __builtin_amdgcn_exp2f(fminf(p1[i] - mrc, 120.f)); rs += p0[i] + p1[i]; \
              if (i & 1) { KF[i >> 1] = *(const bf16x8*)(kgl + (size_t)j2 * 4096 + (i >> 1) * 512); __builtin_amdgcn_sched_barrier(0); } \
            } \
            rs = x32_sum(rs); \
            f32x16 o0 = z, o1 = z; \
            _Pragma("unroll") for (int gk = 0; gk < 4; ++gk) { const bf16x8 pb = (gk < 2) ? pack8(p0, gk & 1) : pack8(p1, gk & 1); o0 = MFMA32(VF[gk], pb, o0); o1 = MFMA32(VF[4 + gk], pb, o1); } \
            { unsigned char* sp_ = SLOT + (set * 4 + wu) * 8192 + r * 256; \
              _Pragma("unroll") for (int gi = 0; gi < 4; ++gi) { \
                const f32x4 va_ = {o0[4 * gi], o0[4 * gi + 1], o0[4 * gi + 2], o0[4 * gi + 3]}; const f32x4 vb_ = {o1[4 * gi], o1[4 * gi + 1], o1[4 * gi + 2], o1[4 * gi + 3]}; \
                *(f32x4*)(sp_ + (((2 * gi + hh) ^ (r & 15)) * 16)) = va_; *(f32x4*)(sp_ + (((8 + 2 * gi + hh) ^ (r & 15)) * 16)) = vb_; \
                VF[2 * gi] = *(const bf16x8*)(vgl + (size_t)j2 * 4096 + (2 * gi) * 512); VF[2 * gi + 1] = *(const bf16x8*)(vgl + (size_t)j2 * 4096 + (2 * gi + 1) * 512); \
                __builtin_amdgcn_sched_barrier(0); \
              } } \
            if (hh == 0) LS[(set * 4 + wu) * 32 + r] = rs; \
            if (validc && h == 0 && hh == 0) INVQ[set * 256 + qqc * 4 + wu] = (unsigned char)((r >> 2) + 1); \
            rowc = rown; qqc = qqn; validc = validn; mrc = mrn; en = en2; \
          } } while (0)
        for (int rd = 0; rd < nrounds; rd += 2) {
          ITEM_ROUND(kfA, vfA, rd);
          __syncthreads();
          if (rd + 1 < nrounds) {
            ITEM_ROUND(kfB, vfB, rd + 1);
            __syncthreads();
          }
        }
#undef ITEM_ROUND
#undef FLOAD
#undef ITEM_META
#undef KLOAD
#undef VLOAD
        __syncthreads();
#pragma unroll
        for (int i = 0; i < 16; ++i) { S.o0[i] = otg(i); S.o1[i] = otg(16 + i); }
        SLOT_WRITE(w, S.o0, S.o1, 1.0f);
        __syncthreads();
      }
    }
#undef SLOT_WRITE
#undef SLOT_READ
  }
  __syncthreads();
#undef ST_LOAD
#undef ST_STORE
#undef SWEEP
#undef ST_LOADF
#undef ST_STOREF
#undef SWEEPF
#undef gates
#undef otg
#undef QF_LOAD
#undef AT_QKV
#undef AT_IDS
}
DI void phase_attn(const Params& P_, unsigned char* lds) {
  Params P = P_; { size_t z_ = 0; asm volatile("" : "+s"(z_)); P.ws = P_.ws + z_; }
  const int G = gridDim.x, bx = obid();
  const int vcu = (G % 8 == 0) ? (bx % 8) * (G / 8) + bx / 8 : bx;
  for (int idx = vcu; idx < 1024; idx += G) {
    const int i = idx >> 8, v = idx & 255, bg = v >> 5, s = v & 31;
    const int c = i == 0 ? s : i == 1 ? 63 - s : i == 2 ? 64 + s : 127 - s;
    attn_tile(P, lds, bg >> 2, bg & 3, c);
  }
}


#define LAS __attribute__((address_space(3)))
#define XB_TMO      128
#define XB_XCNT(j)  (256  + 64 * (j))
#define XB_XSUB(j)  (1280 + 64 * (j))
#define XB_XGEN(j)  (2304 + 64 * (j))
#define XB_TOP      3328
#define XB_TOPGEN   3392
#define XCD_BAR_WORDS 3456
#define XB_SPIN_CAP (1u << 18)
__device__ __forceinline__ unsigned xb_ld(unsigned* p)              { return __hip_atomic_load(p, __ATOMIC_RELAXED, __HIP_MEMORY_SCOPE_AGENT); }
__device__ __forceinline__ unsigned xb_add(unsigned* p, unsigned v) { return __hip_atomic_fetch_add(p, v, __ATOMIC_RELAXED, __HIP_MEMORY_SCOPE_AGENT); }
__device__ __forceinline__ unsigned xb_xcc_id() { return (unsigned)__builtin_amdgcn_s_getreg((3 << 11) | 20) & 0xFu; }
#define XB_SPIN(cond, bar) do { unsigned _sp = 0; while (cond) { __builtin_amdgcn_s_sleep(1); \
    if ((++_sp & 255u) == 0u) { if (xb_ld(&(bar)[XB_TMO])) break; if (_sp > XB_SPIN_CAP) { atomicAdd(&(bar)[XB_TMO], 1u); break; } } } } while (0)
struct XcdBarrier { unsigned* bar; unsigned x; volatile LAS unsigned* st; };
__device__ __forceinline__ XcdBarrier xcd_barrier_post(unsigned* bar, volatile LAS unsigned* st) {
    XcdBarrier b; b.bar = bar; b.x = xb_xcc_id(); b.st = st;
    if (threadIdx.x == 0) (void)xb_add(&bar[XB_XCNT(b.x)], 1u);
    return b;
}
__device__ __forceinline__ void xcd_barrier_complete(unsigned* bar, unsigned x, unsigned& nloc, unsigned& nx) {
    const unsigned G = gridDim.x * gridDim.y * gridDim.z;
    unsigned sum, cnt, mine, sp = 0u;
    for (;;) {
        sum = 0u; cnt = 0u; mine = 0u;
#pragma unroll
        for (unsigned j = 0; j < 16; ++j) { const unsigned c = xb_ld(&bar[XB_XCNT(j)]); sum += c; cnt += (c > 0u) ? 1u : 0u; mine = (j == x) ? c : mine; }
        if (sum == G) break;
        __builtin_amdgcn_s_sleep(1);
        if ((++sp & 255u) == 0u) { if (xb_ld(&bar[XB_TMO])) break; if (sp > XB_SPIN_CAP) { atomicAdd(&bar[XB_TMO], 1u); break; } }
    }
    nloc = mine > 0u ? mine : 1u; nx = cnt > 0u ? cnt : 1u;
}
__device__ __forceinline__ void xcd_barrier(const XcdBarrier& b) {
    asm volatile("s_waitcnt vmcnt(0)" ::: "memory");
    __syncthreads();
    if (threadIdx.x == 0) {
        unsigned* bar = b.bar; { size_t z_ = 0; asm volatile("" : "+s"(z_)); bar += z_; }
        __builtin_amdgcn_s_waitcnt(0);
        unsigned nloc = b.st[0], nx = b.st[1];
        if (nloc == 0u) { xcd_barrier_complete(bar, b.x, nloc, nx); b.st[0] = nloc; b.st[1] = nx; }
        const unsigned old = xb_add(&bar[XB_XSUB(b.x)], 1u);
        const unsigned gen = old / nloc;
        if (old + 1u == (gen + 1u) * nloc) {
            __builtin_amdgcn_fence(__ATOMIC_RELEASE, "agent");
            asm volatile("s_waitcnt vmcnt(0)" ::: "memory");
            const unsigned og = xb_add(&bar[XB_TOP], 1u);
            const unsigned tg = og / nx;
            if (og + 1u == (tg + 1u) * nx) xb_add(&bar[XB_TOPGEN], 1u);
            else XB_SPIN(xb_ld(&bar[XB_TOPGEN]) == tg, bar);
            __builtin_amdgcn_fence(__ATOMIC_ACQUIRE, "agent");
            xb_add(&bar[XB_XGEN(b.x)], 1u);
            asm volatile("s_waitcnt vmcnt(0)" ::: "memory");
        } else {
            XB_SPIN(xb_ld(&bar[XB_XGEN(b.x)]) == gen, bar);
            __builtin_amdgcn_fence(__ATOMIC_ACQUIRE, "agent");
            asm volatile("s_waitcnt vmcnt(0)" ::: "memory");
        }
    }
    __syncthreads();
}

__global__ void __launch_bounds__(NTHR) fwd_kernel(Params P) {
  extern __shared__ __attribute__((aligned(16))) unsigned char lds[];
  cg::grid_group grid = cg::this_grid();
  const int gtid = blockIdx.x * NTHR + threadIdx.x;
  if (threadIdx.x < 4) ((unsigned*)(lds + LDS_BYTES - 16))[threadIdx.x] = 0u;
  __syncthreads();
  const XcdBarrier xbar = xcd_barrier_post((unsigned*)(P.ws + WS_BAR), (volatile LAS unsigned*)(lds + LDS_BYTES - 16));
#define GSYNC() xcd_barrier(xbar)
  s5_params(P, gtid);
  {
    float* modb = (float*)(P.ws + WS_MOD); float* cbb = (float*)(P.ws + WS_CB);
    for (int it = blockIdx.x; it < 192 + 16; it += gridDim.x) {
      if (it < 192) { const int l = it / 96, j0 = (it % 96) * 64;
        gemv_item((float*)lds, P.in[2] + (size_t)l * DM * 6144, DM, 6144, j0, P.in[1], P.in[1] + DM, true, P.in[3] + l * 6144, modb + (size_t)(l * 2) * 6144, modb + (size_t)(l * 2 + 1) * 6144);
      } else { const int r = it - 192, l = r >> 3, kv = (r >> 2) & 1, j0 = (r & 3) * 64;
        gemv_item((float*)lds, P.in[17] + (size_t)(l * 2 + kv) * 2048 * 256, 2048, 256, j0, P.in[16] + (size_t)(l * 2 + kv) * 2048, nullptr, false, nullptr, cbb + (l * 2 + kv) * 256, nullptr);
      }
    }
  }
  for (int it = blockIdx.x; it < DEPTH * 32 * 6; it += gridDim.x) s5_tables(P, it / 192, (it % 192) / 6, it % 6, lds);
  convert_weights(P, 0, lds);
  grid.sync();
  for (int l = 0; l < DEPTH; ++l) {
    if (l == 0) norm_simple<0>(P, l); else { norm_simple<1>(P, l); convert_weights(P, 1, lds); }
    GSYNC();
#if EN_MIXER
    phase_inproj8(P, lds);
    GSYNC();
    phase_s5a(P, l, lds);
    __syncthreads();
#if EN_ATTN
    phase_gates(P, lds);
    __syncthreads();
    phase_cmp1(P, l, lds);
#endif
    GSYNC();
    s5_carry(P, l);
#if EN_ATTN
    phase_cmp2(P, lds);
#endif
    GSYNC();
#if EN_ATTN
    phase_attn(P, lds);
    __syncthreads();
#endif
    phase_s5c(P, l, lds);
    GSYNC();
    phase_glu(P, lds);
    GSYNC();
    phase_merge8(P, lds);
    GSYNC();
    phase_wout8(P, l, lds);
    GSYNC();
#else
    if (l == 0) { for (size_t i = (size_t)gtid * 4; i < (size_t)NT * DM; i += (size_t)gridDim.x * NTHR * 4) *(f32x4*)(P.out + i) = *(const f32x4*)(P.in[0] + i); GSYNC(); }
#endif
#if EN_MOE
    norm_route(P, l, lds);
    GSYNC();
    phase_moe1(P, l, lds);
    GSYNC();
    phase_moe2(P, l, lds);
    GSYNC();
#endif
  }
  norm_simple<3>(P, 0);
}

extern "C" void kernel_launch(void* const* d_in, const int* in_sizes, int n_in, void* d_out, int out_size, void* d_ws, size_t ws_size, hipStream_t stream) {
  static int grid = 0;
  if (grid == 0) {
    if (n_in != 30 || out_size != NT * DM || ws_size < WS_END2) { fprintf(stderr, "kernel_launch: unexpected shapes (n_in %d out %d ws %zu need %zu)\n", n_in, out_size, ws_size, (size_t)WS_END2); grid = -1; return; }
    int dev = 0, cus = 0, per_cu = 0;
    hipGetDevice(&dev);
    hipDeviceGetAttribute(&cus, hipDeviceAttributeMultiprocessorCount, dev);
    hipFuncSetAttribute((const void*)fwd_kernel, hipFuncAttributeMaxDynamicSharedMemorySize, LDS_BYTES);
    hipOccupancyMaxActiveBlocksPerMultiprocessor(&per_cu, (const void*)fwd_kernel, NTHR, LDS_BYTES);
    if (per_cu < 1) { fprintf(stderr, "kernel_launch: occupancy query says %d blocks/CU\n", per_cu); per_cu = 1; }
    grid = cus;
    (void)hipGetLastError();
  }
  if (grid < 0) return;
  Params p{};
  for (int i = 0; i < 30; ++i) p.in[i] = (const float*)d_in[i];
  p.out = (float*)d_out; p.ws = (unsigned char*)d_ws;
  if (hipMemsetAsync(p.ws, 0, WS_ZERO_BYTES, stream) != hipSuccess) { fprintf(stderr, "kernel_launch: memset failed\n"); return; }
  void* args[] = {&p};
  hipError_t e = hipLaunchCooperativeKernel((const void*)fwd_kernel, dim3(grid), dim3(NTHR), args, LDS_BYTES, stream);
  if (e != hipSuccess) fprintf(stderr, "cooperative launch failed: %s (grid %d)\n", hipGetErrorString(e), grid);
}
```

```cpp
#include <hip/hip_runtime.h>
#include <hip/hip_cooperative_groups.h>
#include <cstdio>
#include <cstdint>
namespace cg = cooperative_groups;

#ifndef EN_MIXER
#define EN_MIXER 1
#endif
#ifndef EN_ATTN
#define EN_ATTN 1
#endif
#ifndef EN_MOE
#define EN_MOE 1
#endif

#define DI __device__ __forceinline__
typedef unsigned short bf16_t;
typedef short bf16x8 __attribute__((ext_vector_type(8)));
typedef short s16x4 __attribute__((ext_vector_type(4)));
typedef float f32x4 __attribute__((ext_vector_type(4)));
typedef float f32x16 __attribute__((ext_vector_type(16)));
typedef unsigned u32x4 __attribute__((ext_vector_type(4)));
typedef unsigned u32x2 __attribute__((ext_vector_type(2)));

constexpr int DM = 1024, NB = 2, SEQ = 8192, NT = NB * SEQ, DEPTH = 2;
constexpr int INW = 5168, INWP = 5376;
constexpr int NTHR = 512, NWAVE = 8;
constexpr int NEXP = 32, LISTCAP = 16384;
constexpr float EPS = 1e-6f;
constexpr float QSCALE = 0.125f * 1.4426950408889634f;

constexpr size_t MiB = 1u << 20;
constexpr size_t WS_CNT = 0;
constexpr size_t WS_BAR = 1024;
constexpr size_t WS_ZERO_BYTES = 16384;
constexpr size_t WS_MOD = 16384;
constexpr size_t WS_CB = WS_MOD + 2 * 2 * 6144 * 4;
constexpr size_t WS_S5P = WS_CB + 2 * 2 * 256 * 4;
constexpr size_t WS_WT = WS_S5P + 2 * 32 * 64 * 36 * 4;
constexpr size_t WS_SMALL_END = WS_WT + (size_t)NT * 2 * 4;
static_assert(WS_SMALL_END <= 1 * MiB, "small region");
constexpr size_t WS_W = 1 * MiB;
constexpr size_t W_IN = 0;
constexpr size_t W_GLU = W_IN + (size_t)INWP * 1024 * 2;
constexpr size_t W_O = W_GLU + 512 * 512 * 2;
constexpr size_t W_SO = W_O + 1024 * 1024 * 2;
constexpr size_t W_OUT = W_SO + 1024 * 512 * 2;
constexpr size_t W_C1 = W_OUT + 1024 * 1024 * 2;
constexpr size_t W_C2 = W_C1 + 2 * 256 * 2048 * 2;
constexpr size_t W_GU = W_C2 + 2 * 128 * 256 * 2;
constexpr size_t W_D = W_GU + (size_t)32 * 512 * 1024 * 2;
constexpr size_t W_END = W_D + (size_t)32 * 1024 * 256 * 2;
static_assert(W_END <= 67 * MiB, "weights region");
constexpr size_t WS_A = 68 * MiB;
constexpr size_t WS_B = WS_A + 32 * MiB;
constexpr size_t WS_C = WS_B + 32 * MiB;
constexpr size_t WS_DV = WS_C + 32 * MiB;
constexpr size_t WS_E = WS_DV + 16 * MiB;
constexpr size_t WS_F = WS_E + 32 * MiB;
constexpr size_t WS_G = WS_F + 64 * MiB;
constexpr size_t WS_GATES = WS_G + 16 * MiB;
constexpr size_t WS_HID = WS_GATES + 3 * MiB;
constexpr size_t WS_KC = WS_HID + 4 * MiB;
constexpr size_t WS_VC = WS_KC + 512 * 1024;
constexpr size_t WS_L = WS_VC + 512 * 1024;
constexpr size_t WS_LIST = WS_L + 4 * MiB;
constexpr size_t WS_OT = WS_LIST + 2 * MiB;
constexpr size_t WS_TAB = WS_OT + 16 * MiB;
constexpr size_t TAB_KT = 0, TAB_M1 = 1 * MiB, TAB_M2 = 9 * MiB, TAB_LAYER = 17 * MiB;
constexpr size_t WS_END = WS_TAB + 2 * TAB_LAYER;
constexpr size_t WS_KSF = WS_END;
constexpr size_t WS_END2 = WS_KSF + 8 * MiB;
constexpr size_t WS_SIN = WS_E + 16 * MiB;
constexpr int LDS_BYTES = 151552;

struct Params { const float* in[30]; float* out; unsigned char* ws; };

DI int otid() { int t = threadIdx.x; asm volatile("" : "+v"(t)); return t; }
DI int obid() { int t = blockIdx.x; asm volatile("" : "+s"(t)); return t; }
DI unsigned f2bf(float f) { unsigned u = __float_as_uint(f); return (u + 0x7fffu + ((u >> 16) & 1u)) >> 16; }
typedef float f32x2_t __attribute__((ext_vector_type(2))); typedef __bf16 bf16x2_t __attribute__((ext_vector_type(2)));
DI unsigned pk2(float lo, float hi) { const f32x2_t v = {lo, hi}; const bf16x2_t b = __builtin_convertvector(v, bf16x2_t); return __builtin_bit_cast(unsigned, b); }
DI float bflo(unsigned w) { return __uint_as_float(w << 16); }
DI float bfhi(unsigned w) { return __uint_as_float(w & 0xffff0000u); }
DI int perm16(int x) { return (x & ~12) | ((x & 4) << 1) | ((x & 8) >> 1); }
template <int CTRL> DI float dppf(float x) { return __builtin_bit_cast(float, __builtin_amdgcn_mov_dpp(__builtin_bit_cast(int, x), CTRL, 0xf, 0xf, true)); }
template <int CTRL> DI int dppi(int x) { return __builtin_amdgcn_mov_dpp(x, CTRL, 0xf, 0xf, true); }
constexpr int DPP_X1 = 0xB1, DPP_X2 = 0x4E, DPP_HM = 0x141, DPP_X8 = 0x128;
DI float x32_sum(float x) { auto t = __builtin_amdgcn_permlane32_swap(__float_as_uint(x), __float_as_uint(x), false, false); return __uint_as_float(t[0]) + __uint_as_float(t[1]); }
DI float x32_max(float x) { auto t = __builtin_amdgcn_permlane32_swap(__float_as_uint(x), __float_as_uint(x), false, false); return fmaxf(__uint_as_float(t[0]), __uint_as_float(t[1])); }
DI float x16_sum(float x) { auto t = __builtin_amdgcn_permlane16_swap(__float_as_uint(x), __float_as_uint(x), false, false); return __uint_as_float(t[0]) + __uint_as_float(t[1]); }
DI int sum8i(int v) { v += dppi<DPP_X1>(v); v += dppi<DPP_X2>(v); v += dppi<DPP_HM>(v); return v; }
DI float wave_sum(float v) {
  v += dppf<DPP_X1>(v); v += dppf<DPP_X2>(v); v += dppf<DPP_HM>(v); v += dppf<DPP_X8>(v);
  return x32_sum(x16_sum(v));
}
DI float sigmoidf_(float x) { return __builtin_amdgcn_rcpf(1.f + __expf(-x)); }
DI float gelu_tanh(float x) {
  const float z = 0.7978845608028654f * (x + 0.044715f * x * x * x);
  const float e = __expf(2.f * z);
  const float th = 1.f - 2.f * __builtin_amdgcn_rcpf(e + 1.f);
  return 0.5f * x * (1.f + th);
}
DI void sincos_d(double x, double& s, double& c) {
  const double k = rint(x * 0.6366197723675814);
  double r = fma(-k, 1.5707963267948966, x);
  r = fma(-k, 6.123233995736766e-17, r);
  const int q = ((int)k) & 3;
  const double r2 = r * r;
  const double sp = r * (1.0 + r2 * (-1.0 / 6 + r2 * (1.0 / 120 + r2 * (-1.0 / 5040 + r2 * (1.0 / 362880 + r2 * (-1.0 / 39916800 + r2 * (1.0 / 6227020800.0)))))));
  const double cp = 1.0 + r2 * (-0.5 + r2 * (1.0 / 24 + r2 * (-1.0 / 720 + r2 * (1.0 / 40320 + r2 * (-1.0 / 3628800 + r2 * (1.0 / 479001600 + r2 * (-1.0 / 87178291200.0)))))));
  s = (q == 0) ? sp : (q == 1) ? cp : (q == 2) ? -sp : -cp;
  c = (q == 0) ? cp : (q == 1) ? -sp : (q == 2) ? -cp : sp;
}

DI void gemv_item(float* lds, const float* W, int K, int N, int j0, const float* v0, const float* v1, bool do_silu, const float* bias, float* o0, float* o1) {
  const int tid = otid();
  float* sv = lds; float* red = lds + 4096;
  for (int k = tid; k < K; k += NTHR) {
    float a = v0[k], b = v1 ? v1[k] : 0.f;
    if (do_silu) { a = a / (1.f + expf(-a)); b = b / (1.f + expf(-b)); }
    sv[k] = a; sv[2048 + k] = b;
  }
  __syncthreads();
  const int jl = tid & 63, ks = tid >> 6, kper = K >> 3;
  const float* wp = W + (size_t)(ks * kper) * N + j0 + jl;
  float a0 = 0.f, a1 = 0.f;
#pragma unroll 8
  for (int k = 0; k < kper; ++k) { const float w = wp[(size_t)k * N]; a0 += sv[ks * kper + k] * w; a1 += sv[2048 + ks * kper + k] * w; }
  red[(ks * 64 + jl) * 2] = a0; red[(ks * 64 + jl) * 2 + 1] = a1;
  __syncthreads();
  if (tid < 64) {
    float s0 = 0.f, s1 = 0.f;
    for (int i = 0; i < 8; ++i) { s0 += red[(i * 64 + tid) * 2]; s1 += red[(i * 64 + tid) * 2 + 1]; }
    const float bb = bias ? bias[j0 + tid] : 0.f;
    o0[j0 + tid] = s0 + bb; if (o1) o1[j0 + tid] = s1 + bb;
  }
  __syncthreads();
}

DI void s5_params(const Params& P, int gtid) {
  if (gtid >= DEPTH * 32 * 64) return;
  const int l = gtid / 2048, g = (gtid / 64) % 32, p = gtid % 64;
  const float dt = expf(P.in[8][l * 32 + g]);
  const float lr = P.in[6][(l * 32 + g) * 64 + p], li = P.in[7][(l * 32 + g) * 64 + p];
  const float mag = expf(lr * dt); const float ang = li * dt;
  double sd, cd; sincos_d((double)ang, sd, cd);
  const float ab_re = mag * (float)cd, ab_im = mag * (float)sd;
  float* o = (float*)(P.ws + WS_S5P) + (size_t)((l * 32 + g) * 64 + p) * 36;
  o[0] = ab_re; o[1] = ab_im;
  double pr = ab_re, pi = ab_im;
  for (int i = 0; i < 6; ++i) { const double nr2 = pr * pr - pi * pi, ni2 = 2.0 * pr * pi; pr = nr2; pi = ni2; }
  o[2] = (float)pr; o[3] = (float)pi;
}

DI void s5_tables(const Params& P, int l, int g, int part, unsigned char* lds) {
  const int tid = otid(), lane = tid & 63;
  float* BBr = (float*)lds; float* BBi = BBr + 1024; float* CR = BBi + 1024; float* CI = CR + 1024;
  float* APr = CI + 1024; float* APi = APr + 65 * 64;
  bf16_t* tab = (bf16_t*)(P.ws + WS_TAB + (size_t)l * TAB_LAYER);
  bf16_t* Kt = tab + TAB_KT / 2 + (size_t)g * 64 * 256; bf16_t* M1 = tab + TAB_M1 / 2 + (size_t)g * 128 * 1024; bf16_t* M2 = tab + TAB_M2 / 2 + (size_t)g * 1024 * 128;
  __syncthreads();
  if (tid < 64) {
    const int p = tid;
    const float dt = expf(P.in[8][l * 32 + g]);
    const float lr = P.in[6][(l * 32 + g) * 64 + p], li = P.in[7][(l * 32 + g) * 64 + p];
    const float mag = expf(lr * dt); const float ang = li * dt;
    double sd, cd; sincos_d((double)ang, sd, cd);
    const float ab_re = mag * (float)cd, ab_im = mag * (float)sd;
    const float den = lr * lr + li * li, nr = ab_re - 1.0f;
    const float cr = (nr * lr + ab_im * li) / den, ci = (ab_im * lr - nr * li) / den;
    const float* br = P.in[9] + (size_t)((l * 32 + g) * 64 + p) * 16; const float* bi = P.in[10] + (size_t)((l * 32 + g) * 64 + p) * 16;
    for (int h = 0; h < 16; ++h) { BBr[p * 16 + h] = cr * br[h] - ci * bi[h]; BBi[p * 16 + h] = cr * bi[h] + ci * br[h]; }
    double pr = 1.0, pi = 0.0;
    for (int tau = 0; tau <= 64; ++tau) { APr[tau * 64 + p] = (float)pr; APi[tau * 64 + p] = (float)pi; const double n1 = pr * ab_re - pi * ab_im, n2 = pr * ab_im + pi * ab_re; pr = n1; pi = n2; }
  }
  for (int i = tid; i < 1024; i += NTHR) { CR[i] = P.in[11][(size_t)(l * 32 + g) * 1024 + i]; CI[i] = P.in[12][(size_t)(l * 32 + g) * 1024 + i]; }
  __syncthreads();
  if (part < 4)
  for (int task = part * 256 + tid; task < part * 256 + 256; task += NTHR) {
    const int tau = task >> 4, h = task & 15;
    float a[16];
#pragma unroll
    for (int j = 0; j < 16; ++j) a[j] = 0.f;
    for (int p = 0; p < 64; ++p) {
      const float c_r = CR[h * 64 + p], c_i = CI[h * 64 + p], a_r = APr[tau * 64 + p], a_i = APi[tau * 64 + p];
      const float xr = c_r * a_r - c_i * a_i, xi = c_r * a_i + c_i * a_r;
#pragma unroll
      for (int j4 = 0; j4 < 4; ++j4) { const f32x4 b_r = *(const f32x4*)(BBr + p * 16 + 4 * j4), b_i = *(const f32x4*)(BBi + p * 16 + 4 * j4);
        a[4 * j4] += xr * b_r.x - xi * b_i.x; a[4 * j4 + 1] += xr * b_r.y - xi * b_i.y; a[4 * j4 + 2] += xr * b_r.z - xi * b_i.z; a[4 * j4 + 3] += xr * b_r.w - xi * b_i.w; }
    }
    u32x4 o0, o1; o0.x = pk2(a[0], a[1]); o0.y = pk2(a[2], a[3]); o0.z = pk2(a[4], a[5]); o0.w = pk2(a[6], a[7]); o1.x = pk2(a[8], a[9]); o1.y = pk2(a[10], a[11]); o1.z = pk2(a[12], a[13]); o1.w = pk2(a[14], a[15]);
    *(u32x4*)(Kt + (size_t)task * 16) = o0; *(u32x4*)(Kt + (size_t)task * 16 + 8) = o1;
  }
  if (part == 4)
  for (int task = tid; task < 4096; task += NTHR) {
    const int p = task >> 6, i = task & 63;
    const float a_r = APr[(63 - i) * 64 + p], a_i = APi[(63 - i) * 64 + p];
    float re[16], im[16];
#pragma unroll
    for (int j = 0; j < 16; ++j) { const float b_r = BBr[p * 16 + j], b_i = BBi[p * 16 + j]; re[j] = a_r * b_r - a_i * b_i; im[j] = a_r * b_i + a_i * b_r; }
    u32x4 o; bf16_t* d0 = M1 + (size_t)(2 * p) * 1024 + i * 16; bf16_t* d1 = d0 + 1024;
    o.x = pk2(re[0], re[1]); o.y = pk2(re[2], re[3]); o.z = pk2(re[4], re[5]); o.w = pk2(re[6], re[7]); *(u32x4*)d0 = o;
    o.x = pk2(re[8], re[9]); o.y = pk2(re[10], re[11]); o.z = pk2(re[12], re[13]); o.w = pk2(re[14], re[15]); *(u32x4*)(d0 + 8) = o;
    o.x = pk2(im[0], im[1]); o.y = pk2(im[2], im[3]); o.z = pk2(im[4], im[5]); o.w = pk2(im[6], im[7]); *(u32x4*)d1 = o;
    o.x = pk2(im[8], im[9]); o.y = pk2(im[10], im[11]); o.z = pk2(im[12], im[13]); o.w = pk2(im[14], im[15]); *(u32x4*)(d1 + 8) = o;
  }
  if (part == 5)
  for (int task = tid; task < 4096; task += NTHR) {
    const int th = task >> 2, pq = task & 3, t = th >> 4, h = th & 15;
    unsigned w[16];
#pragma unroll
    for (int j = 0; j < 16; ++j) { const int p = pq * 16 + j;
      const float c_r = CR[h * 64 + p], c_i = CI[h * 64 + p], a_r = APr[(t + 1) * 64 + p], a_i = APi[(t + 1) * 64 + p];
      w[j] = pk2(c_r * a_r - c_i * a_i, -(c_r * a_i + c_i * a_r)); }
    bf16_t* d = M2 + (size_t)th * 128 + pq * 32;
    *(u32x4*)d = (u32x4){w[0], w[1], w[2], w[3]}; *(u32x4*)(d + 8) = (u32x4){w[4], w[5], w[6], w[7]};
    *(u32x4*)(d + 16) = (u32x4){w[8], w[9], w[10], w[11]}; *(u32x4*)(d + 24) = (u32x4){w[12], w[13], w[14], w[15]};
  }
  __syncthreads();
}

struct ConvJob { const float* src; bf16_t* dst; int ldw, K, c0, ncols, nmat, ldd, drow0, mode; size_t sstride, dstride; };
DI int conv_nitems(const ConvJob& j) { return j.nmat * (j.K >> 6) * ((j.ncols + 31) >> 5); }
DI int conv_drow(int mode, int drow0, int n) { return mode == 0 ? drow0 + n : drow0 + ((n >> 6) * 128 + ((n >> 4) & 3) * 32 + (n & 15)); }
DI void conv_item(const ConvJob& jb, int item, float* scr, int lane) {
  const int nblk = (jb.ncols + 31) >> 5, per = (jb.K >> 6) * nblk;
  const int mat = item / per, r = item % per, kb = r / nblk, nb = r % nblk, k0 = 64 * kb, n0 = 32 * nb;
  const float* W = jb.src + (size_t)mat * jb.sstride; bf16_t* WT = jb.dst + (size_t)mat * jb.dstride;
  const int n4 = (lane & 7) * 4; const bool nok = (n0 + n4) < jb.ncols;
#pragma unroll
  for (int i = 0; i < 8; ++i) { const int kk = 8 * i + (lane >> 3);
    const f32x4 v = nok ? *(const f32x4*)(W + (size_t)(k0 + kk) * jb.ldw + jb.c0 + n0 + n4) : (f32x4){0.f, 0.f, 0.f, 0.f};
    *(f32x4*)(scr + kk * 36 + n4) = v; }
  asm volatile("s_waitcnt lgkmcnt(0)" ::: "memory");
  const int c = lane & 7;
#pragma unroll
  for (int j = 0; j < 4; ++j) {
    const int n = (lane >> 3) + 8 * j; const float* sp = scr + (8 * c) * 36 + n;
    u32x4 o; o.x = pk2(sp[0], sp[36]); o.y = pk2(sp[72], sp[108]); o.z = pk2(sp[144], sp[180]); o.w = pk2(sp[216], sp[252]);
    if (n0 + n < jb.ncols) *(u32x4*)(WT + (size_t)conv_drow(jb.mode, jb.drow0, n0 + n) * jb.ldd + k0 + 8 * c) = o;
  }
  asm volatile("s_waitcnt lgkmcnt(0)" ::: "memory");
}
DI ConvJob conv_job(const Params& P, int l, int j) {
  unsigned char* wb = P.ws + WS_W; ConvJob J; J.nmat = 1; J.mode = 0; J.sstride = 0; J.dstride = 0; J.drow0 = 0; J.c0 = 0;
  const float* win = P.in[5] + (size_t)l * 1024 * INW;
  if (j < 5) { J.src = win; J.ldw = INW; J.K = 1024; J.dst = (bf16_t*)(wb + W_IN); J.ldd = 1024;
    if (j == 0) { J.c0 = 0; J.ncols = 1024; J.drow0 = 0; }
    else if (j == 1) { J.c0 = 1024; J.ncols = 1536; J.drow0 = 1024; }
    else if (j == 2) { J.c0 = 3120; J.ncols = 2048; J.drow0 = 2560; }
    else if (j == 3) { J.c0 = 2608; J.ncols = 512; J.drow0 = 4608; }
    else { J.c0 = 2560; J.ncols = 48; J.drow0 = 5120; }
  } else if (j == 5) { J.src = P.in[14] + (size_t)l * 512 * 512; J.ldw = 512; J.K = 512; J.ncols = 512; J.dst = (bf16_t*)(wb + W_GLU); J.ldd = 512; }
  else if (j == 6) { J.src = P.in[19] + (size_t)l * 1024 * 1024; J.ldw = 1024; J.K = 1024; J.ncols = 1024; J.dst = (bf16_t*)(wb + W_O); J.ldd = 1024; }
  else if (j == 7) { J.src = P.in[15] + (size_t)l * 512 * 1024; J.ldw = 1024; J.K = 512; J.ncols = 1024; J.dst = (bf16_t*)(wb + W_SO); J.ldd = 512; }
  else if (j == 8) { J.src = P.in[20] + (size_t)l * 1024 * 1024; J.ldw = 1024; J.K = 1024; J.ncols = 1024; J.dst = (bf16_t*)(wb + W_OUT); J.ldd = 1024; }
  else if (j == 9) { J.src = P.in[17] + (size_t)l * 2 * 2048 * 256; J.ldw = 256; J.K = 2048; J.ncols = 256; J.nmat = 2; J.sstride = 2048 * 256; J.dstride = 256 * 2048; J.dst = (bf16_t*)(wb + W_C1); J.ldd = 2048; }
  else if (j == 10) { J.src = P.in[18] + (size_t)l * 2 * 256 * 64; J.ldw = 64; J.K = 256; J.ncols = 64; J.nmat = 2; J.sstride = 256 * 64; J.dstride = 128 * 256; J.dst = (bf16_t*)(wb + W_C2); J.ldd = 256; }
  else if (j == 11) { J.src = P.in[26] + (size_t)l * 32 * 1024 * 256; J.ldw = 256; J.K = 1024; J.ncols = 256; J.nmat = 32; J.sstride = 1024 * 256; J.dstride = 512 * 1024; J.dst = (bf16_t*)(wb + W_GU); J.ldd = 1024; J.mode = 1; J.drow0 = 0; }
  else if (j == 12) { J.src = P.in[27] + (size_t)l * 32 * 1024 * 256; J.ldw = 256; J.K = 1024; J.ncols = 256; J.nmat = 32; J.sstride = 1024 * 256; J.dstride = 512 * 1024; J.dst = (bf16_t*)(wb + W_GU); J.ldd = 1024; J.mode = 1; J.drow0 = 16; }
  else { J.src = P.in[28] + (size_t)l * 32 * 256 * 1024; J.ldw = 1024; J.K = 256; J.ncols = 1024; J.nmat = 32; J.sstride = 256 * 1024; J.dstride = 1024 * 256; J.dst = (bf16_t*)(wb + W_D); J.ldd = 256; }
  return J;
}
DI void convert_weights(const Params& P_, int l, unsigned char* lds) {
  Params P = P_; { size_t z_ = 0; asm volatile("" : "+s"(z_)); P.ws = P_.ws + z_; }
  const int tid_ = otid(), bid = obid(), wave = tid_ >> 6, lane = tid_ & 63; (void)bid;
  float* scr = (float*)lds + wave * (64 * 36);
  const int NGW = gridDim.x * NWAVE; int off = bid * NWAVE + wave;
  for (int j = 0; j < 14; ++j) {
    const ConvJob J = conv_job(P, l, j); const int n = conv_nitems(J);
    while (off < n) { conv_item(J, off, scr, lane); off += NGW; }
    off -= n;
  }
}

template <int MODE>
DI void norm_simple(const Params& P_, int l) {
  Params P = P_; { size_t z_ = 0; asm volatile("" : "+s"(z_)); P.ws = P_.ws + z_; }
  const int tid_ = otid(), bid = obid(), wave = tid_ >> 6, lane = tid_ & 63; (void)bid;
  const int NGW = gridDim.x * NWAVE;
  const float* mod = (const float*)(P.ws + WS_MOD);
  const bf16_t* ys = (const bf16_t*)(P.ws + WS_F);
  bf16_t* xn = (bf16_t*)(P.ws + WS_A);
  const float* xbase = MODE == 0 ? P.in[0] : P.out;
  constexpr bool ADDY = (MODE != 0) && EN_MOE;
  f32x4 g[4], sh[4], sc[4], gg[4]; int pb = -1;
  { const float* gp = MODE == 3 ? P.in[29] : P.in[4] + (size_t)l * DM;
#pragma unroll
    for (int j = 0; j < 4; ++j) g[j] = *(const f32x4*)(gp + 4 * lane + 256 * j); }
  f32x4 v[4]; u32x2 y0[4], y1[4];
#define NS_LOAD(vv, a0, a1, rr) do { const float* xr_ = xbase + (size_t)(rr) * DM; \
    _Pragma("unroll") for (int j = 0; j < 4; ++j) vv[j] = *(const f32x4*)(xr_ + 4 * lane + 256 * j); \
    if (ADDY) { _Pragma("unroll") for (int j = 0; j < 4; ++j) { a0[j] = *(const u32x2*)(ys + (size_t)((rr) * 2) * DM + 4 * lane + 256 * j); a1[j] = *(const u32x2*)(ys + (size_t)((rr) * 2 + 1) * DM + 4 * lane + 256 * j); } } } while (0)
  const int row0 = bid * NWAVE + wave;
  if (row0 < NT) NS_LOAD(v, y0, y1, row0);
  for (int row = row0; row < NT; row += NGW) {
    const int b = row >> 13;
    if (b != pb) { pb = b;
      if (ADDY) { const float* g2 = mod + (size_t)(((MODE == 1 ? 0 : 1) * 2 + b) * 6144) + 5120;
#pragma unroll
        for (int j = 0; j < 4; ++j) gg[j] = *(const f32x4*)(g2 + 4 * lane + 256 * j); }
      if (MODE != 3) { const float* md = mod + (size_t)((l * 2 + b) * 6144);
#pragma unroll
        for (int j = 0; j < 4; ++j) { sh[j] = *(const f32x4*)(md + 4 * lane + 256 * j); sc[j] = *(const f32x4*)(md + 1024 + 4 * lane + 256 * j); } }
    }
    f32x4 vn[4]; u32x2 y0n[4], y1n[4];
    if (row + NGW < NT) NS_LOAD(vn, y0n, y1n, row + NGW);
    __builtin_amdgcn_sched_barrier(0);
    if (ADDY) {
#pragma unroll
      for (int j = 0; j < 4; ++j) {
        v[j].x += gg[j].x * (bflo(y0[j].x) + bflo(y1[j].x)); v[j].y += gg[j].y * (bfhi(y0[j].x) + bfhi(y1[j].x));
        v[j].z += gg[j].z * (bflo(y0[j].y) + bflo(y1[j].y)); v[j].w += gg[j].w * (bfhi(y0[j].y) + bfhi(y1[j].y));
      }
    }
    float ss = 0.f;
#pragma unroll
    for (int j = 0; j < 4; ++j) ss += v[j].x * v[j].x + v[j].y * v[j].y + v[j].z * v[j].z + v[j].w * v[j].w;
    ss = wave_sum(ss);
    const float inv = rsqrtf(ss * (1.f / DM) + EPS);
    if (MODE == 3) {
#pragma unroll
      for (int j = 0; j < 4; ++j) { const int col = 4 * lane + 256 * j; *(f32x4*)(P.out + (size_t)row * DM + col) = v[j] * inv * g[j]; }
    } else {
      if (MODE == 1) {
#pragma unroll
        for (int j = 0; j < 4; ++j) *(f32x4*)(P.out + (size_t)row * DM + 4 * lane + 256 * j) = v[j];
      }
#pragma unroll
      for (int j = 0; j < 4; ++j) {
        const int col = 4 * lane + 256 * j;
        const f32x4 h = v[j] * inv * g[j] * (sc[j] + 1.f) + sh[j];
        u32x2 o; o.x = pk2(h.x, h.y); o.y = pk2(h.z, h.w);
        *(u32x2*)(xn + (size_t)row * DM + col) = o;
      }
    }
#pragma unroll
    for (int j = 0; j < 4; ++j) { v[j] = vn[j]; y0[j] = y0n[j]; y1[j] = y1n[j]; }
  }
#undef NS_LOAD
}

constexpr int RT_HS = 1028;
DI void norm_route(const Params& P_, int l, unsigned char* lds) {
  Params P = P_; { size_t z_ = 0; asm volatile("" : "+s"(z_)); P.ws = P_.ws + z_; }
  const int tid = otid(), bid = obid(), wave = tid >> 6, lane = tid & 63;
  const float* mod = (const float*)(P.ws + WS_MOD);
  bf16_t* h2 = (bf16_t*)(P.ws + WS_A);
  float* hs = (float*)lds;
  float* Wc = (float*)lds + 32 * RT_HS;
  const float* wg = P.in[22] + (size_t)l * DM * 4; const float* we = P.in[24] + (size_t)l * DM * 32;
  const float* bg = P.in[23] + l * 4; const float* be = P.in[25] + l * 32;
  int* cnt = (int*)(P.ws + WS_CNT) + l * 32; int* list = (int*)(P.ws + WS_LIST); float* wts = (float*)(P.ws + WS_WT);
  const int rg = wave >> 2, kq = wave & 3;
  for (int grp = bid; grp < NT / 32; grp += gridDim.x) {
    const int row0 = grp * 32 + wave * 4, b = row0 >> 13;
    const float* ng = P.in[21] + (size_t)l * DM; const float* md = mod + (size_t)((l * 2 + b) * 6144);
    {
      f32x4 v[4][4];
#pragma unroll
      for (int r = 0; r < 4; ++r)
#pragma unroll
        for (int j = 0; j < 4; ++j) v[r][j] = *(const f32x4*)(P.out + (size_t)(row0 + r) * DM + 4 * lane + 256 * j);
      float inv[4];
#pragma unroll
      for (int r = 0; r < 4; ++r) { float ss = 0.f;
#pragma unroll
        for (int j = 0; j < 4; ++j) ss += v[r][j].x * v[r][j].x + v[r][j].y * v[r][j].y + v[r][j].z * v[r][j].z + v[r][j].w * v[r][j].w;
        inv[r] = rsqrtf(wave_sum(ss) * (1.f / DM) + EPS); }
#pragma unroll
      for (int j = 0; j < 4; ++j) {
        const int col = 4 * lane + 256 * j;
        const f32x4 g = *(const f32x4*)(ng + col), sh = *(const f32x4*)(md + 3072 + col), sc = *(const f32x4*)(md + 4096 + col);
#pragma unroll
        for (int r = 0; r < 4; ++r) {
          const f32x4 hh = v[r][j] * inv[r] * g * (sc + 1.f) + sh;
          u32x2 o; o.x = pk2(hh.x, hh.y); o.y = pk2(hh.z, hh.w);
          *(u32x2*)(h2 + (size_t)(row0 + r) * DM + col) = o;
          *(f32x4*)(hs + (wave * 4 + r) * RT_HS + col) = hh;
        }
      }
    }
    f32x4 we0, we1, wg0 = {0.f, 0.f, 0.f, 0.f};
#define WLOAD(kc) do { we0 = *(const f32x4*)(we + (size_t)(kc) * 4096 + tid * 4); we1 = *(const f32x4*)(we + (size_t)(kc) * 4096 + 2048 + tid * 4); if (tid < 128) wg0 = *(const f32x4*)(wg + (size_t)(kc) * 512 + tid * 4); } while (0)
#define WSTORE() do { *(f32x4*)(Wc + (tid >> 3) * 36 + (tid & 7) * 4) = we0; *(f32x4*)(Wc + (64 + (tid >> 3)) * 36 + (tid & 7) * 4) = we1; if (tid < 128) *(f32x4*)(Wc + tid * 36 + 32) = wg0; } while (0)
    WLOAD(0);
    f32x4 acc0 = {0.f, 0.f, 0.f, 0.f}, acc1 = acc0, acc2 = acc0;
    for (int kc = 0; kc < 8; ++kc) {
      __syncthreads();
      WSTORE();
      if (kc + 1 < 8) WLOAD(kc + 1);
      __syncthreads();
      const float* ap = hs + (rg * 16 + (lane & 15)) * RT_HS + kc * 128 + kq * 32 + (lane >> 4);
      const float* bp = Wc + (kq * 32 + (lane >> 4)) * 36 + (lane & 15);
#pragma unroll
      for (int ks = 0; ks < 8; ++ks) {
        const float av = ap[4 * ks];
        const float b0 = bp[(4 * ks) * 36], b1 = bp[(4 * ks) * 36 + 16], b2 = (lane & 15) < 4 ? bp[(4 * ks) * 36 + 32] : 0.f;
        acc0 = __builtin_amdgcn_mfma_f32_16x16x4f32(av, b0, acc0, 0, 0, 0);
        acc1 = __builtin_amdgcn_mfma_f32_16x16x4f32(av, b1, acc1, 0, 0, 0);
        acc2 = __builtin_amdgcn_mfma_f32_16x16x4f32(av, b2, acc2, 0, 0, 0);
      }
    }
#undef WLOAD
#undef WSTORE
    __syncthreads();
    {
      float* part = hs + kq * (32 * 40);
#pragma unroll
      for (int i = 0; i < 4; ++i) { const int row = rg * 16 + 4 * (lane >> 4) + i, col = lane & 15;
        part[row * 40 + col] = acc0[i]; part[row * 40 + 16 + col] = acc1[i]; if (col < 4) part[row * 40 + 32 + col] = acc2[i]; }
    }
    __syncthreads();
    if (tid < 32) {
      const int row = grp * 32 + tid;
      float L[36];
#pragma unroll
      for (int o = 0; o < 36; ++o) L[o] = (hs[tid * 40 + o] + hs[1280 + tid * 40 + o]) + (hs[2560 + tid * 40 + o] + hs[3840 + tid * 40 + o]);
      float gm = -1e30f; int gi = 0;
#pragma unroll
      for (int i = 0; i < 4; ++i) { const float v = L[32 + i] + bg[i]; if (v > gm) { gm = v; gi = i; } }
      float gs = 0.f;
#pragma unroll
      for (int i = 0; i < 4; ++i) gs += expf(L[32 + i] + bg[i] - gm);
      const float gp = 1.f / gs;
      float el[8];
#pragma unroll
      for (int i = 0; i < 8; ++i) el[i] = (gi == 0 ? L[i] : gi == 1 ? L[8 + i] : gi == 2 ? L[16 + i] : L[24 + i]) + be[gi * 8 + i];
      float em = -1e30f;
#pragma unroll
      for (int i = 0; i < 8; ++i) em = fmaxf(em, el[i]);
      float p1 = -1.f, p2 = -1.f; int i1 = 0, i2 = 0;
#pragma unroll
      for (int i = 0; i < 8; ++i) {
        const float pe = expf(el[i] - em);
        if (pe > p1) { p2 = p1; i2 = i1; p1 = pe; i1 = i; } else if (pe > p2) { p2 = pe; i2 = i; }
      }
      const float w1 = gp * p1 / (p1 + p2), w2 = gp * p2 / (p1 + p2);
      const int e1 = gi * 8 + i1, e2 = gi * 8 + i2;
      const int pos1 = atomicAdd(&cnt[e1], 1); list[e1 * LISTCAP + pos1] = row * 2; wts[row * 2] = w1;
      const int pos2 = atomicAdd(&cnt[e2], 1); list[e2 * LISTCAP + pos2] = row * 2 + 1; wts[row * 2 + 1] = w2;
    }
    __syncthreads();
  }
}

namespace pg8 {
#define PG8_LAS __attribute__((address_space(3)))
typedef unsigned short bf16_t;
typedef short bf16x8 __attribute__((ext_vector_type(8)));
typedef float f32x4 __attribute__((ext_vector_type(4)));
typedef unsigned u32x4 __attribute__((ext_vector_type(4)));
constexpr int BM = 256, BK = 64, HALF = 128, HTB = HALF * BK * 2  , STAGE_BYTES = 8 * HTB, NXCD = 8, WGM = 8;

__host__ __device__ __forceinline__ int lds_byte(int r, int c) { const int st = (r >> 4) * 2 + (c >> 5), rr = r & 15, cc = c & 31, ob = rr * 64 + cc * 2; return st * 1024 + (ob ^ (((ob >> 9) & 1) << 5)); }
__host__ __device__ __forceinline__ void stage_rc(int b, int& R, int& C) { const int st = b / 1024, sb = b % 1024, swz = sb ^ (((sb >> 9) & 1) << 5); R = (st >> 1) * 16 + swz / 64; C = (st & 1) * 32 + (swz % 64) / 2; }
__host__ __device__ __forceinline__ int perm32(int rho) { const int n = rho >> 4, i = rho & 15; return 8 * (i >> 2) + 4 * n + (i & 3); }

struct Unit { int pm, pn; };
struct Gemm { const bf16_t* A; const bf16_t* Bt; int M, N, K; };

struct StaticOrder {
    int nM, nN, nwg, G, c;
    __host__ __device__ void init(int M, int N, int G_, int c_) { nM = M / BM; nN = N / BM; nwg = nM * nN; G = G_; c = c_; }
    __host__ __device__ bool next(int i, Unit& u) const {
        const long L = (long)i * G + c; if (L >= nwg) return false;
        int wgid = (int)L; { const int q = nwg / NXCD, r = nwg % NXCD, xcd = wgid % NXCD, off = wgid / NXCD; wgid = (xcd < r ? xcd * (q + 1) : r * (q + 1) + (xcd - r) * q) + off; }
        const int nig = WGM * nN, gid = wgid / nig, fm = gid * WGM, gsz = (nM - fm) < WGM ? (nM - fm) : WGM;
        u.pm = fm + ((wgid % nig) % gsz); u.pn = (wgid % nig) / gsz; return true;
    }
    __device__ __forceinline__ void a_ready(const Unit&) const {}
    __device__ __forceinline__ void done(const Unit&) const {}
};
template <class Epi, class Sched, bool ALIGN_EPI = false, bool SP2 = false>
__device__ __forceinline__ void gemm_phase(PG8_LAS unsigned char* lds, const Gemm g, const Sched& S, const Epi& E) {
    const int tid = otid(), wid = __builtin_amdgcn_readfirstlane(tid >> 6), lane = tid & 63, wr = wid >> 2, wc = wid & 3, fr = lane & 15, fq = lane >> 4;
    const int K = g.K, nt = K / BK;
    unsigned voffA[2], voffB[2];
#pragma unroll
    for (int i = 0; i < 2; ++i) { int R, C; stage_rc(tid * 16 + i * 8192, R, C); const int Rb = Epi::PERM ? ((R & ~31) + perm32(R & 31)) : R;
        voffA[i] = (unsigned)(R * K + C) * 2u; voffB[i] = (unsigned)(Rb * K + C) * 2u; }
    const size_t kstep = (size_t)(BK * 2);
    const size_t hstep = (size_t)HALF * K * 2;
    const size_t tstep = 2 * hstep;
    const unsigned ldsw = (unsigned)wid * 1024u;
    const int aoff = lds_byte(wr * 64 + fr, fq * 8), boff = lds_byte(wc * 32 + fr, fq * 8);
#define PG8_SA(b, h) (((b) * 2 + (h)) * HTB)
#define PG8_SB(b, h) ((4 + (b) * 2 + (h)) * HTB)
#define PG8_STAGE(bufoff, gbase, voff) do { _Pragma("unroll") for (int _i = 0; _i < 2; ++_i) \
        __builtin_amdgcn_global_load_lds((const unsigned*)((const char*)(gbase) + (voff)[_i]), (PG8_LAS unsigned*)(lds + (bufoff) + ldsw + _i * 8192), 16, 0, 0); } while (0)
#define PG8_LDA(dst, b, h) do { _Pragma("unroll") for (int m = 0; m < 4; ++m) _Pragma("unroll") for (int k = 0; k < 2; ++k) dst[m][k] = *(const PG8_LAS bf16x8*)(lds + PG8_SA(b, h) + aoff + m * 2048 + k * 1024); } while (0)
#define PG8_LDB(dst, b, h) do { _Pragma("unroll") for (int n = 0; n < 2; ++n) _Pragma("unroll") for (int k = 0; k < 2; ++k) dst[n][k] = *(const PG8_LAS bf16x8*)(lds + PG8_SB(b, h) + boff + n * 2048 + k * 1024); } while (0)
#define PG8_MMA(ai, bj, At, Bt) do { __builtin_amdgcn_s_setprio(1); _Pragma("unroll") for (int m = 0; m < 4; ++m) _Pragma("unroll") for (int n = 0; n < 2; ++n) _Pragma("unroll") for (int k = 0; k < 2; ++k) \
        acc[ai][bj][m][n] = __builtin_amdgcn_mfma_f32_16x16x32_bf16(Bt[n][k], At[m][k], acc[ai][bj][m][n], 0, 0, 0); __builtin_amdgcn_s_setprio(0); } while (0)
#define PG8_WAIT_V(n) asm volatile("s_waitcnt vmcnt(" #n ")" ::: "memory")
#define PG8_WAIT_L(n) asm volatile("s_waitcnt lgkmcnt(" #n ")" ::: "memory")
#define PG8_BAR __builtin_amdgcn_s_barrier()
#define PG8_SCHED __builtin_amdgcn_sched_barrier(0)
    Unit cur, nxt; int ui = 0;
    if (!S.next(0, cur)) return;
    f32x4 acc[2][2][4][2];
#pragma unroll
    for (int a = 0; a < 2; ++a)
#pragma unroll
        for (int b = 0; b < 2; ++b)
#pragma unroll
            for (int m = 0; m < 4; ++m)
#pragma unroll
                for (int n = 0; n < 2; ++n) acc[a][b][m][n] = (f32x4){0.f, 0.f, 0.f, 0.f};
    bf16x8 At[4][2], B0[2][2], B1[2][2];
    const char* cA = (const char*)g.A + (size_t)cur.pm * tstep; const char* cB = (const char*)g.Bt + (size_t)cur.pn * tstep;
    S.a_ready(cur);
    if constexpr (SP2) {
        PG8_STAGE(PG8_SB(0, 0), cB, voffB); PG8_STAGE(PG8_SB(0, 1), cB + hstep, voffB); PG8_STAGE(PG8_SA(0, 0), cA, voffA); PG8_STAGE(PG8_SA(0, 1), cA + hstep, voffA);
        if (wr == 1) PG8_BAR;
        PG8_WAIT_V(2); PG8_BAR;
        PG8_STAGE(PG8_SB(1, 0), cB + kstep, voffB); PG8_STAGE(PG8_SA(1, 0), cA + kstep, voffA); PG8_STAGE(PG8_SB(1, 1), cB + hstep + kstep, voffB);
        PG8_WAIT_V(6); PG8_BAR;
    } else {
        PG8_STAGE(PG8_SB(0, 0), cB, voffB); PG8_STAGE(PG8_SA(0, 0), cA, voffA); PG8_STAGE(PG8_SB(0, 1), cB + hstep, voffB); PG8_STAGE(PG8_SA(0, 1), cA + hstep, voffA);
        if (wr == 1) PG8_BAR;
        PG8_WAIT_V(4); PG8_BAR;
        PG8_STAGE(PG8_SB(1, 0), cB + kstep, voffB); PG8_STAGE(PG8_SA(1, 0), cA + kstep, voffA); PG8_STAGE(PG8_SB(1, 1), cB + hstep + kstep, voffB);
        PG8_WAIT_V(6); PG8_BAR;
    }
    for (;;) {
        const bool has_next = S.next(ui + 1, nxt);
        const char* nA = has_next ? (const char*)g.A + (size_t)nxt.pm * tstep : cA; const char* nB = has_next ? (const char*)g.Bt + (size_t)nxt.pn * tstep : cB;
        for (int t = 0; t < nt; t += 2) {
            const bool last = (t == nt - 2);
            const char* a1 = cA + (size_t)(t + 1) * kstep;
            const char* a2 = last ? nA : cA + (size_t)(t + 2) * kstep; const char* b2 = last ? nB : cB + (size_t)(t + 2) * kstep;
            const char* a3 = a2 + kstep; const char* b3 = b2 + kstep;
            if (last && has_next) S.a_ready(nxt);
            if constexpr (SP2) {
            PG8_LDB(B0, 0, 0); PG8_LDB(B1, 0, 1); PG8_SCHED; PG8_LDA(At, 0, 0); PG8_STAGE(PG8_SA(1, 1), a1 + hstep, voffA);
            PG8_WAIT_V(8); PG8_WAIT_L(0); PG8_BAR; PG8_MMA(0, 0, At, B0); PG8_MMA(0, 1, At, B1); PG8_BAR; PG8_SCHED;
            PG8_LDA(At, 0, 1); PG8_STAGE(PG8_SB(0, 0), b2, voffB); PG8_STAGE(PG8_SB(0, 1), b2 + hstep, voffB); PG8_STAGE(PG8_SA(0, 0), a2, voffA);
            PG8_WAIT_V(8); PG8_WAIT_L(0); PG8_BAR; PG8_MMA(1, 0, At, B0); PG8_MMA(1, 1, At, B1); PG8_BAR; PG8_SCHED;
            PG8_LDB(B0, 1, 0); PG8_LDB(B1, 1, 1); PG8_SCHED; PG8_LDA(At, 1, 0); PG8_STAGE(PG8_SA(0, 1), a2 + hstep, voffA);
            PG8_WAIT_V(8); PG8_WAIT_L(0); PG8_BAR; PG8_MMA(0, 0, At, B0); PG8_MMA(0, 1, At, B1); PG8_BAR; PG8_SCHED;
            PG8_LDA(At, 1, 1); PG8_STAGE(PG8_SB(1, 0), b3, voffB); PG8_STAGE(PG8_SB(1, 1), b3 + hstep, voffB); PG8_STAGE(PG8_SA(1, 0), a3, voffA);
            PG8_WAIT_V(8); PG8_WAIT_L(0); PG8_BAR; PG8_MMA(1, 0, At, B0); PG8_MMA(1, 1, At, B1); PG8_BAR; PG8_SCHED;
            } else {
            PG8_LDB(B0, 0, 0); PG8_SCHED; PG8_LDA(At, 0, 0); PG8_STAGE(PG8_SA(1, 1), a1 + hstep, voffA);
            PG8_WAIT_L(8); PG8_BAR; PG8_WAIT_L(0); PG8_MMA(0, 0, At, B0); PG8_BAR; PG8_SCHED;
            PG8_LDB(B1, 0, 1); PG8_STAGE(PG8_SB(0, 0), b2, voffB);
            PG8_BAR; PG8_WAIT_L(0); PG8_MMA(0, 1, At, B1); PG8_BAR;
            PG8_LDA(At, 0, 1); PG8_STAGE(PG8_SA(0, 0), a2, voffA);
            PG8_BAR; PG8_WAIT_L(0); PG8_MMA(1, 0, At, B0); PG8_BAR; PG8_SCHED;
            PG8_STAGE(PG8_SB(0, 1), b2 + hstep, voffB);
            PG8_WAIT_V(6); PG8_BAR; PG8_MMA(1, 1, At, B1); PG8_BAR;
            PG8_LDB(B0, 1, 0); PG8_SCHED; PG8_LDA(At, 1, 0); PG8_STAGE(PG8_SA(0, 1), a2 + hstep, voffA);
            PG8_WAIT_L(8); PG8_BAR; PG8_WAIT_L(0); PG8_MMA(0, 0, At, B0); PG8_BAR; PG8_SCHED;
            PG8_LDB(B1, 1, 1); PG8_STAGE(PG8_SB(1, 0), b3, voffB);
            PG8_BAR; PG8_WAIT_L(0); PG8_MMA(0, 1, At, B1); PG8_BAR;
            PG8_LDA(At, 1, 1); PG8_STAGE(PG8_SA(1, 0), a3, voffA);
            PG8_BAR; PG8_WAIT_L(0); PG8_MMA(1, 0, At, B0); PG8_BAR; PG8_SCHED;
            PG8_STAGE(PG8_SB(1, 1), b3 + hstep, voffB);
            PG8_WAIT_V(6); PG8_BAR; PG8_MMA(1, 1, At, B1); PG8_BAR;
            }
        }
        if constexpr (ALIGN_EPI) { if (wr == 0) PG8_BAR; }
        if constexpr (!Epi::AFTER_DRAIN) { E(acc, cur, wr, wc, fr, fq); S.done(cur); }
        if (!has_next) break;
#pragma unroll
        for (int a = 0; a < 2; ++a)
#pragma unroll
            for (int b = 0; b < 2; ++b)
#pragma unroll
                for (int m = 0; m < 4; ++m)
#pragma unroll
                    for (int n = 0; n < 2; ++n) acc[a][b][m][n] = (f32x4){0.f, 0.f, 0.f, 0.f};
        cur = nxt; cA = nA; cB = nB; ++ui;
        if constexpr (ALIGN_EPI) { if (wr == 1) PG8_BAR; }
    }
    PG8_WAIT_V(0);
    if constexpr (!ALIGN_EPI) { if (wr == 0) PG8_BAR; }
    PG8_BAR;
    if constexpr (Epi::AFTER_DRAIN) { E.fused(acc, cur, wr, wc, fr, fq, lds, wid, lane); S.done(cur); }
#undef PG8_SA
#undef PG8_SB
#undef PG8_STAGE
#undef PG8_LDA
#undef PG8_LDB
#undef PG8_MMA
#undef PG8_WAIT_V
#undef PG8_WAIT_L
#undef PG8_BAR
#undef PG8_SCHED
}
}

constexpr int GT_ROWB = 128, GT_A = 0, GT_B = 128 * GT_ROWB, GT_STAGE = 2 * 128 * GT_ROWB;
#define GT_WOFF(lr_, tid_) ((lr_) * GT_ROWB + ((((tid_) & 7) ^ ((lr_) & 7)) * 16))
#define GT_RSW(ks_, fq_, fr_) ((((ks_) * 4 + (fq_)) ^ ((fr_) & 7)) * 16)
DI void gemm_kloop(unsigned char* lds, const bf16_t* a0, const bf16_t* a1, int a_kadv, const bf16_t* b0, const bf16_t* b1, int nk, f32x4 (&acc)[4][2]) {
  const int tid = otid(), lane = tid & 63, wid = tid >> 6, wr = wid >> 2, wc = wid & 3, fr = lane & 15, fq = lane >> 4;
  const int lr = tid >> 3, lkb = (tid & 7) * 16;
  u32x4 xa0, xa1, xb0, xb1, ya0, ya1, yb0, yb1;
#define GT_GLOAD(p0_, p1_, q0_, q1_, kt) do { p0_ = *(const u32x4*)(a0 + (size_t)(kt) * a_kadv); p1_ = *(const u32x4*)(a1 + (size_t)(kt) * a_kadv); q0_ = *(const u32x4*)(b0 + (kt) * 64); q1_ = *(const u32x4*)(b1 + (kt) * 64); } while (0)
#define GT_LSTORE(p0_, p1_, q0_, q1_, buf) do { unsigned char* s_ = lds + (buf) * GT_STAGE; \
    *(u32x4*)(s_ + GT_A + GT_WOFF(lr, tid)) = p0_; *(u32x4*)(s_ + GT_A + 64 * GT_ROWB + GT_WOFF(lr, tid)) = p1_; \
    *(u32x4*)(s_ + GT_B + GT_WOFF(lr, tid)) = q0_; *(u32x4*)(s_ + GT_B + 64 * GT_ROWB + GT_WOFF(lr, tid)) = q1_; } while (0)
#define GT_COMPUTE(buf) do { \
    const unsigned char* As = lds + (buf) * GT_STAGE + GT_A + (wr * 64 + fr) * GT_ROWB; \
    const unsigned char* Bs = lds + (buf) * GT_STAGE + GT_B + (wc * 32 + fr) * GT_ROWB; \
    _Pragma("unroll") for (int ks = 0; ks < 2; ++ks) { \
      bf16x8 af[4], bfr[2]; \
      _Pragma("unroll") for (int m = 0; m < 4; ++m) af[m] = *(const bf16x8*)(As + m * 16 * GT_ROWB + GT_RSW(ks, fq, fr)); \
      _Pragma("unroll") for (int n = 0; n < 2; ++n) bfr[n] = *(const bf16x8*)(Bs + n * 16 * GT_ROWB + GT_RSW(ks, fq, fr)); \
      _Pragma("unroll") for (int m = 0; m < 4; ++m) _Pragma("unroll") for (int n = 0; n < 2; ++n) acc[m][n] = __builtin_amdgcn_mfma_f32_16x16x32_bf16(bfr[n], af[m], acc[m][n], 0, 0, 0); } } while (0)
  GT_GLOAD(xa0, xa1, xb0, xb1, 0); GT_LSTORE(xa0, xa1, xb0, xb1, 0); if (nk > 1) GT_GLOAD(ya0, ya1, yb0, yb1, 1); __syncthreads();
  for (int kt = 0; kt < nk; kt += 2) {
    if (kt + 2 < nk) GT_GLOAD(xa0, xa1, xb0, xb1, kt + 2);
    GT_COMPUTE(0);
    if (kt + 1 < nk) GT_LSTORE(ya0, ya1, yb0, yb1, 1);
    __syncthreads();
    if (kt + 1 >= nk) break;
    if (kt + 3 < nk) GT_GLOAD(ya0, ya1, yb0, yb1, kt + 3);
    GT_COMPUTE(1);
    if (kt + 2 < nk) GT_LSTORE(xa0, xa1, xb0, xb1, 0);
    __syncthreads();
  }
#undef GT_GLOAD
#undef GT_LSTORE
#undef GT_COMPUTE
}
#define ACC_ZERO(acc) do { _Pragma("unroll") for (int m_ = 0; m_ < 4; ++m_) _Pragma("unroll") for (int n_ = 0; n_ < 2; ++n_) acc[m_][n_] = (f32x4){0.f, 0.f, 0.f, 0.f}; } while (0)
#define TILE_IDS const int tid = otid(), bid = obid(), lane = tid & 63, wid = tid >> 6, wr = wid >> 2, wc = wid & 3, fr = lane & 15, fq = lane >> 4, lr = tid >> 3, lk = (tid & 7) * 8; (void)bid; (void)lane; (void)wr; (void)wc; (void)fr; (void)fq; (void)lr; (void)lk

DI void phase_gates(const Params& P_, unsigned char* lds) {
  Params P = P_; { size_t z_ = 0; asm volatile("" : "+s"(z_)); P.ws = P_.ws + z_; }
  TILE_IDS;
  const bf16_t* xn = (const bf16_t*)(P.ws + WS_A); const bf16_t* wt = (const bf16_t*)(P.ws + WS_W + W_IN) + (size_t)5120 * DM; float* gates = (float*)(P.ws + WS_GATES);
  for (int tile = (int)gridDim.x - 1 - bid; tile < NT / 128; tile += gridDim.x) {
    const int row0 = tile * 128;
    f32x4 acc[4][2]; ACC_ZERO(acc);
    gemm_kloop(lds, xn + (size_t)(row0 + lr) * DM + lk, xn + (size_t)(row0 + lr + 64) * DM + lk, 64, wt + (size_t)lr * DM + lk, wt + (size_t)(lr + 64) * DM + lk, DM / 64, acc);
#pragma unroll
    for (int m = 0; m < 4; ++m)
#pragma unroll
      for (int n = 0; n < 2; ++n) {
        const int row = row0 + wr * 64 + m * 16 + fr, c2 = wc * 32 + n * 16 + 4 * fq; const f32x4 v = acc[m][n];
        if (c2 < 48) { f32x4 o = {sigmoidf_(v.x), sigmoidf_(v.y), sigmoidf_(v.z), sigmoidf_(v.w)}; *(f32x4*)(gates + (size_t)row * 48 + c2) = o; }
      }
  }
}
DI void phase_cmp1(const Params& P_, int l, unsigned char* lds) {
  Params P = P_; { size_t z_ = 0; asm volatile("" : "+s"(z_)); P.ws = P_.ws + z_; }
  TILE_IDS;
  const bf16_t* kvk = (const bf16_t*)(P.ws + WS_C); bf16_t* hid = (bf16_t*)(P.ws + WS_HID);
  const float* cb = (const float*)(P.ws + WS_CB) + l * 512;
  for (int tile = bid; tile < 128; tile += gridDim.x) {
    const int kv = tile >> 6, rt = (tile >> 1) & 31, ct = tile & 1, row0 = rt * 128, col0 = ct * 128;
    const bf16_t* wt = (const bf16_t*)(P.ws + WS_W + W_C1) + (size_t)kv * 256 * 2048;
    const bf16_t* ap[2];
#pragma unroll
    for (int i = 0; i < 2; ++i) { const int rr = row0 + lr + 64 * i, b = rr >> 11, n = (rr >> 2) & 511, g = rr & 3, nn = n > 510 ? 510 : n;
      ap[i] = kvk + (size_t)(b * SEQ + 16 * nn) * DM + kv * 256 + g * 64 + lk; }
    f32x4 acc[4][2]; ACC_ZERO(acc);
    gemm_kloop(lds, ap[0], ap[1], DM, wt + (size_t)(col0 + lr) * 2048 + lk, wt + (size_t)(col0 + lr + 64) * 2048 + lk, 32, acc);
#pragma unroll
    for (int m = 0; m < 4; ++m)
#pragma unroll
      for (int n = 0; n < 2; ++n) {
        const int row = row0 + wr * 64 + m * 16 + fr, col = col0 + wc * 32 + n * 16 + 4 * fq;
        const f32x4 bb = *(const f32x4*)(cb + kv * 256 + col); const f32x4 v = acc[m][n] + bb;
        u32x2 o; o.x = pk2(gelu_tanh(v.x), gelu_tanh(v.y)); o.y = pk2(gelu_tanh(v.z), gelu_tanh(v.w));
        *(u32x2*)(hid + ((size_t)kv * 4096 + row) * 256 + col) = o;
      }
  }
}
DI void phase_cmp2(const Params& P_, unsigned char* lds) {
  Params P = P_; { size_t z_ = 0; asm volatile("" : "+s"(z_)); P.ws = P_.ws + z_; }
  TILE_IDS;
  const bf16_t* hid = (const bf16_t*)(P.ws + WS_HID); bf16_t* kc = (bf16_t*)(P.ws + WS_KC); bf16_t* vc = (bf16_t*)(P.ws + WS_VC);
  for (int tile = bid; tile < 64; tile += gridDim.x) {
    const int kv = tile >> 5, rt = tile & 31, row0 = rt * 128;
    const bf16_t* wt = (const bf16_t*)(P.ws + WS_W + W_C2) + (size_t)kv * 128 * 256;
    const bf16_t* a = hid + ((size_t)kv * 4096 + row0) * 256;
    f32x4 acc[4][2]; ACC_ZERO(acc);
    gemm_kloop(lds, a + (size_t)lr * 256 + lk, a + (size_t)(lr + 64) * 256 + lk, 64, wt + (size_t)lr * 256 + lk, wt + (size_t)(lr + 64) * 256 + lk, 4, acc);
    if (wc < 2) {
#pragma unroll
      for (int m = 0; m < 4; ++m)
#pragma unroll
        for (int n = 0; n < 2; ++n) {
          const int rr = row0 + wr * 64 + m * 16 + fr, d = wc * 32 + n * 16 + 4 * fq;
          const int b = rr >> 11, nn = (rr >> 2) & 511, g = rr & 3; const f32x4 v = acc[m][n];
          if (kv == 0) { u32x2 o; o.x = pk2(v.x, v.y); o.y = pk2(v.z, v.w); *(u32x2*)(kc + ((size_t)((b * 4 + g) * 512 + nn)) * 64 + d) = o; }
          else { bf16_t* dst = vc + ((size_t)((b * 4 + g) * 64 + d)) * 512 + perm16(nn); dst[0] = (bf16_t)f2bf(v.x); dst[512] = (bf16_t)f2bf(v.y); dst[1024] = (bf16_t)f2bf(v.z); dst[1536] = (bf16_t)f2bf(v.w); }
        }
    }
  }
}
DI void phase_glu(const Params& P_, unsigned char* lds) {
  Params P = P_; { size_t z_ = 0; asm volatile("" : "+s"(z_)); P.ws = P_.ws + z_; }
  TILE_IDS;
  const bf16_t* y = (const bf16_t*)(P.ws + WS_G); const bf16_t* wt = (const bf16_t*)(P.ws + WS_W + W_GLU); bf16_t* ssm = (bf16_t*)(P.ws + WS_E);
  for (int tile = bid; tile < (NT / 128) * 4; tile += gridDim.x) {
    const int rt = tile >> 2, ct = tile & 3, row0 = rt * 128, col0 = ct * 128;
    f32x4 acc[4][2]; ACC_ZERO(acc);
    gemm_kloop(lds, y + (size_t)(row0 + lr) * 512 + lk, y + (size_t)(row0 + lr + 64) * 512 + lk, 64, wt + (size_t)(col0 + lr) * 512 + lk, wt + (size_t)(col0 + lr + 64) * 512 + lk, 8, acc);
#pragma unroll
    for (int m = 0; m < 4; ++m)
#pragma unroll
      for (int n = 0; n < 2; ++n) {
        const int row = row0 + wr * 64 + m * 16 + fr, col = col0 + wc * 32 + n * 16 + 4 * fq;
        const u32x2 yy = *(const u32x2*)(y + (size_t)row * 512 + col); const f32x4 v = acc[m][n];
        u32x2 o; o.x = pk2(bflo(yy.x) * sigmoidf_(v.x), bfhi(yy.x) * sigmoidf_(v.y)); o.y = pk2(bflo(yy.y) * sigmoidf_(v.z), bfhi(yy.y) * sigmoidf_(v.w));
        *(u32x2*)(ssm + (size_t)row * 512 + col) = o;
      }
  }
}
struct EpiInproj {
  static constexpr bool PERM = false, AFTER_DRAIN = false;
  bf16_t* qb; bf16_t* kvk; bf16_t* vT; bf16_t* mg; bf16_t* ub; float* gates;
  DI void operator()(const f32x4 (&acc)[2][2][4][2], const pg8::Unit& u, int wr, int wc, int fr_, int fq_) const {
    const int pn = u.pn; int fr = fr_, fq = fq_; asm volatile("" : "+v"(fr), "+v"(fq));
#pragma unroll
    for (int ai = 0; ai < 2; ++ai)
#pragma unroll
      for (int m = 0; m < 4; ++m) {
        const int row = u.pm * 256 + ai * 128 + wr * 64 + m * 16 + fr;
#pragma unroll
        for (int bj = 0; bj < 2; ++bj)
#pragma unroll
          for (int n = 0; n < 2; ++n) {
            const int cl = bj * 128 + wc * 32 + n * 16 + 4 * fq;
            const f32x4 v = acc[ai][bj][m][n];
            if (pn < 4) { u32x2 o; o.x = pk2(v.x * QSCALE, v.y * QSCALE); o.y = pk2(v.z * QSCALE, v.w * QSCALE); *(u32x2*)(qb + (size_t)row * DM + pn * 256 + cl) = o; }
            else if (pn < 10) {
              const int seg = pn - 4;
              if (seg == 5) {
                const int b = row >> 13, t = row & (SEQ - 1), g = cl >> 6, d = cl & 63;
                bf16_t* dst = vT + ((size_t)(((1 * NB + b) * 4 + g) * 64 + d)) * SEQ + perm16(t);
                dst[0] = (bf16_t)f2bf(v.x); dst[SEQ] = (bf16_t)f2bf(v.y); dst[2 * SEQ] = (bf16_t)f2bf(v.z); dst[3 * SEQ] = (bf16_t)f2bf(v.w);
              } else if (seg == 3) {
                const unsigned t = row & (SEQ - 1), pos = perm16(t) & 63;
                const unsigned ro = ((unsigned)(row >> 13) * 512u + (t >> 6)) * 4096u + (pos >> 3) * 256u + (pos & 7), co = (unsigned)(cl >> 6) * 524288u + (unsigned)((cl >> 5) & 1) * 2048u + (unsigned)(cl & 31) * 8u;
                bf16_t* dst = vT + (ro + co);
                dst[0] = (bf16_t)f2bf(v.x); dst[8] = (bf16_t)f2bf(v.y); dst[16] = (bf16_t)f2bf(v.z); dst[24] = (bf16_t)f2bf(v.w);
              } else if (seg == 2) {
                const unsigned t = row & (SEQ - 1);
                const unsigned ro = ((unsigned)(row >> 13) * 512u + (t >> 6)) * 4096u + ((t >> 5) & 1) * 2048u + (t & 31) * 8u, co = (unsigned)(cl >> 6) * 524288u + (unsigned)((cl >> 3) & 7) * 256u + (unsigned)(cl & 7);
                u32x2 o; o.x = pk2(v.x, v.y); o.y = pk2(v.z, v.w);
                *(u32x2*)(kvk + (WS_KSF - WS_C) / 2 + (ro + co)) = o;
              } else {
                const int slot = seg == 4 ? 3 : seg;
                u32x2 o; o.x = pk2(v.x, v.y); o.y = pk2(v.z, v.w); *(u32x2*)(kvk + (size_t)row * DM + slot * 256 + cl) = o;
              }
            } else if (pn < 18) {
              u32x2 o; o.x = pk2(sigmoidf_(v.x), sigmoidf_(v.y)); o.y = pk2(sigmoidf_(v.z), sigmoidf_(v.w)); *(u32x2*)(mg + (size_t)row * 2048 + (pn - 10) * 256 + cl) = o;
            } else if (pn < 20) { const int ch = (pn - 18) * 256 + cl; u32x2 o; o.x = pk2(v.x, v.y); o.y = pk2(v.z, v.w); *(u32x2*)(ub + ((size_t)(ch >> 4) * NT + row) * 16 + (ch & 15)) = o; }
            else { if (cl < 48) { f32x4 o = {sigmoidf_(v.x), sigmoidf_(v.y), sigmoidf_(v.z), sigmoidf_(v.w)}; *(f32x4*)(gates + (size_t)row * 48 + cl) = o; } }
          }
      }
  }
};
DI void phase_inproj8(const Params& P_, unsigned char* lds) {
  Params P = P_; { size_t z_ = 0; asm volatile("" : "+s"(z_)); P.ws = P_.ws + z_; }
  pg8::Gemm g{(const bf16_t*)(P.ws + WS_A), (const bf16_t*)(P.ws + WS_W + W_IN), NT, 5120, DM};
  pg8::StaticOrder S; S.init(NT, 5120, gridDim.x, obid());
  EpiInproj E{(bf16_t*)(P.ws + WS_B), (bf16_t*)(P.ws + WS_C), (bf16_t*)(P.ws + WS_DV), (bf16_t*)(P.ws + WS_F), (bf16_t*)(P.ws + WS_E), (float*)(P.ws + WS_GATES)};
  pg8::gemm_phase<EpiInproj, pg8::StaticOrder, true, true>((PG8_LAS unsigned char*)lds, g, S, E);
}
struct EpiMerge1 {
  static constexpr bool PERM = false, AFTER_DRAIN = false;
  const bf16_t* mg; bf16_t* tmp;
  DI void operator()(const f32x4 (&acc)[2][2][4][2], const pg8::Unit& u, int wr, int wc, int fr, int fq) const {
#pragma unroll
    for (int ai = 0; ai < 2; ++ai) {
      u32x2 ga[4][2][2];
#pragma unroll
      for (int m = 0; m < 4; ++m)
#pragma unroll
        for (int bj = 0; bj < 2; ++bj)
#pragma unroll
          for (int n = 0; n < 2; ++n) {
            const int row = u.pm * 256 + ai * 128 + wr * 64 + m * 16 + fr, col = u.pn * 256 + bj * 128 + wc * 32 + n * 16 + 4 * fq;
            ga[m][bj][n] = *(const u32x2*)(mg + (size_t)row * 2048 + col);
          }
      __builtin_amdgcn_sched_barrier(0);
#pragma unroll
      for (int m = 0; m < 4; ++m)
#pragma unroll
        for (int bj = 0; bj < 2; ++bj)
#pragma unroll
          for (int n = 0; n < 2; ++n) {
            const int row = u.pm * 256 + ai * 128 + wr * 64 + m * 16 + fr, col = u.pn * 256 + bj * 128 + wc * 32 + n * 16 + 4 * fq;
            const f32x4 v = acc[ai][bj][m][n]; const u32x2 g = ga[m][bj][n];
            u32x2 o; o.x = pk2(v.x * bflo(g.x), v.y * bfhi(g.x)); o.y = pk2(v.z * bflo(g.y), v.w * bfhi(g.y));
            *(u32x2*)(tmp + (size_t)row * DM + col) = o;
          }
      __builtin_amdgcn_sched_barrier(0);
    }
  }
};
struct EpiMerge2 {
  static constexpr bool PERM = false, AFTER_DRAIN = false;
  const bf16_t* mg; const bf16_t* tmp; bf16_t* mer;
  DI void operator()(const f32x4 (&acc)[2][2][4][2], const pg8::Unit& u, int wr, int wc, int fr, int fq) const {
#pragma unroll
    for (int ai = 0; ai < 2; ++ai)
#pragma unroll
      for (int mh = 0; mh < 2; ++mh) {
        u32x2 gs[2][2][2], tv[2][2][2];
#pragma unroll
        for (int mm = 0; mm < 2; ++mm)
#pragma unroll
          for (int bj = 0; bj < 2; ++bj)
#pragma unroll
            for (int n = 0; n < 2; ++n) {
              const int row = u.pm * 256 + ai * 128 + wr * 64 + (mh * 2 + mm) * 16 + fr, col = u.pn * 256 + bj * 128 + wc * 32 + n * 16 + 4 * fq;
              gs[mm][bj][n] = *(const u32x2*)(mg + (size_t)row * 2048 + 1024 + col);
#if EN_ATTN
              tv[mm][bj][n] = *(const u32x2*)(tmp + (size_t)row * DM + col);
#else
              tv[mm][bj][n] = (u32x2){0u, 0u};
#endif
            }
        __builtin_amdgcn_sched_barrier(0);
#pragma unroll
        for (int mm = 0; mm < 2; ++mm)
#pragma unroll
          for (int bj = 0; bj < 2; ++bj)
#pragma unroll
            for (int n = 0; n < 2; ++n) {
              const int row = u.pm * 256 + ai * 128 + wr * 64 + (mh * 2 + mm) * 16 + fr, col = u.pn * 256 + bj * 128 + wc * 32 + n * 16 + 4 * fq;
              const f32x4 v = acc[ai][bj][mh * 2 + mm][n]; const u32x2 g = gs[mm][bj][n], t = tv[mm][bj][n];
              u32x2 o; o.x = pk2(bflo(t.x) + v.x * bflo(g.x), bfhi(t.x) + v.y * bfhi(g.x)); o.y = pk2(bflo(t.y) + v.z * bflo(g.y), bfhi(t.y) + v.w * bfhi(g.y));
              *(u32x2*)(mer + (size_t)row * DM + col) = o;
            }
        __builtin_amdgcn_sched_barrier(0);
      }
  }
};
DI void phase_merge8(const Params& P_, unsigned char* lds) {
  Params P = P_; { size_t z_ = 0; asm volatile("" : "+s"(z_)); P.ws = P_.ws + z_; }
#if EN_ATTN
  { pg8::Gemm g{(const bf16_t*)(P.ws + WS_A), (const bf16_t*)(P.ws + WS_W + W_O), NT, DM, DM};
    pg8::StaticOrder S; S.init(NT, DM, gridDim.x, obid());
    EpiMerge1 E{(const bf16_t*)(P.ws + WS_F), (bf16_t*)(P.ws + WS_C)};
    pg8::gemm_phase<EpiMerge1, pg8::StaticOrder, true, true>((PG8_LAS unsigned char*)lds, g, S, E); }
#endif
  { pg8::Gemm g{(const bf16_t*)(P.ws + WS_E), (const bf16_t*)(P.ws + WS_W + W_SO), NT, DM, 512};
    pg8::StaticOrder S; S.init(NT, DM, gridDim.x, obid());
    EpiMerge2 E{(const bf16_t*)(P.ws + WS_F), (const bf16_t*)(P.ws + WS_C), (bf16_t*)(P.ws + WS_B)};
    pg8::gemm_phase<EpiMerge2, pg8::StaticOrder, true, true>((PG8_LAS unsigned char*)lds, g, S, E); }
}
struct EpiWout {
  static constexpr bool PERM = false, AFTER_DRAIN = false;
  const float* mod; const float* xin; float* out;
  DI void operator()(const f32x4 (&acc)[2][2][4][2], const pg8::Unit& u, int wr, int wc, int fr, int fq) const {
    const int b = (u.pm * 256) >> 13;
    f32x4 g1[2][2];
#pragma unroll
    for (int bj = 0; bj < 2; ++bj)
#pragma unroll
      for (int n = 0; n < 2; ++n) g1[bj][n] = *(const f32x4*)(mod + (size_t)b * 6144 + 2048 + u.pn * 256 + bj * 128 + wc * 32 + n * 16 + 4 * fq);
#pragma unroll
    for (int ai = 0; ai < 2; ++ai)
#pragma unroll
      for (int mh = 0; mh < 2; ++mh) {
        f32x4 xv[2][2][2];
#pragma unroll
        for (int mm = 0; mm < 2; ++mm)
#pragma unroll
          for (int bj = 0; bj < 2; ++bj)
#pragma unroll
            for (int n = 0; n < 2; ++n) {
              const int row = u.pm * 256 + ai * 128 + wr * 64 + (mh * 2 + mm) * 16 + fr, col = u.pn * 256 + bj * 128 + wc * 32 + n * 16 + 4 * fq;
              xv[mm][bj][n] = *(const f32x4*)(xin + (size_t)row * DM + col);
            }
        __builtin_amdgcn_sched_barrier(0);
#pragma unroll
        for (int mm = 0; mm < 2; ++mm)
#pragma unroll
          for (int bj = 0; bj < 2; ++bj)
#pragma unroll
            for (int n = 0; n < 2; ++n) {
              const int row = u.pm * 256 + ai * 128 + wr * 64 + (mh * 2 + mm) * 16 + fr, col = u.pn * 256 + bj * 128 + wc * 32 + n * 16 + 4 * fq;
              *(f32x4*)(out + (size_t)row * DM + col) = xv[mm][bj][n] + g1[bj][n] * acc[ai][bj][mh * 2 + mm][n];
            }
        __builtin_amdgcn_sched_barrier(0);
      }
  }
};
DI void phase_wout8(const Params& P_, int l, unsigned char* lds) {
  Params P = P_; { size_t z_ = 0; asm volatile("" : "+s"(z_)); P.ws = P_.ws + z_; }
  pg8::Gemm g{(const bf16_t*)(P.ws + WS_B), (const bf16_t*)(P.ws + WS_W + W_OUT), NT, DM, DM};
  pg8::StaticOrder S; S.init(NT, DM, gridDim.x, obid());
  EpiWout E{(const float*)(P.ws + WS_MOD) + (size_t)(l * 2) * 6144, l == 0 ? P.in[0] : P.out, P.out};
  pg8::gemm_phase<EpiWout, pg8::StaticOrder, true, true>((PG8_LAS unsigned char*)lds, g, S, E);
}

struct MoeTab { int cv, pin; };
DI MoeTab moe_tab(const int* cnt) {
  const int lane = otid() & 63; MoeTab T; T.cv = cnt[lane & 31]; int p = (T.cv + 127) >> 7;
#pragma unroll
  for (int o = 1; o < 32; o <<= 1) { const int t = __shfl_up(p, o); if ((lane & 31) >= o) p += t; }
  T.pin = p; return T;
}
DI int moe_total(const MoeTab& T) { return __builtin_amdgcn_readlane(T.pin, 31); }
DI void moe_find(const MoeTab& T, int rb, int& e, int& rbl, int& ce) {
  const unsigned m = (unsigned)__ballot(T.pin <= rb);
  e = __popc(m); e = e < NEXP ? e : NEXP - 1;
  const int nb = (__shfl(T.cv, e) + 127) >> 7;
  ce = __shfl(T.cv, e); rbl = rb - (__shfl(T.pin, e) - nb);
  e = __builtin_amdgcn_readfirstlane(e); rbl = __builtin_amdgcn_readfirstlane(rbl); ce = __builtin_amdgcn_readfirstlane(ce);
}
DI void phase_moe1(const Params& P_, int l, unsigned char* lds) {
  Params P = P_; { size_t z_ = 0; asm volatile("" : "+s"(z_)); P.ws = P_.ws + z_; }
  TILE_IDS;
  const int* cnt = (const int*)(P.ws + WS_CNT) + l * 32; const int* list = (const int*)(P.ws + WS_LIST);
  const bf16_t* h2 = (const bf16_t*)(P.ws + WS_A); bf16_t* act = (bf16_t*)(P.ws + WS_B);
  const MoeTab MT = moe_tab(cnt); const int total = moe_total(MT);
  const int G_ = gridDim.x, nx_ = (G_ % 8 == 0) ? 8 : 1, xg_ = bid % nx_, xs_ = bid / nx_, xb0_ = (int)((long)total * xg_ / nx_), xb1_ = (int)((long)total * (xg_ + 1) / nx_);
  for (int tl = xs_; tl < (xb1_ - xb0_) * 4; tl += G_ / nx_) {
    const int rb = xb0_ + (tl >> 2), ct = tl & 3; int e = 0, rbl = 0, ce = 1; moe_find(MT, rb, e, rbl, ce);
    const bf16_t* wt = (const bf16_t*)(P.ws + WS_W + W_GU) + (size_t)e * 512 * 1024 + (size_t)(ct * 128) * 1024;
    const bf16_t* ap[2];
#pragma unroll
    for (int i = 0; i < 2; ++i) { int idx = rbl * 128 + lr + 64 * i; idx = idx < ce ? idx : ce - 1; const int tok = list[e * LISTCAP + idx] >> 1; ap[i] = h2 + (size_t)tok * DM + lk; }
    f32x4 acc[4][2]; ACC_ZERO(acc);
    gemm_kloop(lds, ap[0], ap[1], 64, wt + (size_t)lr * DM + lk, wt + (size_t)(lr + 64) * DM + lk, 16, acc);
#pragma unroll
    for (int m = 0; m < 4; ++m) {
      const int arow = rb * 128 + wr * 64 + m * 16 + fr, col = ct * 64 + wc * 16 + 4 * fq;
      const f32x4 g = acc[m][0], u = acc[m][1];
      u32x2 o; o.x = pk2(g.x * sigmoidf_(g.x) * u.x, g.y * sigmoidf_(g.y) * u.y); o.y = pk2(g.z * sigmoidf_(g.z) * u.z, g.w * sigmoidf_(g.w) * u.w);
      *(u32x2*)(act + (size_t)arow * 256 + col) = o;
    }
  }
}
DI void phase_moe2(const Params& P_, int l, unsigned char* lds) {
  Params P = P_; { size_t z_ = 0; asm volatile("" : "+s"(z_)); P.ws = P_.ws + z_; }
  TILE_IDS;
  const int* cnt = (const int*)(P.ws + WS_CNT) + l * 32; const int* list = (const int*)(P.ws + WS_LIST); const float* wts = (const float*)(P.ws + WS_WT);
  const bf16_t* act = (const bf16_t*)(P.ws + WS_B); bf16_t* ys = (bf16_t*)(P.ws + WS_F);
  constexpr int ASUB = 128 * GT_ROWB, BOFF = 4 * ASUB;
  const MoeTab MT = moe_tab(cnt); const int total = moe_total(MT);
  const int lkb = (tid & 7) * 16;
  const int G_ = gridDim.x, nx_ = (G_ % 8 == 0) ? 8 : 1, xg_ = bid % nx_, xs_ = bid / nx_, xb0_ = (int)((long)total * xg_ / nx_), xb1_ = (int)((long)total * (xg_ + 1) / nx_);
  for (int tl = xs_; tl < (xb1_ - xb0_) * 4; tl += G_ / nx_) {
    const int rb = xb0_ + (tl >> 2), ct0 = (tl & 3) * 2; int e = 0, rbl = 0, ce = 1; moe_find(MT, rb, e, rbl, ce);
    const bf16_t* wt = (const bf16_t*)(P.ws + WS_W + W_D) + (size_t)e * 1024 * 256;
    const bf16_t* a0 = act + (size_t)(rb * 128 + lr) * 256 + lk; const bf16_t* a1 = a0 + 64 * 256;
    u32x4 ra[8], bq[8][2];
#pragma unroll
    for (int k = 0; k < 4; ++k) { ra[2 * k] = *(const u32x4*)(a0 + 64 * k); ra[2 * k + 1] = *(const u32x4*)(a1 + 64 * k); }
#define M2_BLOAD(q0_, q1_, s_) do { const bf16_t* bp_ = wt + (size_t)((ct0 + ((s_) >> 2)) * 128 + lr) * 256 + ((s_) & 3) * 64 + lk; q0_ = *(const u32x4*)bp_; q1_ = *(const u32x4*)(bp_ + 64 * 256); } while (0)
#define M2_BSTORE(q0_, q1_, buf_) do { unsigned char* s_ = lds + BOFF + (buf_) * ASUB; *(u32x4*)(s_ + GT_WOFF(lr, tid)) = q0_; *(u32x4*)(s_ + 64 * GT_ROWB + GT_WOFF(lr, tid)) = q1_; } while (0)
#define M2_COMPUTE(s_, buf_) do { \
      const unsigned char* As = lds + ((s_) & 3) * ASUB + (wr * 64 + fr) * GT_ROWB; \
      const unsigned char* Bs = lds + BOFF + (buf_) * ASUB + (wc * 32 + fr) * GT_ROWB; \
      _Pragma("unroll") for (int ks = 0; ks < 2; ++ks) { \
        bf16x8 af[4], bfr[2]; \
        _Pragma("unroll") for (int m = 0; m < 4; ++m) af[m] = *(const bf16x8*)(As + m * 16 * GT_ROWB + GT_RSW(ks, fq, fr)); \
        _Pragma("unroll") for (int n = 0; n < 2; ++n) bfr[n] = *(const bf16x8*)(Bs + n * 16 * GT_ROWB + GT_RSW(ks, fq, fr)); \
        _Pragma("unroll") for (int m = 0; m < 4; ++m) _Pragma("unroll") for (int n = 0; n < 2; ++n) acc[m][n] = __builtin_amdgcn_mfma_f32_16x16x32_bf16(bfr[n], af[m], acc[m][n], 0, 0, 0); } } while (0)
#define M2_EPI(ct_) do { _Pragma("unroll") for (int m = 0; m < 4; ++m) { const int idx = rbl * 128 + wr * 64 + m * 16 + fr; \
      if (idx < ce) { const int slot = eslot[m]; const float w_ = ewt[m]; \
        _Pragma("unroll") for (int n = 0; n < 2; ++n) { const int col = (ct_) * 128 + wc * 32 + n * 16 + 4 * fq; const f32x4 v = acc[m][n] * w_; \
          u32x2 o; o.x = pk2(v.x, v.y); o.y = pk2(v.z, v.w); *(u32x2*)(ys + (size_t)slot * DM + col) = o; } } } ACC_ZERO(acc); } while (0)
    int eslot[4]; float ewt[4];
#pragma unroll
    for (int m = 0; m < 4; ++m) { int idx = rbl * 128 + wr * 64 + m * 16 + fr; idx = idx < ce ? idx : ce - 1; eslot[m] = list[e * LISTCAP + idx]; }
#pragma unroll
    for (int s2 = 0; s2 < 8; ++s2) M2_BLOAD(bq[s2][0], bq[s2][1], s2);
#pragma unroll
    for (int m = 0; m < 4; ++m) ewt[m] = wts[eslot[m]];
#pragma unroll
    for (int k = 0; k < 4; ++k) { *(u32x4*)(lds + k * ASUB + GT_WOFF(lr, tid)) = ra[2 * k]; *(u32x4*)(lds + k * ASUB + 64 * GT_ROWB + GT_WOFF(lr, tid)) = ra[2 * k + 1]; }
    M2_BSTORE(bq[0][0], bq[0][1], 0);
    __syncthreads();
    f32x4 acc[4][2]; ACC_ZERO(acc);
#pragma unroll
    for (int s2 = 0; s2 < 8; ++s2) {
      M2_COMPUTE(s2, s2 & 1);
      if (s2 + 1 < 8) M2_BSTORE(bq[s2 + 1][0], bq[s2 + 1][1], (s2 + 1) & 1);
      if (s2 == 3) M2_EPI(ct0);
      if (s2 == 7) M2_EPI(ct0 + 1);
      __syncthreads();
    }
#undef M2_BLOAD
#undef M2_BSTORE
#undef M2_COMPUTE
#undef M2_EPI
  }
}

typedef float f32x2v __attribute__((ext_vector_type(2)));
DI void phase_s5a(const Params& P_, int l, unsigned char* lds) {
  Params P = P_; { size_t z_ = 0; asm volatile("" : "+s"(z_)); P.ws = P_.ws + z_; }
  TILE_IDS;
  const bf16_t* ub = (const bf16_t*)(P.ws + WS_E); float* Lb = (float*)(P.ws + WS_L);
  const bf16_t* M1 = (const bf16_t*)(P.ws + WS_TAB + (size_t)l * TAB_LAYER + TAB_M1);
  const int first = (int)gridDim.x >= 192 ? 128 : 0;
  for (int tile = bid - first; tile >= 0 && tile < 64; tile += gridDim.x) {
    const int g = tile >> 1, rt = tile & 1;
    const bf16_t* a = ub + ((size_t)g * NT / 64 + rt * 128) * 1024;
    const bf16_t* wt = M1 + (size_t)g * 128 * 1024;
    f32x4 acc[4][2]; ACC_ZERO(acc);
    gemm_kloop(lds, a + (size_t)lr * 1024 + lk, a + (size_t)(lr + 64) * 1024 + lk, 64, wt + (size_t)lr * 1024 + lk, wt + (size_t)(lr + 64) * 1024 + lk, 16, acc);
#pragma unroll
    for (int m = 0; m < 4; ++m)
#pragma unroll
      for (int n = 0; n < 2; ++n) {
        const int R = rt * 128 + wr * 64 + m * 16 + fr, comp = wc * 32 + n * 16 + 4 * fq;
        *(f32x4*)(Lb + ((size_t)(R * 32 + g) * 64) * 2 + comp) = acc[m][n];
      }
  }
}
DI void s5_carry(const Params& P_, int l) {
  Params P = P_; { size_t z_ = 0; asm volatile("" : "+s"(z_)); P.ws = P_.ws + z_; }
  const int tid_ = otid(), bid = obid(), wave = tid_ >> 6, lane = tid_ & 63;
  const int item = (gridDim.x * NWAVE - 1) - (bid * NWAVE + wave);
  if (item >= NB * 32) return;
  const int b = item >> 5, g = item & 31;
  const float* pp = (const float*)(P.ws + WS_S5P) + (size_t)((l * 32 + g) * 64 + lane) * 36;
  const float aTr = pp[2], aTi = pp[3];
  float2* Lp = (float2*)(P.ws + WS_L) + ((size_t)(b * 128) * 32 + g) * 64 + lane;
  unsigned* Sp = (unsigned*)(P.ws + WS_SIN) + ((size_t)(g * 256 + b * 128)) * 64 + lane;
  float sr = 0.f, si = 0.f; asm volatile("" : "+v"(sr), "+v"(si));
  float2 va[8], vb[8];
#define CY_LOAD(vv, c0_) do { _Pragma("unroll") for (int k = 0; k < 8; ++k) vv[k] = Lp[(size_t)((c0_) + k) * 2048]; } while (0)
#define CY_STEP(vv, c0_) do { _Pragma("unroll") for (int k = 0; k < 8; ++k) { Lp[(size_t)((c0_) + k) * 2048] = make_float2(sr, si); Sp[(size_t)((c0_) + k) * 64] = pk2(sr, si); \
      const float nr = aTr * sr - aTi * si + vv[k].x, ni = aTr * si + aTi * sr + vv[k].y; sr = nr; si = ni; } } while (0)
#define CY_PIN(vv) do { _Pragma("unroll") for (int k = 0; k < 8; ++k) asm volatile("" : "+v"(vv[k].x), "+v"(vv[k].y)); } while (0)
  CY_LOAD(va, 0);
#pragma unroll
  for (int c0 = 0; c0 < 128; c0 += 16) {
    CY_LOAD(vb, c0 + 8);
    CY_PIN(va);
    CY_STEP(va, c0);
    if (c0 + 16 < 128) CY_LOAD(va, c0 + 16);
    CY_PIN(vb);
    CY_STEP(vb, c0 + 8);
  }
#undef CY_PIN
#undef CY_LOAD
#undef CY_STEP
}
DI void phase_s5c(const Params& P_, int l, unsigned char* lds) {
  Params P = P_; { size_t z_ = 0; asm volatile("" : "+s"(z_)); P.ws = P_.ws + z_; }
  TILE_IDS;
  const bf16_t* ub = (const bf16_t*)(P.ws + WS_E); const bf16_t* sinb = (const bf16_t*)(P.ws + WS_SIN); bf16_t* yb = (bf16_t*)(P.ws + WS_G);
  const bf16_t* tab = (const bf16_t*)(P.ws + WS_TAB + (size_t)l * TAB_LAYER);
  int* dctr = (int*)(P.ws + 640) + l; int* dslot = (int*)(lds + LDS_BYTES - 32);
  constexpr int ROWB = GT_ROWB, SA = 0, SB = 128 * ROWB, STAGE = 2 * 128 * ROWB;
  const int lkb = (tid & 7) * 16, kch = tid & 7;
  for (;;) {
    if (threadIdx.x == 0) *dslot = atomicAdd(dctr, 1);
    __syncthreads();
    const int tile = *dslot;
    __syncthreads();
    if (tile >= 512) break;
    const int g = tile >> 4, rt = (tile >> 3) & 1, ct = tile & 7;
    const bf16_t* Kt = tab + TAB_KT / 2 + (size_t)g * 64 * 256; const bf16_t* M2 = tab + TAB_M2 / 2 + (size_t)g * 1024 * 128;
    const bf16_t* ua = ub + ((size_t)g * 256 + rt * 128) * 1024; const bf16_t* sa = sinb + ((size_t)g * 256 + rt * 128) * 128;
    const int nbt = 2 * ct + 2 < 16 ? 2 * ct + 2 : 16, ns = nbt + 2;
    u32x4 xa0, xa1, xb0, xb1, ya0, ya1, yb0, yb1;
#define S5_LOAD(p0_, p1_, q0_, q1_, s_) do { \
      if ((s_) < nbt) { p0_ = *(const u32x4*)(ua + (size_t)lr * 1024 + (s_) * 64 + lk); p1_ = *(const u32x4*)(ua + (size_t)(lr + 64) * 1024 + (s_) * 64 + lk); \
        const int i_ = 4 * (s_) + (kch >> 1), hq_ = (kch & 1) * 8; \
        { const int t_ = 8 * ct + (lr >> 4), h_ = lr & 15; q0_ = t_ >= i_ ? *(const u32x4*)(Kt + ((t_ - i_) * 16 + h_) * 16 + hq_) : (u32x4){0u, 0u, 0u, 0u}; } \
        { const int t_ = 8 * ct + 4 + (lr >> 4), h_ = lr & 15; q1_ = t_ >= i_ ? *(const u32x4*)(Kt + ((t_ - i_) * 16 + h_) * 16 + hq_) : (u32x4){0u, 0u, 0u, 0u}; } \
      } else { const int k0_ = ((s_) - nbt) * 64 + lk; \
        p0_ = *(const u32x4*)(sa + (size_t)lr * 128 + k0_); p1_ = *(const u32x4*)(sa + (size_t)(lr + 64) * 128 + k0_); \
        q0_ = *(const u32x4*)(M2 + (size_t)(ct * 128 + lr) * 128 + k0_); q1_ = *(const u32x4*)(M2 + (size_t)(ct * 128 + lr + 64) * 128 + k0_); } } while (0)
#define S5_STORE(p0_, p1_, q0_, q1_, buf) do { unsigned char* s_ = lds + (buf) * STAGE; \
      *(u32x4*)(s_ + SA + GT_WOFF(lr, tid)) = p0_; *(u32x4*)(s_ + SA + 64 * ROWB + GT_WOFF(lr, tid)) = p1_; \
      *(u32x4*)(s_ + SB + GT_WOFF(lr, tid)) = q0_; *(u32x4*)(s_ + SB + 64 * ROWB + GT_WOFF(lr, tid)) = q1_; } while (0)
#define S5_COMPUTE(buf) do { \
      const unsigned char* As = lds + (buf) * STAGE + SA + (wr * 64 + fr) * ROWB; \
      const unsigned char* Bs = lds + (buf) * STAGE + SB + (wc * 32 + fr) * ROWB; \
      _Pragma("unroll") for (int ks = 0; ks < 2; ++ks) { \
        bf16x8 af[4], bfr[2]; \
        _Pragma("unroll") for (int m = 0; m < 4; ++m) af[m] = *(const bf16x8*)(As + m * 16 * ROWB + GT_RSW(ks, fq, fr)); \
        _Pragma("unroll") for (int n = 0; n < 2; ++n) bfr[n] = *(const bf16x8*)(Bs + n * 16 * ROWB + GT_RSW(ks, fq, fr)); \
        _Pragma("unroll") for (int m = 0; m < 4; ++m) _Pragma("unroll") for (int n = 0; n < 2; ++n) acc[m][n] = __builtin_amdgcn_mfma_f32_16x16x32_bf16(bfr[n], af[m], acc[m][n], 0, 0, 0); } } while (0)
    f32x4 acc[4][2]; ACC_ZERO(acc);
    S5_LOAD(xa0, xa1, xb0, xb1, 0); S5_STORE(xa0, xa1, xb0, xb1, 0); S5_LOAD(ya0, ya1, yb0, yb1, 1); __syncthreads();
    for (int st = 0; st < ns; st += 2) {
      if (st + 2 < ns) S5_LOAD(xa0, xa1, xb0, xb1, st + 2);
      S5_COMPUTE(0);
      if (st + 1 < ns) S5_STORE(ya0, ya1, yb0, yb1, 1);
      __syncthreads();
      if (st + 1 >= ns) break;
      if (st + 3 < ns) S5_LOAD(ya0, ya1, yb0, yb1, st + 3);
      S5_COMPUTE(1);
      if (st + 2 < ns) S5_STORE(xa0, xa1, xb0, xb1, 0);
      __syncthreads();
    }
#undef S5_LOAD
#undef S5_STORE
#undef S5_COMPUTE
    const float* dsk = P.in[13] + (size_t)(l * 32 + g) * 16;
#pragma unroll
    for (int m = 0; m < 4; ++m)
#pragma unroll
      for (int n = 0; n < 2; ++n) {
        const int R = rt * 128 + wr * 64 + m * 16 + fr, col = ct * 128 + wc * 32 + n * 16 + 4 * fq, t = col >> 4, h = col & 15;
        const u32x2 uu = *(const u32x2*)(ub + ((size_t)g * 256 + R) * 1024 + col); const f32x4 dd = *(const f32x4*)(dsk + h); const f32x4 v = acc[m][n];
        const float y0 = gelu_tanh(v.x + dd.x * bflo(uu.x)), y1 = gelu_tanh(v.y + dd.y * bfhi(uu.x)), y2 = gelu_tanh(v.z + dd.z * bflo(uu.y)), y3 = gelu_tanh(v.w + dd.w * bfhi(uu.y));
        const size_t tokn = (size_t)(R >> 7) * SEQ + 64 * (R & 127) + t;
        u32x2 o; o.x = pk2(y0, y1); o.y = pk2(y2, y3); *(u32x2*)(yb + tokn * 512 + g * 16 + h) = o;
      }
  }
}

constexpr int AT_ROWB = 144, AT_KS = 0, AT_VS = 2 * 64 * AT_ROWB, AT_IMP = 4 * 64 * AT_ROWB, AT_OACC = AT_IMP, AT_IMPS = 129, AT_EE = AT_IMP + 64 * AT_IMPS * 4,
              AT_SEL = AT_IMP + 66048, AT_QS = AT_SEL + 1024, AT_QL = AT_QS + 32768, AT_NJ = AT_QL + 8192, AT_ITEMS = AT_NJ + 512, AT_MREF = AT_ITEMS + 512,
              AT_LACC = AT_MREF + 1024, AT_INVQ = AT_LACC + 1024, AT_MISC = AT_INVQ + 512, AT_LOWN = AT_MISC + 64, AT_END = AT_LOWN + 1024;
static_assert(AT_END <= LDS_BYTES - 16, "attention LDS");
#define MFMA32(a, b, c) __builtin_amdgcn_mfma_f32_32x32x16_bf16((a), (b), (c), 0, 0, 0)
DI int crow_of(int reg, int hh) { return (reg & 3) + 8 * (reg >> 2) + 4 * hh; }

struct AttnState { f32x16 o0, o1; float m, l; };
DI void st_init(AttnState& S) { S.m = -1e30f; S.l = 0.f;
#pragma unroll
  for (int i = 0; i < 16; ++i) { S.o0[i] = 0.f; S.o1[i] = 0.f; } }

DI void at_ldk(const unsigned char* lds, int buf, int r, int hh, bf16x8 (&kf)[8]) {
  const unsigned char* kb = lds + AT_KS + buf * 64 * AT_ROWB + r * AT_ROWB + hh * 16;
#pragma unroll
  for (int ds = 0; ds < 4; ++ds) { kf[ds] = *(const bf16x8*)(kb + ds * 32); kf[4 + ds] = *(const bf16x8*)(kb + 32 * AT_ROWB + ds * 32); }
}
DI void at_ldv(const unsigned char* lds, int buf, int r, int hh, bf16x8 (&vf)[8]) {
  const unsigned char* vb = lds + AT_VS + buf * 64 * AT_ROWB + r * AT_ROWB + hh * 16;
#pragma unroll
  for (int gk = 0; gk < 4; ++gk) { vf[gk] = *(const bf16x8*)(vb + gk * 32); vf[4 + gk] = *(const bf16x8*)(vb + 32 * AT_ROWB + gk * 32); }
}
DI void at_qk(const bf16x8 (&kf)[8], const bf16x8 (&qf)[4], f32x16& p0, f32x16& p1) {
  const f32x16 z = {0.f, 0.f, 0.f, 0.f, 0.f, 0.f, 0.f, 0.f, 0.f, 0.f, 0.f, 0.f, 0.f, 0.f, 0.f, 0.f};
#pragma unroll
  for (int ds = 0; ds < 4; ++ds) { if (ds == 0) { p0 = MFMA32(kf[0], qf[0], z); p1 = MFMA32(kf[4], qf[0], z); } else { p0 = MFMA32(kf[ds], qf[ds], p0); p1 = MFMA32(kf[4 + ds], qf[ds], p1); } }
}
DI bf16x8 pack8(const f32x16& p, int s2) {
  u32x4 w; w.x = pk2(p[8 * s2], p[8 * s2 + 1]); w.y = pk2(p[8 * s2 + 2], p[8 * s2 + 3]); w.z = pk2(p[8 * s2 + 4], p[8 * s2 + 5]); w.w = pk2(p[8 * s2 + 6], p[8 * s2 + 7]);
  return __builtin_bit_cast(bf16x8, w);
}
DI void at_pv(const bf16x8 (&vf)[8], const f32x16& p0, const f32x16& p1, f32x16& oa, f32x16& ob) {
#pragma unroll
  for (int gk = 0; gk < 4; ++gk) {
    const bf16x8 pb = (gk < 2) ? pack8(p0, gk & 1) : pack8(p1, gk & 1);
    oa = MFMA32(vf[gk], pb, oa); ob = MFMA32(vf[4 + gk], pb, ob);
  }
}
template <int MODE>
DI void at_online(AttnState& S, f32x16& p0, f32x16& p1, int key0, int lo, int hi, bool on, int hh) {
  float tm = -1e30f;
  if (MODE == 1 && on) {
    int lor = lo - key0 - 4 * hh, hir = hi - key0 - 4 * hh;
    if (hir < lor) { lor = 4096; hir = 4096; }
    const unsigned span = (unsigned)(hir - lor);
#pragma unroll
    for (int i = 0; i < 16; ++i) { const int c0 = (i & 3) + 8 * (i >> 2);
      p0[i] = ((unsigned)(c0 - lor) <= span) ? p0[i] : -1e30f; p1[i] = ((unsigned)(c0 + 32 - lor) <= span) ? p1[i] : -1e30f; }
  }
  asm volatile("s_nop 15\n\ts_nop 7" : "+v"(tm) : "v"(p0[15]), "v"(p1[15]));
#define MX3_8(o_) asm("v_max3_f32 %0, %0, %1, %2\n\tv_max3_f32 %0, %0, %3, %4\n\tv_max3_f32 %0, %0, %5, %6\n\tv_max3_f32 %0, %0, %7, %8\n\tv_max3_f32 %0, %0, %9, %10\n\tv_max3_f32 %0, %0, %11, %12\n\tv_max3_f32 %0, %0, %13, %14\n\tv_max3_f32 %0, %0, %15, %16" \
      : "+v"(tm) : "v"(p0[o_]), "v"(p1[o_]), "v"(p0[o_ + 1]), "v"(p1[o_ + 1]), "v"(p0[o_ + 2]), "v"(p1[o_ + 2]), "v"(p0[o_ + 3]), "v"(p1[o_ + 3]), "v"(p0[o_ + 4]), "v"(p1[o_ + 4]), "v"(p0[o_ + 5]), "v"(p1[o_ + 5]), "v"(p0[o_ + 6]), "v"(p1[o_ + 6]), "v"(p0[o_ + 7]), "v"(p1[o_ + 7]))
  MX3_8(0); MX3_8(8);
#undef MX3_8
  tm = x32_max(tm);
  if (MODE == 2) tm = on ? tm : -1e30f;
  { const float mn = fmaxf(S.m, tm); const float al = __builtin_amdgcn_exp2f(S.m - mn); S.m = mn; S.l *= al;
#pragma unroll
    for (int i = 0; i < 16; ++i) { S.o0[i] *= al; S.o1[i] *= al; } }
  float mn = S.m;
  if (MODE == 2) mn = on ? mn : 1e30f;
  if (MODE == 1) mn = mn < -1e29f ? 1e30f : mn;
  float rs = 0.f;
#pragma unroll
  for (int i = 0; i < 16; ++i) {
    const float e0 = __builtin_amdgcn_exp2f(p0[i] - mn), e1 = __builtin_amdgcn_exp2f(p1[i] - mn);
    p0[i] = e0; p1[i] = e1; rs += e0 + e1;
  }
  S.l += rs;
}

DI void attn_tile(const Params& P_, unsigned char* lds, int b, int g, int c) {
  Params P = P_; { size_t z_ = 0; asm volatile("" : "+s"(z_)); P.ws = P_.ws + z_; }
#define AT_IDS const int tid = otid(), lane = tid & 63, w = tid >> 6, r = lane & 31, hh = lane >> 5, qi = 8 * w + (r >> 2), h = r & 3, t = 64 * c + qi, qrow = 32 * w + r, srow = tid >> 3, sch = (tid & 7) * 8, ahead = lane >> 4, ach = lane & 15; const unsigned tok = (unsigned)b * SEQ + t, goff = tok * 48 + g * 4 + h; (void)qi; (void)h; (void)t; (void)qrow; (void)srow; (void)sch; (void)ahead; (void)ach; (void)tok; (void)goff; (void)hh; (void)w; (void)r
  const bf16_t* qb = (const bf16_t*)(P.ws + WS_B); const bf16_t* kvk = (const bf16_t*)(P.ws + WS_C); const bf16_t* vT = (const bf16_t*)(P.ws + WS_DV);
  const bf16_t* kcb = (const bf16_t*)(P.ws + WS_KC); const bf16_t* vcb = (const bf16_t*)(P.ws + WS_VC);
  const float* gbase = (const float*)(P.ws + WS_GATES);
#define gates(i) gbase[goff + (i)]
  bf16_t* attn = (bf16_t*)(P.ws + WS_A);
  float* otb = (float*)(P.ws + WS_OT) + (size_t)obid() * 16384;
#define otg(i) otb[(unsigned)tid + (i) * 512u]
  float* IMP = (float*)(lds + AT_IMP); float* EE = (float*)(lds + AT_EE); unsigned* SEL = (unsigned*)(lds + AT_SEL);
  AttnState S; f32x16 p0, p1; u32x4 rkA, rvA; bf16x8 qf[4], kfr[8], vfr[8];
#define QF_LOAD() do { _Pragma("unroll") for (int ds_ = 0; ds_ < 4; ++ds_) qf[ds_] = *(const bf16x8*)(lds + AT_QS + qrow * 128 + (((ds_ * 2 + hh) ^ (qrow & 7)) * 16)); } while (0)
#define AT_QKV() do { at_ldk(lds, buf_, r, hh, kfr); __builtin_amdgcn_sched_barrier(0); at_qk(kfr, qf, p0, p1); at_ldv(lds, buf_, r, hh, vfr); __builtin_amdgcn_sched_barrier(0); } while (0)
  { AT_IDS;
  { const int row = tid >> 1, half = tid & 1, q_i = row >> 2, hd = row & 3;
    const unsigned so = ((unsigned)b * SEQ + 64 * c + q_i) * DM + (g * 4 + hd) * 64 + half * 32;
#pragma unroll
    for (int k = 0; k < 4; ++k) { const u32x4 v = *(const u32x4*)(qb + so + k * 8); *(u32x4*)(lds + AT_QS + row * 128 + (((half * 4 + k) ^ (row & 7)) * 16)) = v; } }
  __syncthreads();
  QF_LOAD();
#define ST_LOAD(rk, rv, kp, kstride, vp, vstride, kt) do { rk = *(const u32x4*)((kp) + (unsigned)(((kt) * 64 + srow) * (kstride) + sch)); rv = *(const u32x4*)((vp) + (unsigned)(srow * (vstride) + (kt) * 64 + sch)); } while (0)
#define ST_STORE(rk, rv, buf) do { *(u32x4*)(lds + AT_KS + (buf) * 64 * AT_ROWB + srow * AT_ROWB + sch * 2) = rk; *(u32x4*)(lds + AT_VS + (buf) * 64 * AT_ROWB + srow * AT_ROWB + sch * 2) = rv; } while (0)
#define SWEEP(kp, kstride, vp, vstride, kt0, n, ...) do { \
    ST_LOAD(rkA, rvA, kp, kstride, vp, vstride, (kt0)); ST_STORE(rkA, rvA, 0); __syncthreads(); \
    for (int i_ = 0; i_ < (n); ++i_) { \
      if (i_ + 1 < (n)) ST_LOAD(rkA, rvA, kp, kstride, vp, vstride, (kt0) + i_ + 1); \
      { const int step_ = i_; const int buf_ = i_ & 1; __VA_ARGS__ } \
      if (i_ + 1 < (n)) ST_STORE(rkA, rvA, (i_ + 1) & 1); \
      __syncthreads(); \
    } } while (0)
#define ST_LOADF(rk, rv, kt) do { rk = *(const u32x4*)(kps + (size_t)(kt) * 4096 + tid * 8); rv = *(const u32x4*)(vps + (size_t)(kt) * 4096 + tid * 8); } while (0)
#define ST_STOREF(rk, rv, buf) do { const int fo_ = ((tid >> 8) * 32 + (tid & 31)) * AT_ROWB + (((tid >> 6) & 3) * 2 + ((tid >> 5) & 1)) * 16; \
    *(u32x4*)(lds + AT_KS + (buf) * 64 * AT_ROWB + fo_) = rk; *(u32x4*)(lds + AT_VS + (buf) * 64 * AT_ROWB + fo_) = rv; } while (0)
#define SWEEPF(kt0, n, ...) do { \
    ST_LOADF(rkA, rvA, (kt0)); ST_STOREF(rkA, rvA, 0); __syncthreads(); \
    for (int i_ = 0; i_ < (n); ++i_) { \
      if (i_ + 1 < (n)) ST_LOADF(rkA, rvA, (kt0) + i_ + 1); \
      { const int step_ = i_; const int buf_ = i_ & 1; __VA_ARGS__ } \
      if (i_ + 1 < (n)) ST_STOREF(rkA, rvA, (i_ + 1) & 1); \
      __syncthreads(); \
    } } while (0)
  {
    const bf16_t* kp = kvk + (size_t)b * SEQ * DM + 3 * 256 + g * 64; const bf16_t* vp = vT + (size_t)(((1 * NB + b) * 4 + g) * 64) * SEQ;
    const int j0 = c >= 8 ? c - 8 : 0, nj = c - j0 + 1;
    st_init(S);
    SWEEP(kp, DM, vp, SEQ, j0, nj, {
      AT_QKV();
      at_online<1>(S, p0, p1, (j0 + step_) * 64, t - 511, t, (step_ == 0 && c >= 8) || step_ == nj - 1, hh);
      at_pv(vfr, p0, p1, S.o0, S.o1); });
    const float lt = x32_sum(S.l); const float sc = lt > 0.f ? gates(32) / lt : 0.f;
#pragma unroll
    for (int i = 0; i < 16; ++i) { otg(i) = S.o0[i] * sc; otg(16 + i) = S.o1[i] * sc; }
  }
  {
    const bf16_t* kcp = kcb + (size_t)((b * 4 + g) * 512) * 64; const bf16_t* vcp = vcb + (size_t)((b * 4 + g) * 64) * 512;
    const int nmax = t >= 31 ? (t - 31) >> 4 : -1;
    const int nct = (4 * c + 2) / 64 + 1;
    st_init(S);
    SWEEP(kcp, 64, vcp, 512, 0, nct, {
      at_ldk(lds, buf_, r, hh, kfr); __builtin_amdgcn_sched_barrier(0); at_qk(kfr, qf, p0, p1);
      at_online<1>(S, p0, p1, step_ * 64, 0, nmax, 64 * step_ + 63 > 4 * c - 2, hh); });
    const float lt = x32_sum(S.l);
    const float cinv = lt > 0.f ? 1.f / lt : 0.f; const float cm = S.m;
    st_init(S);
    SWEEP(kcp, 64, vcp, 512, 0, nct, {
      AT_QKV();
      if (64 * step_ + 63 <= 4 * c - 2) {
        _Pragma("unroll") for (int k = 0; k < 16; ++k) { p0[k] = __builtin_amdgcn_exp2f(p0[k] - cm) * cinv; p1[k] = __builtin_amdgcn_exp2f(p1[k] - cm) * cinv; }
      } else {
        const int nrel = nmax - step_ * 64 - 4 * hh;
        _Pragma("unroll") for (int k = 0; k < 16; ++k) { const int c0 = (k & 3) + 8 * (k >> 2), c1 = c0 + 32;
          p0[k] = c0 <= nrel ? __builtin_amdgcn_exp2f(p0[k] - cm) * cinv : 0.f; p1[k] = c1 <= nrel ? __builtin_amdgcn_exp2f(p1[k] - cm) * cinv : 0.f; }
      }
      at_pv(vfr, p0, p1, S.o0, S.o1);
      _Pragma("unroll") for (int kh = 0; kh < 2; ++kh)
      _Pragma("unroll") for (int gi = 0; gi < 4; ++gi) {
          float g4 = kh == 0 ? (p0[4 * gi] + p0[4 * gi + 1]) + (p0[4 * gi + 2] + p0[4 * gi + 3]) : (p1[4 * gi] + p1[4 * gi + 1]) + (p1[4 * gi + 2] + p1[4 * gi + 3]);
          float e3 = kh == 0 ? p0[4 * gi + 3] : p1[4 * gi + 3];
          g4 += dppf<DPP_X1>(g4); g4 += dppf<DPP_X2>(g4); e3 += dppf<DPP_X1>(e3); e3 += dppf<DPP_X2>(e3);
          if (h == 0) { const int s = (step_ * 64 + kh * 32 + 8 * gi + 4 * hh) >> 2; IMP[qi * AT_IMPS + s] = g4; EE[qi * AT_IMPS + s] = e3; }
      } });
    const float gc = gates(0);
#pragma unroll
    for (int i = 0; i < 16; ++i) { p0[i] = otg(i); p1[i] = otg(16 + i); }
    __builtin_amdgcn_sched_barrier(0);
#pragma unroll
    for (int i = 0; i < 16; ++i) { otg(i) = p0[i] + S.o0[i] * gc; otg(16 + i) = p1[i] + S.o1[i] * gc; }
  }
  }
  const bf16_t* kps = (const bf16_t*)(P.ws + WS_KSF) + (size_t)((b * 4 + g) * 128) * 4096; const bf16_t* vps = vT + (size_t)((b * 4 + g) * 128) * 4096;
  if (c <= 15) { AT_IDS; QF_LOAD();
    st_init(S);
    if (c > 0) {
      SWEEPF(0, c, {
        AT_QKV();
        at_online<0>(S, p0, p1, 0, 0, 0, true, hh);
        at_pv(vfr, p0, p1, S.o0, S.o1); });
    }
    SWEEPF(c, 1, {
      AT_QKV();
      at_online<1>(S, p0, p1, (c + step_) * 64, 0, t, true, hh);
      at_pv(vfr, p0, p1, S.o0, S.o1); });
    const float lt = x32_sum(S.l); const float slc_sc = lt > 0.f ? gates(16) / lt : 0.f;
    bf16_t* op = attn + (tok * DM + (g * 4 + h) * 64);
#pragma unroll
    for (int i = 0; i < 16; ++i) { S.o0[i] = S.o0[i] * slc_sc + otg(i); S.o1[i] = S.o1[i] * slc_sc + otg(16 + i); }
#pragma unroll
    for (int gi = 0; gi < 4; ++gi) {
      u32x2 a; a.x = pk2(S.o0[4 * gi], S.o0[4 * gi + 1]); a.y = pk2(S.o0[4 * gi + 2], S.o0[4 * gi + 3]);
      u32x2 bq; bq.x = pk2(S.o1[4 * gi], S.o1[4 * gi + 1]); bq.y = pk2(S.o1[4 * gi + 2], S.o1[4 * gi + 3]);
      *(u32x2*)(op + 8 * gi + 4 * hh) = a; *(u32x2*)(op + 32 + 8 * gi + 4 * hh) = bq;
    }
  } else {
    const int nc = c - 2;
    unsigned char* QL = lds + AT_QL; int* NJ = (int*)(lds + AT_NJ); unsigned short* ITEMS = (unsigned short*)(lds + AT_ITEMS); int* MISC = (int*)(lds + AT_MISC);
    float* MREF = (float*)(lds + AT_MREF); float* LS = (float*)(lds + AT_LACC); unsigned char* INVQ = lds + AT_INVQ; unsigned char* SLOT = lds + AT_IMP;
    float* const LOWN = (float*)(lds + AT_LOWN); const float k64 = 5.421010862427522e-20f;
    { AT_IDS;
    { const int q = tid >> 3; for (int s = 1 + (tid & 7); s <= nc; s += 8) IMP[q * AT_IMPS + s] += EE[q * AT_IMPS + s - 1]; }
    if (tid < 256) SEL[tid] = 0u;
    if (tid < 128) ((unsigned*)INVQ)[tid] = 0u;
    __syncthreads();
    {
      const int q = tid >> 3, sub = tid & 7; const float* ip = IMP + q * AT_IMPS;
      unsigned key[16];
#pragma unroll
      for (int k = 0; k < 16; ++k) { const int s = 1 + sub + 8 * k; key[k] = s <= nc ? __float_as_uint(ip[s]) + 1u : 0u; }
      unsigned T = 0u;
      for (int bit = 30; bit >= 0; --bit) {
        const unsigned cand = T | (1u << bit); int cn = 0;
#pragma unroll
        for (int k = 0; k < 16; ++k) cn += key[k] >= cand ? 1 : 0;
        cn = sum8i(cn);
        if (cn >= 13) T = cand;
      }
      int ngt = 0, neq = 0;
#pragma unroll
      for (int k = 0; k < 16; ++k) { ngt += key[k] > T ? 1 : 0; neq += key[k] == T ? 1 : 0; }
      ngt = sum8i(ngt); neq = sum8i(neq);
      const int need = 13 - ngt;
      unsigned w0 = 0u, w1 = 0u, w2 = 0u, w3 = 0u;
      if (!__any(neq > need)) {
#pragma unroll
        for (int k = 0; k < 16; ++k) if (key[k] >= T && key[k] != 0u) { const int s = 1 + sub + 8 * k; const unsigned bt = 1u << (s & 31); if (s < 32) w0 |= bt; else if (s < 64) w1 |= bt; else if (s < 96) w2 |= bt; else w3 |= bt; }
      } else {
        int taken = 0; const int gsh = lane & ~7;
#pragma unroll
        for (int k = 0; k < 16; ++k) {
          const bool eq = key[k] == T && key[k] != 0u; const unsigned long long mk = __ballot(eq);
          const unsigned grp = (unsigned)(mk >> gsh) & 0xffu; const int before = __popc(grp & ((1u << sub) - 1u));
          const bool pick = key[k] > T || (eq && taken + before < need);
          taken += __popc(grp);
          if (pick) { const int s = 1 + sub + 8 * k; const unsigned bt = 1u << (s & 31); if (s < 32) w0 |= bt; else if (s < 64) w1 |= bt; else if (s < 96) w2 |= bt; else w3 |= bt; }
        }
      }
      if (w0) atomicOr(&SEL[q * 4], w0); if (w1) atomicOr(&SEL[q * 4 + 1], w1); if (w2) atomicOr(&SEL[q * 4 + 2], w2); if (w3) atomicOr(&SEL[q * 4 + 3], w3);
    }
    __syncthreads();
    for (int j = 1 + w; j <= nc; j += NWAVE) {
      const bool bit = (SEL[lane * 4 + (j >> 5)] >> (j & 31)) & 1u;
      const unsigned long long mk = __ballot(bit);
      const int rank = __builtin_amdgcn_mbcnt_hi((unsigned)(mk >> 32), __builtin_amdgcn_mbcnt_lo((unsigned)mk, 0u));
      if (bit) QL[j * 64 + rank] = (unsigned char)lane;
      const int cnt = __popcll(mk);
      if (lane < ((8 - (cnt & 7)) & 7)) QL[j * 64 + cnt + lane] = 0;
      if (lane == 0) NJ[j] = cnt;
    }
    __syncthreads();
    if (w == 0) {
      const int ja = 1 + lane, jb = 65 + lane;
      const int ca = ja <= nc ? (NJ[ja] + 7) >> 3 : 0, cb = jb <= nc ? (NJ[jb] + 7) >> 3 : 0;
      int sa = ca, sb = cb;
#pragma unroll
      for (int o = 1; o < 64; o <<= 1) { const int ta = __shfl_up(sa, o), tb = __shfl_up(sb, o); if (lane >= o) { sa += ta; sb += tb; } }
      const int tota = __shfl(sa, 63);
      for (int k = 0; k < ca; ++k) ITEMS[sa - ca + k] = (unsigned short)(ja * 8 + k);
      for (int k = 0; k < cb; ++k) ITEMS[tota + sb - cb + k] = (unsigned short)(jb * 8 + k);
      if (lane == 63) MISC[0] = tota + sb;
    }
    }
    { AT_IDS; QF_LOAD();
    st_init(S);
    SWEEPF(0, 1, {
      AT_QKV();
      at_online<0>(S, p0, p1, 0, 0, 0, true, hh);
      at_pv(vfr, p0, p1, S.o0, S.o1); });
    SWEEPF(c - 1, 2, {
      AT_QKV();
      at_online<1>(S, p0, p1, c * 64, 0, t, step_ == 1, hh);
      at_pv(vfr, p0, p1, S.o0, S.o1); });
    { const float lt = x32_sum(S.l);
      if (hh == 0) { MREF[qrow] = S.m + 64.f; LS[w * 32 + r] = lt * k64; } }
#define SLOT_WRITE(x, o0_, o1_, scale_) do { unsigned char* sp_ = SLOT + (x) * 8192 + r * 256; \
      _Pragma("unroll") for (int gi_ = 0; gi_ < 4; ++gi_) { \
        const f32x4 va_ = {o0_[4 * gi_] * (scale_), o0_[4 * gi_ + 1] * (scale_), o0_[4 * gi_ + 2] * (scale_), o0_[4 * gi_ + 3] * (scale_)}; \
        const f32x4 vb_ = {o1_[4 * gi_] * (scale_), o1_[4 * gi_ + 1] * (scale_), o1_[4 * gi_ + 2] * (scale_), o1_[4 * gi_ + 3] * (scale_)}; \
        *(f32x4*)(sp_ + (((2 * gi_ + hh) ^ (r & 15)) * 16)) = va_; *(f32x4*)(sp_ + (((8 + 2 * gi_ + hh) ^ (r & 15)) * 16)) = vb_; } } while (0)
#define SLOT_READ(x, col_) (*(const f32x4*)(SLOT + (x) * 8192 + (col_) * 256 + ((ach ^ ((col_) & 15)) * 16)))
    SLOT_WRITE(w, S.o0, S.o1, k64);
    __syncthreads();
    }
    {
      AT_IDS; const int wu = __builtin_amdgcn_readfirstlane(w);
      const int nitems = MISC[0], nrounds = (nitems + 3) >> 2;
      if (wu >= 4) {
        const int ow = wu - 4, oq = lane >> 2, oh = lane & 3, srcslot = 2 * ow + (lane >> 5), scol = lane & 31;
        f32x4 acc[16]; float accl;
        { const unsigned char* rp = SLOT + srcslot * 8192 + scol * 256;
#pragma unroll
          for (int k = 0; k < 16; ++k) acc[k] = *(const f32x4*)(rp + ((k ^ (scol & 15)) * 16));
          accl = LS[srcslot * 32 + scol]; }
        __syncthreads();
        for (int rd = 0; rd <= nrounds; ++rd) {
          if (rd > 0) {
            const int set = (rd - 1) & 1;
            unsigned* ivp = (unsigned*)(INVQ + set * 256) + 16 * ow + oq;
            unsigned iv = *ivp;
            if (__any(iv != 0u)) {
              if (iv != 0u && oh == 0) *ivp = 0u;
              do {
                const int x = (iv & 0xffu) ? 0 : (iv & 0xff00u) ? 1 : (iv & 0xff0000u) ? 2 : 3;
                const unsigned byte = (iv >> (8 * x)) & 0xffu;
                iv &= ~(0xffu << (8 * x));
                if (byte) {
                  const int col = (int)(byte - 1) * 4 + oh;
                  const unsigned char* rp = SLOT + (set * 4 + x) * 8192 + col * 256;
                  f32x4 tq[16];
#pragma unroll
                  for (int k = 0; k < 16; ++k) tq[k] = *(const f32x4*)(rp + ((k ^ (col & 15)) * 16));
                  const float tl = LS[(set * 4 + x) * 32 + col];
                  __builtin_amdgcn_sched_barrier(0);
#pragma unroll
                  for (int k = 0; k < 16; ++k) acc[k] += tq[k];
                  accl += tl;
                }
              } while (__any(iv != 0u));
            }
          }
          __syncthreads();
        }
#pragma unroll
        for (int i = 0; i < 16; ++i) { S.o0[i] = otg(i); S.o1[i] = otg(16 + i); }
        SLOT_WRITE(w, S.o0, S.o1, 1.0f);
        __syncthreads();
        {
          const unsigned tq = (unsigned)b * SEQ + 64 * c + 16 * ow + oq;
          const float gs = gbase[tq * 48 + 16 + g * 4 + oh]; const float sc = accl > 0.f ? gs / accl : 0.f;
          const unsigned char* rp = SLOT + srcslot * 8192 + scol * 256;
          bf16_t* op = attn + (tq * DM + (g * 4 + oh) * 64);
#pragma unroll
          for (int k2 = 0; k2 < 8; ++k2) {
            const f32x4 v0 = acc[2 * k2] * sc + *(const f32x4*)(rp + (((2 * k2) ^ (scol & 15)) * 16)), v1 = acc[2 * k2 + 1] * sc + *(const f32x4*)(rp + (((2 * k2 + 1) ^ (scol & 15)) * 16));
            u32x4 o; o.x = pk2(v0.x, v0.y); o.y = pk2(v0.z, v0.w); o.z = pk2(v1.x, v1.y); o.w = pk2(v1.z, v1.w);
            *(u32x4*)(op + 8 * k2) = o;
          }
        }
      } else {
        __syncthreads();
        const bf16_t* kgl = kps + lane * 8; const bf16_t* vgl = vps + lane * 8;
        bf16x8 kfA[8], vfA[8], kfB[8], vfB[8];
#define FLOAD(KF, VF, jj) do { _Pragma("unroll") for (int f_ = 0; f_ < 8; ++f_) { KF[f_] = *(const bf16x8*)(kgl + (size_t)(jj) * 4096 + f_ * 512); VF[f_] = *(const bf16x8*)(vgl + (size_t)(jj) * 4096 + f_ * 512); } } while (0)
        int rowc = 0, qqc = 0; bool validc = false; float mrc = 1e30f; int en = 0;
        if (wu < nitems) { const int e0 = ITEMS[wu]; const int j0_ = e0 >> 3; const int qs_ = 8 * (e0 & 7) + (r >> 2); validc = qs_ < NJ[j0_]; qqc = QL[j0_ * 64 + qs_]; rowc = qqc * 4 + h; mrc = validc ? MREF[rowc] : 1e30f; FLOAD(kfA, vfA, j0_); }
        if (wu + 4 < nitems) en = __builtin_amdgcn_readfirstlane(ITEMS[wu + 4]);
        FLOAD(kfB, vfB, en >> 3);
#define ITEM_ROUND(KF, VF, rd_) do { \
          const int it = (rd_) * 4 + wu, set = (rd_) & 1; \
          if (it < nitems) { \
            const bool hasn = it + 4 < nitems; \
            const int jn = en >> 3, qsn = 8 * (en & 7) + (r >> 2);        \
            bf16x8 qv[4];                                               \
            _Pragma("unroll") for (int ds = 0; ds < 4; ++ds) qv[ds] = *(const bf16x8*)(lds + AT_QS + rowc * 128 + (((ds * 2 + hh) ^ (rowc & 7)) * 16)); \
            const int njn = NJ[jn]; const int qqn = QL[jn * 64 + qsn]; \
            const int en2 = it + 8 < nitems ? __builtin_amdgcn_readfirstlane(ITEMS[it + 8]) : 0; const int j2 = en2 >> 3; \
            __builtin_amdgcn_sched_barrier(0); \
            const f32x16 z = {0.f, 0.f, 0.f, 0.f, 0.f, 0.f, 0.f, 0.f, 0.f, 0.f, 0.f, 0.f, 0.f, 0.f, 0.f, 0.f}; \
            _Pragma("unroll") for (int ds = 0; ds < 4; ++ds) { \
              if (ds == 0) { p0 = MFMA32(KF[0], qv[0], z); p1 = MFMA32(KF[4], qv[0], z); } else { p0 = MFMA32(KF[ds], qv[ds], p0); p1 = MFMA32(KF[4 + ds], qv[ds], p1); } \
            } \
            const bool validn = hasn && qsn < njn; const int rown = qqn * 4 + h; \
            const float mrn = validn ? MREF[rown] : 1e30f; \
            float rs = 0.f; \
            _Pragma("unroll") for (int i = 0; i < 16; ++i) { \
              p0[i] = __builtin_amdgcn_exp2f(fminf(p0[i] - mrc, 120.f)); p1[i] = __builtin_amdgcn_exp2f(fminf(p1[i] - mrc, 120.f)); rs += p0[i] + p1[i]; \
              if (i & 1) { KF[i >> 1] = *(const bf16x8*)(kgl + (size_t)j2 * 4096 + (i >> 1) * 512); __builtin_amdgcn_sched_barrier(0); } \
            } \
            rs = x32_sum(rs); \
            f32x16 o0 = z, o1 = z; \
            _Pragma("unroll") for (int gk = 0; gk < 4; ++gk) { const bf16x8 pb = (gk < 2) ? pack8(p0, gk & 1) : pack8(p1, gk & 1); o0 = MFMA32(VF[gk], pb, o0); o1 = MFMA32(VF[4 + gk], pb, o1); } \
            { unsigned char* sp_ = SLOT + (set * 4 + wu) * 8192 + r * 256; \
              _Pragma("unroll") for (int gi = 0; gi < 4; ++gi) { \
                const f32x4 va_ = {o0[4 * gi], o0[4 * gi + 1], o0[4 * gi + 2], o0[4 * gi + 3]}; const f32x4 vb_ = {o1[4 * gi], o1[4 * gi + 1], o1[4 * gi + 2], o1[4 * gi + 3]}; \
                *(f32x4*)(sp_ + (((2 * gi + hh) ^ (r & 15)) * 16)) = va_; *(f32x4*)(sp_ + (((8 + 2 * gi + hh) ^ (r & 15)) * 16)) = vb_; \
                VF[2 * gi] = *(const bf16x8*)(vgl + (size_t)j2 * 4096 + (2 * gi) * 512); VF[2 * gi + 1] = *(const bf16x8*)(vgl + (size_t)j2 * 4096 + (2 * gi + 1) * 512); \
                __builtin_amdgcn_sched_barrier(0); \
              } } \
            if (hh == 0) LS[(set * 4 + wu) * 32 + r] = rs; \
            if (validc && h == 0 && hh == 0) INVQ[set * 256 + qqc * 4 + wu] = (unsigned char)((r >> 2) + 1); \
            rowc = rown; qqc = qqn; validc = validn; mrc = mrn; en = en2; \
          } } while (0)
        for (int rd = 0; rd < nrounds; rd += 2) {
          ITEM_ROUND(kfA, vfA, rd);
          __syncthreads();
          if (rd + 1 < nrounds) {
            ITEM_ROUND(kfB, vfB, rd + 1);
            __syncthreads();
          }
        }
#undef ITEM_ROUND
#undef FLOAD
#undef ITEM_META
#undef KLOAD
#undef VLOAD
        __syncthreads();
#pragma unroll
        for (int i = 0; i < 16; ++i) { S.o0[i] = otg(i); S.o1[i] = otg(16 + i); }
        SLOT_WRITE(w, S.o0, S.o1, 1.0f);
        __syncthreads();
      }
    }
#undef SLOT_WRITE
#undef SLOT_READ
  }
  __syncthreads();
#undef ST_LOAD
#undef ST_STORE
#undef SWEEP
#undef ST_LOADF
#undef ST_STOREF
#undef SWEEPF
#undef gates
#undef otg
#undef QF_LOAD
#undef AT_QKV
#undef AT_IDS
}
DI void phase_attn(const Params& P_, unsigned char* lds) {
  Params P = P_; { size_t z_ = 0; asm volatile("" : "+s"(z_)); P.ws = P_.ws + z_; }
  const int G = gridDim.x, bx = obid();
  const int vcu = (G % 8 == 0) ? (bx % 8) * (G / 8) + bx / 8 : bx;
  for (int idx = vcu; idx < 1024; idx += G) {
    const int i = idx >> 8, v = idx & 255, bg = v >> 5, s = v & 31;
    const int c = i == 0 ? s : i == 1 ? 63 - s : i == 2 ? 64 + s : 127 - s;
    attn_tile(P, lds, bg >> 2, bg & 3, c);
  }
}


#define LAS __attribute__((address_space(3)))
#define XB_TMO      128
#define XB_XCNT(j)  (256  + 64 * (j))
#define XB_XSUB(j)  (1280 + 64 * (j))
#define XB_XGEN(j)  (2304 + 64 * (j))
#define XB_TOP      3328
#define XB_TOPGEN   3392
#define XCD_BAR_WORDS 3456
#define XB_SPIN_CAP (1u << 18)
__device__ __forceinline__ unsigned xb_ld(unsigned* p)              { return __hip_atomic_load(p, __ATOMIC_RELAXED, __HIP_MEMORY_SCOPE_AGENT); }
__device__ __forceinline__ unsigned xb_add(unsigned* p, unsigned v) { return __hip_atomic_fetch_add(p, v, __ATOMIC_RELAXED, __HIP_MEMORY_SCOPE_AGENT); }
__device__ __forceinline__ unsigned xb_xcc_id() { return (unsigned)__builtin_amdgcn_s_getreg((3 << 11) | 20) & 0xFu; }
#define XB_SPIN(cond, bar) do { unsigned _sp = 0; while (cond) { __builtin_amdgcn_s_sleep(1); \
    if ((++_sp & 255u) == 0u) { if (xb_ld(&(bar)[XB_TMO])) break; if (_sp > XB_SPIN_CAP) { atomicAdd(&(bar)[XB_TMO], 1u); break; } } } } while (0)
struct XcdBarrier { unsigned* bar; unsigned x; volatile LAS unsigned* st; };
__device__ __forceinline__ XcdBarrier xcd_barrier_post(unsigned* bar, volatile LAS unsigned* st) {
    XcdBarrier b; b.bar = bar; b.x = xb_xcc_id(); b.st = st;
    if (threadIdx.x == 0) (void)xb_add(&bar[XB_XCNT(b.x)], 1u);
    return b;
}
__device__ __forceinline__ void xcd_barrier_complete(unsigned* bar, unsigned x, unsigned& nloc, unsigned& nx) {
    const unsigned G = gridDim.x * gridDim.y * gridDim.z;
    unsigned sum, cnt, mine, sp = 0u;
    for (;;) {
        sum = 0u; cnt = 0u; mine = 0u;
#pragma unroll
        for (unsigned j = 0; j < 16; ++j) { const unsigned c = xb_ld(&bar[XB_XCNT(j)]); sum += c; cnt += (c > 0u) ? 1u : 0u; mine = (j == x) ? c : mine; }
        if (sum == G) break;
        __builtin_amdgcn_s_sleep(1);
        if ((++sp & 255u) == 0u) { if (xb_ld(&bar[XB_TMO])) break; if (sp > XB_SPIN_CAP) { atomicAdd(&bar[XB_TMO], 1u); break; } }
    }
    nloc = mine > 0u ? mine : 1u; nx = cnt > 0u ? cnt : 1u;
}
__device__ __forceinline__ void xcd_barrier(const XcdBarrier& b) {
    asm volatile("s_waitcnt vmcnt(0)" ::: "memory");
    __syncthreads();
    if (threadIdx.x == 0) {
        unsigned* bar = b.bar; { size_t z_ = 0; asm volatile("" : "+s"(z_)); bar += z_; }
        __builtin_amdgcn_s_waitcnt(0);
        unsigned nloc = b.st[0], nx = b.st[1];
        if (nloc == 0u) { xcd_barrier_complete(bar, b.x, nloc, nx); b.st[0] = nloc; b.st[1] = nx; }
        const unsigned old = xb_add(&bar[XB_XSUB(b.x)], 1u);
        const unsigned gen = old / nloc;
        if (old + 1u == (gen + 1u) * nloc) {
            __builtin_amdgcn_fence(__ATOMIC_RELEASE, "agent");
            asm volatile("s_waitcnt vmcnt(0)" ::: "memory");
            const unsigned og = xb_add(&bar[XB_TOP], 1u);
            const unsigned tg = og / nx;
            if (og + 1u == (tg + 1u) * nx) xb_add(&bar[XB_TOPGEN], 1u);
            else XB_SPIN(xb_ld(&bar[XB_TOPGEN]) == tg, bar);
            __builtin_amdgcn_fence(__ATOMIC_ACQUIRE, "agent");
            xb_add(&bar[XB_XGEN(b.x)], 1u);
            asm volatile("s_waitcnt vmcnt(0)" ::: "memory");
        } else {
            XB_SPIN(xb_ld(&bar[XB_XGEN(b.x)]) == gen, bar);
            __builtin_amdgcn_fence(__ATOMIC_ACQUIRE, "agent");
            asm volatile("s_waitcnt vmcnt(0)" ::: "memory");
        }
    }
    __syncthreads();
}

__global__ void __launch_bounds__(NTHR) fwd_kernel(Params P) {
  extern __shared__ __attribute__((aligned(16))) unsigned char lds[];
  cg::grid_group grid = cg::this_grid();
  const int gtid = blockIdx.x * NTHR + threadIdx.x;
  if (threadIdx.x < 4) ((unsigned*)(lds + LDS_BYTES - 16))[threadIdx.x] = 0u;
  __syncthreads();
  const XcdBarrier xbar = xcd_barrier_post((unsigned*)(P.ws + WS_BAR), (volatile LAS unsigned*)(lds + LDS_BYTES - 16));
#define GSYNC() xcd_barrier(xbar)
  s5_params(P, gtid);
  {
    float* modb = (float*)(P.ws + WS_MOD); float* cbb = (float*)(P.ws + WS_CB);
    for (int it = blockIdx.x; it < 192 + 16; it += gridDim.x) {
      if (it < 192) { const int l = it / 96, j0 = (it % 96) * 64;
        gemv_item((float*)lds, P.in[2] + (size_t)l * DM * 6144, DM, 6144, j0, P.in[1], P.in[1] + DM, true, P.in[3] + l * 6144, modb + (size_t)(l * 2) * 6144, modb + (size_t)(l * 2 + 1) * 6144);
      } else { const int r = it - 192, l = r >> 3, kv = (r >> 2) & 1, j0 = (r & 3) * 64;
        gemv_item((float*)lds, P.in[17] + (size_t)(l * 2 + kv) * 2048 * 256, 2048, 256, j0, P.in[16] + (size_t)(l * 2 + kv) * 2048, nullptr, false, nullptr, cbb + (l * 2 + kv) * 256, nullptr);
      }
    }
  }
  for (int it = blockIdx.x; it < DEPTH * 32 * 6; it += gridDim.x) s5_tables(P, it / 192, (it % 192) / 6, it % 6, lds);
  convert_weights(P, 0, lds);
  grid.sync();
  for (int l = 0; l < DEPTH; ++l) {
    if (l == 0) norm_simple<0>(P, l); else { norm_simple<1>(P, l); convert_weights(P, 1, lds); }
    GSYNC();
#if EN_MIXER
    phase_inproj8(P, lds);
    GSYNC();
    phase_s5a(P, l, lds);
    __syncthreads();
#if EN_ATTN
    phase_gates(P, lds);
    __syncthreads();
    phase_cmp1(P, l, lds);
#endif
    GSYNC();
    s5_carry(P, l);
#if EN_ATTN
    phase_cmp2(P, lds);
#endif
    GSYNC();
#if EN_ATTN
    phase_attn(P, lds);
    __syncthreads();
#endif
    phase_s5c(P, l, lds);
    GSYNC();
    phase_glu(P, lds);
    GSYNC();
    phase_merge8(P, lds);
    GSYNC();
    phase_wout8(P, l, lds);
    GSYNC();
#else
    if (l == 0) { for (size_t i = (size_t)gtid * 4; i < (size_t)NT * DM; i += (size_t)gridDim.x * NTHR * 4) *(f32x4*)(P.out + i) = *(const f32x4*)(P.in[0] + i); GSYNC(); }
#endif
#if EN_MOE
    norm_route(P, l, lds);
    GSYNC();
    phase_moe1(P, l, lds);
    GSYNC();
    phase_moe2(P, l, lds);
    GSYNC();
#endif
  }
  norm_simple<3>(P, 0);
}

extern "C" void kernel_launch(void* const* d_in, const int* in_sizes, int n_in, void* d_out, int out_size, void* d_ws, size_t ws_size, hipStream_t stream) {
  static int grid = 0;
  if (grid == 0) {
    if (n_in != 30 || out_size != NT * DM || ws_size < WS_END2) { fprintf(stderr, "kernel_launch: unexpected shapes (n_in %d out %d ws %zu need %zu)\n", n_in, out_size, ws_size, (size_t)WS_END2); grid = -1; return; }
    int dev = 0, cus = 0, per_cu = 0;
    hipGetDevice(&dev);
    hipDeviceGetAttribute(&cus, hipDeviceAttributeMultiprocessorCount, dev);
    hipFuncSetAttribute((const void*)fwd_kernel, hipFuncAttributeMaxDynamicSharedMemorySize, LDS_BYTES);
    hipOccupancyMaxActiveBlocksPerMultiprocessor(&per_cu, (const void*)fwd_kernel, NTHR, LDS_BYTES);
    if (per_cu < 1) { fprintf(stderr, "kernel_launch: occupancy query says %d blocks/CU\n", per_cu); per_cu = 1; }
    grid = cus;
    (void)hipGetLastError();
  }
  if (grid < 0) return;
  Params p{};
  for (int i = 0; i < 30; ++i) p.in[i] = (const float*)d_in[i];
  p.out = (float*)d_out; p.ws = (unsigned char*)d_ws;
  if (hipMemsetAsync(p.ws, 0, WS_ZERO_BYTES, stream) != hipSuccess) { fprintf(stderr, "kernel_launch: memset failed\n"); return; }
  void* args[] = {&p};
  hipError_t e = hipLaunchCooperativeKernel((const void*)fwd_kernel, dim3(grid), dim3(NTHR), args, LDS_BYTES, stream);
  if (e != hipSuccess) fprintf(stderr, "cooperative launch failed: %s (grid %d)\n", hipGetErrorString(e), grid);
}
```

```cpp
#include <hip/hip_runtime.h>
#include <hip/hip_cooperative_groups.h>
#include <cstdio>
#include <cstdint>
namespace cg = cooperative_groups;

#ifndef EN_MIXER
#define EN_MIXER 1
#endif
#ifndef EN_ATTN
#define EN_ATTN 1
#endif
#ifndef EN_MOE
#define EN_MOE 1
#endif

#define DI __device__ __forceinline__
typedef unsigned short bf16_t;
typedef short bf16x8 __attribute__((ext_vector_type(8)));
typedef short s16x4 __attribute__((ext_vector_type(4)));
typedef float f32x4 __attribute__((ext_vector_type(4)));
typedef float f32x16 __attribute__((ext_vector_type(16)));
typedef unsigned u32x4 __attribute__((ext_vector_type(4)));
typedef unsigned u32x2 __attribute__((ext_vector_type(2)));

constexpr int DM = 1024, NB = 2, SEQ = 8192, NT = NB * SEQ, DEPTH = 2;
constexpr int INW = 5168, INWP = 5376;
constexpr int NTHR = 512, NWAVE = 8;
constexpr int NEXP = 32, LISTCAP = 16384;
constexpr float EPS = 1e-6f;
constexpr float QSCALE = 0.125f * 1.4426950408889634f;

constexpr size_t MiB = 1u << 20;
constexpr size_t WS_CNT = 0;
constexpr size_t WS_BAR = 1024;
constexpr size_t WS_ZERO_BYTES = 16384;
constexpr size_t WS_MOD = 16384;
constexpr size_t WS_CB = WS_MOD + 2 * 2 * 6144 * 4;
constexpr size_t WS_S5P = WS_CB + 2 * 2 * 256 * 4;
constexpr size_t WS_WT = WS_S5P + 2 * 32 * 64 * 36 * 4;
constexpr size_t WS_SMALL_END = WS_WT + (size_t)NT * 2 * 4;
static_assert(WS_SMALL_END <= 1 * MiB, "small region");
constexpr size_t WS_W = 1 * MiB;
constexpr size_t W_IN = 0;
constexpr size_t W_GLU = W_IN + (size_t)INWP * 1024 * 2;
constexpr size_t W_O = W_GLU + 512 * 512 * 2;
constexpr size_t W_SO = W_O + 1024 * 1024 * 2;
constexpr size_t W_OUT = W_SO + 1024 * 512 * 2;
constexpr size_t W_C1 = W_OUT + 1024 * 1024 * 2;
constexpr size_t W_C2 = W_C1 + 2 * 256 * 2048 * 2;
constexpr size_t W_GU = W_C2 + 2 * 128 * 256 * 2;
constexpr size_t W_D = W_GU + (size_t)32 * 512 * 1024 * 2;
constexpr size_t W_END = W_D + (size_t)32 * 1024 * 256 * 2;
static_assert(W_END <= 67 * MiB, "weights region");
constexpr size_t WS_A = 68 * MiB;
constexpr size_t WS_B = WS_A + 32 * MiB;
constexpr size_t WS_C = WS_B + 32 * MiB;
constexpr size_t WS_DV = WS_C + 32 * MiB;
constexpr size_t WS_E = WS_DV + 16 * MiB;
constexpr size_t WS_F = WS_E + 32 * MiB;
constexpr size_t WS_G = WS_F + 64 * MiB;
constexpr size_t WS_GATES = WS_G + 16 * MiB;
constexpr size_t WS_HID = WS_GATES + 3 * MiB;
constexpr size_t WS_KC = WS_HID + 4 * MiB;
constexpr size_t WS_VC = WS_KC + 512 * 1024;
constexpr size_t WS_L = WS_VC + 512 * 1024;
constexpr size_t WS_LIST = WS_L + 4 * MiB;
constexpr size_t WS_OT = WS_LIST + 2 * MiB;
constexpr size_t WS_TAB = WS_OT + 16 * MiB;
constexpr size_t TAB_KT = 0, TAB_M1 = 1 * MiB, TAB_M2 = 9 * MiB, TAB_LAYER = 17 * MiB;
constexpr size_t WS_END = WS_TAB + 2 * TAB_LAYER;
constexpr size_t WS_KSF = WS_END;
constexpr size_t WS_END2 = WS_KSF + 8 * MiB;
constexpr size_t WS_SIN = WS_E + 16 * MiB;
constexpr int LDS_BYTES = 151552;

struct Params { const float* in[30]; float* out; unsigned char* ws; };

DI int otid() { int t = threadIdx.x; asm volatile("" : "+v"(t)); return t; }
DI int obid() { int t = blockIdx.x; asm volatile("" : "+s"(t)); return t; }
DI unsigned f2bf(float f) { unsigned u = __float_as_uint(f); return (u + 0x7fffu + ((u >> 16) & 1u)) >> 16; }
typedef float f32x2_t __attribute__((ext_vector_type(2))); typedef __bf16 bf16x2_t __attribute__((ext_vector_type(2)));
DI unsigned pk2(float lo, float hi) { const f32x2_t v = {lo, hi}; const bf16x2_t b = __builtin_convertvector(v, bf16x2_t); return __builtin_bit_cast(unsigned, b); }
DI float bflo(unsigned w) { return __uint_as_float(w << 16); }
DI float bfhi(unsigned w) { return __uint_as_float(w & 0xffff0000u); }
DI int perm16(int x) { return (x & ~12) | ((x & 4) << 1) | ((x & 8) >> 1); }
template <int CTRL> DI float dppf(float x) { return __builtin_bit_cast(float, __builtin_amdgcn_mov_dpp(__builtin_bit_cast(int, x), CTRL, 0xf, 0xf, true)); }
template <int CTRL> DI int dppi(int x) { return __builtin_amdgcn_mov_dpp(x, CTRL, 0xf, 0xf, true); }
constexpr int DPP_X1 = 0xB1, DPP_X2 = 0x4E, DPP_HM = 0x141, DPP_X8 = 0x128;
DI float x32_sum(float x) { auto t = __builtin_amdgcn_permlane32_swap(__float_as_uint(x), __float_as_uint(x), false, false); return __uint_as_float(t[0]) + __uint_as_float(t[1]); }
DI float x32_max(float x) { auto t = __builtin_amdgcn_permlane32_swap(__float_as_uint(x), __float_as_uint(x), false, false); return fmaxf(__uint_as_float(t[0]), __uint_as_float(t[1])); }
DI float x16_sum(float x) { auto t = __builtin_amdgcn_permlane16_swap(__float_as_uint(x), __float_as_uint(x), false, false); return __uint_as_float(t[0]) + __uint_as_float(t[1]); }
DI u32x4 widen16(u32x2 o0, u32x2 o1) {
  auto rx = __builtin_amdgcn_permlane16_swap(o0.x, o1.x, false, false); auto ry = __builtin_amdgcn_permlane16_swap(o0.y, o1.y, false, false);
  return (u32x4){rx[0], ry[0], rx[1], ry[1]};
}
DI int widen16_col(int fq) { return (fq & 1) ? 16 + 4 * (fq - 1) : 4 * fq; }
DI int sum8i(int v) { v += dppi<DPP_X1>(v); v += dppi<DPP_X2>(v); v += dppi<DPP_HM>(v); return v; }
DI float wave_sum(float v) {
  v += dppf<DPP_X1>(v); v += dppf<DPP_X2>(v); v += dppf<DPP_HM>(v); v += dppf<DPP_X8>(v);
  return x32_sum(x16_sum(v));
}
DI float sigmoidf_(float x) { return __builtin_amdgcn_rcpf(1.f + __expf(-x)); }
DI float gelu_tanh(float x) {
  const float z = 0.7978845608028654f * (x + 0.044715f * x * x * x);
  const float e = __expf(2.f * z);
  const float th = 1.f - 2.f * __builtin_amdgcn_rcpf(e + 1.f);
  return 0.5f * x * (1.f + th);
}
DI void sincos_d(double x, double& s, double& c) {
  const double k = rint(x * 0.6366197723675814);
  double r = fma(-k, 1.5707963267948966, x);
  r = fma(-k, 6.123233995736766e-17, r);
  const int q = ((int)k) & 3;
  const double r2 = r * r;
  const double sp = r * (1.0 + r2 * (-1.0 / 6 + r2 * (1.0 / 120 + r2 * (-1.0 / 5040 + r2 * (1.0 / 362880 + r2 * (-1.0 / 39916800 + r2 * (1.0 / 6227020800.0)))))));
  const double cp = 1.0 + r2 * (-0.5 + r2 * (1.0 / 24 + r2 * (-1.0 / 720 + r2 * (1.0 / 40320 + r2 * (-1.0 / 3628800 + r2 * (1.0 / 479001600 + r2 * (-1.0 / 87178291200.0)))))));
  s = (q == 0) ? sp : (q == 1) ? cp : (q == 2) ? -sp : -cp;
  c = (q == 0) ? cp : (q == 1) ? -sp : (q == 2) ? -cp : sp;
}

DI void gemv_item(float* lds, const float* W, int K, int N, int j0, const float* v0, const float* v1, bool do_silu, const float* bias, float* o0, float* o1) {
  const int tid = otid();
  float* sv = lds; float* red = lds + 4096;
  for (int k = tid; k < K; k += NTHR) {
    float a = v0[k], b = v1 ? v1[k] : 0.f;
    if (do_silu) { a = a / (1.f + expf(-a)); b = b / (1.f + expf(-b)); }
    sv[k] = a; sv[2048 + k] = b;
  }
  __syncthreads();
  const int jl = tid & 63, ks = tid >> 6, kper = K >> 3;
  const float* wp = W + (size_t)(ks * kper) * N + j0 + jl;
  float a0 = 0.f, a1 = 0.f;
#pragma unroll 8
  for (int k = 0; k < kper; ++k) { const float w = wp[(size_t)k * N]; a0 += sv[ks * kper + k] * w; a1 += sv[2048 + ks * kper + k] * w; }
  red[(ks * 64 + jl) * 2] = a0; red[(ks * 64 + jl) * 2 + 1] = a1;
  __syncthreads();
  if (tid < 64) {
    float s0 = 0.f, s1 = 0.f;
    for (int i = 0; i < 8; ++i) { s0 += red[(i * 64 + tid) * 2]; s1 += red[(i * 64 + tid) * 2 + 1]; }
    const float bb = bias ? bias[j0 + tid] : 0.f;
    o0[j0 + tid] = s0 + bb; if (o1) o1[j0 + tid] = s1 + bb;
  }
  __syncthreads();
}

DI void s5_params(const Params& P, int gtid) {
  if (gtid >= DEPTH * 32 * 64) return;
  const int l = gtid / 2048, g = (gtid / 64) % 32, p = gtid % 64;
  const float dt = expf(P.in[8][l * 32 + g]);
  const float lr = P.in[6][(l * 32 + g) * 64 + p], li = P.in[7][(l * 32 + g) * 64 + p];
  const float mag = expf(lr * dt); const float ang = li * dt;
  double sd, cd; sincos_d((double)ang, sd, cd);
  const float ab_re = mag * (float)cd, ab_im = mag * (float)sd;
  float* o = (float*)(P.ws + WS_S5P) + (size_t)((l * 32 + g) * 64 + p) * 36;
  o[0] = ab_re; o[1] = ab_im;
  double pr = ab_re, pi = ab_im;
  for (int i = 0; i < 6; ++i) { const double nr2 = pr * pr - pi * pi, ni2 = 2.0 * pr * pi; pr = nr2; pi = ni2; }
  o[2] = (float)pr; o[3] = (float)pi;
}

DI void s5_tables(const Params& P, int l, int g, int part, unsigned char* lds) {
  const int tid = otid(), lane = tid & 63;
  float* BBr = (float*)lds; float* BBi = BBr + 1024; float* CR = BBi + 1024; float* CI = CR + 1024;
  float* APr = CI + 1024; float* APi = APr + 65 * 64;
  bf16_t* tab = (bf16_t*)(P.ws + WS_TAB + (size_t)l * TAB_LAYER);
  bf16_t* Kt = tab + TAB_KT / 2 + (size_t)g * 64 * 256; bf16_t* M1 = tab + TAB_M1 / 2 + (size_t)g * 128 * 1024; bf16_t* M2 = tab + TAB_M2 / 2 + (size_t)g * 1024 * 128;
  __syncthreads();
  if (tid < 64) {
    const int p = tid;
    const float dt = expf(P.in[8][l * 32 + g]);
    const float lr = P.in[6][(l * 32 + g) * 64 + p], li = P.in[7][(l * 32 + g) * 64 + p];
    const float mag = expf(lr * dt); const float ang = li * dt;
    double sd, cd; sincos_d((double)ang, sd, cd);
    const float ab_re = mag * (float)cd, ab_im = mag * (float)sd;
    const float den = lr * lr + li * li, nr = ab_re - 1.0f;
    const float cr = (nr * lr + ab_im * li) / den, ci = (ab_im * lr - nr * li) / den;
    const float* br = P.in[9] + (size_t)((l * 32 + g) * 64 + p) * 16; const float* bi = P.in[10] + (size_t)((l * 32 + g) * 64 + p) * 16;
    for (int h = 0; h < 16; ++h) { BBr[p * 16 + h] = cr * br[h] - ci * bi[h]; BBi[p * 16 + h] = cr * bi[h] + ci * br[h]; }
    double pr = 1.0, pi = 0.0;
    for (int tau = 0; tau <= 64; ++tau) { APr[tau * 64 + p] = (float)pr; APi[tau * 64 + p] = (float)pi; const double n1 = pr * ab_re - pi * ab_im, n2 = pr * ab_im + pi * ab_re; pr = n1; pi = n2; }
  }
  for (int i = tid; i < 1024; i += NTHR) { CR[i] = P.in[11][(size_t)(l * 32 + g) * 1024 + i]; CI[i] = P.in[12][(size_t)(l * 32 + g) * 1024 + i]; }
  __syncthreads();
  if (part < 4)
  for (int task = part * 256 + tid; task < part * 256 + 256; task += NTHR) {
    const int tau = task >> 4, h = task & 15;
    float a[16];
#pragma unroll
    for (int j = 0; j < 16; ++j) a[j] = 0.f;
    for (int p = 0; p < 64; ++p) {
      const float c_r = CR[h * 64 + p], c_i = CI[h * 64 + p], a_r = APr[tau * 64 + p], a_i = APi[tau * 64 + p];
      const float xr = c_r * a_r - c_i * a_i, xi = c_r * a_i + c_i * a_r;
#pragma unroll
      for (int j4 = 0; j4 < 4; ++j4) { const f32x4 b_r = *(const f32x4*)(BBr + p * 16 + 4 * j4), b_i = *(const f32x4*)(BBi + p * 16 + 4 * j4);
        a[4 * j4] += xr * b_r.x - xi * b_i.x; a[4 * j4 + 1] += xr * b_r.y - xi * b_i.y; a[4 * j4 + 2] += xr * b_r.z - xi * b_i.z; a[4 * j4 + 3] += xr * b_r.w - xi * b_i.w; }
    }
    u32x4 o0, o1; o0.x = pk2(a[0], a[1]); o0.y = pk2(a[2], a[3]); o0.z = pk2(a[4], a[5]); o0.w = pk2(a[6], a[7]); o1.x = pk2(a[8], a[9]); o1.y = pk2(a[10], a[11]); o1.z = pk2(a[12], a[13]); o1.w = pk2(a[14], a[15]);
    *(u32x4*)(Kt + (size_t)task * 16) = o0; *(u32x4*)(Kt + (size_t)task * 16 + 8) = o1;
  }
  if (part == 4)
  for (int task = tid; task < 4096; task += NTHR) {
    const int p = task >> 6, i = task & 63;
    const float a_r = APr[(63 - i) * 64 + p], a_i = APi[(63 - i) * 64 + p];
    float re[16], im[16];
#pragma unroll
    for (int j = 0; j < 16; ++j) { const float b_r = BBr[p * 16 + j], b_i = BBi[p * 16 + j]; re[j] = a_r * b_r - a_i * b_i; im[j] = a_r * b_i + a_i * b_r; }
    u32x4 o; bf16_t* d0 = M1 + (size_t)(2 * p) * 1024 + i * 16; bf16_t* d1 = d0 + 1024;
    o.x = pk2(re[0], re[1]); o.y = pk2(re[2], re[3]); o.z = pk2(re[4], re[5]); o.w = pk2(re[6], re[7]); *(u32x4*)d0 = o;
    o.x = pk2(re[8], re[9]); o.y = pk2(re[10], re[11]); o.z = pk2(re[12], re[13]); o.w = pk2(re[14], re[15]); *(u32x4*)(d0 + 8) = o;
    o.x = pk2(im[0], im[1]); o.y = pk2(im[2], im[3]); o.z = pk2(im[4], im[5]); o.w = pk2(im[6], im[7]); *(u32x4*)d1 = o;
    o.x = pk2(im[8], im[9]); o.y = pk2(im[10], im[11]); o.z = pk2(im[12], im[13]); o.w = pk2(im[14], im[15]); *(u32x4*)(d1 + 8) = o;
  }
  if (part == 5)
  for (int task = tid; task < 4096; task += NTHR) {
    const int th = task >> 2, pq = task & 3, t = th >> 4, h = th & 15;
    unsigned w[16];
#pragma unroll
    for (int j = 0; j < 16; ++j) { const int p = pq * 16 + j;
      const float c_r = CR[h * 64 + p], c_i = CI[h * 64 + p], a_r = APr[(t + 1) * 64 + p], a_i = APi[(t + 1) * 64 + p];
      w[j] = pk2(c_r * a_r - c_i * a_i, -(c_r * a_i + c_i * a_r)); }
    bf16_t* d = M2 + (size_t)th * 128 + pq * 32;
    *(u32x4*)d = (u32x4){w[0], w[1], w[2], w[3]}; *(u32x4*)(d + 8) = (u32x4){w[4], w[5], w[6], w[7]};
    *(u32x4*)(d + 16) = (u32x4){w[8], w[9], w[10], w[11]}; *(u32x4*)(d + 24) = (u32x4){w[12], w[13], w[14], w[15]};
  }
  __syncthreads();
}

struct ConvJob { const float* src; bf16_t* dst; int ldw, K, c0, ncols, nmat, ldd, drow0, mode; size_t sstride, dstride; };
DI int conv_nitems(const ConvJob& j) { return j.nmat * (j.K >> 6) * ((j.ncols + 31) >> 5); }
DI int conv_drow(int mode, int drow0, int n) { return mode == 0 ? drow0 + n : drow0 + ((n >> 6) * 128 + ((n >> 4) & 3) * 32 + (n & 15)); }
DI void conv_item(const ConvJob& jb, int item, float* scr, int lane) {
  const int nblk = (jb.ncols + 31) >> 5, per = (jb.K >> 6) * nblk;
  const int mat = item / per, r = item % per, kb = r / nblk, nb = r % nblk, k0 = 64 * kb, n0 = 32 * nb;
  const float* W = jb.src + (size_t)mat * jb.sstride; bf16_t* WT = jb.dst + (size_t)mat * jb.dstride;
  const int n4 = (lane & 7) * 4; const bool nok = (n0 + n4) < jb.ncols;
#pragma unroll
  for (int i = 0; i < 8; ++i) { const int kk = 8 * i + (lane >> 3);
    const f32x4 v = nok ? *(const f32x4*)(W + (size_t)(k0 + kk) * jb.ldw + jb.c0 + n0 + n4) : (f32x4){0.f, 0.f, 0.f, 0.f};
    *(f32x4*)(scr + kk * 36 + n4) = v; }
  asm volatile("s_waitcnt lgkmcnt(0)" ::: "memory");
  const int c = lane & 7;
#pragma unroll
  for (int j = 0; j < 4; ++j) {
    const int n = (lane >> 3) + 8 * j; const float* sp = scr + (8 * c) * 36 + n;
    u32x4 o; o.x = pk2(sp[0], sp[36]); o.y = pk2(sp[72], sp[108]); o.z = pk2(sp[144], sp[180]); o.w = pk2(sp[216], sp[252]);
    if (n0 + n < jb.ncols) *(u32x4*)(WT + (size_t)conv_drow(jb.mode, jb.drow0, n0 + n) * jb.ldd + k0 + 8 * c) = o;
  }
  asm volatile("s_waitcnt lgkmcnt(0)" ::: "memory");
}
DI ConvJob conv_job(const Params& P, int l, int j) {
  unsigned char* wb = P.ws + WS_W; ConvJob J; J.nmat = 1; J.mode = 0; J.sstride = 0; J.dstride = 0; J.drow0 = 0; J.c0 = 0;
  const float* win = P.in[5] + (size_t)l * 1024 * INW;
  if (j < 5) { J.src = win; J.ldw = INW; J.K = 1024; J.dst = (bf16_t*)(wb + W_IN); J.ldd = 1024;
    if (j == 0) { J.c0 = 0; J.ncols = 1024; J.drow0 = 0; }
    else if (j == 1) { J.c0 = 1024; J.ncols = 1536; J.drow0 = 1024; }
    else if (j == 2) { J.c0 = 3120; J.ncols = 2048; J.drow0 = 2560; }
    else if (j == 3) { J.c0 = 2608; J.ncols = 512; J.drow0 = 4608; }
    else { J.c0 = 2560; J.ncols = 48; J.drow0 = 5120; }
  } else if (j == 5) { J.src = P.in[14] + (size_t)l * 512 * 512; J.ldw = 512; J.K = 512; J.ncols = 512; J.dst = (bf16_t*)(wb + W_GLU); J.ldd = 512; }
  else if (j == 6) { J.src = P.in[19] + (size_t)l * 1024 * 1024; J.ldw = 1024; J.K = 1024; J.ncols = 1024; J.dst = (bf16_t*)(wb + W_O); J.ldd = 1024; }
  else if (j == 7) { J.src = P.in[15] + (size_t)l * 512 * 1024; J.ldw = 1024; J.K = 512; J.ncols = 1024; J.dst = (bf16_t*)(wb + W_SO); J.ldd = 512; }
  else if (j == 8) { J.src = P.in[20] + (size_t)l * 1024 * 1024; J.ldw = 1024; J.K = 1024; J.ncols = 1024; J.dst = (bf16_t*)(wb + W_OUT); J.ldd = 1024; }
  else if (j == 9) { J.src = P.in[17] + (size_t)l * 2 * 2048 * 256; J.ldw = 256; J.K = 2048; J.ncols = 256; J.nmat = 2; J.sstride = 2048 * 256; J.dstride = 256 * 2048; J.dst = (bf16_t*)(wb + W_C1); J.ldd = 2048; }
  else if (j == 10) { J.src = P.in[18] + (size_t)l * 2 * 256 * 64; J.ldw = 64; J.K = 256; J.ncols = 64; J.nmat = 2; J.sstride = 256 * 64; J.dstride = 128 * 256; J.dst = (bf16_t*)(wb + W_C2); J.ldd = 256; }
  else if (j == 11) { J.src = P.in[26] + (size_t)l * 32 * 1024 * 256; J.ldw = 256; J.K = 1024; J.ncols = 256; J.nmat = 32; J.sstride = 1024 * 256; J.dstride = 512 * 1024; J.dst = (bf16_t*)(wb + W_GU); J.ldd = 1024; J.mode = 1; J.drow0 = 0; }
  else if (j == 12) { J.src = P.in[27] + (size_t)l * 32 * 1024 * 256; J.ldw = 256; J.K = 1024; J.ncols = 256; J.nmat = 32; J.sstride = 1024 * 256; J.dstride = 512 * 1024; J.dst = (bf16_t*)(wb + W_GU); J.ldd = 1024; J.mode = 1; J.drow0 = 16; }
  else { J.src = P.in[28] + (size_t)l * 32 * 256 * 1024; J.ldw = 1024; J.K = 256; J.ncols = 1024; J.nmat = 32; J.sstride = 256 * 1024; J.dstride = 1024 * 256; J.dst = (bf16_t*)(wb + W_D); J.ldd = 256; }
  return J;
}
DI void convert_weights(const Params& P_, int l, unsigned char* lds) {
  Params P = P_; { size_t z_ = 0; asm volatile("" : "+s"(z_)); P.ws = P_.ws + z_; }
  const int tid_ = otid(), bid = obid(), wave = tid_ >> 6, lane = tid_ & 63; (void)bid;
  float* scr = (float*)lds + wave * (64 * 36);
  const int NGW = gridDim.x * NWAVE; int off = bid * NWAVE + wave;
  for (int j = 0; j < 14; ++j) {
    const ConvJob J = conv_job(P, l, j); const int n = conv_nitems(J);
    while (off < n) { conv_item(J, off, scr, lane); off += NGW; }
    off -= n;
  }
}

template <int MODE>
DI void norm_simple(const Params& P_, int l) {
  Params P = P_; { size_t z_ = 0; asm volatile("" : "+s"(z_)); P.ws = P_.ws + z_; }
  const int tid_ = otid(), bid = obid(), wave = tid_ >> 6, lane = tid_ & 63; (void)bid;
  const int NGW = gridDim.x * NWAVE;
  const float* mod = (const float*)(P.ws + WS_MOD);
  const bf16_t* ys = (const bf16_t*)(P.ws + WS_F);
  bf16_t* xn = (bf16_t*)(P.ws + WS_A);
  const float* xbase = MODE == 0 ? P.in[0] : P.out;
  constexpr bool ADDY = (MODE != 0) && EN_MOE;
  f32x4 g[4], sh[4], sc[4], gg[4]; int pb = -1;
  { const float* gp = MODE == 3 ? P.in[29] : P.in[4] + (size_t)l * DM;
#pragma unroll
    for (int j = 0; j < 4; ++j) g[j] = *(const f32x4*)(gp + 4 * lane + 256 * j); }
  f32x4 v[4]; u32x2 y0[4], y1[4];
#define NS_LOAD(vv, a0, a1, rr) do { const float* xr_ = xbase + (size_t)(rr) * DM; \
    _Pragma("unroll") for (int j = 0; j < 4; ++j) vv[j] = *(const f32x4*)(xr_ + 4 * lane + 256 * j); \
    if (ADDY) { _Pragma("unroll") for (int j = 0; j < 4; ++j) { a0[j] = *(const u32x2*)(ys + (size_t)((rr) * 2) * DM + 4 * lane + 256 * j); a1[j] = *(const u32x2*)(ys + (size_t)((rr) * 2 + 1) * DM + 4 * lane + 256 * j); } } } while (0)
  const int row0 = bid * NWAVE + wave;
  if (row0 < NT) NS_LOAD(v, y0, y1, row0);
  for (int row = row0; row < NT; row += NGW) {
    const int b = row >> 13;
    if (b != pb) { pb = b;
      if (ADDY) { const float* g2 = mod + (size_t)(((MODE == 1 ? 0 : 1) * 2 + b) * 6144) + 5120;
#pragma unroll
        for (int j = 0; j < 4; ++j) gg[j] = *(const f32x4*)(g2 + 4 * lane + 256 * j); }
      if (MODE != 3) { const float* md = mod + (size_t)((l * 2 + b) * 6144);
#pragma unroll
        for (int j = 0; j < 4; ++j) { sh[j] = *(const f32x4*)(md + 4 * lane + 256 * j); sc[j] = *(const f32x4*)(md + 1024 + 4 * lane + 256 * j); } }
    }
    f32x4 vn[4]; u32x2 y0n[4], y1n[4];
    if (row + NGW < NT) NS_LOAD(vn, y0n, y1n, row + NGW);
    __builtin_amdgcn_sched_barrier(0);
    if (ADDY) {
#pragma unroll
      for (int j = 0; j < 4; ++j) {
        v[j].x += gg[j].x * (bflo(y0[j].x) + bflo(y1[j].x)); v[j].y += gg[j].y * (bfhi(y0[j].x) + bfhi(y1[j].x));
        v[j].z += gg[j].z * (bflo(y0[j].y) + bflo(y1[j].y)); v[j].w += gg[j].w * (bfhi(y0[j].y) + bfhi(y1[j].y));
      }
    }
    float ss = 0.f;
#pragma unroll
    for (int j = 0; j < 4; ++j) ss += v[j].x * v[j].x + v[j].y * v[j].y + v[j].z * v[j].z + v[j].w * v[j].w;
    ss = wave_sum(ss);
    const float inv = rsqrtf(ss * (1.f / DM) + EPS);
    if (MODE == 3) {
#pragma unroll
      for (int j = 0; j < 4; ++j) { const int col = 4 * lane + 256 * j; *(f32x4*)(P.out + (size_t)row * DM + col) = v[j] * inv * g[j]; }
    } else {
      if (MODE == 1) {
#pragma unroll
        for (int j = 0; j < 4; ++j) *(f32x4*)(P.out + (size_t)row * DM + 4 * lane + 256 * j) = v[j];
      }
#pragma unroll
      for (int j = 0; j < 4; ++j) {
        const int col = 4 * lane + 256 * j;
        const f32x4 h = v[j] * inv * g[j] * (sc[j] + 1.f) + sh[j];
        u32x2 o; o.x = pk2(h.x, h.y); o.y = pk2(h.z, h.w);
        *(u32x2*)(xn + (size_t)row * DM + col) = o;
      }
    }
#pragma unroll
    for (int j = 0; j < 4; ++j) { v[j] = vn[j]; y0[j] = y0n[j]; y1[j] = y1n[j]; }
  }
#undef NS_LOAD
}

constexpr int RT_HS = 1028;
DI void norm_route(const Params& P_, int l, unsigned char* lds) {
  Params P = P_; { size_t z_ = 0; asm volatile("" : "+s"(z_)); P.ws = P_.ws + z_; }
  const int tid = otid(), bid = obid(), wave = tid >> 6, lane = tid & 63;
  const float* mod = (const float*)(P.ws + WS_MOD);
  bf16_t* h2 = (bf16_t*)(P.ws + WS_A);
  float* hs = (float*)lds;
  float* Wc = (float*)lds + 32 * RT_HS;
  const float* wg = P.in[22] + (size_t)l * DM * 4; const float* we = P.in[24] + (size_t)l * DM * 32;
  const float* bg = P.in[23] + l * 4; const float* be = P.in[25] + l * 32;
  int* cnt = (int*)(P.ws + WS_CNT) + l * 32; int* list = (int*)(P.ws + WS_LIST); float* wts = (float*)(P.ws + WS_WT);
  const int rg = wave >> 2, kq = wave & 3;
  for (int grp = bid; grp < NT / 32; grp += gridDim.x) {
    const int row0 = grp * 32 + wave * 4, b = row0 >> 13;
    const float* ng = P.in[21] + (size_t)l * DM; const float* md = mod + (size_t)((l * 2 + b) * 6144);
    {
      f32x4 v[4][4];
#pragma unroll
      for (int r = 0; r < 4; ++r)
#pragma unroll
        for (int j = 0; j < 4; ++j) v[r][j] = *(const f32x4*)(P.out + (size_t)(row0 + r) * DM + 4 * lane + 256 * j);
      float inv[4];
#pragma unroll
      for (int r = 0; r < 4; ++r) { float ss = 0.f;
#pragma unroll
        for (int j = 0; j < 4; ++j) ss += v[r][j].x * v[r][j].x + v[r][j].y * v[r][j].y + v[r][j].z * v[r][j].z + v[r][j].w * v[r][j].w;
        inv[r] = rsqrtf(wave_sum(ss) * (1.f / DM) + EPS); }
#pragma unroll
      for (int j = 0; j < 4; ++j) {
        const int col = 4 * lane + 256 * j;
        const f32x4 g = *(const f32x4*)(ng + col), sh = *(const f32x4*)(md + 3072 + col), sc = *(const f32x4*)(md + 4096 + col);
#pragma unroll
        for (int r = 0; r < 4; ++r) {
          const f32x4 hh = v[r][j] * inv[r] * g * (sc + 1.f) + sh;
          u32x2 o; o.x = pk2(hh.x, hh.y); o.y = pk2(hh.z, hh.w);
          *(u32x2*)(h2 + (size_t)(row0 + r) * DM + col) = o;
          *(f32x4*)(hs + (wave * 4 + r) * RT_HS + col) = hh;
        }
      }
    }
    f32x4 we0, we1, wg0 = {0.f, 0.f, 0.f, 0.f};
#define WLOAD(kc) do { we0 = *(const f32x4*)(we + (size_t)(kc) * 4096 + tid * 4); we1 = *(const f32x4*)(we + (size_t)(kc) * 4096 + 2048 + tid * 4); if (tid < 128) wg0 = *(const f32x4*)(wg + (size_t)(kc) * 512 + tid * 4); } while (0)
#define WSTORE() do { *(f32x4*)(Wc + (tid >> 3) * 36 + (tid & 7) * 4) = we0; *(f32x4*)(Wc + (64 + (tid >> 3)) * 36 + (tid & 7) * 4) = we1; if (tid < 128) *(f32x4*)(Wc + tid * 36 + 32) = wg0; } while (0)
    WLOAD(0);
    f32x4 acc0 = {0.f, 0.f, 0.f, 0.f}, acc1 = acc0, acc2 = acc0;
    for (int kc = 0; kc < 8; ++kc) {
      __syncthreads();
      WSTORE();
      if (kc + 1 < 8) WLOAD(kc + 1);
      __syncthreads();
      const float* ap = hs + (rg * 16 + (lane & 15)) * RT_HS + kc * 128 + kq * 32 + (lane >> 4);
      const float* bp = Wc + (kq * 32 + (lane >> 4)) * 36 + (lane & 15);
#pragma unroll
      for (int ks = 0; ks < 8; ++ks) {
        const float av = ap[4 * ks];
        const float b0 = bp[(4 * ks) * 36], b1 = bp[(4 * ks) * 36 + 16], b2 = (lane & 15) < 4 ? bp[(4 * ks) * 36 + 32] : 0.f;
        acc0 = __builtin_amdgcn_mfma_f32_16x16x4f32(av, b0, acc0, 0, 0, 0);
        acc1 = __builtin_amdgcn_mfma_f32_16x16x4f32(av, b1, acc1, 0, 0, 0);
        acc2 = __builtin_amdgcn_mfma_f32_16x16x4f32(av, b2, acc2, 0, 0, 0);
      }
    }
#undef WLOAD
#undef WSTORE
    __syncthreads();
    {
      float* part = hs + kq * (32 * 40);
#pragma unroll
      for (int i = 0; i < 4; ++i) { const int row = rg * 16 + 4 * (lane >> 4) + i, col = lane & 15;
        part[row * 40 + col] = acc0[i]; part[row * 40 + 16 + col] = acc1[i]; if (col < 4) part[row * 40 + 32 + col] = acc2[i]; }
    }
    __syncthreads();
    if (tid < 32) {
      const int row = grp * 32 + tid;
      float L[36];
#pragma unroll
      for (int o = 0; o < 36; ++o) L[o] = (hs[tid * 40 + o] + hs[1280 + tid * 40 + o]) + (hs[2560 + tid * 40 + o] + hs[3840 + tid * 40 + o]);
      float gm = -1e30f; int gi = 0;
#pragma unroll
      for (int i = 0; i < 4; ++i) { const float v = L[32 + i] + bg[i]; if (v > gm) { gm = v; gi = i; } }
      float gs = 0.f;
#pragma unroll
      for (int i = 0; i < 4; ++i) gs += expf(L[32 + i] + bg[i] - gm);
      const float gp = 1.f / gs;
      float el[8];
#pragma unroll
      for (int i = 0; i < 8; ++i) el[i] = (gi == 0 ? L[i] : gi == 1 ? L[8 + i] : gi == 2 ? L[16 + i] : L[24 + i]) + be[gi * 8 + i];
      float em = -1e30f;
#pragma unroll
      for (int i = 0; i < 8; ++i) em = fmaxf(em, el[i]);
      float p1 = -1.f, p2 = -1.f; int i1 = 0, i2 = 0;
#pragma unroll
      for (int i = 0; i < 8; ++i) {
        const float pe = expf(el[i] - em);
        if (pe > p1) { p2 = p1; i2 = i1; p1 = pe; i1 = i; } else if (pe > p2) { p2 = pe; i2 = i; }
      }
      const float w1 = gp * p1 / (p1 + p2), w2 = gp * p2 / (p1 + p2);
      const int e1 = gi * 8 + i1, e2 = gi * 8 + i2;
      const int pos1 = atomicAdd(&cnt[e1], 1); list[e1 * LISTCAP + pos1] = row * 2; wts[row * 2] = w1;
      const int pos2 = atomicAdd(&cnt[e2], 1); list[e2 * LISTCAP + pos2] = row * 2 + 1; wts[row * 2 + 1] = w2;
    }
    __syncthreads();
  }
}

namespace pg8 {
#define PG8_LAS __attribute__((address_space(3)))
typedef unsigned short bf16_t;
typedef short bf16x8 __attribute__((ext_vector_type(8)));
typedef float f32x4 __attribute__((ext_vector_type(4)));
typedef unsigned u32x4 __attribute__((ext_vector_type(4)));
constexpr int BM = 256, BK = 64, HALF = 128, HTB = HALF * BK * 2  , STAGE_BYTES = 8 * HTB, NXCD = 8, WGM = 8;

__host__ __device__ __forceinline__ int lds_byte(int r, int c) { const int st = (r >> 4) * 2 + (c >> 5), rr = r & 15, cc = c & 31, ob = rr * 64 + cc * 2; return st * 1024 + (ob ^ (((ob >> 9) & 1) << 5)); }
__host__ __device__ __forceinline__ void stage_rc(int b, int& R, int& C) { const int st = b / 1024, sb = b % 1024, swz = sb ^ (((sb >> 9) & 1) << 5); R = (st >> 1) * 16 + swz / 64; C = (st & 1) * 32 + (swz % 64) / 2; }
__host__ __device__ __forceinline__ int perm32(int rho) { const int n = rho >> 4, i = rho & 15; return 8 * (i >> 2) + 4 * n + (i & 3); }

struct Unit { int pm, pn; };
struct Gemm { const bf16_t* A; const bf16_t* Bt; int M, N, K; };

struct StaticOrder {
    int nM, nN, nwg, G, c;
    __host__ __device__ void init(int M, int N, int G_, int c_) { nM = M / BM; nN = N / BM; nwg = nM * nN; G = G_; c = c_; }
    __host__ __device__ bool next(int i, Unit& u) const {
        const long L = (long)i * G + c; if (L >= nwg) return false;
        int wgid = (int)L; { const int q = nwg / NXCD, r = nwg % NXCD, xcd = wgid % NXCD, off = wgid / NXCD; wgid = (xcd < r ? xcd * (q + 1) : r * (q + 1) + (xcd - r) * q) + off; }
        const int nig = WGM * nN, gid = wgid / nig, fm = gid * WGM, gsz = (nM - fm) < WGM ? (nM - fm) : WGM;
        u.pm = fm + ((wgid % nig) % gsz); u.pn = (wgid % nig) / gsz; return true;
    }
    __device__ __forceinline__ void a_ready(const Unit&) const {}
    __device__ __forceinline__ void done(const Unit&) const {}
};
template <class Epi, class Sched, bool ALIGN_EPI = false, bool SP2 = false>
__device__ __forceinline__ void gemm_phase(PG8_LAS unsigned char* lds, const Gemm g, const Sched& S, const Epi& E) {
    const int tid = otid(), wid = __builtin_amdgcn_readfirstlane(tid >> 6), lane = tid & 63, wr = wid >> 2, wc = wid & 3, fr = lane & 15, fq = lane >> 4;
    const int K = g.K, nt = K / BK;
    unsigned voffA[2], voffB[2];
#pragma unroll
    for (int i = 0; i < 2; ++i) { int R, C; stage_rc(tid * 16 + i * 8192, R, C); const int Rb = Epi::PERM ? ((R & ~31) + perm32(R & 31)) : R;
        voffA[i] = (unsigned)(R * K + C) * 2u; voffB[i] = (unsigned)(Rb * K + C) * 2u; }
    const size_t kstep = (size_t)(BK * 2);
    const size_t hstep = (size_t)HALF * K * 2;
    const size_t tstep = 2 * hstep;
    const unsigned ldsw = (unsigned)wid * 1024u;
    const int aoff = lds_byte(wr * 64 + fr, fq * 8), boff = lds_byte(wc * 32 + fr, fq * 8);
#define PG8_SA(b, h) (((b) * 2 + (h)) * HTB)
#define PG8_SB(b, h) ((4 + (b) * 2 + (h)) * HTB)
#define PG8_STAGE(bufoff, gbase, voff) do { _Pragma("unroll") for (int _i = 0; _i < 2; ++_i) \
        __builtin_amdgcn_global_load_lds((const unsigned*)((const char*)(gbase) + (voff)[_i]), (PG8_LAS unsigned*)(lds + (bufoff) + ldsw + _i * 8192), 16, 0, 0); } while (0)
#define PG8_LDA(dst, b, h) do { _Pragma("unroll") for (int m = 0; m < 4; ++m) _Pragma("unroll") for (int k = 0; k < 2; ++k) dst[m][k] = *(const PG8_LAS bf16x8*)(lds + PG8_SA(b, h) + aoff + m * 2048 + k * 1024); } while (0)
#define PG8_LDB(dst, b, h) do { _Pragma("unroll") for (int n = 0; n < 2; ++n) _Pragma("unroll") for (int k = 0; k < 2; ++k) dst[n][k] = *(const PG8_LAS bf16x8*)(lds + PG8_SB(b, h) + boff + n * 2048 + k * 1024); } while (0)
#define PG8_MMA(ai, bj, At, Bt) do { __builtin_amdgcn_s_setprio(1); _Pragma("unroll") for (int m = 0; m < 4; ++m) _Pragma("unroll") for (int n = 0; n < 2; ++n) _Pragma("unroll") for (int k = 0; k < 2; ++k) \
        acc[ai][bj][m][n] = __builtin_amdgcn_mfma_f32_16x16x32_bf16(Bt[n][k], At[m][k], acc[ai][bj][m][n], 0, 0, 0); __builtin_amdgcn_s_setprio(0); } while (0)
#define PG8_WAIT_V(n) asm volatile("s_waitcnt vmcnt(" #n ")" ::: "memory")
#define PG8_WAIT_L(n) asm volatile("s_waitcnt lgkmcnt(" #n ")" ::: "memory")
#define PG8_BAR __builtin_amdgcn_s_barrier()
#define PG8_SCHED __builtin_amdgcn_sched_barrier(0)
    Unit cur, nxt; int ui = 0;
    if (!S.next(0, cur)) return;
    f32x4 acc[2][2][4][2];
#pragma unroll
    for (int a = 0; a < 2; ++a)
#pragma unroll
        for (int b = 0; b < 2; ++b)
#pragma unroll
            for (int m = 0; m < 4; ++m)
#pragma unroll
                for (int n = 0; n < 2; ++n) acc[a][b][m][n] = (f32x4){0.f, 0.f, 0.f, 0.f};
    bf16x8 At[4][2], B0[2][2], B1[2][2];
    const char* cA = (const char*)g.A + (size_t)cur.pm * tstep; const char* cB = (const char*)g.Bt + (size_t)cur.pn * tstep;
    S.a_ready(cur);
    if constexpr (SP2) {
        PG8_STAGE(PG8_SB(0, 0), cB, voffB); PG8_STAGE(PG8_SB(0, 1), cB + hstep, voffB); PG8_STAGE(PG8_SA(0, 0), cA, voffA); PG8_STAGE(PG8_SA(0, 1), cA + hstep, voffA);
        if (wr == 1) PG8_BAR;
        PG8_WAIT_V(2); PG8_BAR;
        PG8_STAGE(PG8_SB(1, 0), cB + kstep, voffB); PG8_STAGE(PG8_SA(1, 0), cA + kstep, voffA); PG8_STAGE(PG8_SB(1, 1), cB + hstep + kstep, voffB);
        PG8_WAIT_V(6); PG8_BAR;
    } else {
        PG8_STAGE(PG8_SB(0, 0), cB, voffB); PG8_STAGE(PG8_SA(0, 0), cA, voffA); PG8_STAGE(PG8_SB(0, 1), cB + hstep, voffB); PG8_STAGE(PG8_SA(0, 1), cA + hstep, voffA);
        if (wr == 1) PG8_BAR;
        PG8_WAIT_V(4); PG8_BAR;
        PG8_STAGE(PG8_SB(1, 0), cB + kstep, voffB); PG8_STAGE(PG8_SA(1, 0), cA + kstep, voffA); PG8_STAGE(PG8_SB(1, 1), cB + hstep + kstep, voffB);
        PG8_WAIT_V(6); PG8_BAR;
    }
    for (;;) {
        const bool has_next = S.next(ui + 1, nxt);
        const char* nA = has_next ? (const char*)g.A + (size_t)nxt.pm * tstep : cA; const char* nB = has_next ? (const char*)g.Bt + (size_t)nxt.pn * tstep : cB;
        for (int t = 0; t < nt; t += 2) {
            const bool last = (t == nt - 2);
            const char* a1 = cA + (size_t)(t + 1) * kstep;
            const char* a2 = last ? nA : cA + (size_t)(t + 2) * kstep; const char* b2 = last ? nB : cB + (size_t)(t + 2) * kstep;
            const char* a3 = a2 + kstep; const char* b3 = b2 + kstep;
            if (last && has_next) S.a_ready(nxt);
            if constexpr (SP2) {
            PG8_LDB(B0, 0, 0); PG8_LDB(B1, 0, 1); PG8_SCHED; PG8_LDA(At, 0, 0); PG8_STAGE(PG8_SA(1, 1), a1 + hstep, voffA);
            PG8_WAIT_V(8); PG8_WAIT_L(0); PG8_BAR; PG8_MMA(0, 0, At, B0); PG8_MMA(0, 1, At, B1); PG8_BAR; PG8_SCHED;
            PG8_LDA(At, 0, 1); PG8_STAGE(PG8_SB(0, 0), b2, voffB); PG8_STAGE(PG8_SB(0, 1), b2 + hstep, voffB); PG8_STAGE(PG8_SA(0, 0), a2, voffA);
            PG8_WAIT_V(8); PG8_WAIT_L(0); PG8_BAR; PG8_MMA(1, 0, At, B0); PG8_MMA(1, 1, At, B1); PG8_BAR; PG8_SCHED;
            PG8_LDB(B0, 1, 0); PG8_LDB(B1, 1, 1); PG8_SCHED; PG8_LDA(At, 1, 0); PG8_STAGE(PG8_SA(0, 1), a2 + hstep, voffA);
            PG8_WAIT_V(8); PG8_WAIT_L(0); PG8_BAR; PG8_MMA(0, 0, At, B0); PG8_MMA(0, 1, At, B1); PG8_BAR; PG8_SCHED;
            PG8_LDA(At, 1, 1); PG8_STAGE(PG8_SB(1, 0), b3, voffB); PG8_STAGE(PG8_SB(1, 1), b3 + hstep, voffB); PG8_STAGE(PG8_SA(1, 0), a3, voffA);
            PG8_WAIT_V(8); PG8_WAIT_L(0); PG8_BAR; PG8_MMA(1, 0, At, B0); PG8_MMA(1, 1, At, B1); PG8_BAR; PG8_SCHED;
            } else {
            PG8_LDB(B0, 0, 0); PG8_SCHED; PG8_LDA(At, 0, 0); PG8_STAGE(PG8_SA(1, 1), a1 + hstep, voffA);
            PG8_WAIT_L(8); PG8_BAR; PG8_WAIT_L(0); PG8_MMA(0, 0, At, B0); PG8_BAR; PG8_SCHED;
            PG8_LDB(B1, 0, 1); PG8_STAGE(PG8_SB(0, 0), b2, voffB);
            PG8_BAR; PG8_WAIT_L(0); PG8_MMA(0, 1, At, B1); PG8_BAR;
            PG8_LDA(At, 0, 1); PG8_STAGE(PG8_SA(0, 0), a2, voffA);
            PG8_BAR; PG8_WAIT_L(0); PG8_MMA(1, 0, At, B0); PG8_BAR; PG8_SCHED;
            PG8_STAGE(PG8_SB(0, 1), b2 + hstep, voffB);
            PG8_WAIT_V(6); PG8_BAR; PG8_MMA(1, 1, At, B1); PG8_BAR;
            PG8_LDB(B0, 1, 0); PG8_SCHED; PG8_LDA(At, 1, 0); PG8_STAGE(PG8_SA(0, 1), a2 + hstep, voffA);
            PG8_WAIT_L(8); PG8_BAR; PG8_WAIT_L(0); PG8_MMA(0, 0, At, B0); PG8_BAR; PG8_SCHED;
            PG8_LDB(B1, 1, 1); PG8_STAGE(PG8_SB(1, 0), b3, voffB);
            PG8_BAR; PG8_WAIT_L(0); PG8_MMA(0, 1, At, B1); PG8_BAR;
            PG8_LDA(At, 1, 1); PG8_STAGE(PG8_SA(1, 0), a3, voffA);
            PG8_BAR; PG8_WAIT_L(0); PG8_MMA(1, 0, At, B0); PG8_BAR; PG8_SCHED;
            PG8_STAGE(PG8_SB(1, 1), b3 + hstep, voffB);
            PG8_WAIT_V(6); PG8_BAR; PG8_MMA(1, 1, At, B1); PG8_BAR;
            }
        }
        if constexpr (ALIGN_EPI) { if (wr == 0) PG8_BAR; }
        if constexpr (!Epi::AFTER_DRAIN) { E(acc, cur, wr, wc, fr, fq); S.done(cur); }
        if (!has_next) break;
#pragma unroll
        for (int a = 0; a < 2; ++a)
#pragma unroll
            for (int b = 0; b < 2; ++b)
#pragma unroll
                for (int m = 0; m < 4; ++m)
#pragma unroll
                    for (int n = 0; n < 2; ++n) acc[a][b][m][n] = (f32x4){0.f, 0.f, 0.f, 0.f};
        cur = nxt; cA = nA; cB = nB; ++ui;
        if constexpr (ALIGN_EPI) { if (wr == 1) PG8_BAR; }
    }
    PG8_WAIT_V(0);
    if constexpr (!ALIGN_EPI) { if (wr == 0) PG8_BAR; }
    PG8_BAR;
    if constexpr (Epi::AFTER_DRAIN) { E.fused(acc, cur, wr, wc, fr, fq, lds, wid, lane); S.done(cur); }
#undef PG8_SA
#undef PG8_SB
#undef PG8_STAGE
#undef PG8_LDA
#undef PG8_LDB
#undef PG8_MMA
#undef PG8_WAIT_V
#undef PG8_WAIT_L
#undef PG8_BAR
#undef PG8_SCHED
}
}

constexpr int GT_ROWB = 128, GT_A = 0, GT_B = 128 * GT_ROWB, GT_STAGE = 2 * 128 * GT_ROWB;
#define GT_WOFF(lr_, tid_) ((lr_) * GT_ROWB + ((((tid_) & 7) ^ ((lr_) & 7)) * 16))
#define GT_RSW(ks_, fq_, fr_) ((((ks_) * 4 + (fq_)) ^ ((fr_) & 7)) * 16)
DI void gemm_kloop(unsigned char* lds, const bf16_t* a0, const bf16_t* a1, int a_kadv, const bf16_t* b0, const bf16_t* b1, int nk, f32x4 (&acc)[4][2]) {
  const int tid = otid(), lane = tid & 63, wid = tid >> 6, wr = wid >> 2, wc = wid & 3, fr = lane & 15, fq = lane >> 4;
  const int lr = tid >> 3, lkb = (tid & 7) * 16;
  u32x4 xa0, xa1, xb0, xb1, ya0, ya1, yb0, yb1;
#define GT_GLOAD(p0_, p1_, q0_, q1_, kt) do { p0_ = *(const u32x4*)(a0 + (size_t)(kt) * a_kadv); p1_ = *(const u32x4*)(a1 + (size_t)(kt) * a_kadv); q0_ = *(const u32x4*)(b0 + (kt) * 64); q1_ = *(const u32x4*)(b1 + (kt) * 64); } while (0)
#define GT_LSTORE(p0_, p1_, q0_, q1_, buf) do { unsigned char* s_ = lds + (buf) * GT_STAGE; \
    *(u32x4*)(s_ + GT_A + GT_WOFF(lr, tid)) = p0_; *(u32x4*)(s_ + GT_A + 64 * GT_ROWB + GT_WOFF(lr, tid)) = p1_; \
    *(u32x4*)(s_ + GT_B + GT_WOFF(lr, tid)) = q0_; *(u32x4*)(s_ + GT_B + 64 * GT_ROWB + GT_WOFF(lr, tid)) = q1_; } while (0)
#define GT_COMPUTE(buf) do { \
    const unsigned char* As = lds + (buf) * GT_STAGE + GT_A + (wr * 64 + fr) * GT_ROWB; \
    const unsigned char* Bs = lds + (buf) * GT_STAGE + GT_B + (wc * 32 + fr) * GT_ROWB; \
    _Pragma("unroll") for (int ks = 0; ks < 2; ++ks) { \
      bf16x8 af[4], bfr[2]; \
      _Pragma("unroll") for (int m = 0; m < 4; ++m) af[m] = *(const bf16x8*)(As + m * 16 * GT_ROWB + GT_RSW(ks, fq, fr)); \
      _Pragma("unroll") for (int n = 0; n < 2; ++n) bfr[n] = *(const bf16x8*)(Bs + n * 16 * GT_ROWB + GT_RSW(ks, fq, fr)); \
      _Pragma("unroll") for (int m = 0; m < 4; ++m) _Pragma("unroll") for (int n = 0; n < 2; ++n) acc[m][n] = __builtin_amdgcn_mfma_f32_16x16x32_bf16(bfr[n], af[m], acc[m][n], 0, 0, 0); } } while (0)
  GT_GLOAD(xa0, xa1, xb0, xb1, 0); GT_LSTORE(xa0, xa1, xb0, xb1, 0); if (nk > 1) GT_GLOAD(ya0, ya1, yb0, yb1, 1); __syncthreads();
  for (int kt = 0; kt < nk; kt += 2) {
    if (kt + 2 < nk) GT_GLOAD(xa0, xa1, xb0, xb1, kt + 2);
    GT_COMPUTE(0);
    if (kt + 1 < nk) GT_LSTORE(ya0, ya1, yb0, yb1, 1);
    __syncthreads();
    if (kt + 1 >= nk) break;
    if (kt + 3 < nk) GT_GLOAD(ya0, ya1, yb0, yb1, kt + 3);
    GT_COMPUTE(1);
    if (kt + 2 < nk) GT_LSTORE(xa0, xa1, xb0, xb1, 0);
    __syncthreads();
  }
#undef GT_GLOAD
#undef GT_LSTORE
#undef GT_COMPUTE
}
#define ACC_ZERO(acc) do { _Pragma("unroll") for (int m_ = 0; m_ < 4; ++m_) _Pragma("unroll") for (int n_ = 0; n_ < 2; ++n_) acc[m_][n_] = (f32x4){0.f, 0.f, 0.f, 0.f}; } while (0)
#define TILE_IDS const int tid = otid(), bid = obid(), lane = tid & 63, wid = tid >> 6, wr = wid >> 2, wc = wid & 3, fr = lane & 15, fq = lane >> 4, lr = tid >> 3, lk = (tid & 7) * 8; (void)bid; (void)lane; (void)wr; (void)wc; (void)fr; (void)fq; (void)lr; (void)lk

DI void phase_gates(const Params& P_, unsigned char* lds) {
  Params P = P_; { size_t z_ = 0; asm volatile("" : "+s"(z_)); P.ws = P_.ws + z_; }
  TILE_IDS;
  const bf16_t* xn = (const bf16_t*)(P.ws + WS_A); const bf16_t* wt = (const bf16_t*)(P.ws + WS_W + W_IN) + (size_t)5120 * DM; float* gates = (float*)(P.ws + WS_GATES);
  for (int tile = (int)gridDim.x - 1 - bid; tile < NT / 128; tile += gridDim.x) {
    const int row0 = tile * 128;
    f32x4 acc[4][2]; ACC_ZERO(acc);
    gemm_kloop(lds, xn + (size_t)(row0 + lr) * DM + lk, xn + (size_t)(row0 + lr + 64) * DM + lk, 64, wt + (size_t)lr * DM + lk, wt + (size_t)(lr + 64) * DM + lk, DM / 64, acc);
#pragma unroll
    for (int m = 0; m < 4; ++m)
#pragma unroll
      for (int n = 0; n < 2; ++n) {
        const int row = row0 + wr * 64 + m * 16 + fr, c2 = wc * 32 + n * 16 + 4 * fq; const f32x4 v = acc[m][n];
        if (c2 < 48) { f32x4 o = {sigmoidf_(v.x), sigmoidf_(v.y), sigmoidf_(v.z), sigmoidf_(v.w)}; *(f32x4*)(gates + (size_t)row * 48 + c2) = o; }
      }
  }
}
DI void phase_cmp1(const Params& P_, int l, unsigned char* lds) {
  Params P = P_; { size_t z_ = 0; asm volatile("" : "+s"(z_)); P.ws = P_.ws + z_; }
  TILE_IDS;
  const bf16_t* kvk = (const bf16_t*)(P.ws + WS_C); bf16_t* hid = (bf16_t*)(P.ws + WS_HID);
  const float* cb = (const float*)(P.ws + WS_CB) + l * 512;
  for (int tile = bid; tile < 128; tile += gridDim.x) {
    const int kv = tile >> 6, rt = (tile >> 1) & 31, ct = tile & 1, row0 = rt * 128, col0 = ct * 128;
    const bf16_t* wt = (const bf16_t*)(P.ws + WS_W + W_C1) + (size_t)kv * 256 * 2048;
    const bf16_t* ap[2];
#pragma unroll
    for (int i = 0; i < 2; ++i) { const int rr = row0 + lr + 64 * i, b = rr >> 11, n = (rr >> 2) & 511, g = rr & 3, nn = n > 510 ? 510 : n;
      ap[i] = kvk + (size_t)(b * SEQ + 16 * nn) * DM + kv * 256 + g * 64 + lk; }
    f32x4 acc[4][2]; ACC_ZERO(acc);
    gemm_kloop(lds, ap[0], ap[1], DM, wt + (size_t)(col0 + lr) * 2048 + lk, wt + (size_t)(col0 + lr + 64) * 2048 + lk, 32, acc);
#pragma unroll
    for (int m = 0; m < 4; ++m)
#pragma unroll
      for (int n = 0; n < 2; ++n) {
        const int row = row0 + wr * 64 + m * 16 + fr, col = col0 + wc * 32 + n * 16 + 4 * fq;
        const f32x4 bb = *(const f32x4*)(cb + kv * 256 + col); const f32x4 v = acc[m][n] + bb;
        u32x2 o; o.x = pk2(gelu_tanh(v.x), gelu_tanh(v.y)); o.y = pk2(gelu_tanh(v.z), gelu_tanh(v.w));
        *(u32x2*)(hid + ((size_t)kv * 4096 + row) * 256 + col) = o;
      }
  }
}
DI void phase_cmp2(const Params& P_, unsigned char* lds) {
  Params P = P_; { size_t z_ = 0; asm volatile("" : "+s"(z_)); P.ws = P_.ws + z_; }
  TILE_IDS;
  const bf16_t* hid = (const bf16_t*)(P.ws + WS_HID); bf16_t* kc = (bf16_t*)(P.ws + WS_KC); bf16_t* vc = (bf16_t*)(P.ws + WS_VC);
  for (int tile = bid; tile < 64; tile += gridDim.x) {
    const int kv = tile >> 5, rt = tile & 31, row0 = rt * 128;
    const bf16_t* wt = (const bf16_t*)(P.ws + WS_W + W_C2) + (size_t)kv * 128 * 256;
    const bf16_t* a = hid + ((size_t)kv * 4096 + row0) * 256;
    f32x4 acc[4][2]; ACC_ZERO(acc);
    gemm_kloop(lds, a + (size_t)lr * 256 + lk, a + (size_t)(lr + 64) * 256 + lk, 64, wt + (size_t)lr * 256 + lk, wt + (size_t)(lr + 64) * 256 + lk, 4, acc);
    if (wc < 2) {
#pragma unroll
      for (int m = 0; m < 4; ++m)
#pragma unroll
        for (int n = 0; n < 2; ++n) {
          const int rr = row0 + wr * 64 + m * 16 + fr, d = wc * 32 + n * 16 + 4 * fq;
          const int b = rr >> 11, nn = (rr >> 2) & 511, g = rr & 3; const f32x4 v = acc[m][n];
          if (kv == 0) { u32x2 o; o.x = pk2(v.x, v.y); o.y = pk2(v.z, v.w); *(u32x2*)(kc + ((size_t)((b * 4 + g) * 512 + nn)) * 64 + d) = o; }
          else { bf16_t* dst = vc + ((size_t)((b * 4 + g) * 64 + d)) * 512 + perm16(nn); dst[0] = (bf16_t)f2bf(v.x); dst[512] = (bf16_t)f2bf(v.y); dst[1024] = (bf16_t)f2bf(v.z); dst[1536] = (bf16_t)f2bf(v.w); }
        }
    }
  }
}
DI void phase_glu(const Params& P_, unsigned char* lds) {
  Params P = P_; { size_t z_ = 0; asm volatile("" : "+s"(z_)); P.ws = P_.ws + z_; }
  TILE_IDS;
  const bf16_t* y = (const bf16_t*)(P.ws + WS_G); const bf16_t* wt = (const bf16_t*)(P.ws + WS_W + W_GLU); bf16_t* ssm = (bf16_t*)(P.ws + WS_E);
  for (int tile = bid; tile < (NT / 128) * 4; tile += gridDim.x) {
    const int rt = tile >> 2, ct = tile & 3, row0 = rt * 128, col0 = ct * 128;
    f32x4 acc[4][2]; ACC_ZERO(acc);
    gemm_kloop(lds, y + (size_t)(row0 + lr) * 512 + lk, y + (size_t)(row0 + lr + 64) * 512 + lk, 64, wt + (size_t)(col0 + lr) * 512 + lk, wt + (size_t)(col0 + lr + 64) * 512 + lk, 8, acc);
#pragma unroll
    for (int m = 0; m < 4; ++m)
#pragma unroll
      for (int n = 0; n < 2; ++n) {
        const int row = row0 + wr * 64 + m * 16 + fr, col = col0 + wc * 32 + n * 16 + 4 * fq;
        const u32x2 yy = *(const u32x2*)(y + (size_t)row * 512 + col); const f32x4 v = acc[m][n];
        u32x2 o; o.x = pk2(bflo(yy.x) * sigmoidf_(v.x), bfhi(yy.x) * sigmoidf_(v.y)); o.y = pk2(bflo(yy.y) * sigmoidf_(v.z), bfhi(yy.y) * sigmoidf_(v.w));
        *(u32x2*)(ssm + (size_t)row * 512 + col) = o;
      }
  }
}
struct EpiInproj {
  static constexpr bool PERM = false, AFTER_DRAIN = false;
  bf16_t* qb; bf16_t* kvk; bf16_t* vT; bf16_t* mg; bf16_t* ub; float* gates;
  DI void operator()(const f32x4 (&acc)[2][2][4][2], const pg8::Unit& u, int wr, int wc, int fr_, int fq_) const {
    const int pn = u.pn; int fr = fr_, fq = fq_; asm volatile("" : "+v"(fr), "+v"(fq));
#pragma unroll
    for (int ai = 0; ai < 2; ++ai)
#pragma unroll
      for (int m = 0; m < 4; ++m) {
        const int row = u.pm * 256 + ai * 128 + wr * 64 + m * 16 + fr;
        const bool paired = pn < 4 || pn == 4 || pn == 5 || pn == 8 || (pn >= 10 && pn < 18);
#pragma unroll
        for (int bj = 0; bj < 2; ++bj) {
          if (paired) {
            const f32x4 v0 = acc[ai][bj][m][0], v1 = acc[ai][bj][m][1]; u32x2 o0, o1; bf16_t* dst;
            const int clw = bj * 128 + wc * 32 + widen16_col(fq);
            if (pn < 4) { o0.x = pk2(v0.x * QSCALE, v0.y * QSCALE); o0.y = pk2(v0.z * QSCALE, v0.w * QSCALE); o1.x = pk2(v1.x * QSCALE, v1.y * QSCALE); o1.y = pk2(v1.z * QSCALE, v1.w * QSCALE);
              dst = qb + (size_t)row * DM + pn * 256 + clw; }
            else if (pn < 10) { o0.x = pk2(v0.x, v0.y); o0.y = pk2(v0.z, v0.w); o1.x = pk2(v1.x, v1.y); o1.y = pk2(v1.z, v1.w);
              dst = kvk + (size_t)row * DM + (pn == 8 ? 3 : pn - 4) * 256 + clw; }
            else { o0.x = pk2(sigmoidf_(v0.x), sigmoidf_(v0.y)); o0.y = pk2(sigmoidf_(v0.z), sigmoidf_(v0.w)); o1.x = pk2(sigmoidf_(v1.x), sigmoidf_(v1.y)); o1.y = pk2(sigmoidf_(v1.z), sigmoidf_(v1.w));
              dst = mg + (size_t)row * 2048 + (pn - 10) * 256 + clw; }
            *(u32x4*)dst = widen16(o0, o1);
          } else
#pragma unroll
          for (int n = 0; n < 2; ++n) {
            const int cl = bj * 128 + wc * 32 + n * 16 + 4 * fq;
            const f32x4 v = acc[ai][bj][m][n];
            if (pn < 4) { u32x2 o; o.x = pk2(v.x * QSCALE, v.y * QSCALE); o.y = pk2(v.z * QSCALE, v.w * QSCALE); *(u32x2*)(qb + (size_t)row * DM + pn * 256 + cl) = o; }
            else if (pn < 10) {
              const int seg = pn - 4;
              if (seg == 5) {
                const int b = row >> 13, t = row & (SEQ - 1), g = cl >> 6, d = cl & 63;
                bf16_t* dst = vT + ((size_t)(((1 * NB + b) * 4 + g) * 64 + d)) * SEQ + perm16(t);
                dst[0] = (bf16_t)f2bf(v.x); dst[SEQ] = (bf16_t)f2bf(v.y); dst[2 * SEQ] = (bf16_t)f2bf(v.z); dst[3 * SEQ] = (bf16_t)f2bf(v.w);
              } else if (seg == 3) {
                const unsigned t = row & (SEQ - 1), pos = perm16(t) & 63;
                const unsigned ro = ((unsigned)(row >> 13) * 512u + (t >> 6)) * 4096u + (pos >> 3) * 256u + (pos & 7), co = (unsigned)(cl >> 6) * 524288u + (unsigned)((cl >> 5) & 1) * 2048u + (unsigned)(cl & 31) * 8u;
                bf16_t* dst = vT + (ro + co);
                dst[0] = (bf16_t)f2bf(v.x); dst[8] = (bf16_t)f2bf(v.y); dst[16] = (bf16_t)f2bf(v.z); dst[24] = (bf16_t)f2bf(v.w);
              } else if (seg == 2) {
                const unsigned t = row & (SEQ - 1);
                const unsigned ro = ((unsigned)(row >> 13) * 512u + (t >> 6)) * 4096u + ((t >> 5) & 1) * 2048u + (t & 31) * 8u, co = (unsigned)(cl >> 6) * 524288u + (unsigned)((cl >> 3) & 7) * 256u + (unsigned)(cl & 7);
                u32x2 o; o.x = pk2(v.x, v.y); o.y = pk2(v.z, v.w);
                *(u32x2*)(kvk + (WS_KSF - WS_C) / 2 + (ro + co)) = o;
              } else {
                const int slot = seg == 4 ? 3 : seg;
                u32x2 o; o.x = pk2(v.x, v.y); o.y = pk2(v.z, v.w); *(u32x2*)(kvk + (size_t)row * DM + slot * 256 + cl) = o;
              }
            } else if (pn < 18) {
              u32x2 o; o.x = pk2(sigmoidf_(v.x), sigmoidf_(v.y)); o.y = pk2(sigmoidf_(v.z), sigmoidf_(v.w)); *(u32x2*)(mg + (size_t)row * 2048 + (pn - 10) * 256 + cl) = o;
            } else if (pn < 20) { const int ch = (pn - 18) * 256 + cl; u32x2 o; o.x = pk2(v.x, v.y); o.y = pk2(v.z, v.w); *(u32x2*)(ub + ((size_t)(ch >> 4) * NT + row) * 16 + (ch & 15)) = o; }
            else { if (cl < 48) { f32x4 o = {sigmoidf_(v.x), sigmoidf_(v.y), sigmoidf_(v.z), sigmoidf_(v.w)}; *(f32x4*)(gates + (size_t)row * 48 + cl) = o; } }
          }
        }
      }
  }
};
DI void phase_inproj8(const Params& P_, unsigned char* lds) {
  Params P = P_; { size_t z_ = 0; asm volatile("" : "+s"(z_)); P.ws = P_.ws + z_; }
  pg8::Gemm g{(const bf16_t*)(P.ws + WS_A), (const bf16_t*)(P.ws + WS_W + W_IN), NT, 5120, DM};
  pg8::StaticOrder S; S.init(NT, 5120, gridDim.x, obid());
  EpiInproj E{(bf16_t*)(P.ws + WS_B), (bf16_t*)(P.ws + WS_C), (bf16_t*)(P.ws + WS_DV), (bf16_t*)(P.ws + WS_F), (bf16_t*)(P.ws + WS_E), (float*)(P.ws + WS_GATES)};
  pg8::gemm_phase<EpiInproj, pg8::StaticOrder, true, true>((PG8_LAS unsigned char*)lds, g, S, E);
}
struct EpiMerge1 {
  static constexpr bool PERM = false, AFTER_DRAIN = false;
  const bf16_t* mg; bf16_t* tmp;
  DI void operator()(const f32x4 (&acc)[2][2][4][2], const pg8::Unit& u, int wr, int wc, int fr, int fq) const {
#pragma unroll
    for (int ai = 0; ai < 2; ++ai) {
      u32x2 ga[4][2][2];
#pragma unroll
      for (int m = 0; m < 4; ++m)
#pragma unroll
        for (int bj = 0; bj < 2; ++bj)
#pragma unroll
          for (int n = 0; n < 2; ++n) {
            const int row = u.pm * 256 + ai * 128 + wr * 64 + m * 16 + fr, col = u.pn * 256 + bj * 128 + wc * 32 + n * 16 + 4 * fq;
            ga[m][bj][n] = *(const u32x2*)(mg + (size_t)row * 2048 + col);
          }
      __builtin_amdgcn_sched_barrier(0);
#pragma unroll
      for (int m = 0; m < 4; ++m)
#pragma unroll
        for (int bj = 0; bj < 2; ++bj)
#pragma unroll
          for (int n = 0; n < 2; ++n) {
            const int row = u.pm * 256 + ai * 128 + wr * 64 + m * 16 + fr, col = u.pn * 256 + bj * 128 + wc * 32 + n * 16 + 4 * fq;
            const f32x4 v = acc[ai][bj][m][n]; const u32x2 g = ga[m][bj][n];
            u32x2 o; o.x = pk2(v.x * bflo(g.x), v.y * bfhi(g.x)); o.y = pk2(v.z * bflo(g.y), v.w * bfhi(g.y));
            *(u32x2*)(tmp + (size_t)row * DM + col) = o;
          }
      __builtin_amdgcn_sched_barrier(0);
    }
  }
};
struct EpiMerge2 {
  static constexpr bool PERM = false, AFTER_DRAIN = false;
  const bf16_t* mg; const bf16_t* tmp; bf16_t* mer;
  DI void operator()(const f32x4 (&acc)[2][2][4][2], const pg8::Unit& u, int wr, int wc, int fr, int fq) const {
#pragma unroll
    for (int ai = 0; ai < 2; ++ai)
#pragma unroll
      for (int mh = 0; mh < 2; ++mh) {
        u32x2 gs[2][2][2], tv[2][2][2];
#pragma unroll
        for (int mm = 0; mm < 2; ++mm)
#pragma unroll
          for (int bj = 0; bj < 2; ++bj)
#pragma unroll
            for (int n = 0; n < 2; ++n) {
              const int row = u.pm * 256 + ai * 128 + wr * 64 + (mh * 2 + mm) * 16 + fr, col = u.pn * 256 + bj * 128 + wc * 32 + n * 16 + 4 * fq;
              gs[mm][bj][n] = *(const u32x2*)(mg + (size_t)row * 2048 + 1024 + col);
#if EN_ATTN
              tv[mm][bj][n] = *(const u32x2*)(tmp + (size_t)row * DM + col);
#else
              tv[mm][bj][n] = (u32x2){0u, 0u};
#endif
            }
        __builtin_amdgcn_sched_barrier(0);
#pragma unroll
        for (int mm = 0; mm < 2; ++mm)
#pragma unroll
          for (int bj = 0; bj < 2; ++bj)
#pragma unroll
            for (int n = 0; n < 2; ++n) {
              const int row = u.pm * 256 + ai * 128 + wr * 64 + (mh * 2 + mm) * 16 + fr, col = u.pn * 256 + bj * 128 + wc * 32 + n * 16 + 4 * fq;
              const f32x4 v = acc[ai][bj][mh * 2 + mm][n]; const u32x2 g = gs[mm][bj][n], t = tv[mm][bj][n];
              u32x2 o; o.x = pk2(bflo(t.x) + v.x * bflo(g.x), bfhi(t.x) + v.y * bfhi(g.x)); o.y = pk2(bflo(t.y) + v.z * bflo(g.y), bfhi(t.y) + v.w * bfhi(g.y));
              *(u32x2*)(mer + (size_t)row * DM + col) = o;
            }
        __builtin_amdgcn_sched_barrier(0);
      }
  }
};
DI void phase_merge8(const Params& P_, unsigned char* lds) {
  Params P = P_; { size_t z_ = 0; asm volatile("" : "+s"(z_)); P.ws = P_.ws + z_; }
#if EN_ATTN
  { pg8::Gemm g{(const bf16_t*)(P.ws + WS_A), (const bf16_t*)(P.ws + WS_W + W_O), NT, DM, DM};
    pg8::StaticOrder S; S.init(NT, DM, gridDim.x, obid());
    EpiMerge1 E{(const bf16_t*)(P.ws + WS_F), (bf16_t*)(P.ws + WS_C)};
    pg8::gemm_phase<EpiMerge1, pg8::StaticOrder, true, true>((PG8_LAS unsigned char*)lds, g, S, E); }
#endif
  { pg8::Gemm g{(const bf16_t*)(P.ws + WS_E), (const bf16_t*)(P.ws + WS_W + W_SO), NT, DM, 512};
    pg8::StaticOrder S; S.init(NT, DM, gridDim.x, obid());
    EpiMerge2 E{(const bf16_t*)(P.ws + WS_F), (const bf16_t*)(P.ws + WS_C), (bf16_t*)(P.ws + WS_B)};
    pg8::gemm_phase<EpiMerge2, pg8::StaticOrder, true, true>((PG8_LAS unsigned char*)lds, g, S, E); }
}
struct EpiWout {
  static constexpr bool PERM = false, AFTER_DRAIN = false;
  const float* mod; const float* xin; float* out;
  DI void operator()(const f32x4 (&acc)[2][2][4][2], const pg8::Unit& u, int wr, int wc, int fr, int fq) const {
    const int b = (u.pm * 256) >> 13;
    f32x4 g1[2][2];
#pragma unroll
    for (int bj = 0; bj < 2; ++bj)
#pragma unroll
      for (int n = 0; n < 2; ++n) g1[bj][n] = *(const f32x4*)(mod + (size_t)b * 6144 + 2048 + u.pn * 256 + bj * 128 + wc * 32 + n * 16 + 4 * fq);
#pragma unroll
    for (int ai = 0; ai < 2; ++ai)
#pragma unroll
      for (int mh = 0; mh < 2; ++mh) {
        f32x4 xv[2][2][2];
#pragma unroll
        for (int mm = 0; mm < 2; ++mm)
#pragma unroll
          for (int bj = 0; bj < 2; ++bj)
#pragma unroll
            for (int n = 0; n < 2; ++n) {
              const int row = u.pm * 256 + ai * 128 + wr * 64 + (mh * 2 + mm) * 16 + fr, col = u.pn * 256 + bj * 128 + wc * 32 + n * 16 + 4 * fq;
              xv[mm][bj][n] = *(const f32x4*)(xin + (size_t)row * DM + col);
            }
        __builtin_amdgcn_sched_barrier(0);
#pragma unroll
        for (int mm = 0; mm < 2; ++mm)
#pragma unroll
          for (int bj = 0; bj < 2; ++bj)
#pragma unroll
            for (int n = 0; n < 2; ++n) {
              const int row = u.pm * 256 + ai * 128 + wr * 64 + (mh * 2 + mm) * 16 + fr, col = u.pn * 256 + bj * 128 + wc * 32 + n * 16 + 4 * fq;
              *(f32x4*)(out + (size_t)row * DM + col) = xv[mm][bj][n] + g1[bj][n] * acc[ai][bj][mh * 2 + mm][n];
            }
        __builtin_amdgcn_sched_barrier(0);
      }
  }
};
DI void phase_wout8(const Params& P_, int l, unsigned char* lds) {
  Params P = P_; { size_t z_ = 0; asm volatile("" : "+s"(z_)); P.ws = P_.ws + z_; }
  pg8::Gemm g{(const bf16_t*)(P.ws + WS_B), (const bf16_t*)(P.ws + WS_W + W_OUT), NT, DM, DM};
  pg8::StaticOrder S; S.init(NT, DM, gridDim.x, obid());
  EpiWout E{(const float*)(P.ws + WS_MOD) + (size_t)(l * 2) * 6144, l == 0 ? P.in[0] : P.out, P.out};
  pg8::gemm_phase<EpiWout, pg8::StaticOrder, true, true>((PG8_LAS unsigned char*)lds, g, S, E);
}

struct MoeTab { int cv, pin; };
DI MoeTab moe_tab(const int* cnt) {
  const int lane = otid() & 63; MoeTab T; T.cv = cnt[lane & 31]; int p = (T.cv + 127) >> 7;
#pragma unroll
  for (int o = 1; o < 32; o <<= 1) { const int t = __shfl_up(p, o); if ((lane & 31) >= o) p += t; }
  T.pin = p; return T;
}
DI int moe_total(const MoeTab& T) { return __builtin_amdgcn_readlane(T.pin, 31); }
DI void moe_find(const MoeTab& T, int rb, int& e, int& rbl, int& ce) {
  const unsigned m = (unsigned)__ballot(T.pin <= rb);
  e = __popc(m); e = e < NEXP ? e : NEXP - 1;
  const int nb = (__shfl(T.cv, e) + 127) >> 7;
  ce = __shfl(T.cv, e); rbl = rb - (__shfl(T.pin, e) - nb);
  e = __builtin_amdgcn_readfirstlane(e); rbl = __builtin_amdgcn_readfirstlane(rbl); ce = __builtin_amdgcn_readfirstlane(ce);
}
DI void phase_moe1(const Params& P_, int l, unsigned char* lds) {
  Params P = P_; { size_t z_ = 0; asm volatile("" : "+s"(z_)); P.ws = P_.ws + z_; }
  TILE_IDS;
  const int* cnt = (const int*)(P.ws + WS_CNT) + l * 32; const int* list = (const int*)(P.ws + WS_LIST);
  const bf16_t* h2 = (const bf16_t*)(P.ws + WS_A); bf16_t* act = (bf16_t*)(P.ws + WS_B);
  const MoeTab MT = moe_tab(cnt); const int total = moe_total(MT);
  const int G_ = gridDim.x, nx_ = (G_ % 8 == 0) ? 8 : 1, xg_ = bid % nx_, xs_ = bid / nx_, xb0_ = (int)((long)total * xg_ / nx_), xb1_ = (int)((long)total * (xg_ + 1) / nx_);
  for (int tl = xs_; tl < (xb1_ - xb0_) * 4; tl += G_ / nx_) {
    const int rb = xb0_ + (tl >> 2), ct = tl & 3; int e = 0, rbl = 0, ce = 1; moe_find(MT, rb, e, rbl, ce);
    const bf16_t* wt = (const bf16_t*)(P.ws + WS_W + W_GU) + (size_t)e * 512 * 1024 + (size_t)(ct * 128) * 1024;
    const bf16_t* ap[2];
#pragma unroll
    for (int i = 0; i < 2; ++i) { int idx = rbl * 128 + lr + 64 * i; idx = idx < ce ? idx : ce - 1; const int tok = list[e * LISTCAP + idx] >> 1; ap[i] = h2 + (size_t)tok * DM + lk; }
    f32x4 acc[4][2]; ACC_ZERO(acc);
    gemm_kloop(lds, ap[0], ap[1], 64, wt + (size_t)lr * DM + lk, wt + (size_t)(lr + 64) * DM + lk, 16, acc);
#pragma unroll
    for (int m = 0; m < 4; ++m) {
      const int arow = rb * 128 + wr * 64 + m * 16 + fr, col = ct * 64 + wc * 16 + 4 * fq;
      const f32x4 g = acc[m][0], u = acc[m][1];
      u32x2 o; o.x = pk2(g.x * sigmoidf_(g.x) * u.x, g.y * sigmoidf_(g.y) * u.y); o.y = pk2(g.z * sigmoidf_(g.z) * u.z, g.w * sigmoidf_(g.w) * u.w);
      *(u32x2*)(act + (size_t)arow * 256 + col) = o;
    }
  }
}
DI void phase_moe2(const Params& P_, int l, unsigned char* lds) {
  Params P = P_; { size_t z_ = 0; asm volatile("" : "+s"(z_)); P.ws = P_.ws + z_; }
  TILE_IDS;
  const int* cnt = (const int*)(P.ws + WS_CNT) + l * 32; const int* list = (const int*)(P.ws + WS_LIST); const float* wts = (const float*)(P.ws + WS_WT);
  const bf16_t* act = (const bf16_t*)(P.ws + WS_B); bf16_t* ys = (bf16_t*)(P.ws + WS_F);
  constexpr int ASUB = 128 * GT_ROWB, BOFF = 4 * ASUB;
  const MoeTab MT = moe_tab(cnt); const int total = moe_total(MT);
  const int lkb = (tid & 7) * 16;
  const int G_ = gridDim.x, nx_ = (G_ % 8 == 0) ? 8 : 1, xg_ = bid % nx_, xs_ = bid / nx_, xb0_ = (int)((long)total * xg_ / nx_), xb1_ = (int)((long)total * (xg_ + 1) / nx_);
  for (int tl = xs_; tl < (xb1_ - xb0_) * 4; tl += G_ / nx_) {
    const int rb = xb0_ + (tl >> 2), ct0 = (tl & 3) * 2; int e = 0, rbl = 0, ce = 1; moe_find(MT, rb, e, rbl, ce);
    const bf16_t* wt = (const bf16_t*)(P.ws + WS_W + W_D) + (size_t)e * 1024 * 256;
    const bf16_t* a0 = act + (size_t)(rb * 128 + lr) * 256 + lk; const bf16_t* a1 = a0 + 64 * 256;
    u32x4 ra[8], bq[8][2];
#pragma unroll
    for (int k = 0; k < 4; ++k) { ra[2 * k] = *(const u32x4*)(a0 + 64 * k); ra[2 * k + 1] = *(const u32x4*)(a1 + 64 * k); }
#define M2_BLOAD(q0_, q1_, s_) do { const bf16_t* bp_ = wt + (size_t)((ct0 + ((s_) >> 2)) * 128 + lr) * 256 + ((s_) & 3) * 64 + lk; q0_ = *(const u32x4*)bp_; q1_ = *(const u32x4*)(bp_ + 64 * 256); } while (0)
#define M2_BSTORE(q0_, q1_, buf_) do { unsigned char* s_ = lds + BOFF + (buf_) * ASUB; *(u32x4*)(s_ + GT_WOFF(lr, tid)) = q0_; *(u32x4*)(s_ + 64 * GT_ROWB + GT_WOFF(lr, tid)) = q1_; } while (0)
#define M2_COMPUTE(s_, buf_) do { \
      const unsigned char* As = lds + ((s_) & 3) * ASUB + (wr * 64 + fr) * GT_ROWB; \
      const unsigned char* Bs = lds + BOFF + (buf_) * ASUB + (wc * 32 + fr) * GT_ROWB; \
      _Pragma("unroll") for (int ks = 0; ks < 2; ++ks) { \
        bf16x8 af[4], bfr[2]; \
        _Pragma("unroll") for (int m = 0; m < 4; ++m) af[m] = *(const bf16x8*)(As + m * 16 * GT_ROWB + GT_RSW(ks, fq, fr)); \
        _Pragma("unroll") for (int n = 0; n < 2; ++n) bfr[n] = *(const bf16x8*)(Bs + n * 16 * GT_ROWB + GT_RSW(ks, fq, fr)); \
        _Pragma("unroll") for (int m = 0; m < 4; ++m) _Pragma("unroll") for (int n = 0; n < 2; ++n) acc[m][n] = __builtin_amdgcn_mfma_f32_16x16x32_bf16(bfr[n], af[m], acc[m][n], 0, 0, 0); } } while (0)
#define M2_EPI(ct_) do { _Pragma("unroll") for (int m = 0; m < 4; ++m) { const int idx = rbl * 128 + wr * 64 + m * 16 + fr; \
      const int slot = eslot[m]; const float w_ = ewt[m]; const f32x4 v0 = acc[m][0] * w_, v1 = acc[m][1] * w_; \
      u32x2 o0, o1; o0.x = pk2(v0.x, v0.y); o0.y = pk2(v0.z, v0.w); o1.x = pk2(v1.x, v1.y); o1.y = pk2(v1.z, v1.w); \
      const u32x4 ow_ = widen16(o0, o1);                          \
      if (idx < ce) *(u32x4*)(ys + (size_t)slot * DM + (ct_) * 128 + wc * 32 + widen16_col(fq)) = ow_; } ACC_ZERO(acc); } while (0)
    int eslot[4]; float ewt[4];
#pragma unroll
    for (int m = 0; m < 4; ++m) { int idx = rbl * 128 + wr * 64 + m * 16 + fr; idx = idx < ce ? idx : ce - 1; eslot[m] = list[e * LISTCAP + idx]; }
#pragma unroll
    for (int s2 = 0; s2 < 8; ++s2) M2_BLOAD(bq[s2][0], bq[s2][1], s2);
#pragma unroll
    for (int m = 0; m < 4; ++m) ewt[m] = wts[eslot[m]];
#pragma unroll
    for (int k = 0; k < 4; ++k) { *(u32x4*)(lds + k * ASUB + GT_WOFF(lr, tid)) = ra[2 * k]; *(u32x4*)(lds + k * ASUB + 64 * GT_ROWB + GT_WOFF(lr, tid)) = ra[2 * k + 1]; }
    M2_BSTORE(bq[0][0], bq[0][1], 0);
    __syncthreads();
    f32x4 acc[4][2]; ACC_ZERO(acc);
#pragma unroll
    for (int s2 = 0; s2 < 8; ++s2) {
      M2_COMPUTE(s2, s2 & 1);
      if (s2 + 1 < 8) M2_BSTORE(bq[s2 + 1][0], bq[s2 + 1][1], (s2 + 1) & 1);
      if (s2 == 3) M2_EPI(ct0);
      if (s2 == 7) M2_EPI(ct0 + 1);
      __syncthreads();
    }
#undef M2_BLOAD
#undef M2_BSTORE
#undef M2_COMPUTE
#undef M2_EPI
  }
}

typedef float f32x2v __attribute__((ext_vector_type(2)));
DI void phase_s5a(const Params& P_, int l, unsigned char* lds) {
  Params P = P_; { size_t z_ = 0; asm volatile("" : "+s"(z_)); P.ws = P_.ws + z_; }
  TILE_IDS;
  const bf16_t* ub = (const bf16_t*)(P.ws + WS_E); float* Lb = (float*)(P.ws + WS_L);
  const bf16_t* M1 = (const bf16_t*)(P.ws + WS_TAB + (size_t)l * TAB_LAYER + TAB_M1);
  const int first = (int)gridDim.x >= 192 ? 128 : 0;
  for (int tile = bid - first; tile >= 0 && tile < 64; tile += gridDim.x) {
    const int g = tile >> 1, rt = tile & 1;
    const bf16_t* a = ub + ((size_t)g * NT / 64 + rt * 128) * 1024;
    const bf16_t* wt = M1 + (size_t)g * 128 * 1024;
    f32x4 acc[4][2]; ACC_ZERO(acc);
    gemm_kloop(lds, a + (size_t)lr * 1024 + lk, a + (size_t)(lr + 64) * 1024 + lk, 64, wt + (size_t)lr * 1024 + lk, wt + (size_t)(lr + 64) * 1024 + lk, 16, acc);
#pragma unroll
    for (int m = 0; m < 4; ++m)
#pragma unroll
      for (int n = 0; n < 2; ++n) {
        const int R = rt * 128 + wr * 64 + m * 16 + fr, comp = wc * 32 + n * 16 + 4 * fq;
        *(f32x4*)(Lb + ((size_t)(R * 32 + g) * 64) * 2 + comp) = acc[m][n];
      }
  }
}
DI void s5_carry(const Params& P_, int l) {
  Params P = P_; { size_t z_ = 0; asm volatile("" : "+s"(z_)); P.ws = P_.ws + z_; }
  const int tid_ = otid(), bid = obid(), wave = tid_ >> 6, lane = tid_ & 63;
  const int item = (gridDim.x * NWAVE - 1) - (bid * NWAVE + wave);
  if (item >= NB * 32) return;
  const int b = item >> 5, g = item & 31;
  const float* pp = (const float*)(P.ws + WS_S5P) + (size_t)((l * 32 + g) * 64 + lane) * 36;
  const float aTr = pp[2], aTi = pp[3];
  float2* Lp = (float2*)(P.ws + WS_L) + ((size_t)(b * 128) * 32 + g) * 64 + lane;
  unsigned* Sp = (unsigned*)(P.ws + WS_SIN) + ((size_t)(g * 256 + b * 128)) * 64 + lane;
  float sr = 0.f, si = 0.f; asm volatile("" : "+v"(sr), "+v"(si));
  float2 va[8], vb[8];
#define CY_LOAD(vv, c0_) do { _Pragma("unroll") for (int k = 0; k < 8; ++k) vv[k] = Lp[(size_t)((c0_) + k) * 2048]; } while (0)
#define CY_STEP(vv, c0_) do { _Pragma("unroll") for (int k = 0; k < 8; ++k) { Lp[(size_t)((c0_) + k) * 2048] = make_float2(sr, si); Sp[(size_t)((c0_) + k) * 64] = pk2(sr, si); \
      const float nr = aTr * sr - aTi * si + vv[k].x, ni = aTr * si + aTi * sr + vv[k].y; sr = nr; si = ni; } } while (0)
#define CY_PIN(vv) do { _Pragma("unroll") for (int k = 0; k < 8; ++k) asm volatile("" : "+v"(vv[k].x), "+v"(vv[k].y)); } while (0)
  CY_LOAD(va, 0);
#pragma unroll
  for (int c0 = 0; c0 < 128; c0 += 16) {
    CY_LOAD(vb, c0 + 8);
    CY_PIN(va);
    CY_STEP(va, c0);
    if (c0 + 16 < 128) CY_LOAD(va, c0 + 16);
    CY_PIN(vb);
    CY_STEP(vb, c0 + 8);
  }
#undef CY_PIN
#undef CY_LOAD
#undef CY_STEP
}
DI void phase_s5c(const Params& P_, int l, unsigned char* lds) {
  Params P = P_; { size_t z_ = 0; asm volatile("" : "+s"(z_)); P.ws = P_.ws + z_; }
  TILE_IDS;
  const bf16_t* ub = (const bf16_t*)(P.ws + WS_E); const bf16_t* sinb = (const bf16_t*)(P.ws + WS_SIN); bf16_t* yb = (bf16_t*)(P.ws + WS_G);
  const bf16_t* tab = (const bf16_t*)(P.ws + WS_TAB + (size_t)l * TAB_LAYER);
  int* dctr = (int*)(P.ws + 640) + l; int* dslot = (int*)(lds + LDS_BYTES - 32);
  constexpr int ROWB = GT_ROWB, SA = 0, SB = 128 * ROWB, STAGE = 2 * 128 * ROWB;
  const int lkb = (tid & 7) * 16, kch = tid & 7;
  for (;;) {
    if (threadIdx.x == 0) *dslot = atomicAdd(dctr, 1);
    __syncthreads();
    const int tile = *dslot;
    __syncthreads();
    if (tile >= 512) break;
    const int g = tile >> 4, rt = (tile >> 3) & 1, ct = tile & 7;
    const bf16_t* Kt = tab + TAB_KT / 2 + (size_t)g * 64 * 256; const bf16_t* M2 = tab + TAB_M2 / 2 + (size_t)g * 1024 * 128;
    const bf16_t* ua = ub + ((size_t)g * 256 + rt * 128) * 1024; const bf16_t* sa = sinb + ((size_t)g * 256 + rt * 128) * 128;
    const int nbt = 2 * ct + 2 < 16 ? 2 * ct + 2 : 16, ns = nbt + 2;
    u32x4 xa0, xa1, xb0, xb1, ya0, ya1, yb0, yb1;
#define S5_LOAD(p0_, p1_, q0_, q1_, s_) do { \
      if ((s_) < nbt) { p0_ = *(const u32x4*)(ua + (size_t)lr * 1024 + (s_) * 64 + lk); p1_ = *(const u32x4*)(ua + (size_t)(lr + 64) * 1024 + (s_) * 64 + lk); \
        const int i_ = 4 * (s_) + (kch >> 1), hq_ = (kch & 1) * 8; \
        { const int t_ = 8 * ct + (lr >> 4), h_ = lr & 15; q0_ = t_ >= i_ ? *(const u32x4*)(Kt + ((t_ - i_) * 16 + h_) * 16 + hq_) : (u32x4){0u, 0u, 0u, 0u}; } \
        { const int t_ = 8 * ct + 4 + (lr >> 4), h_ = lr & 15; q1_ = t_ >= i_ ? *(const u32x4*)(Kt + ((t_ - i_) * 16 + h_) * 16 + hq_) : (u32x4){0u, 0u, 0u, 0u}; } \
      } else { const int k0_ = ((s_) - nbt) * 64 + lk; \
        p0_ = *(const u32x4*)(sa + (size_t)lr * 128 + k0_); p1_ = *(const u32x4*)(sa + (size_t)(lr + 64) * 128 + k0_); \
        q0_ = *(const u32x4*)(M2 + (size_t)(ct * 128 + lr) * 128 + k0_); q1_ = *(const u32x4*)(M2 + (size_t)(ct * 128 + lr + 64) * 128 + k0_); } } while (0)
#define S5_STORE(p0_, p1_, q0_, q1_, buf) do { unsigned char* s_ = lds + (buf) * STAGE; \
      *(u32x4*)(s_ + SA + GT_WOFF(lr, tid)) = p0_; *(u32x4*)(s_ + SA + 64 * ROWB + GT_WOFF(lr, tid)) = p1_; \
      *(u32x4*)(s_ + SB + GT_WOFF(lr, tid)) = q0_; *(u32x4*)(s_ + SB + 64 * ROWB + GT_WOFF(lr, tid)) = q1_; } while (0)
#define S5_COMPUTE(buf) do { \
      const unsigned char* As = lds + (buf) * STAGE + SA + (wr * 64 + fr) * ROWB; \
      const unsigned char* Bs = lds + (buf) * STAGE + SB + (wc * 32 + fr) * ROWB; \
      _Pragma("unroll") for (int ks = 0; ks < 2; ++ks) { \
        bf16x8 af[4], bfr[2]; \
        _Pragma("unroll") for (int m = 0; m < 4; ++m) af[m] = *(const bf16x8*)(As + m * 16 * ROWB + GT_RSW(ks, fq, fr)); \
        _Pragma("unroll") for (int n = 0; n < 2; ++n) bfr[n] = *(const bf16x8*)(Bs + n * 16 * ROWB + GT_RSW(ks, fq, fr)); \
        _Pragma("unroll") for (int m = 0; m < 4; ++m) _Pragma("unroll") for (int n = 0; n < 2; ++n) acc[m][n] = __builtin_amdgcn_mfma_f32_16x16x32_bf16(bfr[n], af[m], acc[m][n], 0, 0, 0); } } while (0)
    f32x4 acc[4][2]; ACC_ZERO(acc);
    S5_LOAD(xa0, xa1, xb0, xb1, 0); S5_STORE(xa0, xa1, xb0, xb1, 0); S5_LOAD(ya0, ya1, yb0, yb1, 1); __syncthreads();
    for (int st = 0; st < ns; st += 2) {
      if (st + 2 < ns) S5_LOAD(xa0, xa1, xb0, xb1, st + 2);
      S5_COMPUTE(0);
      if (st + 1 < ns) S5_STORE(ya0, ya1, yb0, yb1, 1);
      __syncthreads();
      if (st + 1 >= ns) break;
      if (st + 3 < ns) S5_LOAD(ya0, ya1, yb0, yb1, st + 3);
      S5_COMPUTE(1);
      if (st + 2 < ns) S5_STORE(xa0, xa1, xb0, xb1, 0);
      __syncthreads();
    }
#undef S5_LOAD
#undef S5_STORE
#undef S5_COMPUTE
    const float* dsk = P.in[13] + (size_t)(l * 32 + g) * 16;
#pragma unroll
    for (int m = 0; m < 4; ++m)
#pragma unroll
      for (int n = 0; n < 2; ++n) {
        const int R = rt * 128 + wr * 64 + m * 16 + fr, col = ct * 128 + wc * 32 + n * 16 + 4 * fq, t = col >> 4, h = col & 15;
        const u32x2 uu = *(const u32x2*)(ub + ((size_t)g * 256 + R) * 1024 + col); const f32x4 dd = *(const f32x4*)(dsk + h); const f32x4 v = acc[m][n];
        const float y0 = gelu_tanh(v.x + dd.x * bflo(uu.x)), y1 = gelu_tanh(v.y + dd.y * bfhi(uu.x)), y2 = gelu_tanh(v.z + dd.z * bflo(uu.y)), y3 = gelu_tanh(v.w + dd.w * bfhi(uu.y));
        const size_t tokn = (size_t)(R >> 7) * SEQ + 64 * (R & 127) + t;
        u32x2 o; o.x = pk2(y0, y1); o.y = pk2(y2, y3); *(u32x2*)(yb + tokn * 512 + g * 16 + h) = o;
      }
  }
}

constexpr int AT_ROWB = 144, AT_KS = 0, AT_VS = 2 * 64 * AT_ROWB, AT_IMP = 4 * 64 * AT_ROWB, AT_OACC = AT_IMP, AT_IMPS = 129, AT_EE = AT_IMP + 64 * AT_IMPS * 4,
              AT_SEL = AT_IMP + 66048, AT_QS = AT_SEL + 1024, AT_QL = AT_QS + 32768, AT_NJ = AT_QL + 8192, AT_ITEMS = AT_NJ + 512, AT_MREF = AT_ITEMS + 512,
              AT_LACC = AT_MREF + 1024, AT_INVQ = AT_LACC + 1024, AT_MISC = AT_INVQ + 512, AT_LOWN = AT_MISC + 64, AT_END = AT_LOWN + 1024;
static_assert(AT_END <= LDS_BYTES - 16, "attention LDS");
#define MFMA32(a, b, c) __builtin_amdgcn_mfma_f32_32x32x16_bf16((a), (b), (c), 0, 0, 0)
DI int crow_of(int reg, int hh) { return (reg & 3) + 8 * (reg >> 2) + 4 * hh; }

struct AttnState { f32x16 o0, o1; float m, l; };
DI void st_init(AttnState& S) { S.m = -1e30f; S.l = 0.f;
#pragma unroll
  for (int i = 0; i < 16; ++i) { S.o0[i] = 0.f; S.o1[i] = 0.f; } }

DI void at_ldk(const unsigned char* lds, int buf, int r, int hh, bf16x8 (&kf)[8]) {
  const unsigned char* kb = lds + AT_KS + buf * 64 * AT_ROWB + r * AT_ROWB + hh * 16;
#pragma unroll
  for (int ds = 0; ds < 4; ++ds) { kf[ds] = *(const bf16x8*)(kb + ds * 32); kf[4 + ds] = *(const bf16x8*)(kb + 32 * AT_ROWB + ds * 32); }
}
DI void at_ldv(const unsigned char* lds, int buf, int r, int hh, bf16x8 (&vf)[8]) {
  const unsigned char* vb = lds + AT_VS + buf * 64 * AT_ROWB + r * AT_ROWB + hh * 16;
#pragma unroll
  for (int gk = 0; gk < 4; ++gk) { vf[gk] = *(const bf16x8*)(vb + gk * 32); vf[4 + gk] = *(const bf16x8*)(vb + 32 * AT_ROWB + gk * 32); }
}
DI void at_qk(const bf16x8 (&kf)[8], const bf16x8 (&qf)[4], f32x16& p0, f32x16& p1) {
  const f32x16 z = {0.f, 0.f, 0.f, 0.f, 0.f, 0.f, 0.f, 0.f, 0.f, 0.f, 0.f, 0.f, 0.f, 0.f, 0.f, 0.f};
#pragma unroll
  for (int ds = 0; ds < 4; ++ds) { if (ds == 0) { p0 = MFMA32(kf[0], qf[0], z); p1 = MFMA32(kf[4], qf[0], z); } else { p0 = MFMA32(kf[ds], qf[ds], p0); p1 = MFMA32(kf[4 + ds], qf[ds], p1); } }
}
DI bf16x8 pack8(const f32x16& p, int s2) {
  u32x4 w; w.x = pk2(p[8 * s2], p[8 * s2 + 1]); w.y = pk2(p[8 * s2 + 2], p[8 * s2 + 3]); w.z = pk2(p[8 * s2 + 4], p[8 * s2 + 5]); w.w = pk2(p[8 * s2 + 6], p[8 * s2 + 7]);
  return __builtin_bit_cast(bf16x8, w);
}
DI void at_pv(const bf16x8 (&vf)[8], const f32x16& p0, const f32x16& p1, f32x16& oa, f32x16& ob) {
#pragma unroll
  for (int gk = 0; gk < 4; ++gk) {
    const bf16x8 pb = (gk < 2) ? pack8(p0, gk & 1) : pack8(p1, gk & 1);
    oa = MFMA32(vf[gk], pb, oa); ob = MFMA32(vf[4 + gk], pb, ob);
  }
}
template <int MODE>
DI void at_online(AttnState& S, f32x16& p0, f32x16& p1, int key0, int lo, int hi, bool on, int hh) {
  float tm = -1e30f;
  if (MODE == 1 && on) {
    int lor = lo - key0 - 4 * hh, hir = hi - key0 - 4 * hh;
    if (hir < lor) { lor = 4096; hir = 4096; }
    const unsigned span = (unsigned)(hir - lor);
#pragma unroll
    for (int i = 0; i < 16; ++i) { const int c0 = (i & 3) + 8 * (i >> 2);
      p0[i] = ((unsigned)(c0 - lor) <= span) ? p0[i] : -1e30f; p1[i] = ((unsigned)(c0 + 32 - lor) <= span) ? p1[i] : -1e30f; }
  }
  asm volatile("s_nop 15\n\ts_nop 7" : "+v"(tm) : "v"(p0[15]), "v"(p1[15]));
#define MX3_8(o_) asm("v_max3_f32 %0, %0, %1, %2\n\tv_max3_f32 %0, %0, %3, %4\n\tv_max3_f32 %0, %0, %5, %6\n\tv_max3_f32 %0, %0, %7, %8\n\tv_max3_f32 %0, %0, %9, %10\n\tv_max3_f32 %0, %0, %11, %12\n\tv_max3_f32 %0, %0, %13, %14\n\tv_max3_f32 %0, %0, %15, %16" \
      : "+v"(tm) : "v"(p0[o_]), "v"(p1[o_]), "v"(p0[o_ + 1]), "v"(p1[o_ + 1]), "v"(p0[o_ + 2]), "v"(p1[o_ + 2]), "v"(p0[o_ + 3]), "v"(p1[o_ + 3]), "v"(p0[o_ + 4]), "v"(p1[o_ + 4]), "v"(p0[o_ + 5]), "v"(p1[o_ + 5]), "v"(p0[o_ + 6]), "v"(p1[o_ + 6]), "v"(p0[o_ + 7]), "v"(p1[o_ + 7]))
  MX3_8(0); MX3_8(8);
#undef MX3_8
  tm = x32_max(tm);
  if (MODE == 2) tm = on ? tm : -1e30f;
  { const float mn = fmaxf(S.m, tm); const float al = __builtin_amdgcn_exp2f(S.m - mn); S.m = mn; S.l *= al;
#pragma unroll
    for (int i = 0; i < 16; ++i) { S.o0[i] *= al; S.o1[i] *= al; } }
  float mn = S.m;
  if (MODE == 2) mn = on ? mn : 1e30f;
  if (MODE == 1) mn = mn < -1e29f ? 1e30f : mn;
  float rs = 0.f;
#pragma unroll
  for (int i = 0; i < 16; ++i) {
    const float e0 = __builtin_amdgcn_exp2f(p0[i] - mn), e1 = __builtin_amdgcn_exp2f(p1[i] - mn);
    p0[i] = e0; p1[i] = e1; rs += e0 + e1;
  }
  S.l += rs;
}

DI void attn_tile(const Params& P_, unsigned char* lds, int b, int g, int c) {
  Params P = P_; { size_t z_ = 0; asm volatile("" : "+s"(z_)); P.ws = P_.ws + z_; }
#define AT_IDS const int tid = otid(), lane = tid & 63, w = tid >> 6, r = lane & 31, hh = lane >> 5, qi = 8 * w + (r >> 2), h = r & 3, t = 64 * c + qi, qrow = 32 * w + r, srow = tid >> 3, sch = (tid & 7) * 8, ahead = lane >> 4, ach = lane & 15; const unsigned tok = (unsigned)b * SEQ + t, goff = tok * 48 + g * 4 + h; (void)qi; (void)h; (void)t; (void)qrow; (void)srow; (void)sch; (void)ahead; (void)ach; (void)tok; (void)goff; (void)hh; (void)w; (void)r
  const bf16_t* qb = (const bf16_t*)(P.ws + WS_B); const bf16_t* kvk = (const bf16_t*)(P.ws + WS_C); const bf16_t* vT = (const bf16_t*)(P.ws + WS_DV);
  const bf16_t* kcb = (const bf16_t*)(P.ws + WS_KC); const bf16_t* vcb = (const bf16_t*)(P.ws + WS_VC);
  const float* gbase = (const float*)(P.ws + WS_GATES);
#define gates(i) gbase[goff + (i)]
  bf16_t* attn = (bf16_t*)(P.ws + WS_A);
  float* otb = (float*)(P.ws + WS_OT) + (size_t)obid() * 16384;
#define otg(i) otb[(unsigned)tid + (i) * 512u]
  float* IMP = (float*)(lds + AT_IMP); float* EE = (float*)(lds + AT_EE); unsigned* SEL = (unsigned*)(lds + AT_SEL);
  AttnState S; f32x16 p0, p1; u32x4 rkA, rvA; bf16x8 qf[4], kfr[8], vfr[8];
#define QF_LOAD() do { _Pragma("unroll") for (int ds_ = 0; ds_ < 4; ++ds_) qf[ds_] = *(const bf16x8*)(lds + AT_QS + qrow * 128 + (((ds_ * 2 + hh) ^ (qrow & 7)) * 16)); } while (0)
#define AT_QKV() do { at_ldk(lds, buf_, r, hh, kfr); __builtin_amdgcn_sched_barrier(0); at_qk(kfr, qf, p0, p1); at_ldv(lds, buf_, r, hh, vfr); __builtin_amdgcn_sched_barrier(0); } while (0)
  { AT_IDS;
  { const int row = tid >> 1, half = tid & 1, q_i = row >> 2, hd = row & 3;
    const unsigned so = ((unsigned)b * SEQ + 64 * c + q_i) * DM + (g * 4 + hd) * 64 + half * 32;
#pragma unroll
    for (int k = 0; k < 4; ++k) { const u32x4 v = *(const u32x4*)(qb + so + k * 8); *(u32x4*)(lds + AT_QS + row * 128 + (((half * 4 + k) ^ (row & 7)) * 16)) = v; } }
  __syncthreads();
  QF_LOAD();
#define ST_LOAD(rk, rv, kp, kstride, vp, vstride, kt) do { rk = *(const u32x4*)((kp) + (unsigned)(((kt) * 64 + srow) * (kstride) + sch)); rv = *(const u32x4*)((vp) + (unsigned)(srow * (vstride) + (kt) * 64 + sch)); } while (0)
#define ST_STORE(rk, rv, buf) do { *(u32x4*)(lds + AT_KS + (buf) * 64 * AT_ROWB + srow * AT_ROWB + sch * 2) = rk; *(u32x4*)(lds + AT_VS + (buf) * 64 * AT_ROWB + srow * AT_ROWB + sch * 2) = rv; } while (0)
#define SWEEP(kp, kstride, vp, vstride, kt0, n, ...) do { \
    ST_LOAD(rkA, rvA, kp, kstride, vp, vstride, (kt0)); ST_STORE(rkA, rvA, 0); __syncthreads(); \
    for (int i_ = 0; i_ < (n); ++i_) { \
      if (i_ + 1 < (n)) ST_LOAD(rkA, rvA, kp, kstride, vp, vstride, (kt0) + i_ + 1); \
      { const int step_ = i_; const int buf_ = i_ & 1; __VA_ARGS__ } \
      if (i_ + 1 < (n)) ST_STORE(rkA, rvA, (i_ + 1) & 1); \
      __syncthreads(); \
    } } while (0)
#define ST_LOADF(rk, rv, kt) do { rk = *(const u32x4*)(kps + (size_t)(kt) * 4096 + tid * 8); rv = *(const u32x4*)(vps + (size_t)(kt) * 4096 + tid * 8); } while (0)
#define ST_STOREF(rk, rv, buf) do { const int fo_ = ((tid >> 8) * 32 + (tid & 31)) * AT_ROWB + (((tid >> 6) & 3) * 2 + ((tid >> 5) & 1)) * 16; \
    *(u32x4*)(lds + AT_KS + (buf) * 64 * AT_ROWB + fo_) = rk; *(u32x4*)(lds + AT_VS + (buf) * 64 * AT_ROWB + fo_) = rv; } while (0)
#define SWEEPF(kt0, n, ...) do { \
    ST_LOADF(rkA, rvA, (kt0)); ST_STOREF(rkA, rvA, 0); __syncthreads(); \
    for (int i_ = 0; i_ < (n); ++i_) { \
      if (i_ + 1 < (n)) ST_LOADF(rkA, rvA, (kt0) + i_ + 1); \
      { const int step_ = i_; const int buf_ = i_ & 1; __VA_ARGS__ } \
      if (i_ + 1 < (n)) ST_STOREF(rkA, rvA, (i_ + 1) & 1); \
      __syncthreads(); \
    } } while (0)
  {
    const bf16_t* kp = kvk + (size_t)b * SEQ * DM + 3 * 256 + g * 64; const bf16_t* vp = vT + (size_t)(((1 * NB + b) * 4 + g) * 64) * SEQ;
    const int j0 = c >= 8 ? c - 8 : 0, nj = c - j0 + 1;
    st_init(S);
    SWEEP(kp, DM, vp, SEQ, j0, nj, {
      AT_QKV();
      at_online<1>(S, p0, p1, (j0 + step_) * 64, t - 511, t, (step_ == 0 && c >= 8) || step_ == nj - 1, hh);
      at_pv(vfr, p0, p1, S.o0, S.o1); });
    const float lt = x32_sum(S.l); const float sc = lt > 0.f ? gates(32) / lt : 0.f;
#pragma unroll
    for (int i = 0; i < 16; ++i) { otg(i) = S.o0[i] * sc; otg(16 + i) = S.o1[i] * sc; }
  }
  {
    const bf16_t* kcp = kcb + (size_t)((b * 4 + g) * 512) * 64; const bf16_t* vcp = vcb + (size_t)((b * 4 + g) * 64) * 512;
    const int nmax = t >= 31 ? (t - 31) >> 4 : -1;
    const int nct = (4 * c + 2) / 64 + 1;
    st_init(S);
    SWEEP(kcp, 64, vcp, 512, 0, nct, {
      at_ldk(lds, buf_, r, hh, kfr); __builtin_amdgcn_sched_barrier(0); at_qk(kfr, qf, p0, p1);
      at_online<1>(S, p0, p1, step_ * 64, 0, nmax, 64 * step_ + 63 > 4 * c - 2, hh); });
    const float lt = x32_sum(S.l);
    const float cinv = lt > 0.f ? 1.f / lt : 0.f; const float cm = S.m;
    st_init(S);
    SWEEP(kcp, 64, vcp, 512, 0, nct, {
      AT_QKV();
      if (64 * step_ + 63 <= 4 * c - 2) {
        _Pragma("unroll") for (int k = 0; k < 16; ++k) { p0[k] = __builtin_amdgcn_exp2f(p0[k] - cm) * cinv; p1[k] = __builtin_amdgcn_exp2f(p1[k] - cm) * cinv; }
      } else {
        const int nrel = nmax - step_ * 64 - 4 * hh;
        _Pragma("unroll") for (int k = 0; k < 16; ++k) { const int c0 = (k & 3) + 8 * (k >> 2), c1 = c0 + 32;
          p0[k] = c0 <= nrel ? __builtin_amdgcn_exp2f(p0[k] - cm) * cinv : 0.f; p1[k] = c1 <= nrel ? __builtin_amdgcn_exp2f(p1[k] - cm) * cinv : 0.f; }
      }
      at_pv(vfr, p0, p1, S.o0, S.o1);
      _Pragma("unroll") for (int kh = 0; kh < 2; ++kh)
      _Pragma("unroll") for (int gi = 0; gi < 4; ++gi) {
          float g4 = kh == 0 ? (p0[4 * gi] + p0[4 * gi + 1]) + (p0[4 * gi + 2] + p0[4 * gi + 3]) : (p1[4 * gi] + p1[4 * gi + 1]) + (p1[4 * gi + 2] + p1[4 * gi + 3]);
          float e3 = kh == 0 ? p0[4 * gi + 3] : p1[4 * gi + 3];
          g4 += dppf<DPP_X1>(g4); g4 += dppf<DPP_X2>(g4); e3 += dppf<DPP_X1>(e3); e3 += dppf<DPP_X2>(e3);
          if (h == 0) { const int s = (step_ * 64 + kh * 32 + 8 * gi + 4 * hh) >> 2; IMP[qi * AT_IMPS + s] = g4; EE[qi * AT_IMPS + s] = e3; }
      } });
    const float gc = gates(0);
#pragma unroll
    for (int i = 0; i < 16; ++i) { p0[i] = otg(i); p1[i] = otg(16 + i); }
    __builtin_amdgcn_sched_barrier(0);
#pragma unroll
    for (int i = 0; i < 16; ++i) { otg(i) = p0[i] + S.o0[i] * gc; otg(16 + i) = p1[i] + S.o1[i] * gc; }
  }
  }
  const bf16_t* kps = (const bf16_t*)(P.ws + WS_KSF) + (size_t)((b * 4 + g) * 128) * 4096; const bf16_t* vps = vT + (size_t)((b * 4 + g) * 128) * 4096;
  if (c <= 15) { AT_IDS; QF_LOAD();
    st_init(S);
    if (c > 0) {
      SWEEPF(0, c, {
        AT_QKV();
        at_online<0>(S, p0, p1, 0, 0, 0, true, hh);
        at_pv(vfr, p0, p1, S.o0, S.o1); });
    }
    SWEEPF(c, 1, {
      AT_QKV();
      at_online<1>(S, p0, p1, (c + step_) * 64, 0, t, true, hh);
      at_pv(vfr, p0, p1, S.o0, S.o1); });
    const float lt = x32_sum(S.l); const float slc_sc = lt > 0.f ? gates(16) / lt : 0.f;
    bf16_t* op = attn + (tok * DM + (g * 4 + h) * 64);
#pragma unroll
    for (int i = 0; i < 16; ++i) { S.o0[i] = S.o0[i] * slc_sc + otg(i); S.o1[i] = S.o1[i] * slc_sc + otg(16 + i); }
#pragma unroll
    for (int gi = 0; gi < 4; ++gi) {
      u32x2 a; a.x = pk2(S.o0[4 * gi], S.o0[4 * gi + 1]); a.y = pk2(S.o0[4 * gi + 2], S.o0[4 * gi + 3]);
      u32x2 bq; bq.x = pk2(S.o1[4 * gi], S.o1[4 * gi + 1]); bq.y = pk2(S.o1[4 * gi + 2], S.o1[4 * gi + 3]);
      *(u32x2*)(op + 8 * gi + 4 * hh) = a; *(u32x2*)(op + 32 + 8 * gi + 4 * hh) = bq;
    }
  } else {
    const int nc = c - 2;
    unsigned char* QL = lds + AT_QL; int* NJ = (int*)(lds + AT_NJ); unsigned short* ITEMS = (unsigned short*)(lds + AT_ITEMS); int* MISC = (int*)(lds + AT_MISC);
    float* MREF = (float*)(lds + AT_MREF); float* LS = (float*)(lds + AT_LACC); unsigned char* INVQ = lds + AT_INVQ; unsigned char* SLOT = lds + AT_IMP;
    float* const LOWN = (float*)(lds + AT_LOWN); const float k64 = 5.421010862427522e-20f;
    { AT_IDS;
    { const int q = tid >> 3; for (int s = 1 + (tid & 7); s <= nc; s += 8) IMP[q * AT_IMPS + s] += EE[q * AT_IMPS + s - 1]; }
    if (tid < 256) SEL[tid] = 0u;
    if (tid < 128) ((unsigned*)INVQ)[tid] = 0u;
    __syncthreads();
    {
      const int q = tid >> 3, sub = tid & 7; const float* ip = IMP + q * AT_IMPS;
      unsigned key[16];
#pragma unroll
      for (int k = 0; k < 16; ++k) { const int s = 1 + sub + 8 * k; key[k] = s <= nc ? __float_as_uint(ip[s]) + 1u : 0u; }
      unsigned T = 0u;
      for (int bit = 30; bit >= 0; --bit) {
        const unsigned cand = T | (1u << bit); int cn = 0;
#pragma unroll
        for (int k = 0; k < 16; ++k) cn += key[k] >= cand ? 1 : 0;
        cn = sum8i(cn);
        if (cn >= 13) T = cand;
      }
      int ngt = 0, neq = 0;
#pragma unroll
      for (int k = 0; k < 16; ++k) { ngt += key[k] > T ? 1 : 0; neq += key[k] == T ? 1 : 0; }
      ngt = sum8i(ngt); neq = sum8i(neq);
      const int need = 13 - ngt;
      unsigned w0 = 0u, w1 = 0u, w2 = 0u, w3 = 0u;
      if (!__any(neq > need)) {
#pragma unroll
        for (int k = 0; k < 16; ++k) if (key[k] >= T && key[k] != 0u) { const int s = 1 + sub + 8 * k; const unsigned bt = 1u << (s & 31); if (s < 32) w0 |= bt; else if (s < 64) w1 |= bt; else if (s < 96) w2 |= bt; else w3 |= bt; }
      } else {
        int taken = 0; const int gsh = lane & ~7;
#pragma unroll
        for (int k = 0; k < 16; ++k) {
          const bool eq = key[k] == T && key[k] != 0u; const unsigned long long mk = __ballot(eq);
          const unsigned grp = (unsigned)(mk >> gsh) & 0xffu; const int before = __popc(grp & ((1u << sub) - 1u));
          const bool pick = key[k] > T || (eq && taken + before < need);
          taken += __popc(grp);
          if (pick) { const int s = 1 + sub + 8 * k; const unsigned bt = 1u << (s & 31); if (s < 32) w0 |= bt; else if (s < 64) w1 |= bt; else if (s < 96) w2 |= bt; else w3 |= bt; }
        }
      }
      if (w0) atomicOr(&SEL[q * 4], w0); if (w1) atomicOr(&SEL[q * 4 + 1], w1); if (w2) atomicOr(&SEL[q * 4 + 2], w2); if (w3) atomicOr(&SEL[q * 4 + 3], w3);
    }
    __syncthreads();
    for (int j = 1 + w; j <= nc; j += NWAVE) {
      const bool bit = (SEL[lane * 4 + (j >> 5)] >> (j & 31)) & 1u;
      const unsigned long long mk = __ballot(bit);
      const int rank = __builtin_amdgcn_mbcnt_hi((unsigned)(mk >> 32), __builtin_amdgcn_mbcnt_lo((unsigned)mk, 0u));
      if (bit) QL[j * 64 + rank] = (unsigned char)lane;
      const int cnt = __popcll(mk);
      if (lane < ((8 - (cnt & 7)) & 7)) QL[j * 64 + cnt + lane] = 0;
      if (lane == 0) NJ[j] = cnt;
    }
    __syncthreads();
    if (w == 0) {
      const int ja = 1 + lane, jb = 65 + lane;
      const int ca = ja <= nc ? (NJ[ja] + 7) >> 3 : 0, cb = jb <= nc ? (NJ[jb] + 7) >> 3 : 0;
      int sa = ca, sb = cb;
#pragma unroll
      for (int o = 1; o < 64; o <<= 1) { const int ta = __shfl_up(sa, o), tb = __shfl_up(sb, o); if (lane >= o) { sa += ta; sb += tb; } }
      const int tota = __shfl(sa, 63);
      for (int k = 0; k < ca; ++k) ITEMS[sa - ca + k] = (unsigned short)(ja * 8 + k);
      for (int k = 0; k < cb; ++k) ITEMS[tota + sb - cb + k] = (unsigned short)(jb * 8 + k);
      if (lane == 63) MISC[0] = tota + sb;
    }
    }
    { AT_IDS; QF_LOAD();
    st_init(S);
    SWEEPF(0, 1, {
      AT_QKV();
      at_online<0>(S, p0, p1, 0, 0, 0, true, hh);
      at_pv(vfr, p0, p1, S.o0, S.o1); });
    SWEEPF(c - 1, 2, {
      AT_QKV();
      at_online<1>(S, p0, p1, c * 64, 0, t, step_ == 1, hh);
      at_pv(vfr, p0, p1, S.o0, S.o1); });
    { const float lt = x32_sum(S.l);
      if (hh == 0) { MREF[qrow] = S.m + 64.f; LS[w * 32 + r] = lt * k64; } }
#define SLOT_WRITE(x, o0_, o1_, scale_) do { unsigned char* sp_ = SLOT + (x) * 8192 + r * 256; \
      _Pragma("unroll") for (int gi_ = 0; gi_ < 4; ++gi_) { \
        const f32x4 va_ = {o0_[4 * gi_] * (scale_), o0_[4 * gi_ + 1] * (scale_), o0_[4 * gi_ + 2] * (scale_), o0_[4 * gi_ + 3] * (scale_)}; \
        const f32x4 vb_ = {o1_[4 * gi_] * (scale_), o1_[4 * gi_ + 1] * (scale_), o1_[4 * gi_ + 2] * (scale_), o1_[4 * gi_ + 3] * (scale_)}; \
        *(f32x4*)(sp_ + (((2 * gi_ + hh) ^ (r & 15)) * 16)) = va_; *(f32x4*)(sp_ + (((8 + 2 * gi_ + hh) ^ (r & 15)) * 16)) = vb_; } } while (0)
#define SLOT_READ(x, col_) (*(const f32x4*)(SLOT + (x) * 8192 + (col_) * 256 + ((ach ^ ((col_) & 15)) * 16)))
    SLOT_WRITE(w, S.o0, S.o1, k64);
    __syncthreads();
    }
    {
      AT_IDS; const int wu = __builtin_amdgcn_readfirstlane(w);
      const int nitems = MISC[0], nrounds = (nitems + 3) >> 2;
      if (wu >= 4) {
        const int ow = wu - 4, oq = lane >> 2, oh = lane & 3, srcslot = 2 * ow + (lane >> 5), scol = lane & 31;
        f32x4 acc[16]; float accl;
        { const unsigned char* rp = SLOT + srcslot * 8192 + scol * 256;
#pragma unroll
          for (int k = 0; k < 16; ++k) acc[k] = *(const f32x4*)(rp + ((k ^ (scol & 15)) * 16));
          accl = LS[srcslot * 32 + scol]; }
        __syncthreads();
        for (int rd = 0; rd <= nrounds; ++rd) {
          if (rd > 0) {
            const int set = (rd - 1) & 1;
            unsigned* ivp = (unsigned*)(INVQ + set * 256) + 16 * ow + oq;
            unsigned iv = *ivp;
            if (__any(iv != 0u)) {
              if (iv != 0u && oh == 0) *ivp = 0u;
              do {
                const int x = (iv & 0xffu) ? 0 : (iv & 0xff00u) ? 1 : (iv & 0xff0000u) ? 2 : 3;
                const unsigned byte = (iv >> (8 * x)) & 0xffu;
                iv &= ~(0xffu << (8 * x));
                if (byte) {
                  const int col = (int)(byte - 1) * 4 + oh;
                  const unsigned char* rp = SLOT + (set * 4 + x) * 8192 + col * 256;
                  f32x4 tq[16];
#pragma unroll
                  for (int k = 0; k < 16; ++k) tq[k] = *(const f32x4*)(rp + ((k ^ (col & 15)) * 16));
                  const float tl = LS[(set * 4 + x) * 32 + col];
                  __builtin_amdgcn_sched_barrier(0);
#pragma unroll
                  for (int k = 0; k < 16; ++k) acc[k] += tq[k];
                  accl += tl;
                }
              } while (__any(iv != 0u));
            }
          }
          __syncthreads();
        }
#pragma unroll
        for (int i = 0; i < 16; ++i) { S.o0[i] = otg(i); S.o1[i] = otg(16 + i); }
        SLOT_WRITE(w, S.o0, S.o1, 1.0f);
        __syncthreads();
        {
          const unsigned tq = (unsigned)b * SEQ + 64 * c + 16 * ow + oq;
          const float gs = gbase[tq * 48 + 16 + g * 4 + oh]; const float sc = accl > 0.f ? gs / accl : 0.f;
          const unsigned char* rp = SLOT + srcslot * 8192 + scol * 256;
          bf16_t* op = attn + (tq * DM + (g * 4 + oh) * 64);
#pragma unroll
          for (int k2 = 0; k2 < 8; ++k2) {
            const f32x4 v0 = acc[2 * k2] * sc + *(const f32x4*)(rp + (((2 * k2) ^ (scol & 15)) * 16)), v1 = acc[2 * k2 + 1] * sc + *(const f32x4*)(rp + (((2 * k2 + 1) ^ (scol & 15)) * 16));
            u32x4 o; o.x = pk2(v0.x, v0.y); o.y = pk2(v0.z, v0.w); o.z = pk2(v1.x, v1.y); o.w = pk2(v1.z, v1.w);
            *(u32x4*)(op + 8 * k2) = o;
          }
        }
      } else {
        __syncthreads();
        const bf16_t* kgl = kps + lane * 8; const bf16_t* vgl = vps + lane * 8;
        bf16x8 kfA[8], vfA[8], kfB[8], vfB[8];
#define FLOAD(KF, VF, jj) do { _Pragma("unroll") for (int f_ = 0; f_ < 8; ++f_) { KF[f_] = *(const bf16x8*)(kgl + (size_t)(jj) * 4096 + f_ * 512); VF[f_] = *(const bf16x8*)(vgl + (size_t)(jj) * 4096 + f_ * 512); } } while (0)
        int rowc = 0, qqc = 0; bool validc = false; float mrc = 1e30f; int en = 0;
        if (wu < nitems) { const int e0 = ITEMS[wu]; const int j0_ = e0 >> 3; const int qs_ = 8 * (e0 & 7) + (r >> 2); validc = qs_ < NJ[j0_]; qqc = QL[j0_ * 64 + qs_]; rowc = qqc * 4 + h; mrc = validc ? MREF[rowc] : 1e30f; FLOAD(kfA, vfA, j0_); }
        if (wu + 4 < nitems) en = __builtin_amdgcn_readfirstlane(ITEMS[wu + 4]);
        FLOAD(kfB, vfB, en >> 3);
#define ITEM_ROUND(KF, VF, rd_) do { \
          const int it = (rd_) * 4 + wu, set = (rd_) & 1; \
          if (it < nitems) { \
            const bool hasn = it + 4 < nitems; \
            const int jn = en >> 3, qsn = 8 * (en & 7) + (r >> 2);        \
            bf16x8 qv[4];                                               \
            _Pragma("unroll") for (int ds = 0; ds < 4; ++ds) qv[ds] = *(const bf16x8*)(lds + AT_QS + rowc * 128 + (((ds * 2 + hh) ^ (rowc & 7)) * 16)); \
            const int njn = NJ[jn]; const int qqn = QL[jn * 64 + qsn]; \
            const int en2 = it + 8 < nitems ? __builtin_amdgcn_readfirstlane(ITEMS[it + 8]) : 0; const int j2 = en2 >> 3; \
            __builtin_amdgcn_sched_barrier(0); \
            const f32x16 z = {0.f, 0.f, 0.f, 0.f, 0.f, 0.f, 0.f, 0.f, 0.f, 0.f, 0.f, 0.f, 0.f, 0.f, 0.f, 0.f}; \
            _Pragma("unroll") for (int ds = 0; ds < 4; ++ds) { \
              if (ds == 0) { p0 = MFMA32(KF[0], qv[0], z); p1 = MFMA32(KF[4], qv[0], z); } else { p0 = MFMA32(KF[ds], qv[ds], p0); p1 = MFMA32(KF[4 + ds], qv[ds], p1); } \
            } \
            const bool validn = hasn && qsn < njn; const int rown = qqn * 4 + h; \
            const float mrn = validn ? MREF[rown] : 1e30f; \
            float rs = 0.f; \
            _Pragma("unroll") for (int i = 0; i < 16; ++i) { \
              p0[i] = __builtin_amdgcn_exp2f(fminf(p0[i] - mrc, 120.f)); p1[i] = __builtin_amdgcn_exp2f(fminf(p1[i] - mrc, 120.f)); rs += p0[i] + p1[i]; \
              if (i & 1) { KF[i >> 1] = *(const bf16x8*)(kgl + (size_t)j2 * 4096 + (i >> 1) * 512); __builtin_amdgcn_sched_barrier(0); } \
            } \
            rs = x32_sum(rs); \
            f32x16 o0 = z, o1 = z; \
            _Pragma("unroll") for (int gk = 0; gk < 4; ++gk) { const bf16x8 pb = (gk < 2) ? pack8(p0, gk & 1) : pack8(p1, gk & 1); o0 = MFMA32(VF[gk], pb, o0); o1 = MFMA32(VF[4 + gk], pb, o1); } \
            { unsigned char* sp_ = SLOT + (set * 4 + wu) * 8192 + r * 256; \
              _Pragma("unroll") for (int gi = 0; gi < 4; ++gi) { \
                const f32x4 va_ = {o0[4 * gi], o0[4 * gi + 1], o0[4 * gi + 2], o0[4 * gi + 3]}; const f32x4 vb_ = {o1[4 * gi], o1[4 * gi + 1], o1[4 * gi + 2], o1[4 * gi + 3]}; \
                *(f32x4*)(sp_ + (((2 * gi + hh) ^ (r & 15)) * 16)) = va_; *(f32x4*)(sp_ + (((8 + 2 * gi + hh) ^ (r & 15)) * 16)) = vb_; \
                VF[2 * gi] = *(const bf16x8*)(vgl + (size_t)j2 * 4096 + (2 * gi) * 512); VF[2 * gi + 1] = *(const bf16x8*)(vgl + (size_t)j2 * 4096 + (2 * gi + 1) * 512); \
                __builtin_amdgcn_sched_barrier(0); \
              } } \
            if (hh == 0) LS[(set * 4 + wu) * 32 + r] = rs; \
            if (validc && h == 0 && hh == 0) INVQ[set * 256 + qqc * 4 + wu] = (unsigned char)((r >> 2) + 1); \
            rowc = rown; qqc = qqn; validc = validn; mrc = mrn; en = en2; \
          } } while (0)
        for (int rd = 0; rd < nrounds; rd += 2) {
          ITEM_ROUND(kfA, vfA, rd);
          __syncthreads();
          if (rd + 1 < nrounds) {
            ITEM_ROUND(kfB, vfB, rd + 1);
            __syncthreads();
          }
        }
#undef ITEM_ROUND
#undef FLOAD
#undef ITEM_META
#undef KLOAD
#undef VLOAD
        __syncthreads();
#pragma unroll
        for (int i = 0; i < 16; ++i) { S.o0[i] = otg(i); S.o1[i] = otg(16 + i); }
        SLOT_WRITE(w, S.o0, S.o1, 1.0f);
        __syncthreads();
      }
    }
#undef SLOT_WRITE
#undef SLOT_READ
  }
  __syncthreads();
#undef ST_LOAD
#undef ST_STORE
#undef SWEEP
#undef ST_LOADF
#undef ST_STOREF
#undef SWEEPF
#undef gates
#undef otg
#undef QF_LOAD
#undef AT_QKV
#undef AT_IDS
}
DI void phase_attn(const Params& P_, unsigned char* lds) {
  Params P = P_; { size_t z_ = 0; asm volatile("" : "+s"(z_)); P.ws = P_.ws + z_; }
  const int G = gridDim.x, bx = obid();
  const int vcu = (G % 8 == 0) ? (bx % 8) * (G / 8) + bx / 8 : bx;
  for (int idx = vcu; idx < 1024; idx += G) {
    const int i = idx >> 8, v = idx & 255, bg = v >> 5, s = v & 31;
    const int c = i == 0 ? s : i == 1 ? 63 - s : i == 2 ? 64 + s : 127 - s;
    attn_tile(P, lds, bg >> 2, bg & 3, c);
  }
}


#define LAS __attribute__((address_space(3)))
#define XB_TMO      128
#define XB_XCNT(j)  (256  + 64 * (j))
#define XB_XSUB(j)  (1280 + 64 * (j))
#define XB_XGEN(j)  (2304 + 64 * (j))
#define XB_TOP      3328
#define XB_TOPGEN   3392
#define XCD_BAR_WORDS 3456
#define XB_SPIN_CAP (1u << 18)
__device__ __forceinline__ unsigned xb_ld(unsigned* p)              { return __hip_atomic_load(p, __ATOMIC_RELAXED, __HIP_MEMORY_SCOPE_AGENT); }
__device__ __forceinline__ unsigned xb_add(unsigned* p, unsigned v) { return __hip_atomic_fetch_add(p, v, __ATOMIC_RELAXED, __HIP_MEMORY_SCOPE_AGENT); }
__device__ __forceinline__ unsigned xb_xcc_id() { return (unsigned)__builtin_amdgcn_s_getreg((3 << 11) | 20) & 0xFu; }
#define XB_SPIN(cond, bar) do { unsigned _sp = 0; while (cond) { __builtin_amdgcn_s_sleep(1); \
    if ((++_sp & 255u) == 0u) { if (xb_ld(&(bar)[XB_TMO])) break; if (_sp > XB_SPIN_CAP) { atomicAdd(&(bar)[XB_TMO], 1u); break; } } } } while (0)
struct XcdBarrier { unsigned* bar; unsigned x; volatile LAS unsigned* st; };
__device__ __forceinline__ XcdBarrier xcd_barrier_post(unsigned* bar, volatile LAS unsigned* st) {
    XcdBarrier b; b.bar = bar; b.x = xb_xcc_id(); b.st = st;
    if (threadIdx.x == 0) (void)xb_add(&bar[XB_XCNT(b.x)], 1u);
    return b;
}
__device__ __forceinline__ void xcd_barrier_complete(unsigned* bar, unsigned x, unsigned& nloc, unsigned& nx) {
    const unsigned G = gridDim.x * gridDim.y * gridDim.z;
    unsigned sum, cnt, mine, sp = 0u;
    for (;;) {
        sum = 0u; cnt = 0u; mine = 0u;
#pragma unroll
        for (unsigned j = 0; j < 16; ++j) { const unsigned c = xb_ld(&bar[XB_XCNT(j)]); sum += c; cnt += (c > 0u) ? 1u : 0u; mine = (j == x) ? c : mine; }
        if (sum == G) break;
        __builtin_amdgcn_s_sleep(1);
        if ((++sp & 255u) == 0u) { if (xb_ld(&bar[XB_TMO])) break; if (sp > XB_SPIN_CAP) { atomicAdd(&bar[XB_TMO], 1u); break; } }
    }
    nloc = mine > 0u ? mine : 1u; nx = cnt > 0u ? cnt : 1u;
}
__device__ __forceinline__ void xcd_barrier(const XcdBarrier& b) {
    asm volatile("s_waitcnt vmcnt(0)" ::: "memory");
    __syncthreads();
    if (threadIdx.x == 0) {
        unsigned* bar = b.bar; { size_t z_ = 0; asm volatile("" : "+s"(z_)); bar += z_; }
        __builtin_amdgcn_s_waitcnt(0);
        unsigned nloc = b.st[0], nx = b.st[1];
        if (nloc == 0u) { xcd_barrier_complete(bar, b.x, nloc, nx); b.st[0] = nloc; b.st[1] = nx; }
        const unsigned old = xb_add(&bar[XB_XSUB(b.x)], 1u);
        const unsigned gen = old / nloc;
        if (old + 1u == (gen + 1u) * nloc) {
            __builtin_amdgcn_fence(__ATOMIC_RELEASE, "agent");
            asm volatile("s_waitcnt vmcnt(0)" ::: "memory");
            const unsigned og = xb_add(&bar[XB_TOP], 1u);
            const unsigned tg = og / nx;
            if (og + 1u == (tg + 1u) * nx) xb_add(&bar[XB_TOPGEN], 1u);
            else XB_SPIN(xb_ld(&bar[XB_TOPGEN]) == tg, bar);
            __builtin_amdgcn_fence(__ATOMIC_ACQUIRE, "agent");
            xb_add(&bar[XB_XGEN(b.x)], 1u);
            asm volatile("s_waitcnt vmcnt(0)" ::: "memory");
        } else {
            XB_SPIN(xb_ld(&bar[XB_XGEN(b.x)]) == gen, bar);
            __builtin_amdgcn_fence(__ATOMIC_ACQUIRE, "agent");
            asm volatile("s_waitcnt vmcnt(0)" ::: "memory");
        }
    }
    __syncthreads();
}

__global__ void __launch_bounds__(NTHR) fwd_kernel(Params P) {
  extern __shared__ __attribute__((aligned(16))) unsigned char lds[];
  cg::grid_group grid = cg::this_grid();
  const int gtid = blockIdx.x * NTHR + threadIdx.x;
  if (threadIdx.x < 4) ((unsigned*)(lds + LDS_BYTES - 16))[threadIdx.x] = 0u;
  __syncthreads();
  const XcdBarrier xbar = xcd_barrier_post((unsigned*)(P.ws + WS_BAR), (volatile LAS unsigned*)(lds + LDS_BYTES - 16));
#define GSYNC() xcd_barrier(xbar)
  s5_params(P, gtid);
  {
    float* modb = (float*)(P.ws + WS_MOD); float* cbb = (float*)(P.ws + WS_CB);
    for (int it = blockIdx.x; it < 192 + 16; it += gridDim.x) {
      if (it < 192) { const int l = it / 96, j0 = (it % 96) * 64;
        gemv_item((float*)lds, P.in[2] + (size_t)l * DM * 6144, DM, 6144, j0, P.in[1], P.in[1] + DM, true, P.in[3] + l * 6144, modb + (size_t)(l * 2) * 6144, modb + (size_t)(l * 2 + 1) * 6144);
      } else { const int r = it - 192, l = r >> 3, kv = (r >> 2) & 1, j0 = (r & 3) * 64;
        gemv_item((float*)lds, P.in[17] + (size_t)(l * 2 + kv) * 2048 * 256, 2048, 256, j0, P.in[16] + (size_t)(l * 2 + kv) * 2048, nullptr, false, nullptr, cbb + (l * 2 + kv) * 256, nullptr);
      }
    }
  }
  for (int it = blockIdx.x; it < DEPTH * 32 * 6; it += gridDim.x) s5_tables(P, it / 192, (it % 192) / 6, it % 6, lds);
  convert_weights(P, 0, lds);
  grid.sync();
  for (int l = 0; l < DEPTH; ++l) {
    if (l == 0) norm_simple<0>(P, l); else { norm_simple<1>(P, l); convert_weights(P, 1, lds); }
    GSYNC();
#if EN_MIXER
    phase_inproj8(P, lds);
    GSYNC();
    phase_s5a(P, l, lds);
    __syncthreads();
#if EN_ATTN
    phase_gates(P, lds);
    __syncthreads();
    phase_cmp1(P, l, lds);
#endif
    GSYNC();
    s5_carry(P, l);
#if EN_ATTN
    phase_cmp2(P, lds);
#endif
    GSYNC();
#if EN_ATTN
    phase_attn(P, lds);
    __syncthreads();
#endif
    phase_s5c(P, l, lds);
    GSYNC();
    phase_glu(P, lds);
    GSYNC();
    phase_merge8(P, lds);
    GSYNC();
    phase_wout8(P, l, lds);
    GSYNC();
#else
    if (l == 0) { for (size_t i = (size_t)gtid * 4; i < (size_t)NT * DM; i += (size_t)gridDim.x * NTHR * 4) *(f32x4*)(P.out + i) = *(const f32x4*)(P.in[0] + i); GSYNC(); }
#endif
#if EN_MOE
    norm_route(P, l, lds);
    GSYNC();
    phase_moe1(P, l, lds);
    GSYNC();
    phase_moe2(P, l, lds);
    GSYNC();
#endif
  }
  norm_simple<3>(P, 0);
}

extern "C" void kernel_launch(void* const* d_in, const int* in_sizes, int n_in, void* d_out, int out_size, void* d_ws, size_t ws_size, hipStream_t stream) {
  static int grid = 0;
  if (grid == 0) {
    if (n_in != 30 || out_size != NT * DM || ws_size < WS_END2) { fprintf(stderr, "kernel_launch: unexpected shapes (n_in %d out %d ws %zu need %zu)\n", n_in, out_size, ws_size, (size_t)WS_END2); grid = -1; return; }
    int dev = 0, cus = 0, per_cu = 0;
    hipGetDevice(&dev);
    hipDeviceGetAttribute(&cus, hipDeviceAttributeMultiprocessorCount, dev);
    hipFuncSetAttribute((const void*)fwd_kernel, hipFuncAttributeMaxDynamicSharedMemorySize, LDS_BYTES);
    hipOccupancyMaxActiveBlocksPerMultiprocessor(&per_cu, (const void*)fwd_kernel, NTHR, LDS_BYTES);
    if (per_cu < 1) { fprintf(stderr, "kernel_launch: occupancy query says %d blocks/CU\n", per_cu); per_cu = 1; }
    grid = cus;
    (void)hipGetLastError();
  }
  if (grid < 0) return;
  Params p{};
  for (int i = 0; i < 30; ++i) p.in[i] = (const float*)d_in[i];
  p.out = (float*)d_out; p.ws = (unsigned char*)d_ws;
  if (hipMemsetAsync(p.ws, 0, WS_ZERO_BYTES, stream) != hipSuccess) { fprintf(stderr, "kernel_launch: memset failed\n"); return; }
  void* args[] = {&p};
  hipError_t e = hipLaunchCooperativeKernel((const void*)fwd_kernel, dim3(grid), dim3(NTHR), args, LDS_BYTES, stream);
  if (e != hipSuccess) fprintf(stderr, "cooperative launch failed: %s (grid %d)\n", hipGetErrorString(e), grid);
}
```

```cpp
#include <hip/hip_runtime.h>
#include <hip/hip_cooperative_groups.h>
#include <cstdio>
#include <cstdint>
namespace cg = cooperative_groups;

#ifndef EN_MIXER
#define EN_MIXER 1
#endif
#ifndef EN_ATTN
#define EN_ATTN 1
#endif
#ifndef EN_MOE
#define EN_MOE 1
#endif

#define DI __device__ __forceinline__
typedef unsigned short bf16_t;
typedef short bf16x8 __attribute__((ext_vector_type(8)));
typedef short s16x4 __attribute__((ext_vector_type(4)));
typedef float f32x4 __attribute__((ext_vector_type(4)));
typedef float f32x16 __attribute__((ext_vector_type(16)));
typedef unsigned u32x4 __attribute__((ext_vector_type(4)));
typedef unsigned u32x2 __attribute__((ext_vector_type(2)));

constexpr int DM = 1024, NB = 2, SEQ = 8192, NT = NB * SEQ, DEPTH = 2;
constexpr int INW = 5168, INWP = 5376;
constexpr int NTHR = 512, NWAVE = 8;
constexpr int NEXP = 32, LISTCAP = 16384;
constexpr float EPS = 1e-6f;
constexpr float QSCALE = 0.125f * 1.4426950408889634f;

constexpr size_t MiB = 1u << 20;
constexpr size_t WS_CNT = 0;
constexpr size_t WS_BAR = 1024;
constexpr size_t WS_ZERO_BYTES = 16384;
constexpr size_t WS_MOD = 16384;
constexpr size_t WS_CB = WS_MOD + 2 * 2 * 6144 * 4;
constexpr size_t WS_S5P = WS_CB + 2 * 2 * 256 * 4;
constexpr size_t WS_WT = WS_S5P + 2 * 32 * 64 * 36 * 4;
constexpr size_t WS_SMALL_END = WS_WT + (size_t)NT * 2 * 4;
static_assert(WS_SMALL_END <= 1 * MiB, "small region");
constexpr size_t WS_W = 1 * MiB;
constexpr size_t W_IN = 0;
constexpr size_t W_GLU = W_IN + (size_t)INWP * 1024 * 2;
constexpr size_t W_O = W_GLU + 512 * 512 * 2;
constexpr size_t W_SO = W_O + 1024 * 1024 * 2;
constexpr size_t W_OUT = W_SO + 1024 * 512 * 2;
constexpr size_t W_C1 = W_OUT + 1024 * 1024 * 2;
constexpr size_t W_C2 = W_C1 + 2 * 256 * 2048 * 2;
constexpr size_t W_GU = W_C2 + 2 * 128 * 256 * 2;
constexpr size_t W_D = W_GU + (size_t)32 * 512 * 1024 * 2;
constexpr size_t W_END = W_D + (size_t)32 * 1024 * 256 * 2;
static_assert(W_END <= 67 * MiB, "weights region");
constexpr size_t WS_A = 68 * MiB;
constexpr size_t WS_B = WS_A + 32 * MiB;
constexpr size_t WS_C = WS_B + 32 * MiB;
constexpr size_t WS_DV = WS_C + 32 * MiB;
constexpr size_t WS_E = WS_DV + 16 * MiB;
constexpr size_t WS_F = WS_E + 32 * MiB;
constexpr size_t WS_G = WS_F + 64 * MiB;
constexpr size_t WS_GATES = WS_G + 16 * MiB;
constexpr size_t WS_HID = WS_GATES + 3 * MiB;
constexpr size_t WS_KC = WS_HID + 4 * MiB;
constexpr size_t WS_VC = WS_KC + 512 * 1024;
constexpr size_t WS_L = WS_VC + 512 * 1024;
constexpr size_t WS_LIST = WS_L + 4 * MiB;
constexpr size_t WS_OT = WS_LIST + 2 * MiB;
constexpr size_t WS_TAB = WS_OT + 16 * MiB;
constexpr size_t TAB_KT = 0, TAB_M1 = 1 * MiB, TAB_M2 = 9 * MiB, TAB_LAYER = 17 * MiB;
constexpr size_t WS_END = WS_TAB + 2 * TAB_LAYER;
constexpr size_t WS_KSF = WS_END;
constexpr size_t WS_END2 = WS_KSF + 8 * MiB;
constexpr size_t WS_SIN = WS_E + 16 * MiB;
constexpr int LDS_BYTES = 151552;

struct Params { const float* in[30]; float* out; unsigned char* ws; };

DI int otid() { int t = threadIdx.x; asm volatile("" : "+v"(t)); return t; }
DI int obid() { int t = blockIdx.x; asm volatile("" : "+s"(t)); return t; }
DI unsigned f2bf(float f) { unsigned u = __float_as_uint(f); return (u + 0x7fffu + ((u >> 16) & 1u)) >> 16; }
typedef float f32x2_t __attribute__((ext_vector_type(2))); typedef __bf16 bf16x2_t __attribute__((ext_vector_type(2)));
DI unsigned pk2(float lo, float hi) { const f32x2_t v = {lo, hi}; const bf16x2_t b = __builtin_convertvector(v, bf16x2_t); return __builtin_bit_cast(unsigned, b); }
DI float bflo(unsigned w) { return __uint_as_float(w << 16); }
DI float bfhi(unsigned w) { return __uint_as_float(w & 0xffff0000u); }
DI int perm16(int x) { return (x & ~12) | ((x & 4) << 1) | ((x & 8) >> 1); }
template <int CTRL> DI float dppf(float x) { return __builtin_bit_cast(float, __builtin_amdgcn_mov_dpp(__builtin_bit_cast(int, x), CTRL, 0xf, 0xf, true)); }
template <int CTRL> DI int dppi(int x) { return __builtin_amdgcn_mov_dpp(x, CTRL, 0xf, 0xf, true); }
constexpr int DPP_X1 = 0xB1, DPP_X2 = 0x4E, DPP_HM = 0x141, DPP_X8 = 0x128;
DI float x32_sum(float x) { auto t = __builtin_amdgcn_permlane32_swap(__float_as_uint(x), __float_as_uint(x), false, false); return __uint_as_float(t[0]) + __uint_as_float(t[1]); }
DI float x32_max(float x) { auto t = __builtin_amdgcn_permlane32_swap(__float_as_uint(x), __float_as_uint(x), false, false); return fmaxf(__uint_as_float(t[0]), __uint_as_float(t[1])); }
DI float x16_sum(float x) { auto t = __builtin_amdgcn_permlane16_swap(__float_as_uint(x), __float_as_uint(x), false, false); return __uint_as_float(t[0]) + __uint_as_float(t[1]); }
DI u32x4 widen16(u32x2 o0, u32x2 o1) {
  auto rx = __builtin_amdgcn_permlane16_swap(o0.x, o1.x, false, false); auto ry = __builtin_amdgcn_permlane16_swap(o0.y, o1.y, false, false);
  return (u32x4){rx[0], ry[0], rx[1], ry[1]};
}
DI int widen16_col(int fq) { return (fq & 1) ? 16 + 4 * (fq - 1) : 4 * fq; }
DI int sum8i(int v) { v += dppi<DPP_X1>(v); v += dppi<DPP_X2>(v); v += dppi<DPP_HM>(v); return v; }
DI float wave_sum(float v) {
  v += dppf<DPP_X1>(v); v += dppf<DPP_X2>(v); v += dppf<DPP_HM>(v); v += dppf<DPP_X8>(v);
  return x32_sum(x16_sum(v));
}
DI float sigmoidf_(float x) { return __builtin_amdgcn_rcpf(1.f + __expf(-x)); }
DI float gelu_tanh(float x) {
  const float z = 0.7978845608028654f * (x + 0.044715f * x * x * x);
  const float e = __expf(2.f * z);
  const float th = 1.f - 2.f * __builtin_amdgcn_rcpf(e + 1.f);
  return 0.5f * x * (1.f + th);
}
DI void sincos_d(double x, double& s, double& c) {
  const double k = rint(x * 0.6366197723675814);
  double r = fma(-k, 1.5707963267948966, x);
  r = fma(-k, 6.123233995736766e-17, r);
  const int q = ((int)k) & 3;
  const double r2 = r * r;
  const double sp = r * (1.0 + r2 * (-1.0 / 6 + r2 * (1.0 / 120 + r2 * (-1.0 / 5040 + r2 * (1.0 / 362880 + r2 * (-1.0 / 39916800 + r2 * (1.0 / 6227020800.0)))))));
  const double cp = 1.0 + r2 * (-0.5 + r2 * (1.0 / 24 + r2 * (-1.0 / 720 + r2 * (1.0 / 40320 + r2 * (-1.0 / 3628800 + r2 * (1.0 / 479001600 + r2 * (-1.0 / 87178291200.0)))))));
  s = (q == 0) ? sp : (q == 1) ? cp : (q == 2) ? -sp : -cp;
  c = (q == 0) ? cp : (q == 1) ? -sp : (q == 2) ? -cp : sp;
}

DI void gemv_item(float* lds, const float* W, int K, int N, int j0, const float* v0, const float* v1, bool do_silu, const float* bias, float* o0, float* o1) {
  const int tid = otid();
  float* sv = lds; float* red = lds + 4096;
  for (int k = tid; k < K; k += NTHR) {
    float a = v0[k], b = v1 ? v1[k] : 0.f;
    if (do_silu) { a = a / (1.f + expf(-a)); b = b / (1.f + expf(-b)); }
    sv[k] = a; sv[2048 + k] = b;
  }
  __syncthreads();
  const int jl = tid & 63, ks = tid >> 6, kper = K >> 3;
  const float* wp = W + (size_t)(ks * kper) * N + j0 + jl;
  float a0 = 0.f, a1 = 0.f;
#pragma unroll 8
  for (int k = 0; k < kper; ++k) { const float w = wp[(size_t)k * N]; a0 += sv[ks * kper + k] * w; a1 += sv[2048 + ks * kper + k] * w; }
  red[(ks * 64 + jl) * 2] = a0; red[(ks * 64 + jl) * 2 + 1] = a1;
  __syncthreads();
  if (tid < 64) {
    float s0 = 0.f, s1 = 0.f;
    for (int i = 0; i < 8; ++i) { s0 += red[(i * 64 + tid) * 2]; s1 += red[(i * 64 + tid) * 2 + 1]; }
    const float bb = bias ? bias[j0 + tid] : 0.f;
    o0[j0 + tid] = s0 + bb; if (o1) o1[j0 + tid] = s1 + bb;
  }
  __syncthreads();
}

DI void s5_params(const Params& P, int gtid) {
  if (gtid >= DEPTH * 32 * 64) return;
  const int l = gtid / 2048, g = (gtid / 64) % 32, p = gtid % 64;
  const float dt = expf(P.in[8][l * 32 + g]);
  const float lr = P.in[6][(l * 32 + g) * 64 + p], li = P.in[7][(l * 32 + g) * 64 + p];
  const float mag = expf(lr * dt); const float ang = li * dt;
  double sd, cd; sincos_d((double)ang, sd, cd);
  const float ab_re = mag * (float)cd, ab_im = mag * (float)sd;
  float* o = (float*)(P.ws + WS_S5P) + (size_t)((l * 32 + g) * 64 + p) * 36;
  o[0] = ab_re; o[1] = ab_im;
  double pr = ab_re, pi = ab_im;
  for (int i = 0; i < 6; ++i) { const double nr2 = pr * pr - pi * pi, ni2 = 2.0 * pr * pi; pr = nr2; pi = ni2; }
  o[2] = (float)pr; o[3] = (float)pi;
}

DI void s5_tables(const Params& P, int l, int g, int part, unsigned char* lds) {
  const int tid = otid(), lane = tid & 63;
  float* BBr = (float*)lds; float* BBi = BBr + 1024; float* CR = BBi + 1024; float* CI = CR + 1024;
  float* APr = CI + 1024; float* APi = APr + 65 * 64;
  bf16_t* tab = (bf16_t*)(P.ws + WS_TAB + (size_t)l * TAB_LAYER);
  bf16_t* Kt = tab + TAB_KT / 2 + (size_t)g * 64 * 256; bf16_t* M1 = tab + TAB_M1 / 2 + (size_t)g * 128 * 1024; bf16_t* M2 = tab + TAB_M2 / 2 + (size_t)g * 1024 * 128;
  __syncthreads();
  if (tid < 64) {
    const int p = tid;
    const float dt = expf(P.in[8][l * 32 + g]);
    const float lr = P.in[6][(l * 32 + g) * 64 + p], li = P.in[7][(l * 32 + g) * 64 + p];
    const float mag = expf(lr * dt); const float ang = li * dt;
    double sd, cd; sincos_d((double)ang, sd, cd);
    const float ab_re = mag * (float)cd, ab_im = mag * (float)sd;
    const float den = lr * lr + li * li, nr = ab_re - 1.0f;
    const float cr = (nr * lr + ab_im * li) / den, ci = (ab_im * lr - nr * li) / den;
    const float* br = P.in[9] + (size_t)((l * 32 + g) * 64 + p) * 16; const float* bi = P.in[10] + (size_t)((l * 32 + g) * 64 + p) * 16;
    for (int h = 0; h < 16; ++h) { BBr[p * 16 + h] = cr * br[h] - ci * bi[h]; BBi[p * 16 + h] = cr * bi[h] + ci * br[h]; }
    double pr = 1.0, pi = 0.0;
    for (int tau = 0; tau <= 64; ++tau) { APr[tau * 64 + p] = (float)pr; APi[tau * 64 + p] = (float)pi; const double n1 = pr * ab_re - pi * ab_im, n2 = pr * ab_im + pi * ab_re; pr = n1; pi = n2; }
  }
  for (int i = tid; i < 1024; i += NTHR) { CR[i] = P.in[11][(size_t)(l * 32 + g) * 1024 + i]; CI[i] = P.in[12][(size_t)(l * 32 + g) * 1024 + i]; }
  __syncthreads();
  if (part < 4)
  for (int task = part * 256 + tid; task < part * 256 + 256; task += NTHR) {
    const int tau = task >> 4, h = task & 15;
    float a[16];
#pragma unroll
    for (int j = 0; j < 16; ++j) a[j] = 0.f;
    for (int p = 0; p < 64; ++p) {
      const float c_r = CR[h * 64 + p], c_i = CI[h * 64 + p], a_r = APr[tau * 64 + p], a_i = APi[tau * 64 + p];
      const float xr = c_r * a_r - c_i * a_i, xi = c_r * a_i + c_i * a_r;
#pragma unroll
      for (int j4 = 0; j4 < 4; ++j4) { const f32x4 b_r = *(const f32x4*)(BBr + p * 16 + 4 * j4), b_i = *(const f32x4*)(BBi + p * 16 + 4 * j4);
        a[4 * j4] += xr * b_r.x - xi * b_i.x; a[4 * j4 + 1] += xr * b_r.y - xi * b_i.y; a[4 * j4 + 2] += xr * b_r.z - xi * b_i.z; a[4 * j4 + 3] += xr * b_r.w - xi * b_i.w; }
    }
    u32x4 o0, o1; o0.x = pk2(a[0], a[1]); o0.y = pk2(a[2], a[3]); o0.z = pk2(a[4], a[5]); o0.w = pk2(a[6], a[7]); o1.x = pk2(a[8], a[9]); o1.y = pk2(a[10], a[11]); o1.z = pk2(a[12], a[13]); o1.w = pk2(a[14], a[15]);
    *(u32x4*)(Kt + (size_t)task * 16) = o0; *(u32x4*)(Kt + (size_t)task * 16 + 8) = o1;
  }
  if (part == 4)
  for (int task = tid; task < 4096; task += NTHR) {
    const int p = task >> 6, i = task & 63;
    const float a_r = APr[(63 - i) * 64 + p], a_i = APi[(63 - i) * 64 + p];
    float re[16], im[16];
#pragma unroll
    for (int j = 0; j < 16; ++j) { const float b_r = BBr[p * 16 + j], b_i = BBi[p * 16 + j]; re[j] = a_r * b_r - a_i * b_i; im[j] = a_r * b_i + a_i * b_r; }
    u32x4 o; bf16_t* d0 = M1 + (size_t)(2 * p) * 1024 + i * 16; bf16_t* d1 = d0 + 1024;
    o.x = pk2(re[0], re[1]); o.y = pk2(re[2], re[3]); o.z = pk2(re[4], re[5]); o.w = pk2(re[6], re[7]); *(u32x4*)d0 = o;
    o.x = pk2(re[8], re[9]); o.y = pk2(re[10], re[11]); o.z = pk2(re[12], re[13]); o.w = pk2(re[14], re[15]); *(u32x4*)(d0 + 8) = o;
    o.x = pk2(im[0], im[1]); o.y = pk2(im[2], im[3]); o.z = pk2(im[4], im[5]); o.w = pk2(im[6], im[7]); *(u32x4*)d1 = o;
    o.x = pk2(im[8], im[9]); o.y = pk2(im[10], im[11]); o.z = pk2(im[12], im[13]); o.w = pk2(im[14], im[15]); *(u32x4*)(d1 + 8) = o;
  }
  if (part == 5)
  for (int task = tid; task < 4096; task += NTHR) {
    const int th = task >> 2, pq = task & 3, t = th >> 4, h = th & 15;
    unsigned w[16];
#pragma unroll
    for (int j = 0; j < 16; ++j) { const int p = pq * 16 + j;
      const float c_r = CR[h * 64 + p], c_i = CI[h * 64 + p], a_r = APr[(t + 1) * 64 + p], a_i = APi[(t + 1) * 64 + p];
      w[j] = pk2(c_r * a_r - c_i * a_i, -(c_r * a_i + c_i * a_r)); }
    bf16_t* d = M2 + (size_t)th * 128 + pq * 32;
    *(u32x4*)d = (u32x4){w[0], w[1], w[2], w[3]}; *(u32x4*)(d + 8) = (u32x4){w[4], w[5], w[6], w[7]};
    *(u32x4*)(d + 16) = (u32x4){w[8], w[9], w[10], w[11]}; *(u32x4*)(d + 24) = (u32x4){w[12], w[13], w[14], w[15]};
  }
  __syncthreads();
}

struct ConvJob { const float* src; bf16_t* dst; int ldw, K, c0, ncols, nmat, ldd, drow0, mode; size_t sstride, dstride; };
DI int conv_nitems(const ConvJob& j) { return j.nmat * (j.K >> 6) * ((j.ncols + 31) >> 5); }
DI int conv_drow(int mode, int drow0, int n) { return mode == 0 ? drow0 + n : drow0 + ((n >> 6) * 128 + ((n >> 4) & 3) * 32 + (n & 15)); }
DI void conv_item(const ConvJob& jb, int item, float* scr, int lane) {
  const int nblk = (jb.ncols + 31) >> 5, per = (jb.K >> 6) * nblk;
  const int mat = item / per, r = item % per, kb = r / nblk, nb = r % nblk, k0 = 64 * kb, n0 = 32 * nb;
  const float* W = jb.src + (size_t)mat * jb.sstride; bf16_t* WT = jb.dst + (size_t)mat * jb.dstride;
  const int n4 = (lane & 7) * 4; const bool nok = (n0 + n4) < jb.ncols;
#pragma unroll
  for (int i = 0; i < 8; ++i) { const int kk = 8 * i + (lane >> 3);
    const f32x4 v = nok ? *(const f32x4*)(W + (size_t)(k0 + kk) * jb.ldw + jb.c0 + n0 + n4) : (f32x4){0.f, 0.f, 0.f, 0.f};
    *(f32x4*)(scr + kk * 36 + n4) = v; }
  asm volatile("s_waitcnt lgkmcnt(0)" ::: "memory");
  const int c = lane & 7;
#pragma unroll
  for (int j = 0; j < 4; ++j) {
    const int n = (lane >> 3) + 8 * j; const float* sp = scr + (8 * c) * 36 + n;
    u32x4 o; o.x = pk2(sp[0], sp[36]); o.y = pk2(sp[72], sp[108]); o.z = pk2(sp[144], sp[180]); o.w = pk2(sp[216], sp[252]);
    if (n0 + n < jb.ncols) *(u32x4*)(WT + (size_t)conv_drow(jb.mode, jb.drow0, n0 + n) * jb.ldd + k0 + 8 * c) = o;
  }
  asm volatile("s_waitcnt lgkmcnt(0)" ::: "memory");
}
DI ConvJob conv_job(const Params& P, int l, int j) {
  unsigned char* wb = P.ws + WS_W; ConvJob J; J.nmat = 1; J.mode = 0; J.sstride = 0; J.dstride = 0; J.drow0 = 0; J.c0 = 0;
  const float* win = P.in[5] + (size_t)l * 1024 * INW;
  if (j < 5) { J.src = win; J.ldw = INW; J.K = 1024; J.dst = (bf16_t*)(wb + W_IN); J.ldd = 1024;
    if (j == 0) { J.c0 = 0; J.ncols = 1024; J.drow0 = 0; }
    else if (j == 1) { J.c0 = 1024; J.ncols = 1536; J.drow0 = 1024; }
    else if (j == 2) { J.c0 = 3120; J.ncols = 2048; J.drow0 = 2560; }
    else if (j == 3) { J.c0 = 2608; J.ncols = 512; J.drow0 = 4608; }
    else { J.c0 = 2560; J.ncols = 48; J.drow0 = 5120; }
  } else if (j == 5) { J.src = P.in[14] + (size_t)l * 512 * 512; J.ldw = 512; J.K = 512; J.ncols = 512; J.dst = (bf16_t*)(wb + W_GLU); J.ldd = 512; }
  else if (j == 6) { J.src = P.in[19] + (size_t)l * 1024 * 1024; J.ldw = 1024; J.K = 1024; J.ncols = 1024; J.dst = (bf16_t*)(wb + W_O); J.ldd = 1024; }
  else if (j == 7) { J.src = P.in[15] + (size_t)l * 512 * 1024; J.ldw = 1024; J.K = 512; J.ncols = 1024; J.dst = (bf16_t*)(wb + W_SO); J.ldd = 512; }
  else if (j == 8) { J.src = P.in[20] + (size_t)l * 1024 * 1024; J.ldw = 1024; J.K = 1024; J.ncols = 1024; J.dst = (bf16_t*)(wb + W_OUT); J.ldd = 1024; }
  else if (j == 9) { J.src = P.in[17] + (size_t)l * 2 * 2048 * 256; J.ldw = 256; J.K = 2048; J.ncols = 256; J.nmat = 2; J.sstride = 2048 * 256; J.dstride = 256 * 2048; J.dst = (bf16_t*)(wb + W_C1); J.ldd = 2048; }
  else if (j == 10) { J.src = P.in[18] + (size_t)l * 2 * 256 * 64; J.ldw = 64; J.K = 256; J.ncols = 64; J.nmat = 2; J.sstride = 256 * 64; J.dstride = 128 * 256; J.dst = (bf16_t*)(wb + W_C2); J.ldd = 256; }
  else if (j == 11) { J.src = P.in[26] + (size_t)l * 32 * 1024 * 256; J.ldw = 256; J.K = 1024; J.ncols = 256; J.nmat = 32; J.sstride = 1024 * 256; J.dstride = 512 * 1024; J.dst = (bf16_t*)(wb + W_GU); J.ldd = 1024; J.mode = 1; J.drow0 = 0; }
  else if (j == 12) { J.src = P.in[27] + (size_t)l * 32 * 1024 * 256; J.ldw = 256; J.K = 1024; J.ncols = 256; J.nmat = 32; J.sstride = 1024 * 256; J.dstride = 512 * 1024; J.dst = (bf16_t*)(wb + W_GU); J.ldd = 1024; J.mode = 1; J.drow0 = 16; }
  else { J.src = P.in[28] + (size_t)l * 32 * 256 * 1024; J.ldw = 1024; J.K = 256; J.ncols = 1024; J.nmat = 32; J.sstride = 256 * 1024; J.dstride = 1024 * 256; J.dst = (bf16_t*)(wb + W_D); J.ldd = 256; }
  return J;
}
DI void convert_weights(const Params& P_, int l, unsigned char* lds) {
  Params P = P_; { size_t z_ = 0; asm volatile("" : "+s"(z_)); P.ws = P_.ws + z_; }
  const int tid_ = otid(), bid = obid(), wave = tid_ >> 6, lane = tid_ & 63; (void)bid;
  float* scr = (float*)lds + wave * (64 * 36);
  const int NGW = gridDim.x * NWAVE; int off = bid * NWAVE + wave;
  for (int j = 0; j < 14; ++j) {
    const ConvJob J = conv_job(P, l, j); const int n = conv_nitems(J);
    while (off < n) { conv_item(J, off, scr, lane); off += NGW; }
    off -= n;
  }
}

template <int MODE>
DI void norm_simple(const Params& P_, int l) {
  Params P = P_; { size_t z_ = 0; asm volatile("" : "+s"(z_)); P.ws = P_.ws + z_; }
  const int tid_ = otid(), bid = obid(), wave = tid_ >> 6, lane = tid_ & 63; (void)bid;
  const int NGW = gridDim.x * NWAVE;
  const float* mod = (const float*)(P.ws + WS_MOD);
  const bf16_t* ys = (const bf16_t*)(P.ws + WS_F);
  bf16_t* xn = (bf16_t*)(P.ws + WS_A);
  const float* xbase = MODE == 0 ? P.in[0] : P.out;
  constexpr bool ADDY = (MODE != 0) && EN_MOE;
  f32x4 g[4], sh[4], sc[4], gg[4]; int pb = -1;
  { const float* gp = MODE == 3 ? P.in[29] : P.in[4] + (size_t)l * DM;
#pragma unroll
    for (int j = 0; j < 4; ++j) g[j] = *(const f32x4*)(gp + 4 * lane + 256 * j); }
  f32x4 v[4]; u32x2 y0[4], y1[4];
#define NS_LOAD(vv, a0, a1, rr) do { const float* xr_ = xbase + (size_t)(rr) * DM; \
    _Pragma("unroll") for (int j = 0; j < 4; ++j) vv[j] = *(const f32x4*)(xr_ + 4 * lane + 256 * j); \
    if (ADDY) { _Pragma("unroll") for (int j = 0; j < 4; ++j) { a0[j] = *(const u32x2*)(ys + (size_t)((rr) * 2) * DM + 4 * lane + 256 * j); a1[j] = *(const u32x2*)(ys + (size_t)((rr) * 2 + 1) * DM + 4 * lane + 256 * j); } } } while (0)
  const int row0 = bid * NWAVE + wave;
  if (row0 < NT) NS_LOAD(v, y0, y1, row0);
  for (int row = row0; row < NT; row += NGW) {
    const int b = row >> 13;
    if (b != pb) { pb = b;
      if (ADDY) { const float* g2 = mod + (size_t)(((MODE == 1 ? 0 : 1) * 2 + b) * 6144) + 5120;
#pragma unroll
        for (int j = 0; j < 4; ++j) gg[j] = *(const f32x4*)(g2 + 4 * lane + 256 * j); }
      if (MODE != 3) { const float* md = mod + (size_t)((l * 2 + b) * 6144);
#pragma unroll
        for (int j = 0; j < 4; ++j) { sh[j] = *(const f32x4*)(md + 4 * lane + 256 * j); sc[j] = *(const f32x4*)(md + 1024 + 4 * lane + 256 * j); } }
    }
    f32x4 vn[4]; u32x2 y0n[4], y1n[4];
    if (row + NGW < NT) NS_LOAD(vn, y0n, y1n, row + NGW);
    __builtin_amdgcn_sched_barrier(0);
    if (ADDY) {
#pragma unroll
      for (int j = 0; j < 4; ++j) {
        v[j].x += gg[j].x * (bflo(y0[j].x) + bflo(y1[j].x)); v[j].y += gg[j].y * (bfhi(y0[j].x) + bfhi(y1[j].x));
        v[j].z += gg[j].z * (bflo(y0[j].y) + bflo(y1[j].y)); v[j].w += gg[j].w * (bfhi(y0[j].y) + bfhi(y1[j].y));
      }
    }
    float ss = 0.f;
#pragma unroll
    for (int j = 0; j < 4; ++j) ss += v[j].x * v[j].x + v[j].y * v[j].y + v[j].z * v[j].z + v[j].w * v[j].w;
    ss = wave_sum(ss);
    const float inv = rsqrtf(ss * (1.f / DM) + EPS);
    if (MODE == 3) {
#pragma unroll
      for (int j = 0; j < 4; ++j) { const int col = 4 * lane + 256 * j; *(f32x4*)(P.out + (size_t)row * DM + col) = v[j] * inv * g[j]; }
    } else {
      if (MODE == 1) {
#pragma unroll
        for (int j = 0; j < 4; ++j) *(f32x4*)(P.out + (size_t)row * DM + 4 * lane + 256 * j) = v[j];
      }
#pragma unroll
      for (int j = 0; j < 4; ++j) {
        const int col = 4 * lane + 256 * j;
        const f32x4 h = v[j] * inv * g[j] * (sc[j] + 1.f) + sh[j];
        u32x2 o; o.x = pk2(h.x, h.y); o.y = pk2(h.z, h.w);
        *(u32x2*)(xn + (size_t)row * DM + col) = o;
      }
    }
#pragma unroll
    for (int j = 0; j < 4; ++j) { v[j] = vn[j]; y0[j] = y0n[j]; y1[j] = y1n[j]; }
  }
#undef NS_LOAD
}

constexpr int RT_HS = 1028;
DI void norm_route(const Params& P_, int l, unsigned char* lds) {
  Params P = P_; { size_t z_ = 0; asm volatile("" : "+s"(z_)); P.ws = P_.ws + z_; }
  const int tid = otid(), bid = obid(), wave = tid >> 6, lane = tid & 63;
  const float* mod = (const float*)(P.ws + WS_MOD);
  bf16_t* h2 = (bf16_t*)(P.ws + WS_A);
  float* hs = (float*)lds;
  float* Wc = (float*)lds + 32 * RT_HS;
  const float* wg = P.in[22] + (size_t)l * DM * 4; const float* we = P.in[24] + (size_t)l * DM * 32;
  const float* bg = P.in[23] + l * 4; const float* be = P.in[25] + l * 32;
  int* cnt = (int*)(P.ws + WS_CNT) + l * 32; int* list = (int*)(P.ws + WS_LIST); float* wts = (float*)(P.ws + WS_WT);
  const int rg = wave >> 2, kq = wave & 3;
  for (int grp = bid; grp < NT / 32; grp += gridDim.x) {
    const int row0 = grp * 32 + wave * 4, b = row0 >> 13;
    const float* ng = P.in[21] + (size_t)l * DM; const float* md = mod + (size_t)((l * 2 + b) * 6144);
    {
      f32x4 v[4][4];
#pragma unroll
      for (int r = 0; r < 4; ++r)
#pragma unroll
        for (int j = 0; j < 4; ++j) v[r][j] = *(const f32x4*)(P.out + (size_t)(row0 + r) * DM + 4 * lane + 256 * j);
      float inv[4];
#pragma unroll
      for (int r = 0; r < 4; ++r) { float ss = 0.f;
#pragma unroll
        for (int j = 0; j < 4; ++j) ss += v[r][j].x * v[r][j].x + v[r][j].y * v[r][j].y + v[r][j].z * v[r][j].z + v[r][j].w * v[r][j].w;
        inv[r] = rsqrtf(wave_sum(ss) * (1.f / DM) + EPS); }
#pragma unroll
      for (int j = 0; j < 4; ++j) {
        const int col = 4 * lane + 256 * j;
        const f32x4 g = *(const f32x4*)(ng + col), sh = *(const f32x4*)(md + 3072 + col), sc = *(const f32x4*)(md + 4096 + col);
#pragma unroll
        for (int r = 0; r < 4; ++r) {
          const f32x4 hh = v[r][j] * inv[r] * g * (sc + 1.f) + sh;
          u32x2 o; o.x = pk2(hh.x, hh.y); o.y = pk2(hh.z, hh.w);
          *(u32x2*)(h2 + (size_t)(row0 + r) * DM + col) = o;
          *(f32x4*)(hs + (wave * 4 + r) * RT_HS + col) = hh;
        }
      }
    }
    f32x4 we0, we1, wg0 = {0.f, 0.f, 0.f, 0.f};
#define WLOAD(kc) do { we0 = *(const f32x4*)(we + (size_t)(kc) * 4096 + tid * 4); we1 = *(const f32x4*)(we + (size_t)(kc) * 4096 + 2048 + tid * 4); if (tid < 128) wg0 = *(const f32x4*)(wg + (size_t)(kc) * 512 + tid * 4); } while (0)
#define WSTORE() do { *(f32x4*)(Wc + (tid >> 3) * 36 + (tid & 7) * 4) = we0; *(f32x4*)(Wc + (64 + (tid >> 3)) * 36 + (tid & 7) * 4) = we1; if (tid < 128) *(f32x4*)(Wc + tid * 36 + 32) = wg0; } while (0)
    WLOAD(0);
    f32x4 acc0 = {0.f, 0.f, 0.f, 0.f}, acc1 = acc0, acc2 = acc0;
    for (int kc = 0; kc < 8; ++kc) {
      __syncthreads();
      WSTORE();
      if (kc + 1 < 8) WLOAD(kc + 1);
      __syncthreads();
      const float* ap = hs + (rg * 16 + (lane & 15)) * RT_HS + kc * 128 + kq * 32 + (lane >> 4);
      const float* bp = Wc + (kq * 32 + (lane >> 4)) * 36 + (lane & 15);
#pragma unroll
      for (int ks = 0; ks < 8; ++ks) {
        const float av = ap[4 * ks];
        const float b0 = bp[(4 * ks) * 36], b1 = bp[(4 * ks) * 36 + 16], b2 = (lane & 15) < 4 ? bp[(4 * ks) * 36 + 32] : 0.f;
        acc0 = __builtin_amdgcn_mfma_f32_16x16x4f32(av, b0, acc0, 0, 0, 0);
        acc1 = __builtin_amdgcn_mfma_f32_16x16x4f32(av, b1, acc1, 0, 0, 0);
        acc2 = __builtin_amdgcn_mfma_f32_16x16x4f32(av, b2, acc2, 0, 0, 0);
      }
    }
#undef WLOAD
#undef WSTORE
    __syncthreads();
    {
      float* part = hs + kq * (32 * 40);
#pragma unroll
      for (int i = 0; i < 4; ++i) { const int row = rg * 16 + 4 * (lane >> 4) + i, col = lane & 15;
        part[row * 40 + col] = acc0[i]; part[row * 40 + 16 + col] = acc1[i]; if (col < 4) part[row * 40 + 32 + col] = acc2[i]; }
    }
    __syncthreads();
    if (tid < 32) {
      const int row = grp * 32 + tid;
      float L[36];
#pragma unroll
      for (int o = 0; o < 36; ++o) L[o] = (hs[tid * 40 + o] + hs[1280 + tid * 40 + o]) + (hs[2560 + tid * 40 + o] + hs[3840 + tid * 40 + o]);
      float gm = -1e30f; int gi = 0;
#pragma unroll
      for (int i = 0; i < 4; ++i) { const float v = L[32 + i] + bg[i]; if (v > gm) { gm = v; gi = i; } }
      float gs = 0.f;
#pragma unroll
      for (int i = 0; i < 4; ++i) gs += expf(L[32 + i] + bg[i] - gm);
      const float gp = 1.f / gs;
      float el[8];
#pragma unroll
      for (int i = 0; i < 8; ++i) el[i] = (gi == 0 ? L[i] : gi == 1 ? L[8 + i] : gi == 2 ? L[16 + i] : L[24 + i]) + be[gi * 8 + i];
      float em = -1e30f;
#pragma unroll
      for (int i = 0; i < 8; ++i) em = fmaxf(em, el[i]);
      float p1 = -1.f, p2 = -1.f; int i1 = 0, i2 = 0;
#pragma unroll
      for (int i = 0; i < 8; ++i) {
        const float pe = expf(el[i] - em);
        if (pe > p1) { p2 = p1; i2 = i1; p1 = pe; i1 = i; } else if (pe > p2) { p2 = pe; i2 = i; }
      }
      const float w1 = gp * p1 / (p1 + p2), w2 = gp * p2 / (p1 + p2);
      const int e1 = gi * 8 + i1, e2 = gi * 8 + i2;
      const int pos1 = atomicAdd(&cnt[e1], 1); list[e1 * LISTCAP + pos1] = row * 2; wts[row * 2] = w1;
      const int pos2 = atomicAdd(&cnt[e2], 1); list[e2 * LISTCAP + pos2] = row * 2 + 1; wts[row * 2 + 1] = w2;
    }
    __syncthreads();
  }
}

namespace pg8 {
#define PG8_LAS __attribute__((address_space(3)))
typedef unsigned short bf16_t;
typedef short bf16x8 __attribute__((ext_vector_type(8)));
typedef float f32x4 __attribute__((ext_vector_type(4)));
typedef unsigned u32x4 __attribute__((ext_vector_type(4)));
constexpr int BM = 256, BK = 64, HALF = 128, HTB = HALF * BK * 2  , STAGE_BYTES = 8 * HTB, NXCD = 8, WGM = 8;

__host__ __device__ __forceinline__ int lds_byte(int r, int c) { const int st = (r >> 4) * 2 + (c >> 5), rr = r & 15, cc = c & 31, ob = rr * 64 + cc * 2; return st * 1024 + (ob ^ (((ob >> 9) & 1) << 5)); }
__host__ __device__ __forceinline__ void stage_rc(int b, int& R, int& C) { const int st = b / 1024, sb = b % 1024, swz = sb ^ (((sb >> 9) & 1) << 5); R = (st >> 1) * 16 + swz / 64; C = (st & 1) * 32 + (swz % 64) / 2; }
__host__ __device__ __forceinline__ int perm32(int rho) { const int n = rho >> 4, i = rho & 15; return 8 * (i >> 2) + 4 * n + (i & 3); }

struct Unit { int pm, pn; };
struct Gemm { const bf16_t* A; const bf16_t* Bt; int M, N, K; };

struct StaticOrder {
    int nM, nN, nwg, G, c;
    __host__ __device__ void init(int M, int N, int G_, int c_) { nM = M / BM; nN = N / BM; nwg = nM * nN; G = G_; c = c_; }
    __host__ __device__ bool next(int i, Unit& u) const {
        const long L = (long)i * G + c; if (L >= nwg) return false;
        int wgid = (int)L; { const int q = nwg / NXCD, r = nwg % NXCD, xcd = wgid % NXCD, off = wgid / NXCD; wgid = (xcd < r ? xcd * (q + 1) : r * (q + 1) + (xcd - r) * q) + off; }
        const int nig = WGM * nN, gid = wgid / nig, fm = gid * WGM, gsz = (nM - fm) < WGM ? (nM - fm) : WGM;
        u.pm = fm + ((wgid % nig) % gsz); u.pn = (wgid % nig) / gsz; return true;
    }
    __device__ __forceinline__ void a_ready(const Unit&) const {}
    __device__ __forceinline__ void done(const Unit&) const {}
};
template <class Epi, class Sched, bool ALIGN_EPI = false, bool SP2 = false>
__device__ __forceinline__ void gemm_phase(PG8_LAS unsigned char* lds, const Gemm g, const Sched& S, const Epi& E) {
    const int tid = otid(), wid = __builtin_amdgcn_readfirstlane(tid >> 6), lane = tid & 63, wr = wid >> 2, wc = wid & 3, fr = lane & 15, fq = lane >> 4;
    const int K = g.K, nt = K / BK;
    unsigned voffA[2], voffB[2];
#pragma unroll
    for (int i = 0; i < 2; ++i) { int R, C; stage_rc(tid * 16 + i * 8192, R, C); const int Rb = Epi::PERM ? ((R & ~31) + perm32(R & 31)) : R;
        voffA[i] = (unsigned)(R * K + C) * 2u; voffB[i] = (unsigned)(Rb * K + C) * 2u; }
    const size_t kstep = (size_t)(BK * 2);
    const size_t hstep = (size_t)HALF * K * 2;
    const size_t tstep = 2 * hstep;
    const unsigned ldsw = (unsigned)wid * 1024u;
    const int aoff = lds_byte(wr * 64 + fr, fq * 8), boff = lds_byte(wc * 32 + fr, fq * 8);
#define PG8_SA(b, h) (((b) * 2 + (h)) * HTB)
#define PG8_SB(b, h) ((4 + (b) * 2 + (h)) * HTB)
#define PG8_STAGE(bufoff, gbase, voff) do { _Pragma("unroll") for (int _i = 0; _i < 2; ++_i) \
        __builtin_amdgcn_global_load_lds((const unsigned*)((const char*)(gbase) + (voff)[_i]), (PG8_LAS unsigned*)(lds + (bufoff) + ldsw + _i * 8192), 16, 0, 0); } while (0)
#define PG8_LDA(dst, b, h) do { _Pragma("unroll") for (int m = 0; m < 4; ++m) _Pragma("unroll") for (int k = 0; k < 2; ++k) dst[m][k] = *(const PG8_LAS bf16x8*)(lds + PG8_SA(b, h) + aoff + m * 2048 + k * 1024); } while (0)
#define PG8_LDB(dst, b, h) do { _Pragma("unroll") for (int n = 0; n < 2; ++n) _Pragma("unroll") for (int k = 0; k < 2; ++k) dst[n][k] = *(const PG8_LAS bf16x8*)(lds + PG8_SB(b, h) + boff + n * 2048 + k * 1024); } while (0)
#define PG8_MMA(ai, bj, At, Bt) do { __builtin_amdgcn_s_setprio(1); _Pragma("unroll") for (int m = 0; m < 4; ++m) _Pragma("unroll") for (int n = 0; n < 2; ++n) _Pragma("unroll") for (int k = 0; k < 2; ++k) \
        acc[ai][bj][m][n] = __builtin_amdgcn_mfma_f32_16x16x32_bf16(Bt[n][k], At[m][k], acc[ai][bj][m][n], 0, 0, 0); __builtin_amdgcn_s_setprio(0); } while (0)
#define PG8_WAIT_V(n) asm volatile("s_waitcnt vmcnt(" #n ")" ::: "memory")
#define PG8_WAIT_L(n) asm volatile("s_waitcnt lgkmcnt(" #n ")" ::: "memory")
#define PG8_BAR __builtin_amdgcn_s_barrier()
#define PG8_SCHED __builtin_amdgcn_sched_barrier(0)
    Unit cur, nxt; int ui = 0;
    if (!S.next(0, cur)) return;
    f32x4 acc[2][2][4][2];
#pragma unroll
    for (int a = 0; a < 2; ++a)
#pragma unroll
        for (int b = 0; b < 2; ++b)
#pragma unroll
            for (int m = 0; m < 4; ++m)
#pragma unroll
                for (int n = 0; n < 2; ++n) acc[a][b][m][n] = (f32x4){0.f, 0.f, 0.f, 0.f};
    bf16x8 At[4][2], B0[2][2], B1[2][2];
    const char* cA = (const char*)g.A + (size_t)cur.pm * tstep; const char* cB = (const char*)g.Bt + (size_t)cur.pn * tstep;
    S.a_ready(cur);
    if constexpr (SP2) {
        PG8_STAGE(PG8_SB(0, 0), cB, voffB); PG8_STAGE(PG8_SB(0, 1), cB + hstep, voffB); PG8_STAGE(PG8_SA(0, 0), cA, voffA); PG8_STAGE(PG8_SA(0, 1), cA + hstep, voffA);
        if (wr == 1) PG8_BAR;
        PG8_WAIT_V(2); PG8_BAR;
        PG8_STAGE(PG8_SB(1, 0), cB + kstep, voffB); PG8_STAGE(PG8_SA(1, 0), cA + kstep, voffA); PG8_STAGE(PG8_SB(1, 1), cB + hstep + kstep, voffB);
        PG8_WAIT_V(6); PG8_BAR;
    } else {
        PG8_STAGE(PG8_SB(0, 0), cB, voffB); PG8_STAGE(PG8_SA(0, 0), cA, voffA); PG8_STAGE(PG8_SB(0, 1), cB + hstep, voffB); PG8_STAGE(PG8_SA(0, 1), cA + hstep, voffA);
        if (wr == 1) PG8_BAR;
        PG8_WAIT_V(4); PG8_BAR;
        PG8_STAGE(PG8_SB(1, 0), cB + kstep, voffB); PG8_STAGE(PG8_SA(1, 0), cA + kstep, voffA); PG8_STAGE(PG8_SB(1, 1), cB + hstep + kstep, voffB);
        PG8_WAIT_V(6); PG8_BAR;
    }
    for (;;) {
        const bool has_next = S.next(ui + 1, nxt);
        const char* nA = has_next ? (const char*)g.A + (size_t)nxt.pm * tstep : cA; const char* nB = has_next ? (const char*)g.Bt + (size_t)nxt.pn * tstep : cB;
        for (int t = 0; t < nt; t += 2) {
            const bool last = (t == nt - 2);
            const char* a1 = cA + (size_t)(t + 1) * kstep;
            const char* a2 = last ? nA : cA + (size_t)(t + 2) * kstep; const char* b2 = last ? nB : cB + (size_t)(t + 2) * kstep;
            const char* a3 = a2 + kstep; const char* b3 = b2 + kstep;
            if (last && has_next) S.a_ready(nxt);
            if constexpr (SP2) {
            PG8_LDB(B0, 0, 0); PG8_LDB(B1, 0, 1); PG8_SCHED; PG8_LDA(At, 0, 0); PG8_STAGE(PG8_SA(1, 1), a1 + hstep, voffA);
            PG8_WAIT_V(8); PG8_WAIT_L(0); PG8_BAR; PG8_MMA(0, 0, At, B0); PG8_MMA(0, 1, At, B1); PG8_BAR; PG8_SCHED;
            PG8_LDA(At, 0, 1); PG8_STAGE(PG8_SB(0, 0), b2, voffB); PG8_STAGE(PG8_SB(0, 1), b2 + hstep, voffB); PG8_STAGE(PG8_SA(0, 0), a2, voffA);
            PG8_WAIT_V(8); PG8_WAIT_L(0); PG8_BAR; PG8_MMA(1, 0, At, B0); PG8_MMA(1, 1, At, B1); PG8_BAR; PG8_SCHED;
            PG8_LDB(B0, 1, 0); PG8_LDB(B1, 1, 1); PG8_SCHED; PG8_LDA(At, 1, 0); PG8_STAGE(PG8_SA(0, 1), a2 + hstep, voffA);
            PG8_WAIT_V(8); PG8_WAIT_L(0); PG8_BAR; PG8_MMA(0, 0, At, B0); PG8_MMA(0, 1, At, B1); PG8_BAR; PG8_SCHED;
            PG8_LDA(At, 1, 1); PG8_STAGE(PG8_SB(1, 0), b3, voffB); PG8_STAGE(PG8_SB(1, 1), b3 + hstep, voffB); PG8_STAGE(PG8_SA(1, 0), a3, voffA);
            PG8_WAIT_V(8); PG8_WAIT_L(0); PG8_BAR; PG8_MMA(1, 0, At, B0); PG8_MMA(1, 1, At, B1); PG8_BAR; PG8_SCHED;
            } else {
            PG8_LDB(B0, 0, 0); PG8_SCHED; PG8_LDA(At, 0, 0); PG8_STAGE(PG8_SA(1, 1), a1 + hstep, voffA);
            PG8_WAIT_L(8); PG8_BAR; PG8_WAIT_L(0); PG8_MMA(0, 0, At, B0); PG8_BAR; PG8_SCHED;
            PG8_LDB(B1, 0, 1); PG8_STAGE(PG8_SB(0, 0), b2, voffB);
            PG8_BAR; PG8_WAIT_L(0); PG8_MMA(0, 1, At, B1); PG8_BAR;
            PG8_LDA(At, 0, 1); PG8_STAGE(PG8_SA(0, 0), a2, voffA);
            PG8_BAR; PG8_WAIT_L(0); PG8_MMA(1, 0, At, B0); PG8_BAR; PG8_SCHED;
            PG8_STAGE(PG8_SB(0, 1), b2 + hstep, voffB);
            PG8_WAIT_V(6); PG8_BAR; PG8_MMA(1, 1, At, B1); PG8_BAR;
            PG8_LDB(B0, 1, 0); PG8_SCHED; PG8_LDA(At, 1, 0); PG8_STAGE(PG8_SA(0, 1), a2 + hstep, voffA);
            PG8_WAIT_L(8); PG8_BAR; PG8_WAIT_L(0); PG8_MMA(0, 0, At, B0); PG8_BAR; PG8_SCHED;
            PG8_LDB(B1, 1, 1); PG8_STAGE(PG8_SB(1, 0), b3, voffB);
            PG8_BAR; PG8_WAIT_L(0); PG8_MMA(0, 1, At, B1); PG8_BAR;
            PG8_LDA(At, 1, 1); PG8_STAGE(PG8_SA(1, 0), a3, voffA);
            PG8_BAR; PG8_WAIT_L(0); PG8_MMA(1, 0, At, B0); PG8_BAR; PG8_SCHED;
            PG8_STAGE(PG8_SB(1, 1), b3 + hstep, voffB);
            PG8_WAIT_V(6); PG8_BAR; PG8_MMA(1, 1, At, B1); PG8_BAR;
            }
        }
        if constexpr (ALIGN_EPI) { if (wr == 0) PG8_BAR; }
        if constexpr (!Epi::AFTER_DRAIN) { E(acc, cur, wr, wc, fr, fq); S.done(cur); }
        if (!has_next) break;
#pragma unroll
        for (int a = 0; a < 2; ++a)
#pragma unroll
            for (int b = 0; b < 2; ++b)
#pragma unroll
                for (int m = 0; m < 4; ++m)
#pragma unroll
                    for (int n = 0; n < 2; ++n) acc[a][b][m][n] = (f32x4){0.f, 0.f, 0.f, 0.f};
        cur = nxt; cA = nA; cB = nB; ++ui;
        if constexpr (ALIGN_EPI) { if (wr == 1) PG8_BAR; }
    }
    PG8_WAIT_V(0);
    if constexpr (!ALIGN_EPI) { if (wr == 0) PG8_BAR; }
    PG8_BAR;
    if constexpr (Epi::AFTER_DRAIN) { E.fused(acc, cur, wr, wc, fr, fq, lds, wid, lane); S.done(cur); }
#undef PG8_SA
#undef PG8_SB
#undef PG8_STAGE
#undef PG8_LDA
#undef PG8_LDB
#undef PG8_MMA
#undef PG8_WAIT_V
#undef PG8_WAIT_L
#undef PG8_BAR
#undef PG8_SCHED
}
}

constexpr int GT_ROWB = 128, GT_A = 0, GT_B = 128 * GT_ROWB, GT_STAGE = 2 * 128 * GT_ROWB;
#define GT_WOFF(lr_, tid_) ((lr_) * GT_ROWB + ((((tid_) & 7) ^ ((lr_) & 7)) * 16))
#define GT_RSW(ks_, fq_, fr_) ((((ks_) * 4 + (fq_)) ^ ((fr_) & 7)) * 16)
DI void gemm_kloop(unsigned char* lds, const bf16_t* a0, const bf16_t* a1, int a_kadv, const bf16_t* b0, const bf16_t* b1, int nk, f32x4 (&acc)[4][2]) {
  const int tid = otid(), lane = tid & 63, wid = tid >> 6, wr = wid >> 2, wc = wid & 3, fr = lane & 15, fq = lane >> 4;
  const int lr = tid >> 3, lkb = (tid & 7) * 16;
  u32x4 xa0, xa1, xb0, xb1, ya0, ya1, yb0, yb1;
#define GT_GLOAD(p0_, p1_, q0_, q1_, kt) do { p0_ = *(const u32x4*)(a0 + (size_t)(kt) * a_kadv); p1_ = *(const u32x4*)(a1 + (size_t)(kt) * a_kadv); q0_ = *(const u32x4*)(b0 + (kt) * 64); q1_ = *(const u32x4*)(b1 + (kt) * 64); } while (0)
#define GT_LSTORE(p0_, p1_, q0_, q1_, buf) do { unsigned char* s_ = lds + (buf) * GT_STAGE; \
    *(u32x4*)(s_ + GT_A + GT_WOFF(lr, tid)) = p0_; *(u32x4*)(s_ + GT_A + 64 * GT_ROWB + GT_WOFF(lr, tid)) = p1_; \
    *(u32x4*)(s_ + GT_B + GT_WOFF(lr, tid)) = q0_; *(u32x4*)(s_ + GT_B + 64 * GT_ROWB + GT_WOFF(lr, tid)) = q1_; } while (0)
#define GT_COMPUTE(buf) do { \
    const unsigned char* As = lds + (buf) * GT_STAGE + GT_A + (wr * 64 + fr) * GT_ROWB; \
    const unsigned char* Bs = lds + (buf) * GT_STAGE + GT_B + (wc * 32 + fr) * GT_ROWB; \
    _Pragma("unroll") for (int ks = 0; ks < 2; ++ks) { \
      bf16x8 af[4], bfr[2]; \
      _Pragma("unroll") for (int m = 0; m < 4; ++m) af[m] = *(const bf16x8*)(As + m * 16 * GT_ROWB + GT_RSW(ks, fq, fr)); \
      _Pragma("unroll") for (int n = 0; n < 2; ++n) bfr[n] = *(const bf16x8*)(Bs + n * 16 * GT_ROWB + GT_RSW(ks, fq, fr)); \
      _Pragma("unroll") for (int m = 0; m < 4; ++m) _Pragma("unroll") for (int n = 0; n < 2; ++n) acc[m][n] = __builtin_amdgcn_mfma_f32_16x16x32_bf16(bfr[n], af[m], acc[m][n], 0, 0, 0); } } while (0)
  GT_GLOAD(xa0, xa1, xb0, xb1, 0); GT_LSTORE(xa0, xa1, xb0, xb1, 0); if (nk > 1) GT_GLOAD(ya0, ya1, yb0, yb1, 1); __syncthreads();
  for (int kt = 0; kt < nk; kt += 2) {
    if (kt + 2 < nk) GT_GLOAD(xa0, xa1, xb0, xb1, kt + 2);
    GT_COMPUTE(0);
    if (kt + 1 < nk) GT_LSTORE(ya0, ya1, yb0, yb1, 1);
    __syncthreads();
    if (kt + 1 >= nk) break;
    if (kt + 3 < nk) GT_GLOAD(ya0, ya1, yb0, yb1, kt + 3);
    GT_COMPUTE(1);
    if (kt + 2 < nk) GT_LSTORE(xa0, xa1, xb0, xb1, 0);
    __syncthreads();
  }
#undef GT_GLOAD
#undef GT_LSTORE
#undef GT_COMPUTE
}
#define ACC_ZERO(acc) do { _Pragma("unroll") for (int m_ = 0; m_ < 4; ++m_) _Pragma("unroll") for (int n_ = 0; n_ < 2; ++n_) acc[m_][n_] = (f32x4){0.f, 0.f, 0.f, 0.f}; } while (0)
#define TILE_IDS const int tid = otid(), bid = obid(), lane = tid & 63, wid = tid >> 6, wr = wid >> 2, wc = wid & 3, fr = lane & 15, fq = lane >> 4, lr = tid >> 3, lk = (tid & 7) * 8; (void)bid; (void)lane; (void)wr; (void)wc; (void)fr; (void)fq; (void)lr; (void)lk

DI void phase_gates(const Params& P_, unsigned char* lds) {
  Params P = P_; { size_t z_ = 0; asm volatile("" : "+s"(z_)); P.ws = P_.ws + z_; }
  TILE_IDS;
  const bf16_t* xn = (const bf16_t*)(P.ws + WS_A); const bf16_t* wt = (const bf16_t*)(P.ws + WS_W + W_IN) + (size_t)5120 * DM; float* gates = (float*)(P.ws + WS_GATES);
  for (int tile = (int)gridDim.x - 1 - bid; tile < NT / 128; tile += gridDim.x) {
    const int row0 = tile * 128;
    f32x4 acc[4][2]; ACC_ZERO(acc);
    gemm_kloop(lds, xn + (size_t)(row0 + lr) * DM + lk, xn + (size_t)(row0 + lr + 64) * DM + lk, 64, wt + (size_t)lr * DM + lk, wt + (size_t)(lr + 64) * DM + lk, DM / 64, acc);
#pragma unroll
    for (int m = 0; m < 4; ++m)
#pragma unroll
      for (int n = 0; n < 2; ++n) {
        const int row = row0 + wr * 64 + m * 16 + fr, c2 = wc * 32 + n * 16 + 4 * fq; const f32x4 v = acc[m][n];
        if (c2 < 48) { f32x4 o = {sigmoidf_(v.x), sigmoidf_(v.y), sigmoidf_(v.z), sigmoidf_(v.w)}; *(f32x4*)(gates + (size_t)row * 48 + c2) = o; }
      }
  }
}
DI void phase_cmp1(const Params& P_, int l, unsigned char* lds) {
  Params P = P_; { size_t z_ = 0; asm volatile("" : "+s"(z_)); P.ws = P_.ws + z_; }
  TILE_IDS;
  const bf16_t* kvk = (const bf16_t*)(P.ws + WS_C); bf16_t* hid = (bf16_t*)(P.ws + WS_HID);
  const float* cb = (const float*)(P.ws + WS_CB) + l * 512;
  for (int tile = bid; tile < 128; tile += gridDim.x) {
    const int kv = tile >> 6, rt = (tile >> 1) & 31, ct = tile & 1, row0 = rt * 128, col0 = ct * 128;
    const bf16_t* wt = (const bf16_t*)(P.ws + WS_W + W_C1) + (size_t)kv * 256 * 2048;
    const bf16_t* ap[2];
#pragma unroll
    for (int i = 0; i < 2; ++i) { const int rr = row0 + lr + 64 * i, b = rr >> 11, n = (rr >> 2) & 511, g = rr & 3, nn = n > 510 ? 510 : n;
      ap[i] = kvk + (size_t)(b * SEQ + 16 * nn) * DM + kv * 256 + g * 64 + lk; }
    f32x4 acc[4][2]; ACC_ZERO(acc);
    gemm_kloop(lds, ap[0], ap[1], DM, wt + (size_t)(col0 + lr) * 2048 + lk, wt + (size_t)(col0 + lr + 64) * 2048 + lk, 32, acc);
#pragma unroll
    for (int m = 0; m < 4; ++m)
#pragma unroll
      for (int n = 0; n < 2; ++n) {
        const int row = row0 + wr * 64 + m * 16 + fr, col = col0 + wc * 32 + n * 16 + 4 * fq;
        const f32x4 bb = *(const f32x4*)(cb + kv * 256 + col); const f32x4 v = acc[m][n] + bb;
        u32x2 o; o.x = pk2(gelu_tanh(v.x), gelu_tanh(v.y)); o.y = pk2(gelu_tanh(v.z), gelu_tanh(v.w));
        *(u32x2*)(hid + ((size_t)kv * 4096 + row) * 256 + col) = o;
      }
  }
}
DI void phase_cmp2(const Params& P_, unsigned char* lds) {
  Params P = P_; { size_t z_ = 0; asm volatile("" : "+s"(z_)); P.ws = P_.ws + z_; }
  TILE_IDS;
  const bf16_t* hid = (const bf16_t*)(P.ws + WS_HID); bf16_t* kc = (bf16_t*)(P.ws + WS_KC); bf16_t* vc = (bf16_t*)(P.ws + WS_VC);
  for (int tile = bid; tile < 64; tile += gridDim.x) {
    const int kv = tile >> 5, rt = tile & 31, row0 = rt * 128;
    const bf16_t* wt = (const bf16_t*)(P.ws + WS_W + W_C2) + (size_t)kv * 128 * 256;
    const bf16_t* a = hid + ((size_t)kv * 4096 + row0) * 256;
    f32x4 acc[4][2]; ACC_ZERO(acc);
    gemm_kloop(lds, a + (size_t)lr * 256 + lk, a + (size_t)(lr + 64) * 256 + lk, 64, wt + (size_t)lr * 256 + lk, wt + (size_t)(lr + 64) * 256 + lk, 4, acc);
    if (wc < 2) {
#pragma unroll
      for (int m = 0; m < 4; ++m)
#pragma unroll
        for (int n = 0; n < 2; ++n) {
          const int rr = row0 + wr * 64 + m * 16 + fr, d = wc * 32 + n * 16 + 4 * fq;
          const int b = rr >> 11, nn = (rr >> 2) & 511, g = rr & 3; const f32x4 v = acc[m][n];
          if (kv == 0) { u32x2 o; o.x = pk2(v.x, v.y); o.y = pk2(v.z, v.w); *(u32x2*)(kc + ((size_t)((b * 4 + g) * 512 + nn)) * 64 + d) = o; }
          else { bf16_t* dst = vc + ((size_t)((b * 4 + g) * 64 + d)) * 512 + perm16(nn); dst[0] = (bf16_t)f2bf(v.x); dst[512] = (bf16_t)f2bf(v.y); dst[1024] = (bf16_t)f2bf(v.z); dst[1536] = (bf16_t)f2bf(v.w); }
        }
    }
  }
}
DI void phase_glu(const Params& P_, unsigned char* lds) {
  Params P = P_; { size_t z_ = 0; asm volatile("" : "+s"(z_)); P.ws = P_.ws + z_; }
  TILE_IDS;
  const bf16_t* y = (const bf16_t*)(P.ws + WS_G); const bf16_t* wt = (const bf16_t*)(P.ws + WS_W + W_GLU); bf16_t* ssm = (bf16_t*)(P.ws + WS_E);
  for (int tile = bid; tile < (NT / 128) * 4; tile += gridDim.x) {
    const int rt = tile >> 2, ct = tile & 3, row0 = rt * 128, col0 = ct * 128;
    f32x4 acc[4][2]; ACC_ZERO(acc);
    gemm_kloop(lds, y + (size_t)(row0 + lr) * 512 + lk, y + (size_t)(row0 + lr + 64) * 512 + lk, 64, wt + (size_t)(col0 + lr) * 512 + lk, wt + (size_t)(col0 + lr + 64) * 512 + lk, 8, acc);
#pragma unroll
    for (int m = 0; m < 4; ++m)
#pragma unroll
      for (int n = 0; n < 2; ++n) {
        const int row = row0 + wr * 64 + m * 16 + fr, col = col0 + wc * 32 + n * 16 + 4 * fq;
        const u32x2 yy = *(const u32x2*)(y + (size_t)row * 512 + col); const f32x4 v = acc[m][n];
        u32x2 o; o.x = pk2(bflo(yy.x) * sigmoidf_(v.x), bfhi(yy.x) * sigmoidf_(v.y)); o.y = pk2(bflo(yy.y) * sigmoidf_(v.z), bfhi(yy.y) * sigmoidf_(v.w));
        *(u32x2*)(ssm + (size_t)row * 512 + col) = o;
      }
  }
}
struct EpiInproj {
  static constexpr bool PERM = false, AFTER_DRAIN = false;
  bf16_t* qb; bf16_t* kvk; bf16_t* vT; bf16_t* mg; bf16_t* ub; float* gates;
#define EPI_ROWS(ai, m) const int row = u.pm * 256 + (ai) * 128 + wr * 64 + (m) * 16 + fr
#define EPI_LOOP2(...) _Pragma("unroll") for (int ai = 0; ai < 2; ++ai) _Pragma("unroll") for (int m = 0; m < 4; ++m) { EPI_ROWS(ai, m); _Pragma("unroll") for (int bj = 0; bj < 2; ++bj) { __VA_ARGS__ } }
  DI void operator()(const f32x4 (&acc)[2][2][4][2], const pg8::Unit& u, int wr, int wc, int fr_, int fq_) const {
    const int pn = u.pn; int fr = fr_, fq = fq_; asm volatile("" : "+v"(fr), "+v"(fq));
    if (pn < 4) {
      EPI_LOOP2(
        const f32x4 v0 = acc[ai][bj][m][0], v1 = acc[ai][bj][m][1]; u32x2 o0, o1;
        o0.x = pk2(v0.x * QSCALE, v0.y * QSCALE); o0.y = pk2(v0.z * QSCALE, v0.w * QSCALE); o1.x = pk2(v1.x * QSCALE, v1.y * QSCALE); o1.y = pk2(v1.z * QSCALE, v1.w * QSCALE);
        *(u32x4*)(qb + (size_t)row * DM + pn * 256 + bj * 128 + wc * 32 + widen16_col(fq)) = widen16(o0, o1); )
    } else if (pn == 4 || pn == 5 || pn == 8) {
      const int slot = pn == 8 ? 3 : pn - 4;
      EPI_LOOP2(
        const f32x4 v0 = acc[ai][bj][m][0], v1 = acc[ai][bj][m][1]; u32x2 o0, o1;
        o0.x = pk2(v0.x, v0.y); o0.y = pk2(v0.z, v0.w); o1.x = pk2(v1.x, v1.y); o1.y = pk2(v1.z, v1.w);
        *(u32x4*)(kvk + (size_t)row * DM + slot * 256 + bj * 128 + wc * 32 + widen16_col(fq)) = widen16(o0, o1); )
    } else if (pn == 6) {
      EPI_LOOP2(
        const unsigned t = row & (SEQ - 1);
        const unsigned ro = ((unsigned)(row >> 13) * 512u + (t >> 6)) * 4096u + ((t >> 5) & 1) * 2048u + (t & 31) * 8u;
        _Pragma("unroll") for (int n = 0; n < 2; ++n) { const int cl = bj * 128 + wc * 32 + n * 16 + 4 * fq; const f32x4 v = acc[ai][bj][m][n];
          const unsigned co = (unsigned)(cl >> 6) * 524288u + (unsigned)((cl >> 3) & 7) * 256u + (unsigned)(cl & 7);
          u32x2 o; o.x = pk2(v.x, v.y); o.y = pk2(v.z, v.w); *(u32x2*)(kvk + (WS_KSF - WS_C) / 2 + (ro + co)) = o; } )
    } else if (pn == 7) {
      EPI_LOOP2(
        const unsigned t = row & (SEQ - 1), pos = perm16(t) & 63;
        const unsigned ro = ((unsigned)(row >> 13) * 512u + (t >> 6)) * 4096u + (pos >> 3) * 256u + (pos & 7);
        _Pragma("unroll") for (int n = 0; n < 2; ++n) { const int cl = bj * 128 + wc * 32 + n * 16 + 4 * fq; const f32x4 v = acc[ai][bj][m][n];
          const unsigned co = (unsigned)(cl >> 6) * 524288u + (unsigned)((cl >> 5) & 1) * 2048u + (unsigned)(cl & 31) * 8u;
          bf16_t* dst = vT + (ro + co);
          dst[0] = (bf16_t)f2bf(v.x); dst[8] = (bf16_t)f2bf(v.y); dst[16] = (bf16_t)f2bf(v.z); dst[24] = (bf16_t)f2bf(v.w); } )
    } else if (pn == 9) {
      EPI_LOOP2(
        const int b = row >> 13, t = row & (SEQ - 1);
        _Pragma("unroll") for (int n = 0; n < 2; ++n) { const int cl = bj * 128 + wc * 32 + n * 16 + 4 * fq; const f32x4 v = acc[ai][bj][m][n];
          bf16_t* dst = vT + ((size_t)(((1 * NB + b) * 4 + (cl >> 6)) * 64 + (cl & 63))) * SEQ + perm16(t);
          dst[0] = (bf16_t)f2bf(v.x); dst[SEQ] = (bf16_t)f2bf(v.y); dst[2 * SEQ] = (bf16_t)f2bf(v.z); dst[3 * SEQ] = (bf16_t)f2bf(v.w); } )
    } else if (pn < 18) {
      EPI_LOOP2(
        const f32x4 v0 = acc[ai][bj][m][0], v1 = acc[ai][bj][m][1]; u32x2 o0, o1;
        o0.x = pk2(sigmoidf_(v0.x), sigmoidf_(v0.y)); o0.y = pk2(sigmoidf_(v0.z), sigmoidf_(v0.w)); o1.x = pk2(sigmoidf_(v1.x), sigmoidf_(v1.y)); o1.y = pk2(sigmoidf_(v1.z), sigmoidf_(v1.w));
        *(u32x4*)(mg + (size_t)row * 2048 + (pn - 10) * 256 + bj * 128 + wc * 32 + widen16_col(fq)) = widen16(o0, o1); )
    } else {
      EPI_LOOP2(
        _Pragma("unroll") for (int n = 0; n < 2; ++n) { const int ch = (pn - 18) * 256 + bj * 128 + wc * 32 + n * 16 + 4 * fq; const f32x4 v = acc[ai][bj][m][n];
          u32x2 o; o.x = pk2(v.x, v.y); o.y = pk2(v.z, v.w); *(u32x2*)(ub + ((size_t)(ch >> 4) * NT + row) * 16 + (ch & 15)) = o; } )
    }
  }
#undef EPI_LOOP2
#undef EPI_ROWS
};
DI void phase_inproj8(const Params& P_, unsigned char* lds) {
  Params P = P_; { size_t z_ = 0; asm volatile("" : "+s"(z_)); P.ws = P_.ws + z_; }
  pg8::Gemm g{(const bf16_t*)(P.ws + WS_A), (const bf16_t*)(P.ws + WS_W + W_IN), NT, 5120, DM};
  pg8::StaticOrder S; S.init(NT, 5120, gridDim.x, obid());
  EpiInproj E{(bf16_t*)(P.ws + WS_B), (bf16_t*)(P.ws + WS_C), (bf16_t*)(P.ws + WS_DV), (bf16_t*)(P.ws + WS_F), (bf16_t*)(P.ws + WS_E), (float*)(P.ws + WS_GATES)};
  pg8::gemm_phase<EpiInproj, pg8::StaticOrder, true, true>((PG8_LAS unsigned char*)lds, g, S, E);
}
struct EpiMerge1 {
  static constexpr bool PERM = false, AFTER_DRAIN = false;
  const bf16_t* mg; bf16_t* tmp;
  DI void operator()(const f32x4 (&acc)[2][2][4][2], const pg8::Unit& u, int wr, int wc, int fr, int fq) const {
#pragma unroll
    for (int ai = 0; ai < 2; ++ai) {
      u32x2 ga[4][2][2];
#pragma unroll
      for (int m = 0; m < 4; ++m)
#pragma unroll
        for (int bj = 0; bj < 2; ++bj)
#pragma unroll
          for (int n = 0; n < 2; ++n) {
            const int row = u.pm * 256 + ai * 128 + wr * 64 + m * 16 + fr, col = u.pn * 256 + bj * 128 + wc * 32 + n * 16 + 4 * fq;
            ga[m][bj][n] = *(const u32x2*)(mg + (size_t)row * 2048 + col);
          }
      __builtin_amdgcn_sched_barrier(0);
#pragma unroll
      for (int m = 0; m < 4; ++m)
#pragma unroll
        for (int bj = 0; bj < 2; ++bj)
#pragma unroll
          for (int n = 0; n < 2; ++n) {
            const int row = u.pm * 256 + ai * 128 + wr * 64 + m * 16 + fr, col = u.pn * 256 + bj * 128 + wc * 32 + n * 16 + 4 * fq;
            const f32x4 v = acc[ai][bj][m][n]; const u32x2 g = ga[m][bj][n];
            u32x2 o; o.x = pk2(v.x * bflo(g.x), v.y * bfhi(g.x)); o.y = pk2(v.z * bflo(g.y), v.w * bfhi(g.y));
            *(u32x2*)(tmp + (size_t)row * DM + col) = o;
          }
      __builtin_amdgcn_sched_barrier(0);
    }
  }
};
struct EpiMerge2 {
  static constexpr bool PERM = false, AFTER_DRAIN = false;
  const bf16_t* mg; const bf16_t* tmp; bf16_t* mer;
  DI void operator()(const f32x4 (&acc)[2][2][4][2], const pg8::Unit& u, int wr, int wc, int fr, int fq) const {
#pragma unroll
    for (int ai = 0; ai < 2; ++ai)
#pragma unroll
      for (int mh = 0; mh < 2; ++mh) {
        u32x2 gs[2][2][2], tv[2][2][2];
#pragma unroll
        for (int mm = 0; mm < 2; ++mm)
#pragma unroll
          for (int bj = 0; bj < 2; ++bj)
#pragma unroll
            for (int n = 0; n < 2; ++n) {
              const int row = u.pm * 256 + ai * 128 + wr * 64 + (mh * 2 + mm) * 16 + fr, col = u.pn * 256 + bj * 128 + wc * 32 + n * 16 + 4 * fq;
              gs[mm][bj][n] = *(const u32x2*)(mg + (size_t)row * 2048 + 1024 + col);
#if EN_ATTN
              tv[mm][bj][n] = *(const u32x2*)(tmp + (size_t)row * DM + col);
#else
              tv[mm][bj][n] = (u32x2){0u, 0u};
#endif
            }
        __builtin_amdgcn_sched_barrier(0);
#pragma unroll
        for (int mm = 0; mm < 2; ++mm)
#pragma unroll
          for (int bj = 0; bj < 2; ++bj)
#pragma unroll
            for (int n = 0; n < 2; ++n) {
              const int row = u.pm * 256 + ai * 128 + wr * 64 + (mh * 2 + mm) * 16 + fr, col = u.pn * 256 + bj * 128 + wc * 32 + n * 16 + 4 * fq;
              const f32x4 v = acc[ai][bj][mh * 2 + mm][n]; const u32x2 g = gs[mm][bj][n], t = tv[mm][bj][n];
              u32x2 o; o.x = pk2(bflo(t.x) + v.x * bflo(g.x), bfhi(t.x) + v.y * bfhi(g.x)); o.y = pk2(bflo(t.y) + v.z * bflo(g.y), bfhi(t.y) + v.w * bfhi(g.y));
              *(u32x2*)(mer + (size_t)row * DM + col) = o;
            }
        __builtin_amdgcn_sched_barrier(0);
      }
  }
};
DI void phase_merge8(const Params& P_, unsigned char* lds) {
  Params P = P_; { size_t z_ = 0; asm volatile("" : "+s"(z_)); P.ws = P_.ws + z_; }
#if EN_ATTN
  { pg8::Gemm g{(const bf16_t*)(P.ws + WS_A), (const bf16_t*)(P.ws + WS_W + W_O), NT, DM, DM};
    pg8::StaticOrder S; S.init(NT, DM, gridDim.x, obid());
    EpiMerge1 E{(const bf16_t*)(P.ws + WS_F), (bf16_t*)(P.ws + WS_C)};
    pg8::gemm_phase<EpiMerge1, pg8::StaticOrder, true, true>((PG8_LAS unsigned char*)lds, g, S, E); }
#endif
  { pg8::Gemm g{(const bf16_t*)(P.ws + WS_E), (const bf16_t*)(P.ws + WS_W + W_SO), NT, DM, 512};
    pg8::StaticOrder S; S.init(NT, DM, gridDim.x, obid());
    EpiMerge2 E{(const bf16_t*)(P.ws + WS_F), (const bf16_t*)(P.ws + WS_C), (bf16_t*)(P.ws + WS_B)};
    pg8::gemm_phase<EpiMerge2, pg8::StaticOrder, true, true>((PG8_LAS unsigned char*)lds, g, S, E); }
}
struct EpiWout {
  static constexpr bool PERM = false, AFTER_DRAIN = false;
  const float* mod; const float* xin; float* out;
  DI void operator()(const f32x4 (&acc)[2][2][4][2], const pg8::Unit& u, int wr, int wc, int fr, int fq) const {
    const int b = (u.pm * 256) >> 13;
    f32x4 g1[2][2];
#pragma unroll
    for (int bj = 0; bj < 2; ++bj)
#pragma unroll
      for (int n = 0; n < 2; ++n) g1[bj][n] = *(const f32x4*)(mod + (size_t)b * 6144 + 2048 + u.pn * 256 + bj * 128 + wc * 32 + n * 16 + 4 * fq);
#pragma unroll
    for (int ai = 0; ai < 2; ++ai)
#pragma unroll
      for (int mh = 0; mh < 2; ++mh) {
        f32x4 xv[2][2][2];
#pragma unroll
        for (int mm = 0; mm < 2; ++mm)
#pragma unroll
          for (int bj = 0; bj < 2; ++bj)
#pragma unroll
            for (int n = 0; n < 2; ++n) {
              const int row = u.pm * 256 + ai * 128 + wr * 64 + (mh * 2 + mm) * 16 + fr, col = u.pn * 256 + bj * 128 + wc * 32 + n * 16 + 4 * fq;
              xv[mm][bj][n] = *(const f32x4*)(xin + (size_t)row * DM + col);
            }
        __builtin_amdgcn_sched_barrier(0);
#pragma unroll
        for (int mm = 0; mm < 2; ++mm)
#pragma unroll
          for (int bj = 0; bj < 2; ++bj)
#pragma unroll
            for (int n = 0; n < 2; ++n) {
              const int row = u.pm * 256 + ai * 128 + wr * 64 + (mh * 2 + mm) * 16 + fr, col = u.pn * 256 + bj * 128 + wc * 32 + n * 16 + 4 * fq;
              *(f32x4*)(out + (size_t)row * DM + col) = xv[mm][bj][n] + g1[bj][n] * acc[ai][bj][mh * 2 + mm][n];
            }
        __builtin_amdgcn_sched_barrier(0);
      }
  }
};
DI void phase_wout8(const Params& P_, int l, unsigned char* lds) {
  Params P = P_; { size_t z_ = 0; asm volatile("" : "+s"(z_)); P.ws = P_.ws + z_; }
  pg8::Gemm g{(const bf16_t*)(P.ws + WS_B), (const bf16_t*)(P.ws + WS_W + W_OUT), NT, DM, DM};
  pg8::StaticOrder S; S.init(NT, DM, gridDim.x, obid());
  EpiWout E{(const float*)(P.ws + WS_MOD) + (size_t)(l * 2) * 6144, l == 0 ? P.in[0] : P.out, P.out};
  pg8::gemm_phase<EpiWout, pg8::StaticOrder, true, true>((PG8_LAS unsigned char*)lds, g, S, E);
}

struct MoeTab { int cv, pin; };
DI MoeTab moe_tab(const int* cnt) {
  const int lane = otid() & 63; MoeTab T; T.cv = cnt[lane & 31]; int p = (T.cv + 127) >> 7;
#pragma unroll
  for (int o = 1; o < 32; o <<= 1) { const int t = __shfl_up(p, o); if ((lane & 31) >= o) p += t; }
  T.pin = p; return T;
}
DI int moe_total(const MoeTab& T) { return __builtin_amdgcn_readlane(T.pin, 31); }
DI void moe_find(const MoeTab& T, int rb, int& e, int& rbl, int& ce) {
  const unsigned m = (unsigned)__ballot(T.pin <= rb);
  e = __popc(m); e = e < NEXP ? e : NEXP - 1;
  const int nb = (__shfl(T.cv, e) + 127) >> 7;
  ce = __shfl(T.cv, e); rbl = rb - (__shfl(T.pin, e) - nb);
  e = __builtin_amdgcn_readfirstlane(e); rbl = __builtin_amdgcn_readfirstlane(rbl); ce = __builtin_amdgcn_readfirstlane(ce);
}
DI void phase_moe1(const Params& P_, int l, unsigned char* lds) {
  Params P = P_; { size_t z_ = 0; asm volatile("" : "+s"(z_)); P.ws = P_.ws + z_; }
  TILE_IDS;
  const int* cnt = (const int*)(P.ws + WS_CNT) + l * 32; const int* list = (const int*)(P.ws + WS_LIST);
  const bf16_t* h2 = (const bf16_t*)(P.ws + WS_A); bf16_t* act = (bf16_t*)(P.ws + WS_B);
  const MoeTab MT = moe_tab(cnt); const int total = moe_total(MT);
  const int G_ = gridDim.x, nx_ = (G_ % 8 == 0) ? 8 : 1, xg_ = bid % nx_, xs_ = bid / nx_, xb0_ = (int)((long)total * xg_ / nx_), xb1_ = (int)((long)total * (xg_ + 1) / nx_);
  for (int tl = xs_; tl < (xb1_ - xb0_) * 4; tl += G_ / nx_) {
    const int rb = xb0_ + (tl >> 2), ct = tl & 3; int e = 0, rbl = 0, ce = 1; moe_find(MT, rb, e, rbl, ce);
    const bf16_t* wt = (const bf16_t*)(P.ws + WS_W + W_GU) + (size_t)e * 512 * 1024 + (size_t)(ct * 128) * 1024;
    const bf16_t* ap[2];
#pragma unroll
    for (int i = 0; i < 2; ++i) { int idx = rbl * 128 + lr + 64 * i; idx = idx < ce ? idx : ce - 1; const int tok = list[e * LISTCAP + idx] >> 1; ap[i] = h2 + (size_t)tok * DM + lk; }
    f32x4 acc[4][2]; ACC_ZERO(acc);
    gemm_kloop(lds, ap[0], ap[1], 64, wt + (size_t)lr * DM + lk, wt + (size_t)(lr + 64) * DM + lk, 16, acc);
#pragma unroll
    for (int m = 0; m < 4; ++m) {
      const int arow = rb * 128 + wr * 64 + m * 16 + fr, col = ct * 64 + wc * 16 + 4 * fq;
      const f32x4 g = acc[m][0], u = acc[m][1];
      u32x2 o; o.x = pk2(g.x * sigmoidf_(g.x) * u.x, g.y * sigmoidf_(g.y) * u.y); o.y = pk2(g.z * sigmoidf_(g.z) * u.z, g.w * sigmoidf_(g.w) * u.w);
      *(u32x2*)(act + (size_t)arow * 256 + col) = o;
    }
  }
}
DI void phase_moe2(const Params& P_, int l, unsigned char* lds) {
  Params P = P_; { size_t z_ = 0; asm volatile("" : "+s"(z_)); P.ws = P_.ws + z_; }
  TILE_IDS;
  const int* cnt = (const int*)(P.ws + WS_CNT) + l * 32; const int* list = (const int*)(P.ws + WS_LIST); const float* wts = (const float*)(P.ws + WS_WT);
  const bf16_t* act = (const bf16_t*)(P.ws + WS_B); bf16_t* ys = (bf16_t*)(P.ws + WS_F);
  constexpr int ASUB = 128 * GT_ROWB, BOFF = 4 * ASUB;
  const MoeTab MT = moe_tab(cnt); const int total = moe_total(MT);
  const int lkb = (tid & 7) * 16;
  const int G_ = gridDim.x, nx_ = (G_ % 8 == 0) ? 8 : 1, xg_ = bid % nx_, xs_ = bid / nx_, xb0_ = (int)((long)total * xg_ / nx_), xb1_ = (int)((long)total * (xg_ + 1) / nx_);
  for (int tl = xs_; tl < (xb1_ - xb0_) * 4; tl += G_ / nx_) {
    const int rb = xb0_ + (tl >> 2), ct0 = (tl & 3) * 2; int e = 0, rbl = 0, ce = 1; moe_find(MT, rb, e, rbl, ce);
    const bf16_t* wt = (const bf16_t*)(P.ws + WS_W + W_D) + (size_t)e * 1024 * 256;
    const bf16_t* a0 = act + (size_t)(rb * 128 + lr) * 256 + lk; const bf16_t* a1 = a0 + 64 * 256;
    u32x4 ra[8], bq[8][2];
#pragma unroll
    for (int k = 0; k < 4; ++k) { ra[2 * k] = *(const u32x4*)(a0 + 64 * k); ra[2 * k + 1] = *(const u32x4*)(a1 + 64 * k); }
#define M2_BLOAD(q0_, q1_, s_) do { const bf16_t* bp_ = wt + (size_t)((ct0 + ((s_) >> 2)) * 128 + lr) * 256 + ((s_) & 3) * 64 + lk; q0_ = *(const u32x4*)bp_; q1_ = *(const u32x4*)(bp_ + 64 * 256); } while (0)
#define M2_BSTORE(q0_, q1_, buf_) do { unsigned char* s_ = lds + BOFF + (buf_) * ASUB; *(u32x4*)(s_ + GT_WOFF(lr, tid)) = q0_; *(u32x4*)(s_ + 64 * GT_ROWB + GT_WOFF(lr, tid)) = q1_; } while (0)
#define M2_COMPUTE(s_, buf_) do { \
      const unsigned char* As = lds + ((s_) & 3) * ASUB + (wr * 64 + fr) * GT_ROWB; \
      const unsigned char* Bs = lds + BOFF + (buf_) * ASUB + (wc * 32 + fr) * GT_ROWB; \
      _Pragma("unroll") for (int ks = 0; ks < 2; ++ks) { \
        bf16x8 af[4], bfr[2]; \
        _Pragma("unroll") for (int m = 0; m < 4; ++m) af[m] = *(const bf16x8*)(As + m * 16 * GT_ROWB + GT_RSW(ks, fq, fr)); \
        _Pragma("unroll") for (int n = 0; n < 2; ++n) bfr[n] = *(const bf16x8*)(Bs + n * 16 * GT_ROWB + GT_RSW(ks, fq, fr)); \
        _Pragma("unroll") for (int m = 0; m < 4; ++m) _Pragma("unroll") for (int n = 0; n < 2; ++n) acc[m][n] = __builtin_amdgcn_mfma_f32_16x16x32_bf16(bfr[n], af[m], acc[m][n], 0, 0, 0); } } while (0)
#define M2_EPI(ct_) do { _Pragma("unroll") for (int m = 0; m < 4; ++m) { const int idx = rbl * 128 + wr * 64 + m * 16 + fr; \
      const int slot = eslot[m]; const float w_ = ewt[m]; const f32x4 v0 = acc[m][0] * w_, v1 = acc[m][1] * w_; \
      u32x2 o0, o1; o0.x = pk2(v0.x, v0.y); o0.y = pk2(v0.z, v0.w); o1.x = pk2(v1.x, v1.y); o1.y = pk2(v1.z, v1.w); \
      const u32x4 ow_ = widen16(o0, o1);                          \
      if (idx < ce) *(u32x4*)(ys + (size_t)slot * DM + (ct_) * 128 + wc * 32 + widen16_col(fq)) = ow_; } ACC_ZERO(acc); } while (0)
    int eslot[4]; float ewt[4];
#pragma unroll
    for (int m = 0; m < 4; ++m) { int idx = rbl * 128 + wr * 64 + m * 16 + fr; idx = idx < ce ? idx : ce - 1; eslot[m] = list[e * LISTCAP + idx]; }
#pragma unroll
    for (int s2 = 0; s2 < 8; ++s2) M2_BLOAD(bq[s2][0], bq[s2][1], s2);
#pragma unroll
    for (int m = 0; m < 4; ++m) ewt[m] = wts[eslot[m]];
#pragma unroll
    for (int k = 0; k < 4; ++k) { *(u32x4*)(lds + k * ASUB + GT_WOFF(lr, tid)) = ra[2 * k]; *(u32x4*)(lds + k * ASUB + 64 * GT_ROWB + GT_WOFF(lr, tid)) = ra[2 * k + 1]; }
    M2_BSTORE(bq[0][0], bq[0][1], 0);
    __syncthreads();
    f32x4 acc[4][2]; ACC_ZERO(acc);
#pragma unroll
    for (int s2 = 0; s2 < 8; ++s2) {
      M2_COMPUTE(s2, s2 & 1);
      if (s2 + 1 < 8) M2_BSTORE(bq[s2 + 1][0], bq[s2 + 1][1], (s2 + 1) & 1);
      if (s2 == 3) M2_EPI(ct0);
      if (s2 == 7) M2_EPI(ct0 + 1);
      __syncthreads();
    }
#undef M2_BLOAD
#undef M2_BSTORE
#undef M2_COMPUTE
#undef M2_EPI
  }
}

typedef float f32x2v __attribute__((ext_vector_type(2)));
DI void phase_s5a(const Params& P_, int l, unsigned char* lds) {
  Params P = P_; { size_t z_ = 0; asm volatile("" : "+s"(z_)); P.ws = P_.ws + z_; }
  TILE_IDS;
  const bf16_t* ub = (const bf16_t*)(P.ws + WS_E); float* Lb = (float*)(P.ws + WS_L);
  const bf16_t* M1 = (const bf16_t*)(P.ws + WS_TAB + (size_t)l * TAB_LAYER + TAB_M1);
  const int first = (int)gridDim.x >= 192 ? 128 : 0;
  for (int tile = bid - first; tile >= 0 && tile < 64; tile += gridDim.x) {
    const int g = tile >> 1, rt = tile & 1;
    const bf16_t* a = ub + ((size_t)g * NT / 64 + rt * 128) * 1024;
    const bf16_t* wt = M1 + (size_t)g * 128 * 1024;
    f32x4 acc[4][2]; ACC_ZERO(acc);
    gemm_kloop(lds, a + (size_t)lr * 1024 + lk, a + (size_t)(lr + 64) * 1024 + lk, 64, wt + (size_t)lr * 1024 + lk, wt + (size_t)(lr + 64) * 1024 + lk, 16, acc);
#pragma unroll
    for (int m = 0; m < 4; ++m)
#pragma unroll
      for (int n = 0; n < 2; ++n) {
        const int R = rt * 128 + wr * 64 + m * 16 + fr, comp = wc * 32 + n * 16 + 4 * fq;
        *(f32x4*)(Lb + ((size_t)(R * 32 + g) * 64) * 2 + comp) = acc[m][n];
      }
  }
}
DI void s5_carry(const Params& P_, int l) {
  Params P = P_; { size_t z_ = 0; asm volatile("" : "+s"(z_)); P.ws = P_.ws + z_; }
  const int tid_ = otid(), bid = obid(), wave = tid_ >> 6, lane = tid_ & 63;
  const int item = (gridDim.x * NWAVE - 1) - (bid * NWAVE + wave);
  if (item >= NB * 32) return;
  const int b = item >> 5, g = item & 31;
  const float* pp = (const float*)(P.ws + WS_S5P) + (size_t)((l * 32 + g) * 64 + lane) * 36;
  const float aTr = pp[2], aTi = pp[3];
  float2* Lp = (float2*)(P.ws + WS_L) + ((size_t)(b * 128) * 32 + g) * 64 + lane;
  unsigned* Sp = (unsigned*)(P.ws + WS_SIN) + ((size_t)(g * 256 + b * 128)) * 64 + lane;
  float sr = 0.f, si = 0.f; asm volatile("" : "+v"(sr), "+v"(si));
  float2 va[8], vb[8];
#define CY_LOAD(vv, c0_) do { _Pragma("unroll") for (int k = 0; k < 8; ++k) vv[k] = Lp[(size_t)((c0_) + k) * 2048]; } while (0)
#define CY_STEP(vv, c0_) do { _Pragma("unroll") for (int k = 0; k < 8; ++k) { Lp[(size_t)((c0_) + k) * 2048] = make_float2(sr, si); Sp[(size_t)((c0_) + k) * 64] = pk2(sr, si); \
      const float nr = aTr * sr - aTi * si + vv[k].x, ni = aTr * si + aTi * sr + vv[k].y; sr = nr; si = ni; } } while (0)
#define CY_PIN(vv) do { _Pragma("unroll") for (int k = 0; k < 8; ++k) asm volatile("" : "+v"(vv[k].x), "+v"(vv[k].y)); } while (0)
  CY_LOAD(va, 0);
#pragma unroll
  for (int c0 = 0; c0 < 128; c0 += 16) {
    CY_LOAD(vb, c0 + 8);
    CY_PIN(va);
    CY_STEP(va, c0);
    if (c0 + 16 < 128) CY_LOAD(va, c0 + 16);
    CY_PIN(vb);
    CY_STEP(vb, c0 + 8);
  }
#undef CY_PIN
#undef CY_LOAD
#undef CY_STEP
}
DI void phase_s5c(const Params& P_, int l, unsigned char* lds) {
  Params P = P_; { size_t z_ = 0; asm volatile("" : "+s"(z_)); P.ws = P_.ws + z_; }
  TILE_IDS;
  const bf16_t* ub = (const bf16_t*)(P.ws + WS_E); const bf16_t* sinb = (const bf16_t*)(P.ws + WS_SIN); bf16_t* yb = (bf16_t*)(P.ws + WS_G);
  const bf16_t* tab = (const bf16_t*)(P.ws + WS_TAB + (size_t)l * TAB_LAYER);
  int* dctr = (int*)(P.ws + 640) + l; int* dslot = (int*)(lds + LDS_BYTES - 32);
  constexpr int ROWB = GT_ROWB, SA = 0, SB = 128 * ROWB, STAGE = 2 * 128 * ROWB;
  const int lkb = (tid & 7) * 16, kch = tid & 7;
  for (;;) {
    if (threadIdx.x == 0) *dslot = atomicAdd(dctr, 1);
    __syncthreads();
    const int tile = *dslot;
    __syncthreads();
    if (tile >= 512) break;
    const int g = tile >> 4, rt = (tile >> 3) & 1, ct = tile & 7;
    const bf16_t* Kt = tab + TAB_KT / 2 + (size_t)g * 64 * 256; const bf16_t* M2 = tab + TAB_M2 / 2 + (size_t)g * 1024 * 128;
    const bf16_t* ua = ub + ((size_t)g * 256 + rt * 128) * 1024; const bf16_t* sa = sinb + ((size_t)g * 256 + rt * 128) * 128;
    const int nbt = 2 * ct + 2 < 16 ? 2 * ct + 2 : 16, ns = nbt + 2;
    u32x4 xa0, xa1, xb0, xb1, ya0, ya1, yb0, yb1;
#define S5_LOAD(p0_, p1_, q0_, q1_, s_) do { \
      if ((s_) < nbt) { p0_ = *(const u32x4*)(ua + (size_t)lr * 1024 + (s_) * 64 + lk); p1_ = *(const u32x4*)(ua + (size_t)(lr + 64) * 1024 + (s_) * 64 + lk); \
        const int i_ = 4 * (s_) + (kch >> 1), hq_ = (kch & 1) * 8; \
        { const int t_ = 8 * ct + (lr >> 4), h_ = lr & 15; q0_ = t_ >= i_ ? *(const u32x4*)(Kt + ((t_ - i_) * 16 + h_) * 16 + hq_) : (u32x4){0u, 0u, 0u, 0u}; } \
        { const int t_ = 8 * ct + 4 + (lr >> 4), h_ = lr & 15; q1_ = t_ >= i_ ? *(const u32x4*)(Kt + ((t_ - i_) * 16 + h_) * 16 + hq_) : (u32x4){0u, 0u, 0u, 0u}; } \
      } else { const int k0_ = ((s_) - nbt) * 64 + lk; \
        p0_ = *(const u32x4*)(sa + (size_t)lr * 128 + k0_); p1_ = *(const u32x4*)(sa + (size_t)(lr + 64) * 128 + k0_); \
        q0_ = *(const u32x4*)(M2 + (size_t)(ct * 128 + lr) * 128 + k0_); q1_ = *(const u32x4*)(M2 + (size_t)(ct * 128 + lr + 64) * 128 + k0_); } } while (0)
#define S5_STORE(p0_, p1_, q0_, q1_, buf) do { unsigned char* s_ = lds + (buf) * STAGE; \
      *(u32x4*)(s_ + SA + GT_WOFF(lr, tid)) = p0_; *(u32x4*)(s_ + SA + 64 * ROWB + GT_WOFF(lr, tid)) = p1_; \
      *(u32x4*)(s_ + SB + GT_WOFF(lr, tid)) = q0_; *(u32x4*)(s_ + SB + 64 * ROWB + GT_WOFF(lr, tid)) = q1_; } while (0)
#define S5_COMPUTE(buf) do { \
      const unsigned char* As = lds + (buf) * STAGE + SA + (wr * 64 + fr) * ROWB; \
      const unsigned char* Bs = lds + (buf) * STAGE + SB + (wc * 32 + fr) * ROWB; \
      _Pragma("unroll") for (int ks = 0; ks < 2; ++ks) { \
        bf16x8 af[4], bfr[2]; \
        _Pragma("unroll") for (int m = 0; m < 4; ++m) af[m] = *(const bf16x8*)(As + m * 16 * ROWB + GT_RSW(ks, fq, fr)); \
        _Pragma("unroll") for (int n = 0; n < 2; ++n) bfr[n] = *(const bf16x8*)(Bs + n * 16 * ROWB + GT_RSW(ks, fq, fr)); \
        _Pragma("unroll") for (int m = 0; m < 4; ++m) _Pragma("unroll") for (int n = 0; n < 2; ++n) acc[m][n] = __builtin_amdgcn_mfma_f32_16x16x32_bf16(bfr[n], af[m], acc[m][n], 0, 0, 0); } } while (0)
    f32x4 acc[4][2]; ACC_ZERO(acc);
    S5_LOAD(xa0, xa1, xb0, xb1, 0); S5_STORE(xa0, xa1, xb0, xb1, 0); S5_LOAD(ya0, ya1, yb0, yb1, 1); __syncthreads();
    for (int st = 0; st < ns; st += 2) {
      if (st + 2 < ns) S5_LOAD(xa0, xa1, xb0, xb1, st + 2);
      S5_COMPUTE(0);
      if (st + 1 < ns) S5_STORE(ya0, ya1, yb0, yb1, 1);
      __syncthreads();
      if (st + 1 >= ns) break;
      if (st + 3 < ns) S5_LOAD(ya0, ya1, yb0, yb1, st + 3);
      S5_COMPUTE(1);
      if (st + 2 < ns) S5_STORE(xa0, xa1, xb0, xb1, 0);
      __syncthreads();
    }
#undef S5_LOAD
#undef S5_STORE
#undef S5_COMPUTE
    const float* dsk = P.in[13] + (size_t)(l * 32 + g) * 16;
#pragma unroll
    for (int m = 0; m < 4; ++m)
#pragma unroll
      for (int n = 0; n < 2; ++n) {
        const int R = rt * 128 + wr * 64 + m * 16 + fr, col = ct * 128 + wc * 32 + n * 16 + 4 * fq, t = col >> 4, h = col & 15;
        const u32x2 uu = *(const u32x2*)(ub + ((size_t)g * 256 + R) * 1024 + col); const f32x4 dd = *(const f32x4*)(dsk + h); const f32x4 v = acc[m][n];
        const float y0 = gelu_tanh(v.x + dd.x * bflo(uu.x)), y1 = gelu_tanh(v.y + dd.y * bfhi(uu.x)), y2 = gelu_tanh(v.z + dd.z * bflo(uu.y)), y3 = gelu_tanh(v.w + dd.w * bfhi(uu.y));
        const size_t tokn = (size_t)(R >> 7) * SEQ + 64 * (R & 127) + t;
        u32x2 o; o.x = pk2(y0, y1); o.y = pk2(y2, y3); *(u32x2*)(yb + tokn * 512 + g * 16 + h) = o;
      }
  }
}

constexpr int AT_ROWB = 144, AT_KS = 0, AT_VS = 2 * 64 * AT_ROWB, AT_IMP = 4 * 64 * AT_ROWB, AT_OACC = AT_IMP, AT_IMPS = 129, AT_EE = AT_IMP + 64 * AT_IMPS * 4,
              AT_SEL = AT_IMP + 66048, AT_QS = AT_SEL + 1024, AT_QL = AT_QS + 32768, AT_NJ = AT_QL + 8192, AT_ITEMS = AT_NJ + 512, AT_MREF = AT_ITEMS + 512,
              AT_LACC = AT_MREF + 1024, AT_INVQ = AT_LACC + 1024, AT_MISC = AT_INVQ + 512, AT_LOWN = AT_MISC + 64, AT_END = AT_LOWN + 1024;
static_assert(AT_END <= LDS_BYTES - 16, "attention LDS");
#define MFMA32(a, b, c) __builtin_amdgcn_mfma_f32_32x32x16_bf16((a), (b), (c), 0, 0, 0)
DI int crow_of(int reg, int hh) { return (reg & 3) + 8 * (reg >> 2) + 4 * hh; }

struct AttnState { f32x16 o0, o1; float m, l; };
DI void st_init(AttnState& S) { S.m = -1e30f; S.l = 0.f;
#pragma unroll
  for (int i = 0; i < 16; ++i) { S.o0[i] = 0.f; S.o1[i] = 0.f; } }

DI void at_ldk(const unsigned char* lds, int buf, int r, int hh, bf16x8 (&kf)[8]) {
  const unsigned char* kb = lds + AT_KS + buf * 64 * AT_ROWB + r * AT_ROWB + hh * 16;
#pragma unroll
  for (int ds = 0; ds < 4; ++ds) { kf[ds] = *(const bf16x8*)(kb + ds * 32); kf[4 + ds] = *(const bf16x8*)(kb + 32 * AT_ROWB + ds * 32); }
}
DI void at_ldv(const unsigned char* lds, int buf, int r, int hh, bf16x8 (&vf)[8]) {
  const unsigned char* vb = lds + AT_VS + buf * 64 * AT_ROWB + r * AT_ROWB + hh * 16;
#pragma unroll
  for (int gk = 0; gk < 4; ++gk) { vf[gk] = *(const bf16x8*)(vb + gk * 32); vf[4 + gk] = *(const bf16x8*)(vb + 32 * AT_ROWB + gk * 32); }
}
DI void at_qk(const bf16x8 (&kf)[8], const bf16x8 (&qf)[4], f32x16& p0, f32x16& p1) {
  const f32x16 z = {0.f, 0.f, 0.f, 0.f, 0.f, 0.f, 0.f, 0.f, 0.f, 0.f, 0.f, 0.f, 0.f, 0.f, 0.f, 0.f};
#pragma unroll
  for (int ds = 0; ds < 4; ++ds) { if (ds == 0) { p0 = MFMA32(kf[0], qf[0], z); p1 = MFMA32(kf[4], qf[0], z); } else { p0 = MFMA32(kf[ds], qf[ds], p0); p1 = MFMA32(kf[4 + ds], qf[ds], p1); } }
}
DI bf16x8 pack8(const f32x16& p, int s2) {
  u32x4 w; w.x = pk2(p[8 * s2], p[8 * s2 + 1]); w.y = pk2(p[8 * s2 + 2], p[8 * s2 + 3]); w.z = pk2(p[8 * s2 + 4], p[8 * s2 + 5]); w.w = pk2(p[8 * s2 + 6], p[8 * s2 + 7]);
  return __builtin_bit_cast(bf16x8, w);
}
DI void at_pv(const bf16x8 (&vf)[8], const f32x16& p0, const f32x16& p1, f32x16& oa, f32x16& ob) {
#pragma unroll
  for (int gk = 0; gk < 4; ++gk) {
    const bf16x8 pb = (gk < 2) ? pack8(p0, gk & 1) : pack8(p1, gk & 1);
    oa = MFMA32(vf[gk], pb, oa); ob = MFMA32(vf[4 + gk], pb, ob);
  }
}
template <int MODE>
DI void at_online(AttnState& S, f32x16& p0, f32x16& p1, int key0, int lo, int hi, bool on, int hh) {
  float tm = -1e30f;
  if (MODE == 1 && on) {
    int lor = lo - key0 - 4 * hh, hir = hi - key0 - 4 * hh;
    if (hir < lor) { lor = 4096; hir = 4096; }
    const unsigned span = (unsigned)(hir - lor);
#pragma unroll
    for (int i = 0; i < 16; ++i) { const int c0 = (i & 3) + 8 * (i >> 2);
      p0[i] = ((unsigned)(c0 - lor) <= span) ? p0[i] : -1e30f; p1[i] = ((unsigned)(c0 + 32 - lor) <= span) ? p1[i] : -1e30f; }
  }
  asm volatile("s_nop 15\n\ts_nop 7" : "+v"(tm) : "v"(p0[15]), "v"(p1[15]));
#define MX3_8(o_) asm("v_max3_f32 %0, %0, %1, %2\n\tv_max3_f32 %0, %0, %3, %4\n\tv_max3_f32 %0, %0, %5, %6\n\tv_max3_f32 %0, %0, %7, %8\n\tv_max3_f32 %0, %0, %9, %10\n\tv_max3_f32 %0, %0, %11, %12\n\tv_max3_f32 %0, %0, %13, %14\n\tv_max3_f32 %0, %0, %15, %16" \
      : "+v"(tm) : "v"(p0[o_]), "v"(p1[o_]), "v"(p0[o_ + 1]), "v"(p1[o_ + 1]), "v"(p0[o_ + 2]), "v"(p1[o_ + 2]), "v"(p0[o_ + 3]), "v"(p1[o_ + 3]), "v"(p0[o_ + 4]), "v"(p1[o_ + 4]), "v"(p0[o_ + 5]), "v"(p1[o_ + 5]), "v"(p0[o_ + 6]), "v"(p1[o_ + 6]), "v"(p0[o_ + 7]), "v"(p1[o_ + 7]))
  MX3_8(0); MX3_8(8);
#undef MX3_8
  tm = x32_max(tm);
  if (MODE == 2) tm = on ? tm : -1e30f;
  { const float mn = fmaxf(S.m, tm); const float al = __builtin_amdgcn_exp2f(S.m - mn); S.m = mn; S.l *= al;
#pragma unroll
    for (int i = 0; i < 16; ++i) { S.o0[i] *= al; S.o1[i] *= al; } }
  float mn = S.m;
  if (MODE == 2) mn = on ? mn : 1e30f;
  if (MODE == 1) mn = mn < -1e29f ? 1e30f : mn;
  float rs = 0.f;
#pragma unroll
  for (int i = 0; i < 16; ++i) {
    const float e0 = __builtin_amdgcn_exp2f(p0[i] - mn), e1 = __builtin_amdgcn_exp2f(p1[i] - mn);
    p0[i] = e0; p1[i] = e1; rs += e0 + e1;
  }
  S.l += rs;
}

DI void attn_tile(const Params& P_, unsigned char* lds, int b, int g, int c) {
  Params P = P_; { size_t z_ = 0; asm volatile("" : "+s"(z_)); P.ws = P_.ws + z_; }
#define AT_IDS const int tid = otid(), lane = tid & 63, w = tid >> 6, r = lane & 31, hh = lane >> 5, qi = 8 * w + (r >> 2), h = r & 3, t = 64 * c + qi, qrow = 32 * w + r, srow = tid >> 3, sch = (tid & 7) * 8, ahead = lane >> 4, ach = lane & 15; const unsigned tok = (unsigned)b * SEQ + t, goff = tok * 48 + g * 4 + h; (void)qi; (void)h; (void)t; (void)qrow; (void)srow; (void)sch; (void)ahead; (void)ach; (void)tok; (void)goff; (void)hh; (void)w; (void)r
  const bf16_t* qb = (const bf16_t*)(P.ws + WS_B); const bf16_t* kvk = (const bf16_t*)(P.ws + WS_C); const bf16_t* vT = (const bf16_t*)(P.ws + WS_DV);
  const bf16_t* kcb = (const bf16_t*)(P.ws + WS_KC); const bf16_t* vcb = (const bf16_t*)(P.ws + WS_VC);
  const float* gbase = (const float*)(P.ws + WS_GATES);
#define gates(i) gbase[goff + (i)]
  bf16_t* attn = (bf16_t*)(P.ws + WS_A);
  float* otb = (float*)(P.ws + WS_OT) + (size_t)obid() * 16384;
#define otg(i) otb[(unsigned)tid + (i) * 512u]
  float* IMP = (float*)(lds + AT_IMP); float* EE = (float*)(lds + AT_EE); unsigned* SEL = (unsigned*)(lds + AT_SEL);
  AttnState S; f32x16 p0, p1; u32x4 rkA, rvA; bf16x8 qf[4], kfr[8], vfr[8];
#define QF_LOAD() do { _Pragma("unroll") for (int ds_ = 0; ds_ < 4; ++ds_) qf[ds_] = *(const bf16x8*)(lds + AT_QS + qrow * 128 + (((ds_ * 2 + hh) ^ (qrow & 7)) * 16)); } while (0)
#define AT_QKV() do { at_ldk(lds, buf_, r, hh, kfr); __builtin_amdgcn_sched_barrier(0); at_qk(kfr, qf, p0, p1); at_ldv(lds, buf_, r, hh, vfr); __builtin_amdgcn_sched_barrier(0); } while (0)
  { AT_IDS;
  { const int row = tid >> 1, half = tid & 1, q_i = row >> 2, hd = row & 3;
    const unsigned so = ((unsigned)b * SEQ + 64 * c + q_i) * DM + (g * 4 + hd) * 64 + half * 32;
#pragma unroll
    for (int k = 0; k < 4; ++k) { const u32x4 v = *(const u32x4*)(qb + so + k * 8); *(u32x4*)(lds + AT_QS + row * 128 + (((half * 4 + k) ^ (row & 7)) * 16)) = v; } }
  __syncthreads();
  QF_LOAD();
#define ST_LOAD(rk, rv, kp, kstride, vp, vstride, kt) do { rk = *(const u32x4*)((kp) + (unsigned)(((kt) * 64 + srow) * (kstride) + sch)); rv = *(const u32x4*)((vp) + (unsigned)(srow * (vstride) + (kt) * 64 + sch)); } while (0)
#define ST_STORE(rk, rv, buf) do { *(u32x4*)(lds + AT_KS + (buf) * 64 * AT_ROWB + srow * AT_ROWB + sch * 2) = rk; *(u32x4*)(lds + AT_VS + (buf) * 64 * AT_ROWB + srow * AT_ROWB + sch * 2) = rv; } while (0)
#define SWEEP(kp, kstride, vp, vstride, kt0, n, ...) do { \
    ST_LOAD(rkA, rvA, kp, kstride, vp, vstride, (kt0)); ST_STORE(rkA, rvA, 0); __syncthreads(); \
    for (int i_ = 0; i_ < (n); ++i_) { \
      if (i_ + 1 < (n)) ST_LOAD(rkA, rvA, kp, kstride, vp, vstride, (kt0) + i_ + 1); \
      { const int step_ = i_; const int buf_ = i_ & 1; __VA_ARGS__ } \
      if (i_ + 1 < (n)) ST_STORE(rkA, rvA, (i_ + 1) & 1); \
      __syncthreads(); \
    } } while (0)
#define ST_LOADF(rk, rv, kt) do { rk = *(const u32x4*)(kps + (size_t)(kt) * 4096 + tid * 8); rv = *(const u32x4*)(vps + (size_t)(kt) * 4096 + tid * 8); } while (0)
#define ST_STOREF(rk, rv, buf) do { const int fo_ = ((tid >> 8) * 32 + (tid & 31)) * AT_ROWB + (((tid >> 6) & 3) * 2 + ((tid >> 5) & 1)) * 16; \
    *(u32x4*)(lds + AT_KS + (buf) * 64 * AT_ROWB + fo_) = rk; *(u32x4*)(lds + AT_VS + (buf) * 64 * AT_ROWB + fo_) = rv; } while (0)
#define SWEEPF(kt0, n, ...) do { \
    ST_LOADF(rkA, rvA, (kt0)); ST_STOREF(rkA, rvA, 0); __syncthreads(); \
    for (int i_ = 0; i_ < (n); ++i_) { \
      if (i_ + 1 < (n)) ST_LOADF(rkA, rvA, (kt0) + i_ + 1); \
      { const int step_ = i_; const int buf_ = i_ & 1; __VA_ARGS__ } \
      if (i_ + 1 < (n)) ST_STOREF(rkA, rvA, (i_ + 1) & 1); \
      __syncthreads(); \
    } } while (0)
  {
    const bf16_t* kp = kvk + (size_t)b * SEQ * DM + 3 * 256 + g * 64; const bf16_t* vp = vT + (size_t)(((1 * NB + b) * 4 + g) * 64) * SEQ;
    const int j0 = c >= 8 ? c - 8 : 0, nj = c - j0 + 1;
    st_init(S);
    SWEEP(kp, DM, vp, SEQ, j0, nj, {
      AT_QKV();
      at_online<1>(S, p0, p1, (j0 + step_) * 64, t - 511, t, (step_ == 0 && c >= 8) || step_ == nj - 1, hh);
      at_pv(vfr, p0, p1, S.o0, S.o1); });
    const float lt = x32_sum(S.l); const float sc = lt > 0.f ? gates(32) / lt : 0.f;
#pragma unroll
    for (int i = 0; i < 16; ++i) { otg(i) = S.o0[i] * sc; otg(16 + i) = S.o1[i] * sc; }
  }
  {
    const bf16_t* kcp = kcb + (size_t)((b * 4 + g) * 512) * 64; const bf16_t* vcp = vcb + (size_t)((b * 4 + g) * 64) * 512;
    const int nmax = t >= 31 ? (t - 31) >> 4 : -1;
    const int nct = (4 * c + 2) / 64 + 1;
    st_init(S);
    SWEEP(kcp, 64, vcp, 512, 0, nct, {
      at_ldk(lds, buf_, r, hh, kfr); __builtin_amdgcn_sched_barrier(0); at_qk(kfr, qf, p0, p1);
      at_online<1>(S, p0, p1, step_ * 64, 0, nmax, 64 * step_ + 63 > 4 * c - 2, hh); });
    const float lt = x32_sum(S.l);
    const float cinv = lt > 0.f ? 1.f / lt : 0.f; const float cm = S.m;
    st_init(S);
    SWEEP(kcp, 64, vcp, 512, 0, nct, {
      AT_QKV();
      if (64 * step_ + 63 <= 4 * c - 2) {
        _Pragma("unroll") for (int k = 0; k < 16; ++k) { p0[k] = __builtin_amdgcn_exp2f(p0[k] - cm) * cinv; p1[k] = __builtin_amdgcn_exp2f(p1[k] - cm) * cinv; }
      } else {
        const int nrel = nmax - step_ * 64 - 4 * hh;
        _Pragma("unroll") for (int k = 0; k < 16; ++k) { const int c0 = (k & 3) + 8 * (k >> 2), c1 = c0 + 32;
          p0[k] = c0 <= nrel ? __builtin_amdgcn_exp2f(p0[k] - cm) * cinv : 0.f; p1[k] = c1 <= nrel ? __builtin_amdgcn_exp2f(p1[k] - cm) * cinv : 0.f; }
      }
      at_pv(vfr, p0, p1, S.o0, S.o1);
      _Pragma("unroll") for (int kh = 0; kh < 2; ++kh)
      _Pragma("unroll") for (int gi = 0; gi < 4; ++gi) {
          float g4 = kh == 0 ? (p0[4 * gi] + p0[4 * gi + 1]) + (p0[4 * gi + 2] + p0[4 * gi + 3]) : (p1[4 * gi] + p1[4 * gi + 1]) + (p1[4 * gi + 2] + p1[4 * gi + 3]);
          float e3 = kh == 0 ? p0[4 * gi + 3] : p1[4 * gi + 3];
          g4 += dppf<DPP_X1>(g4); g4 += dppf<DPP_X2>(g4); e3 += dppf<DPP_X1>(e3); e3 += dppf<DPP_X2>(e3);
          if (h == 0) { const int s = (step_ * 64 + kh * 32 + 8 * gi + 4 * hh) >> 2; IMP[qi * AT_IMPS + s] = g4; EE[qi * AT_IMPS + s] = e3; }
      } });
    const float gc = gates(0);
#pragma unroll
    for (int i = 0; i < 16; ++i) { p0[i] = otg(i); p1[i] = otg(16 + i); }
    __builtin_amdgcn_sched_barrier(0);
#pragma unroll
    for (int i = 0; i < 16; ++i) { otg(i) = p0[i] + S.o0[i] * gc; otg(16 + i) = p1[i] + S.o1[i] * gc; }
  }
  }
  const bf16_t* kps = (const bf16_t*)(P.ws + WS_KSF) + (size_t)((b * 4 + g) * 128) * 4096; const bf16_t* vps = vT + (size_t)((b * 4 + g) * 128) * 4096;
  if (c <= 15) { AT_IDS; QF_LOAD();
    st_init(S);
    if (c > 0) {
      SWEEPF(0, c, {
        AT_QKV();
        at_online<0>(S, p0, p1, 0, 0, 0, true, hh);
        at_pv(vfr, p0, p1, S.o0, S.o1); });
    }
    SWEEPF(c, 1, {
      AT_QKV();
      at_online<1>(S, p0, p1, (c + step_) * 64, 0, t, true, hh);
      at_pv(vfr, p0, p1, S.o0, S.o1); });
    const float lt = x32_sum(S.l); const float slc_sc = lt > 0.f ? gates(16) / lt : 0.f;
    bf16_t* op = attn + (tok * DM + (g * 4 + h) * 64);
#pragma unroll
    for (int i = 0; i < 16; ++i) { S.o0[i] = S.o0[i] * slc_sc + otg(i); S.o1[i] = S.o1[i] * slc_sc + otg(16 + i); }
#pragma unroll
    for (int gi = 0; gi < 4; ++gi) {
      u32x2 a; a.x = pk2(S.o0[4 * gi], S.o0[4 * gi + 1]); a.y = pk2(S.o0[4 * gi + 2], S.o0[4 * gi + 3]);
      u32x2 bq; bq.x = pk2(S.o1[4 * gi], S.o1[4 * gi + 1]); bq.y = pk2(S.o1[4 * gi + 2], S.o1[4 * gi + 3]);
      *(u32x2*)(op + 8 * gi + 4 * hh) = a; *(u32x2*)(op + 32 + 8 * gi + 4 * hh) = bq;
    }
  } else {
    const int nc = c - 2;
    unsigned char* QL = lds + AT_QL; int* NJ = (int*)(lds + AT_NJ); unsigned short* ITEMS = (unsigned short*)(lds + AT_ITEMS); int* MISC = (int*)(lds + AT_MISC);
    float* MREF = (float*)(lds + AT_MREF); float* LS = (float*)(lds + AT_LACC); unsigned char* INVQ = lds + AT_INVQ; unsigned char* SLOT = lds + AT_IMP;
    float* const LOWN = (float*)(lds + AT_LOWN); const float k64 = 5.421010862427522e-20f;
    { AT_IDS;
    { const int q = tid >> 3; for (int s = 1 + (tid & 7); s <= nc; s += 8) IMP[q * AT_IMPS + s] += EE[q * AT_IMPS + s - 1]; }
    if (tid < 256) SEL[tid] = 0u;
    if (tid < 128) ((unsigned*)INVQ)[tid] = 0u;
    __syncthreads();
    {
      const int q = tid >> 3, sub = tid & 7; const float* ip = IMP + q * AT_IMPS;
      unsigned key[16];
#pragma unroll
      for (int k = 0; k < 16; ++k) { const int s = 1 + sub + 8 * k; key[k] = s <= nc ? __float_as_uint(ip[s]) + 1u : 0u; }
      unsigned T = 0u;
      for (int bit = 30; bit >= 0; --bit) {
        const unsigned cand = T | (1u << bit); int cn = 0;
#pragma unroll
        for (int k = 0; k < 16; ++k) cn += key[k] >= cand ? 1 : 0;
        cn = sum8i(cn);
        if (cn >= 13) T = cand;
      }
      int ngt = 0, neq = 0;
#pragma unroll
      for (int k = 0; k < 16; ++k) { ngt += key[k] > T ? 1 : 0; neq += key[k] == T ? 1 : 0; }
      ngt = sum8i(ngt); neq = sum8i(neq);
      const int need = 13 - ngt;
      unsigned w0 = 0u, w1 = 0u, w2 = 0u, w3 = 0u;
      if (!__any(neq > need)) {
#pragma unroll
        for (int k = 0; k < 16; ++k) if (key[k] >= T && key[k] != 0u) { const int s = 1 + sub + 8 * k; const unsigned bt = 1u << (s & 31); if (s < 32) w0 |= bt; else if (s < 64) w1 |= bt; else if (s < 96) w2 |= bt; else w3 |= bt; }
      } else {
        int taken = 0; const int gsh = lane & ~7;
#pragma unroll
        for (int k = 0; k < 16; ++k) {
          const bool eq = key[k] == T && key[k] != 0u; const unsigned long long mk = __ballot(eq);
          const unsigned grp = (unsigned)(mk >> gsh) & 0xffu; const int before = __popc(grp & ((1u << sub) - 1u));
          const bool pick = key[k] > T || (eq && taken + before < need);
          taken += __popc(grp);
          if (pick) { const int s = 1 + sub + 8 * k; const unsigned bt = 1u << (s & 31); if (s < 32) w0 |= bt; else if (s < 64) w1 |= bt; else if (s < 96) w2 |= bt; else w3 |= bt; }
        }
      }
      if (w0) atomicOr(&SEL[q * 4], w0); if (w1) atomicOr(&SEL[q * 4 + 1], w1); if (w2) atomicOr(&SEL[q * 4 + 2], w2); if (w3) atomicOr(&SEL[q * 4 + 3], w3);
    }
    __syncthreads();
    for (int j = 1 + w; j <= nc; j += NWAVE) {
      const bool bit = (SEL[lane * 4 + (j >> 5)] >> (j & 31)) & 1u;
      const unsigned long long mk = __ballot(bit);
      const int rank = __builtin_amdgcn_mbcnt_hi((unsigned)(mk >> 32), __builtin_amdgcn_mbcnt_lo((unsigned)mk, 0u));
      if (bit) QL[j * 64 + rank] = (unsigned char)lane;
      const int cnt = __popcll(mk);
      if (lane < ((8 - (cnt & 7)) & 7)) QL[j * 64 + cnt + lane] = 0;
      if (lane == 0) NJ[j] = cnt;
    }
    __syncthreads();
    if (w == 0) {
      const int ja = 1 + lane, jb = 65 + lane;
      const int ca = ja <= nc ? (NJ[ja] + 7) >> 3 : 0, cb = jb <= nc ? (NJ[jb] + 7) >> 3 : 0;
      int sa = ca, sb = cb;
#pragma unroll
      for (int o = 1; o < 64; o <<= 1) { const int ta = __shfl_up(sa, o), tb = __shfl_up(sb, o); if (lane >= o) { sa += ta; sb += tb; } }
      const int tota = __shfl(sa, 63);
      for (int k = 0; k < ca; ++k) ITEMS[sa - ca + k] = (unsigned short)(ja * 8 + k);
      for (int k = 0; k < cb; ++k) ITEMS[tota + sb - cb + k] = (unsigned short)(jb * 8 + k);
      if (lane == 63) MISC[0] = tota + sb;
    }
    }
    { AT_IDS; QF_LOAD();
    st_init(S);
    SWEEPF(0, 1, {
      AT_QKV();
      at_online<0>(S, p0, p1, 0, 0, 0, true, hh);
      at_pv(vfr, p0, p1, S.o0, S.o1); });
    SWEEPF(c - 1, 2, {
      AT_QKV();
      at_online<1>(S, p0, p1, c * 64, 0, t, step_ == 1, hh);
      at_pv(vfr, p0, p1, S.o0, S.o1); });
    { const float lt = x32_sum(S.l);
      if (hh == 0) { MREF[qrow] = S.m + 64.f; LS[w * 32 + r] = lt * k64; } }
#define SLOT_WRITE(x, o0_, o1_, scale_) do { unsigned char* sp_ = SLOT + (x) * 8192 + r * 256; \
      _Pragma("unroll") for (int gi_ = 0; gi_ < 4; ++gi_) { \
        const f32x4 va_ = {o0_[4 * gi_] * (scale_), o0_[4 * gi_ + 1] * (scale_), o0_[4 * gi_ + 2] * (scale_), o0_[4 * gi_ + 3] * (scale_)}; \
        const f32x4 vb_ = {o1_[4 * gi_] * (scale_), o1_[4 * gi_ + 1] * (scale_), o1_[4 * gi_ + 2] * (scale_), o1_[4 * gi_ + 3] * (scale_)}; \
        *(f32x4*)(sp_ + (((2 * gi_ + hh) ^ (r & 15)) * 16)) = va_; *(f32x4*)(sp_ + (((8 + 2 * gi_ + hh) ^ (r & 15)) * 16)) = vb_; } } while (0)
#define SLOT_READ(x, col_) (*(const f32x4*)(SLOT + (x) * 8192 + (col_) * 256 + ((ach ^ ((col_) & 15)) * 16)))
    SLOT_WRITE(w, S.o0, S.o1, k64);
    __syncthreads();
    }
    {
      AT_IDS; const int wu = __builtin_amdgcn_readfirstlane(w);
      const int nitems = MISC[0], nrounds = (nitems + 3) >> 2;
      if (wu >= 4) {
        const int ow = wu - 4, oq = lane >> 2, oh = lane & 3, srcslot = 2 * ow + (lane >> 5), scol = lane & 31;
        f32x4 acc[16]; float accl;
        { const unsigned char* rp = SLOT + srcslot * 8192 + scol * 256;
#pragma unroll
          for (int k = 0; k < 16; ++k) acc[k] = *(const f32x4*)(rp + ((k ^ (scol & 15)) * 16));
          accl = LS[srcslot * 32 + scol]; }
        __syncthreads();
        for (int rd = 0; rd <= nrounds; ++rd) {
          if (rd > 0) {
            const int set = (rd - 1) & 1;
            unsigned* ivp = (unsigned*)(INVQ + set * 256) + 16 * ow + oq;
            unsigned iv = *ivp;
            if (__any(iv != 0u)) {
              if (iv != 0u && oh == 0) *ivp = 0u;
              do {
                const int x = (iv & 0xffu) ? 0 : (iv & 0xff00u) ? 1 : (iv & 0xff0000u) ? 2 : 3;
                const unsigned byte = (iv >> (8 * x)) & 0xffu;
                iv &= ~(0xffu << (8 * x));
                if (byte) {
                  const int col = (int)(byte - 1) * 4 + oh;
                  const unsigned char* rp = SLOT + (set * 4 + x) * 8192 + col * 256;
                  f32x4 tq[16];
#pragma unroll
                  for (int k = 0; k < 16; ++k) tq[k] = *(const f32x4*)(rp + ((k ^ (col & 15)) * 16));
                  const float tl = LS[(set * 4 + x) * 32 + col];
                  __builtin_amdgcn_sched_barrier(0);
#pragma unroll
                  for (int k = 0; k < 16; ++k) acc[k] += tq[k];
                  accl += tl;
                }
              } while (__any(iv != 0u));
            }
          }
          __syncthreads();
        }
#pragma unroll
        for (int i = 0; i < 16; ++i) { S.o0[i] = otg(i); S.o1[i] = otg(16 + i); }
        SLOT_WRITE(w, S.o0, S.o1, 1.0f);
        __syncthreads();
        {
          const unsigned tq = (unsigned)b * SEQ + 64 * c + 16 * ow + oq;
          const float gs = gbase[tq * 48 + 16 + g * 4 + oh]; const float sc = accl > 0.f ? gs / accl : 0.f;
          const unsigned char* rp = SLOT + srcslot * 8192 + scol * 256;
          bf16_t* op = attn + (tq * DM + (g * 4 + oh) * 64);
#pragma unroll
          for (int k2 = 0; k2 < 8; ++k2) {
            const f32x4 v0 = acc[2 * k2] * sc + *(const f32x4*)(rp + (((2 * k2) ^ (scol & 15)) * 16)), v1 = acc[2 * k2 + 1] * sc + *(const f32x4*)(rp + (((2 * k2 + 1) ^ (scol & 15)) * 16));
            u32x4 o; o.x = pk2(v0.x, v0.y); o.y = pk2(v0.z, v0.w); o.z = pk2(v1.x, v1.y); o.w = pk2(v1.z, v1.w);
            *(u32x4*)(op + 8 * k2) = o;
          }
        }
      } else {
        __syncthreads();
        const bf16_t* kgl = kps + lane * 8; const bf16_t* vgl = vps + lane * 8;
        bf16x8 kfA[8], vfA[8], kfB[8], vfB[8];
#define FLOAD(KF, VF, jj) do { _Pragma("unroll") for (int f_ = 0; f_ < 8; ++f_) { KF[f_] = *(const bf16x8*)(kgl + (size_t)(jj) * 4096 + f_ * 512); VF[f_] = *(const bf16x8*)(vgl + (size_t)(jj) * 4096 + f_ * 512); } } while (0)
        int rowc = 0, qqc = 0; bool validc = false; float mrc = 1e30f; int en = 0;
        if (wu < nitems) { const int e0 = ITEMS[wu]; const int j0_ = e0 >> 3; const int qs_ = 8 * (e0 & 7) + (r >> 2); validc = qs_ < NJ[j0_]; qqc = QL[j0_ * 64 + qs_]; rowc = qqc * 4 + h; mrc = validc ? MREF[rowc] : 1e30f; FLOAD(kfA, vfA, j0_); }
        if (wu + 4 < nitems) en = __builtin_amdgcn_readfirstlane(ITEMS[wu + 4]);
        FLOAD(kfB, vfB, en >> 3);
#define ITEM_ROUND(KF, VF, rd_) do { \
          const int it = (rd_) * 4 + wu, set = (rd_) & 1; \
          if (it < nitems) { \
            const bool hasn = it + 4 < nitems; \
            const int jn = en >> 3, qsn = 8 * (en & 7) + (r >> 2);        \
            bf16x8 qv[4];                                               \
            _Pragma("unroll") for (int ds = 0; ds < 4; ++ds) qv[ds] = *(const bf16x8*)(lds + AT_QS + rowc * 128 + (((ds * 2 + hh) ^ (rowc & 7)) * 16)); \
            const int njn = NJ[jn]; const int qqn = QL[jn * 64 + qsn]; \
            const int en2 = it + 8 < nitems ? __builtin_amdgcn_readfirstlane(ITEMS[it + 8]) : 0; const int j2 = en2 >> 3; \
            __builtin_amdgcn_sched_barrier(0); \
            const f32x16 z = {0.f, 0.f, 0.f, 0.f, 0.f, 0.f, 0.f, 0.f, 0.f, 0.f, 0.f, 0.f, 0.f, 0.f, 0.f, 0.f}; \
            _Pragma("unroll") for (int ds = 0; ds < 4; ++ds) { \
              if (ds == 0) { p0 = MFMA32(KF[0], qv[0], z); p1 = MFMA32(KF[4], qv[0], z); } else { p0 = MFMA32(KF[ds], qv[ds], p0); p1 = MFMA32(KF[4 + ds], qv[ds], p1); } \
            } \
            const bool validn = hasn && qsn < njn; const int rown = qqn * 4 + h; \
            const float mrn = validn ? MREF[rown] : 1e30f; \
            float rs = 0.f; \
            _Pragma("unroll") for (int i = 0; i < 16; ++i) { \
              p0[i] = __builtin_amdgcn_exp2f(fminf(p0[i] - mrc, 120.f)); p1[i] = __builtin_amdgcn_exp2f(fminf(p1[i] - mrc, 120.f)); rs += p0[i] + p1[i]; \
              if (i & 1) { KF[i >> 1] = *(const bf16x8*)(kgl + (size_t)j2 * 4096 + (i >> 1) * 512); __builtin_amdgcn_sched_barrier(0); } \
            } \
            rs = x32_sum(rs); \
            f32x16 o0 = z, o1 = z; \
            _Pragma("unroll") for (int gk = 0; gk < 4; ++gk) { const bf16x8 pb = (gk < 2) ? pack8(p0, gk & 1) : pack8(p1, gk & 1); o0 = MFMA32(VF[gk], pb, o0); o1 = MFMA32(VF[4 + gk], pb, o1); } \
            { unsigned char* sp_ = SLOT + (set * 4 + wu) * 8192 + r * 256; \
              _Pragma("unroll") for (int gi = 0; gi < 4; ++gi) { \
                const f32x4 va_ = {o0[4 * gi], o0[4 * gi + 1], o0[4 * gi + 2], o0[4 * gi + 3]}; const f32x4 vb_ = {o1[4 * gi], o1[4 * gi + 1], o1[4 * gi + 2], o1[4 * gi + 3]}; \
                *(f32x4*)(sp_ + (((2 * gi + hh) ^ (r & 15)) * 16)) = va_; *(f32x4*)(sp_ + (((8 + 2 * gi + hh) ^ (r & 15)) * 16)) = vb_; \
                VF[2 * gi] = *(const bf16x8*)(vgl + (size_t)j2 * 4096 + (2 * gi) * 512); VF[2 * gi + 1] = *(const bf16x8*)(vgl + (size_t)j2 * 4096 + (2 * gi + 1) * 512); \
                __builtin_amdgcn_sched_barrier(0); \
              } } \
            if (hh == 0) LS[(set * 4 + wu) * 32 + r] = rs; \
            if (validc && h == 0 && hh == 0) INVQ[set * 256 + qqc * 4 + wu] = (unsigned char)((r >> 2) + 1); \
            rowc = rown; qqc = qqn; validc = validn; mrc = mrn; en = en2; \
          } } while (0)
        for (int rd = 0; rd < nrounds; rd += 2) {
          ITEM_ROUND(kfA, vfA, rd);
          __syncthreads();
          if (rd + 1 < nrounds) {
            ITEM_ROUND(kfB, vfB, rd + 1);
            __syncthreads();
          }
        }
#undef ITEM_ROUND
#undef FLOAD
#undef ITEM_META
#undef KLOAD
#undef VLOAD
        __syncthreads();
#pragma unroll
        for (int i = 0; i < 16; ++i) { S.o0[i] = otg(i); S.o1[i] = otg(16 + i); }
        SLOT_WRITE(w, S.o0, S.o1, 1.0f);
        __syncthreads();
      }
    }
#undef SLOT_WRITE
#undef SLOT_READ
  }
  __syncthreads();
#undef ST_LOAD
#undef ST_STORE
#undef SWEEP
#undef ST_LOADF
#undef ST_STOREF
#undef SWEEPF
#undef gates
#undef otg
#undef QF_LOAD
#undef AT_QKV
#undef AT_IDS
}
DI void phase_attn(const Params& P_, unsigned char* lds) {
  Params P = P_; { size_t z_ = 0; asm volatile("" : "+s"(z_)); P.ws = P_.ws + z_; }
  const int G = gridDim.x, bx = obid();
  const int vcu = (G % 8 == 0) ? (bx % 8) * (G / 8) + bx / 8 : bx;
  for (int idx = vcu; idx < 1024; idx += G) {
    const int i = idx >> 8, v = idx & 255, bg = v >> 5, s = v & 31;
    const int c = i == 0 ? s : i == 1 ? 63 - s : i == 2 ? 64 + s : 127 - s;
    attn_tile(P, lds, bg >> 2, bg & 3, c);
  }
}


#define LAS __attribute__((address_space(3)))
#define XB_TMO      128
#define XB_XCNT(j)  (256  + 64 * (j))
#define XB_XSUB(j)  (1280 + 64 * (j))
#define XB_XGEN(j)  (2304 + 64 * (j))
#define XB_TOP      3328
#define XB_TOPGEN   3392
#define XCD_BAR_WORDS 3456
#define XB_SPIN_CAP (1u << 18)
__device__ __forceinline__ unsigned xb_ld(unsigned* p)              { return __hip_atomic_load(p, __ATOMIC_RELAXED, __HIP_MEMORY_SCOPE_AGENT); }
__device__ __forceinline__ unsigned xb_add(unsigned* p, unsigned v) { return __hip_atomic_fetch_add(p, v, __ATOMIC_RELAXED, __HIP_MEMORY_SCOPE_AGENT); }
__device__ __forceinline__ unsigned xb_xcc_id() { return (unsigned)__builtin_amdgcn_s_getreg((3 << 11) | 20) & 0xFu; }
#define XB_SPIN(cond, bar) do { unsigned _sp = 0; while (cond) { __builtin_amdgcn_s_sleep(1); \
    if ((++_sp & 255u) == 0u) { if (xb_ld(&(bar)[XB_TMO])) break; if (_sp > XB_SPIN_CAP) { atomicAdd(&(bar)[XB_TMO], 1u); break; } } } } while (0)
struct XcdBarrier { unsigned* bar; unsigned x; volatile LAS unsigned* st; };
__device__ __forceinline__ XcdBarrier xcd_barrier_post(unsigned* bar, volatile LAS unsigned* st) {
    XcdBarrier b; b.bar = bar; b.x = xb_xcc_id(); b.st = st;
    if (threadIdx.x == 0) (void)xb_add(&bar[XB_XCNT(b.x)], 1u);
    return b;
}
__device__ __forceinline__ void xcd_barrier_complete(unsigned* bar, unsigned x, unsigned& nloc, unsigned& nx) {
    const unsigned G = gridDim.x * gridDim.y * gridDim.z;
    unsigned sum, cnt, mine, sp = 0u;
    for (;;) {
        sum = 0u; cnt = 0u; mine = 0u;
#pragma unroll
        for (unsigned j = 0; j < 16; ++j) { const unsigned c = xb_ld(&bar[XB_XCNT(j)]); sum += c; cnt += (c > 0u) ? 1u : 0u; mine = (j == x) ? c : mine; }
        if (sum == G) break;
        __builtin_amdgcn_s_sleep(1);
        if ((++sp & 255u) == 0u) { if (xb_ld(&bar[XB_TMO])) break; if (sp > XB_SPIN_CAP) { atomicAdd(&bar[XB_TMO], 1u); break; } }
    }
    nloc = mine > 0u ? mine : 1u; nx = cnt > 0u ? cnt : 1u;
}
__device__ __forceinline__ void xcd_barrier(const XcdBarrier& b) {
    asm volatile("s_waitcnt vmcnt(0)" ::: "memory");
    __syncthreads();
    if (threadIdx.x == 0) {
        unsigned* bar = b.bar; { size_t z_ = 0; asm volatile("" : "+s"(z_)); bar += z_; }
        __builtin_amdgcn_s_waitcnt(0);
        unsigned nloc = b.st[0], nx = b.st[1];
        if (nloc == 0u) { xcd_barrier_complete(bar, b.x, nloc, nx); b.st[0] = nloc; b.st[1] = nx; }
        const unsigned old = xb_add(&bar[XB_XSUB(b.x)], 1u);
        const unsigned gen = old / nloc;
        if (old + 1u == (gen + 1u) * nloc) {
            __builtin_amdgcn_fence(__ATOMIC_RELEASE, "agent");
            asm volatile("s_waitcnt vmcnt(0)" ::: "memory");
            const unsigned og = xb_add(&bar[XB_TOP], 1u);
            const unsigned tg = og / nx;
            if (og + 1u == (tg + 1u) * nx) xb_add(&bar[XB_TOPGEN], 1u);
            else XB_SPIN(xb_ld(&bar[XB_TOPGEN]) == tg, bar);
            __builtin_amdgcn_fence(__ATOMIC_ACQUIRE, "agent");
            xb_add(&bar[XB_XGEN(b.x)], 1u);
            asm volatile("s_waitcnt vmcnt(0)" ::: "memory");
        } else {
            XB_SPIN(xb_ld(&bar[XB_XGEN(b.x)]) == gen, bar);
            __builtin_amdgcn_fence(__ATOMIC_ACQUIRE, "agent");
            asm volatile("s_waitcnt vmcnt(0)" ::: "memory");
        }
    }
    __syncthreads();
}

__global__ void __launch_bounds__(NTHR) fwd_kernel(Params P) {
  extern __shared__ __attribute__((aligned(16))) unsigned char lds[];
  cg::grid_group grid = cg::this_grid();
  const int gtid = blockIdx.x * NTHR + threadIdx.x;
  if (threadIdx.x < 4) ((unsigned*)(lds + LDS_BYTES - 16))[threadIdx.x] = 0u;
  __syncthreads();
  const XcdBarrier xbar = xcd_barrier_post((unsigned*)(P.ws + WS_BAR), (volatile LAS unsigned*)(lds + LDS_BYTES - 16));
#define GSYNC() xcd_barrier(xbar)
  s5_params(P, gtid);
  {
    float* modb = (float*)(P.ws + WS_MOD); float* cbb = (float*)(P.ws + WS_CB);
    for (int it = blockIdx.x; it < 192 + 16; it += gridDim.x) {
      if (it < 192) { const int l = it / 96, j0 = (it % 96) * 64;
        gemv_item((float*)lds, P.in[2] + (size_t)l * DM * 6144, DM, 6144, j0, P.in[1], P.in[1] + DM, true, P.in[3] + l * 6144, modb + (size_t)(l * 2) * 6144, modb + (size_t)(l * 2 + 1) * 6144);
      } else { const int r = it - 192, l = r >> 3, kv = (r >> 2) & 1, j0 = (r & 3) * 64;
        gemv_item((float*)lds, P.in[17] + (size_t)(l * 2 + kv) * 2048 * 256, 2048, 256, j0, P.in[16] + (size_t)(l * 2 + kv) * 2048, nullptr, false, nullptr, cbb + (l * 2 + kv) * 256, nullptr);
      }
    }
  }
  for (int it = blockIdx.x; it < DEPTH * 32 * 6; it += gridDim.x) s5_tables(P, it / 192, (it % 192) / 6, it % 6, lds);
  convert_weights(P, 0, lds);
  grid.sync();
  for (int l = 0; l < DEPTH; ++l) {
    if (l == 0) norm_simple<0>(P, l); else { norm_simple<1>(P, l); convert_weights(P, 1, lds); }
    GSYNC();
#if EN_MIXER
    phase_inproj8(P, lds);
    GSYNC();
    phase_s5a(P, l, lds);
    __syncthreads();
#if EN_ATTN
    phase_gates(P, lds);
    __syncthreads();
    phase_cmp1(P, l, lds);
#endif
    GSYNC();
    s5_carry(P, l);
#if EN_ATTN
    phase_cmp2(P, lds);
#endif
    GSYNC();
#if EN_ATTN
    phase_attn(P, lds);
    __syncthreads();
#endif
    phase_s5c(P, l, lds);
    GSYNC();
    phase_glu(P, lds);
    GSYNC();
    phase_merge8(P, lds);
    GSYNC();
    phase_wout8(P, l, lds);
    GSYNC();
#else
    if (l == 0) { for (size_t i = (size_t)gtid * 4; i < (size_t)NT * DM; i += (size_t)gridDim.x * NTHR * 4) *(f32x4*)(P.out + i) = *(const f32x4*)(P.in[0] + i); GSYNC(); }
#endif
#if EN_MOE
    norm_route(P, l, lds);
    GSYNC();
    phase_moe1(P, l, lds);
    GSYNC();
    phase_moe2(P, l, lds);
    GSYNC();
#endif
  }
  norm_simple<3>(P, 0);
}

extern "C" void kernel_launch(void* const* d_in, const int* in_sizes, int n_in, void* d_out, int out_size, void* d_ws, size_t ws_size, hipStream_t stream) {
  static int grid = 0;
  if (grid == 0) {
    if (n_in != 30 || out_size != NT * DM || ws_size < WS_END2) { fprintf(stderr, "kernel_launch: unexpected shapes (n_in %d out %d ws %zu need %zu)\n", n_in, out_size, ws_size, (size_t)WS_END2); grid = -1; return; }
    int dev = 0, cus = 0, per_cu = 0;
    hipGetDevice(&dev);
    hipDeviceGetAttribute(&cus, hipDeviceAttributeMultiprocessorCount, dev);
    hipFuncSetAttribute((const void*)fwd_kernel, hipFuncAttributeMaxDynamicSharedMemorySize, LDS_BYTES);
    hipOccupancyMaxActiveBlocksPerMultiprocessor(&per_cu, (const void*)fwd_kernel, NTHR, LDS_BYTES);
    if (per_cu < 1) { fprintf(stderr, "kernel_launch: occupancy query says %d blocks/CU\n", per_cu); per_cu = 1; }
    grid = cus;
    (void)hipGetLastError();
  }
  if (grid < 0) return;
  Params p{};
  for (int i = 0; i < 30; ++i) p.in[i] = (const float*)d_in[i];
  p.out = (float*)d_out; p.ws = (unsigned char*)d_ws;
  if (hipMemsetAsync(p.ws, 0, WS_ZERO_BYTES, stream) != hipSuccess) { fprintf(stderr, "kernel_launch: memset failed\n"); return; }
  void* args[] = {&p};
  hipError_t e = hipLaunchCooperativeKernel((const void*)fwd_kernel, dim3(grid), dim3(NTHR), args, LDS_BYTES, stream);
  if (e != hipSuccess) fprintf(stderr, "cooperative launch failed: %s (grid %d)\n", hipGetErrorString(e), grid);
}
```

```cpp
#include <hip/hip_runtime.h>
#include <hip/hip_cooperative_groups.h>
#include <cstdio>
#include <cstdint>
namespace cg = cooperative_groups;

#ifndef EN_MIXER
#define EN_MIXER 1
#endif
#ifndef EN_ATTN
#define EN_ATTN 1
#endif
#ifndef EN_MOE
#define EN_MOE 1
#endif

#define DI __device__ __forceinline__
typedef unsigned short bf16_t;
typedef short bf16x8 __attribute__((ext_vector_type(8)));
typedef short s16x4 __attribute__((ext_vector_type(4)));
typedef float f32x4 __attribute__((ext_vector_type(4)));
typedef float f32x16 __attribute__((ext_vector_type(16)));
typedef unsigned u32x4 __attribute__((ext_vector_type(4)));
typedef unsigned u32x2 __attribute__((ext_vector_type(2)));

constexpr int DM = 1024, NB = 2, SEQ = 8192, NT = NB * SEQ, DEPTH = 2;
constexpr int INW = 5168, INWP = 5376;
constexpr int NTHR = 512, NWAVE = 8;
constexpr int NEXP = 32, LISTCAP = 16384;
constexpr float EPS = 1e-6f;
constexpr float QSCALE = 0.125f * 1.4426950408889634f;

constexpr size_t MiB = 1u << 20;
constexpr size_t WS_CNT = 0;
constexpr size_t WS_BAR = 1024;
constexpr size_t WS_ZERO_BYTES = 16384;
constexpr size_t WS_MOD = 16384;
constexpr size_t WS_CB = WS_MOD + 2 * 2 * 6144 * 4;
constexpr size_t WS_S5P = WS_CB + 2 * 2 * 256 * 4;
constexpr size_t WS_WT = WS_S5P + 2 * 32 * 64 * 36 * 4;
constexpr size_t WS_SMALL_END = WS_WT + (size_t)NT * 2 * 4;
static_assert(WS_SMALL_END <= 1 * MiB, "small region");
constexpr size_t WS_W = 1 * MiB;
constexpr size_t W_IN = 0;
constexpr size_t W_GLU = W_IN + (size_t)INWP * 1024 * 2;
constexpr size_t W_O = W_GLU + 512 * 512 * 2;
constexpr size_t W_SO = W_O + 1024 * 1024 * 2;
constexpr size_t W_OUT = W_SO + 1024 * 512 * 2;
constexpr size_t W_C1 = W_OUT + 1024 * 1024 * 2;
constexpr size_t W_C2 = W_C1 + 2 * 256 * 2048 * 2;
constexpr size_t W_GU = W_C2 + 2 * 128 * 256 * 2;
constexpr size_t W_D = W_GU + (size_t)32 * 512 * 1024 * 2;
constexpr size_t W_END = W_D + (size_t)32 * 1024 * 256 * 2;
static_assert(W_END <= 67 * MiB, "weights region");
constexpr size_t WS_A = 68 * MiB;
constexpr size_t WS_B = WS_A + 32 * MiB;
constexpr size_t WS_C = WS_B + 32 * MiB;
constexpr size_t WS_DV = WS_C + 32 * MiB;
constexpr size_t WS_E = WS_DV + 16 * MiB;
constexpr size_t WS_F = WS_E + 32 * MiB;
constexpr size_t WS_G = WS_F + 64 * MiB;
constexpr size_t WS_GATES = WS_G + 16 * MiB;
constexpr size_t WS_HID = WS_GATES + 3 * MiB;
constexpr size_t WS_KC = WS_HID + 4 * MiB;
constexpr size_t WS_VC = WS_KC + 512 * 1024;
constexpr size_t WS_L = WS_VC + 512 * 1024;
constexpr size_t WS_LIST = WS_L + 4 * MiB;
constexpr size_t WS_OT = WS_LIST + 2 * MiB;
constexpr size_t WS_TAB = WS_OT + 16 * MiB;
constexpr size_t TAB_KT = 0, TAB_M1 = 1 * MiB, TAB_M2 = 9 * MiB, TAB_LAYER = 17 * MiB;
constexpr size_t WS_END = WS_TAB + 2 * TAB_LAYER;
constexpr size_t WS_KSF = WS_END;
constexpr size_t WS_END2 = WS_KSF + 8 * MiB;
constexpr size_t WS_SIN = WS_E + 16 * MiB;
constexpr int LDS_BYTES = 151552;

struct Params { const float* in[30]; float* out; unsigned char* ws; };

DI int otid() { int t = threadIdx.x; asm volatile("" : "+v"(t)); return t; }
DI int obid() { int t = blockIdx.x; asm volatile("" : "+s"(t)); return t; }
DI unsigned f2bf(float f) { unsigned u = __float_as_uint(f); return (u + 0x7fffu + ((u >> 16) & 1u)) >> 16; }
typedef float f32x2_t __attribute__((ext_vector_type(2))); typedef __bf16 bf16x2_t __attribute__((ext_vector_type(2)));
DI unsigned pk2(float lo, float hi) { const f32x2_t v = {lo, hi}; const bf16x2_t b = __builtin_convertvector(v, bf16x2_t); return __builtin_bit_cast(unsigned, b); }
DI float bflo(unsigned w) { return __uint_as_float(w << 16); }
DI float bfhi(unsigned w) { return __uint_as_float(w & 0xffff0000u); }
DI int perm16(int x) { return (x & ~12) | ((x & 4) << 1) | ((x & 8) >> 1); }
template <int CTRL> DI float dppf(float x) { return __builtin_bit_cast(float, __builtin_amdgcn_mov_dpp(__builtin_bit_cast(int, x), CTRL, 0xf, 0xf, true)); }
template <int CTRL> DI int dppi(int x) { return __builtin_amdgcn_mov_dpp(x, CTRL, 0xf, 0xf, true); }
constexpr int DPP_X1 = 0xB1, DPP_X2 = 0x4E, DPP_HM = 0x141, DPP_X8 = 0x128;
DI float x32_sum(float x) { auto t = __builtin_amdgcn_permlane32_swap(__float_as_uint(x), __float_as_uint(x), false, false); return __uint_as_float(t[0]) + __uint_as_float(t[1]); }
DI float x32_max(float x) { auto t = __builtin_amdgcn_permlane32_swap(__float_as_uint(x), __float_as_uint(x), false, false); return fmaxf(__uint_as_float(t[0]), __uint_as_float(t[1])); }
DI float x16_sum(float x) { auto t = __builtin_amdgcn_permlane16_swap(__float_as_uint(x), __float_as_uint(x), false, false); return __uint_as_float(t[0]) + __uint_as_float(t[1]); }
DI u32x4 widen16(u32x2 o0, u32x2 o1) {
  auto rx = __builtin_amdgcn_permlane16_swap(o0.x, o1.x, false, false); auto ry = __builtin_amdgcn_permlane16_swap(o0.y, o1.y, false, false);
  return (u32x4){rx[0], ry[0], rx[1], ry[1]};
}
DI int widen16_col(int fq) { return (fq & 1) ? 16 + 4 * (fq - 1) : 4 * fq; }
DI int sum8i(int v) { v += dppi<DPP_X1>(v); v += dppi<DPP_X2>(v); v += dppi<DPP_HM>(v); return v; }
DI float wave_sum(float v) {
  v += dppf<DPP_X1>(v); v += dppf<DPP_X2>(v); v += dppf<DPP_HM>(v); v += dppf<DPP_X8>(v);
  return x32_sum(x16_sum(v));
}
DI float sigmoidf_(float x) { return __builtin_amdgcn_rcpf(1.f + __expf(-x)); }
DI float gelu_tanh(float x) {
  const float z = 0.7978845608028654f * (x + 0.044715f * x * x * x);
  const float e = __expf(2.f * z);
  const float th = 1.f - 2.f * __builtin_amdgcn_rcpf(e + 1.f);
  return 0.5f * x * (1.f + th);
}
DI void sincos_d(double x, double& s, double& c) {
  const double k = rint(x * 0.6366197723675814);
  double r = fma(-k, 1.5707963267948966, x);
  r = fma(-k, 6.123233995736766e-17, r);
  const int q = ((int)k) & 3;
  const double r2 = r * r;
  const double sp = r * (1.0 + r2 * (-1.0 / 6 + r2 * (1.0 / 120 + r2 * (-1.0 / 5040 + r2 * (1.0 / 362880 + r2 * (-1.0 / 39916800 + r2 * (1.0 / 6227020800.0)))))));
  const double cp = 1.0 + r2 * (-0.5 + r2 * (1.0 / 24 + r2 * (-1.0 / 720 + r2 * (1.0 / 40320 + r2 * (-1.0 / 3628800 + r2 * (1.0 / 479001600 + r2 * (-1.0 / 87178291200.0)))))));
  s = (q == 0) ? sp : (q == 1) ? cp : (q == 2) ? -sp : -cp;
  c = (q == 0) ? cp : (q == 1) ? -sp : (q == 2) ? -cp : sp;
}

DI void gemv_item(float* lds, const float* W, int K, int N, int j0, const float* v0, const float* v1, bool do_silu, const float* bias, float* o0, float* o1) {
  const int tid = otid();
  float* sv = lds; float* red = lds + 4096;
  for (int k = tid; k < K; k += NTHR) {
    float a = v0[k], b = v1 ? v1[k] : 0.f;
    if (do_silu) { a = a / (1.f + expf(-a)); b = b / (1.f + expf(-b)); }
    sv[k] = a; sv[2048 + k] = b;
  }
  __syncthreads();
  const int jl = tid & 63, ks = tid >> 6, kper = K >> 3;
  const float* wp = W + (size_t)(ks * kper) * N + j0 + jl;
  float a0 = 0.f, a1 = 0.f;
#pragma unroll 8
  for (int k = 0; k < kper; ++k) { const float w = wp[(size_t)k * N]; a0 += sv[ks * kper + k] * w; a1 += sv[2048 + ks * kper + k] * w; }
  red[(ks * 64 + jl) * 2] = a0; red[(ks * 64 + jl) * 2 + 1] = a1;
  __syncthreads();
  if (tid < 64) {
    float s0 = 0.f, s1 = 0.f;
    for (int i = 0; i < 8; ++i) { s0 += red[(i * 64 + tid) * 2]; s1 += red[(i * 64 + tid) * 2 + 1]; }
    const float bb = bias ? bias[j0 + tid] : 0.f;
    o0[j0 + tid] = s0 + bb; if (o1) o1[j0 + tid] = s1 + bb;
  }
  __syncthreads();
}

DI void s5_params(const Params& P, int gtid) {
  if (gtid >= DEPTH * 32 * 64) return;
  const int l = gtid / 2048, g = (gtid / 64) % 32, p = gtid % 64;
  const float dt = expf(P.in[8][l * 32 + g]);
  const float lr = P.in[6][(l * 32 + g) * 64 + p], li = P.in[7][(l * 32 + g) * 64 + p];
  const float mag = expf(lr * dt); const float ang = li * dt;
  double sd, cd; sincos_d((double)ang, sd, cd);
  const float ab_re = mag * (float)cd, ab_im = mag * (float)sd;
  float* o = (float*)(P.ws + WS_S5P) + (size_t)((l * 32 + g) * 64 + p) * 36;
  o[0] = ab_re; o[1] = ab_im;
  double pr = ab_re, pi = ab_im;
  for (int i = 0; i < 6; ++i) { const double nr2 = pr * pr - pi * pi, ni2 = 2.0 * pr * pi; pr = nr2; pi = ni2; }
  o[2] = (float)pr; o[3] = (float)pi;
}

DI void s5_tables(const Params& P, int l, int g, int part, unsigned char* lds) {
  const int tid = otid(), lane = tid & 63;
  float* BBr = (float*)lds; float* BBi = BBr + 1024; float* CR = BBi + 1024; float* CI = CR + 1024;
  float* APr = CI + 1024; float* APi = APr + 65 * 64;
  bf16_t* tab = (bf16_t*)(P.ws + WS_TAB + (size_t)l * TAB_LAYER);
  bf16_t* Kt = tab + TAB_KT / 2 + (size_t)g * 64 * 256; bf16_t* M1 = tab + TAB_M1 / 2 + (size_t)g * 128 * 1024; bf16_t* M2 = tab + TAB_M2 / 2 + (size_t)g * 1024 * 128;
  __syncthreads();
  if (tid < 64) {
    const int p = tid;
    const float dt = expf(P.in[8][l * 32 + g]);
    const float lr = P.in[6][(l * 32 + g) * 64 + p], li = P.in[7][(l * 32 + g) * 64 + p];
    const float mag = expf(lr * dt); const float ang = li * dt;
    double sd, cd; sincos_d((double)ang, sd, cd);
    const float ab_re = mag * (float)cd, ab_im = mag * (float)sd;
    const float den = lr * lr + li * li, nr = ab_re - 1.0f;
    const float cr = (nr * lr + ab_im * li) / den, ci = (ab_im * lr - nr * li) / den;
    const float* br = P.in[9] + (size_t)((l * 32 + g) * 64 + p) * 16; const float* bi = P.in[10] + (size_t)((l * 32 + g) * 64 + p) * 16;
    for (int h = 0; h < 16; ++h) { BBr[p * 16 + h] = cr * br[h] - ci * bi[h]; BBi[p * 16 + h] = cr * bi[h] + ci * br[h]; }
    double pr = 1.0, pi = 0.0;
    for (int tau = 0; tau <= 64; ++tau) { APr[tau * 64 + p] = (float)pr; APi[tau * 64 + p] = (float)pi; const double n1 = pr * ab_re - pi * ab_im, n2 = pr * ab_im + pi * ab_re; pr = n1; pi = n2; }
  }
  for (int i = tid; i < 1024; i += NTHR) { CR[i] = P.in[11][(size_t)(l * 32 + g) * 1024 + i]; CI[i] = P.in[12][(size_t)(l * 32 + g) * 1024 + i]; }
  __syncthreads();
  if (part < 4)
  for (int task = part * 256 + tid; task < part * 256 + 256; task += NTHR) {
    const int tau = task >> 4, h = task & 15;
    float a[16];
#pragma unroll
    for (int j = 0; j < 16; ++j) a[j] = 0.f;
    for (int p = 0; p < 64; ++p) {
      const float c_r = CR[h * 64 + p], c_i = CI[h * 64 + p], a_r = APr[tau * 64 + p], a_i = APi[tau * 64 + p];
      const float xr = c_r * a_r - c_i * a_i, xi = c_r * a_i + c_i * a_r;
#pragma unroll
      for (int j4 = 0; j4 < 4; ++j4) { const f32x4 b_r = *(const f32x4*)(BBr + p * 16 + 4 * j4), b_i = *(const f32x4*)(BBi + p * 16 + 4 * j4);
        a[4 * j4] += xr * b_r.x - xi * b_i.x; a[4 * j4 + 1] += xr * b_r.y - xi * b_i.y; a[4 * j4 + 2] += xr * b_r.z - xi * b_i.z; a[4 * j4 + 3] += xr * b_r.w - xi * b_i.w; }
    }
    u32x4 o0, o1; o0.x = pk2(a[0], a[1]); o0.y = pk2(a[2], a[3]); o0.z = pk2(a[4], a[5]); o0.w = pk2(a[6], a[7]); o1.x = pk2(a[8], a[9]); o1.y = pk2(a[10], a[11]); o1.z = pk2(a[12], a[13]); o1.w = pk2(a[14], a[15]);
    *(u32x4*)(Kt + (size_t)task * 16) = o0; *(u32x4*)(Kt + (size_t)task * 16 + 8) = o1;
  }
  if (part == 4)
  for (int task = tid; task < 4096; task += NTHR) {
    const int p = task >> 6, i = task & 63;
    const float a_r = APr[(63 - i) * 64 + p], a_i = APi[(63 - i) * 64 + p];
    float re[16], im[16];
#pragma unroll
    for (int j = 0; j < 16; ++j) { const float b_r = BBr[p * 16 + j], b_i = BBi[p * 16 + j]; re[j] = a_r * b_r - a_i * b_i; im[j] = a_r * b_i + a_i * b_r; }
    u32x4 o; bf16_t* d0 = M1 + (size_t)(2 * p) * 1024 + i * 16; bf16_t* d1 = d0 + 1024;
    o.x = pk2(re[0], re[1]); o.y = pk2(re[2], re[3]); o.z = pk2(re[4], re[5]); o.w = pk2(re[6], re[7]); *(u32x4*)d0 = o;
    o.x = pk2(re[8], re[9]); o.y = pk2(re[10], re[11]); o.z = pk2(re[12], re[13]); o.w = pk2(re[14], re[15]); *(u32x4*)(d0 + 8) = o;
    o.x = pk2(im[0], im[1]); o.y = pk2(im[2], im[3]); o.z = pk2(im[4], im[5]); o.w = pk2(im[6], im[7]); *(u32x4*)d1 = o;
    o.x = pk2(im[8], im[9]); o.y = pk2(im[10], im[11]); o.z = pk2(im[12], im[13]); o.w = pk2(im[14], im[15]); *(u32x4*)(d1 + 8) = o;
  }
  if (part == 5)
  for (int task = tid; task < 4096; task += NTHR) {
    const int th = task >> 2, pq = task & 3, t = th >> 4, h = th & 15;
    unsigned w[16];
#pragma unroll
    for (int j = 0; j < 16; ++j) { const int p = pq * 16 + j;
      const float c_r = CR[h * 64 + p], c_i = CI[h * 64 + p], a_r = APr[(t + 1) * 64 + p], a_i = APi[(t + 1) * 64 + p];
      w[j] = pk2(c_r * a_r - c_i * a_i, -(c_r * a_i + c_i * a_r)); }
    bf16_t* d = M2 + (size_t)th * 128 + pq * 32;
    *(u32x4*)d = (u32x4){w[0], w[1], w[2], w[3]}; *(u32x4*)(d + 8) = (u32x4){w[4], w[5], w[6], w[7]};
    *(u32x4*)(d + 16) = (u32x4){w[8], w[9], w[10], w[11]}; *(u32x4*)(d + 24) = (u32x4){w[12], w[13], w[14], w[15]};
  }
  __syncthreads();
}

struct ConvJob { const float* src; bf16_t* dst; int ldw, K, c0, ncols, nmat, ldd, drow0, mode; size_t sstride, dstride; };
DI int conv_nitems(const ConvJob& j) { return j.nmat * (j.K >> 6) * ((j.ncols + 31) >> 5); }
DI int conv_drow(int mode, int drow0, int n) { return mode == 0 ? drow0 + n : drow0 + ((n >> 6) * 128 + ((n >> 4) & 3) * 32 + (n & 15)); }
DI void conv_item(const ConvJob& jb, int item, float* scr, int lane) {
  const int nblk = (jb.ncols + 31) >> 5, per = (jb.K >> 6) * nblk;
  const int mat = item / per, r = item % per, kb = r / nblk, nb = r % nblk, k0 = 64 * kb, n0 = 32 * nb;
  const float* W = jb.src + (size_t)mat * jb.sstride; bf16_t* WT = jb.dst + (size_t)mat * jb.dstride;
  const int n4 = (lane & 7) * 4; const bool nok = (n0 + n4) < jb.ncols;
#pragma unroll
  for (int i = 0; i < 8; ++i) { const int kk = 8 * i + (lane >> 3);
    const f32x4 v = nok ? *(const f32x4*)(W + (size_t)(k0 + kk) * jb.ldw + jb.c0 + n0 + n4) : (f32x4){0.f, 0.f, 0.f, 0.f};
    *(f32x4*)(scr + kk * 36 + n4) = v; }
  asm volatile("s_waitcnt lgkmcnt(0)" ::: "memory");
  const int c = lane & 7;
#pragma unroll
  for (int j = 0; j < 4; ++j) {
    const int n = (lane >> 3) + 8 * j; const float* sp = scr + (8 * c) * 36 + n;
    u32x4 o; o.x = pk2(sp[0], sp[36]); o.y = pk2(sp[72], sp[108]); o.z = pk2(sp[144], sp[180]); o.w = pk2(sp[216], sp[252]);
    if (n0 + n < jb.ncols) *(u32x4*)(WT + (size_t)conv_drow(jb.mode, jb.drow0, n0 + n) * jb.ldd + k0 + 8 * c) = o;
  }
  asm volatile("s_waitcnt lgkmcnt(0)" ::: "memory");
}
DI void conv_ld(const ConvJob& jb, int item, int lane, f32x4 (&v)[8]) {
  const int nblk = (jb.ncols + 31) >> 5, per = (jb.K >> 6) * nblk;
  const int mat = item / per, r = item % per, kb = r / nblk, nb = r % nblk, k0 = 64 * kb, n0 = 32 * nb;
  const float* W = jb.src + (size_t)mat * jb.sstride;
  const int n4 = (lane & 7) * 4; const bool nok = (n0 + n4) < jb.ncols;
#pragma unroll
  for (int i = 0; i < 8; ++i) { const int kk = 8 * i + (lane >> 3);
    v[i] = nok ? *(const f32x4*)(W + (size_t)(k0 + kk) * jb.ldw + jb.c0 + n0 + n4) : (f32x4){0.f, 0.f, 0.f, 0.f}; }
}
DI void conv_st(const ConvJob& jb, int item, float* scr, int lane, const f32x4 (&v)[8]) {
  const int nblk = (jb.ncols + 31) >> 5, per = (jb.K >> 6) * nblk;
  const int mat = item / per, r = item % per, kb = r / nblk, nb = r % nblk, k0 = 64 * kb, n0 = 32 * nb;
  bf16_t* WT = jb.dst + (size_t)mat * jb.dstride;
  const int n4 = (lane & 7) * 4;
#pragma unroll
  for (int i = 0; i < 8; ++i) { const int kk = 8 * i + (lane >> 3); *(f32x4*)(scr + kk * 36 + n4) = v[i]; }
  asm volatile("s_waitcnt lgkmcnt(0)" ::: "memory");
  const int c = lane & 7;
#pragma unroll
  for (int j = 0; j < 4; ++j) {
    const int n = (lane >> 3) + 8 * j; const float* sp = scr + (8 * c) * 36 + n;
    u32x4 o; o.x = pk2(sp[0], sp[36]); o.y = pk2(sp[72], sp[108]); o.z = pk2(sp[144], sp[180]); o.w = pk2(sp[216], sp[252]);
    if (n0 + n < jb.ncols) *(u32x4*)(WT + (size_t)conv_drow(jb.mode, jb.drow0, n0 + n) * jb.ldd + k0 + 8 * c) = o;
  }
  asm volatile("s_waitcnt lgkmcnt(0)" ::: "memory");
}
DI ConvJob conv_job(const Params& P, int l, int j) {
  unsigned char* wb = P.ws + WS_W; ConvJob J; J.nmat = 1; J.mode = 0; J.sstride = 0; J.dstride = 0; J.drow0 = 0; J.c0 = 0;
  const float* win = P.in[5] + (size_t)l * 1024 * INW;
  if (j < 5) { J.src = win; J.ldw = INW; J.K = 1024; J.dst = (bf16_t*)(wb + W_IN); J.ldd = 1024;
    if (j == 0) { J.c0 = 0; J.ncols = 1024; J.drow0 = 0; }
    else if (j == 1) { J.c0 = 1024; J.ncols = 1536; J.drow0 = 1024; }
    else if (j == 2) { J.c0 = 3120; J.ncols = 2048; J.drow0 = 2560; }
    else if (j == 3) { J.c0 = 2608; J.ncols = 512; J.drow0 = 4608; }
    else { J.c0 = 2560; J.ncols = 48; J.drow0 = 5120; }
  } else if (j == 5) { J.src = P.in[14] + (size_t)l * 512 * 512; J.ldw = 512; J.K = 512; J.ncols = 512; J.dst = (bf16_t*)(wb + W_GLU); J.ldd = 512; }
  else if (j == 6) { J.src = P.in[19] + (size_t)l * 1024 * 1024; J.ldw = 1024; J.K = 1024; J.ncols = 1024; J.dst = (bf16_t*)(wb + W_O); J.ldd = 1024; }
  else if (j == 7) { J.src = P.in[15] + (size_t)l * 512 * 1024; J.ldw = 1024; J.K = 512; J.ncols = 1024; J.dst = (bf16_t*)(wb + W_SO); J.ldd = 512; }
  else if (j == 8) { J.src = P.in[20] + (size_t)l * 1024 * 1024; J.ldw = 1024; J.K = 1024; J.ncols = 1024; J.dst = (bf16_t*)(wb + W_OUT); J.ldd = 1024; }
  else if (j == 9) { J.src = P.in[17] + (size_t)l * 2 * 2048 * 256; J.ldw = 256; J.K = 2048; J.ncols = 256; J.nmat = 2; J.sstride = 2048 * 256; J.dstride = 256 * 2048; J.dst = (bf16_t*)(wb + W_C1); J.ldd = 2048; }
  else if (j == 10) { J.src = P.in[18] + (size_t)l * 2 * 256 * 64; J.ldw = 64; J.K = 256; J.ncols = 64; J.nmat = 2; J.sstride = 256 * 64; J.dstride = 128 * 256; J.dst = (bf16_t*)(wb + W_C2); J.ldd = 256; }
  else if (j == 11) { J.src = P.in[26] + (size_t)l * 32 * 1024 * 256; J.ldw = 256; J.K = 1024; J.ncols = 256; J.nmat = 32; J.sstride = 1024 * 256; J.dstride = 512 * 1024; J.dst = (bf16_t*)(wb + W_GU); J.ldd = 1024; J.mode = 1; J.drow0 = 0; }
  else if (j == 12) { J.src = P.in[27] + (size_t)l * 32 * 1024 * 256; J.ldw = 256; J.K = 1024; J.ncols = 256; J.nmat = 32; J.sstride = 1024 * 256; J.dstride = 512 * 1024; J.dst = (bf16_t*)(wb + W_GU); J.ldd = 1024; J.mode = 1; J.drow0 = 16; }
  else { J.src = P.in[28] + (size_t)l * 32 * 256 * 1024; J.ldw = 1024; J.K = 256; J.ncols = 1024; J.nmat = 32; J.sstride = 256 * 1024; J.dstride = 1024 * 256; J.dst = (bf16_t*)(wb + W_D); J.ldd = 256; }
  return J;
}
DI void convert_weights(const Params& P_, int l, unsigned char* lds) {
  Params P = P_; { size_t z_ = 0; asm volatile("" : "+s"(z_)); P.ws = P_.ws + z_; }
  const int tid_ = otid(), bid = obid(), wave = tid_ >> 6, lane = tid_ & 63; (void)bid;
  float* scr = (float*)lds + wave * (64 * 36);
  const int NGW = gridDim.x * NWAVE; int off = bid * NWAVE + wave;
  for (int j = 0; j < 14; ++j) {
    const ConvJob J = conv_job(P, l, j); const int n = conv_nitems(J);
    while (off < n) {
      const bool two = off + NGW < n; f32x4 va[8], vb[8];
      conv_ld(J, off, lane, va);
      if (two) conv_ld(J, off + NGW, lane, vb);
      __builtin_amdgcn_sched_barrier(0);
      conv_st(J, off, scr, lane, va);
      if (two) conv_st(J, off + NGW, scr, lane, vb);
      off += two ? 2 * NGW : NGW;
    }
    off -= n;
  }
}

template <int MODE>
DI void norm_simple(const Params& P_, int l) {
  Params P = P_; { size_t z_ = 0; asm volatile("" : "+s"(z_)); P.ws = P_.ws + z_; }
  const int tid_ = otid(), bid = obid(), wave = tid_ >> 6, lane = tid_ & 63; (void)bid;
  const int NGW = gridDim.x * NWAVE;
  const float* mod = (const float*)(P.ws + WS_MOD);
  const bf16_t* ys = (const bf16_t*)(P.ws + WS_F);
  bf16_t* xn = (bf16_t*)(P.ws + WS_A);
  const float* xbase = P.in[0];
  const bf16_t* sb = MODE == 3 ? (const bf16_t*)(P.ws + WS_C) : (const bf16_t*)P.out;
  constexpr bool ADDY = (MODE != 0) && EN_MOE;
  f32x4 g[4], sh[4], sc[4], gg[4]; int pb = -1;
  { const float* gp = MODE == 3 ? P.in[29] : P.in[4] + (size_t)l * DM;
#pragma unroll
    for (int j = 0; j < 4; ++j) g[j] = *(const f32x4*)(gp + 4 * lane + 256 * j); }
  f32x4 v[4]; u32x2 xb[4], y0[4], y1[4];
#define NS_LOAD(vv, xx, a0, a1, rr) do { const float* xr_ = xbase + (size_t)(rr) * DM; \
    if (MODE == 0) { _Pragma("unroll") for (int j = 0; j < 4; ++j) vv[j] = *(const f32x4*)(xr_ + 4 * lane + 256 * j); } \
    else { _Pragma("unroll") for (int j = 0; j < 4; ++j) xx[j] = *(const u32x2*)(sb + (size_t)(rr) * DM + 4 * lane + 256 * j); } \
    if (ADDY) { _Pragma("unroll") for (int j = 0; j < 4; ++j) { a0[j] = *(const u32x2*)(ys + (size_t)((rr) * 2) * DM + 4 * lane + 256 * j); a1[j] = *(const u32x2*)(ys + (size_t)((rr) * 2 + 1) * DM + 4 * lane + 256 * j); } } } while (0)
  const int row0 = bid * NWAVE + wave;
  if (row0 < NT) NS_LOAD(v, xb, y0, y1, row0);
  for (int row = row0; row < NT; row += NGW) {
    const int b = row >> 13;
    if (b != pb) { pb = b;
      if (ADDY) { const float* g2 = mod + (size_t)(((MODE == 1 ? 0 : 1) * 2 + b) * 6144) + 5120;
#pragma unroll
        for (int j = 0; j < 4; ++j) gg[j] = *(const f32x4*)(g2 + 4 * lane + 256 * j); }
      if (MODE != 3) { const float* md = mod + (size_t)((l * 2 + b) * 6144);
#pragma unroll
        for (int j = 0; j < 4; ++j) { sh[j] = *(const f32x4*)(md + 4 * lane + 256 * j); sc[j] = *(const f32x4*)(md + 1024 + 4 * lane + 256 * j); } }
    }
    f32x4 vn[4]; u32x2 xbn[4], y0n[4], y1n[4];
    if (row + NGW < NT) NS_LOAD(vn, xbn, y0n, y1n, row + NGW);
    __builtin_amdgcn_sched_barrier(0);
    if (MODE != 0) {
#pragma unroll
      for (int j = 0; j < 4; ++j) v[j] = (f32x4){bflo(xb[j].x), bfhi(xb[j].x), bflo(xb[j].y), bfhi(xb[j].y)};
    }
    if (ADDY) {
#pragma unroll
      for (int j = 0; j < 4; ++j) {
        v[j].x += gg[j].x * (bflo(y0[j].x) + bflo(y1[j].x)); v[j].y += gg[j].y * (bfhi(y0[j].x) + bfhi(y1[j].x));
        v[j].z += gg[j].z * (bflo(y0[j].y) + bflo(y1[j].y)); v[j].w += gg[j].w * (bfhi(y0[j].y) + bfhi(y1[j].y));
      }
    }
    float ss = 0.f;
#pragma unroll
    for (int j = 0; j < 4; ++j) ss += v[j].x * v[j].x + v[j].y * v[j].y + v[j].z * v[j].z + v[j].w * v[j].w;
    ss = wave_sum(ss);
    const float inv = rsqrtf(ss * (1.f / DM) + EPS);
    if (MODE == 3) {
#pragma unroll
      for (int j = 0; j < 4; ++j) { const int col = 4 * lane + 256 * j; *(f32x4*)(P.out + (size_t)row * DM + col) = v[j] * inv * g[j]; }
    } else {
      if (MODE == 1) {
#pragma unroll
        for (int j = 0; j < 4; ++j) { u32x2 o; o.x = pk2(v[j].x, v[j].y); o.y = pk2(v[j].z, v[j].w); *(u32x2*)((bf16_t*)P.out + (size_t)row * DM + 4 * lane + 256 * j) = o; }
      }
#pragma unroll
      for (int j = 0; j < 4; ++j) {
        const int col = 4 * lane + 256 * j;
        const f32x4 h = v[j] * inv * g[j] * (sc[j] + 1.f) + sh[j];
        u32x2 o; o.x = pk2(h.x, h.y); o.y = pk2(h.z, h.w);
        *(u32x2*)(xn + (size_t)row * DM + col) = o;
      }
    }
#pragma unroll
    for (int j = 0; j < 4; ++j) { if (MODE == 0) v[j] = vn[j]; else xb[j] = xbn[j]; y0[j] = y0n[j]; y1[j] = y1n[j]; }
  }
#undef NS_LOAD
}

constexpr int RT_HS = 1028;
DI void norm_route(const Params& P_, int l, unsigned char* lds) {
  Params P = P_; { size_t z_ = 0; asm volatile("" : "+s"(z_)); P.ws = P_.ws + z_; }
  const int tid = otid(), bid = obid(), wave = tid >> 6, lane = tid & 63;
  const float* mod = (const float*)(P.ws + WS_MOD);
  bf16_t* h2 = (bf16_t*)(P.ws + WS_A);
  float* hs = (float*)lds;
  float* Wc = (float*)lds + 32 * RT_HS;
  const float* wg = P.in[22] + (size_t)l * DM * 4; const float* we = P.in[24] + (size_t)l * DM * 32;
  const float* bg = P.in[23] + l * 4; const float* be = P.in[25] + l * 32;
  int* cnt = (int*)(P.ws + WS_CNT) + l * 32; int* list = (int*)(P.ws + WS_LIST); float* wts = (float*)(P.ws + WS_WT);
  const int rg = wave >> 2, kq = wave & 3;
  int* ENT_E = (int*)(lds + 150016); int* ENT_S = ENT_E + 128; int nent = 0;
  for (int grp = bid; grp < NT / 32; grp += gridDim.x) {
    const int row0 = grp * 32 + wave * 4, b = row0 >> 13;
    const float* ng = P.in[21] + (size_t)l * DM; const float* md = mod + (size_t)((l * 2 + b) * 6144);
    {
      f32x4 v[4][4]; u32x2 xb[4][4];
      const bf16_t* strm = l == 0 ? (const bf16_t*)P.out : (const bf16_t*)(P.ws + WS_C);
#pragma unroll
      for (int r = 0; r < 4; ++r)
#pragma unroll
        for (int j = 0; j < 4; ++j) xb[r][j] = *(const u32x2*)(strm + (size_t)(row0 + r) * DM + 4 * lane + 256 * j);
#pragma unroll
      for (int r = 0; r < 4; ++r)
#pragma unroll
        for (int j = 0; j < 4; ++j) v[r][j] = (f32x4){bflo(xb[r][j].x), bfhi(xb[r][j].x), bflo(xb[r][j].y), bfhi(xb[r][j].y)};
      float inv[4];
#pragma unroll
      for (int r = 0; r < 4; ++r) { float ss = 0.f;
#pragma unroll
        for (int j = 0; j < 4; ++j) ss += v[r][j].x * v[r][j].x + v[r][j].y * v[r][j].y + v[r][j].z * v[r][j].z + v[r][j].w * v[r][j].w;
        inv[r] = rsqrtf(wave_sum(ss) * (1.f / DM) + EPS); }
#pragma unroll
      for (int j = 0; j < 4; ++j) {
        const int col = 4 * lane + 256 * j;
        const f32x4 g = *(const f32x4*)(ng + col), sh = *(const f32x4*)(md + 3072 + col), sc = *(const f32x4*)(md + 4096 + col);
#pragma unroll
        for (int r = 0; r < 4; ++r) {
          const f32x4 hh = v[r][j] * inv[r] * g * (sc + 1.f) + sh;
          u32x2 o; o.x = pk2(hh.x, hh.y); o.y = pk2(hh.z, hh.w);
          *(u32x2*)(h2 + (size_t)(row0 + r) * DM + col) = o;
          *(f32x4*)(hs + (wave * 4 + r) * RT_HS + col) = hh;
        }
      }
    }
    f32x4 we0, we1, wg0 = {0.f, 0.f, 0.f, 0.f};
#define WLOAD(kc) do { we0 = *(const f32x4*)(we + (size_t)(kc) * 4096 + tid * 4); we1 = *(const f32x4*)(we + (size_t)(kc) * 4096 + 2048 + tid * 4); if (tid < 128) wg0 = *(const f32x4*)(wg + (size_t)(kc) * 512 + tid * 4); } while (0)
#define WSTORE() do { *(f32x4*)(Wc + (tid >> 3) * 36 + (tid & 7) * 4) = we0; *(f32x4*)(Wc + (64 + (tid >> 3)) * 36 + (tid & 7) * 4) = we1; if (tid < 128) *(f32x4*)(Wc + tid * 36 + 32) = wg0; } while (0)
    WLOAD(0);
    f32x4 acc0 = {0.f, 0.f, 0.f, 0.f}, acc1 = acc0, acc2 = acc0;
    for (int kc = 0; kc < 8; ++kc) {
      __syncthreads();
      WSTORE();
      if (kc + 1 < 8) WLOAD(kc + 1);
      __syncthreads();
      const float* ap = hs + (rg * 16 + (lane & 15)) * RT_HS + kc * 128 + kq * 32 + (lane >> 4);
      const float* bp = Wc + (kq * 32 + (lane >> 4)) * 36 + (lane & 15);
#pragma unroll
      for (int ks = 0; ks < 8; ++ks) {
        const float av = ap[4 * ks];
        const float b0 = bp[(4 * ks) * 36], b1 = bp[(4 * ks) * 36 + 16], b2 = (lane & 15) < 4 ? bp[(4 * ks) * 36 + 32] : 0.f;
        acc0 = __builtin_amdgcn_mfma_f32_16x16x4f32(av, b0, acc0, 0, 0, 0);
        acc1 = __builtin_amdgcn_mfma_f32_16x16x4f32(av, b1, acc1, 0, 0, 0);
        acc2 = __builtin_amdgcn_mfma_f32_16x16x4f32(av, b2, acc2, 0, 0, 0);
      }
    }
#undef WLOAD
#undef WSTORE
    __syncthreads();
    {
      float* part = hs + kq * (32 * 40);
#pragma unroll
      for (int i = 0; i < 4; ++i) { const int row = rg * 16 + 4 * (lane >> 4) + i, col = lane & 15;
        part[row * 40 + col] = acc0[i]; part[row * 40 + 16 + col] = acc1[i]; if (col < 4) part[row * 40 + 32 + col] = acc2[i]; }
    }
    __syncthreads();
    if (tid < 32) {
      const int row = grp * 32 + tid;
      float L[36];
#pragma unroll
      for (int o = 0; o < 36; ++o) L[o] = (hs[tid * 40 + o] + hs[1280 + tid * 40 + o]) + (hs[2560 + tid * 40 + o] + hs[3840 + tid * 40 + o]);
      float gm = -1e30f; int gi = 0;
#pragma unroll
      for (int i = 0; i < 4; ++i) { const float v = L[32 + i] + bg[i]; if (v > gm) { gm = v; gi = i; } }
      float gs = 0.f;
#pragma unroll
      for (int i = 0; i < 4; ++i) gs += expf(L[32 + i] + bg[i] - gm);
      const float gp = 1.f / gs;
      float el[8];
#pragma unroll
      for (int i = 0; i < 8; ++i) el[i] = (gi == 0 ? L[i] : gi == 1 ? L[8 + i] : gi == 2 ? L[16 + i] : L[24 + i]) + be[gi * 8 + i];
      float em = -1e30f;
#pragma unroll
      for (int i = 0; i < 8; ++i) em = fmaxf(em, el[i]);
      float p1 = -1.f, p2 = -1.f; int i1 = 0, i2 = 0;
#pragma unroll
      for (int i = 0; i < 8; ++i) {
        const float pe = expf(el[i] - em);
        if (pe > p1) { p2 = p1; i2 = i1; p1 = pe; i1 = i; } else if (pe > p2) { p2 = pe; i2 = i; }
      }
      const float w1 = gp * p1 / (p1 + p2), w2 = gp * p2 / (p1 + p2);
      const int e1 = gi * 8 + i1, e2 = gi * 8 + i2;
      wts[row * 2] = w1; wts[row * 2 + 1] = w2;
      ENT_E[nent + tid] = e1; ENT_S[nent + tid] = row * 2; ENT_E[nent + 32 + tid] = e2; ENT_S[nent + 32 + tid] = row * 2 + 1;
    }
    __syncthreads();
    nent += 64;
    if (nent == 128 || grp + (int)gridDim.x >= NT / 32) {
      if (wave == 0) {
        const int ea = lane < nent ? ENT_E[lane] : -1, eb = lane + 64 < nent ? ENT_E[lane + 64] : -1;
        const int sa = ENT_S[lane], sb = ENT_S[lane + 64];
        const unsigned long long lt = (1ull << lane) - 1ull;
        int ra = 0, rbk = 0, cE = 0;
        for (int e = 0; e < NEXP; ++e) {
          const unsigned long long ma = __ballot(ea == e), mb = __ballot(eb == e); const int ca = __popcll(ma);
          if (ea == e) ra = __popcll(ma & lt);
          if (eb == e) rbk = ca + __popcll(mb & lt);
          if (lane == e) cE = ca + __popcll(mb);
        }
        int baseE = 0; if (lane < NEXP && cE > 0) baseE = atomicAdd(&cnt[lane], cE);
        const int ba = __shfl(baseE, ea & 31), bb = __shfl(baseE, eb & 31);
        if (ea >= 0) list[ea * LISTCAP + ba + ra] = sa;
        if (eb >= 0) list[eb * LISTCAP + bb + rbk] = sb;
      }
      nent = 0;
      __syncthreads();
    }
  }
}

namespace pg8 {
#define PG8_LAS __attribute__((address_space(3)))
typedef unsigned short bf16_t;
typedef short bf16x8 __attribute__((ext_vector_type(8)));
typedef float f32x4 __attribute__((ext_vector_type(4)));
typedef unsigned u32x4 __attribute__((ext_vector_type(4)));
constexpr int BM = 256, BK = 64, HALF = 128, HTB = HALF * BK * 2  , STAGE_BYTES = 8 * HTB, NXCD = 8, WGM = 8;

__host__ __device__ __forceinline__ int lds_byte(int r, int c) { const int st = (r >> 4) * 2 + (c >> 5), rr = r & 15, cc = c & 31, ob = rr * 64 + cc * 2; return st * 1024 + (ob ^ (((ob >> 9) & 1) << 5)); }
__host__ __device__ __forceinline__ void stage_rc(int b, int& R, int& C) { const int st = b / 1024, sb = b % 1024, swz = sb ^ (((sb >> 9) & 1) << 5); R = (st >> 1) * 16 + swz / 64; C = (st & 1) * 32 + (swz % 64) / 2; }
__host__ __device__ __forceinline__ int perm32(int rho) { const int n = rho >> 4, i = rho & 15; return 8 * (i >> 2) + 4 * n + (i & 3); }

struct Unit { int pm, pn; };
struct Gemm { const bf16_t* A; const bf16_t* Bt; int M, N, K; };

struct StaticOrder {
    int nM, nN, nwg, G, c;
    __host__ __device__ void init(int M, int N, int G_, int c_) { nM = M / BM; nN = N / BM; nwg = nM * nN; G = G_; c = c_; }
    __host__ __device__ bool next(int i, Unit& u) const {
        const long L = (long)i * G + c; if (L >= nwg) return false;
        int wgid = (int)L; { const int q = nwg / NXCD, r = nwg % NXCD, xcd = wgid % NXCD, off = wgid / NXCD; wgid = (xcd < r ? xcd * (q + 1) : r * (q + 1) + (xcd - r) * q) + off; }
        const int nig = WGM * nN, gid = wgid / nig, fm = gid * WGM, gsz = (nM - fm) < WGM ? (nM - fm) : WGM;
        u.pm = fm + ((wgid % nig) % gsz); u.pn = (wgid % nig) / gsz; return true;
    }
    __device__ __forceinline__ void a_ready(const Unit&) const {}
    __device__ __forceinline__ void done(const Unit&) const {}
};
template <class Epi, class Sched, bool ALIGN_EPI = false, bool SP2 = false>
__device__ __forceinline__ void gemm_phase(PG8_LAS unsigned char* lds, const Gemm g, const Sched& S, const Epi& E) {
    const int tid = otid(), wid = __builtin_amdgcn_readfirstlane(tid >> 6), lane = tid & 63, wr = wid >> 2, wc = wid & 3, fr = lane & 15, fq = lane >> 4;
    const int K = g.K, nt = K / BK;
    unsigned voffA[2], voffB[2];
#pragma unroll
    for (int i = 0; i < 2; ++i) { int R, C; stage_rc(tid * 16 + i * 8192, R, C); const int Rb = Epi::PERM ? ((R & ~31) + perm32(R & 31)) : R;
        voffA[i] = (unsigned)(R * K + C) * 2u; voffB[i] = (unsigned)(Rb * K + C) * 2u; }
    const size_t kstep = (size_t)(BK * 2);
    const size_t hstep = (size_t)HALF * K * 2;
    const size_t tstep = 2 * hstep;
    const unsigned ldsw = (unsigned)wid * 1024u;
    const int aoff = lds_byte(wr * 64 + fr, fq * 8), boff = lds_byte(wc * 32 + fr, fq * 8);
#define PG8_SA(b, h) (((b) * 2 + (h)) * HTB)
#define PG8_SB(b, h) ((4 + (b) * 2 + (h)) * HTB)
#define PG8_STAGE(bufoff, gbase, voff) do { _Pragma("unroll") for (int _i = 0; _i < 2; ++_i) \
        __builtin_amdgcn_global_load_lds((const unsigned*)((const char*)(gbase) + (voff)[_i]), (PG8_LAS unsigned*)(lds + (bufoff) + ldsw + _i * 8192), 16, 0, 0); } while (0)
#define PG8_LDA(dst, b, h) do { _Pragma("unroll") for (int m = 0; m < 4; ++m) _Pragma("unroll") for (int k = 0; k < 2; ++k) dst[m][k] = *(const PG8_LAS bf16x8*)(lds + PG8_SA(b, h) + aoff + m * 2048 + k * 1024); } while (0)
#define PG8_LDB(dst, b, h) do { _Pragma("unroll") for (int n = 0; n < 2; ++n) _Pragma("unroll") for (int k = 0; k < 2; ++k) dst[n][k] = *(const PG8_LAS bf16x8*)(lds + PG8_SB(b, h) + boff + n * 2048 + k * 1024); } while (0)
#define PG8_MMA(ai, bj, At, Bt) do { __builtin_amdgcn_s_setprio(1); _Pragma("unroll") for (int m = 0; m < 4; ++m) _Pragma("unroll") for (int n = 0; n < 2; ++n) _Pragma("unroll") for (int k = 0; k < 2; ++k) \
        acc[ai][bj][m][n] = __builtin_amdgcn_mfma_f32_16x16x32_bf16(Bt[n][k], At[m][k], acc[ai][bj][m][n], 0, 0, 0); __builtin_amdgcn_s_setprio(0); } while (0)
#define PG8_WAIT_V(n) asm volatile("s_waitcnt vmcnt(" #n ")" ::: "memory")
#define PG8_WAIT_L(n) asm volatile("s_waitcnt lgkmcnt(" #n ")" ::: "memory")
#define PG8_BAR __builtin_amdgcn_s_barrier()
#define PG8_SCHED __builtin_amdgcn_sched_barrier(0)
    Unit cur, nxt; int ui = 0;
    if (!S.next(0, cur)) return;
    f32x4 acc[2][2][4][2];
#pragma unroll
    for (int a = 0; a < 2; ++a)
#pragma unroll
        for (int b = 0; b < 2; ++b)
#pragma unroll
            for (int m = 0; m < 4; ++m)
#pragma unroll
                for (int n = 0; n < 2; ++n) acc[a][b][m][n] = (f32x4){0.f, 0.f, 0.f, 0.f};
    bf16x8 At[4][2], B0[2][2], B1[2][2];
    const char* cA = (const char*)g.A + (size_t)cur.pm * tstep; const char* cB = (const char*)g.Bt + (size_t)cur.pn * tstep;
    S.a_ready(cur);
    if constexpr (SP2) {
        PG8_STAGE(PG8_SB(0, 0), cB, voffB); PG8_STAGE(PG8_SB(0, 1), cB + hstep, voffB); PG8_STAGE(PG8_SA(0, 0), cA, voffA); PG8_STAGE(PG8_SA(0, 1), cA + hstep, voffA);
        if (wr == 1) PG8_BAR;
        PG8_WAIT_V(2); PG8_BAR;
        PG8_STAGE(PG8_SB(1, 0), cB + kstep, voffB); PG8_STAGE(PG8_SA(1, 0), cA + kstep, voffA); PG8_STAGE(PG8_SB(1, 1), cB + hstep + kstep, voffB);
        PG8_WAIT_V(6); PG8_BAR;
    } else {
        PG8_STAGE(PG8_SB(0, 0), cB, voffB); PG8_STAGE(PG8_SA(0, 0), cA, voffA); PG8_STAGE(PG8_SB(0, 1), cB + hstep, voffB); PG8_STAGE(PG8_SA(0, 1), cA + hstep, voffA);
        if (wr == 1) PG8_BAR;
        PG8_WAIT_V(4); PG8_BAR;
        PG8_STAGE(PG8_SB(1, 0), cB + kstep, voffB); PG8_STAGE(PG8_SA(1, 0), cA + kstep, voffA); PG8_STAGE(PG8_SB(1, 1), cB + hstep + kstep, voffB);
        PG8_WAIT_V(6); PG8_BAR;
    }
    for (;;) {
        const bool has_next = S.next(ui + 1, nxt);
        const char* nA = has_next ? (const char*)g.A + (size_t)nxt.pm * tstep : cA; const char* nB = has_next ? (const char*)g.Bt + (size_t)nxt.pn * tstep : cB;
        for (int t = 0; t < nt; t += 2) {
            const bool last = (t == nt - 2);
            const char* a1 = cA + (size_t)(t + 1) * kstep;
            const char* a2 = last ? nA : cA + (size_t)(t + 2) * kstep; const char* b2 = last ? nB : cB + (size_t)(t + 2) * kstep;
            const char* a3 = a2 + kstep; const char* b3 = b2 + kstep;
            if (last && has_next) S.a_ready(nxt);
            if constexpr (SP2) {
            PG8_LDB(B0, 0, 0); PG8_LDB(B1, 0, 1); PG8_SCHED; PG8_LDA(At, 0, 0); PG8_STAGE(PG8_SA(1, 1), a1 + hstep, voffA);
            PG8_WAIT_V(8); PG8_WAIT_L(0); PG8_BAR; PG8_MMA(0, 0, At, B0); PG8_MMA(0, 1, At, B1); PG8_BAR; PG8_SCHED;
            PG8_LDA(At, 0, 1); PG8_STAGE(PG8_SB(0, 0), b2, voffB); PG8_STAGE(PG8_SB(0, 1), b2 + hstep, voffB); PG8_STAGE(PG8_SA(0, 0), a2, voffA);
            PG8_WAIT_V(8); PG8_WAIT_L(0); PG8_BAR; PG8_MMA(1, 0, At, B0); PG8_MMA(1, 1, At, B1); PG8_BAR; PG8_SCHED;
            PG8_LDB(B0, 1, 0); PG8_LDB(B1, 1, 1); PG8_SCHED; PG8_LDA(At, 1, 0); PG8_STAGE(PG8_SA(0, 1), a2 + hstep, voffA);
            PG8_WAIT_V(8); PG8_WAIT_L(0); PG8_BAR; PG8_MMA(0, 0, At, B0); PG8_MMA(0, 1, At, B1); PG8_BAR; PG8_SCHED;
            PG8_LDA(At, 1, 1); PG8_STAGE(PG8_SB(1, 0), b3, voffB); PG8_STAGE(PG8_SB(1, 1), b3 + hstep, voffB); PG8_STAGE(PG8_SA(1, 0), a3, voffA);
            PG8_WAIT_V(8); PG8_WAIT_L(0); PG8_BAR; PG8_MMA(1, 0, At, B0); PG8_MMA(1, 1, At, B1); PG8_BAR; PG8_SCHED;
            } else {
            PG8_LDB(B0, 0, 0); PG8_SCHED; PG8_LDA(At, 0, 0); PG8_STAGE(PG8_SA(1, 1), a1 + hstep, voffA);
            PG8_WAIT_L(8); PG8_BAR; PG8_WAIT_L(0); PG8_MMA(0, 0, At, B0); PG8_BAR; PG8_SCHED;
            PG8_LDB(B1, 0, 1); PG8_STAGE(PG8_SB(0, 0), b2, voffB);
            PG8_BAR; PG8_WAIT_L(0); PG8_MMA(0, 1, At, B1); PG8_BAR;
            PG8_LDA(At, 0, 1); PG8_STAGE(PG8_SA(0, 0), a2, voffA);
            PG8_BAR; PG8_WAIT_L(0); PG8_MMA(1, 0, At, B0); PG8_BAR; PG8_SCHED;
            PG8_STAGE(PG8_SB(0, 1), b2 + hstep, voffB);
            PG8_WAIT_V(6); PG8_BAR; PG8_MMA(1, 1, At, B1); PG8_BAR;
            PG8_LDB(B0, 1, 0); PG8_SCHED; PG8_LDA(At, 1, 0); PG8_STAGE(PG8_SA(0, 1), a2 + hstep, voffA);
            PG8_WAIT_L(8); PG8_BAR; PG8_WAIT_L(0); PG8_MMA(0, 0, At, B0); PG8_BAR; PG8_SCHED;
            PG8_LDB(B1, 1, 1); PG8_STAGE(PG8_SB(1, 0), b3, voffB);
            PG8_BAR; PG8_WAIT_L(0); PG8_MMA(0, 1, At, B1); PG8_BAR;
            PG8_LDA(At, 1, 1); PG8_STAGE(PG8_SA(1, 0), a3, voffA);
            PG8_BAR; PG8_WAIT_L(0); PG8_MMA(1, 0, At, B0); PG8_BAR; PG8_SCHED;
            PG8_STAGE(PG8_SB(1, 1), b3 + hstep, voffB);
            PG8_WAIT_V(6); PG8_BAR; PG8_MMA(1, 1, At, B1); PG8_BAR;
            }
        }
        if constexpr (ALIGN_EPI) { if (wr == 0) PG8_BAR; }
        if constexpr (!Epi::AFTER_DRAIN) { E(acc, cur, wr, wc, fr, fq); S.done(cur); }
        if (!has_next) break;
#pragma unroll
        for (int a = 0; a < 2; ++a)
#pragma unroll
            for (int b = 0; b < 2; ++b)
#pragma unroll
                for (int m = 0; m < 4; ++m)
#pragma unroll
                    for (int n = 0; n < 2; ++n) acc[a][b][m][n] = (f32x4){0.f, 0.f, 0.f, 0.f};
        cur = nxt; cA = nA; cB = nB; ++ui;
        if constexpr (ALIGN_EPI) { if (wr == 1) PG8_BAR; }
    }
    PG8_WAIT_V(0);
    if constexpr (!ALIGN_EPI) { if (wr == 0) PG8_BAR; }
    PG8_BAR;
    if constexpr (Epi::AFTER_DRAIN) { E.fused(acc, cur, wr, wc, fr, fq, lds, wid, lane); S.done(cur); }
}
template <class Mid, class End, class Sched>
__device__ __forceinline__ void gemm_phase_2seg(PG8_LAS unsigned char* lds, const Gemm g0, const Gemm g1, const Sched& S, const Mid& Mh, const End& E) {
    const int tid = otid(), wid = __builtin_amdgcn_readfirstlane(tid >> 6), lane = tid & 63, wr = wid >> 2, wc = wid & 3, fr = lane & 15, fq = lane >> 4;
    const int nt0 = g0.K / BK, nt1 = g1.K / BK;
    unsigned vA0[2], vA1[2];
#pragma unroll
    for (int i = 0; i < 2; ++i) { int R, C; stage_rc(tid * 16 + i * 8192, R, C); vA0[i] = (unsigned)(R * g0.K + C) * 2u; vA1[i] = (unsigned)(R * g1.K + C) * 2u; }
    const size_t kstep = (size_t)(BK * 2);
    const size_t hs0 = (size_t)HALF * g0.K * 2, hs1 = (size_t)HALF * g1.K * 2;
    const unsigned ldsw = (unsigned)wid * 1024u;
    const int aoff = lds_byte(wr * 64 + fr, fq * 8), boff = lds_byte(wc * 32 + fr, fq * 8);
    Unit cur, nxt; int ui = 0;
    if (!S.next(0, cur)) return;
    f32x4 acc[2][2][4][2];
#define PG8_ZERO() do { _Pragma("unroll") for (int a = 0; a < 2; ++a) _Pragma("unroll") for (int b = 0; b < 2; ++b) _Pragma("unroll") for (int m = 0; m < 4; ++m) _Pragma("unroll") for (int n = 0; n < 2; ++n) acc[a][b][m][n] = (f32x4){0.f, 0.f, 0.f, 0.f}; } while (0)
    PG8_ZERO();
    bf16x8 At[4][2], B0[2][2], B1[2][2];
#define PG8_KLOOP(cA_, cB_, NT_, VOA, HS, nA_, nB_, NVOA, NHS) \
    for (int t = 0; t < (NT_); t += 2) { \
        const bool last = (t == (NT_) - 2); \
        const char* a1 = (cA_) + (size_t)(t + 1) * kstep; \
        const char* a2 = last ? (nA_) : (cA_) + (size_t)(t + 2) * kstep; const char* b2 = last ? (nB_) : (cB_) + (size_t)(t + 2) * kstep; \
        const char* a3 = a2 + kstep; const char* b3 = b2 + kstep; \
        unsigned va2[2] = {last ? NVOA[0] : VOA[0], last ? NVOA[1] : VOA[1]}; const size_t hs2 = last ? (NHS) : (HS); \
        PG8_LDB(B0, 0, 0); PG8_LDB(B1, 0, 1); PG8_SCHED; PG8_LDA(At, 0, 0); PG8_STAGE(PG8_SA(1, 1), a1 + (HS), VOA); \
        PG8_WAIT_V(8); PG8_WAIT_L(0); PG8_BAR; PG8_MMA(0, 0, At, B0); PG8_MMA(0, 1, At, B1); PG8_BAR; PG8_SCHED; \
        PG8_LDA(At, 0, 1); PG8_STAGE(PG8_SB(0, 0), b2, va2); PG8_STAGE(PG8_SB(0, 1), b2 + hs2, va2); PG8_STAGE(PG8_SA(0, 0), a2, va2); \
        PG8_WAIT_V(8); PG8_WAIT_L(0); PG8_BAR; PG8_MMA(1, 0, At, B0); PG8_MMA(1, 1, At, B1); PG8_BAR; PG8_SCHED; \
        PG8_LDB(B0, 1, 0); PG8_LDB(B1, 1, 1); PG8_SCHED; PG8_LDA(At, 1, 0); PG8_STAGE(PG8_SA(0, 1), a2 + hs2, va2); \
        PG8_WAIT_V(8); PG8_WAIT_L(0); PG8_BAR; PG8_MMA(0, 0, At, B0); PG8_MMA(0, 1, At, B1); PG8_BAR; PG8_SCHED; \
        PG8_LDA(At, 1, 1); PG8_STAGE(PG8_SB(1, 0), b3, va2); PG8_STAGE(PG8_SB(1, 1), b3 + hs2, va2); PG8_STAGE(PG8_SA(1, 0), a3, va2); \
        PG8_WAIT_V(8); PG8_WAIT_L(0); PG8_BAR; PG8_MMA(1, 0, At, B0); PG8_MMA(1, 1, At, B1); PG8_BAR; PG8_SCHED; \
    }
    const char* cA0 = (const char*)g0.A + (size_t)cur.pm * 2 * hs0; const char* cB0 = (const char*)g0.Bt + (size_t)cur.pn * 2 * hs0;
    PG8_STAGE(PG8_SB(0, 0), cB0, vA0); PG8_STAGE(PG8_SB(0, 1), cB0 + hs0, vA0); PG8_STAGE(PG8_SA(0, 0), cA0, vA0); PG8_STAGE(PG8_SA(0, 1), cA0 + hs0, vA0);
    if (wr == 1) PG8_BAR;
    PG8_WAIT_V(2); PG8_BAR;
    PG8_STAGE(PG8_SB(1, 0), cB0 + kstep, vA0); PG8_STAGE(PG8_SA(1, 0), cA0 + kstep, vA0); PG8_STAGE(PG8_SB(1, 1), cB0 + hs0 + kstep, vA0);
    PG8_WAIT_V(6); PG8_BAR;
    for (;;) {
        const bool has_next = S.next(ui + 1, nxt);
        const char* cA1 = (const char*)g1.A + (size_t)cur.pm * 2 * hs1; const char* cB1 = (const char*)g1.Bt + (size_t)cur.pn * 2 * hs1;
        PG8_KLOOP(cA0, cB0, nt0, vA0, hs0, cA1, cB1, vA1, hs1)
        if (wr == 0) PG8_BAR;
        Mh(acc, cur, wr, wc, fr, fq);
        if (wr == 1) PG8_BAR;
        const char* nA0 = has_next ? (const char*)g0.A + (size_t)nxt.pm * 2 * hs0 : cA1; const char* nB0 = has_next ? (const char*)g0.Bt + (size_t)nxt.pn * 2 * hs0 : cB1;
        unsigned vN[2] = {has_next ? vA0[0] : vA1[0], has_next ? vA0[1] : vA1[1]}; const size_t hsN = has_next ? hs0 : hs1;
        PG8_KLOOP(cA1, cB1, nt1, vA1, hs1, nA0, nB0, vN, hsN)
        if (wr == 0) PG8_BAR;
        E(acc, cur, wr, wc, fr, fq);
        if (!has_next) break;
        PG8_ZERO();
        cur = nxt; cA0 = nA0; cB0 = nB0; ++ui;
        if (wr == 1) PG8_BAR;
    }
    PG8_WAIT_V(0);
    PG8_BAR;
#undef PG8_KLOOP
#undef PG8_ZERO
#undef PG8_SA
#undef PG8_SB
#undef PG8_STAGE
#undef PG8_LDA
#undef PG8_LDB
#undef PG8_MMA
#undef PG8_WAIT_V
#undef PG8_WAIT_L
#undef PG8_BAR
#undef PG8_SCHED
}
}

constexpr int GT_ROWB = 128, GT_A = 0, GT_B = 128 * GT_ROWB, GT_STAGE = 2 * 128 * GT_ROWB;
#define GT_WOFF(lr_, tid_) ((lr_) * GT_ROWB + ((((tid_) & 7) ^ ((lr_) & 7)) * 16))
#define GT_RSW(ks_, fq_, fr_) ((((ks_) * 4 + (fq_)) ^ ((fr_) & 7)) * 16)
DI void gemm_kloop(unsigned char* lds, const bf16_t* a0, const bf16_t* a1, int a_kadv, const bf16_t* b0, const bf16_t* b1, int nk, f32x4 (&acc)[4][2]) {
  const int tid = otid(), lane = tid & 63, wid = __builtin_amdgcn_readfirstlane(tid >> 6), wr = wid >> 2, wc = wid & 3, fr = lane & 15, fq = lane >> 4;
  const int lr = tid >> 3;
  const int sw = ((((tid & 7) ^ (lr & 7)) - (tid & 7)) * 8);
  const bf16_t* pa0 = a0 + sw; const bf16_t* pa1 = a1 + sw; const bf16_t* pb0 = b0 + sw; const bf16_t* pb1 = b1 + sw;
  PG8_LAS unsigned char* l3 = (PG8_LAS unsigned char*)lds;
  const unsigned wbase = (unsigned)wid * 1024u;
  constexpr int GT_STAGE3 = 2 * 128 * GT_ROWB;
#define GT_DMA(kt, st) do { PG8_LAS unsigned char* d_ = l3 + (st) * GT_STAGE3 + wbase; \
    __builtin_amdgcn_global_load_lds((const unsigned*)(pa0 + (size_t)(kt) * a_kadv), (PG8_LAS unsigned*)(d_ + GT_A), 16, 0, 0); \
    __builtin_amdgcn_global_load_lds((const unsigned*)(pa1 + (size_t)(kt) * a_kadv), (PG8_LAS unsigned*)(d_ + GT_A + 8192), 16, 0, 0); \
    __builtin_amdgcn_global_load_lds((const unsigned*)(pb0 + (kt) * 64), (PG8_LAS unsigned*)(d_ + GT_B), 16, 0, 0); \
    __builtin_amdgcn_global_load_lds((const unsigned*)(pb1 + (kt) * 64), (PG8_LAS unsigned*)(d_ + GT_B + 8192), 16, 0, 0); } while (0)
#define GT_COMPUTE(st) do { \
    const unsigned char* As = lds + (st) * GT_STAGE3 + GT_A + (wr * 64 + fr) * GT_ROWB; \
    const unsigned char* Bs = lds + (st) * GT_STAGE3 + GT_B + (wc * 32 + fr) * GT_ROWB; \
    _Pragma("unroll") for (int ks = 0; ks < 2; ++ks) { \
      bf16x8 af[4], bfr[2]; \
      _Pragma("unroll") for (int m = 0; m < 4; ++m) af[m] = *(const bf16x8*)(As + m * 16 * GT_ROWB + GT_RSW(ks, fq, fr)); \
      _Pragma("unroll") for (int n = 0; n < 2; ++n) bfr[n] = *(const bf16x8*)(Bs + n * 16 * GT_ROWB + GT_RSW(ks, fq, fr)); \
      _Pragma("unroll") for (int m = 0; m < 4; ++m) _Pragma("unroll") for (int n = 0; n < 2; ++n) acc[m][n] = __builtin_amdgcn_mfma_f32_16x16x32_bf16(bfr[n], af[m], acc[m][n], 0, 0, 0); } } while (0)
#define GT_BAR() do { asm volatile("s_waitcnt lgkmcnt(0)" ::: "memory"); __builtin_amdgcn_s_barrier(); asm volatile("" ::: "memory"); } while (0)
  GT_DMA(0, 0);
  if (nk > 1) { GT_DMA(1, 1); asm volatile("s_waitcnt vmcnt(4)" ::: "memory"); } else asm volatile("s_waitcnt vmcnt(0)" ::: "memory");
  GT_BAR();
  int st = 0;
  for (int kt = 0; kt < nk; ++kt) {
    const int st2 = st >= 1 ? st - 1 : 2;
    if (kt + 2 < nk) GT_DMA(kt + 2, st2);
    GT_COMPUTE(st);
    if (kt + 2 < nk) asm volatile("s_waitcnt vmcnt(4)" ::: "memory"); else asm volatile("s_waitcnt vmcnt(0)" ::: "memory");
    GT_BAR();
    st = st == 2 ? 0 : st + 1;
  }
#undef GT_DMA
#undef GT_COMPUTE
#undef GT_BAR
}
#define ACC_ZERO(acc) do { _Pragma("unroll") for (int m_ = 0; m_ < 4; ++m_) _Pragma("unroll") for (int n_ = 0; n_ < 2; ++n_) acc[m_][n_] = (f32x4){0.f, 0.f, 0.f, 0.f}; } while (0)
#define TILE_IDS const int tid = otid(), bid = obid(), lane = tid & 63, wid = tid >> 6, wr = wid >> 2, wc = wid & 3, fr = lane & 15, fq = lane >> 4, lr = tid >> 3, lk = (tid & 7) * 8; (void)bid; (void)lane; (void)wr; (void)wc; (void)fr; (void)fq; (void)lr; (void)lk

DI void phase_gates(const Params& P_, unsigned char* lds) {
  Params P = P_; { size_t z_ = 0; asm volatile("" : "+s"(z_)); P.ws = P_.ws + z_; }
  TILE_IDS;
  const bf16_t* xn = (const bf16_t*)(P.ws + WS_A); const bf16_t* wt = (const bf16_t*)(P.ws + WS_W + W_IN) + (size_t)5120 * DM; float* gates = (float*)(P.ws + WS_GATES);
  for (int tile = (int)gridDim.x - 1 - bid; tile < NT / 128; tile += gridDim.x) {
    const int row0 = tile * 128;
    f32x4 acc[4][2]; ACC_ZERO(acc);
    gemm_kloop(lds, xn + (size_t)(row0 + lr) * DM + lk, xn + (size_t)(row0 + lr + 64) * DM + lk, 64, wt + (size_t)lr * DM + lk, wt + (size_t)(lr + 64) * DM + lk, DM / 64, acc);
#pragma unroll
    for (int m = 0; m < 4; ++m)
#pragma unroll
      for (int n = 0; n < 2; ++n) {
        const int row = row0 + wr * 64 + m * 16 + fr, c2 = wc * 32 + n * 16 + 4 * fq; const f32x4 v = acc[m][n];
        if (c2 < 48) { f32x4 o = {sigmoidf_(v.x), sigmoidf_(v.y), sigmoidf_(v.z), sigmoidf_(v.w)}; *(f32x4*)(gates + (size_t)row * 48 + c2) = o; }
      }
  }
}
DI void phase_cmp1(const Params& P_, int l, unsigned char* lds) {
  Params P = P_; { size_t z_ = 0; asm volatile("" : "+s"(z_)); P.ws = P_.ws + z_; }
  TILE_IDS;
  const bf16_t* kvk = (const bf16_t*)(P.ws + WS_C); bf16_t* hid = (bf16_t*)(P.ws + WS_HID);
  const float* cb = (const float*)(P.ws + WS_CB) + l * 512;
  for (int tile = bid; tile < 128; tile += gridDim.x) {
    const int kv = tile >> 6, rt = (tile >> 1) & 31, ct = tile & 1, row0 = rt * 128, col0 = ct * 128;
    const bf16_t* wt = (const bf16_t*)(P.ws + WS_W + W_C1) + (size_t)kv * 256 * 2048;
    const bf16_t* ap[2];
#pragma unroll
    for (int i = 0; i < 2; ++i) { const int rr = row0 + lr + 64 * i, b = rr >> 11, n = (rr >> 2) & 511, g = rr & 3, nn = n > 510 ? 510 : n;
      ap[i] = kvk + (size_t)(b * SEQ + 16 * nn) * DM + kv * 256 + g * 64 + lk; }
    f32x4 acc[4][2]; ACC_ZERO(acc);
    gemm_kloop(lds, ap[0], ap[1], DM, wt + (size_t)(col0 + lr) * 2048 + lk, wt + (size_t)(col0 + lr + 64) * 2048 + lk, 32, acc);
#pragma unroll
    for (int m = 0; m < 4; ++m)
#pragma unroll
      for (int n = 0; n < 2; ++n) {
        const int row = row0 + wr * 64 + m * 16 + fr, col = col0 + wc * 32 + n * 16 + 4 * fq;
        const f32x4 bb = *(const f32x4*)(cb + kv * 256 + col); const f32x4 v = acc[m][n] + bb;
        u32x2 o; o.x = pk2(gelu_tanh(v.x), gelu_tanh(v.y)); o.y = pk2(gelu_tanh(v.z), gelu_tanh(v.w));
        *(u32x2*)(hid + ((size_t)kv * 4096 + row) * 256 + col) = o;
      }
  }
}
DI void phase_cmp2(const Params& P_, unsigned char* lds) {
  Params P = P_; { size_t z_ = 0; asm volatile("" : "+s"(z_)); P.ws = P_.ws + z_; }
  TILE_IDS;
  const bf16_t* hid = (const bf16_t*)(P.ws + WS_HID); bf16_t* kc = (bf16_t*)(P.ws + WS_KC); bf16_t* vc = (bf16_t*)(P.ws + WS_VC);
  for (int tile = bid; tile < 64; tile += gridDim.x) {
    const int kv = tile >> 5, rt = tile & 31, row0 = rt * 128;
    const bf16_t* wt = (const bf16_t*)(P.ws + WS_W + W_C2) + (size_t)kv * 128 * 256;
    const bf16_t* a = hid + ((size_t)kv * 4096 + row0) * 256;
    f32x4 acc[4][2]; ACC_ZERO(acc);
    gemm_kloop(lds, a + (size_t)lr * 256 + lk, a + (size_t)(lr + 64) * 256 + lk, 64, wt + (size_t)lr * 256 + lk, wt + (size_t)(lr + 64) * 256 + lk, 4, acc);
    if (wc < 2) {
#pragma unroll
      for (int m = 0; m < 4; ++m)
#pragma unroll
        for (int n = 0; n < 2; ++n) {
          const int rr = row0 + wr * 64 + m * 16 + fr, d = wc * 32 + n * 16 + 4 * fq;
          const int b = rr >> 11, nn = (rr >> 2) & 511, g = rr & 3; const f32x4 v = acc[m][n];
          if (kv == 0) { u32x2 o; o.x = pk2(v.x, v.y); o.y = pk2(v.z, v.w); *(u32x2*)(kc + ((size_t)((b * 4 + g) * 512 + nn)) * 64 + d) = o; }
          else { bf16_t* dst = vc + ((size_t)((b * 4 + g) * 64 + d)) * 512 + perm16(nn); dst[0] = (bf16_t)f2bf(v.x); dst[512] = (bf16_t)f2bf(v.y); dst[1024] = (bf16_t)f2bf(v.z); dst[1536] = (bf16_t)f2bf(v.w); }
        }
    }
  }
}
DI void phase_glu(const Params& P_, unsigned char* lds) {
  Params P = P_; { size_t z_ = 0; asm volatile("" : "+s"(z_)); P.ws = P_.ws + z_; }
  TILE_IDS;
  const bf16_t* y = (const bf16_t*)(P.ws + WS_G); const bf16_t* wt = (const bf16_t*)(P.ws + WS_W + W_GLU); bf16_t* ssm = (bf16_t*)(P.ws + WS_E);
  for (int tile = bid; tile < (NT / 128) * 4; tile += gridDim.x) {
    const int rt = tile >> 2, ct = tile & 3, row0 = rt * 128, col0 = ct * 128;
    f32x4 acc[4][2]; ACC_ZERO(acc);
    gemm_kloop(lds, y + (size_t)(row0 + lr) * 512 + lk, y + (size_t)(row0 + lr + 64) * 512 + lk, 64, wt + (size_t)(col0 + lr) * 512 + lk, wt + (size_t)(col0 + lr + 64) * 512 + lk, 8, acc);
#pragma unroll
    for (int m = 0; m < 4; ++m)
#pragma unroll
      for (int n = 0; n < 2; ++n) {
        const int row = row0 + wr * 64 + m * 16 + fr, col = col0 + wc * 32 + n * 16 + 4 * fq;
        const u32x2 yy = *(const u32x2*)(y + (size_t)row * 512 + col); const f32x4 v = acc[m][n];
        u32x2 o; o.x = pk2(bflo(yy.x) * sigmoidf_(v.x), bfhi(yy.x) * sigmoidf_(v.y)); o.y = pk2(bflo(yy.y) * sigmoidf_(v.z), bfhi(yy.y) * sigmoidf_(v.w));
        *(u32x2*)(ssm + (size_t)row * 512 + col) = o;
      }
  }
}
struct EpiInproj {
  static constexpr bool PERM = false, AFTER_DRAIN = false;
  bf16_t* qb; bf16_t* kvk; bf16_t* vT; bf16_t* mg; bf16_t* ub; float* gates;
#define EPI_ROWS(ai, m) const int row = u.pm * 256 + (ai) * 128 + wr * 64 + (m) * 16 + fr
#define EPI_LOOP2(...) _Pragma("unroll") for (int ai = 0; ai < 2; ++ai) _Pragma("unroll") for (int m = 0; m < 4; ++m) { EPI_ROWS(ai, m); _Pragma("unroll") for (int bj = 0; bj < 2; ++bj) { __VA_ARGS__ } }
  DI void operator()(const f32x4 (&acc)[2][2][4][2], const pg8::Unit& u, int wr, int wc, int fr_, int fq_) const {
    const int pn = u.pn; int fr = fr_, fq = fq_; asm volatile("" : "+v"(fr), "+v"(fq));
    if (pn < 4) {
      EPI_LOOP2(
        const f32x4 v0 = acc[ai][bj][m][0], v1 = acc[ai][bj][m][1]; u32x2 o0, o1;
        o0.x = pk2(v0.x * QSCALE, v0.y * QSCALE); o0.y = pk2(v0.z * QSCALE, v0.w * QSCALE); o1.x = pk2(v1.x * QSCALE, v1.y * QSCALE); o1.y = pk2(v1.z * QSCALE, v1.w * QSCALE);
        *(u32x4*)(qb + (size_t)row * DM + pn * 256 + bj * 128 + wc * 32 + widen16_col(fq)) = widen16(o0, o1); )
    } else if (pn == 4 || pn == 5 || pn == 8) {
      const int slot = pn == 8 ? 3 : pn - 4;
      EPI_LOOP2(
        const f32x4 v0 = acc[ai][bj][m][0], v1 = acc[ai][bj][m][1]; u32x2 o0, o1;
        o0.x = pk2(v0.x, v0.y); o0.y = pk2(v0.z, v0.w); o1.x = pk2(v1.x, v1.y); o1.y = pk2(v1.z, v1.w);
        *(u32x4*)(kvk + (size_t)row * DM + slot * 256 + bj * 128 + wc * 32 + widen16_col(fq)) = widen16(o0, o1); )
    } else if (pn == 6) {
      EPI_LOOP2(
        const unsigned t = row & (SEQ - 1);
        const unsigned ro = ((unsigned)(row >> 13) * 512u + (t >> 6)) * 4096u + ((t >> 5) & 1) * 2048u + (t & 31) * 8u;
        _Pragma("unroll") for (int n = 0; n < 2; ++n) { const int cl = bj * 128 + wc * 32 + n * 16 + 4 * fq; const f32x4 v = acc[ai][bj][m][n];
          const unsigned co = (unsigned)(cl >> 6) * 524288u + (unsigned)((cl >> 3) & 7) * 256u + (unsigned)(cl & 7);
          u32x2 o; o.x = pk2(v.x, v.y); o.y = pk2(v.z, v.w); *(u32x2*)(kvk + (WS_KSF - WS_C) / 2 + (ro + co)) = o; } )
    } else if (pn == 7) {
      EPI_LOOP2(
        const unsigned t = row & (SEQ - 1), pos = perm16(t) & 63;
        const unsigned ro = ((unsigned)(row >> 13) * 512u + (t >> 6)) * 4096u + (pos >> 3) * 256u + (pos & 7);
        _Pragma("unroll") for (int n = 0; n < 2; ++n) { const int cl = bj * 128 + wc * 32 + n * 16 + 4 * fq; const f32x4 v = acc[ai][bj][m][n];
          const unsigned co = (unsigned)(cl >> 6) * 524288u + (unsigned)((cl >> 5) & 1) * 2048u + (unsigned)(cl & 31) * 8u;
          bf16_t* dst = vT + (ro + co);
          dst[0] = (bf16_t)f2bf(v.x); dst[8] = (bf16_t)f2bf(v.y); dst[16] = (bf16_t)f2bf(v.z); dst[24] = (bf16_t)f2bf(v.w); } )
    } else if (pn == 9) {
      EPI_LOOP2(
        const int b = row >> 13, t = row & (SEQ - 1);
        _Pragma("unroll") for (int n = 0; n < 2; ++n) { const int cl = bj * 128 + wc * 32 + n * 16 + 4 * fq; const f32x4 v = acc[ai][bj][m][n];
          bf16_t* dst = vT + ((size_t)(((1 * NB + b) * 4 + (cl >> 6)) * 64 + (cl & 63))) * SEQ + perm16(t);
          dst[0] = (bf16_t)f2bf(v.x); dst[SEQ] = (bf16_t)f2bf(v.y); dst[2 * SEQ] = (bf16_t)f2bf(v.z); dst[3 * SEQ] = (bf16_t)f2bf(v.w); } )
    } else if (pn < 18) {
      EPI_LOOP2(
        const f32x4 v0 = acc[ai][bj][m][0], v1 = acc[ai][bj][m][1]; u32x2 o0, o1;
        o0.x = pk2(sigmoidf_(v0.x), sigmoidf_(v0.y)); o0.y = pk2(sigmoidf_(v0.z), sigmoidf_(v0.w)); o1.x = pk2(sigmoidf_(v1.x), sigmoidf_(v1.y)); o1.y = pk2(sigmoidf_(v1.z), sigmoidf_(v1.w));
        *(u32x4*)(mg + (size_t)row * 2048 + (pn - 10) * 256 + bj * 128 + wc * 32 + widen16_col(fq)) = widen16(o0, o1); )
    } else {
      EPI_LOOP2(
        _Pragma("unroll") for (int n = 0; n < 2; ++n) { const int ch = (pn - 18) * 256 + bj * 128 + wc * 32 + n * 16 + 4 * fq; const f32x4 v = acc[ai][bj][m][n];
          u32x2 o; o.x = pk2(v.x, v.y); o.y = pk2(v.z, v.w); *(u32x2*)(ub + ((size_t)(ch >> 4) * NT + row) * 16 + (ch & 15)) = o; } )
    }
  }
#undef EPI_LOOP2
#undef EPI_ROWS
};
DI void phase_inproj8(const Params& P_, unsigned char* lds) {
  Params P = P_; { size_t z_ = 0; asm volatile("" : "+s"(z_)); P.ws = P_.ws + z_; }
  pg8::Gemm g{(const bf16_t*)(P.ws + WS_A), (const bf16_t*)(P.ws + WS_W + W_IN), NT, 5120, DM};
  pg8::StaticOrder S; S.init(NT, 5120, gridDim.x, obid());
  EpiInproj E{(bf16_t*)(P.ws + WS_B), (bf16_t*)(P.ws + WS_C), (bf16_t*)(P.ws + WS_DV), (bf16_t*)(P.ws + WS_F), (bf16_t*)(P.ws + WS_E), (float*)(P.ws + WS_GATES)};
  pg8::gemm_phase<EpiInproj, pg8::StaticOrder, true, true>((PG8_LAS unsigned char*)lds, g, S, E);
}
struct EpiMerge1 {
  static constexpr bool PERM = false, AFTER_DRAIN = false;
  const bf16_t* mg; bf16_t* tmp;
  DI void operator()(const f32x4 (&acc)[2][2][4][2], const pg8::Unit& u, int wr, int wc, int fr, int fq) const {
#pragma unroll
    for (int ai = 0; ai < 2; ++ai) {
      u32x2 ga[4][2][2];
#pragma unroll
      for (int m = 0; m < 4; ++m)
#pragma unroll
        for (int bj = 0; bj < 2; ++bj)
#pragma unroll
          for (int n = 0; n < 2; ++n) {
            const int row = u.pm * 256 + ai * 128 + wr * 64 + m * 16 + fr, col = u.pn * 256 + bj * 128 + wc * 32 + n * 16 + 4 * fq;
            ga[m][bj][n] = *(const u32x2*)(mg + (size_t)row * 2048 + col);
          }
      __builtin_amdgcn_sched_barrier(0);
#pragma unroll
      for (int m = 0; m < 4; ++m)
#pragma unroll
        for (int bj = 0; bj < 2; ++bj)
#pragma unroll
          for (int n = 0; n < 2; ++n) {
            const int row = u.pm * 256 + ai * 128 + wr * 64 + m * 16 + fr, col = u.pn * 256 + bj * 128 + wc * 32 + n * 16 + 4 * fq;
            const f32x4 v = acc[ai][bj][m][n]; const u32x2 g = ga[m][bj][n];
            u32x2 o; o.x = pk2(v.x * bflo(g.x), v.y * bfhi(g.x)); o.y = pk2(v.z * bflo(g.y), v.w * bfhi(g.y));
            *(u32x2*)(tmp + (size_t)row * DM + col) = o;
          }
      __builtin_amdgcn_sched_barrier(0);
    }
  }
};
struct EpiMerge2 {
  static constexpr bool PERM = false, AFTER_DRAIN = false;
  const bf16_t* mg; const bf16_t* tmp; bf16_t* mer;
  DI void operator()(const f32x4 (&acc)[2][2][4][2], const pg8::Unit& u, int wr, int wc, int fr, int fq) const {
#pragma unroll
    for (int ai = 0; ai < 2; ++ai)
#pragma unroll
      for (int mh = 0; mh < 2; ++mh) {
        u32x2 gs[2][2][2], tv[2][2][2];
#pragma unroll
        for (int mm = 0; mm < 2; ++mm)
#pragma unroll
          for (int bj = 0; bj < 2; ++bj)
#pragma unroll
            for (int n = 0; n < 2; ++n) {
              const int row = u.pm * 256 + ai * 128 + wr * 64 + (mh * 2 + mm) * 16 + fr, col = u.pn * 256 + bj * 128 + wc * 32 + n * 16 + 4 * fq;
              gs[mm][bj][n] = *(const u32x2*)(mg + (size_t)row * 2048 + 1024 + col);
#if EN_ATTN
              tv[mm][bj][n] = *(const u32x2*)(tmp + (size_t)row * DM + col);
#else
              tv[mm][bj][n] = (u32x2){0u, 0u};
#endif
            }
        __builtin_amdgcn_sched_barrier(0);
#pragma unroll
        for (int mm = 0; mm < 2; ++mm)
#pragma unroll
          for (int bj = 0; bj < 2; ++bj)
#pragma unroll
            for (int n = 0; n < 2; ++n) {
              const int row = u.pm * 256 + ai * 128 + wr * 64 + (mh * 2 + mm) * 16 + fr, col = u.pn * 256 + bj * 128 + wc * 32 + n * 16 + 4 * fq;
              const f32x4 v = acc[ai][bj][mh * 2 + mm][n]; const u32x2 g = gs[mm][bj][n], t = tv[mm][bj][n];
              u32x2 o; o.x = pk2(bflo(t.x) + v.x * bflo(g.x), bfhi(t.x) + v.y * bfhi(g.x)); o.y = pk2(bflo(t.y) + v.z * bflo(g.y), bfhi(t.y) + v.w * bfhi(g.y));
              *(u32x2*)(mer + (size_t)row * DM + col) = o;
            }
        __builtin_amdgcn_sched_barrier(0);
      }
  }
};
struct EpiMergeMid {
  const bf16_t* mg;
  DI void operator()(f32x4 (&acc)[2][2][4][2], const pg8::Unit& u, int wr, int wc, int fr_, int fq_) const {
    int fr = fr_, fq = fq_; asm volatile("" : "+v"(fr), "+v"(fq));
#pragma unroll
    for (int ai = 0; ai < 2; ++ai)
#pragma unroll
      for (int mh = 0; mh < 2; ++mh) {
        u32x2 ga[2][2][2], gs[2][2][2];
        asm volatile("" ::: "memory");
#pragma unroll
        for (int mm = 0; mm < 2; ++mm)
#pragma unroll
          for (int bj = 0; bj < 2; ++bj)
#pragma unroll
            for (int n = 0; n < 2; ++n) {
              const int row = u.pm * 256 + ai * 128 + wr * 64 + (mh * 2 + mm) * 16 + fr;
              const bf16_t* gp = mg + (size_t)row * 2048 + u.pn * 256 + bj * 128 + wc * 32 + n * 16 + 4 * fq;
              ga[mm][bj][n] = *(const u32x2*)gp; gs[mm][bj][n] = *(const u32x2*)(gp + 1024);
            }
        __builtin_amdgcn_sched_barrier(0);
#pragma unroll
        for (int mm = 0; mm < 2; ++mm)
#pragma unroll
          for (int bj = 0; bj < 2; ++bj)
#pragma unroll
            for (int n = 0; n < 2; ++n) {
              const u32x2 a = ga[mm][bj][n], g = gs[mm][bj][n]; const float fl = 8.673617379884035e-19f;
              f32x4 v = acc[ai][bj][mh * 2 + mm][n];
              v.x *= bflo(a.x) * __builtin_amdgcn_rcpf(fmaxf(bflo(g.x), fl)); v.y *= bfhi(a.x) * __builtin_amdgcn_rcpf(fmaxf(bfhi(g.x), fl));
              v.z *= bflo(a.y) * __builtin_amdgcn_rcpf(fmaxf(bflo(g.y), fl)); v.w *= bfhi(a.y) * __builtin_amdgcn_rcpf(fmaxf(bfhi(g.y), fl));
              asm volatile("" : "+v"(v));
              acc[ai][bj][mh * 2 + mm][n] = v;
            }
        __builtin_amdgcn_sched_barrier(0);
      }
    asm volatile("" ::: "memory");
  }
};
struct EpiMergeEnd {
  const bf16_t* mg; bf16_t* mer;
  DI void operator()(const f32x4 (&acc)[2][2][4][2], const pg8::Unit& u, int wr, int wc, int fr_, int fq_) const {
    int fr = fr_, fq = fq_; asm volatile("" : "+v"(fr), "+v"(fq));
#pragma unroll
    for (int ai = 0; ai < 2; ++ai) {
      u32x2 gs[4][2][2];
#pragma unroll
      for (int m = 0; m < 4; ++m)
#pragma unroll
        for (int bj = 0; bj < 2; ++bj)
#pragma unroll
          for (int n = 0; n < 2; ++n) {
            const int row = u.pm * 256 + ai * 128 + wr * 64 + m * 16 + fr, col = u.pn * 256 + bj * 128 + wc * 32 + n * 16 + 4 * fq;
            gs[m][bj][n] = *(const u32x2*)(mg + (size_t)row * 2048 + 1024 + col);
          }
      __builtin_amdgcn_sched_barrier(0);
#pragma unroll
      for (int m = 0; m < 4; ++m)
#pragma unroll
        for (int bj = 0; bj < 2; ++bj)
#pragma unroll
          for (int n = 0; n < 2; ++n) {
            const int row = u.pm * 256 + ai * 128 + wr * 64 + m * 16 + fr, col = u.pn * 256 + bj * 128 + wc * 32 + n * 16 + 4 * fq;
            const f32x4 v = acc[ai][bj][m][n]; const u32x2 g = gs[m][bj][n]; const float fl = 8.673617379884035e-19f;
            u32x2 o; o.x = pk2(v.x * fmaxf(bflo(g.x), fl), v.y * fmaxf(bfhi(g.x), fl)); o.y = pk2(v.z * fmaxf(bflo(g.y), fl), v.w * fmaxf(bfhi(g.y), fl));
            *(u32x2*)(mer + (size_t)row * DM + col) = o;
          }
      __builtin_amdgcn_sched_barrier(0);
    }
  }
};
DI void phase_merge8(const Params& P_, unsigned char* lds) {
  Params P = P_; { size_t z_ = 0; asm volatile("" : "+s"(z_)); P.ws = P_.ws + z_; }
  pg8::Gemm g0{(const bf16_t*)(P.ws + WS_A), (const bf16_t*)(P.ws + WS_W + W_O), NT, DM, DM};
  pg8::Gemm g1{(const bf16_t*)(P.ws + WS_E), (const bf16_t*)(P.ws + WS_W + W_SO), NT, DM, 512};
  pg8::StaticOrder S; S.init(NT, DM, gridDim.x, obid());
  EpiMergeMid Mh{(const bf16_t*)(P.ws + WS_F)};
  EpiMergeEnd E{(const bf16_t*)(P.ws + WS_F), (bf16_t*)(P.ws + WS_B)};
  pg8::gemm_phase_2seg<EpiMergeMid, EpiMergeEnd, pg8::StaticOrder>((PG8_LAS unsigned char*)lds, g0, g1, S, Mh, E);
}
struct EpiWout {
  static constexpr bool PERM = false, AFTER_DRAIN = false;
  const float* mod; const float* xin; const bf16_t* sin_; bf16_t* sout; bool first;
  DI void operator()(const f32x4 (&acc)[2][2][4][2], const pg8::Unit& u, int wr, int wc, int fr, int fq) const {
    const int b = (u.pm * 256) >> 13;
    f32x4 g1[2][2];
#pragma unroll
    for (int bj = 0; bj < 2; ++bj)
#pragma unroll
      for (int n = 0; n < 2; ++n) g1[bj][n] = *(const f32x4*)(mod + (size_t)b * 6144 + 2048 + u.pn * 256 + bj * 128 + wc * 32 + n * 16 + 4 * fq);
#define WO_STORE(X0_, X1_) do { \
      const f32x4 r0_ = (X0_) + g1[bj][0] * acc[ai][bj][mh * 2 + mm][0], r1_ = (X1_) + g1[bj][1] * acc[ai][bj][mh * 2 + mm][1]; \
      u32x2 o0_, o1_; o0_.x = pk2(r0_.x, r0_.y); o0_.y = pk2(r0_.z, r0_.w); o1_.x = pk2(r1_.x, r1_.y); o1_.y = pk2(r1_.z, r1_.w); \
      *(u32x4*)(sout + (size_t)row * DM + u.pn * 256 + bj * 128 + wc * 32 + widen16_col(fq)) = widen16(o0_, o1_); } while (0)
    if (first) {
#pragma unroll
      for (int ai = 0; ai < 2; ++ai)
#pragma unroll
        for (int mh = 0; mh < 2; ++mh) {
          f32x4 xv[2][2][2];
#pragma unroll
          for (int mm = 0; mm < 2; ++mm)
#pragma unroll
            for (int bj = 0; bj < 2; ++bj)
#pragma unroll
              for (int n = 0; n < 2; ++n) {
                const int row = u.pm * 256 + ai * 128 + wr * 64 + (mh * 2 + mm) * 16 + fr, col = u.pn * 256 + bj * 128 + wc * 32 + n * 16 + 4 * fq;
                xv[mm][bj][n] = *(const f32x4*)(xin + (size_t)row * DM + col);
              }
          __builtin_amdgcn_sched_barrier(0);
#pragma unroll
          for (int mm = 0; mm < 2; ++mm)
#pragma unroll
            for (int bj = 0; bj < 2; ++bj) {
              const int row = u.pm * 256 + ai * 128 + wr * 64 + (mh * 2 + mm) * 16 + fr;
              WO_STORE(xv[mm][bj][0], xv[mm][bj][1]);
            }
          __builtin_amdgcn_sched_barrier(0);
        }
    } else {
#pragma unroll
      for (int ai = 0; ai < 2; ++ai)
#pragma unroll
        for (int mh = 0; mh < 2; ++mh) {
          u32x2 xb[2][2][2];
#pragma unroll
          for (int mm = 0; mm < 2; ++mm)
#pragma unroll
            for (int bj = 0; bj < 2; ++bj)
#pragma unroll
              for (int n = 0; n < 2; ++n) {
                const int row = u.pm * 256 + ai * 128 + wr * 64 + (mh * 2 + mm) * 16 + fr, col = u.pn * 256 + bj * 128 + wc * 32 + n * 16 + 4 * fq;
                xb[mm][bj][n] = *(const u32x2*)(sin_ + (size_t)row * DM + col);
              }
          __builtin_amdgcn_sched_barrier(0);
#pragma unroll
          for (int mm = 0; mm < 2; ++mm)
#pragma unroll
            for (int bj = 0; bj < 2; ++bj) {
              const int row = u.pm * 256 + ai * 128 + wr * 64 + (mh * 2 + mm) * 16 + fr;
              const f32x4 x0 = {bflo(xb[mm][bj][0].x), bfhi(xb[mm][bj][0].x), bflo(xb[mm][bj][0].y), bfhi(xb[mm][bj][0].y)};
              const f32x4 x1 = {bflo(xb[mm][bj][1].x), bfhi(xb[mm][bj][1].x), bflo(xb[mm][bj][1].y), bfhi(xb[mm][bj][1].y)};
              WO_STORE(x0, x1);
            }
          __builtin_amdgcn_sched_barrier(0);
        }
    }
#undef WO_STORE
  }
};
DI void phase_wout8(const Params& P_, int l, unsigned char* lds) {
  Params P = P_; { size_t z_ = 0; asm volatile("" : "+s"(z_)); P.ws = P_.ws + z_; }
  pg8::Gemm g{(const bf16_t*)(P.ws + WS_B), (const bf16_t*)(P.ws + WS_W + W_OUT), NT, DM, DM};
  pg8::StaticOrder S; S.init(NT, DM, gridDim.x, obid());
  EpiWout E{(const float*)(P.ws + WS_MOD) + (size_t)(l * 2) * 6144, P.in[0], (const bf16_t*)P.out, l == 0 ? (bf16_t*)P.out : (bf16_t*)(P.ws + WS_C), l == 0};
  pg8::gemm_phase<EpiWout, pg8::StaticOrder, true, true>((PG8_LAS unsigned char*)lds, g, S, E);
}

struct MoeTab { int cv, pin; };
DI MoeTab moe_tab(const int* cnt) {
  const int lane = otid() & 63; MoeTab T; T.cv = cnt[lane & 31]; int p = (T.cv + 127) >> 7;
#pragma unroll
  for (int o = 1; o < 32; o <<= 1) { const int t = __shfl_up(p, o); if ((lane & 31) >= o) p += t; }
  T.pin = p; return T;
}
DI int moe_total(const MoeTab& T) { return __builtin_amdgcn_readlane(T.pin, 31); }
DI void moe_find(const MoeTab& T, int rb, int& e, int& rbl, int& ce) {
  const unsigned m = (unsigned)__ballot(T.pin <= rb);
  e = __popc(m); e = e < NEXP ? e : NEXP - 1;
  const int nb = (__shfl(T.cv, e) + 127) >> 7;
  ce = __shfl(T.cv, e); rbl = rb - (__shfl(T.pin, e) - nb);
  e = __builtin_amdgcn_readfirstlane(e); rbl = __builtin_amdgcn_readfirstlane(rbl); ce = __builtin_amdgcn_readfirstlane(ce);
}
DI void phase_moe1(const Params& P_, int l, unsigned char* lds) {
  Params P = P_; { size_t z_ = 0; asm volatile("" : "+s"(z_)); P.ws = P_.ws + z_; }
  TILE_IDS;
  const int* cnt = (const int*)(P.ws + WS_CNT) + l * 32; const int* list = (const int*)(P.ws + WS_LIST);
  const bf16_t* h2 = (const bf16_t*)(P.ws + WS_A); bf16_t* act = (bf16_t*)(P.ws + WS_B);
  const MoeTab MT = moe_tab(cnt); const int total = moe_total(MT);
  const int G_ = gridDim.x, nx_ = (G_ % 8 == 0) ? 8 : 1, xg_ = bid % nx_, xs_ = bid / nx_, xb0_ = (int)((long)total * xg_ / nx_), xb1_ = (int)((long)total * (xg_ + 1) / nx_);
  for (int tl = xs_; tl < (xb1_ - xb0_) * 4; tl += G_ / nx_) {
    const int rb = xb0_ + (tl >> 2), ct = tl & 3; int e = 0, rbl = 0, ce = 1; moe_find(MT, rb, e, rbl, ce);
    const bf16_t* wt = (const bf16_t*)(P.ws + WS_W + W_GU) + (size_t)e * 512 * 1024 + (size_t)(ct * 128) * 1024;
    const bf16_t* ap[2];
#pragma unroll
    for (int i = 0; i < 2; ++i) { int idx = rbl * 128 + lr + 64 * i; idx = idx < ce ? idx : ce - 1; const int tok = list[e * LISTCAP + idx] >> 1; ap[i] = h2 + (size_t)tok * DM + lk; }
    f32x4 acc[4][2]; ACC_ZERO(acc);
    gemm_kloop(lds, ap[0], ap[1], 64, wt + (size_t)lr * DM + lk, wt + (size_t)(lr + 64) * DM + lk, 16, acc);
#pragma unroll
    for (int m = 0; m < 4; ++m) {
      const int arow = rb * 128 + wr * 64 + m * 16 + fr, col = ct * 64 + wc * 16 + 4 * fq;
      const f32x4 g = acc[m][0], u = acc[m][1];
      u32x2 o; o.x = pk2(g.x * sigmoidf_(g.x) * u.x, g.y * sigmoidf_(g.y) * u.y); o.y = pk2(g.z * sigmoidf_(g.z) * u.z, g.w * sigmoidf_(g.w) * u.w);
      *(u32x2*)(act + (size_t)arow * 256 + col) = o;
    }
  }
}
DI void phase_moe2(const Params& P_, int l, unsigned char* lds) {
  Params P = P_; { size_t z_ = 0; asm volatile("" : "+s"(z_)); P.ws = P_.ws + z_; }
  TILE_IDS;
  const int* cnt = (const int*)(P.ws + WS_CNT) + l * 32; const int* list = (const int*)(P.ws + WS_LIST); const float* wts = (const float*)(P.ws + WS_WT);
  const bf16_t* act = (const bf16_t*)(P.ws + WS_B); bf16_t* ys = (bf16_t*)(P.ws + WS_F);
  constexpr int ASUB = 128 * GT_ROWB, BOFF = 4 * ASUB;
  const MoeTab MT = moe_tab(cnt); const int total = moe_total(MT);
  const int lkb = (tid & 7) * 16;
  const int G_ = gridDim.x, nx_ = (G_ % 8 == 0) ? 8 : 1, xg_ = bid % nx_, xs_ = bid / nx_, xb0_ = (int)((long)total * xg_ / nx_), xb1_ = (int)((long)total * (xg_ + 1) / nx_);
  const int st_ = G_ / nx_, T4_ = (xb1_ - xb0_) * 4;
  u32x4 nra[8], nb[3][2]; int neslot[4]; int n_e = 0, n_rbl = 0, n_ce = 1;
#define M2_PREFETCH(tl_) do { const int rb_ = xb0_ + ((tl_) >> 2), c0_ = ((tl_) & 3) * 2; moe_find(MT, rb_, n_e, n_rbl, n_ce); \
    const bf16_t* wt_ = (const bf16_t*)(P.ws + WS_W + W_D) + (size_t)n_e * 1024 * 256; \
    const bf16_t* a0_ = act + (size_t)(rb_ * 128 + lr) * 256 + lk; const bf16_t* a1_ = a0_ + 64 * 256; \
    _Pragma("unroll") for (int k = 0; k < 4; ++k) { nra[2 * k] = *(const u32x4*)(a0_ + 64 * k); nra[2 * k + 1] = *(const u32x4*)(a1_ + 64 * k); } \
    _Pragma("unroll") for (int m = 0; m < 4; ++m) { int idx_ = n_rbl * 128 + wr * 64 + m * 16 + fr; idx_ = idx_ < n_ce ? idx_ : n_ce - 1; neslot[m] = list[n_e * LISTCAP + idx_]; } \
    _Pragma("unroll") for (int s_ = 0; s_ < 3; ++s_) { const bf16_t* bp_ = wt_ + (size_t)(c0_ * 128 + lr) * 256 + s_ * 64 + lk; nb[s_][0] = *(const u32x4*)bp_; nb[s_][1] = *(const u32x4*)(bp_ + 64 * 256); } } while (0)
  if (xs_ < T4_) M2_PREFETCH(xs_);
  for (int tl = xs_; tl < T4_; tl += st_) {
    const int ct0 = (tl & 3) * 2; const int e = n_e, rbl = n_rbl, ce = n_ce;
    const bf16_t* wt = (const bf16_t*)(P.ws + WS_W + W_D) + (size_t)e * 1024 * 256;
    u32x4 ra[8], bq[8][2]; int eslot[4]; float ewt[4];
#pragma unroll
    for (int k = 0; k < 8; ++k) ra[k] = nra[k];
    bq[0][0] = nb[0][0]; bq[0][1] = nb[0][1]; bq[1][0] = nb[1][0]; bq[1][1] = nb[1][1]; bq[2][0] = nb[2][0]; bq[2][1] = nb[2][1];
#pragma unroll
    for (int m = 0; m < 4; ++m) eslot[m] = neslot[m];
#define M2_BLOAD(q0_, q1_, s_) do { const bf16_t* bp_ = wt + (size_t)((ct0 + ((s_) >> 2)) * 128 + lr) * 256 + ((s_) & 3) * 64 + lk; q0_ = *(const u32x4*)bp_; q1_ = *(const u32x4*)(bp_ + 64 * 256); } while (0)
#define M2_BSTORE(q0_, q1_, buf_) do { unsigned char* s_ = lds + BOFF + (buf_) * ASUB; *(u32x4*)(s_ + GT_WOFF(lr, tid)) = q0_; *(u32x4*)(s_ + 64 * GT_ROWB + GT_WOFF(lr, tid)) = q1_; } while (0)
#define M2_COMPUTE(s_, buf_) do { \
      const unsigned char* As = lds + ((s_) & 3) * ASUB + (wr * 64 + fr) * GT_ROWB; \
      const unsigned char* Bs = lds + BOFF + (buf_) * ASUB + (wc * 32 + fr) * GT_ROWB; \
      _Pragma("unroll") for (int ks = 0; ks < 2; ++ks) { \
        bf16x8 af[4], bfr[2]; \
        _Pragma("unroll") for (int m = 0; m < 4; ++m) af[m] = *(const bf16x8*)(As + m * 16 * GT_ROWB + GT_RSW(ks, fq, fr)); \
        _Pragma("unroll") for (int n = 0; n < 2; ++n) bfr[n] = *(const bf16x8*)(Bs + n * 16 * GT_ROWB + GT_RSW(ks, fq, fr)); \
        _Pragma("unroll") for (int m = 0; m < 4; ++m) _Pragma("unroll") for (int n = 0; n < 2; ++n) acc[m][n] = __builtin_amdgcn_mfma_f32_16x16x32_bf16(bfr[n], af[m], acc[m][n], 0, 0, 0); } } while (0)
#define M2_EPI(ct_) do { _Pragma("unroll") for (int m = 0; m < 4; ++m) { const int idx = rbl * 128 + wr * 64 + m * 16 + fr; \
      const int slot = eslot[m]; const float w_ = ewt[m]; const f32x4 v0 = acc[m][0] * w_, v1 = acc[m][1] * w_; \
      u32x2 o0, o1; o0.x = pk2(v0.x, v0.y); o0.y = pk2(v0.z, v0.w); o1.x = pk2(v1.x, v1.y); o1.y = pk2(v1.z, v1.w); \
      const u32x4 ow_ = widen16(o0, o1);                          \
      if (idx < ce) *(u32x4*)(ys + (size_t)slot * DM + (ct_) * 128 + wc * 32 + widen16_col(fq)) = ow_; } ACC_ZERO(acc); } while (0)
#pragma unroll
    for (int s2 = 3; s2 < 8; ++s2) M2_BLOAD(bq[s2][0], bq[s2][1], s2);
#pragma unroll
    for (int m = 0; m < 4; ++m) ewt[m] = wts[eslot[m]];
#pragma unroll
    for (int k = 0; k < 4; ++k) { *(u32x4*)(lds + k * ASUB + GT_WOFF(lr, tid)) = ra[2 * k]; *(u32x4*)(lds + k * ASUB + 64 * GT_ROWB + GT_WOFF(lr, tid)) = ra[2 * k + 1]; }
    M2_BSTORE(bq[0][0], bq[0][1], 0);
    __syncthreads();
    f32x4 acc[4][2]; ACC_ZERO(acc);
#pragma unroll
    for (int s2 = 0; s2 < 8; ++s2) {
      M2_COMPUTE(s2, s2 & 1);
      if (s2 + 1 < 8) M2_BSTORE(bq[s2 + 1][0], bq[s2 + 1][1], (s2 + 1) & 1);
      if (s2 == 3) M2_EPI(ct0);
      if (s2 == 4 && tl + st_ < T4_) M2_PREFETCH(tl + st_);
      if (s2 == 7) M2_EPI(ct0 + 1);
      __syncthreads();
    }
#undef M2_BLOAD
#undef M2_BSTORE
#undef M2_COMPUTE
#undef M2_EPI
  }
#undef M2_PREFETCH
}

typedef float f32x2v __attribute__((ext_vector_type(2)));
DI void phase_s5a(const Params& P_, int l, unsigned char* lds) {
  Params P = P_; { size_t z_ = 0; asm volatile("" : "+s"(z_)); P.ws = P_.ws + z_; }
  TILE_IDS;
  const bf16_t* ub = (const bf16_t*)(P.ws + WS_E); float* Lb = (float*)(P.ws + WS_L);
  const bf16_t* M1 = (const bf16_t*)(P.ws + WS_TAB + (size_t)l * TAB_LAYER + TAB_M1);
  const int first = (int)gridDim.x >= 192 ? 128 : 0;
  for (int tile = bid - first; tile >= 0 && tile < 64; tile += gridDim.x) {
    const int g = tile >> 1, rt = tile & 1;
    const bf16_t* a = ub + ((size_t)g * NT / 64 + rt * 128) * 1024;
    const bf16_t* wt = M1 + (size_t)g * 128 * 1024;
    f32x4 acc[4][2]; ACC_ZERO(acc);
    gemm_kloop(lds, a + (size_t)lr * 1024 + lk, a + (size_t)(lr + 64) * 1024 + lk, 64, wt + (size_t)lr * 1024 + lk, wt + (size_t)(lr + 64) * 1024 + lk, 16, acc);
#pragma unroll
    for (int m = 0; m < 4; ++m)
#pragma unroll
      for (int n = 0; n < 2; ++n) {
        const int R = rt * 128 + wr * 64 + m * 16 + fr, comp = wc * 32 + n * 16 + 4 * fq;
        *(f32x4*)(Lb + ((size_t)(R * 32 + g) * 64) * 2 + comp) = acc[m][n];
      }
  }
}
DI void s5_carry(const Params& P_, int l) {
  Params P = P_; { size_t z_ = 0; asm volatile("" : "+s"(z_)); P.ws = P_.ws + z_; }
  const int tid_ = otid(), bid = obid(), wave = tid_ >> 6, lane = tid_ & 63;
  const int item = (gridDim.x * NWAVE - 1) - (bid * NWAVE + wave);
  if (item >= NB * 32) return;
  const int b = item >> 5, g = item & 31;
  const float* pp = (const float*)(P.ws + WS_S5P) + (size_t)((l * 32 + g) * 64 + lane) * 36;
  const float aTr = pp[2], aTi = pp[3];
  float2* Lp = (float2*)(P.ws + WS_L) + ((size_t)(b * 128) * 32 + g) * 64 + lane;
  unsigned* Sp = (unsigned*)(P.ws + WS_SIN) + ((size_t)(g * 256 + b * 128)) * 64 + lane;
  float sr = 0.f, si = 0.f; asm volatile("" : "+v"(sr), "+v"(si));
  float2 va[8], vb[8];
#define CY_LOAD(vv, c0_) do { _Pragma("unroll") for (int k = 0; k < 8; ++k) vv[k] = Lp[(size_t)((c0_) + k) * 2048]; } while (0)
#define CY_STEP(vv, c0_) do { _Pragma("unroll") for (int k = 0; k < 8; ++k) { Lp[(size_t)((c0_) + k) * 2048] = make_float2(sr, si); Sp[(size_t)((c0_) + k) * 64] = pk2(sr, si); \
      const float nr = aTr * sr - aTi * si + vv[k].x, ni = aTr * si + aTi * sr + vv[k].y; sr = nr; si = ni; } } while (0)
#define CY_PIN(vv) do { _Pragma("unroll") for (int k = 0; k < 8; ++k) asm volatile("" : "+v"(vv[k].x), "+v"(vv[k].y)); } while (0)
  CY_LOAD(va, 0);
#pragma unroll
  for (int c0 = 0; c0 < 128; c0 += 16) {
    CY_LOAD(vb, c0 + 8);
    CY_PIN(va);
    CY_STEP(va, c0);
    if (c0 + 16 < 128) CY_LOAD(va, c0 + 16);
    CY_PIN(vb);
    CY_STEP(vb, c0 + 8);
  }
#undef CY_PIN
#undef CY_LOAD
#undef CY_STEP
}
DI void phase_s5c(const Params& P_, int l, unsigned char* lds) {
  Params P = P_; { size_t z_ = 0; asm volatile("" : "+s"(z_)); P.ws = P_.ws + z_; }
  TILE_IDS;
  const bf16_t* ub = (const bf16_t*)(P.ws + WS_E); const bf16_t* sinb = (const bf16_t*)(P.ws + WS_SIN); bf16_t* yb = (bf16_t*)(P.ws + WS_G);
  const bf16_t* tab = (const bf16_t*)(P.ws + WS_TAB + (size_t)l * TAB_LAYER);
  int* dctr = (int*)(P.ws + 640) + l; int* dslot = (int*)(lds + LDS_BYTES - 32);
  constexpr int ROWB = GT_ROWB, SA = 0, SB = 128 * ROWB, STAGE = 2 * 128 * ROWB;
  const int lkb = (tid & 7) * 16, kch = tid & 7;
  for (;;) {
    if (threadIdx.x == 0) *dslot = atomicAdd(dctr, 1);
    __syncthreads();
    const int tile = *dslot;
    __syncthreads();
    if (tile >= 512) break;
    const int g = tile >> 4, rt = (tile >> 3) & 1, ct = tile & 7;
    const bf16_t* Kt = tab + TAB_KT / 2 + (size_t)g * 64 * 256; const bf16_t* M2 = tab + TAB_M2 / 2 + (size_t)g * 1024 * 128;
    const bf16_t* ua = ub + ((size_t)g * 256 + rt * 128) * 1024; const bf16_t* sa = sinb + ((size_t)g * 256 + rt * 128) * 128;
    const int nbt = 2 * ct + 2 < 16 ? 2 * ct + 2 : 16, ns = nbt + 2;
    u32x4 xa0, xa1, xb0, xb1, ya0, ya1, yb0, yb1;
#define S5_LOAD(p0_, p1_, q0_, q1_, s_) do { \
      if ((s_) < nbt) { p0_ = *(const u32x4*)(ua + (size_t)lr * 1024 + (s_) * 64 + lk); p1_ = *(const u32x4*)(ua + (size_t)(lr + 64) * 1024 + (s_) * 64 + lk); \
        const int i_ = 4 * (s_) + (kch >> 1), hq_ = (kch & 1) * 8; \
        { const int t_ = 8 * ct + (lr >> 4), h_ = lr & 15; q0_ = t_ >= i_ ? *(const u32x4*)(Kt + ((t_ - i_) * 16 + h_) * 16 + hq_) : (u32x4){0u, 0u, 0u, 0u}; } \
        { const int t_ = 8 * ct + 4 + (lr >> 4), h_ = lr & 15; q1_ = t_ >= i_ ? *(const u32x4*)(Kt + ((t_ - i_) * 16 + h_) * 16 + hq_) : (u32x4){0u, 0u, 0u, 0u}; } \
      } else { const int k0_ = ((s_) - nbt) * 64 + lk; \
        p0_ = *(const u32x4*)(sa + (size_t)lr * 128 + k0_); p1_ = *(const u32x4*)(sa + (size_t)(lr + 64) * 128 + k0_); \
        q0_ = *(const u32x4*)(M2 + (size_t)(ct * 128 + lr) * 128 + k0_); q1_ = *(const u32x4*)(M2 + (size_t)(ct * 128 + lr + 64) * 128 + k0_); } } while (0)
#define S5_STORE(p0_, p1_, q0_, q1_, buf) do { unsigned char* s_ = lds + (buf) * STAGE; \
      *(u32x4*)(s_ + SA + GT_WOFF(lr, tid)) = p0_; *(u32x4*)(s_ + SA + 64 * ROWB + GT_WOFF(lr, tid)) = p1_; \
      *(u32x4*)(s_ + SB + GT_WOFF(lr, tid)) = q0_; *(u32x4*)(s_ + SB + 64 * ROWB + GT_WOFF(lr, tid)) = q1_; } while (0)
#define S5_COMPUTE(buf) do { \
      const unsigned char* As = lds + (buf) * STAGE + SA + (wr * 64 + fr) * ROWB; \
      const unsigned char* Bs = lds + (buf) * STAGE + SB + (wc * 32 + fr) * ROWB; \
      _Pragma("unroll") for (int ks = 0; ks < 2; ++ks) { \
        bf16x8 af[4], bfr[2]; \
        _Pragma("unroll") for (int m = 0; m < 4; ++m) af[m] = *(const bf16x8*)(As + m * 16 * ROWB + GT_RSW(ks, fq, fr)); \
        _Pragma("unroll") for (int n = 0; n < 2; ++n) bfr[n] = *(const bf16x8*)(Bs + n * 16 * ROWB + GT_RSW(ks, fq, fr)); \
        _Pragma("unroll") for (int m = 0; m < 4; ++m) _Pragma("unroll") for (int n = 0; n < 2; ++n) acc[m][n] = __builtin_amdgcn_mfma_f32_16x16x32_bf16(bfr[n], af[m], acc[m][n], 0, 0, 0); } } while (0)
    f32x4 acc[4][2]; ACC_ZERO(acc);
    S5_LOAD(xa0, xa1, xb0, xb1, 0); S5_STORE(xa0, xa1, xb0, xb1, 0); S5_LOAD(ya0, ya1, yb0, yb1, 1); __syncthreads();
    for (int st = 0; st < ns; st += 2) {
      if (st + 2 < ns) S5_LOAD(xa0, xa1, xb0, xb1, st + 2);
      S5_COMPUTE(0);
      if (st + 1 < ns) S5_STORE(ya0, ya1, yb0, yb1, 1);
      __syncthreads();
      if (st + 1 >= ns) break;
      if (st + 3 < ns) S5_LOAD(ya0, ya1, yb0, yb1, st + 3);
      S5_COMPUTE(1);
      if (st + 2 < ns) S5_STORE(xa0, xa1, xb0, xb1, 0);
      __syncthreads();
    }
#undef S5_LOAD
#undef S5_STORE
#undef S5_COMPUTE
    const float* dsk = P.in[13] + (size_t)(l * 32 + g) * 16;
#pragma unroll
    for (int m = 0; m < 4; ++m)
#pragma unroll
      for (int n = 0; n < 2; ++n) {
        const int R = rt * 128 + wr * 64 + m * 16 + fr, col = ct * 128 + wc * 32 + n * 16 + 4 * fq, t = col >> 4, h = col & 15;
        const u32x2 uu = *(const u32x2*)(ub + ((size_t)g * 256 + R) * 1024 + col); const f32x4 dd = *(const f32x4*)(dsk + h); const f32x4 v = acc[m][n];
        const float y0 = gelu_tanh(v.x + dd.x * bflo(uu.x)), y1 = gelu_tanh(v.y + dd.y * bfhi(uu.x)), y2 = gelu_tanh(v.z + dd.z * bflo(uu.y)), y3 = gelu_tanh(v.w + dd.w * bfhi(uu.y));
        const size_t tokn = (size_t)(R >> 7) * SEQ + 64 * (R & 127) + t;
        u32x2 o; o.x = pk2(y0, y1); o.y = pk2(y2, y3); *(u32x2*)(yb + tokn * 512 + g * 16 + h) = o;
      }
  }
}

DI void evt_arrive(const Params& P, int l) {
  asm volatile("s_waitcnt vmcnt(0)" ::: "memory");
  __syncthreads();
  const int G = gridDim.x, bid = obid();
  if (threadIdx.x == 0 && (G < 72 || bid < 64 || bid >= G - 8)) {
    __builtin_amdgcn_fence(__ATOMIC_RELEASE, "agent");
    (void)__hip_atomic_fetch_add((unsigned*)(P.ws + 768 + 64 * l), 1u, __ATOMIC_RELAXED, __HIP_MEMORY_SCOPE_AGENT);
  }
}
DI void evt_wait(const Params& P, int l) {
  const unsigned need = gridDim.x < 72 ? gridDim.x : 72u;
  if (threadIdx.x == 0) {
    unsigned* e = (unsigned*)(P.ws + 768 + 64 * l); unsigned sp = 0u;
    while (__hip_atomic_load(e, __ATOMIC_RELAXED, __HIP_MEMORY_SCOPE_AGENT) < need) { __builtin_amdgcn_s_sleep(1); if (++sp > (1u << 24)) break; }
    __builtin_amdgcn_fence(__ATOMIC_ACQUIRE, "agent");
  }
  __syncthreads();
}

constexpr int AT_ROWB = 144, AT_KS = 0, AT_VS = 2 * 64 * AT_ROWB, AT_IMP = 4 * 64 * AT_ROWB, AT_OACC = AT_IMP, AT_IMPS = 129, AT_EE = AT_IMP + 64 * AT_IMPS * 4,
              AT_SEL = AT_IMP + 66048, AT_QS = AT_SEL + 1024, AT_QL = AT_QS + 32768, AT_NJ = AT_QL + 8192, AT_ITEMS = AT_NJ + 512, AT_MREF = AT_ITEMS + 512,
              AT_LACC = AT_MREF + 1024, AT_INVQ = AT_LACC + 1024, AT_MISC = AT_INVQ + 512, AT_LOWN = AT_MISC + 64, AT_END = AT_LOWN + 1024;
static_assert(AT_END <= LDS_BYTES - 16, "attention LDS");
#define MFMA32(a, b, c) __builtin_amdgcn_mfma_f32_32x32x16_bf16((a), (b), (c), 0, 0, 0)
DI int crow_of(int reg, int hh) { return (reg & 3) + 8 * (reg >> 2) + 4 * hh; }

struct AttnState { f32x16 o0, o1; float m, l; };
DI void st_init(AttnState& S) { S.m = -1e30f; S.l = 0.f;
#pragma unroll
  for (int i = 0; i < 16; ++i) { S.o0[i] = 0.f; S.o1[i] = 0.f; } }

DI void at_ldk(const unsigned char* lds, int buf, int r, int hh, bf16x8 (&kf)[8]) {
  const unsigned char* kb = lds + AT_KS + buf * 64 * AT_ROWB + r * AT_ROWB + hh * 16;
#pragma unroll
  for (int ds = 0; ds < 4; ++ds) { kf[ds] = *(const bf16x8*)(kb + ds * 32); kf[4 + ds] = *(const bf16x8*)(kb + 32 * AT_ROWB + ds * 32); }
}
DI void at_ldv(const unsigned char* lds, int buf, int r, int hh, bf16x8 (&vf)[8]) {
  const unsigned char* vb = lds + AT_VS + buf * 64 * AT_ROWB + r * AT_ROWB + hh * 16;
#pragma unroll
  for (int gk = 0; gk < 4; ++gk) { vf[gk] = *(const bf16x8*)(vb + gk * 32); vf[4 + gk] = *(const bf16x8*)(vb + 32 * AT_ROWB + gk * 32); }
}
DI void at_qk(const bf16x8 (&kf)[8], const bf16x8 (&qf)[4], f32x16& p0, f32x16& p1) {
  const f32x16 z = {0.f, 0.f, 0.f, 0.f, 0.f, 0.f, 0.f, 0.f, 0.f, 0.f, 0.f, 0.f, 0.f, 0.f, 0.f, 0.f};
#pragma unroll
  for (int ds = 0; ds < 4; ++ds) { if (ds == 0) { p0 = MFMA32(kf[0], qf[0], z); p1 = MFMA32(kf[4], qf[0], z); } else { p0 = MFMA32(kf[ds], qf[ds], p0); p1 = MFMA32(kf[4 + ds], qf[ds], p1); } }
}
DI bf16x8 pack8(const f32x16& p, int s2) {
  u32x4 w; w.x = pk2(p[8 * s2], p[8 * s2 + 1]); w.y = pk2(p[8 * s2 + 2], p[8 * s2 + 3]); w.z = pk2(p[8 * s2 + 4], p[8 * s2 + 5]); w.w = pk2(p[8 * s2 + 6], p[8 * s2 + 7]);
  return __builtin_bit_cast(bf16x8, w);
}
DI void at_pv(const bf16x8 (&vf)[8], const f32x16& p0, const f32x16& p1, f32x16& oa, f32x16& ob) {
#pragma unroll
  for (int gk = 0; gk < 4; ++gk) {
    const bf16x8 pb = (gk < 2) ? pack8(p0, gk & 1) : pack8(p1, gk & 1);
    oa = MFMA32(vf[gk], pb, oa); ob = MFMA32(vf[4 + gk], pb, ob);
  }
}
template <int MODE>
DI void at_online(AttnState& S, f32x16& p0, f32x16& p1, int key0, int lo, int hi, bool on, int hh) {
  float tm = -1e30f;
  if (MODE == 1 && on) {
    int lor = lo - key0 - 4 * hh, hir = hi - key0 - 4 * hh;
    if (hir < lor) { lor = 4096; hir = 4096; }
    const unsigned span = (unsigned)(hir - lor);
#pragma unroll
    for (int i = 0; i < 16; ++i) { const int c0 = (i & 3) + 8 * (i >> 2);
      p0[i] = ((unsigned)(c0 - lor) <= span) ? p0[i] : -1e30f; p1[i] = ((unsigned)(c0 + 32 - lor) <= span) ? p1[i] : -1e30f; }
  }
  asm volatile("s_nop 15\n\ts_nop 7" : "+v"(tm) : "v"(p0[15]), "v"(p1[15]));
#define MX3_8(o_) asm("v_max3_f32 %0, %0, %1, %2\n\tv_max3_f32 %0, %0, %3, %4\n\tv_max3_f32 %0, %0, %5, %6\n\tv_max3_f32 %0, %0, %7, %8\n\tv_max3_f32 %0, %0, %9, %10\n\tv_max3_f32 %0, %0, %11, %12\n\tv_max3_f32 %0, %0, %13, %14\n\tv_max3_f32 %0, %0, %15, %16" \
      : "+v"(tm) : "v"(p0[o_]), "v"(p1[o_]), "v"(p0[o_ + 1]), "v"(p1[o_ + 1]), "v"(p0[o_ + 2]), "v"(p1[o_ + 2]), "v"(p0[o_ + 3]), "v"(p1[o_ + 3]), "v"(p0[o_ + 4]), "v"(p1[o_ + 4]), "v"(p0[o_ + 5]), "v"(p1[o_ + 5]), "v"(p0[o_ + 6]), "v"(p1[o_ + 6]), "v"(p0[o_ + 7]), "v"(p1[o_ + 7]))
  MX3_8(0); MX3_8(8);
#undef MX3_8
  tm = x32_max(tm);
  if (MODE == 2) tm = on ? tm : -1e30f;
  { const float mn = fmaxf(S.m, tm); const float al = __builtin_amdgcn_exp2f(S.m - mn); S.m = mn; S.l *= al;
#pragma unroll
    for (int i = 0; i < 16; ++i) { S.o0[i] *= al; S.o1[i] *= al; } }
  float mn = S.m;
  if (MODE == 2) mn = on ? mn : 1e30f;
  if (MODE == 1) mn = mn < -1e29f ? 1e30f : mn;
  float rs = 0.f;
#pragma unroll
  for (int i = 0; i < 16; ++i) {
    const float e0 = __builtin_amdgcn_exp2f(p0[i] - mn), e1 = __builtin_amdgcn_exp2f(p1[i] - mn);
    p0[i] = e0; p1[i] = e1; rs += e0 + e1;
  }
  S.l += rs;
}

DI void attn_tile(const Params& P_, unsigned char* lds, int b, int g, int c, int wl) {
  Params P = P_; { size_t z_ = 0; asm volatile("" : "+s"(z_)); P.ws = P_.ws + z_; }
#define AT_IDS const int tid = otid(), lane = tid & 63, w = tid >> 6, r = lane & 31, hh = lane >> 5, qi = 8 * w + (r >> 2), h = r & 3, t = 64 * c + qi, qrow = 32 * w + r, srow = tid >> 3, sch = (tid & 7) * 8, ahead = lane >> 4, ach = lane & 15; const unsigned tok = (unsigned)b * SEQ + t, goff = tok * 48 + g * 4 + h; (void)qi; (void)h; (void)t; (void)qrow; (void)srow; (void)sch; (void)ahead; (void)ach; (void)tok; (void)goff; (void)hh; (void)w; (void)r
  const bf16_t* qb = (const bf16_t*)(P.ws + WS_B); const bf16_t* kvk = (const bf16_t*)(P.ws + WS_C); const bf16_t* vT = (const bf16_t*)(P.ws + WS_DV);
  const bf16_t* kcb = (const bf16_t*)(P.ws + WS_KC); const bf16_t* vcb = (const bf16_t*)(P.ws + WS_VC);
  const float* gbase = (const float*)(P.ws + WS_GATES);
#define gates(i) gbase[goff + (i)]
  bf16_t* attn = (bf16_t*)(P.ws + WS_A);
  float* otb = (float*)(P.ws + WS_OT) + (size_t)obid() * 16384;
#define otg(i) otb[(unsigned)tid + (i) * 512u]
  float* IMP = (float*)(lds + AT_IMP); float* EE = (float*)(lds + AT_EE); unsigned* SEL = (unsigned*)(lds + AT_SEL);
  AttnState S; f32x16 p0, p1; u32x4 rkA, rvA; bf16x8 qf[4], kfr[8], vfr[8];
#define QF_LOAD() do { _Pragma("unroll") for (int ds_ = 0; ds_ < 4; ++ds_) qf[ds_] = *(const bf16x8*)(lds + AT_QS + qrow * 128 + (((ds_ * 2 + hh) ^ (qrow & 7)) * 16)); } while (0)
#define AT_QKV() do { at_ldk(lds, buf_, r, hh, kfr); __builtin_amdgcn_sched_barrier(0); at_qk(kfr, qf, p0, p1); at_ldv(lds, buf_, r, hh, vfr); __builtin_amdgcn_sched_barrier(0); } while (0)
  { AT_IDS;
  { const int row = tid >> 1, half = tid & 1, q_i = row >> 2, hd = row & 3;
    const unsigned so = ((unsigned)b * SEQ + 64 * c + q_i) * DM + (g * 4 + hd) * 64 + half * 32;
#pragma unroll
    for (int k = 0; k < 4; ++k) { const u32x4 v = *(const u32x4*)(qb + so + k * 8); *(u32x4*)(lds + AT_QS + row * 128 + (((half * 4 + k) ^ (row & 7)) * 16)) = v; } }
  __syncthreads();
  QF_LOAD();
#define ST_LOAD(rk, rv, kp, kstride, vp, vstride, kt) do { rk = *(const u32x4*)((kp) + (unsigned)(((kt) * 64 + srow) * (kstride) + sch)); rv = *(const u32x4*)((vp) + (unsigned)(srow * (vstride) + (kt) * 64 + sch)); } while (0)
#define ST_STORE(rk, rv, buf) do { *(u32x4*)(lds + AT_KS + (buf) * 64 * AT_ROWB + srow * AT_ROWB + sch * 2) = rk; *(u32x4*)(lds + AT_VS + (buf) * 64 * AT_ROWB + srow * AT_ROWB + sch * 2) = rv; } while (0)
#define SWEEP(kp, kstride, vp, vstride, kt0, n, ...) do { \
    ST_LOAD(rkA, rvA, kp, kstride, vp, vstride, (kt0)); ST_STORE(rkA, rvA, 0); __syncthreads(); \
    for (int i_ = 0; i_ < (n); ++i_) { \
      if (i_ + 1 < (n)) ST_LOAD(rkA, rvA, kp, kstride, vp, vstride, (kt0) + i_ + 1); \
      { const int step_ = i_; const int buf_ = i_ & 1; __VA_ARGS__ } \
      if (i_ + 1 < (n)) ST_STORE(rkA, rvA, (i_ + 1) & 1); \
      __syncthreads(); \
    } } while (0)
#define ST_LOADF(rk, rv, kt) do { rk = *(const u32x4*)(kps + (size_t)(kt) * 4096 + tid * 8); rv = *(const u32x4*)(vps + (size_t)(kt) * 4096 + tid * 8); } while (0)
#define ST_STOREF(rk, rv, buf) do { const int fo_ = ((tid >> 8) * 32 + (tid & 31)) * AT_ROWB + (((tid >> 6) & 3) * 2 + ((tid >> 5) & 1)) * 16; \
    *(u32x4*)(lds + AT_KS + (buf) * 64 * AT_ROWB + fo_) = rk; *(u32x4*)(lds + AT_VS + (buf) * 64 * AT_ROWB + fo_) = rv; } while (0)
#define SWEEPF(kt0, n, ...) do { \
    ST_LOADF(rkA, rvA, (kt0)); ST_STOREF(rkA, rvA, 0); __syncthreads(); \
    for (int i_ = 0; i_ < (n); ++i_) { \
      if (i_ + 1 < (n)) ST_LOADF(rkA, rvA, (kt0) + i_ + 1); \
      { const int step_ = i_; const int buf_ = i_ & 1; __VA_ARGS__ } \
      if (i_ + 1 < (n)) ST_STOREF(rkA, rvA, (i_ + 1) & 1); \
      __syncthreads(); \
    } } while (0)
  {
    const bf16_t* kp = kvk + (size_t)b * SEQ * DM + 3 * 256 + g * 64; const bf16_t* vp = vT + (size_t)(((1 * NB + b) * 4 + g) * 64) * SEQ;
    const int j0 = c >= 8 ? c - 8 : 0, nj = c - j0 + 1;
    st_init(S);
    SWEEP(kp, DM, vp, SEQ, j0, nj, {
      AT_QKV();
      at_online<1>(S, p0, p1, (j0 + step_) * 64, t - 511, t, (step_ == 0 && c >= 8) || step_ == nj - 1, hh);
      at_pv(vfr, p0, p1, S.o0, S.o1); });
    const float lt = x32_sum(S.l); const float sc = lt > 0.f ? gates(32) / lt : 0.f;
#pragma unroll
    for (int i = 0; i < 16; ++i) { otg(i) = S.o0[i] * sc; otg(16 + i) = S.o1[i] * sc; }
  }
  if (wl >= 0) evt_wait(P, wl);
  {
    const bf16_t* kcp = kcb + (size_t)((b * 4 + g) * 512) * 64; const bf16_t* vcp = vcb + (size_t)((b * 4 + g) * 64) * 512;
    const int nmax = t >= 31 ? (t - 31) >> 4 : -1;
    const int nct = (4 * c + 2) / 64 + 1;
    st_init(S);
    SWEEP(kcp, 64, vcp, 512, 0, nct, {
      at_ldk(lds, buf_, r, hh, kfr); __builtin_amdgcn_sched_barrier(0); at_qk(kfr, qf, p0, p1);
      at_online<1>(S, p0, p1, step_ * 64, 0, nmax, 64 * step_ + 63 > 4 * c - 2, hh); });
    const float lt = x32_sum(S.l);
    const float cm = lt > 0.f ? S.m + __builtin_amdgcn_logf(lt) : 1e30f;
    st_init(S);
    SWEEP(kcp, 64, vcp, 512, 0, nct, {
      AT_QKV();
      _Pragma("unroll") for (int k = 0; k < 16; ++k) { p0[k] = __builtin_amdgcn_exp2f(p0[k] - cm); p1[k] = __builtin_amdgcn_exp2f(p1[k] - cm); }
      if (64 * step_ + 63 > 4 * c - 2) {
        const int nrel = nmax - step_ * 64 - 4 * hh;
        _Pragma("unroll") for (int k = 0; k < 16; ++k) { const int c0 = (k & 3) + 8 * (k >> 2), c1 = c0 + 32; p0[k] = c0 <= nrel ? p0[k] : 0.f; p1[k] = c1 <= nrel ? p1[k] : 0.f; }
      }
      at_pv(vfr, p0, p1, S.o0, S.o1);
      _Pragma("unroll") for (int kh = 0; kh < 2; ++kh)
      _Pragma("unroll") for (int gi = 0; gi < 4; ++gi) {
          float g4 = kh == 0 ? (p0[4 * gi] + p0[4 * gi + 1]) + (p0[4 * gi + 2] + p0[4 * gi + 3]) : (p1[4 * gi] + p1[4 * gi + 1]) + (p1[4 * gi + 2] + p1[4 * gi + 3]);
          float e3 = kh == 0 ? p0[4 * gi + 3] : p1[4 * gi + 3];
          g4 += dppf<DPP_X1>(g4); g4 += dppf<DPP_X2>(g4); e3 += dppf<DPP_X1>(e3); e3 += dppf<DPP_X2>(e3);
          if (h == 0) { const int s = (step_ * 64 + kh * 32 + 8 * gi + 4 * hh) >> 2; IMP[qi * AT_IMPS + s] = g4; EE[qi * AT_IMPS + s] = e3; }
      } });
    const float gc = gates(0);
#pragma unroll
    for (int i = 0; i < 16; ++i) { p0[i] = otg(i); p1[i] = otg(16 + i); }
    __builtin_amdgcn_sched_barrier(0);
#pragma unroll
    for (int i = 0; i < 16; ++i) { otg(i) = p0[i] + S.o0[i] * gc; otg(16 + i) = p1[i] + S.o1[i] * gc; }
  }
  }
  const bf16_t* kps = (const bf16_t*)(P.ws + WS_KSF) + (size_t)((b * 4 + g) * 128) * 4096; const bf16_t* vps = vT + (size_t)((b * 4 + g) * 128) * 4096;
  if (c <= 15) { AT_IDS; QF_LOAD();
    st_init(S);
    if (c > 0) {
      SWEEPF(0, c, {
        AT_QKV();
        at_online<0>(S, p0, p1, 0, 0, 0, true, hh);
        at_pv(vfr, p0, p1, S.o0, S.o1); });
    }
    SWEEPF(c, 1, {
      AT_QKV();
      at_online<1>(S, p0, p1, (c + step_) * 64, 0, t, true, hh);
      at_pv(vfr, p0, p1, S.o0, S.o1); });
    const float lt = x32_sum(S.l); const float slc_sc = lt > 0.f ? gates(16) / lt : 0.f;
    bf16_t* op = attn + (tok * DM + (g * 4 + h) * 64);
#pragma unroll
    for (int i = 0; i < 16; ++i) { S.o0[i] = S.o0[i] * slc_sc + otg(i); S.o1[i] = S.o1[i] * slc_sc + otg(16 + i); }
#pragma unroll
    for (int gi = 0; gi < 4; ++gi) {
      u32x2 a; a.x = pk2(S.o0[4 * gi], S.o0[4 * gi + 1]); a.y = pk2(S.o0[4 * gi + 2], S.o0[4 * gi + 3]);
      u32x2 bq; bq.x = pk2(S.o1[4 * gi], S.o1[4 * gi + 1]); bq.y = pk2(S.o1[4 * gi + 2], S.o1[4 * gi + 3]);
      *(u32x2*)(op + 8 * gi + 4 * hh) = a; *(u32x2*)(op + 32 + 8 * gi + 4 * hh) = bq;
    }
  } else {
    const int nc = c - 2;
    unsigned char* QL = lds + AT_QL; int* NJ = (int*)(lds + AT_NJ); unsigned short* ITEMS = (unsigned short*)(lds + AT_ITEMS); int* MISC = (int*)(lds + AT_MISC);
    float* MREF = (float*)(lds + AT_MREF); float* LS = (float*)(lds + AT_LACC); unsigned char* INVQ = lds + AT_INVQ; unsigned char* SLOT = lds + AT_IMP;
    float* const LOWN = (float*)(lds + AT_LOWN); const float k64 = 5.421010862427522e-20f;
    { AT_IDS;
    { const int q = tid >> 3; for (int s = 1 + (tid & 7); s <= nc; s += 8) IMP[q * AT_IMPS + s] += EE[q * AT_IMPS + s - 1]; }
    if (tid < 256) SEL[tid] = 0u;
    if (tid < 128) ((unsigned*)INVQ)[tid] = 0u;
    __syncthreads();
    {
      const int q = tid >> 3, sub = tid & 7; const float* ip = IMP + q * AT_IMPS;
      unsigned key[16];
#pragma unroll
      for (int k = 0; k < 16; ++k) { const int s = 1 + sub + 8 * k; key[k] = s <= nc ? __float_as_uint(ip[s]) + 1u : 0u; }
      unsigned T = 0u; bool exact = false;
      for (int bit = 30; bit >= 0; --bit) {
        const unsigned cand = T | (1u << bit); int cn = 0;
#pragma unroll
        for (int k = 0; k < 16; ++k) cn += key[k] >= cand ? 1 : 0;
        cn = sum8i(cn);
        if (!exact && cn >= 13) { T = cand; exact = cn == 13; }
        if (__all(exact)) break;
      }
      int ngt = 0, neq = 0;
#pragma unroll
      for (int k = 0; k < 16; ++k) { ngt += key[k] > T ? 1 : 0; neq += key[k] == T ? 1 : 0; }
      ngt = sum8i(ngt); neq = sum8i(neq);
      const int need = 13 - ngt;
      unsigned w0 = 0u, w1 = 0u, w2 = 0u, w3 = 0u;
      if (!__any(neq > need)) {
#pragma unroll
        for (int k = 0; k < 16; ++k) if (key[k] >= T && key[k] != 0u) { const int s = 1 + sub + 8 * k; const unsigned bt = 1u << (s & 31); if (s < 32) w0 |= bt; else if (s < 64) w1 |= bt; else if (s < 96) w2 |= bt; else w3 |= bt; }
      } else {
        int taken = 0; const int gsh = lane & ~7;
#pragma unroll
        for (int k = 0; k < 16; ++k) {
          const bool eq = key[k] == T && key[k] != 0u; const unsigned long long mk = __ballot(eq);
          const unsigned grp = (unsigned)(mk >> gsh) & 0xffu; const int before = __popc(grp & ((1u << sub) - 1u));
          const bool pick = key[k] > T || (eq && taken + before < need);
          taken += __popc(grp);
          if (pick) { const int s = 1 + sub + 8 * k; const unsigned bt = 1u << (s & 31); if (s < 32) w0 |= bt; else if (s < 64) w1 |= bt; else if (s < 96) w2 |= bt; else w3 |= bt; }
        }
      }
      if (w0) atomicOr(&SEL[q * 4], w0); if (w1) atomicOr(&SEL[q * 4 + 1], w1); if (w2) atomicOr(&SEL[q * 4 + 2], w2); if (w3) atomicOr(&SEL[q * 4 + 3], w3);
    }
    __syncthreads();
    for (int j = 1 + w; j <= nc; j += NWAVE) {
      const bool bit = (SEL[lane * 4 + (j >> 5)] >> (j & 31)) & 1u;
      const unsigned long long mk = __ballot(bit);
      const int rank = __builtin_amdgcn_mbcnt_hi((unsigned)(mk >> 32), __builtin_amdgcn_mbcnt_lo((unsigned)mk, 0u));
      if (bit) QL[j * 64 + rank] = (unsigned char)lane;
      const int cnt = __popcll(mk);
      if (lane < ((8 - (cnt & 7)) & 7)) QL[j * 64 + cnt + lane] = 0;
      if (lane == 0) NJ[j] = cnt;
    }
    __syncthreads();
    if (w == 0) {
      const int ja = 1 + lane, jb = 65 + lane;
      const int ca = ja <= nc ? (NJ[ja] + 7) >> 3 : 0, cb = jb <= nc ? (NJ[jb] + 7) >> 3 : 0;
      int sa = ca, sb = cb;
#pragma unroll
      for (int o = 1; o < 64; o <<= 1) { const int ta = __shfl_up(sa, o), tb = __shfl_up(sb, o); if (lane >= o) { sa += ta; sb += tb; } }
      const int tota = __shfl(sa, 63);
      for (int k = 0; k < ca; ++k) ITEMS[sa - ca + k] = (unsigned short)(ja * 8 + k);
      for (int k = 0; k < cb; ++k) ITEMS[tota + sb - cb + k] = (unsigned short)(jb * 8 + k);
      if (lane == 63) MISC[0] = tota + sb;
    }
    }
    { AT_IDS; QF_LOAD();
    st_init(S);
    ST_LOADF(rkA, rvA, 0); ST_STOREF(rkA, rvA, 0); __syncthreads();
    for (int i_ = 0; i_ < 3; ++i_) {
      if (i_ + 1 < 3) ST_LOADF(rkA, rvA, c - 1 + i_);
      { const int step_ = i_; const int buf_ = i_ & 1;
        AT_QKV();
        at_online<1>(S, p0, p1, c * 64, 0, t, step_ == 2, hh);
        at_pv(vfr, p0, p1, S.o0, S.o1); }
      if (i_ + 1 < 3) ST_STOREF(rkA, rvA, (i_ + 1) & 1);
      __syncthreads();
    }
    { const float lt = x32_sum(S.l);
      if (hh == 0) { MREF[qrow] = S.m + 64.f; LS[w * 32 + r] = lt * k64; } }
#define SLOT_WRITE(x, o0_, o1_, scale_) do { unsigned char* sp_ = SLOT + (x) * 8192 + r * 256; \
      _Pragma("unroll") for (int gi_ = 0; gi_ < 4; ++gi_) { \
        const f32x4 va_ = {o0_[4 * gi_] * (scale_), o0_[4 * gi_ + 1] * (scale_), o0_[4 * gi_ + 2] * (scale_), o0_[4 * gi_ + 3] * (scale_)}; \
        const f32x4 vb_ = {o1_[4 * gi_] * (scale_), o1_[4 * gi_ + 1] * (scale_), o1_[4 * gi_ + 2] * (scale_), o1_[4 * gi_ + 3] * (scale_)}; \
        *(f32x4*)(sp_ + (((2 * gi_ + hh) ^ (r & 15)) * 16)) = va_; *(f32x4*)(sp_ + (((8 + 2 * gi_ + hh) ^ (r & 15)) * 16)) = vb_; } } while (0)
#define SLOT_READ(x, col_) (*(const f32x4*)(SLOT + (x) * 8192 + (col_) * 256 + ((ach ^ ((col_) & 15)) * 16)))
    SLOT_WRITE(w, S.o0, S.o1, k64);
    __syncthreads();
    }
    {
      AT_IDS; const int wu = __builtin_amdgcn_readfirstlane(w);
      const int nitems = MISC[0], nrounds = (((nitems + 3) >> 2) + 1) & ~1;
      if (wu >= 4) {
        const int ow = wu - 4, oq = lane >> 2, oh = lane & 3, srcslot = 2 * ow + (lane >> 5), scol = lane & 31;
        f32x4 acc[16]; float accl;
        { const unsigned char* rp = SLOT + srcslot * 8192 + scol * 256;
#pragma unroll
          for (int k = 0; k < 16; ++k) acc[k] = *(const f32x4*)(rp + ((k ^ (scol & 15)) * 16));
          accl = LS[srcslot * 32 + scol]; }
        __syncthreads();
        for (int rd = 0; rd <= nrounds; ++rd) {
          if (rd > 0) {
            const int set = (rd - 1) & 1;
            unsigned* ivp = (unsigned*)(INVQ + set * 256) + 16 * ow + oq;
            unsigned iv = *ivp;
            if (__any(iv != 0u)) {
              if (iv != 0u && oh == 0) *ivp = 0u;
              do {
                const int xa = (iv & 0xffu) ? 0 : (iv & 0xff00u) ? 1 : (iv & 0xff0000u) ? 2 : 3;
                const unsigned ba = (iv >> (8 * xa)) & 0xffu; iv &= ~(0xffu << (8 * xa));
                const int xb = (iv & 0xffu) ? 0 : (iv & 0xff00u) ? 1 : (iv & 0xff0000u) ? 2 : 3;
                const unsigned bb = (iv >> (8 * xb)) & 0xffu; iv &= ~(0xffu << (8 * xb));
                const float wa = ba ? 1.f : 0.f, wb = bb ? 1.f : 0.f;
                const int cola = ba ? (int)(ba - 1) * 4 + oh : 0, colb = bb ? (int)(bb - 1) * 4 + oh : 0;
                const unsigned char* rpa = SLOT + (set * 4 + xa) * 8192 + cola * 256; const unsigned char* rpb = SLOT + (set * 4 + xb) * 8192 + colb * 256;
                const bool twob = __any(bb != 0u);
                f32x4 tq[16], tr[16]; float tla, tlb = 0.f;
#pragma unroll
                for (int k = 0; k < 16; ++k) tq[k] = *(const f32x4*)(rpa + ((k ^ (cola & 15)) * 16));
                tla = LS[(set * 4 + xa) * 32 + cola];
                if (twob) {
#pragma unroll
                  for (int k = 0; k < 16; ++k) tr[k] = *(const f32x4*)(rpb + ((k ^ (colb & 15)) * 16));
                  tlb = LS[(set * 4 + xb) * 32 + colb];
                }
                __builtin_amdgcn_sched_barrier(0);
#pragma unroll
                for (int k = 0; k < 16; ++k) acc[k] += wa * tq[k];
                accl += wa * tla;
                if (twob) {
#pragma unroll
                  for (int k = 0; k < 16; ++k) acc[k] += wb * tr[k];
                  accl += wb * tlb;
                }
              } while (__any(iv != 0u));
            }
          }
          __syncthreads();
        }
#pragma unroll
        for (int i = 0; i < 16; ++i) { S.o0[i] = otg(i); S.o1[i] = otg(16 + i); }
        SLOT_WRITE(w, S.o0, S.o1, 1.0f);
        __syncthreads();
        {
          const unsigned tq = (unsigned)b * SEQ + 64 * c + 16 * ow + oq;
          const float gs = gbase[tq * 48 + 16 + g * 4 + oh]; const float sc = accl > 0.f ? gs / accl : 0.f;
          const unsigned char* rp = SLOT + srcslot * 8192 + scol * 256;
          bf16_t* op = attn + (tq * DM + (g * 4 + oh) * 64);
#pragma unroll
          for (int k2 = 0; k2 < 8; ++k2) {
            const f32x4 v0 = acc[2 * k2] * sc + *(const f32x4*)(rp + (((2 * k2) ^ (scol & 15)) * 16)), v1 = acc[2 * k2 + 1] * sc + *(const f32x4*)(rp + (((2 * k2 + 1) ^ (scol & 15)) * 16));
            u32x4 o; o.x = pk2(v0.x, v0.y); o.y = pk2(v0.z, v0.w); o.z = pk2(v1.x, v1.y); o.w = pk2(v1.z, v1.w);
            *(u32x4*)(op + 8 * k2) = o;
          }
        }
      } else {
        __syncthreads();
        const bf16_t* kgl = kps + lane * 8; const bf16_t* vgl = vps + lane * 8;
        bf16x8 kfA[8], kfB[8], vf[8]; f32x16 pn0, pn1;
#define ENTRY(k_) ((wu + 4 * (k_)) < nitems ? __builtin_amdgcn_readfirstlane((int)ITEMS[wu + 4 * (k_)]) : 0)
#define KLOAD8(KF, e_) do { _Pragma("unroll") for (int f_ = 0; f_ < 8; ++f_) KF[f_] = *(const bf16x8*)(kgl + (size_t)((e_) >> 3) * 4096 + f_ * 512); } while (0)
#define VLOAD8(e_) do { _Pragma("unroll") for (int f_ = 0; f_ < 8; ++f_) vf[f_] = *(const bf16x8*)(vgl + (size_t)((e_) >> 3) * 4096 + f_ * 512); } while (0)
#define QKMM(KF, row_, d0, d1) do { bf16x8 qv[4]; \
          _Pragma("unroll") for (int ds = 0; ds < 4; ++ds) qv[ds] = *(const bf16x8*)(lds + AT_QS + (row_) * 128 + (((ds * 2 + hh) ^ ((row_) & 7)) * 16)); \
          __builtin_amdgcn_sched_barrier(0); \
          const f32x16 z_ = {0.f, 0.f, 0.f, 0.f, 0.f, 0.f, 0.f, 0.f, 0.f, 0.f, 0.f, 0.f, 0.f, 0.f, 0.f, 0.f}; \
          _Pragma("unroll") for (int ds = 0; ds < 4; ++ds) { if (ds == 0) { d0 = MFMA32(KF[0], qv[0], z_); d1 = MFMA32(KF[4], qv[0], z_); } else { d0 = MFMA32(KF[ds], qv[ds], d0); d1 = MFMA32(KF[4 + ds], qv[ds], d1); } } } while (0)
        int e1 = ENTRY(1), e2 = ENTRY(2);
        int qqc, rowN, qqN; bool validc, validN; float mrc;
        { const int e0 = ENTRY(0);
          KLOAD8(kfA, e0); VLOAD8(e0); KLOAD8(kfB, e1);
          const int j0_ = e0 >> 3, qs0 = 8 * (e0 & 7) + (r >> 2); validc = wu < nitems && qs0 < NJ[j0_]; qqc = QL[j0_ * 64 + qs0] & 63; const int row0_ = qqc * 4 + h; mrc = validc ? MREF[row0_] : 1e30f;
          const int j1_ = e1 >> 3, qs1 = 8 * (e1 & 7) + (r >> 2); validN = wu + 4 < nitems && qs1 < NJ[j1_]; qqN = QL[j1_ * 64 + qs1] & 63; rowN = qqN * 4 + h;
          QKMM(kfA, row0_, p0, p1);
          KLOAD8(kfA, e2); }
#define ITEM_ROUND(KQ, k_, PC0, PC1, PX0, PX1) do { \
          const int set = (k_) & 1; \
          const int e3 = ENTRY((k_) + 3); \
          const int j2_ = e2 >> 3, qs2 = 8 * (e2 & 7) + (r >> 2); const int nj2 = NJ[j2_]; const int qq2 = QL[j2_ * 64 + qs2] & 63; \
          const float mrN = validN ? MREF[rowN] : 1e30f; \
          QKMM(KQ, rowN, PX0, PX1);                                       \
          float rs = 0.f; \
          _Pragma("unroll") for (int i = 0; i < 16; ++i) { \
            PC0[i] = __builtin_amdgcn_exp2f(fminf(PC0[i] - mrc, 120.f)); PC1[i] = __builtin_amdgcn_exp2f(fminf(PC1[i] - mrc, 120.f)); rs += PC0[i] + PC1[i]; \
            if (i & 1) { KQ[i >> 1] = *(const bf16x8*)(kgl + (size_t)(e3 >> 3) * 4096 + (i >> 1) * 512); __builtin_amdgcn_sched_barrier(0); } \
          } \
          rs = x32_sum(rs); \
          const f32x16 z = {0.f, 0.f, 0.f, 0.f, 0.f, 0.f, 0.f, 0.f, 0.f, 0.f, 0.f, 0.f, 0.f, 0.f, 0.f, 0.f}; \
          f32x16 o0 = z, o1 = z; \
          _Pragma("unroll") for (int gk = 0; gk < 4; ++gk) { const bf16x8 pb = (gk < 2) ? pack8(PC0, gk & 1) : pack8(PC1, gk & 1); o0 = MFMA32(vf[gk], pb, o0); o1 = MFMA32(vf[4 + gk], pb, o1); } \
          { unsigned char* sp_ = SLOT + (set * 4 + wu) * 8192 + r * 256; \
            _Pragma("unroll") for (int gi = 0; gi < 4; ++gi) { \
              const f32x4 va_ = {o0[4 * gi], o0[4 * gi + 1], o0[4 * gi + 2], o0[4 * gi + 3]}; const f32x4 vb_ = {o1[4 * gi], o1[4 * gi + 1], o1[4 * gi + 2], o1[4 * gi + 3]}; \
              *(f32x4*)(sp_ + (((2 * gi + hh) ^ (r & 15)) * 16)) = va_; *(f32x4*)(sp_ + (((8 + 2 * gi + hh) ^ (r & 15)) * 16)) = vb_; \
              vf[2 * gi] = *(const bf16x8*)(vgl + (size_t)(e1 >> 3) * 4096 + (2 * gi) * 512); vf[2 * gi + 1] = *(const bf16x8*)(vgl + (size_t)(e1 >> 3) * 4096 + (2 * gi + 1) * 512); \
              __builtin_amdgcn_sched_barrier(0); \
            } } \
          if (hh == 0) LS[(set * 4 + wu) * 32 + r] = rs; \
          if (validc && h == 0 && hh == 0) INVQ[set * 256 + qqc * 4 + wu] = (unsigned char)((r >> 2) + 1); \
          qqc = qqN; validc = validN; mrc = mrN; \
          validN = (wu + 4 * ((k_) + 2)) < nitems && qs2 < nj2; qqN = qq2; rowN = qq2 * 4 + h; \
          e1 = e2; e2 = e3; \
        } while (0)
        for (int rd = 0; rd < nrounds; rd += 2) {
          ITEM_ROUND(kfB, rd, p0, p1, pn0, pn1);
          __syncthreads();
          ITEM_ROUND(kfA, rd + 1, pn0, pn1, p0, p1);
          __syncthreads();
        }
#undef ITEM_ROUND
#undef QKMM
#undef KLOAD8
#undef VLOAD8
#undef ENTRY
#undef ITEM_META
#undef KLOAD
#undef VLOAD
        __syncthreads();
#pragma unroll
        for (int i = 0; i < 16; ++i) { S.o0[i] = otg(i); S.o1[i] = otg(16 + i); }
        SLOT_WRITE(w, S.o0, S.o1, 1.0f);
        __syncthreads();
      }
    }
#undef SLOT_WRITE
#undef SLOT_READ
  }
  __syncthreads();
#undef ST_LOAD
#undef ST_STORE
#undef SWEEP
#undef ST_LOADF
#undef ST_STOREF
#undef SWEEPF
#undef gates
#undef otg
#undef QF_LOAD
#undef AT_QKV
#undef AT_IDS
}
DI void phase_attn(const Params& P_, int l, unsigned char* lds) {
  Params P = P_; { size_t z_ = 0; asm volatile("" : "+s"(z_)); P.ws = P_.ws + z_; }
  const int G = gridDim.x, bx = obid();
  const int vcu = (G % 8 == 0) ? (bx % 8) * (G / 8) + bx / 8 : bx;
  int wl = l;
  for (int idx = vcu; idx < 1024; idx += G) {
    const int i = idx >> 8, v = idx & 255, bg = v >> 5, s = v & 31;
    const int c = i == 0 ? s : i == 1 ? 63 - s : i == 2 ? 64 + s : 127 - s;
    attn_tile(P, lds, bg >> 2, bg & 3, c, wl);
    wl = -1;
  }
  if (wl >= 0) evt_wait(P, wl);
}


#define LAS __attribute__((address_space(3)))
#define XB_TMO      128
#define XB_XCNT(j)  (256  + 64 * (j))
#define XB_XSUB(j)  (1280 + 64 * (j))
#define XB_XGEN(j)  (2304 + 64 * (j))
#define XB_TOP      3328
#define XB_TOPGEN   3392
#define XCD_BAR_WORDS 3456
#define XB_SPIN_CAP (1u << 18)
__device__ __forceinline__ unsigned xb_ld(unsigned* p)              { return __hip_atomic_load(p, __ATOMIC_RELAXED, __HIP_MEMORY_SCOPE_AGENT); }
__device__ __forceinline__ unsigned xb_add(unsigned* p, unsigned v) { return __hip_atomic_fetch_add(p, v, __ATOMIC_RELAXED, __HIP_MEMORY_SCOPE_AGENT); }
__device__ __forceinline__ unsigned xb_xcc_id() { return (unsigned)__builtin_amdgcn_s_getreg((3 << 11) | 20) & 0xFu; }
#define XB_SPIN(cond, bar) do { unsigned _sp = 0; while (cond) { __builtin_amdgcn_s_sleep(1); \
    if ((++_sp & 255u) == 0u) { if (xb_ld(&(bar)[XB_TMO])) break; if (_sp > XB_SPIN_CAP) { atomicAdd(&(bar)[XB_TMO], 1u); break; } } } } while (0)
struct XcdBarrier { unsigned* bar; unsigned x; volatile LAS unsigned* st; };
__device__ __forceinline__ XcdBarrier xcd_barrier_post(unsigned* bar, volatile LAS unsigned* st) {
    XcdBarrier b; b.bar = bar; b.x = xb_xcc_id(); b.st = st;
    if (threadIdx.x == 0) (void)xb_add(&bar[XB_XCNT(b.x)], 1u);
    return b;
}
__device__ __forceinline__ void xcd_barrier_complete(unsigned* bar, unsigned x, unsigned& nloc, unsigned& nx) {
    const unsigned G = gridDim.x * gridDim.y * gridDim.z;
    unsigned sum, cnt, mine, sp = 0u;
    for (;;) {
        sum = 0u; cnt = 0u; mine = 0u;
#pragma unroll
        for (unsigned j = 0; j < 16; ++j) { const unsigned c = xb_ld(&bar[XB_XCNT(j)]); sum += c; cnt += (c > 0u) ? 1u : 0u; mine = (j == x) ? c : mine; }
        if (sum == G) break;
        __builtin_amdgcn_s_sleep(1);
        if ((++sp & 255u) == 0u) { if (xb_ld(&bar[XB_TMO])) break; if (sp > XB_SPIN_CAP) { atomicAdd(&bar[XB_TMO], 1u); break; } }
    }
    nloc = mine > 0u ? mine : 1u; nx = cnt > 0u ? cnt : 1u;
}
__device__ __forceinline__ void xcd_barrier(const XcdBarrier& b) {
    asm volatile("s_waitcnt vmcnt(0)" ::: "memory");
    __syncthreads();
    if (threadIdx.x == 0) {
        unsigned* bar = b.bar; { size_t z_ = 0; asm volatile("" : "+s"(z_)); bar += z_; }
        __builtin_amdgcn_s_waitcnt(0);
        unsigned nloc = b.st[0], nx = b.st[1];
        if (nloc == 0u) { xcd_barrier_complete(bar, b.x, nloc, nx); b.st[0] = nloc; b.st[1] = nx; }
        const unsigned old = xb_add(&bar[XB_XSUB(b.x)], 1u);
        const unsigned gen = old / nloc;
        const unsigned target = (gen + 1u) * nx;
        bool done_ = false;
        if (old + 1u == (gen + 1u) * nloc) {
            __builtin_amdgcn_fence(__ATOMIC_RELEASE, "agent");
            asm volatile("s_waitcnt vmcnt(0)" ::: "memory");
            done_ = xb_add(&bar[XB_TOP], 1u) + 1u >= target;
        }
        if (!done_) XB_SPIN(xb_ld(&bar[XB_TOP]) < target, bar);
        __builtin_amdgcn_fence(__ATOMIC_ACQUIRE, "agent");
        asm volatile("s_waitcnt vmcnt(0)" ::: "memory");
    }
    __syncthreads();
}

__global__ void __launch_bounds__(NTHR) fwd_kernel(Params P) {
  extern __shared__ __attribute__((aligned(16))) unsigned char lds[];
  cg::grid_group grid = cg::this_grid();
  const int gtid = blockIdx.x * NTHR + threadIdx.x;
  if (threadIdx.x < 4) ((unsigned*)(lds + LDS_BYTES - 16))[threadIdx.x] = 0u;
  __syncthreads();
  if (blockIdx.x == 0) for (int i = threadIdx.x; i < (int)(WS_ZERO_BYTES / 16); i += NTHR) ((u32x4*)P.ws)[i] = (u32x4){0u, 0u, 0u, 0u};
  s5_params(P, gtid);
  {
    float* modb = (float*)(P.ws + WS_MOD); float* cbb = (float*)(P.ws + WS_CB);
    for (int it = blockIdx.x; it < 192 + 16; it += gridDim.x) {
      if (it < 192) { const int l = it / 96, j0 = (it % 96) * 64;
        gemv_item((float*)lds, P.in[2] + (size_t)l * DM * 6144, DM, 6144, j0, P.in[1], P.in[1] + DM, true, P.in[3] + l * 6144, modb + (size_t)(l * 2) * 6144, modb + (size_t)(l * 2 + 1) * 6144);
      } else { const int r = it - 192, l = r >> 3, kv = (r >> 2) & 1, j0 = (r & 3) * 64;
        gemv_item((float*)lds, P.in[17] + (size_t)(l * 2 + kv) * 2048 * 256, 2048, 256, j0, P.in[16] + (size_t)(l * 2 + kv) * 2048, nullptr, false, nullptr, cbb + (l * 2 + kv) * 256, nullptr);
      }
    }
  }
  if ((blockIdx.x >> 3) & 1) { convert_weights(P, 0, lds); __syncthreads(); }
  for (int it = blockIdx.x; it < DEPTH * 32 * 6; it += gridDim.x) s5_tables(P, it / 192, (it % 192) / 6, it % 6, lds);
  if (!((blockIdx.x >> 3) & 1)) { __syncthreads(); convert_weights(P, 0, lds); }
  grid.sync();
  const XcdBarrier xbar = xcd_barrier_post((unsigned*)(P.ws + WS_BAR), (volatile LAS unsigned*)(lds + LDS_BYTES - 16));
#define GSYNC() xcd_barrier(xbar)
  for (int l = 0; l < DEPTH; ++l) {
    if (l == 0) norm_simple<0>(P, l); else { norm_simple<1>(P, l); convert_weights(P, 1, lds); }
    GSYNC();
#if EN_MIXER
    phase_inproj8(P, lds);
    GSYNC();
    phase_s5a(P, l, lds);
    __syncthreads();
#if EN_ATTN
    phase_gates(P, lds);
    __syncthreads();
    phase_cmp1(P, l, lds);
#endif
    GSYNC();
    s5_carry(P, l);
#if EN_ATTN
    phase_cmp2(P, lds);
    evt_arrive(P, l);
    phase_attn(P, l, lds);
    __syncthreads();
#else
    GSYNC();
#endif
    phase_s5c(P, l, lds);
    GSYNC();
    phase_glu(P, lds);
    GSYNC();
    phase_merge8(P, lds);
    GSYNC();
    phase_wout8(P, l, lds);
    GSYNC();
#else
    if (l == 0) { for (size_t i = (size_t)gtid * 4; i < (size_t)NT * DM; i += (size_t)gridDim.x * NTHR * 4) *(f32x4*)(P.out + i) = *(const f32x4*)(P.in[0] + i); GSYNC(); }
#endif
#if EN_MOE
    norm_route(P, l, lds);
    GSYNC();
    phase_moe1(P, l, lds);
    GSYNC();
    phase_moe2(P, l, lds);
    GSYNC();
#endif
  }
  norm_simple<3>(P, 0);
}

extern "C" void kernel_launch(void* const* d_in, const int* in_sizes, int n_in, void* d_out, int out_size, void* d_ws, size_t ws_size, hipStream_t stream) {
  static int grid = 0;
  if (grid == 0) {
    if (n_in != 30 || out_size != NT * DM || ws_size < WS_END2) { fprintf(stderr, "kernel_launch: unexpected shapes (n_in %d out %d ws %zu need %zu)\n", n_in, out_size, ws_size, (size_t)WS_END2); grid = -1; return; }
    int dev = 0, cus = 0, per_cu = 0;
    hipGetDevice(&dev);
    hipDeviceGetAttribute(&cus, hipDeviceAttributeMultiprocessorCount, dev);
    hipFuncSetAttribute((const void*)fwd_kernel, hipFuncAttributeMaxDynamicSharedMemorySize, LDS_BYTES);
    hipOccupancyMaxActiveBlocksPerMultiprocessor(&per_cu, (const void*)fwd_kernel, NTHR, LDS_BYTES);
    if (per_cu < 1) { fprintf(stderr, "kernel_launch: occupancy query says %d blocks/CU\n", per_cu); per_cu = 1; }
    grid = cus;
    (void)hipGetLastError();
  }
  if (grid < 0) return;
  Params p{};
  for (int i = 0; i < 30; ++i) p.in[i] = (const float*)d_in[i];
  p.out = (float*)d_out; p.ws = (unsigned char*)d_ws;
  void* args[] = {&p};
  hipError_t e = hipLaunchCooperativeKernel((const void*)fwd_kernel, dim3(grid), dim3(NTHR), args, LDS_BYTES, stream);
  if (e != hipSuccess) fprintf(stderr, "cooperative launch failed: %s (grid %d)\n", hipGetErrorString(e), grid);
}
```
